# Optimizing an MI355X kernel written in HIP

```python
import jax
import jax.numpy as jnp
from jax import lax
import numpy as np

D_MODEL = 1024
BATCH = 16
SEQ = 2048
DEPTH = 4

N_MIXERS = 2
N_A_LAYERS = (DEPTH + 1) // 2
N_B_LAYERS = DEPTH // 2
HGRN_EXPAND = 128
HGRN_HEADS = D_MODEL // HGRN_EXPAND
HGRN_HEAD_V = D_MODEL // HGRN_HEADS
HGRN_CHUNK = 16
HGRN_IN = 4 * D_MODEL
RET_HEADS = 4
RET_QK_DIM = D_MODEL // RET_HEADS
RET_V_DIM = 2 * D_MODEL // RET_HEADS
RET_QK = RET_HEADS * RET_QK_DIM
RET_VD = RET_HEADS * RET_V_DIM
RET_IN = 2 * RET_QK + 2 * RET_VD
RET_CHUNK = 128
ROPE_BASE = 10000.0
N_EXPERTS = 32
TOP_K = 4
D_FF = D_MODEL
SWIGLU_LIMIT = 7.0
SWIGLU_ALPHA = 1.702
EXPERT_BLOCK = 256
DN_ALPHA = (2 * DEPTH) ** 0.25
DN_BETA = (8 * DEPTH) ** -0.25
LN_EPS = 1e-5
RMS_EPS = 1e-6

kernel_name = "hgrn2_retention_moe_deepnorm"


def layer_norm(x, g, b):
    xf = x.astype(jnp.float32)
    mu = jnp.mean(xf, axis=-1, keepdims=True)
    var = jnp.mean(jnp.square(xf - mu), axis=-1, keepdims=True)
    return ((xf - mu) * lax.rsqrt(var + LN_EPS) * g.astype(jnp.float32) + b.astype(jnp.float32)).astype(x.dtype)


def rms_norm(x, g):
    xf = x.astype(jnp.float32)
    return xf * lax.rsqrt(jnp.mean(jnp.square(xf), axis=-1, keepdims=True) + RMS_EPS) * g.astype(jnp.float32)


def rotate_every_two(t):
    t1 = t[..., ::2]
    t2 = t[..., 1::2]
    return jnp.stack((-t2, t1), axis=-1).reshape(t.shape)


def rotary_tables(seq_len):
    pos = jnp.arange(seq_len, dtype=jnp.float32)
    inv = 1.0 / (ROPE_BASE ** jnp.linspace(0.0, 1.0, RET_QK_DIM // 2, dtype=jnp.float32))
    theta = pos[:, None] * jnp.repeat(inv, 2)[None, :]
    return jnp.cos(theta), jnp.sin(theta)


def chunk_gated_linear_recurrence(q, k, v, log_f, chunk):
    B, H, S, K = q.shape
    V = v.shape[-1]
    n = S // chunk
    q = q.reshape(B, H, n, chunk, K)
    k = k.reshape(B, H, n, chunk, K)
    v = v.reshape(B, H, n, chunk, V)
    b = jnp.cumsum(log_f.reshape(B, H, n, chunk, K), axis=3)
    b_last = b[:, :, :, -1:, :]
    q_dec = q * jnp.exp(b)
    k_inv = k * jnp.exp(-b)
    k_st = k * jnp.exp(b_last - b)
    causal = jnp.tril(jnp.ones((chunk, chunk), dtype=bool))
    scores = jnp.where(causal, jnp.einsum('bhnck,bhnsk->bhncs', q_dec, k_inv), 0.0)
    o_intra = jnp.einsum('bhncs,bhnsv->bhncv', scores, v)
    chunk_decay = jnp.exp(b_last[:, :, :, 0, :])

    def step(state, inp):
        qc, kc, vc, dc = inp
        out = jnp.einsum('bhck,bhkv->bhcv', qc, state)
        state = state * dc[..., None] + jnp.einsum('bhck,bhcv->bhkv', kc, vc)
        return state, out

    init = jnp.zeros((B, H, K, V), jnp.float32)
    xs = (jnp.moveaxis(q_dec, 2, 0), jnp.moveaxis(k_st, 2, 0), jnp.moveaxis(v, 2, 0), jnp.moveaxis(chunk_decay, 2, 0))
    _, o_inter = lax.scan(step, init, xs)
    return (o_intra + jnp.moveaxis(o_inter, 0, 2)).reshape(B, H, S, V)


def chunk_retention(q, k, v, log_gamma, chunk):
    B, H, S, K = q.shape
    V = v.shape[-1]
    n = S // chunk
    q = q.reshape(B, H, n, chunk, K)
    k = k.reshape(B, H, n, chunk, K)
    v = v.reshape(B, H, n, chunk, V)
    idx = jnp.arange(chunk, dtype=jnp.float32)
    lg = log_gamma[:, None]
    rel = idx[:, None] - idx[None, :]
    decay = jnp.where(rel >= 0, jnp.exp(rel[None] * log_gamma[:, None, None]), 0.0)
    scores = jnp.einsum('bhnck,bhnsk->bhncs', q, k) * decay[None, :, None]
    o_intra = jnp.einsum('bhncs,bhnsv->bhncv', scores, v)
    q_in = q * jnp.exp((idx + 1.0)[None, :] * lg)[None, :, None, :, None]
    k_st = k * jnp.exp((chunk - 1.0 - idx)[None, :] * lg)[None, :, None, :, None]
    chunk_decay = jnp.exp(chunk * log_gamma)[None, :, None, None]

    def step(state, inp):
        qc, kc, vc = inp
        out = jnp.einsum('bhck,bhkv->bhcv', qc, state)
        state = state * chunk_decay + jnp.einsum('bhck,bhcv->bhkv', kc, vc)
        return state, out

    init = jnp.zeros((B, H, K, V), jnp.float32)
    xs = (jnp.moveaxis(q_in, 2, 0), jnp.moveaxis(k_st, 2, 0), jnp.moveaxis(v, 2, 0))
    _, o_inter = lax.scan(step, init, xs)
    return (o_intra + jnp.moveaxis(o_inter, 0, 2)).reshape(B, H, S, V)


def hgrn2_mixer(x, w_in, norm_g, w_out, lb):
    B, S, D = x.shape
    q, f, i, g = jnp.split(x @ w_in, 4, axis=-1)
    sf = f.astype(jnp.float32)
    forget = lb + (1.0 - lb) * jax.nn.sigmoid(sf)
    k = (1.0 - lb) * jax.nn.sigmoid(-sf)
    log_f = jnp.log(forget)

    def heads(t, d):
        return t.reshape(B, S, HGRN_HEADS, d).transpose(0, 2, 1, 3).astype(jnp.float32)

    o = chunk_gated_linear_recurrence(heads(jax.nn.silu(q), HGRN_EXPAND), heads(k, HGRN_EXPAND),
                                      heads(i, HGRN_HEAD_V), heads(log_f, HGRN_EXPAND), HGRN_CHUNK)
    o = o.transpose(0, 2, 1, 3).reshape(B, S, D)
    o = rms_norm(o, norm_g) * jax.nn.silu(g.astype(jnp.float32))
    return o.astype(x.dtype) @ w_out


def retention_mixer(x, w_in, w_out, cos, sin):
    B, S, _ = x.shape
    h = x @ w_in
    q = h[..., :RET_QK].reshape(B, S, RET_HEADS, RET_QK_DIM)
    k = h[..., RET_QK:2 * RET_QK].reshape(B, S, RET_HEADS, RET_QK_DIM)
    v = h[..., 2 * RET_QK:2 * RET_QK + RET_VD].reshape(B, S, RET_HEADS, RET_V_DIM)
    g = h[..., 2 * RET_QK + RET_VD:]
    c = cos[None, :, None, :]
    s = sin[None, :, None, :]
    q = q * c + rotate_every_two(q) * s
    k = (k * c + rotate_every_two(k) * s) * (RET_QK_DIM ** -0.5)

    def bhsd(t):
        return t.transpose(0, 2, 1, 3).astype(jnp.float32)

    log_gamma = jnp.log(1.0 - 2.0 ** (-5.0 - jnp.arange(RET_HEADS, dtype=jnp.float32)))
    o = chunk_retention(bhsd(q), bhsd(k), bhsd(v), log_gamma, RET_CHUNK)
    mu = jnp.mean(o, axis=-1, keepdims=True)
    var = jnp.mean(jnp.square(o - mu), axis=-1, keepdims=True)
    o = (o - mu) * lax.rsqrt(var + LN_EPS)
    o = o.transpose(0, 2, 1, 3).reshape(B, S, RET_VD)
    return (jax.nn.silu(g.astype(jnp.float32)) * o).astype(x.dtype) @ w_out


def moe_ffn(x2, w_r, b_r, w_gu, b_gu, w_dn, b_dn):
    N, D = x2.shape
    logits = (x2 @ w_r).astype(jnp.float32) + b_r.astype(jnp.float32)
    top_val, top_idx = lax.top_k(logits, TOP_K)
    gate = jax.nn.softmax(top_val, axis=-1)
    A = N * TOP_K
    flat_e = top_idx.reshape(-1)
    flat_tok = jnp.arange(A, dtype=jnp.int32) // TOP_K
    flat_w = gate.reshape(-1)
    order = jnp.argsort(flat_e)
    se = flat_e[order]
    counts = jnp.bincount(flat_e, length=N_EXPERTS).astype(jnp.int32)
    padded = (counts + EXPERT_BLOCK - 1) // EXPERT_BLOCK * EXPERT_BLOCK
    start = jnp.cumsum(counts) - counts
    pend = jnp.cumsum(padded)
    pstart = pend - padded
    dest = pstart[se] + (jnp.arange(A, dtype=jnp.int32) - start[se])
    n_blocks = -(-A // EXPERT_BLOCK) + N_EXPERTS
    n_rows = n_blocks * EXPERT_BLOCK
    row_tok = jnp.zeros((n_rows,), jnp.int32).at[dest].set(flat_tok[order])
    row_w = jnp.zeros((n_rows,), x2.dtype).at[dest].set(flat_w[order].astype(x2.dtype))
    block_starts = jnp.arange(n_blocks, dtype=jnp.int32) * EXPERT_BLOCK
    blk_e = jnp.minimum(jnp.searchsorted(pend, block_starts, side='right'), N_EXPERTS - 1)

    def expert_block(args):
        tok, wt, e = args
        h = x2[tok] @ w_gu[e] + b_gu[e]
        glu = jnp.minimum(h[:, ::2], SWIGLU_LIMIT)
        lin = jnp.clip(h[:, 1::2], -SWIGLU_LIMIT, SWIGLU_LIMIT)
        a = glu * jax.nn.sigmoid(SWIGLU_ALPHA * glu) * (lin + 1.0)
        return (a @ w_dn[e] + b_dn[e]) * wt[:, None]

    yb = lax.map(expert_block, (row_tok.reshape(n_blocks, EXPERT_BLOCK),
                                row_w.reshape(n_blocks, EXPERT_BLOCK), blk_e))
    return jax.ops.segment_sum(yb.reshape(n_rows, D), row_tok, num_segments=N)


def setup_inputs(seed: int = 0) -> dict:
    key = jax.random.key(seed)
    ks = jax.random.split(key, 20)

    def nrm(k, shape, scale):
        return jax.random.normal(k, shape, jnp.float32) * scale

    s_in = D_MODEL ** -0.5
    hgrn_cols = jnp.concatenate([jnp.ones((2 * D_MODEL,)), jnp.full((D_MODEL,), DN_BETA),
                                 jnp.ones((D_MODEL,))]).astype(jnp.float32)
    ret_cols = jnp.concatenate([jnp.ones((2 * RET_QK,)), jnp.full((RET_VD,), DN_BETA),
                                jnp.ones((RET_VD,))]).astype(jnp.float32)
    return {
        "x": nrm(ks[0], (BATCH, SEQ, D_MODEL), 1.0),
        "hgrn_w_in": nrm(ks[1], (N_A_LAYERS, D_MODEL, HGRN_IN), s_in) * hgrn_cols,
        "hgrn_norm_g": 1.0 + nrm(ks[2], (N_A_LAYERS, D_MODEL), 0.02),
        "hgrn_w_out": nrm(ks[3], (N_A_LAYERS, D_MODEL, D_MODEL), s_in * DN_BETA),
        "lower_bounds": nrm(ks[4], (DEPTH, D_MODEL), 0.1),
        "ret_w_in": nrm(ks[5], (N_B_LAYERS, D_MODEL, RET_IN), s_in) * ret_cols,
        "ret_w_out": nrm(ks[6], (N_B_LAYERS, RET_VD, D_MODEL), RET_VD ** -0.5 * DN_BETA),
        "ln_mix_g": 1.0 + nrm(ks[7], (DEPTH, D_MODEL), 0.02),
        "ln_mix_b": nrm(ks[8], (DEPTH, D_MODEL), 0.02),
        "ln_ffn_g": 1.0 + nrm(ks[9], (DEPTH, D_MODEL), 0.02),
        "ln_ffn_b": nrm(ks[10], (DEPTH, D_MODEL), 0.02),
        "router_w": nrm(ks[11], (DEPTH, D_MODEL, N_EXPERTS), s_in),
        "router_b": nrm(ks[12], (DEPTH, N_EXPERTS), 0.01),
        "expert_w_gu": nrm(ks[13], (DEPTH, N_EXPERTS, D_MODEL, 2 * D_FF), s_in),
        "expert_b_gu": nrm(ks[14], (DEPTH, N_EXPERTS, 2 * D_FF), 0.02),
        "expert_w_down": nrm(ks[15], (DEPTH, N_EXPERTS, D_FF, D_MODEL), D_FF ** -0.5 * DN_BETA),
        "expert_b_down": nrm(ks[16], (DEPTH, N_EXPERTS, D_MODEL), 0.02),
    }


def reference(x, hgrn_w_in, hgrn_norm_g, hgrn_w_out, lower_bounds, ret_w_in, ret_w_out,
              ln_mix_g, ln_mix_b, ln_ffn_g, ln_ffn_b, router_w, router_b,
              expert_w_gu, expert_b_gu, expert_w_down, expert_b_down):
    B, S, D = x.shape
    lb_soft = jax.nn.softmax(lower_bounds.astype(jnp.float32), axis=0)
    lbs = jnp.cumsum(lb_soft, axis=0) - lb_soft[0]
    cos, sin = rotary_tables(S)
    for i in range(DEPTH):
        j = i // N_MIXERS
        if i % N_MIXERS == 0:
            mix = hgrn2_mixer(x, hgrn_w_in[j], hgrn_norm_g[j], hgrn_w_out[j], lbs[i])
        else:
            mix = retention_mixer(x, ret_w_in[j], ret_w_out[j], cos, sin)
        x = layer_norm(DN_ALPHA * x + mix, ln_mix_g[i], ln_mix_b[i])
        ffn = moe_ffn(x.reshape(B * S, D), router_w[i], router_b[i], expert_w_gu[i],
                      expert_b_gu[i], expert_w_down[i], expert_b_down[i]).reshape(B, S, D)
        x = layer_norm(DN_ALPHA * x + ffn.astype(x.dtype), ln_ffn_g[i], ln_ffn_b[i])
    return x
```

```cpp
#include <hip/hip_runtime.h>
#include <cstdio>
#include <cstdint>

#ifndef MK_MULTI
#define MK_MULTI 0
#endif
#ifndef SLOW_REC
#define SLOW_REC 1
#endif

#define GAS __attribute__((address_space(1)))
#define LAS __attribute__((address_space(3)))
typedef unsigned short bf16;
typedef unsigned v4u __attribute__((ext_vector_type(4)));
typedef unsigned v2u __attribute__((ext_vector_type(2)));
typedef float f32x4 __attribute__((ext_vector_type(4)));
typedef float f32x2 __attribute__((ext_vector_type(2)));
typedef short bf16x8 __attribute__((ext_vector_type(8)));
typedef GAS unsigned gu32;

constexpr int DM = 1024, NBATCH = 16, SEQ = 2048, NTOK = NBATCH * SEQ, DEPTH = 4;
constexpr int NE = 32, TOPK = 4;
constexpr int HG_HEADS = 8, HG_K = 128;
constexpr int RT_HEADS = 4, RT_K = 256, RT_V = 512, RT_VD = 2048, RT_IN = 6144, HG_IN = 4096;
constexpr int ECAP = NTOK;
constexpr int MOE_ROWS = NTOK * TOPK + NE * 256;
constexpr float DN_ALPHA = 1.681792830507429f;
constexpr float LN_EPS = 1e-5f, RMS_EPS = 1e-6f;

constexpr size_t MiB = 1ull << 20;
constexpr size_t WS_CTL = 0, CTL_ZERO_BYTES = 1 * MiB;
constexpr size_t WS_LBS = 1 * MiB;
constexpr size_t WS_BGU = 2 * MiB;
constexpr size_t WS_ROT = 4 * MiB;
constexpr size_t WS_ROWDST = 8 * MiB;
constexpr size_t WS_ROWGATE = 12 * MiB;
constexpr size_t WS_W_HIN = 16 * MiB;
constexpr size_t WS_W_HOUT = WS_W_HIN + 16 * MiB;
constexpr size_t WS_W_RIN = WS_W_HOUT + 4 * MiB;
constexpr size_t WS_W_ROUT = WS_W_RIN + 24 * MiB;
constexpr size_t WS_W_GU = WS_W_ROUT + 8 * MiB;
constexpr size_t WS_W_DN = WS_W_GU + 512 * MiB;
constexpr size_t WS_XB = WS_W_DN + 256 * MiB;
constexpr size_t WS_H = WS_XB + 64 * MiB;
constexpr size_t WS_DEC = WS_H + 320 * MiB;
constexpr size_t WS_O = WS_H + 384 * MiB;
constexpr size_t WS_A2 = WS_O + 128 * MiB;
constexpr size_t WS_Y = WS_A2 + 128 * MiB;
constexpr size_t WS_X1F = WS_Y + 128 * MiB;
constexpr size_t WS_X1B = WS_X1F + 128 * MiB;
constexpr size_t WS_ACT = WS_X1B + 64 * MiB;
constexpr size_t WS_YSLOT = WS_ACT + 272 * MiB;
constexpr size_t WS_END = WS_YSLOT + 256 * MiB;

constexpr int CW_BAR = 4096;
constexpr int CW_ECNT = 16384;

constexpr int RING_BYTES = 131072;
constexpr int MISC_OFF = 135168;
constexpr int LDS_BYTES = 147456;
constexpr int MO_BARW = 0;
constexpr int MO_GTAB = 64;
constexpr int MO_TPRE = 64 + 2048;
constexpr int MO_EBASE = MO_TPRE + 160;
constexpr int MO_ECNT = MO_EBASE + 128;
constexpr int MO_LCNT = MO_ECNT + 128;
constexpr int MO_LBASE = MO_LCNT + 128;
constexpr int MO_SEL = MO_LBASE + 128;
constexpr int MO_SELW = MO_SEL + 2048;
constexpr int MO_RANK = MO_SELW + 2048;
constexpr int MO_ULIST = MO_RANK + 2048;
static_assert(MISC_OFF + MO_ULIST + 1024 <= LDS_BYTES, "LDS map");

#define RLX_AGENT __ATOMIC_RELAXED, __HIP_MEMORY_SCOPE_AGENT
#define LDS_WAIT() asm volatile("s_waitcnt lgkmcnt(0)" ::: "memory")
#define VM_WAIT() asm volatile("s_waitcnt vmcnt(0)" ::: "memory")

__device__ __forceinline__ unsigned f2bf(float f) { unsigned u = __builtin_bit_cast(unsigned, f); return (u + 0x7fffu + ((u >> 16) & 1u)) >> 16; }
__device__ __forceinline__ unsigned pk2(float lo, float hi) { return f2bf(lo) | (f2bf(hi) << 16); }
__device__ __forceinline__ unsigned cvt_pk_bf16(float lo, float hi) { unsigned r; asm volatile("v_cvt_pk_bf16_f32 %0, %1, %2" : "=v"(r) : "v"(lo), "v"(hi)); return r; }
__device__ __forceinline__ float bflo(unsigned u) { return __builtin_bit_cast(float, u << 16); }
__device__ __forceinline__ float bfhi(unsigned u) { return __builtin_bit_cast(float, u & 0xffff0000u); }
__device__ __forceinline__ float bf1(bf16 b) { return __builtin_bit_cast(float, ((unsigned)b) << 16); }
__device__ __forceinline__ float fexp(float x) { return __builtin_amdgcn_exp2f(x * 1.4426950408889634f); }
__device__ __forceinline__ float frcp(float x) { return __builtin_amdgcn_rcpf(x); }
__device__ __forceinline__ float fsigmoid(float x) { return frcp(1.0f + fexp(-x)); }
__device__ __forceinline__ float wave_sum(float v) {
#pragma unroll
    for (int o = 1; o < 64; o <<= 1) v += __shfl_xor(v, o);
    return v;
}
__device__ __forceinline__ float wave_max(float v) {
#pragma unroll
    for (int o = 1; o < 64; o <<= 1) v = fmaxf(v, __shfl_xor(v, o));
    return v;
}

#define XB_TMO      128
#define XB_XCNT(j)  (256  + 64 * (j))
#define XB_XSUB(j)  (1280 + 64 * (j))
#define XB_XGEN(j)  (2304 + 64 * (j))
#define XB_TOP      3328
#define XB_TOPGEN   3392
#define XCD_BAR_WORDS 3456
#define XB_SPIN_CAP (1u << 22)

__device__ __forceinline__ unsigned xb_ld(unsigned* p)              { return __hip_atomic_load(p, __ATOMIC_RELAXED, __HIP_MEMORY_SCOPE_AGENT); }
__device__ __forceinline__ unsigned xb_add(unsigned* p, unsigned v) { return __hip_atomic_fetch_add(p, v, __ATOMIC_RELAXED, __HIP_MEMORY_SCOPE_AGENT); }
__device__ __forceinline__ unsigned xb_xcc_id() { return (unsigned)__builtin_amdgcn_s_getreg((3 << 11) | 20) & 0xFu; }
#define XB_SPIN(cond, bar) do { unsigned _sp = 0; while (cond) { __builtin_amdgcn_s_sleep(1); \
    if ((++_sp & 255u) == 0u) { if (xb_ld(&(bar)[XB_TMO])) break; if (_sp > XB_SPIN_CAP) { atomicAdd(&(bar)[XB_TMO], 1u); break; } } } } while (0)

struct XcdBarrier { unsigned* bar; unsigned x; volatile LAS unsigned* st; };

__device__ __forceinline__ XcdBarrier xcd_barrier_post(unsigned* bar, volatile LAS unsigned* st) {
    XcdBarrier b; b.bar = bar; b.x = xb_xcc_id(); b.st = st;
    if (threadIdx.x == 0) (void)xb_add(&bar[XB_XCNT(b.x)], 1u);
    return b;
}
__device__ __forceinline__ void xcd_barrier_complete(unsigned* bar, unsigned x, unsigned& nloc, unsigned& nx) {
    const unsigned G = gridDim.x * gridDim.y * gridDim.z;
    unsigned sum, cnt, mine, sp = 0u;
    for (;;) {
        sum = 0u; cnt = 0u; mine = 0u;
#pragma unroll
        for (unsigned j = 0; j < 16; ++j) { const unsigned c = xb_ld(&bar[XB_XCNT(j)]); sum += c; cnt += (c > 0u) ? 1u : 0u; mine = (j == x) ? c : mine; }
        if (sum == G) break;
        __builtin_amdgcn_s_sleep(1);
        if ((++sp & 255u) == 0u) { if (xb_ld(&bar[XB_TMO])) break; if (sp > XB_SPIN_CAP) { atomicAdd(&bar[XB_TMO], 1u); break; } }
    }
    nloc = mine > 0u ? mine : 1u; nx = cnt > 0u ? cnt : 1u;
}
__device__ __forceinline__ void xcd_barrier(const XcdBarrier& b) {
    asm volatile("s_waitcnt vmcnt(0)" ::: "memory");
    __syncthreads();
    if (threadIdx.x == 0) {
        unsigned* bar = b.bar;
        __builtin_amdgcn_s_waitcnt(0);
        unsigned nloc = b.st[0], nx = b.st[1];
        if (nloc == 0u) { xcd_barrier_complete(bar, b.x, nloc, nx); b.st[0] = nloc; b.st[1] = nx; }
        const unsigned old = xb_add(&bar[XB_XSUB(b.x)], 1u);
        const unsigned gen = old / nloc;
        if (old + 1u == (gen + 1u) * nloc) {
            __builtin_amdgcn_fence(__ATOMIC_RELEASE, "agent");
            asm volatile("s_waitcnt vmcnt(0)" ::: "memory");
            const unsigned og = xb_add(&bar[XB_TOP], 1u);
            const unsigned tg = og / nx;
            if (og + 1u == (tg + 1u) * nx) xb_add(&bar[XB_TOPGEN], 1u);
            else XB_SPIN(xb_ld(&bar[XB_TOPGEN]) == tg, bar);
            __builtin_amdgcn_fence(__ATOMIC_ACQUIRE, "agent");
            xb_add(&bar[XB_XGEN(b.x)], 1u);
            asm volatile("s_waitcnt vmcnt(0)" ::: "memory");
        } else {
            XB_SPIN(xb_ld(&bar[XB_XGEN(b.x)]) == gen, bar);
            __builtin_amdgcn_fence(__ATOMIC_ACQUIRE, "agent");
            asm volatile("s_waitcnt vmcnt(0)" ::: "memory");
        }
    }
    __syncthreads();
}

namespace pg8 {
constexpr int BM = 256, BK = 64, HALF = 128, HTB = HALF * BK * 2, STAGE_BYTES = 8 * HTB, NXCD = 8, WGM = 8, MAXU = 32;
__host__ __device__ __forceinline__ int lds_byte(int r, int c) { const int st = (r >> 4) * 2 + (c >> 5), rr = r & 15, cc = c & 31, ob = rr * 64 + cc * 2; return st * 1024 + (ob ^ (((ob >> 9) & 1) << 5)); }
__host__ __device__ __forceinline__ void stage_rc(int b, int& R, int& C) { const int st = b / 1024, sb = b % 1024, swz = sb ^ (((sb >> 9) & 1) << 5); R = (st >> 1) * 16 + swz / 64; C = (st & 1) * 32 + (swz % 64) / 2; }
__host__ __device__ __forceinline__ int perm32(int rho) { const int n = rho >> 4, i = rho & 15; return 8 * (i >> 2) + 4 * n + (i & 3); }

struct Unit { int pm, pn, e, rowbase, cnt; unsigned boff; int gidx; };

__device__ __forceinline__ bool tile_of(long L, int nM, int nN, int& gm, int& pn) {
    const int nwg = nM * nN; if (L >= nwg) return false;
    int wgid = (int)L; { const int q = nwg / NXCD, r = nwg % NXCD, xcd = wgid % NXCD, off = wgid / NXCD; wgid = (xcd < r ? xcd * (q + 1) : r * (q + 1) + (xcd - r) * q) + off; }
    const int nig = WGM * nN, gid = wgid / nig, fm = gid * WGM, gsz = (nM - fm) < WGM ? (nM - fm) : WGM;
    gm = fm + ((wgid % nig) % gsz); pn = (wgid % nig) / gsz; return true;
}
__device__ __forceinline__ void build_units_dense(const int i, LAS int* ul, int nM, int nN, int K) {
    if (i < MAXU) { int gm = 0, pn = 0; const bool ok = tile_of((long)i * gridDim.x + blockIdx.x, nM, nN, gm, pn);
        ul[i * 8 + 0] = ok ? 1 : 0; ul[i * 8 + 1] = gm; ul[i * 8 + 2] = pn; ul[i * 8 + 3] = 0; ul[i * 8 + 4] = gm * BM; ul[i * 8 + 5] = BM; ul[i * 8 + 6] = (int)((unsigned)pn * BM * (unsigned)K * 2u); ul[i * 8 + 7] = 0; }
    __syncthreads();
}
__device__ __forceinline__ void build_units_moe(const int i, LAS int* ul, const LAS int* tpre, const LAS int* ebase, const LAS int* ecnt, int nN, int K, unsigned wstride) {
    if (i < MAXU) { int gm = 0, pn = 0; const bool ok = tile_of((long)i * gridDim.x + blockIdx.x, tpre[NE], nN, gm, pn);
        int e = 0;
_Pragma("unroll 1")
        for (int s = 16; s >= 1; s >>= 1) { if (e + s < NE && tpre[e + s] <= gm) e += s; }
        const int pm = gm - tpre[e];
        ul[i * 8 + 0] = ok ? 1 : 0; ul[i * 8 + 1] = pm; ul[i * 8 + 2] = pn; ul[i * 8 + 3] = e; ul[i * 8 + 4] = ebase[e] + pm * BM; ul[i * 8 + 5] = ecnt[e] - pm * BM;
        ul[i * 8 + 6] = (int)((unsigned)e * wstride + (unsigned)pn * BM * (unsigned)K * 2u); ul[i * 8 + 7] = e * ECAP + pm * BM; }
    __syncthreads();
}
__device__ __forceinline__ bool ld_unit(const LAS int* ul, int i, Unit& u) {
    if (i >= MAXU) return false;
    const LAS int* p = ul + i * 8;
    if (__builtin_amdgcn_readfirstlane(p[0]) == 0) return false;
    u.pm = __builtin_amdgcn_readfirstlane(p[1]); u.pn = __builtin_amdgcn_readfirstlane(p[2]); u.e = __builtin_amdgcn_readfirstlane(p[3]); u.rowbase = __builtin_amdgcn_readfirstlane(p[4]);
    u.cnt = __builtin_amdgcn_readfirstlane(p[5]); u.boff = (unsigned)__builtin_amdgcn_readfirstlane(p[6]); u.gidx = __builtin_amdgcn_readfirstlane(p[7]); return true;
}
template <bool GATHER> __device__ __forceinline__ void stage_a(LAS unsigned char* dst, const char* sbase, unsigned o0, unsigned o1, size_t r64) {
    __builtin_amdgcn_global_load_lds((const unsigned*)(sbase + o0), (LAS unsigned*)dst, 16, 0, 0);
    if constexpr (GATHER) __builtin_amdgcn_global_load_lds((const unsigned*)(sbase + o1), (LAS unsigned*)(dst + 8192), 16, 0, 0);
    else __builtin_amdgcn_global_load_lds((const unsigned*)(sbase + r64 + o0), (LAS unsigned*)(dst + 8192), 16, 0, 0);
}

template <class Epi, bool GATHER, bool ALIGN_EPI>
__device__ __forceinline__ void gemm_phase(const int tid, LAS unsigned char* lds, const LAS int* ul, LAS int* gtab, const char* Abase, const char* Bbase, const int* rowdst, const int K, const Epi& E) {
    const int wid = __builtin_amdgcn_readfirstlane(tid >> 6), lane = tid & 63, wr = wid >> 2, wc = wid & 3, fr = lane & 15, fq = lane >> 4;
    const int nt = K / BK;
    int R0, C0; stage_rc(tid * 16, R0, C0);
    const int Rb0 = Epi::PERM ? ((R0 & ~31) + perm32(R0 & 31)) : R0;
    const unsigned voffB = (unsigned)(Rb0 * K + C0) * 2u;
    const unsigned cb0 = (unsigned)C0 * 2u, K2 = (unsigned)K * 2u;
    const size_t kstep = (size_t)(BK * 2);
    const size_t r64 = (size_t)64 * K * 2;
    const size_t hstep = (size_t)HALF * K * 2;
    const unsigned ldsw = (unsigned)wid * 1024u;
    const int aoff = lds_byte(wr * 64 + fr, fq * 8), boff = lds_byte(wc * 32 + fr, fq * 8);
#define PG8_SA(b, h) (((b) * 2 + (h)) * HTB)
#define PG8_SB(b, h) ((4 + (b) * 2 + (h)) * HTB)
#define PG8_STAGE(bufoff, gbase) do { \
        __builtin_amdgcn_global_load_lds((const unsigned*)((const char*)(gbase) + voffB), (LAS unsigned*)(lds + (bufoff) + ldsw), 16, 0, 0); \
        __builtin_amdgcn_global_load_lds((const unsigned*)((const char*)(gbase) + r64 + voffB), (LAS unsigned*)(lds + (bufoff) + ldsw + 8192), 16, 0, 0); } while (0)
#define PG8_STAGEA0(bufoff, kb, o0, o1) stage_a<GATHER>(lds + (bufoff) + ldsw, Abase + (kb), o0, o1, r64)
#define PG8_STAGEA1(bufoff, kb, o0, o2, o3) stage_a<GATHER>(lds + (bufoff) + ldsw, Abase + (kb) + (GATHER ? (size_t)0 : hstep), GATHER ? (o2) : (o0), o3, r64)
#define PG8_LDA(dst, b, h) do { _Pragma("unroll") for (int m = 0; m < 4; ++m) _Pragma("unroll") for (int k = 0; k < 2; ++k) dst[m][k] = *(const LAS bf16x8*)(lds + PG8_SA(b, h) + aoff + m * 2048 + k * 1024); } while (0)
#define PG8_LDB(dst, b, h) do { _Pragma("unroll") for (int n = 0; n < 2; ++n) _Pragma("unroll") for (int k = 0; k < 2; ++k) dst[n][k] = *(const LAS bf16x8*)(lds + PG8_SB(b, h) + boff + n * 2048 + k * 1024); } while (0)
#define PG8_MMA(ai, bj, At, Bt) do { __builtin_amdgcn_s_setprio(1); _Pragma("unroll") for (int m = 0; m < 4; ++m) _Pragma("unroll") for (int n = 0; n < 2; ++n) _Pragma("unroll") for (int k = 0; k < 2; ++k) \
        acc[ai][bj][m][n] = __builtin_amdgcn_mfma_f32_16x16x32_bf16(Bt[n][k], At[m][k], acc[ai][bj][m][n], 0, 0, 0); __builtin_amdgcn_s_setprio(0); } while (0)
#define PG8_WAIT_V(n) asm volatile("s_waitcnt vmcnt(" #n ")" ::: "memory")
#define PG8_WAIT_L(n) asm volatile("s_waitcnt lgkmcnt(" #n ")" ::: "memory")
#define PG8_BAR __builtin_amdgcn_s_barrier()
#define PG8_SCHED __builtin_amdgcn_sched_barrier(0)
    Unit cur, nxt; int ui = 0;
    if (!ld_unit(ul, 0, cur)) return;
    f32x4 acc[2][2][4][2];
#pragma unroll
    for (int a = 0; a < 2; ++a)
#pragma unroll
        for (int b = 0; b < 2; ++b)
#pragma unroll
            for (int m = 0; m < 4; ++m)
#pragma unroll
                for (int n = 0; n < 2; ++n) acc[a][b][m][n] = (f32x4){0.f, 0.f, 0.f, 0.f};
    bf16x8 At[4][2], B0[2][2], B1[2][2];
    unsigned oA0, oA1 = 0, oA2 = 0, oA3 = 0, oN0, oN1 = 0, oN2 = 0, oN3 = 0;
    if constexpr (GATHER) {
        const int c1 = cur.cnt - 1; const int* gp = rowdst + cur.gidx;
        oA0 = ((unsigned)gp[min(R0, c1)] >> 2) * K2 + cb0; oA1 = ((unsigned)gp[min(R0 + 64, c1)] >> 2) * K2 + cb0; oA2 = ((unsigned)gp[min(R0 + 128, c1)] >> 2) * K2 + cb0; oA3 = ((unsigned)gp[min(R0 + 192, c1)] >> 2) * K2 + cb0;
    } else {
        oA0 = (unsigned)(cur.rowbase + R0) * K2 + cb0;
    }
    oN0 = oA0; oN1 = oA1; oN2 = oA2; oN3 = oA3;
    const char* cB = Bbase + cur.boff;
    PG8_STAGE(PG8_SB(0, 0), cB); PG8_STAGE(PG8_SB(0, 1), cB + hstep); PG8_STAGEA0(PG8_SA(0, 0), (size_t)0, oA0, oA1); PG8_STAGEA1(PG8_SA(0, 1), (size_t)0, oA0, oA2, oA3);
    if (wr == 1) PG8_BAR;
    PG8_WAIT_V(2); PG8_BAR;
    PG8_STAGE(PG8_SB(1, 0), cB + kstep); PG8_STAGEA0(PG8_SA(1, 0), kstep, oA0, oA1); PG8_STAGE(PG8_SB(1, 1), cB + hstep + kstep);
    PG8_WAIT_V(6); PG8_BAR;
    for (;;) {
        const bool has_next = ld_unit(ul, ui + 1, nxt);
        const char* nB = has_next ? Bbase + nxt.boff : cB;
        if constexpr (GATHER) {
            if (has_next && tid < 256) gtab[tid] = (int)((unsigned)rowdst[nxt.gidx + min(tid, nxt.cnt - 1)] >> 2);
        }
        for (int t = 0; t < nt; t += 2) {
            const bool last = (t == nt - 2);
            if (last && has_next) {
                if constexpr (GATHER) {
                    oN0 = (unsigned)gtab[R0] * K2 + cb0; oN1 = (unsigned)gtab[R0 + 64] * K2 + cb0; oN2 = (unsigned)gtab[R0 + 128] * K2 + cb0; oN3 = (unsigned)gtab[R0 + 192] * K2 + cb0;
                } else {
                    oN0 = (unsigned)(nxt.rowbase + R0) * K2 + cb0;
                }
            }
            const size_t kb1 = (size_t)(t + 1) * kstep;
            const size_t kb2 = last ? (size_t)0 : (size_t)(t + 2) * kstep, kb3 = kb2 + kstep;
            const unsigned p0 = last ? oN0 : oA0, p1 = last ? oN1 : oA1, p2 = last ? oN2 : oA2, p3 = last ? oN3 : oA3;
            const char* b2 = last ? nB : cB + (size_t)(t + 2) * kstep; const char* b3 = b2 + kstep;
            PG8_LDB(B0, 0, 0); PG8_LDB(B1, 0, 1); PG8_SCHED; PG8_LDA(At, 0, 0); PG8_STAGEA1(PG8_SA(1, 1), kb1, oA0, oA2, oA3);
            PG8_WAIT_V(8); PG8_WAIT_L(0); PG8_BAR; PG8_MMA(0, 0, At, B0); PG8_MMA(0, 1, At, B1); PG8_BAR; PG8_SCHED;
            PG8_LDA(At, 0, 1); PG8_STAGE(PG8_SB(0, 0), b2); PG8_STAGE(PG8_SB(0, 1), b2 + hstep); PG8_STAGEA0(PG8_SA(0, 0), kb2, p0, p1);
            PG8_WAIT_V(8); PG8_WAIT_L(0); PG8_BAR; PG8_MMA(1, 0, At, B0); PG8_MMA(1, 1, At, B1); PG8_BAR; PG8_SCHED;
            PG8_LDB(B0, 1, 0); PG8_LDB(B1, 1, 1); PG8_SCHED; PG8_LDA(At, 1, 0); PG8_STAGEA1(PG8_SA(0, 1), kb2, p0, p2, p3);
            PG8_WAIT_V(8); PG8_WAIT_L(0); PG8_BAR; PG8_MMA(0, 0, At, B0); PG8_MMA(0, 1, At, B1); PG8_BAR; PG8_SCHED;
            PG8_LDA(At, 1, 1); PG8_STAGE(PG8_SB(1, 0), b3); PG8_STAGE(PG8_SB(1, 1), b3 + hstep); PG8_STAGEA0(PG8_SA(1, 0), kb3, p0, p1);
            PG8_WAIT_V(8); PG8_WAIT_L(0); PG8_BAR; PG8_MMA(1, 0, At, B0); PG8_MMA(1, 1, At, B1); PG8_BAR; PG8_SCHED;
        }
        if constexpr (ALIGN_EPI) { if (wr == 0) PG8_BAR; }
        E(acc, cur, wr, wc, fr, fq);
        if (!has_next) break;
#pragma unroll
        for (int a = 0; a < 2; ++a)
#pragma unroll
            for (int b = 0; b < 2; ++b)
#pragma unroll
                for (int m = 0; m < 4; ++m)
#pragma unroll
                    for (int n = 0; n < 2; ++n) acc[a][b][m][n] = (f32x4){0.f, 0.f, 0.f, 0.f};
        cur = nxt; cB = nB; oA0 = oN0; oA1 = oN1; oA2 = oN2; oA3 = oN3; ++ui;
        if constexpr (ALIGN_EPI) { if (wr == 1) PG8_BAR; }
    }
    PG8_WAIT_V(0);
    if constexpr (!ALIGN_EPI) { if (wr == 0) PG8_BAR; }
    PG8_BAR;
#undef PG8_SA
#undef PG8_SB
#undef PG8_STAGE
#undef PG8_STAGEA0
#undef PG8_STAGEA1
#undef PG8_LDA
#undef PG8_LDB
#undef PG8_MMA
#undef PG8_WAIT_V
#undef PG8_WAIT_L
#undef PG8_BAR
#undef PG8_SCHED
}

__device__ __forceinline__ unsigned char* launder(unsigned char* p) { asm volatile("" : "+s"(p)); return p; }
struct EpiHgrnIn {
    static constexpr bool PERM = true;
    unsigned char* ws0; int L;
    __device__ __forceinline__ void operator()(const f32x4 (&acc)[2][2][4][2], const Unit& u, int wr, int wc, int fr, int fq) const {
        unsigned char* ws = launder(ws0);
        bf16* QD = (bf16*)(ws + WS_H);
        const int row0 = u.rowbase + wr * 64 + fr;
        if (u.pn >= 8) {
            const bool isg = u.pn >= 12; bf16* base = QD + (size_t)(isg ? 4 : 3) * NTOK * DM; const int colt = (u.pn - (isg ? 12 : 8)) * BM + wc * 32 + 8 * fq;
#pragma unroll
            for (int ai = 0; ai < 2; ++ai)
#pragma unroll
                for (int m = 0; m < 4; ++m) { bf16* rowp = base + (size_t)(row0 + ai * HALF + m * 16) * DM + colt;
#pragma unroll
                    for (int bj = 0; bj < 2; ++bj) { f32x4 v0 = acc[ai][bj][m][0], v1 = acc[ai][bj][m][1];
                        if (isg) {
#pragma unroll
                            for (int j = 0; j < 4; ++j) { v0[j] = v0[j] * fsigmoid(v0[j]); v1[j] = v1[j] * fsigmoid(v1[j]); } }
                        v4u w; w.x = cvt_pk_bf16(v0[0], v0[1]); w.y = cvt_pk_bf16(v0[2], v0[3]); w.z = cvt_pk_bf16(v1[0], v1[1]); w.w = cvt_pk_bf16(v1[2], v1[3]);
                        *(v4u*)(rowp + bj * HALF) = w; } }
            return;
        }
        const int col = u.pn * HG_K + wc * 32 + 8 * fq;
        const float* lb = (const float*)(ws + WS_LBS) + L * DM;
        const f32x4 lb0 = *(const f32x4*)(lb + col), lb1 = *(const f32x4*)(lb + col + 4);
#if !SLOW_REC
        const int lane = fq * 16 + fr;
        float* DEC = (float*)(ws + WS_DEC);
#endif
#pragma unroll
        for (int ai = 0; ai < 2; ++ai)
#pragma unroll
            for (int m = 0; m < 4; ++m) {
                const int row = row0 + ai * HALF + m * 16;
                float qd[8], ki[8], ks[8];
#if !SLOW_REC
                float de[8];
#endif
#pragma unroll
                for (int j = 0; j < 8; ++j) {
                    const float q = acc[ai][0][m][j >> 2][j & 3], f = acc[ai][1][m][j >> 2][j & 3], lbv = j < 4 ? lb0[j & 3] : lb1[j & 3];
                    const float sg = fsigmoid(f), fg = lbv + (1.0f - lbv) * sg, kk = (1.0f - lbv) * (1.0f - sg);
#if SLOW_REC
                    qd[j] = q * fsigmoid(q); ki[j] = kk; ks[j] = fg;
#else
                    float b = __builtin_amdgcn_logf(fg) * 0.6931471805599453f;
                    b += __builtin_bit_cast(float, __builtin_amdgcn_update_dpp(0, __builtin_bit_cast(int, b), 0x111, 0xf, 0xf, true));
                    b += __builtin_bit_cast(float, __builtin_amdgcn_update_dpp(0, __builtin_bit_cast(int, b), 0x112, 0xf, 0xf, true));
                    b += __builtin_bit_cast(float, __builtin_amdgcn_update_dpp(0, __builtin_bit_cast(int, b), 0x114, 0xf, 0xf, true));
                    b += __builtin_bit_cast(float, __builtin_amdgcn_update_dpp(0, __builtin_bit_cast(int, b), 0x118, 0xf, 0xf, true));
                    const float bl = __shfl(b, lane | 15);
                    qd[j] = q * fsigmoid(q) * fexp(b); ki[j] = kk * fexp(-b); ks[j] = kk * fexp(bl - b); de[j] = fexp(bl);
#endif
                }
                const size_t o = (size_t)row * DM + col;
                v4u w;
                w.x = cvt_pk_bf16(qd[0], qd[1]); w.y = cvt_pk_bf16(qd[2], qd[3]); w.z = cvt_pk_bf16(qd[4], qd[5]); w.w = cvt_pk_bf16(qd[6], qd[7]); *(v4u*)(QD + o) = w;
                w.x = cvt_pk_bf16(ki[0], ki[1]); w.y = cvt_pk_bf16(ki[2], ki[3]); w.z = cvt_pk_bf16(ki[4], ki[5]); w.w = cvt_pk_bf16(ki[6], ki[7]); *(v4u*)(QD + (size_t)NTOK * DM + o) = w;
                w.x = cvt_pk_bf16(ks[0], ks[1]); w.y = cvt_pk_bf16(ks[2], ks[3]); w.z = cvt_pk_bf16(ks[4], ks[5]); w.w = cvt_pk_bf16(ks[6], ks[7]); *(v4u*)(QD + 2 * (size_t)NTOK * DM + o) = w;
#if !SLOW_REC
                if (fr == 0) { float* dp = DEC + (size_t)(row >> 4) * DM + col; *(f32x4*)dp = (f32x4){de[0], de[1], de[2], de[3]}; *(f32x4*)(dp + 4) = (f32x4){de[4], de[5], de[6], de[7]}; }
#endif
            }
    }
};
struct EpiRetIn {
    static constexpr bool PERM = true;
    unsigned char* ws0;
    __device__ __forceinline__ void operator()(const f32x4 (&acc)[2][2][4][2], const Unit& u, int wr, int wc, int fr, int fq) const {
        unsigned char* ws = launder(ws0);
        bf16* H = (bf16*)(ws + WS_H); const float* rot = (const float*)(ws + WS_ROT);
        const int row0 = u.rowbase + wr * 64 + fr; const int colt = u.pn * BM + wc * 32 + 8 * fq;
        const int kind = u.pn < 4 ? 0 : (u.pn < 8 ? 1 : (u.pn < 16 ? 2 : 3));
#pragma unroll
        for (int ai = 0; ai < 2; ++ai)
#pragma unroll
            for (int m = 0; m < 4; ++m) { const int row = row0 + ai * HALF + m * 16; bf16* rowp = H + (size_t)row * RT_IN + colt; const int pos = row & (SEQ - 1);
#pragma unroll
                for (int bj = 0; bj < 2; ++bj) { f32x4 v0 = acc[ai][bj][m][0], v1 = acc[ai][bj][m][1];
                    if (kind <= 1) {
                        const int p0 = (bj * HALF + wc * 32 + 8 * fq) >> 1;
                        const float* rp = rot + ((size_t)pos * 128 + p0) * 2;
                        const f32x4 r0 = *(const f32x4*)rp, r1 = *(const f32x4*)(rp + 4);
                        const float sc = kind == 1 ? 0.0625f : 1.0f;
                        f32x4 o0, o1;
                        o0[0] = (v0[0] * r0[0] - v0[1] * r0[1]) * sc; o0[1] = (v0[1] * r0[0] + v0[0] * r0[1]) * sc;
                        o0[2] = (v0[2] * r0[2] - v0[3] * r0[3]) * sc; o0[3] = (v0[3] * r0[2] + v0[2] * r0[3]) * sc;
                        o1[0] = (v1[0] * r1[0] - v1[1] * r1[1]) * sc; o1[1] = (v1[1] * r1[0] + v1[0] * r1[1]) * sc;
                        o1[2] = (v1[2] * r1[2] - v1[3] * r1[3]) * sc; o1[3] = (v1[3] * r1[2] + v1[2] * r1[3]) * sc;
                        v0 = o0; v1 = o1;
                    } else if (kind == 3) {
#pragma unroll
                        for (int j = 0; j < 4; ++j) { v0[j] = v0[j] * fsigmoid(v0[j]); v1[j] = v1[j] * fsigmoid(v1[j]); }
                    }
                    v4u w; w.x = cvt_pk_bf16(v0[0], v0[1]); w.y = cvt_pk_bf16(v0[2], v0[3]); w.z = cvt_pk_bf16(v1[0], v1[1]); w.w = cvt_pk_bf16(v1[2], v1[3]);
                    *(v4u*)(rowp + bj * HALF) = w; } }
    }
};
struct EpiRes {
    static constexpr bool PERM = false;
    const float* X; unsigned char* ws0;
    __device__ __forceinline__ void operator()(const f32x4 (&acc)[2][2][4][2], const Unit& u, int wr, int wc, int fr, int fq) const {
        float* Y = (float*)(launder(ws0) + WS_Y);
        const int row0 = u.rowbase + wr * 64 + fr, col0 = u.pn * BM + wc * 32 + 4 * fq;
#pragma unroll
        for (int ai = 0; ai < 2; ++ai)
#pragma unroll
            for (int m = 0; m < 4; ++m) { const size_t off = (size_t)(row0 + ai * HALF + m * 16) * DM + col0;
#pragma unroll
                for (int bj = 0; bj < 2; ++bj)
#pragma unroll
                    for (int n = 0; n < 2; ++n) { const f32x4 xs = *(const f32x4*)(X + off + bj * HALF + n * 16); *(f32x4*)(Y + off + bj * HALF + n * 16) = xs * DN_ALPHA + acc[ai][bj][m][n]; }
                asm volatile("" ::: "memory"); }
    }
};
struct EpiMoeGU {
    static constexpr bool PERM = true;
    unsigned char* ws0; int L;
    __device__ __forceinline__ void operator()(const f32x4 (&acc)[2][2][4][2], const Unit& u, int wr, int wc, int fr, int fq) const {
        unsigned char* ws = launder(ws0);
        bf16* ACT = (bf16*)(ws + WS_ACT); const float* bias = (const float*)(ws + WS_BGU) + (size_t)L * NE * 2048;
        const int row0 = u.rowbase + wr * 64 + fr; const int c8 = wc * 32 + 8 * fq;
        const float* bp = bias + ((size_t)u.e * 8 + u.pn) * 256 + c8;
        const f32x4 bg0 = *(const f32x4*)bp, bg1 = *(const f32x4*)(bp + 4), bl0 = *(const f32x4*)(bp + HALF), bl1 = *(const f32x4*)(bp + HALF + 4);
#pragma unroll
        for (int ai = 0; ai < 2; ++ai)
#pragma unroll
            for (int m = 0; m < 4; ++m) { bf16* rowp = ACT + (size_t)(row0 + ai * HALF + m * 16) * DM + u.pn * HALF + c8;
                float a[8];
#pragma unroll
                for (int j = 0; j < 8; ++j) {
                    float g = acc[ai][0][m][j >> 2][j & 3] + (j < 4 ? bg0[j & 3] : bg1[j & 3]);
                    float l = acc[ai][1][m][j >> 2][j & 3] + (j < 4 ? bl0[j & 3] : bl1[j & 3]);
                    g = fminf(g, 7.0f); l = fminf(fmaxf(l, -7.0f), 7.0f);
                    a[j] = g * fsigmoid(1.702f * g) * (l + 1.0f);
                }
                v4u w; w.x = cvt_pk_bf16(a[0], a[1]); w.y = cvt_pk_bf16(a[2], a[3]); w.z = cvt_pk_bf16(a[4], a[5]); w.w = cvt_pk_bf16(a[6], a[7]);
                *(v4u*)rowp = w; }
    }
};
struct EpiMoeDown {
    static constexpr bool PERM = true;
    unsigned char* ws0; const float* bias;
    __device__ __forceinline__ void operator()(const f32x4 (&acc)[2][2][4][2], const Unit& u, int wr, int wc, int fr, int fq) const {
        unsigned char* ws = launder(ws0);
        bf16* YS = (bf16*)(ws + WS_YSLOT); const int* rowdst = (const int*)(ws + WS_ROWDST); const float* rowgate = (const float*)(ws + WS_ROWGATE);
        const int c8 = u.pn * BM + wc * 32 + 8 * fq;
        const float* bp = bias + (size_t)u.e * DM + c8;
        f32x4 bv[2][2];
#pragma unroll
        for (int bj = 0; bj < 2; ++bj) { bv[bj][0] = *(const f32x4*)(bp + bj * HALF); bv[bj][1] = *(const f32x4*)(bp + bj * HALF + 4); }
#pragma unroll
        for (int ai = 0; ai < 2; ++ai)
#pragma unroll
            for (int m = 0; m < 4; ++m) { const int r = ai * HALF + wr * 64 + m * 16 + fr;
                if (r < u.cnt) {
                    const size_t ti = (size_t)u.gidx + r; const int dst = rowdst[ti]; const float gt = rowgate[ti];
                    bf16* rowp = YS + (size_t)dst * DM + c8;
#pragma unroll
                    for (int bj = 0; bj < 2; ++bj) { const f32x4 v0 = (acc[ai][bj][m][0] + bv[bj][0]) * gt, v1 = (acc[ai][bj][m][1] + bv[bj][1]) * gt;
                        v4u w; w.x = cvt_pk_bf16(v0[0], v0[1]); w.y = cvt_pk_bf16(v0[2], v0[3]); w.z = cvt_pk_bf16(v1[0], v1[1]); w.w = cvt_pk_bf16(v1[2], v1[3]);
                        *(v4u*)(rowp + bj * HALF) = w; } } }
    }
};
}

struct Args { const float* in[17]; float* out; unsigned char* ws; int ph_lo, ph_hi; };
enum { I_X = 0, I_HWIN, I_HNG, I_HWOUT, I_LB, I_RWIN, I_RWOUT, I_LNMG, I_LNMB, I_LNFG, I_LNFB, I_RW, I_RB, I_WGU, I_BGU, I_WDN, I_BDN };

__device__ __forceinline__ int dest_row(int mode, int n) {
    if (mode == 1) { if (n < 1024) return ((n >> 7) << 8) + (n & 127); if (n < 2048) { const int q = n - 1024; return ((q >> 7) << 8) + 128 + (q & 127); } return n; }
    if (mode == 2) { const int j2 = n >> 1; return ((j2 >> 7) << 8) + ((n & 1) << 7) + (j2 & 127); }
    return n;
}
__device__ __forceinline__ void transpose_item(const float* W, int K, int N, bf16* WT, int mode, LAS float* scr, int item, int lane) {
    const int nblk = N / 64, kb = item / nblk, nb = item % nblk, k0 = 64 * kb, n0 = 64 * nb;
#pragma unroll 4
    for (int i = 0; i < 16; ++i) { const int kk = 4 * i + (lane >> 4), c4 = (lane & 15) * 4;
        const f32x4 v = *(const GAS f32x4*)(W + (size_t)(k0 + kk) * N + n0 + c4);
        LAS float* s = scr + kk * 65 + c4; s[0] = v[0]; s[1] = v[1]; s[2] = v[2]; s[3] = v[3]; }
    LDS_WAIT(); asm volatile("" ::: "memory");
    const int c = lane & 7;
#pragma unroll 2
    for (int j = 0; j < 8; ++j) { const int n = (lane >> 3) + 8 * j; const LAS float* s = scr + (8 * c) * 65 + n;
        v4u o; o.x = pk2(s[0 * 65], s[1 * 65]); o.y = pk2(s[2 * 65], s[3 * 65]); o.z = pk2(s[4 * 65], s[5 * 65]); o.w = pk2(s[6 * 65], s[7 * 65]);
        *(GAS v4u*)(WT + (size_t)dest_row(mode, n0 + n) * K + k0 + 8 * c) = o; }
    LDS_WAIT(); asm volatile("" ::: "memory");
}

#ifndef SITE_MASK
#define SITE_MASK 0xffff
#endif
#define SITE(n) (((SITE_MASK) >> (n)) & 1)
typedef const __attribute__((address_space(4))) Args* KArgs;
__device__ __forceinline__ int otid() { int t = threadIdx.x; asm volatile("" : "+v"(t)); return t; }
__device__ __forceinline__ LAS unsigned char* olds(LAS unsigned char* p) { asm volatile("" : "+s"(p)); return p; }
__device__ __forceinline__ KArgs kargs() { KArgs p = (KArgs)__builtin_amdgcn_kernarg_segment_ptr(); asm volatile("" : "+s"(p)); return p; }
#define IN(k) (ap->ph_lo <= (k) && (k) < ap->ph_hi)
#define GRID_BAR() do { if (ap->ph_hi - ap->ph_lo > 1) { XcdBarrier _b; _b.bar = (unsigned*)(ap->ws + WS_CTL) + CW_BAR; _b.x = xb_xcc_id(); _b.st = (volatile LAS unsigned*)(lds + MISC_OFF + MO_BARW); xcd_barrier(_b); } } while (0)
#define VCU() ((gridDim.x % 8 == 0) ? (int)((blockIdx.x % 8) * (gridDim.x / 8) + blockIdx.x / 8) : (int)blockIdx.x)

__global__ void __launch_bounds__(512, 2) mk_fwd(Args args_unused) {
    extern __shared__ __attribute__((aligned(16))) unsigned char lds_raw[];
    LAS unsigned char* const lds0 = (LAS unsigned char*)lds_raw;
    {
        LAS unsigned char* lds = lds0;
        for (int u = threadIdx.x; u < (LDS_BYTES - MISC_OFF) / 4; u += 512) ((LAS unsigned*)(lds + MISC_OFF))[u] = 0u;
        __syncthreads();
        KArgs ap = kargs();
        if (ap->ph_hi - ap->ph_lo > 1) (void)xcd_barrier_post((unsigned*)(ap->ws + WS_CTL) + CW_BAR, (volatile LAS unsigned*)(lds + MISC_OFF + MO_BARW));
    }

#if SITE(0)
    { KArgs ap = kargs(); const int tid = otid(); LAS unsigned char* lds = olds(lds0); (void)tid;
    if (IN(0)) {
        const int lane = tid & 63, wave = __builtin_amdgcn_readfirstlane(tid >> 6), G = gridDim.x, vcu = VCU(), gw = vcu * 8 + wave, NGW = G * 8;
        unsigned char* ws = ap->ws;
        LAS float* scr = (LAS float*)(lds + wave * 16640);
        constexpr int I_HIN = 2 * 16 * 64, I_HOUT = 2 * 16 * 16, I_RIN = 2 * 16 * 96, I_ROUT = 2 * 32 * 16, I_GU = 128 * 16 * 32, I_DN = 128 * 16 * 16;
        constexpr int NITEMS = I_HIN + I_HOUT + I_RIN + I_ROUT + I_GU + I_DN;
        for (int it = gw; it < NITEMS; it += NGW) {
            int r = it;
            if (r < I_HIN) { const int j = r / (16 * 64); transpose_item(ap->in[I_HWIN] + (size_t)j * DM * HG_IN, DM, HG_IN, (bf16*)(ws + WS_W_HIN) + (size_t)j * HG_IN * DM, 1, scr, r % (16 * 64), lane); continue; } r -= I_HIN;
            if (r < I_HOUT) { const int j = r / 256; transpose_item(ap->in[I_HWOUT] + (size_t)j * DM * DM, DM, DM, (bf16*)(ws + WS_W_HOUT) + (size_t)j * DM * DM, 0, scr, r % 256, lane); continue; } r -= I_HOUT;
            if (r < I_RIN) { const int j = r / (16 * 96); transpose_item(ap->in[I_RWIN] + (size_t)j * DM * RT_IN, DM, RT_IN, (bf16*)(ws + WS_W_RIN) + (size_t)j * RT_IN * DM, 0, scr, r % (16 * 96), lane); continue; } r -= I_RIN;
            if (r < I_ROUT) { const int j = r / 512; transpose_item(ap->in[I_RWOUT] + (size_t)j * RT_VD * DM, RT_VD, DM, (bf16*)(ws + WS_W_ROUT) + (size_t)j * DM * RT_VD, 0, scr, r % 512, lane); continue; } r -= I_ROUT;
            if (r < I_GU) { const int j = r / 512; transpose_item(ap->in[I_WGU] + (size_t)j * DM * 2048, DM, 2048, (bf16*)(ws + WS_W_GU) + (size_t)j * 2048 * DM, 2, scr, r % 512, lane); continue; } r -= I_GU;
            { const int j = r / 256; transpose_item(ap->in[I_WDN] + (size_t)j * DM * DM, DM, DM, (bf16*)(ws + WS_W_DN) + (size_t)j * DM * DM, 0, scr, r % 256, lane); }
        }
        const int gt = vcu * 512 + tid, NGT = G * 512;
        float* LBS = (float*)(ws + WS_LBS); float* BGU = (float*)(ws + WS_BGU); float* ROT = (float*)(ws + WS_ROT); bf16* XB = (bf16*)(ws + WS_XB);
        for (int d = gt; d < DM; d += NGT) { const float* lbp = ap->in[I_LB]; const float v0 = lbp[d], v1 = lbp[DM + d], v2 = lbp[2 * DM + d], v3 = lbp[3 * DM + d]; const float mx = fmaxf(fmaxf(v0, v1), fmaxf(v2, v3));
            const float e0 = __expf(v0 - mx), e1 = __expf(v1 - mx), e2 = __expf(v2 - mx), e3 = __expf(v3 - mx), is = 1.0f / (e0 + e1 + e2 + e3);
            LBS[d] = 0.f; LBS[DM + d] = e1 * is; LBS[2 * DM + d] = (e1 + e2) * is; LBS[3 * DM + d] = (e1 + e2 + e3) * is; }
        for (int i = gt; i < SEQ * 128; i += NGT) { const int pos = i >> 7, p = i & 127; const float inv = 1.0f / __builtin_amdgcn_exp2f(13.287712379549449f * ((float)p / 127.0f)); const float th = (float)pos * inv;
            double rev = (double)th * 0.15915494309189535; rev -= floor(rev); const float fr = (float)rev; ROT[2 * i] = __builtin_amdgcn_cosf(fr); ROT[2 * i + 1] = __builtin_amdgcn_sinf(fr); }
        for (int i = gt; i < 4 * 32 * 2048; i += NGT) { const int le = i >> 11, n = i & 2047; BGU[(size_t)le * 2048 + dest_row(2, n)] = ap->in[I_BGU][i]; }
        for (size_t i = (size_t)gt; i < (size_t)NTOK * DM / 4; i += NGT) { const f32x4 v = ((const f32x4*)ap->in[I_X])[i]; v2u o; o.x = pk2(v[0], v[1]); o.y = pk2(v[2], v[3]); ((v2u*)XB)[i] = o; }
        GRID_BAR();
    } }
#endif

#pragma unroll 1
    for (int L = 0; L < DEPTH; ++L) {
        const int pb = 1 + 8 * L;
        if ((L & 1) == 0) {
#if SITE(1)
            { KArgs ap = kargs(); const int tid = otid(); LAS unsigned char* lds = olds(lds0); (void)tid;
            if (IN(pb + 0)) {
                unsigned char* ws = ap->ws; const int j = L >> 1;
                LAS int* ul = (LAS int*)(lds + MISC_OFF + MO_ULIST);
                pg8::build_units_dense(tid, ul, NTOK / 256, HG_IN / 256, DM);
                pg8::EpiHgrnIn E{ws, L};
                pg8::gemm_phase<pg8::EpiHgrnIn, false, true>(tid, lds, ul, (LAS int*)(lds + MISC_OFF + MO_GTAB), (const char*)(ws + WS_XB), (const char*)((bf16*)(ws + WS_W_HIN) + (size_t)j * HG_IN * DM), nullptr, DM, E);
                GRID_BAR();
            } }
#endif
#if SITE(2)
            { KArgs ap = kargs(); const int tid = otid(); LAS unsigned char* lds = olds(lds0); (void)tid;
            if (IN(pb + 1)) {
#if SLOW_REC
                unsigned char* ws = ap->ws; const bf16* QD = (const bf16*)(ws + WS_H); const bf16* KI = QD + (size_t)NTOK * DM; const bf16* KS = QD + 2 * (size_t)NTOK * DM; const bf16* VV = QD + 3 * (size_t)NTOK * DM; bf16* OB = (bf16*)(ws + WS_O);
                LAS float* qf = (LAS float*)lds; LAS float* kf = qf + 16 * 4 * 36; LAS float* ff = kf + 16 * 4 * 36; LAS float* vf = ff + 16 * 4 * 36;
                for (int un = blockIdx.x; un < NBATCH * HG_HEADS; un += gridDim.x) {
                    const int b = un >> 3, h = un & 7; const int vc = tid >> 2, kq = tid & 3;
                    float st[32];
#pragma unroll
                    for (int i = 0; i < 32; ++i) st[i] = 0.f;
                    for (int t0 = 0; t0 < SEQ; t0 += 16) {
                        __syncthreads();
                        for (int e = tid; e < 16 * 128; e += 512) { const int tt = e >> 7, k = e & 127; const size_t gi = (size_t)(b * SEQ + t0 + tt) * DM + h * 128 + k; const int li = tt * 144 + (k & 3) * 36 + (k >> 2);
                            qf[li] = bf1(QD[gi]); kf[li] = bf1(KI[gi]); ff[li] = bf1(KS[gi]); vf[tt * 128 + k] = bf1(VV[gi]); }
                        __syncthreads();
                        for (int tt = 0; tt < 16; ++tt) {
                            const float v = vf[tt * 128 + vc]; float a = 0.f; const int lb = tt * 144 + kq * 36;
#pragma unroll
                            for (int i = 0; i < 32; ++i) { st[i] = ff[lb + i] * st[i] + kf[lb + i] * v; a += qf[lb + i] * st[i]; }
                            a += __shfl_xor(a, 1); a += __shfl_xor(a, 2);
                            if (kq == 0) OB[(size_t)(b * SEQ + t0 + tt) * DM + h * 128 + vc] = (bf16)f2bf(a);
                        }
                    }
                }
#endif
                GRID_BAR();
            } }
#endif
#if SITE(3)
            { KArgs ap = kargs(); const int tid = otid(); LAS unsigned char* lds = olds(lds0); (void)tid;
            if (IN(pb + 2)) {
                const int lane = tid & 63, wave = __builtin_amdgcn_readfirstlane(tid >> 6), gw = VCU() * 8 + wave, NGW = gridDim.x * 8;
                unsigned char* ws = ap->ws; const bf16* OB = (const bf16*)(ws + WS_O); const bf16* GG = (const bf16*)(ws + WS_H) + 4 * (size_t)NTOK * DM; bf16* A2 = (bf16*)(ws + WS_A2);
                const float* ng = ap->in[I_HNG] + (L >> 1) * DM;
                for (int row = gw; row < NTOK; row += NGW) {
                    float o[16]; float ss = 0.f;
#pragma unroll
                    for (int q = 0; q < 4; ++q) { const v2u w = *(const v2u*)(OB + (size_t)row * DM + 256 * q + 4 * lane); o[4 * q] = bflo(w.x); o[4 * q + 1] = bfhi(w.x); o[4 * q + 2] = bflo(w.y); o[4 * q + 3] = bfhi(w.y); }
#pragma unroll
                    for (int i = 0; i < 16; ++i) ss += o[i] * o[i];
                    const float rs = 1.0f / sqrtf(wave_sum(ss) * (1.0f / DM) + RMS_EPS);
#pragma unroll
                    for (int q = 0; q < 4; ++q) { const v2u gw2 = *(const v2u*)(GG + (size_t)row * DM + 256 * q + 4 * lane); const f32x4 g4 = *(const f32x4*)(ng + 256 * q + 4 * lane);
                        v2u w; w.x = pk2(o[4 * q] * rs * g4[0] * bflo(gw2.x), o[4 * q + 1] * rs * g4[1] * bfhi(gw2.x)); w.y = pk2(o[4 * q + 2] * rs * g4[2] * bflo(gw2.y), o[4 * q + 3] * rs * g4[3] * bfhi(gw2.y));
                        *(v2u*)(A2 + (size_t)row * DM + 256 * q + 4 * lane) = w; }
                }
                GRID_BAR();
            } }
#endif
        } else {
#if SITE(4)
            { KArgs ap = kargs(); const int tid = otid(); LAS unsigned char* lds = olds(lds0); (void)tid;
            if (IN(pb + 0)) {
                unsigned char* ws = ap->ws; const int j = L >> 1;
                LAS int* ul = (LAS int*)(lds + MISC_OFF + MO_ULIST);
                pg8::build_units_dense(tid, ul, NTOK / 256, RT_IN / 256, DM);
                pg8::EpiRetIn E{ws};
                pg8::gemm_phase<pg8::EpiRetIn, false, true>(tid, lds, ul, (LAS int*)(lds + MISC_OFF + MO_GTAB), (const char*)(ws + WS_XB), (const char*)((bf16*)(ws + WS_W_RIN) + (size_t)j * RT_IN * DM), nullptr, DM, E);
                GRID_BAR();
            } }
#endif
#if SITE(5)
            { KArgs ap = kargs(); const int tid = otid(); LAS unsigned char* lds = olds(lds0); (void)tid;
            if (IN(pb + 1)) {
#if SLOW_REC
                unsigned char* ws = ap->ws; const bf16* HB = (const bf16*)(ws + WS_H); bf16* OB = (bf16*)(ws + WS_O);
                LAS float* qf = (LAS float*)lds; LAS float* kf = qf + 16 * 4 * 68; LAS float* vf = kf + 16 * 4 * 68;
                for (int un = blockIdx.x; un < NBATCH * RT_HEADS * 4; un += gridDim.x) {
                    const int b = un >> 4, h = (un >> 2) & 3, vq = un & 3; const int vc = tid >> 2, kq = tid & 3;
                    const float gam = 1.0f - exp2f(-5.0f - (float)h);
                    float st[64];
#pragma unroll
                    for (int i = 0; i < 64; ++i) st[i] = 0.f;
                    for (int t0 = 0; t0 < SEQ; t0 += 16) {
                        __syncthreads();
                        for (int e = tid; e < 16 * 256; e += 512) { const int tt = e >> 8, k = e & 255; const size_t gi = (size_t)(b * SEQ + t0 + tt) * RT_IN + h * 256 + k; const int li = tt * 272 + (k & 3) * 68 + (k >> 2);
                            qf[li] = bf1(HB[gi]); kf[li] = bf1(HB[gi + 1024]); }
                        for (int e = tid; e < 16 * 128; e += 512) { const int tt = e >> 7, c = e & 127; vf[e] = bf1(HB[(size_t)(b * SEQ + t0 + tt) * RT_IN + 2048 + h * 512 + vq * 128 + c]); }
                        __syncthreads();
                        for (int tt = 0; tt < 16; ++tt) {
                            const float v = vf[tt * 128 + vc]; float a = 0.f; const int lb = tt * 272 + kq * 68;
#pragma unroll
                            for (int i = 0; i < 64; ++i) { st[i] = gam * st[i] + kf[lb + i] * v; a += qf[lb + i] * st[i]; }
                            a += __shfl_xor(a, 1); a += __shfl_xor(a, 2);
                            if (kq == 0) OB[(size_t)(b * SEQ + t0 + tt) * RT_VD + h * 512 + vq * 128 + vc] = (bf16)f2bf(a);
                        }
                    }
                }
#endif
                GRID_BAR();
            } }
#endif
#if SITE(6)
            { KArgs ap = kargs(); const int tid = otid(); LAS unsigned char* lds = olds(lds0); (void)tid;
            if (IN(pb + 2)) {
                const int lane = tid & 63, wave = __builtin_amdgcn_readfirstlane(tid >> 6), gw = VCU() * 8 + wave, NGW = gridDim.x * 8;
                unsigned char* ws = ap->ws; const bf16* OB = (const bf16*)(ws + WS_O); const bf16* HB = (const bf16*)(ws + WS_H); bf16* A2 = (bf16*)(ws + WS_A2);
                for (int row = gw; row < NTOK; row += NGW) {
#pragma unroll
                    for (int h = 0; h < 4; ++h) {
                        const v4u w = *(const v4u*)(OB + (size_t)row * RT_VD + 512 * h + 8 * lane);
                        float o[8] = {bflo(w.x), bfhi(w.x), bflo(w.y), bfhi(w.y), bflo(w.z), bfhi(w.z), bflo(w.w), bfhi(w.w)};
                        float s = 0.f;
#pragma unroll
                        for (int i = 0; i < 8; ++i) s += o[i];
                        const float mu = wave_sum(s) * (1.0f / 512.0f); float q = 0.f;
#pragma unroll
                        for (int i = 0; i < 8; ++i) { o[i] -= mu; q += o[i] * o[i]; }
                        const float rs = 1.0f / sqrtf(wave_sum(q) * (1.0f / 512.0f) + LN_EPS);
                        const v4u g = *(const v4u*)(HB + (size_t)row * RT_IN + 4096 + 512 * h + 8 * lane);
                        v4u r; r.x = pk2(o[0] * rs * bflo(g.x), o[1] * rs * bfhi(g.x)); r.y = pk2(o[2] * rs * bflo(g.y), o[3] * rs * bfhi(g.y));
                        r.z = pk2(o[4] * rs * bflo(g.z), o[5] * rs * bfhi(g.z)); r.w = pk2(o[6] * rs * bflo(g.w), o[7] * rs * bfhi(g.w));
                        *(v4u*)(A2 + (size_t)row * RT_VD + 512 * h + 8 * lane) = r;
                    }
                }
                GRID_BAR();
            } }
#endif
        }
#if SITE(7)
        { KArgs ap = kargs(); const int tid = otid(); LAS unsigned char* lds = olds(lds0); (void)tid;
        if (IN(pb + 3)) {
            unsigned char* ws = ap->ws; const int j = L >> 1; const bool ret = (L & 1) != 0;
            const int Ko = ret ? RT_VD : DM;
            LAS int* ul = (LAS int*)(lds + MISC_OFF + MO_ULIST);
            pg8::build_units_dense(tid, ul, NTOK / 256, DM / 256, Ko);
            const char* Bt = ret ? (const char*)((bf16*)(ws + WS_W_ROUT) + (size_t)j * DM * RT_VD) : (const char*)((bf16*)(ws + WS_W_HOUT) + (size_t)j * DM * DM);
            pg8::EpiRes E{(L == 0) ? ap->in[I_X] : (const float*)ap->out, ws};
            pg8::gemm_phase<pg8::EpiRes, false, true>(tid, lds, ul, (LAS int*)(lds + MISC_OFF + MO_GTAB), (const char*)(ws + WS_A2), Bt, nullptr, Ko, E);
            GRID_BAR();
        } }
#endif
#if SITE(8)
        { KArgs ap = kargs(); const int tid = otid(); LAS unsigned char* lds = olds(lds0); (void)tid;
        if (IN(pb + 4)) {
            const int lane = tid & 63, wave = __builtin_amdgcn_readfirstlane(tid >> 6);
            unsigned char* ws = ap->ws; unsigned* ctl = (unsigned*)(ws + WS_CTL);
            const float* Y = (const float*)(ws + WS_Y); float* X1F = (float*)(ws + WS_X1F); bf16* X1B = (bf16*)(ws + WS_X1B);
            int* ROWDST = (int*)(ws + WS_ROWDST); float* ROWGATE = (float*)(ws + WS_ROWGATE);
            LAS float* wT = (LAS float*)lds;
            LAS int* lcnt = (LAS int*)(lds + MISC_OFF + MO_LCNT); LAS int* lbase = (LAS int*)(lds + MISC_OFF + MO_LBASE);
            LAS int* sel = (LAS int*)(lds + MISC_OFF + MO_SEL); LAS float* selw = (LAS float*)(lds + MISC_OFF + MO_SELW);
            const float* rw = ap->in[I_RW] + (size_t)L * DM * NE; const float* rb = ap->in[I_RB] + L * NE;
            const float* lg = ap->in[I_LNMG] + L * DM; const float* lbb = ap->in[I_LNMB] + L * DM;
            for (int e4 = tid; e4 < DM * NE / 4; e4 += 512) { const f32x4 v = ((const f32x4*)rw)[e4]; const int d = e4 >> 3, e0 = (e4 & 7) * 4; wT[(e0 + 0) * DM + d] = v[0]; wT[(e0 + 1) * DM + d] = v[1]; wT[(e0 + 2) * DM + d] = v[2]; wT[(e0 + 3) * DM + d] = v[3]; }
            const float rbias = rb[lane >> 1];
            for (int blk = VCU(); blk < NTOK / 128; blk += gridDim.x) {
                if (tid < 32) lcnt[tid] = 0;
                __syncthreads();
#pragma unroll 1
                for (int rr = 0; rr < 16; ++rr) {
                    const int rloc = wave * 16 + rr, row = blk * 128 + rloc;
                    f32x4 x[4]; float s = 0.f;
#pragma unroll
                    for (int q = 0; q < 4; ++q) { x[q] = *(const f32x4*)(Y + (size_t)row * DM + 256 * q + 4 * lane); s += (x[q][0] + x[q][1]) + (x[q][2] + x[q][3]); }
                    const float mu = wave_sum(s) * (1.0f / DM); float qq = 0.f;
#pragma unroll
                    for (int q = 0; q < 4; ++q) { x[q] = x[q] - mu; qq += (x[q][0] * x[q][0] + x[q][1] * x[q][1]) + (x[q][2] * x[q][2] + x[q][3] * x[q][3]); }
                    const float rs = 1.0f / sqrtf(wave_sum(qq) * (1.0f / DM) + LN_EPS);
#pragma unroll
                    for (int q = 0; q < 4; ++q) { const f32x4 g4 = *(const f32x4*)(lg + 256 * q + 4 * lane), b4 = *(const f32x4*)(lbb + 256 * q + 4 * lane); x[q] = x[q] * rs * g4 + b4;
                        *(f32x4*)(X1F + (size_t)row * DM + 256 * q + 4 * lane) = x[q];
                        v2u w; w.x = pk2(x[q][0], x[q][1]); w.y = pk2(x[q][2], x[q][3]); *(v2u*)(X1B + (size_t)row * DM + 256 * q + 4 * lane) = w; }
                    float a[32];
#pragma unroll
                    for (int e = 0; e < 32; ++e) { float t = 0.f;
#pragma unroll
                        for (int q = 0; q < 4; ++q) { const f32x4 w = *(const LAS f32x4*)(wT + e * DM + 256 * q + 4 * lane); t += (x[q][0] * w[0] + x[q][1] * w[1]) + (x[q][2] * w[2] + x[q][3] * w[3]); }
                        a[e] = t; }
#pragma unroll
                    for (int st = 0; st < 5; ++st) { const int n = 16 >> st, msk = 32 >> st; const bool up = (lane & msk) != 0;
#pragma unroll
                        for (int i = 0; i < n; ++i) { const float keep = up ? a[i + n] : a[i], send = up ? a[i] : a[i + n]; a[i] = keep + __shfl_xor(send, msk); } }
                    float lgt = a[0] + __shfl_xor(a[0], 1) + rbias;
                    float v = lgt; int se[4]; float sv[4];
#pragma unroll
                    for (int k = 0; k < 4; ++k) { const float m = wave_max(v); const unsigned long long bal = __ballot(v == m); const int l0 = __builtin_ctzll(bal); se[k] = l0 >> 1; sv[k] = m; if ((lane >> 1) == se[k]) v = -3.0e38f; }
                    const float e1 = __expf(sv[1] - sv[0]), e2 = __expf(sv[2] - sv[0]), e3 = __expf(sv[3] - sv[0]); const float inv = 1.0f / (1.0f + e1 + e2 + e3);
                    if (lane < 4) { const int ee = lane == 0 ? se[0] : (lane == 1 ? se[1] : (lane == 2 ? se[2] : se[3])); const float ww = (lane == 0 ? 1.0f : (lane == 1 ? e1 : (lane == 2 ? e2 : e3))) * inv;
                        sel[rloc * 4 + lane] = ee; selw[rloc * 4 + lane] = ww; }
                }
                __syncthreads();
                const int myE = sel[tid]; const int rank = __hip_atomic_fetch_add(lcnt + myE, 1, __ATOMIC_RELAXED, __HIP_MEMORY_SCOPE_WORKGROUP);
                __syncthreads();
                if (tid < 32) lbase[tid] = (int)__hip_atomic_fetch_add(ctl + CW_ECNT + L * 32 + tid, (unsigned)lcnt[tid], RLX_AGENT);
                __syncthreads();
                { const int pos = lbase[myE] + rank; const size_t ti = (size_t)myE * ECAP + pos; ROWDST[ti] = (blk * 128 + (tid >> 2)) * 4 + (tid & 3); ROWGATE[ti] = selw[tid]; }
                __syncthreads();
            }
            GRID_BAR();
        } }
#endif
#if SITE(9)
        { KArgs ap = kargs(); const int tid = otid(); LAS unsigned char* lds = olds(lds0); (void)tid;
        if (IN(pb + 5)) {
            unsigned char* ws = ap->ws; unsigned* ctl = (unsigned*)(ws + WS_CTL);
            LAS int* tpre = (LAS int*)(lds + MISC_OFF + MO_TPRE); LAS int* ebase = (LAS int*)(lds + MISC_OFF + MO_EBASE); LAS int* ecnt = (LAS int*)(lds + MISC_OFF + MO_ECNT);
            if (tid == 0) { int t = 0;
_Pragma("unroll 1")
 for (int e = 0; e < NE; ++e) { const int c = (int)__hip_atomic_load(ctl + CW_ECNT + L * 32 + e, RLX_AGENT); ecnt[e] = c; tpre[e] = t; ebase[e] = t * 256; t += (c + 255) >> 8; } tpre[NE] = t; }
            __syncthreads();
            LAS int* ul = (LAS int*)(lds + MISC_OFF + MO_ULIST);
            pg8::build_units_moe(tid, ul, tpre, ebase, ecnt, 8, DM, 2048u * DM * 2u);
            pg8::EpiMoeGU E{ws, L};
            pg8::gemm_phase<pg8::EpiMoeGU, true, true>(tid, lds, ul, (LAS int*)(lds + MISC_OFF + MO_GTAB), (const char*)(ws + WS_X1B), (const char*)((bf16*)(ws + WS_W_GU) + (size_t)L * NE * 2048 * DM), (const int*)(ws + WS_ROWDST), DM, E);
            GRID_BAR();
        } }
#endif
#if SITE(10)
        { KArgs ap = kargs(); const int tid = otid(); LAS unsigned char* lds = olds(lds0); (void)tid;
        if (IN(pb + 6)) {
            unsigned char* ws = ap->ws; unsigned* ctl = (unsigned*)(ws + WS_CTL);
            LAS int* tpre = (LAS int*)(lds + MISC_OFF + MO_TPRE); LAS int* ebase = (LAS int*)(lds + MISC_OFF + MO_EBASE); LAS int* ecnt = (LAS int*)(lds + MISC_OFF + MO_ECNT);
            __syncthreads();
            if (tid == 0) { int t = 0;
_Pragma("unroll 1")
 for (int e = 0; e < NE; ++e) { const int c = (int)__hip_atomic_load(ctl + CW_ECNT + L * 32 + e, RLX_AGENT); ecnt[e] = c; tpre[e] = t; ebase[e] = t * 256; t += (c + 255) >> 8; } tpre[NE] = t; }
            __syncthreads();
            LAS int* ul = (LAS int*)(lds + MISC_OFF + MO_ULIST);
            pg8::build_units_moe(tid, ul, tpre, ebase, ecnt, 4, DM, (unsigned)DM * DM * 2u);
            pg8::EpiMoeDown E{ws, ap->in[I_BDN] + (size_t)L * NE * DM};
            pg8::gemm_phase<pg8::EpiMoeDown, false, true>(tid, lds, ul, (LAS int*)(lds + MISC_OFF + MO_GTAB), (const char*)(ws + WS_ACT), (const char*)((bf16*)(ws + WS_W_DN) + (size_t)L * NE * DM * DM), nullptr, DM, E);
            GRID_BAR();
        } }
#endif
#if SITE(11)
        { KArgs ap = kargs(); const int tid = otid(); LAS unsigned char* lds = olds(lds0); (void)tid;
        if (IN(pb + 7)) {
            const int lane = tid & 63, wave = __builtin_amdgcn_readfirstlane(tid >> 6), gw = VCU() * 8 + wave, NGW = gridDim.x * 8;
            unsigned char* ws = ap->ws; const float* X1F = (const float*)(ws + WS_X1F); const bf16* YS = (const bf16*)(ws + WS_YSLOT); bf16* XB = (bf16*)(ws + WS_XB); float* out = ap->out;
            const float* lg = ap->in[I_LNFG] + L * DM; const float* lbb = ap->in[I_LNFB] + L * DM;
            for (int row = gw; row < NTOK; row += NGW) {
                f32x4 x[4]; float s = 0.f;
#pragma unroll
                for (int q = 0; q < 4; ++q) { x[q] = *(const f32x4*)(X1F + (size_t)row * DM + 256 * q + 4 * lane) * DN_ALPHA;
#pragma unroll
                    for (int k = 0; k < 4; ++k) { const v2u w = *(const v2u*)(YS + ((size_t)row * 4 + k) * DM + 256 * q + 4 * lane); x[q][0] += bflo(w.x); x[q][1] += bfhi(w.x); x[q][2] += bflo(w.y); x[q][3] += bfhi(w.y); }
                    s += (x[q][0] + x[q][1]) + (x[q][2] + x[q][3]); }
                const float mu = wave_sum(s) * (1.0f / DM); float qq = 0.f;
#pragma unroll
                for (int q = 0; q < 4; ++q) { x[q] = x[q] - mu; qq += (x[q][0] * x[q][0] + x[q][1] * x[q][1]) + (x[q][2] * x[q][2] + x[q][3] * x[q][3]); }
                const float rs = 1.0f / sqrtf(wave_sum(qq) * (1.0f / DM) + LN_EPS);
#pragma unroll
                for (int q = 0; q < 4; ++q) { const f32x4 g = *(const f32x4*)(lg + 256 * q + 4 * lane), bb = *(const f32x4*)(lbb + 256 * q + 4 * lane); x[q] = x[q] * rs * g + bb;
                    *(f32x4*)(out + (size_t)row * DM + 256 * q + 4 * lane) = x[q];
                    v2u w; w.x = pk2(x[q][0], x[q][1]); w.y = pk2(x[q][2], x[q][3]); *(v2u*)(XB + (size_t)row * DM + 256 * q + 4 * lane) = w; }
            }
            if (L + 1 < DEPTH) GRID_BAR();
        } }
#endif
    }
#undef IN
#undef GRID_BAR
}

extern "C" void kernel_launch(void* const* d_in, const int* in_sizes, int n_in, void* d_out, int out_size, void* d_ws, size_t ws_size, hipStream_t stream) {
    static int grid = 0;
    if (grid == 0) {
        if (n_in != 17 || out_size != NTOK * DM || ws_size < WS_END) { fprintf(stderr, "kernel_launch: unexpected shapes (n_in %d, out %d, ws %zu < %zu)\n", n_in, out_size, ws_size, (size_t)WS_END); grid = -1; return; }
        int dev = 0, cus = 0, per_cu = 0;
        if (hipGetDevice(&dev) != hipSuccess || hipDeviceGetAttribute(&cus, hipDeviceAttributeMultiprocessorCount, dev) != hipSuccess) { grid = -1; return; }
        if (hipFuncSetAttribute((const void*)mk_fwd, hipFuncAttributeMaxDynamicSharedMemorySize, LDS_BYTES) != hipSuccess) { fprintf(stderr, "kernel_launch: hipFuncSetAttribute failed\n"); grid = -1; return; }
        if (hipOccupancyMaxActiveBlocksPerMultiprocessor(&per_cu, (const void*)mk_fwd, 512, LDS_BYTES) != hipSuccess || per_cu < 1) { fprintf(stderr, "kernel_launch: occupancy query says %d\n", per_cu); }
        (void)hipGetLastError();
        grid = cus;
    }
    if (grid < 0) return;
    (void)hipMemsetAsync((char*)d_ws + WS_CTL, 0, CTL_ZERO_BYTES, stream);
    Args a{};
    for (int i = 0; i < 17; ++i) a.in[i] = (const float*)d_in[i];
    a.out = (float*)d_out; a.ws = (unsigned char*)d_ws;
#if MK_MULTI
    for (int p = 0; p < 1 + 8 * DEPTH; ++p) { a.ph_lo = p; a.ph_hi = p + 1; hipLaunchKernelGGL(mk_fwd, dim3(grid), dim3(512), LDS_BYTES, stream, a); }
#else
    a.ph_lo = 0; a.ph_hi = 1 + 8 * DEPTH;
    hipLaunchKernelGGL(mk_fwd, dim3(grid), dim3(512), LDS_BYTES, stream, a);
#endif
}
```

```cpp
#include <hip/hip_runtime.h>
#include <cstdio>
#include <cstdint>

#ifndef MK_MULTI
#define MK_MULTI 0
#endif
#ifndef SLOW_HGRN
#define SLOW_HGRN 0
#endif
#ifndef SLOW_RET
#define SLOW_RET 0
#endif

#define GAS __attribute__((address_space(1)))
#define LAS __attribute__((address_space(3)))
typedef unsigned short bf16;
typedef unsigned v4u __attribute__((ext_vector_type(4)));
typedef unsigned v2u __attribute__((ext_vector_type(2)));
typedef float f32x4 __attribute__((ext_vector_type(4)));
typedef float f32x2 __attribute__((ext_vector_type(2)));
typedef short bf16x8 __attribute__((ext_vector_type(8)));
typedef GAS unsigned gu32;

constexpr int DM = 1024, NBATCH = 16, SEQ = 2048, NTOK = NBATCH * SEQ, DEPTH = 4;
constexpr int NE = 32, TOPK = 4;
constexpr int HG_HEADS = 8, HG_K = 128;
constexpr int RT_HEADS = 4, RT_K = 256, RT_V = 512, RT_VD = 2048, RT_IN = 6144, HG_IN = 4096;
constexpr int ECAP = NTOK;
constexpr int MOE_ROWS = NTOK * TOPK + NE * 256;
constexpr float DN_ALPHA = 1.681792830507429f;
constexpr float LN_EPS = 1e-5f, RMS_EPS = 1e-6f;

constexpr size_t MiB = 1ull << 20;
constexpr size_t WS_CTL = 0, CTL_ZERO_BYTES = 1 * MiB;
constexpr size_t WS_LBS = 1 * MiB;
constexpr size_t WS_BGU = 2 * MiB;
constexpr size_t WS_ROT = 4 * MiB;
constexpr size_t WS_ROWDST = 8 * MiB;
constexpr size_t WS_ROWGATE = 12 * MiB;
constexpr size_t WS_W_HIN = 16 * MiB;
constexpr size_t WS_W_HOUT = WS_W_HIN + 16 * MiB;
constexpr size_t WS_W_RIN = WS_W_HOUT + 4 * MiB;
constexpr size_t WS_W_ROUT = WS_W_RIN + 24 * MiB;
constexpr size_t WS_W_GU = WS_W_ROUT + 8 * MiB;
constexpr size_t WS_W_DN = WS_W_GU + 512 * MiB;
constexpr size_t WS_XB = WS_W_DN + 256 * MiB;
constexpr size_t WS_H = WS_XB + 64 * MiB;
constexpr size_t WS_DEC = WS_H + 320 * MiB;
constexpr size_t WS_O = WS_H + 384 * MiB;
constexpr size_t WS_A2 = WS_O + 128 * MiB;
constexpr size_t WS_Y = WS_A2 + 128 * MiB;
constexpr size_t WS_X1F = WS_Y + 128 * MiB;
constexpr size_t WS_X1B = WS_X1F + 128 * MiB;
constexpr size_t WS_ACT = WS_X1B + 64 * MiB;
constexpr size_t WS_YSLOT = WS_ACT + 272 * MiB;
constexpr size_t WS_END = WS_YSLOT + 256 * MiB;

constexpr int CW_BAR = 4096;
constexpr int CW_ECNT = 16384;

constexpr int RING_BYTES = 131072;
constexpr int MISC_OFF = 135168;
constexpr int LDS_BYTES = 147456;
constexpr int MO_BARW = 0;
constexpr int MO_GTAB = 64;
constexpr int MO_TPRE = 64 + 2048;
constexpr int MO_EBASE = MO_TPRE + 160;
constexpr int MO_ECNT = MO_EBASE + 128;
constexpr int MO_LCNT = MO_ECNT + 128;
constexpr int MO_LBASE = MO_LCNT + 128;
constexpr int MO_SEL = MO_LBASE + 128;
constexpr int MO_SELW = MO_SEL + 2048;
constexpr int MO_RANK = MO_SELW + 2048;
constexpr int MO_ULIST = MO_RANK + 2048;
static_assert(MISC_OFF + MO_ULIST + 1024 <= LDS_BYTES, "LDS map");

#define RLX_AGENT __ATOMIC_RELAXED, __HIP_MEMORY_SCOPE_AGENT
#define LDS_WAIT() asm volatile("s_waitcnt lgkmcnt(0)" ::: "memory")
#define VM_WAIT() asm volatile("s_waitcnt vmcnt(0)" ::: "memory")

__device__ __forceinline__ unsigned f2bf(float f) { unsigned u = __builtin_bit_cast(unsigned, f); return (u + 0x7fffu + ((u >> 16) & 1u)) >> 16; }
__device__ __forceinline__ unsigned pk2(float lo, float hi) { return f2bf(lo) | (f2bf(hi) << 16); }
__device__ __forceinline__ unsigned cvt_pk_bf16(float lo, float hi) { unsigned r; asm volatile("v_cvt_pk_bf16_f32 %0, %1, %2" : "=v"(r) : "v"(lo), "v"(hi)); return r; }
__device__ __forceinline__ float bflo(unsigned u) { return __builtin_bit_cast(float, u << 16); }
__device__ __forceinline__ float bfhi(unsigned u) { return __builtin_bit_cast(float, u & 0xffff0000u); }
__device__ __forceinline__ float bf1(bf16 b) { return __builtin_bit_cast(float, ((unsigned)b) << 16); }
__device__ __forceinline__ float fexp(float x) { return __builtin_amdgcn_exp2f(x * 1.4426950408889634f); }
__device__ __forceinline__ float frcp(float x) { return __builtin_amdgcn_rcpf(x); }
__device__ __forceinline__ float fsigmoid(float x) { return frcp(1.0f + fexp(-x)); }
__device__ __forceinline__ float wave_sum(float v) {
#pragma unroll
    for (int o = 1; o < 64; o <<= 1) v += __shfl_xor(v, o);
    return v;
}
__device__ __forceinline__ float wave_max(float v) {
#pragma unroll
    for (int o = 1; o < 64; o <<= 1) v = fmaxf(v, __shfl_xor(v, o));
    return v;
}

#define XB_TMO      128
#define XB_XCNT(j)  (256  + 64 * (j))
#define XB_XSUB(j)  (1280 + 64 * (j))
#define XB_XGEN(j)  (2304 + 64 * (j))
#define XB_TOP      3328
#define XB_TOPGEN   3392
#define XCD_BAR_WORDS 3456
#define XB_SPIN_CAP (1u << 22)

__device__ __forceinline__ unsigned xb_ld(unsigned* p)              { return __hip_atomic_load(p, __ATOMIC_RELAXED, __HIP_MEMORY_SCOPE_AGENT); }
__device__ __forceinline__ unsigned xb_add(unsigned* p, unsigned v) { return __hip_atomic_fetch_add(p, v, __ATOMIC_RELAXED, __HIP_MEMORY_SCOPE_AGENT); }
__device__ __forceinline__ unsigned xb_xcc_id() { return (unsigned)__builtin_amdgcn_s_getreg((3 << 11) | 20) & 0xFu; }
#define XB_SPIN(cond, bar) do { unsigned _sp = 0; while (cond) { __builtin_amdgcn_s_sleep(1); \
    if ((++_sp & 255u) == 0u) { if (xb_ld(&(bar)[XB_TMO])) break; if (_sp > XB_SPIN_CAP) { atomicAdd(&(bar)[XB_TMO], 1u); break; } } } } while (0)

struct XcdBarrier { unsigned* bar; unsigned x; volatile LAS unsigned* st; };

__device__ __forceinline__ XcdBarrier xcd_barrier_post(unsigned* bar, volatile LAS unsigned* st) {
    XcdBarrier b; b.bar = bar; b.x = xb_xcc_id(); b.st = st;
    if (threadIdx.x == 0) (void)xb_add(&bar[XB_XCNT(b.x)], 1u);
    return b;
}
__device__ __forceinline__ void xcd_barrier_complete(unsigned* bar, unsigned x, unsigned& nloc, unsigned& nx) {
    const unsigned G = gridDim.x * gridDim.y * gridDim.z;
    unsigned sum, cnt, mine, sp = 0u;
    for (;;) {
        sum = 0u; cnt = 0u; mine = 0u;
#pragma unroll
        for (unsigned j = 0; j < 16; ++j) { const unsigned c = xb_ld(&bar[XB_XCNT(j)]); sum += c; cnt += (c > 0u) ? 1u : 0u; mine = (j == x) ? c : mine; }
        if (sum == G) break;
        __builtin_amdgcn_s_sleep(1);
        if ((++sp & 255u) == 0u) { if (xb_ld(&bar[XB_TMO])) break; if (sp > XB_SPIN_CAP) { atomicAdd(&bar[XB_TMO], 1u); break; } }
    }
    nloc = mine > 0u ? mine : 1u; nx = cnt > 0u ? cnt : 1u;
}
__device__ __forceinline__ void xcd_barrier(const XcdBarrier& b) {
    asm volatile("s_waitcnt vmcnt(0)" ::: "memory");
    __syncthreads();
    if (threadIdx.x == 0) {
        unsigned* bar = b.bar;
        __builtin_amdgcn_s_waitcnt(0);
        unsigned nloc = b.st[0], nx = b.st[1];
        if (nloc == 0u) { xcd_barrier_complete(bar, b.x, nloc, nx); b.st[0] = nloc; b.st[1] = nx; }
        const unsigned old = xb_add(&bar[XB_XSUB(b.x)], 1u);
        const unsigned gen = old / nloc;
        if (old + 1u == (gen + 1u) * nloc) {
            __builtin_amdgcn_fence(__ATOMIC_RELEASE, "agent");
            asm volatile("s_waitcnt vmcnt(0)" ::: "memory");
            const unsigned og = xb_add(&bar[XB_TOP], 1u);
            const unsigned tg = og / nx;
            if (og + 1u == (tg + 1u) * nx) xb_add(&bar[XB_TOPGEN], 1u);
            else XB_SPIN(xb_ld(&bar[XB_TOPGEN]) == tg, bar);
            __builtin_amdgcn_fence(__ATOMIC_ACQUIRE, "agent");
            xb_add(&bar[XB_XGEN(b.x)], 1u);
            asm volatile("s_waitcnt vmcnt(0)" ::: "memory");
        } else {
            XB_SPIN(xb_ld(&bar[XB_XGEN(b.x)]) == gen, bar);
            __builtin_amdgcn_fence(__ATOMIC_ACQUIRE, "agent");
            asm volatile("s_waitcnt vmcnt(0)" ::: "memory");
        }
    }
    __syncthreads();
}

namespace pg8 {
constexpr int BM = 256, BK = 64, HALF = 128, HTB = HALF * BK * 2, STAGE_BYTES = 8 * HTB, NXCD = 8, WGM = 8, MAXU = 32;
__host__ __device__ __forceinline__ int lds_byte(int r, int c) { const int st = (r >> 4) * 2 + (c >> 5), rr = r & 15, cc = c & 31, ob = rr * 64 + cc * 2; return st * 1024 + (ob ^ (((ob >> 9) & 1) << 5)); }
__host__ __device__ __forceinline__ void stage_rc(int b, int& R, int& C) { const int st = b / 1024, sb = b % 1024, swz = sb ^ (((sb >> 9) & 1) << 5); R = (st >> 1) * 16 + swz / 64; C = (st & 1) * 32 + (swz % 64) / 2; }
__host__ __device__ __forceinline__ int perm32(int rho) { const int n = rho >> 4, i = rho & 15; return 8 * (i >> 2) + 4 * n + (i & 3); }

struct Unit { int pm, pn, e, rowbase, cnt; unsigned boff; int gidx; };

__device__ __forceinline__ bool tile_of(long L, int nM, int nN, int& gm, int& pn) {
    const int nwg = nM * nN; if (L >= nwg) return false;
    int wgid = (int)L; { const int q = nwg / NXCD, r = nwg % NXCD, xcd = wgid % NXCD, off = wgid / NXCD; wgid = (xcd < r ? xcd * (q + 1) : r * (q + 1) + (xcd - r) * q) + off; }
    const int nig = WGM * nN, gid = wgid / nig, fm = gid * WGM, gsz = (nM - fm) < WGM ? (nM - fm) : WGM;
    gm = fm + ((wgid % nig) % gsz); pn = (wgid % nig) / gsz; return true;
}
__device__ __forceinline__ void build_units_dense(const int i, LAS int* ul, int nM, int nN, int K) {
    if (i < MAXU) { int gm = 0, pn = 0; const bool ok = tile_of((long)i * gridDim.x + blockIdx.x, nM, nN, gm, pn);
        ul[i * 8 + 0] = ok ? 1 : 0; ul[i * 8 + 1] = gm; ul[i * 8 + 2] = pn; ul[i * 8 + 3] = 0; ul[i * 8 + 4] = gm * BM; ul[i * 8 + 5] = BM; ul[i * 8 + 6] = (int)((unsigned)pn * BM * (unsigned)K * 2u); ul[i * 8 + 7] = 0; }
    __syncthreads();
}
__device__ __forceinline__ void build_units_moe(const int i, LAS int* ul, const LAS int* tpre, const LAS int* ebase, const LAS int* ecnt, int nN, int K, unsigned wstride) {
    if (i < MAXU) { int gm = 0, pn = 0; const bool ok = tile_of((long)i * gridDim.x + blockIdx.x, tpre[NE], nN, gm, pn);
        int e = 0;
_Pragma("unroll 1")
        for (int s = 16; s >= 1; s >>= 1) { if (e + s < NE && tpre[e + s] <= gm) e += s; }
        const int pm = gm - tpre[e];
        ul[i * 8 + 0] = ok ? 1 : 0; ul[i * 8 + 1] = pm; ul[i * 8 + 2] = pn; ul[i * 8 + 3] = e; ul[i * 8 + 4] = ebase[e] + pm * BM; ul[i * 8 + 5] = ecnt[e] - pm * BM;
        ul[i * 8 + 6] = (int)((unsigned)e * wstride + (unsigned)pn * BM * (unsigned)K * 2u); ul[i * 8 + 7] = e * ECAP + pm * BM; }
    __syncthreads();
}
__device__ __forceinline__ bool ld_unit(const LAS int* ul, int i, Unit& u) {
    if (i >= MAXU) return false;
    const LAS int* p = ul + i * 8;
    if (__builtin_amdgcn_readfirstlane(p[0]) == 0) return false;
    u.pm = __builtin_amdgcn_readfirstlane(p[1]); u.pn = __builtin_amdgcn_readfirstlane(p[2]); u.e = __builtin_amdgcn_readfirstlane(p[3]); u.rowbase = __builtin_amdgcn_readfirstlane(p[4]);
    u.cnt = __builtin_amdgcn_readfirstlane(p[5]); u.boff = (unsigned)__builtin_amdgcn_readfirstlane(p[6]); u.gidx = __builtin_amdgcn_readfirstlane(p[7]); return true;
}
template <bool GATHER> __device__ __forceinline__ void stage_a(LAS unsigned char* dst, const char* sbase, unsigned o0, unsigned o1, size_t r64) {
    __builtin_amdgcn_global_load_lds((const unsigned*)(sbase + o0), (LAS unsigned*)dst, 16, 0, 0);
    if constexpr (GATHER) __builtin_amdgcn_global_load_lds((const unsigned*)(sbase + o1), (LAS unsigned*)(dst + 8192), 16, 0, 0);
    else __builtin_amdgcn_global_load_lds((const unsigned*)(sbase + r64 + o0), (LAS unsigned*)(dst + 8192), 16, 0, 0);
}

template <class Epi, bool GATHER, bool ALIGN_EPI>
__device__ __forceinline__ void gemm_phase(const int tid, LAS unsigned char* lds, const LAS int* ul, LAS int* gtab, const char* Abase, const char* Bbase, const int* rowdst, const int K, const Epi& E) {
    const int wid = __builtin_amdgcn_readfirstlane(tid >> 6), lane = tid & 63, wr = wid >> 2, wc = wid & 3, fr = lane & 15, fq = lane >> 4;
    const int nt = K / BK;
    int R0, C0; stage_rc(tid * 16, R0, C0);
    const int Rb0 = Epi::PERM ? ((R0 & ~31) + perm32(R0 & 31)) : R0;
    const unsigned voffB = (unsigned)(Rb0 * K + C0) * 2u;
    const unsigned cb0 = (unsigned)C0 * 2u, K2 = (unsigned)K * 2u;
    const size_t kstep = (size_t)(BK * 2);
    const size_t r64 = (size_t)64 * K * 2;
    const size_t hstep = (size_t)HALF * K * 2;
    const unsigned ldsw = (unsigned)wid * 1024u;
    const int aoff = lds_byte(wr * 64 + fr, fq * 8), boff = lds_byte(wc * 32 + fr, fq * 8);
#define PG8_SA(b, h) (((b) * 2 + (h)) * HTB)
#define PG8_SB(b, h) ((4 + (b) * 2 + (h)) * HTB)
#define PG8_STAGE(bufoff, gbase) do { \
        __builtin_amdgcn_global_load_lds((const unsigned*)((const char*)(gbase) + voffB), (LAS unsigned*)(lds + (bufoff) + ldsw), 16, 0, 0); \
        __builtin_amdgcn_global_load_lds((const unsigned*)((const char*)(gbase) + r64 + voffB), (LAS unsigned*)(lds + (bufoff) + ldsw + 8192), 16, 0, 0); } while (0)
#define PG8_STAGEA0(bufoff, kb, o0, o1) stage_a<GATHER>(lds + (bufoff) + ldsw, Abase + (kb), o0, o1, r64)
#define PG8_STAGEA1(bufoff, kb, o0, o2, o3) stage_a<GATHER>(lds + (bufoff) + ldsw, Abase + (kb) + (GATHER ? (size_t)0 : hstep), GATHER ? (o2) : (o0), o3, r64)
#define PG8_LDA(dst, b, h) do { _Pragma("unroll") for (int m = 0; m < 4; ++m) _Pragma("unroll") for (int k = 0; k < 2; ++k) dst[m][k] = *(const LAS bf16x8*)(lds + PG8_SA(b, h) + aoff + m * 2048 + k * 1024); } while (0)
#define PG8_LDB(dst, b, h) do { _Pragma("unroll") for (int n = 0; n < 2; ++n) _Pragma("unroll") for (int k = 0; k < 2; ++k) dst[n][k] = *(const LAS bf16x8*)(lds + PG8_SB(b, h) + boff + n * 2048 + k * 1024); } while (0)
#define PG8_MMA(ai, bj, At, Bt) do { __builtin_amdgcn_s_setprio(1); _Pragma("unroll") for (int m = 0; m < 4; ++m) _Pragma("unroll") for (int n = 0; n < 2; ++n) _Pragma("unroll") for (int k = 0; k < 2; ++k) \
        acc[ai][bj][m][n] = __builtin_amdgcn_mfma_f32_16x16x32_bf16(Bt[n][k], At[m][k], acc[ai][bj][m][n], 0, 0, 0); __builtin_amdgcn_s_setprio(0); } while (0)
#define PG8_WAIT_V(n) asm volatile("s_waitcnt vmcnt(" #n ")" ::: "memory")
#define PG8_WAIT_L(n) asm volatile("s_waitcnt lgkmcnt(" #n ")" ::: "memory")
#define PG8_BAR __builtin_amdgcn_s_barrier()
#define PG8_SCHED __builtin_amdgcn_sched_barrier(0)
    Unit cur, nxt; int ui = 0;
    if (!ld_unit(ul, 0, cur)) return;
    f32x4 acc[2][2][4][2];
#pragma unroll
    for (int a = 0; a < 2; ++a)
#pragma unroll
        for (int b = 0; b < 2; ++b)
#pragma unroll
            for (int m = 0; m < 4; ++m)
#pragma unroll
                for (int n = 0; n < 2; ++n) acc[a][b][m][n] = (f32x4){0.f, 0.f, 0.f, 0.f};
    bf16x8 At[4][2], B0[2][2], B1[2][2];
    unsigned oA0, oA1 = 0, oA2 = 0, oA3 = 0, oN0, oN1 = 0, oN2 = 0, oN3 = 0;
    if constexpr (GATHER) {
        const int c1 = cur.cnt - 1; const int* gp = rowdst + cur.gidx;
        oA0 = ((unsigned)gp[min(R0, c1)] >> 2) * K2 + cb0; oA1 = ((unsigned)gp[min(R0 + 64, c1)] >> 2) * K2 + cb0; oA2 = ((unsigned)gp[min(R0 + 128, c1)] >> 2) * K2 + cb0; oA3 = ((unsigned)gp[min(R0 + 192, c1)] >> 2) * K2 + cb0;
    } else {
        oA0 = (unsigned)(cur.rowbase + R0) * K2 + cb0;
    }
    oN0 = oA0; oN1 = oA1; oN2 = oA2; oN3 = oA3;
    const char* cB = Bbase + cur.boff;
    PG8_STAGE(PG8_SB(0, 0), cB); PG8_STAGE(PG8_SB(0, 1), cB + hstep); PG8_STAGEA0(PG8_SA(0, 0), (size_t)0, oA0, oA1); PG8_STAGEA1(PG8_SA(0, 1), (size_t)0, oA0, oA2, oA3);
    if (wr == 1) PG8_BAR;
    PG8_WAIT_V(2); PG8_BAR;
    PG8_STAGE(PG8_SB(1, 0), cB + kstep); PG8_STAGEA0(PG8_SA(1, 0), kstep, oA0, oA1); PG8_STAGE(PG8_SB(1, 1), cB + hstep + kstep);
    PG8_WAIT_V(6); PG8_BAR;
    for (;;) {
        const bool has_next = ld_unit(ul, ui + 1, nxt);
        const char* nB = has_next ? Bbase + nxt.boff : cB;
        if constexpr (GATHER) {
            if (has_next && tid < 256) gtab[tid] = (int)((unsigned)rowdst[nxt.gidx + min(tid, nxt.cnt - 1)] >> 2);
        }
        for (int t = 0; t < nt; t += 2) {
            const bool last = (t == nt - 2);
            if (last && has_next) {
                if constexpr (GATHER) {
                    oN0 = (unsigned)gtab[R0] * K2 + cb0; oN1 = (unsigned)gtab[R0 + 64] * K2 + cb0; oN2 = (unsigned)gtab[R0 + 128] * K2 + cb0; oN3 = (unsigned)gtab[R0 + 192] * K2 + cb0;
                } else {
                    oN0 = (unsigned)(nxt.rowbase + R0) * K2 + cb0;
                }
            }
            const size_t kb1 = (size_t)(t + 1) * kstep;
            const size_t kb2 = last ? (size_t)0 : (size_t)(t + 2) * kstep, kb3 = kb2 + kstep;
            const unsigned p0 = last ? oN0 : oA0, p1 = last ? oN1 : oA1, p2 = last ? oN2 : oA2, p3 = last ? oN3 : oA3;
            const char* b2 = last ? nB : cB + (size_t)(t + 2) * kstep; const char* b3 = b2 + kstep;
            PG8_LDB(B0, 0, 0); PG8_LDB(B1, 0, 1); PG8_SCHED; PG8_LDA(At, 0, 0); PG8_STAGEA1(PG8_SA(1, 1), kb1, oA0, oA2, oA3);
            PG8_WAIT_V(8); PG8_WAIT_L(0); PG8_BAR; PG8_MMA(0, 0, At, B0); PG8_MMA(0, 1, At, B1); PG8_BAR; PG8_SCHED;
            PG8_LDA(At, 0, 1); PG8_STAGE(PG8_SB(0, 0), b2); PG8_STAGE(PG8_SB(0, 1), b2 + hstep); PG8_STAGEA0(PG8_SA(0, 0), kb2, p0, p1);
            PG8_WAIT_V(8); PG8_WAIT_L(0); PG8_BAR; PG8_MMA(1, 0, At, B0); PG8_MMA(1, 1, At, B1); PG8_BAR; PG8_SCHED;
            PG8_LDB(B0, 1, 0); PG8_LDB(B1, 1, 1); PG8_SCHED; PG8_LDA(At, 1, 0); PG8_STAGEA1(PG8_SA(0, 1), kb2, p0, p2, p3);
            PG8_WAIT_V(8); PG8_WAIT_L(0); PG8_BAR; PG8_MMA(0, 0, At, B0); PG8_MMA(0, 1, At, B1); PG8_BAR; PG8_SCHED;
            PG8_LDA(At, 1, 1); PG8_STAGE(PG8_SB(1, 0), b3); PG8_STAGE(PG8_SB(1, 1), b3 + hstep); PG8_STAGEA0(PG8_SA(1, 0), kb3, p0, p1);
            PG8_WAIT_V(8); PG8_WAIT_L(0); PG8_BAR; PG8_MMA(1, 0, At, B0); PG8_MMA(1, 1, At, B1); PG8_BAR; PG8_SCHED;
        }
        if constexpr (ALIGN_EPI) { if (wr == 0) PG8_BAR; }
        E(acc, cur, wr, wc, fr, fq);
        if (!has_next) break;
#pragma unroll
        for (int a = 0; a < 2; ++a)
#pragma unroll
            for (int b = 0; b < 2; ++b)
#pragma unroll
                for (int m = 0; m < 4; ++m)
#pragma unroll
                    for (int n = 0; n < 2; ++n) acc[a][b][m][n] = (f32x4){0.f, 0.f, 0.f, 0.f};
        cur = nxt; cB = nB; oA0 = oN0; oA1 = oN1; oA2 = oN2; oA3 = oN3; ++ui;
        if constexpr (ALIGN_EPI) { if (wr == 1) PG8_BAR; }
    }
    PG8_WAIT_V(0);
    if constexpr (!ALIGN_EPI) { if (wr == 0) PG8_BAR; }
    PG8_BAR;
#undef PG8_SA
#undef PG8_SB
#undef PG8_STAGE
#undef PG8_STAGEA0
#undef PG8_STAGEA1
#undef PG8_LDA
#undef PG8_LDB
#undef PG8_MMA
#undef PG8_WAIT_V
#undef PG8_WAIT_L
#undef PG8_BAR
#undef PG8_SCHED
}

__device__ __forceinline__ unsigned char* launder(unsigned char* p) { asm volatile("" : "+s"(p)); return p; }
struct EpiHgrnIn {
    static constexpr bool PERM = true;
    unsigned char* ws0; int L;
    __device__ __forceinline__ void operator()(const f32x4 (&acc)[2][2][4][2], const Unit& u, int wr, int wc, int fr, int fq) const {
        unsigned char* ws = launder(ws0);
        bf16* QD = (bf16*)(ws + WS_H);
        const int row0 = u.rowbase + wr * 64 + fr;
        if (u.pn >= 8) {
            const bool isg = u.pn >= 12; bf16* base = QD + (size_t)(isg ? 4 : 3) * NTOK * DM; const int colt = (u.pn - (isg ? 12 : 8)) * BM + wc * 32 + 8 * fq;
#pragma unroll
            for (int ai = 0; ai < 2; ++ai)
#pragma unroll
                for (int m = 0; m < 4; ++m) { bf16* rowp = base + (size_t)(row0 + ai * HALF + m * 16) * DM + colt;
#pragma unroll
                    for (int bj = 0; bj < 2; ++bj) { f32x4 v0 = acc[ai][bj][m][0], v1 = acc[ai][bj][m][1];
                        if (isg) {
#pragma unroll
                            for (int j = 0; j < 4; ++j) { v0[j] = v0[j] * fsigmoid(v0[j]); v1[j] = v1[j] * fsigmoid(v1[j]); } }
                        v4u w; w.x = cvt_pk_bf16(v0[0], v0[1]); w.y = cvt_pk_bf16(v0[2], v0[3]); w.z = cvt_pk_bf16(v1[0], v1[1]); w.w = cvt_pk_bf16(v1[2], v1[3]);
                        *(v4u*)(rowp + bj * HALF) = w; } }
            return;
        }
        const int col = u.pn * HG_K + wc * 32 + 8 * fq;
        const float* lb = (const float*)(ws + WS_LBS) + L * DM;
        const f32x4 lb0 = *(const f32x4*)(lb + col), lb1 = *(const f32x4*)(lb + col + 4);
#if !SLOW_HGRN
        const int lane = fq * 16 + fr;
        float* DEC = (float*)(ws + WS_DEC);
#endif
#pragma unroll
        for (int ai = 0; ai < 2; ++ai)
#pragma unroll
            for (int m = 0; m < 4; ++m) {
                const int row = row0 + ai * HALF + m * 16;
                float qd[8], ki[8], ks[8];
#if !SLOW_HGRN
                float de[8];
#endif
#pragma unroll
                for (int j = 0; j < 8; ++j) {
                    const float q = acc[ai][0][m][j >> 2][j & 3], f = acc[ai][1][m][j >> 2][j & 3], lbv = j < 4 ? lb0[j & 3] : lb1[j & 3];
                    const float sg = fsigmoid(f), fg = lbv + (1.0f - lbv) * sg, kk = (1.0f - lbv) * (1.0f - sg);
#if SLOW_HGRN
                    qd[j] = q * fsigmoid(q); ki[j] = kk; ks[j] = fg;
#else
                    float b = __builtin_amdgcn_logf(fg) * 0.6931471805599453f;
                    b += __builtin_bit_cast(float, __builtin_amdgcn_update_dpp(0, __builtin_bit_cast(int, b), 0x111, 0xf, 0xf, true));
                    b += __builtin_bit_cast(float, __builtin_amdgcn_update_dpp(0, __builtin_bit_cast(int, b), 0x112, 0xf, 0xf, true));
                    b += __builtin_bit_cast(float, __builtin_amdgcn_update_dpp(0, __builtin_bit_cast(int, b), 0x114, 0xf, 0xf, true));
                    b += __builtin_bit_cast(float, __builtin_amdgcn_update_dpp(0, __builtin_bit_cast(int, b), 0x118, 0xf, 0xf, true));
                    const float bl = __shfl(b, lane | 15);
                    qd[j] = q * fsigmoid(q) * fexp(b); ki[j] = kk * fexp(-b); ks[j] = kk * fexp(bl - b); de[j] = fexp(bl);
#endif
                }
                const size_t o = (size_t)row * DM + col;
                v4u w;
                w.x = cvt_pk_bf16(qd[0], qd[1]); w.y = cvt_pk_bf16(qd[2], qd[3]); w.z = cvt_pk_bf16(qd[4], qd[5]); w.w = cvt_pk_bf16(qd[6], qd[7]); *(v4u*)(QD + o) = w;
                w.x = cvt_pk_bf16(ki[0], ki[1]); w.y = cvt_pk_bf16(ki[2], ki[3]); w.z = cvt_pk_bf16(ki[4], ki[5]); w.w = cvt_pk_bf16(ki[6], ki[7]); *(v4u*)(QD + (size_t)NTOK * DM + o) = w;
                w.x = cvt_pk_bf16(ks[0], ks[1]); w.y = cvt_pk_bf16(ks[2], ks[3]); w.z = cvt_pk_bf16(ks[4], ks[5]); w.w = cvt_pk_bf16(ks[6], ks[7]); *(v4u*)(QD + 2 * (size_t)NTOK * DM + o) = w;
#if !SLOW_HGRN
                if (fr == 0) { float* dp = DEC + (size_t)(row >> 4) * DM + col; *(f32x4*)dp = (f32x4){de[0], de[1], de[2], de[3]}; *(f32x4*)(dp + 4) = (f32x4){de[4], de[5], de[6], de[7]}; }
#endif
            }
    }
};
struct EpiRetIn {
    static constexpr bool PERM = true;
    unsigned char* ws0;
    __device__ __forceinline__ void operator()(const f32x4 (&acc)[2][2][4][2], const Unit& u, int wr, int wc, int fr, int fq) const {
        unsigned char* ws = launder(ws0);
        bf16* H = (bf16*)(ws + WS_H); const float* rot = (const float*)(ws + WS_ROT);
        const int row0 = u.rowbase + wr * 64 + fr; const int colt = u.pn * BM + wc * 32 + 8 * fq;
        const int kind = u.pn < 4 ? 0 : (u.pn < 8 ? 1 : (u.pn < 16 ? 2 : 3));
#pragma unroll
        for (int ai = 0; ai < 2; ++ai)
#pragma unroll
            for (int m = 0; m < 4; ++m) { const int row = row0 + ai * HALF + m * 16; bf16* rowp = H + (size_t)row * RT_IN + colt; const int pos = row & (SEQ - 1);
#pragma unroll
                for (int bj = 0; bj < 2; ++bj) { f32x4 v0 = acc[ai][bj][m][0], v1 = acc[ai][bj][m][1];
                    if (kind <= 1) {
                        const int p0 = (bj * HALF + wc * 32 + 8 * fq) >> 1;
                        const float* rp = rot + ((size_t)pos * 128 + p0) * 2;
                        const f32x4 r0 = *(const f32x4*)rp, r1 = *(const f32x4*)(rp + 4);
                        const float sc = kind == 1 ? 0.0625f : 1.0f;
                        f32x4 o0, o1;
                        o0[0] = (v0[0] * r0[0] - v0[1] * r0[1]) * sc; o0[1] = (v0[1] * r0[0] + v0[0] * r0[1]) * sc;
                        o0[2] = (v0[2] * r0[2] - v0[3] * r0[3]) * sc; o0[3] = (v0[3] * r0[2] + v0[2] * r0[3]) * sc;
                        o1[0] = (v1[0] * r1[0] - v1[1] * r1[1]) * sc; o1[1] = (v1[1] * r1[0] + v1[0] * r1[1]) * sc;
                        o1[2] = (v1[2] * r1[2] - v1[3] * r1[3]) * sc; o1[3] = (v1[3] * r1[2] + v1[2] * r1[3]) * sc;
                        v0 = o0; v1 = o1;
                    } else if (kind == 3) {
#pragma unroll
                        for (int j = 0; j < 4; ++j) { v0[j] = v0[j] * fsigmoid(v0[j]); v1[j] = v1[j] * fsigmoid(v1[j]); }
                    }
                    v4u w; w.x = cvt_pk_bf16(v0[0], v0[1]); w.y = cvt_pk_bf16(v0[2], v0[3]); w.z = cvt_pk_bf16(v1[0], v1[1]); w.w = cvt_pk_bf16(v1[2], v1[3]);
                    *(v4u*)(rowp + bj * HALF) = w; } }
    }
};
struct EpiRes {
    static constexpr bool PERM = false;
    const float* X; unsigned char* ws0;
    __device__ __forceinline__ void operator()(const f32x4 (&acc)[2][2][4][2], const Unit& u, int wr, int wc, int fr, int fq) const {
        float* Y = (float*)(launder(ws0) + WS_Y);
        const int row0 = u.rowbase + wr * 64 + fr, col0 = u.pn * BM + wc * 32 + 4 * fq;
#pragma unroll
        for (int ai = 0; ai < 2; ++ai)
#pragma unroll
            for (int m = 0; m < 4; ++m) { const size_t off = (size_t)(row0 + ai * HALF + m * 16) * DM + col0;
#pragma unroll
                for (int bj = 0; bj < 2; ++bj)
#pragma unroll
                    for (int n = 0; n < 2; ++n) { const f32x4 xs = *(const f32x4*)(X + off + bj * HALF + n * 16); *(f32x4*)(Y + off + bj * HALF + n * 16) = xs * DN_ALPHA + acc[ai][bj][m][n]; }
                asm volatile("" ::: "memory"); }
    }
};
struct EpiMoeGU {
    static constexpr bool PERM = true;
    unsigned char* ws0; int L;
    __device__ __forceinline__ void operator()(const f32x4 (&acc)[2][2][4][2], const Unit& u, int wr, int wc, int fr, int fq) const {
        unsigned char* ws = launder(ws0);
        bf16* ACT = (bf16*)(ws + WS_ACT); const float* bias = (const float*)(ws + WS_BGU) + (size_t)L * NE * 2048;
        const int row0 = u.rowbase + wr * 64 + fr; const int c8 = wc * 32 + 8 * fq;
        const float* bp = bias + ((size_t)u.e * 8 + u.pn) * 256 + c8;
        const f32x4 bg0 = *(const f32x4*)bp, bg1 = *(const f32x4*)(bp + 4), bl0 = *(const f32x4*)(bp + HALF), bl1 = *(const f32x4*)(bp + HALF + 4);
#pragma unroll
        for (int ai = 0; ai < 2; ++ai)
#pragma unroll
            for (int m = 0; m < 4; ++m) { bf16* rowp = ACT + (size_t)(row0 + ai * HALF + m * 16) * DM + u.pn * HALF + c8;
                float a[8];
#pragma unroll
                for (int j = 0; j < 8; ++j) {
                    float g = acc[ai][0][m][j >> 2][j & 3] + (j < 4 ? bg0[j & 3] : bg1[j & 3]);
                    float l = acc[ai][1][m][j >> 2][j & 3] + (j < 4 ? bl0[j & 3] : bl1[j & 3]);
                    g = fminf(g, 7.0f); l = fminf(fmaxf(l, -7.0f), 7.0f);
                    a[j] = g * fsigmoid(1.702f * g) * (l + 1.0f);
                }
                v4u w; w.x = cvt_pk_bf16(a[0], a[1]); w.y = cvt_pk_bf16(a[2], a[3]); w.z = cvt_pk_bf16(a[4], a[5]); w.w = cvt_pk_bf16(a[6], a[7]);
                *(v4u*)rowp = w; }
    }
};
struct EpiMoeDown {
    static constexpr bool PERM = true;
    unsigned char* ws0; const float* bias;
    __device__ __forceinline__ void operator()(const f32x4 (&acc)[2][2][4][2], const Unit& u, int wr, int wc, int fr, int fq) const {
        unsigned char* ws = launder(ws0);
        bf16* YS = (bf16*)(ws + WS_YSLOT); const int* rowdst = (const int*)(ws + WS_ROWDST); const float* rowgate = (const float*)(ws + WS_ROWGATE);
        const int c8 = u.pn * BM + wc * 32 + 8 * fq;
        const float* bp = bias + (size_t)u.e * DM + c8;
        f32x4 bv[2][2];
#pragma unroll
        for (int bj = 0; bj < 2; ++bj) { bv[bj][0] = *(const f32x4*)(bp + bj * HALF); bv[bj][1] = *(const f32x4*)(bp + bj * HALF + 4); }
#pragma unroll
        for (int ai = 0; ai < 2; ++ai)
#pragma unroll
            for (int m = 0; m < 4; ++m) { const int r = ai * HALF + wr * 64 + m * 16 + fr;
                if (r < u.cnt) {
                    const size_t ti = (size_t)u.gidx + r; const int dst = rowdst[ti]; const float gt = rowgate[ti];
                    bf16* rowp = YS + (size_t)dst * DM + c8;
#pragma unroll
                    for (int bj = 0; bj < 2; ++bj) { const f32x4 v0 = (acc[ai][bj][m][0] + bv[bj][0]) * gt, v1 = (acc[ai][bj][m][1] + bv[bj][1]) * gt;
                        v4u w; w.x = cvt_pk_bf16(v0[0], v0[1]); w.y = cvt_pk_bf16(v0[2], v0[3]); w.z = cvt_pk_bf16(v1[0], v1[1]); w.w = cvt_pk_bf16(v1[2], v1[3]);
                        *(v4u*)(rowp + bj * HALF) = w; } } }
    }
};
}

typedef short s16x4 __attribute__((ext_vector_type(4)));
typedef __bf16 bf16x2_t __attribute__((ext_vector_type(2)));
__device__ __forceinline__ unsigned cvtpk(float lo, float hi) { f32x2 v = {lo, hi}; bf16x2_t b = __builtin_convertvector(v, bf16x2_t); return __builtin_bit_cast(unsigned, b); }
__device__ __forceinline__ s16x4 tr_read(const LAS unsigned char* p) { return __builtin_bit_cast(s16x4, __builtin_amdgcn_ds_read_tr16_b64_v4i16((LAS s16x4*)p)); }
__device__ __forceinline__ bf16x8 cat8(s16x4 lo, s16x4 hi) { return __builtin_shufflevector(lo, hi, 0, 1, 2, 3, 4, 5, 6, 7); }
__device__ __forceinline__ bf16x8 pack8(const f32x4& a, const f32x4& b) { v4u p; p.x = cvtpk(a[0], a[1]); p.y = cvtpk(a[2], a[3]); p.z = cvtpk(b[0], b[1]); p.w = cvtpk(b[2], b[3]); return __builtin_bit_cast(bf16x8, p); }
__device__ __forceinline__ s16x4 pack4(const f32x4& a) { v2u p; p.x = cvtpk(a[0], a[1]); p.y = cvtpk(a[2], a[3]); return __builtin_bit_cast(s16x4, p); }
#define MFMA32(a, b, c) __builtin_amdgcn_mfma_f32_16x16x32_bf16((a), (b), (c), 0, 0, 0)
#define MFMA16(a, b, c) __builtin_amdgcn_mfma_f32_16x16x16bf16_1k((a), (b), (c), 0, 0, 0)

__device__ __forceinline__ void ret_fast(const int tid, LAS unsigned char* lds, const bf16* HB, bf16* OB) {
    constexpr int QP = 528, VP = 272, PP = 144;
    constexpr int OFF_Q = 0, OFF_K = 64 * QP, OFF_V = 2 * 64 * QP, OFF_P = OFF_V + 64 * VP;
    const int lane = tid & 63, w = __builtin_amdgcn_readfirstlane(tid >> 6), r = lane & 15, g = lane >> 4, q4 = (lane & 15) >> 2, p4 = lane & 3;
    const int prow = tid >> 3, pc = tid & 7;
    for (int un = blockIdx.x; un < NBATCH * RT_HEADS * 4; un += gridDim.x) {
        const int b = un >> 4, h = (un >> 2) & 3, vs = un & 3;
        const float l2g = __builtin_amdgcn_logf(1.0f - __builtin_amdgcn_exp2f(-5.0f - (float)h));
        const float dC = __builtin_amdgcn_exp2f(64.0f * l2g);
        f32x4 st[16];
#pragma unroll
        for (int i = 0; i < 16; ++i) st[i] = (f32x4){0.f, 0.f, 0.f, 0.f};
        const bf16* gbase = HB + (size_t)(b * SEQ + prow) * RT_IN;
        v4u pq[4], pk[4], pv[2];
#pragma unroll
        for (int j = 0; j < 4; ++j) { pq[j] = *(const v4u*)(gbase + h * 256 + (pc + 8 * j) * 8); pk[j] = *(const v4u*)(gbase + 1024 + h * 256 + (pc + 8 * j) * 8); }
#pragma unroll
        for (int j = 0; j < 2; ++j) pv[j] = *(const v4u*)(gbase + 2048 + h * 512 + vs * 128 + (pc + 8 * j) * 8);
#pragma unroll 1
        for (int ch = 0; ch < SEQ / 64; ++ch) {
            __syncthreads();
#pragma unroll
            for (int j = 0; j < 4; ++j) { *(LAS v4u*)(lds + OFF_Q + prow * QP + (pc + 8 * j) * 16) = pq[j]; *(LAS v4u*)(lds + OFF_K + prow * QP + (pc + 8 * j) * 16) = pk[j]; }
#pragma unroll
            for (int j = 0; j < 2; ++j) *(LAS v4u*)(lds + OFF_V + prow * VP + (pc + 8 * j) * 16) = pv[j];
            if (ch + 1 < SEQ / 64) {
                const bf16* gn = gbase + (size_t)(ch + 1) * 64 * RT_IN;
#pragma unroll
                for (int j = 0; j < 4; ++j) { pq[j] = *(const v4u*)(gn + h * 256 + (pc + 8 * j) * 8); pk[j] = *(const v4u*)(gn + 1024 + h * 256 + (pc + 8 * j) * 8); }
#pragma unroll
                for (int j = 0; j < 2; ++j) pv[j] = *(const v4u*)(gn + 2048 + h * 512 + vs * 128 + (pc + 8 * j) * 8);
            }
            __syncthreads();
            {
                const int ct = w >> 1, st0 = 2 * (w & 1);
                f32x4 sa0 = {0.f, 0.f, 0.f, 0.f}, sa1 = {0.f, 0.f, 0.f, 0.f};
                const LAS unsigned char* qb = lds + OFF_Q + (16 * ct + r) * QP + g * 16;
                const LAS unsigned char* kb0 = lds + OFF_K + (16 * st0 + r) * QP + g * 16;
#pragma unroll
                for (int kb = 0; kb < 8; ++kb) {
                    const bf16x8 qf = *(const LAS bf16x8*)(qb + kb * 64), k0 = *(const LAS bf16x8*)(kb0 + kb * 64), k1 = *(const LAS bf16x8*)(kb0 + 16 * QP + kb * 64);
                    sa0 = MFMA32(k0, qf, sa0); sa1 = MFMA32(k1, qf, sa1);
                }
                const int c = 16 * ct + r;
#pragma unroll
                for (int t = 0; t < 2; ++t) {
                    const f32x4 sa = t ? sa1 : sa0; const int s0 = 16 * (st0 + t) + 4 * g; float v[4];
#pragma unroll
                    for (int i = 0; i < 4; ++i) { const int d = c - (s0 + i); v[i] = d >= 0 ? sa[i] * __builtin_amdgcn_exp2f((float)d * l2g) : 0.f; }
                    v2u pw; pw.x = cvtpk(v[0], v[1]); pw.y = cvtpk(v[2], v[3]);
                    *(LAS v2u*)(lds + OFF_P + c * PP + s0 * 2) = pw;
                }
            }
            __syncthreads();
            f32x4 o[4];
#pragma unroll
            for (int ct = 0; ct < 4; ++ct) o[ct] = (f32x4){0.f, 0.f, 0.f, 0.f};
#pragma unroll
            for (int kb = 0; kb < 8; ++kb) {
                const bf16x8 sa = pack8(st[2 * kb], st[2 * kb + 1]);
#pragma unroll
                for (int ct = 0; ct < 4; ++ct) {
                    const LAS unsigned char* qp = lds + OFF_Q + (16 * ct + r) * QP + (32 * kb + 4 * g) * 2;
                    const s16x4 lo = *(const LAS s16x4*)qp, hi = *(const LAS s16x4*)(qp + 32);
                    o[ct] = MFMA32(sa, cat8(lo, hi), o[ct]);
                }
            }
#pragma unroll
            for (int ct = 0; ct < 4; ++ct) o[ct] = o[ct] * __builtin_amdgcn_exp2f((float)(16 * ct + r + 1) * l2g);
            bf16x8 vf[2];
#pragma unroll
            for (int sb = 0; sb < 2; ++sb) {
                const LAS unsigned char* vp = lds + OFF_V + (32 * sb + 8 * g + q4) * VP + (16 * w + 4 * p4) * 2;
                vf[sb] = cat8(tr_read(vp), tr_read(vp + 4 * VP));
            }
#pragma unroll
            for (int ct = 0; ct < 4; ++ct)
#pragma unroll
                for (int sb = 0; sb < 2; ++sb) if (sb <= (ct >> 1)) {
                    const bf16x8 pf = *(const LAS bf16x8*)(lds + OFF_P + (16 * ct + r) * PP + (32 * sb + 8 * g) * 2);
                    o[ct] = MFMA32(vf[sb], pf, o[ct]);
                }
            {
                bf16* ob = OB + (size_t)(b * SEQ + ch * 64 + r) * RT_VD + h * 512 + vs * 128 + 16 * w + 4 * g;
#pragma unroll
                for (int ct = 0; ct < 4; ++ct) { v2u ow; ow.x = cvtpk(o[ct][0], o[ct][1]); ow.y = cvtpk(o[ct][2], o[ct][3]); *(v2u*)(ob + (size_t)ct * 16 * RT_VD) = ow; }
            }
            bf16x8 vz[2];
#pragma unroll
            for (int sb = 0; sb < 2; ++sb) {
                const v4u raw = __builtin_bit_cast(v4u, vf[sb]); float f[8] = {bflo(raw.x), bfhi(raw.x), bflo(raw.y), bfhi(raw.y), bflo(raw.z), bfhi(raw.z), bflo(raw.w), bfhi(raw.w)};
#pragma unroll
                for (int j = 0; j < 8; ++j) f[j] *= __builtin_amdgcn_exp2f((float)(63 - (32 * sb + 8 * g + j)) * l2g);
                v4u z; z.x = cvtpk(f[0], f[1]); z.y = cvtpk(f[2], f[3]); z.z = cvtpk(f[4], f[5]); z.w = cvtpk(f[6], f[7]); vz[sb] = __builtin_bit_cast(bf16x8, z);
            }
#pragma unroll
            for (int kt = 0; kt < 16; ++kt) {
                st[kt] = st[kt] * dC;
#pragma unroll
                for (int sb = 0; sb < 2; ++sb) {
                    const LAS unsigned char* kp = lds + OFF_K + (32 * sb + 8 * g + q4) * QP + (16 * kt + 4 * p4) * 2;
                    st[kt] = MFMA32(cat8(tr_read(kp), tr_read(kp + 4 * QP)), vz[sb], st[kt]);
                }
            }
        }
        __syncthreads();
    }
}

__device__ __forceinline__ void hgrn_fast(const int tid, LAS unsigned char* lds, const bf16* QD, const bf16* KI, const bf16* KS, const bf16* VV, const float* DEC, bf16* OB) {
    constexpr int TP = 272;
    constexpr int OFF_QD = 0, OFF_KI = 64 * TP, OFF_KS = 2 * 64 * TP, OFF_V = 3 * 64 * TP, OFF_DEC = 4 * 64 * TP;
    const int lane = tid & 63, w = __builtin_amdgcn_readfirstlane(tid >> 6), r = lane & 15, g = lane >> 4, q4 = (lane & 15) >> 2, p4 = lane & 3;
    const int prow = tid >> 3, pc = tid & 7;
    for (int un = blockIdx.x; un < NBATCH * HG_HEADS; un += gridDim.x) {
        const int b = un >> 3, h = un & 7;
        f32x4 st[8];
#pragma unroll
        for (int i = 0; i < 8; ++i) st[i] = (f32x4){0.f, 0.f, 0.f, 0.f};
        const size_t goff = (size_t)(b * SEQ + prow) * DM + h * 128;
        v4u p0[2], p1[2], p2[2], p3[2]; f32x4 pd = {0.f, 0.f, 0.f, 0.f};
#pragma unroll
        for (int j = 0; j < 2; ++j) { const size_t o = goff + (pc + 8 * j) * 8; p0[j] = *(const v4u*)(QD + o); p1[j] = *(const v4u*)(KI + o); p2[j] = *(const v4u*)(KS + o); p3[j] = *(const v4u*)(VV + o); }
        if (tid < 128) pd = *(const f32x4*)(DEC + (size_t)((b * SEQ) / 16 + (tid >> 5)) * DM + h * 128 + (tid & 31) * 4);
#pragma unroll 1
        for (int rd = 0; rd < SEQ / 64; ++rd) {
            __syncthreads();
#pragma unroll
            for (int j = 0; j < 2; ++j) { const int lo = prow * TP + (pc + 8 * j) * 16; *(LAS v4u*)(lds + OFF_QD + lo) = p0[j]; *(LAS v4u*)(lds + OFF_KI + lo) = p1[j]; *(LAS v4u*)(lds + OFF_KS + lo) = p2[j]; *(LAS v4u*)(lds + OFF_V + lo) = p3[j]; }
            if (tid < 128) *(LAS f32x4*)(lds + OFF_DEC + tid * 16) = pd;
            if (rd + 1 < SEQ / 64) {
                const size_t gn = goff + (size_t)(rd + 1) * 64 * DM;
#pragma unroll
                for (int j = 0; j < 2; ++j) { const size_t o = gn + (pc + 8 * j) * 8; p0[j] = *(const v4u*)(QD + o); p1[j] = *(const v4u*)(KI + o); p2[j] = *(const v4u*)(KS + o); p3[j] = *(const v4u*)(VV + o); }
                if (tid < 128) pd = *(const f32x4*)(DEC + (size_t)((b * SEQ + (rd + 1) * 64) / 16 + (tid >> 5)) * DM + h * 128 + (tid & 31) * 4);
            }
            __syncthreads();
#pragma unroll 1
            for (int cc = 0; cc < 4; ++cc) {
                bf16x8 qf[4], kf[4];
#pragma unroll
                for (int kb = 0; kb < 4; ++kb) {
                    const int off = (16 * cc + r) * TP + (32 * kb + 4 * g) * 2;
                    qf[kb] = cat8(*(const LAS s16x4*)(lds + OFF_QD + off), *(const LAS s16x4*)(lds + OFF_QD + off + 32));
                    kf[kb] = cat8(*(const LAS s16x4*)(lds + OFF_KI + off), *(const LAS s16x4*)(lds + OFF_KI + off + 32));
                }
                f32x4 sc = {0.f, 0.f, 0.f, 0.f}, oa = {0.f, 0.f, 0.f, 0.f};
#pragma unroll
                for (int kb = 0; kb < 4; ++kb) sc = MFMA32(kf[kb], qf[kb], sc);
#pragma unroll
                for (int i = 0; i < 4; ++i) sc[i] = (4 * g + i <= r) ? sc[i] : 0.f;
                const s16x4 pf = pack4(sc);
#pragma unroll
                for (int kb = 0; kb < 4; ++kb) oa = MFMA32(pack8(st[2 * kb], st[2 * kb + 1]), qf[kb], oa);
                const s16x4 vfr = tr_read(lds + OFF_V + (16 * cc + 4 * g + q4) * TP + (16 * w + 4 * p4) * 2);
                oa = MFMA16(vfr, pf, oa);
                { v2u ow; ow.x = cvtpk(oa[0], oa[1]); ow.y = cvtpk(oa[2], oa[3]); *(v2u*)(OB + (size_t)(b * SEQ + rd * 64 + cc * 16 + r) * DM + h * 128 + 16 * w + 4 * g) = ow; }
#pragma unroll
                for (int kt = 0; kt < 8; ++kt) {
                    const f32x4 d4 = *(const LAS f32x4*)(lds + OFF_DEC + cc * 512 + (16 * kt + 4 * g) * 4);
                    const s16x4 ks = tr_read(lds + OFF_KS + (16 * cc + 4 * g + q4) * TP + (16 * kt + 4 * p4) * 2);
                    st[kt] = MFMA16(ks, vfr, st[kt] * d4);
                }
            }
        }
        __syncthreads();
    }
}

struct Args { const float* in[17]; float* out; unsigned char* ws; int ph_lo, ph_hi; };
enum { I_X = 0, I_HWIN, I_HNG, I_HWOUT, I_LB, I_RWIN, I_RWOUT, I_LNMG, I_LNMB, I_LNFG, I_LNFB, I_RW, I_RB, I_WGU, I_BGU, I_WDN, I_BDN };

__device__ __forceinline__ int dest_row(int mode, int n) {
    if (mode == 1) { if (n < 1024) return ((n >> 7) << 8) + (n & 127); if (n < 2048) { const int q = n - 1024; return ((q >> 7) << 8) + 128 + (q & 127); } return n; }
    if (mode == 2) { const int j2 = n >> 1; return ((j2 >> 7) << 8) + ((n & 1) << 7) + (j2 & 127); }
    return n;
}
__device__ __forceinline__ void transpose_item(const float* W, int K, int N, bf16* WT, int mode, LAS float* scr, int item, int lane) {
    const int nblk = N / 64, kb = item / nblk, nb = item % nblk, k0 = 64 * kb, n0 = 64 * nb;
#pragma unroll 4
    for (int i = 0; i < 16; ++i) { const int kk = 4 * i + (lane >> 4), c4 = (lane & 15) * 4;
        const f32x4 v = *(const GAS f32x4*)(W + (size_t)(k0 + kk) * N + n0 + c4);
        LAS float* s = scr + kk * 65 + c4; s[0] = v[0]; s[1] = v[1]; s[2] = v[2]; s[3] = v[3]; }
    LDS_WAIT(); asm volatile("" ::: "memory");
    const int c = lane & 7;
#pragma unroll 2
    for (int j = 0; j < 8; ++j) { const int n = (lane >> 3) + 8 * j; const LAS float* s = scr + (8 * c) * 65 + n;
        v4u o; o.x = pk2(s[0 * 65], s[1 * 65]); o.y = pk2(s[2 * 65], s[3 * 65]); o.z = pk2(s[4 * 65], s[5 * 65]); o.w = pk2(s[6 * 65], s[7 * 65]);
        *(GAS v4u*)(WT + (size_t)dest_row(mode, n0 + n) * K + k0 + 8 * c) = o; }
    LDS_WAIT(); asm volatile("" ::: "memory");
}

#ifndef SITE_MASK
#define SITE_MASK 0xffff
#endif
#define SITE(n) (((SITE_MASK) >> (n)) & 1)
typedef const __attribute__((address_space(4))) Args* KArgs;
__device__ __forceinline__ int otid() { int t = threadIdx.x; asm volatile("" : "+v"(t)); return t; }
__device__ __forceinline__ LAS unsigned char* olds(LAS unsigned char* p) { asm volatile("" : "+s"(p)); return p; }
__device__ __forceinline__ KArgs kargs() { KArgs p = (KArgs)__builtin_amdgcn_kernarg_segment_ptr(); asm volatile("" : "+s"(p)); return p; }
#define IN(k) (ap->ph_lo <= (k) && (k) < ap->ph_hi)
#define GRID_BAR() do { if (ap->ph_hi - ap->ph_lo > 1) { XcdBarrier _b; _b.bar = (unsigned*)(ap->ws + WS_CTL) + CW_BAR; _b.x = xb_xcc_id(); _b.st = (volatile LAS unsigned*)(lds + MISC_OFF + MO_BARW); xcd_barrier(_b); } } while (0)
#define VCU() ((gridDim.x % 8 == 0) ? (int)((blockIdx.x % 8) * (gridDim.x / 8) + blockIdx.x / 8) : (int)blockIdx.x)

__global__ void __launch_bounds__(512, 2) mk_fwd(Args args_unused) {
    extern __shared__ __attribute__((aligned(16))) unsigned char lds_raw[];
    LAS unsigned char* const lds0 = (LAS unsigned char*)lds_raw;
    {
        LAS unsigned char* lds = lds0;
        for (int u = threadIdx.x; u < (LDS_BYTES - MISC_OFF) / 4; u += 512) ((LAS unsigned*)(lds + MISC_OFF))[u] = 0u;
        __syncthreads();
        KArgs ap = kargs();
        if (ap->ph_hi - ap->ph_lo > 1) (void)xcd_barrier_post((unsigned*)(ap->ws + WS_CTL) + CW_BAR, (volatile LAS unsigned*)(lds + MISC_OFF + MO_BARW));
    }

#if SITE(0)
    { KArgs ap = kargs(); const int tid = otid(); LAS unsigned char* lds = olds(lds0); (void)tid;
    if (IN(0)) {
        const int lane = tid & 63, wave = __builtin_amdgcn_readfirstlane(tid >> 6), G = gridDim.x, vcu = VCU(), gw = vcu * 8 + wave, NGW = G * 8;
        unsigned char* ws = ap->ws;
        LAS float* scr = (LAS float*)(lds + wave * 16640);
        constexpr int I_HIN = 2 * 16 * 64, I_HOUT = 2 * 16 * 16, I_RIN = 2 * 16 * 96, I_ROUT = 2 * 32 * 16, I_GU = 128 * 16 * 32, I_DN = 128 * 16 * 16;
        constexpr int NITEMS = I_HIN + I_HOUT + I_RIN + I_ROUT + I_GU + I_DN;
        for (int it = gw; it < NITEMS; it += NGW) {
            int r = it;
            if (r < I_HIN) { const int j = r / (16 * 64); transpose_item(ap->in[I_HWIN] + (size_t)j * DM * HG_IN, DM, HG_IN, (bf16*)(ws + WS_W_HIN) + (size_t)j * HG_IN * DM, 1, scr, r % (16 * 64), lane); continue; } r -= I_HIN;
            if (r < I_HOUT) { const int j = r / 256; transpose_item(ap->in[I_HWOUT] + (size_t)j * DM * DM, DM, DM, (bf16*)(ws + WS_W_HOUT) + (size_t)j * DM * DM, 0, scr, r % 256, lane); continue; } r -= I_HOUT;
            if (r < I_RIN) { const int j = r / (16 * 96); transpose_item(ap->in[I_RWIN] + (size_t)j * DM * RT_IN, DM, RT_IN, (bf16*)(ws + WS_W_RIN) + (size_t)j * RT_IN * DM, 0, scr, r % (16 * 96), lane); continue; } r -= I_RIN;
            if (r < I_ROUT) { const int j = r / 512; transpose_item(ap->in[I_RWOUT] + (size_t)j * RT_VD * DM, RT_VD, DM, (bf16*)(ws + WS_W_ROUT) + (size_t)j * DM * RT_VD, 0, scr, r % 512, lane); continue; } r -= I_ROUT;
            if (r < I_GU) { const int j = r / 512; transpose_item(ap->in[I_WGU] + (size_t)j * DM * 2048, DM, 2048, (bf16*)(ws + WS_W_GU) + (size_t)j * 2048 * DM, 2, scr, r % 512, lane); continue; } r -= I_GU;
            { const int j = r / 256; transpose_item(ap->in[I_WDN] + (size_t)j * DM * DM, DM, DM, (bf16*)(ws + WS_W_DN) + (size_t)j * DM * DM, 0, scr, r % 256, lane); }
        }
        const int gt = vcu * 512 + tid, NGT = G * 512;
        float* LBS = (float*)(ws + WS_LBS); float* BGU = (float*)(ws + WS_BGU); float* ROT = (float*)(ws + WS_ROT); bf16* XB = (bf16*)(ws + WS_XB);
        for (int d = gt; d < DM; d += NGT) { const float* lbp = ap->in[I_LB]; const float v0 = lbp[d], v1 = lbp[DM + d], v2 = lbp[2 * DM + d], v3 = lbp[3 * DM + d]; const float mx = fmaxf(fmaxf(v0, v1), fmaxf(v2, v3));
            const float e0 = __expf(v0 - mx), e1 = __expf(v1 - mx), e2 = __expf(v2 - mx), e3 = __expf(v3 - mx), is = 1.0f / (e0 + e1 + e2 + e3);
            LBS[d] = 0.f; LBS[DM + d] = e1 * is; LBS[2 * DM + d] = (e1 + e2) * is; LBS[3 * DM + d] = (e1 + e2 + e3) * is; }
        for (int i = gt; i < SEQ * 128; i += NGT) { const int pos = i >> 7, p = i & 127; const float inv = 1.0f / __builtin_amdgcn_exp2f(13.287712379549449f * ((float)p / 127.0f)); const float th = (float)pos * inv;
            double rev = (double)th * 0.15915494309189535; rev -= floor(rev); const float fr = (float)rev; ROT[2 * i] = __builtin_amdgcn_cosf(fr); ROT[2 * i + 1] = __builtin_amdgcn_sinf(fr); }
        for (int i = gt; i < 4 * 32 * 2048; i += NGT) { const int le = i >> 11, n = i & 2047; BGU[(size_t)le * 2048 + dest_row(2, n)] = ap->in[I_BGU][i]; }
        for (size_t i = (size_t)gt; i < (size_t)NTOK * DM / 4; i += NGT) { const f32x4 v = ((const f32x4*)ap->in[I_X])[i]; v2u o; o.x = pk2(v[0], v[1]); o.y = pk2(v[2], v[3]); ((v2u*)XB)[i] = o; }
        GRID_BAR();
    } }
#endif

#pragma unroll 1
    for (int L = 0; L < DEPTH; ++L) {
        const int pb = 1 + 8 * L;
        if ((L & 1) == 0) {
#if SITE(1)
            { KArgs ap = kargs(); const int tid = otid(); LAS unsigned char* lds = olds(lds0); (void)tid;
            if (IN(pb + 0)) {
                unsigned char* ws = ap->ws; const int j = L >> 1;
                LAS int* ul = (LAS int*)(lds + MISC_OFF + MO_ULIST);
                pg8::build_units_dense(tid, ul, NTOK / 256, HG_IN / 256, DM);
                pg8::EpiHgrnIn E{ws, L};
                pg8::gemm_phase<pg8::EpiHgrnIn, false, true>(tid, lds, ul, (LAS int*)(lds + MISC_OFF + MO_GTAB), (const char*)(ws + WS_XB), (const char*)((bf16*)(ws + WS_W_HIN) + (size_t)j * HG_IN * DM), nullptr, DM, E);
                GRID_BAR();
            } }
#endif
#if SITE(2)
            { KArgs ap = kargs(); const int tid = otid(); LAS unsigned char* lds = olds(lds0); (void)tid;
            if (IN(pb + 1)) {
#if !SLOW_HGRN
                { unsigned char* ws = ap->ws; const bf16* QD = (const bf16*)(ws + WS_H);
                  hgrn_fast(tid, lds, QD, QD + (size_t)NTOK * DM, QD + 2 * (size_t)NTOK * DM, QD + 3 * (size_t)NTOK * DM, (const float*)(ws + WS_DEC), (bf16*)(ws + WS_O)); }
#else
                unsigned char* ws = ap->ws; const bf16* QD = (const bf16*)(ws + WS_H); const bf16* KI = QD + (size_t)NTOK * DM; const bf16* KS = QD + 2 * (size_t)NTOK * DM; const bf16* VV = QD + 3 * (size_t)NTOK * DM; bf16* OB = (bf16*)(ws + WS_O);
                LAS float* qf = (LAS float*)lds; LAS float* kf = qf + 16 * 4 * 36; LAS float* ff = kf + 16 * 4 * 36; LAS float* vf = ff + 16 * 4 * 36;
                for (int un = blockIdx.x; un < NBATCH * HG_HEADS; un += gridDim.x) {
                    const int b = un >> 3, h = un & 7; const int vc = tid >> 2, kq = tid & 3;
                    float st[32];
#pragma unroll
                    for (int i = 0; i < 32; ++i) st[i] = 0.f;
                    for (int t0 = 0; t0 < SEQ; t0 += 16) {
                        __syncthreads();
                        for (int e = tid; e < 16 * 128; e += 512) { const int tt = e >> 7, k = e & 127; const size_t gi = (size_t)(b * SEQ + t0 + tt) * DM + h * 128 + k; const int li = tt * 144 + (k & 3) * 36 + (k >> 2);
                            qf[li] = bf1(QD[gi]); kf[li] = bf1(KI[gi]); ff[li] = bf1(KS[gi]); vf[tt * 128 + k] = bf1(VV[gi]); }
                        __syncthreads();
                        for (int tt = 0; tt < 16; ++tt) {
                            const float v = vf[tt * 128 + vc]; float a = 0.f; const int lb = tt * 144 + kq * 36;
#pragma unroll
                            for (int i = 0; i < 32; ++i) { st[i] = ff[lb + i] * st[i] + kf[lb + i] * v; a += qf[lb + i] * st[i]; }
                            a += __shfl_xor(a, 1); a += __shfl_xor(a, 2);
                            if (kq == 0) OB[(size_t)(b * SEQ + t0 + tt) * DM + h * 128 + vc] = (bf16)f2bf(a);
                        }
                    }
                }
#endif
                GRID_BAR();
            } }
#endif
#if SITE(3)
            { KArgs ap = kargs(); const int tid = otid(); LAS unsigned char* lds = olds(lds0); (void)tid;
            if (IN(pb + 2)) {
                const int lane = tid & 63, wave = __builtin_amdgcn_readfirstlane(tid >> 6), gw = VCU() * 8 + wave, NGW = gridDim.x * 8;
                unsigned char* ws = ap->ws; const bf16* OB = (const bf16*)(ws + WS_O); const bf16* GG = (const bf16*)(ws + WS_H) + 4 * (size_t)NTOK * DM; bf16* A2 = (bf16*)(ws + WS_A2);
                const float* ng = ap->in[I_HNG] + (L >> 1) * DM;
                for (int row = gw; row < NTOK; row += NGW) {
                    float o[16]; float ss = 0.f;
#pragma unroll
                    for (int q = 0; q < 4; ++q) { const v2u w = *(const v2u*)(OB + (size_t)row * DM + 256 * q + 4 * lane); o[4 * q] = bflo(w.x); o[4 * q + 1] = bfhi(w.x); o[4 * q + 2] = bflo(w.y); o[4 * q + 3] = bfhi(w.y); }
#pragma unroll
                    for (int i = 0; i < 16; ++i) ss += o[i] * o[i];
                    const float rs = 1.0f / sqrtf(wave_sum(ss) * (1.0f / DM) + RMS_EPS);
#pragma unroll
                    for (int q = 0; q < 4; ++q) { const v2u gw2 = *(const v2u*)(GG + (size_t)row * DM + 256 * q + 4 * lane); const f32x4 g4 = *(const f32x4*)(ng + 256 * q + 4 * lane);
                        v2u w; w.x = pk2(o[4 * q] * rs * g4[0] * bflo(gw2.x), o[4 * q + 1] * rs * g4[1] * bfhi(gw2.x)); w.y = pk2(o[4 * q + 2] * rs * g4[2] * bflo(gw2.y), o[4 * q + 3] * rs * g4[3] * bfhi(gw2.y));
                        *(v2u*)(A2 + (size_t)row * DM + 256 * q + 4 * lane) = w; }
                }
                GRID_BAR();
            } }
#endif
        } else {
#if SITE(4)
            { KArgs ap = kargs(); const int tid = otid(); LAS unsigned char* lds = olds(lds0); (void)tid;
            if (IN(pb + 0)) {
                unsigned char* ws = ap->ws; const int j = L >> 1;
                LAS int* ul = (LAS int*)(lds + MISC_OFF + MO_ULIST);
                pg8::build_units_dense(tid, ul, NTOK / 256, RT_IN / 256, DM);
                pg8::EpiRetIn E{ws};
                pg8::gemm_phase<pg8::EpiRetIn, false, true>(tid, lds, ul, (LAS int*)(lds + MISC_OFF + MO_GTAB), (const char*)(ws + WS_XB), (const char*)((bf16*)(ws + WS_W_RIN) + (size_t)j * RT_IN * DM), nullptr, DM, E);
                GRID_BAR();
            } }
#endif
#if SITE(5)
            { KArgs ap = kargs(); const int tid = otid(); LAS unsigned char* lds = olds(lds0); (void)tid;
            if (IN(pb + 1)) {
#if !SLOW_RET
                { unsigned char* ws = ap->ws; ret_fast(tid, lds, (const bf16*)(ws + WS_H), (bf16*)(ws + WS_O)); }
#else
                unsigned char* ws = ap->ws; const bf16* HB = (const bf16*)(ws + WS_H); bf16* OB = (bf16*)(ws + WS_O);
                LAS float* qf = (LAS float*)lds; LAS float* kf = qf + 16 * 4 * 68; LAS float* vf = kf + 16 * 4 * 68;
                for (int un = blockIdx.x; un < NBATCH * RT_HEADS * 4; un += gridDim.x) {
                    const int b = un >> 4, h = (un >> 2) & 3, vq = un & 3; const int vc = tid >> 2, kq = tid & 3;
                    const float gam = 1.0f - exp2f(-5.0f - (float)h);
                    float st[64];
#pragma unroll
                    for (int i = 0; i < 64; ++i) st[i] = 0.f;
                    for (int t0 = 0; t0 < SEQ; t0 += 16) {
                        __syncthreads();
                        for (int e = tid; e < 16 * 256; e += 512) { const int tt = e >> 8, k = e & 255; const size_t gi = (size_t)(b * SEQ + t0 + tt) * RT_IN + h * 256 + k; const int li = tt * 272 + (k & 3) * 68 + (k >> 2);
                            qf[li] = bf1(HB[gi]); kf[li] = bf1(HB[gi + 1024]); }
                        for (int e = tid; e < 16 * 128; e += 512) { const int tt = e >> 7, c = e & 127; vf[e] = bf1(HB[(size_t)(b * SEQ + t0 + tt) * RT_IN + 2048 + h * 512 + vq * 128 + c]); }
                        __syncthreads();
                        for (int tt = 0; tt < 16; ++tt) {
                            const float v = vf[tt * 128 + vc]; float a = 0.f; const int lb = tt * 272 + kq * 68;
#pragma unroll
                            for (int i = 0; i < 64; ++i) { st[i] = gam * st[i] + kf[lb + i] * v; a += qf[lb + i] * st[i]; }
                            a += __shfl_xor(a, 1); a += __shfl_xor(a, 2);
                            if (kq == 0) OB[(size_t)(b * SEQ + t0 + tt) * RT_VD + h * 512 + vq * 128 + vc] = (bf16)f2bf(a);
                        }
                    }
                }
#endif
                GRID_BAR();
            } }
#endif
#if SITE(6)
            { KArgs ap = kargs(); const int tid = otid(); LAS unsigned char* lds = olds(lds0); (void)tid;
            if (IN(pb + 2)) {
                const int lane = tid & 63, wave = __builtin_amdgcn_readfirstlane(tid >> 6), gw = VCU() * 8 + wave, NGW = gridDim.x * 8;
                unsigned char* ws = ap->ws; const bf16* OB = (const bf16*)(ws + WS_O); const bf16* HB = (const bf16*)(ws + WS_H); bf16* A2 = (bf16*)(ws + WS_A2);
                for (int row = gw; row < NTOK; row += NGW) {
#pragma unroll
                    for (int h = 0; h < 4; ++h) {
                        const v4u w = *(const v4u*)(OB + (size_t)row * RT_VD + 512 * h + 8 * lane);
                        float o[8] = {bflo(w.x), bfhi(w.x), bflo(w.y), bfhi(w.y), bflo(w.z), bfhi(w.z), bflo(w.w), bfhi(w.w)};
                        float s = 0.f;
#pragma unroll
                        for (int i = 0; i < 8; ++i) s += o[i];
                        const float mu = wave_sum(s) * (1.0f / 512.0f); float q = 0.f;
#pragma unroll
                        for (int i = 0; i < 8; ++i) { o[i] -= mu; q += o[i] * o[i]; }
                        const float rs = 1.0f / sqrtf(wave_sum(q) * (1.0f / 512.0f) + LN_EPS);
                        const v4u g = *(const v4u*)(HB + (size_t)row * RT_IN + 4096 + 512 * h + 8 * lane);
                        v4u r; r.x = pk2(o[0] * rs * bflo(g.x), o[1] * rs * bfhi(g.x)); r.y = pk2(o[2] * rs * bflo(g.y), o[3] * rs * bfhi(g.y));
                        r.z = pk2(o[4] * rs * bflo(g.z), o[5] * rs * bfhi(g.z)); r.w = pk2(o[6] * rs * bflo(g.w), o[7] * rs * bfhi(g.w));
                        *(v4u*)(A2 + (size_t)row * RT_VD + 512 * h + 8 * lane) = r;
                    }
                }
                GRID_BAR();
            } }
#endif
        }
#if SITE(7)
        { KArgs ap = kargs(); const int tid = otid(); LAS unsigned char* lds = olds(lds0); (void)tid;
        if (IN(pb + 3)) {
            unsigned char* ws = ap->ws; const int j = L >> 1; const bool ret = (L & 1) != 0;
            const int Ko = ret ? RT_VD : DM;
            LAS int* ul = (LAS int*)(lds + MISC_OFF + MO_ULIST);
            pg8::build_units_dense(tid, ul, NTOK / 256, DM / 256, Ko);
            const char* Bt = ret ? (const char*)((bf16*)(ws + WS_W_ROUT) + (size_t)j * DM * RT_VD) : (const char*)((bf16*)(ws + WS_W_HOUT) + (size_t)j * DM * DM);
            pg8::EpiRes E{(L == 0) ? ap->in[I_X] : (const float*)ap->out, ws};
            pg8::gemm_phase<pg8::EpiRes, false, true>(tid, lds, ul, (LAS int*)(lds + MISC_OFF + MO_GTAB), (const char*)(ws + WS_A2), Bt, nullptr, Ko, E);
            GRID_BAR();
        } }
#endif
#if SITE(8)
        { KArgs ap = kargs(); const int tid = otid(); LAS unsigned char* lds = olds(lds0); (void)tid;
        if (IN(pb + 4)) {
            const int lane = tid & 63, wave = __builtin_amdgcn_readfirstlane(tid >> 6);
            unsigned char* ws = ap->ws; unsigned* ctl = (unsigned*)(ws + WS_CTL);
            const float* Y = (const float*)(ws + WS_Y); float* X1F = (float*)(ws + WS_X1F); bf16* X1B = (bf16*)(ws + WS_X1B);
            int* ROWDST = (int*)(ws + WS_ROWDST); float* ROWGATE = (float*)(ws + WS_ROWGATE);
            LAS float* wT = (LAS float*)lds;
            LAS int* lcnt = (LAS int*)(lds + MISC_OFF + MO_LCNT); LAS int* lbase = (LAS int*)(lds + MISC_OFF + MO_LBASE);
            LAS int* sel = (LAS int*)(lds + MISC_OFF + MO_SEL); LAS float* selw = (LAS float*)(lds + MISC_OFF + MO_SELW);
            const float* rw = ap->in[I_RW] + (size_t)L * DM * NE; const float* rb = ap->in[I_RB] + L * NE;
            const float* lg = ap->in[I_LNMG] + L * DM; const float* lbb = ap->in[I_LNMB] + L * DM;
            for (int e4 = tid; e4 < DM * NE / 4; e4 += 512) { const f32x4 v = ((const f32x4*)rw)[e4]; const int d = e4 >> 3, e0 = (e4 & 7) * 4; wT[(e0 + 0) * DM + d] = v[0]; wT[(e0 + 1) * DM + d] = v[1]; wT[(e0 + 2) * DM + d] = v[2]; wT[(e0 + 3) * DM + d] = v[3]; }
            const float rbias = rb[lane >> 1];
            for (int blk = VCU(); blk < NTOK / 128; blk += gridDim.x) {
                if (tid < 32) lcnt[tid] = 0;
                __syncthreads();
#pragma unroll 1
                for (int rr = 0; rr < 16; ++rr) {
                    const int rloc = wave * 16 + rr, row = blk * 128 + rloc;
                    f32x4 x[4]; float s = 0.f;
#pragma unroll
                    for (int q = 0; q < 4; ++q) { x[q] = *(const f32x4*)(Y + (size_t)row * DM + 256 * q + 4 * lane); s += (x[q][0] + x[q][1]) + (x[q][2] + x[q][3]); }
                    const float mu = wave_sum(s) * (1.0f / DM); float qq = 0.f;
#pragma unroll
                    for (int q = 0; q < 4; ++q) { x[q] = x[q] - mu; qq += (x[q][0] * x[q][0] + x[q][1] * x[q][1]) + (x[q][2] * x[q][2] + x[q][3] * x[q][3]); }
                    const float rs = 1.0f / sqrtf(wave_sum(qq) * (1.0f / DM) + LN_EPS);
#pragma unroll
                    for (int q = 0; q < 4; ++q) { const f32x4 g4 = *(const f32x4*)(lg + 256 * q + 4 * lane), b4 = *(const f32x4*)(lbb + 256 * q + 4 * lane); x[q] = x[q] * rs * g4 + b4;
                        *(f32x4*)(X1F + (size_t)row * DM + 256 * q + 4 * lane) = x[q];
                        v2u w; w.x = pk2(x[q][0], x[q][1]); w.y = pk2(x[q][2], x[q][3]); *(v2u*)(X1B + (size_t)row * DM + 256 * q + 4 * lane) = w; }
                    float a[32];
#pragma unroll
                    for (int e = 0; e < 32; ++e) { float t = 0.f;
#pragma unroll
                        for (int q = 0; q < 4; ++q) { const f32x4 w = *(const LAS f32x4*)(wT + e * DM + 256 * q + 4 * lane); t += (x[q][0] * w[0] + x[q][1] * w[1]) + (x[q][2] * w[2] + x[q][3] * w[3]); }
                        a[e] = t; }
#pragma unroll
                    for (int st = 0; st < 5; ++st) { const int n = 16 >> st, msk = 32 >> st; const bool up = (lane & msk) != 0;
#pragma unroll
                        for (int i = 0; i < n; ++i) { const float keep = up ? a[i + n] : a[i], send = up ? a[i] : a[i + n]; a[i] = keep + __shfl_xor(send, msk); } }
                    float lgt = a[0] + __shfl_xor(a[0], 1) + rbias;
                    float v = lgt; int se[4]; float sv[4];
#pragma unroll
                    for (int k = 0; k < 4; ++k) { const float m = wave_max(v); const unsigned long long bal = __ballot(v == m); const int l0 = __builtin_ctzll(bal); se[k] = l0 >> 1; sv[k] = m; if ((lane >> 1) == se[k]) v = -3.0e38f; }
                    const float e1 = __expf(sv[1] - sv[0]), e2 = __expf(sv[2] - sv[0]), e3 = __expf(sv[3] - sv[0]); const float inv = 1.0f / (1.0f + e1 + e2 + e3);
                    if (lane < 4) { const int ee = lane == 0 ? se[0] : (lane == 1 ? se[1] : (lane == 2 ? se[2] : se[3])); const float ww = (lane == 0 ? 1.0f : (lane == 1 ? e1 : (lane == 2 ? e2 : e3))) * inv;
                        sel[rloc * 4 + lane] = ee; selw[rloc * 4 + lane] = ww; }
                }
                __syncthreads();
                const int myE = sel[tid]; const int rank = __hip_atomic_fetch_add(lcnt + myE, 1, __ATOMIC_RELAXED, __HIP_MEMORY_SCOPE_WORKGROUP);
                __syncthreads();
                if (tid < 32) lbase[tid] = (int)__hip_atomic_fetch_add(ctl + CW_ECNT + L * 32 + tid, (unsigned)lcnt[tid], RLX_AGENT);
                __syncthreads();
                { const int pos = lbase[myE] + rank; const size_t ti = (size_t)myE * ECAP + pos; ROWDST[ti] = (blk * 128 + (tid >> 2)) * 4 + (tid & 3); ROWGATE[ti] = selw[tid]; }
                __syncthreads();
            }
            GRID_BAR();
        } }
#endif
#if SITE(9)
        { KArgs ap = kargs(); const int tid = otid(); LAS unsigned char* lds = olds(lds0); (void)tid;
        if (IN(pb + 5)) {
            unsigned char* ws = ap->ws; unsigned* ctl = (unsigned*)(ws + WS_CTL);
            LAS int* tpre = (LAS int*)(lds + MISC_OFF + MO_TPRE); LAS int* ebase = (LAS int*)(lds + MISC_OFF + MO_EBASE); LAS int* ecnt = (LAS int*)(lds + MISC_OFF + MO_ECNT);
            if (tid == 0) { int t = 0;
_Pragma("unroll 1")
 for (int e = 0; e < NE; ++e) { const int c = (int)__hip_atomic_load(ctl + CW_ECNT + L * 32 + e, RLX_AGENT); ecnt[e] = c; tpre[e] = t; ebase[e] = t * 256; t += (c + 255) >> 8; } tpre[NE] = t; }
            __syncthreads();
            LAS int* ul = (LAS int*)(lds + MISC_OFF + MO_ULIST);
            pg8::build_units_moe(tid, ul, tpre, ebase, ecnt, 8, DM, 2048u * DM * 2u);
            pg8::EpiMoeGU E{ws, L};
            pg8::gemm_phase<pg8::EpiMoeGU, true, true>(tid, lds, ul, (LAS int*)(lds + MISC_OFF + MO_GTAB), (const char*)(ws + WS_X1B), (const char*)((bf16*)(ws + WS_W_GU) + (size_t)L * NE * 2048 * DM), (const int*)(ws + WS_ROWDST), DM, E);
            GRID_BAR();
        } }
#endif
#if SITE(10)
        { KArgs ap = kargs(); const int tid = otid(); LAS unsigned char* lds = olds(lds0); (void)tid;
        if (IN(pb + 6)) {
            unsigned char* ws = ap->ws; unsigned* ctl = (unsigned*)(ws + WS_CTL);
            LAS int* tpre = (LAS int*)(lds + MISC_OFF + MO_TPRE); LAS int* ebase = (LAS int*)(lds + MISC_OFF + MO_EBASE); LAS int* ecnt = (LAS int*)(lds + MISC_OFF + MO_ECNT);
            __syncthreads();
            if (tid == 0) { int t = 0;
_Pragma("unroll 1")
 for (int e = 0; e < NE; ++e) { const int c = (int)__hip_atomic_load(ctl + CW_ECNT + L * 32 + e, RLX_AGENT); ecnt[e] = c; tpre[e] = t; ebase[e] = t * 256; t += (c + 255) >> 8; } tpre[NE] = t; }
            __syncthreads();
            LAS int* ul = (LAS int*)(lds + MISC_OFF + MO_ULIST);
            pg8::build_units_moe(tid, ul, tpre, ebase, ecnt, 4, DM, (unsigned)DM * DM * 2u);
            pg8::EpiMoeDown E{ws, ap->in[I_BDN] + (size_t)L * NE * DM};
            pg8::gemm_phase<pg8::EpiMoeDown, false, true>(tid, lds, ul, (LAS int*)(lds + MISC_OFF + MO_GTAB), (const char*)(ws + WS_ACT), (const char*)((bf16*)(ws + WS_W_DN) + (size_t)L * NE * DM * DM), nullptr, DM, E);
            GRID_BAR();
        } }
#endif
#if SITE(11)
        { KArgs ap = kargs(); const int tid = otid(); LAS unsigned char* lds = olds(lds0); (void)tid;
        if (IN(pb + 7)) {
            const int lane = tid & 63, wave = __builtin_amdgcn_readfirstlane(tid >> 6), gw = VCU() * 8 + wave, NGW = gridDim.x * 8;
            unsigned char* ws = ap->ws; const float* X1F = (const float*)(ws + WS_X1F); const bf16* YS = (const bf16*)(ws + WS_YSLOT); bf16* XB = (bf16*)(ws + WS_XB); float* out = ap->out;
            const float* lg = ap->in[I_LNFG] + L * DM; const float* lbb = ap->in[I_LNFB] + L * DM;
            for (int row = gw; row < NTOK; row += NGW) {
                f32x4 x[4]; float s = 0.f;
#pragma unroll
                for (int q = 0; q < 4; ++q) { x[q] = *(const f32x4*)(X1F + (size_t)row * DM + 256 * q + 4 * lane) * DN_ALPHA;
#pragma unroll
                    for (int k = 0; k < 4; ++k) { const v2u w = *(const v2u*)(YS + ((size_t)row * 4 + k) * DM + 256 * q + 4 * lane); x[q][0] += bflo(w.x); x[q][1] += bfhi(w.x); x[q][2] += bflo(w.y); x[q][3] += bfhi(w.y); }
                    s += (x[q][0] + x[q][1]) + (x[q][2] + x[q][3]); }
                const float mu = wave_sum(s) * (1.0f / DM); float qq = 0.f;
#pragma unroll
                for (int q = 0; q < 4; ++q) { x[q] = x[q] - mu; qq += (x[q][0] * x[q][0] + x[q][1] * x[q][1]) + (x[q][2] * x[q][2] + x[q][3] * x[q][3]); }
                const float rs = 1.0f / sqrtf(wave_sum(qq) * (1.0f / DM) + LN_EPS);
#pragma unroll
                for (int q = 0; q < 4; ++q) { const f32x4 g = *(const f32x4*)(lg + 256 * q + 4 * lane), bb = *(const f32x4*)(lbb + 256 * q + 4 * lane); x[q] = x[q] * rs * g + bb;
                    *(f32x4*)(out + (size_t)row * DM + 256 * q + 4 * lane) = x[q];
                    v2u w; w.x = pk2(x[q][0], x[q][1]); w.y = pk2(x[q][2], x[q][3]); *(v2u*)(XB + (size_t)row * DM + 256 * q + 4 * lane) = w; }
            }
            if (L + 1 < DEPTH) GRID_BAR();
        } }
#endif
    }
#undef IN
#undef GRID_BAR
}

extern "C" void kernel_launch(void* const* d_in, const int* in_sizes, int n_in, void* d_out, int out_size, void* d_ws, size_t ws_size, hipStream_t stream) {
    static int grid = 0;
    if (grid == 0) {
        if (n_in != 17 || out_size != NTOK * DM || ws_size < WS_END) { fprintf(stderr, "kernel_launch: unexpected shapes (n_in %d, out %d, ws %zu < %zu)\n", n_in, out_size, ws_size, (size_t)WS_END); grid = -1; return; }
        int dev = 0, cus = 0, per_cu = 0;
        if (hipGetDevice(&dev) != hipSuccess || hipDeviceGetAttribute(&cus, hipDeviceAttributeMultiprocessorCount, dev) != hipSuccess) { grid = -1; return; }
        if (hipFuncSetAttribute((const void*)mk_fwd, hipFuncAttributeMaxDynamicSharedMemorySize, LDS_BYTES) != hipSuccess) { fprintf(stderr, "kernel_launch: hipFuncSetAttribute failed\n"); grid = -1; return; }
        if (hipOccupancyMaxActiveBlocksPerMultiprocessor(&per_cu, (const void*)mk_fwd, 512, LDS_BYTES) != hipSuccess || per_cu < 1) { fprintf(stderr, "kernel_launch: occupancy query says %d\n", per_cu); }
        (void)hipGetLastError();
        grid = cus;
    }
    if (grid < 0) return;
    (void)hipMemsetAsync((char*)d_ws + WS_CTL, 0, CTL_ZERO_BYTES, stream);
    Args a{};
    for (int i = 0; i < 17; ++i) a.in[i] = (const float*)d_in[i];
    a.out = (float*)d_out; a.ws = (unsigned char*)d_ws;
#if MK_MULTI
    for (int p = 0; p < 1 + 8 * DEPTH; ++p) { a.ph_lo = p; a.ph_hi = p + 1; hipLaunchKernelGGL(mk_fwd, dim3(grid), dim3(512), LDS_BYTES, stream, a); }
#else
    a.ph_lo = 0; a.ph_hi = 1 + 8 * DEPTH;
    hipLaunchKernelGGL(mk_fwd, dim3(grid), dim3(512), LDS_BYTES, stream, a);
#endif
}
```

```cpp
#include <hip/hip_runtime.h>
#include <cstdio>
#include <cstdint>

#ifndef MK_MULTI
#define MK_MULTI 0
#endif
#ifndef MOE_FP8
#define MOE_FP8 1
#endif
#ifndef SLOW_HGRN
#define SLOW_HGRN 0
#endif
#ifndef SLOW_RET
#define SLOW_RET 0
#endif

#define GAS __attribute__((address_space(1)))
#define LAS __attribute__((address_space(3)))
typedef unsigned short bf16;
typedef unsigned v4u __attribute__((ext_vector_type(4)));
typedef unsigned v2u __attribute__((ext_vector_type(2)));
typedef float f32x4 __attribute__((ext_vector_type(4)));
typedef float f32x2 __attribute__((ext_vector_type(2)));
typedef short bf16x8 __attribute__((ext_vector_type(8)));
typedef GAS unsigned gu32;

constexpr int DM = 1024, NBATCH = 16, SEQ = 2048, NTOK = NBATCH * SEQ, DEPTH = 4;
constexpr int NE = 32, TOPK = 4;
constexpr int HG_HEADS = 8, HG_K = 128;
constexpr int RT_HEADS = 4, RT_K = 256, RT_V = 512, RT_VD = 2048, RT_IN = 6144, HG_IN = 4096;
constexpr int ECAP = NTOK;
constexpr int MOE_ROWS = NTOK * TOPK + NE * 256;
constexpr float DN_ALPHA = 1.681792830507429f;
constexpr float LN_EPS = 1e-5f, RMS_EPS = 1e-6f;

constexpr size_t MiB = 1ull << 20;
constexpr size_t WS_CTL = 0, CTL_ZERO_BYTES = 1 * MiB;
constexpr size_t WS_LBS = 1 * MiB;
constexpr size_t WS_BGU = 2 * MiB;
constexpr size_t WS_ROT = 4 * MiB;
constexpr size_t WS_ROWDST = 8 * MiB;
constexpr size_t WS_ROWGATE = 12 * MiB;
constexpr size_t WS_W_HIN = 16 * MiB;
constexpr size_t WS_W_HOUT = WS_W_HIN + 16 * MiB;
constexpr size_t WS_W_RIN = WS_W_HOUT + 4 * MiB;
constexpr size_t WS_W_ROUT = WS_W_RIN + 24 * MiB;
constexpr size_t WS_W_GU = WS_W_ROUT + 8 * MiB;
constexpr size_t WS_W_DN = WS_W_GU + 512 * MiB;
constexpr size_t WS_XB = WS_W_DN + 256 * MiB;
constexpr size_t WS_H = WS_XB + 64 * MiB;
constexpr size_t WS_DEC = WS_H + 320 * MiB;
constexpr size_t WS_O = WS_H + 384 * MiB;
constexpr size_t WS_A2 = WS_O + 128 * MiB;
constexpr size_t WS_Y = WS_A2 + 128 * MiB;
constexpr size_t WS_X1F = WS_Y + 128 * MiB;
constexpr size_t WS_X1B = WS_X1F + 128 * MiB;
constexpr size_t WS_ACT = WS_X1B + 64 * MiB;
constexpr size_t WS_YSLOT = WS_ACT + 272 * MiB;
constexpr size_t WS_END = WS_YSLOT + 256 * MiB;

constexpr int CW_BAR = 4096;
constexpr int CW_ECNT = 16384;

constexpr int RING_BYTES = 131072;
constexpr int MISC_OFF = 135168;
constexpr int LDS_BYTES = 147456;
constexpr int MO_BARW = 0;
constexpr int MO_GTAB = 64;
constexpr int MO_TPRE = 64 + 2048;
constexpr int MO_EBASE = MO_TPRE + 160;
constexpr int MO_ECNT = MO_EBASE + 128;
constexpr int MO_LCNT = MO_ECNT + 128;
constexpr int MO_LBASE = MO_LCNT + 128;
constexpr int MO_SEL = MO_LBASE + 128;
constexpr int MO_SELW = MO_SEL + 2048;
constexpr int MO_RANK = MO_SELW + 2048;
constexpr int MO_ULIST = MO_RANK + 2048;
static_assert(MISC_OFF + MO_ULIST + 1024 <= LDS_BYTES, "LDS map");

#define RLX_AGENT __ATOMIC_RELAXED, __HIP_MEMORY_SCOPE_AGENT
#define LDS_WAIT() asm volatile("s_waitcnt lgkmcnt(0)" ::: "memory")
#define VM_WAIT() asm volatile("s_waitcnt vmcnt(0)" ::: "memory")

__device__ __forceinline__ unsigned f2bf(float f) { unsigned u = __builtin_bit_cast(unsigned, f); return (u + 0x7fffu + ((u >> 16) & 1u)) >> 16; }
__device__ __forceinline__ unsigned pk2(float lo, float hi) { return f2bf(lo) | (f2bf(hi) << 16); }
__device__ __forceinline__ unsigned cvt_pk_bf16(float lo, float hi) { unsigned r; asm volatile("v_cvt_pk_bf16_f32 %0, %1, %2" : "=v"(r) : "v"(lo), "v"(hi)); return r; }
#if MOE_FP8
constexpr float X_SCALE = 4.0f, WGU_SCALE = 64.0f, ACT_SCALE = 4.0f, WDN_SCALE = 128.0f;
constexpr float GU_DESCALE = 1.0f / (X_SCALE * WGU_SCALE), DN_DESCALE = 1.0f / (ACT_SCALE * WDN_SCALE);
#else
constexpr float GU_DESCALE = 1.0f, DN_DESCALE = 1.0f, ACT_SCALE = 1.0f;
#endif
__device__ __forceinline__ unsigned pk4_fp8(float a, float b, float c, float d) {
    a = __builtin_amdgcn_fmed3f(a, -448.0f, 448.0f); b = __builtin_amdgcn_fmed3f(b, -448.0f, 448.0f); c = __builtin_amdgcn_fmed3f(c, -448.0f, 448.0f); d = __builtin_amdgcn_fmed3f(d, -448.0f, 448.0f);
    int p = __builtin_amdgcn_cvt_pk_fp8_f32(a, b, 0, false); p = __builtin_amdgcn_cvt_pk_fp8_f32(c, d, p, true); return (unsigned)p; }
__device__ __forceinline__ float bflo(unsigned u) { return __builtin_bit_cast(float, u << 16); }
__device__ __forceinline__ float bfhi(unsigned u) { return __builtin_bit_cast(float, u & 0xffff0000u); }
__device__ __forceinline__ float bf1(bf16 b) { return __builtin_bit_cast(float, ((unsigned)b) << 16); }
__device__ __forceinline__ float fexp(float x) { return __builtin_amdgcn_exp2f(x * 1.4426950408889634f); }
__device__ __forceinline__ float frcp(float x) { return __builtin_amdgcn_rcpf(x); }
__device__ __forceinline__ float fsigmoid(float x) { return frcp(1.0f + fexp(-x)); }
__device__ __forceinline__ float wave_sum(float v) {
#pragma unroll
    for (int o = 1; o < 64; o <<= 1) v += __shfl_xor(v, o);
    return v;
}
__device__ __forceinline__ float wave_max(float v) {
#pragma unroll
    for (int o = 1; o < 64; o <<= 1) v = fmaxf(v, __shfl_xor(v, o));
    return v;
}

#define XB_TMO      128
#define XB_XCNT(j)  (256  + 64 * (j))
#define XB_XSUB(j)  (1280 + 64 * (j))
#define XB_XGEN(j)  (2304 + 64 * (j))
#define XB_TOP      3328
#define XB_TOPGEN   3392
#define XCD_BAR_WORDS 3456
#define XB_SPIN_CAP (1u << 22)

__device__ __forceinline__ unsigned xb_ld(unsigned* p)              { return __hip_atomic_load(p, __ATOMIC_RELAXED, __HIP_MEMORY_SCOPE_AGENT); }
__device__ __forceinline__ unsigned xb_add(unsigned* p, unsigned v) { return __hip_atomic_fetch_add(p, v, __ATOMIC_RELAXED, __HIP_MEMORY_SCOPE_AGENT); }
__device__ __forceinline__ unsigned xb_xcc_id() { return (unsigned)__builtin_amdgcn_s_getreg((3 << 11) | 20) & 0xFu; }
#define XB_SPIN(cond, bar) do { unsigned _sp = 0; while (cond) { __builtin_amdgcn_s_sleep(1); \
    if ((++_sp & 255u) == 0u) { if (xb_ld(&(bar)[XB_TMO])) break; if (_sp > XB_SPIN_CAP) { atomicAdd(&(bar)[XB_TMO], 1u); break; } } } } while (0)

struct XcdBarrier { unsigned* bar; unsigned x; volatile LAS unsigned* st; };

__device__ __forceinline__ XcdBarrier xcd_barrier_post(unsigned* bar, volatile LAS unsigned* st) {
    XcdBarrier b; b.bar = bar; b.x = xb_xcc_id(); b.st = st;
    if (threadIdx.x == 0) (void)xb_add(&bar[XB_XCNT(b.x)], 1u);
    return b;
}
__device__ __forceinline__ void xcd_barrier_complete(unsigned* bar, unsigned x, unsigned& nloc, unsigned& nx) {
    const unsigned G = gridDim.x * gridDim.y * gridDim.z;
    unsigned sum, cnt, mine, sp = 0u;
    for (;;) {
        sum = 0u; cnt = 0u; mine = 0u;
#pragma unroll
        for (unsigned j = 0; j < 16; ++j) { const unsigned c = xb_ld(&bar[XB_XCNT(j)]); sum += c; cnt += (c > 0u) ? 1u : 0u; mine = (j == x) ? c : mine; }
        if (sum == G) break;
        __builtin_amdgcn_s_sleep(1);
        if ((++sp & 255u) == 0u) { if (xb_ld(&bar[XB_TMO])) break; if (sp > XB_SPIN_CAP) { atomicAdd(&bar[XB_TMO], 1u); break; } }
    }
    nloc = mine > 0u ? mine : 1u; nx = cnt > 0u ? cnt : 1u;
}
__device__ __forceinline__ void xcd_barrier(const XcdBarrier& b) {
    asm volatile("s_waitcnt vmcnt(0)" ::: "memory");
    __syncthreads();
    if (threadIdx.x == 0) {
        unsigned* bar = b.bar;
        __builtin_amdgcn_s_waitcnt(0);
        unsigned nloc = b.st[0], nx = b.st[1];
        if (nloc == 0u) { xcd_barrier_complete(bar, b.x, nloc, nx); b.st[0] = nloc; b.st[1] = nx; }
        const unsigned old = xb_add(&bar[XB_XSUB(b.x)], 1u);
        const unsigned gen = old / nloc;
        if (old + 1u == (gen + 1u) * nloc) {
            __builtin_amdgcn_fence(__ATOMIC_RELEASE, "agent");
            asm volatile("s_waitcnt vmcnt(0)" ::: "memory");
            const unsigned og = xb_add(&bar[XB_TOP], 1u);
            const unsigned tg = og / nx;
            if (og + 1u == (tg + 1u) * nx) xb_add(&bar[XB_TOPGEN], 1u);
            else XB_SPIN(xb_ld(&bar[XB_TOPGEN]) == tg, bar);
            __builtin_amdgcn_fence(__ATOMIC_ACQUIRE, "agent");
            xb_add(&bar[XB_XGEN(b.x)], 1u);
            asm volatile("s_waitcnt vmcnt(0)" ::: "memory");
        } else {
            XB_SPIN(xb_ld(&bar[XB_XGEN(b.x)]) == gen, bar);
            __builtin_amdgcn_fence(__ATOMIC_ACQUIRE, "agent");
            asm volatile("s_waitcnt vmcnt(0)" ::: "memory");
        }
    }
    __syncthreads();
}

namespace pg8 {
constexpr int BM = 256, BK = 64, HALF = 128, HTB = HALF * BK * 2, STAGE_BYTES = 8 * HTB, NXCD = 8, WGM = 8, MAXU = 32;
__host__ __device__ __forceinline__ int lds_byte(int r, int c) { const int st = (r >> 4) * 2 + (c >> 5), rr = r & 15, cc = c & 31, ob = rr * 64 + cc * 2; return st * 1024 + (ob ^ (((ob >> 9) & 1) << 5)); }
__host__ __device__ __forceinline__ void stage_rc(int b, int& R, int& C) { const int st = b / 1024, sb = b % 1024, swz = sb ^ (((sb >> 9) & 1) << 5); R = (st >> 1) * 16 + swz / 64; C = (st & 1) * 32 + (swz % 64) / 2; }
__host__ __device__ __forceinline__ int perm32(int rho) { const int n = rho >> 4, i = rho & 15; return 8 * (i >> 2) + 4 * n + (i & 3); }

struct Unit { int pm, pn, e, rowbase, cnt; unsigned boff; int gidx; };

__device__ __forceinline__ bool tile_of(long L, int nM, int nN, int& gm, int& pn) {
    const int nwg = nM * nN; if (L >= nwg) return false;
    int wgid = (int)L; { const int q = nwg / NXCD, r = nwg % NXCD, xcd = wgid % NXCD, off = wgid / NXCD; wgid = (xcd < r ? xcd * (q + 1) : r * (q + 1) + (xcd - r) * q) + off; }
    const int nig = WGM * nN, gid = wgid / nig, fm = gid * WGM, gsz = (nM - fm) < WGM ? (nM - fm) : WGM;
    gm = fm + ((wgid % nig) % gsz); pn = (wgid % nig) / gsz; return true;
}
__device__ __forceinline__ void build_units_dense(const int i, LAS int* ul, int nM, int nN, int RB) {
    if (i < MAXU) { int gm = 0, pn = 0; const bool ok = tile_of((long)i * gridDim.x + blockIdx.x, nM, nN, gm, pn);
        ul[i * 8 + 0] = ok ? 1 : 0; ul[i * 8 + 1] = gm; ul[i * 8 + 2] = pn; ul[i * 8 + 3] = 0; ul[i * 8 + 4] = gm * BM; ul[i * 8 + 5] = BM; ul[i * 8 + 6] = (int)((unsigned)pn * BM * (unsigned)RB); ul[i * 8 + 7] = 0; }
    __syncthreads();
}
__device__ __forceinline__ void build_units_moe(const int i, LAS int* ul, const LAS int* tpre, const LAS int* ebase, const LAS int* ecnt, int nN, int RB, unsigned wstride) {
    if (i < MAXU) { int gm = 0, pn = 0; const bool ok = tile_of((long)i * gridDim.x + blockIdx.x, tpre[NE], nN, gm, pn);
        int e = 0;
_Pragma("unroll 1")
        for (int s = 16; s >= 1; s >>= 1) { if (e + s < NE && tpre[e + s] <= gm) e += s; }
        const int pm = gm - tpre[e];
        ul[i * 8 + 0] = ok ? 1 : 0; ul[i * 8 + 1] = pm; ul[i * 8 + 2] = pn; ul[i * 8 + 3] = e; ul[i * 8 + 4] = ebase[e] + pm * BM; ul[i * 8 + 5] = ecnt[e] - pm * BM;
        ul[i * 8 + 6] = (int)((unsigned)e * wstride + (unsigned)pn * BM * (unsigned)RB); ul[i * 8 + 7] = e * ECAP + pm * BM; }
    __syncthreads();
}
__device__ __forceinline__ bool ld_unit(const LAS int* ul, int i, Unit& u) {
    if (i >= MAXU) return false;
    const LAS int* p = ul + i * 8;
    if (__builtin_amdgcn_readfirstlane(p[0]) == 0) return false;
    u.pm = __builtin_amdgcn_readfirstlane(p[1]); u.pn = __builtin_amdgcn_readfirstlane(p[2]); u.e = __builtin_amdgcn_readfirstlane(p[3]); u.rowbase = __builtin_amdgcn_readfirstlane(p[4]);
    u.cnt = __builtin_amdgcn_readfirstlane(p[5]); u.boff = (unsigned)__builtin_amdgcn_readfirstlane(p[6]); u.gidx = __builtin_amdgcn_readfirstlane(p[7]); return true;
}
__device__ __forceinline__ void glds16(const char* sbase, unsigned voff, LAS unsigned char* dst) {
    asm volatile("" : "+s"(sbase));
    __builtin_amdgcn_global_load_lds((const unsigned*)(sbase + voff), (LAS unsigned*)dst, 16, 0, 0);
}
template <bool GATHER> __device__ __forceinline__ void stage_a(LAS unsigned char* dst, const char* sbase, unsigned o0, unsigned o1, size_t r64) {
    glds16(sbase, o0, dst);
    if constexpr (GATHER) glds16(sbase, o1, dst + 8192);
    else glds16(sbase + r64, o0, dst + 8192);
}

typedef int v8i __attribute__((ext_vector_type(8)));
typedef int v4i __attribute__((ext_vector_type(4)));
__device__ __forceinline__ v8i cat_frag(const bf16x8& a, const bf16x8& b) { return __builtin_shufflevector(__builtin_bit_cast(v4i, a), __builtin_bit_cast(v4i, b), 0, 1, 2, 3, 4, 5, 6, 7); }
template <class Epi, bool GATHER, bool ALIGN_EPI, bool FP8>
__device__ __forceinline__ void gemm_phase(const int tid, LAS unsigned char* lds, const LAS int* ul, LAS int* gtab, const char* Abase, const char* Bbase, const int* rowdst, const int RB, const Epi& E) {
    const int wid = __builtin_amdgcn_readfirstlane(tid >> 6), lane = tid & 63, wr = wid >> 2, wc = wid & 3, fr = lane & 15, fq = lane >> 4;
    const int nt = RB / 128;
    int R0, C0; stage_rc(tid * 16, R0, C0);
    const int Rb0 = Epi::PERM ? ((R0 & ~31) + perm32(R0 & 31)) : R0;
    const unsigned voffB = (unsigned)(Rb0 * RB + C0 * 2);
    const unsigned cb0 = (unsigned)C0 * 2u, K2 = (unsigned)RB;
    const size_t kstep = (size_t)128;
    const size_t r64 = (size_t)64 * RB;
    const size_t hstep = (size_t)HALF * RB;
    const unsigned ldsw = (unsigned)wid * 1024u;
    const int aoff = lds_byte(wr * 64 + fr, fq * 8), boff = lds_byte(wc * 32 + fr, fq * 8);
#define PG8_SA(b, h) (((b) * 2 + (h)) * HTB)
#define PG8_SB(b, h) ((4 + (b) * 2 + (h)) * HTB)
#define PG8_STAGE(bufoff, gbase) do { glds16((const char*)(gbase), voffB, lds + (bufoff) + ldsw); glds16((const char*)(gbase) + r64, voffB, lds + (bufoff) + ldsw + 8192); } while (0)
#define PG8_STAGEA0(bufoff, kb, o0, o1) stage_a<GATHER>(lds + (bufoff) + ldsw, Abase + (kb), o0, o1, r64)
#define PG8_STAGEA1(bufoff, kb, o0, o2, o3) stage_a<GATHER>(lds + (bufoff) + ldsw, Abase + (kb) + (GATHER ? (size_t)0 : hstep), GATHER ? (o2) : (o0), o3, r64)
#define PG8_LDA(dst, b, h) do { _Pragma("unroll") for (int m = 0; m < 4; ++m) { const v4i _l = *(const LAS v4i*)(lds + PG8_SA(b, h) + aoff + m * 2048), _h = *(const LAS v4i*)(lds + PG8_SA(b, h) + aoff + m * 2048 + 1024); dst[m] = __builtin_shufflevector(_l, _h, 0, 1, 2, 3, 4, 5, 6, 7); } } while (0)
#define PG8_LDB(dst, b, h) do { _Pragma("unroll") for (int n = 0; n < 2; ++n) { const v4i _l = *(const LAS v4i*)(lds + PG8_SB(b, h) + boff + n * 2048), _h = *(const LAS v4i*)(lds + PG8_SB(b, h) + boff + n * 2048 + 1024); dst[n] = __builtin_shufflevector(_l, _h, 0, 1, 2, 3, 4, 5, 6, 7); } } while (0)
#define PG8_LO(x) __builtin_bit_cast(bf16x8, __builtin_shufflevector(x, x, 0, 1, 2, 3))
#define PG8_HI(x) __builtin_bit_cast(bf16x8, __builtin_shufflevector(x, x, 4, 5, 6, 7))
#define PG8_MMA(ai, bj, At, Bt) do { __builtin_amdgcn_s_setprio(1); _Pragma("unroll") for (int m = 0; m < 4; ++m) _Pragma("unroll") for (int n = 0; n < 2; ++n) { \
        if constexpr (FP8) asm volatile("v_mfma_scale_f32_16x16x128_f8f6f4 %0, %1, %2, %0, %3, %3 op_sel_hi:[0,0,0]" : "+v"(acc[ai][bj][m][n]) : "v"(Bt[n]), "v"(At[m]), "v"(sc1)); \
        else { acc[ai][bj][m][n] = __builtin_amdgcn_mfma_f32_16x16x32_bf16(PG8_LO(Bt[n]), PG8_LO(At[m]), acc[ai][bj][m][n], 0, 0, 0); \
               acc[ai][bj][m][n] = __builtin_amdgcn_mfma_f32_16x16x32_bf16(PG8_HI(Bt[n]), PG8_HI(At[m]), acc[ai][bj][m][n], 0, 0, 0); } } \
        __builtin_amdgcn_s_setprio(0); } while (0)
#define PG8_WAIT_V(n) asm volatile("s_waitcnt vmcnt(" #n ")" ::: "memory")
#define PG8_WAIT_L(n) asm volatile("s_waitcnt lgkmcnt(" #n ")" ::: "memory")
#define PG8_BAR __builtin_amdgcn_s_barrier()
#define PG8_SCHED __builtin_amdgcn_sched_barrier(0)
    Unit cur, nxt; int ui = 0;
    if (!ld_unit(ul, 0, cur)) return;
    f32x4 acc[2][2][4][2];
#pragma unroll
    for (int a = 0; a < 2; ++a)
#pragma unroll
        for (int b = 0; b < 2; ++b)
#pragma unroll
            for (int m = 0; m < 4; ++m)
#pragma unroll
                for (int n = 0; n < 2; ++n) acc[a][b][m][n] = (f32x4){0.f, 0.f, 0.f, 0.f};
    v8i At[4], B0[2], B1[2];
    const int sc1 = 0x7f7f7f7f;
    unsigned oA0, oA1 = 0, oA2 = 0, oA3 = 0, oN0, oN1 = 0, oN2 = 0, oN3 = 0;
    if constexpr (GATHER) {
        const int c1 = cur.cnt - 1; const int* gp = rowdst + cur.gidx;
        oA0 = ((unsigned)gp[min(R0, c1)] >> 2) * K2 + cb0; oA1 = ((unsigned)gp[min(R0 + 64, c1)] >> 2) * K2 + cb0; oA2 = ((unsigned)gp[min(R0 + 128, c1)] >> 2) * K2 + cb0; oA3 = ((unsigned)gp[min(R0 + 192, c1)] >> 2) * K2 + cb0;
    } else {
        oA0 = (unsigned)(cur.rowbase + R0) * K2 + cb0;
    }
    oN0 = oA0; oN1 = oA1; oN2 = oA2; oN3 = oA3;
    const char* cB = Bbase + cur.boff;
    PG8_STAGE(PG8_SB(0, 0), cB); PG8_STAGE(PG8_SB(0, 1), cB + hstep); PG8_STAGEA0(PG8_SA(0, 0), (size_t)0, oA0, oA1); PG8_STAGEA1(PG8_SA(0, 1), (size_t)0, oA0, oA2, oA3);
    if (wr == 1) PG8_BAR;
    PG8_WAIT_V(2); PG8_BAR;
    PG8_STAGE(PG8_SB(1, 0), cB + kstep); PG8_STAGEA0(PG8_SA(1, 0), kstep, oA0, oA1); PG8_STAGE(PG8_SB(1, 1), cB + hstep + kstep);
    PG8_WAIT_V(6); PG8_BAR;
    for (;;) {
        const bool has_next = ld_unit(ul, ui + 1, nxt);
        const char* nB = has_next ? Bbase + nxt.boff : cB;
        if constexpr (GATHER) {
            if (has_next && tid < 256) gtab[tid] = (int)((unsigned)rowdst[nxt.gidx + min(tid, nxt.cnt - 1)] >> 2);
        }
_Pragma("unroll 1")
        for (int t = 0; t < nt; t += 2) {
            const bool last = (t == nt - 2);
            if (last && has_next) {
                if constexpr (GATHER) {
                    oN0 = (unsigned)gtab[R0] * K2 + cb0; oN1 = (unsigned)gtab[R0 + 64] * K2 + cb0; oN2 = (unsigned)gtab[R0 + 128] * K2 + cb0; oN3 = (unsigned)gtab[R0 + 192] * K2 + cb0;
                } else {
                    oN0 = (unsigned)(nxt.rowbase + R0) * K2 + cb0;
                }
            }
            const size_t kb1 = (size_t)(t + 1) * kstep;
            const size_t kb2 = last ? (size_t)0 : (size_t)(t + 2) * kstep, kb3 = kb2 + kstep;
            const unsigned p0 = last ? oN0 : oA0, p1 = last ? oN1 : oA1, p2 = last ? oN2 : oA2, p3 = last ? oN3 : oA3;
            const char* b2 = last ? nB : cB + (size_t)(t + 2) * kstep; const char* b3 = b2 + kstep;
            PG8_LDB(B0, 0, 0); PG8_LDB(B1, 0, 1); PG8_SCHED; PG8_LDA(At, 0, 0); PG8_STAGEA1(PG8_SA(1, 1), kb1, oA0, oA2, oA3);
            PG8_WAIT_V(8); PG8_WAIT_L(0); PG8_BAR; PG8_MMA(0, 0, At, B0); PG8_MMA(0, 1, At, B1); PG8_BAR; PG8_SCHED;
            PG8_LDA(At, 0, 1); PG8_STAGE(PG8_SB(0, 0), b2); PG8_STAGE(PG8_SB(0, 1), b2 + hstep); PG8_STAGEA0(PG8_SA(0, 0), kb2, p0, p1);
            PG8_WAIT_V(8); PG8_WAIT_L(0); PG8_BAR; PG8_MMA(1, 0, At, B0); PG8_MMA(1, 1, At, B1); PG8_BAR; PG8_SCHED;
            PG8_LDB(B0, 1, 0); PG8_LDB(B1, 1, 1); PG8_SCHED; PG8_LDA(At, 1, 0); PG8_STAGEA1(PG8_SA(0, 1), kb2, p0, p2, p3);
            PG8_WAIT_V(8); PG8_WAIT_L(0); PG8_BAR; PG8_MMA(0, 0, At, B0); PG8_MMA(0, 1, At, B1); PG8_BAR; PG8_SCHED;
            PG8_LDA(At, 1, 1); PG8_STAGE(PG8_SB(1, 0), b3); PG8_STAGE(PG8_SB(1, 1), b3 + hstep); PG8_STAGEA0(PG8_SA(1, 0), kb3, p0, p1);
            PG8_WAIT_V(8); PG8_WAIT_L(0); PG8_BAR; PG8_MMA(1, 0, At, B0); PG8_MMA(1, 1, At, B1); PG8_BAR; PG8_SCHED;
        }
        if constexpr (FP8) asm volatile("s_nop 7\n\ts_nop 7\n\ts_nop 7" ::: "memory");
        if constexpr (ALIGN_EPI) { if (wr == 0) PG8_BAR; }
        E(acc, cur, wr, wc, fr, fq);
        if (!has_next) break;
#pragma unroll
        for (int a = 0; a < 2; ++a)
#pragma unroll
            for (int b = 0; b < 2; ++b)
#pragma unroll
                for (int m = 0; m < 4; ++m)
#pragma unroll
                    for (int n = 0; n < 2; ++n) acc[a][b][m][n] = (f32x4){0.f, 0.f, 0.f, 0.f};
        cur = nxt; cB = nB; oA0 = oN0; oA1 = oN1; oA2 = oN2; oA3 = oN3; ++ui;
        if constexpr (ALIGN_EPI) { if (wr == 1) PG8_BAR; }
    }
    PG8_WAIT_V(0);
    if constexpr (!ALIGN_EPI) { if (wr == 0) PG8_BAR; }
    PG8_BAR;
#undef PG8_SA
#undef PG8_SB
#undef PG8_STAGE
#undef PG8_STAGEA0
#undef PG8_STAGEA1
#undef PG8_LDA
#undef PG8_LDB
#undef PG8_LO
#undef PG8_HI
#undef PG8_MMA
#undef PG8_WAIT_V
#undef PG8_WAIT_L
#undef PG8_BAR
#undef PG8_SCHED
}

__device__ __forceinline__ GAS unsigned char* launder(unsigned char* p) { asm volatile("" : "+s"(p)); return (GAS unsigned char*)p; }
#define OPAQUE_LANE(fr, fq) asm volatile("" : "+v"(fr), "+v"(fq))
struct EpiHgrnIn {
    static constexpr bool PERM = true;
    unsigned char* ws0; int L;
    __device__ __forceinline__ void operator()(const f32x4 (&acc)[2][2][4][2], const Unit& u, int wr, int wc, int fr, int fq) const {
        OPAQUE_LANE(fr, fq);
        GAS unsigned char* ws = launder(ws0);
        GAS bf16* QD = (GAS bf16*)(ws + WS_H);
        const int row0 = u.rowbase + wr * 64 + fr;
        if (u.pn >= 8) {
            const bool isg = u.pn >= 12; GAS bf16* base = QD + (size_t)(isg ? 4 : 3) * NTOK * DM; const int colt = (u.pn - (isg ? 12 : 8)) * BM + wc * 32 + 8 * fq;
#pragma unroll
            for (int ai = 0; ai < 2; ++ai)
#pragma unroll
                for (int m = 0; m < 4; ++m) { GAS bf16* rowp = base + (size_t)(row0 + ai * HALF + m * 16) * DM + colt;
#pragma unroll
                    for (int bj = 0; bj < 2; ++bj) { f32x4 v0 = acc[ai][bj][m][0], v1 = acc[ai][bj][m][1];
                        if (isg) {
#pragma unroll
                            for (int j = 0; j < 4; ++j) { v0[j] = v0[j] * fsigmoid(v0[j]); v1[j] = v1[j] * fsigmoid(v1[j]); } }
                        v4u w; w.x = cvt_pk_bf16(v0[0], v0[1]); w.y = cvt_pk_bf16(v0[2], v0[3]); w.z = cvt_pk_bf16(v1[0], v1[1]); w.w = cvt_pk_bf16(v1[2], v1[3]);
                        *(GAS v4u*)(rowp + bj * HALF) = w; } }
            return;
        }
        const int col = u.pn * HG_K + wc * 32 + 8 * fq;
        const GAS float* lb = (const GAS float*)(ws + WS_LBS) + L * DM;
        const f32x4 lb0 = *(const GAS f32x4*)(lb + col), lb1 = *(const GAS f32x4*)(lb + col + 4);
#if !SLOW_HGRN
        const int lane = fq * 16 + fr;
        GAS float* DEC = (GAS float*)(ws + WS_DEC);
#endif
#pragma unroll
        for (int ai = 0; ai < 2; ++ai)
#pragma unroll
            for (int m = 0; m < 4; ++m) {
                const int row = row0 + ai * HALF + m * 16;
                float qd[8], ki[8], ks[8];
#if !SLOW_HGRN
                float de[8];
#endif
#pragma unroll
                for (int j = 0; j < 8; ++j) {
                    const float q = acc[ai][0][m][j >> 2][j & 3], f = acc[ai][1][m][j >> 2][j & 3], lbv = j < 4 ? lb0[j & 3] : lb1[j & 3];
                    const float sg = fsigmoid(f), fg = lbv + (1.0f - lbv) * sg, kk = (1.0f - lbv) * (1.0f - sg);
#if SLOW_HGRN
                    qd[j] = q * fsigmoid(q); ki[j] = kk; ks[j] = fg;
#else
                    float b = __builtin_amdgcn_logf(fg) * 0.6931471805599453f;
                    b += __builtin_bit_cast(float, __builtin_amdgcn_update_dpp(0, __builtin_bit_cast(int, b), 0x111, 0xf, 0xf, true));
                    b += __builtin_bit_cast(float, __builtin_amdgcn_update_dpp(0, __builtin_bit_cast(int, b), 0x112, 0xf, 0xf, true));
                    b += __builtin_bit_cast(float, __builtin_amdgcn_update_dpp(0, __builtin_bit_cast(int, b), 0x114, 0xf, 0xf, true));
                    b += __builtin_bit_cast(float, __builtin_amdgcn_update_dpp(0, __builtin_bit_cast(int, b), 0x118, 0xf, 0xf, true));
                    const float bl = __shfl(b, lane | 15);
                    qd[j] = q * fsigmoid(q) * fexp(b); ki[j] = kk * fexp(-b); ks[j] = kk * fexp(bl - b); de[j] = fexp(bl);
#endif
                }
                const size_t o = (size_t)row * DM + col;
                v4u w;
                w.x = cvt_pk_bf16(qd[0], qd[1]); w.y = cvt_pk_bf16(qd[2], qd[3]); w.z = cvt_pk_bf16(qd[4], qd[5]); w.w = cvt_pk_bf16(qd[6], qd[7]); *(GAS v4u*)(QD + o) = w;
                w.x = cvt_pk_bf16(ki[0], ki[1]); w.y = cvt_pk_bf16(ki[2], ki[3]); w.z = cvt_pk_bf16(ki[4], ki[5]); w.w = cvt_pk_bf16(ki[6], ki[7]); *(GAS v4u*)(QD + (size_t)NTOK * DM + o) = w;
                w.x = cvt_pk_bf16(ks[0], ks[1]); w.y = cvt_pk_bf16(ks[2], ks[3]); w.z = cvt_pk_bf16(ks[4], ks[5]); w.w = cvt_pk_bf16(ks[6], ks[7]); *(GAS v4u*)(QD + 2 * (size_t)NTOK * DM + o) = w;
#if !SLOW_HGRN
                if (fr == 0) { GAS float* dp = DEC + (size_t)(row >> 4) * DM + col; *(GAS f32x4*)dp = (f32x4){de[0], de[1], de[2], de[3]}; *(GAS f32x4*)(dp + 4) = (f32x4){de[4], de[5], de[6], de[7]}; }
#endif
            }
    }
};
struct EpiRetIn {
    static constexpr bool PERM = true;
    unsigned char* ws0;
    __device__ __forceinline__ void operator()(const f32x4 (&acc)[2][2][4][2], const Unit& u, int wr, int wc, int fr, int fq) const {
        OPAQUE_LANE(fr, fq);
        GAS unsigned char* ws = launder(ws0);
        GAS bf16* H = (GAS bf16*)(ws + WS_H); const GAS float* rot = (const GAS float*)(ws + WS_ROT);
        const int row0 = u.rowbase + wr * 64 + fr; const int colt = u.pn * BM + wc * 32 + 8 * fq;
        const int kind = u.pn < 4 ? 0 : (u.pn < 8 ? 1 : (u.pn < 16 ? 2 : 3));
#pragma unroll
        for (int ai = 0; ai < 2; ++ai)
#pragma unroll
            for (int m = 0; m < 4; ++m) { const int row = row0 + ai * HALF + m * 16; GAS bf16* rowp = H + (size_t)row * RT_IN + colt; const int pos = row & (SEQ - 1);
#pragma unroll
                for (int bj = 0; bj < 2; ++bj) { f32x4 v0 = acc[ai][bj][m][0], v1 = acc[ai][bj][m][1];
                    if (kind <= 1) {
                        const int p0 = (bj * HALF + wc * 32 + 8 * fq) >> 1;
                        const GAS float* rp = rot + ((size_t)pos * 128 + p0) * 2;
                        const f32x4 r0 = *(const GAS f32x4*)rp, r1 = *(const GAS f32x4*)(rp + 4);
                        const float sc = kind == 1 ? 0.0625f : 1.0f;
                        f32x4 o0, o1;
                        o0[0] = (v0[0] * r0[0] - v0[1] * r0[1]) * sc; o0[1] = (v0[1] * r0[0] + v0[0] * r0[1]) * sc;
                        o0[2] = (v0[2] * r0[2] - v0[3] * r0[3]) * sc; o0[3] = (v0[3] * r0[2] + v0[2] * r0[3]) * sc;
                        o1[0] = (v1[0] * r1[0] - v1[1] * r1[1]) * sc; o1[1] = (v1[1] * r1[0] + v1[0] * r1[1]) * sc;
                        o1[2] = (v1[2] * r1[2] - v1[3] * r1[3]) * sc; o1[3] = (v1[3] * r1[2] + v1[2] * r1[3]) * sc;
                        v0 = o0; v1 = o1;
                    } else if (kind == 3) {
#pragma unroll
                        for (int j = 0; j < 4; ++j) { v0[j] = v0[j] * fsigmoid(v0[j]); v1[j] = v1[j] * fsigmoid(v1[j]); }
                    }
                    v4u w; w.x = cvt_pk_bf16(v0[0], v0[1]); w.y = cvt_pk_bf16(v0[2], v0[3]); w.z = cvt_pk_bf16(v1[0], v1[1]); w.w = cvt_pk_bf16(v1[2], v1[3]);
                    *(GAS v4u*)(rowp + bj * HALF) = w; } }
    }
};
struct EpiRes {
    static constexpr bool PERM = false;
    const float* X; unsigned char* ws0;
    __device__ __forceinline__ void operator()(const f32x4 (&acc)[2][2][4][2], const Unit& u, int wr, int wc, int fr, int fq) const {
        OPAQUE_LANE(fr, fq);
        GAS float* Y = (GAS float*)(launder(ws0) + WS_Y); const GAS float* Xg = (const GAS float*)X;
        const int row0 = u.rowbase + wr * 64 + fr, col0 = u.pn * BM + wc * 32 + 4 * fq;
#pragma unroll
        for (int ai = 0; ai < 2; ++ai)
#pragma unroll
            for (int m = 0; m < 4; ++m) { const size_t off = (size_t)(row0 + ai * HALF + m * 16) * DM + col0;
#pragma unroll
                for (int bj = 0; bj < 2; ++bj)
#pragma unroll
                    for (int n = 0; n < 2; ++n) { const f32x4 xs = *(const GAS f32x4*)(Xg + off + bj * HALF + n * 16); *(GAS f32x4*)(Y + off + bj * HALF + n * 16) = xs * DN_ALPHA + acc[ai][bj][m][n]; }
                asm volatile("" ::: "memory"); }
    }
};
struct EpiMoeGU {
    static constexpr bool PERM = true;
    unsigned char* ws0; int L;
    __device__ __forceinline__ void operator()(const f32x4 (&acc)[2][2][4][2], const Unit& u, int wr, int wc, int fr, int fq) const {
        OPAQUE_LANE(fr, fq);
        GAS unsigned char* ws = launder(ws0);
        const GAS float* bias = (const GAS float*)(ws + WS_BGU) + (size_t)L * NE * 2048;
        const int row0 = u.rowbase + wr * 64 + fr; const int c8 = wc * 32 + 8 * fq;
        const GAS float* bp = bias + ((size_t)u.e * 8 + u.pn) * 256 + c8;
        const f32x4 bg0 = *(const GAS f32x4*)bp, bg1 = *(const GAS f32x4*)(bp + 4), bl0 = *(const GAS f32x4*)(bp + HALF), bl1 = *(const GAS f32x4*)(bp + HALF + 4);
#pragma unroll
        for (int ai = 0; ai < 2; ++ai)
#pragma unroll
            for (int m = 0; m < 4; ++m) { const size_t eo = (size_t)(row0 + ai * HALF + m * 16) * DM + u.pn * HALF + c8;
                float a[8];
#pragma unroll
                for (int j = 0; j < 8; ++j) {
                    float g = acc[ai][0][m][j >> 2][j & 3] * GU_DESCALE + (j < 4 ? bg0[j & 3] : bg1[j & 3]);
                    float l = acc[ai][1][m][j >> 2][j & 3] * GU_DESCALE + (j < 4 ? bl0[j & 3] : bl1[j & 3]);
                    g = fminf(g, 7.0f); l = fminf(fmaxf(l, -7.0f), 7.0f);
                    a[j] = g * fsigmoid(1.702f * g) * (l + 1.0f);
                }
#if MOE_FP8
                v2u w; w.x = pk4_fp8(a[0] * ACT_SCALE, a[1] * ACT_SCALE, a[2] * ACT_SCALE, a[3] * ACT_SCALE); w.y = pk4_fp8(a[4] * ACT_SCALE, a[5] * ACT_SCALE, a[6] * ACT_SCALE, a[7] * ACT_SCALE);
                *(GAS v2u*)(ws + WS_ACT + eo) = w;
#else
                v4u w; w.x = cvt_pk_bf16(a[0], a[1]); w.y = cvt_pk_bf16(a[2], a[3]); w.z = cvt_pk_bf16(a[4], a[5]); w.w = cvt_pk_bf16(a[6], a[7]);
                *(GAS v4u*)((GAS bf16*)(ws + WS_ACT) + eo) = w;
#endif
            }
    }
};
struct EpiMoeDown {
    static constexpr bool PERM = true;
    unsigned char* ws0; const float* bias;
    __device__ __forceinline__ void operator()(const f32x4 (&acc)[2][2][4][2], const Unit& u, int wr, int wc, int fr, int fq) const {
        OPAQUE_LANE(fr, fq);
        GAS unsigned char* ws = launder(ws0);
        GAS bf16* YS = (GAS bf16*)(ws + WS_YSLOT); const GAS int* rowdst = (const GAS int*)(ws + WS_ROWDST); const GAS float* rowgate = (const GAS float*)(ws + WS_ROWGATE);
        const int c8 = u.pn * BM + wc * 32 + 8 * fq;
        const GAS float* bp = (const GAS float*)bias + (size_t)u.e * DM + c8;
        f32x4 bv[2][2];
#pragma unroll
        for (int bj = 0; bj < 2; ++bj) { bv[bj][0] = *(const GAS f32x4*)(bp + bj * HALF); bv[bj][1] = *(const GAS f32x4*)(bp + bj * HALF + 4); }
#pragma unroll
        for (int ai = 0; ai < 2; ++ai)
#pragma unroll
            for (int m = 0; m < 4; ++m) { const int r = ai * HALF + wr * 64 + m * 16 + fr;
                if (r < u.cnt) {
                    const size_t ti = (size_t)u.gidx + r; const int dst = rowdst[ti]; const float gt = rowgate[ti];
                    GAS bf16* rowp = YS + (size_t)dst * DM + c8;
#pragma unroll
                    for (int bj = 0; bj < 2; ++bj) { const f32x4 v0 = (acc[ai][bj][m][0] * DN_DESCALE + bv[bj][0]) * gt, v1 = (acc[ai][bj][m][1] * DN_DESCALE + bv[bj][1]) * gt;
                        v4u w; w.x = cvt_pk_bf16(v0[0], v0[1]); w.y = cvt_pk_bf16(v0[2], v0[3]); w.z = cvt_pk_bf16(v1[0], v1[1]); w.w = cvt_pk_bf16(v1[2], v1[3]);
                        *(GAS v4u*)(rowp + bj * HALF) = w; } } }
    }
};
}

typedef short s16x4 __attribute__((ext_vector_type(4)));
typedef __bf16 bf16x2_t __attribute__((ext_vector_type(2)));
__device__ __forceinline__ unsigned cvtpk(float lo, float hi) { f32x2 v = {lo, hi}; bf16x2_t b = __builtin_convertvector(v, bf16x2_t); return __builtin_bit_cast(unsigned, b); }
__device__ __forceinline__ s16x4 tr_read(const LAS unsigned char* p) { return __builtin_bit_cast(s16x4, __builtin_amdgcn_ds_read_tr16_b64_v4i16((LAS s16x4*)p)); }
__device__ __forceinline__ bf16x8 cat8(s16x4 lo, s16x4 hi) { return __builtin_shufflevector(lo, hi, 0, 1, 2, 3, 4, 5, 6, 7); }
__device__ __forceinline__ bf16x8 pack8(const f32x4& a, const f32x4& b) { v4u p; p.x = cvtpk(a[0], a[1]); p.y = cvtpk(a[2], a[3]); p.z = cvtpk(b[0], b[1]); p.w = cvtpk(b[2], b[3]); return __builtin_bit_cast(bf16x8, p); }
__device__ __forceinline__ s16x4 pack4(const f32x4& a) { v2u p; p.x = cvtpk(a[0], a[1]); p.y = cvtpk(a[2], a[3]); return __builtin_bit_cast(s16x4, p); }
#define MFMA32(a, b, c) __builtin_amdgcn_mfma_f32_16x16x32_bf16((a), (b), (c), 0, 0, 0)
#define MFMA16(a, b, c) __builtin_amdgcn_mfma_f32_16x16x16bf16_1k((a), (b), (c), 0, 0, 0)

__device__ __forceinline__ void ret_fast(const int tid, LAS unsigned char* lds, const bf16* HB, bf16* OB) {
    constexpr int QP = 528, VP = 272, PP = 144;
    constexpr int OFF_Q = 0, OFF_K = 64 * QP, OFF_V = 2 * 64 * QP, OFF_P = OFF_V + 64 * VP;
    const int lane = tid & 63, w = __builtin_amdgcn_readfirstlane(tid >> 6), r = lane & 15, g = lane >> 4, q4 = (lane & 15) >> 2, p4 = lane & 3;
    const int prow = tid >> 3, pc = tid & 7;
    for (int un = blockIdx.x; un < NBATCH * RT_HEADS * 4; un += gridDim.x) {
        const int b = un >> 4, h = (un >> 2) & 3, vs = un & 3;
        const float l2g = __builtin_amdgcn_logf(1.0f - __builtin_amdgcn_exp2f(-5.0f - (float)h));
        const float dC = __builtin_amdgcn_exp2f(64.0f * l2g);
        f32x4 st[16];
#pragma unroll
        for (int i = 0; i < 16; ++i) st[i] = (f32x4){0.f, 0.f, 0.f, 0.f};
        const bf16* gbase = HB + (size_t)(b * SEQ + prow) * RT_IN;
        v4u pq[4], pk[4], pv[2];
#pragma unroll
        for (int j = 0; j < 4; ++j) { pq[j] = *(const v4u*)(gbase + h * 256 + (pc + 8 * j) * 8); pk[j] = *(const v4u*)(gbase + 1024 + h * 256 + (pc + 8 * j) * 8); }
#pragma unroll
        for (int j = 0; j < 2; ++j) pv[j] = *(const v4u*)(gbase + 2048 + h * 512 + vs * 128 + (pc + 8 * j) * 8);
#pragma unroll 1
        for (int ch = 0; ch < SEQ / 64; ++ch) {
            __syncthreads();
#pragma unroll
            for (int j = 0; j < 4; ++j) { *(LAS v4u*)(lds + OFF_Q + prow * QP + (pc + 8 * j) * 16) = pq[j]; *(LAS v4u*)(lds + OFF_K + prow * QP + (pc + 8 * j) * 16) = pk[j]; }
#pragma unroll
            for (int j = 0; j < 2; ++j) *(LAS v4u*)(lds + OFF_V + prow * VP + (pc + 8 * j) * 16) = pv[j];
            if (ch + 1 < SEQ / 64) {
                const bf16* gn = gbase + (size_t)(ch + 1) * 64 * RT_IN;
#pragma unroll
                for (int j = 0; j < 4; ++j) { pq[j] = *(const v4u*)(gn + h * 256 + (pc + 8 * j) * 8); pk[j] = *(const v4u*)(gn + 1024 + h * 256 + (pc + 8 * j) * 8); }
#pragma unroll
                for (int j = 0; j < 2; ++j) pv[j] = *(const v4u*)(gn + 2048 + h * 512 + vs * 128 + (pc + 8 * j) * 8);
            }
            __syncthreads();
            {
                const int ct = w >> 1, st0 = 2 * (w & 1);
                f32x4 sa0 = {0.f, 0.f, 0.f, 0.f}, sa1 = {0.f, 0.f, 0.f, 0.f};
                const LAS unsigned char* qb = lds + OFF_Q + (16 * ct + r) * QP + g * 16;
                const LAS unsigned char* kb0 = lds + OFF_K + (16 * st0 + r) * QP + g * 16;
#pragma unroll
                for (int kb = 0; kb < 8; ++kb) {
                    const bf16x8 qf = *(const LAS bf16x8*)(qb + kb * 64), k0 = *(const LAS bf16x8*)(kb0 + kb * 64), k1 = *(const LAS bf16x8*)(kb0 + 16 * QP + kb * 64);
                    sa0 = MFMA32(k0, qf, sa0); sa1 = MFMA32(k1, qf, sa1);
                }
                const int c = 16 * ct + r;
#pragma unroll
                for (int t = 0; t < 2; ++t) {
                    const f32x4 sa = t ? sa1 : sa0; const int s0 = 16 * (st0 + t) + 4 * g; float v[4];
#pragma unroll
                    for (int i = 0; i < 4; ++i) { const int d = c - (s0 + i); v[i] = d >= 0 ? sa[i] * __builtin_amdgcn_exp2f((float)d * l2g) : 0.f; }
                    v2u pw; pw.x = cvtpk(v[0], v[1]); pw.y = cvtpk(v[2], v[3]);
                    *(LAS v2u*)(lds + OFF_P + c * PP + s0 * 2) = pw;
                }
            }
            __syncthreads();
            f32x4 o[4];
#pragma unroll
            for (int ct = 0; ct < 4; ++ct) o[ct] = (f32x4){0.f, 0.f, 0.f, 0.f};
#pragma unroll
            for (int kb = 0; kb < 8; ++kb) {
                const bf16x8 sa = pack8(st[2 * kb], st[2 * kb + 1]);
#pragma unroll
                for (int ct = 0; ct < 4; ++ct) {
                    const LAS unsigned char* qp = lds + OFF_Q + (16 * ct + r) * QP + (32 * kb + 4 * g) * 2;
                    const s16x4 lo = *(const LAS s16x4*)qp, hi = *(const LAS s16x4*)(qp + 32);
                    o[ct] = MFMA32(sa, cat8(lo, hi), o[ct]);
                }
            }
#pragma unroll
            for (int ct = 0; ct < 4; ++ct) o[ct] = o[ct] * __builtin_amdgcn_exp2f((float)(16 * ct + r + 1) * l2g);
            bf16x8 vf[2];
#pragma unroll
            for (int sb = 0; sb < 2; ++sb) {
                const LAS unsigned char* vp = lds + OFF_V + (32 * sb + 8 * g + q4) * VP + (16 * w + 4 * p4) * 2;
                vf[sb] = cat8(tr_read(vp), tr_read(vp + 4 * VP));
            }
#pragma unroll
            for (int ct = 0; ct < 4; ++ct)
#pragma unroll
                for (int sb = 0; sb < 2; ++sb) if (sb <= (ct >> 1)) {
                    const bf16x8 pf = *(const LAS bf16x8*)(lds + OFF_P + (16 * ct + r) * PP + (32 * sb + 8 * g) * 2);
                    o[ct] = MFMA32(vf[sb], pf, o[ct]);
                }
            {
                bf16* ob = OB + (size_t)(b * SEQ + ch * 64 + r) * RT_VD + h * 512 + vs * 128 + 16 * w + 4 * g;
#pragma unroll
                for (int ct = 0; ct < 4; ++ct) { v2u ow; ow.x = cvtpk(o[ct][0], o[ct][1]); ow.y = cvtpk(o[ct][2], o[ct][3]); *(v2u*)(ob + (size_t)ct * 16 * RT_VD) = ow; }
            }
            bf16x8 vz[2];
#pragma unroll
            for (int sb = 0; sb < 2; ++sb) {
                const v4u raw = __builtin_bit_cast(v4u, vf[sb]); float f[8] = {bflo(raw.x), bfhi(raw.x), bflo(raw.y), bfhi(raw.y), bflo(raw.z), bfhi(raw.z), bflo(raw.w), bfhi(raw.w)};
#pragma unroll
                for (int j = 0; j < 8; ++j) f[j] *= __builtin_amdgcn_exp2f((float)(63 - (32 * sb + 8 * g + j)) * l2g);
                v4u z; z.x = cvtpk(f[0], f[1]); z.y = cvtpk(f[2], f[3]); z.z = cvtpk(f[4], f[5]); z.w = cvtpk(f[6], f[7]); vz[sb] = __builtin_bit_cast(bf16x8, z);
            }
#pragma unroll
            for (int kt = 0; kt < 16; ++kt) {
                st[kt] = st[kt] * dC;
#pragma unroll
                for (int sb = 0; sb < 2; ++sb) {
                    const LAS unsigned char* kp = lds + OFF_K + (32 * sb + 8 * g + q4) * QP + (16 * kt + 4 * p4) * 2;
                    st[kt] = MFMA32(cat8(tr_read(kp), tr_read(kp + 4 * QP)), vz[sb], st[kt]);
                }
            }
        }
        __syncthreads();
    }
}

__device__ __forceinline__ void hgrn_fast(const int tid, LAS unsigned char* lds, const bf16* QD, const bf16* KI, const bf16* KS, const bf16* VV, const float* DEC, bf16* OB) {
    constexpr int TP = 272;
    constexpr int OFF_QD = 0, OFF_KI = 64 * TP, OFF_KS = 2 * 64 * TP, OFF_V = 3 * 64 * TP, OFF_DEC = 4 * 64 * TP;
    const int lane = tid & 63, w = __builtin_amdgcn_readfirstlane(tid >> 6), r = lane & 15, g = lane >> 4, q4 = (lane & 15) >> 2, p4 = lane & 3;
    const int prow = tid >> 3, pc = tid & 7;
    for (int un = blockIdx.x; un < NBATCH * HG_HEADS; un += gridDim.x) {
        const int b = un >> 3, h = un & 7;
        f32x4 st[8];
#pragma unroll
        for (int i = 0; i < 8; ++i) st[i] = (f32x4){0.f, 0.f, 0.f, 0.f};
        const size_t goff = (size_t)(b * SEQ + prow) * DM + h * 128;
        v4u p0[2], p1[2], p2[2], p3[2]; f32x4 pd = {0.f, 0.f, 0.f, 0.f};
#pragma unroll
        for (int j = 0; j < 2; ++j) { const size_t o = goff + (pc + 8 * j) * 8; p0[j] = *(const v4u*)(QD + o); p1[j] = *(const v4u*)(KI + o); p2[j] = *(const v4u*)(KS + o); p3[j] = *(const v4u*)(VV + o); }
        if (tid < 128) pd = *(const f32x4*)(DEC + (size_t)((b * SEQ) / 16 + (tid >> 5)) * DM + h * 128 + (tid & 31) * 4);
#pragma unroll 1
        for (int rd = 0; rd < SEQ / 64; ++rd) {
            __syncthreads();
#pragma unroll
            for (int j = 0; j < 2; ++j) { const int lo = prow * TP + (pc + 8 * j) * 16; *(LAS v4u*)(lds + OFF_QD + lo) = p0[j]; *(LAS v4u*)(lds + OFF_KI + lo) = p1[j]; *(LAS v4u*)(lds + OFF_KS + lo) = p2[j]; *(LAS v4u*)(lds + OFF_V + lo) = p3[j]; }
            if (tid < 128) *(LAS f32x4*)(lds + OFF_DEC + tid * 16) = pd;
            if (rd + 1 < SEQ / 64) {
                const size_t gn = goff + (size_t)(rd + 1) * 64 * DM;
#pragma unroll
                for (int j = 0; j < 2; ++j) { const size_t o = gn + (pc + 8 * j) * 8; p0[j] = *(const v4u*)(QD + o); p1[j] = *(const v4u*)(KI + o); p2[j] = *(const v4u*)(KS + o); p3[j] = *(const v4u*)(VV + o); }
                if (tid < 128) pd = *(const f32x4*)(DEC + (size_t)((b * SEQ + (rd + 1) * 64) / 16 + (tid >> 5)) * DM + h * 128 + (tid & 31) * 4);
            }
            __syncthreads();
#pragma unroll 1
            for (int cc = 0; cc < 4; ++cc) {
                bf16x8 qf[4], kf[4];
#pragma unroll
                for (int kb = 0; kb < 4; ++kb) {
                    const int off = (16 * cc + r) * TP + (32 * kb + 4 * g) * 2;
                    qf[kb] = cat8(*(const LAS s16x4*)(lds + OFF_QD + off), *(const LAS s16x4*)(lds + OFF_QD + off + 32));
                    kf[kb] = cat8(*(const LAS s16x4*)(lds + OFF_KI + off), *(const LAS s16x4*)(lds + OFF_KI + off + 32));
                }
                f32x4 sc = {0.f, 0.f, 0.f, 0.f}, oa = {0.f, 0.f, 0.f, 0.f};
#pragma unroll
                for (int kb = 0; kb < 4; ++kb) sc = MFMA32(kf[kb], qf[kb], sc);
#pragma unroll
                for (int i = 0; i < 4; ++i) sc[i] = (4 * g + i <= r) ? sc[i] : 0.f;
                const s16x4 pf = pack4(sc);
#pragma unroll
                for (int kb = 0; kb < 4; ++kb) oa = MFMA32(pack8(st[2 * kb], st[2 * kb + 1]), qf[kb], oa);
                const s16x4 vfr = tr_read(lds + OFF_V + (16 * cc + 4 * g + q4) * TP + (16 * w + 4 * p4) * 2);
                oa = MFMA16(vfr, pf, oa);
                { v2u ow; ow.x = cvtpk(oa[0], oa[1]); ow.y = cvtpk(oa[2], oa[3]); *(v2u*)(OB + (size_t)(b * SEQ + rd * 64 + cc * 16 + r) * DM + h * 128 + 16 * w + 4 * g) = ow; }
#pragma unroll
                for (int kt = 0; kt < 8; ++kt) {
                    const f32x4 d4 = *(const LAS f32x4*)(lds + OFF_DEC + cc * 512 + (16 * kt + 4 * g) * 4);
                    const s16x4 ks = tr_read(lds + OFF_KS + (16 * cc + 4 * g + q4) * TP + (16 * kt + 4 * p4) * 2);
                    st[kt] = MFMA16(ks, vfr, st[kt] * d4);
                }
            }
        }
        __syncthreads();
    }
}

struct Args { const float* in[17]; float* out; unsigned char* ws; int ph_lo, ph_hi; };
enum { I_X = 0, I_HWIN, I_HNG, I_HWOUT, I_LB, I_RWIN, I_RWOUT, I_LNMG, I_LNMB, I_LNFG, I_LNFB, I_RW, I_RB, I_WGU, I_BGU, I_WDN, I_BDN };

__device__ __forceinline__ int dest_row(int mode, int n) {
    if (mode == 1) { if (n < 1024) return ((n >> 7) << 8) + (n & 127); if (n < 2048) { const int q = n - 1024; return ((q >> 7) << 8) + 128 + (q & 127); } return n; }
    if (mode == 2) { const int j2 = n >> 1; return ((j2 >> 7) << 8) + ((n & 1) << 7) + (j2 & 127); }
    return n;
}
__device__ __forceinline__ void transpose_item(const float* W, int K, int N, bf16* WT, int mode, LAS float* scr, int item, int lane) {
    const int nblk = N / 64, kb = item / nblk, nb = item % nblk, k0 = 64 * kb, n0 = 64 * nb;
#pragma unroll 4
    for (int i = 0; i < 16; ++i) { const int kk = 4 * i + (lane >> 4), c4 = (lane & 15) * 4;
        const f32x4 v = *(const GAS f32x4*)(W + (size_t)(k0 + kk) * N + n0 + c4);
        LAS float* s = scr + kk * 65 + c4; s[0] = v[0]; s[1] = v[1]; s[2] = v[2]; s[3] = v[3]; }
    LDS_WAIT(); asm volatile("" ::: "memory");
    const int c = lane & 7;
#pragma unroll 2
    for (int j = 0; j < 8; ++j) { const int n = (lane >> 3) + 8 * j; const LAS float* s = scr + (8 * c) * 65 + n;
        v4u o; o.x = pk2(s[0 * 65], s[1 * 65]); o.y = pk2(s[2 * 65], s[3 * 65]); o.z = pk2(s[4 * 65], s[5 * 65]); o.w = pk2(s[6 * 65], s[7 * 65]);
        *(GAS v4u*)(WT + (size_t)dest_row(mode, n0 + n) * K + k0 + 8 * c) = o; }
    LDS_WAIT(); asm volatile("" ::: "memory");
}

__device__ __forceinline__ void transpose_item_fp8(const float* W, int K, int N, unsigned char* WT, int mode, float scale, LAS float* scr, int item, int lane) {
    const int nblk = N / 64, kb = item / nblk, nb = item % nblk, k0 = 64 * kb, n0 = 64 * nb;
#pragma unroll 4
    for (int i = 0; i < 16; ++i) { const int kk = 4 * i + (lane >> 4), c4 = (lane & 15) * 4;
        const f32x4 v = *(const GAS f32x4*)(W + (size_t)(k0 + kk) * N + n0 + c4);
        LAS float* s = scr + kk * 65 + c4; s[0] = v[0]; s[1] = v[1]; s[2] = v[2]; s[3] = v[3]; }
    LDS_WAIT(); asm volatile("" ::: "memory");
    const int c = lane & 7;
#pragma unroll 2
    for (int j = 0; j < 8; ++j) { const int n = (lane >> 3) + 8 * j; const LAS float* s = scr + (8 * c) * 65 + n;
        v2u o; o.x = pk4_fp8(s[0 * 65] * scale, s[1 * 65] * scale, s[2 * 65] * scale, s[3 * 65] * scale); o.y = pk4_fp8(s[4 * 65] * scale, s[5 * 65] * scale, s[6 * 65] * scale, s[7 * 65] * scale);
        *(GAS v2u*)(WT + (size_t)dest_row(mode, n0 + n) * K + k0 + 8 * c) = o; }
    LDS_WAIT(); asm volatile("" ::: "memory");
}

#ifndef SITE_MASK
#define SITE_MASK 0xffff
#endif
#define SITE(n) (((SITE_MASK) >> (n)) & 1)
#ifndef PROBE_MASK
#define PROBE_MASK 0
#endif
#define REP(n) (1 + (((PROBE_MASK) >> (n)) & 1))
typedef const __attribute__((address_space(4))) Args* KArgs;
__device__ __forceinline__ int otid() { int t = threadIdx.x; asm volatile("" : "+v"(t)); return t; }
__device__ __forceinline__ LAS unsigned char* olds(LAS unsigned char* p) { asm volatile("" : "+s"(p)); return p; }
__device__ __forceinline__ KArgs kargs() { KArgs p = (KArgs)__builtin_amdgcn_kernarg_segment_ptr(); asm volatile("" : "+s"(p)); return p; }
#define IN(k) (ap->ph_lo <= (k) && (k) < ap->ph_hi)
#define GRID_BAR() do { if (ap->ph_hi - ap->ph_lo > 1) { XcdBarrier _b; _b.bar = (unsigned*)(ap->ws + WS_CTL) + CW_BAR; _b.x = xb_xcc_id(); _b.st = (volatile LAS unsigned*)(lds + MISC_OFF + MO_BARW); xcd_barrier(_b); } } while (0)
#define VCU() ((gridDim.x % 8 == 0) ? (int)((blockIdx.x % 8) * (gridDim.x / 8) + blockIdx.x / 8) : (int)blockIdx.x)

__global__ void __launch_bounds__(512, 2) mk_fwd(Args args_unused) {
    extern __shared__ __attribute__((aligned(16))) unsigned char lds_raw[];
    LAS unsigned char* const lds0 = (LAS unsigned char*)lds_raw;
    {
        LAS unsigned char* lds = lds0;
        for (int u = threadIdx.x; u < (LDS_BYTES - MISC_OFF) / 4; u += 512) ((LAS unsigned*)(lds + MISC_OFF))[u] = 0u;
        __syncthreads();
        KArgs ap = kargs();
        if (ap->ph_hi - ap->ph_lo > 1) (void)xcd_barrier_post((unsigned*)(ap->ws + WS_CTL) + CW_BAR, (volatile LAS unsigned*)(lds + MISC_OFF + MO_BARW));
    }

#if SITE(0)
    { KArgs ap = kargs(); const int tid = otid(); LAS unsigned char* lds = olds(lds0); (void)tid;
    if (IN(0)) for (int rep_ = 0; rep_ < REP(0); ++rep_) {
        const int lane = tid & 63, wave = __builtin_amdgcn_readfirstlane(tid >> 6), G = gridDim.x, vcu = VCU(), gw = vcu * 8 + wave, NGW = G * 8;
        unsigned char* ws = ap->ws;
        LAS float* scr = (LAS float*)(lds + wave * 16640);
        constexpr int I_HIN = 2 * 16 * 64, I_HOUT = 2 * 16 * 16, I_RIN = 2 * 16 * 96, I_ROUT = 2 * 32 * 16, I_GU = 128 * 16 * 32, I_DN = 128 * 16 * 16;
        constexpr int NITEMS = I_HIN + I_HOUT + I_RIN + I_ROUT + I_GU + I_DN;
        for (int it = gw; it < NITEMS; it += NGW) {
            int r = it;
            if (r < I_HIN) { const int j = r / (16 * 64); transpose_item(ap->in[I_HWIN] + (size_t)j * DM * HG_IN, DM, HG_IN, (bf16*)(ws + WS_W_HIN) + (size_t)j * HG_IN * DM, 1, scr, r % (16 * 64), lane); continue; } r -= I_HIN;
            if (r < I_HOUT) { const int j = r / 256; transpose_item(ap->in[I_HWOUT] + (size_t)j * DM * DM, DM, DM, (bf16*)(ws + WS_W_HOUT) + (size_t)j * DM * DM, 0, scr, r % 256, lane); continue; } r -= I_HOUT;
            if (r < I_RIN) { const int j = r / (16 * 96); transpose_item(ap->in[I_RWIN] + (size_t)j * DM * RT_IN, DM, RT_IN, (bf16*)(ws + WS_W_RIN) + (size_t)j * RT_IN * DM, 0, scr, r % (16 * 96), lane); continue; } r -= I_RIN;
            if (r < I_ROUT) { const int j = r / 512; transpose_item(ap->in[I_RWOUT] + (size_t)j * RT_VD * DM, RT_VD, DM, (bf16*)(ws + WS_W_ROUT) + (size_t)j * DM * RT_VD, 0, scr, r % 512, lane); continue; } r -= I_ROUT;
#if MOE_FP8
            if (r < I_GU) { const int j = r / 512; transpose_item_fp8(ap->in[I_WGU] + (size_t)j * DM * 2048, DM, 2048, ws + WS_W_GU + (size_t)j * 2048 * DM, 2, WGU_SCALE, scr, r % 512, lane); continue; } r -= I_GU;
            { const int j = r / 256; transpose_item_fp8(ap->in[I_WDN] + (size_t)j * DM * DM, DM, DM, ws + WS_W_DN + (size_t)j * DM * DM, 0, WDN_SCALE, scr, r % 256, lane); }
#else
            if (r < I_GU) { const int j = r / 512; transpose_item(ap->in[I_WGU] + (size_t)j * DM * 2048, DM, 2048, (bf16*)(ws + WS_W_GU) + (size_t)j * 2048 * DM, 2, scr, r % 512, lane); continue; } r -= I_GU;
            { const int j = r / 256; transpose_item(ap->in[I_WDN] + (size_t)j * DM * DM, DM, DM, (bf16*)(ws + WS_W_DN) + (size_t)j * DM * DM, 0, scr, r % 256, lane); }
#endif
        }
        const int gt = vcu * 512 + tid, NGT = G * 512;
        float* LBS = (float*)(ws + WS_LBS); float* BGU = (float*)(ws + WS_BGU); float* ROT = (float*)(ws + WS_ROT); bf16* XB = (bf16*)(ws + WS_XB);
        for (int d = gt; d < DM; d += NGT) { const float* lbp = ap->in[I_LB]; const float v0 = lbp[d], v1 = lbp[DM + d], v2 = lbp[2 * DM + d], v3 = lbp[3 * DM + d]; const float mx = fmaxf(fmaxf(v0, v1), fmaxf(v2, v3));
            const float e0 = __expf(v0 - mx), e1 = __expf(v1 - mx), e2 = __expf(v2 - mx), e3 = __expf(v3 - mx), is = 1.0f / (e0 + e1 + e2 + e3);
            LBS[d] = 0.f; LBS[DM + d] = e1 * is; LBS[2 * DM + d] = (e1 + e2) * is; LBS[3 * DM + d] = (e1 + e2 + e3) * is; }
        for (int i = gt; i < SEQ * 128; i += NGT) { const int pos = i >> 7, p = i & 127; const float inv = 1.0f / __builtin_amdgcn_exp2f(13.287712379549449f * ((float)p / 127.0f)); const float th = (float)pos * inv;
            double rev = (double)th * 0.15915494309189535; rev -= floor(rev); const float fr = (float)rev; ROT[2 * i] = __builtin_amdgcn_cosf(fr); ROT[2 * i + 1] = __builtin_amdgcn_sinf(fr); }
        for (int i = gt; i < 4 * 32 * 2048; i += NGT) { const int le = i >> 11, n = i & 2047; BGU[(size_t)le * 2048 + dest_row(2, n)] = ap->in[I_BGU][i]; }
        for (size_t i = (size_t)gt; i < (size_t)NTOK * DM / 4; i += NGT) { const f32x4 v = ((const f32x4*)ap->in[I_X])[i]; v2u o; o.x = pk2(v[0], v[1]); o.y = pk2(v[2], v[3]); ((v2u*)XB)[i] = o; }
        GRID_BAR();
    } }
#endif

#pragma unroll 1
    for (int L = 0; L < DEPTH; ++L) {
        const int pb = 1 + 8 * L;
        if ((L & 1) == 0) {
#if SITE(1)
            { KArgs ap = kargs(); const int tid = otid(); LAS unsigned char* lds = olds(lds0); (void)tid;
            if (IN(pb + 0)) for (int rep_ = 0; rep_ < REP(1); ++rep_) {
                unsigned char* ws = ap->ws; const int j = L >> 1;
                LAS int* ul = (LAS int*)(lds + MISC_OFF + MO_ULIST);
                pg8::build_units_dense(tid, ul, NTOK / 256, HG_IN / 256, DM * 2);
                pg8::EpiHgrnIn E{ws, L};
                pg8::gemm_phase<pg8::EpiHgrnIn, false, true, false>(tid, lds, ul, (LAS int*)(lds + MISC_OFF + MO_GTAB), (const char*)(ws + WS_XB), (const char*)((bf16*)(ws + WS_W_HIN) + (size_t)j * HG_IN * DM), nullptr, DM * 2, E);
                GRID_BAR();
            } }
#endif
#if SITE(2)
            { KArgs ap = kargs(); const int tid = otid(); LAS unsigned char* lds = olds(lds0); (void)tid;
            if (IN(pb + 1)) for (int rep_ = 0; rep_ < REP(2); ++rep_) {
#if !SLOW_HGRN
                { unsigned char* ws = ap->ws; const bf16* QD = (const bf16*)(ws + WS_H);
                  hgrn_fast(tid, lds, QD, QD + (size_t)NTOK * DM, QD + 2 * (size_t)NTOK * DM, QD + 3 * (size_t)NTOK * DM, (const float*)(ws + WS_DEC), (bf16*)(ws + WS_O)); }
#else
                unsigned char* ws = ap->ws; const bf16* QD = (const bf16*)(ws + WS_H); const bf16* KI = QD + (size_t)NTOK * DM; const bf16* KS = QD + 2 * (size_t)NTOK * DM; const bf16* VV = QD + 3 * (size_t)NTOK * DM; bf16* OB = (bf16*)(ws + WS_O);
                LAS float* qf = (LAS float*)lds; LAS float* kf = qf + 16 * 4 * 36; LAS float* ff = kf + 16 * 4 * 36; LAS float* vf = ff + 16 * 4 * 36;
                for (int un = blockIdx.x; un < NBATCH * HG_HEADS; un += gridDim.x) {
                    const int b = un >> 3, h = un & 7; const int vc = tid >> 2, kq = tid & 3;
                    float st[32];
#pragma unroll
                    for (int i = 0; i < 32; ++i) st[i] = 0.f;
                    for (int t0 = 0; t0 < SEQ; t0 += 16) {
                        __syncthreads();
                        for (int e = tid; e < 16 * 128; e += 512) { const int tt = e >> 7, k = e & 127; const size_t gi = (size_t)(b * SEQ + t0 + tt) * DM + h * 128 + k; const int li = tt * 144 + (k & 3) * 36 + (k >> 2);
                            qf[li] = bf1(QD[gi]); kf[li] = bf1(KI[gi]); ff[li] = bf1(KS[gi]); vf[tt * 128 + k] = bf1(VV[gi]); }
                        __syncthreads();
                        for (int tt = 0; tt < 16; ++tt) {
                            const float v = vf[tt * 128 + vc]; float a = 0.f; const int lb = tt * 144 + kq * 36;
#pragma unroll
                            for (int i = 0; i < 32; ++i) { st[i] = ff[lb + i] * st[i] + kf[lb + i] * v; a += qf[lb + i] * st[i]; }
                            a += __shfl_xor(a, 1); a += __shfl_xor(a, 2);
                            if (kq == 0) OB[(size_t)(b * SEQ + t0 + tt) * DM + h * 128 + vc] = (bf16)f2bf(a);
                        }
                    }
                }
#endif
                GRID_BAR();
            } }
#endif
#if SITE(3)
            { KArgs ap = kargs(); const int tid = otid(); LAS unsigned char* lds = olds(lds0); (void)tid;
            if (IN(pb + 2)) for (int rep_ = 0; rep_ < REP(3); ++rep_) {
                const int lane = tid & 63, wave = __builtin_amdgcn_readfirstlane(tid >> 6), gw = VCU() * 8 + wave, NGW = gridDim.x * 8;
                unsigned char* ws = ap->ws; const bf16* OB = (const bf16*)(ws + WS_O); const bf16* GG = (const bf16*)(ws + WS_H) + 4 * (size_t)NTOK * DM; bf16* A2 = (bf16*)(ws + WS_A2);
                const float* ng = ap->in[I_HNG] + (L >> 1) * DM;
                for (int row = gw; row < NTOK; row += NGW) {
                    float o[16]; float ss = 0.f;
#pragma unroll
                    for (int q = 0; q < 4; ++q) { const v2u w = *(const v2u*)(OB + (size_t)row * DM + 256 * q + 4 * lane); o[4 * q] = bflo(w.x); o[4 * q + 1] = bfhi(w.x); o[4 * q + 2] = bflo(w.y); o[4 * q + 3] = bfhi(w.y); }
#pragma unroll
                    for (int i = 0; i < 16; ++i) ss += o[i] * o[i];
                    const float rs = 1.0f / sqrtf(wave_sum(ss) * (1.0f / DM) + RMS_EPS);
#pragma unroll
                    for (int q = 0; q < 4; ++q) { const v2u gw2 = *(const v2u*)(GG + (size_t)row * DM + 256 * q + 4 * lane); const f32x4 g4 = *(const f32x4*)(ng + 256 * q + 4 * lane);
                        v2u w; w.x = pk2(o[4 * q] * rs * g4[0] * bflo(gw2.x), o[4 * q + 1] * rs * g4[1] * bfhi(gw2.x)); w.y = pk2(o[4 * q + 2] * rs * g4[2] * bflo(gw2.y), o[4 * q + 3] * rs * g4[3] * bfhi(gw2.y));
                        *(v2u*)(A2 + (size_t)row * DM + 256 * q + 4 * lane) = w; }
                }
                GRID_BAR();
            } }
#endif
        } else {
#if SITE(4)
            { KArgs ap = kargs(); const int tid = otid(); LAS unsigned char* lds = olds(lds0); (void)tid;
            if (IN(pb + 0)) for (int rep_ = 0; rep_ < REP(4); ++rep_) {
                unsigned char* ws = ap->ws; const int j = L >> 1;
                LAS int* ul = (LAS int*)(lds + MISC_OFF + MO_ULIST);
                pg8::build_units_dense(tid, ul, NTOK / 256, RT_IN / 256, DM * 2);
                pg8::EpiRetIn E{ws};
                pg8::gemm_phase<pg8::EpiRetIn, false, true, false>(tid, lds, ul, (LAS int*)(lds + MISC_OFF + MO_GTAB), (const char*)(ws + WS_XB), (const char*)((bf16*)(ws + WS_W_RIN) + (size_t)j * RT_IN * DM), nullptr, DM * 2, E);
                GRID_BAR();
            } }
#endif
#if SITE(5)
            { KArgs ap = kargs(); const int tid = otid(); LAS unsigned char* lds = olds(lds0); (void)tid;
            if (IN(pb + 1)) for (int rep_ = 0; rep_ < REP(5); ++rep_) {
#if !SLOW_RET
                { unsigned char* ws = ap->ws; ret_fast(tid, lds, (const bf16*)(ws + WS_H), (bf16*)(ws + WS_O)); }
#else
                unsigned char* ws = ap->ws; const bf16* HB = (const bf16*)(ws + WS_H); bf16* OB = (bf16*)(ws + WS_O);
                LAS float* qf = (LAS float*)lds; LAS float* kf = qf + 16 * 4 * 68; LAS float* vf = kf + 16 * 4 * 68;
                for (int un = blockIdx.x; un < NBATCH * RT_HEADS * 4; un += gridDim.x) {
                    const int b = un >> 4, h = (un >> 2) & 3, vq = un & 3; const int vc = tid >> 2, kq = tid & 3;
                    const float gam = 1.0f - exp2f(-5.0f - (float)h);
                    float st[64];
#pragma unroll
                    for (int i = 0; i < 64; ++i) st[i] = 0.f;
                    for (int t0 = 0; t0 < SEQ; t0 += 16) {
                        __syncthreads();
                        for (int e = tid; e < 16 * 256; e += 512) { const int tt = e >> 8, k = e & 255; const size_t gi = (size_t)(b * SEQ + t0 + tt) * RT_IN + h * 256 + k; const int li = tt * 272 + (k & 3) * 68 + (k >> 2);
                            qf[li] = bf1(HB[gi]); kf[li] = bf1(HB[gi + 1024]); }
                        for (int e = tid; e < 16 * 128; e += 512) { const int tt = e >> 7, c = e & 127; vf[e] = bf1(HB[(size_t)(b * SEQ + t0 + tt) * RT_IN + 2048 + h * 512 + vq * 128 + c]); }
                        __syncthreads();
                        for (int tt = 0; tt < 16; ++tt) {
                            const float v = vf[tt * 128 + vc]; float a = 0.f; const int lb = tt * 272 + kq * 68;
#pragma unroll
                            for (int i = 0; i < 64; ++i) { st[i] = gam * st[i] + kf[lb + i] * v; a += qf[lb + i] * st[i]; }
                            a += __shfl_xor(a, 1); a += __shfl_xor(a, 2);
                            if (kq == 0) OB[(size_t)(b * SEQ + t0 + tt) * RT_VD + h * 512 + vq * 128 + vc] = (bf16)f2bf(a);
                        }
                    }
                }
#endif
                GRID_BAR();
            } }
#endif
#if SITE(6)
            { KArgs ap = kargs(); const int tid = otid(); LAS unsigned char* lds = olds(lds0); (void)tid;
            if (IN(pb + 2)) for (int rep_ = 0; rep_ < REP(6); ++rep_) {
                const int lane = tid & 63, wave = __builtin_amdgcn_readfirstlane(tid >> 6), gw = VCU() * 8 + wave, NGW = gridDim.x * 8;
                unsigned char* ws = ap->ws; const bf16* OB = (const bf16*)(ws + WS_O); const bf16* HB = (const bf16*)(ws + WS_H); bf16* A2 = (bf16*)(ws + WS_A2);
                for (int row = gw; row < NTOK; row += NGW) {
#pragma unroll
                    for (int h = 0; h < 4; ++h) {
                        const v4u w = *(const v4u*)(OB + (size_t)row * RT_VD + 512 * h + 8 * lane);
                        float o[8] = {bflo(w.x), bfhi(w.x), bflo(w.y), bfhi(w.y), bflo(w.z), bfhi(w.z), bflo(w.w), bfhi(w.w)};
                        float s = 0.f;
#pragma unroll
                        for (int i = 0; i < 8; ++i) s += o[i];
                        const float mu = wave_sum(s) * (1.0f / 512.0f); float q = 0.f;
#pragma unroll
                        for (int i = 0; i < 8; ++i) { o[i] -= mu; q += o[i] * o[i]; }
                        const float rs = 1.0f / sqrtf(wave_sum(q) * (1.0f / 512.0f) + LN_EPS);
                        const v4u g = *(const v4u*)(HB + (size_t)row * RT_IN + 4096 + 512 * h + 8 * lane);
                        v4u r; r.x = pk2(o[0] * rs * bflo(g.x), o[1] * rs * bfhi(g.x)); r.y = pk2(o[2] * rs * bflo(g.y), o[3] * rs * bfhi(g.y));
                        r.z = pk2(o[4] * rs * bflo(g.z), o[5] * rs * bfhi(g.z)); r.w = pk2(o[6] * rs * bflo(g.w), o[7] * rs * bfhi(g.w));
                        *(v4u*)(A2 + (size_t)row * RT_VD + 512 * h + 8 * lane) = r;
                    }
                }
                GRID_BAR();
            } }
#endif
        }
#if SITE(7)
        { KArgs ap = kargs(); const int tid = otid(); LAS unsigned char* lds = olds(lds0); (void)tid;
        if (IN(pb + 3)) for (int rep_ = 0; rep_ < REP(7); ++rep_) {
            unsigned char* ws = ap->ws; const int j = L >> 1; const bool ret = (L & 1) != 0;
            const int Ko = ret ? RT_VD : DM;
            LAS int* ul = (LAS int*)(lds + MISC_OFF + MO_ULIST);
            pg8::build_units_dense(tid, ul, NTOK / 256, DM / 256, Ko * 2);
            const char* Bt = ret ? (const char*)((bf16*)(ws + WS_W_ROUT) + (size_t)j * DM * RT_VD) : (const char*)((bf16*)(ws + WS_W_HOUT) + (size_t)j * DM * DM);
            pg8::EpiRes E{(L == 0) ? ap->in[I_X] : (const float*)ap->out, ws};
            pg8::gemm_phase<pg8::EpiRes, false, true, false>(tid, lds, ul, (LAS int*)(lds + MISC_OFF + MO_GTAB), (const char*)(ws + WS_A2), Bt, nullptr, Ko * 2, E);
            GRID_BAR();
        } }
#endif
#if SITE(8)
        { KArgs ap = kargs(); const int tid = otid(); LAS unsigned char* lds = olds(lds0); (void)tid;
        if (IN(pb + 4)) for (int rep_ = 0; rep_ < REP(8); ++rep_) {
            const int lane = tid & 63, wave = __builtin_amdgcn_readfirstlane(tid >> 6);
            unsigned char* ws = ap->ws; unsigned* ctl = (unsigned*)(ws + WS_CTL);
            const float* Y = (const float*)(ws + WS_Y); float* X1F = (float*)(ws + WS_X1F); bf16* X1B = (bf16*)(ws + WS_X1B);
            int* ROWDST = (int*)(ws + WS_ROWDST); float* ROWGATE = (float*)(ws + WS_ROWGATE);
            LAS float* wT = (LAS float*)lds;
            LAS int* lcnt = (LAS int*)(lds + MISC_OFF + MO_LCNT); LAS int* lbase = (LAS int*)(lds + MISC_OFF + MO_LBASE);
            LAS int* sel = (LAS int*)(lds + MISC_OFF + MO_SEL); LAS float* selw = (LAS float*)(lds + MISC_OFF + MO_SELW);
            const float* rw = ap->in[I_RW] + (size_t)L * DM * NE; const float* rb = ap->in[I_RB] + L * NE;
            const float* lg = ap->in[I_LNMG] + L * DM; const float* lbb = ap->in[I_LNMB] + L * DM;
            for (int e4 = tid; e4 < DM * NE / 4; e4 += 512) { const f32x4 v = ((const f32x4*)rw)[e4]; const int d = e4 >> 3, e0 = (e4 & 7) * 4; wT[(e0 + 0) * DM + d] = v[0]; wT[(e0 + 1) * DM + d] = v[1]; wT[(e0 + 2) * DM + d] = v[2]; wT[(e0 + 3) * DM + d] = v[3]; }
            const float rbias = rb[lane >> 1];
            for (int blk = VCU(); blk < NTOK / 128; blk += gridDim.x) {
                if (tid < 32) lcnt[tid] = 0;
                __syncthreads();
#pragma unroll 1
                for (int rr = 0; rr < 16; ++rr) {
                    const int rloc = wave * 16 + rr, row = blk * 128 + rloc;
                    f32x4 x[4]; float s = 0.f;
#pragma unroll
                    for (int q = 0; q < 4; ++q) { x[q] = *(const f32x4*)(Y + (size_t)row * DM + 256 * q + 4 * lane); s += (x[q][0] + x[q][1]) + (x[q][2] + x[q][3]); }
                    const float mu = wave_sum(s) * (1.0f / DM); float qq = 0.f;
#pragma unroll
                    for (int q = 0; q < 4; ++q) { x[q] = x[q] - mu; qq += (x[q][0] * x[q][0] + x[q][1] * x[q][1]) + (x[q][2] * x[q][2] + x[q][3] * x[q][3]); }
                    const float rs = 1.0f / sqrtf(wave_sum(qq) * (1.0f / DM) + LN_EPS);
#pragma unroll
                    for (int q = 0; q < 4; ++q) { const f32x4 g4 = *(const f32x4*)(lg + 256 * q + 4 * lane), b4 = *(const f32x4*)(lbb + 256 * q + 4 * lane); x[q] = x[q] * rs * g4 + b4;
                        *(f32x4*)(X1F + (size_t)row * DM + 256 * q + 4 * lane) = x[q];
#if MOE_FP8
                        *(unsigned*)((unsigned char*)X1B + (size_t)row * DM + 256 * q + 4 * lane) = pk4_fp8(x[q][0] * X_SCALE, x[q][1] * X_SCALE, x[q][2] * X_SCALE, x[q][3] * X_SCALE); }
#else
                        v2u w; w.x = pk2(x[q][0], x[q][1]); w.y = pk2(x[q][2], x[q][3]); *(v2u*)(X1B + (size_t)row * DM + 256 * q + 4 * lane) = w; }
#endif
                    float a[32];
#pragma unroll
                    for (int e = 0; e < 32; ++e) { float t = 0.f;
#pragma unroll
                        for (int q = 0; q < 4; ++q) { const f32x4 w = *(const LAS f32x4*)(wT + e * DM + 256 * q + 4 * lane); t += (x[q][0] * w[0] + x[q][1] * w[1]) + (x[q][2] * w[2] + x[q][3] * w[3]); }
                        a[e] = t; }
#pragma unroll
                    for (int st = 0; st < 5; ++st) { const int n = 16 >> st, msk = 32 >> st; const bool up = (lane & msk) != 0;
#pragma unroll
                        for (int i = 0; i < n; ++i) { const float keep = up ? a[i + n] : a[i], send = up ? a[i] : a[i + n]; a[i] = keep + __shfl_xor(send, msk); } }
                    float lgt = a[0] + __shfl_xor(a[0], 1) + rbias;
                    float v = lgt; int se[4]; float sv[4];
#pragma unroll
                    for (int k = 0; k < 4; ++k) { const float m = wave_max(v); const unsigned long long bal = __ballot(v == m); const int l0 = __builtin_ctzll(bal); se[k] = l0 >> 1; sv[k] = m; if ((lane >> 1) == se[k]) v = -3.0e38f; }
                    const float e1 = __expf(sv[1] - sv[0]), e2 = __expf(sv[2] - sv[0]), e3 = __expf(sv[3] - sv[0]); const float inv = 1.0f / (1.0f + e1 + e2 + e3);
                    if (lane < 4) { const int ee = lane == 0 ? se[0] : (lane == 1 ? se[1] : (lane == 2 ? se[2] : se[3])); const float ww = (lane == 0 ? 1.0f : (lane == 1 ? e1 : (lane == 2 ? e2 : e3))) * inv;
                        sel[rloc * 4 + lane] = ee; selw[rloc * 4 + lane] = ww; }
                }
                __syncthreads();
                const int myE = sel[tid]; const int rank = __hip_atomic_fetch_add(lcnt + myE, 1, __ATOMIC_RELAXED, __HIP_MEMORY_SCOPE_WORKGROUP);
                __syncthreads();
                if (tid < 32) lbase[tid] = (int)__hip_atomic_fetch_add(ctl + CW_ECNT + L * 32 + tid, (unsigned)lcnt[tid], RLX_AGENT);
                __syncthreads();
                { const int pos = lbase[myE] + rank; const size_t ti = (size_t)myE * ECAP + pos; ROWDST[ti] = (blk * 128 + (tid >> 2)) * 4 + (tid & 3); ROWGATE[ti] = selw[tid]; }
                __syncthreads();
            }
            GRID_BAR();
        } }
#endif
#if SITE(9)
        { KArgs ap = kargs(); const int tid = otid(); LAS unsigned char* lds = olds(lds0); (void)tid;
        if (IN(pb + 5)) for (int rep_ = 0; rep_ < REP(9); ++rep_) {
            unsigned char* ws = ap->ws; unsigned* ctl = (unsigned*)(ws + WS_CTL);
            LAS int* tpre = (LAS int*)(lds + MISC_OFF + MO_TPRE); LAS int* ebase = (LAS int*)(lds + MISC_OFF + MO_EBASE); LAS int* ecnt = (LAS int*)(lds + MISC_OFF + MO_ECNT);
            if (tid == 0) { int t = 0;
_Pragma("unroll 1")
 for (int e = 0; e < NE; ++e) { const int c = (int)__hip_atomic_load(ctl + CW_ECNT + L * 32 + e, RLX_AGENT); ecnt[e] = c; tpre[e] = t; ebase[e] = t * 256; t += (c + 255) >> 8; } tpre[NE] = t; }
            __syncthreads();
            LAS int* ul = (LAS int*)(lds + MISC_OFF + MO_ULIST);
            constexpr int EB = MOE_FP8 ? 1 : 2;
            pg8::build_units_moe(tid, ul, tpre, ebase, ecnt, 8, DM * EB, 2048u * DM * EB);
            pg8::EpiMoeGU E{ws, L};
            pg8::gemm_phase<pg8::EpiMoeGU, true, true, MOE_FP8 != 0>(tid, lds, ul, (LAS int*)(lds + MISC_OFF + MO_GTAB), (const char*)(ws + WS_X1B), (const char*)(ws + WS_W_GU + (size_t)L * NE * 2048 * DM * EB), (const int*)(ws + WS_ROWDST), DM * EB, E);
            GRID_BAR();
        } }
#endif
#if SITE(10)
        { KArgs ap = kargs(); const int tid = otid(); LAS unsigned char* lds = olds(lds0); (void)tid;
        if (IN(pb + 6)) for (int rep_ = 0; rep_ < REP(10); ++rep_) {
            unsigned char* ws = ap->ws; unsigned* ctl = (unsigned*)(ws + WS_CTL);
            LAS int* tpre = (LAS int*)(lds + MISC_OFF + MO_TPRE); LAS int* ebase = (LAS int*)(lds + MISC_OFF + MO_EBASE); LAS int* ecnt = (LAS int*)(lds + MISC_OFF + MO_ECNT);
            __syncthreads();
            if (tid == 0) { int t = 0;
_Pragma("unroll 1")
 for (int e = 0; e < NE; ++e) { const int c = (int)__hip_atomic_load(ctl + CW_ECNT + L * 32 + e, RLX_AGENT); ecnt[e] = c; tpre[e] = t; ebase[e] = t * 256; t += (c + 255) >> 8; } tpre[NE] = t; }
            __syncthreads();
            LAS int* ul = (LAS int*)(lds + MISC_OFF + MO_ULIST);
            constexpr int EB = MOE_FP8 ? 1 : 2;
            pg8::build_units_moe(tid, ul, tpre, ebase, ecnt, 4, DM * EB, (unsigned)DM * DM * EB);
            pg8::EpiMoeDown E{ws, ap->in[I_BDN] + (size_t)L * NE * DM};
            pg8::gemm_phase<pg8::EpiMoeDown, false, true, MOE_FP8 != 0>(tid, lds, ul, (LAS int*)(lds + MISC_OFF + MO_GTAB), (const char*)(ws + WS_ACT), (const char*)(ws + WS_W_DN + (size_t)L * NE * DM * DM * EB), nullptr, DM * EB, E);
            GRID_BAR();
        } }
#endif
#if SITE(11)
        { KArgs ap = kargs(); const int tid = otid(); LAS unsigned char* lds = olds(lds0); (void)tid;
        if (IN(pb + 7)) for (int rep_ = 0; rep_ < REP(11); ++rep_) {
            const int lane = tid & 63, wave = __builtin_amdgcn_readfirstlane(tid >> 6), gw = VCU() * 8 + wave, NGW = gridDim.x * 8;
            unsigned char* ws = ap->ws; const float* X1F = (const float*)(ws + WS_X1F); const bf16* YS = (const bf16*)(ws + WS_YSLOT); bf16* XB = (bf16*)(ws + WS_XB); float* out = ap->out;
            const float* lg = ap->in[I_LNFG] + L * DM; const float* lbb = ap->in[I_LNFB] + L * DM;
            for (int row = gw; row < NTOK; row += NGW) {
                f32x4 x[4]; float s = 0.f;
#pragma unroll
                for (int q = 0; q < 4; ++q) { x[q] = *(const f32x4*)(X1F + (size_t)row * DM + 256 * q + 4 * lane) * DN_ALPHA;
#pragma unroll
                    for (int k = 0; k < 4; ++k) { const v2u w = *(const v2u*)(YS + ((size_t)row * 4 + k) * DM + 256 * q + 4 * lane); x[q][0] += bflo(w.x); x[q][1] += bfhi(w.x); x[q][2] += bflo(w.y); x[q][3] += bfhi(w.y); }
                    s += (x[q][0] + x[q][1]) + (x[q][2] + x[q][3]); }
                const float mu = wave_sum(s) * (1.0f / DM); float qq = 0.f;
#pragma unroll
                for (int q = 0; q < 4; ++q) { x[q] = x[q] - mu; qq += (x[q][0] * x[q][0] + x[q][1] * x[q][1]) + (x[q][2] * x[q][2] + x[q][3] * x[q][3]); }
                const float rs = 1.0f / sqrtf(wave_sum(qq) * (1.0f / DM) + LN_EPS);
#pragma unroll
                for (int q = 0; q < 4; ++q) { const f32x4 g = *(const f32x4*)(lg + 256 * q + 4 * lane), bb = *(const f32x4*)(lbb + 256 * q + 4 * lane); x[q] = x[q] * rs * g + bb;
                    *(f32x4*)(out + (size_t)row * DM + 256 * q + 4 * lane) = x[q];
                    v2u w; w.x = pk2(x[q][0], x[q][1]); w.y = pk2(x[q][2], x[q][3]); *(v2u*)(XB + (size_t)row * DM + 256 * q + 4 * lane) = w; }
            }
            if (L + 1 < DEPTH) GRID_BAR();
        } }
#endif
    }
#undef IN
#undef GRID_BAR
}

extern "C" void kernel_launch(void* const* d_in, const int* in_sizes, int n_in, void* d_out, int out_size, void* d_ws, size_t ws_size, hipStream_t stream) {
    static int grid = 0;
    if (grid == 0) {
        if (n_in != 17 || out_size != NTOK * DM || ws_size < WS_END) { fprintf(stderr, "kernel_launch: unexpected shapes (n_in %d, out %d, ws %zu < %zu)\n", n_in, out_size, ws_size, (size_t)WS_END); grid = -1; return; }
        int dev = 0, cus = 0, per_cu = 0;
        if (hipGetDevice(&dev) != hipSuccess || hipDeviceGetAttribute(&cus, hipDeviceAttributeMultiprocessorCount, dev) != hipSuccess) { grid = -1; return; }
        if (hipFuncSetAttribute((const void*)mk_fwd, hipFuncAttributeMaxDynamicSharedMemorySize, LDS_BYTES) != hipSuccess) { fprintf(stderr, "kernel_launch: hipFuncSetAttribute failed\n"); grid = -1; return; }
        if (hipOccupancyMaxActiveBlocksPerMultiprocessor(&per_cu, (const void*)mk_fwd, 512, LDS_BYTES) != hipSuccess || per_cu < 1) { fprintf(stderr, "kernel_launch: occupancy query says %d\n", per_cu); }
        (void)hipGetLastError();
        grid = cus;
    }
    if (grid < 0) return;
    (void)hipMemsetAsync((char*)d_ws + WS_CTL, 0, CTL_ZERO_BYTES, stream);
    Args a{};
    for (int i = 0; i < 17; ++i) a.in[i] = (const float*)d_in[i];
    a.out = (float*)d_out; a.ws = (unsigned char*)d_ws;
#if MK_MULTI
    for (int p = 0; p < 1 + 8 * DEPTH; ++p) { a.ph_lo = p; a.ph_hi = p + 1; hipLaunchKernelGGL(mk_fwd, dim3(grid), dim3(512), LDS_BYTES, stream, a); }
#else
    a.ph_lo = 0; a.ph_hi = 1 + 8 * DEPTH;
    hipLaunchKernelGGL(mk_fwd, dim3(grid), dim3(512), LDS_BYTES, stream, a);
#endif
}
```

```cpp
#include <hip/hip_runtime.h>
#include <cstdio>
#include <cstdint>

#ifndef MK_MULTI
#define MK_MULTI 0
#endif
#ifndef MOE_FP8
#define MOE_FP8 1
#endif
#ifndef SLOW_HGRN
#define SLOW_HGRN 0
#endif
#ifndef SLOW_RET
#define SLOW_RET 0
#endif

#define GAS __attribute__((address_space(1)))
#define LAS __attribute__((address_space(3)))
typedef unsigned short bf16;
typedef unsigned v4u __attribute__((ext_vector_type(4)));
typedef unsigned v2u __attribute__((ext_vector_type(2)));
typedef float f32x4 __attribute__((ext_vector_type(4)));
typedef float f32x2 __attribute__((ext_vector_type(2)));
typedef short bf16x8 __attribute__((ext_vector_type(8)));
typedef GAS unsigned gu32;

constexpr int DM = 1024, NBATCH = 16, SEQ = 2048, NTOK = NBATCH * SEQ, DEPTH = 4;
constexpr int NE = 32, TOPK = 4;
constexpr int HG_HEADS = 8, HG_K = 128;
constexpr int RT_HEADS = 4, RT_K = 256, RT_V = 512, RT_VD = 2048, RT_IN = 6144, HG_IN = 4096;
constexpr int ECAP = NTOK;
constexpr int MOE_ROWS = NTOK * TOPK + NE * 256;
constexpr float DN_ALPHA = 1.681792830507429f;
constexpr float LN_EPS = 1e-5f, RMS_EPS = 1e-6f;

constexpr size_t MiB = 1ull << 20;
constexpr size_t WS_CTL = 0, CTL_ZERO_BYTES = 1 * MiB;
constexpr size_t WS_LBS = 1 * MiB;
constexpr size_t WS_BGU = 2 * MiB;
constexpr size_t WS_ROT = 4 * MiB;
constexpr size_t WS_ROWDST = 8 * MiB;
constexpr size_t WS_ROWGATE = 12 * MiB;
constexpr size_t WS_W_HIN = 16 * MiB;
constexpr size_t WS_W_HOUT = WS_W_HIN + 16 * MiB;
constexpr size_t WS_W_RIN = WS_W_HOUT + 4 * MiB;
constexpr size_t WS_W_ROUT = WS_W_RIN + 24 * MiB;
constexpr size_t WS_W_GU = WS_W_ROUT + 8 * MiB;
constexpr size_t WS_W_DN = WS_W_GU + 512 * MiB;
constexpr size_t WS_XB = WS_W_DN + 256 * MiB;
constexpr size_t WS_H = WS_XB + 64 * MiB;
constexpr size_t WS_DEC = WS_H + 320 * MiB;
constexpr size_t WS_O = WS_H + 384 * MiB;
constexpr size_t WS_A2 = WS_O + 128 * MiB;
constexpr size_t WS_Y = WS_A2 + 128 * MiB;
constexpr size_t WS_X1F = WS_Y + 128 * MiB;
constexpr size_t WS_X1B = WS_X1F + 128 * MiB;
constexpr size_t WS_ACT = WS_X1B + 64 * MiB;
constexpr size_t WS_YSLOT = WS_ACT + 272 * MiB;
constexpr size_t WS_END = WS_YSLOT + 256 * MiB;

constexpr int CW_BAR = 4096;
constexpr int CW_ECNT = 16384;

constexpr int RING_BYTES = 131072;
constexpr int MISC_OFF = 135168;
constexpr int LDS_BYTES = 147456;
constexpr int MO_BARW = 0;
constexpr int MO_GTAB = 64;
constexpr int MO_TPRE = 64 + 2048;
constexpr int MO_EBASE = MO_TPRE + 160;
constexpr int MO_ECNT = MO_EBASE + 128;
constexpr int MO_LCNT = MO_ECNT + 128;
constexpr int MO_LBASE = MO_LCNT + 128;
constexpr int MO_SEL = MO_LBASE + 128;
constexpr int MO_SELW = MO_SEL + 2048;
constexpr int MO_RANK = MO_SELW + 2048;
constexpr int MO_ULIST = MO_RANK + 2048;
static_assert(MISC_OFF + MO_ULIST + 1024 <= LDS_BYTES, "LDS map");

#define RLX_AGENT __ATOMIC_RELAXED, __HIP_MEMORY_SCOPE_AGENT
#define LDS_WAIT() asm volatile("s_waitcnt lgkmcnt(0)" ::: "memory")
#define VM_WAIT() asm volatile("s_waitcnt vmcnt(0)" ::: "memory")

__device__ __forceinline__ unsigned f2bf(float f) { unsigned u = __builtin_bit_cast(unsigned, f); return (u + 0x7fffu + ((u >> 16) & 1u)) >> 16; }
__device__ __forceinline__ unsigned pk2(float lo, float hi) { return f2bf(lo) | (f2bf(hi) << 16); }
__device__ __forceinline__ unsigned cvt_pk_bf16(float lo, float hi) { unsigned r; asm volatile("v_cvt_pk_bf16_f32 %0, %1, %2" : "=v"(r) : "v"(lo), "v"(hi)); return r; }
#if MOE_FP8
constexpr float X_SCALE = 4.0f, WGU_SCALE = 64.0f, ACT_SCALE = 4.0f, WDN_SCALE = 128.0f;
constexpr float GU_DESCALE = 1.0f / (X_SCALE * WGU_SCALE), DN_DESCALE = 1.0f / (ACT_SCALE * WDN_SCALE);
#else
constexpr float GU_DESCALE = 1.0f, DN_DESCALE = 1.0f, ACT_SCALE = 1.0f;
#endif
__device__ __forceinline__ unsigned pk4_fp8(float a, float b, float c, float d) {
    a = __builtin_amdgcn_fmed3f(a, -448.0f, 448.0f); b = __builtin_amdgcn_fmed3f(b, -448.0f, 448.0f); c = __builtin_amdgcn_fmed3f(c, -448.0f, 448.0f); d = __builtin_amdgcn_fmed3f(d, -448.0f, 448.0f);
    int p = __builtin_amdgcn_cvt_pk_fp8_f32(a, b, 0, false); p = __builtin_amdgcn_cvt_pk_fp8_f32(c, d, p, true); return (unsigned)p; }
__device__ __forceinline__ float bflo(unsigned u) { return __builtin_bit_cast(float, u << 16); }
__device__ __forceinline__ float bfhi(unsigned u) { return __builtin_bit_cast(float, u & 0xffff0000u); }
__device__ __forceinline__ float bf1(bf16 b) { return __builtin_bit_cast(float, ((unsigned)b) << 16); }
__device__ __forceinline__ float fexp(float x) { return __builtin_amdgcn_exp2f(x * 1.4426950408889634f); }
__device__ __forceinline__ float frcp(float x) { return __builtin_amdgcn_rcpf(x); }
__device__ __forceinline__ float fsigmoid(float x) { return frcp(1.0f + fexp(-x)); }
__device__ __forceinline__ float wave_sum(float v) {
#pragma unroll
    for (int o = 1; o < 64; o <<= 1) v += __shfl_xor(v, o);
    return v;
}
__device__ __forceinline__ float wave_max(float v) {
#pragma unroll
    for (int o = 1; o < 64; o <<= 1) v = fmaxf(v, __shfl_xor(v, o));
    return v;
}

#define XB_TMO      128
#define XB_XCNT(j)  (256  + 64 * (j))
#define XB_XSUB(j)  (1280 + 64 * (j))
#define XB_XGEN(j)  (2304 + 64 * (j))
#define XB_TOP      3328
#define XB_TOPGEN   3392
#define XCD_BAR_WORDS 3456
#define XB_SPIN_CAP (1u << 22)

__device__ __forceinline__ unsigned xb_ld(unsigned* p)              { return __hip_atomic_load(p, __ATOMIC_RELAXED, __HIP_MEMORY_SCOPE_AGENT); }
__device__ __forceinline__ unsigned xb_add(unsigned* p, unsigned v) { return __hip_atomic_fetch_add(p, v, __ATOMIC_RELAXED, __HIP_MEMORY_SCOPE_AGENT); }
__device__ __forceinline__ unsigned xb_xcc_id() { return (unsigned)__builtin_amdgcn_s_getreg((3 << 11) | 20) & 0xFu; }
#define XB_SPIN(cond, bar) do { unsigned _sp = 0; while (cond) { __builtin_amdgcn_s_sleep(1); \
    if ((++_sp & 255u) == 0u) { if (xb_ld(&(bar)[XB_TMO])) break; if (_sp > XB_SPIN_CAP) { atomicAdd(&(bar)[XB_TMO], 1u); break; } } } } while (0)

struct XcdBarrier { unsigned* bar; unsigned x; volatile LAS unsigned* st; };

__device__ __forceinline__ XcdBarrier xcd_barrier_post(unsigned* bar, volatile LAS unsigned* st) {
    XcdBarrier b; b.bar = bar; b.x = xb_xcc_id(); b.st = st;
    if (threadIdx.x == 0) (void)xb_add(&bar[XB_XCNT(b.x)], 1u);
    return b;
}
__device__ __forceinline__ void xcd_barrier_complete(unsigned* bar, unsigned x, unsigned& nloc, unsigned& nx) {
    const unsigned G = gridDim.x * gridDim.y * gridDim.z;
    unsigned sum, cnt, mine, sp = 0u;
    for (;;) {
        sum = 0u; cnt = 0u; mine = 0u;
#pragma unroll
        for (unsigned j = 0; j < 16; ++j) { const unsigned c = xb_ld(&bar[XB_XCNT(j)]); sum += c; cnt += (c > 0u) ? 1u : 0u; mine = (j == x) ? c : mine; }
        if (sum == G) break;
        __builtin_amdgcn_s_sleep(1);
        if ((++sp & 255u) == 0u) { if (xb_ld(&bar[XB_TMO])) break; if (sp > XB_SPIN_CAP) { atomicAdd(&bar[XB_TMO], 1u); break; } }
    }
    nloc = mine > 0u ? mine : 1u; nx = cnt > 0u ? cnt : 1u;
}
__device__ __forceinline__ void xcd_barrier(const XcdBarrier& b) {
    asm volatile("s_waitcnt vmcnt(0)" ::: "memory");
    __syncthreads();
    if (threadIdx.x == 0) {
        unsigned* bar = b.bar;
        __builtin_amdgcn_s_waitcnt(0);
        unsigned nloc = b.st[0], nx = b.st[1];
        if (nloc == 0u) { xcd_barrier_complete(bar, b.x, nloc, nx); b.st[0] = nloc; b.st[1] = nx; }
        const unsigned old = xb_add(&bar[XB_XSUB(b.x)], 1u);
        const unsigned gen = old / nloc;
        if (old + 1u == (gen + 1u) * nloc) {
            __builtin_amdgcn_fence(__ATOMIC_RELEASE, "agent");
            asm volatile("s_waitcnt vmcnt(0)" ::: "memory");
            const unsigned og = xb_add(&bar[XB_TOP], 1u);
            const unsigned tg = og / nx;
            if (og + 1u == (tg + 1u) * nx) xb_add(&bar[XB_TOPGEN], 1u);
            else XB_SPIN(xb_ld(&bar[XB_TOPGEN]) == tg, bar);
            __builtin_amdgcn_fence(__ATOMIC_ACQUIRE, "agent");
            xb_add(&bar[XB_XGEN(b.x)], 1u);
            asm volatile("s_waitcnt vmcnt(0)" ::: "memory");
        } else {
            XB_SPIN(xb_ld(&bar[XB_XGEN(b.x)]) == gen, bar);
            __builtin_amdgcn_fence(__ATOMIC_ACQUIRE, "agent");
            asm volatile("s_waitcnt vmcnt(0)" ::: "memory");
        }
    }
    __syncthreads();
}

namespace pg8 {
constexpr int BM = 256, BK = 64, HALF = 128, HTB = HALF * BK * 2, STAGE_BYTES = 8 * HTB, NXCD = 8, WGM = 8, MAXU = 32;
__host__ __device__ __forceinline__ int lds_byte(int r, int c) { const int st = (r >> 4) * 2 + (c >> 5), rr = r & 15, cc = c & 31, ob = rr * 64 + cc * 2; return st * 1024 + (ob ^ (((ob >> 9) & 1) << 5)); }
__host__ __device__ __forceinline__ void stage_rc(int b, int& R, int& C) { const int st = b / 1024, sb = b % 1024, swz = sb ^ (((sb >> 9) & 1) << 5); R = (st >> 1) * 16 + swz / 64; C = (st & 1) * 32 + (swz % 64) / 2; }
__host__ __device__ __forceinline__ int perm32(int rho) { const int n = rho >> 4, i = rho & 15; return 8 * (i >> 2) + 4 * n + (i & 3); }

struct Unit { int pm, pn, e, rowbase, cnt; unsigned boff; int gidx; };

__device__ __forceinline__ bool tile_of(long L, int nM, int nN, int& gm, int& pn) {
    const int nwg = nM * nN; if (L >= nwg) return false;
    int wgid = (int)L; { const int q = nwg / NXCD, r = nwg % NXCD, xcd = wgid % NXCD, off = wgid / NXCD; wgid = (xcd < r ? xcd * (q + 1) : r * (q + 1) + (xcd - r) * q) + off; }
    const int nig = WGM * nN, gid = wgid / nig, fm = gid * WGM, gsz = (nM - fm) < WGM ? (nM - fm) : WGM;
    gm = fm + ((wgid % nig) % gsz); pn = (wgid % nig) / gsz; return true;
}
__device__ __forceinline__ void build_units_dense(const int i, LAS int* ul, int nM, int nN, int RB) {
    if (i < MAXU) { int gm = 0, pn = 0; const bool ok = tile_of((long)i * gridDim.x + blockIdx.x, nM, nN, gm, pn);
        ul[i * 8 + 0] = ok ? 1 : 0; ul[i * 8 + 1] = gm; ul[i * 8 + 2] = pn; ul[i * 8 + 3] = 0; ul[i * 8 + 4] = gm * BM; ul[i * 8 + 5] = BM; ul[i * 8 + 6] = (int)((unsigned)pn * BM * (unsigned)RB); ul[i * 8 + 7] = 0; }
    __syncthreads();
}
__device__ __forceinline__ void build_units_moe(const int i, LAS int* ul, const LAS int* tpre, const LAS int* ebase, const LAS int* ecnt, int nN, int RB, unsigned wstride) {
    if (i < MAXU) { int gm = 0, pn = 0; const bool ok = tile_of((long)i * gridDim.x + blockIdx.x, tpre[NE], nN, gm, pn);
        int e = 0;
_Pragma("unroll 1")
        for (int s = 16; s >= 1; s >>= 1) { if (e + s < NE && tpre[e + s] <= gm) e += s; }
        const int pm = gm - tpre[e];
        ul[i * 8 + 0] = ok ? 1 : 0; ul[i * 8 + 1] = pm; ul[i * 8 + 2] = pn; ul[i * 8 + 3] = e; ul[i * 8 + 4] = ebase[e] + pm * BM; ul[i * 8 + 5] = ecnt[e] - pm * BM;
        ul[i * 8 + 6] = (int)((unsigned)e * wstride + (unsigned)pn * BM * (unsigned)RB); ul[i * 8 + 7] = e * ECAP + pm * BM; }
    __syncthreads();
}
__device__ __forceinline__ bool ld_unit(const LAS int* ul, int i, Unit& u) {
    if (i >= MAXU) return false;
    const LAS int* p = ul + i * 8;
    if (__builtin_amdgcn_readfirstlane(p[0]) == 0) return false;
    u.pm = __builtin_amdgcn_readfirstlane(p[1]); u.pn = __builtin_amdgcn_readfirstlane(p[2]); u.e = __builtin_amdgcn_readfirstlane(p[3]); u.rowbase = __builtin_amdgcn_readfirstlane(p[4]);
    u.cnt = __builtin_amdgcn_readfirstlane(p[5]); u.boff = (unsigned)__builtin_amdgcn_readfirstlane(p[6]); u.gidx = __builtin_amdgcn_readfirstlane(p[7]); return true;
}
__device__ __forceinline__ void glds16(const char* sbase, unsigned voff, LAS unsigned char* dst) {
    asm volatile("" : "+s"(sbase));
    __builtin_amdgcn_global_load_lds((const unsigned*)(sbase + voff), (LAS unsigned*)dst, 16, 0, 0);
}
template <bool GATHER> __device__ __forceinline__ void stage_a(LAS unsigned char* dst, const char* sbase, unsigned o0, unsigned o1, size_t r64) {
    glds16(sbase, o0, dst);
    if constexpr (GATHER) glds16(sbase, o1, dst + 8192);
    else glds16(sbase + r64, o0, dst + 8192);
}

typedef int v8i __attribute__((ext_vector_type(8)));
typedef int v4i __attribute__((ext_vector_type(4)));
__device__ __forceinline__ v8i cat_frag(const bf16x8& a, const bf16x8& b) { return __builtin_shufflevector(__builtin_bit_cast(v4i, a), __builtin_bit_cast(v4i, b), 0, 1, 2, 3, 4, 5, 6, 7); }
template <class Epi, bool GATHER, bool ALIGN_EPI, bool FP8>
__device__ __forceinline__ void gemm_phase(const int tid, LAS unsigned char* lds, const LAS int* ul, LAS int* gtab, const char* Abase, const char* Bbase, const int* rowdst, const int RB, const Epi& E) {
    const int wid = __builtin_amdgcn_readfirstlane(tid >> 6), lane = tid & 63, wr = wid >> 2, wc = wid & 3, fr = lane & 15, fq = lane >> 4;
    const int nt = RB / 128;
    int R0, C0; stage_rc(tid * 16, R0, C0);
    const int Rb0 = Epi::PERM ? ((R0 & ~31) + perm32(R0 & 31)) : R0;
    const unsigned voffB = (unsigned)(Rb0 * RB + C0 * 2);
    const unsigned cb0 = (unsigned)C0 * 2u, K2 = (unsigned)RB;
    const size_t kstep = (size_t)128;
    const size_t r64 = (size_t)64 * RB;
    const size_t hstep = (size_t)HALF * RB;
    const unsigned ldsw = (unsigned)wid * 1024u;
    const int aoff = lds_byte(wr * 64 + fr, fq * 8), boff = lds_byte(wc * 32 + fr, fq * 8);
#define PG8_SA(b, h) (((b) * 2 + (h)) * HTB)
#define PG8_SB(b, h) ((4 + (b) * 2 + (h)) * HTB)
#define PG8_STAGE(bufoff, gbase) do { glds16((const char*)(gbase), voffB, lds + (bufoff) + ldsw); glds16((const char*)(gbase) + r64, voffB, lds + (bufoff) + ldsw + 8192); } while (0)
#define PG8_STAGEA0(bufoff, kb, o0, o1) stage_a<GATHER>(lds + (bufoff) + ldsw, Abase + (kb), o0, o1, r64)
#define PG8_STAGEA1(bufoff, kb, o0, o2, o3) stage_a<GATHER>(lds + (bufoff) + ldsw, Abase + (kb) + (GATHER ? (size_t)0 : hstep), GATHER ? (o2) : (o0), o3, r64)
#define PG8_LDA(dst, b, h) do { _Pragma("unroll") for (int m = 0; m < 4; ++m) { const v4i _l = *(const LAS v4i*)(lds + PG8_SA(b, h) + aoff + m * 2048), _h = *(const LAS v4i*)(lds + PG8_SA(b, h) + aoff + m * 2048 + 1024); dst[m] = __builtin_shufflevector(_l, _h, 0, 1, 2, 3, 4, 5, 6, 7); } } while (0)
#define PG8_LDB(dst, b, h) do { _Pragma("unroll") for (int n = 0; n < 2; ++n) { const v4i _l = *(const LAS v4i*)(lds + PG8_SB(b, h) + boff + n * 2048), _h = *(const LAS v4i*)(lds + PG8_SB(b, h) + boff + n * 2048 + 1024); dst[n] = __builtin_shufflevector(_l, _h, 0, 1, 2, 3, 4, 5, 6, 7); } } while (0)
#define PG8_LO(x) __builtin_bit_cast(bf16x8, __builtin_shufflevector(x, x, 0, 1, 2, 3))
#define PG8_HI(x) __builtin_bit_cast(bf16x8, __builtin_shufflevector(x, x, 4, 5, 6, 7))
#define PG8_MMA(ai, bj, At, Bt) do { __builtin_amdgcn_s_setprio(1); _Pragma("unroll") for (int m = 0; m < 4; ++m) _Pragma("unroll") for (int n = 0; n < 2; ++n) { \
        if constexpr (FP8) asm volatile("v_mfma_scale_f32_16x16x128_f8f6f4 %0, %1, %2, %0, %3, %3 op_sel_hi:[0,0,0]" : "+v"(acc[ai][bj][m][n]) : "v"(Bt[n]), "v"(At[m]), "v"(sc1)); \
        else { acc[ai][bj][m][n] = __builtin_amdgcn_mfma_f32_16x16x32_bf16(PG8_LO(Bt[n]), PG8_LO(At[m]), acc[ai][bj][m][n], 0, 0, 0); \
               acc[ai][bj][m][n] = __builtin_amdgcn_mfma_f32_16x16x32_bf16(PG8_HI(Bt[n]), PG8_HI(At[m]), acc[ai][bj][m][n], 0, 0, 0); } } \
        __builtin_amdgcn_s_setprio(0); } while (0)
#define PG8_WAIT_V(n) asm volatile("s_waitcnt vmcnt(" #n ")" ::: "memory")
#define PG8_WAIT_L(n) asm volatile("s_waitcnt lgkmcnt(" #n ")" ::: "memory")
#define PG8_BAR __builtin_amdgcn_s_barrier()
#define PG8_SCHED __builtin_amdgcn_sched_barrier(0)
    Unit cur, nxt; int ui = 0;
    if (!ld_unit(ul, 0, cur)) return;
    f32x4 acc[2][2][4][2];
#pragma unroll
    for (int a = 0; a < 2; ++a)
#pragma unroll
        for (int b = 0; b < 2; ++b)
#pragma unroll
            for (int m = 0; m < 4; ++m)
#pragma unroll
                for (int n = 0; n < 2; ++n) acc[a][b][m][n] = (f32x4){0.f, 0.f, 0.f, 0.f};
    v8i At[4], B0[2], B1[2];
    const int sc1 = 0x7f7f7f7f;
    unsigned oA0, oA1 = 0, oA2 = 0, oA3 = 0, oN0, oN1 = 0, oN2 = 0, oN3 = 0;
    if constexpr (GATHER) {
        const int c1 = cur.cnt - 1; const int* gp = rowdst + cur.gidx;
        oA0 = ((unsigned)gp[min(R0, c1)] >> 2) * K2 + cb0; oA1 = ((unsigned)gp[min(R0 + 64, c1)] >> 2) * K2 + cb0; oA2 = ((unsigned)gp[min(R0 + 128, c1)] >> 2) * K2 + cb0; oA3 = ((unsigned)gp[min(R0 + 192, c1)] >> 2) * K2 + cb0;
    } else {
        oA0 = (unsigned)(cur.rowbase + R0) * K2 + cb0;
    }
    oN0 = oA0; oN1 = oA1; oN2 = oA2; oN3 = oA3;
    const char* cB = Bbase + cur.boff;
    PG8_STAGE(PG8_SB(0, 0), cB); PG8_STAGE(PG8_SB(0, 1), cB + hstep); PG8_STAGEA0(PG8_SA(0, 0), (size_t)0, oA0, oA1); PG8_STAGEA1(PG8_SA(0, 1), (size_t)0, oA0, oA2, oA3);
    if (wr == 1) PG8_BAR;
    PG8_WAIT_V(2); PG8_BAR;
    PG8_STAGE(PG8_SB(1, 0), cB + kstep); PG8_STAGEA0(PG8_SA(1, 0), kstep, oA0, oA1); PG8_STAGE(PG8_SB(1, 1), cB + hstep + kstep);
    PG8_WAIT_V(6); PG8_BAR;
    for (;;) {
        const bool has_next = ld_unit(ul, ui + 1, nxt);
        const char* nB = has_next ? Bbase + nxt.boff : cB;
        if constexpr (GATHER) {
            if (has_next && tid < 256) gtab[tid] = (int)((unsigned)rowdst[nxt.gidx + min(tid, nxt.cnt - 1)] >> 2);
        }
_Pragma("unroll 1")
        for (int t = 0; t < nt; t += 2) {
            const bool last = (t == nt - 2);
            if (last && has_next) {
                if constexpr (GATHER) {
                    oN0 = (unsigned)gtab[R0] * K2 + cb0; oN1 = (unsigned)gtab[R0 + 64] * K2 + cb0; oN2 = (unsigned)gtab[R0 + 128] * K2 + cb0; oN3 = (unsigned)gtab[R0 + 192] * K2 + cb0;
                } else {
                    oN0 = (unsigned)(nxt.rowbase + R0) * K2 + cb0;
                }
            }
            const size_t kb1 = (size_t)(t + 1) * kstep;
            const size_t kb2 = last ? (size_t)0 : (size_t)(t + 2) * kstep, kb3 = kb2 + kstep;
            const unsigned p0 = last ? oN0 : oA0, p1 = last ? oN1 : oA1, p2 = last ? oN2 : oA2, p3 = last ? oN3 : oA3;
            const char* b2 = last ? nB : cB + (size_t)(t + 2) * kstep; const char* b3 = b2 + kstep;
            PG8_LDB(B0, 0, 0); PG8_LDB(B1, 0, 1); PG8_SCHED; PG8_LDA(At, 0, 0); PG8_STAGEA1(PG8_SA(1, 1), kb1, oA0, oA2, oA3);
            PG8_WAIT_V(8); PG8_WAIT_L(0); PG8_BAR; PG8_MMA(0, 0, At, B0); PG8_MMA(0, 1, At, B1); PG8_BAR; PG8_SCHED;
            PG8_LDA(At, 0, 1); PG8_STAGE(PG8_SB(0, 0), b2); PG8_STAGE(PG8_SB(0, 1), b2 + hstep); PG8_STAGEA0(PG8_SA(0, 0), kb2, p0, p1);
            PG8_WAIT_V(8); PG8_WAIT_L(0); PG8_BAR; PG8_MMA(1, 0, At, B0); PG8_MMA(1, 1, At, B1); PG8_BAR; PG8_SCHED;
            PG8_LDB(B0, 1, 0); PG8_LDB(B1, 1, 1); PG8_SCHED; PG8_LDA(At, 1, 0); PG8_STAGEA1(PG8_SA(0, 1), kb2, p0, p2, p3);
            PG8_WAIT_V(8); PG8_WAIT_L(0); PG8_BAR; PG8_MMA(0, 0, At, B0); PG8_MMA(0, 1, At, B1); PG8_BAR; PG8_SCHED;
            PG8_LDA(At, 1, 1); PG8_STAGE(PG8_SB(1, 0), b3); PG8_STAGE(PG8_SB(1, 1), b3 + hstep); PG8_STAGEA0(PG8_SA(1, 0), kb3, p0, p1);
            PG8_WAIT_V(8); PG8_WAIT_L(0); PG8_BAR; PG8_MMA(1, 0, At, B0); PG8_MMA(1, 1, At, B1); PG8_BAR; PG8_SCHED;
        }
        if constexpr (FP8) asm volatile("s_nop 7\n\ts_nop 7\n\ts_nop 7" ::: "memory");
        if constexpr (ALIGN_EPI) { if (wr == 0) PG8_BAR; }
        E(acc, cur, wr, wc, fr, fq);
        if (!has_next) break;
#pragma unroll
        for (int a = 0; a < 2; ++a)
#pragma unroll
            for (int b = 0; b < 2; ++b)
#pragma unroll
                for (int m = 0; m < 4; ++m)
#pragma unroll
                    for (int n = 0; n < 2; ++n) acc[a][b][m][n] = (f32x4){0.f, 0.f, 0.f, 0.f};
        cur = nxt; cB = nB; oA0 = oN0; oA1 = oN1; oA2 = oN2; oA3 = oN3; ++ui;
        if constexpr (ALIGN_EPI) { if (wr == 1) PG8_BAR; }
    }
    PG8_WAIT_V(0);
    if constexpr (!ALIGN_EPI) { if (wr == 0) PG8_BAR; }
    PG8_BAR;
#undef PG8_SA
#undef PG8_SB
#undef PG8_STAGE
#undef PG8_STAGEA0
#undef PG8_STAGEA1
#undef PG8_LDA
#undef PG8_LDB
#undef PG8_LO
#undef PG8_HI
#undef PG8_MMA
#undef PG8_WAIT_V
#undef PG8_WAIT_L
#undef PG8_BAR
#undef PG8_SCHED
}

__device__ __forceinline__ GAS unsigned char* launder(unsigned char* p) { asm volatile("" : "+s"(p)); return (GAS unsigned char*)p; }
#define OPAQUE_LANE(fr, fq) asm volatile("" : "+v"(fr), "+v"(fq))
struct EpiHgrnIn {
    static constexpr bool PERM = true;
    unsigned char* ws0; int L;
    __device__ __forceinline__ void operator()(const f32x4 (&acc)[2][2][4][2], const Unit& u, int wr, int wc, int fr, int fq) const {
        OPAQUE_LANE(fr, fq);
        GAS unsigned char* ws = launder(ws0);
        GAS bf16* QD = (GAS bf16*)(ws + WS_H);
        const int row0 = u.rowbase + wr * 64 + fr;
        if (u.pn >= 8) {
            const bool isg = u.pn >= 12; GAS bf16* base = QD + (size_t)(isg ? 4 : 3) * NTOK * DM; const int colt = (u.pn - (isg ? 12 : 8)) * BM + wc * 32 + 8 * fq;
#pragma unroll
            for (int ai = 0; ai < 2; ++ai)
#pragma unroll
                for (int m = 0; m < 4; ++m) { GAS bf16* rowp = base + (size_t)(row0 + ai * HALF + m * 16) * DM + colt;
#pragma unroll
                    for (int bj = 0; bj < 2; ++bj) { f32x4 v0 = acc[ai][bj][m][0], v1 = acc[ai][bj][m][1];
                        if (isg) {
#pragma unroll
                            for (int j = 0; j < 4; ++j) { v0[j] = v0[j] * fsigmoid(v0[j]); v1[j] = v1[j] * fsigmoid(v1[j]); } }
                        v4u w; w.x = cvt_pk_bf16(v0[0], v0[1]); w.y = cvt_pk_bf16(v0[2], v0[3]); w.z = cvt_pk_bf16(v1[0], v1[1]); w.w = cvt_pk_bf16(v1[2], v1[3]);
                        *(GAS v4u*)(rowp + bj * HALF) = w; } }
            return;
        }
        const int col = u.pn * HG_K + wc * 32 + 8 * fq;
        const GAS float* lb = (const GAS float*)(ws + WS_LBS) + L * DM;
        const f32x4 lb0 = *(const GAS f32x4*)(lb + col), lb1 = *(const GAS f32x4*)(lb + col + 4);
#if !SLOW_HGRN
        const int lane = fq * 16 + fr;
        GAS float* DEC = (GAS float*)(ws + WS_DEC);
#endif
#pragma unroll
        for (int ai = 0; ai < 2; ++ai)
#pragma unroll
            for (int m = 0; m < 4; ++m) {
                const int row = row0 + ai * HALF + m * 16;
                float qd[8], ki[8], ks[8];
#if !SLOW_HGRN
                float de[8];
#endif
#pragma unroll
                for (int j = 0; j < 8; ++j) {
                    const float q = acc[ai][0][m][j >> 2][j & 3], f = acc[ai][1][m][j >> 2][j & 3], lbv = j < 4 ? lb0[j & 3] : lb1[j & 3];
                    const float sg = fsigmoid(f), fg = lbv + (1.0f - lbv) * sg, kk = (1.0f - lbv) * (1.0f - sg);
#if SLOW_HGRN
                    qd[j] = q * fsigmoid(q); ki[j] = kk; ks[j] = fg;
#else
                    float b = __builtin_amdgcn_logf(fg) * 0.6931471805599453f;
                    b += __builtin_bit_cast(float, __builtin_amdgcn_update_dpp(0, __builtin_bit_cast(int, b), 0x111, 0xf, 0xf, true));
                    b += __builtin_bit_cast(float, __builtin_amdgcn_update_dpp(0, __builtin_bit_cast(int, b), 0x112, 0xf, 0xf, true));
                    b += __builtin_bit_cast(float, __builtin_amdgcn_update_dpp(0, __builtin_bit_cast(int, b), 0x114, 0xf, 0xf, true));
                    b += __builtin_bit_cast(float, __builtin_amdgcn_update_dpp(0, __builtin_bit_cast(int, b), 0x118, 0xf, 0xf, true));
                    const float bl = __shfl(b, lane | 15);
                    qd[j] = q * fsigmoid(q) * fexp(b); ki[j] = kk * fexp(-b); ks[j] = kk * fexp(bl - b); de[j] = fexp(bl);
#endif
                }
                const size_t o = (size_t)row * DM + col;
                v4u w;
                w.x = cvt_pk_bf16(qd[0], qd[1]); w.y = cvt_pk_bf16(qd[2], qd[3]); w.z = cvt_pk_bf16(qd[4], qd[5]); w.w = cvt_pk_bf16(qd[6], qd[7]); *(GAS v4u*)(QD + o) = w;
                w.x = cvt_pk_bf16(ki[0], ki[1]); w.y = cvt_pk_bf16(ki[2], ki[3]); w.z = cvt_pk_bf16(ki[4], ki[5]); w.w = cvt_pk_bf16(ki[6], ki[7]); *(GAS v4u*)(QD + (size_t)NTOK * DM + o) = w;
                w.x = cvt_pk_bf16(ks[0], ks[1]); w.y = cvt_pk_bf16(ks[2], ks[3]); w.z = cvt_pk_bf16(ks[4], ks[5]); w.w = cvt_pk_bf16(ks[6], ks[7]); *(GAS v4u*)(QD + 2 * (size_t)NTOK * DM + o) = w;
#if !SLOW_HGRN
                if (fr == 0) { GAS float* dp = DEC + (size_t)(row >> 4) * DM + col; *(GAS f32x4*)dp = (f32x4){de[0], de[1], de[2], de[3]}; *(GAS f32x4*)(dp + 4) = (f32x4){de[4], de[5], de[6], de[7]}; }
#endif
            }
    }
};
struct EpiRetIn {
    static constexpr bool PERM = true;
    unsigned char* ws0;
    __device__ __forceinline__ void operator()(const f32x4 (&acc)[2][2][4][2], const Unit& u, int wr, int wc, int fr, int fq) const {
        OPAQUE_LANE(fr, fq);
        GAS unsigned char* ws = launder(ws0);
        GAS bf16* H = (GAS bf16*)(ws + WS_H); const GAS float* rot = (const GAS float*)(ws + WS_ROT);
        const int row0 = u.rowbase + wr * 64 + fr; const int colt = u.pn * BM + wc * 32 + 8 * fq;
        const int kind = u.pn < 4 ? 0 : (u.pn < 8 ? 1 : (u.pn < 16 ? 2 : 3));
#pragma unroll
        for (int ai = 0; ai < 2; ++ai)
#pragma unroll
            for (int m = 0; m < 4; ++m) { const int row = row0 + ai * HALF + m * 16; GAS bf16* rowp = H + (size_t)row * RT_IN + colt; const int pos = row & (SEQ - 1);
#pragma unroll
                for (int bj = 0; bj < 2; ++bj) { f32x4 v0 = acc[ai][bj][m][0], v1 = acc[ai][bj][m][1];
                    if (kind <= 1) {
                        const int p0 = (bj * HALF + wc * 32 + 8 * fq) >> 1;
                        const GAS float* rp = rot + ((size_t)pos * 128 + p0) * 2;
                        const f32x4 r0 = *(const GAS f32x4*)rp, r1 = *(const GAS f32x4*)(rp + 4);
                        const float sc = kind == 1 ? 0.0625f : 1.0f;
                        f32x4 o0, o1;
                        o0[0] = (v0[0] * r0[0] - v0[1] * r0[1]) * sc; o0[1] = (v0[1] * r0[0] + v0[0] * r0[1]) * sc;
                        o0[2] = (v0[2] * r0[2] - v0[3] * r0[3]) * sc; o0[3] = (v0[3] * r0[2] + v0[2] * r0[3]) * sc;
                        o1[0] = (v1[0] * r1[0] - v1[1] * r1[1]) * sc; o1[1] = (v1[1] * r1[0] + v1[0] * r1[1]) * sc;
                        o1[2] = (v1[2] * r1[2] - v1[3] * r1[3]) * sc; o1[3] = (v1[3] * r1[2] + v1[2] * r1[3]) * sc;
                        v0 = o0; v1 = o1;
                    } else if (kind == 3) {
#pragma unroll
                        for (int j = 0; j < 4; ++j) { v0[j] = v0[j] * fsigmoid(v0[j]); v1[j] = v1[j] * fsigmoid(v1[j]); }
                    }
                    v4u w; w.x = cvt_pk_bf16(v0[0], v0[1]); w.y = cvt_pk_bf16(v0[2], v0[3]); w.z = cvt_pk_bf16(v1[0], v1[1]); w.w = cvt_pk_bf16(v1[2], v1[3]);
                    *(GAS v4u*)(rowp + bj * HALF) = w; } }
    }
};
struct EpiRes {
    static constexpr bool PERM = true;
    unsigned char* ws0;
    __device__ __forceinline__ void operator()(const f32x4 (&acc)[2][2][4][2], const Unit& u, int wr, int wc, int fr, int fq) const {
        OPAQUE_LANE(fr, fq);
        GAS unsigned char* ws = launder(ws0);
        GAS bf16* Y = (GAS bf16*)(ws + WS_Y); const GAS bf16* X = (const GAS bf16*)(ws + WS_XB);
        const int row0 = u.rowbase + wr * 64 + fr, col0 = u.pn * BM + wc * 32 + 8 * fq;
#pragma unroll
        for (int ai = 0; ai < 2; ++ai)
#pragma unroll
            for (int m = 0; m < 4; ++m) { const size_t off = (size_t)(row0 + ai * HALF + m * 16) * DM + col0;
#pragma unroll
                for (int bj = 0; bj < 2; ++bj) { const v4u xs = *(const GAS v4u*)(X + off + bj * HALF); const f32x4 a0 = acc[ai][bj][m][0], a1 = acc[ai][bj][m][1];
                    v4u w; w.x = cvt_pk_bf16(bflo(xs.x) * DN_ALPHA + a0[0], bfhi(xs.x) * DN_ALPHA + a0[1]); w.y = cvt_pk_bf16(bflo(xs.y) * DN_ALPHA + a0[2], bfhi(xs.y) * DN_ALPHA + a0[3]);
                    w.z = cvt_pk_bf16(bflo(xs.z) * DN_ALPHA + a1[0], bfhi(xs.z) * DN_ALPHA + a1[1]); w.w = cvt_pk_bf16(bflo(xs.w) * DN_ALPHA + a1[2], bfhi(xs.w) * DN_ALPHA + a1[3]);
                    *(GAS v4u*)(Y + off + bj * HALF) = w; } }
    }
};
struct EpiMoeGU {
    static constexpr bool PERM = true;
    unsigned char* ws0; int L;
    __device__ __forceinline__ void operator()(const f32x4 (&acc)[2][2][4][2], const Unit& u, int wr, int wc, int fr, int fq) const {
        OPAQUE_LANE(fr, fq);
        GAS unsigned char* ws = launder(ws0);
        const GAS float* bias = (const GAS float*)(ws + WS_BGU) + (size_t)L * NE * 2048;
        const int row0 = u.rowbase + wr * 64 + fr; const int c8 = wc * 32 + 8 * fq;
        const GAS float* bp = bias + ((size_t)u.e * 8 + u.pn) * 256 + c8;
        const f32x4 bg0 = *(const GAS f32x4*)bp, bg1 = *(const GAS f32x4*)(bp + 4), bl0 = *(const GAS f32x4*)(bp + HALF), bl1 = *(const GAS f32x4*)(bp + HALF + 4);
#pragma unroll
        for (int ai = 0; ai < 2; ++ai)
#pragma unroll
            for (int m = 0; m < 4; ++m) { const size_t eo = (size_t)(row0 + ai * HALF + m * 16) * DM + u.pn * HALF + c8;
                float a[8];
#pragma unroll
                for (int j = 0; j < 8; ++j) {
                    float g = acc[ai][0][m][j >> 2][j & 3] * GU_DESCALE + (j < 4 ? bg0[j & 3] : bg1[j & 3]);
                    float l = acc[ai][1][m][j >> 2][j & 3] * GU_DESCALE + (j < 4 ? bl0[j & 3] : bl1[j & 3]);
                    g = fminf(g, 7.0f); l = fminf(fmaxf(l, -7.0f), 7.0f);
                    a[j] = g * fsigmoid(1.702f * g) * (l + 1.0f);
                }
#if MOE_FP8
                v2u w; w.x = pk4_fp8(a[0] * ACT_SCALE, a[1] * ACT_SCALE, a[2] * ACT_SCALE, a[3] * ACT_SCALE); w.y = pk4_fp8(a[4] * ACT_SCALE, a[5] * ACT_SCALE, a[6] * ACT_SCALE, a[7] * ACT_SCALE);
                *(GAS v2u*)(ws + WS_ACT + eo) = w;
#else
                v4u w; w.x = cvt_pk_bf16(a[0], a[1]); w.y = cvt_pk_bf16(a[2], a[3]); w.z = cvt_pk_bf16(a[4], a[5]); w.w = cvt_pk_bf16(a[6], a[7]);
                *(GAS v4u*)((GAS bf16*)(ws + WS_ACT) + eo) = w;
#endif
            }
    }
};
struct EpiMoeDown {
    static constexpr bool PERM = true;
    unsigned char* ws0; const float* bias;
    __device__ __forceinline__ void operator()(const f32x4 (&acc)[2][2][4][2], const Unit& u, int wr, int wc, int fr, int fq) const {
        OPAQUE_LANE(fr, fq);
        GAS unsigned char* ws = launder(ws0);
        GAS bf16* YS = (GAS bf16*)(ws + WS_YSLOT); const GAS int* rowdst = (const GAS int*)(ws + WS_ROWDST); const GAS float* rowgate = (const GAS float*)(ws + WS_ROWGATE);
        const int c8 = u.pn * BM + wc * 32 + 8 * fq;
        const GAS float* bp = (const GAS float*)bias + (size_t)u.e * DM + c8;
        f32x4 bv[2][2];
#pragma unroll
        for (int bj = 0; bj < 2; ++bj) { bv[bj][0] = *(const GAS f32x4*)(bp + bj * HALF); bv[bj][1] = *(const GAS f32x4*)(bp + bj * HALF + 4); }
#pragma unroll
        for (int ai = 0; ai < 2; ++ai)
#pragma unroll
            for (int m = 0; m < 4; ++m) { const int r = ai * HALF + wr * 64 + m * 16 + fr;
                if (r < u.cnt) {
                    const size_t ti = (size_t)u.gidx + r; const int dst = rowdst[ti]; const float gt = rowgate[ti];
                    GAS bf16* rowp = YS + (size_t)dst * DM + c8;
#pragma unroll
                    for (int bj = 0; bj < 2; ++bj) { const f32x4 v0 = (acc[ai][bj][m][0] * DN_DESCALE + bv[bj][0]) * gt, v1 = (acc[ai][bj][m][1] * DN_DESCALE + bv[bj][1]) * gt;
                        v4u w; w.x = cvt_pk_bf16(v0[0], v0[1]); w.y = cvt_pk_bf16(v0[2], v0[3]); w.z = cvt_pk_bf16(v1[0], v1[1]); w.w = cvt_pk_bf16(v1[2], v1[3]);
                        *(GAS v4u*)(rowp + bj * HALF) = w; } } }
    }
};
}

typedef short s16x4 __attribute__((ext_vector_type(4)));
typedef __bf16 bf16x2_t __attribute__((ext_vector_type(2)));
__device__ __forceinline__ unsigned cvtpk(float lo, float hi) { f32x2 v = {lo, hi}; bf16x2_t b = __builtin_convertvector(v, bf16x2_t); return __builtin_bit_cast(unsigned, b); }
__device__ __forceinline__ s16x4 tr_read(const LAS unsigned char* p) { return __builtin_bit_cast(s16x4, __builtin_amdgcn_ds_read_tr16_b64_v4i16((LAS s16x4*)p)); }
__device__ __forceinline__ bf16x8 cat8(s16x4 lo, s16x4 hi) { return __builtin_shufflevector(lo, hi, 0, 1, 2, 3, 4, 5, 6, 7); }
__device__ __forceinline__ bf16x8 pack8(const f32x4& a, const f32x4& b) { v4u p; p.x = cvtpk(a[0], a[1]); p.y = cvtpk(a[2], a[3]); p.z = cvtpk(b[0], b[1]); p.w = cvtpk(b[2], b[3]); return __builtin_bit_cast(bf16x8, p); }
__device__ __forceinline__ s16x4 pack4(const f32x4& a) { v2u p; p.x = cvtpk(a[0], a[1]); p.y = cvtpk(a[2], a[3]); return __builtin_bit_cast(s16x4, p); }
#define MFMA32(a, b, c) __builtin_amdgcn_mfma_f32_16x16x32_bf16((a), (b), (c), 0, 0, 0)
#define MFMA16(a, b, c) __builtin_amdgcn_mfma_f32_16x16x16bf16_1k((a), (b), (c), 0, 0, 0)

__device__ __forceinline__ void ret_fast(const int tid, LAS unsigned char* lds, const bf16* HB, bf16* OB) {
    constexpr int QP = 528, VP = 272, PP = 144;
    constexpr int OFF_Q = 0, OFF_K = 64 * QP, OFF_V = 2 * 64 * QP, OFF_P = OFF_V + 64 * VP;
    const int lane = tid & 63, w = __builtin_amdgcn_readfirstlane(tid >> 6), r = lane & 15, g = lane >> 4, q4 = (lane & 15) >> 2, p4 = lane & 3;
    const int prow = tid >> 3, pc = tid & 7;
    for (int un = blockIdx.x; un < NBATCH * RT_HEADS * 4; un += gridDim.x) {
        const int b = un >> 4, h = (un >> 2) & 3, vs = un & 3;
        const float l2g = __builtin_amdgcn_logf(1.0f - __builtin_amdgcn_exp2f(-5.0f - (float)h));
        const float dC = __builtin_amdgcn_exp2f(64.0f * l2g);
        f32x4 st[16];
#pragma unroll
        for (int i = 0; i < 16; ++i) st[i] = (f32x4){0.f, 0.f, 0.f, 0.f};
        const bf16* gbase = HB + (size_t)(b * SEQ + prow) * RT_IN;
        v4u pq[4], pk[4], pv[2];
#pragma unroll
        for (int j = 0; j < 4; ++j) { pq[j] = *(const v4u*)(gbase + h * 256 + (pc + 8 * j) * 8); pk[j] = *(const v4u*)(gbase + 1024 + h * 256 + (pc + 8 * j) * 8); }
#pragma unroll
        for (int j = 0; j < 2; ++j) pv[j] = *(const v4u*)(gbase + 2048 + h * 512 + vs * 128 + (pc + 8 * j) * 8);
#pragma unroll 1
        for (int ch = 0; ch < SEQ / 64; ++ch) {
            __syncthreads();
#pragma unroll
            for (int j = 0; j < 4; ++j) { *(LAS v4u*)(lds + OFF_Q + prow * QP + (pc + 8 * j) * 16) = pq[j]; *(LAS v4u*)(lds + OFF_K + prow * QP + (pc + 8 * j) * 16) = pk[j]; }
#pragma unroll
            for (int j = 0; j < 2; ++j) *(LAS v4u*)(lds + OFF_V + prow * VP + (pc + 8 * j) * 16) = pv[j];
            if (ch + 1 < SEQ / 64) {
                const bf16* gn = gbase + (size_t)(ch + 1) * 64 * RT_IN;
#pragma unroll
                for (int j = 0; j < 4; ++j) { pq[j] = *(const v4u*)(gn + h * 256 + (pc + 8 * j) * 8); pk[j] = *(const v4u*)(gn + 1024 + h * 256 + (pc + 8 * j) * 8); }
#pragma unroll
                for (int j = 0; j < 2; ++j) pv[j] = *(const v4u*)(gn + 2048 + h * 512 + vs * 128 + (pc + 8 * j) * 8);
            }
            __syncthreads();
            {
                const int ct = w >> 1, st0 = 2 * (w & 1);
                f32x4 sa0 = {0.f, 0.f, 0.f, 0.f}, sa1 = {0.f, 0.f, 0.f, 0.f};
                const LAS unsigned char* qb = lds + OFF_Q + (16 * ct + r) * QP + g * 16;
                const LAS unsigned char* kb0 = lds + OFF_K + (16 * st0 + r) * QP + g * 16;
#pragma unroll
                for (int kb = 0; kb < 8; ++kb) {
                    const bf16x8 qf = *(const LAS bf16x8*)(qb + kb * 64), k0 = *(const LAS bf16x8*)(kb0 + kb * 64), k1 = *(const LAS bf16x8*)(kb0 + 16 * QP + kb * 64);
                    sa0 = MFMA32(k0, qf, sa0); sa1 = MFMA32(k1, qf, sa1);
                }
                const int c = 16 * ct + r;
#pragma unroll
                for (int t = 0; t < 2; ++t) {
                    const f32x4 sa = t ? sa1 : sa0; const int s0 = 16 * (st0 + t) + 4 * g; float v[4];
#pragma unroll
                    for (int i = 0; i < 4; ++i) { const int d = c - (s0 + i); v[i] = d >= 0 ? sa[i] * __builtin_amdgcn_exp2f((float)d * l2g) : 0.f; }
                    v2u pw; pw.x = cvtpk(v[0], v[1]); pw.y = cvtpk(v[2], v[3]);
                    *(LAS v2u*)(lds + OFF_P + c * PP + s0 * 2) = pw;
                }
            }
            __syncthreads();
            f32x4 o[4];
#pragma unroll
            for (int ct = 0; ct < 4; ++ct) o[ct] = (f32x4){0.f, 0.f, 0.f, 0.f};
#pragma unroll
            for (int kb = 0; kb < 8; ++kb) {
                const bf16x8 sa = pack8(st[2 * kb], st[2 * kb + 1]);
#pragma unroll
                for (int ct = 0; ct < 4; ++ct) {
                    const LAS unsigned char* qp = lds + OFF_Q + (16 * ct + r) * QP + (32 * kb + 4 * g) * 2;
                    const s16x4 lo = *(const LAS s16x4*)qp, hi = *(const LAS s16x4*)(qp + 32);
                    o[ct] = MFMA32(sa, cat8(lo, hi), o[ct]);
                }
            }
#pragma unroll
            for (int ct = 0; ct < 4; ++ct) o[ct] = o[ct] * __builtin_amdgcn_exp2f((float)(16 * ct + r + 1) * l2g);
            bf16x8 vf[2];
#pragma unroll
            for (int sb = 0; sb < 2; ++sb) {
                const LAS unsigned char* vp = lds + OFF_V + (32 * sb + 8 * g + q4) * VP + (16 * w + 4 * p4) * 2;
                vf[sb] = cat8(tr_read(vp), tr_read(vp + 4 * VP));
            }
#pragma unroll
            for (int ct = 0; ct < 4; ++ct)
#pragma unroll
                for (int sb = 0; sb < 2; ++sb) if (sb <= (ct >> 1)) {
                    const bf16x8 pf = *(const LAS bf16x8*)(lds + OFF_P + (16 * ct + r) * PP + (32 * sb + 8 * g) * 2);
                    o[ct] = MFMA32(vf[sb], pf, o[ct]);
                }
            {
                bf16* ob = OB + (size_t)(b * SEQ + ch * 64 + r) * RT_VD + h * 512 + vs * 128 + 16 * w + 4 * g;
#pragma unroll
                for (int ct = 0; ct < 4; ++ct) { v2u ow; ow.x = cvtpk(o[ct][0], o[ct][1]); ow.y = cvtpk(o[ct][2], o[ct][3]); *(v2u*)(ob + (size_t)ct * 16 * RT_VD) = ow; }
            }
            bf16x8 vz[2];
#pragma unroll
            for (int sb = 0; sb < 2; ++sb) {
                const v4u raw = __builtin_bit_cast(v4u, vf[sb]); float f[8] = {bflo(raw.x), bfhi(raw.x), bflo(raw.y), bfhi(raw.y), bflo(raw.z), bfhi(raw.z), bflo(raw.w), bfhi(raw.w)};
#pragma unroll
                for (int j = 0; j < 8; ++j) f[j] *= __builtin_amdgcn_exp2f((float)(63 - (32 * sb + 8 * g + j)) * l2g);
                v4u z; z.x = cvtpk(f[0], f[1]); z.y = cvtpk(f[2], f[3]); z.z = cvtpk(f[4], f[5]); z.w = cvtpk(f[6], f[7]); vz[sb] = __builtin_bit_cast(bf16x8, z);
            }
#pragma unroll
            for (int kt = 0; kt < 16; ++kt) {
                st[kt] = st[kt] * dC;
#pragma unroll
                for (int sb = 0; sb < 2; ++sb) {
                    const LAS unsigned char* kp = lds + OFF_K + (32 * sb + 8 * g + q4) * QP + (16 * kt + 4 * p4) * 2;
                    st[kt] = MFMA32(cat8(tr_read(kp), tr_read(kp + 4 * QP)), vz[sb], st[kt]);
                }
            }
        }
        __syncthreads();
    }
}

__device__ __forceinline__ void hgrn_fast(const int tid, LAS unsigned char* lds, const bf16* QD, const bf16* KI, const bf16* KS, const bf16* VV, const float* DEC, bf16* OB) {
    constexpr int TP = 272;
    constexpr int OFF_QD = 0, OFF_KI = 64 * TP, OFF_KS = 2 * 64 * TP, OFF_V = 3 * 64 * TP, OFF_DEC = 4 * 64 * TP;
    const int lane = tid & 63, w = __builtin_amdgcn_readfirstlane(tid >> 6), r = lane & 15, g = lane >> 4, q4 = (lane & 15) >> 2, p4 = lane & 3;
    const int prow = tid >> 3, pc = tid & 7;
    for (int un = blockIdx.x; un < NBATCH * HG_HEADS; un += gridDim.x) {
        const int b = un >> 3, h = un & 7;
        f32x4 st[8];
#pragma unroll
        for (int i = 0; i < 8; ++i) st[i] = (f32x4){0.f, 0.f, 0.f, 0.f};
        const size_t goff = (size_t)(b * SEQ + prow) * DM + h * 128;
        v4u p0[2], p1[2], p2[2], p3[2]; f32x4 pd = {0.f, 0.f, 0.f, 0.f};
#pragma unroll
        for (int j = 0; j < 2; ++j) { const size_t o = goff + (pc + 8 * j) * 8; p0[j] = *(const v4u*)(QD + o); p1[j] = *(const v4u*)(KI + o); p2[j] = *(const v4u*)(KS + o); p3[j] = *(const v4u*)(VV + o); }
        if (tid < 128) pd = *(const f32x4*)(DEC + (size_t)((b * SEQ) / 16 + (tid >> 5)) * DM + h * 128 + (tid & 31) * 4);
#pragma unroll 1
        for (int rd = 0; rd < SEQ / 64; ++rd) {
            __syncthreads();
#pragma unroll
            for (int j = 0; j < 2; ++j) { const int lo = prow * TP + (pc + 8 * j) * 16; *(LAS v4u*)(lds + OFF_QD + lo) = p0[j]; *(LAS v4u*)(lds + OFF_KI + lo) = p1[j]; *(LAS v4u*)(lds + OFF_KS + lo) = p2[j]; *(LAS v4u*)(lds + OFF_V + lo) = p3[j]; }
            if (tid < 128) *(LAS f32x4*)(lds + OFF_DEC + tid * 16) = pd;
            if (rd + 1 < SEQ / 64) {
                const size_t gn = goff + (size_t)(rd + 1) * 64 * DM;
#pragma unroll
                for (int j = 0; j < 2; ++j) { const size_t o = gn + (pc + 8 * j) * 8; p0[j] = *(const v4u*)(QD + o); p1[j] = *(const v4u*)(KI + o); p2[j] = *(const v4u*)(KS + o); p3[j] = *(const v4u*)(VV + o); }
                if (tid < 128) pd = *(const f32x4*)(DEC + (size_t)((b * SEQ + (rd + 1) * 64) / 16 + (tid >> 5)) * DM + h * 128 + (tid & 31) * 4);
            }
            __syncthreads();
#pragma unroll 1
            for (int cc = 0; cc < 4; ++cc) {
                bf16x8 qf[4], kf[4];
#pragma unroll
                for (int kb = 0; kb < 4; ++kb) {
                    const int off = (16 * cc + r) * TP + (32 * kb + 4 * g) * 2;
                    qf[kb] = cat8(*(const LAS s16x4*)(lds + OFF_QD + off), *(const LAS s16x4*)(lds + OFF_QD + off + 32));
                    kf[kb] = cat8(*(const LAS s16x4*)(lds + OFF_KI + off), *(const LAS s16x4*)(lds + OFF_KI + off + 32));
                }
                f32x4 sc = {0.f, 0.f, 0.f, 0.f}, oa = {0.f, 0.f, 0.f, 0.f};
#pragma unroll
                for (int kb = 0; kb < 4; ++kb) sc = MFMA32(kf[kb], qf[kb], sc);
#pragma unroll
                for (int i = 0; i < 4; ++i) sc[i] = (4 * g + i <= r) ? sc[i] : 0.f;
                const s16x4 pf = pack4(sc);
#pragma unroll
                for (int kb = 0; kb < 4; ++kb) oa = MFMA32(pack8(st[2 * kb], st[2 * kb + 1]), qf[kb], oa);
                const s16x4 vfr = tr_read(lds + OFF_V + (16 * cc + 4 * g + q4) * TP + (16 * w + 4 * p4) * 2);
                oa = MFMA16(vfr, pf, oa);
                { v2u ow; ow.x = cvtpk(oa[0], oa[1]); ow.y = cvtpk(oa[2], oa[3]); *(v2u*)(OB + (size_t)(b * SEQ + rd * 64 + cc * 16 + r) * DM + h * 128 + 16 * w + 4 * g) = ow; }
#pragma unroll
                for (int kt = 0; kt < 8; ++kt) {
                    const f32x4 d4 = *(const LAS f32x4*)(lds + OFF_DEC + cc * 512 + (16 * kt + 4 * g) * 4);
                    const s16x4 ks = tr_read(lds + OFF_KS + (16 * cc + 4 * g + q4) * TP + (16 * kt + 4 * p4) * 2);
                    st[kt] = MFMA16(ks, vfr, st[kt] * d4);
                }
            }
        }
        __syncthreads();
    }
}

struct Args { const float* in[17]; float* out; unsigned char* ws; int ph_lo, ph_hi; };
enum { I_X = 0, I_HWIN, I_HNG, I_HWOUT, I_LB, I_RWIN, I_RWOUT, I_LNMG, I_LNMB, I_LNFG, I_LNFB, I_RW, I_RB, I_WGU, I_BGU, I_WDN, I_BDN };

__device__ __forceinline__ int dest_row(int mode, int n) {
    if (mode == 1) { if (n < 1024) return ((n >> 7) << 8) + (n & 127); if (n < 2048) { const int q = n - 1024; return ((q >> 7) << 8) + 128 + (q & 127); } return n; }
    if (mode == 2) { const int j2 = n >> 1; return ((j2 >> 7) << 8) + ((n & 1) << 7) + (j2 & 127); }
    return n;
}
__device__ __forceinline__ void transpose_item(const float* W, int K, int N, bf16* WT, int mode, LAS float* scr, int item, int lane) {
    const int nblk = N / 64, kb = item / nblk, nb = item % nblk, k0 = 64 * kb, n0 = 64 * nb;
#pragma unroll 4
    for (int i = 0; i < 16; ++i) { const int kk = 4 * i + (lane >> 4), c4 = (lane & 15) * 4;
        const f32x4 v = *(const GAS f32x4*)(W + (size_t)(k0 + kk) * N + n0 + c4);
        LAS float* s = scr + kk * 65 + c4; s[0] = v[0]; s[1] = v[1]; s[2] = v[2]; s[3] = v[3]; }
    LDS_WAIT(); asm volatile("" ::: "memory");
    const int c = lane & 7;
#pragma unroll 2
    for (int j = 0; j < 8; ++j) { const int n = (lane >> 3) + 8 * j; const LAS float* s = scr + (8 * c) * 65 + n;
        v4u o; o.x = pk2(s[0 * 65], s[1 * 65]); o.y = pk2(s[2 * 65], s[3 * 65]); o.z = pk2(s[4 * 65], s[5 * 65]); o.w = pk2(s[6 * 65], s[7 * 65]);
        *(GAS v4u*)(WT + (size_t)dest_row(mode, n0 + n) * K + k0 + 8 * c) = o; }
    LDS_WAIT(); asm volatile("" ::: "memory");
}

__device__ __forceinline__ void transpose_item_fp8(const float* W, int K, int N, unsigned char* WT, int mode, float scale, LAS float* scr, int item, int lane) {
    const int nblk = N / 64, kb = item / nblk, nb = item % nblk, k0 = 64 * kb, n0 = 64 * nb;
#pragma unroll 4
    for (int i = 0; i < 16; ++i) { const int kk = 4 * i + (lane >> 4), c4 = (lane & 15) * 4;
        const f32x4 v = *(const GAS f32x4*)(W + (size_t)(k0 + kk) * N + n0 + c4);
        LAS float* s = scr + kk * 65 + c4; s[0] = v[0]; s[1] = v[1]; s[2] = v[2]; s[3] = v[3]; }
    LDS_WAIT(); asm volatile("" ::: "memory");
    const int c = lane & 7;
#pragma unroll 2
    for (int j = 0; j < 8; ++j) { const int n = (lane >> 3) + 8 * j; const LAS float* s = scr + (8 * c) * 65 + n;
        v2u o; o.x = pk4_fp8(s[0 * 65] * scale, s[1 * 65] * scale, s[2 * 65] * scale, s[3 * 65] * scale); o.y = pk4_fp8(s[4 * 65] * scale, s[5 * 65] * scale, s[6 * 65] * scale, s[7 * 65] * scale);
        *(GAS v2u*)(WT + (size_t)dest_row(mode, n0 + n) * K + k0 + 8 * c) = o; }
    LDS_WAIT(); asm volatile("" ::: "memory");
}

#ifndef SITE_MASK
#define SITE_MASK 0xffff
#endif
#define SITE(n) (((SITE_MASK) >> (n)) & 1)
#ifndef PROBE_MASK
#define PROBE_MASK 0
#endif
#define REP(n) (1 + (((PROBE_MASK) >> (n)) & 1))
typedef const __attribute__((address_space(4))) Args* KArgs;
__device__ __forceinline__ int otid() { int t = threadIdx.x; asm volatile("" : "+v"(t)); return t; }
__device__ __forceinline__ LAS unsigned char* olds(LAS unsigned char* p) { asm volatile("" : "+s"(p)); return p; }
__device__ __forceinline__ KArgs kargs() { KArgs p = (KArgs)__builtin_amdgcn_kernarg_segment_ptr(); asm volatile("" : "+s"(p)); return p; }
#define IN(k) (ap->ph_lo <= (k) && (k) < ap->ph_hi)
#define GRID_BAR() do { if (ap->ph_hi - ap->ph_lo > 1) { XcdBarrier _b; _b.bar = (unsigned*)(ap->ws + WS_CTL) + CW_BAR; _b.x = xb_xcc_id(); _b.st = (volatile LAS unsigned*)(lds + MISC_OFF + MO_BARW); xcd_barrier(_b); } } while (0)
#define VCU() ((gridDim.x % 8 == 0) ? (int)((blockIdx.x % 8) * (gridDim.x / 8) + blockIdx.x / 8) : (int)blockIdx.x)

__global__ void __launch_bounds__(512, 2) mk_fwd(Args args_unused) {
    extern __shared__ __attribute__((aligned(16))) unsigned char lds_raw[];
    LAS unsigned char* const lds0 = (LAS unsigned char*)lds_raw;
    {
        LAS unsigned char* lds = lds0;
        for (int u = threadIdx.x; u < (LDS_BYTES - MISC_OFF) / 4; u += 512) ((LAS unsigned*)(lds + MISC_OFF))[u] = 0u;
        __syncthreads();
        KArgs ap = kargs();
        if (ap->ph_hi - ap->ph_lo > 1) (void)xcd_barrier_post((unsigned*)(ap->ws + WS_CTL) + CW_BAR, (volatile LAS unsigned*)(lds + MISC_OFF + MO_BARW));
    }

#if SITE(0)
    { KArgs ap = kargs(); const int tid = otid(); LAS unsigned char* lds = olds(lds0); (void)tid;
    if (IN(0)) for (int rep_ = 0; rep_ < REP(0); ++rep_) {
        const int lane = tid & 63, wave = __builtin_amdgcn_readfirstlane(tid >> 6), G = gridDim.x, vcu = VCU(), gw = vcu * 8 + wave, NGW = G * 8;
        unsigned char* ws = ap->ws;
        LAS float* scr = (LAS float*)(lds + wave * 16640);
        constexpr int I_HIN = 2 * 16 * 64, I_HOUT = 2 * 16 * 16, I_RIN = 2 * 16 * 96, I_ROUT = 2 * 32 * 16, I_GU = 128 * 16 * 32, I_DN = 128 * 16 * 16;
        constexpr int NITEMS = I_HIN + I_HOUT + I_RIN + I_ROUT + I_GU + I_DN;
        for (int it = gw; it < NITEMS; it += NGW) {
            int r = it;
            if (r < I_HIN) { const int j = r / (16 * 64); transpose_item(ap->in[I_HWIN] + (size_t)j * DM * HG_IN, DM, HG_IN, (bf16*)(ws + WS_W_HIN) + (size_t)j * HG_IN * DM, 1, scr, r % (16 * 64), lane); continue; } r -= I_HIN;
            if (r < I_HOUT) { const int j = r / 256; transpose_item(ap->in[I_HWOUT] + (size_t)j * DM * DM, DM, DM, (bf16*)(ws + WS_W_HOUT) + (size_t)j * DM * DM, 0, scr, r % 256, lane); continue; } r -= I_HOUT;
            if (r < I_RIN) { const int j = r / (16 * 96); transpose_item(ap->in[I_RWIN] + (size_t)j * DM * RT_IN, DM, RT_IN, (bf16*)(ws + WS_W_RIN) + (size_t)j * RT_IN * DM, 0, scr, r % (16 * 96), lane); continue; } r -= I_RIN;
            if (r < I_ROUT) { const int j = r / 512; transpose_item(ap->in[I_RWOUT] + (size_t)j * RT_VD * DM, RT_VD, DM, (bf16*)(ws + WS_W_ROUT) + (size_t)j * DM * RT_VD, 0, scr, r % 512, lane); continue; } r -= I_ROUT;
#if MOE_FP8
            if (r < I_GU) { const int j = r / 512; transpose_item_fp8(ap->in[I_WGU] + (size_t)j * DM * 2048, DM, 2048, ws + WS_W_GU + (size_t)j * 2048 * DM, 2, WGU_SCALE, scr, r % 512, lane); continue; } r -= I_GU;
            { const int j = r / 256; transpose_item_fp8(ap->in[I_WDN] + (size_t)j * DM * DM, DM, DM, ws + WS_W_DN + (size_t)j * DM * DM, 0, WDN_SCALE, scr, r % 256, lane); }
#else
            if (r < I_GU) { const int j = r / 512; transpose_item(ap->in[I_WGU] + (size_t)j * DM * 2048, DM, 2048, (bf16*)(ws + WS_W_GU) + (size_t)j * 2048 * DM, 2, scr, r % 512, lane); continue; } r -= I_GU;
            { const int j = r / 256; transpose_item(ap->in[I_WDN] + (size_t)j * DM * DM, DM, DM, (bf16*)(ws + WS_W_DN) + (size_t)j * DM * DM, 0, scr, r % 256, lane); }
#endif
        }
        const int gt = vcu * 512 + tid, NGT = G * 512;
        float* LBS = (float*)(ws + WS_LBS); float* BGU = (float*)(ws + WS_BGU); float* ROT = (float*)(ws + WS_ROT); bf16* XB = (bf16*)(ws + WS_XB);
        for (int d = gt; d < DM; d += NGT) { const float* lbp = ap->in[I_LB]; const float v0 = lbp[d], v1 = lbp[DM + d], v2 = lbp[2 * DM + d], v3 = lbp[3 * DM + d]; const float mx = fmaxf(fmaxf(v0, v1), fmaxf(v2, v3));
            const float e0 = __expf(v0 - mx), e1 = __expf(v1 - mx), e2 = __expf(v2 - mx), e3 = __expf(v3 - mx), is = 1.0f / (e0 + e1 + e2 + e3);
            LBS[d] = 0.f; LBS[DM + d] = e1 * is; LBS[2 * DM + d] = (e1 + e2) * is; LBS[3 * DM + d] = (e1 + e2 + e3) * is; }
        for (int i = gt; i < SEQ * 128; i += NGT) { const int pos = i >> 7, p = i & 127; const float inv = 1.0f / __builtin_amdgcn_exp2f(13.287712379549449f * ((float)p / 127.0f)); const float th = (float)pos * inv;
            double rev = (double)th * 0.15915494309189535; rev -= floor(rev); const float fr = (float)rev; ROT[2 * i] = __builtin_amdgcn_cosf(fr); ROT[2 * i + 1] = __builtin_amdgcn_sinf(fr); }
        for (int i = gt; i < 4 * 32 * 2048; i += NGT) { const int le = i >> 11, n = i & 2047; BGU[(size_t)le * 2048 + dest_row(2, n)] = ap->in[I_BGU][i]; }
        for (size_t i = (size_t)gt; i < (size_t)NTOK * DM / 4; i += NGT) { const f32x4 v = ((const f32x4*)ap->in[I_X])[i]; v2u o; o.x = pk2(v[0], v[1]); o.y = pk2(v[2], v[3]); ((v2u*)XB)[i] = o; }
        GRID_BAR();
    } }
#endif

#pragma unroll 1
    for (int L = 0; L < DEPTH; ++L) {
        const int pb = 1 + 8 * L;
        if ((L & 1) == 0) {
#if SITE(1)
            { KArgs ap = kargs(); const int tid = otid(); LAS unsigned char* lds = olds(lds0); (void)tid;
            if (IN(pb + 0)) for (int rep_ = 0; rep_ < REP(1); ++rep_) {
                unsigned char* ws = ap->ws; const int j = L >> 1;
                LAS int* ul = (LAS int*)(lds + MISC_OFF + MO_ULIST);
                pg8::build_units_dense(tid, ul, NTOK / 256, HG_IN / 256, DM * 2);
                pg8::EpiHgrnIn E{ws, L};
                pg8::gemm_phase<pg8::EpiHgrnIn, false, true, false>(tid, lds, ul, (LAS int*)(lds + MISC_OFF + MO_GTAB), (const char*)(ws + WS_XB), (const char*)((bf16*)(ws + WS_W_HIN) + (size_t)j * HG_IN * DM), nullptr, DM * 2, E);
                GRID_BAR();
            } }
#endif
#if SITE(2)
            { KArgs ap = kargs(); const int tid = otid(); LAS unsigned char* lds = olds(lds0); (void)tid;
            if (IN(pb + 1)) for (int rep_ = 0; rep_ < REP(2); ++rep_) {
#if !SLOW_HGRN
                { unsigned char* ws = ap->ws; const bf16* QD = (const bf16*)(ws + WS_H);
                  hgrn_fast(tid, lds, QD, QD + (size_t)NTOK * DM, QD + 2 * (size_t)NTOK * DM, QD + 3 * (size_t)NTOK * DM, (const float*)(ws + WS_DEC), (bf16*)(ws + WS_O)); }
#else
                unsigned char* ws = ap->ws; const bf16* QD = (const bf16*)(ws + WS_H); const bf16* KI = QD + (size_t)NTOK * DM; const bf16* KS = QD + 2 * (size_t)NTOK * DM; const bf16* VV = QD + 3 * (size_t)NTOK * DM; bf16* OB = (bf16*)(ws + WS_O);
                LAS float* qf = (LAS float*)lds; LAS float* kf = qf + 16 * 4 * 36; LAS float* ff = kf + 16 * 4 * 36; LAS float* vf = ff + 16 * 4 * 36;
                for (int un = blockIdx.x; un < NBATCH * HG_HEADS; un += gridDim.x) {
                    const int b = un >> 3, h = un & 7; const int vc = tid >> 2, kq = tid & 3;
                    float st[32];
#pragma unroll
                    for (int i = 0; i < 32; ++i) st[i] = 0.f;
                    for (int t0 = 0; t0 < SEQ; t0 += 16) {
                        __syncthreads();
                        for (int e = tid; e < 16 * 128; e += 512) { const int tt = e >> 7, k = e & 127; const size_t gi = (size_t)(b * SEQ + t0 + tt) * DM + h * 128 + k; const int li = tt * 144 + (k & 3) * 36 + (k >> 2);
                            qf[li] = bf1(QD[gi]); kf[li] = bf1(KI[gi]); ff[li] = bf1(KS[gi]); vf[tt * 128 + k] = bf1(VV[gi]); }
                        __syncthreads();
                        for (int tt = 0; tt < 16; ++tt) {
                            const float v = vf[tt * 128 + vc]; float a = 0.f; const int lb = tt * 144 + kq * 36;
#pragma unroll
                            for (int i = 0; i < 32; ++i) { st[i] = ff[lb + i] * st[i] + kf[lb + i] * v; a += qf[lb + i] * st[i]; }
                            a += __shfl_xor(a, 1); a += __shfl_xor(a, 2);
                            if (kq == 0) OB[(size_t)(b * SEQ + t0 + tt) * DM + h * 128 + vc] = (bf16)f2bf(a);
                        }
                    }
                }
#endif
                GRID_BAR();
            } }
#endif
#if SITE(3)
            { KArgs ap = kargs(); const int tid = otid(); LAS unsigned char* lds = olds(lds0); (void)tid;
            if (IN(pb + 2)) for (int rep_ = 0; rep_ < REP(3); ++rep_) {
                const int lane = tid & 63, wave = __builtin_amdgcn_readfirstlane(tid >> 6), gw = VCU() * 8 + wave, NGW = gridDim.x * 8;
                unsigned char* ws = ap->ws; const bf16* OB = (const bf16*)(ws + WS_O); const bf16* GG = (const bf16*)(ws + WS_H) + 4 * (size_t)NTOK * DM; bf16* A2 = (bf16*)(ws + WS_A2);
                const float* ng = ap->in[I_HNG] + (L >> 1) * DM;
                f32x4 g4[4];
#pragma unroll
                for (int q = 0; q < 4; ++q) g4[q] = *(const f32x4*)(ng + 256 * q + 4 * lane);
                v2u on[4], gn[4];
#pragma unroll
                for (int q = 0; q < 4; ++q) { on[q] = *(const v2u*)(OB + (size_t)gw * DM + 256 * q + 4 * lane); gn[q] = *(const v2u*)(GG + (size_t)gw * DM + 256 * q + 4 * lane); }
#pragma unroll 1
                for (int row = gw; row < NTOK; row += NGW) {
                    v2u oc[4], gc[4];
#pragma unroll
                    for (int q = 0; q < 4; ++q) { oc[q] = on[q]; gc[q] = gn[q]; }
                    if (row + NGW < NTOK) {
#pragma unroll
                        for (int q = 0; q < 4; ++q) { on[q] = *(const v2u*)(OB + (size_t)(row + NGW) * DM + 256 * q + 4 * lane); gn[q] = *(const v2u*)(GG + (size_t)(row + NGW) * DM + 256 * q + 4 * lane); } }
                    float o[16]; float ss = 0.f;
#pragma unroll
                    for (int q = 0; q < 4; ++q) { o[4 * q] = bflo(oc[q].x); o[4 * q + 1] = bfhi(oc[q].x); o[4 * q + 2] = bflo(oc[q].y); o[4 * q + 3] = bfhi(oc[q].y); }
#pragma unroll
                    for (int i = 0; i < 16; ++i) ss += o[i] * o[i];
                    const float rs = 1.0f / sqrtf(wave_sum(ss) * (1.0f / DM) + RMS_EPS);
#pragma unroll
                    for (int q = 0; q < 4; ++q) {
                        v2u w; w.x = pk2(o[4 * q] * rs * g4[q][0] * bflo(gc[q].x), o[4 * q + 1] * rs * g4[q][1] * bfhi(gc[q].x)); w.y = pk2(o[4 * q + 2] * rs * g4[q][2] * bflo(gc[q].y), o[4 * q + 3] * rs * g4[q][3] * bfhi(gc[q].y));
                        *(v2u*)(A2 + (size_t)row * DM + 256 * q + 4 * lane) = w; }
                }
                GRID_BAR();
            } }
#endif
        } else {
#if SITE(4)
            { KArgs ap = kargs(); const int tid = otid(); LAS unsigned char* lds = olds(lds0); (void)tid;
            if (IN(pb + 0)) for (int rep_ = 0; rep_ < REP(4); ++rep_) {
                unsigned char* ws = ap->ws; const int j = L >> 1;
                LAS int* ul = (LAS int*)(lds + MISC_OFF + MO_ULIST);
                pg8::build_units_dense(tid, ul, NTOK / 256, RT_IN / 256, DM * 2);
                pg8::EpiRetIn E{ws};
                pg8::gemm_phase<pg8::EpiRetIn, false, true, false>(tid, lds, ul, (LAS int*)(lds + MISC_OFF + MO_GTAB), (const char*)(ws + WS_XB), (const char*)((bf16*)(ws + WS_W_RIN) + (size_t)j * RT_IN * DM), nullptr, DM * 2, E);
                GRID_BAR();
            } }
#endif
#if SITE(5)
            { KArgs ap = kargs(); const int tid = otid(); LAS unsigned char* lds = olds(lds0); (void)tid;
            if (IN(pb + 1)) for (int rep_ = 0; rep_ < REP(5); ++rep_) {
#if !SLOW_RET
                { unsigned char* ws = ap->ws; ret_fast(tid, lds, (const bf16*)(ws + WS_H), (bf16*)(ws + WS_O)); }
#else
                unsigned char* ws = ap->ws; const bf16* HB = (const bf16*)(ws + WS_H); bf16* OB = (bf16*)(ws + WS_O);
                LAS float* qf = (LAS float*)lds; LAS float* kf = qf + 16 * 4 * 68; LAS float* vf = kf + 16 * 4 * 68;
                for (int un = blockIdx.x; un < NBATCH * RT_HEADS * 4; un += gridDim.x) {
                    const int b = un >> 4, h = (un >> 2) & 3, vq = un & 3; const int vc = tid >> 2, kq = tid & 3;
                    const float gam = 1.0f - exp2f(-5.0f - (float)h);
                    float st[64];
#pragma unroll
                    for (int i = 0; i < 64; ++i) st[i] = 0.f;
                    for (int t0 = 0; t0 < SEQ; t0 += 16) {
                        __syncthreads();
                        for (int e = tid; e < 16 * 256; e += 512) { const int tt = e >> 8, k = e & 255; const size_t gi = (size_t)(b * SEQ + t0 + tt) * RT_IN + h * 256 + k; const int li = tt * 272 + (k & 3) * 68 + (k >> 2);
                            qf[li] = bf1(HB[gi]); kf[li] = bf1(HB[gi + 1024]); }
                        for (int e = tid; e < 16 * 128; e += 512) { const int tt = e >> 7, c = e & 127; vf[e] = bf1(HB[(size_t)(b * SEQ + t0 + tt) * RT_IN + 2048 + h * 512 + vq * 128 + c]); }
                        __syncthreads();
                        for (int tt = 0; tt < 16; ++tt) {
                            const float v = vf[tt * 128 + vc]; float a = 0.f; const int lb = tt * 272 + kq * 68;
#pragma unroll
                            for (int i = 0; i < 64; ++i) { st[i] = gam * st[i] + kf[lb + i] * v; a += qf[lb + i] * st[i]; }
                            a += __shfl_xor(a, 1); a += __shfl_xor(a, 2);
                            if (kq == 0) OB[(size_t)(b * SEQ + t0 + tt) * RT_VD + h * 512 + vq * 128 + vc] = (bf16)f2bf(a);
                        }
                    }
                }
#endif
                GRID_BAR();
            } }
#endif
#if SITE(6)
            { KArgs ap = kargs(); const int tid = otid(); LAS unsigned char* lds = olds(lds0); (void)tid;
            if (IN(pb + 2)) for (int rep_ = 0; rep_ < REP(6); ++rep_) {
                const int lane = tid & 63, wave = __builtin_amdgcn_readfirstlane(tid >> 6), gw = VCU() * 8 + wave, NGW = gridDim.x * 8;
                unsigned char* ws = ap->ws; const bf16* OB = (const bf16*)(ws + WS_O); const bf16* HB = (const bf16*)(ws + WS_H); bf16* A2 = (bf16*)(ws + WS_A2);
                v4u on[4], gn[4];
#pragma unroll
                for (int h = 0; h < 4; ++h) { on[h] = *(const v4u*)(OB + (size_t)gw * RT_VD + 512 * h + 8 * lane); gn[h] = *(const v4u*)(HB + (size_t)gw * RT_IN + 4096 + 512 * h + 8 * lane); }
#pragma unroll 1
                for (int row = gw; row < NTOK; row += NGW) {
                    v4u oc[4], gc[4];
#pragma unroll
                    for (int h = 0; h < 4; ++h) { oc[h] = on[h]; gc[h] = gn[h]; }
                    if (row + NGW < NTOK) {
#pragma unroll
                        for (int h = 0; h < 4; ++h) { on[h] = *(const v4u*)(OB + (size_t)(row + NGW) * RT_VD + 512 * h + 8 * lane); gn[h] = *(const v4u*)(HB + (size_t)(row + NGW) * RT_IN + 4096 + 512 * h + 8 * lane); } }
#pragma unroll
                    for (int h = 0; h < 4; ++h) {
                        const v4u w = oc[h];
                        float o[8] = {bflo(w.x), bfhi(w.x), bflo(w.y), bfhi(w.y), bflo(w.z), bfhi(w.z), bflo(w.w), bfhi(w.w)};
                        float s = 0.f;
#pragma unroll
                        for (int i = 0; i < 8; ++i) s += o[i];
                        const float mu = wave_sum(s) * (1.0f / 512.0f); float q = 0.f;
#pragma unroll
                        for (int i = 0; i < 8; ++i) { o[i] -= mu; q += o[i] * o[i]; }
                        const float rs = 1.0f / sqrtf(wave_sum(q) * (1.0f / 512.0f) + LN_EPS);
                        const v4u g = gc[h];
                        v4u r; r.x = pk2(o[0] * rs * bflo(g.x), o[1] * rs * bfhi(g.x)); r.y = pk2(o[2] * rs * bflo(g.y), o[3] * rs * bfhi(g.y));
                        r.z = pk2(o[4] * rs * bflo(g.z), o[5] * rs * bfhi(g.z)); r.w = pk2(o[6] * rs * bflo(g.w), o[7] * rs * bfhi(g.w));
                        *(v4u*)(A2 + (size_t)row * RT_VD + 512 * h + 8 * lane) = r;
                    }
                }
                GRID_BAR();
            } }
#endif
        }
#if SITE(7)
        { KArgs ap = kargs(); const int tid = otid(); LAS unsigned char* lds = olds(lds0); (void)tid;
        if (IN(pb + 3)) for (int rep_ = 0; rep_ < REP(7); ++rep_) {
            unsigned char* ws = ap->ws; const int j = L >> 1; const bool ret = (L & 1) != 0;
            const int Ko = ret ? RT_VD : DM;
            LAS int* ul = (LAS int*)(lds + MISC_OFF + MO_ULIST);
            pg8::build_units_dense(tid, ul, NTOK / 256, DM / 256, Ko * 2);
            const char* Bt = ret ? (const char*)((bf16*)(ws + WS_W_ROUT) + (size_t)j * DM * RT_VD) : (const char*)((bf16*)(ws + WS_W_HOUT) + (size_t)j * DM * DM);
            pg8::EpiRes E{ws};
            pg8::gemm_phase<pg8::EpiRes, false, true, false>(tid, lds, ul, (LAS int*)(lds + MISC_OFF + MO_GTAB), (const char*)(ws + WS_A2), Bt, nullptr, Ko * 2, E);
            GRID_BAR();
        } }
#endif
#if SITE(8)
        { KArgs ap = kargs(); const int tid = otid(); LAS unsigned char* lds = olds(lds0); (void)tid;
        if (IN(pb + 4)) for (int rep_ = 0; rep_ < REP(8); ++rep_) {
            const int lane = tid & 63, wave = __builtin_amdgcn_readfirstlane(tid >> 6);
            unsigned char* ws = ap->ws; unsigned* ctl = (unsigned*)(ws + WS_CTL);
            const bf16* Y = (const bf16*)(ws + WS_Y); bf16* X1R = (bf16*)(ws + WS_X1F); bf16* X1B = (bf16*)(ws + WS_X1B);
            int* ROWDST = (int*)(ws + WS_ROWDST); float* ROWGATE = (float*)(ws + WS_ROWGATE);
            LAS float* wT = (LAS float*)lds;
            LAS int* lcnt = (LAS int*)(lds + MISC_OFF + MO_LCNT); LAS int* lbase = (LAS int*)(lds + MISC_OFF + MO_LBASE);
            LAS int* sel = (LAS int*)(lds + MISC_OFF + MO_SEL); LAS float* selw = (LAS float*)(lds + MISC_OFF + MO_SELW);
            const float* rw = ap->in[I_RW] + (size_t)L * DM * NE; const float* rb = ap->in[I_RB] + L * NE;
            const float* lg = ap->in[I_LNMG] + L * DM; const float* lbb = ap->in[I_LNMB] + L * DM;
            for (int e4 = tid; e4 < DM * NE / 4; e4 += 512) { const f32x4 v = ((const f32x4*)rw)[e4]; const int d = e4 >> 3, e0 = (e4 & 7) * 4; wT[(e0 + 0) * DM + d] = v[0]; wT[(e0 + 1) * DM + d] = v[1]; wT[(e0 + 2) * DM + d] = v[2]; wT[(e0 + 3) * DM + d] = v[3]; }
            const float rbias = rb[lane >> 1];
            for (int blk = VCU(); blk < NTOK / 128; blk += gridDim.x) {
                if (tid < 32) lcnt[tid] = 0;
                __syncthreads();
                v2u xn[4];
#pragma unroll
                for (int q = 0; q < 4; ++q) xn[q] = *(const v2u*)(Y + (size_t)(blk * 128 + wave * 16) * DM + 256 * q + 4 * lane);
#pragma unroll 1
                for (int rr = 0; rr < 16; ++rr) {
                    const int rloc = wave * 16 + rr, row = blk * 128 + rloc;
                    f32x4 x[4]; float s = 0.f;
#pragma unroll
                    for (int q = 0; q < 4; ++q) { x[q] = (f32x4){bflo(xn[q].x), bfhi(xn[q].x), bflo(xn[q].y), bfhi(xn[q].y)}; s += (x[q][0] + x[q][1]) + (x[q][2] + x[q][3]); }
                    if (rr + 1 < 16) {
#pragma unroll
                        for (int q = 0; q < 4; ++q) xn[q] = *(const v2u*)(Y + (size_t)(row + 1) * DM + 256 * q + 4 * lane); }
                    const float mu = wave_sum(s) * (1.0f / DM); float qq = 0.f;
#pragma unroll
                    for (int q = 0; q < 4; ++q) { x[q] = x[q] - mu; qq += (x[q][0] * x[q][0] + x[q][1] * x[q][1]) + (x[q][2] * x[q][2] + x[q][3] * x[q][3]); }
                    const float rs = 1.0f / sqrtf(wave_sum(qq) * (1.0f / DM) + LN_EPS);
#pragma unroll
                    for (int q = 0; q < 4; ++q) { const f32x4 g4 = *(const f32x4*)(lg + 256 * q + 4 * lane), b4 = *(const f32x4*)(lbb + 256 * q + 4 * lane); x[q] = x[q] * rs * g4 + b4;
                        { v2u wr_; wr_.x = pk2(x[q][0], x[q][1]); wr_.y = pk2(x[q][2], x[q][3]); *(v2u*)(X1R + (size_t)row * DM + 256 * q + 4 * lane) = wr_; }
#if MOE_FP8
                        *(unsigned*)((unsigned char*)X1B + (size_t)row * DM + 256 * q + 4 * lane) = pk4_fp8(x[q][0] * X_SCALE, x[q][1] * X_SCALE, x[q][2] * X_SCALE, x[q][3] * X_SCALE); }
#else
                        v2u w; w.x = pk2(x[q][0], x[q][1]); w.y = pk2(x[q][2], x[q][3]); *(v2u*)(X1B + (size_t)row * DM + 256 * q + 4 * lane) = w; }
#endif
                    float a[32];
#pragma unroll
                    for (int e = 0; e < 32; ++e) { float t = 0.f;
#pragma unroll
                        for (int q = 0; q < 4; ++q) { const f32x4 w = *(const LAS f32x4*)(wT + e * DM + 256 * q + 4 * lane); t += (x[q][0] * w[0] + x[q][1] * w[1]) + (x[q][2] * w[2] + x[q][3] * w[3]); }
                        a[e] = t; }
#pragma unroll
                    for (int st = 0; st < 5; ++st) { const int n = 16 >> st, msk = 32 >> st; const bool up = (lane & msk) != 0;
#pragma unroll
                        for (int i = 0; i < n; ++i) { const float keep = up ? a[i + n] : a[i], send = up ? a[i] : a[i + n]; a[i] = keep + __shfl_xor(send, msk); } }
                    float lgt = a[0] + __shfl_xor(a[0], 1) + rbias;
                    float v = lgt; int se[4]; float sv[4];
#pragma unroll
                    for (int k = 0; k < 4; ++k) { const float m = wave_max(v); const unsigned long long bal = __ballot(v == m); const int l0 = __builtin_ctzll(bal); se[k] = l0 >> 1; sv[k] = m; if ((lane >> 1) == se[k]) v = -3.0e38f; }
                    const float e1 = __expf(sv[1] - sv[0]), e2 = __expf(sv[2] - sv[0]), e3 = __expf(sv[3] - sv[0]); const float inv = 1.0f / (1.0f + e1 + e2 + e3);
                    if (lane < 4) { const int ee = lane == 0 ? se[0] : (lane == 1 ? se[1] : (lane == 2 ? se[2] : se[3])); const float ww = (lane == 0 ? 1.0f : (lane == 1 ? e1 : (lane == 2 ? e2 : e3))) * inv;
                        sel[rloc * 4 + lane] = ee; selw[rloc * 4 + lane] = ww; }
                }
                __syncthreads();
                const int myE = sel[tid]; const int rank = __hip_atomic_fetch_add(lcnt + myE, 1, __ATOMIC_RELAXED, __HIP_MEMORY_SCOPE_WORKGROUP);
                __syncthreads();
                if (tid < 32) lbase[tid] = (int)__hip_atomic_fetch_add(ctl + CW_ECNT + L * 32 + tid, (unsigned)lcnt[tid], RLX_AGENT);
                __syncthreads();
                { const int pos = lbase[myE] + rank; const size_t ti = (size_t)myE * ECAP + pos; ROWDST[ti] = (blk * 128 + (tid >> 2)) * 4 + (tid & 3); ROWGATE[ti] = selw[tid]; }
                __syncthreads();
            }
            GRID_BAR();
        } }
#endif
#if SITE(9)
        { KArgs ap = kargs(); const int tid = otid(); LAS unsigned char* lds = olds(lds0); (void)tid;
        if (IN(pb + 5)) for (int rep_ = 0; rep_ < REP(9); ++rep_) {
            unsigned char* ws = ap->ws; unsigned* ctl = (unsigned*)(ws + WS_CTL);
            LAS int* tpre = (LAS int*)(lds + MISC_OFF + MO_TPRE); LAS int* ebase = (LAS int*)(lds + MISC_OFF + MO_EBASE); LAS int* ecnt = (LAS int*)(lds + MISC_OFF + MO_ECNT);
            if (tid == 0) { int t = 0;
_Pragma("unroll 1")
 for (int e = 0; e < NE; ++e) { const int c = (int)__hip_atomic_load(ctl + CW_ECNT + L * 32 + e, RLX_AGENT); ecnt[e] = c; tpre[e] = t; ebase[e] = t * 256; t += (c + 255) >> 8; } tpre[NE] = t; }
            __syncthreads();
            LAS int* ul = (LAS int*)(lds + MISC_OFF + MO_ULIST);
            constexpr int EB = MOE_FP8 ? 1 : 2;
            pg8::build_units_moe(tid, ul, tpre, ebase, ecnt, 8, DM * EB, 2048u * DM * EB);
            pg8::EpiMoeGU E{ws, L};
            pg8::gemm_phase<pg8::EpiMoeGU, true, true, MOE_FP8 != 0>(tid, lds, ul, (LAS int*)(lds + MISC_OFF + MO_GTAB), (const char*)(ws + WS_X1B), (const char*)(ws + WS_W_GU + (size_t)L * NE * 2048 * DM * EB), (const int*)(ws + WS_ROWDST), DM * EB, E);
            GRID_BAR();
        } }
#endif
#if SITE(10)
        { KArgs ap = kargs(); const int tid = otid(); LAS unsigned char* lds = olds(lds0); (void)tid;
        if (IN(pb + 6)) for (int rep_ = 0; rep_ < REP(10); ++rep_) {
            unsigned char* ws = ap->ws; unsigned* ctl = (unsigned*)(ws + WS_CTL);
            LAS int* tpre = (LAS int*)(lds + MISC_OFF + MO_TPRE); LAS int* ebase = (LAS int*)(lds + MISC_OFF + MO_EBASE); LAS int* ecnt = (LAS int*)(lds + MISC_OFF + MO_ECNT);
            __syncthreads();
            if (tid == 0) { int t = 0;
_Pragma("unroll 1")
 for (int e = 0; e < NE; ++e) { const int c = (int)__hip_atomic_load(ctl + CW_ECNT + L * 32 + e, RLX_AGENT); ecnt[e] = c; tpre[e] = t; ebase[e] = t * 256; t += (c + 255) >> 8; } tpre[NE] = t; }
            __syncthreads();
            LAS int* ul = (LAS int*)(lds + MISC_OFF + MO_ULIST);
            constexpr int EB = MOE_FP8 ? 1 : 2;
            pg8::build_units_moe(tid, ul, tpre, ebase, ecnt, 4, DM * EB, (unsigned)DM * DM * EB);
            pg8::EpiMoeDown E{ws, ap->in[I_BDN] + (size_t)L * NE * DM};
            pg8::gemm_phase<pg8::EpiMoeDown, false, true, MOE_FP8 != 0>(tid, lds, ul, (LAS int*)(lds + MISC_OFF + MO_GTAB), (const char*)(ws + WS_ACT), (const char*)(ws + WS_W_DN + (size_t)L * NE * DM * DM * EB), nullptr, DM * EB, E);
            GRID_BAR();
        } }
#endif
#if SITE(11)
        { KArgs ap = kargs(); const int tid = otid(); LAS unsigned char* lds = olds(lds0); (void)tid;
        if (IN(pb + 7)) for (int rep_ = 0; rep_ < REP(11); ++rep_) {
            const int lane = tid & 63, wave = __builtin_amdgcn_readfirstlane(tid >> 6), gw = VCU() * 8 + wave, NGW = gridDim.x * 8;
            unsigned char* ws = ap->ws; const bf16* X1R = (const bf16*)(ws + WS_X1F); const bf16* YS = (const bf16*)(ws + WS_YSLOT); bf16* XB = (bf16*)(ws + WS_XB); float* out = ap->out;
            const float* lg = ap->in[I_LNFG] + L * DM; const float* lbb = ap->in[I_LNFB] + L * DM;
            v2u xn[4]; f32x4 g4[4], b4[4]; v2u yn[4][4];
#pragma unroll
            for (int q = 0; q < 4; ++q) { g4[q] = *(const f32x4*)(lg + 256 * q + 4 * lane); b4[q] = *(const f32x4*)(lbb + 256 * q + 4 * lane); xn[q] = *(const v2u*)(X1R + (size_t)gw * DM + 256 * q + 4 * lane);
#pragma unroll
                for (int k = 0; k < 4; ++k) yn[q][k] = *(const v2u*)(YS + ((size_t)gw * 4 + k) * DM + 256 * q + 4 * lane); }
#pragma unroll 1
            for (int row = gw; row < NTOK; row += NGW) {
                f32x4 x[4]; v2u yc[4][4]; float s = 0.f;
#pragma unroll
                for (int q = 0; q < 4; ++q) { x[q] = (f32x4){bflo(xn[q].x), bfhi(xn[q].x), bflo(xn[q].y), bfhi(xn[q].y)} * DN_ALPHA;
#pragma unroll
                    for (int k = 0; k < 4; ++k) yc[q][k] = yn[q][k]; }
                if (row + NGW < NTOK) {
#pragma unroll
                    for (int q = 0; q < 4; ++q) { xn[q] = *(const v2u*)(X1R + (size_t)(row + NGW) * DM + 256 * q + 4 * lane);
#pragma unroll
                        for (int k = 0; k < 4; ++k) yn[q][k] = *(const v2u*)(YS + ((size_t)(row + NGW) * 4 + k) * DM + 256 * q + 4 * lane); } }
#pragma unroll
                for (int q = 0; q < 4; ++q) {
#pragma unroll
                    for (int k = 0; k < 4; ++k) { const v2u w = yc[q][k]; x[q][0] += bflo(w.x); x[q][1] += bfhi(w.x); x[q][2] += bflo(w.y); x[q][3] += bfhi(w.y); }
                    s += (x[q][0] + x[q][1]) + (x[q][2] + x[q][3]); }
                const float mu = wave_sum(s) * (1.0f / DM); float qq = 0.f;
#pragma unroll
                for (int q = 0; q < 4; ++q) { x[q] = x[q] - mu; qq += (x[q][0] * x[q][0] + x[q][1] * x[q][1]) + (x[q][2] * x[q][2] + x[q][3] * x[q][3]); }
                const float rs = 1.0f / sqrtf(wave_sum(qq) * (1.0f / DM) + LN_EPS);
#pragma unroll
                for (int q = 0; q < 4; ++q) { x[q] = x[q] * rs * g4[q] + b4[q];
                    if (L + 1 == DEPTH) *(f32x4*)(out + (size_t)row * DM + 256 * q + 4 * lane) = x[q];
                    else { v2u w; w.x = pk2(x[q][0], x[q][1]); w.y = pk2(x[q][2], x[q][3]); *(v2u*)(XB + (size_t)row * DM + 256 * q + 4 * lane) = w; } }
            }
            if (L + 1 < DEPTH) GRID_BAR();
        } }
#endif
    }
#undef IN
#undef GRID_BAR
}

extern "C" void kernel_launch(void* const* d_in, const int* in_sizes, int n_in, void* d_out, int out_size, void* d_ws, size_t ws_size, hipStream_t stream) {
    static int grid = 0;
    if (grid == 0) {
        if (n_in != 17 || out_size != NTOK * DM || ws_size < WS_END) { fprintf(stderr, "kernel_launch: unexpected shapes (n_in %d, out %d, ws %zu < %zu)\n", n_in, out_size, ws_size, (size_t)WS_END); grid = -1; return; }
        int dev = 0, cus = 0, per_cu = 0;
        if (hipGetDevice(&dev) != hipSuccess || hipDeviceGetAttribute(&cus, hipDeviceAttributeMultiprocessorCount, dev) != hipSuccess) { grid = -1; return; }
        if (hipFuncSetAttribute((const void*)mk_fwd, hipFuncAttributeMaxDynamicSharedMemorySize, LDS_BYTES) != hipSuccess) { fprintf(stderr, "kernel_launch: hipFuncSetAttribute failed\n"); grid = -1; return; }
        if (hipOccupancyMaxActiveBlocksPerMultiprocessor(&per_cu, (const void*)mk_fwd, 512, LDS_BYTES) != hipSuccess || per_cu < 1) { fprintf(stderr, "kernel_launch: occupancy query says %d\n", per_cu); }
        (void)hipGetLastError();
        grid = cus;
    }
    if (grid < 0) return;
    (void)hipMemsetAsync((char*)d_ws + WS_CTL, 0, CTL_ZERO_BYTES, stream);
    Args a{};
    for (int i = 0; i < 17; ++i) a.in[i] = (const float*)d_in[i];
    a.out = (float*)d_out; a.ws = (unsigned char*)d_ws;
#if MK_MULTI
    for (int p = 0; p < 1 + 8 * DEPTH; ++p) { a.ph_lo = p; a.ph_hi = p + 1; hipLaunchKernelGGL(mk_fwd, dim3(grid), dim3(512), LDS_BYTES, stream, a); }
#else
    a.ph_lo = 0; a.ph_hi = 1 + 8 * DEPTH;
    hipLaunchKernelGGL(mk_fwd, dim3(grid), dim3(512), LDS_BYTES, stream, a);
#endif
}
```

```cpp
#include <hip/hip_runtime.h>
#include <cstdio>
#include <cstdint>

#ifndef MK_MULTI
#define MK_MULTI 0
#endif
#ifndef PROBE_EPI2
#define PROBE_EPI2 0
#endif
#ifndef MOE_FP8
#define MOE_FP8 1
#endif
#ifndef SLOW_HGRN
#define SLOW_HGRN 0
#endif
#ifndef SLOW_RET
#define SLOW_RET 0
#endif

#define GAS __attribute__((address_space(1)))
#define LAS __attribute__((address_space(3)))
typedef unsigned short bf16;
typedef unsigned v4u __attribute__((ext_vector_type(4)));
typedef unsigned v2u __attribute__((ext_vector_type(2)));
typedef float f32x4 __attribute__((ext_vector_type(4)));
typedef float f32x2 __attribute__((ext_vector_type(2)));
typedef short bf16x8 __attribute__((ext_vector_type(8)));
typedef GAS unsigned gu32;

constexpr int DM = 1024, NBATCH = 16, SEQ = 2048, NTOK = NBATCH * SEQ, DEPTH = 4;
constexpr int NE = 32, TOPK = 4;
constexpr int HG_HEADS = 8, HG_K = 128;
constexpr int RT_HEADS = 4, RT_K = 256, RT_V = 512, RT_VD = 2048, RT_IN = 6144, HG_IN = 4096;
constexpr int ECAP = NTOK;
constexpr int MOE_ROWS = NTOK * TOPK + NE * 256;
constexpr float DN_ALPHA = 1.681792830507429f;
constexpr float LN_EPS = 1e-5f, RMS_EPS = 1e-6f;

constexpr size_t MiB = 1ull << 20;
constexpr size_t WS_CTL = 0, CTL_ZERO_BYTES = 1 * MiB;
constexpr size_t WS_LBS = 1 * MiB;
constexpr size_t WS_WRH = 1 * MiB + 128 * 1024, WS_WRL = 1 * MiB + 512 * 1024;
constexpr size_t WS_BGU = 2 * MiB;
constexpr size_t WS_ROT = 4 * MiB;
constexpr size_t WS_ROWDST = 8 * MiB;
constexpr size_t WS_ROWGATE = 12 * MiB;
constexpr size_t WS_W_HIN = 16 * MiB;
constexpr size_t WS_W_HOUT = WS_W_HIN + 16 * MiB;
constexpr size_t WS_W_RIN = WS_W_HOUT + 4 * MiB;
constexpr size_t WS_W_ROUT = WS_W_RIN + 24 * MiB;
constexpr size_t WS_W_GU = WS_W_ROUT + 8 * MiB;
constexpr size_t WS_W_DN = WS_W_GU + 512 * MiB;
constexpr size_t WS_XB = WS_W_DN + 256 * MiB;
constexpr size_t WS_H = WS_XB + 64 * MiB;
constexpr size_t WS_DEC = WS_H + 320 * MiB;
constexpr size_t WS_O = WS_H + 384 * MiB;
constexpr size_t WS_A2 = WS_O + 128 * MiB;
constexpr size_t WS_Y = WS_A2 + 128 * MiB;
constexpr size_t WS_X1F = WS_Y + 128 * MiB;
constexpr size_t WS_X1B = WS_X1F + 128 * MiB;
constexpr size_t WS_ACT = WS_X1B + 64 * MiB;
constexpr size_t WS_YSLOT = WS_ACT + 272 * MiB;
constexpr size_t WS_END = WS_YSLOT + 256 * MiB;

constexpr int CW_BAR = 4096;
constexpr int CW_ECNT = 16384;

constexpr int RING_BYTES = 131072;
constexpr int MISC_OFF = 135168;
constexpr int LDS_BYTES = 147456;
constexpr int MO_BARW = 0;
constexpr int MO_GTAB = 64;
constexpr int MO_TPRE = 64 + 2048;
constexpr int MO_EBASE = MO_TPRE + 160;
constexpr int MO_ECNT = MO_EBASE + 128;
constexpr int MO_LCNT = MO_ECNT + 128;
constexpr int MO_LBASE = MO_LCNT + 128;
constexpr int MO_SEL = MO_LBASE + 128;
constexpr int MO_SELW = MO_SEL + 2048;
constexpr int MO_RANK = MO_SELW + 2048;
constexpr int MO_ULIST = MO_RANK + 2048;
static_assert(MISC_OFF + MO_ULIST + 1024 <= LDS_BYTES, "LDS map");

#define RLX_AGENT __ATOMIC_RELAXED, __HIP_MEMORY_SCOPE_AGENT
#define LDS_WAIT() asm volatile("s_waitcnt lgkmcnt(0)" ::: "memory")
#define VM_WAIT() asm volatile("s_waitcnt vmcnt(0)" ::: "memory")

__device__ __forceinline__ unsigned f2bf(float f) { unsigned u = __builtin_bit_cast(unsigned, f); return (u + 0x7fffu + ((u >> 16) & 1u)) >> 16; }
__device__ __forceinline__ unsigned pk2(float lo, float hi) { return f2bf(lo) | (f2bf(hi) << 16); }
__device__ __forceinline__ unsigned cvt_pk_bf16(float lo, float hi) { unsigned r; asm volatile("v_cvt_pk_bf16_f32 %0, %1, %2" : "=v"(r) : "v"(lo), "v"(hi)); return r; }
#if MOE_FP8
constexpr float X_SCALE = 4.0f, WGU_SCALE = 64.0f, ACT_SCALE = 4.0f, WDN_SCALE = 128.0f;
constexpr float GU_DESCALE = 1.0f / (X_SCALE * WGU_SCALE), DN_DESCALE = 1.0f / (ACT_SCALE * WDN_SCALE);
#else
constexpr float GU_DESCALE = 1.0f, DN_DESCALE = 1.0f, ACT_SCALE = 1.0f;
#endif
__device__ __forceinline__ unsigned pk4_fp8(float a, float b, float c, float d) {
    a = __builtin_amdgcn_fmed3f(a, -448.0f, 448.0f); b = __builtin_amdgcn_fmed3f(b, -448.0f, 448.0f); c = __builtin_amdgcn_fmed3f(c, -448.0f, 448.0f); d = __builtin_amdgcn_fmed3f(d, -448.0f, 448.0f);
    int p = __builtin_amdgcn_cvt_pk_fp8_f32(a, b, 0, false); p = __builtin_amdgcn_cvt_pk_fp8_f32(c, d, p, true); return (unsigned)p; }
__device__ __forceinline__ float bflo(unsigned u) { return __builtin_bit_cast(float, u << 16); }
__device__ __forceinline__ float bfhi(unsigned u) { return __builtin_bit_cast(float, u & 0xffff0000u); }
__device__ __forceinline__ float bf1(bf16 b) { return __builtin_bit_cast(float, ((unsigned)b) << 16); }
__device__ __forceinline__ float fexp(float x) { return __builtin_amdgcn_exp2f(x * 1.4426950408889634f); }
__device__ __forceinline__ float frcp(float x) { return __builtin_amdgcn_rcpf(x); }
__device__ __forceinline__ float fsigmoid(float x) { return frcp(1.0f + fexp(-x)); }
__device__ __forceinline__ float wave_sum(float v) {
#pragma unroll
    for (int o = 1; o < 64; o <<= 1) v += __shfl_xor(v, o);
    return v;
}
__device__ __forceinline__ float wave_max(float v) {
#pragma unroll
    for (int o = 1; o < 64; o <<= 1) v = fmaxf(v, __shfl_xor(v, o));
    return v;
}

template <int CTRL> __device__ __forceinline__ float dppf(float v) { return __builtin_bit_cast(float, __builtin_amdgcn_update_dpp(0, __builtin_bit_cast(int, v), CTRL, 0xf, 0xf, true)); }
template <int CTRL> __device__ __forceinline__ int dppi(int v) { return __builtin_amdgcn_update_dpp(0, v, CTRL, 0xf, 0xf, true); }
__device__ __forceinline__ float rlane(float v, int l) { return __builtin_bit_cast(float, __builtin_amdgcn_readlane(__builtin_bit_cast(int, v), l)); }
__device__ __forceinline__ float wave_sum_u(float v) {
    v += dppf<0xB1>(v); v += dppf<0x4E>(v); v += dppf<0x141>(v); v += dppf<0x140>(v);
    return (rlane(v, 0) + rlane(v, 16)) + (rlane(v, 32) + rlane(v, 48));
}
#define XB_TMO      128
#define XB_XCNT(j)  (256  + 64 * (j))
#define XB_XSUB(j)  (1280 + 64 * (j))
#define XB_XGEN(j)  (2304 + 64 * (j))
#define XB_TOP      3328
#define XB_TOPGEN   3392
#define XCD_BAR_WORDS 3456
#define XB_SPIN_CAP (1u << 22)

__device__ __forceinline__ unsigned xb_ld(unsigned* p)              { return __hip_atomic_load(p, __ATOMIC_RELAXED, __HIP_MEMORY_SCOPE_AGENT); }
__device__ __forceinline__ unsigned xb_add(unsigned* p, unsigned v) { return __hip_atomic_fetch_add(p, v, __ATOMIC_RELAXED, __HIP_MEMORY_SCOPE_AGENT); }
__device__ __forceinline__ unsigned xb_xcc_id() { return (unsigned)__builtin_amdgcn_s_getreg((3 << 11) | 20) & 0xFu; }
#define XB_SPIN(cond, bar) do { unsigned _sp = 0; while (cond) { __builtin_amdgcn_s_sleep(1); \
    if ((++_sp & 255u) == 0u) { if (xb_ld(&(bar)[XB_TMO])) break; if (_sp > XB_SPIN_CAP) { atomicAdd(&(bar)[XB_TMO], 1u); break; } } } } while (0)

struct XcdBarrier { unsigned* bar; unsigned x; volatile LAS unsigned* st; };

__device__ __forceinline__ XcdBarrier xcd_barrier_post(unsigned* bar, volatile LAS unsigned* st) {
    XcdBarrier b; b.bar = bar; b.x = xb_xcc_id(); b.st = st;
    if (threadIdx.x == 0) (void)xb_add(&bar[XB_XCNT(b.x)], 1u);
    return b;
}
__device__ __forceinline__ void xcd_barrier_complete(unsigned* bar, unsigned x, unsigned& nloc, unsigned& nx) {
    const unsigned G = gridDim.x * gridDim.y * gridDim.z;
    unsigned sum, cnt, mine, sp = 0u;
    for (;;) {
        sum = 0u; cnt = 0u; mine = 0u;
#pragma unroll
        for (unsigned j = 0; j < 16; ++j) { const unsigned c = xb_ld(&bar[XB_XCNT(j)]); sum += c; cnt += (c > 0u) ? 1u : 0u; mine = (j == x) ? c : mine; }
        if (sum == G) break;
        __builtin_amdgcn_s_sleep(1);
        if ((++sp & 255u) == 0u) { if (xb_ld(&bar[XB_TMO])) break; if (sp > XB_SPIN_CAP) { atomicAdd(&bar[XB_TMO], 1u); break; } }
    }
    nloc = mine > 0u ? mine : 1u; nx = cnt > 0u ? cnt : 1u;
}
__device__ __forceinline__ void xcd_barrier(const XcdBarrier& b) {
    asm volatile("s_waitcnt vmcnt(0)" ::: "memory");
    __syncthreads();
    if (threadIdx.x == 0) {
        unsigned* bar = b.bar;
        __builtin_amdgcn_s_waitcnt(0);
        unsigned nloc = b.st[0], nx = b.st[1];
        if (nloc == 0u) { xcd_barrier_complete(bar, b.x, nloc, nx); b.st[0] = nloc; b.st[1] = nx; }
        const unsigned old = xb_add(&bar[XB_XSUB(b.x)], 1u);
        const unsigned gen = old / nloc;
        if (old + 1u == (gen + 1u) * nloc) {
            __builtin_amdgcn_fence(__ATOMIC_RELEASE, "agent");
            asm volatile("s_waitcnt vmcnt(0)" ::: "memory");
            const unsigned og = xb_add(&bar[XB_TOP], 1u);
            const unsigned tg = og / nx;
            if (og + 1u == (tg + 1u) * nx) xb_add(&bar[XB_TOPGEN], 1u);
            else XB_SPIN(xb_ld(&bar[XB_TOPGEN]) == tg, bar);
            __builtin_amdgcn_fence(__ATOMIC_ACQUIRE, "agent");
            xb_add(&bar[XB_XGEN(b.x)], 1u);
            asm volatile("s_waitcnt vmcnt(0)" ::: "memory");
        } else {
            XB_SPIN(xb_ld(&bar[XB_XGEN(b.x)]) == gen, bar);
            __builtin_amdgcn_fence(__ATOMIC_ACQUIRE, "agent");
            asm volatile("s_waitcnt vmcnt(0)" ::: "memory");
        }
    }
    __syncthreads();
}

namespace pg8 {
constexpr int BM = 256, BK = 64, HALF = 128, HTB = HALF * BK * 2, STAGE_BYTES = 8 * HTB, NXCD = 8, WGM = 8, MAXU = 32;
__host__ __device__ __forceinline__ int lds_byte(int r, int c) { const int st = (r >> 4) * 2 + (c >> 5), rr = r & 15, cc = c & 31, ob = rr * 64 + cc * 2; return st * 1024 + (ob ^ (((ob >> 9) & 1) << 5)); }
__host__ __device__ __forceinline__ void stage_rc(int b, int& R, int& C) { const int st = b / 1024, sb = b % 1024, swz = sb ^ (((sb >> 9) & 1) << 5); R = (st >> 1) * 16 + swz / 64; C = (st & 1) * 32 + (swz % 64) / 2; }
__host__ __device__ __forceinline__ int perm32(int rho) { const int n = rho >> 4, i = rho & 15; return 8 * (i >> 2) + 4 * n + (i & 3); }

struct Unit { int pm, pn, e, rowbase, cnt; unsigned boff; int gidx; };

__device__ __forceinline__ bool tile_of(long L, int nM, int nN, int& gm, int& pn) {
    const int nwg = nM * nN; if (L >= nwg) return false;
    int wgid = (int)L; { const int q = nwg / NXCD, r = nwg % NXCD, xcd = wgid % NXCD, off = wgid / NXCD; wgid = (xcd < r ? xcd * (q + 1) : r * (q + 1) + (xcd - r) * q) + off; }
    const int nig = WGM * nN, gid = wgid / nig, fm = gid * WGM, gsz = (nM - fm) < WGM ? (nM - fm) : WGM;
    gm = fm + ((wgid % nig) % gsz); pn = (wgid % nig) / gsz; return true;
}
__device__ __forceinline__ void build_units_dense(const int i, LAS int* ul, int nM, int nN, int RB) {
    if (i < MAXU) { int gm = 0, pn = 0; const bool ok = tile_of((long)i * gridDim.x + blockIdx.x, nM, nN, gm, pn);
        ul[i * 8 + 0] = ok ? 1 : 0; ul[i * 8 + 1] = gm; ul[i * 8 + 2] = pn; ul[i * 8 + 3] = 0; ul[i * 8 + 4] = gm * BM; ul[i * 8 + 5] = BM; ul[i * 8 + 6] = (int)((unsigned)pn * BM * (unsigned)RB); ul[i * 8 + 7] = 0; }
    __syncthreads();
}
__device__ __forceinline__ void build_units_moe(const int i, LAS int* ul, const LAS int* tpre, const LAS int* ebase, const LAS int* ecnt, int nN, int RB, unsigned wstride) {
    if (i < MAXU) { int gm = 0, pn = 0; const bool ok = tile_of((long)i * gridDim.x + blockIdx.x, tpre[NE], nN, gm, pn);
        int e = 0;
_Pragma("unroll 1")
        for (int s = 16; s >= 1; s >>= 1) { if (e + s < NE && tpre[e + s] <= gm) e += s; }
        const int pm = gm - tpre[e];
        ul[i * 8 + 0] = ok ? 1 : 0; ul[i * 8 + 1] = pm; ul[i * 8 + 2] = pn; ul[i * 8 + 3] = e; ul[i * 8 + 4] = ebase[e] + pm * BM; ul[i * 8 + 5] = ecnt[e] - pm * BM;
        ul[i * 8 + 6] = (int)((unsigned)e * wstride + (unsigned)pn * BM * (unsigned)RB); ul[i * 8 + 7] = e * ECAP + pm * BM; }
    __syncthreads();
}
__device__ __forceinline__ bool ld_unit(const LAS int* ul, int i, Unit& u) {
    if (i >= MAXU) return false;
    const LAS int* p = ul + i * 8;
    if (__builtin_amdgcn_readfirstlane(p[0]) == 0) return false;
    u.pm = __builtin_amdgcn_readfirstlane(p[1]); u.pn = __builtin_amdgcn_readfirstlane(p[2]); u.e = __builtin_amdgcn_readfirstlane(p[3]); u.rowbase = __builtin_amdgcn_readfirstlane(p[4]);
    u.cnt = __builtin_amdgcn_readfirstlane(p[5]); u.boff = (unsigned)__builtin_amdgcn_readfirstlane(p[6]); u.gidx = __builtin_amdgcn_readfirstlane(p[7]); return true;
}
__device__ __forceinline__ void glds16(const char* sbase, unsigned voff, LAS unsigned char* dst) {
    asm volatile("" : "+s"(sbase));
    __builtin_amdgcn_global_load_lds((const unsigned*)(sbase + voff), (LAS unsigned*)dst, 16, 0, 0);
}
template <bool GATHER> __device__ __forceinline__ void stage_a(LAS unsigned char* dst, const char* sbase, unsigned o0, unsigned o1, size_t r64) {
    glds16(sbase, o0, dst);
    if constexpr (GATHER) glds16(sbase, o1, dst + 8192);
    else glds16(sbase + r64, o0, dst + 8192);
}

typedef int v8i __attribute__((ext_vector_type(8)));
typedef int v4i __attribute__((ext_vector_type(4)));
__device__ __forceinline__ v8i cat_frag(const bf16x8& a, const bf16x8& b) { return __builtin_shufflevector(__builtin_bit_cast(v4i, a), __builtin_bit_cast(v4i, b), 0, 1, 2, 3, 4, 5, 6, 7); }
template <class Epi, bool GATHER, bool ALIGN_EPI, bool FP8>
__device__ __forceinline__ void gemm_phase(const int tid, LAS unsigned char* lds, const LAS int* ul, LAS int* gtab, const char* Abase, const char* Bbase, const int* rowdst, const int RB, const Epi& E) {
    const int wid = __builtin_amdgcn_readfirstlane(tid >> 6), lane = tid & 63, wr = wid >> 2, wc = wid & 3, fr = lane & 15, fq = lane >> 4;
    const int nt = RB / 128;
    int R0, C0; stage_rc(tid * 16, R0, C0);
    const int Rb0 = Epi::PERM ? ((R0 & ~31) + perm32(R0 & 31)) : R0;
    const unsigned voffB = (unsigned)(Rb0 * RB + C0 * 2);
    const unsigned cb0 = (unsigned)C0 * 2u, K2 = (unsigned)RB;
    const size_t kstep = (size_t)128;
    const size_t r64 = (size_t)64 * RB;
    const size_t hstep = (size_t)HALF * RB;
    const unsigned ldsw = (unsigned)wid * 1024u;
    const int aoff = lds_byte(wr * 64 + fr, fq * 8), boff = lds_byte(wc * 32 + fr, fq * 8);
#define PG8_SA(b, h) (((b) * 2 + (h)) * HTB)
#define PG8_SB(b, h) ((4 + (b) * 2 + (h)) * HTB)
#define PG8_STAGE(bufoff, gbase) do { glds16((const char*)(gbase), voffB, lds + (bufoff) + ldsw); glds16((const char*)(gbase) + r64, voffB, lds + (bufoff) + ldsw + 8192); } while (0)
#define PG8_STAGEA0(bufoff, kb, o0, o1) stage_a<GATHER>(lds + (bufoff) + ldsw, Abase + (kb), o0, o1, r64)
#define PG8_STAGEA1(bufoff, kb, o0, o2, o3) stage_a<GATHER>(lds + (bufoff) + ldsw, Abase + (kb) + (GATHER ? (size_t)0 : hstep), GATHER ? (o2) : (o0), o3, r64)
#define PG8_LDA(dst, b, h) do { _Pragma("unroll") for (int m = 0; m < 4; ++m) { const v4i _l = *(const LAS v4i*)(lds + PG8_SA(b, h) + aoff + m * 2048), _h = *(const LAS v4i*)(lds + PG8_SA(b, h) + aoff + m * 2048 + 1024); dst[m] = __builtin_shufflevector(_l, _h, 0, 1, 2, 3, 4, 5, 6, 7); } } while (0)
#define PG8_LDB(dst, b, h) do { _Pragma("unroll") for (int n = 0; n < 2; ++n) { const v4i _l = *(const LAS v4i*)(lds + PG8_SB(b, h) + boff + n * 2048), _h = *(const LAS v4i*)(lds + PG8_SB(b, h) + boff + n * 2048 + 1024); dst[n] = __builtin_shufflevector(_l, _h, 0, 1, 2, 3, 4, 5, 6, 7); } } while (0)
#define PG8_LO(x) __builtin_bit_cast(bf16x8, __builtin_shufflevector(x, x, 0, 1, 2, 3))
#define PG8_HI(x) __builtin_bit_cast(bf16x8, __builtin_shufflevector(x, x, 4, 5, 6, 7))
#define PG8_MMA(ai, bj, At, Bt) do { __builtin_amdgcn_s_setprio(1); _Pragma("unroll") for (int m = 0; m < 4; ++m) _Pragma("unroll") for (int n = 0; n < 2; ++n) { \
        if constexpr (FP8) asm volatile("v_mfma_scale_f32_16x16x128_f8f6f4 %0, %1, %2, %0, %3, %3 op_sel_hi:[0,0,0]" : "+v"(acc[ai][bj][m][n]) : "v"(Bt[n]), "v"(At[m]), "v"(sc1)); \
        else { acc[ai][bj][m][n] = __builtin_amdgcn_mfma_f32_16x16x32_bf16(PG8_LO(Bt[n]), PG8_LO(At[m]), acc[ai][bj][m][n], 0, 0, 0); \
               acc[ai][bj][m][n] = __builtin_amdgcn_mfma_f32_16x16x32_bf16(PG8_HI(Bt[n]), PG8_HI(At[m]), acc[ai][bj][m][n], 0, 0, 0); } } \
        __builtin_amdgcn_s_setprio(0); } while (0)
#define PG8_WAIT_V(n) asm volatile("s_waitcnt vmcnt(" #n ")" ::: "memory")
#define PG8_WAIT_L(n) asm volatile("s_waitcnt lgkmcnt(" #n ")" ::: "memory")
#define PG8_BAR __builtin_amdgcn_s_barrier()
#define PG8_SCHED __builtin_amdgcn_sched_barrier(0)
    Unit cur, nxt; int ui = 0;
    if (!ld_unit(ul, 0, cur)) return;
    f32x4 acc[2][2][4][2];
#pragma unroll
    for (int a = 0; a < 2; ++a)
#pragma unroll
        for (int b = 0; b < 2; ++b)
#pragma unroll
            for (int m = 0; m < 4; ++m)
#pragma unroll
                for (int n = 0; n < 2; ++n) acc[a][b][m][n] = (f32x4){0.f, 0.f, 0.f, 0.f};
    v8i At[4], B0[2], B1[2];
    const int sc1 = 0x7f7f7f7f;
    unsigned oA0, oA1 = 0, oA2 = 0, oA3 = 0, oN0, oN1 = 0, oN2 = 0, oN3 = 0;
    if constexpr (GATHER) {
        const int c1 = cur.cnt - 1; const int* gp = rowdst + cur.gidx;
        oA0 = ((unsigned)gp[min(R0, c1)] >> 2) * K2 + cb0; oA1 = ((unsigned)gp[min(R0 + 64, c1)] >> 2) * K2 + cb0; oA2 = ((unsigned)gp[min(R0 + 128, c1)] >> 2) * K2 + cb0; oA3 = ((unsigned)gp[min(R0 + 192, c1)] >> 2) * K2 + cb0;
    } else {
        oA0 = (unsigned)(cur.rowbase + R0) * K2 + cb0;
    }
    oN0 = oA0; oN1 = oA1; oN2 = oA2; oN3 = oA3;
    const char* cB = Bbase + cur.boff;
    PG8_STAGE(PG8_SB(0, 0), cB); PG8_STAGE(PG8_SB(0, 1), cB + hstep); PG8_STAGEA0(PG8_SA(0, 0), (size_t)0, oA0, oA1); PG8_STAGEA1(PG8_SA(0, 1), (size_t)0, oA0, oA2, oA3);
    if (wr == 1) PG8_BAR;
    PG8_WAIT_V(2); PG8_BAR;
    PG8_STAGE(PG8_SB(1, 0), cB + kstep); PG8_STAGEA0(PG8_SA(1, 0), kstep, oA0, oA1); PG8_STAGE(PG8_SB(1, 1), cB + hstep + kstep);
    PG8_WAIT_V(6); PG8_BAR;
    for (;;) {
        const bool has_next = ld_unit(ul, ui + 1, nxt);
        const char* nB = has_next ? Bbase + nxt.boff : cB;
        if constexpr (GATHER) {
            if (has_next && tid < 256) gtab[tid] = (int)((unsigned)rowdst[nxt.gidx + min(tid, nxt.cnt - 1)] >> 2);
        }
_Pragma("unroll 1")
        for (int t = 0; t < nt; t += 2) {
            const bool last = (t == nt - 2);
            if (last && has_next) {
                if constexpr (GATHER) {
                    oN0 = (unsigned)gtab[R0] * K2 + cb0; oN1 = (unsigned)gtab[R0 + 64] * K2 + cb0; oN2 = (unsigned)gtab[R0 + 128] * K2 + cb0; oN3 = (unsigned)gtab[R0 + 192] * K2 + cb0;
                } else {
                    oN0 = (unsigned)(nxt.rowbase + R0) * K2 + cb0;
                }
            }
            const size_t kb1 = (size_t)(t + 1) * kstep;
            const size_t kb2 = last ? (size_t)0 : (size_t)(t + 2) * kstep, kb3 = kb2 + kstep;
            const unsigned p0 = last ? oN0 : oA0, p1 = last ? oN1 : oA1, p2 = last ? oN2 : oA2, p3 = last ? oN3 : oA3;
            const char* b2 = last ? nB : cB + (size_t)(t + 2) * kstep; const char* b3 = b2 + kstep;
            PG8_LDB(B0, 0, 0); PG8_LDB(B1, 0, 1); PG8_SCHED; PG8_LDA(At, 0, 0); PG8_STAGEA1(PG8_SA(1, 1), kb1, oA0, oA2, oA3);
            PG8_WAIT_V(8); PG8_WAIT_L(0); PG8_BAR; PG8_MMA(0, 0, At, B0); PG8_MMA(0, 1, At, B1); PG8_BAR; PG8_SCHED;
            PG8_LDA(At, 0, 1); PG8_STAGE(PG8_SB(0, 0), b2); PG8_STAGE(PG8_SB(0, 1), b2 + hstep); PG8_STAGEA0(PG8_SA(0, 0), kb2, p0, p1);
            PG8_WAIT_V(8); PG8_WAIT_L(0); PG8_BAR; PG8_MMA(1, 0, At, B0); PG8_MMA(1, 1, At, B1); PG8_BAR; PG8_SCHED;
            PG8_LDB(B0, 1, 0); PG8_LDB(B1, 1, 1); PG8_SCHED; PG8_LDA(At, 1, 0); PG8_STAGEA1(PG8_SA(0, 1), kb2, p0, p2, p3);
            PG8_WAIT_V(8); PG8_WAIT_L(0); PG8_BAR; PG8_MMA(0, 0, At, B0); PG8_MMA(0, 1, At, B1); PG8_BAR; PG8_SCHED;
            PG8_LDA(At, 1, 1); PG8_STAGE(PG8_SB(1, 0), b3); PG8_STAGE(PG8_SB(1, 1), b3 + hstep); PG8_STAGEA0(PG8_SA(1, 0), kb3, p0, p1);
            PG8_WAIT_V(8); PG8_WAIT_L(0); PG8_BAR; PG8_MMA(1, 0, At, B0); PG8_MMA(1, 1, At, B1); PG8_BAR; PG8_SCHED;
        }
        if constexpr (FP8) asm volatile("s_nop 7\n\ts_nop 7\n\ts_nop 7" ::: "memory");
        if constexpr (ALIGN_EPI) { if (wr == 0) PG8_BAR; }
        E(acc, cur, wr, wc, fr, fq);
#if PROBE_EPI2
        if constexpr (FP8) E(acc, cur, wr, wc, fr, fq);
#endif
        if (!has_next) break;
#pragma unroll
        for (int a = 0; a < 2; ++a)
#pragma unroll
            for (int b = 0; b < 2; ++b)
#pragma unroll
                for (int m = 0; m < 4; ++m)
#pragma unroll
                    for (int n = 0; n < 2; ++n) acc[a][b][m][n] = (f32x4){0.f, 0.f, 0.f, 0.f};
        cur = nxt; cB = nB; oA0 = oN0; oA1 = oN1; oA2 = oN2; oA3 = oN3; ++ui;
        if constexpr (ALIGN_EPI) { if (wr == 1) PG8_BAR; }
    }
    PG8_WAIT_V(0);
    if constexpr (!ALIGN_EPI) { if (wr == 0) PG8_BAR; }
    PG8_BAR;
#undef PG8_SA
#undef PG8_SB
#undef PG8_STAGE
#undef PG8_STAGEA0
#undef PG8_STAGEA1
#undef PG8_LDA
#undef PG8_LDB
#undef PG8_LO
#undef PG8_HI
#undef PG8_MMA
#undef PG8_WAIT_V
#undef PG8_WAIT_L
#undef PG8_BAR
#undef PG8_SCHED
}

__device__ __forceinline__ GAS unsigned char* launder(unsigned char* p) { asm volatile("" : "+s"(p)); return (GAS unsigned char*)p; }
#define OPAQUE_LANE(fr, fq) asm volatile("" : "+v"(fr), "+v"(fq))
struct EpiHgrnIn {
    static constexpr bool PERM = true;
    unsigned char* ws0; int L;
    __device__ __forceinline__ void operator()(const f32x4 (&acc)[2][2][4][2], const Unit& u, int wr, int wc, int fr, int fq) const {
        OPAQUE_LANE(fr, fq);
        GAS unsigned char* ws = launder(ws0);
        GAS bf16* QD = (GAS bf16*)(ws + WS_H);
        const int row0 = u.rowbase + wr * 64 + fr;
        if (u.pn >= 8) {
            const bool isg = u.pn >= 12; GAS bf16* base = QD + (size_t)(isg ? 4 : 3) * NTOK * DM; const int colt = (u.pn - (isg ? 12 : 8)) * BM + wc * 32 + 8 * fq;
#pragma unroll
            for (int ai = 0; ai < 2; ++ai)
#pragma unroll
                for (int m = 0; m < 4; ++m) { GAS bf16* rowp = base + (size_t)(row0 + ai * HALF + m * 16) * DM + colt;
#pragma unroll
                    for (int bj = 0; bj < 2; ++bj) { f32x4 v0 = acc[ai][bj][m][0], v1 = acc[ai][bj][m][1];
                        if (isg) {
#pragma unroll
                            for (int j = 0; j < 4; ++j) { v0[j] = v0[j] * fsigmoid(v0[j]); v1[j] = v1[j] * fsigmoid(v1[j]); } }
                        v4u w; w.x = cvt_pk_bf16(v0[0], v0[1]); w.y = cvt_pk_bf16(v0[2], v0[3]); w.z = cvt_pk_bf16(v1[0], v1[1]); w.w = cvt_pk_bf16(v1[2], v1[3]);
                        *(GAS v4u*)(rowp + bj * HALF) = w; } }
            return;
        }
        const int col = u.pn * HG_K + wc * 32 + 8 * fq;
        const GAS float* lb = (const GAS float*)(ws + WS_LBS) + L * DM;
        const f32x4 lb0 = *(const GAS f32x4*)(lb + col), lb1 = *(const GAS f32x4*)(lb + col + 4);
#if !SLOW_HGRN
        const int lane = fq * 16 + fr;
        GAS float* DEC = (GAS float*)(ws + WS_DEC);
#endif
#pragma unroll
        for (int ai = 0; ai < 2; ++ai)
#pragma unroll
            for (int m = 0; m < 4; ++m) {
                const int row = row0 + ai * HALF + m * 16;
                float qd[8], ki[8], ks[8];
#if !SLOW_HGRN
                float de[8];
#endif
#pragma unroll
                for (int j = 0; j < 8; ++j) {
                    const float q = acc[ai][0][m][j >> 2][j & 3], f = acc[ai][1][m][j >> 2][j & 3], lbv = j < 4 ? lb0[j & 3] : lb1[j & 3];
                    const float sg = fsigmoid(f), fg = lbv + (1.0f - lbv) * sg, kk = (1.0f - lbv) * (1.0f - sg);
#if SLOW_HGRN
                    qd[j] = q * fsigmoid(q); ki[j] = kk; ks[j] = fg;
#else
                    float b = __builtin_amdgcn_logf(fg) * 0.6931471805599453f;
                    b += __builtin_bit_cast(float, __builtin_amdgcn_update_dpp(0, __builtin_bit_cast(int, b), 0x111, 0xf, 0xf, true));
                    b += __builtin_bit_cast(float, __builtin_amdgcn_update_dpp(0, __builtin_bit_cast(int, b), 0x112, 0xf, 0xf, true));
                    b += __builtin_bit_cast(float, __builtin_amdgcn_update_dpp(0, __builtin_bit_cast(int, b), 0x114, 0xf, 0xf, true));
                    b += __builtin_bit_cast(float, __builtin_amdgcn_update_dpp(0, __builtin_bit_cast(int, b), 0x118, 0xf, 0xf, true));
                    const float bl = __shfl(b, lane | 15);
                    qd[j] = q * fsigmoid(q) * fexp(b); ki[j] = kk * fexp(-b); ks[j] = kk * fexp(bl - b); de[j] = fexp(bl);
#endif
                }
                const size_t o = (size_t)row * DM + col;
                v4u w;
                w.x = cvt_pk_bf16(qd[0], qd[1]); w.y = cvt_pk_bf16(qd[2], qd[3]); w.z = cvt_pk_bf16(qd[4], qd[5]); w.w = cvt_pk_bf16(qd[6], qd[7]); *(GAS v4u*)(QD + o) = w;
                w.x = cvt_pk_bf16(ki[0], ki[1]); w.y = cvt_pk_bf16(ki[2], ki[3]); w.z = cvt_pk_bf16(ki[4], ki[5]); w.w = cvt_pk_bf16(ki[6], ki[7]); *(GAS v4u*)(QD + (size_t)NTOK * DM + o) = w;
                w.x = cvt_pk_bf16(ks[0], ks[1]); w.y = cvt_pk_bf16(ks[2], ks[3]); w.z = cvt_pk_bf16(ks[4], ks[5]); w.w = cvt_pk_bf16(ks[6], ks[7]); *(GAS v4u*)(QD + 2 * (size_t)NTOK * DM + o) = w;
#if !SLOW_HGRN
                if (fr == 0) { GAS float* dp = DEC + (size_t)(row >> 4) * DM + col; *(GAS f32x4*)dp = (f32x4){de[0], de[1], de[2], de[3]}; *(GAS f32x4*)(dp + 4) = (f32x4){de[4], de[5], de[6], de[7]}; }
#endif
            }
    }
};
struct EpiRetIn {
    static constexpr bool PERM = true;
    unsigned char* ws0;
    __device__ __forceinline__ void operator()(const f32x4 (&acc)[2][2][4][2], const Unit& u, int wr, int wc, int fr, int fq) const {
        OPAQUE_LANE(fr, fq);
        GAS unsigned char* ws = launder(ws0);
        GAS bf16* H = (GAS bf16*)(ws + WS_H); const GAS float* rot = (const GAS float*)(ws + WS_ROT);
        const int row0 = u.rowbase + wr * 64 + fr; const int colt = u.pn * BM + wc * 32 + 8 * fq;
        const int kind = u.pn < 4 ? 0 : (u.pn < 8 ? 1 : (u.pn < 16 ? 2 : 3));
#pragma unroll
        for (int ai = 0; ai < 2; ++ai)
#pragma unroll
            for (int m = 0; m < 4; ++m) { const int row = row0 + ai * HALF + m * 16; GAS bf16* rowp = H + (size_t)row * RT_IN + colt; const int pos = row & (SEQ - 1);
#pragma unroll
                for (int bj = 0; bj < 2; ++bj) { f32x4 v0 = acc[ai][bj][m][0], v1 = acc[ai][bj][m][1];
                    if (kind <= 1) {
                        const int p0 = (bj * HALF + wc * 32 + 8 * fq) >> 1;
                        const GAS float* rp = rot + ((size_t)pos * 128 + p0) * 2;
                        const f32x4 r0 = *(const GAS f32x4*)rp, r1 = *(const GAS f32x4*)(rp + 4);
                        const float sc = kind == 1 ? 0.0625f : 1.0f;
                        f32x4 o0, o1;
                        o0[0] = (v0[0] * r0[0] - v0[1] * r0[1]) * sc; o0[1] = (v0[1] * r0[0] + v0[0] * r0[1]) * sc;
                        o0[2] = (v0[2] * r0[2] - v0[3] * r0[3]) * sc; o0[3] = (v0[3] * r0[2] + v0[2] * r0[3]) * sc;
                        o1[0] = (v1[0] * r1[0] - v1[1] * r1[1]) * sc; o1[1] = (v1[1] * r1[0] + v1[0] * r1[1]) * sc;
                        o1[2] = (v1[2] * r1[2] - v1[3] * r1[3]) * sc; o1[3] = (v1[3] * r1[2] + v1[2] * r1[3]) * sc;
                        v0 = o0; v1 = o1;
                    } else if (kind == 3) {
#pragma unroll
                        for (int j = 0; j < 4; ++j) { v0[j] = v0[j] * fsigmoid(v0[j]); v1[j] = v1[j] * fsigmoid(v1[j]); }
                    }
                    v4u w; w.x = cvt_pk_bf16(v0[0], v0[1]); w.y = cvt_pk_bf16(v0[2], v0[3]); w.z = cvt_pk_bf16(v1[0], v1[1]); w.w = cvt_pk_bf16(v1[2], v1[3]);
                    *(GAS v4u*)(rowp + bj * HALF) = w; } }
    }
};
struct EpiRes {
    static constexpr bool PERM = true;
    unsigned char* ws0;
    __device__ __forceinline__ void operator()(const f32x4 (&acc)[2][2][4][2], const Unit& u, int wr, int wc, int fr, int fq) const {
        OPAQUE_LANE(fr, fq);
        GAS unsigned char* ws = launder(ws0);
        GAS bf16* Y = (GAS bf16*)(ws + WS_Y); const GAS bf16* X = (const GAS bf16*)(ws + WS_XB);
        const int row0 = u.rowbase + wr * 64 + fr, col0 = u.pn * BM + wc * 32 + 8 * fq;
#pragma unroll
        for (int ai = 0; ai < 2; ++ai)
#pragma unroll
            for (int m = 0; m < 4; ++m) { const size_t off = (size_t)(row0 + ai * HALF + m * 16) * DM + col0;
#pragma unroll
                for (int bj = 0; bj < 2; ++bj) { const v4u xs = *(const GAS v4u*)(X + off + bj * HALF); const f32x4 a0 = acc[ai][bj][m][0], a1 = acc[ai][bj][m][1];
                    v4u w; w.x = cvt_pk_bf16(bflo(xs.x) * DN_ALPHA + a0[0], bfhi(xs.x) * DN_ALPHA + a0[1]); w.y = cvt_pk_bf16(bflo(xs.y) * DN_ALPHA + a0[2], bfhi(xs.y) * DN_ALPHA + a0[3]);
                    w.z = cvt_pk_bf16(bflo(xs.z) * DN_ALPHA + a1[0], bfhi(xs.z) * DN_ALPHA + a1[1]); w.w = cvt_pk_bf16(bflo(xs.w) * DN_ALPHA + a1[2], bfhi(xs.w) * DN_ALPHA + a1[3]);
                    *(GAS v4u*)(Y + off + bj * HALF) = w; } }
    }
};
struct EpiMoeGU {
    static constexpr bool PERM = true;
    unsigned char* ws0; int L;
    __device__ __forceinline__ void operator()(const f32x4 (&acc)[2][2][4][2], const Unit& u, int wr, int wc, int fr, int fq) const {
        OPAQUE_LANE(fr, fq);
        GAS unsigned char* ws = launder(ws0);
        const GAS float* bias = (const GAS float*)(ws + WS_BGU) + (size_t)L * NE * 2048;
        const int row0 = u.rowbase + wr * 64 + fr; const int c8 = wc * 32 + 8 * fq;
        const GAS float* bp = bias + ((size_t)u.e * 8 + u.pn) * 256 + c8;
        const f32x4 bg0 = *(const GAS f32x4*)bp, bg1 = *(const GAS f32x4*)(bp + 4), bl0 = *(const GAS f32x4*)(bp + HALF), bl1 = *(const GAS f32x4*)(bp + HALF + 4);
#pragma unroll
        for (int ai = 0; ai < 2; ++ai)
#pragma unroll
            for (int m = 0; m < 4; ++m) { const size_t eo = (size_t)(row0 + ai * HALF + m * 16) * DM + u.pn * HALF + c8;
                float a[8];
#pragma unroll
                for (int j = 0; j < 8; ++j) {
                    float g = acc[ai][0][m][j >> 2][j & 3] * GU_DESCALE + (j < 4 ? bg0[j & 3] : bg1[j & 3]);
                    float l = acc[ai][1][m][j >> 2][j & 3] * GU_DESCALE + (j < 4 ? bl0[j & 3] : bl1[j & 3]);
                    g = fminf(g, 7.0f); l = fminf(fmaxf(l, -7.0f), 7.0f);
                    a[j] = g * fsigmoid(1.702f * g) * (l + 1.0f);
                }
#if MOE_FP8
                v2u w; w.x = pk4_fp8(a[0] * ACT_SCALE, a[1] * ACT_SCALE, a[2] * ACT_SCALE, a[3] * ACT_SCALE); w.y = pk4_fp8(a[4] * ACT_SCALE, a[5] * ACT_SCALE, a[6] * ACT_SCALE, a[7] * ACT_SCALE);
                *(GAS v2u*)(ws + WS_ACT + eo) = w;
#else
                v4u w; w.x = cvt_pk_bf16(a[0], a[1]); w.y = cvt_pk_bf16(a[2], a[3]); w.z = cvt_pk_bf16(a[4], a[5]); w.w = cvt_pk_bf16(a[6], a[7]);
                *(GAS v4u*)((GAS bf16*)(ws + WS_ACT) + eo) = w;
#endif
            }
    }
};
struct EpiMoeDown {
    static constexpr bool PERM = true;
    unsigned char* ws0; const float* bias;
    __device__ __forceinline__ void operator()(const f32x4 (&acc)[2][2][4][2], const Unit& u, int wr, int wc, int fr, int fq) const {
        OPAQUE_LANE(fr, fq);
        GAS unsigned char* ws = launder(ws0);
        GAS bf16* YS = (GAS bf16*)(ws + WS_YSLOT); const GAS int* rowdst = (const GAS int*)(ws + WS_ROWDST); const GAS float* rowgate = (const GAS float*)(ws + WS_ROWGATE);
        const int c8 = u.pn * BM + wc * 32 + 8 * fq;
        const GAS float* bp = (const GAS float*)bias + (size_t)u.e * DM + c8;
        f32x4 bv[2][2];
#pragma unroll
        for (int bj = 0; bj < 2; ++bj) { bv[bj][0] = *(const GAS f32x4*)(bp + bj * HALF); bv[bj][1] = *(const GAS f32x4*)(bp + bj * HALF + 4); }
#pragma unroll
        for (int ai = 0; ai < 2; ++ai)
#pragma unroll
            for (int m = 0; m < 4; ++m) { const int r = ai * HALF + wr * 64 + m * 16 + fr;
                if (r < u.cnt) {
                    const size_t ti = (size_t)u.gidx + r; const int dst = rowdst[ti]; const float gt = rowgate[ti];
                    GAS bf16* rowp = YS + (size_t)dst * DM + c8;
#pragma unroll
                    for (int bj = 0; bj < 2; ++bj) { const f32x4 v0 = (acc[ai][bj][m][0] * DN_DESCALE + bv[bj][0]) * gt, v1 = (acc[ai][bj][m][1] * DN_DESCALE + bv[bj][1]) * gt;
                        v4u w; w.x = cvt_pk_bf16(v0[0], v0[1]); w.y = cvt_pk_bf16(v0[2], v0[3]); w.z = cvt_pk_bf16(v1[0], v1[1]); w.w = cvt_pk_bf16(v1[2], v1[3]);
                        *(GAS v4u*)(rowp + bj * HALF) = w; } } }
    }
};
}

typedef short s16x4 __attribute__((ext_vector_type(4)));
typedef __bf16 bf16x2_t __attribute__((ext_vector_type(2)));
__device__ __forceinline__ unsigned cvtpk(float lo, float hi) { f32x2 v = {lo, hi}; bf16x2_t b = __builtin_convertvector(v, bf16x2_t); return __builtin_bit_cast(unsigned, b); }
__device__ __forceinline__ s16x4 tr_read(const LAS unsigned char* p) { return __builtin_bit_cast(s16x4, __builtin_amdgcn_ds_read_tr16_b64_v4i16((LAS s16x4*)p)); }
__device__ __forceinline__ bf16x8 cat8(s16x4 lo, s16x4 hi) { return __builtin_shufflevector(lo, hi, 0, 1, 2, 3, 4, 5, 6, 7); }
__device__ __forceinline__ bf16x8 pack8(const f32x4& a, const f32x4& b) { v4u p; p.x = cvtpk(a[0], a[1]); p.y = cvtpk(a[2], a[3]); p.z = cvtpk(b[0], b[1]); p.w = cvtpk(b[2], b[3]); return __builtin_bit_cast(bf16x8, p); }
__device__ __forceinline__ s16x4 pack4(const f32x4& a) { v2u p; p.x = cvtpk(a[0], a[1]); p.y = cvtpk(a[2], a[3]); return __builtin_bit_cast(s16x4, p); }
#define LDS_BARRIER() do { asm volatile("s_waitcnt lgkmcnt(0)" ::: "memory"); __builtin_amdgcn_s_barrier(); asm volatile("" ::: "memory"); } while (0)
#define MFMA32(a, b, c) __builtin_amdgcn_mfma_f32_16x16x32_bf16((a), (b), (c), 0, 0, 0)
#define MFMA16(a, b, c) __builtin_amdgcn_mfma_f32_16x16x16bf16_1k((a), (b), (c), 0, 0, 0)

__device__ __forceinline__ void ret_fast(const int tid, LAS unsigned char* lds, const bf16* HB, bf16* OB) {
    constexpr int QP = 528, VP = 272, PP = 144;
    constexpr int OFF_Q = 0, OFF_K = 64 * QP, OFF_V = 2 * 64 * QP, OFF_P = OFF_V + 64 * VP;
    const int lane0 = tid & 63, w = __builtin_amdgcn_readfirstlane(tid >> 6);
    const int prow = tid >> 3, pc = tid & 7;
    for (int un0 = blockIdx.x; un0 < NBATCH * RT_HEADS * 4; un0 += gridDim.x) {
        const int un = (gridDim.x == 256) ? ((un0 & 7) * 32 + (un0 >> 3)) : un0;
        const int b = un >> 4, h = (un >> 2) & 3, vs = un & 3;
        const float l2g = __builtin_amdgcn_logf(1.0f - __builtin_amdgcn_exp2f(-5.0f - (float)h));
        const float dC = __builtin_amdgcn_exp2f(64.0f * l2g);
        f32x4 st[16];
#pragma unroll
        for (int i = 0; i < 16; ++i) st[i] = (f32x4){0.f, 0.f, 0.f, 0.f};
        const bf16* gbase = HB + (size_t)(b * SEQ + prow) * RT_IN;
        v4u pq[4], pk[4], pv[2];
#pragma unroll
        for (int j = 0; j < 4; ++j) { pq[j] = *(const v4u*)(gbase + h * 256 + (pc + 8 * j) * 8); pk[j] = *(const v4u*)(gbase + 1024 + h * 256 + (pc + 8 * j) * 8); }
#pragma unroll
        for (int j = 0; j < 2; ++j) pv[j] = *(const v4u*)(gbase + 2048 + h * 512 + vs * 128 + (pc + 8 * j) * 8);
#pragma unroll 1
        for (int ch = 0; ch < SEQ / 64; ++ch) {
            int lane = lane0; asm volatile("" : "+v"(lane));
            const int r = lane & 15, g = lane >> 4, q4 = (lane & 15) >> 2, p4 = lane & 3;
            LDS_BARRIER();
#pragma unroll
            for (int j = 0; j < 4; ++j) { *(LAS v4u*)(lds + OFF_Q + prow * QP + (pc + 8 * j) * 16) = pq[j]; *(LAS v4u*)(lds + OFF_K + prow * QP + (pc + 8 * j) * 16) = pk[j]; }
#pragma unroll
            for (int j = 0; j < 2; ++j) *(LAS v4u*)(lds + OFF_V + prow * VP + (pc + 8 * j) * 16) = pv[j];
            if (ch + 1 < SEQ / 64) {
                const bf16* gn = gbase + (size_t)(ch + 1) * 64 * RT_IN;
#pragma unroll
                for (int j = 0; j < 4; ++j) { pq[j] = *(const v4u*)(gn + h * 256 + (pc + 8 * j) * 8); pk[j] = *(const v4u*)(gn + 1024 + h * 256 + (pc + 8 * j) * 8); }
#pragma unroll
                for (int j = 0; j < 2; ++j) pv[j] = *(const v4u*)(gn + 2048 + h * 512 + vs * 128 + (pc + 8 * j) * 8);
            }
            LDS_BARRIER();
            {
                const int ct = w >> 1, st0 = 2 * (w & 1);
                f32x4 sa0 = {0.f, 0.f, 0.f, 0.f}, sa1 = {0.f, 0.f, 0.f, 0.f};
                const LAS unsigned char* qb = lds + OFF_Q + (16 * ct + r) * QP + g * 16;
                const LAS unsigned char* kb0 = lds + OFF_K + (16 * st0 + r) * QP + g * 16;
#pragma unroll
                for (int hb = 0; hb < 4; ++hb) {
                    bf16x8 qf[2], k0[2], k1[2];
#pragma unroll
                    for (int kk = 0; kk < 2; ++kk) { const int kb = hb * 2 + kk; qf[kk] = *(const LAS bf16x8*)(qb + kb * 64); k0[kk] = *(const LAS bf16x8*)(kb0 + kb * 64); k1[kk] = *(const LAS bf16x8*)(kb0 + 16 * QP + kb * 64); }
                    asm volatile("" : "+v"(qf[0]), "+v"(qf[1]), "+v"(k0[0]), "+v"(k0[1]), "+v"(k1[0]), "+v"(k1[1]) :: "memory");
#pragma unroll
                    for (int kk = 0; kk < 2; ++kk) { sa0 = MFMA32(k0[kk], qf[kk], sa0); sa1 = MFMA32(k1[kk], qf[kk], sa1); }
                }
                const int c = 16 * ct + r;
#pragma unroll
                for (int t = 0; t < 2; ++t) {
                    const f32x4 sa = t ? sa1 : sa0; const int s0 = 16 * (st0 + t) + 4 * g; float v[4];
#pragma unroll
                    for (int i = 0; i < 4; ++i) { const int d = c - (s0 + i); v[i] = d >= 0 ? sa[i] * __builtin_amdgcn_exp2f((float)d * l2g) : 0.f; }
                    v2u pw; pw.x = cvtpk(v[0], v[1]); pw.y = cvtpk(v[2], v[3]);
                    *(LAS v2u*)(lds + OFF_P + c * PP + s0 * 2) = pw;
                }
            }
            LDS_BARRIER();
            f32x4 o[4];
#pragma unroll
            for (int ct = 0; ct < 4; ++ct) o[ct] = (f32x4){0.f, 0.f, 0.f, 0.f};
            {
                s16x4 ql[2][4], qh[2][4];
                const LAS unsigned char* qp0 = lds + OFF_Q + r * QP + (4 * g) * 2;
#pragma unroll
                for (int ct = 0; ct < 4; ++ct) { ql[0][ct] = *(const LAS s16x4*)(qp0 + ct * 16 * QP); qh[0][ct] = *(const LAS s16x4*)(qp0 + ct * 16 * QP + 32); }
#pragma unroll
                for (int kb = 0; kb < 8; ++kb) {
                    const int cu = kb & 1, nx = cu ^ 1;
                    if (kb + 1 < 8) {
#pragma unroll
                        for (int ct = 0; ct < 4; ++ct) { ql[nx][ct] = *(const LAS s16x4*)(qp0 + ct * 16 * QP + (kb + 1) * 64); qh[nx][ct] = *(const LAS s16x4*)(qp0 + ct * 16 * QP + (kb + 1) * 64 + 32); }
                    }
                    asm volatile("" : "+v"(ql[cu][0]), "+v"(ql[cu][1]), "+v"(ql[cu][2]), "+v"(ql[cu][3]), "+v"(qh[cu][0]), "+v"(qh[cu][1]), "+v"(qh[cu][2]), "+v"(qh[cu][3]) :: "memory");
                    const bf16x8 sa = pack8(st[2 * kb], st[2 * kb + 1]);
#pragma unroll
                    for (int ct = 0; ct < 4; ++ct) o[ct] = MFMA32(sa, cat8(ql[cu][ct], qh[cu][ct]), o[ct]);
                }
            }
            bf16x8 vf[2], pf[6];
            {
                s16x4 t0[2], t1[2];
#pragma unroll
                for (int sb = 0; sb < 2; ++sb) { const LAS unsigned char* vp = lds + OFF_V + (32 * sb + 8 * g + q4) * VP + (16 * w + 4 * p4) * 2; t0[sb] = tr_read(vp); t1[sb] = tr_read(vp + 4 * VP); }
                pf[0] = *(const LAS bf16x8*)(lds + OFF_P + (0 + r) * PP + (8 * g) * 2);
                pf[1] = *(const LAS bf16x8*)(lds + OFF_P + (16 + r) * PP + (8 * g) * 2);
                pf[2] = *(const LAS bf16x8*)(lds + OFF_P + (32 + r) * PP + (8 * g) * 2);
                pf[3] = *(const LAS bf16x8*)(lds + OFF_P + (32 + r) * PP + (32 + 8 * g) * 2);
                pf[4] = *(const LAS bf16x8*)(lds + OFF_P + (48 + r) * PP + (8 * g) * 2);
                pf[5] = *(const LAS bf16x8*)(lds + OFF_P + (48 + r) * PP + (32 + 8 * g) * 2);
                asm volatile("" : "+v"(t0[0]), "+v"(t0[1]), "+v"(t1[0]), "+v"(t1[1]), "+v"(pf[0]), "+v"(pf[1]), "+v"(pf[2]), "+v"(pf[3]), "+v"(pf[4]), "+v"(pf[5]) :: "memory");
                vf[0] = cat8(t0[0], t1[0]); vf[1] = cat8(t0[1], t1[1]);
            }
#pragma unroll
            for (int ct = 0; ct < 4; ++ct) o[ct] = o[ct] * __builtin_amdgcn_exp2f((float)(16 * ct + r + 1) * l2g);
            o[0] = MFMA32(vf[0], pf[0], o[0]); o[1] = MFMA32(vf[0], pf[1], o[1]);
            o[2] = MFMA32(vf[0], pf[2], o[2]); o[2] = MFMA32(vf[1], pf[3], o[2]);
            o[3] = MFMA32(vf[0], pf[4], o[3]); o[3] = MFMA32(vf[1], pf[5], o[3]);
            {
                bf16* ob = OB + (size_t)(b * SEQ + ch * 64 + r) * RT_VD + h * 512 + vs * 128 + 16 * w + 4 * g;
#pragma unroll
                for (int ct = 0; ct < 4; ++ct) { v2u ow; ow.x = cvtpk(o[ct][0], o[ct][1]); ow.y = cvtpk(o[ct][2], o[ct][3]); *(v2u*)(ob + (size_t)ct * 16 * RT_VD) = ow; }
            }
            bf16x8 vz[2];
#pragma unroll
            for (int sb = 0; sb < 2; ++sb) {
                const v4u raw = __builtin_bit_cast(v4u, vf[sb]); float f[8] = {bflo(raw.x), bfhi(raw.x), bflo(raw.y), bfhi(raw.y), bflo(raw.z), bfhi(raw.z), bflo(raw.w), bfhi(raw.w)};
#pragma unroll
                for (int j = 0; j < 8; ++j) f[j] *= __builtin_amdgcn_exp2f((float)(63 - (32 * sb + 8 * g + j)) * l2g);
                v4u z; z.x = cvtpk(f[0], f[1]); z.y = cvtpk(f[2], f[3]); z.z = cvtpk(f[4], f[5]); z.w = cvtpk(f[6], f[7]); vz[sb] = __builtin_bit_cast(bf16x8, z);
            }
            {
                const LAS unsigned char* kp0 = lds + OFF_K + (8 * g + q4) * QP + (4 * p4) * 2;
#pragma unroll
                for (int kq = 0; kq < 4; ++kq) {
                    s16x4 ka[4][2], kbh[4][2];
#pragma unroll
                    for (int j = 0; j < 4; ++j)
#pragma unroll
                        for (int sb = 0; sb < 2; ++sb) { const LAS unsigned char* kp = kp0 + (32 * sb) * QP + (16 * (kq * 4 + j)) * 2; ka[j][sb] = tr_read(kp); kbh[j][sb] = tr_read(kp + 4 * QP); }
                    asm volatile("" : "+v"(ka[0][0]), "+v"(ka[0][1]), "+v"(ka[1][0]), "+v"(ka[1][1]), "+v"(ka[2][0]), "+v"(ka[2][1]), "+v"(ka[3][0]), "+v"(ka[3][1]),
                                      "+v"(kbh[0][0]), "+v"(kbh[0][1]), "+v"(kbh[1][0]), "+v"(kbh[1][1]), "+v"(kbh[2][0]), "+v"(kbh[2][1]), "+v"(kbh[3][0]), "+v"(kbh[3][1]) :: "memory");
#pragma unroll
                    for (int j = 0; j < 4; ++j) { const int kt = kq * 4 + j;
                        st[kt] = st[kt] * dC;
                        st[kt] = MFMA32(cat8(ka[j][0], kbh[j][0]), vz[0], st[kt]);
                        st[kt] = MFMA32(cat8(ka[j][1], kbh[j][1]), vz[1], st[kt]); }
                }
            }
        }
        LDS_BARRIER();
    }
}

__device__ __forceinline__ void hgrn_fast(const int tid, LAS unsigned char* lds, const bf16* QD, const bf16* KI, const bf16* KS, const bf16* VV, const float* DEC, bf16* OB) {
    constexpr int TP = 272;
    constexpr int OFF_QD = 0, OFF_KI = 64 * TP, OFF_KS = 2 * 64 * TP, OFF_V = 3 * 64 * TP, OFF_DEC = 4 * 64 * TP;
    const int lane = tid & 63, w = __builtin_amdgcn_readfirstlane(tid >> 6), r = lane & 15, g = lane >> 4, q4 = (lane & 15) >> 2, p4 = lane & 3;
    const int prow = tid >> 3, pc = tid & 7;
    for (int un = blockIdx.x; un < NBATCH * HG_HEADS; un += gridDim.x) {
        const int b = un >> 3, h = un & 7;
        f32x4 st[8];
#pragma unroll
        for (int i = 0; i < 8; ++i) st[i] = (f32x4){0.f, 0.f, 0.f, 0.f};
        const size_t goff = (size_t)(b * SEQ + prow) * DM + h * 128;
        v4u p0[2], p1[2], p2[2], p3[2]; f32x4 pd = {0.f, 0.f, 0.f, 0.f};
#pragma unroll
        for (int j = 0; j < 2; ++j) { const size_t o = goff + (pc + 8 * j) * 8; p0[j] = *(const v4u*)(QD + o); p1[j] = *(const v4u*)(KI + o); p2[j] = *(const v4u*)(KS + o); p3[j] = *(const v4u*)(VV + o); }
        if (tid < 128) pd = *(const f32x4*)(DEC + (size_t)((b * SEQ) / 16 + (tid >> 5)) * DM + h * 128 + (tid & 31) * 4);
#pragma unroll 1
        for (int rd = 0; rd < SEQ / 64; ++rd) {
            LDS_BARRIER();
#pragma unroll
            for (int j = 0; j < 2; ++j) { const int lo = prow * TP + (pc + 8 * j) * 16; *(LAS v4u*)(lds + OFF_QD + lo) = p0[j]; *(LAS v4u*)(lds + OFF_KI + lo) = p1[j]; *(LAS v4u*)(lds + OFF_KS + lo) = p2[j]; *(LAS v4u*)(lds + OFF_V + lo) = p3[j]; }
            if (tid < 128) *(LAS f32x4*)(lds + OFF_DEC + tid * 16) = pd;
            if (rd + 1 < SEQ / 64) {
                const size_t gn = goff + (size_t)(rd + 1) * 64 * DM;
#pragma unroll
                for (int j = 0; j < 2; ++j) { const size_t o = gn + (pc + 8 * j) * 8; p0[j] = *(const v4u*)(QD + o); p1[j] = *(const v4u*)(KI + o); p2[j] = *(const v4u*)(KS + o); p3[j] = *(const v4u*)(VV + o); }
                if (tid < 128) pd = *(const f32x4*)(DEC + (size_t)((b * SEQ + (rd + 1) * 64) / 16 + (tid >> 5)) * DM + h * 128 + (tid & 31) * 4);
            }
            LDS_BARRIER();
#pragma unroll 1
            for (int cc = 0; cc < 4; ++cc) {
                s16x4 ql[4], qh[4], kl[4], kh[4], ksr[8]; f32x4 d4[8];
#pragma unroll
                for (int kb = 0; kb < 4; ++kb) {
                    const int off = (16 * cc + r) * TP + (32 * kb + 4 * g) * 2;
                    ql[kb] = *(const LAS s16x4*)(lds + OFF_QD + off); qh[kb] = *(const LAS s16x4*)(lds + OFF_QD + off + 32);
                    kl[kb] = *(const LAS s16x4*)(lds + OFF_KI + off); kh[kb] = *(const LAS s16x4*)(lds + OFF_KI + off + 32);
                }
                s16x4 vfr = tr_read(lds + OFF_V + (16 * cc + 4 * g + q4) * TP + (16 * w + 4 * p4) * 2);
#pragma unroll
                for (int kt = 0; kt < 8; ++kt) {
                    d4[kt] = *(const LAS f32x4*)(lds + OFF_DEC + cc * 512 + (16 * kt + 4 * g) * 4);
                    ksr[kt] = tr_read(lds + OFF_KS + (16 * cc + 4 * g + q4) * TP + (16 * kt + 4 * p4) * 2);
                }
                asm volatile("" : "+v"(ql[0]), "+v"(ql[1]), "+v"(ql[2]), "+v"(ql[3]), "+v"(qh[0]), "+v"(qh[1]), "+v"(qh[2]), "+v"(qh[3]),
                                  "+v"(kl[0]), "+v"(kl[1]), "+v"(kl[2]), "+v"(kl[3]), "+v"(kh[0]), "+v"(kh[1]), "+v"(kh[2]), "+v"(kh[3]), "+v"(vfr));
                asm volatile("" : "+v"(ksr[0]), "+v"(ksr[1]), "+v"(ksr[2]), "+v"(ksr[3]), "+v"(ksr[4]), "+v"(ksr[5]), "+v"(ksr[6]), "+v"(ksr[7]),
                                  "+v"(d4[0]), "+v"(d4[1]), "+v"(d4[2]), "+v"(d4[3]), "+v"(d4[4]), "+v"(d4[5]), "+v"(d4[6]), "+v"(d4[7]));
                bf16x8 qf[4];
#pragma unroll
                for (int kb = 0; kb < 4; ++kb) qf[kb] = cat8(ql[kb], qh[kb]);
                f32x4 sc = {0.f, 0.f, 0.f, 0.f}, oa = {0.f, 0.f, 0.f, 0.f};
#pragma unroll
                for (int kb = 0; kb < 4; ++kb) sc = MFMA32(cat8(kl[kb], kh[kb]), qf[kb], sc);
#pragma unroll
                for (int kb = 0; kb < 4; ++kb) oa = MFMA32(pack8(st[2 * kb], st[2 * kb + 1]), qf[kb], oa);
#pragma unroll
                for (int kt = 0; kt < 8; ++kt) st[kt] = MFMA16(ksr[kt], vfr, st[kt] * d4[kt]);
#pragma unroll
                for (int i = 0; i < 4; ++i) sc[i] = (4 * g + i <= r) ? sc[i] : 0.f;
                oa = MFMA16(vfr, pack4(sc), oa);
                { v2u ow; ow.x = cvtpk(oa[0], oa[1]); ow.y = cvtpk(oa[2], oa[3]); *(v2u*)(OB + (size_t)(b * SEQ + rd * 64 + cc * 16 + r) * DM + h * 128 + 16 * w + 4 * g) = ow; }
            }
        }
        LDS_BARRIER();
    }
}

struct Args { const float* in[17]; float* out; unsigned char* ws; int ph_lo, ph_hi; };
enum { I_X = 0, I_HWIN, I_HNG, I_HWOUT, I_LB, I_RWIN, I_RWOUT, I_LNMG, I_LNMB, I_LNFG, I_LNFB, I_RW, I_RB, I_WGU, I_BGU, I_WDN, I_BDN };

__device__ __forceinline__ int dest_row(int mode, int n) {
    if (mode == 1) { if (n < 1024) return ((n >> 7) << 8) + (n & 127); if (n < 2048) { const int q = n - 1024; return ((q >> 7) << 8) + 128 + (q & 127); } return n; }
    if (mode == 2) { const int j2 = n >> 1; return ((j2 >> 7) << 8) + ((n & 1) << 7) + (j2 & 127); }
    return n;
}
__device__ __forceinline__ void transpose_item(const float* W, int K, int N, bf16* WT, int mode, LAS float* scr, int item, int lane) {
    const int nblk = N / 64, kb = item / nblk, nb = item % nblk, k0 = 64 * kb, n0 = 64 * nb;
#pragma unroll 4
    for (int i = 0; i < 16; ++i) { const int kk = 4 * i + (lane >> 4), c4 = (lane & 15) * 4;
        const f32x4 v = *(const GAS f32x4*)(W + (size_t)(k0 + kk) * N + n0 + c4);
        LAS float* s = scr + kk * 65 + c4; s[0] = v[0]; s[1] = v[1]; s[2] = v[2]; s[3] = v[3]; }
    LDS_WAIT(); asm volatile("" ::: "memory");
    const int c = lane & 7;
#pragma unroll 2
    for (int j = 0; j < 8; ++j) { const int n = (lane >> 3) + 8 * j; const LAS float* s = scr + (8 * c) * 65 + n;
        v4u o; o.x = pk2(s[0 * 65], s[1 * 65]); o.y = pk2(s[2 * 65], s[3 * 65]); o.z = pk2(s[4 * 65], s[5 * 65]); o.w = pk2(s[6 * 65], s[7 * 65]);
        *(GAS v4u*)(WT + (size_t)dest_row(mode, n0 + n) * K + k0 + 8 * c) = o; }
    LDS_WAIT(); asm volatile("" ::: "memory");
}

__device__ __forceinline__ void transpose_item_fp8(const float* W, int K, int N, unsigned char* WT, int mode, float scale, LAS float* scr, int item, int lane) {
    const int nblk = N / 64, kb = item / nblk, nb = item % nblk, k0 = 64 * kb, n0 = 64 * nb;
#pragma unroll 4
    for (int i = 0; i < 16; ++i) { const int kk = 4 * i + (lane >> 4), c4 = (lane & 15) * 4;
        const f32x4 v = *(const GAS f32x4*)(W + (size_t)(k0 + kk) * N + n0 + c4);
        LAS float* s = scr + kk * 65 + c4; s[0] = v[0]; s[1] = v[1]; s[2] = v[2]; s[3] = v[3]; }
    LDS_WAIT(); asm volatile("" ::: "memory");
    const int c = lane & 7;
#pragma unroll 2
    for (int j = 0; j < 8; ++j) { const int n = (lane >> 3) + 8 * j; const LAS float* s = scr + (8 * c) * 65 + n;
        v2u o; o.x = pk4_fp8(s[0 * 65] * scale, s[1 * 65] * scale, s[2 * 65] * scale, s[3 * 65] * scale); o.y = pk4_fp8(s[4 * 65] * scale, s[5 * 65] * scale, s[6 * 65] * scale, s[7 * 65] * scale);
        *(GAS v2u*)(WT + (size_t)dest_row(mode, n0 + n) * K + k0 + 8 * c) = o; }
    LDS_WAIT(); asm volatile("" ::: "memory");
}

#ifndef SITE_MASK
#define SITE_MASK 0xffff
#endif
#define SITE(n) (((SITE_MASK) >> (n)) & 1)
#ifndef PROBE_MASK
#define PROBE_MASK 0
#endif
#define REP(n) (1 + (((PROBE_MASK) >> (n)) & 1))
typedef const __attribute__((address_space(4))) Args* KArgs;
__device__ __forceinline__ int otid(int wave0) { int l; asm volatile("v_mbcnt_lo_u32_b32 %0, -1, 0\n\tv_mbcnt_hi_u32_b32 %0, -1, %0" : "=v"(l)); asm volatile("" : "+s"(wave0)); return wave0 * 64 + l; }
__device__ __forceinline__ LAS unsigned char* olds(LAS unsigned char* p) { asm volatile("" : "+s"(p)); return p; }
__device__ __forceinline__ KArgs kargs() { KArgs p = (KArgs)__builtin_amdgcn_kernarg_segment_ptr(); asm volatile("" : "+s"(p)); return p; }
#define IN(k) (ap->ph_lo <= (k) && (k) < ap->ph_hi)
#ifndef PROBE_BAR
#define PROBE_BAR 1
#endif
#define GRID_BAR() for (int _r = 0; _r < PROBE_BAR; ++_r) do { if (ap->ph_hi - ap->ph_lo > 1) { XcdBarrier _b; _b.bar = (unsigned*)(ap->ws + WS_CTL) + CW_BAR; _b.x = xb_xcc_id(); _b.st = (volatile LAS unsigned*)(lds + MISC_OFF + MO_BARW); xcd_barrier(_b); } } while (0)
#define VCU() ((gridDim.x % 8 == 0) ? (int)((blockIdx.x % 8) * (gridDim.x / 8) + blockIdx.x / 8) : (int)blockIdx.x)

__global__ void __launch_bounds__(512, 2) mk_fwd(Args args_unused) {
    extern __shared__ __attribute__((aligned(16))) unsigned char lds_raw[];
    LAS unsigned char* const lds0 = (LAS unsigned char*)lds_raw;
    const int wave0 = __builtin_amdgcn_readfirstlane((int)(threadIdx.x >> 6));
    {
        LAS unsigned char* lds = lds0;
        for (int u = threadIdx.x; u < (LDS_BYTES - MISC_OFF) / 4; u += 512) ((LAS unsigned*)(lds + MISC_OFF))[u] = 0u;
        __syncthreads();
        KArgs ap = kargs();
        if (ap->ph_hi - ap->ph_lo > 1) (void)xcd_barrier_post((unsigned*)(ap->ws + WS_CTL) + CW_BAR, (volatile LAS unsigned*)(lds + MISC_OFF + MO_BARW));
    }

#if SITE(0)
    { KArgs ap = kargs(); const int tid = otid(wave0); LAS unsigned char* lds = olds(lds0); (void)tid;
    if (IN(0)) for (int rep_ = 0; rep_ < REP(0); ++rep_) {
        const int lane = tid & 63, wave = __builtin_amdgcn_readfirstlane(tid >> 6), G = gridDim.x, vcu = VCU(), gw = vcu * 8 + wave, NGW = G * 8;
        unsigned char* ws = ap->ws;
        LAS float* scr = (LAS float*)(lds + wave * 16640);
        constexpr int I_HIN = 2 * 16 * 64, I_HOUT = 2 * 16 * 16, I_RIN = 2 * 16 * 96, I_ROUT = 2 * 32 * 16, I_GU = 128 * 16 * 32, I_DN = 128 * 16 * 16;
        constexpr int NITEMS = I_HIN + I_HOUT + I_RIN + I_ROUT + I_GU + I_DN;
        for (int it = gw; it < NITEMS; it += NGW) {
            int r = it;
            if (r < I_HIN) { const int j = r / (16 * 64); transpose_item(ap->in[I_HWIN] + (size_t)j * DM * HG_IN, DM, HG_IN, (bf16*)(ws + WS_W_HIN) + (size_t)j * HG_IN * DM, 1, scr, r % (16 * 64), lane); continue; } r -= I_HIN;
            if (r < I_HOUT) { const int j = r / 256; transpose_item(ap->in[I_HWOUT] + (size_t)j * DM * DM, DM, DM, (bf16*)(ws + WS_W_HOUT) + (size_t)j * DM * DM, 0, scr, r % 256, lane); continue; } r -= I_HOUT;
            if (r < I_RIN) { const int j = r / (16 * 96); transpose_item(ap->in[I_RWIN] + (size_t)j * DM * RT_IN, DM, RT_IN, (bf16*)(ws + WS_W_RIN) + (size_t)j * RT_IN * DM, 0, scr, r % (16 * 96), lane); continue; } r -= I_RIN;
            if (r < I_ROUT) { const int j = r / 512; transpose_item(ap->in[I_RWOUT] + (size_t)j * RT_VD * DM, RT_VD, DM, (bf16*)(ws + WS_W_ROUT) + (size_t)j * DM * RT_VD, 0, scr, r % 512, lane); continue; } r -= I_ROUT;
#if MOE_FP8
            if (r < I_GU) { const int j = r / 512; transpose_item_fp8(ap->in[I_WGU] + (size_t)j * DM * 2048, DM, 2048, ws + WS_W_GU + (size_t)j * 2048 * DM, 2, WGU_SCALE, scr, r % 512, lane); continue; } r -= I_GU;
            { const int j = r / 256; transpose_item_fp8(ap->in[I_WDN] + (size_t)j * DM * DM, DM, DM, ws + WS_W_DN + (size_t)j * DM * DM, 0, WDN_SCALE, scr, r % 256, lane); }
#else
            if (r < I_GU) { const int j = r / 512; transpose_item(ap->in[I_WGU] + (size_t)j * DM * 2048, DM, 2048, (bf16*)(ws + WS_W_GU) + (size_t)j * 2048 * DM, 2, scr, r % 512, lane); continue; } r -= I_GU;
            { const int j = r / 256; transpose_item(ap->in[I_WDN] + (size_t)j * DM * DM, DM, DM, (bf16*)(ws + WS_W_DN) + (size_t)j * DM * DM, 0, scr, r % 256, lane); }
#endif
        }
        const int gt = vcu * 512 + tid, NGT = G * 512;
        float* LBS = (float*)(ws + WS_LBS); float* BGU = (float*)(ws + WS_BGU); float* ROT = (float*)(ws + WS_ROT); bf16* XB = (bf16*)(ws + WS_XB);
        for (int d = gt; d < DM; d += NGT) { const float* lbp = ap->in[I_LB]; const float v0 = lbp[d], v1 = lbp[DM + d], v2 = lbp[2 * DM + d], v3 = lbp[3 * DM + d]; const float mx = fmaxf(fmaxf(v0, v1), fmaxf(v2, v3));
            const float e0 = __expf(v0 - mx), e1 = __expf(v1 - mx), e2 = __expf(v2 - mx), e3 = __expf(v3 - mx), is = 1.0f / (e0 + e1 + e2 + e3);
            LBS[d] = 0.f; LBS[DM + d] = e1 * is; LBS[2 * DM + d] = (e1 + e2) * is; LBS[3 * DM + d] = (e1 + e2 + e3) * is; }
        for (int i = gt; i < SEQ * 128; i += NGT) { const int pos = i >> 7, p = i & 127; const float inv = 1.0f / __builtin_amdgcn_exp2f(13.287712379549449f * ((float)p / 127.0f)); const float th = (float)pos * inv;
            double rev = (double)th * 0.15915494309189535; rev -= floor(rev); const float fr = (float)rev; ROT[2 * i] = __builtin_amdgcn_cosf(fr); ROT[2 * i + 1] = __builtin_amdgcn_sinf(fr); }
        for (int i = gt; i < 4 * DM * NE; i += NGT) { const int l = i >> 15, d = (i >> 5) & 1023, e = i & 31; const float wv = ap->in[I_RW][i]; const unsigned hb = f2bf(wv); const float hv = __builtin_bit_cast(float, hb << 16);
            ((bf16*)(ws + WS_WRH))[(size_t)l * 32768 + e * 1024 + d] = (bf16)hb; ((bf16*)(ws + WS_WRL))[(size_t)l * 32768 + e * 1024 + d] = (bf16)f2bf(wv - hv); }
        for (int i = gt; i < 4 * 32 * 2048; i += NGT) { const int le = i >> 11, n = i & 2047; BGU[(size_t)le * 2048 + dest_row(2, n)] = ap->in[I_BGU][i]; }
        for (size_t i = (size_t)gt; i < (size_t)NTOK * DM / 4; i += NGT) { const f32x4 v = ((const f32x4*)ap->in[I_X])[i]; v2u o; o.x = pk2(v[0], v[1]); o.y = pk2(v[2], v[3]); ((v2u*)XB)[i] = o; }
        GRID_BAR();
    } }
#endif

#pragma unroll 1
    for (int L = 0; L < DEPTH; ++L) {
        const int pb = 1 + 8 * L;
        if ((L & 1) == 0) {
#if SITE(1)
            { KArgs ap = kargs(); const int tid = otid(wave0); LAS unsigned char* lds = olds(lds0); (void)tid;
            if (IN(pb + 0)) for (int rep_ = 0; rep_ < REP(1); ++rep_) {
                unsigned char* ws = ap->ws; const int j = L >> 1;
                LAS int* ul = (LAS int*)(lds + MISC_OFF + MO_ULIST);
                pg8::build_units_dense(tid, ul, NTOK / 256, HG_IN / 256, DM * 2);
                pg8::EpiHgrnIn E{ws, L};
                pg8::gemm_phase<pg8::EpiHgrnIn, false, true, false>(tid, lds, ul, (LAS int*)(lds + MISC_OFF + MO_GTAB), (const char*)(ws + WS_XB), (const char*)((bf16*)(ws + WS_W_HIN) + (size_t)j * HG_IN * DM), nullptr, DM * 2, E);
                GRID_BAR();
            } }
#endif
#if SITE(2)
            { KArgs ap = kargs(); const int tid = otid(wave0); LAS unsigned char* lds = olds(lds0); (void)tid;
            if (IN(pb + 1)) for (int rep_ = 0; rep_ < REP(2); ++rep_) {
#if !SLOW_HGRN
                { unsigned char* ws = ap->ws; const bf16* QD = (const bf16*)(ws + WS_H);
                  hgrn_fast(tid, lds, QD, QD + (size_t)NTOK * DM, QD + 2 * (size_t)NTOK * DM, QD + 3 * (size_t)NTOK * DM, (const float*)(ws + WS_DEC), (bf16*)(ws + WS_O)); }
#else
                unsigned char* ws = ap->ws; const bf16* QD = (const bf16*)(ws + WS_H); const bf16* KI = QD + (size_t)NTOK * DM; const bf16* KS = QD + 2 * (size_t)NTOK * DM; const bf16* VV = QD + 3 * (size_t)NTOK * DM; bf16* OB = (bf16*)(ws + WS_O);
                LAS float* qf = (LAS float*)lds; LAS float* kf = qf + 16 * 4 * 36; LAS float* ff = kf + 16 * 4 * 36; LAS float* vf = ff + 16 * 4 * 36;
                for (int un = blockIdx.x; un < NBATCH * HG_HEADS; un += gridDim.x) {
                    const int b = un >> 3, h = un & 7; const int vc = tid >> 2, kq = tid & 3;
                    float st[32];
#pragma unroll
                    for (int i = 0; i < 32; ++i) st[i] = 0.f;
                    for (int t0 = 0; t0 < SEQ; t0 += 16) {
                        __syncthreads();
                        for (int e = tid; e < 16 * 128; e += 512) { const int tt = e >> 7, k = e & 127; const size_t gi = (size_t)(b * SEQ + t0 + tt) * DM + h * 128 + k; const int li = tt * 144 + (k & 3) * 36 + (k >> 2);
                            qf[li] = bf1(QD[gi]); kf[li] = bf1(KI[gi]); ff[li] = bf1(KS[gi]); vf[tt * 128 + k] = bf1(VV[gi]); }
                        __syncthreads();
                        for (int tt = 0; tt < 16; ++tt) {
                            const float v = vf[tt * 128 + vc]; float a = 0.f; const int lb = tt * 144 + kq * 36;
#pragma unroll
                            for (int i = 0; i < 32; ++i) { st[i] = ff[lb + i] * st[i] + kf[lb + i] * v; a += qf[lb + i] * st[i]; }
                            a += __shfl_xor(a, 1); a += __shfl_xor(a, 2);
                            if (kq == 0) OB[(size_t)(b * SEQ + t0 + tt) * DM + h * 128 + vc] = (bf16)f2bf(a);
                        }
                    }
                }
#endif
                GRID_BAR();
            } }
#endif
#if SITE(3)
            { KArgs ap = kargs(); const int tid = otid(wave0); LAS unsigned char* lds = olds(lds0); (void)tid;
            if (IN(pb + 2)) for (int rep_ = 0; rep_ < REP(3); ++rep_) {
                const int lane = tid & 63, wave = __builtin_amdgcn_readfirstlane(tid >> 6), gw = VCU() * 8 + wave, NGW = gridDim.x * 8;
                unsigned char* ws = ap->ws; const bf16* OB = (const bf16*)(ws + WS_O); const bf16* GG = (const bf16*)(ws + WS_H) + 4 * (size_t)NTOK * DM; bf16* A2 = (bf16*)(ws + WS_A2);
                const float* ng = ap->in[I_HNG] + (L >> 1) * DM;
                f32x4 g4[4];
#pragma unroll
                for (int q = 0; q < 4; ++q) g4[q] = *(const f32x4*)(ng + 256 * q + 4 * lane);
                v2u on[4], gn[4];
#pragma unroll
                for (int q = 0; q < 4; ++q) { on[q] = *(const v2u*)(OB + (size_t)gw * DM + 256 * q + 4 * lane); gn[q] = *(const v2u*)(GG + (size_t)gw * DM + 256 * q + 4 * lane); }
#pragma unroll 1
                for (int row = gw; row < NTOK; row += NGW) {
                    v2u oc[4], gc[4];
#pragma unroll
                    for (int q = 0; q < 4; ++q) { oc[q] = on[q]; gc[q] = gn[q]; }
                    if (row + NGW < NTOK) {
#pragma unroll
                        for (int q = 0; q < 4; ++q) { on[q] = *(const v2u*)(OB + (size_t)(row + NGW) * DM + 256 * q + 4 * lane); gn[q] = *(const v2u*)(GG + (size_t)(row + NGW) * DM + 256 * q + 4 * lane); } }
                    float o[16]; float ss = 0.f;
#pragma unroll
                    for (int q = 0; q < 4; ++q) { o[4 * q] = bflo(oc[q].x); o[4 * q + 1] = bfhi(oc[q].x); o[4 * q + 2] = bflo(oc[q].y); o[4 * q + 3] = bfhi(oc[q].y); }
#pragma unroll
                    for (int i = 0; i < 16; ++i) ss += o[i] * o[i];
                    const float rs = 1.0f / sqrtf(wave_sum(ss) * (1.0f / DM) + RMS_EPS);
#pragma unroll
                    for (int q = 0; q < 4; ++q) {
                        v2u w; w.x = pk2(o[4 * q] * rs * g4[q][0] * bflo(gc[q].x), o[4 * q + 1] * rs * g4[q][1] * bfhi(gc[q].x)); w.y = pk2(o[4 * q + 2] * rs * g4[q][2] * bflo(gc[q].y), o[4 * q + 3] * rs * g4[q][3] * bfhi(gc[q].y));
                        *(v2u*)(A2 + (size_t)row * DM + 256 * q + 4 * lane) = w; }
                }
                GRID_BAR();
            } }
#endif
        } else {
#if SITE(4)
            { KArgs ap = kargs(); const int tid = otid(wave0); LAS unsigned char* lds = olds(lds0); (void)tid;
            if (IN(pb + 0)) for (int rep_ = 0; rep_ < REP(4); ++rep_) {
                unsigned char* ws = ap->ws; const int j = L >> 1;
                LAS int* ul = (LAS int*)(lds + MISC_OFF + MO_ULIST);
                pg8::build_units_dense(tid, ul, NTOK / 256, RT_IN / 256, DM * 2);
                pg8::EpiRetIn E{ws};
                pg8::gemm_phase<pg8::EpiRetIn, false, true, false>(tid, lds, ul, (LAS int*)(lds + MISC_OFF + MO_GTAB), (const char*)(ws + WS_XB), (const char*)((bf16*)(ws + WS_W_RIN) + (size_t)j * RT_IN * DM), nullptr, DM * 2, E);
                GRID_BAR();
            } }
#endif
#if SITE(5)
            { KArgs ap = kargs(); const int tid = otid(wave0); LAS unsigned char* lds = olds(lds0); (void)tid;
            if (IN(pb + 1)) for (int rep_ = 0; rep_ < REP(5); ++rep_) {
#if !SLOW_RET
                { unsigned char* ws = ap->ws; ret_fast(tid, lds, (const bf16*)(ws + WS_H), (bf16*)(ws + WS_O)); }
#else
                unsigned char* ws = ap->ws; const bf16* HB = (const bf16*)(ws + WS_H); bf16* OB = (bf16*)(ws + WS_O);
                LAS float* qf = (LAS float*)lds; LAS float* kf = qf + 16 * 4 * 68; LAS float* vf = kf + 16 * 4 * 68;
                for (int un = blockIdx.x; un < NBATCH * RT_HEADS * 4; un += gridDim.x) {
                    const int b = un >> 4, h = (un >> 2) & 3, vq = un & 3; const int vc = tid >> 2, kq = tid & 3;
                    const float gam = 1.0f - exp2f(-5.0f - (float)h);
                    float st[64];
#pragma unroll
                    for (int i = 0; i < 64; ++i) st[i] = 0.f;
                    for (int t0 = 0; t0 < SEQ; t0 += 16) {
                        __syncthreads();
                        for (int e = tid; e < 16 * 256; e += 512) { const int tt = e >> 8, k = e & 255; const size_t gi = (size_t)(b * SEQ + t0 + tt) * RT_IN + h * 256 + k; const int li = tt * 272 + (k & 3) * 68 + (k >> 2);
                            qf[li] = bf1(HB[gi]); kf[li] = bf1(HB[gi + 1024]); }
                        for (int e = tid; e < 16 * 128; e += 512) { const int tt = e >> 7, c = e & 127; vf[e] = bf1(HB[(size_t)(b * SEQ + t0 + tt) * RT_IN + 2048 + h * 512 + vq * 128 + c]); }
                        __syncthreads();
                        for (int tt = 0; tt < 16; ++tt) {
                            const float v = vf[tt * 128 + vc]; float a = 0.f; const int lb = tt * 272 + kq * 68;
#pragma unroll
                            for (int i = 0; i < 64; ++i) { st[i] = gam * st[i] + kf[lb + i] * v; a += qf[lb + i] * st[i]; }
                            a += __shfl_xor(a, 1); a += __shfl_xor(a, 2);
                            if (kq == 0) OB[(size_t)(b * SEQ + t0 + tt) * RT_VD + h * 512 + vq * 128 + vc] = (bf16)f2bf(a);
                        }
                    }
                }
#endif
                GRID_BAR();
            } }
#endif
#if SITE(6)
            { KArgs ap = kargs(); const int tid = otid(wave0); LAS unsigned char* lds = olds(lds0); (void)tid;
            if (IN(pb + 2)) for (int rep_ = 0; rep_ < REP(6); ++rep_) {
                const int lane = tid & 63, wave = __builtin_amdgcn_readfirstlane(tid >> 6), gw = VCU() * 8 + wave, NGW = gridDim.x * 8;
                unsigned char* ws = ap->ws; const bf16* OB = (const bf16*)(ws + WS_O); const bf16* HB = (const bf16*)(ws + WS_H); bf16* A2 = (bf16*)(ws + WS_A2);
                v4u on[4], gn[4];
#pragma unroll
                for (int h = 0; h < 4; ++h) { on[h] = *(const v4u*)(OB + (size_t)gw * RT_VD + 512 * h + 8 * lane); gn[h] = *(const v4u*)(HB + (size_t)gw * RT_IN + 4096 + 512 * h + 8 * lane); }
#pragma unroll 1
                for (int row = gw; row < NTOK; row += NGW) {
                    v4u oc[4], gc[4];
#pragma unroll
                    for (int h = 0; h < 4; ++h) { oc[h] = on[h]; gc[h] = gn[h]; }
                    if (row + NGW < NTOK) {
#pragma unroll
                        for (int h = 0; h < 4; ++h) { on[h] = *(const v4u*)(OB + (size_t)(row + NGW) * RT_VD + 512 * h + 8 * lane); gn[h] = *(const v4u*)(HB + (size_t)(row + NGW) * RT_IN + 4096 + 512 * h + 8 * lane); } }
#pragma unroll
                    for (int h = 0; h < 4; ++h) {
                        const v4u w = oc[h];
                        float o[8] = {bflo(w.x), bfhi(w.x), bflo(w.y), bfhi(w.y), bflo(w.z), bfhi(w.z), bflo(w.w), bfhi(w.w)};
                        float s = 0.f;
#pragma unroll
                        for (int i = 0; i < 8; ++i) s += o[i];
                        const float mu = wave_sum(s) * (1.0f / 512.0f); float q = 0.f;
#pragma unroll
                        for (int i = 0; i < 8; ++i) { o[i] -= mu; q += o[i] * o[i]; }
                        const float rs = 1.0f / sqrtf(wave_sum(q) * (1.0f / 512.0f) + LN_EPS);
                        const v4u g = gc[h];
                        v4u r; r.x = pk2(o[0] * rs * bflo(g.x), o[1] * rs * bfhi(g.x)); r.y = pk2(o[2] * rs * bflo(g.y), o[3] * rs * bfhi(g.y));
                        r.z = pk2(o[4] * rs * bflo(g.z), o[5] * rs * bfhi(g.z)); r.w = pk2(o[6] * rs * bflo(g.w), o[7] * rs * bfhi(g.w));
                        *(v4u*)(A2 + (size_t)row * RT_VD + 512 * h + 8 * lane) = r;
                    }
                }
                GRID_BAR();
            } }
#endif
        }
#if SITE(7)
        { KArgs ap = kargs(); const int tid = otid(wave0); LAS unsigned char* lds = olds(lds0); (void)tid;
        if (IN(pb + 3)) for (int rep_ = 0; rep_ < REP(7); ++rep_) {
            unsigned char* ws = ap->ws; const int j = L >> 1; const bool ret = (L & 1) != 0;
            const int Ko = ret ? RT_VD : DM;
            LAS int* ul = (LAS int*)(lds + MISC_OFF + MO_ULIST);
            pg8::build_units_dense(tid, ul, NTOK / 256, DM / 256, Ko * 2);
            const char* Bt = ret ? (const char*)((bf16*)(ws + WS_W_ROUT) + (size_t)j * DM * RT_VD) : (const char*)((bf16*)(ws + WS_W_HOUT) + (size_t)j * DM * DM);
            pg8::EpiRes E{ws};
            pg8::gemm_phase<pg8::EpiRes, false, true, false>(tid, lds, ul, (LAS int*)(lds + MISC_OFF + MO_GTAB), (const char*)(ws + WS_A2), Bt, nullptr, Ko * 2, E);
            GRID_BAR();
        } }
#endif
#if SITE(8)
        { KArgs ap = kargs(); const int tid = otid(wave0); LAS unsigned char* lds = olds(lds0); (void)tid;
        if (IN(pb + 4)) for (int rep_ = 0; rep_ < REP(8); ++rep_) {
            const int lane = tid & 63, wave = __builtin_amdgcn_readfirstlane(tid >> 6), r = lane & 15, g = lane >> 4;
            unsigned char* ws = ap->ws; unsigned* ctl = (unsigned*)(ws + WS_CTL);
            const bf16* Y = (const bf16*)(ws + WS_Y); bf16* X1R = (bf16*)(ws + WS_X1F); bf16* X1B = (bf16*)(ws + WS_X1B);
            int* ROWDST = (int*)(ws + WS_ROWDST); float* ROWGATE = (float*)(ws + WS_ROWGATE);
            constexpr int WP = 2064;
            LAS unsigned char* wH = lds; LAS unsigned char* wL = lds + 32 * WP;
            LAS int* lcnt = (LAS int*)(lds + MISC_OFF + MO_LCNT); LAS int* lbase = (LAS int*)(lds + MISC_OFF + MO_LBASE);
            LAS int* sel = (LAS int*)(lds + MISC_OFF + MO_SEL); LAS float* selw = (LAS float*)(lds + MISC_OFF + MO_SELW);
            const float* rb = ap->in[I_RB] + L * NE;
            const float* lg = ap->in[I_LNMG] + L * DM; const float* lbb = ap->in[I_LNMB] + L * DM;
            { const v4u* gh = (const v4u*)(ws + WS_WRH) + (size_t)L * 4096; const v4u* gl = (const v4u*)(ws + WS_WRL) + (size_t)L * 4096;
              for (int c = tid; c < 4096; c += 512) { const int e = c >> 7, cc = c & 127; *(LAS v4u*)(wH + e * WP + cc * 16) = gh[c]; *(LAS v4u*)(wL + e * WP + cc * 16) = gl[c]; } }
            const float rb0 = rb[r], rb1 = rb[16 + r];
            for (int blk = VCU(); blk < NTOK / 128; blk += gridDim.x) {
                if (tid < 32) lcnt[tid] = 0;
                __syncthreads();
                const int row0 = blk * 128 + wave * 16;
                v2u xn[4];
#pragma unroll
                for (int q = 0; q < 4; ++q) xn[q] = *(const v2u*)(Y + (size_t)row0 * DM + 256 * q + 4 * lane);
#pragma unroll 1
                for (int rr = 0; rr < 16; ++rr) {
                    const int row = row0 + rr;
                    f32x4 x[4]; float s = 0.f;
#pragma unroll
                    for (int q = 0; q < 4; ++q) { x[q] = (f32x4){bflo(xn[q].x), bfhi(xn[q].x), bflo(xn[q].y), bfhi(xn[q].y)}; s += (x[q][0] + x[q][1]) + (x[q][2] + x[q][3]); }
                    if (rr + 1 < 16) {
#pragma unroll
                        for (int q = 0; q < 4; ++q) xn[q] = *(const v2u*)(Y + (size_t)(row + 1) * DM + 256 * q + 4 * lane); }
                    const float mu = wave_sum_u(s) * (1.0f / DM); float qq = 0.f;
#pragma unroll
                    for (int q = 0; q < 4; ++q) { x[q] = x[q] - mu; qq += (x[q][0] * x[q][0] + x[q][1] * x[q][1]) + (x[q][2] * x[q][2] + x[q][3] * x[q][3]); }
                    const float rs = 1.0f / sqrtf(wave_sum_u(qq) * (1.0f / DM) + LN_EPS);
#pragma unroll
                    for (int q = 0; q < 4; ++q) { const f32x4 g4 = *(const f32x4*)(lg + 256 * q + 4 * lane), b4 = *(const f32x4*)(lbb + 256 * q + 4 * lane); x[q] = x[q] * rs * g4 + b4;
                        { v2u wr_; wr_.x = pk2(x[q][0], x[q][1]); wr_.y = pk2(x[q][2], x[q][3]); *(v2u*)(X1R + (size_t)row * DM + 256 * q + 4 * lane) = wr_; }
#if MOE_FP8
                        *(unsigned*)((unsigned char*)X1B + (size_t)row * DM + 256 * q + 4 * lane) = pk4_fp8(x[q][0] * X_SCALE, x[q][1] * X_SCALE, x[q][2] * X_SCALE, x[q][3] * X_SCALE); }
#else
                        v2u w; w.x = pk2(x[q][0], x[q][1]); w.y = pk2(x[q][2], x[q][3]); *(v2u*)(X1B + (size_t)row * DM + 256 * q + 4 * lane) = w; }
#endif
                }
                asm volatile("s_waitcnt vmcnt(0)" ::: "memory");
                f32x4 lgt0 = {0.f, 0.f, 0.f, 0.f}, lgt1 = {0.f, 0.f, 0.f, 0.f};
                {
                    const bf16* xa = X1R + (size_t)(row0 + r) * DM + 8 * g;
#pragma unroll 1
                    for (int kq = 0; kq < 4; ++kq) {
                        bf16x8 af[8], h0[8], h1[8], l0[8], l1[8];
#pragma unroll
                        for (int j = 0; j < 8; ++j) { const int kb = kq * 8 + j; af[j] = *(const bf16x8*)(xa + 32 * kb);
                            h0[j] = *(const LAS bf16x8*)(wH + r * WP + (32 * kb + 8 * g) * 2); h1[j] = *(const LAS bf16x8*)(wH + (16 + r) * WP + (32 * kb + 8 * g) * 2);
                            l0[j] = *(const LAS bf16x8*)(wL + r * WP + (32 * kb + 8 * g) * 2); l1[j] = *(const LAS bf16x8*)(wL + (16 + r) * WP + (32 * kb + 8 * g) * 2); }
#pragma unroll
                        for (int j = 0; j < 8; ++j) { lgt0 = MFMA32(af[j], h0[j], lgt0); lgt1 = MFMA32(af[j], h1[j], lgt1); lgt0 = MFMA32(af[j], l0[j], lgt0); lgt1 = MFMA32(af[j], l1[j], lgt1); }
                    }
                }
#pragma unroll
                for (int i = 0; i < 4; ++i) {
                    float v0 = lgt0[i] + rb0, v1 = lgt1[i] + rb1; int se[4]; float sv[4];
#pragma unroll
                    for (int k = 0; k < 4; ++k) {
                        float m = fmaxf(v0, v1);
                        m = fmaxf(m, dppf<0xB1>(m)); m = fmaxf(m, dppf<0x4E>(m)); m = fmaxf(m, dppf<0x141>(m)); m = fmaxf(m, dppf<0x140>(m));
                        int ec = (v0 == m) ? r : ((v1 == m) ? 16 + r : 99);
                        ec = min(ec, dppi<0xB1>(ec)); ec = min(ec, dppi<0x4E>(ec)); ec = min(ec, dppi<0x141>(ec)); ec = min(ec, dppi<0x140>(ec));
                        se[k] = ec; sv[k] = m;
                        if (ec == r) v0 = -3.0e38f;
                        if (ec == 16 + r) v1 = -3.0e38f;
                    }
                    const float e1 = __expf(sv[1] - sv[0]), e2 = __expf(sv[2] - sv[0]), e3 = __expf(sv[3] - sv[0]); const float inv = 1.0f / (1.0f + e1 + e2 + e3);
                    if (r < 4) { const int rloc = wave * 16 + 4 * g + i; const int ee = r == 0 ? se[0] : (r == 1 ? se[1] : (r == 2 ? se[2] : se[3])); const float ww = (r == 0 ? 1.0f : (r == 1 ? e1 : (r == 2 ? e2 : e3))) * inv;
                        sel[rloc * 4 + r] = ee; selw[rloc * 4 + r] = ww; }
                }
                __syncthreads();
                const int myE = sel[tid]; const int rank = __hip_atomic_fetch_add(lcnt + myE, 1, __ATOMIC_RELAXED, __HIP_MEMORY_SCOPE_WORKGROUP);
                __syncthreads();
                if (tid < 32) lbase[tid] = (int)__hip_atomic_fetch_add(ctl + CW_ECNT + (L + 4 * rep_) * 32 + tid, (unsigned)lcnt[tid], RLX_AGENT);
                __syncthreads();
                { const int pos = lbase[myE] + rank; const size_t ti = (size_t)myE * ECAP + pos; ROWDST[ti] = (blk * 128 + (tid >> 2)) * 4 + (tid & 3); ROWGATE[ti] = selw[tid]; }
                __syncthreads();
            }
            GRID_BAR();
        } }
#endif
#if SITE(9)
        { KArgs ap = kargs(); const int tid = otid(wave0); LAS unsigned char* lds = olds(lds0); (void)tid;
        if (IN(pb + 5)) for (int rep_ = 0; rep_ < REP(9); ++rep_) {
            unsigned char* ws = ap->ws; unsigned* ctl = (unsigned*)(ws + WS_CTL);
            LAS int* tpre = (LAS int*)(lds + MISC_OFF + MO_TPRE); LAS int* ebase = (LAS int*)(lds + MISC_OFF + MO_EBASE); LAS int* ecnt = (LAS int*)(lds + MISC_OFF + MO_ECNT);
            if (tid == 0) { int t = 0;
_Pragma("unroll 1")
 for (int e = 0; e < NE; ++e) { const int c = (int)__hip_atomic_load(ctl + CW_ECNT + L * 32 + e, RLX_AGENT); ecnt[e] = c; tpre[e] = t; ebase[e] = t * 256; t += (c + 255) >> 8; } tpre[NE] = t; }
            __syncthreads();
            LAS int* ul = (LAS int*)(lds + MISC_OFF + MO_ULIST);
            constexpr int EB = MOE_FP8 ? 1 : 2;
            pg8::build_units_moe(tid, ul, tpre, ebase, ecnt, 8, DM * EB, 2048u * DM * EB);
            pg8::EpiMoeGU E{ws, L};
            pg8::gemm_phase<pg8::EpiMoeGU, true, true, MOE_FP8 != 0>(tid, lds, ul, (LAS int*)(lds + MISC_OFF + MO_GTAB), (const char*)(ws + WS_X1B), (const char*)(ws + WS_W_GU + (size_t)L * NE * 2048 * DM * EB), (const int*)(ws + WS_ROWDST), DM * EB, E);
            GRID_BAR();
        } }
#endif
#if SITE(10)
        { KArgs ap = kargs(); const int tid = otid(wave0); LAS unsigned char* lds = olds(lds0); (void)tid;
        if (IN(pb + 6)) for (int rep_ = 0; rep_ < REP(10); ++rep_) {
            unsigned char* ws = ap->ws; unsigned* ctl = (unsigned*)(ws + WS_CTL);
            LAS int* tpre = (LAS int*)(lds + MISC_OFF + MO_TPRE); LAS int* ebase = (LAS int*)(lds + MISC_OFF + MO_EBASE); LAS int* ecnt = (LAS int*)(lds + MISC_OFF + MO_ECNT);
            __syncthreads();
            if (tid == 0) { int t = 0;
_Pragma("unroll 1")
 for (int e = 0; e < NE; ++e) { const int c = (int)__hip_atomic_load(ctl + CW_ECNT + L * 32 + e, RLX_AGENT); ecnt[e] = c; tpre[e] = t; ebase[e] = t * 256; t += (c + 255) >> 8; } tpre[NE] = t; }
            __syncthreads();
            LAS int* ul = (LAS int*)(lds + MISC_OFF + MO_ULIST);
            constexpr int EB = MOE_FP8 ? 1 : 2;
            pg8::build_units_moe(tid, ul, tpre, ebase, ecnt, 4, DM * EB, (unsigned)DM * DM * EB);
            pg8::EpiMoeDown E{ws, ap->in[I_BDN] + (size_t)L * NE * DM};
            pg8::gemm_phase<pg8::EpiMoeDown, false, true, MOE_FP8 != 0>(tid, lds, ul, (LAS int*)(lds + MISC_OFF + MO_GTAB), (const char*)(ws + WS_ACT), (const char*)(ws + WS_W_DN + (size_t)L * NE * DM * DM * EB), nullptr, DM * EB, E);
            GRID_BAR();
        } }
#endif
#if SITE(11)
        { KArgs ap = kargs(); const int tid = otid(wave0); LAS unsigned char* lds = olds(lds0); (void)tid;
        if (IN(pb + 7)) for (int rep_ = 0; rep_ < REP(11); ++rep_) {
            const int lane = tid & 63, wave = __builtin_amdgcn_readfirstlane(tid >> 6), gw = VCU() * 8 + wave, NGW = gridDim.x * 8;
            unsigned char* ws = ap->ws; const bf16* X1R = (const bf16*)(ws + WS_X1F); const bf16* YS = (const bf16*)(ws + WS_YSLOT); bf16* XB = (bf16*)(ws + WS_XB); float* out = ap->out;
            const float* lg = ap->in[I_LNFG] + L * DM; const float* lbb = ap->in[I_LNFB] + L * DM;
            v2u xn[4]; f32x4 g4[4], b4[4]; v2u yn[4][4];
#pragma unroll
            for (int q = 0; q < 4; ++q) { g4[q] = *(const f32x4*)(lg + 256 * q + 4 * lane); b4[q] = *(const f32x4*)(lbb + 256 * q + 4 * lane); xn[q] = *(const v2u*)(X1R + (size_t)gw * DM + 256 * q + 4 * lane);
#pragma unroll
                for (int k = 0; k < 4; ++k) yn[q][k] = *(const v2u*)(YS + ((size_t)gw * 4 + k) * DM + 256 * q + 4 * lane); }
#pragma unroll 1
            for (int row = gw; row < NTOK; row += NGW) {
                f32x4 x[4]; v2u yc[4][4]; float s = 0.f;
#pragma unroll
                for (int q = 0; q < 4; ++q) { x[q] = (f32x4){bflo(xn[q].x), bfhi(xn[q].x), bflo(xn[q].y), bfhi(xn[q].y)} * DN_ALPHA;
#pragma unroll
                    for (int k = 0; k < 4; ++k) yc[q][k] = yn[q][k]; }
                if (row + NGW < NTOK) {
#pragma unroll
                    for (int q = 0; q < 4; ++q) { xn[q] = *(const v2u*)(X1R + (size_t)(row + NGW) * DM + 256 * q + 4 * lane);
#pragma unroll
                        for (int k = 0; k < 4; ++k) yn[q][k] = *(const v2u*)(YS + ((size_t)(row + NGW) * 4 + k) * DM + 256 * q + 4 * lane); } }
#pragma unroll
                for (int q = 0; q < 4; ++q) {
#pragma unroll
                    for (int k = 0; k < 4; ++k) { const v2u w = yc[q][k]; x[q][0] += bflo(w.x); x[q][1] += bfhi(w.x); x[q][2] += bflo(w.y); x[q][3] += bfhi(w.y); }
                    s += (x[q][0] + x[q][1]) + (x[q][2] + x[q][3]); }
                const float mu = wave_sum(s) * (1.0f / DM); float qq = 0.f;
#pragma unroll
                for (int q = 0; q < 4; ++q) { x[q] = x[q] - mu; qq += (x[q][0] * x[q][0] + x[q][1] * x[q][1]) + (x[q][2] * x[q][2] + x[q][3] * x[q][3]); }
                const float rs = 1.0f / sqrtf(wave_sum(qq) * (1.0f / DM) + LN_EPS);
#pragma unroll
                for (int q = 0; q < 4; ++q) { x[q] = x[q] * rs * g4[q] + b4[q];
                    if (L + 1 == DEPTH) *(f32x4*)(out + (size_t)row * DM + 256 * q + 4 * lane) = x[q];
                    else { v2u w; w.x = pk2(x[q][0], x[q][1]); w.y = pk2(x[q][2], x[q][3]); *(v2u*)(XB + (size_t)row * DM + 256 * q + 4 * lane) = w; } }
            }
            if (L + 1 < DEPTH) GRID_BAR();
        } }
#endif
    }
#undef IN
#undef GRID_BAR
}

extern "C" void kernel_launch(void* const* d_in, const int* in_sizes, int n_in, void* d_out, int out_size, void* d_ws, size_t ws_size, hipStream_t stream) {
    static int grid = 0;
    if (grid == 0) {
        if (n_in != 17 || out_size != NTOK * DM || ws_size < WS_END) { fprintf(stderr, "kernel_launch: unexpected shapes (n_in %d, out %d, ws %zu < %zu)\n", n_in, out_size, ws_size, (size_t)WS_END); grid = -1; return; }
        int dev = 0, cus = 0, per_cu = 0;
        if (hipGetDevice(&dev) != hipSuccess || hipDeviceGetAttribute(&cus, hipDeviceAttributeMultiprocessorCount, dev) != hipSuccess) { grid = -1; return; }
        if (hipFuncSetAttribute((const void*)mk_fwd, hipFuncAttributeMaxDynamicSharedMemorySize, LDS_BYTES) != hipSuccess) { fprintf(stderr, "kernel_launch: hipFuncSetAttribute failed\n"); grid = -1; return; }
        if (hipOccupancyMaxActiveBlocksPerMultiprocessor(&per_cu, (const void*)mk_fwd, 512, LDS_BYTES) != hipSuccess || per_cu < 1) { fprintf(stderr, "kernel_launch: occupancy query says %d\n", per_cu); }
        (void)hipGetLastError();
        grid = cus;
    }
    if (grid < 0) return;
    (void)hipMemsetAsync((char*)d_ws + WS_CTL, 0, CTL_ZERO_BYTES, stream);
    Args a{};
    for (int i = 0; i < 17; ++i) a.in[i] = (const float*)d_in[i];
    a.out = (float*)d_out; a.ws = (unsigned char*)d_ws;
#if MK_MULTI
    for (int p = 0; p < 1 + 8 * DEPTH; ++p) { a.ph_lo = p; a.ph_hi = p + 1; hipLaunchKernelGGL(mk_fwd, dim3(grid), dim3(512), LDS_BYTES, stream, a); }
#else
    a.ph_lo = 0; a.ph_hi = 1 + 8 * DEPTH;
    hipLaunchKernelGGL(mk_fwd, dim3(grid), dim3(512), LDS_BYTES, stream, a);
#endif
}
```

```cpp
#include <hip/hip_runtime.h>
#include <cstdio>
#include <cstdint>

#ifndef MK_MULTI
#define MK_MULTI 0
#endif
#ifndef PROBE_EPI2
#define PROBE_EPI2 0
#endif
#ifndef MOE_FP8
#define MOE_FP8 1
#endif
#ifndef YS_FP8
#define YS_FP8 1
#endif
#ifndef SLOW_HGRN
#define SLOW_HGRN 0
#endif
#ifndef SLOW_RET
#define SLOW_RET 0
#endif

#define GAS __attribute__((address_space(1)))
#define LAS __attribute__((address_space(3)))
typedef unsigned short bf16;
typedef unsigned v4u __attribute__((ext_vector_type(4)));
typedef unsigned v2u __attribute__((ext_vector_type(2)));
typedef float f32x4 __attribute__((ext_vector_type(4)));
typedef float f32x2 __attribute__((ext_vector_type(2)));
typedef short bf16x8 __attribute__((ext_vector_type(8)));
typedef GAS unsigned gu32;

constexpr int DM = 1024, NBATCH = 16, SEQ = 2048, NTOK = NBATCH * SEQ, DEPTH = 4;
constexpr int NE = 32, TOPK = 4;
constexpr int HG_HEADS = 8, HG_K = 128;
constexpr int RT_HEADS = 4, RT_K = 256, RT_V = 512, RT_VD = 2048, RT_IN = 6144, HG_IN = 4096;
constexpr int ECAP = NTOK;
constexpr int MOE_ROWS = NTOK * TOPK + NE * 256;
constexpr float DN_ALPHA = 1.681792830507429f;
constexpr float LN_EPS = 1e-5f, RMS_EPS = 1e-6f;

constexpr size_t MiB = 1ull << 20;
constexpr size_t WS_CTL = 0, CTL_ZERO_BYTES = 1 * MiB;
constexpr size_t WS_LBS = 1 * MiB;
constexpr size_t WS_WRH = 1 * MiB + 128 * 1024, WS_WRL = 1 * MiB + 512 * 1024;
constexpr size_t WS_BGU = 2 * MiB;
constexpr size_t WS_ROT = 4 * MiB;
constexpr size_t WS_ROWDST = 8 * MiB;
constexpr size_t WS_ROWGATE = 12 * MiB;
constexpr size_t WS_W_HIN = 16 * MiB;
constexpr size_t WS_W_HOUT = WS_W_HIN + 16 * MiB;
constexpr size_t WS_W_RIN = WS_W_HOUT + 4 * MiB;
constexpr size_t WS_W_ROUT = WS_W_RIN + 24 * MiB;
constexpr size_t WS_W_GU = WS_W_ROUT + 8 * MiB;
constexpr size_t WS_W_DN = WS_W_GU + 512 * MiB;
constexpr size_t WS_XB = WS_W_DN + 256 * MiB;
constexpr size_t WS_H = WS_XB + 64 * MiB;
constexpr size_t WS_DEC = WS_H + 320 * MiB;
constexpr size_t WS_O = WS_H + 384 * MiB;
constexpr size_t WS_A2 = WS_O + 128 * MiB;
constexpr size_t WS_Y = WS_A2 + 128 * MiB;
constexpr size_t WS_X1F = WS_Y + 128 * MiB;
constexpr size_t WS_X1B = WS_X1F + 128 * MiB;
constexpr size_t WS_ACT = WS_X1B + 64 * MiB;
constexpr size_t WS_YSLOT = WS_ACT + 272 * MiB;
constexpr size_t WS_END = WS_YSLOT + 256 * MiB;

constexpr int CW_BAR = 4096;
constexpr int CW_ECNT = 16384;

constexpr int RING_BYTES = 131072;
constexpr int MISC_OFF = 135168;
constexpr int LDS_BYTES = 147456;
constexpr int MO_BARW = 0;
constexpr int MO_GTAB = 64;
constexpr int MO_TPRE = 64 + 2048;
constexpr int MO_EBASE = MO_TPRE + 160;
constexpr int MO_ECNT = MO_EBASE + 128;
constexpr int MO_LCNT = MO_ECNT + 128;
constexpr int MO_LBASE = MO_LCNT + 128;
constexpr int MO_SEL = MO_LBASE + 128;
constexpr int MO_SELW = MO_SEL + 2048;
constexpr int MO_RANK = MO_SELW + 2048;
constexpr int MO_ULIST = MO_RANK + 2048;
static_assert(MISC_OFF + MO_ULIST + 1024 <= LDS_BYTES, "LDS map");

#define RLX_AGENT __ATOMIC_RELAXED, __HIP_MEMORY_SCOPE_AGENT
#define LDS_WAIT() asm volatile("s_waitcnt lgkmcnt(0)" ::: "memory")
#define VM_WAIT() asm volatile("s_waitcnt vmcnt(0)" ::: "memory")

__device__ __forceinline__ unsigned f2bf(float f) { unsigned u = __builtin_bit_cast(unsigned, f); return (u + 0x7fffu + ((u >> 16) & 1u)) >> 16; }
__device__ __forceinline__ unsigned pk2(float lo, float hi) { return f2bf(lo) | (f2bf(hi) << 16); }
__device__ __forceinline__ unsigned cvt_pk_bf16(float lo, float hi) { unsigned r; asm volatile("v_cvt_pk_bf16_f32 %0, %1, %2" : "=v"(r) : "v"(lo), "v"(hi)); return r; }
#if MOE_FP8
constexpr float X_SCALE = 4.0f, WGU_SCALE = 64.0f, ACT_SCALE = 4.0f, WDN_SCALE = 128.0f;
constexpr float GU_DESCALE = 1.0f / (X_SCALE * WGU_SCALE), DN_DESCALE = 1.0f / (ACT_SCALE * WDN_SCALE);
#else
constexpr float GU_DESCALE = 1.0f, DN_DESCALE = 1.0f, ACT_SCALE = 1.0f;
#endif
__device__ __forceinline__ unsigned pk4_fp8(float a, float b, float c, float d) {
    a = __builtin_amdgcn_fmed3f(a, -448.0f, 448.0f); b = __builtin_amdgcn_fmed3f(b, -448.0f, 448.0f); c = __builtin_amdgcn_fmed3f(c, -448.0f, 448.0f); d = __builtin_amdgcn_fmed3f(d, -448.0f, 448.0f);
    int p = __builtin_amdgcn_cvt_pk_fp8_f32(a, b, 0, false); p = __builtin_amdgcn_cvt_pk_fp8_f32(c, d, p, true); return (unsigned)p; }
__device__ __forceinline__ float bflo(unsigned u) { return __builtin_bit_cast(float, u << 16); }
__device__ __forceinline__ float bfhi(unsigned u) { return __builtin_bit_cast(float, u & 0xffff0000u); }
__device__ __forceinline__ float bf1(bf16 b) { return __builtin_bit_cast(float, ((unsigned)b) << 16); }
__device__ __forceinline__ float fexp(float x) { return __builtin_amdgcn_exp2f(x * 1.4426950408889634f); }
__device__ __forceinline__ float frcp(float x) { return __builtin_amdgcn_rcpf(x); }
__device__ __forceinline__ float fsigmoid(float x) { return frcp(1.0f + fexp(-x)); }
__device__ __forceinline__ float wave_sum(float v) {
#pragma unroll
    for (int o = 1; o < 64; o <<= 1) v += __shfl_xor(v, o);
    return v;
}
__device__ __forceinline__ float wave_max(float v) {
#pragma unroll
    for (int o = 1; o < 64; o <<= 1) v = fmaxf(v, __shfl_xor(v, o));
    return v;
}

template <int CTRL> __device__ __forceinline__ float dppf(float v) { return __builtin_bit_cast(float, __builtin_amdgcn_update_dpp(0, __builtin_bit_cast(int, v), CTRL, 0xf, 0xf, true)); }
template <int CTRL> __device__ __forceinline__ int dppi(int v) { return __builtin_amdgcn_update_dpp(0, v, CTRL, 0xf, 0xf, true); }
__device__ __forceinline__ float rlane(float v, int l) { return __builtin_bit_cast(float, __builtin_amdgcn_readlane(__builtin_bit_cast(int, v), l)); }
__device__ __forceinline__ float wave_sum_u(float v) {
    v += dppf<0xB1>(v); v += dppf<0x4E>(v); v += dppf<0x141>(v); v += dppf<0x140>(v);
    return (rlane(v, 0) + rlane(v, 16)) + (rlane(v, 32) + rlane(v, 48));
}
#define XB_TMO      128
#define XB_XCNT(j)  (256  + 64 * (j))
#define XB_XSUB(j)  (1280 + 64 * (j))
#define XB_XGEN(j)  (2304 + 64 * (j))
#define XB_TOP      3328
#define XB_TOPGEN   3392
#define XCD_BAR_WORDS 3456
#define XB_SPIN_CAP (1u << 22)

__device__ __forceinline__ unsigned xb_ld(unsigned* p)              { return __hip_atomic_load(p, __ATOMIC_RELAXED, __HIP_MEMORY_SCOPE_AGENT); }
__device__ __forceinline__ unsigned xb_add(unsigned* p, unsigned v) { return __hip_atomic_fetch_add(p, v, __ATOMIC_RELAXED, __HIP_MEMORY_SCOPE_AGENT); }
__device__ __forceinline__ unsigned xb_xcc_id() { return (unsigned)__builtin_amdgcn_s_getreg((3 << 11) | 20) & 0xFu; }
#define XB_SPIN(cond, bar) do { unsigned _sp = 0; while (cond) { __builtin_amdgcn_s_sleep(1); \
    if ((++_sp & 255u) == 0u) { if (xb_ld(&(bar)[XB_TMO])) break; if (_sp > XB_SPIN_CAP) { atomicAdd(&(bar)[XB_TMO], 1u); break; } } } } while (0)

struct XcdBarrier { unsigned* bar; unsigned x; volatile LAS unsigned* st; };

__device__ __forceinline__ XcdBarrier xcd_barrier_post(unsigned* bar, volatile LAS unsigned* st) {
    XcdBarrier b; b.bar = bar; b.x = xb_xcc_id(); b.st = st;
    if (threadIdx.x == 0) (void)xb_add(&bar[XB_XCNT(b.x)], 1u);
    return b;
}
__device__ __forceinline__ void xcd_barrier_complete(unsigned* bar, unsigned x, unsigned& nloc, unsigned& nx) {
    const unsigned G = gridDim.x * gridDim.y * gridDim.z;
    unsigned sum, cnt, mine, sp = 0u;
    for (;;) {
        sum = 0u; cnt = 0u; mine = 0u;
#pragma unroll
        for (unsigned j = 0; j < 16; ++j) { const unsigned c = xb_ld(&bar[XB_XCNT(j)]); sum += c; cnt += (c > 0u) ? 1u : 0u; mine = (j == x) ? c : mine; }
        if (sum == G) break;
        __builtin_amdgcn_s_sleep(1);
        if ((++sp & 255u) == 0u) { if (xb_ld(&bar[XB_TMO])) break; if (sp > XB_SPIN_CAP) { atomicAdd(&bar[XB_TMO], 1u); break; } }
    }
    nloc = mine > 0u ? mine : 1u; nx = cnt > 0u ? cnt : 1u;
}
__device__ __forceinline__ void xcd_barrier(const XcdBarrier& b) {
    asm volatile("s_waitcnt vmcnt(0)" ::: "memory");
    __syncthreads();
    if (threadIdx.x == 0) {
        unsigned* bar = b.bar;
        __builtin_amdgcn_s_waitcnt(0);
        unsigned nloc = b.st[0], nx = b.st[1];
        if (nloc == 0u) { xcd_barrier_complete(bar, b.x, nloc, nx); b.st[0] = nloc; b.st[1] = nx; }
        const unsigned old = xb_add(&bar[XB_XSUB(b.x)], 1u);
        const unsigned gen = old / nloc;
        if (old + 1u == (gen + 1u) * nloc) {
            __builtin_amdgcn_fence(__ATOMIC_RELEASE, "agent");
            asm volatile("s_waitcnt vmcnt(0)" ::: "memory");
            const unsigned og = xb_add(&bar[XB_TOP], 1u);
            const unsigned tg = og / nx;
            if (og + 1u == (tg + 1u) * nx) xb_add(&bar[XB_TOPGEN], 1u);
            else XB_SPIN(xb_ld(&bar[XB_TOPGEN]) == tg, bar);
            __builtin_amdgcn_fence(__ATOMIC_ACQUIRE, "agent");
            xb_add(&bar[XB_XGEN(b.x)], 1u);
            asm volatile("s_waitcnt vmcnt(0)" ::: "memory");
        } else {
            XB_SPIN(xb_ld(&bar[XB_XGEN(b.x)]) == gen, bar);
            __builtin_amdgcn_fence(__ATOMIC_ACQUIRE, "agent");
            asm volatile("s_waitcnt vmcnt(0)" ::: "memory");
        }
    }
    __syncthreads();
}

namespace pg8 {
constexpr int BM = 256, BK = 64, HALF = 128, HTB = HALF * BK * 2, STAGE_BYTES = 8 * HTB, NXCD = 8, WGM = 8, MAXU = 32;
__host__ __device__ __forceinline__ int lds_byte(int r, int c) { const int st = (r >> 4) * 2 + (c >> 5), rr = r & 15, cc = c & 31, ob = rr * 64 + cc * 2; return st * 1024 + (ob ^ (((ob >> 9) & 1) << 5)); }
__host__ __device__ __forceinline__ void stage_rc(int b, int& R, int& C) { const int st = b / 1024, sb = b % 1024, swz = sb ^ (((sb >> 9) & 1) << 5); R = (st >> 1) * 16 + swz / 64; C = (st & 1) * 32 + (swz % 64) / 2; }
__host__ __device__ __forceinline__ int perm32(int rho) { const int n = rho >> 4, i = rho & 15; return 8 * (i >> 2) + 4 * n + (i & 3); }

struct Unit { int pm, pn, e, rowbase, cnt; unsigned boff; int gidx; };

__device__ __forceinline__ bool tile_of(long L, int nM, int nN, int& gm, int& pn) {
    const int nwg = nM * nN; if (L >= nwg) return false;
    int wgid = (int)L; { const int q = nwg / NXCD, r = nwg % NXCD, xcd = wgid % NXCD, off = wgid / NXCD; wgid = (xcd < r ? xcd * (q + 1) : r * (q + 1) + (xcd - r) * q) + off; }
    const int nig = WGM * nN, gid = wgid / nig, fm = gid * WGM, gsz = (nM - fm) < WGM ? (nM - fm) : WGM;
    gm = fm + ((wgid % nig) % gsz); pn = (wgid % nig) / gsz; return true;
}
__device__ __forceinline__ void build_units_dense(const int i, LAS int* ul, int nM, int nN, int RB) {
    if (i < MAXU) { int gm = 0, pn = 0; const bool ok = tile_of((long)i * gridDim.x + blockIdx.x, nM, nN, gm, pn);
        ul[i * 8 + 0] = ok ? 1 : 0; ul[i * 8 + 1] = gm; ul[i * 8 + 2] = pn; ul[i * 8 + 3] = 0; ul[i * 8 + 4] = gm * BM; ul[i * 8 + 5] = BM; ul[i * 8 + 6] = (int)((unsigned)pn * BM * (unsigned)RB); ul[i * 8 + 7] = 0; }
    __syncthreads();
}
__device__ __forceinline__ void build_units_moe(const int i, LAS int* ul, const LAS int* tpre, const LAS int* ebase, const LAS int* ecnt, int nN, int RB, unsigned wstride) {
    if (i < MAXU) { int gm = 0, pn = 0; const bool ok = tile_of((long)i * gridDim.x + blockIdx.x, tpre[NE], nN, gm, pn);
        int e = 0;
_Pragma("unroll 1")
        for (int s = 16; s >= 1; s >>= 1) { if (e + s < NE && tpre[e + s] <= gm) e += s; }
        const int pm = gm - tpre[e];
        ul[i * 8 + 0] = ok ? 1 : 0; ul[i * 8 + 1] = pm; ul[i * 8 + 2] = pn; ul[i * 8 + 3] = e; ul[i * 8 + 4] = ebase[e] + pm * BM; ul[i * 8 + 5] = ecnt[e] - pm * BM;
        ul[i * 8 + 6] = (int)((unsigned)e * wstride + (unsigned)pn * BM * (unsigned)RB); ul[i * 8 + 7] = e * ECAP + pm * BM; }
    __syncthreads();
}
__device__ __forceinline__ bool ld_unit(const LAS int* ul, int i, Unit& u) {
    if (i >= MAXU) return false;
    const LAS int* p = ul + i * 8;
    if (__builtin_amdgcn_readfirstlane(p[0]) == 0) return false;
    u.pm = __builtin_amdgcn_readfirstlane(p[1]); u.pn = __builtin_amdgcn_readfirstlane(p[2]); u.e = __builtin_amdgcn_readfirstlane(p[3]); u.rowbase = __builtin_amdgcn_readfirstlane(p[4]);
    u.cnt = __builtin_amdgcn_readfirstlane(p[5]); u.boff = (unsigned)__builtin_amdgcn_readfirstlane(p[6]); u.gidx = __builtin_amdgcn_readfirstlane(p[7]); return true;
}
__device__ __forceinline__ void glds16(const char* sbase, unsigned voff, LAS unsigned char* dst) {
    asm volatile("" : "+s"(sbase));
    __builtin_amdgcn_global_load_lds((const unsigned*)(sbase + voff), (LAS unsigned*)dst, 16, 0, 0);
}
template <bool GATHER> __device__ __forceinline__ void stage_a(LAS unsigned char* dst, const char* sbase, unsigned o0, unsigned o1, size_t r64) {
    glds16(sbase, o0, dst);
    if constexpr (GATHER) glds16(sbase, o1, dst + 8192);
    else glds16(sbase + r64, o0, dst + 8192);
}

typedef int v8i __attribute__((ext_vector_type(8)));
typedef int v4i __attribute__((ext_vector_type(4)));
__device__ __forceinline__ v8i cat_frag(const bf16x8& a, const bf16x8& b) { return __builtin_shufflevector(__builtin_bit_cast(v4i, a), __builtin_bit_cast(v4i, b), 0, 1, 2, 3, 4, 5, 6, 7); }
template <class Epi, bool GATHER, bool ALIGN_EPI, bool FP8>
__device__ __forceinline__ void gemm_phase(const int tid, LAS unsigned char* lds, const LAS int* ul, LAS int* gtab, const char* Abase, const char* Bbase, const int* rowdst, const int RB, const Epi& E) {
    const int wid = __builtin_amdgcn_readfirstlane(tid >> 6), lane = tid & 63, wr = wid >> 2, wc = wid & 3, fr = lane & 15, fq = lane >> 4;
    const int nt = RB / 128;
    int R0, C0; stage_rc(tid * 16, R0, C0);
    const int Rb0 = Epi::PERM ? ((R0 & ~31) + perm32(R0 & 31)) : R0;
    const unsigned voffB = (unsigned)(Rb0 * RB + C0 * 2);
    const unsigned cb0 = (unsigned)C0 * 2u, K2 = (unsigned)RB;
    const size_t kstep = (size_t)128;
    const size_t r64 = (size_t)64 * RB;
    const size_t hstep = (size_t)HALF * RB;
    const unsigned ldsw = (unsigned)wid * 1024u;
    const int aoff = lds_byte(wr * 64 + fr, fq * 8), boff = lds_byte(wc * 32 + fr, fq * 8);
#define PG8_SA(b, h) (((b) * 2 + (h)) * HTB)
#define PG8_SB(b, h) ((4 + (b) * 2 + (h)) * HTB)
#define PG8_STAGE(bufoff, gbase) do { glds16((const char*)(gbase), voffB, lds + (bufoff) + ldsw); glds16((const char*)(gbase) + r64, voffB, lds + (bufoff) + ldsw + 8192); } while (0)
#define PG8_STAGEA0(bufoff, kb, o0, o1) stage_a<GATHER>(lds + (bufoff) + ldsw, Abase + (kb), o0, o1, r64)
#define PG8_STAGEA1(bufoff, kb, o0, o2, o3) stage_a<GATHER>(lds + (bufoff) + ldsw, Abase + (kb) + (GATHER ? (size_t)0 : hstep), GATHER ? (o2) : (o0), o3, r64)
#define PG8_LDA(dst, b, h) do { _Pragma("unroll") for (int m = 0; m < 4; ++m) { const v4i _l = *(const LAS v4i*)(lds + PG8_SA(b, h) + aoff + m * 2048), _h = *(const LAS v4i*)(lds + PG8_SA(b, h) + aoff + m * 2048 + 1024); dst[m] = __builtin_shufflevector(_l, _h, 0, 1, 2, 3, 4, 5, 6, 7); } } while (0)
#define PG8_LDB(dst, b, h) do { _Pragma("unroll") for (int n = 0; n < 2; ++n) { const v4i _l = *(const LAS v4i*)(lds + PG8_SB(b, h) + boff + n * 2048), _h = *(const LAS v4i*)(lds + PG8_SB(b, h) + boff + n * 2048 + 1024); dst[n] = __builtin_shufflevector(_l, _h, 0, 1, 2, 3, 4, 5, 6, 7); } } while (0)
#define PG8_LO(x) __builtin_bit_cast(bf16x8, __builtin_shufflevector(x, x, 0, 1, 2, 3))
#define PG8_HI(x) __builtin_bit_cast(bf16x8, __builtin_shufflevector(x, x, 4, 5, 6, 7))
#define PG8_MMA(ai, bj, At, Bt) do { __builtin_amdgcn_s_setprio(1); _Pragma("unroll") for (int m = 0; m < 4; ++m) _Pragma("unroll") for (int n = 0; n < 2; ++n) { \
        if constexpr (FP8) asm volatile("v_mfma_scale_f32_16x16x128_f8f6f4 %0, %1, %2, %0, %3, %3 op_sel_hi:[0,0,0]" : "+v"(acc[ai][bj][m][n]) : "v"(Bt[n]), "v"(At[m]), "v"(sc1)); \
        else { acc[ai][bj][m][n] = __builtin_amdgcn_mfma_f32_16x16x32_bf16(PG8_LO(Bt[n]), PG8_LO(At[m]), acc[ai][bj][m][n], 0, 0, 0); \
               acc[ai][bj][m][n] = __builtin_amdgcn_mfma_f32_16x16x32_bf16(PG8_HI(Bt[n]), PG8_HI(At[m]), acc[ai][bj][m][n], 0, 0, 0); } } \
        __builtin_amdgcn_s_setprio(0); } while (0)
#define PG8_WAIT_V(n) asm volatile("s_waitcnt vmcnt(" #n ")" ::: "memory")
#define PG8_WAIT_L(n) asm volatile("s_waitcnt lgkmcnt(" #n ")" ::: "memory")
#define PG8_BAR __builtin_amdgcn_s_barrier()
#define PG8_SCHED __builtin_amdgcn_sched_barrier(0)
    Unit cur, nxt; int ui = 0;
    if (!ld_unit(ul, 0, cur)) return;
    f32x4 acc[2][2][4][2];
#pragma unroll
    for (int a = 0; a < 2; ++a)
#pragma unroll
        for (int b = 0; b < 2; ++b)
#pragma unroll
            for (int m = 0; m < 4; ++m)
#pragma unroll
                for (int n = 0; n < 2; ++n) acc[a][b][m][n] = (f32x4){0.f, 0.f, 0.f, 0.f};
    v8i At[4], B0[2], B1[2];
    const int sc1 = 0x7f7f7f7f;
    unsigned oA0, oA1 = 0, oA2 = 0, oA3 = 0, oN0, oN1 = 0, oN2 = 0, oN3 = 0;
    if constexpr (GATHER) {
        const int c1 = cur.cnt - 1; const int* gp = rowdst + cur.gidx;
        oA0 = ((unsigned)gp[min(R0, c1)] >> 2) * K2 + cb0; oA1 = ((unsigned)gp[min(R0 + 64, c1)] >> 2) * K2 + cb0; oA2 = ((unsigned)gp[min(R0 + 128, c1)] >> 2) * K2 + cb0; oA3 = ((unsigned)gp[min(R0 + 192, c1)] >> 2) * K2 + cb0;
    } else {
        oA0 = (unsigned)(cur.rowbase + R0) * K2 + cb0;
    }
    oN0 = oA0; oN1 = oA1; oN2 = oA2; oN3 = oA3;
    const char* cB = Bbase + cur.boff;
    PG8_STAGE(PG8_SB(0, 0), cB); PG8_STAGE(PG8_SB(0, 1), cB + hstep); PG8_STAGEA0(PG8_SA(0, 0), (size_t)0, oA0, oA1); PG8_STAGEA1(PG8_SA(0, 1), (size_t)0, oA0, oA2, oA3);
    if (wr == 1) PG8_BAR;
    PG8_WAIT_V(2); PG8_BAR;
    PG8_STAGE(PG8_SB(1, 0), cB + kstep); PG8_STAGEA0(PG8_SA(1, 0), kstep, oA0, oA1); PG8_STAGE(PG8_SB(1, 1), cB + hstep + kstep);
    PG8_WAIT_V(6); PG8_BAR;
    for (;;) {
        const bool has_next = ld_unit(ul, ui + 1, nxt);
        const char* nB = has_next ? Bbase + nxt.boff : cB;
        if constexpr (GATHER) {
            if (has_next && tid < 256) gtab[tid] = (int)((unsigned)rowdst[nxt.gidx + min(tid, nxt.cnt - 1)] >> 2);
        }
_Pragma("unroll 1")
        for (int t = 0; t < nt; t += 2) {
            const bool last = (t == nt - 2);
            if (last && has_next) {
                if constexpr (GATHER) {
                    oN0 = (unsigned)gtab[R0] * K2 + cb0; oN1 = (unsigned)gtab[R0 + 64] * K2 + cb0; oN2 = (unsigned)gtab[R0 + 128] * K2 + cb0; oN3 = (unsigned)gtab[R0 + 192] * K2 + cb0;
                } else {
                    oN0 = (unsigned)(nxt.rowbase + R0) * K2 + cb0;
                }
            }
            const size_t kb1 = (size_t)(t + 1) * kstep;
            const size_t kb2 = last ? (size_t)0 : (size_t)(t + 2) * kstep, kb3 = kb2 + kstep;
            const unsigned p0 = last ? oN0 : oA0, p1 = last ? oN1 : oA1, p2 = last ? oN2 : oA2, p3 = last ? oN3 : oA3;
            const char* b2 = last ? nB : cB + (size_t)(t + 2) * kstep; const char* b3 = b2 + kstep;
            PG8_LDB(B0, 0, 0); PG8_LDB(B1, 0, 1); PG8_SCHED; PG8_LDA(At, 0, 0); PG8_STAGEA1(PG8_SA(1, 1), kb1, oA0, oA2, oA3);
            PG8_WAIT_V(8); PG8_WAIT_L(0); PG8_BAR; PG8_MMA(0, 0, At, B0); PG8_MMA(0, 1, At, B1); PG8_BAR; PG8_SCHED;
            PG8_LDA(At, 0, 1); PG8_STAGE(PG8_SB(0, 0), b2); PG8_STAGE(PG8_SB(0, 1), b2 + hstep); PG8_STAGEA0(PG8_SA(0, 0), kb2, p0, p1);
            PG8_WAIT_V(8); PG8_WAIT_L(0); PG8_BAR; PG8_MMA(1, 0, At, B0); PG8_MMA(1, 1, At, B1); PG8_BAR; PG8_SCHED;
            PG8_LDB(B0, 1, 0); PG8_LDB(B1, 1, 1); PG8_SCHED; PG8_LDA(At, 1, 0); PG8_STAGEA1(PG8_SA(0, 1), kb2, p0, p2, p3);
            PG8_WAIT_V(8); PG8_WAIT_L(0); PG8_BAR; PG8_MMA(0, 0, At, B0); PG8_MMA(0, 1, At, B1); PG8_BAR; PG8_SCHED;
            PG8_LDA(At, 1, 1); PG8_STAGE(PG8_SB(1, 0), b3); PG8_STAGE(PG8_SB(1, 1), b3 + hstep); PG8_STAGEA0(PG8_SA(1, 0), kb3, p0, p1);
            PG8_WAIT_V(8); PG8_WAIT_L(0); PG8_BAR; PG8_MMA(1, 0, At, B0); PG8_MMA(1, 1, At, B1); PG8_BAR; PG8_SCHED;
        }
        if constexpr (FP8) asm volatile("s_nop 7\n\ts_nop 7\n\ts_nop 7" ::: "memory");
        if constexpr (ALIGN_EPI) { if (wr == 0) PG8_BAR; }
        E(acc, cur, wr, wc, fr, fq);
#if PROBE_EPI2
        if constexpr (FP8) E(acc, cur, wr, wc, fr, fq);
#endif
        if (!has_next) break;
#pragma unroll
        for (int a = 0; a < 2; ++a)
#pragma unroll
            for (int b = 0; b < 2; ++b)
#pragma unroll
                for (int m = 0; m < 4; ++m)
#pragma unroll
                    for (int n = 0; n < 2; ++n) acc[a][b][m][n] = (f32x4){0.f, 0.f, 0.f, 0.f};
        cur = nxt; cB = nB; oA0 = oN0; oA1 = oN1; oA2 = oN2; oA3 = oN3; ++ui;
        if constexpr (ALIGN_EPI) { if (wr == 1) PG8_BAR; }
    }
    PG8_WAIT_V(0);
    if constexpr (!ALIGN_EPI) { if (wr == 0) PG8_BAR; }
    PG8_BAR;
#undef PG8_SA
#undef PG8_SB
#undef PG8_STAGE
#undef PG8_STAGEA0
#undef PG8_STAGEA1
#undef PG8_LDA
#undef PG8_LDB
#undef PG8_LO
#undef PG8_HI
#undef PG8_MMA
#undef PG8_WAIT_V
#undef PG8_WAIT_L
#undef PG8_BAR
#undef PG8_SCHED
}

__device__ __forceinline__ GAS unsigned char* launder(unsigned char* p) { asm volatile("" : "+s"(p)); return (GAS unsigned char*)p; }
#define OPAQUE_LANE(fr, fq) asm volatile("" : "+v"(fr), "+v"(fq))
struct EpiHgrnIn {
    static constexpr bool PERM = true;
    unsigned char* ws0; int L;
    __device__ __forceinline__ void operator()(const f32x4 (&acc)[2][2][4][2], const Unit& u, int wr, int wc, int fr, int fq) const {
        OPAQUE_LANE(fr, fq);
        GAS unsigned char* ws = launder(ws0);
        GAS bf16* QD = (GAS bf16*)(ws + WS_H);
        const int row0 = u.rowbase + wr * 64 + fr;
        if (u.pn >= 8) {
            const bool isg = u.pn >= 12; GAS bf16* base = QD + (size_t)(isg ? 4 : 3) * NTOK * DM; const int colt = (u.pn - (isg ? 12 : 8)) * BM + wc * 32 + 8 * fq;
#pragma unroll
            for (int ai = 0; ai < 2; ++ai)
#pragma unroll
                for (int m = 0; m < 4; ++m) { GAS bf16* rowp = base + (size_t)(row0 + ai * HALF + m * 16) * DM + colt;
#pragma unroll
                    for (int bj = 0; bj < 2; ++bj) { f32x4 v0 = acc[ai][bj][m][0], v1 = acc[ai][bj][m][1];
                        if (isg) {
#pragma unroll
                            for (int j = 0; j < 4; ++j) { v0[j] = v0[j] * fsigmoid(v0[j]); v1[j] = v1[j] * fsigmoid(v1[j]); } }
                        v4u w; w.x = cvt_pk_bf16(v0[0], v0[1]); w.y = cvt_pk_bf16(v0[2], v0[3]); w.z = cvt_pk_bf16(v1[0], v1[1]); w.w = cvt_pk_bf16(v1[2], v1[3]);
                        *(GAS v4u*)(rowp + bj * HALF) = w; } }
            return;
        }
        const int col = u.pn * HG_K + wc * 32 + 8 * fq;
        const GAS float* lb = (const GAS float*)(ws + WS_LBS) + L * DM;
        const f32x4 lb0 = *(const GAS f32x4*)(lb + col), lb1 = *(const GAS f32x4*)(lb + col + 4);
#if !SLOW_HGRN
        const int lane = fq * 16 + fr;
        GAS float* DEC = (GAS float*)(ws + WS_DEC);
#endif
#pragma unroll
        for (int ai = 0; ai < 2; ++ai)
#pragma unroll
            for (int m = 0; m < 4; ++m) {
                const int row = row0 + ai * HALF + m * 16;
                float qd[8], ki[8], ks[8];
#if !SLOW_HGRN
                float de[8];
#endif
#pragma unroll
                for (int j = 0; j < 8; ++j) {
                    const float q = acc[ai][0][m][j >> 2][j & 3], f = acc[ai][1][m][j >> 2][j & 3], lbv = j < 4 ? lb0[j & 3] : lb1[j & 3];
                    const float sg = fsigmoid(f), fg = lbv + (1.0f - lbv) * sg, kk = (1.0f - lbv) * (1.0f - sg);
#if SLOW_HGRN
                    qd[j] = q * fsigmoid(q); ki[j] = kk; ks[j] = fg;
#else
                    float P = fg;
                    P *= __builtin_bit_cast(float, __builtin_amdgcn_update_dpp(0x3f800000, __builtin_bit_cast(int, P), 0x111, 0xf, 0xf, false));
                    P *= __builtin_bit_cast(float, __builtin_amdgcn_update_dpp(0x3f800000, __builtin_bit_cast(int, P), 0x112, 0xf, 0xf, false));
                    P *= __builtin_bit_cast(float, __builtin_amdgcn_update_dpp(0x3f800000, __builtin_bit_cast(int, P), 0x114, 0xf, 0xf, false));
                    P *= __builtin_bit_cast(float, __builtin_amdgcn_update_dpp(0x3f800000, __builtin_bit_cast(int, P), 0x118, 0xf, 0xf, false));
                    const float Pl = __shfl(P, lane | 15), iP = frcp(P);
                    qd[j] = q * fsigmoid(q) * P; ki[j] = kk * iP; ks[j] = kk * (Pl * iP); de[j] = Pl;
#endif
                }
                const size_t o = (size_t)row * DM + col;
                v4u w;
                w.x = cvt_pk_bf16(qd[0], qd[1]); w.y = cvt_pk_bf16(qd[2], qd[3]); w.z = cvt_pk_bf16(qd[4], qd[5]); w.w = cvt_pk_bf16(qd[6], qd[7]); *(GAS v4u*)(QD + o) = w;
                w.x = cvt_pk_bf16(ki[0], ki[1]); w.y = cvt_pk_bf16(ki[2], ki[3]); w.z = cvt_pk_bf16(ki[4], ki[5]); w.w = cvt_pk_bf16(ki[6], ki[7]); *(GAS v4u*)(QD + (size_t)NTOK * DM + o) = w;
                w.x = cvt_pk_bf16(ks[0], ks[1]); w.y = cvt_pk_bf16(ks[2], ks[3]); w.z = cvt_pk_bf16(ks[4], ks[5]); w.w = cvt_pk_bf16(ks[6], ks[7]); *(GAS v4u*)(QD + 2 * (size_t)NTOK * DM + o) = w;
#if !SLOW_HGRN
                if (fr == 0) { GAS float* dp = DEC + (size_t)(row >> 4) * DM + col; *(GAS f32x4*)dp = (f32x4){de[0], de[1], de[2], de[3]}; *(GAS f32x4*)(dp + 4) = (f32x4){de[4], de[5], de[6], de[7]}; }
#endif
            }
    }
};
struct EpiRetIn {
    static constexpr bool PERM = true;
    unsigned char* ws0;
    __device__ __forceinline__ void operator()(const f32x4 (&acc)[2][2][4][2], const Unit& u, int wr, int wc, int fr, int fq) const {
        OPAQUE_LANE(fr, fq);
        GAS unsigned char* ws = launder(ws0);
        GAS bf16* H = (GAS bf16*)(ws + WS_H); const GAS float* rot = (const GAS float*)(ws + WS_ROT);
        const int row0 = u.rowbase + wr * 64 + fr; const int colt = u.pn * BM + wc * 32 + 8 * fq;
        const int kind = u.pn < 4 ? 0 : (u.pn < 8 ? 1 : (u.pn < 16 ? 2 : 3));
#pragma unroll
        for (int ai = 0; ai < 2; ++ai)
#pragma unroll
            for (int m = 0; m < 4; ++m) { const int row = row0 + ai * HALF + m * 16; GAS bf16* rowp = H + (size_t)row * RT_IN + colt; const int pos = row & (SEQ - 1);
#pragma unroll
                for (int bj = 0; bj < 2; ++bj) { f32x4 v0 = acc[ai][bj][m][0], v1 = acc[ai][bj][m][1];
                    if (kind <= 1) {
                        const int p0 = (bj * HALF + wc * 32 + 8 * fq) >> 1;
                        const GAS float* rp = rot + ((size_t)pos * 128 + p0) * 2;
                        const f32x4 r0 = *(const GAS f32x4*)rp, r1 = *(const GAS f32x4*)(rp + 4);
                        const float sc = kind == 1 ? 0.0625f : 1.0f;
                        f32x4 o0, o1;
                        o0[0] = (v0[0] * r0[0] - v0[1] * r0[1]) * sc; o0[1] = (v0[1] * r0[0] + v0[0] * r0[1]) * sc;
                        o0[2] = (v0[2] * r0[2] - v0[3] * r0[3]) * sc; o0[3] = (v0[3] * r0[2] + v0[2] * r0[3]) * sc;
                        o1[0] = (v1[0] * r1[0] - v1[1] * r1[1]) * sc; o1[1] = (v1[1] * r1[0] + v1[0] * r1[1]) * sc;
                        o1[2] = (v1[2] * r1[2] - v1[3] * r1[3]) * sc; o1[3] = (v1[3] * r1[2] + v1[2] * r1[3]) * sc;
                        v0 = o0; v1 = o1;
                    } else if (kind == 3) {
#pragma unroll
                        for (int j = 0; j < 4; ++j) { v0[j] = v0[j] * fsigmoid(v0[j]); v1[j] = v1[j] * fsigmoid(v1[j]); }
                    }
                    v4u w; w.x = cvt_pk_bf16(v0[0], v0[1]); w.y = cvt_pk_bf16(v0[2], v0[3]); w.z = cvt_pk_bf16(v1[0], v1[1]); w.w = cvt_pk_bf16(v1[2], v1[3]);
                    *(GAS v4u*)(rowp + bj * HALF) = w; } }
    }
};
struct EpiRes {
    static constexpr bool PERM = true;
    unsigned char* ws0;
    __device__ __forceinline__ void operator()(const f32x4 (&acc)[2][2][4][2], const Unit& u, int wr, int wc, int fr, int fq) const {
        OPAQUE_LANE(fr, fq);
        GAS unsigned char* ws = launder(ws0);
        GAS bf16* Y = (GAS bf16*)(ws + WS_Y); const GAS bf16* X = (const GAS bf16*)(ws + WS_XB);
        const int row0 = u.rowbase + wr * 64 + fr, col0 = u.pn * BM + wc * 32 + 8 * fq;
#pragma unroll
        for (int ai = 0; ai < 2; ++ai)
#pragma unroll
            for (int m = 0; m < 4; ++m) { const size_t off = (size_t)(row0 + ai * HALF + m * 16) * DM + col0;
#pragma unroll
                for (int bj = 0; bj < 2; ++bj) { const v4u xs = *(const GAS v4u*)(X + off + bj * HALF); const f32x4 a0 = acc[ai][bj][m][0], a1 = acc[ai][bj][m][1];
                    v4u w; w.x = cvt_pk_bf16(bflo(xs.x) * DN_ALPHA + a0[0], bfhi(xs.x) * DN_ALPHA + a0[1]); w.y = cvt_pk_bf16(bflo(xs.y) * DN_ALPHA + a0[2], bfhi(xs.y) * DN_ALPHA + a0[3]);
                    w.z = cvt_pk_bf16(bflo(xs.z) * DN_ALPHA + a1[0], bfhi(xs.z) * DN_ALPHA + a1[1]); w.w = cvt_pk_bf16(bflo(xs.w) * DN_ALPHA + a1[2], bfhi(xs.w) * DN_ALPHA + a1[3]);
                    *(GAS v4u*)(Y + off + bj * HALF) = w; } }
    }
};
struct EpiMoeGU {
    static constexpr bool PERM = true;
    unsigned char* ws0; int L;
    __device__ __forceinline__ void operator()(const f32x4 (&acc)[2][2][4][2], const Unit& u, int wr, int wc, int fr, int fq) const {
        OPAQUE_LANE(fr, fq);
        GAS unsigned char* ws = launder(ws0);
        const GAS float* bias = (const GAS float*)(ws + WS_BGU) + (size_t)L * NE * 2048;
        const int row0 = u.rowbase + wr * 64 + fr; const int c8 = wc * 32 + 8 * fq;
        const GAS float* bp = bias + ((size_t)u.e * 8 + u.pn) * 256 + c8;
        const f32x4 bg0 = *(const GAS f32x4*)bp, bg1 = *(const GAS f32x4*)(bp + 4);
        const f32x4 bl0 = (*(const GAS f32x4*)(bp + HALF) + 1.0f) * ACT_SCALE, bl1 = (*(const GAS f32x4*)(bp + HALF + 4) + 1.0f) * ACT_SCALE;
#pragma unroll
        for (int ai = 0; ai < 2; ++ai)
#pragma unroll
            for (int m = 0; m < 4; ++m) { const size_t eo = (size_t)(row0 + ai * HALF + m * 16) * DM + u.pn * HALF + c8;
                float a[8];
#pragma unroll
                for (int j = 0; j < 8; ++j) {
                    const float g = fminf(fmaf(acc[ai][0][m][j >> 2][j & 3], GU_DESCALE, j < 4 ? bg0[j & 3] : bg1[j & 3]), 7.0f);
                    const float l1 = __builtin_amdgcn_fmed3f(fmaf(acc[ai][1][m][j >> 2][j & 3], GU_DESCALE * ACT_SCALE, j < 4 ? bl0[j & 3] : bl1[j & 3]), -6.0f * ACT_SCALE, 8.0f * ACT_SCALE);
                    a[j] = g * frcp(1.0f + __builtin_amdgcn_exp2f(g * -2.4554669595930156f)) * l1;
                }
#if MOE_FP8
                v2u w;
                { int p = __builtin_amdgcn_cvt_pk_fp8_f32(a[0], a[1], 0, false); p = __builtin_amdgcn_cvt_pk_fp8_f32(a[2], a[3], p, true); w.x = (unsigned)p; }
                { int p = __builtin_amdgcn_cvt_pk_fp8_f32(a[4], a[5], 0, false); p = __builtin_amdgcn_cvt_pk_fp8_f32(a[6], a[7], p, true); w.y = (unsigned)p; }
                *(GAS v2u*)(ws + WS_ACT + eo) = w;
#else
                v4u w; w.x = cvt_pk_bf16(a[0], a[1]); w.y = cvt_pk_bf16(a[2], a[3]); w.z = cvt_pk_bf16(a[4], a[5]); w.w = cvt_pk_bf16(a[6], a[7]);
                *(GAS v4u*)((GAS bf16*)(ws + WS_ACT) + eo) = w;
#endif
            }
    }
};
struct EpiMoeDown {
    static constexpr bool PERM = true;
    unsigned char* ws0; const float* bias;
    __device__ __forceinline__ void operator()(const f32x4 (&acc)[2][2][4][2], const Unit& u, int wr, int wc, int fr, int fq) const {
        OPAQUE_LANE(fr, fq);
        GAS unsigned char* ws = launder(ws0);
        GAS bf16* YS = (GAS bf16*)(ws + WS_YSLOT); const GAS int* rowdst = (const GAS int*)(ws + WS_ROWDST); const GAS float* rowgate = (const GAS float*)(ws + WS_ROWGATE);
        const int c8 = u.pn * BM + wc * 32 + 8 * fq;
        const GAS float* bp = (const GAS float*)bias + (size_t)u.e * DM + c8;
        f32x4 bv[2][2];
#pragma unroll
        for (int bj = 0; bj < 2; ++bj) { bv[bj][0] = *(const GAS f32x4*)(bp + bj * HALF); bv[bj][1] = *(const GAS f32x4*)(bp + bj * HALF + 4); }
#pragma unroll
        for (int ai = 0; ai < 2; ++ai)
#pragma unroll
            for (int m = 0; m < 4; ++m) { const int r = ai * HALF + wr * 64 + m * 16 + fr;
                if (r < u.cnt) {
                    const size_t ti = (size_t)u.gidx + r; const int dst = rowdst[ti]; const float gt = rowgate[ti];
#if YS_FP8
                    GAS unsigned char* rowp = (GAS unsigned char*)YS + (size_t)dst * DM + c8;
#pragma unroll
                    for (int bj = 0; bj < 2; ++bj) { const f32x4 v0 = (acc[ai][bj][m][0] * DN_DESCALE + bv[bj][0]) * (gt * 64.0f), v1 = (acc[ai][bj][m][1] * DN_DESCALE + bv[bj][1]) * (gt * 64.0f);
                        v2u w; w.x = pk4_fp8(v0[0], v0[1], v0[2], v0[3]); w.y = pk4_fp8(v1[0], v1[1], v1[2], v1[3]);
                        *(GAS v2u*)(rowp + bj * HALF) = w; } } }
#else
                    GAS bf16* rowp = YS + (size_t)dst * DM + c8;
#pragma unroll
                    for (int bj = 0; bj < 2; ++bj) { const f32x4 v0 = (acc[ai][bj][m][0] * DN_DESCALE + bv[bj][0]) * gt, v1 = (acc[ai][bj][m][1] * DN_DESCALE + bv[bj][1]) * gt;
                        v4u w; w.x = cvt_pk_bf16(v0[0], v0[1]); w.y = cvt_pk_bf16(v0[2], v0[3]); w.z = cvt_pk_bf16(v1[0], v1[1]); w.w = cvt_pk_bf16(v1[2], v1[3]);
                        *(GAS v4u*)(rowp + bj * HALF) = w; } } }
#endif
    }
};
}

typedef short s16x4 __attribute__((ext_vector_type(4)));
typedef __bf16 bf16x2_t __attribute__((ext_vector_type(2)));
__device__ __forceinline__ unsigned cvtpk(float lo, float hi) { f32x2 v = {lo, hi}; bf16x2_t b = __builtin_convertvector(v, bf16x2_t); return __builtin_bit_cast(unsigned, b); }
__device__ __forceinline__ s16x4 tr_read(const LAS unsigned char* p) { return __builtin_bit_cast(s16x4, __builtin_amdgcn_ds_read_tr16_b64_v4i16((LAS s16x4*)p)); }
__device__ __forceinline__ bf16x8 cat8(s16x4 lo, s16x4 hi) { return __builtin_shufflevector(lo, hi, 0, 1, 2, 3, 4, 5, 6, 7); }
__device__ __forceinline__ bf16x8 pack8(const f32x4& a, const f32x4& b) { v4u p; p.x = cvtpk(a[0], a[1]); p.y = cvtpk(a[2], a[3]); p.z = cvtpk(b[0], b[1]); p.w = cvtpk(b[2], b[3]); return __builtin_bit_cast(bf16x8, p); }
__device__ __forceinline__ s16x4 pack4(const f32x4& a) { v2u p; p.x = cvtpk(a[0], a[1]); p.y = cvtpk(a[2], a[3]); return __builtin_bit_cast(s16x4, p); }
#define LDS_BARRIER() do { asm volatile("s_waitcnt lgkmcnt(0)" ::: "memory"); __builtin_amdgcn_s_barrier(); asm volatile("" ::: "memory"); } while (0)
#define MFMA32(a, b, c) __builtin_amdgcn_mfma_f32_16x16x32_bf16((a), (b), (c), 0, 0, 0)
#define MFMA16(a, b, c) __builtin_amdgcn_mfma_f32_16x16x16bf16_1k((a), (b), (c), 0, 0, 0)

__device__ __forceinline__ void ret_fast(const int tid, LAS unsigned char* lds, const bf16* HB, bf16* OB) {
    constexpr int QP = 528, VP = 272, PP = 144;
    constexpr int OFF_Q = 0, OFF_K = 64 * QP, OFF_V = 2 * 64 * QP, OFF_P = OFF_V + 64 * VP;
    const int lane0 = tid & 63, w = __builtin_amdgcn_readfirstlane(tid >> 6);
    const int prow = tid >> 3, pc = tid & 7;
    for (int un0 = blockIdx.x; un0 < NBATCH * RT_HEADS * 4; un0 += gridDim.x) {
        const int un = (gridDim.x == 256) ? ((un0 & 7) * 32 + (un0 >> 3)) : un0;
        const int b = un >> 4, h = (un >> 2) & 3, vs = un & 3;
        const float l2g = __builtin_amdgcn_logf(1.0f - __builtin_amdgcn_exp2f(-5.0f - (float)h));
        const float dC = __builtin_amdgcn_exp2f(64.0f * l2g);
        f32x4 st[16];
#pragma unroll
        for (int i = 0; i < 16; ++i) st[i] = (f32x4){0.f, 0.f, 0.f, 0.f};
        const bf16* gbase = HB + (size_t)(b * SEQ + prow) * RT_IN;
        v4u pq[4], pk[4], pv[2];
#pragma unroll
        for (int j = 0; j < 4; ++j) { pq[j] = *(const v4u*)(gbase + h * 256 + (pc + 8 * j) * 8); pk[j] = *(const v4u*)(gbase + 1024 + h * 256 + (pc + 8 * j) * 8); }
#pragma unroll
        for (int j = 0; j < 2; ++j) pv[j] = *(const v4u*)(gbase + 2048 + h * 512 + vs * 128 + (pc + 8 * j) * 8);
#pragma unroll 1
        for (int ch = 0; ch < SEQ / 64; ++ch) {
            int lane = lane0; asm volatile("" : "+v"(lane));
            const int r = lane & 15, g = lane >> 4, q4 = (lane & 15) >> 2, p4 = lane & 3;
            LDS_BARRIER();
#pragma unroll
            for (int j = 0; j < 4; ++j) { *(LAS v4u*)(lds + OFF_Q + prow * QP + (pc + 8 * j) * 16) = pq[j]; *(LAS v4u*)(lds + OFF_K + prow * QP + (pc + 8 * j) * 16) = pk[j]; }
#pragma unroll
            for (int j = 0; j < 2; ++j) *(LAS v4u*)(lds + OFF_V + prow * VP + (pc + 8 * j) * 16) = pv[j];
            if (ch + 1 < SEQ / 64) {
                const bf16* gn = gbase + (size_t)(ch + 1) * 64 * RT_IN;
#pragma unroll
                for (int j = 0; j < 4; ++j) { pq[j] = *(const v4u*)(gn + h * 256 + (pc + 8 * j) * 8); pk[j] = *(const v4u*)(gn + 1024 + h * 256 + (pc + 8 * j) * 8); }
#pragma unroll
                for (int j = 0; j < 2; ++j) pv[j] = *(const v4u*)(gn + 2048 + h * 512 + vs * 128 + (pc + 8 * j) * 8);
            }
            LDS_BARRIER();
            {
                const int ct = w >> 1, st0 = 2 * (w & 1);
                f32x4 sa0 = {0.f, 0.f, 0.f, 0.f}, sa1 = {0.f, 0.f, 0.f, 0.f};
                const LAS unsigned char* qb = lds + OFF_Q + (16 * ct + r) * QP + g * 16;
                const LAS unsigned char* kb0 = lds + OFF_K + (16 * st0 + r) * QP + g * 16;
#pragma unroll
                for (int hb = 0; hb < 4; ++hb) {
                    bf16x8 qf[2], k0[2], k1[2];
#pragma unroll
                    for (int kk = 0; kk < 2; ++kk) { const int kb = hb * 2 + kk; qf[kk] = *(const LAS bf16x8*)(qb + kb * 64); k0[kk] = *(const LAS bf16x8*)(kb0 + kb * 64); k1[kk] = *(const LAS bf16x8*)(kb0 + 16 * QP + kb * 64); }
                    asm volatile("" : "+v"(qf[0]), "+v"(qf[1]), "+v"(k0[0]), "+v"(k0[1]), "+v"(k1[0]), "+v"(k1[1]) :: "memory");
#pragma unroll
                    for (int kk = 0; kk < 2; ++kk) { sa0 = MFMA32(k0[kk], qf[kk], sa0); sa1 = MFMA32(k1[kk], qf[kk], sa1); }
                }
                const int c = 16 * ct + r;
#pragma unroll
                for (int t = 0; t < 2; ++t) {
                    const f32x4 sa = t ? sa1 : sa0; const int s0 = 16 * (st0 + t) + 4 * g; float v[4];
#pragma unroll
                    for (int i = 0; i < 4; ++i) { const int d = c - (s0 + i); v[i] = d >= 0 ? sa[i] * __builtin_amdgcn_exp2f((float)d * l2g) : 0.f; }
                    v2u pw; pw.x = cvtpk(v[0], v[1]); pw.y = cvtpk(v[2], v[3]);
                    *(LAS v2u*)(lds + OFF_P + c * PP + s0 * 2) = pw;
                }
            }
            LDS_BARRIER();
            f32x4 o[4];
#pragma unroll
            for (int ct = 0; ct < 4; ++ct) o[ct] = (f32x4){0.f, 0.f, 0.f, 0.f};
            {
                s16x4 ql[2][4], qh[2][4];
                const LAS unsigned char* qp0 = lds + OFF_Q + r * QP + (4 * g) * 2;
#pragma unroll
                for (int ct = 0; ct < 4; ++ct) { ql[0][ct] = *(const LAS s16x4*)(qp0 + ct * 16 * QP); qh[0][ct] = *(const LAS s16x4*)(qp0 + ct * 16 * QP + 32); }
#pragma unroll
                for (int kb = 0; kb < 8; ++kb) {
                    const int cu = kb & 1, nx = cu ^ 1;
                    if (kb + 1 < 8) {
#pragma unroll
                        for (int ct = 0; ct < 4; ++ct) { ql[nx][ct] = *(const LAS s16x4*)(qp0 + ct * 16 * QP + (kb + 1) * 64); qh[nx][ct] = *(const LAS s16x4*)(qp0 + ct * 16 * QP + (kb + 1) * 64 + 32); }
                    }
                    asm volatile("" : "+v"(ql[cu][0]), "+v"(ql[cu][1]), "+v"(ql[cu][2]), "+v"(ql[cu][3]), "+v"(qh[cu][0]), "+v"(qh[cu][1]), "+v"(qh[cu][2]), "+v"(qh[cu][3]) :: "memory");
                    const bf16x8 sa = pack8(st[2 * kb], st[2 * kb + 1]);
#pragma unroll
                    for (int ct = 0; ct < 4; ++ct) o[ct] = MFMA32(sa, cat8(ql[cu][ct], qh[cu][ct]), o[ct]);
                }
            }
            bf16x8 vf[2], pf[6];
            {
                s16x4 t0[2], t1[2];
#pragma unroll
                for (int sb = 0; sb < 2; ++sb) { const LAS unsigned char* vp = lds + OFF_V + (32 * sb + 8 * g + q4) * VP + (16 * w + 4 * p4) * 2; t0[sb] = tr_read(vp); t1[sb] = tr_read(vp + 4 * VP); }
                pf[0] = *(const LAS bf16x8*)(lds + OFF_P + (0 + r) * PP + (8 * g) * 2);
                pf[1] = *(const LAS bf16x8*)(lds + OFF_P + (16 + r) * PP + (8 * g) * 2);
                pf[2] = *(const LAS bf16x8*)(lds + OFF_P + (32 + r) * PP + (8 * g) * 2);
                pf[3] = *(const LAS bf16x8*)(lds + OFF_P + (32 + r) * PP + (32 + 8 * g) * 2);
                pf[4] = *(const LAS bf16x8*)(lds + OFF_P + (48 + r) * PP + (8 * g) * 2);
                pf[5] = *(const LAS bf16x8*)(lds + OFF_P + (48 + r) * PP + (32 + 8 * g) * 2);
                asm volatile("" : "+v"(t0[0]), "+v"(t0[1]), "+v"(t1[0]), "+v"(t1[1]), "+v"(pf[0]), "+v"(pf[1]), "+v"(pf[2]), "+v"(pf[3]), "+v"(pf[4]), "+v"(pf[5]) :: "memory");
                vf[0] = cat8(t0[0], t1[0]); vf[1] = cat8(t0[1], t1[1]);
            }
#pragma unroll
            for (int ct = 0; ct < 4; ++ct) o[ct] = o[ct] * __builtin_amdgcn_exp2f((float)(16 * ct + r + 1) * l2g);
            o[0] = MFMA32(vf[0], pf[0], o[0]); o[1] = MFMA32(vf[0], pf[1], o[1]);
            o[2] = MFMA32(vf[0], pf[2], o[2]); o[2] = MFMA32(vf[1], pf[3], o[2]);
            o[3] = MFMA32(vf[0], pf[4], o[3]); o[3] = MFMA32(vf[1], pf[5], o[3]);
            {
                bf16* ob = OB + (size_t)(b * SEQ + ch * 64 + r) * RT_VD + h * 512 + vs * 128 + 16 * w + 4 * g;
#pragma unroll
                for (int ct = 0; ct < 4; ++ct) { v2u ow; ow.x = cvtpk(o[ct][0], o[ct][1]); ow.y = cvtpk(o[ct][2], o[ct][3]); *(v2u*)(ob + (size_t)ct * 16 * RT_VD) = ow; }
            }
            bf16x8 vz[2];
#pragma unroll
            for (int sb = 0; sb < 2; ++sb) {
                const v4u raw = __builtin_bit_cast(v4u, vf[sb]); float f[8] = {bflo(raw.x), bfhi(raw.x), bflo(raw.y), bfhi(raw.y), bflo(raw.z), bfhi(raw.z), bflo(raw.w), bfhi(raw.w)};
#pragma unroll
                for (int j = 0; j < 8; ++j) f[j] *= __builtin_amdgcn_exp2f((float)(63 - (32 * sb + 8 * g + j)) * l2g);
                v4u z; z.x = cvtpk(f[0], f[1]); z.y = cvtpk(f[2], f[3]); z.z = cvtpk(f[4], f[5]); z.w = cvtpk(f[6], f[7]); vz[sb] = __builtin_bit_cast(bf16x8, z);
            }
            {
                const LAS unsigned char* kp0 = lds + OFF_K + (8 * g + q4) * QP + (4 * p4) * 2;
#pragma unroll
                for (int kq = 0; kq < 4; ++kq) {
                    s16x4 ka[4][2], kbh[4][2];
#pragma unroll
                    for (int j = 0; j < 4; ++j)
#pragma unroll
                        for (int sb = 0; sb < 2; ++sb) { const LAS unsigned char* kp = kp0 + (32 * sb) * QP + (16 * (kq * 4 + j)) * 2; ka[j][sb] = tr_read(kp); kbh[j][sb] = tr_read(kp + 4 * QP); }
                    asm volatile("" : "+v"(ka[0][0]), "+v"(ka[0][1]), "+v"(ka[1][0]), "+v"(ka[1][1]), "+v"(ka[2][0]), "+v"(ka[2][1]), "+v"(ka[3][0]), "+v"(ka[3][1]),
                                      "+v"(kbh[0][0]), "+v"(kbh[0][1]), "+v"(kbh[1][0]), "+v"(kbh[1][1]), "+v"(kbh[2][0]), "+v"(kbh[2][1]), "+v"(kbh[3][0]), "+v"(kbh[3][1]) :: "memory");
#pragma unroll
                    for (int j = 0; j < 4; ++j) { const int kt = kq * 4 + j;
                        st[kt] = st[kt] * dC;
                        st[kt] = MFMA32(cat8(ka[j][0], kbh[j][0]), vz[0], st[kt]);
                        st[kt] = MFMA32(cat8(ka[j][1], kbh[j][1]), vz[1], st[kt]); }
                }
            }
        }
        LDS_BARRIER();
    }
}

__device__ __forceinline__ void hgrn_fast(const int tid, LAS unsigned char* lds, const bf16* QD, const bf16* KI, const bf16* KS, const bf16* VV, const float* DEC, bf16* OB) {
    constexpr int TP = 272;
    constexpr int OFF_QD = 0, OFF_KI = 64 * TP, OFF_KS = 2 * 64 * TP, OFF_V = 3 * 64 * TP, OFF_DEC = 4 * 64 * TP;
    const int lane = tid & 63, w = __builtin_amdgcn_readfirstlane(tid >> 6), r = lane & 15, g = lane >> 4, q4 = (lane & 15) >> 2, p4 = lane & 3;
    const int prow = tid >> 3, pc = tid & 7;
    for (int un = blockIdx.x; un < NBATCH * HG_HEADS; un += gridDim.x) {
        const int b = un >> 3, h = un & 7;
        f32x4 st[8];
#pragma unroll
        for (int i = 0; i < 8; ++i) st[i] = (f32x4){0.f, 0.f, 0.f, 0.f};
        const size_t goff = (size_t)(b * SEQ + prow) * DM + h * 128;
        v4u p0[2], p1[2], p2[2], p3[2]; f32x4 pd = {0.f, 0.f, 0.f, 0.f};
#pragma unroll
        for (int j = 0; j < 2; ++j) { const size_t o = goff + (pc + 8 * j) * 8; p0[j] = *(const v4u*)(QD + o); p1[j] = *(const v4u*)(KI + o); p2[j] = *(const v4u*)(KS + o); p3[j] = *(const v4u*)(VV + o); }
        if (tid < 128) pd = *(const f32x4*)(DEC + (size_t)((b * SEQ) / 16 + (tid >> 5)) * DM + h * 128 + (tid & 31) * 4);
#pragma unroll 1
        for (int rd = 0; rd < SEQ / 64; ++rd) {
            LDS_BARRIER();
#pragma unroll
            for (int j = 0; j < 2; ++j) { const int lo = prow * TP + (pc + 8 * j) * 16; *(LAS v4u*)(lds + OFF_QD + lo) = p0[j]; *(LAS v4u*)(lds + OFF_KI + lo) = p1[j]; *(LAS v4u*)(lds + OFF_KS + lo) = p2[j]; *(LAS v4u*)(lds + OFF_V + lo) = p3[j]; }
            if (tid < 128) *(LAS f32x4*)(lds + OFF_DEC + tid * 16) = pd;
            if (rd + 1 < SEQ / 64) {
                const size_t gn = goff + (size_t)(rd + 1) * 64 * DM;
#pragma unroll
                for (int j = 0; j < 2; ++j) { const size_t o = gn + (pc + 8 * j) * 8; p0[j] = *(const v4u*)(QD + o); p1[j] = *(const v4u*)(KI + o); p2[j] = *(const v4u*)(KS + o); p3[j] = *(const v4u*)(VV + o); }
                if (tid < 128) pd = *(const f32x4*)(DEC + (size_t)((b * SEQ + (rd + 1) * 64) / 16 + (tid >> 5)) * DM + h * 128 + (tid & 31) * 4);
            }
            LDS_BARRIER();
#pragma unroll 1
            for (int cc = 0; cc < 4; ++cc) {
                s16x4 ql[4], qh[4], kl[4], kh[4], ksr[8]; f32x4 d4[8];
#pragma unroll
                for (int kb = 0; kb < 4; ++kb) {
                    const int off = (16 * cc + r) * TP + (32 * kb + 4 * g) * 2;
                    ql[kb] = *(const LAS s16x4*)(lds + OFF_QD + off); qh[kb] = *(const LAS s16x4*)(lds + OFF_QD + off + 32);
                    kl[kb] = *(const LAS s16x4*)(lds + OFF_KI + off); kh[kb] = *(const LAS s16x4*)(lds + OFF_KI + off + 32);
                }
                s16x4 vfr = tr_read(lds + OFF_V + (16 * cc + 4 * g + q4) * TP + (16 * w + 4 * p4) * 2);
#pragma unroll
                for (int kt = 0; kt < 8; ++kt) {
                    d4[kt] = *(const LAS f32x4*)(lds + OFF_DEC + cc * 512 + (16 * kt + 4 * g) * 4);
                    ksr[kt] = tr_read(lds + OFF_KS + (16 * cc + 4 * g + q4) * TP + (16 * kt + 4 * p4) * 2);
                }
                asm volatile("" : "+v"(ql[0]), "+v"(ql[1]), "+v"(ql[2]), "+v"(ql[3]), "+v"(qh[0]), "+v"(qh[1]), "+v"(qh[2]), "+v"(qh[3]),
                                  "+v"(kl[0]), "+v"(kl[1]), "+v"(kl[2]), "+v"(kl[3]), "+v"(kh[0]), "+v"(kh[1]), "+v"(kh[2]), "+v"(kh[3]), "+v"(vfr));
                asm volatile("" : "+v"(ksr[0]), "+v"(ksr[1]), "+v"(ksr[2]), "+v"(ksr[3]), "+v"(ksr[4]), "+v"(ksr[5]), "+v"(ksr[6]), "+v"(ksr[7]),
                                  "+v"(d4[0]), "+v"(d4[1]), "+v"(d4[2]), "+v"(d4[3]), "+v"(d4[4]), "+v"(d4[5]), "+v"(d4[6]), "+v"(d4[7]));
                bf16x8 qf[4];
#pragma unroll
                for (int kb = 0; kb < 4; ++kb) qf[kb] = cat8(ql[kb], qh[kb]);
                f32x4 sc = {0.f, 0.f, 0.f, 0.f}, oa = {0.f, 0.f, 0.f, 0.f};
#pragma unroll
                for (int kb = 0; kb < 4; ++kb) sc = MFMA32(cat8(kl[kb], kh[kb]), qf[kb], sc);
#pragma unroll
                for (int kb = 0; kb < 4; ++kb) oa = MFMA32(pack8(st[2 * kb], st[2 * kb + 1]), qf[kb], oa);
#pragma unroll
                for (int kt = 0; kt < 8; ++kt) st[kt] = MFMA16(ksr[kt], vfr, st[kt] * d4[kt]);
#pragma unroll
                for (int i = 0; i < 4; ++i) sc[i] = (4 * g + i <= r) ? sc[i] : 0.f;
                oa = MFMA16(vfr, pack4(sc), oa);
                { v2u ow; ow.x = cvtpk(oa[0], oa[1]); ow.y = cvtpk(oa[2], oa[3]); *(v2u*)(OB + (size_t)(b * SEQ + rd * 64 + cc * 16 + r) * DM + h * 128 + 16 * w + 4 * g) = ow; }
            }
        }
        LDS_BARRIER();
    }
}

struct Args { const float* in[17]; float* out; unsigned char* ws; int ph_lo, ph_hi; };
enum { I_X = 0, I_HWIN, I_HNG, I_HWOUT, I_LB, I_RWIN, I_RWOUT, I_LNMG, I_LNMB, I_LNFG, I_LNFB, I_RW, I_RB, I_WGU, I_BGU, I_WDN, I_BDN };

__device__ __forceinline__ int dest_row(int mode, int n) {
    if (mode == 1) { if (n < 1024) return ((n >> 7) << 8) + (n & 127); if (n < 2048) { const int q = n - 1024; return ((q >> 7) << 8) + 128 + (q & 127); } return n; }
    if (mode == 2) { const int j2 = n >> 1; return ((j2 >> 7) << 8) + ((n & 1) << 7) + (j2 & 127); }
    return n;
}
__device__ __forceinline__ void transpose_item(const float* W, int K, int N, bf16* WT, int mode, LAS float* scr, int item, int lane) {
    const int nblk = N / 64, kb = item / nblk, nb = item % nblk, k0 = 64 * kb, n0 = 64 * nb;
#pragma unroll 4
    for (int i = 0; i < 16; ++i) { const int kk = 4 * i + (lane >> 4), c4 = (lane & 15) * 4;
        const f32x4 v = *(const GAS f32x4*)(W + (size_t)(k0 + kk) * N + n0 + c4);
        LAS float* s = scr + kk * 65 + c4; s[0] = v[0]; s[1] = v[1]; s[2] = v[2]; s[3] = v[3]; }
    LDS_WAIT(); asm volatile("" ::: "memory");
    const int c = lane & 7;
#pragma unroll 2
    for (int j = 0; j < 8; ++j) { const int n = (lane >> 3) + 8 * j; const LAS float* s = scr + (8 * c) * 65 + n;
        v4u o; o.x = pk2(s[0 * 65], s[1 * 65]); o.y = pk2(s[2 * 65], s[3 * 65]); o.z = pk2(s[4 * 65], s[5 * 65]); o.w = pk2(s[6 * 65], s[7 * 65]);
        *(GAS v4u*)(WT + (size_t)dest_row(mode, n0 + n) * K + k0 + 8 * c) = o; }
    LDS_WAIT(); asm volatile("" ::: "memory");
}

__device__ __forceinline__ void transpose_item_fp8(const float* W, int K, int N, unsigned char* WT, int mode, float scale, LAS float* scr, int item, int lane) {
    const int nblk = N / 64, kb = item / nblk, nb = item % nblk, k0 = 64 * kb, n0 = 64 * nb;
#pragma unroll 4
    for (int i = 0; i < 16; ++i) { const int kk = 4 * i + (lane >> 4), c4 = (lane & 15) * 4;
        const f32x4 v = *(const GAS f32x4*)(W + (size_t)(k0 + kk) * N + n0 + c4);
        LAS float* s = scr + kk * 65 + c4; s[0] = v[0]; s[1] = v[1]; s[2] = v[2]; s[3] = v[3]; }
    LDS_WAIT(); asm volatile("" ::: "memory");
    const int c = lane & 7;
#pragma unroll 2
    for (int j = 0; j < 8; ++j) { const int n = (lane >> 3) + 8 * j; const LAS float* s = scr + (8 * c) * 65 + n;
        v2u o; o.x = pk4_fp8(s[0 * 65] * scale, s[1 * 65] * scale, s[2 * 65] * scale, s[3 * 65] * scale); o.y = pk4_fp8(s[4 * 65] * scale, s[5 * 65] * scale, s[6 * 65] * scale, s[7 * 65] * scale);
        *(GAS v2u*)(WT + (size_t)dest_row(mode, n0 + n) * K + k0 + 8 * c) = o; }
    LDS_WAIT(); asm volatile("" ::: "memory");
}

#ifndef SITE_MASK
#define SITE_MASK 0xffff
#endif
#define SITE(n) (((SITE_MASK) >> (n)) & 1)
#ifndef PROBE_MASK
#define PROBE_MASK 0
#endif
#define REP(n) (1 + (((PROBE_MASK) >> (n)) & 1))
typedef const __attribute__((address_space(4))) Args* KArgs;
__device__ __forceinline__ int otid(int wave0) { int l; asm volatile("v_mbcnt_lo_u32_b32 %0, -1, 0\n\tv_mbcnt_hi_u32_b32 %0, -1, %0" : "=v"(l)); asm volatile("" : "+s"(wave0)); return wave0 * 64 + l; }
__device__ __forceinline__ LAS unsigned char* olds(LAS unsigned char* p) { asm volatile("" : "+s"(p)); return p; }
__device__ __forceinline__ KArgs kargs() { KArgs p = (KArgs)__builtin_amdgcn_kernarg_segment_ptr(); asm volatile("" : "+s"(p)); return p; }
#define IN(k) (ap->ph_lo <= (k) && (k) < ap->ph_hi)
#ifndef PROBE_BAR
#define PROBE_BAR 1
#endif
#define GRID_BAR() for (int _r = 0; _r < PROBE_BAR; ++_r) do { if (ap->ph_hi - ap->ph_lo > 1) { XcdBarrier _b; _b.bar = (unsigned*)(ap->ws + WS_CTL) + CW_BAR; _b.x = xb_xcc_id(); _b.st = (volatile LAS unsigned*)(lds + MISC_OFF + MO_BARW); xcd_barrier(_b); } } while (0)
#define VCU() ((gridDim.x % 8 == 0) ? (int)((blockIdx.x % 8) * (gridDim.x / 8) + blockIdx.x / 8) : (int)blockIdx.x)

__global__ void __launch_bounds__(512, 2) mk_fwd(Args args_unused) {
    extern __shared__ __attribute__((aligned(16))) unsigned char lds_raw[];
    LAS unsigned char* const lds0 = (LAS unsigned char*)lds_raw;
    const int wave0 = __builtin_amdgcn_readfirstlane((int)(threadIdx.x >> 6));
    {
        LAS unsigned char* lds = lds0;
        for (int u = threadIdx.x; u < (LDS_BYTES - MISC_OFF) / 4; u += 512) ((LAS unsigned*)(lds + MISC_OFF))[u] = 0u;
        __syncthreads();
        KArgs ap = kargs();
        if (ap->ph_hi - ap->ph_lo > 1) (void)xcd_barrier_post((unsigned*)(ap->ws + WS_CTL) + CW_BAR, (volatile LAS unsigned*)(lds + MISC_OFF + MO_BARW));
    }

#if SITE(0)
    { KArgs ap = kargs(); const int tid = otid(wave0); LAS unsigned char* lds = olds(lds0); (void)tid;
    if (IN(0)) for (int rep_ = 0; rep_ < REP(0); ++rep_) {
        const int lane = tid & 63, wave = __builtin_amdgcn_readfirstlane(tid >> 6), G = gridDim.x, vcu = VCU(), gw = vcu * 8 + wave, NGW = G * 8;
        unsigned char* ws = ap->ws;
        LAS float* scr = (LAS float*)(lds + wave * 16640);
        constexpr int I_HIN = 2 * 16 * 64, I_HOUT = 2 * 16 * 16, I_RIN = 2 * 16 * 96, I_ROUT = 2 * 32 * 16, I_GU = 128 * 16 * 32, I_DN = 128 * 16 * 16;
        constexpr int NITEMS = I_HIN + I_HOUT + I_RIN + I_ROUT + I_GU + I_DN;
        for (int it = gw; it < NITEMS; it += NGW) {
            int r = it;
            if (r < I_HIN) { const int j = r / (16 * 64); transpose_item(ap->in[I_HWIN] + (size_t)j * DM * HG_IN, DM, HG_IN, (bf16*)(ws + WS_W_HIN) + (size_t)j * HG_IN * DM, 1, scr, r % (16 * 64), lane); continue; } r -= I_HIN;
            if (r < I_HOUT) { const int j = r / 256; transpose_item(ap->in[I_HWOUT] + (size_t)j * DM * DM, DM, DM, (bf16*)(ws + WS_W_HOUT) + (size_t)j * DM * DM, 0, scr, r % 256, lane); continue; } r -= I_HOUT;
            if (r < I_RIN) { const int j = r / (16 * 96); transpose_item(ap->in[I_RWIN] + (size_t)j * DM * RT_IN, DM, RT_IN, (bf16*)(ws + WS_W_RIN) + (size_t)j * RT_IN * DM, 0, scr, r % (16 * 96), lane); continue; } r -= I_RIN;
            if (r < I_ROUT) { const int j = r / 512; transpose_item(ap->in[I_RWOUT] + (size_t)j * RT_VD * DM, RT_VD, DM, (bf16*)(ws + WS_W_ROUT) + (size_t)j * DM * RT_VD, 0, scr, r % 512, lane); continue; } r -= I_ROUT;
#if MOE_FP8
            if (r < I_GU) { const int j = r / 512; transpose_item_fp8(ap->in[I_WGU] + (size_t)j * DM * 2048, DM, 2048, ws + WS_W_GU + (size_t)j * 2048 * DM, 2, WGU_SCALE, scr, r % 512, lane); continue; } r -= I_GU;
            { const int j = r / 256; transpose_item_fp8(ap->in[I_WDN] + (size_t)j * DM * DM, DM, DM, ws + WS_W_DN + (size_t)j * DM * DM, 0, WDN_SCALE, scr, r % 256, lane); }
#else
            if (r < I_GU) { const int j = r / 512; transpose_item(ap->in[I_WGU] + (size_t)j * DM * 2048, DM, 2048, (bf16*)(ws + WS_W_GU) + (size_t)j * 2048 * DM, 2, scr, r % 512, lane); continue; } r -= I_GU;
            { const int j = r / 256; transpose_item(ap->in[I_WDN] + (size_t)j * DM * DM, DM, DM, (bf16*)(ws + WS_W_DN) + (size_t)j * DM * DM, 0, scr, r % 256, lane); }
#endif
        }
        const int gt = vcu * 512 + tid, NGT = G * 512;
        float* LBS = (float*)(ws + WS_LBS); float* BGU = (float*)(ws + WS_BGU); float* ROT = (float*)(ws + WS_ROT); bf16* XB = (bf16*)(ws + WS_XB);
        for (int d = gt; d < DM; d += NGT) { const float* lbp = ap->in[I_LB]; const float v0 = lbp[d], v1 = lbp[DM + d], v2 = lbp[2 * DM + d], v3 = lbp[3 * DM + d]; const float mx = fmaxf(fmaxf(v0, v1), fmaxf(v2, v3));
            const float e0 = __expf(v0 - mx), e1 = __expf(v1 - mx), e2 = __expf(v2 - mx), e3 = __expf(v3 - mx), is = 1.0f / (e0 + e1 + e2 + e3);
            LBS[d] = 0.f; LBS[DM + d] = e1 * is; LBS[2 * DM + d] = (e1 + e2) * is; LBS[3 * DM + d] = (e1 + e2 + e3) * is; }
        for (int i = gt; i < SEQ * 128; i += NGT) { const int pos = i >> 7, p = i & 127; const float inv = 1.0f / __builtin_amdgcn_exp2f(13.287712379549449f * ((float)p / 127.0f)); const float th = (float)pos * inv;
            double rev = (double)th * 0.15915494309189535; rev -= floor(rev); const float fr = (float)rev; ROT[2 * i] = __builtin_amdgcn_cosf(fr); ROT[2 * i + 1] = __builtin_amdgcn_sinf(fr); }
        for (int i = gt; i < 4 * DM * NE; i += NGT) { const int l = i >> 15, d = (i >> 5) & 1023, e = i & 31; const float wv = ap->in[I_RW][i]; const unsigned hb = f2bf(wv); const float hv = __builtin_bit_cast(float, hb << 16);
            ((bf16*)(ws + WS_WRH))[(size_t)l * 32768 + e * 1024 + d] = (bf16)hb; ((bf16*)(ws + WS_WRL))[(size_t)l * 32768 + e * 1024 + d] = (bf16)f2bf(wv - hv); }
        for (int i = gt; i < 4 * 32 * 2048; i += NGT) { const int le = i >> 11, n = i & 2047; BGU[(size_t)le * 2048 + dest_row(2, n)] = ap->in[I_BGU][i]; }
        for (size_t i = (size_t)gt; i < (size_t)NTOK * DM / 4; i += NGT) { const f32x4 v = ((const f32x4*)ap->in[I_X])[i]; v2u o; o.x = pk2(v[0], v[1]); o.y = pk2(v[2], v[3]); ((v2u*)XB)[i] = o; }
        GRID_BAR();
    } }
#endif

#pragma unroll 1
    for (int L = 0; L < DEPTH; ++L) {
        const int pb = 1 + 8 * L;
        if ((L & 1) == 0) {
#if SITE(1)
            { KArgs ap = kargs(); const int tid = otid(wave0); LAS unsigned char* lds = olds(lds0); (void)tid;
            if (IN(pb + 0)) for (int rep_ = 0; rep_ < REP(1); ++rep_) {
                unsigned char* ws = ap->ws; const int j = L >> 1;
                LAS int* ul = (LAS int*)(lds + MISC_OFF + MO_ULIST);
                pg8::build_units_dense(tid, ul, NTOK / 256, HG_IN / 256, DM * 2);
                pg8::EpiHgrnIn E{ws, L};
                pg8::gemm_phase<pg8::EpiHgrnIn, false, true, false>(tid, lds, ul, (LAS int*)(lds + MISC_OFF + MO_GTAB), (const char*)(ws + WS_XB), (const char*)((bf16*)(ws + WS_W_HIN) + (size_t)j * HG_IN * DM), nullptr, DM * 2, E);
                GRID_BAR();
            } }
#endif
#if SITE(2)
            { KArgs ap = kargs(); const int tid = otid(wave0); LAS unsigned char* lds = olds(lds0); (void)tid;
            if (IN(pb + 1)) for (int rep_ = 0; rep_ < REP(2); ++rep_) {
#if !SLOW_HGRN
                { unsigned char* ws = ap->ws; const bf16* QD = (const bf16*)(ws + WS_H);
                  hgrn_fast(tid, lds, QD, QD + (size_t)NTOK * DM, QD + 2 * (size_t)NTOK * DM, QD + 3 * (size_t)NTOK * DM, (const float*)(ws + WS_DEC), (bf16*)(ws + WS_O)); }
#else
                unsigned char* ws = ap->ws; const bf16* QD = (const bf16*)(ws + WS_H); const bf16* KI = QD + (size_t)NTOK * DM; const bf16* KS = QD + 2 * (size_t)NTOK * DM; const bf16* VV = QD + 3 * (size_t)NTOK * DM; bf16* OB = (bf16*)(ws + WS_O);
                LAS float* qf = (LAS float*)lds; LAS float* kf = qf + 16 * 4 * 36; LAS float* ff = kf + 16 * 4 * 36; LAS float* vf = ff + 16 * 4 * 36;
                for (int un = blockIdx.x; un < NBATCH * HG_HEADS; un += gridDim.x) {
                    const int b = un >> 3, h = un & 7; const int vc = tid >> 2, kq = tid & 3;
                    float st[32];
#pragma unroll
                    for (int i = 0; i < 32; ++i) st[i] = 0.f;
                    for (int t0 = 0; t0 < SEQ; t0 += 16) {
                        __syncthreads();
                        for (int e = tid; e < 16 * 128; e += 512) { const int tt = e >> 7, k = e & 127; const size_t gi = (size_t)(b * SEQ + t0 + tt) * DM + h * 128 + k; const int li = tt * 144 + (k & 3) * 36 + (k >> 2);
                            qf[li] = bf1(QD[gi]); kf[li] = bf1(KI[gi]); ff[li] = bf1(KS[gi]); vf[tt * 128 + k] = bf1(VV[gi]); }
                        __syncthreads();
                        for (int tt = 0; tt < 16; ++tt) {
                            const float v = vf[tt * 128 + vc]; float a = 0.f; const int lb = tt * 144 + kq * 36;
#pragma unroll
                            for (int i = 0; i < 32; ++i) { st[i] = ff[lb + i] * st[i] + kf[lb + i] * v; a += qf[lb + i] * st[i]; }
                            a += __shfl_xor(a, 1); a += __shfl_xor(a, 2);
                            if (kq == 0) OB[(size_t)(b * SEQ + t0 + tt) * DM + h * 128 + vc] = (bf16)f2bf(a);
                        }
                    }
                }
#endif
                GRID_BAR();
            } }
#endif
#if SITE(3)
            { KArgs ap = kargs(); const int tid = otid(wave0); LAS unsigned char* lds = olds(lds0); (void)tid;
            if (IN(pb + 2)) for (int rep_ = 0; rep_ < REP(3); ++rep_) {
                const int lane = tid & 63, wave = __builtin_amdgcn_readfirstlane(tid >> 6), gw = VCU() * 8 + wave, NGW = gridDim.x * 8;
                unsigned char* ws = ap->ws; const bf16* OB = (const bf16*)(ws + WS_O); const bf16* GG = (const bf16*)(ws + WS_H) + 4 * (size_t)NTOK * DM; bf16* A2 = (bf16*)(ws + WS_A2);
                const float* ng = ap->in[I_HNG] + (L >> 1) * DM;
                f32x4 g4[4];
#pragma unroll
                for (int q = 0; q < 4; ++q) g4[q] = *(const f32x4*)(ng + 256 * q + 4 * lane);
                v2u on[4], gn[4];
#pragma unroll
                for (int q = 0; q < 4; ++q) { on[q] = *(const v2u*)(OB + (size_t)gw * DM + 256 * q + 4 * lane); gn[q] = *(const v2u*)(GG + (size_t)gw * DM + 256 * q + 4 * lane); }
#pragma unroll 1
                for (int row = gw; row < NTOK; row += NGW) {
                    v2u oc[4], gc[4];
#pragma unroll
                    for (int q = 0; q < 4; ++q) { oc[q] = on[q]; gc[q] = gn[q]; }
                    if (row + NGW < NTOK) {
#pragma unroll
                        for (int q = 0; q < 4; ++q) { on[q] = *(const v2u*)(OB + (size_t)(row + NGW) * DM + 256 * q + 4 * lane); gn[q] = *(const v2u*)(GG + (size_t)(row + NGW) * DM + 256 * q + 4 * lane); } }
                    float o[16]; float ss = 0.f;
#pragma unroll
                    for (int q = 0; q < 4; ++q) { o[4 * q] = bflo(oc[q].x); o[4 * q + 1] = bfhi(oc[q].x); o[4 * q + 2] = bflo(oc[q].y); o[4 * q + 3] = bfhi(oc[q].y); }
#pragma unroll
                    for (int i = 0; i < 16; ++i) ss += o[i] * o[i];
                    const float rs = 1.0f / sqrtf(wave_sum(ss) * (1.0f / DM) + RMS_EPS);
#pragma unroll
                    for (int q = 0; q < 4; ++q) {
                        v2u w; w.x = pk2(o[4 * q] * rs * g4[q][0] * bflo(gc[q].x), o[4 * q + 1] * rs * g4[q][1] * bfhi(gc[q].x)); w.y = pk2(o[4 * q + 2] * rs * g4[q][2] * bflo(gc[q].y), o[4 * q + 3] * rs * g4[q][3] * bfhi(gc[q].y));
                        *(v2u*)(A2 + (size_t)row * DM + 256 * q + 4 * lane) = w; }
                }
                GRID_BAR();
            } }
#endif
        } else {
#if SITE(4)
            { KArgs ap = kargs(); const int tid = otid(wave0); LAS unsigned char* lds = olds(lds0); (void)tid;
            if (IN(pb + 0)) for (int rep_ = 0; rep_ < REP(4); ++rep_) {
                unsigned char* ws = ap->ws; const int j = L >> 1;
                LAS int* ul = (LAS int*)(lds + MISC_OFF + MO_ULIST);
                pg8::build_units_dense(tid, ul, NTOK / 256, RT_IN / 256, DM * 2);
                pg8::EpiRetIn E{ws};
                pg8::gemm_phase<pg8::EpiRetIn, false, true, false>(tid, lds, ul, (LAS int*)(lds + MISC_OFF + MO_GTAB), (const char*)(ws + WS_XB), (const char*)((bf16*)(ws + WS_W_RIN) + (size_t)j * RT_IN * DM), nullptr, DM * 2, E);
                GRID_BAR();
            } }
#endif
#if SITE(5)
            { KArgs ap = kargs(); const int tid = otid(wave0); LAS unsigned char* lds = olds(lds0); (void)tid;
            if (IN(pb + 1)) for (int rep_ = 0; rep_ < REP(5); ++rep_) {
#if !SLOW_RET
                { unsigned char* ws = ap->ws; ret_fast(tid, lds, (const bf16*)(ws + WS_H), (bf16*)(ws + WS_O)); }
#else
                unsigned char* ws = ap->ws; const bf16* HB = (const bf16*)(ws + WS_H); bf16* OB = (bf16*)(ws + WS_O);
                LAS float* qf = (LAS float*)lds; LAS float* kf = qf + 16 * 4 * 68; LAS float* vf = kf + 16 * 4 * 68;
                for (int un = blockIdx.x; un < NBATCH * RT_HEADS * 4; un += gridDim.x) {
                    const int b = un >> 4, h = (un >> 2) & 3, vq = un & 3; const int vc = tid >> 2, kq = tid & 3;
                    const float gam = 1.0f - exp2f(-5.0f - (float)h);
                    float st[64];
#pragma unroll
                    for (int i = 0; i < 64; ++i) st[i] = 0.f;
                    for (int t0 = 0; t0 < SEQ; t0 += 16) {
                        __syncthreads();
                        for (int e = tid; e < 16 * 256; e += 512) { const int tt = e >> 8, k = e & 255; const size_t gi = (size_t)(b * SEQ + t0 + tt) * RT_IN + h * 256 + k; const int li = tt * 272 + (k & 3) * 68 + (k >> 2);
                            qf[li] = bf1(HB[gi]); kf[li] = bf1(HB[gi + 1024]); }
                        for (int e = tid; e < 16 * 128; e += 512) { const int tt = e >> 7, c = e & 127; vf[e] = bf1(HB[(size_t)(b * SEQ + t0 + tt) * RT_IN + 2048 + h * 512 + vq * 128 + c]); }
                        __syncthreads();
                        for (int tt = 0; tt < 16; ++tt) {
                            const float v = vf[tt * 128 + vc]; float a = 0.f; const int lb = tt * 272 + kq * 68;
#pragma unroll
                            for (int i = 0; i < 64; ++i) { st[i] = gam * st[i] + kf[lb + i] * v; a += qf[lb + i] * st[i]; }
                            a += __shfl_xor(a, 1); a += __shfl_xor(a, 2);
                            if (kq == 0) OB[(size_t)(b * SEQ + t0 + tt) * RT_VD + h * 512 + vq * 128 + vc] = (bf16)f2bf(a);
                        }
                    }
                }
#endif
                GRID_BAR();
            } }
#endif
#if SITE(6)
            { KArgs ap = kargs(); const int tid = otid(wave0); LAS unsigned char* lds = olds(lds0); (void)tid;
            if (IN(pb + 2)) for (int rep_ = 0; rep_ < REP(6); ++rep_) {
                const int lane = tid & 63, wave = __builtin_amdgcn_readfirstlane(tid >> 6), gw = VCU() * 8 + wave, NGW = gridDim.x * 8;
                unsigned char* ws = ap->ws; const bf16* OB = (const bf16*)(ws + WS_O); const bf16* HB = (const bf16*)(ws + WS_H); bf16* A2 = (bf16*)(ws + WS_A2);
                v4u on[4], gn[4];
#pragma unroll
                for (int h = 0; h < 4; ++h) { on[h] = *(const v4u*)(OB + (size_t)gw * RT_VD + 512 * h + 8 * lane); gn[h] = *(const v4u*)(HB + (size_t)gw * RT_IN + 4096 + 512 * h + 8 * lane); }
#pragma unroll 1
                for (int row = gw; row < NTOK; row += NGW) {
                    v4u oc[4], gc[4];
#pragma unroll
                    for (int h = 0; h < 4; ++h) { oc[h] = on[h]; gc[h] = gn[h]; }
                    if (row + NGW < NTOK) {
#pragma unroll
                        for (int h = 0; h < 4; ++h) { on[h] = *(const v4u*)(OB + (size_t)(row + NGW) * RT_VD + 512 * h + 8 * lane); gn[h] = *(const v4u*)(HB + (size_t)(row + NGW) * RT_IN + 4096 + 512 * h + 8 * lane); } }
#pragma unroll
                    for (int h = 0; h < 4; ++h) {
                        const v4u w = oc[h];
                        float o[8] = {bflo(w.x), bfhi(w.x), bflo(w.y), bfhi(w.y), bflo(w.z), bfhi(w.z), bflo(w.w), bfhi(w.w)};
                        float s = 0.f;
#pragma unroll
                        for (int i = 0; i < 8; ++i) s += o[i];
                        const float mu = wave_sum(s) * (1.0f / 512.0f); float q = 0.f;
#pragma unroll
                        for (int i = 0; i < 8; ++i) { o[i] -= mu; q += o[i] * o[i]; }
                        const float rs = 1.0f / sqrtf(wave_sum(q) * (1.0f / 512.0f) + LN_EPS);
                        const v4u g = gc[h];
                        v4u r; r.x = pk2(o[0] * rs * bflo(g.x), o[1] * rs * bfhi(g.x)); r.y = pk2(o[2] * rs * bflo(g.y), o[3] * rs * bfhi(g.y));
                        r.z = pk2(o[4] * rs * bflo(g.z), o[5] * rs * bfhi(g.z)); r.w = pk2(o[6] * rs * bflo(g.w), o[7] * rs * bfhi(g.w));
                        *(v4u*)(A2 + (size_t)row * RT_VD + 512 * h + 8 * lane) = r;
                    }
                }
                GRID_BAR();
            } }
#endif
        }
#if SITE(7)
        { KArgs ap = kargs(); const int tid = otid(wave0); LAS unsigned char* lds = olds(lds0); (void)tid;
        if (IN(pb + 3)) for (int rep_ = 0; rep_ < REP(7); ++rep_) {
            unsigned char* ws = ap->ws; const int j = L >> 1; const bool ret = (L & 1) != 0;
            const int Ko = ret ? RT_VD : DM;
            LAS int* ul = (LAS int*)(lds + MISC_OFF + MO_ULIST);
            pg8::build_units_dense(tid, ul, NTOK / 256, DM / 256, Ko * 2);
            const char* Bt = ret ? (const char*)((bf16*)(ws + WS_W_ROUT) + (size_t)j * DM * RT_VD) : (const char*)((bf16*)(ws + WS_W_HOUT) + (size_t)j * DM * DM);
            pg8::EpiRes E{ws};
            pg8::gemm_phase<pg8::EpiRes, false, true, false>(tid, lds, ul, (LAS int*)(lds + MISC_OFF + MO_GTAB), (const char*)(ws + WS_A2), Bt, nullptr, Ko * 2, E);
            GRID_BAR();
        } }
#endif
#if SITE(8)
        { KArgs ap = kargs(); const int tid = otid(wave0); LAS unsigned char* lds = olds(lds0); (void)tid;
        if (IN(pb + 4)) for (int rep_ = 0; rep_ < REP(8); ++rep_) {
            const int lane = tid & 63, wave = __builtin_amdgcn_readfirstlane(tid >> 6), r = lane & 15, g = lane >> 4;
            unsigned char* ws = ap->ws; unsigned* ctl = (unsigned*)(ws + WS_CTL);
            const bf16* Y = (const bf16*)(ws + WS_Y); bf16* X1R = (bf16*)(ws + WS_X1F); bf16* X1B = (bf16*)(ws + WS_X1B);
            int* ROWDST = (int*)(ws + WS_ROWDST); float* ROWGATE = (float*)(ws + WS_ROWGATE);
            constexpr int WP = 2064;
            LAS unsigned char* wH = lds; LAS unsigned char* wL = lds + 32 * WP;
            LAS int* lcnt = (LAS int*)(lds + MISC_OFF + MO_LCNT); LAS int* lbase = (LAS int*)(lds + MISC_OFF + MO_LBASE);
            LAS int* sel = (LAS int*)(lds + MISC_OFF + MO_SEL); LAS float* selw = (LAS float*)(lds + MISC_OFF + MO_SELW);
            const float* rb = ap->in[I_RB] + L * NE;
            const float* lg = ap->in[I_LNMG] + L * DM; const float* lbb = ap->in[I_LNMB] + L * DM;
            { const v4u* gh = (const v4u*)(ws + WS_WRH) + (size_t)L * 4096; const v4u* gl = (const v4u*)(ws + WS_WRL) + (size_t)L * 4096;
              for (int c = tid; c < 4096; c += 512) { const int e = c >> 7, cc = c & 127; *(LAS v4u*)(wH + e * WP + cc * 16) = gh[c]; *(LAS v4u*)(wL + e * WP + cc * 16) = gl[c]; } }
            const float rb0 = rb[r], rb1 = rb[16 + r];
            for (int blk = VCU(); blk < NTOK / 128; blk += gridDim.x) {
                if (tid < 32) lcnt[tid] = 0;
                __syncthreads();
                const int row0 = blk * 128 + wave * 16;
                v2u xn[4];
#pragma unroll
                for (int q = 0; q < 4; ++q) xn[q] = *(const v2u*)(Y + (size_t)row0 * DM + 256 * q + 4 * lane);
#pragma unroll 1
                for (int rr = 0; rr < 16; ++rr) {
                    const int row = row0 + rr;
                    f32x4 x[4]; float s = 0.f;
#pragma unroll
                    for (int q = 0; q < 4; ++q) { x[q] = (f32x4){bflo(xn[q].x), bfhi(xn[q].x), bflo(xn[q].y), bfhi(xn[q].y)}; s += (x[q][0] + x[q][1]) + (x[q][2] + x[q][3]); }
                    if (rr + 1 < 16) {
#pragma unroll
                        for (int q = 0; q < 4; ++q) xn[q] = *(const v2u*)(Y + (size_t)(row + 1) * DM + 256 * q + 4 * lane); }
                    const float mu = wave_sum_u(s) * (1.0f / DM); float qq = 0.f;
#pragma unroll
                    for (int q = 0; q < 4; ++q) { x[q] = x[q] - mu; qq += (x[q][0] * x[q][0] + x[q][1] * x[q][1]) + (x[q][2] * x[q][2] + x[q][3] * x[q][3]); }
                    const float rs = 1.0f / sqrtf(wave_sum_u(qq) * (1.0f / DM) + LN_EPS);
#pragma unroll
                    for (int q = 0; q < 4; ++q) { const f32x4 g4 = *(const f32x4*)(lg + 256 * q + 4 * lane), b4 = *(const f32x4*)(lbb + 256 * q + 4 * lane); x[q] = x[q] * rs * g4 + b4;
                        { v2u wr_; wr_.x = pk2(x[q][0], x[q][1]); wr_.y = pk2(x[q][2], x[q][3]); *(v2u*)(X1R + (size_t)row * DM + 256 * q + 4 * lane) = wr_; }
#if MOE_FP8
                        *(unsigned*)((unsigned char*)X1B + (size_t)row * DM + 256 * q + 4 * lane) = pk4_fp8(x[q][0] * X_SCALE, x[q][1] * X_SCALE, x[q][2] * X_SCALE, x[q][3] * X_SCALE); }
#else
                        v2u w; w.x = pk2(x[q][0], x[q][1]); w.y = pk2(x[q][2], x[q][3]); *(v2u*)(X1B + (size_t)row * DM + 256 * q + 4 * lane) = w; }
#endif
                }
                asm volatile("s_waitcnt vmcnt(0)" ::: "memory");
                f32x4 lgt0 = {0.f, 0.f, 0.f, 0.f}, lgt1 = {0.f, 0.f, 0.f, 0.f};
                {
                    const bf16* xa = X1R + (size_t)(row0 + r) * DM + 8 * g;
#pragma unroll 1
                    for (int kq = 0; kq < 4; ++kq) {
                        bf16x8 af[8], h0[8], h1[8], l0[8], l1[8];
#pragma unroll
                        for (int j = 0; j < 8; ++j) { const int kb = kq * 8 + j; af[j] = *(const bf16x8*)(xa + 32 * kb);
                            h0[j] = *(const LAS bf16x8*)(wH + r * WP + (32 * kb + 8 * g) * 2); h1[j] = *(const LAS bf16x8*)(wH + (16 + r) * WP + (32 * kb + 8 * g) * 2);
                            l0[j] = *(const LAS bf16x8*)(wL + r * WP + (32 * kb + 8 * g) * 2); l1[j] = *(const LAS bf16x8*)(wL + (16 + r) * WP + (32 * kb + 8 * g) * 2); }
#pragma unroll
                        for (int j = 0; j < 8; ++j) { lgt0 = MFMA32(af[j], h0[j], lgt0); lgt1 = MFMA32(af[j], h1[j], lgt1); lgt0 = MFMA32(af[j], l0[j], lgt0); lgt1 = MFMA32(af[j], l1[j], lgt1); }
                    }
                }
#pragma unroll
                for (int i = 0; i < 4; ++i) {
                    float v0 = lgt0[i] + rb0, v1 = lgt1[i] + rb1; int se[4]; float sv[4];
#pragma unroll
                    for (int k = 0; k < 4; ++k) {
                        float m = fmaxf(v0, v1);
                        m = fmaxf(m, dppf<0xB1>(m)); m = fmaxf(m, dppf<0x4E>(m)); m = fmaxf(m, dppf<0x141>(m)); m = fmaxf(m, dppf<0x140>(m));
                        int ec = (v0 == m) ? r : ((v1 == m) ? 16 + r : 99);
                        ec = min(ec, dppi<0xB1>(ec)); ec = min(ec, dppi<0x4E>(ec)); ec = min(ec, dppi<0x141>(ec)); ec = min(ec, dppi<0x140>(ec));
                        se[k] = ec; sv[k] = m;
                        if (ec == r) v0 = -3.0e38f;
                        if (ec == 16 + r) v1 = -3.0e38f;
                    }
                    const float e1 = __expf(sv[1] - sv[0]), e2 = __expf(sv[2] - sv[0]), e3 = __expf(sv[3] - sv[0]); const float inv = 1.0f / (1.0f + e1 + e2 + e3);
                    if (r < 4) { const int rloc = wave * 16 + 4 * g + i; const int ee = r == 0 ? se[0] : (r == 1 ? se[1] : (r == 2 ? se[2] : se[3])); const float ww = (r == 0 ? 1.0f : (r == 1 ? e1 : (r == 2 ? e2 : e3))) * inv;
                        sel[rloc * 4 + r] = ee; selw[rloc * 4 + r] = ww; }
                }
                __syncthreads();
                const int myE = sel[tid]; const int rank = __hip_atomic_fetch_add(lcnt + myE, 1, __ATOMIC_RELAXED, __HIP_MEMORY_SCOPE_WORKGROUP);
                __syncthreads();
                if (tid < 32) lbase[tid] = (int)__hip_atomic_fetch_add(ctl + CW_ECNT + (L + 4 * rep_) * 32 + tid, (unsigned)lcnt[tid], RLX_AGENT);
                __syncthreads();
                { const int pos = lbase[myE] + rank; const size_t ti = (size_t)myE * ECAP + pos; ROWDST[ti] = (blk * 128 + (tid >> 2)) * 4 + (tid & 3); ROWGATE[ti] = selw[tid]; }
                __syncthreads();
            }
            GRID_BAR();
        } }
#endif
#if SITE(9)
        { KArgs ap = kargs(); const int tid = otid(wave0); LAS unsigned char* lds = olds(lds0); (void)tid;
        if (IN(pb + 5)) for (int rep_ = 0; rep_ < REP(9); ++rep_) {
            unsigned char* ws = ap->ws; unsigned* ctl = (unsigned*)(ws + WS_CTL);
            LAS int* tpre = (LAS int*)(lds + MISC_OFF + MO_TPRE); LAS int* ebase = (LAS int*)(lds + MISC_OFF + MO_EBASE); LAS int* ecnt = (LAS int*)(lds + MISC_OFF + MO_ECNT);
            if (tid == 0) { int t = 0;
_Pragma("unroll 1")
 for (int e = 0; e < NE; ++e) { const int c = (int)__hip_atomic_load(ctl + CW_ECNT + L * 32 + e, RLX_AGENT); ecnt[e] = c; tpre[e] = t; ebase[e] = t * 256; t += (c + 255) >> 8; } tpre[NE] = t; }
            __syncthreads();
            LAS int* ul = (LAS int*)(lds + MISC_OFF + MO_ULIST);
            constexpr int EB = MOE_FP8 ? 1 : 2;
            pg8::build_units_moe(tid, ul, tpre, ebase, ecnt, 8, DM * EB, 2048u * DM * EB);
            pg8::EpiMoeGU E{ws, L};
            pg8::gemm_phase<pg8::EpiMoeGU, true, true, MOE_FP8 != 0>(tid, lds, ul, (LAS int*)(lds + MISC_OFF + MO_GTAB), (const char*)(ws + WS_X1B), (const char*)(ws + WS_W_GU + (size_t)L * NE * 2048 * DM * EB), (const int*)(ws + WS_ROWDST), DM * EB, E);
            GRID_BAR();
        } }
#endif
#if SITE(10)
        { KArgs ap = kargs(); const int tid = otid(wave0); LAS unsigned char* lds = olds(lds0); (void)tid;
        if (IN(pb + 6)) for (int rep_ = 0; rep_ < REP(10); ++rep_) {
            unsigned char* ws = ap->ws; unsigned* ctl = (unsigned*)(ws + WS_CTL);
            LAS int* tpre = (LAS int*)(lds + MISC_OFF + MO_TPRE); LAS int* ebase = (LAS int*)(lds + MISC_OFF + MO_EBASE); LAS int* ecnt = (LAS int*)(lds + MISC_OFF + MO_ECNT);
            __syncthreads();
            if (tid == 0) { int t = 0;
_Pragma("unroll 1")
 for (int e = 0; e < NE; ++e) { const int c = (int)__hip_atomic_load(ctl + CW_ECNT + L * 32 + e, RLX_AGENT); ecnt[e] = c; tpre[e] = t; ebase[e] = t * 256; t += (c + 255) >> 8; } tpre[NE] = t; }
            __syncthreads();
            LAS int* ul = (LAS int*)(lds + MISC_OFF + MO_ULIST);
            constexpr int EB = MOE_FP8 ? 1 : 2;
            pg8::build_units_moe(tid, ul, tpre, ebase, ecnt, 4, DM * EB, (unsigned)DM * DM * EB);
            pg8::EpiMoeDown E{ws, ap->in[I_BDN] + (size_t)L * NE * DM};
            pg8::gemm_phase<pg8::EpiMoeDown, false, true, MOE_FP8 != 0>(tid, lds, ul, (LAS int*)(lds + MISC_OFF + MO_GTAB), (const char*)(ws + WS_ACT), (const char*)(ws + WS_W_DN + (size_t)L * NE * DM * DM * EB), nullptr, DM * EB, E);
            GRID_BAR();
        } }
#endif
#if SITE(11)
        { KArgs ap = kargs(); const int tid = otid(wave0); LAS unsigned char* lds = olds(lds0); (void)tid;
        if (IN(pb + 7)) for (int rep_ = 0; rep_ < REP(11); ++rep_) {
            const int lane = tid & 63, wave = __builtin_amdgcn_readfirstlane(tid >> 6), gw = VCU() * 8 + wave, NGW = gridDim.x * 8;
            unsigned char* ws = ap->ws; const bf16* X1R = (const bf16*)(ws + WS_X1F); const bf16* YS = (const bf16*)(ws + WS_YSLOT); bf16* XB = (bf16*)(ws + WS_XB); float* out = ap->out;
            const float* lg = ap->in[I_LNFG] + L * DM; const float* lbb = ap->in[I_LNFB] + L * DM;
#if YS_FP8
            typedef unsigned ys_t; constexpr int YSB = 1;
#else
            typedef v2u ys_t; constexpr int YSB = 2;
#endif
            v2u xn[4]; f32x4 g4[4], b4[4]; ys_t yn[4][4];
#pragma unroll
            for (int q = 0; q < 4; ++q) { g4[q] = *(const f32x4*)(lg + 256 * q + 4 * lane); b4[q] = *(const f32x4*)(lbb + 256 * q + 4 * lane); xn[q] = *(const v2u*)(X1R + (size_t)gw * DM + 256 * q + 4 * lane);
#pragma unroll
                for (int k = 0; k < 4; ++k) yn[q][k] = *(const ys_t*)((const unsigned char*)YS + (((size_t)gw * 4 + k) * DM + 256 * q + 4 * lane) * YSB); }
#pragma unroll 1
            for (int row = gw; row < NTOK; row += NGW) {
                f32x4 x[4]; ys_t yc[4][4]; float s = 0.f;
#pragma unroll
                for (int q = 0; q < 4; ++q) { x[q] = (f32x4){bflo(xn[q].x), bfhi(xn[q].x), bflo(xn[q].y), bfhi(xn[q].y)} * DN_ALPHA;
#pragma unroll
                    for (int k = 0; k < 4; ++k) yc[q][k] = yn[q][k]; }
                if (row + NGW < NTOK) {
#pragma unroll
                    for (int q = 0; q < 4; ++q) { xn[q] = *(const v2u*)(X1R + (size_t)(row + NGW) * DM + 256 * q + 4 * lane);
#pragma unroll
                        for (int k = 0; k < 4; ++k) yn[q][k] = *(const ys_t*)((const unsigned char*)YS + (((size_t)(row + NGW) * 4 + k) * DM + 256 * q + 4 * lane) * YSB); } }
#pragma unroll
                for (int q = 0; q < 4; ++q) {
#pragma unroll
#if YS_FP8
                    for (int k = 0; k < 4; ++k) { const f32x2 lo = __builtin_amdgcn_cvt_pk_f32_fp8((int)yc[q][k], false), hi = __builtin_amdgcn_cvt_pk_f32_fp8((int)yc[q][k], true);
                        x[q][0] += lo[0] * 0.015625f; x[q][1] += lo[1] * 0.015625f; x[q][2] += hi[0] * 0.015625f; x[q][3] += hi[1] * 0.015625f; }
#else
                    for (int k = 0; k < 4; ++k) { const v2u w = yc[q][k]; x[q][0] += bflo(w.x); x[q][1] += bfhi(w.x); x[q][2] += bflo(w.y); x[q][3] += bfhi(w.y); }
#endif
                    s += (x[q][0] + x[q][1]) + (x[q][2] + x[q][3]); }
                const float mu = wave_sum(s) * (1.0f / DM); float qq = 0.f;
#pragma unroll
                for (int q = 0; q < 4; ++q) { x[q] = x[q] - mu; qq += (x[q][0] * x[q][0] + x[q][1] * x[q][1]) + (x[q][2] * x[q][2] + x[q][3] * x[q][3]); }
                const float rs = 1.0f / sqrtf(wave_sum(qq) * (1.0f / DM) + LN_EPS);
#pragma unroll
                for (int q = 0; q < 4; ++q) { x[q] = x[q] * rs * g4[q] + b4[q];
                    if (L + 1 == DEPTH) *(f32x4*)(out + (size_t)row * DM + 256 * q + 4 * lane) = x[q];
                    else { v2u w; w.x = pk2(x[q][0], x[q][1]); w.y = pk2(x[q][2], x[q][3]); *(v2u*)(XB + (size_t)row * DM + 256 * q + 4 * lane) = w; } }
            }
            if (L + 1 < DEPTH) GRID_BAR();
        } }
#endif
    }
#undef IN
#undef GRID_BAR
}

extern "C" void kernel_launch(void* const* d_in, const int* in_sizes, int n_in, void* d_out, int out_size, void* d_ws, size_t ws_size, hipStream_t stream) {
    static int grid = 0;
    if (grid == 0) {
        if (n_in != 17 || out_size != NTOK * DM || ws_size < WS_END) { fprintf(stderr, "kernel_launch: unexpected shapes (n_in %d, out %d, ws %zu < %zu)\n", n_in, out_size, ws_size, (size_t)WS_END); grid = -1; return; }
        int dev = 0, cus = 0, per_cu = 0;
        if (hipGetDevice(&dev) != hipSuccess || hipDeviceGetAttribute(&cus, hipDeviceAttributeMultiprocessorCount, dev) != hipSuccess) { grid = -1; return; }
        if (hipFuncSetAttribute((const void*)mk_fwd, hipFuncAttributeMaxDynamicSharedMemorySize, LDS_BYTES) != hipSuccess) { fprintf(stderr, "kernel_launch: hipFuncSetAttribute failed\n"); grid = -1; return; }
        if (hipOccupancyMaxActiveBlocksPerMultiprocessor(&per_cu, (const void*)mk_fwd, 512, LDS_BYTES) != hipSuccess || per_cu < 1) { fprintf(stderr, "kernel_launch: occupancy query says %d\n", per_cu); }
        (void)hipGetLastError();
        grid = cus;
    }
    if (grid < 0) return;
    (void)hipMemsetAsync((char*)d_ws + WS_CTL, 0, CTL_ZERO_BYTES, stream);
    Args a{};
    for (int i = 0; i < 17; ++i) a.in[i] = (const float*)d_in[i];
    a.out = (float*)d_out; a.ws = (unsigned char*)d_ws;
#if MK_MULTI
    for (int p = 0; p < 1 + 8 * DEPTH; ++p) { a.ph_lo = p; a.ph_hi = p + 1; hipLaunchKernelGGL(mk_fwd, dim3(grid), dim3(512), LDS_BYTES, stream, a); }
#else
    a.ph_lo = 0; a.ph_hi = 1 + 8 * DEPTH;
    hipLaunchKernelGGL(mk_fwd, dim3(grid), dim3(512), LDS_BYTES, stream, a);
#endif
}
```

```cpp
#include <hip/hip_runtime.h>
#include <cstdio>
#include <cstdint>

#ifndef MK_MULTI
#define MK_MULTI 0
#endif
#ifndef PROBE_EPI2
#define PROBE_EPI2 0
#endif
#ifndef MOE_FP8
#define MOE_FP8 1
#endif
#ifndef YS_FP8
#define YS_FP8 1
#endif
#ifndef SLOW_HGRN
#define SLOW_HGRN 0
#endif
#ifndef SLOW_RET
#define SLOW_RET 0
#endif

#define GAS __attribute__((address_space(1)))
#define LAS __attribute__((address_space(3)))
typedef unsigned short bf16;
typedef unsigned v4u __attribute__((ext_vector_type(4)));
typedef unsigned v2u __attribute__((ext_vector_type(2)));
typedef float f32x4 __attribute__((ext_vector_type(4)));
typedef float f32x2 __attribute__((ext_vector_type(2)));
typedef short bf16x8 __attribute__((ext_vector_type(8)));
typedef GAS unsigned gu32;

constexpr int DM = 1024, NBATCH = 16, SEQ = 2048, NTOK = NBATCH * SEQ, DEPTH = 4;
constexpr int NE = 32, TOPK = 4;
constexpr int HG_HEADS = 8, HG_K = 128;
constexpr int RT_HEADS = 4, RT_K = 256, RT_V = 512, RT_VD = 2048, RT_IN = 6144, HG_IN = 4096;
constexpr int ECAP = NTOK;
constexpr int MOE_ROWS = NTOK * TOPK + NE * 256;
constexpr float DN_ALPHA = 1.681792830507429f;
constexpr float LN_EPS = 1e-5f, RMS_EPS = 1e-6f;

constexpr size_t MiB = 1ull << 20;
constexpr size_t WS_CTL = 0, CTL_ZERO_BYTES = 1 * MiB;
constexpr size_t WS_LBS = 1 * MiB;
constexpr size_t WS_WRH = 1 * MiB + 128 * 1024, WS_WRL = 1 * MiB + 512 * 1024;
constexpr size_t WS_BGU = 2 * MiB;
constexpr size_t WS_ROT = 4 * MiB;
constexpr size_t WS_ROWDST = 8 * MiB;
constexpr size_t WS_ROWGATE = 12 * MiB;
constexpr size_t WS_W_HIN = 16 * MiB;
constexpr size_t WS_W_HOUT = WS_W_HIN + 16 * MiB;
constexpr size_t WS_W_RIN = WS_W_HOUT + 4 * MiB;
constexpr size_t WS_W_ROUT = WS_W_RIN + 24 * MiB;
constexpr size_t WS_W_GU = WS_W_ROUT + 8 * MiB;
constexpr size_t WS_W_DN = WS_W_GU + 512 * MiB;
constexpr size_t WS_XB = WS_W_DN + 256 * MiB;
constexpr size_t WS_H = WS_XB + 64 * MiB;
constexpr size_t WS_DEC = WS_H + 320 * MiB;
constexpr size_t WS_SSP = WS_DEC + 16 * MiB;
constexpr size_t WS_O = WS_H + 384 * MiB;
constexpr size_t WS_A2 = WS_O + 128 * MiB;
constexpr size_t WS_Y = WS_A2 + 128 * MiB;
constexpr size_t WS_X1F = WS_Y + 128 * MiB;
constexpr size_t WS_X1B = WS_X1F + 128 * MiB;
constexpr size_t WS_ACT = WS_X1B + 64 * MiB;
constexpr size_t WS_YSLOT = WS_ACT + 272 * MiB;
constexpr size_t WS_END = WS_YSLOT + 256 * MiB;

constexpr int CW_BAR = 4096;
constexpr int CW_SS = 65536;
constexpr int CW_ECNT = 16384;

constexpr int RING_BYTES = 131072;
constexpr int MISC_OFF = 135168;
constexpr int LDS_BYTES = 163840;
constexpr int MO_BARW = 0;
constexpr int MO_GTAB = 64;
constexpr int MO_TPRE = 64 + 2048;
constexpr int MO_EBASE = MO_TPRE + 160;
constexpr int MO_ECNT = MO_EBASE + 128;
constexpr int MO_LCNT = MO_ECNT + 128;
constexpr int MO_LBASE = MO_LCNT + 128;
constexpr int MO_SEL = MO_LBASE + 128;
constexpr int MO_SELW = MO_SEL + 2048;
constexpr int MO_RANK = MO_SELW + 2048;
constexpr int MO_ULIST = MO_RANK + 2048;
constexpr int MO_GALL = 10240;
constexpr int GALL_UNITS = 18;
static_assert(MO_ULIST + 1024 <= MO_GALL && MISC_OFF + MO_GALL + GALL_UNITS * 1024 <= LDS_BYTES, "LDS map");

#define RLX_AGENT __ATOMIC_RELAXED, __HIP_MEMORY_SCOPE_AGENT
#define LDS_WAIT() asm volatile("s_waitcnt lgkmcnt(0)" ::: "memory")
#define VM_WAIT() asm volatile("s_waitcnt vmcnt(0)" ::: "memory")

__device__ __forceinline__ unsigned f2bf(float f) { unsigned u = __builtin_bit_cast(unsigned, f); return (u + 0x7fffu + ((u >> 16) & 1u)) >> 16; }
__device__ __forceinline__ unsigned pk2(float lo, float hi) { return f2bf(lo) | (f2bf(hi) << 16); }
__device__ __forceinline__ unsigned cvt_pk_bf16(float lo, float hi) { unsigned r; asm volatile("v_cvt_pk_bf16_f32 %0, %1, %2" : "=v"(r) : "v"(lo), "v"(hi)); return r; }
#if MOE_FP8
constexpr float X_SCALE = 4.0f, WGU_SCALE = 64.0f, ACT_SCALE = 4.0f, WDN_SCALE = 128.0f;
constexpr float GU_DESCALE = 1.0f / (X_SCALE * WGU_SCALE), DN_DESCALE = 1.0f / (ACT_SCALE * WDN_SCALE);
#else
constexpr float GU_DESCALE = 1.0f, DN_DESCALE = 1.0f, ACT_SCALE = 1.0f;
#endif
__device__ __forceinline__ unsigned pk4_fp8(float a, float b, float c, float d) {
    a = __builtin_amdgcn_fmed3f(a, -448.0f, 448.0f); b = __builtin_amdgcn_fmed3f(b, -448.0f, 448.0f); c = __builtin_amdgcn_fmed3f(c, -448.0f, 448.0f); d = __builtin_amdgcn_fmed3f(d, -448.0f, 448.0f);
    int p = __builtin_amdgcn_cvt_pk_fp8_f32(a, b, 0, false); p = __builtin_amdgcn_cvt_pk_fp8_f32(c, d, p, true); return (unsigned)p; }
__device__ __forceinline__ float bflo(unsigned u) { return __builtin_bit_cast(float, u << 16); }
__device__ __forceinline__ float bfhi(unsigned u) { return __builtin_bit_cast(float, u & 0xffff0000u); }
__device__ __forceinline__ float bf1(bf16 b) { return __builtin_bit_cast(float, ((unsigned)b) << 16); }
__device__ __forceinline__ float fexp(float x) { return __builtin_amdgcn_exp2f(x * 1.4426950408889634f); }
__device__ __forceinline__ float frcp(float x) { return __builtin_amdgcn_rcpf(x); }
__device__ __forceinline__ float fsigmoid(float x) { return frcp(1.0f + fexp(-x)); }
__device__ __forceinline__ float wave_sum(float v) {
#pragma unroll
    for (int o = 1; o < 64; o <<= 1) v += __shfl_xor(v, o);
    return v;
}
__device__ __forceinline__ float wave_max(float v) {
#pragma unroll
    for (int o = 1; o < 64; o <<= 1) v = fmaxf(v, __shfl_xor(v, o));
    return v;
}

template <int CTRL> __device__ __forceinline__ float dppf(float v) { return __builtin_bit_cast(float, __builtin_amdgcn_update_dpp(0, __builtin_bit_cast(int, v), CTRL, 0xf, 0xf, true)); }
template <int CTRL> __device__ __forceinline__ int dppi(int v) { return __builtin_amdgcn_update_dpp(0, v, CTRL, 0xf, 0xf, true); }
__device__ __forceinline__ float rlane(float v, int l) { return __builtin_bit_cast(float, __builtin_amdgcn_readlane(__builtin_bit_cast(int, v), l)); }
__device__ __forceinline__ float wave_sum_u(float v) {
    v += dppf<0xB1>(v); v += dppf<0x4E>(v); v += dppf<0x141>(v); v += dppf<0x140>(v);
    return (rlane(v, 0) + rlane(v, 16)) + (rlane(v, 32) + rlane(v, 48));
}
#define XB_TMO      128
#define XB_XCNT(j)  (256  + 64 * (j))
#define XB_XSUB(j)  (1280 + 64 * (j))
#define XB_XGEN(j)  (2304 + 64 * (j))
#define XB_TOP      3328
#define XB_TOPGEN   3392
#define XCD_BAR_WORDS 3456
#define XB_SPIN_CAP (1u << 22)

__device__ __forceinline__ unsigned xb_ld(unsigned* p)              { return __hip_atomic_load(p, __ATOMIC_RELAXED, __HIP_MEMORY_SCOPE_AGENT); }
__device__ __forceinline__ unsigned xb_add(unsigned* p, unsigned v) { return __hip_atomic_fetch_add(p, v, __ATOMIC_RELAXED, __HIP_MEMORY_SCOPE_AGENT); }
__device__ __forceinline__ unsigned xb_xcc_id() { return (unsigned)__builtin_amdgcn_s_getreg((3 << 11) | 20) & 0xFu; }
#define XB_SPIN(cond, bar) do { unsigned _sp = 0; while (cond) { __builtin_amdgcn_s_sleep(1); \
    if ((++_sp & 255u) == 0u) { if (xb_ld(&(bar)[XB_TMO])) break; if (_sp > XB_SPIN_CAP) { atomicAdd(&(bar)[XB_TMO], 1u); break; } } } } while (0)

struct XcdBarrier { unsigned* bar; unsigned x; volatile LAS unsigned* st; };

__device__ __forceinline__ XcdBarrier xcd_barrier_post(unsigned* bar, volatile LAS unsigned* st) {
    XcdBarrier b; b.bar = bar; b.x = xb_xcc_id(); b.st = st;
    if (threadIdx.x == 0) (void)xb_add(&bar[XB_XCNT(b.x)], 1u);
    return b;
}
__device__ __forceinline__ void xcd_barrier_complete(unsigned* bar, unsigned x, unsigned& nloc, unsigned& nx) {
    const unsigned G = gridDim.x * gridDim.y * gridDim.z;
    unsigned sum, cnt, mine, sp = 0u;
    for (;;) {
        sum = 0u; cnt = 0u; mine = 0u;
#pragma unroll
        for (unsigned j = 0; j < 16; ++j) { const unsigned c = xb_ld(&bar[XB_XCNT(j)]); sum += c; cnt += (c > 0u) ? 1u : 0u; mine = (j == x) ? c : mine; }
        if (sum == G) break;
        __builtin_amdgcn_s_sleep(1);
        if ((++sp & 255u) == 0u) { if (xb_ld(&bar[XB_TMO])) break; if (sp > XB_SPIN_CAP) { atomicAdd(&bar[XB_TMO], 1u); break; } }
    }
    nloc = mine > 0u ? mine : 1u; nx = cnt > 0u ? cnt : 1u;
}
__device__ __forceinline__ void xcd_barrier(const XcdBarrier& b) {
    asm volatile("s_waitcnt vmcnt(0)" ::: "memory");
    __syncthreads();
    if (threadIdx.x == 0) {
        unsigned* bar = b.bar;
        __builtin_amdgcn_s_waitcnt(0);
        unsigned nloc = b.st[0], nx = b.st[1];
        if (nloc == 0u) { xcd_barrier_complete(bar, b.x, nloc, nx); b.st[0] = nloc; b.st[1] = nx; }
        const unsigned old = xb_add(&bar[XB_XSUB(b.x)], 1u);
        const unsigned gen = old / nloc;
        if (old + 1u == (gen + 1u) * nloc) {
            __builtin_amdgcn_fence(__ATOMIC_RELEASE, "agent");
            asm volatile("s_waitcnt vmcnt(0)" ::: "memory");
            const unsigned og = xb_add(&bar[XB_TOP], 1u);
            const unsigned tg = og / nx;
            if (og + 1u == (tg + 1u) * nx) xb_add(&bar[XB_TOPGEN], 1u);
            else XB_SPIN(xb_ld(&bar[XB_TOPGEN]) == tg, bar);
            __builtin_amdgcn_fence(__ATOMIC_ACQUIRE, "agent");
            xb_add(&bar[XB_XGEN(b.x)], 1u);
            asm volatile("s_waitcnt vmcnt(0)" ::: "memory");
        } else {
            XB_SPIN(xb_ld(&bar[XB_XGEN(b.x)]) == gen, bar);
            __builtin_amdgcn_fence(__ATOMIC_ACQUIRE, "agent");
            asm volatile("s_waitcnt vmcnt(0)" ::: "memory");
        }
    }
    __syncthreads();
}

namespace pg8 {
constexpr int BM = 256, BK = 64, HALF = 128, HTB = HALF * BK * 2, STAGE_BYTES = 8 * HTB, NXCD = 8, WGM = 8, MAXU = 32;
__host__ __device__ __forceinline__ int lds_byte(int r, int c) { const int st = (r >> 4) * 2 + (c >> 5), rr = r & 15, cc = c & 31, ob = rr * 64 + cc * 2; return st * 1024 + (ob ^ (((ob >> 9) & 1) << 5)); }
__host__ __device__ __forceinline__ void stage_rc(int b, int& R, int& C) { const int st = b / 1024, sb = b % 1024, swz = sb ^ (((sb >> 9) & 1) << 5); R = (st >> 1) * 16 + swz / 64; C = (st & 1) * 32 + (swz % 64) / 2; }
__host__ __device__ __forceinline__ int perm32(int rho) { const int n = rho >> 4, i = rho & 15; return 8 * (i >> 2) + 4 * n + (i & 3); }

struct Unit { int pm, pn, e, rowbase, cnt; unsigned boff; int gidx; };

__device__ __forceinline__ bool tile_of(long L, int nM, int nN, int& gm, int& pn) {
    const int nwg = nM * nN; if (L >= nwg) return false;
    int wgid = (int)L; { const int q = nwg / NXCD, r = nwg % NXCD, xcd = wgid % NXCD, off = wgid / NXCD; wgid = (xcd < r ? xcd * (q + 1) : r * (q + 1) + (xcd - r) * q) + off; }
    const int nig = WGM * nN, gid = wgid / nig, fm = gid * WGM, gsz = (nM - fm) < WGM ? (nM - fm) : WGM;
    gm = fm + ((wgid % nig) % gsz); pn = (wgid % nig) / gsz; return true;
}
__device__ __forceinline__ void build_units_dense(const int i, LAS int* ul, int nM, int nN, int RB) {
    if (i < MAXU) { int gm = 0, pn = 0; const bool ok = tile_of((long)i * gridDim.x + blockIdx.x, nM, nN, gm, pn);
        ul[i * 8 + 0] = ok ? 1 : 0; ul[i * 8 + 1] = gm; ul[i * 8 + 2] = pn; ul[i * 8 + 3] = 0; ul[i * 8 + 4] = gm * BM; ul[i * 8 + 5] = BM; ul[i * 8 + 6] = (int)((unsigned)pn * BM * (unsigned)RB); ul[i * 8 + 7] = 0; }
    __syncthreads();
}
__device__ __forceinline__ void build_units_moe(const int i, LAS int* ul, const LAS int* tpre, const LAS int* ebase, const LAS int* ecnt, int nN, int RB, unsigned wstride) {
    if (i < MAXU) { int gm = 0, pn = 0; const bool ok = tile_of((long)i * gridDim.x + blockIdx.x, tpre[NE], nN, gm, pn);
        int e = 0;
_Pragma("unroll 1")
        for (int s = 16; s >= 1; s >>= 1) { if (e + s < NE && tpre[e + s] <= gm) e += s; }
        const int pm = gm - tpre[e];
        ul[i * 8 + 0] = ok ? 1 : 0; ul[i * 8 + 1] = pm; ul[i * 8 + 2] = pn; ul[i * 8 + 3] = e; ul[i * 8 + 4] = ebase[e] + pm * BM; ul[i * 8 + 5] = ecnt[e] - pm * BM;
        ul[i * 8 + 6] = (int)((unsigned)e * wstride + (unsigned)pn * BM * (unsigned)RB); ul[i * 8 + 7] = e * ECAP + pm * BM; }
    __syncthreads();
}
__device__ __forceinline__ bool ld_unit(const LAS int* ul, int i, Unit& u) {
    if (i >= MAXU) return false;
    const LAS int* p = ul + i * 8;
    if (__builtin_amdgcn_readfirstlane(p[0]) == 0) return false;
    u.pm = __builtin_amdgcn_readfirstlane(p[1]); u.pn = __builtin_amdgcn_readfirstlane(p[2]); u.e = __builtin_amdgcn_readfirstlane(p[3]); u.rowbase = __builtin_amdgcn_readfirstlane(p[4]);
    u.cnt = __builtin_amdgcn_readfirstlane(p[5]); u.boff = (unsigned)__builtin_amdgcn_readfirstlane(p[6]); u.gidx = __builtin_amdgcn_readfirstlane(p[7]); return true;
}
__device__ __forceinline__ void glds16(const char* sbase, unsigned voff, LAS unsigned char* dst) {
    asm volatile("" : "+s"(sbase));
    __builtin_amdgcn_global_load_lds((const unsigned*)(sbase + voff), (LAS unsigned*)dst, 16, 0, 0);
}
template <bool GATHER> __device__ __forceinline__ void stage_a(LAS unsigned char* dst, const char* sbase, unsigned o0, unsigned o1, size_t r64) {
    glds16(sbase, o0, dst);
    if constexpr (GATHER) glds16(sbase, o1, dst + 8192);
    else glds16(sbase + r64, o0, dst + 8192);
}

typedef int v8i __attribute__((ext_vector_type(8)));
typedef int v4i __attribute__((ext_vector_type(4)));
__device__ __forceinline__ v8i cat_frag(const bf16x8& a, const bf16x8& b) { return __builtin_shufflevector(__builtin_bit_cast(v4i, a), __builtin_bit_cast(v4i, b), 0, 1, 2, 3, 4, 5, 6, 7); }
template <class Epi, bool GATHER, bool ALIGN_EPI, bool FP8>
__device__ __forceinline__ void gemm_phase(const int tid, LAS unsigned char* lds, const LAS int* ul, LAS int* gtab, const char* Abase, const char* Bbase, const int* rowdst, const int RB, const Epi& E) {
    const int wid = __builtin_amdgcn_readfirstlane(tid >> 6), lane = tid & 63, wr = wid >> 2, wc = wid & 3, fr = lane & 15, fq = lane >> 4;
    const int nt = RB / 128;
    int R0, C0; stage_rc(tid * 16, R0, C0);
    const int Rb0 = Epi::PERM ? ((R0 & ~31) + perm32(R0 & 31)) : R0;
    const unsigned voffB = (unsigned)(Rb0 * RB + C0 * 2);
    const unsigned cb0 = (unsigned)C0 * 2u, K2 = (unsigned)RB;
    const size_t kstep = (size_t)128;
    const size_t r64 = (size_t)64 * RB;
    const size_t hstep = (size_t)HALF * RB;
    const unsigned ldsw = (unsigned)wid * 1024u;
    const int aoff = lds_byte(wr * 64 + fr, fq * 8), boff = lds_byte(wc * 32 + fr, fq * 8);
#define PG8_SA(b, h) (((b) * 2 + (h)) * HTB)
#define PG8_SB(b, h) ((4 + (b) * 2 + (h)) * HTB)
#define PG8_STAGE(bufoff, gbase) do { glds16((const char*)(gbase), voffB, lds + (bufoff) + ldsw); glds16((const char*)(gbase) + r64, voffB, lds + (bufoff) + ldsw + 8192); } while (0)
#define PG8_STAGEA0(bufoff, kb, o0, o1) stage_a<GATHER>(lds + (bufoff) + ldsw, Abase + (kb), o0, o1, r64)
#define PG8_STAGEA1(bufoff, kb, o0, o2, o3) stage_a<GATHER>(lds + (bufoff) + ldsw, Abase + (kb) + (GATHER ? (size_t)0 : hstep), GATHER ? (o2) : (o0), o3, r64)
#define PG8_LDA(dst, b, h) do { _Pragma("unroll") for (int m = 0; m < 4; ++m) { const v4i _l = *(const LAS v4i*)(lds + PG8_SA(b, h) + aoff + m * 2048), _h = *(const LAS v4i*)(lds + PG8_SA(b, h) + aoff + m * 2048 + 1024); dst[m] = __builtin_shufflevector(_l, _h, 0, 1, 2, 3, 4, 5, 6, 7); } } while (0)
#define PG8_LDB(dst, b, h) do { _Pragma("unroll") for (int n = 0; n < 2; ++n) { const v4i _l = *(const LAS v4i*)(lds + PG8_SB(b, h) + boff + n * 2048), _h = *(const LAS v4i*)(lds + PG8_SB(b, h) + boff + n * 2048 + 1024); dst[n] = __builtin_shufflevector(_l, _h, 0, 1, 2, 3, 4, 5, 6, 7); } } while (0)
#define PG8_LO(x) __builtin_bit_cast(bf16x8, __builtin_shufflevector(x, x, 0, 1, 2, 3))
#define PG8_HI(x) __builtin_bit_cast(bf16x8, __builtin_shufflevector(x, x, 4, 5, 6, 7))
#define PG8_MMA(ai, bj, At, Bt) do { __builtin_amdgcn_s_setprio(1); _Pragma("unroll") for (int m = 0; m < 4; ++m) _Pragma("unroll") for (int n = 0; n < 2; ++n) { \
        if constexpr (FP8) asm volatile("v_mfma_scale_f32_16x16x128_f8f6f4 %0, %1, %2, %0, %3, %3 op_sel_hi:[0,0,0]" : "+v"(acc[ai][bj][m][n]) : "v"(Bt[n]), "v"(At[m]), "v"(sc1)); \
        else { acc[ai][bj][m][n] = __builtin_amdgcn_mfma_f32_16x16x32_bf16(PG8_LO(Bt[n]), PG8_LO(At[m]), acc[ai][bj][m][n], 0, 0, 0); \
               acc[ai][bj][m][n] = __builtin_amdgcn_mfma_f32_16x16x32_bf16(PG8_HI(Bt[n]), PG8_HI(At[m]), acc[ai][bj][m][n], 0, 0, 0); } } \
        __builtin_amdgcn_s_setprio(0); } while (0)
#define PG8_WAIT_V(n) asm volatile("s_waitcnt vmcnt(" #n ")" ::: "memory")
#define PG8_WAIT_L(n) asm volatile("s_waitcnt lgkmcnt(" #n ")" ::: "memory")
#define PG8_BAR __builtin_amdgcn_s_barrier()
#define PG8_SCHED __builtin_amdgcn_sched_barrier(0)
    Unit cur, nxt; int ui = 0;
    if (!ld_unit(ul, 0, cur)) return;
    f32x4 acc[2][2][4][2];
#pragma unroll
    for (int a = 0; a < 2; ++a)
#pragma unroll
        for (int b = 0; b < 2; ++b)
#pragma unroll
            for (int m = 0; m < 4; ++m)
#pragma unroll
                for (int n = 0; n < 2; ++n) acc[a][b][m][n] = (f32x4){0.f, 0.f, 0.f, 0.f};
    v8i At[4], B0[2], B1[2];
    const int sc1 = 0x7f7f7f7f;
    unsigned oA0, oA1 = 0, oA2 = 0, oA3 = 0, oN0, oN1 = 0, oN2 = 0, oN3 = 0;
    if constexpr (GATHER) {
        oA0 = (unsigned)gtab[R0] * K2 + cb0; oA1 = (unsigned)gtab[R0 + 64] * K2 + cb0; oA2 = (unsigned)gtab[R0 + 128] * K2 + cb0; oA3 = (unsigned)gtab[R0 + 192] * K2 + cb0;
    } else {
        oA0 = (unsigned)(cur.rowbase + R0) * K2 + cb0;
    }
    oN0 = oA0; oN1 = oA1; oN2 = oA2; oN3 = oA3;
    const char* cB = Bbase + cur.boff;
    PG8_STAGE(PG8_SB(0, 0), cB); PG8_STAGE(PG8_SB(0, 1), cB + hstep); PG8_STAGEA0(PG8_SA(0, 0), (size_t)0, oA0, oA1); PG8_STAGEA1(PG8_SA(0, 1), (size_t)0, oA0, oA2, oA3);
    if (wr == 1) PG8_BAR;
    PG8_WAIT_V(2); PG8_BAR;
    PG8_STAGE(PG8_SB(1, 0), cB + kstep); PG8_STAGEA0(PG8_SA(1, 0), kstep, oA0, oA1); PG8_STAGE(PG8_SB(1, 1), cB + hstep + kstep);
    PG8_WAIT_V(6); PG8_BAR;
    for (;;) {
        const bool has_next = ld_unit(ul, ui + 1, nxt);
        const char* nB = has_next ? Bbase + nxt.boff : cB;
_Pragma("unroll 1")
        for (int t = 0; t < nt; t += 2) {
            const bool last = (t == nt - 2);
            if (last && has_next) {
                if constexpr (GATHER) {
                    const LAS int* gt = gtab + (ui + 1) * 256;
                    oN0 = (unsigned)gt[R0] * K2 + cb0; oN1 = (unsigned)gt[R0 + 64] * K2 + cb0; oN2 = (unsigned)gt[R0 + 128] * K2 + cb0; oN3 = (unsigned)gt[R0 + 192] * K2 + cb0;
                } else {
                    oN0 = (unsigned)(nxt.rowbase + R0) * K2 + cb0;
                }
            }
            const size_t kb1 = (size_t)(t + 1) * kstep;
            const size_t kb2 = last ? (size_t)0 : (size_t)(t + 2) * kstep, kb3 = kb2 + kstep;
            const unsigned p0 = last ? oN0 : oA0, p1 = last ? oN1 : oA1, p2 = last ? oN2 : oA2, p3 = last ? oN3 : oA3;
            const char* b2 = last ? nB : cB + (size_t)(t + 2) * kstep; const char* b3 = b2 + kstep;
            PG8_LDB(B0, 0, 0); PG8_LDB(B1, 0, 1); PG8_SCHED; PG8_LDA(At, 0, 0); PG8_STAGEA1(PG8_SA(1, 1), kb1, oA0, oA2, oA3);
            PG8_WAIT_V(8); PG8_WAIT_L(0); PG8_BAR; PG8_MMA(0, 0, At, B0); PG8_MMA(0, 1, At, B1); PG8_BAR; PG8_SCHED;
            PG8_LDA(At, 0, 1); PG8_STAGE(PG8_SB(0, 0), b2); PG8_STAGE(PG8_SB(0, 1), b2 + hstep); PG8_STAGEA0(PG8_SA(0, 0), kb2, p0, p1);
            PG8_WAIT_V(8); PG8_WAIT_L(0); PG8_BAR; PG8_MMA(1, 0, At, B0); PG8_MMA(1, 1, At, B1); PG8_BAR; PG8_SCHED;
            PG8_LDB(B0, 1, 0); PG8_LDB(B1, 1, 1); PG8_SCHED; PG8_LDA(At, 1, 0); PG8_STAGEA1(PG8_SA(0, 1), kb2, p0, p2, p3);
            PG8_WAIT_V(8); PG8_WAIT_L(0); PG8_BAR; PG8_MMA(0, 0, At, B0); PG8_MMA(0, 1, At, B1); PG8_BAR; PG8_SCHED;
            PG8_LDA(At, 1, 1); PG8_STAGE(PG8_SB(1, 0), b3); PG8_STAGE(PG8_SB(1, 1), b3 + hstep); PG8_STAGEA0(PG8_SA(1, 0), kb3, p0, p1);
            PG8_WAIT_V(8); PG8_WAIT_L(0); PG8_BAR; PG8_MMA(1, 0, At, B0); PG8_MMA(1, 1, At, B1); PG8_BAR; PG8_SCHED;
        }
        if constexpr (FP8) asm volatile("s_nop 7\n\ts_nop 7\n\ts_nop 7" ::: "memory");
        if constexpr (ALIGN_EPI) { if (wr == 0) PG8_BAR; }
        E(acc, cur, wr, wc, fr, fq);
#if PROBE_EPI2
        if constexpr (FP8) E(acc, cur, wr, wc, fr, fq);
#endif
        if (!has_next) break;
#pragma unroll
        for (int a = 0; a < 2; ++a)
#pragma unroll
            for (int b = 0; b < 2; ++b)
#pragma unroll
                for (int m = 0; m < 4; ++m)
#pragma unroll
                    for (int n = 0; n < 2; ++n) acc[a][b][m][n] = (f32x4){0.f, 0.f, 0.f, 0.f};
        cur = nxt; cB = nB; oA0 = oN0; oA1 = oN1; oA2 = oN2; oA3 = oN3; ++ui;
        if constexpr (ALIGN_EPI) { if (wr == 1) PG8_BAR; }
    }
    PG8_WAIT_V(0);
    if constexpr (!ALIGN_EPI) { if (wr == 0) PG8_BAR; }
    PG8_BAR;
#undef PG8_SA
#undef PG8_SB
#undef PG8_STAGE
#undef PG8_STAGEA0
#undef PG8_STAGEA1
#undef PG8_LDA
#undef PG8_LDB
#undef PG8_LO
#undef PG8_HI
#undef PG8_MMA
#undef PG8_WAIT_V
#undef PG8_WAIT_L
#undef PG8_BAR
#undef PG8_SCHED
}

__device__ __forceinline__ GAS unsigned char* launder(unsigned char* p) { asm volatile("" : "+s"(p)); return (GAS unsigned char*)p; }
#define OPAQUE_LANE(fr, fq) asm volatile("" : "+v"(fr), "+v"(fq))
struct EpiHgrnIn {
    static constexpr bool PERM = true;
    unsigned char* ws0; int L;
    __device__ __forceinline__ void operator()(const f32x4 (&acc)[2][2][4][2], const Unit& u, int wr, int wc, int fr, int fq) const {
        OPAQUE_LANE(fr, fq);
        GAS unsigned char* ws = launder(ws0);
        GAS bf16* QD = (GAS bf16*)(ws + WS_H);
        const int row0 = u.rowbase + wr * 64 + fr;
        if (u.pn >= 8) {
            const bool isg = u.pn >= 12; GAS bf16* base = QD + (size_t)(isg ? 4 : 3) * NTOK * DM; const int colt = (u.pn - (isg ? 12 : 8)) * BM + wc * 32 + 8 * fq;
#pragma unroll
            for (int ai = 0; ai < 2; ++ai)
#pragma unroll
                for (int m = 0; m < 4; ++m) { GAS bf16* rowp = base + (size_t)(row0 + ai * HALF + m * 16) * DM + colt;
#pragma unroll
                    for (int bj = 0; bj < 2; ++bj) { f32x4 v0 = acc[ai][bj][m][0], v1 = acc[ai][bj][m][1];
                        if (isg) {
#pragma unroll
                            for (int j = 0; j < 4; ++j) { v0[j] = v0[j] * fsigmoid(v0[j]); v1[j] = v1[j] * fsigmoid(v1[j]); } }
                        v4u w; w.x = cvt_pk_bf16(v0[0], v0[1]); w.y = cvt_pk_bf16(v0[2], v0[3]); w.z = cvt_pk_bf16(v1[0], v1[1]); w.w = cvt_pk_bf16(v1[2], v1[3]);
                        *(GAS v4u*)(rowp + bj * HALF) = w; } }
            return;
        }
        const int col = u.pn * HG_K + wc * 32 + 8 * fq;
        const GAS float* lb = (const GAS float*)(ws + WS_LBS) + L * DM;
        const f32x4 lb0 = *(const GAS f32x4*)(lb + col), lb1 = *(const GAS f32x4*)(lb + col + 4);
#if !SLOW_HGRN
        const int lane = fq * 16 + fr;
        GAS float* DEC = (GAS float*)(ws + WS_DEC);
#endif
#pragma unroll
        for (int ai = 0; ai < 2; ++ai)
#pragma unroll
            for (int m = 0; m < 4; ++m) {
                const int row = row0 + ai * HALF + m * 16;
                float qd[8], ki[8];
#if SLOW_HGRN
                float ks[8];
#endif
#if !SLOW_HGRN
                float de[8];
#endif
#pragma unroll
                for (int j = 0; j < 8; ++j) {
                    const float q = acc[ai][0][m][j >> 2][j & 3], f = acc[ai][1][m][j >> 2][j & 3], lbv = j < 4 ? lb0[j & 3] : lb1[j & 3];
                    const float sg = fsigmoid(f), fg = lbv + (1.0f - lbv) * sg, kk = (1.0f - lbv) * (1.0f - sg);
#if SLOW_HGRN
                    qd[j] = q * fsigmoid(q); ki[j] = kk; ks[j] = fg;
#else
                    float P = fg;
                    P *= __builtin_bit_cast(float, __builtin_amdgcn_update_dpp(0x3f800000, __builtin_bit_cast(int, P), 0x111, 0xf, 0xf, false));
                    P *= __builtin_bit_cast(float, __builtin_amdgcn_update_dpp(0x3f800000, __builtin_bit_cast(int, P), 0x112, 0xf, 0xf, false));
                    P *= __builtin_bit_cast(float, __builtin_amdgcn_update_dpp(0x3f800000, __builtin_bit_cast(int, P), 0x114, 0xf, 0xf, false));
                    P *= __builtin_bit_cast(float, __builtin_amdgcn_update_dpp(0x3f800000, __builtin_bit_cast(int, P), 0x118, 0xf, 0xf, false));
                    const float Pl = __shfl(P, lane | 15), iP = frcp(P);
                    qd[j] = q * fsigmoid(q) * P; ki[j] = kk * iP; de[j] = Pl;
#endif
                }
                const size_t o = (size_t)row * DM + col;
                v4u w;
                w.x = cvt_pk_bf16(qd[0], qd[1]); w.y = cvt_pk_bf16(qd[2], qd[3]); w.z = cvt_pk_bf16(qd[4], qd[5]); w.w = cvt_pk_bf16(qd[6], qd[7]); *(GAS v4u*)(QD + o) = w;
                w.x = cvt_pk_bf16(ki[0], ki[1]); w.y = cvt_pk_bf16(ki[2], ki[3]); w.z = cvt_pk_bf16(ki[4], ki[5]); w.w = cvt_pk_bf16(ki[6], ki[7]); *(GAS v4u*)(QD + (size_t)NTOK * DM + o) = w;
#if SLOW_HGRN
                w.x = cvt_pk_bf16(ks[0], ks[1]); w.y = cvt_pk_bf16(ks[2], ks[3]); w.z = cvt_pk_bf16(ks[4], ks[5]); w.w = cvt_pk_bf16(ks[6], ks[7]); *(GAS v4u*)(QD + 2 * (size_t)NTOK * DM + o) = w;
#endif
#if !SLOW_HGRN
                if (fr == 0) { GAS float* dp = DEC + (size_t)(row >> 4) * DM + col; *(GAS f32x4*)dp = (f32x4){de[0], de[1], de[2], de[3]}; *(GAS f32x4*)(dp + 4) = (f32x4){de[4], de[5], de[6], de[7]}; }
#endif
            }
    }
};
struct EpiRetIn {
    static constexpr bool PERM = true;
    unsigned char* ws0;
    __device__ __forceinline__ void operator()(const f32x4 (&acc)[2][2][4][2], const Unit& u, int wr, int wc, int fr, int fq) const {
        OPAQUE_LANE(fr, fq);
        GAS unsigned char* ws = launder(ws0);
        GAS bf16* H = (GAS bf16*)(ws + WS_H); const GAS float* rot = (const GAS float*)(ws + WS_ROT);
        const int row0 = u.rowbase + wr * 64 + fr; const int colt = u.pn * BM + wc * 32 + 8 * fq;
        const int kind = u.pn < 4 ? 0 : (u.pn < 8 ? 1 : (u.pn < 16 ? 2 : 3));
#pragma unroll
        for (int ai = 0; ai < 2; ++ai)
#pragma unroll
            for (int m = 0; m < 4; ++m) { const int row = row0 + ai * HALF + m * 16; GAS bf16* rowp = H + (size_t)row * RT_IN + colt; const int pos = row & (SEQ - 1);
#pragma unroll
                for (int bj = 0; bj < 2; ++bj) { f32x4 v0 = acc[ai][bj][m][0], v1 = acc[ai][bj][m][1];
                    if (kind <= 1) {
                        const int p0 = (bj * HALF + wc * 32 + 8 * fq) >> 1;
                        const GAS float* rp = rot + ((size_t)pos * 128 + p0) * 2;
                        const f32x4 r0 = *(const GAS f32x4*)rp, r1 = *(const GAS f32x4*)(rp + 4);
                        const float sc = kind == 1 ? 0.0625f : 1.0f;
                        f32x4 o0, o1;
                        o0[0] = (v0[0] * r0[0] - v0[1] * r0[1]) * sc; o0[1] = (v0[1] * r0[0] + v0[0] * r0[1]) * sc;
                        o0[2] = (v0[2] * r0[2] - v0[3] * r0[3]) * sc; o0[3] = (v0[3] * r0[2] + v0[2] * r0[3]) * sc;
                        o1[0] = (v1[0] * r1[0] - v1[1] * r1[1]) * sc; o1[1] = (v1[1] * r1[0] + v1[0] * r1[1]) * sc;
                        o1[2] = (v1[2] * r1[2] - v1[3] * r1[3]) * sc; o1[3] = (v1[3] * r1[2] + v1[2] * r1[3]) * sc;
                        v0 = o0; v1 = o1;
                    } else if (kind == 3) {
#pragma unroll
                        for (int j = 0; j < 4; ++j) { v0[j] = v0[j] * fsigmoid(v0[j]); v1[j] = v1[j] * fsigmoid(v1[j]); }
                    }
                    v4u w; w.x = cvt_pk_bf16(v0[0], v0[1]); w.y = cvt_pk_bf16(v0[2], v0[3]); w.z = cvt_pk_bf16(v1[0], v1[1]); w.w = cvt_pk_bf16(v1[2], v1[3]);
                    *(GAS v4u*)(rowp + bj * HALF) = w; } }
    }
};
struct EpiRes {
    static constexpr bool PERM = true;
    unsigned char* ws0; int ssoff;
    __device__ __forceinline__ void operator()(const f32x4 (&acc)[2][2][4][2], const Unit& u, int wr, int wc, int fr, int fq) const {
        OPAQUE_LANE(fr, fq);
        GAS unsigned char* ws = launder(ws0);
        GAS bf16* Y = (GAS bf16*)(ws + WS_Y); const GAS bf16* X = (const GAS bf16*)(ws + WS_XB);
        const int row0 = u.rowbase + wr * 64 + fr, col0 = u.pn * BM + wc * 32 + 8 * fq;
#pragma unroll
        for (int ai = 0; ai < 2; ++ai)
#pragma unroll
            for (int m = 0; m < 4; ++m) { const size_t off = (size_t)(row0 + ai * HALF + m * 16) * DM + col0;
                float rsc = 1.0f;
                if (ssoff >= 0) { const GAS float* sp = (const GAS float*)(ws + WS_SSP) + row0 + ai * HALF + m * 16; float ssum = 0.f;
#pragma unroll
                    for (int hh = 0; hh < HG_HEADS; ++hh) ssum += sp[(size_t)hh * NTOK];
                    rsc = 1.0f / sqrtf(ssum * (1.0f / DM) + RMS_EPS); }
#pragma unroll
                for (int bj = 0; bj < 2; ++bj) { const v4u xs = *(const GAS v4u*)(X + off + bj * HALF); const f32x4 a0 = acc[ai][bj][m][0] * rsc, a1 = acc[ai][bj][m][1] * rsc;
                    v4u w; w.x = cvt_pk_bf16(bflo(xs.x) * DN_ALPHA + a0[0], bfhi(xs.x) * DN_ALPHA + a0[1]); w.y = cvt_pk_bf16(bflo(xs.y) * DN_ALPHA + a0[2], bfhi(xs.y) * DN_ALPHA + a0[3]);
                    w.z = cvt_pk_bf16(bflo(xs.z) * DN_ALPHA + a1[0], bfhi(xs.z) * DN_ALPHA + a1[1]); w.w = cvt_pk_bf16(bflo(xs.w) * DN_ALPHA + a1[2], bfhi(xs.w) * DN_ALPHA + a1[3]);
                    *(GAS v4u*)(Y + off + bj * HALF) = w; } }
    }
};
struct EpiMoeGU {
    static constexpr bool PERM = true;
    unsigned char* ws0; int L;
    __device__ __forceinline__ void operator()(const f32x4 (&acc)[2][2][4][2], const Unit& u, int wr, int wc, int fr, int fq) const {
        OPAQUE_LANE(fr, fq);
        GAS unsigned char* ws = launder(ws0);
        const GAS float* bias = (const GAS float*)(ws + WS_BGU) + (size_t)L * NE * 2048;
        const int row0 = u.rowbase + wr * 64 + fr; const int c8 = wc * 32 + 8 * fq;
        const GAS float* bp = bias + ((size_t)u.e * 8 + u.pn) * 256 + c8;
        const f32x4 bg0 = *(const GAS f32x4*)bp, bg1 = *(const GAS f32x4*)(bp + 4);
        const f32x4 bl0 = (*(const GAS f32x4*)(bp + HALF) + 1.0f) * ACT_SCALE, bl1 = (*(const GAS f32x4*)(bp + HALF + 4) + 1.0f) * ACT_SCALE;
#pragma unroll
        for (int ai = 0; ai < 2; ++ai)
#pragma unroll
            for (int m = 0; m < 4; ++m) { const size_t eo = (size_t)(row0 + ai * HALF + m * 16) * DM + u.pn * HALF + c8;
                float a[8];
#pragma unroll
                for (int j = 0; j < 8; ++j) {
                    const float g = fminf(fmaf(acc[ai][0][m][j >> 2][j & 3], GU_DESCALE, j < 4 ? bg0[j & 3] : bg1[j & 3]), 7.0f);
                    const float l1 = __builtin_amdgcn_fmed3f(fmaf(acc[ai][1][m][j >> 2][j & 3], GU_DESCALE * ACT_SCALE, j < 4 ? bl0[j & 3] : bl1[j & 3]), -6.0f * ACT_SCALE, 8.0f * ACT_SCALE);
                    a[j] = g * frcp(1.0f + __builtin_amdgcn_exp2f(g * -2.4554669595930156f)) * l1;
                }
#if MOE_FP8
                v2u w;
                { int p = __builtin_amdgcn_cvt_pk_fp8_f32(a[0], a[1], 0, false); p = __builtin_amdgcn_cvt_pk_fp8_f32(a[2], a[3], p, true); w.x = (unsigned)p; }
                { int p = __builtin_amdgcn_cvt_pk_fp8_f32(a[4], a[5], 0, false); p = __builtin_amdgcn_cvt_pk_fp8_f32(a[6], a[7], p, true); w.y = (unsigned)p; }
                *(GAS v2u*)(ws + WS_ACT + eo) = w;
#else
                v4u w; w.x = cvt_pk_bf16(a[0], a[1]); w.y = cvt_pk_bf16(a[2], a[3]); w.z = cvt_pk_bf16(a[4], a[5]); w.w = cvt_pk_bf16(a[6], a[7]);
                *(GAS v4u*)((GAS bf16*)(ws + WS_ACT) + eo) = w;
#endif
            }
    }
};
struct EpiMoeDown {
    static constexpr bool PERM = true;
    unsigned char* ws0; const float* bias;
    __device__ __forceinline__ void operator()(const f32x4 (&acc)[2][2][4][2], const Unit& u, int wr, int wc, int fr, int fq) const {
        OPAQUE_LANE(fr, fq);
        GAS unsigned char* ws = launder(ws0);
        GAS bf16* YS = (GAS bf16*)(ws + WS_YSLOT); const GAS int* rowdst = (const GAS int*)(ws + WS_ROWDST); const GAS float* rowgate = (const GAS float*)(ws + WS_ROWGATE);
        const int c8 = u.pn * BM + wc * 32 + 8 * fq;
        const GAS float* bp = (const GAS float*)bias + (size_t)u.e * DM + c8;
        f32x4 bv[2][2];
#pragma unroll
        for (int bj = 0; bj < 2; ++bj) { bv[bj][0] = *(const GAS f32x4*)(bp + bj * HALF); bv[bj][1] = *(const GAS f32x4*)(bp + bj * HALF + 4); }
#pragma unroll
        for (int ai = 0; ai < 2; ++ai)
#pragma unroll
            for (int m = 0; m < 4; ++m) { const int r = ai * HALF + wr * 64 + m * 16 + fr;
                if (r < u.cnt) {
                    const size_t ti = (size_t)u.gidx + r; const int dst = rowdst[ti]; const float gt = rowgate[ti];
#if YS_FP8
                    GAS unsigned char* rowp = (GAS unsigned char*)YS + (size_t)dst * DM + c8;
#pragma unroll
                    for (int bj = 0; bj < 2; ++bj) { const f32x4 v0 = (acc[ai][bj][m][0] * DN_DESCALE + bv[bj][0]) * (gt * 64.0f), v1 = (acc[ai][bj][m][1] * DN_DESCALE + bv[bj][1]) * (gt * 64.0f);
                        v2u w; w.x = pk4_fp8(v0[0], v0[1], v0[2], v0[3]); w.y = pk4_fp8(v1[0], v1[1], v1[2], v1[3]);
                        *(GAS v2u*)(rowp + bj * HALF) = w; } } }
#else
                    GAS bf16* rowp = YS + (size_t)dst * DM + c8;
#pragma unroll
                    for (int bj = 0; bj < 2; ++bj) { const f32x4 v0 = (acc[ai][bj][m][0] * DN_DESCALE + bv[bj][0]) * gt, v1 = (acc[ai][bj][m][1] * DN_DESCALE + bv[bj][1]) * gt;
                        v4u w; w.x = cvt_pk_bf16(v0[0], v0[1]); w.y = cvt_pk_bf16(v0[2], v0[3]); w.z = cvt_pk_bf16(v1[0], v1[1]); w.w = cvt_pk_bf16(v1[2], v1[3]);
                        *(GAS v4u*)(rowp + bj * HALF) = w; } } }
#endif
    }
};
}

typedef short s16x4 __attribute__((ext_vector_type(4)));
typedef __bf16 bf16x2_t __attribute__((ext_vector_type(2)));
__device__ __forceinline__ unsigned cvtpk(float lo, float hi) { f32x2 v = {lo, hi}; bf16x2_t b = __builtin_convertvector(v, bf16x2_t); return __builtin_bit_cast(unsigned, b); }
__device__ __forceinline__ s16x4 tr_read(const LAS unsigned char* p) { return __builtin_bit_cast(s16x4, __builtin_amdgcn_ds_read_tr16_b64_v4i16((LAS s16x4*)p)); }
__device__ __forceinline__ bf16x8 cat8(s16x4 lo, s16x4 hi) { return __builtin_shufflevector(lo, hi, 0, 1, 2, 3, 4, 5, 6, 7); }
__device__ __forceinline__ bf16x8 pack8(const f32x4& a, const f32x4& b) { v4u p; p.x = cvtpk(a[0], a[1]); p.y = cvtpk(a[2], a[3]); p.z = cvtpk(b[0], b[1]); p.w = cvtpk(b[2], b[3]); return __builtin_bit_cast(bf16x8, p); }
__device__ __forceinline__ s16x4 pack4(const f32x4& a) { v2u p; p.x = cvtpk(a[0], a[1]); p.y = cvtpk(a[2], a[3]); return __builtin_bit_cast(s16x4, p); }
#define LDS_BARRIER() do { asm volatile("s_waitcnt lgkmcnt(0)" ::: "memory"); __builtin_amdgcn_s_barrier(); asm volatile("" ::: "memory"); } while (0)
#define MFMA32(a, b, c) __builtin_amdgcn_mfma_f32_16x16x32_bf16((a), (b), (c), 0, 0, 0)
#define MFMA16(a, b, c) __builtin_amdgcn_mfma_f32_16x16x16bf16_1k((a), (b), (c), 0, 0, 0)

__device__ __forceinline__ void ret_fast(const int tid, LAS unsigned char* lds, const bf16* HB, bf16* OB) {
    constexpr int QP = 528, VP = 272, PP = 144;
    constexpr int OFF_Q = 0, OFF_K = 64 * QP, OFF_V = 2 * 64 * QP, OFF_P = OFF_V + 64 * VP;
    const int lane0 = tid & 63, w = __builtin_amdgcn_readfirstlane(tid >> 6);
    const int prow = tid >> 3, pc = tid & 7;
    for (int un0 = blockIdx.x; un0 < NBATCH * RT_HEADS * 4; un0 += gridDim.x) {
        const int un = (gridDim.x == 256) ? ((un0 & 7) * 32 + (un0 >> 3)) : un0;
        const int b = un >> 4, h = (un >> 2) & 3, vs = un & 3;
        const float l2g = __builtin_amdgcn_logf(1.0f - __builtin_amdgcn_exp2f(-5.0f - (float)h));
        const float dC = __builtin_amdgcn_exp2f(64.0f * l2g);
        f32x4 st[16];
#pragma unroll
        for (int i = 0; i < 16; ++i) st[i] = (f32x4){0.f, 0.f, 0.f, 0.f};
        const bf16* gbase = HB + (size_t)(b * SEQ + prow) * RT_IN;
        v4u pq[4], pk[4], pv[2];
#pragma unroll
        for (int j = 0; j < 4; ++j) { pq[j] = *(const v4u*)(gbase + h * 256 + (pc + 8 * j) * 8); pk[j] = *(const v4u*)(gbase + 1024 + h * 256 + (pc + 8 * j) * 8); }
#pragma unroll
        for (int j = 0; j < 2; ++j) pv[j] = *(const v4u*)(gbase + 2048 + h * 512 + vs * 128 + (pc + 8 * j) * 8);
#pragma unroll 1
        for (int ch = 0; ch < SEQ / 64; ++ch) {
            int lane = lane0; asm volatile("" : "+v"(lane));
            const int r = lane & 15, g = lane >> 4, q4 = (lane & 15) >> 2, p4 = lane & 3;
            LDS_BARRIER();
#pragma unroll
            for (int j = 0; j < 4; ++j) { *(LAS v4u*)(lds + OFF_Q + prow * QP + (pc + 8 * j) * 16) = pq[j]; *(LAS v4u*)(lds + OFF_K + prow * QP + (pc + 8 * j) * 16) = pk[j]; }
#pragma unroll
            for (int j = 0; j < 2; ++j) *(LAS v4u*)(lds + OFF_V + prow * VP + (pc + 8 * j) * 16) = pv[j];
            if (ch + 1 < SEQ / 64) {
                const bf16* gn = gbase + (size_t)(ch + 1) * 64 * RT_IN;
#pragma unroll
                for (int j = 0; j < 4; ++j) { pq[j] = *(const v4u*)(gn + h * 256 + (pc + 8 * j) * 8); pk[j] = *(const v4u*)(gn + 1024 + h * 256 + (pc + 8 * j) * 8); }
#pragma unroll
                for (int j = 0; j < 2; ++j) pv[j] = *(const v4u*)(gn + 2048 + h * 512 + vs * 128 + (pc + 8 * j) * 8);
            }
            LDS_BARRIER();
            {
                const int ct = w >> 1, st0 = 2 * (w & 1);
                f32x4 sa0 = {0.f, 0.f, 0.f, 0.f}, sa1 = {0.f, 0.f, 0.f, 0.f};
                const LAS unsigned char* qb = lds + OFF_Q + (16 * ct + r) * QP + g * 16;
                const LAS unsigned char* kb0 = lds + OFF_K + (16 * st0 + r) * QP + g * 16;
#pragma unroll
                for (int hb = 0; hb < 4; ++hb) {
                    bf16x8 qf[2], k0[2], k1[2];
#pragma unroll
                    for (int kk = 0; kk < 2; ++kk) { const int kb = hb * 2 + kk; qf[kk] = *(const LAS bf16x8*)(qb + kb * 64); k0[kk] = *(const LAS bf16x8*)(kb0 + kb * 64); k1[kk] = *(const LAS bf16x8*)(kb0 + 16 * QP + kb * 64); }
                    asm volatile("" : "+v"(qf[0]), "+v"(qf[1]), "+v"(k0[0]), "+v"(k0[1]), "+v"(k1[0]), "+v"(k1[1]) :: "memory");
#pragma unroll
                    for (int kk = 0; kk < 2; ++kk) { sa0 = MFMA32(k0[kk], qf[kk], sa0); sa1 = MFMA32(k1[kk], qf[kk], sa1); }
                }
                const int c = 16 * ct + r;
#pragma unroll
                for (int t = 0; t < 2; ++t) {
                    const f32x4 sa = t ? sa1 : sa0; const int s0 = 16 * (st0 + t) + 4 * g; float v[4];
#pragma unroll
                    for (int i = 0; i < 4; ++i) { const int d = c - (s0 + i); v[i] = d >= 0 ? sa[i] * __builtin_amdgcn_exp2f((float)d * l2g) : 0.f; }
                    v2u pw; pw.x = cvtpk(v[0], v[1]); pw.y = cvtpk(v[2], v[3]);
                    *(LAS v2u*)(lds + OFF_P + c * PP + s0 * 2) = pw;
                }
            }
            LDS_BARRIER();
            f32x4 o[4];
#pragma unroll
            for (int ct = 0; ct < 4; ++ct) o[ct] = (f32x4){0.f, 0.f, 0.f, 0.f};
            {
                s16x4 ql[2][4], qh[2][4];
                const LAS unsigned char* qp0 = lds + OFF_Q + r * QP + (4 * g) * 2;
#pragma unroll
                for (int ct = 0; ct < 4; ++ct) { ql[0][ct] = *(const LAS s16x4*)(qp0 + ct * 16 * QP); qh[0][ct] = *(const LAS s16x4*)(qp0 + ct * 16 * QP + 32); }
#pragma unroll
                for (int kb = 0; kb < 8; ++kb) {
                    const int cu = kb & 1, nx = cu ^ 1;
                    if (kb + 1 < 8) {
#pragma unroll
                        for (int ct = 0; ct < 4; ++ct) { ql[nx][ct] = *(const LAS s16x4*)(qp0 + ct * 16 * QP + (kb + 1) * 64); qh[nx][ct] = *(const LAS s16x4*)(qp0 + ct * 16 * QP + (kb + 1) * 64 + 32); }
                    }
                    asm volatile("" : "+v"(ql[cu][0]), "+v"(ql[cu][1]), "+v"(ql[cu][2]), "+v"(ql[cu][3]), "+v"(qh[cu][0]), "+v"(qh[cu][1]), "+v"(qh[cu][2]), "+v"(qh[cu][3]) :: "memory");
                    const bf16x8 sa = pack8(st[2 * kb], st[2 * kb + 1]);
#pragma unroll
                    for (int ct = 0; ct < 4; ++ct) o[ct] = MFMA32(sa, cat8(ql[cu][ct], qh[cu][ct]), o[ct]);
                }
            }
            bf16x8 vf[2], pf[6];
            {
                s16x4 t0[2], t1[2];
#pragma unroll
                for (int sb = 0; sb < 2; ++sb) { const LAS unsigned char* vp = lds + OFF_V + (32 * sb + 8 * g + q4) * VP + (16 * w + 4 * p4) * 2; t0[sb] = tr_read(vp); t1[sb] = tr_read(vp + 4 * VP); }
                pf[0] = *(const LAS bf16x8*)(lds + OFF_P + (0 + r) * PP + (8 * g) * 2);
                pf[1] = *(const LAS bf16x8*)(lds + OFF_P + (16 + r) * PP + (8 * g) * 2);
                pf[2] = *(const LAS bf16x8*)(lds + OFF_P + (32 + r) * PP + (8 * g) * 2);
                pf[3] = *(const LAS bf16x8*)(lds + OFF_P + (32 + r) * PP + (32 + 8 * g) * 2);
                pf[4] = *(const LAS bf16x8*)(lds + OFF_P + (48 + r) * PP + (8 * g) * 2);
                pf[5] = *(const LAS bf16x8*)(lds + OFF_P + (48 + r) * PP + (32 + 8 * g) * 2);
                asm volatile("" : "+v"(t0[0]), "+v"(t0[1]), "+v"(t1[0]), "+v"(t1[1]), "+v"(pf[0]), "+v"(pf[1]), "+v"(pf[2]), "+v"(pf[3]), "+v"(pf[4]), "+v"(pf[5]) :: "memory");
                vf[0] = cat8(t0[0], t1[0]); vf[1] = cat8(t0[1], t1[1]);
            }
#pragma unroll
            for (int ct = 0; ct < 4; ++ct) o[ct] = o[ct] * __builtin_amdgcn_exp2f((float)(16 * ct + r + 1) * l2g);
            o[0] = MFMA32(vf[0], pf[0], o[0]); o[1] = MFMA32(vf[0], pf[1], o[1]);
            o[2] = MFMA32(vf[0], pf[2], o[2]); o[2] = MFMA32(vf[1], pf[3], o[2]);
            o[3] = MFMA32(vf[0], pf[4], o[3]); o[3] = MFMA32(vf[1], pf[5], o[3]);
            {
                bf16* ob = OB + (size_t)(b * SEQ + ch * 64 + r) * RT_VD + h * 512 + vs * 128 + 16 * w + 4 * g;
#pragma unroll
                for (int ct = 0; ct < 4; ++ct) { v2u ow; ow.x = cvtpk(o[ct][0], o[ct][1]); ow.y = cvtpk(o[ct][2], o[ct][3]); *(v2u*)(ob + (size_t)ct * 16 * RT_VD) = ow; }
            }
            bf16x8 vz[2];
#pragma unroll
            for (int sb = 0; sb < 2; ++sb) {
                const v4u raw = __builtin_bit_cast(v4u, vf[sb]); float f[8] = {bflo(raw.x), bfhi(raw.x), bflo(raw.y), bfhi(raw.y), bflo(raw.z), bfhi(raw.z), bflo(raw.w), bfhi(raw.w)};
#pragma unroll
                for (int j = 0; j < 8; ++j) f[j] *= __builtin_amdgcn_exp2f((float)(63 - (32 * sb + 8 * g + j)) * l2g);
                v4u z; z.x = cvtpk(f[0], f[1]); z.y = cvtpk(f[2], f[3]); z.z = cvtpk(f[4], f[5]); z.w = cvtpk(f[6], f[7]); vz[sb] = __builtin_bit_cast(bf16x8, z);
            }
            {
                const LAS unsigned char* kp0 = lds + OFF_K + (8 * g + q4) * QP + (4 * p4) * 2;
#pragma unroll
                for (int kq = 0; kq < 4; ++kq) {
                    s16x4 ka[4][2], kbh[4][2];
#pragma unroll
                    for (int j = 0; j < 4; ++j)
#pragma unroll
                        for (int sb = 0; sb < 2; ++sb) { const LAS unsigned char* kp = kp0 + (32 * sb) * QP + (16 * (kq * 4 + j)) * 2; ka[j][sb] = tr_read(kp); kbh[j][sb] = tr_read(kp + 4 * QP); }
                    asm volatile("" : "+v"(ka[0][0]), "+v"(ka[0][1]), "+v"(ka[1][0]), "+v"(ka[1][1]), "+v"(ka[2][0]), "+v"(ka[2][1]), "+v"(ka[3][0]), "+v"(ka[3][1]),
                                      "+v"(kbh[0][0]), "+v"(kbh[0][1]), "+v"(kbh[1][0]), "+v"(kbh[1][1]), "+v"(kbh[2][0]), "+v"(kbh[2][1]), "+v"(kbh[3][0]), "+v"(kbh[3][1]) :: "memory");
#pragma unroll
                    for (int j = 0; j < 4; ++j) { const int kt = kq * 4 + j;
                        st[kt] = st[kt] * dC;
                        st[kt] = MFMA32(cat8(ka[j][0], kbh[j][0]), vz[0], st[kt]);
                        st[kt] = MFMA32(cat8(ka[j][1], kbh[j][1]), vz[1], st[kt]); }
                }
            }
        }
        LDS_BARRIER();
    }
}

__device__ __forceinline__ void hgrn_fast(const int tid, LAS unsigned char* lds, const bf16* QD, const bf16* KI, const bf16* GG, const bf16* VV, const float* DEC, const float* ng, bf16* A2, float* SS) {
    constexpr int TP = 272;
    constexpr int OFF_QD = 0, OFF_KI = 64 * TP, OFF_G = 2 * 64 * TP, OFF_V = 3 * 64 * TP, OFF_DEC = 4 * 64 * TP, OFF_SS = OFF_DEC + 2048;
    const int lane = tid & 63, w = __builtin_amdgcn_readfirstlane(tid >> 6), r = lane & 15, g = lane >> 4, q4 = (lane & 15) >> 2, p4 = lane & 3;
    const int prow = tid >> 3, pc = tid & 7;
    for (int un = blockIdx.x; un < NBATCH * HG_HEADS; un += gridDim.x) {
        const int b = un >> 3, h = un & 7;
        f32x4 st[8];
#pragma unroll
        for (int i = 0; i < 8; ++i) st[i] = (f32x4){0.f, 0.f, 0.f, 0.f};
        const f32x4 ng4 = *(const f32x4*)(ng + h * 128 + 16 * w + 4 * g);
        const size_t goff = (size_t)(b * SEQ + prow) * DM + h * 128;
        v4u p0[2], p1[2], p2[2], p3[2]; f32x4 pd = {0.f, 0.f, 0.f, 0.f};
#pragma unroll
        for (int j = 0; j < 2; ++j) { const size_t o = goff + (pc + 8 * j) * 8; p0[j] = *(const v4u*)(QD + o); p1[j] = *(const v4u*)(KI + o); p2[j] = *(const v4u*)(GG + o); p3[j] = *(const v4u*)(VV + o); }
        if (tid < 128) pd = *(const f32x4*)(DEC + (size_t)((b * SEQ) / 16 + (tid >> 5)) * DM + h * 128 + (tid & 31) * 4);
#pragma unroll 1
        for (int rd = 0; rd < SEQ / 64; ++rd) {
            LDS_BARRIER();
            if (rd > 0 && tid < 64) {
                float s = 0.f;
#pragma unroll
                for (int ww = 0; ww < 8; ++ww) s += *(const LAS float*)(lds + OFF_SS + (ww * 64 + tid) * 4);
                SS[(size_t)h * NTOK + (size_t)b * SEQ + (rd - 1) * 64 + tid] = s;
            }
#pragma unroll
            for (int j = 0; j < 2; ++j) { const int lo = prow * TP + (pc + 8 * j) * 16; *(LAS v4u*)(lds + OFF_QD + lo) = p0[j]; *(LAS v4u*)(lds + OFF_KI + lo) = p1[j]; *(LAS v4u*)(lds + OFF_G + lo) = p2[j]; *(LAS v4u*)(lds + OFF_V + lo) = p3[j]; }
            if (tid < 128) *(LAS f32x4*)(lds + OFF_DEC + tid * 16) = pd;
            if (rd + 1 < SEQ / 64) {
                const size_t gn = goff + (size_t)(rd + 1) * 64 * DM;
#pragma unroll
                for (int j = 0; j < 2; ++j) { const size_t o = gn + (pc + 8 * j) * 8; p0[j] = *(const v4u*)(QD + o); p1[j] = *(const v4u*)(KI + o); p2[j] = *(const v4u*)(GG + o); p3[j] = *(const v4u*)(VV + o); }
                if (tid < 128) pd = *(const f32x4*)(DEC + (size_t)((b * SEQ + (rd + 1) * 64) / 16 + (tid >> 5)) * DM + h * 128 + (tid & 31) * 4);
            }
            LDS_BARRIER();
#pragma unroll 1
            for (int cc = 0; cc < 4; ++cc) {
                s16x4 ql[4], qh[4], kl[4], kh[4], ktr[8]; f32x4 d4[8];
#pragma unroll
                for (int kb = 0; kb < 4; ++kb) {
                    const int off = (16 * cc + r) * TP + (32 * kb + 4 * g) * 2;
                    ql[kb] = *(const LAS s16x4*)(lds + OFF_QD + off); qh[kb] = *(const LAS s16x4*)(lds + OFF_QD + off + 32);
                    kl[kb] = *(const LAS s16x4*)(lds + OFF_KI + off); kh[kb] = *(const LAS s16x4*)(lds + OFF_KI + off + 32);
                }
                s16x4 vfr = tr_read(lds + OFF_V + (16 * cc + 4 * g + q4) * TP + (16 * w + 4 * p4) * 2);
                s16x4 gfr = *(const LAS s16x4*)(lds + OFF_G + (16 * cc + r) * TP + (16 * w + 4 * g) * 2);
#pragma unroll
                for (int kt = 0; kt < 8; ++kt) {
                    d4[kt] = *(const LAS f32x4*)(lds + OFF_DEC + cc * 512 + (16 * kt + 4 * g) * 4);
                    ktr[kt] = tr_read(lds + OFF_KI + (16 * cc + 4 * g + q4) * TP + (16 * kt + 4 * p4) * 2);
                }
                asm volatile("" : "+v"(ql[0]), "+v"(ql[1]), "+v"(ql[2]), "+v"(ql[3]), "+v"(qh[0]), "+v"(qh[1]), "+v"(qh[2]), "+v"(qh[3]),
                                  "+v"(kl[0]), "+v"(kl[1]), "+v"(kl[2]), "+v"(kl[3]), "+v"(kh[0]), "+v"(kh[1]), "+v"(kh[2]), "+v"(kh[3]), "+v"(vfr), "+v"(gfr));
                asm volatile("" : "+v"(ktr[0]), "+v"(ktr[1]), "+v"(ktr[2]), "+v"(ktr[3]), "+v"(ktr[4]), "+v"(ktr[5]), "+v"(ktr[6]), "+v"(ktr[7]),
                                  "+v"(d4[0]), "+v"(d4[1]), "+v"(d4[2]), "+v"(d4[3]), "+v"(d4[4]), "+v"(d4[5]), "+v"(d4[6]), "+v"(d4[7]));
                bf16x8 qf[4];
#pragma unroll
                for (int kb = 0; kb < 4; ++kb) qf[kb] = cat8(ql[kb], qh[kb]);
                f32x4 sc = {0.f, 0.f, 0.f, 0.f}, oa = {0.f, 0.f, 0.f, 0.f};
#pragma unroll
                for (int kb = 0; kb < 4; ++kb) sc = MFMA32(cat8(kl[kb], kh[kb]), qf[kb], sc);
#pragma unroll
                for (int kb = 0; kb < 4; ++kb) oa = MFMA32(pack8(st[2 * kb], st[2 * kb + 1]), qf[kb], oa);
#pragma unroll
                for (int kt = 0; kt < 8; ++kt) st[kt] = MFMA16(ktr[kt], vfr, st[kt]) * d4[kt];
#pragma unroll
                for (int i = 0; i < 4; ++i) sc[i] = (4 * g + i <= r) ? sc[i] : 0.f;
                oa = MFMA16(vfr, pack4(sc), oa);
                { const v2u gr = __builtin_bit_cast(v2u, gfr);
                  v2u ow; ow.x = cvtpk(oa[0] * ng4[0] * bflo(gr.x), oa[1] * ng4[1] * bfhi(gr.x)); ow.y = cvtpk(oa[2] * ng4[2] * bflo(gr.y), oa[3] * ng4[3] * bfhi(gr.y));
                  *(v2u*)(A2 + (size_t)(b * SEQ + rd * 64 + cc * 16 + r) * DM + h * 128 + 16 * w + 4 * g) = ow;
                  float p = (oa[0] * oa[0] + oa[1] * oa[1]) + (oa[2] * oa[2] + oa[3] * oa[3]);
                  p += __shfl_xor(p, 16); p += __shfl_xor(p, 32);
                  if (lane < 16) *(LAS float*)(lds + OFF_SS + (w * 64 + cc * 16 + r) * 4) = p; }
            }
        }
        LDS_BARRIER();
        if (tid < 64) { float s = 0.f;
#pragma unroll
            for (int ww = 0; ww < 8; ++ww) s += *(const LAS float*)(lds + OFF_SS + (ww * 64 + tid) * 4);
            SS[(size_t)h * NTOK + (size_t)b * SEQ + (SEQ / 64 - 1) * 64 + tid] = s; }
        LDS_BARRIER();
    }
}

struct Args { const float* in[17]; float* out; unsigned char* ws; int ph_lo, ph_hi; };
enum { I_X = 0, I_HWIN, I_HNG, I_HWOUT, I_LB, I_RWIN, I_RWOUT, I_LNMG, I_LNMB, I_LNFG, I_LNFB, I_RW, I_RB, I_WGU, I_BGU, I_WDN, I_BDN };

__device__ __forceinline__ int dest_row(int mode, int n) {
    if (mode == 1) { if (n < 1024) return ((n >> 7) << 8) + (n & 127); if (n < 2048) { const int q = n - 1024; return ((q >> 7) << 8) + 128 + (q & 127); } return n; }
    if (mode == 2) { const int j2 = n >> 1; return ((j2 >> 7) << 8) + ((n & 1) << 7) + (j2 & 127); }
    return n;
}
__device__ __forceinline__ void transpose_item(const float* W, int K, int N, bf16* WT, int mode, LAS float* scr, int item, int lane) {
    const int nblk = N / 64, kb = item / nblk, nb = item % nblk, k0 = 64 * kb, n0 = 64 * nb;
#pragma unroll 4
    for (int i = 0; i < 16; ++i) { const int kk = 4 * i + (lane >> 4), c4 = (lane & 15) * 4;
        const f32x4 v = *(const GAS f32x4*)(W + (size_t)(k0 + kk) * N + n0 + c4);
        LAS float* s = scr + kk * 65 + c4; s[0] = v[0]; s[1] = v[1]; s[2] = v[2]; s[3] = v[3]; }
    LDS_WAIT(); asm volatile("" ::: "memory");
    const int c = lane & 7;
#pragma unroll 2
    for (int j = 0; j < 8; ++j) { const int n = (lane >> 3) + 8 * j; const LAS float* s = scr + (8 * c) * 65 + n;
        v4u o; o.x = pk2(s[0 * 65], s[1 * 65]); o.y = pk2(s[2 * 65], s[3 * 65]); o.z = pk2(s[4 * 65], s[5 * 65]); o.w = pk2(s[6 * 65], s[7 * 65]);
        *(GAS v4u*)(WT + (size_t)dest_row(mode, n0 + n) * K + k0 + 8 * c) = o; }
    LDS_WAIT(); asm volatile("" ::: "memory");
}

__device__ __forceinline__ void transpose_item_fp8(const float* W, int K, int N, unsigned char* WT, int mode, float scale, LAS float* scr, int item, int lane) {
    const int nblk = N / 64, kb = item / nblk, nb = item % nblk, k0 = 64 * kb, n0 = 64 * nb;
#pragma unroll 4
    for (int i = 0; i < 16; ++i) { const int kk = 4 * i + (lane >> 4), c4 = (lane & 15) * 4;
        const f32x4 v = *(const GAS f32x4*)(W + (size_t)(k0 + kk) * N + n0 + c4);
        LAS float* s = scr + kk * 65 + c4; s[0] = v[0]; s[1] = v[1]; s[2] = v[2]; s[3] = v[3]; }
    LDS_WAIT(); asm volatile("" ::: "memory");
    const int c = lane & 7;
#pragma unroll 2
    for (int j = 0; j < 8; ++j) { const int n = (lane >> 3) + 8 * j; const LAS float* s = scr + (8 * c) * 65 + n;
        v2u o; o.x = pk4_fp8(s[0 * 65] * scale, s[1 * 65] * scale, s[2 * 65] * scale, s[3 * 65] * scale); o.y = pk4_fp8(s[4 * 65] * scale, s[5 * 65] * scale, s[6 * 65] * scale, s[7 * 65] * scale);
        *(GAS v2u*)(WT + (size_t)dest_row(mode, n0 + n) * K + k0 + 8 * c) = o; }
    LDS_WAIT(); asm volatile("" ::: "memory");
}

#ifndef SITE_MASK
#define SITE_MASK 0xffff
#endif
#define SITE(n) (((SITE_MASK) >> (n)) & 1)
#ifndef PROBE_MASK
#define PROBE_MASK 0
#endif
#define REP(n) (1 + (((PROBE_MASK) >> (n)) & 1))
typedef const __attribute__((address_space(4))) Args* KArgs;
__device__ __forceinline__ int otid(int wave0) { int l; asm volatile("v_mbcnt_lo_u32_b32 %0, -1, 0\n\tv_mbcnt_hi_u32_b32 %0, -1, %0" : "=v"(l)); asm volatile("" : "+s"(wave0)); return wave0 * 64 + l; }
__device__ __forceinline__ LAS unsigned char* olds(LAS unsigned char* p) { asm volatile("" : "+s"(p)); return p; }
__device__ __forceinline__ KArgs kargs() { KArgs p = (KArgs)__builtin_amdgcn_kernarg_segment_ptr(); asm volatile("" : "+s"(p)); return p; }
#define IN(k) (ap->ph_lo <= (k) && (k) < ap->ph_hi)
#ifndef PROBE_BAR
#define PROBE_BAR 1
#endif
#define GRID_BAR() for (int _r = 0; _r < PROBE_BAR; ++_r) do { if (ap->ph_hi - ap->ph_lo > 1) { XcdBarrier _b; _b.bar = (unsigned*)(ap->ws + WS_CTL) + CW_BAR; _b.x = xb_xcc_id(); _b.st = (volatile LAS unsigned*)(lds + MISC_OFF + MO_BARW); xcd_barrier(_b); } } while (0)
#define VCU() ((gridDim.x % 8 == 0) ? (int)((blockIdx.x % 8) * (gridDim.x / 8) + blockIdx.x / 8) : (int)blockIdx.x)

__global__ void __launch_bounds__(512, 2) mk_fwd(Args args_unused) {
    extern __shared__ __attribute__((aligned(16))) unsigned char lds_raw[];
    LAS unsigned char* const lds0 = (LAS unsigned char*)lds_raw;
    const int wave0 = __builtin_amdgcn_readfirstlane((int)(threadIdx.x >> 6));
    {
        LAS unsigned char* lds = lds0;
        for (int u = threadIdx.x; u < (LDS_BYTES - MISC_OFF) / 4; u += 512) ((LAS unsigned*)(lds + MISC_OFF))[u] = 0u;
        __syncthreads();
        KArgs ap = kargs();
        if (ap->ph_hi - ap->ph_lo > 1) (void)xcd_barrier_post((unsigned*)(ap->ws + WS_CTL) + CW_BAR, (volatile LAS unsigned*)(lds + MISC_OFF + MO_BARW));
    }

#if SITE(0)
    { KArgs ap = kargs(); const int tid = otid(wave0); LAS unsigned char* lds = olds(lds0); (void)tid;
    if (IN(0)) for (int rep_ = 0; rep_ < REP(0); ++rep_) {
        const int lane = tid & 63, wave = __builtin_amdgcn_readfirstlane(tid >> 6), G = gridDim.x, vcu = VCU(), gw = vcu * 8 + wave, NGW = G * 8;
        unsigned char* ws = ap->ws;
        LAS float* scr = (LAS float*)(lds + wave * 16640);
        constexpr int I_HIN = 2 * 16 * 64, I_HOUT = 2 * 16 * 16, I_RIN = 2 * 16 * 96, I_ROUT = 2 * 32 * 16, I_GU = 128 * 16 * 32, I_DN = 128 * 16 * 16;
        constexpr int NITEMS = I_HIN + I_HOUT + I_RIN + I_ROUT + I_GU + I_DN;
        for (int it = gw; it < NITEMS; it += NGW) {
            int r = it;
            if (r < I_HIN) { const int j = r / (16 * 64); transpose_item(ap->in[I_HWIN] + (size_t)j * DM * HG_IN, DM, HG_IN, (bf16*)(ws + WS_W_HIN) + (size_t)j * HG_IN * DM, 1, scr, r % (16 * 64), lane); continue; } r -= I_HIN;
            if (r < I_HOUT) { const int j = r / 256; transpose_item(ap->in[I_HWOUT] + (size_t)j * DM * DM, DM, DM, (bf16*)(ws + WS_W_HOUT) + (size_t)j * DM * DM, 0, scr, r % 256, lane); continue; } r -= I_HOUT;
            if (r < I_RIN) { const int j = r / (16 * 96); transpose_item(ap->in[I_RWIN] + (size_t)j * DM * RT_IN, DM, RT_IN, (bf16*)(ws + WS_W_RIN) + (size_t)j * RT_IN * DM, 0, scr, r % (16 * 96), lane); continue; } r -= I_RIN;
            if (r < I_ROUT) { const int j = r / 512; transpose_item(ap->in[I_RWOUT] + (size_t)j * RT_VD * DM, RT_VD, DM, (bf16*)(ws + WS_W_ROUT) + (size_t)j * DM * RT_VD, 0, scr, r % 512, lane); continue; } r -= I_ROUT;
#if MOE_FP8
            if (r < I_GU) { const int j = r / 512; transpose_item_fp8(ap->in[I_WGU] + (size_t)j * DM * 2048, DM, 2048, ws + WS_W_GU + (size_t)j * 2048 * DM, 2, WGU_SCALE, scr, r % 512, lane); continue; } r -= I_GU;
            { const int j = r / 256; transpose_item_fp8(ap->in[I_WDN] + (size_t)j * DM * DM, DM, DM, ws + WS_W_DN + (size_t)j * DM * DM, 0, WDN_SCALE, scr, r % 256, lane); }
#else
            if (r < I_GU) { const int j = r / 512; transpose_item(ap->in[I_WGU] + (size_t)j * DM * 2048, DM, 2048, (bf16*)(ws + WS_W_GU) + (size_t)j * 2048 * DM, 2, scr, r % 512, lane); continue; } r -= I_GU;
            { const int j = r / 256; transpose_item(ap->in[I_WDN] + (size_t)j * DM * DM, DM, DM, (bf16*)(ws + WS_W_DN) + (size_t)j * DM * DM, 0, scr, r % 256, lane); }
#endif
        }
        const int gt = vcu * 512 + tid, NGT = G * 512;
        float* LBS = (float*)(ws + WS_LBS); float* BGU = (float*)(ws + WS_BGU); float* ROT = (float*)(ws + WS_ROT); bf16* XB = (bf16*)(ws + WS_XB);
        for (int d = gt; d < DM; d += NGT) { const float* lbp = ap->in[I_LB]; const float v0 = lbp[d], v1 = lbp[DM + d], v2 = lbp[2 * DM + d], v3 = lbp[3 * DM + d]; const float mx = fmaxf(fmaxf(v0, v1), fmaxf(v2, v3));
            const float e0 = __expf(v0 - mx), e1 = __expf(v1 - mx), e2 = __expf(v2 - mx), e3 = __expf(v3 - mx), is = 1.0f / (e0 + e1 + e2 + e3);
            LBS[d] = 0.f; LBS[DM + d] = e1 * is; LBS[2 * DM + d] = (e1 + e2) * is; LBS[3 * DM + d] = (e1 + e2 + e3) * is; }
        for (int i = gt; i < SEQ * 128; i += NGT) { const int pos = i >> 7, p = i & 127; const float inv = 1.0f / __builtin_amdgcn_exp2f(13.287712379549449f * ((float)p / 127.0f)); const float th = (float)pos * inv;
            double rev = (double)th * 0.15915494309189535; rev -= floor(rev); const float fr = (float)rev; ROT[2 * i] = __builtin_amdgcn_cosf(fr); ROT[2 * i + 1] = __builtin_amdgcn_sinf(fr); }
        for (int i = gt; i < 4 * DM * NE; i += NGT) { const int l = i >> 15, d = (i >> 5) & 1023, e = i & 31; const float wv = ap->in[I_RW][i]; const unsigned hb = f2bf(wv); const float hv = __builtin_bit_cast(float, hb << 16);
            ((bf16*)(ws + WS_WRH))[(size_t)l * 32768 + e * 1024 + d] = (bf16)hb; ((bf16*)(ws + WS_WRL))[(size_t)l * 32768 + e * 1024 + d] = (bf16)f2bf(wv - hv); }
        for (int i = gt; i < 4 * 32 * 2048; i += NGT) { const int le = i >> 11, n = i & 2047; BGU[(size_t)le * 2048 + dest_row(2, n)] = ap->in[I_BGU][i]; }
        for (size_t i = (size_t)gt; i < (size_t)NTOK * DM / 4; i += NGT) { const f32x4 v = ((const f32x4*)ap->in[I_X])[i]; v2u o; o.x = pk2(v[0], v[1]); o.y = pk2(v[2], v[3]); ((v2u*)XB)[i] = o; }
        GRID_BAR();
    } }
#endif

#pragma unroll 1
    for (int L = 0; L < DEPTH; ++L) {
        const int pb = 1 + 8 * L;
        if ((L & 1) == 0) {
#if SITE(1)
            { KArgs ap = kargs(); const int tid = otid(wave0); LAS unsigned char* lds = olds(lds0); (void)tid;
            if (IN(pb + 0)) for (int rep_ = 0; rep_ < REP(1); ++rep_) {
                unsigned char* ws = ap->ws; const int j = L >> 1;
                LAS int* ul = (LAS int*)(lds + MISC_OFF + MO_ULIST);
                pg8::build_units_dense(tid, ul, NTOK / 256, HG_IN / 256, DM * 2);
                pg8::EpiHgrnIn E{ws, L};
                pg8::gemm_phase<pg8::EpiHgrnIn, false, true, false>(tid, lds, ul, (LAS int*)(lds + MISC_OFF + MO_GTAB), (const char*)(ws + WS_XB), (const char*)((bf16*)(ws + WS_W_HIN) + (size_t)j * HG_IN * DM), nullptr, DM * 2, E);
                GRID_BAR();
            } }
#endif
#if SITE(2)
            { KArgs ap = kargs(); const int tid = otid(wave0); LAS unsigned char* lds = olds(lds0); (void)tid;
            if (IN(pb + 1)) for (int rep_ = 0; rep_ < REP(2); ++rep_) {
#if !SLOW_HGRN
                { unsigned char* ws = ap->ws; const bf16* QD = (const bf16*)(ws + WS_H);
                  hgrn_fast(tid, lds, QD, QD + (size_t)NTOK * DM, QD + 4 * (size_t)NTOK * DM, QD + 3 * (size_t)NTOK * DM, (const float*)(ws + WS_DEC), ap->in[I_HNG] + (L >> 1) * DM,
                            (bf16*)(ws + WS_A2), (float*)(ws + WS_SSP)); }
#else
                unsigned char* ws = ap->ws; const bf16* QD = (const bf16*)(ws + WS_H); const bf16* KI = QD + (size_t)NTOK * DM; const bf16* KS = QD + 2 * (size_t)NTOK * DM; const bf16* VV = QD + 3 * (size_t)NTOK * DM; bf16* OB = (bf16*)(ws + WS_O);
                LAS float* qf = (LAS float*)lds; LAS float* kf = qf + 16 * 4 * 36; LAS float* ff = kf + 16 * 4 * 36; LAS float* vf = ff + 16 * 4 * 36;
                for (int un = blockIdx.x; un < NBATCH * HG_HEADS; un += gridDim.x) {
                    const int b = un >> 3, h = un & 7; const int vc = tid >> 2, kq = tid & 3;
                    float st[32];
#pragma unroll
                    for (int i = 0; i < 32; ++i) st[i] = 0.f;
                    for (int t0 = 0; t0 < SEQ; t0 += 16) {
                        __syncthreads();
                        for (int e = tid; e < 16 * 128; e += 512) { const int tt = e >> 7, k = e & 127; const size_t gi = (size_t)(b * SEQ + t0 + tt) * DM + h * 128 + k; const int li = tt * 144 + (k & 3) * 36 + (k >> 2);
                            qf[li] = bf1(QD[gi]); kf[li] = bf1(KI[gi]); ff[li] = bf1(KS[gi]); vf[tt * 128 + k] = bf1(VV[gi]); }
                        __syncthreads();
                        for (int tt = 0; tt < 16; ++tt) {
                            const float v = vf[tt * 128 + vc]; float a = 0.f; const int lb = tt * 144 + kq * 36;
#pragma unroll
                            for (int i = 0; i < 32; ++i) { st[i] = ff[lb + i] * st[i] + kf[lb + i] * v; a += qf[lb + i] * st[i]; }
                            a += __shfl_xor(a, 1); a += __shfl_xor(a, 2);
                            if (kq == 0) OB[(size_t)(b * SEQ + t0 + tt) * DM + h * 128 + vc] = (bf16)f2bf(a);
                        }
                    }
                }
#endif
                GRID_BAR();
            } }
#endif
#if SITE(3) && SLOW_HGRN
            { KArgs ap = kargs(); const int tid = otid(wave0); LAS unsigned char* lds = olds(lds0); (void)tid;
            if (IN(pb + 2)) for (int rep_ = 0; rep_ < REP(3); ++rep_) {
                const int lane = tid & 63, wave = __builtin_amdgcn_readfirstlane(tid >> 6), gw = VCU() * 8 + wave, NGW = gridDim.x * 8;
                unsigned char* ws = ap->ws; const bf16* OB = (const bf16*)(ws + WS_O); const bf16* GG = (const bf16*)(ws + WS_H) + 4 * (size_t)NTOK * DM; bf16* A2 = (bf16*)(ws + WS_A2);
                const float* ng = ap->in[I_HNG] + (L >> 1) * DM;
                f32x4 g4[4];
#pragma unroll
                for (int q = 0; q < 4; ++q) g4[q] = *(const f32x4*)(ng + 256 * q + 4 * lane);
                v2u on[4], gn[4];
#pragma unroll
                for (int q = 0; q < 4; ++q) { on[q] = *(const v2u*)(OB + (size_t)gw * DM + 256 * q + 4 * lane); gn[q] = *(const v2u*)(GG + (size_t)gw * DM + 256 * q + 4 * lane); }
#pragma unroll 1
                for (int row = gw; row < NTOK; row += NGW) {
                    v2u oc[4], gc[4];
#pragma unroll
                    for (int q = 0; q < 4; ++q) { oc[q] = on[q]; gc[q] = gn[q]; }
                    if (row + NGW < NTOK) {
#pragma unroll
                        for (int q = 0; q < 4; ++q) { on[q] = *(const v2u*)(OB + (size_t)(row + NGW) * DM + 256 * q + 4 * lane); gn[q] = *(const v2u*)(GG + (size_t)(row + NGW) * DM + 256 * q + 4 * lane); } }
                    float o[16]; float ss = 0.f;
#pragma unroll
                    for (int q = 0; q < 4; ++q) { o[4 * q] = bflo(oc[q].x); o[4 * q + 1] = bfhi(oc[q].x); o[4 * q + 2] = bflo(oc[q].y); o[4 * q + 3] = bfhi(oc[q].y); }
#pragma unroll
                    for (int i = 0; i < 16; ++i) ss += o[i] * o[i];
                    const float rs = 1.0f / sqrtf(wave_sum(ss) * (1.0f / DM) + RMS_EPS);
#pragma unroll
                    for (int q = 0; q < 4; ++q) {
                        v2u w; w.x = pk2(o[4 * q] * rs * g4[q][0] * bflo(gc[q].x), o[4 * q + 1] * rs * g4[q][1] * bfhi(gc[q].x)); w.y = pk2(o[4 * q + 2] * rs * g4[q][2] * bflo(gc[q].y), o[4 * q + 3] * rs * g4[q][3] * bfhi(gc[q].y));
                        *(v2u*)(A2 + (size_t)row * DM + 256 * q + 4 * lane) = w; }
                }
                GRID_BAR();
            } }
#endif
        } else {
#if SITE(4)
            { KArgs ap = kargs(); const int tid = otid(wave0); LAS unsigned char* lds = olds(lds0); (void)tid;
            if (IN(pb + 0)) for (int rep_ = 0; rep_ < REP(4); ++rep_) {
                unsigned char* ws = ap->ws; const int j = L >> 1;
                LAS int* ul = (LAS int*)(lds + MISC_OFF + MO_ULIST);
                pg8::build_units_dense(tid, ul, NTOK / 256, RT_IN / 256, DM * 2);
                pg8::EpiRetIn E{ws};
                pg8::gemm_phase<pg8::EpiRetIn, false, true, false>(tid, lds, ul, (LAS int*)(lds + MISC_OFF + MO_GTAB), (const char*)(ws + WS_XB), (const char*)((bf16*)(ws + WS_W_RIN) + (size_t)j * RT_IN * DM), nullptr, DM * 2, E);
                GRID_BAR();
            } }
#endif
#if SITE(5)
            { KArgs ap = kargs(); const int tid = otid(wave0); LAS unsigned char* lds = olds(lds0); (void)tid;
            if (IN(pb + 1)) for (int rep_ = 0; rep_ < REP(5); ++rep_) {
#if !SLOW_RET
                { unsigned char* ws = ap->ws; ret_fast(tid, lds, (const bf16*)(ws + WS_H), (bf16*)(ws + WS_O)); }
#else
                unsigned char* ws = ap->ws; const bf16* HB = (const bf16*)(ws + WS_H); bf16* OB = (bf16*)(ws + WS_O);
                LAS float* qf = (LAS float*)lds; LAS float* kf = qf + 16 * 4 * 68; LAS float* vf = kf + 16 * 4 * 68;
                for (int un = blockIdx.x; un < NBATCH * RT_HEADS * 4; un += gridDim.x) {
                    const int b = un >> 4, h = (un >> 2) & 3, vq = un & 3; const int vc = tid >> 2, kq = tid & 3;
                    const float gam = 1.0f - exp2f(-5.0f - (float)h);
                    float st[64];
#pragma unroll
                    for (int i = 0; i < 64; ++i) st[i] = 0.f;
                    for (int t0 = 0; t0 < SEQ; t0 += 16) {
                        __syncthreads();
                        for (int e = tid; e < 16 * 256; e += 512) { const int tt = e >> 8, k = e & 255; const size_t gi = (size_t)(b * SEQ + t0 + tt) * RT_IN + h * 256 + k; const int li = tt * 272 + (k & 3) * 68 + (k >> 2);
                            qf[li] = bf1(HB[gi]); kf[li] = bf1(HB[gi + 1024]); }
                        for (int e = tid; e < 16 * 128; e += 512) { const int tt = e >> 7, c = e & 127; vf[e] = bf1(HB[(size_t)(b * SEQ + t0 + tt) * RT_IN + 2048 + h * 512 + vq * 128 + c]); }
                        __syncthreads();
                        for (int tt = 0; tt < 16; ++tt) {
                            const float v = vf[tt * 128 + vc]; float a = 0.f; const int lb = tt * 272 + kq * 68;
#pragma unroll
                            for (int i = 0; i < 64; ++i) { st[i] = gam * st[i] + kf[lb + i] * v; a += qf[lb + i] * st[i]; }
                            a += __shfl_xor(a, 1); a += __shfl_xor(a, 2);
                            if (kq == 0) OB[(size_t)(b * SEQ + t0 + tt) * RT_VD + h * 512 + vq * 128 + vc] = (bf16)f2bf(a);
                        }
                    }
                }
#endif
                GRID_BAR();
            } }
#endif
#if SITE(6)
            { KArgs ap = kargs(); const int tid = otid(wave0); LAS unsigned char* lds = olds(lds0); (void)tid;
            if (IN(pb + 2)) for (int rep_ = 0; rep_ < REP(6); ++rep_) {
                const int lane = tid & 63, wave = __builtin_amdgcn_readfirstlane(tid >> 6), gw = VCU() * 8 + wave, NGW = gridDim.x * 8;
                unsigned char* ws = ap->ws; const bf16* OB = (const bf16*)(ws + WS_O); const bf16* HB = (const bf16*)(ws + WS_H); bf16* A2 = (bf16*)(ws + WS_A2);
                v4u on[4], gn[4];
#pragma unroll
                for (int h = 0; h < 4; ++h) { on[h] = *(const v4u*)(OB + (size_t)gw * RT_VD + 512 * h + 8 * lane); gn[h] = *(const v4u*)(HB + (size_t)gw * RT_IN + 4096 + 512 * h + 8 * lane); }
#pragma unroll 1
                for (int row = gw; row < NTOK; row += NGW) {
                    v4u oc[4], gc[4];
#pragma unroll
                    for (int h = 0; h < 4; ++h) { oc[h] = on[h]; gc[h] = gn[h]; }
                    if (row + NGW < NTOK) {
#pragma unroll
                        for (int h = 0; h < 4; ++h) { on[h] = *(const v4u*)(OB + (size_t)(row + NGW) * RT_VD + 512 * h + 8 * lane); gn[h] = *(const v4u*)(HB + (size_t)(row + NGW) * RT_IN + 4096 + 512 * h + 8 * lane); } }
#pragma unroll
                    for (int h = 0; h < 4; ++h) {
                        const v4u w = oc[h];
                        float o[8] = {bflo(w.x), bfhi(w.x), bflo(w.y), bfhi(w.y), bflo(w.z), bfhi(w.z), bflo(w.w), bfhi(w.w)};
                        float s = 0.f;
#pragma unroll
                        for (int i = 0; i < 8; ++i) s += o[i];
                        const float mu = wave_sum(s) * (1.0f / 512.0f); float q = 0.f;
#pragma unroll
                        for (int i = 0; i < 8; ++i) { o[i] -= mu; q += o[i] * o[i]; }
                        const float rs = 1.0f / sqrtf(wave_sum(q) * (1.0f / 512.0f) + LN_EPS);
                        const v4u g = gc[h];
                        v4u r; r.x = pk2(o[0] * rs * bflo(g.x), o[1] * rs * bfhi(g.x)); r.y = pk2(o[2] * rs * bflo(g.y), o[3] * rs * bfhi(g.y));
                        r.z = pk2(o[4] * rs * bflo(g.z), o[5] * rs * bfhi(g.z)); r.w = pk2(o[6] * rs * bflo(g.w), o[7] * rs * bfhi(g.w));
                        *(v4u*)(A2 + (size_t)row * RT_VD + 512 * h + 8 * lane) = r;
                    }
                }
                GRID_BAR();
            } }
#endif
        }
#if SITE(7)
        { KArgs ap = kargs(); const int tid = otid(wave0); LAS unsigned char* lds = olds(lds0); (void)tid;
        if (IN(pb + 3)) for (int rep_ = 0; rep_ < REP(7); ++rep_) {
            unsigned char* ws = ap->ws; const int j = L >> 1; const bool ret = (L & 1) != 0;
            const int Ko = ret ? RT_VD : DM;
            LAS int* ul = (LAS int*)(lds + MISC_OFF + MO_ULIST);
            pg8::build_units_dense(tid, ul, NTOK / 256, DM / 256, Ko * 2);
            const char* Bt = ret ? (const char*)((bf16*)(ws + WS_W_ROUT) + (size_t)j * DM * RT_VD) : (const char*)((bf16*)(ws + WS_W_HOUT) + (size_t)j * DM * DM);
            pg8::EpiRes E{ws, (ret || SLOW_HGRN) ? -1 : 0};
            pg8::gemm_phase<pg8::EpiRes, false, true, false>(tid, lds, ul, (LAS int*)(lds + MISC_OFF + MO_GTAB), (const char*)(ws + WS_A2), Bt, nullptr, Ko * 2, E);
            GRID_BAR();
        } }
#endif
#if SITE(8)
        { KArgs ap = kargs(); const int tid = otid(wave0); LAS unsigned char* lds = olds(lds0); (void)tid;
        if (IN(pb + 4)) for (int rep_ = 0; rep_ < REP(8); ++rep_) {
            const int lane = tid & 63, wave = __builtin_amdgcn_readfirstlane(tid >> 6), r = lane & 15, g = lane >> 4;
            unsigned char* ws = ap->ws; unsigned* ctl = (unsigned*)(ws + WS_CTL);
            const bf16* Y = (const bf16*)(ws + WS_Y); bf16* X1R = (bf16*)(ws + WS_X1F); bf16* X1B = (bf16*)(ws + WS_X1B);
            int* ROWDST = (int*)(ws + WS_ROWDST); float* ROWGATE = (float*)(ws + WS_ROWGATE);
            constexpr int WP = 2064;
            LAS unsigned char* wH = lds; LAS unsigned char* wL = lds + 32 * WP;
            LAS int* lcnt = (LAS int*)(lds + MISC_OFF + MO_LCNT); LAS int* lbase = (LAS int*)(lds + MISC_OFF + MO_LBASE);
            LAS int* sel = (LAS int*)(lds + MISC_OFF + MO_SEL); LAS float* selw = (LAS float*)(lds + MISC_OFF + MO_SELW);
            const float* rb = ap->in[I_RB] + L * NE;
            const float* lg = ap->in[I_LNMG] + L * DM; const float* lbb = ap->in[I_LNMB] + L * DM;
            { const v4u* gh = (const v4u*)(ws + WS_WRH) + (size_t)L * 4096; const v4u* gl = (const v4u*)(ws + WS_WRL) + (size_t)L * 4096;
              for (int c = tid; c < 4096; c += 512) { const int e = c >> 7, cc = c & 127; *(LAS v4u*)(wH + e * WP + cc * 16) = gh[c]; *(LAS v4u*)(wL + e * WP + cc * 16) = gl[c]; } }
            const float rb0 = rb[r], rb1 = rb[16 + r];
            for (int blk = VCU(); blk < NTOK / 128; blk += gridDim.x) {
                if (tid < 32) lcnt[tid] = 0;
                __syncthreads();
                const int row0 = blk * 128 + wave * 16;
                v2u xn[4];
#pragma unroll
                for (int q = 0; q < 4; ++q) xn[q] = *(const v2u*)(Y + (size_t)row0 * DM + 256 * q + 4 * lane);
#pragma unroll 1
                for (int rr = 0; rr < 16; ++rr) {
                    const int row = row0 + rr;
                    f32x4 x[4]; float s = 0.f;
#pragma unroll
                    for (int q = 0; q < 4; ++q) { x[q] = (f32x4){bflo(xn[q].x), bfhi(xn[q].x), bflo(xn[q].y), bfhi(xn[q].y)}; s += (x[q][0] + x[q][1]) + (x[q][2] + x[q][3]); }
                    if (rr + 1 < 16) {
#pragma unroll
                        for (int q = 0; q < 4; ++q) xn[q] = *(const v2u*)(Y + (size_t)(row + 1) * DM + 256 * q + 4 * lane); }
                    const float mu = wave_sum_u(s) * (1.0f / DM); float qq = 0.f;
#pragma unroll
                    for (int q = 0; q < 4; ++q) { x[q] = x[q] - mu; qq += (x[q][0] * x[q][0] + x[q][1] * x[q][1]) + (x[q][2] * x[q][2] + x[q][3] * x[q][3]); }
                    const float rs = 1.0f / sqrtf(wave_sum_u(qq) * (1.0f / DM) + LN_EPS);
#pragma unroll
                    for (int q = 0; q < 4; ++q) { const f32x4 g4 = *(const f32x4*)(lg + 256 * q + 4 * lane), b4 = *(const f32x4*)(lbb + 256 * q + 4 * lane); x[q] = x[q] * rs * g4 + b4;
                        { v2u wr_; wr_.x = pk2(x[q][0], x[q][1]); wr_.y = pk2(x[q][2], x[q][3]); *(v2u*)(X1R + (size_t)row * DM + 256 * q + 4 * lane) = wr_; }
#if MOE_FP8
                        *(unsigned*)((unsigned char*)X1B + (size_t)row * DM + 256 * q + 4 * lane) = pk4_fp8(x[q][0] * X_SCALE, x[q][1] * X_SCALE, x[q][2] * X_SCALE, x[q][3] * X_SCALE); }
#else
                        v2u w; w.x = pk2(x[q][0], x[q][1]); w.y = pk2(x[q][2], x[q][3]); *(v2u*)(X1B + (size_t)row * DM + 256 * q + 4 * lane) = w; }
#endif
                }
                asm volatile("s_waitcnt vmcnt(0)" ::: "memory");
                f32x4 lgt0 = {0.f, 0.f, 0.f, 0.f}, lgt1 = {0.f, 0.f, 0.f, 0.f};
                {
                    const bf16* xa = X1R + (size_t)(row0 + r) * DM + 8 * g;
#pragma unroll 1
                    for (int kq = 0; kq < 4; ++kq) {
                        bf16x8 af[8], h0[8], h1[8], l0[8], l1[8];
#pragma unroll
                        for (int j = 0; j < 8; ++j) { const int kb = kq * 8 + j; af[j] = *(const bf16x8*)(xa + 32 * kb);
                            h0[j] = *(const LAS bf16x8*)(wH + r * WP + (32 * kb + 8 * g) * 2); h1[j] = *(const LAS bf16x8*)(wH + (16 + r) * WP + (32 * kb + 8 * g) * 2);
                            l0[j] = *(const LAS bf16x8*)(wL + r * WP + (32 * kb + 8 * g) * 2); l1[j] = *(const LAS bf16x8*)(wL + (16 + r) * WP + (32 * kb + 8 * g) * 2); }
#pragma unroll
                        for (int j = 0; j < 8; ++j) { lgt0 = MFMA32(af[j], h0[j], lgt0); lgt1 = MFMA32(af[j], h1[j], lgt1); lgt0 = MFMA32(af[j], l0[j], lgt0); lgt1 = MFMA32(af[j], l1[j], lgt1); }
                    }
                }
#pragma unroll
                for (int i = 0; i < 4; ++i) {
                    float v0 = lgt0[i] + rb0, v1 = lgt1[i] + rb1; int se[4]; float sv[4];
#pragma unroll
                    for (int k = 0; k < 4; ++k) {
                        float m = fmaxf(v0, v1);
                        m = fmaxf(m, dppf<0xB1>(m)); m = fmaxf(m, dppf<0x4E>(m)); m = fmaxf(m, dppf<0x141>(m)); m = fmaxf(m, dppf<0x140>(m));
                        int ec = (v0 == m) ? r : ((v1 == m) ? 16 + r : 99);
                        ec = min(ec, dppi<0xB1>(ec)); ec = min(ec, dppi<0x4E>(ec)); ec = min(ec, dppi<0x141>(ec)); ec = min(ec, dppi<0x140>(ec));
                        se[k] = ec; sv[k] = m;
                        if (ec == r) v0 = -3.0e38f;
                        if (ec == 16 + r) v1 = -3.0e38f;
                    }
                    const float e1 = __expf(sv[1] - sv[0]), e2 = __expf(sv[2] - sv[0]), e3 = __expf(sv[3] - sv[0]); const float inv = 1.0f / (1.0f + e1 + e2 + e3);
                    if (r < 4) { const int rloc = wave * 16 + 4 * g + i; const int ee = r == 0 ? se[0] : (r == 1 ? se[1] : (r == 2 ? se[2] : se[3])); const float ww = (r == 0 ? 1.0f : (r == 1 ? e1 : (r == 2 ? e2 : e3))) * inv;
                        sel[rloc * 4 + r] = ee; selw[rloc * 4 + r] = ww; }
                }
                __syncthreads();
                const int myE = sel[tid]; const int rank = __hip_atomic_fetch_add(lcnt + myE, 1, __ATOMIC_RELAXED, __HIP_MEMORY_SCOPE_WORKGROUP);
                __syncthreads();
                if (tid < 32) lbase[tid] = (int)__hip_atomic_fetch_add(ctl + CW_ECNT + (L + 4 * rep_) * 32 + tid, (unsigned)lcnt[tid], RLX_AGENT);
                __syncthreads();
                { const int pos = lbase[myE] + rank; const size_t ti = (size_t)myE * ECAP + pos; ROWDST[ti] = (blk * 128 + (tid >> 2)) * 4 + (tid & 3); ROWGATE[ti] = selw[tid]; }
                __syncthreads();
            }
            GRID_BAR();
        } }
#endif
#if SITE(9)
        { KArgs ap = kargs(); const int tid = otid(wave0); LAS unsigned char* lds = olds(lds0); (void)tid;
        if (IN(pb + 5)) for (int rep_ = 0; rep_ < REP(9); ++rep_) {
            unsigned char* ws = ap->ws; unsigned* ctl = (unsigned*)(ws + WS_CTL);
            LAS int* tpre = (LAS int*)(lds + MISC_OFF + MO_TPRE); LAS int* ebase = (LAS int*)(lds + MISC_OFF + MO_EBASE); LAS int* ecnt = (LAS int*)(lds + MISC_OFF + MO_ECNT);
            if (tid < NE) ecnt[tid] = (int)__hip_atomic_load(ctl + CW_ECNT + L * 32 + tid, RLX_AGENT);
            __syncthreads();
            if (tid == 0) { int t = 0;
_Pragma("unroll 1")
 for (int e = 0; e < NE; ++e) { const int c = ecnt[e]; tpre[e] = t; ebase[e] = t * 256; t += (c + 255) >> 8; } tpre[NE] = t; }
            __syncthreads();
            LAS int* ul = (LAS int*)(lds + MISC_OFF + MO_ULIST);
            constexpr int EB = MOE_FP8 ? 1 : 2;
            pg8::build_units_moe(tid, ul, tpre, ebase, ecnt, 8, DM * EB, 2048u * DM * EB);
            { LAS int* gall = (LAS int*)(lds + MISC_OFF + MO_GALL); const int* rd = (const int*)(ws + WS_ROWDST);
              for (int i = tid; i < GALL_UNITS * 256; i += 512) { const int uu = i >> 8, rr = i & 255;
                  if (ul[uu * 8 + 0]) gall[i] = (int)((unsigned)rd[ul[uu * 8 + 7] + min(rr, ul[uu * 8 + 5] - 1)] >> 2); }
              __syncthreads(); }
            pg8::EpiMoeGU E{ws, L};
            pg8::gemm_phase<pg8::EpiMoeGU, true, true, MOE_FP8 != 0>(tid, lds, ul, (LAS int*)(lds + MISC_OFF + MO_GALL), (const char*)(ws + WS_X1B), (const char*)(ws + WS_W_GU + (size_t)L * NE * 2048 * DM * EB), (const int*)(ws + WS_ROWDST), DM * EB, E);
            GRID_BAR();
        } }
#endif
#if SITE(10)
        { KArgs ap = kargs(); const int tid = otid(wave0); LAS unsigned char* lds = olds(lds0); (void)tid;
        if (IN(pb + 6)) for (int rep_ = 0; rep_ < REP(10); ++rep_) {
            unsigned char* ws = ap->ws; unsigned* ctl = (unsigned*)(ws + WS_CTL);
            LAS int* tpre = (LAS int*)(lds + MISC_OFF + MO_TPRE); LAS int* ebase = (LAS int*)(lds + MISC_OFF + MO_EBASE); LAS int* ecnt = (LAS int*)(lds + MISC_OFF + MO_ECNT);
            __syncthreads();
            if (tid < NE) ecnt[tid] = (int)__hip_atomic_load(ctl + CW_ECNT + L * 32 + tid, RLX_AGENT);
            __syncthreads();
            if (tid == 0) { int t = 0;
_Pragma("unroll 1")
 for (int e = 0; e < NE; ++e) { const int c = ecnt[e]; tpre[e] = t; ebase[e] = t * 256; t += (c + 255) >> 8; } tpre[NE] = t; }
            __syncthreads();
            LAS int* ul = (LAS int*)(lds + MISC_OFF + MO_ULIST);
            constexpr int EB = MOE_FP8 ? 1 : 2;
            pg8::build_units_moe(tid, ul, tpre, ebase, ecnt, 4, DM * EB, (unsigned)DM * DM * EB);
            pg8::EpiMoeDown E{ws, ap->in[I_BDN] + (size_t)L * NE * DM};
            pg8::gemm_phase<pg8::EpiMoeDown, false, true, MOE_FP8 != 0>(tid, lds, ul, (LAS int*)(lds + MISC_OFF + MO_GTAB), (const char*)(ws + WS_ACT), (const char*)(ws + WS_W_DN + (size_t)L * NE * DM * DM * EB), nullptr, DM * EB, E);
            GRID_BAR();
        } }
#endif
#if SITE(11)
        { KArgs ap = kargs(); const int tid = otid(wave0); LAS unsigned char* lds = olds(lds0); (void)tid;
        if (IN(pb + 7)) for (int rep_ = 0; rep_ < REP(11); ++rep_) {
            const int lane = tid & 63, wave = __builtin_amdgcn_readfirstlane(tid >> 6), gw = VCU() * 8 + wave, NGW = gridDim.x * 8;
            unsigned char* ws = ap->ws; const bf16* X1R = (const bf16*)(ws + WS_X1F); const bf16* YS = (const bf16*)(ws + WS_YSLOT); bf16* XB = (bf16*)(ws + WS_XB); float* out = ap->out;
            const float* lg = ap->in[I_LNFG] + L * DM; const float* lbb = ap->in[I_LNFB] + L * DM;
#if YS_FP8
            typedef unsigned ys_t; constexpr int YSB = 1;
#else
            typedef v2u ys_t; constexpr int YSB = 2;
#endif
            v2u xn[4]; f32x4 g4[4], b4[4]; ys_t yn[4][4];
#pragma unroll
            for (int q = 0; q < 4; ++q) { g4[q] = *(const f32x4*)(lg + 256 * q + 4 * lane); b4[q] = *(const f32x4*)(lbb + 256 * q + 4 * lane); xn[q] = *(const v2u*)(X1R + (size_t)gw * DM + 256 * q + 4 * lane);
#pragma unroll
                for (int k = 0; k < 4; ++k) yn[q][k] = *(const ys_t*)((const unsigned char*)YS + (((size_t)gw * 4 + k) * DM + 256 * q + 4 * lane) * YSB); }
#pragma unroll 1
            for (int row = gw; row < NTOK; row += NGW) {
                f32x4 x[4]; ys_t yc[4][4]; float s = 0.f;
#pragma unroll
                for (int q = 0; q < 4; ++q) { x[q] = (f32x4){bflo(xn[q].x), bfhi(xn[q].x), bflo(xn[q].y), bfhi(xn[q].y)} * DN_ALPHA;
#pragma unroll
                    for (int k = 0; k < 4; ++k) yc[q][k] = yn[q][k]; }
                if (row + NGW < NTOK) {
#pragma unroll
                    for (int q = 0; q < 4; ++q) { xn[q] = *(const v2u*)(X1R + (size_t)(row + NGW) * DM + 256 * q + 4 * lane);
#pragma unroll
                        for (int k = 0; k < 4; ++k) yn[q][k] = *(const ys_t*)((const unsigned char*)YS + (((size_t)(row + NGW) * 4 + k) * DM + 256 * q + 4 * lane) * YSB); } }
#pragma unroll
                for (int q = 0; q < 4; ++q) {
#pragma unroll
#if YS_FP8
                    for (int k = 0; k < 4; ++k) { const f32x2 lo = __builtin_amdgcn_cvt_pk_f32_fp8((int)yc[q][k], false), hi = __builtin_amdgcn_cvt_pk_f32_fp8((int)yc[q][k], true);
                        x[q][0] += lo[0] * 0.015625f; x[q][1] += lo[1] * 0.015625f; x[q][2] += hi[0] * 0.015625f; x[q][3] += hi[1] * 0.015625f; }
#else
                    for (int k = 0; k < 4; ++k) { const v2u w = yc[q][k]; x[q][0] += bflo(w.x); x[q][1] += bfhi(w.x); x[q][2] += bflo(w.y); x[q][3] += bfhi(w.y); }
#endif
                    s += (x[q][0] + x[q][1]) + (x[q][2] + x[q][3]); }
                const float mu = wave_sum(s) * (1.0f / DM); float qq = 0.f;
#pragma unroll
                for (int q = 0; q < 4; ++q) { x[q] = x[q] - mu; qq += (x[q][0] * x[q][0] + x[q][1] * x[q][1]) + (x[q][2] * x[q][2] + x[q][3] * x[q][3]); }
                const float rs = 1.0f / sqrtf(wave_sum(qq) * (1.0f / DM) + LN_EPS);
#pragma unroll
                for (int q = 0; q < 4; ++q) { x[q] = x[q] * rs * g4[q] + b4[q];
                    if (L + 1 == DEPTH) *(f32x4*)(out + (size_t)row * DM + 256 * q + 4 * lane) = x[q];
                    else { v2u w; w.x = pk2(x[q][0], x[q][1]); w.y = pk2(x[q][2], x[q][3]); *(v2u*)(XB + (size_t)row * DM + 256 * q + 4 * lane) = w; } }
            }
            if (L + 1 < DEPTH) GRID_BAR();
        } }
#endif
    }
#undef IN
#undef GRID_BAR
}

extern "C" void kernel_launch(void* const* d_in, const int* in_sizes, int n_in, void* d_out, int out_size, void* d_ws, size_t ws_size, hipStream_t stream) {
    static int grid = 0;
    if (grid == 0) {
        if (n_in != 17 || out_size != NTOK * DM || ws_size < WS_END) { fprintf(stderr, "kernel_launch: unexpected shapes (n_in %d, out %d, ws %zu < %zu)\n", n_in, out_size, ws_size, (size_t)WS_END); grid = -1; return; }
        int dev = 0, cus = 0, per_cu = 0;
        if (hipGetDevice(&dev) != hipSuccess || hipDeviceGetAttribute(&cus, hipDeviceAttributeMultiprocessorCount, dev) != hipSuccess) { grid = -1; return; }
        if (hipFuncSetAttribute((const void*)mk_fwd, hipFuncAttributeMaxDynamicSharedMemorySize, LDS_BYTES) != hipSuccess) { fprintf(stderr, "kernel_launch: hipFuncSetAttribute failed\n"); grid = -1; return; }
        if (hipOccupancyMaxActiveBlocksPerMultiprocessor(&per_cu, (const void*)mk_fwd, 512, LDS_BYTES) != hipSuccess || per_cu < 1) { fprintf(stderr, "kernel_launch: occupancy query says %d\n", per_cu); }
        (void)hipGetLastError();
        grid = cus;
    }
    if (grid < 0) return;
    (void)hipMemsetAsync((char*)d_ws + WS_CTL, 0, CTL_ZERO_BYTES, stream);
    Args a{};
    for (int i = 0; i < 17; ++i) a.in[i] = (const float*)d_in[i];
    a.out = (float*)d_out; a.ws = (unsigned char*)d_ws;
#if MK_MULTI
    for (int p = 0; p < 1 + 8 * DEPTH; ++p) { a.ph_lo = p; a.ph_hi = p + 1; hipLaunchKernelGGL(mk_fwd, dim3(grid), dim3(512), LDS_BYTES, stream, a); }
#else
    a.ph_lo = 0; a.ph_hi = 1 + 8 * DEPTH;
    hipLaunchKernelGGL(mk_fwd, dim3(grid), dim3(512), LDS_BYTES, stream, a);
#endif
}
```

```cpp
#include <hip/hip_runtime.h>
#include <cstdio>
#include <cstdint>

#ifndef MK_MULTI
#define MK_MULTI 0
#endif
#ifndef PROBE_EPI2
#define PROBE_EPI2 0
#endif
#ifndef MOE_FP8
#define MOE_FP8 1
#endif
#ifndef YS_FP8
#define YS_FP8 1
#endif
#ifndef SLOW_HGRN
#define SLOW_HGRN 0
#endif
#ifndef SLOW_RET
#define SLOW_RET 0
#endif

#define GAS __attribute__((address_space(1)))
#define LAS __attribute__((address_space(3)))
typedef unsigned short bf16;
typedef unsigned v4u __attribute__((ext_vector_type(4)));
typedef unsigned v2u __attribute__((ext_vector_type(2)));
typedef float f32x4 __attribute__((ext_vector_type(4)));
typedef float f32x2 __attribute__((ext_vector_type(2)));
typedef short bf16x8 __attribute__((ext_vector_type(8)));
typedef GAS unsigned gu32;

constexpr int DM = 1024, NBATCH = 16, SEQ = 2048, NTOK = NBATCH * SEQ, DEPTH = 4;
constexpr int NE = 32, TOPK = 4;
constexpr int HG_HEADS = 8, HG_K = 128;
constexpr int RT_HEADS = 4, RT_K = 256, RT_V = 512, RT_VD = 2048, RT_IN = 6144, HG_IN = 4096;
constexpr int ECAP = NTOK;
constexpr int MOE_ROWS = NTOK * TOPK + NE * 256;
constexpr float DN_ALPHA = 1.681792830507429f;
constexpr float LN_EPS = 1e-5f, RMS_EPS = 1e-6f;

constexpr size_t MiB = 1ull << 20;
constexpr size_t WS_CTL = 0, CTL_ZERO_BYTES = 1 * MiB;
constexpr size_t WS_LBS = 1 * MiB;
constexpr size_t WS_WRH = 1 * MiB + 128 * 1024, WS_WRL = 1 * MiB + 512 * 1024;
constexpr size_t WS_BGU = 2 * MiB;
constexpr size_t WS_ROT = 4 * MiB;
constexpr size_t WS_ROWDST = 8 * MiB;
constexpr size_t WS_ROWGATE = 12 * MiB;
constexpr size_t WS_W_HIN = 16 * MiB;
constexpr size_t WS_W_HOUT = WS_W_HIN + 16 * MiB;
constexpr size_t WS_W_RIN = WS_W_HOUT + 4 * MiB;
constexpr size_t WS_W_ROUT = WS_W_RIN + 24 * MiB;
constexpr size_t WS_W_GU = WS_W_ROUT + 8 * MiB;
constexpr size_t WS_W_DN = WS_W_GU + 512 * MiB;
constexpr size_t WS_XB = WS_W_DN + 256 * MiB;
constexpr size_t WS_H = WS_XB + 64 * MiB;
constexpr size_t WS_DEC = WS_H + 320 * MiB;
constexpr size_t WS_SSP = WS_DEC + 16 * MiB;
constexpr size_t WS_O = WS_H + 384 * MiB;
constexpr size_t WS_A2 = WS_O + 128 * MiB;
constexpr size_t WS_Y = WS_A2 + 128 * MiB;
constexpr size_t WS_X1F = WS_Y + 128 * MiB;
constexpr size_t WS_X1B = WS_X1F + 128 * MiB;
constexpr size_t WS_ACT = WS_X1B + 64 * MiB;
constexpr size_t WS_YSLOT = WS_ACT + 272 * MiB;
constexpr size_t WS_END = WS_YSLOT + 256 * MiB;

constexpr int CW_BAR = 4096;
constexpr int CW_SS = 65536;
constexpr int CW_ECNT = 16384;

constexpr int RING_BYTES = 131072;
constexpr int MISC_OFF = 135168;
constexpr int LDS_BYTES = 163840;
constexpr int MO_BARW = 0;
constexpr int MO_GTAB = 64;
constexpr int MO_TPRE = 64 + 2048;
constexpr int MO_EBASE = MO_TPRE + 160;
constexpr int MO_ECNT = MO_EBASE + 128;
constexpr int MO_LCNT = MO_ECNT + 128;
constexpr int MO_LBASE = MO_LCNT + 128;
constexpr int MO_SEL = MO_LBASE + 128;
constexpr int MO_SELW = MO_SEL + 2048;
constexpr int MO_RANK = MO_SELW + 2048;
constexpr int MO_ULIST = MO_RANK + 2048;
constexpr int MO_GALL = 10240;
constexpr int GALL_UNITS = 18;
static_assert(MO_ULIST + 1024 <= MO_GALL && MISC_OFF + MO_GALL + GALL_UNITS * 1024 <= LDS_BYTES, "LDS map");

#define RLX_AGENT __ATOMIC_RELAXED, __HIP_MEMORY_SCOPE_AGENT
#define LDS_WAIT() asm volatile("s_waitcnt lgkmcnt(0)" ::: "memory")
#define VM_WAIT() asm volatile("s_waitcnt vmcnt(0)" ::: "memory")

__device__ __forceinline__ unsigned f2bf(float f) { unsigned u = __builtin_bit_cast(unsigned, f); return (u + 0x7fffu + ((u >> 16) & 1u)) >> 16; }
__device__ __forceinline__ unsigned pk2(float lo, float hi) { return f2bf(lo) | (f2bf(hi) << 16); }
__device__ __forceinline__ unsigned cvt_pk_bf16(float lo, float hi) { unsigned r; asm volatile("v_cvt_pk_bf16_f32 %0, %1, %2" : "=v"(r) : "v"(lo), "v"(hi)); return r; }
#if MOE_FP8
constexpr float X_SCALE = 4.0f, WGU_SCALE = 64.0f, ACT_SCALE = 4.0f, WDN_SCALE = 128.0f;
constexpr float GU_DESCALE = 1.0f / (X_SCALE * WGU_SCALE), DN_DESCALE = 1.0f / (ACT_SCALE * WDN_SCALE);
#else
constexpr float GU_DESCALE = 1.0f, DN_DESCALE = 1.0f, ACT_SCALE = 1.0f;
#endif
__device__ __forceinline__ unsigned pk4_fp8(float a, float b, float c, float d) {
    a = __builtin_amdgcn_fmed3f(a, -448.0f, 448.0f); b = __builtin_amdgcn_fmed3f(b, -448.0f, 448.0f); c = __builtin_amdgcn_fmed3f(c, -448.0f, 448.0f); d = __builtin_amdgcn_fmed3f(d, -448.0f, 448.0f);
    int p = __builtin_amdgcn_cvt_pk_fp8_f32(a, b, 0, false); p = __builtin_amdgcn_cvt_pk_fp8_f32(c, d, p, true); return (unsigned)p; }
__device__ __forceinline__ float bflo(unsigned u) { return __builtin_bit_cast(float, u << 16); }
__device__ __forceinline__ float bfhi(unsigned u) { return __builtin_bit_cast(float, u & 0xffff0000u); }
__device__ __forceinline__ float bf1(bf16 b) { return __builtin_bit_cast(float, ((unsigned)b) << 16); }
__device__ __forceinline__ float fexp(float x) { return __builtin_amdgcn_exp2f(x * 1.4426950408889634f); }
__device__ __forceinline__ float frcp(float x) { return __builtin_amdgcn_rcpf(x); }
__device__ __forceinline__ float fsigmoid(float x) { return frcp(1.0f + fexp(-x)); }
__device__ __forceinline__ float wave_sum(float v) {
#pragma unroll
    for (int o = 1; o < 64; o <<= 1) v += __shfl_xor(v, o);
    return v;
}
__device__ __forceinline__ float wave_max(float v) {
#pragma unroll
    for (int o = 1; o < 64; o <<= 1) v = fmaxf(v, __shfl_xor(v, o));
    return v;
}

template <int CTRL> __device__ __forceinline__ float dppf(float v) { return __builtin_bit_cast(float, __builtin_amdgcn_update_dpp(0, __builtin_bit_cast(int, v), CTRL, 0xf, 0xf, true)); }
template <int CTRL> __device__ __forceinline__ int dppi(int v) { return __builtin_amdgcn_update_dpp(0, v, CTRL, 0xf, 0xf, true); }
__device__ __forceinline__ float rlane(float v, int l) { return __builtin_bit_cast(float, __builtin_amdgcn_readlane(__builtin_bit_cast(int, v), l)); }
__device__ __forceinline__ float wave_sum_u(float v) {
    v += dppf<0xB1>(v); v += dppf<0x4E>(v); v += dppf<0x141>(v); v += dppf<0x140>(v);
    return (rlane(v, 0) + rlane(v, 16)) + (rlane(v, 32) + rlane(v, 48));
}
#define XB_TMO      128
#define XB_XCNT(j)  (256  + 64 * (j))
#define XB_XSUB(j)  (1280 + 64 * (j))
#define XB_XGEN(j)  (2304 + 64 * (j))
#define XB_TOP      3328
#define XB_TOPGEN   3392
#define XCD_BAR_WORDS 3456
#define XB_SPIN_CAP (1u << 22)

__device__ __forceinline__ unsigned xb_ld(unsigned* p)              { return __hip_atomic_load(p, __ATOMIC_RELAXED, __HIP_MEMORY_SCOPE_AGENT); }
__device__ __forceinline__ unsigned xb_add(unsigned* p, unsigned v) { return __hip_atomic_fetch_add(p, v, __ATOMIC_RELAXED, __HIP_MEMORY_SCOPE_AGENT); }
__device__ __forceinline__ unsigned xb_xcc_id() { return (unsigned)__builtin_amdgcn_s_getreg((3 << 11) | 20) & 0xFu; }
#define XB_SPIN(cond, bar) do { unsigned _sp = 0; while (cond) { __builtin_amdgcn_s_sleep(1); \
    if ((++_sp & 255u) == 0u) { if (xb_ld(&(bar)[XB_TMO])) break; if (_sp > XB_SPIN_CAP) { atomicAdd(&(bar)[XB_TMO], 1u); break; } } } } while (0)

struct XcdBarrier { unsigned* bar; unsigned x; volatile LAS unsigned* st; };

__device__ __forceinline__ XcdBarrier xcd_barrier_post(unsigned* bar, volatile LAS unsigned* st) {
    XcdBarrier b; b.bar = bar; b.x = xb_xcc_id(); b.st = st;
    if (threadIdx.x == 0) (void)xb_add(&bar[XB_XCNT(b.x)], 1u);
    return b;
}
__device__ __forceinline__ void xcd_barrier_complete(unsigned* bar, unsigned x, unsigned& nloc, unsigned& nx) {
    const unsigned G = gridDim.x * gridDim.y * gridDim.z;
    unsigned sum, cnt, mine, sp = 0u;
    for (;;) {
        sum = 0u; cnt = 0u; mine = 0u;
#pragma unroll
        for (unsigned j = 0; j < 16; ++j) { const unsigned c = xb_ld(&bar[XB_XCNT(j)]); sum += c; cnt += (c > 0u) ? 1u : 0u; mine = (j == x) ? c : mine; }
        if (sum == G) break;
        __builtin_amdgcn_s_sleep(1);
        if ((++sp & 255u) == 0u) { if (xb_ld(&bar[XB_TMO])) break; if (sp > XB_SPIN_CAP) { atomicAdd(&bar[XB_TMO], 1u); break; } }
    }
    nloc = mine > 0u ? mine : 1u; nx = cnt > 0u ? cnt : 1u;
}
__device__ __forceinline__ void xcd_barrier(const XcdBarrier& b) {
    asm volatile("s_waitcnt vmcnt(0)" ::: "memory");
    __syncthreads();
    if (threadIdx.x == 0) {
        unsigned* bar = b.bar;
        __builtin_amdgcn_s_waitcnt(0);
        unsigned nloc = b.st[0], nx = b.st[1];
        if (nloc == 0u) { xcd_barrier_complete(bar, b.x, nloc, nx); b.st[0] = nloc; b.st[1] = nx; }
        const unsigned old = xb_add(&bar[XB_XSUB(b.x)], 1u);
        const unsigned gen = old / nloc;
        if (old + 1u == (gen + 1u) * nloc) {
            __builtin_amdgcn_fence(__ATOMIC_RELEASE, "agent");
            asm volatile("s_waitcnt vmcnt(0)" ::: "memory");
            const unsigned og = xb_add(&bar[XB_TOP], 1u);
            const unsigned tg = og / nx;
            if (og + 1u == (tg + 1u) * nx) xb_add(&bar[XB_TOPGEN], 1u);
            else XB_SPIN(xb_ld(&bar[XB_TOPGEN]) == tg, bar);
            __builtin_amdgcn_fence(__ATOMIC_ACQUIRE, "agent");
            xb_add(&bar[XB_XGEN(b.x)], 1u);
            asm volatile("s_waitcnt vmcnt(0)" ::: "memory");
        } else {
            XB_SPIN(xb_ld(&bar[XB_XGEN(b.x)]) == gen, bar);
            __builtin_amdgcn_fence(__ATOMIC_ACQUIRE, "agent");
            asm volatile("s_waitcnt vmcnt(0)" ::: "memory");
        }
    }
    __syncthreads();
}

namespace pg8 {
constexpr int BM = 256, BK = 64, HALF = 128, HTB = HALF * BK * 2, STAGE_BYTES = 8 * HTB, NXCD = 8, WGM = 8, MAXU = 32;
__host__ __device__ __forceinline__ int lds_byte(int r, int c) { const int st = (r >> 4) * 2 + (c >> 5), rr = r & 15, cc = c & 31, ob = rr * 64 + cc * 2; return st * 1024 + (ob ^ (((ob >> 9) & 1) << 5)); }
__host__ __device__ __forceinline__ void stage_rc(int b, int& R, int& C) { const int st = b / 1024, sb = b % 1024, swz = sb ^ (((sb >> 9) & 1) << 5); R = (st >> 1) * 16 + swz / 64; C = (st & 1) * 32 + (swz % 64) / 2; }
__host__ __device__ __forceinline__ int perm32(int rho) { const int n = rho >> 4, i = rho & 15; return 8 * (i >> 2) + 4 * n + (i & 3); }

struct Unit { int pm, pn, e, rowbase, cnt; unsigned boff; int gidx; };

__device__ __forceinline__ bool tile_of(long L, int nM, int nN, int& gm, int& pn) {
    const int nwg = nM * nN; if (L >= nwg) return false;
    int wgid = (int)L; { const int q = nwg / NXCD, r = nwg % NXCD, xcd = wgid % NXCD, off = wgid / NXCD; wgid = (xcd < r ? xcd * (q + 1) : r * (q + 1) + (xcd - r) * q) + off; }
    const int nig = WGM * nN, gid = wgid / nig, fm = gid * WGM, gsz = (nM - fm) < WGM ? (nM - fm) : WGM;
    gm = fm + ((wgid % nig) % gsz); pn = (wgid % nig) / gsz; return true;
}
__device__ __forceinline__ void build_units_dense(const int i, LAS int* ul, int nM, int nN, int RB) {
    if (i < MAXU) { int gm = 0, pn = 0; const bool ok = tile_of((long)i * gridDim.x + blockIdx.x, nM, nN, gm, pn);
        ul[i * 8 + 0] = ok ? 1 : 0; ul[i * 8 + 1] = gm; ul[i * 8 + 2] = pn; ul[i * 8 + 3] = 0; ul[i * 8 + 4] = gm * BM; ul[i * 8 + 5] = BM; ul[i * 8 + 6] = (int)((unsigned)pn * BM * (unsigned)RB); ul[i * 8 + 7] = 0; }
    __syncthreads();
}
__device__ __forceinline__ void build_units_moe(const int i, LAS int* ul, const LAS int* tpre, const LAS int* ebase, const LAS int* ecnt, int nN, int RB, unsigned wstride) {
    if (i < MAXU) { int gm = 0, pn = 0; const bool ok = tile_of((long)i * gridDim.x + blockIdx.x, tpre[NE], nN, gm, pn);
        int e = 0;
_Pragma("unroll 1")
        for (int s = 16; s >= 1; s >>= 1) { if (e + s < NE && tpre[e + s] <= gm) e += s; }
        const int pm = gm - tpre[e];
        ul[i * 8 + 0] = ok ? 1 : 0; ul[i * 8 + 1] = pm; ul[i * 8 + 2] = pn; ul[i * 8 + 3] = e; ul[i * 8 + 4] = ebase[e] + pm * BM; ul[i * 8 + 5] = ecnt[e] - pm * BM;
        ul[i * 8 + 6] = (int)((unsigned)e * wstride + (unsigned)pn * BM * (unsigned)RB); ul[i * 8 + 7] = e * ECAP + pm * BM; }
    __syncthreads();
}
__device__ __forceinline__ bool ld_unit(const LAS int* ul, int i, Unit& u) {
    if (i >= MAXU) return false;
    const LAS int* p = ul + i * 8;
    if (__builtin_amdgcn_readfirstlane(p[0]) == 0) return false;
    u.pm = __builtin_amdgcn_readfirstlane(p[1]); u.pn = __builtin_amdgcn_readfirstlane(p[2]); u.e = __builtin_amdgcn_readfirstlane(p[3]); u.rowbase = __builtin_amdgcn_readfirstlane(p[4]);
    u.cnt = __builtin_amdgcn_readfirstlane(p[5]); u.boff = (unsigned)__builtin_amdgcn_readfirstlane(p[6]); u.gidx = __builtin_amdgcn_readfirstlane(p[7]); return true;
}
__device__ __forceinline__ void glds16(const char* sbase, unsigned voff, LAS unsigned char* dst) {
    asm volatile("" : "+s"(sbase));
    __builtin_amdgcn_global_load_lds((const unsigned*)(sbase + voff), (LAS unsigned*)dst, 16, 0, 0);
}
template <bool GATHER> __device__ __forceinline__ void stage_a(LAS unsigned char* dst, const char* sbase, unsigned o0, unsigned o1, size_t r64) {
    glds16(sbase, o0, dst);
    if constexpr (GATHER) glds16(sbase, o1, dst + 8192);
    else glds16(sbase + r64, o0, dst + 8192);
}

typedef int v8i __attribute__((ext_vector_type(8)));
typedef int v4i __attribute__((ext_vector_type(4)));
__device__ __forceinline__ v8i cat_frag(const bf16x8& a, const bf16x8& b) { return __builtin_shufflevector(__builtin_bit_cast(v4i, a), __builtin_bit_cast(v4i, b), 0, 1, 2, 3, 4, 5, 6, 7); }
template <class Epi, bool GATHER, bool ALIGN_EPI, bool FP8>
__device__ __forceinline__ void gemm_phase(const int tid, LAS unsigned char* lds, const LAS int* ul, LAS int* gtab, const char* Abase, const char* Bbase, const int* rowdst, const int RB, const Epi& E) {
    const int wid = __builtin_amdgcn_readfirstlane(tid >> 6), lane = tid & 63, wr = wid >> 2, wc = wid & 3, fr = lane & 15, fq = lane >> 4;
    const int nt = RB / 128;
    int R0, C0; stage_rc(tid * 16, R0, C0);
    const int Rb0 = Epi::PERM ? ((R0 & ~31) + perm32(R0 & 31)) : R0;
    const unsigned voffB = (unsigned)(Rb0 * RB + C0 * 2);
    const unsigned cb0 = (unsigned)C0 * 2u, K2 = (unsigned)RB;
    const size_t kstep = (size_t)128;
    const size_t r64 = (size_t)64 * RB;
    const size_t hstep = (size_t)HALF * RB;
    const unsigned ldsw = (unsigned)wid * 1024u;
    const int aoff = lds_byte(wr * 64 + fr, fq * 8), boff = lds_byte(wc * 32 + fr, fq * 8);
#define PG8_SA(b, h) (((b) * 2 + (h)) * HTB)
#define PG8_SB(b, h) ((4 + (b) * 2 + (h)) * HTB)
#define PG8_STAGE(bufoff, gbase) do { glds16((const char*)(gbase), voffB, lds + (bufoff) + ldsw); glds16((const char*)(gbase) + r64, voffB, lds + (bufoff) + ldsw + 8192); } while (0)
#define PG8_STAGEA0(bufoff, kb, o0, o1) stage_a<GATHER>(lds + (bufoff) + ldsw, Abase + (kb), o0, o1, r64)
#define PG8_STAGEA1(bufoff, kb, o0, o2, o3) stage_a<GATHER>(lds + (bufoff) + ldsw, Abase + (kb) + (GATHER ? (size_t)0 : hstep), GATHER ? (o2) : (o0), o3, r64)
#define PG8_LDA(dst, b, h) do { _Pragma("unroll") for (int m = 0; m < 4; ++m) { const v4i _l = *(const LAS v4i*)(lds + PG8_SA(b, h) + aoff + m * 2048), _h = *(const LAS v4i*)(lds + PG8_SA(b, h) + aoff + m * 2048 + 1024); dst[m] = __builtin_shufflevector(_l, _h, 0, 1, 2, 3, 4, 5, 6, 7); } } while (0)
#define PG8_LDB(dst, b, h) do { _Pragma("unroll") for (int n = 0; n < 2; ++n) { const v4i _l = *(const LAS v4i*)(lds + PG8_SB(b, h) + boff + n * 2048), _h = *(const LAS v4i*)(lds + PG8_SB(b, h) + boff + n * 2048 + 1024); dst[n] = __builtin_shufflevector(_l, _h, 0, 1, 2, 3, 4, 5, 6, 7); } } while (0)
#define PG8_LO(x) __builtin_bit_cast(bf16x8, __builtin_shufflevector(x, x, 0, 1, 2, 3))
#define PG8_HI(x) __builtin_bit_cast(bf16x8, __builtin_shufflevector(x, x, 4, 5, 6, 7))
#define PG8_MMA(ai, bj, At, Bt) do { __builtin_amdgcn_s_setprio(1); _Pragma("unroll") for (int m = 0; m < 4; ++m) _Pragma("unroll") for (int n = 0; n < 2; ++n) { \
        if constexpr (FP8) asm volatile("v_mfma_scale_f32_16x16x128_f8f6f4 %0, %1, %2, %0, %3, %3 op_sel_hi:[0,0,0]" : "+v"(acc[ai][bj][m][n]) : "v"(Bt[n]), "v"(At[m]), "v"(sc1)); \
        else { acc[ai][bj][m][n] = __builtin_amdgcn_mfma_f32_16x16x32_bf16(PG8_LO(Bt[n]), PG8_LO(At[m]), acc[ai][bj][m][n], 0, 0, 0); \
               acc[ai][bj][m][n] = __builtin_amdgcn_mfma_f32_16x16x32_bf16(PG8_HI(Bt[n]), PG8_HI(At[m]), acc[ai][bj][m][n], 0, 0, 0); } } \
        __builtin_amdgcn_s_setprio(0); } while (0)
#define PG8_WAIT_V(n) asm volatile("s_waitcnt vmcnt(" #n ")" ::: "memory")
#define PG8_WAIT_L(n) asm volatile("s_waitcnt lgkmcnt(" #n ")" ::: "memory")
#define PG8_BAR __builtin_amdgcn_s_barrier()
#define PG8_SCHED __builtin_amdgcn_sched_barrier(0)
    Unit cur, nxt; int ui = 0;
    if (!ld_unit(ul, 0, cur)) return;
    f32x4 acc[2][2][4][2];
#pragma unroll
    for (int a = 0; a < 2; ++a)
#pragma unroll
        for (int b = 0; b < 2; ++b)
#pragma unroll
            for (int m = 0; m < 4; ++m)
#pragma unroll
                for (int n = 0; n < 2; ++n) acc[a][b][m][n] = (f32x4){0.f, 0.f, 0.f, 0.f};
    v8i At[4], B0[2], B1[2];
    const int sc1 = 0x7f7f7f7f;
    unsigned oA0, oA1 = 0, oA2 = 0, oA3 = 0, oN0, oN1 = 0, oN2 = 0, oN3 = 0;
    if constexpr (GATHER) {
        oA0 = (unsigned)gtab[R0] * K2 + cb0; oA1 = (unsigned)gtab[R0 + 64] * K2 + cb0; oA2 = (unsigned)gtab[R0 + 128] * K2 + cb0; oA3 = (unsigned)gtab[R0 + 192] * K2 + cb0;
    } else {
        oA0 = (unsigned)(cur.rowbase + R0) * K2 + cb0;
    }
    oN0 = oA0; oN1 = oA1; oN2 = oA2; oN3 = oA3;
    const char* cB = Bbase + cur.boff;
    PG8_STAGE(PG8_SB(0, 0), cB); PG8_STAGE(PG8_SB(0, 1), cB + hstep); PG8_STAGEA0(PG8_SA(0, 0), (size_t)0, oA0, oA1); PG8_STAGEA1(PG8_SA(0, 1), (size_t)0, oA0, oA2, oA3);
    if (wr == 1) PG8_BAR;
    PG8_WAIT_V(2); PG8_BAR;
    PG8_STAGE(PG8_SB(1, 0), cB + kstep); PG8_STAGEA0(PG8_SA(1, 0), kstep, oA0, oA1); PG8_STAGE(PG8_SB(1, 1), cB + hstep + kstep);
    PG8_WAIT_V(6); PG8_BAR;
    for (;;) {
        const bool has_next = ld_unit(ul, ui + 1, nxt);
        const char* nB = has_next ? Bbase + nxt.boff : cB;
_Pragma("unroll 1")
        for (int t = 0; t < nt; t += 2) {
            const bool last = (t == nt - 2);
            if (last && has_next) {
                if constexpr (GATHER) {
                    const LAS int* gt = gtab + (ui + 1) * 256;
                    oN0 = (unsigned)gt[R0] * K2 + cb0; oN1 = (unsigned)gt[R0 + 64] * K2 + cb0; oN2 = (unsigned)gt[R0 + 128] * K2 + cb0; oN3 = (unsigned)gt[R0 + 192] * K2 + cb0;
                } else {
                    oN0 = (unsigned)(nxt.rowbase + R0) * K2 + cb0;
                }
            }
            const size_t kb1 = (size_t)(t + 1) * kstep;
            const size_t kb2 = last ? (size_t)0 : (size_t)(t + 2) * kstep, kb3 = kb2 + kstep;
            const unsigned p0 = last ? oN0 : oA0, p1 = last ? oN1 : oA1, p2 = last ? oN2 : oA2, p3 = last ? oN3 : oA3;
            const char* b2 = last ? nB : cB + (size_t)(t + 2) * kstep; const char* b3 = b2 + kstep;
            PG8_LDB(B0, 0, 0); PG8_LDB(B1, 0, 1); PG8_SCHED; PG8_LDA(At, 0, 0); PG8_STAGEA1(PG8_SA(1, 1), kb1, oA0, oA2, oA3);
            PG8_WAIT_V(8); PG8_WAIT_L(0); PG8_BAR; PG8_MMA(0, 0, At, B0); PG8_MMA(0, 1, At, B1); PG8_BAR; PG8_SCHED;
            PG8_LDA(At, 0, 1); PG8_STAGE(PG8_SB(0, 0), b2); PG8_STAGE(PG8_SB(0, 1), b2 + hstep); PG8_STAGEA0(PG8_SA(0, 0), kb2, p0, p1);
            PG8_WAIT_V(8); PG8_WAIT_L(0); PG8_BAR; PG8_MMA(1, 0, At, B0); PG8_MMA(1, 1, At, B1); PG8_BAR; PG8_SCHED;
            PG8_LDB(B0, 1, 0); PG8_LDB(B1, 1, 1); PG8_SCHED; PG8_LDA(At, 1, 0); PG8_STAGEA1(PG8_SA(0, 1), kb2, p0, p2, p3);
            PG8_WAIT_V(8); PG8_WAIT_L(0); PG8_BAR; PG8_MMA(0, 0, At, B0); PG8_MMA(0, 1, At, B1); PG8_BAR; PG8_SCHED;
            PG8_LDA(At, 1, 1); PG8_STAGE(PG8_SB(1, 0), b3); PG8_STAGE(PG8_SB(1, 1), b3 + hstep); PG8_STAGEA0(PG8_SA(1, 0), kb3, p0, p1);
            PG8_WAIT_V(8); PG8_WAIT_L(0); PG8_BAR; PG8_MMA(1, 0, At, B0); PG8_MMA(1, 1, At, B1); PG8_BAR; PG8_SCHED;
        }
        if constexpr (FP8) asm volatile("s_nop 7\n\ts_nop 7\n\ts_nop 7" ::: "memory");
        if constexpr (ALIGN_EPI) { if (wr == 0) PG8_BAR; }
        E(acc, cur, wr, wc, fr, fq);
#if PROBE_EPI2
        if constexpr (FP8) E(acc, cur, wr, wc, fr, fq);
#endif
        if (!has_next) break;
#pragma unroll
        for (int a = 0; a < 2; ++a)
#pragma unroll
            for (int b = 0; b < 2; ++b)
#pragma unroll
                for (int m = 0; m < 4; ++m)
#pragma unroll
                    for (int n = 0; n < 2; ++n) acc[a][b][m][n] = (f32x4){0.f, 0.f, 0.f, 0.f};
        cur = nxt; cB = nB; oA0 = oN0; oA1 = oN1; oA2 = oN2; oA3 = oN3; ++ui;
        if constexpr (ALIGN_EPI) { if (wr == 1) PG8_BAR; }
    }
    PG8_WAIT_V(0);
    if constexpr (!ALIGN_EPI) { if (wr == 0) PG8_BAR; }
    PG8_BAR;
#undef PG8_SA
#undef PG8_SB
#undef PG8_STAGE
#undef PG8_STAGEA0
#undef PG8_STAGEA1
#undef PG8_LDA
#undef PG8_LDB
#undef PG8_LO
#undef PG8_HI
#undef PG8_MMA
#undef PG8_WAIT_V
#undef PG8_WAIT_L
#undef PG8_BAR
#undef PG8_SCHED
}

__device__ __forceinline__ GAS unsigned char* launder(unsigned char* p) { asm volatile("" : "+s"(p)); return (GAS unsigned char*)p; }
#define OPAQUE_LANE(fr, fq) asm volatile("" : "+v"(fr), "+v"(fq))
struct EpiHgrnIn {
    static constexpr bool PERM = true;
    unsigned char* ws0; int L;
    __device__ __forceinline__ void operator()(const f32x4 (&acc)[2][2][4][2], const Unit& u, int wr, int wc, int fr, int fq) const {
        OPAQUE_LANE(fr, fq);
        GAS unsigned char* ws = launder(ws0);
        GAS bf16* QD = (GAS bf16*)(ws + WS_H);
        const int row0 = u.rowbase + wr * 64 + fr;
        if (u.pn >= 8) {
            const bool isg = u.pn >= 12; GAS bf16* base = QD + (size_t)(isg ? 4 : 3) * NTOK * DM; const int colt = (u.pn - (isg ? 12 : 8)) * BM + wc * 32 + 8 * fq;
#pragma unroll
            for (int ai = 0; ai < 2; ++ai)
#pragma unroll
                for (int m = 0; m < 4; ++m) { GAS bf16* rowp = base + (size_t)(row0 + ai * HALF + m * 16) * DM + colt;
#pragma unroll
                    for (int bj = 0; bj < 2; ++bj) { f32x4 v0 = acc[ai][bj][m][0], v1 = acc[ai][bj][m][1];
                        if (isg) {
#pragma unroll
                            for (int j = 0; j < 4; ++j) { v0[j] = v0[j] * fsigmoid(v0[j]); v1[j] = v1[j] * fsigmoid(v1[j]); } }
                        v4u w; w.x = cvt_pk_bf16(v0[0], v0[1]); w.y = cvt_pk_bf16(v0[2], v0[3]); w.z = cvt_pk_bf16(v1[0], v1[1]); w.w = cvt_pk_bf16(v1[2], v1[3]);
                        *(GAS v4u*)(rowp + bj * HALF) = w; } }
            return;
        }
        const int col = u.pn * HG_K + wc * 32 + 8 * fq;
        const GAS float* lb = (const GAS float*)(ws + WS_LBS) + L * DM;
        const f32x4 lb0 = *(const GAS f32x4*)(lb + col), lb1 = *(const GAS f32x4*)(lb + col + 4);
#if !SLOW_HGRN
        const int lane = fq * 16 + fr;
        GAS float* DEC = (GAS float*)(ws + WS_DEC);
#endif
#pragma unroll
        for (int ai = 0; ai < 2; ++ai)
#pragma unroll
            for (int m = 0; m < 4; ++m) {
                const int row = row0 + ai * HALF + m * 16;
                float qd[8], ki[8];
#if SLOW_HGRN
                float ks[8];
#endif
#if !SLOW_HGRN
                float de[8];
#endif
#pragma unroll
                for (int j = 0; j < 8; ++j) {
                    const float q = acc[ai][0][m][j >> 2][j & 3], f = acc[ai][1][m][j >> 2][j & 3], lbv = j < 4 ? lb0[j & 3] : lb1[j & 3];
                    const float sg = fsigmoid(f), fg = lbv + (1.0f - lbv) * sg, kk = (1.0f - lbv) * (1.0f - sg);
#if SLOW_HGRN
                    qd[j] = q * fsigmoid(q); ki[j] = kk; ks[j] = fg;
#else
                    float P = fg;
                    P *= __builtin_bit_cast(float, __builtin_amdgcn_update_dpp(0x3f800000, __builtin_bit_cast(int, P), 0x111, 0xf, 0xf, false));
                    P *= __builtin_bit_cast(float, __builtin_amdgcn_update_dpp(0x3f800000, __builtin_bit_cast(int, P), 0x112, 0xf, 0xf, false));
                    P *= __builtin_bit_cast(float, __builtin_amdgcn_update_dpp(0x3f800000, __builtin_bit_cast(int, P), 0x114, 0xf, 0xf, false));
                    P *= __builtin_bit_cast(float, __builtin_amdgcn_update_dpp(0x3f800000, __builtin_bit_cast(int, P), 0x118, 0xf, 0xf, false));
                    const float Pl = __shfl(P, lane | 15), iP = frcp(fmaxf(P, 1e-30f));
                    qd[j] = q * fsigmoid(q) * P; ki[j] = kk * iP; de[j] = Pl;
#endif
                }
                const size_t o = (size_t)row * DM + col;
                v4u w;
                w.x = cvt_pk_bf16(qd[0], qd[1]); w.y = cvt_pk_bf16(qd[2], qd[3]); w.z = cvt_pk_bf16(qd[4], qd[5]); w.w = cvt_pk_bf16(qd[6], qd[7]); *(GAS v4u*)(QD + o) = w;
                w.x = cvt_pk_bf16(ki[0], ki[1]); w.y = cvt_pk_bf16(ki[2], ki[3]); w.z = cvt_pk_bf16(ki[4], ki[5]); w.w = cvt_pk_bf16(ki[6], ki[7]); *(GAS v4u*)(QD + (size_t)NTOK * DM + o) = w;
#if SLOW_HGRN
                w.x = cvt_pk_bf16(ks[0], ks[1]); w.y = cvt_pk_bf16(ks[2], ks[3]); w.z = cvt_pk_bf16(ks[4], ks[5]); w.w = cvt_pk_bf16(ks[6], ks[7]); *(GAS v4u*)(QD + 2 * (size_t)NTOK * DM + o) = w;
#endif
#if !SLOW_HGRN
                if (fr == 0) { GAS float* dp = DEC + (size_t)(row >> 4) * DM + col; *(GAS f32x4*)dp = (f32x4){de[0], de[1], de[2], de[3]}; *(GAS f32x4*)(dp + 4) = (f32x4){de[4], de[5], de[6], de[7]}; }
#endif
            }
    }
};
struct EpiRetIn {
    static constexpr bool PERM = true;
    unsigned char* ws0;
    __device__ __forceinline__ void operator()(const f32x4 (&acc)[2][2][4][2], const Unit& u, int wr, int wc, int fr, int fq) const {
        OPAQUE_LANE(fr, fq);
        GAS unsigned char* ws = launder(ws0);
        GAS bf16* H = (GAS bf16*)(ws + WS_H); const GAS float* rot = (const GAS float*)(ws + WS_ROT);
        const int row0 = u.rowbase + wr * 64 + fr; const int colt = u.pn * BM + wc * 32 + 8 * fq;
        const int kind = u.pn < 4 ? 0 : (u.pn < 8 ? 1 : (u.pn < 16 ? 2 : 3));
#pragma unroll
        for (int ai = 0; ai < 2; ++ai)
#pragma unroll
            for (int m = 0; m < 4; ++m) { const int row = row0 + ai * HALF + m * 16; GAS bf16* rowp = H + (size_t)row * RT_IN + colt; const int pos = row & (SEQ - 1);
#pragma unroll
                for (int bj = 0; bj < 2; ++bj) { f32x4 v0 = acc[ai][bj][m][0], v1 = acc[ai][bj][m][1];
                    if (kind <= 1) {
                        const int p0 = (bj * HALF + wc * 32 + 8 * fq) >> 1;
                        const GAS float* rp = rot + ((size_t)pos * 128 + p0) * 2;
                        const f32x4 r0 = *(const GAS f32x4*)rp, r1 = *(const GAS f32x4*)(rp + 4);
                        const float sc = kind == 1 ? 0.0625f : 1.0f;
                        f32x4 o0, o1;
                        o0[0] = (v0[0] * r0[0] - v0[1] * r0[1]) * sc; o0[1] = (v0[1] * r0[0] + v0[0] * r0[1]) * sc;
                        o0[2] = (v0[2] * r0[2] - v0[3] * r0[3]) * sc; o0[3] = (v0[3] * r0[2] + v0[2] * r0[3]) * sc;
                        o1[0] = (v1[0] * r1[0] - v1[1] * r1[1]) * sc; o1[1] = (v1[1] * r1[0] + v1[0] * r1[1]) * sc;
                        o1[2] = (v1[2] * r1[2] - v1[3] * r1[3]) * sc; o1[3] = (v1[3] * r1[2] + v1[2] * r1[3]) * sc;
                        v0 = o0; v1 = o1;
                    } else if (kind == 3) {
#pragma unroll
                        for (int j = 0; j < 4; ++j) { v0[j] = v0[j] * fsigmoid(v0[j]); v1[j] = v1[j] * fsigmoid(v1[j]); }
                    }
                    v4u w; w.x = cvt_pk_bf16(v0[0], v0[1]); w.y = cvt_pk_bf16(v0[2], v0[3]); w.z = cvt_pk_bf16(v1[0], v1[1]); w.w = cvt_pk_bf16(v1[2], v1[3]);
                    *(GAS v4u*)(rowp + bj * HALF) = w; } }
    }
};
struct EpiRes {
    static constexpr bool PERM = true;
    unsigned char* ws0; int ssoff;
    __device__ __forceinline__ void operator()(const f32x4 (&acc)[2][2][4][2], const Unit& u, int wr, int wc, int fr, int fq) const {
        OPAQUE_LANE(fr, fq);
        GAS unsigned char* ws = launder(ws0);
        GAS bf16* Y = (GAS bf16*)(ws + WS_Y); const GAS bf16* X = (const GAS bf16*)(ws + WS_XB);
        const int row0 = u.rowbase + wr * 64 + fr, col0 = u.pn * BM + wc * 32 + 8 * fq;
#pragma unroll
        for (int ai = 0; ai < 2; ++ai)
#pragma unroll
            for (int m = 0; m < 4; ++m) { const size_t off = (size_t)(row0 + ai * HALF + m * 16) * DM + col0;
                float rsc = 1.0f;
                if (ssoff >= 0) { const GAS float* sp = (const GAS float*)(ws + WS_SSP) + row0 + ai * HALF + m * 16; float ssum = 0.f;
#pragma unroll
                    for (int hh = 0; hh < HG_HEADS; ++hh) ssum += sp[(size_t)hh * NTOK];
                    rsc = 1.0f / sqrtf(ssum * (1.0f / DM) + RMS_EPS); }
#pragma unroll
                for (int bj = 0; bj < 2; ++bj) { const v4u xs = *(const GAS v4u*)(X + off + bj * HALF); const f32x4 a0 = acc[ai][bj][m][0] * rsc, a1 = acc[ai][bj][m][1] * rsc;
                    v4u w; w.x = cvt_pk_bf16(bflo(xs.x) * DN_ALPHA + a0[0], bfhi(xs.x) * DN_ALPHA + a0[1]); w.y = cvt_pk_bf16(bflo(xs.y) * DN_ALPHA + a0[2], bfhi(xs.y) * DN_ALPHA + a0[3]);
                    w.z = cvt_pk_bf16(bflo(xs.z) * DN_ALPHA + a1[0], bfhi(xs.z) * DN_ALPHA + a1[1]); w.w = cvt_pk_bf16(bflo(xs.w) * DN_ALPHA + a1[2], bfhi(xs.w) * DN_ALPHA + a1[3]);
                    *(GAS v4u*)(Y + off + bj * HALF) = w; } }
    }
};
struct EpiMoeGU {
    static constexpr bool PERM = true;
    unsigned char* ws0; int L;
    __device__ __forceinline__ void operator()(const f32x4 (&acc)[2][2][4][2], const Unit& u, int wr, int wc, int fr, int fq) const {
        OPAQUE_LANE(fr, fq);
        GAS unsigned char* ws = launder(ws0);
        const GAS float* bias = (const GAS float*)(ws + WS_BGU) + (size_t)L * NE * 2048;
        const int row0 = u.rowbase + wr * 64 + fr; const int c8 = wc * 32 + 8 * fq;
        const GAS float* bp = bias + ((size_t)u.e * 8 + u.pn) * 256 + c8;
        const f32x4 bg0 = *(const GAS f32x4*)bp, bg1 = *(const GAS f32x4*)(bp + 4);
        const f32x4 bl0 = (*(const GAS f32x4*)(bp + HALF) + 1.0f) * ACT_SCALE, bl1 = (*(const GAS f32x4*)(bp + HALF + 4) + 1.0f) * ACT_SCALE;
#pragma unroll
        for (int ai = 0; ai < 2; ++ai)
#pragma unroll
            for (int m = 0; m < 4; ++m) { const size_t eo = (size_t)(row0 + ai * HALF + m * 16) * DM + u.pn * HALF + c8;
                float a[8];
#pragma unroll
                for (int j = 0; j < 8; ++j) {
                    const float g = fminf(fmaf(acc[ai][0][m][j >> 2][j & 3], GU_DESCALE, j < 4 ? bg0[j & 3] : bg1[j & 3]), 7.0f);
                    const float l1 = __builtin_amdgcn_fmed3f(fmaf(acc[ai][1][m][j >> 2][j & 3], GU_DESCALE * ACT_SCALE, j < 4 ? bl0[j & 3] : bl1[j & 3]), -6.0f * ACT_SCALE, 8.0f * ACT_SCALE);
                    a[j] = g * frcp(1.0f + __builtin_amdgcn_exp2f(g * -2.4554669595930156f)) * l1;
                }
#if MOE_FP8
                v2u w;
                { int p = __builtin_amdgcn_cvt_pk_fp8_f32(a[0], a[1], 0, false); p = __builtin_amdgcn_cvt_pk_fp8_f32(a[2], a[3], p, true); w.x = (unsigned)p; }
                { int p = __builtin_amdgcn_cvt_pk_fp8_f32(a[4], a[5], 0, false); p = __builtin_amdgcn_cvt_pk_fp8_f32(a[6], a[7], p, true); w.y = (unsigned)p; }
                *(GAS v2u*)(ws + WS_ACT + eo) = w;
#else
                v4u w; w.x = cvt_pk_bf16(a[0], a[1]); w.y = cvt_pk_bf16(a[2], a[3]); w.z = cvt_pk_bf16(a[4], a[5]); w.w = cvt_pk_bf16(a[6], a[7]);
                *(GAS v4u*)((GAS bf16*)(ws + WS_ACT) + eo) = w;
#endif
            }
    }
};
struct EpiMoeDown {
    static constexpr bool PERM = true;
    unsigned char* ws0; const float* bias;
    __device__ __forceinline__ void operator()(const f32x4 (&acc)[2][2][4][2], const Unit& u, int wr, int wc, int fr, int fq) const {
        OPAQUE_LANE(fr, fq);
        GAS unsigned char* ws = launder(ws0);
        GAS bf16* YS = (GAS bf16*)(ws + WS_YSLOT); const GAS int* rowdst = (const GAS int*)(ws + WS_ROWDST); const GAS float* rowgate = (const GAS float*)(ws + WS_ROWGATE);
        const int c8 = u.pn * BM + wc * 32 + 8 * fq;
        const GAS float* bp = (const GAS float*)bias + (size_t)u.e * DM + c8;
        f32x4 bv[2][2];
#pragma unroll
        for (int bj = 0; bj < 2; ++bj) { bv[bj][0] = *(const GAS f32x4*)(bp + bj * HALF); bv[bj][1] = *(const GAS f32x4*)(bp + bj * HALF + 4); }
#pragma unroll
        for (int ai = 0; ai < 2; ++ai)
#pragma unroll
            for (int m = 0; m < 4; ++m) { const int r = ai * HALF + wr * 64 + m * 16 + fr;
                if (r < u.cnt) {
                    const size_t ti = (size_t)u.gidx + r; const int dst = rowdst[ti]; const float gt = rowgate[ti];
#if YS_FP8
                    GAS unsigned char* rowp = (GAS unsigned char*)YS + (size_t)dst * DM + c8;
#pragma unroll
                    for (int bj = 0; bj < 2; ++bj) { const f32x4 v0 = (acc[ai][bj][m][0] * DN_DESCALE + bv[bj][0]) * (gt * 64.0f), v1 = (acc[ai][bj][m][1] * DN_DESCALE + bv[bj][1]) * (gt * 64.0f);
                        v2u w; w.x = pk4_fp8(v0[0], v0[1], v0[2], v0[3]); w.y = pk4_fp8(v1[0], v1[1], v1[2], v1[3]);
                        *(GAS v2u*)(rowp + bj * HALF) = w; } } }
#else
                    GAS bf16* rowp = YS + (size_t)dst * DM + c8;
#pragma unroll
                    for (int bj = 0; bj < 2; ++bj) { const f32x4 v0 = (acc[ai][bj][m][0] * DN_DESCALE + bv[bj][0]) * gt, v1 = (acc[ai][bj][m][1] * DN_DESCALE + bv[bj][1]) * gt;
                        v4u w; w.x = cvt_pk_bf16(v0[0], v0[1]); w.y = cvt_pk_bf16(v0[2], v0[3]); w.z = cvt_pk_bf16(v1[0], v1[1]); w.w = cvt_pk_bf16(v1[2], v1[3]);
                        *(GAS v4u*)(rowp + bj * HALF) = w; } } }
#endif
    }
};
}

typedef short s16x4 __attribute__((ext_vector_type(4)));
typedef __bf16 bf16x2_t __attribute__((ext_vector_type(2)));
__device__ __forceinline__ unsigned cvtpk(float lo, float hi) { f32x2 v = {lo, hi}; bf16x2_t b = __builtin_convertvector(v, bf16x2_t); return __builtin_bit_cast(unsigned, b); }
__device__ __forceinline__ s16x4 tr_read(const LAS unsigned char* p) { return __builtin_bit_cast(s16x4, __builtin_amdgcn_ds_read_tr16_b64_v4i16((LAS s16x4*)p)); }
__device__ __forceinline__ bf16x8 cat8(s16x4 lo, s16x4 hi) { return __builtin_shufflevector(lo, hi, 0, 1, 2, 3, 4, 5, 6, 7); }
__device__ __forceinline__ bf16x8 pack8(const f32x4& a, const f32x4& b) { v4u p; p.x = cvtpk(a[0], a[1]); p.y = cvtpk(a[2], a[3]); p.z = cvtpk(b[0], b[1]); p.w = cvtpk(b[2], b[3]); return __builtin_bit_cast(bf16x8, p); }
__device__ __forceinline__ s16x4 pack4(const f32x4& a) { v2u p; p.x = cvtpk(a[0], a[1]); p.y = cvtpk(a[2], a[3]); return __builtin_bit_cast(s16x4, p); }
#define LDS_BARRIER() do { asm volatile("s_waitcnt lgkmcnt(0)" ::: "memory"); __builtin_amdgcn_s_barrier(); asm volatile("" ::: "memory"); } while (0)
#define MFMA32(a, b, c) __builtin_amdgcn_mfma_f32_16x16x32_bf16((a), (b), (c), 0, 0, 0)
#define MFMA16(a, b, c) __builtin_amdgcn_mfma_f32_16x16x16bf16_1k((a), (b), (c), 0, 0, 0)

__device__ __forceinline__ void ret_fast(const int tid, LAS unsigned char* lds, const bf16* HB, bf16* OB) {
    constexpr int QP = 528, VP = 272, PP = 144;
    constexpr int OFF_Q = 0, OFF_K = 64 * QP, OFF_V = 2 * 64 * QP, OFF_P = OFF_V + 64 * VP;
    const int lane0 = tid & 63, w = __builtin_amdgcn_readfirstlane(tid >> 6);
    const int prow = tid >> 3, pc = tid & 7;
    for (int un0 = blockIdx.x; un0 < NBATCH * RT_HEADS * 4; un0 += gridDim.x) {
        const int un = (gridDim.x == 256) ? ((un0 & 7) * 32 + (un0 >> 3)) : un0;
        const int b = un >> 4, h = (un >> 2) & 3, vs = un & 3;
        const float l2g = __builtin_amdgcn_logf(1.0f - __builtin_amdgcn_exp2f(-5.0f - (float)h));
        const float dC = __builtin_amdgcn_exp2f(64.0f * l2g);
        f32x4 st[16];
#pragma unroll
        for (int i = 0; i < 16; ++i) st[i] = (f32x4){0.f, 0.f, 0.f, 0.f};
        const bf16* gbase = HB + (size_t)(b * SEQ + prow) * RT_IN;
        v4u pq[4], pk[4], pv[2];
#pragma unroll
        for (int j = 0; j < 4; ++j) { pq[j] = *(const v4u*)(gbase + h * 256 + (pc + 8 * j) * 8); pk[j] = *(const v4u*)(gbase + 1024 + h * 256 + (pc + 8 * j) * 8); }
#pragma unroll
        for (int j = 0; j < 2; ++j) pv[j] = *(const v4u*)(gbase + 2048 + h * 512 + vs * 128 + (pc + 8 * j) * 8);
#pragma unroll 1
        for (int ch = 0; ch < SEQ / 64; ++ch) {
            int lane = lane0; asm volatile("" : "+v"(lane));
            const int r = lane & 15, g = lane >> 4, q4 = (lane & 15) >> 2, p4 = lane & 3;
            LDS_BARRIER();
#pragma unroll
            for (int j = 0; j < 4; ++j) { *(LAS v4u*)(lds + OFF_Q + prow * QP + (pc + 8 * j) * 16) = pq[j]; *(LAS v4u*)(lds + OFF_K + prow * QP + (pc + 8 * j) * 16) = pk[j]; }
#pragma unroll
            for (int j = 0; j < 2; ++j) *(LAS v4u*)(lds + OFF_V + prow * VP + (pc + 8 * j) * 16) = pv[j];
            if (ch + 1 < SEQ / 64) {
                const bf16* gn = gbase + (size_t)(ch + 1) * 64 * RT_IN;
#pragma unroll
                for (int j = 0; j < 4; ++j) { pq[j] = *(const v4u*)(gn + h * 256 + (pc + 8 * j) * 8); pk[j] = *(const v4u*)(gn + 1024 + h * 256 + (pc + 8 * j) * 8); }
#pragma unroll
                for (int j = 0; j < 2; ++j) pv[j] = *(const v4u*)(gn + 2048 + h * 512 + vs * 128 + (pc + 8 * j) * 8);
            }
            LDS_BARRIER();
            {
                const int ct = w >> 1, st0 = 2 * (w & 1);
                f32x4 sa0 = {0.f, 0.f, 0.f, 0.f}, sa1 = {0.f, 0.f, 0.f, 0.f};
                const LAS unsigned char* qb = lds + OFF_Q + (16 * ct + r) * QP + g * 16;
                const LAS unsigned char* kb0 = lds + OFF_K + (16 * st0 + r) * QP + g * 16;
#pragma unroll
                for (int hb = 0; hb < 4; ++hb) {
                    bf16x8 qf[2], k0[2], k1[2];
#pragma unroll
                    for (int kk = 0; kk < 2; ++kk) { const int kb = hb * 2 + kk; qf[kk] = *(const LAS bf16x8*)(qb + kb * 64); k0[kk] = *(const LAS bf16x8*)(kb0 + kb * 64); k1[kk] = *(const LAS bf16x8*)(kb0 + 16 * QP + kb * 64); }
                    asm volatile("" : "+v"(qf[0]), "+v"(qf[1]), "+v"(k0[0]), "+v"(k0[1]), "+v"(k1[0]), "+v"(k1[1]) :: "memory");
#pragma unroll
                    for (int kk = 0; kk < 2; ++kk) { sa0 = MFMA32(k0[kk], qf[kk], sa0); sa1 = MFMA32(k1[kk], qf[kk], sa1); }
                }
                const int c = 16 * ct + r;
#pragma unroll
                for (int t = 0; t < 2; ++t) {
                    const f32x4 sa = t ? sa1 : sa0; const int s0 = 16 * (st0 + t) + 4 * g; float v[4];
#pragma unroll
                    for (int i = 0; i < 4; ++i) { const int d = c - (s0 + i); v[i] = d >= 0 ? sa[i] * __builtin_amdgcn_exp2f((float)d * l2g) : 0.f; }
                    v2u pw; pw.x = cvtpk(v[0], v[1]); pw.y = cvtpk(v[2], v[3]);
                    *(LAS v2u*)(lds + OFF_P + c * PP + s0 * 2) = pw;
                }
            }
            LDS_BARRIER();
            f32x4 o[4];
#pragma unroll
            for (int ct = 0; ct < 4; ++ct) o[ct] = (f32x4){0.f, 0.f, 0.f, 0.f};
            {
                s16x4 ql[2][4], qh[2][4];
                const LAS unsigned char* qp0 = lds + OFF_Q + r * QP + (4 * g) * 2;
#pragma unroll
                for (int ct = 0; ct < 4; ++ct) { ql[0][ct] = *(const LAS s16x4*)(qp0 + ct * 16 * QP); qh[0][ct] = *(const LAS s16x4*)(qp0 + ct * 16 * QP + 32); }
#pragma unroll
                for (int kb = 0; kb < 8; ++kb) {
                    const int cu = kb & 1, nx = cu ^ 1;
                    if (kb + 1 < 8) {
#pragma unroll
                        for (int ct = 0; ct < 4; ++ct) { ql[nx][ct] = *(const LAS s16x4*)(qp0 + ct * 16 * QP + (kb + 1) * 64); qh[nx][ct] = *(const LAS s16x4*)(qp0 + ct * 16 * QP + (kb + 1) * 64 + 32); }
                    }
                    asm volatile("" : "+v"(ql[cu][0]), "+v"(ql[cu][1]), "+v"(ql[cu][2]), "+v"(ql[cu][3]), "+v"(qh[cu][0]), "+v"(qh[cu][1]), "+v"(qh[cu][2]), "+v"(qh[cu][3]) :: "memory");
                    const bf16x8 sa = pack8(st[2 * kb], st[2 * kb + 1]);
#pragma unroll
                    for (int ct = 0; ct < 4; ++ct) o[ct] = MFMA32(sa, cat8(ql[cu][ct], qh[cu][ct]), o[ct]);
                }
            }
            bf16x8 vf[2], pf[6];
            {
                s16x4 t0[2], t1[2];
#pragma unroll
                for (int sb = 0; sb < 2; ++sb) { const LAS unsigned char* vp = lds + OFF_V + (32 * sb + 8 * g + q4) * VP + (16 * w + 4 * p4) * 2; t0[sb] = tr_read(vp); t1[sb] = tr_read(vp + 4 * VP); }
                pf[0] = *(const LAS bf16x8*)(lds + OFF_P + (0 + r) * PP + (8 * g) * 2);
                pf[1] = *(const LAS bf16x8*)(lds + OFF_P + (16 + r) * PP + (8 * g) * 2);
                pf[2] = *(const LAS bf16x8*)(lds + OFF_P + (32 + r) * PP + (8 * g) * 2);
                pf[3] = *(const LAS bf16x8*)(lds + OFF_P + (32 + r) * PP + (32 + 8 * g) * 2);
                pf[4] = *(const LAS bf16x8*)(lds + OFF_P + (48 + r) * PP + (8 * g) * 2);
                pf[5] = *(const LAS bf16x8*)(lds + OFF_P + (48 + r) * PP + (32 + 8 * g) * 2);
                asm volatile("" : "+v"(t0[0]), "+v"(t0[1]), "+v"(t1[0]), "+v"(t1[1]), "+v"(pf[0]), "+v"(pf[1]), "+v"(pf[2]), "+v"(pf[3]), "+v"(pf[4]), "+v"(pf[5]) :: "memory");
                vf[0] = cat8(t0[0], t1[0]); vf[1] = cat8(t0[1], t1[1]);
            }
#pragma unroll
            for (int ct = 0; ct < 4; ++ct) o[ct] = o[ct] * __builtin_amdgcn_exp2f((float)(16 * ct + r + 1) * l2g);
            o[0] = MFMA32(vf[0], pf[0], o[0]); o[1] = MFMA32(vf[0], pf[1], o[1]);
            o[2] = MFMA32(vf[0], pf[2], o[2]); o[2] = MFMA32(vf[1], pf[3], o[2]);
            o[3] = MFMA32(vf[0], pf[4], o[3]); o[3] = MFMA32(vf[1], pf[5], o[3]);
            {
                bf16* ob = OB + (size_t)(b * SEQ + ch * 64 + r) * RT_VD + h * 512 + vs * 128 + 16 * w + 4 * g;
#pragma unroll
                for (int ct = 0; ct < 4; ++ct) { v2u ow; ow.x = cvtpk(o[ct][0], o[ct][1]); ow.y = cvtpk(o[ct][2], o[ct][3]); *(v2u*)(ob + (size_t)ct * 16 * RT_VD) = ow; }
            }
            bf16x8 vz[2];
#pragma unroll
            for (int sb = 0; sb < 2; ++sb) {
                const v4u raw = __builtin_bit_cast(v4u, vf[sb]); float f[8] = {bflo(raw.x), bfhi(raw.x), bflo(raw.y), bfhi(raw.y), bflo(raw.z), bfhi(raw.z), bflo(raw.w), bfhi(raw.w)};
#pragma unroll
                for (int j = 0; j < 8; ++j) f[j] *= __builtin_amdgcn_exp2f((float)(63 - (32 * sb + 8 * g + j)) * l2g);
                v4u z; z.x = cvtpk(f[0], f[1]); z.y = cvtpk(f[2], f[3]); z.z = cvtpk(f[4], f[5]); z.w = cvtpk(f[6], f[7]); vz[sb] = __builtin_bit_cast(bf16x8, z);
            }
            {
                const LAS unsigned char* kp0 = lds + OFF_K + (8 * g + q4) * QP + (4 * p4) * 2;
#pragma unroll
                for (int kq = 0; kq < 4; ++kq) {
                    s16x4 ka[4][2], kbh[4][2];
#pragma unroll
                    for (int j = 0; j < 4; ++j)
#pragma unroll
                        for (int sb = 0; sb < 2; ++sb) { const LAS unsigned char* kp = kp0 + (32 * sb) * QP + (16 * (kq * 4 + j)) * 2; ka[j][sb] = tr_read(kp); kbh[j][sb] = tr_read(kp + 4 * QP); }
                    asm volatile("" : "+v"(ka[0][0]), "+v"(ka[0][1]), "+v"(ka[1][0]), "+v"(ka[1][1]), "+v"(ka[2][0]), "+v"(ka[2][1]), "+v"(ka[3][0]), "+v"(ka[3][1]),
                                      "+v"(kbh[0][0]), "+v"(kbh[0][1]), "+v"(kbh[1][0]), "+v"(kbh[1][1]), "+v"(kbh[2][0]), "+v"(kbh[2][1]), "+v"(kbh[3][0]), "+v"(kbh[3][1]) :: "memory");
#pragma unroll
                    for (int j = 0; j < 4; ++j) { const int kt = kq * 4 + j;
                        st[kt] = st[kt] * dC;
                        st[kt] = MFMA32(cat8(ka[j][0], kbh[j][0]), vz[0], st[kt]);
                        st[kt] = MFMA32(cat8(ka[j][1], kbh[j][1]), vz[1], st[kt]); }
                }
            }
        }
        LDS_BARRIER();
    }
}

__device__ __forceinline__ void hgrn_fast(const int tid, LAS unsigned char* lds, const bf16* QD, const bf16* KI, const bf16* GG, const bf16* VV, const float* DEC, const float* ng, bf16* A2, float* SS) {
    constexpr int TP = 272;
    constexpr int OFF_QD = 0, OFF_KI = 64 * TP, OFF_G = 2 * 64 * TP, OFF_V = 3 * 64 * TP, OFF_DEC = 4 * 64 * TP, OFF_SS = OFF_DEC + 2048;
    const int lane = tid & 63, w = __builtin_amdgcn_readfirstlane(tid >> 6), r = lane & 15, g = lane >> 4, q4 = (lane & 15) >> 2, p4 = lane & 3;
    const int prow = tid >> 3, pc = tid & 7;
    for (int un = blockIdx.x; un < NBATCH * HG_HEADS; un += gridDim.x) {
        const int b = un >> 3, h = un & 7;
        f32x4 st[8];
#pragma unroll
        for (int i = 0; i < 8; ++i) st[i] = (f32x4){0.f, 0.f, 0.f, 0.f};
        const f32x4 ng4 = *(const f32x4*)(ng + h * 128 + 16 * w + 4 * g);
        const size_t goff = (size_t)(b * SEQ + prow) * DM + h * 128;
        v4u p0[2], p1[2], p2[2], p3[2]; f32x4 pd = {0.f, 0.f, 0.f, 0.f};
#pragma unroll
        for (int j = 0; j < 2; ++j) { const size_t o = goff + (pc + 8 * j) * 8; p0[j] = *(const v4u*)(QD + o); p1[j] = *(const v4u*)(KI + o); p2[j] = *(const v4u*)(GG + o); p3[j] = *(const v4u*)(VV + o); }
        if (tid < 128) pd = *(const f32x4*)(DEC + (size_t)((b * SEQ) / 16 + (tid >> 5)) * DM + h * 128 + (tid & 31) * 4);
#pragma unroll 1
        for (int rd = 0; rd < SEQ / 64; ++rd) {
            LDS_BARRIER();
            if (rd > 0 && tid < 64) {
                float s = 0.f;
#pragma unroll
                for (int ww = 0; ww < 8; ++ww) s += *(const LAS float*)(lds + OFF_SS + (ww * 64 + tid) * 4);
                SS[(size_t)h * NTOK + (size_t)b * SEQ + (rd - 1) * 64 + tid] = s;
            }
#pragma unroll
            for (int j = 0; j < 2; ++j) { const int lo = prow * TP + (pc + 8 * j) * 16; *(LAS v4u*)(lds + OFF_QD + lo) = p0[j]; *(LAS v4u*)(lds + OFF_KI + lo) = p1[j]; *(LAS v4u*)(lds + OFF_G + lo) = p2[j]; *(LAS v4u*)(lds + OFF_V + lo) = p3[j]; }
            if (tid < 128) *(LAS f32x4*)(lds + OFF_DEC + tid * 16) = pd;
            if (rd + 1 < SEQ / 64) {
                const size_t gn = goff + (size_t)(rd + 1) * 64 * DM;
#pragma unroll
                for (int j = 0; j < 2; ++j) { const size_t o = gn + (pc + 8 * j) * 8; p0[j] = *(const v4u*)(QD + o); p1[j] = *(const v4u*)(KI + o); p2[j] = *(const v4u*)(GG + o); p3[j] = *(const v4u*)(VV + o); }
                if (tid < 128) pd = *(const f32x4*)(DEC + (size_t)((b * SEQ + (rd + 1) * 64) / 16 + (tid >> 5)) * DM + h * 128 + (tid & 31) * 4);
            }
            LDS_BARRIER();
#pragma unroll 1
            for (int cc = 0; cc < 4; ++cc) {
                s16x4 ql[4], qh[4], kl[4], kh[4], ktr[8]; f32x4 d4[8];
#pragma unroll
                for (int kb = 0; kb < 4; ++kb) {
                    const int off = (16 * cc + r) * TP + (32 * kb + 4 * g) * 2;
                    ql[kb] = *(const LAS s16x4*)(lds + OFF_QD + off); qh[kb] = *(const LAS s16x4*)(lds + OFF_QD + off + 32);
                    kl[kb] = *(const LAS s16x4*)(lds + OFF_KI + off); kh[kb] = *(const LAS s16x4*)(lds + OFF_KI + off + 32);
                }
                s16x4 vfr = tr_read(lds + OFF_V + (16 * cc + 4 * g + q4) * TP + (16 * w + 4 * p4) * 2);
                s16x4 gfr = *(const LAS s16x4*)(lds + OFF_G + (16 * cc + r) * TP + (16 * w + 4 * g) * 2);
#pragma unroll
                for (int kt = 0; kt < 8; ++kt) {
                    d4[kt] = *(const LAS f32x4*)(lds + OFF_DEC + cc * 512 + (16 * kt + 4 * g) * 4);
                    ktr[kt] = tr_read(lds + OFF_KI + (16 * cc + 4 * g + q4) * TP + (16 * kt + 4 * p4) * 2);
                }
                asm volatile("" : "+v"(ql[0]), "+v"(ql[1]), "+v"(ql[2]), "+v"(ql[3]), "+v"(qh[0]), "+v"(qh[1]), "+v"(qh[2]), "+v"(qh[3]),
                                  "+v"(kl[0]), "+v"(kl[1]), "+v"(kl[2]), "+v"(kl[3]), "+v"(kh[0]), "+v"(kh[1]), "+v"(kh[2]), "+v"(kh[3]), "+v"(vfr), "+v"(gfr));
                asm volatile("" : "+v"(ktr[0]), "+v"(ktr[1]), "+v"(ktr[2]), "+v"(ktr[3]), "+v"(ktr[4]), "+v"(ktr[5]), "+v"(ktr[6]), "+v"(ktr[7]),
                                  "+v"(d4[0]), "+v"(d4[1]), "+v"(d4[2]), "+v"(d4[3]), "+v"(d4[4]), "+v"(d4[5]), "+v"(d4[6]), "+v"(d4[7]));
                bf16x8 qf[4];
#pragma unroll
                for (int kb = 0; kb < 4; ++kb) qf[kb] = cat8(ql[kb], qh[kb]);
                f32x4 sc = {0.f, 0.f, 0.f, 0.f}, oa = {0.f, 0.f, 0.f, 0.f};
#pragma unroll
                for (int kb = 0; kb < 4; ++kb) sc = MFMA32(cat8(kl[kb], kh[kb]), qf[kb], sc);
#pragma unroll
                for (int kb = 0; kb < 4; ++kb) oa = MFMA32(pack8(st[2 * kb], st[2 * kb + 1]), qf[kb], oa);
#pragma unroll
                for (int kt = 0; kt < 8; ++kt) st[kt] = MFMA16(ktr[kt], vfr, st[kt]) * d4[kt];
#pragma unroll
                for (int i = 0; i < 4; ++i) sc[i] = (4 * g + i <= r) ? sc[i] : 0.f;
                oa = MFMA16(vfr, pack4(sc), oa);
                { const v2u gr = __builtin_bit_cast(v2u, gfr);
                  v2u ow; ow.x = cvtpk(oa[0] * ng4[0] * bflo(gr.x), oa[1] * ng4[1] * bfhi(gr.x)); ow.y = cvtpk(oa[2] * ng4[2] * bflo(gr.y), oa[3] * ng4[3] * bfhi(gr.y));
                  *(v2u*)(A2 + (size_t)(b * SEQ + rd * 64 + cc * 16 + r) * DM + h * 128 + 16 * w + 4 * g) = ow;
                  float p = (oa[0] * oa[0] + oa[1] * oa[1]) + (oa[2] * oa[2] + oa[3] * oa[3]);
                  p += __shfl_xor(p, 16); p += __shfl_xor(p, 32);
                  if (lane < 16) *(LAS float*)(lds + OFF_SS + (w * 64 + cc * 16 + r) * 4) = p; }
            }
        }
        LDS_BARRIER();
        if (tid < 64) { float s = 0.f;
#pragma unroll
            for (int ww = 0; ww < 8; ++ww) s += *(const LAS float*)(lds + OFF_SS + (ww * 64 + tid) * 4);
            SS[(size_t)h * NTOK + (size_t)b * SEQ + (SEQ / 64 - 1) * 64 + tid] = s; }
        LDS_BARRIER();
    }
}

struct Args { const float* in[17]; float* out; unsigned char* ws; int ph_lo, ph_hi; };
enum { I_X = 0, I_HWIN, I_HNG, I_HWOUT, I_LB, I_RWIN, I_RWOUT, I_LNMG, I_LNMB, I_LNFG, I_LNFB, I_RW, I_RB, I_WGU, I_BGU, I_WDN, I_BDN };

__device__ __forceinline__ int dest_row(int mode, int n) {
    if (mode == 1) { if (n < 1024) return ((n >> 7) << 8) + (n & 127); if (n < 2048) { const int q = n - 1024; return ((q >> 7) << 8) + 128 + (q & 127); } return n; }
    if (mode == 2) { const int j2 = n >> 1; return ((j2 >> 7) << 8) + ((n & 1) << 7) + (j2 & 127); }
    return n;
}
__device__ __forceinline__ void transpose_item(const float* W, int K, int N, bf16* WT, int mode, LAS float* scr, int item, int lane) {
    const int nblk = N / 64, kb = item / nblk, nb = item % nblk, k0 = 64 * kb, n0 = 64 * nb;
#pragma unroll 4
    for (int i = 0; i < 16; ++i) { const int kk = 4 * i + (lane >> 4), c4 = (lane & 15) * 4;
        const f32x4 v = *(const GAS f32x4*)(W + (size_t)(k0 + kk) * N + n0 + c4);
        LAS float* s = scr + kk * 65 + c4; s[0] = v[0]; s[1] = v[1]; s[2] = v[2]; s[3] = v[3]; }
    LDS_WAIT(); asm volatile("" ::: "memory");
    const int c = lane & 7;
#pragma unroll 2
    for (int j = 0; j < 8; ++j) { const int n = (lane >> 3) + 8 * j; const LAS float* s = scr + (8 * c) * 65 + n;
        v4u o; o.x = pk2(s[0 * 65], s[1 * 65]); o.y = pk2(s[2 * 65], s[3 * 65]); o.z = pk2(s[4 * 65], s[5 * 65]); o.w = pk2(s[6 * 65], s[7 * 65]);
        *(GAS v4u*)(WT + (size_t)dest_row(mode, n0 + n) * K + k0 + 8 * c) = o; }
    LDS_WAIT(); asm volatile("" ::: "memory");
}

__device__ __forceinline__ void transpose_item_fp8(const float* W, int K, int N, unsigned char* WT, int mode, float scale, LAS float* scr, int item, int lane) {
    const int nblk = N / 64, kb = item / nblk, nb = item % nblk, k0 = 64 * kb, n0 = 64 * nb;
#pragma unroll 4
    for (int i = 0; i < 16; ++i) { const int kk = 4 * i + (lane >> 4), c4 = (lane & 15) * 4;
        const f32x4 v = *(const GAS f32x4*)(W + (size_t)(k0 + kk) * N + n0 + c4);
        LAS float* s = scr + kk * 65 + c4; s[0] = v[0]; s[1] = v[1]; s[2] = v[2]; s[3] = v[3]; }
    LDS_WAIT(); asm volatile("" ::: "memory");
    const int c = lane & 7;
#pragma unroll 2
    for (int j = 0; j < 8; ++j) { const int n = (lane >> 3) + 8 * j; const LAS float* s = scr + (8 * c) * 65 + n;
        v2u o; o.x = pk4_fp8(s[0 * 65] * scale, s[1 * 65] * scale, s[2 * 65] * scale, s[3 * 65] * scale); o.y = pk4_fp8(s[4 * 65] * scale, s[5 * 65] * scale, s[6 * 65] * scale, s[7 * 65] * scale);
        *(GAS v2u*)(WT + (size_t)dest_row(mode, n0 + n) * K + k0 + 8 * c) = o; }
    LDS_WAIT(); asm volatile("" ::: "memory");
}

#ifndef SITE_MASK
#define SITE_MASK 0xffff
#endif
#define SITE(n) (((SITE_MASK) >> (n)) & 1)
#ifndef PROBE_MASK
#define PROBE_MASK 0
#endif
#define REP(n) (1 + (((PROBE_MASK) >> (n)) & 1))
typedef const __attribute__((address_space(4))) Args* KArgs;
__device__ __forceinline__ int otid(int wave0) { int l; asm volatile("v_mbcnt_lo_u32_b32 %0, -1, 0\n\tv_mbcnt_hi_u32_b32 %0, -1, %0" : "=v"(l)); asm volatile("" : "+s"(wave0)); return wave0 * 64 + l; }
__device__ __forceinline__ LAS unsigned char* olds(LAS unsigned char* p) { asm volatile("" : "+s"(p)); return p; }
__device__ __forceinline__ KArgs kargs() { KArgs p = (KArgs)__builtin_amdgcn_kernarg_segment_ptr(); asm volatile("" : "+s"(p)); return p; }
#define IN(k) (ap->ph_lo <= (k) && (k) < ap->ph_hi)
#ifndef PROBE_BAR
#define PROBE_BAR 1
#endif
#define GRID_BAR() for (int _r = 0; _r < PROBE_BAR; ++_r) do { if (ap->ph_hi - ap->ph_lo > 1) { XcdBarrier _b; _b.bar = (unsigned*)(ap->ws + WS_CTL) + CW_BAR; _b.x = xb_xcc_id(); _b.st = (volatile LAS unsigned*)(lds + MISC_OFF + MO_BARW); xcd_barrier(_b); } } while (0)
#define VCU() ((gridDim.x % 8 == 0) ? (int)((blockIdx.x % 8) * (gridDim.x / 8) + blockIdx.x / 8) : (int)blockIdx.x)

__global__ void __launch_bounds__(512, 2) mk_fwd(Args args_unused) {
    extern __shared__ __attribute__((aligned(16))) unsigned char lds_raw[];
    LAS unsigned char* const lds0 = (LAS unsigned char*)lds_raw;
    const int wave0 = __builtin_amdgcn_readfirstlane((int)(threadIdx.x >> 6));
    {
        LAS unsigned char* lds = lds0;
        for (int u = threadIdx.x; u < (LDS_BYTES - MISC_OFF) / 4; u += 512) ((LAS unsigned*)(lds + MISC_OFF))[u] = 0u;
        __syncthreads();
        KArgs ap = kargs();
        if (ap->ph_hi - ap->ph_lo > 1) (void)xcd_barrier_post((unsigned*)(ap->ws + WS_CTL) + CW_BAR, (volatile LAS unsigned*)(lds + MISC_OFF + MO_BARW));
    }

#if SITE(0)
    { KArgs ap = kargs(); const int tid = otid(wave0); LAS unsigned char* lds = olds(lds0); (void)tid;
    if (IN(0)) for (int rep_ = 0; rep_ < REP(0); ++rep_) {
        const int lane = tid & 63, wave = __builtin_amdgcn_readfirstlane(tid >> 6), G = gridDim.x, vcu = VCU(), gw = vcu * 8 + wave, NGW = G * 8;
        unsigned char* ws = ap->ws;
        LAS float* scr = (LAS float*)(lds + wave * 16640);
        constexpr int I_HIN = 2 * 16 * 64, I_HOUT = 2 * 16 * 16, I_RIN = 2 * 16 * 96, I_ROUT = 2 * 32 * 16, I_GU = 128 * 16 * 32, I_DN = 128 * 16 * 16;
        constexpr int NITEMS = I_HIN + I_HOUT + I_RIN + I_ROUT + I_GU + I_DN;
        for (int it = gw; it < NITEMS; it += NGW) {
            int r = it;
            if (r < I_HIN) { const int j = r / (16 * 64); transpose_item(ap->in[I_HWIN] + (size_t)j * DM * HG_IN, DM, HG_IN, (bf16*)(ws + WS_W_HIN) + (size_t)j * HG_IN * DM, 1, scr, r % (16 * 64), lane); continue; } r -= I_HIN;
            if (r < I_HOUT) { const int j = r / 256; transpose_item(ap->in[I_HWOUT] + (size_t)j * DM * DM, DM, DM, (bf16*)(ws + WS_W_HOUT) + (size_t)j * DM * DM, 0, scr, r % 256, lane); continue; } r -= I_HOUT;
            if (r < I_RIN) { const int j = r / (16 * 96); transpose_item(ap->in[I_RWIN] + (size_t)j * DM * RT_IN, DM, RT_IN, (bf16*)(ws + WS_W_RIN) + (size_t)j * RT_IN * DM, 0, scr, r % (16 * 96), lane); continue; } r -= I_RIN;
            if (r < I_ROUT) { const int j = r / 512; transpose_item(ap->in[I_RWOUT] + (size_t)j * RT_VD * DM, RT_VD, DM, (bf16*)(ws + WS_W_ROUT) + (size_t)j * DM * RT_VD, 0, scr, r % 512, lane); continue; } r -= I_ROUT;
#if MOE_FP8
            if (r < I_GU) { const int j = r / 512; transpose_item_fp8(ap->in[I_WGU] + (size_t)j * DM * 2048, DM, 2048, ws + WS_W_GU + (size_t)j * 2048 * DM, 2, WGU_SCALE, scr, r % 512, lane); continue; } r -= I_GU;
            { const int j = r / 256; transpose_item_fp8(ap->in[I_WDN] + (size_t)j * DM * DM, DM, DM, ws + WS_W_DN + (size_t)j * DM * DM, 0, WDN_SCALE, scr, r % 256, lane); }
#else
            if (r < I_GU) { const int j = r / 512; transpose_item(ap->in[I_WGU] + (size_t)j * DM * 2048, DM, 2048, (bf16*)(ws + WS_W_GU) + (size_t)j * 2048 * DM, 2, scr, r % 512, lane); continue; } r -= I_GU;
            { const int j = r / 256; transpose_item(ap->in[I_WDN] + (size_t)j * DM * DM, DM, DM, (bf16*)(ws + WS_W_DN) + (size_t)j * DM * DM, 0, scr, r % 256, lane); }
#endif
        }
        const int gt = vcu * 512 + tid, NGT = G * 512;
        float* LBS = (float*)(ws + WS_LBS); float* BGU = (float*)(ws + WS_BGU); float* ROT = (float*)(ws + WS_ROT); bf16* XB = (bf16*)(ws + WS_XB);
        for (int d = gt; d < DM; d += NGT) { const float* lbp = ap->in[I_LB]; const float v0 = lbp[d], v1 = lbp[DM + d], v2 = lbp[2 * DM + d], v3 = lbp[3 * DM + d]; const float mx = fmaxf(fmaxf(v0, v1), fmaxf(v2, v3));
            const float e0 = __expf(v0 - mx), e1 = __expf(v1 - mx), e2 = __expf(v2 - mx), e3 = __expf(v3 - mx), is = 1.0f / (e0 + e1 + e2 + e3);
            LBS[d] = 0.f; LBS[DM + d] = e1 * is; LBS[2 * DM + d] = (e1 + e2) * is; LBS[3 * DM + d] = (e1 + e2 + e3) * is; }
        for (int i = gt; i < SEQ * 128; i += NGT) { const int pos = i >> 7, p = i & 127; const float inv = 1.0f / __builtin_amdgcn_exp2f(13.287712379549449f * ((float)p / 127.0f)); const float th = (float)pos * inv;
            double rev = (double)th * 0.15915494309189535; rev -= floor(rev); const float fr = (float)rev; ROT[2 * i] = __builtin_amdgcn_cosf(fr); ROT[2 * i + 1] = __builtin_amdgcn_sinf(fr); }
        for (int i = gt; i < 4 * DM * NE; i += NGT) { const int l = i >> 15, d = (i >> 5) & 1023, e = i & 31; const float wv = ap->in[I_RW][i]; const unsigned hb = f2bf(wv); const float hv = __builtin_bit_cast(float, hb << 16);
            ((bf16*)(ws + WS_WRH))[(size_t)l * 32768 + e * 1024 + d] = (bf16)hb; ((bf16*)(ws + WS_WRL))[(size_t)l * 32768 + e * 1024 + d] = (bf16)f2bf(wv - hv); }
        for (int i = gt; i < 4 * 32 * 2048; i += NGT) { const int le = i >> 11, n = i & 2047; BGU[(size_t)le * 2048 + dest_row(2, n)] = ap->in[I_BGU][i]; }
        for (size_t i = (size_t)gt; i < (size_t)NTOK * DM / 4; i += NGT) { const f32x4 v = ((const f32x4*)ap->in[I_X])[i]; v2u o; o.x = pk2(v[0], v[1]); o.y = pk2(v[2], v[3]); ((v2u*)XB)[i] = o; }
        GRID_BAR();
    } }
#endif

#pragma unroll 1
    for (int L = 0; L < DEPTH; ++L) {
        const int pb = 1 + 8 * L;
        if ((L & 1) == 0) {
#if SITE(1)
            { KArgs ap = kargs(); const int tid = otid(wave0); LAS unsigned char* lds = olds(lds0); (void)tid;
            if (IN(pb + 0)) for (int rep_ = 0; rep_ < REP(1); ++rep_) {
                unsigned char* ws = ap->ws; const int j = L >> 1;
                LAS int* ul = (LAS int*)(lds + MISC_OFF + MO_ULIST);
                pg8::build_units_dense(tid, ul, NTOK / 256, HG_IN / 256, DM * 2);
                pg8::EpiHgrnIn E{ws, L};
                pg8::gemm_phase<pg8::EpiHgrnIn, false, true, false>(tid, lds, ul, (LAS int*)(lds + MISC_OFF + MO_GTAB), (const char*)(ws + WS_XB), (const char*)((bf16*)(ws + WS_W_HIN) + (size_t)j * HG_IN * DM), nullptr, DM * 2, E);
                GRID_BAR();
            } }
#endif
#if SITE(2)
            { KArgs ap = kargs(); const int tid = otid(wave0); LAS unsigned char* lds = olds(lds0); (void)tid;
            if (IN(pb + 1)) for (int rep_ = 0; rep_ < REP(2); ++rep_) {
#if !SLOW_HGRN
                { unsigned char* ws = ap->ws; const bf16* QD = (const bf16*)(ws + WS_H);
                  hgrn_fast(tid, lds, QD, QD + (size_t)NTOK * DM, QD + 4 * (size_t)NTOK * DM, QD + 3 * (size_t)NTOK * DM, (const float*)(ws + WS_DEC), ap->in[I_HNG] + (L >> 1) * DM,
                            (bf16*)(ws + WS_A2), (float*)(ws + WS_SSP)); }
#else
                unsigned char* ws = ap->ws; const bf16* QD = (const bf16*)(ws + WS_H); const bf16* KI = QD + (size_t)NTOK * DM; const bf16* KS = QD + 2 * (size_t)NTOK * DM; const bf16* VV = QD + 3 * (size_t)NTOK * DM; bf16* OB = (bf16*)(ws + WS_O);
                LAS float* qf = (LAS float*)lds; LAS float* kf = qf + 16 * 4 * 36; LAS float* ff = kf + 16 * 4 * 36; LAS float* vf = ff + 16 * 4 * 36;
                for (int un = blockIdx.x; un < NBATCH * HG_HEADS; un += gridDim.x) {
                    const int b = un >> 3, h = un & 7; const int vc = tid >> 2, kq = tid & 3;
                    float st[32];
#pragma unroll
                    for (int i = 0; i < 32; ++i) st[i] = 0.f;
                    for (int t0 = 0; t0 < SEQ; t0 += 16) {
                        __syncthreads();
                        for (int e = tid; e < 16 * 128; e += 512) { const int tt = e >> 7, k = e & 127; const size_t gi = (size_t)(b * SEQ + t0 + tt) * DM + h * 128 + k; const int li = tt * 144 + (k & 3) * 36 + (k >> 2);
                            qf[li] = bf1(QD[gi]); kf[li] = bf1(KI[gi]); ff[li] = bf1(KS[gi]); vf[tt * 128 + k] = bf1(VV[gi]); }
                        __syncthreads();
                        for (int tt = 0; tt < 16; ++tt) {
                            const float v = vf[tt * 128 + vc]; float a = 0.f; const int lb = tt * 144 + kq * 36;
#pragma unroll
                            for (int i = 0; i < 32; ++i) { st[i] = ff[lb + i] * st[i] + kf[lb + i] * v; a += qf[lb + i] * st[i]; }
                            a += __shfl_xor(a, 1); a += __shfl_xor(a, 2);
                            if (kq == 0) OB[(size_t)(b * SEQ + t0 + tt) * DM + h * 128 + vc] = (bf16)f2bf(a);
                        }
                    }
                }
#endif
                GRID_BAR();
            } }
#endif
#if SITE(3) && SLOW_HGRN
            { KArgs ap = kargs(); const int tid = otid(wave0); LAS unsigned char* lds = olds(lds0); (void)tid;
            if (IN(pb + 2)) for (int rep_ = 0; rep_ < REP(3); ++rep_) {
                const int lane = tid & 63, wave = __builtin_amdgcn_readfirstlane(tid >> 6), gw = VCU() * 8 + wave, NGW = gridDim.x * 8;
                unsigned char* ws = ap->ws; const bf16* OB = (const bf16*)(ws + WS_O); const bf16* GG = (const bf16*)(ws + WS_H) + 4 * (size_t)NTOK * DM; bf16* A2 = (bf16*)(ws + WS_A2);
                const float* ng = ap->in[I_HNG] + (L >> 1) * DM;
                f32x4 g4[4];
#pragma unroll
                for (int q = 0; q < 4; ++q) g4[q] = *(const f32x4*)(ng + 256 * q + 4 * lane);
                v2u on[4], gn[4];
#pragma unroll
                for (int q = 0; q < 4; ++q) { on[q] = *(const v2u*)(OB + (size_t)gw * DM + 256 * q + 4 * lane); gn[q] = *(const v2u*)(GG + (size_t)gw * DM + 256 * q + 4 * lane); }
#pragma unroll 1
                for (int row = gw; row < NTOK; row += NGW) {
                    v2u oc[4], gc[4];
#pragma unroll
                    for (int q = 0; q < 4; ++q) { oc[q] = on[q]; gc[q] = gn[q]; }
                    if (row + NGW < NTOK) {
#pragma unroll
                        for (int q = 0; q < 4; ++q) { on[q] = *(const v2u*)(OB + (size_t)(row + NGW) * DM + 256 * q + 4 * lane); gn[q] = *(const v2u*)(GG + (size_t)(row + NGW) * DM + 256 * q + 4 * lane); } }
                    float o[16]; float ss = 0.f;
#pragma unroll
                    for (int q = 0; q < 4; ++q) { o[4 * q] = bflo(oc[q].x); o[4 * q + 1] = bfhi(oc[q].x); o[4 * q + 2] = bflo(oc[q].y); o[4 * q + 3] = bfhi(oc[q].y); }
#pragma unroll
                    for (int i = 0; i < 16; ++i) ss += o[i] * o[i];
                    const float rs = 1.0f / sqrtf(wave_sum(ss) * (1.0f / DM) + RMS_EPS);
#pragma unroll
                    for (int q = 0; q < 4; ++q) {
                        v2u w; w.x = pk2(o[4 * q] * rs * g4[q][0] * bflo(gc[q].x), o[4 * q + 1] * rs * g4[q][1] * bfhi(gc[q].x)); w.y = pk2(o[4 * q + 2] * rs * g4[q][2] * bflo(gc[q].y), o[4 * q + 3] * rs * g4[q][3] * bfhi(gc[q].y));
                        *(v2u*)(A2 + (size_t)row * DM + 256 * q + 4 * lane) = w; }
                }
                GRID_BAR();
            } }
#endif
        } else {
#if SITE(4)
            { KArgs ap = kargs(); const int tid = otid(wave0); LAS unsigned char* lds = olds(lds0); (void)tid;
            if (IN(pb + 0)) for (int rep_ = 0; rep_ < REP(4); ++rep_) {
                unsigned char* ws = ap->ws; const int j = L >> 1;
                LAS int* ul = (LAS int*)(lds + MISC_OFF + MO_ULIST);
                pg8::build_units_dense(tid, ul, NTOK / 256, RT_IN / 256, DM * 2);
                pg8::EpiRetIn E{ws};
                pg8::gemm_phase<pg8::EpiRetIn, false, true, false>(tid, lds, ul, (LAS int*)(lds + MISC_OFF + MO_GTAB), (const char*)(ws + WS_XB), (const char*)((bf16*)(ws + WS_W_RIN) + (size_t)j * RT_IN * DM), nullptr, DM * 2, E);
                GRID_BAR();
            } }
#endif
#if SITE(5)
            { KArgs ap = kargs(); const int tid = otid(wave0); LAS unsigned char* lds = olds(lds0); (void)tid;
            if (IN(pb + 1)) for (int rep_ = 0; rep_ < REP(5); ++rep_) {
#if !SLOW_RET
                { unsigned char* ws = ap->ws; ret_fast(tid, lds, (const bf16*)(ws + WS_H), (bf16*)(ws + WS_O)); }
#else
                unsigned char* ws = ap->ws; const bf16* HB = (const bf16*)(ws + WS_H); bf16* OB = (bf16*)(ws + WS_O);
                LAS float* qf = (LAS float*)lds; LAS float* kf = qf + 16 * 4 * 68; LAS float* vf = kf + 16 * 4 * 68;
                for (int un = blockIdx.x; un < NBATCH * RT_HEADS * 4; un += gridDim.x) {
                    const int b = un >> 4, h = (un >> 2) & 3, vq = un & 3; const int vc = tid >> 2, kq = tid & 3;
                    const float gam = 1.0f - exp2f(-5.0f - (float)h);
                    float st[64];
#pragma unroll
                    for (int i = 0; i < 64; ++i) st[i] = 0.f;
                    for (int t0 = 0; t0 < SEQ; t0 += 16) {
                        __syncthreads();
                        for (int e = tid; e < 16 * 256; e += 512) { const int tt = e >> 8, k = e & 255; const size_t gi = (size_t)(b * SEQ + t0 + tt) * RT_IN + h * 256 + k; const int li = tt * 272 + (k & 3) * 68 + (k >> 2);
                            qf[li] = bf1(HB[gi]); kf[li] = bf1(HB[gi + 1024]); }
                        for (int e = tid; e < 16 * 128; e += 512) { const int tt = e >> 7, c = e & 127; vf[e] = bf1(HB[(size_t)(b * SEQ + t0 + tt) * RT_IN + 2048 + h * 512 + vq * 128 + c]); }
                        __syncthreads();
                        for (int tt = 0; tt < 16; ++tt) {
                            const float v = vf[tt * 128 + vc]; float a = 0.f; const int lb = tt * 272 + kq * 68;
#pragma unroll
                            for (int i = 0; i < 64; ++i) { st[i] = gam * st[i] + kf[lb + i] * v; a += qf[lb + i] * st[i]; }
                            a += __shfl_xor(a, 1); a += __shfl_xor(a, 2);
                            if (kq == 0) OB[(size_t)(b * SEQ + t0 + tt) * RT_VD + h * 512 + vq * 128 + vc] = (bf16)f2bf(a);
                        }
                    }
                }
#endif
                GRID_BAR();
            } }
#endif
#if SITE(6)
            { KArgs ap = kargs(); const int tid = otid(wave0); LAS unsigned char* lds = olds(lds0); (void)tid;
            if (IN(pb + 2)) for (int rep_ = 0; rep_ < REP(6); ++rep_) {
                const int lane = tid & 63, wave = __builtin_amdgcn_readfirstlane(tid >> 6), gw = VCU() * 8 + wave, NGW = gridDim.x * 8;
                unsigned char* ws = ap->ws; const bf16* OB = (const bf16*)(ws + WS_O); const bf16* HB = (const bf16*)(ws + WS_H); bf16* A2 = (bf16*)(ws + WS_A2);
                v4u on[4], gn[4];
#pragma unroll
                for (int h = 0; h < 4; ++h) { on[h] = *(const v4u*)(OB + (size_t)gw * RT_VD + 512 * h + 8 * lane); gn[h] = *(const v4u*)(HB + (size_t)gw * RT_IN + 4096 + 512 * h + 8 * lane); }
#pragma unroll 1
                for (int row = gw; row < NTOK; row += NGW) {
                    v4u oc[4], gc[4];
#pragma unroll
                    for (int h = 0; h < 4; ++h) { oc[h] = on[h]; gc[h] = gn[h]; }
                    if (row + NGW < NTOK) {
#pragma unroll
                        for (int h = 0; h < 4; ++h) { on[h] = *(const v4u*)(OB + (size_t)(row + NGW) * RT_VD + 512 * h + 8 * lane); gn[h] = *(const v4u*)(HB + (size_t)(row + NGW) * RT_IN + 4096 + 512 * h + 8 * lane); } }
#pragma unroll
                    for (int h = 0; h < 4; ++h) {
                        const v4u w = oc[h];
                        float o[8] = {bflo(w.x), bfhi(w.x), bflo(w.y), bfhi(w.y), bflo(w.z), bfhi(w.z), bflo(w.w), bfhi(w.w)};
                        float s = 0.f;
#pragma unroll
                        for (int i = 0; i < 8; ++i) s += o[i];
                        const float mu = wave_sum(s) * (1.0f / 512.0f); float q = 0.f;
#pragma unroll
                        for (int i = 0; i < 8; ++i) { o[i] -= mu; q += o[i] * o[i]; }
                        const float rs = 1.0f / sqrtf(wave_sum(q) * (1.0f / 512.0f) + LN_EPS);
                        const v4u g = gc[h];
                        v4u r; r.x = pk2(o[0] * rs * bflo(g.x), o[1] * rs * bfhi(g.x)); r.y = pk2(o[2] * rs * bflo(g.y), o[3] * rs * bfhi(g.y));
                        r.z = pk2(o[4] * rs * bflo(g.z), o[5] * rs * bfhi(g.z)); r.w = pk2(o[6] * rs * bflo(g.w), o[7] * rs * bfhi(g.w));
                        *(v4u*)(A2 + (size_t)row * RT_VD + 512 * h + 8 * lane) = r;
                    }
                }
                GRID_BAR();
            } }
#endif
        }
#if SITE(7)
        { KArgs ap = kargs(); const int tid = otid(wave0); LAS unsigned char* lds = olds(lds0); (void)tid;
        if (IN(pb + 3)) for (int rep_ = 0; rep_ < REP(7); ++rep_) {
            unsigned char* ws = ap->ws; const int j = L >> 1; const bool ret = (L & 1) != 0;
            const int Ko = ret ? RT_VD : DM;
            LAS int* ul = (LAS int*)(lds + MISC_OFF + MO_ULIST);
            pg8::build_units_dense(tid, ul, NTOK / 256, DM / 256, Ko * 2);
            const char* Bt = ret ? (const char*)((bf16*)(ws + WS_W_ROUT) + (size_t)j * DM * RT_VD) : (const char*)((bf16*)(ws + WS_W_HOUT) + (size_t)j * DM * DM);
            pg8::EpiRes E{ws, (ret || SLOW_HGRN) ? -1 : 0};
            pg8::gemm_phase<pg8::EpiRes, false, true, false>(tid, lds, ul, (LAS int*)(lds + MISC_OFF + MO_GTAB), (const char*)(ws + WS_A2), Bt, nullptr, Ko * 2, E);
            GRID_BAR();
        } }
#endif
#if SITE(8)
        { KArgs ap = kargs(); const int tid = otid(wave0); LAS unsigned char* lds = olds(lds0); (void)tid;
        if (IN(pb + 4)) for (int rep_ = 0; rep_ < REP(8); ++rep_) {
            const int lane = tid & 63, wave = __builtin_amdgcn_readfirstlane(tid >> 6), r = lane & 15, g = lane >> 4;
            unsigned char* ws = ap->ws; unsigned* ctl = (unsigned*)(ws + WS_CTL);
            const bf16* Y = (const bf16*)(ws + WS_Y); bf16* X1R = (bf16*)(ws + WS_X1F); bf16* X1B = (bf16*)(ws + WS_X1B);
            int* ROWDST = (int*)(ws + WS_ROWDST); float* ROWGATE = (float*)(ws + WS_ROWGATE);
            constexpr int WP = 2064;
            LAS unsigned char* wH = lds; LAS unsigned char* wL = lds + 32 * WP;
            LAS int* lcnt = (LAS int*)(lds + MISC_OFF + MO_LCNT); LAS int* lbase = (LAS int*)(lds + MISC_OFF + MO_LBASE);
            LAS int* sel = (LAS int*)(lds + MISC_OFF + MO_SEL); LAS float* selw = (LAS float*)(lds + MISC_OFF + MO_SELW);
            const float* rb = ap->in[I_RB] + L * NE;
            const float* lg = ap->in[I_LNMG] + L * DM; const float* lbb = ap->in[I_LNMB] + L * DM;
            { const v4u* gh = (const v4u*)(ws + WS_WRH) + (size_t)L * 4096; const v4u* gl = (const v4u*)(ws + WS_WRL) + (size_t)L * 4096;
              for (int c = tid; c < 4096; c += 512) { const int e = c >> 7, cc = c & 127; *(LAS v4u*)(wH + e * WP + cc * 16) = gh[c]; *(LAS v4u*)(wL + e * WP + cc * 16) = gl[c]; } }
            const float rb0 = rb[r], rb1 = rb[16 + r];
            for (int blk = VCU(); blk < NTOK / 128; blk += gridDim.x) {
                if (tid < 32) lcnt[tid] = 0;
                __syncthreads();
                const int row0 = blk * 128 + wave * 16;
                v2u xn[4];
#pragma unroll
                for (int q = 0; q < 4; ++q) xn[q] = *(const v2u*)(Y + (size_t)row0 * DM + 256 * q + 4 * lane);
#pragma unroll 1
                for (int rr = 0; rr < 16; ++rr) {
                    const int row = row0 + rr;
                    f32x4 x[4]; float s = 0.f;
#pragma unroll
                    for (int q = 0; q < 4; ++q) { x[q] = (f32x4){bflo(xn[q].x), bfhi(xn[q].x), bflo(xn[q].y), bfhi(xn[q].y)}; s += (x[q][0] + x[q][1]) + (x[q][2] + x[q][3]); }
                    if (rr + 1 < 16) {
#pragma unroll
                        for (int q = 0; q < 4; ++q) xn[q] = *(const v2u*)(Y + (size_t)(row + 1) * DM + 256 * q + 4 * lane); }
                    const float mu = wave_sum_u(s) * (1.0f / DM); float qq = 0.f;
#pragma unroll
                    for (int q = 0; q < 4; ++q) { x[q] = x[q] - mu; qq += (x[q][0] * x[q][0] + x[q][1] * x[q][1]) + (x[q][2] * x[q][2] + x[q][3] * x[q][3]); }
                    const float rs = 1.0f / sqrtf(wave_sum_u(qq) * (1.0f / DM) + LN_EPS);
#pragma unroll
                    for (int q = 0; q < 4; ++q) { const f32x4 g4 = *(const f32x4*)(lg + 256 * q + 4 * lane), b4 = *(const f32x4*)(lbb + 256 * q + 4 * lane); x[q] = x[q] * rs * g4 + b4;
                        { v2u wr_; wr_.x = pk2(x[q][0], x[q][1]); wr_.y = pk2(x[q][2], x[q][3]); *(v2u*)(X1R + (size_t)row * DM + 256 * q + 4 * lane) = wr_; }
#if MOE_FP8
                        *(unsigned*)((unsigned char*)X1B + (size_t)row * DM + 256 * q + 4 * lane) = pk4_fp8(x[q][0] * X_SCALE, x[q][1] * X_SCALE, x[q][2] * X_SCALE, x[q][3] * X_SCALE); }
#else
                        v2u w; w.x = pk2(x[q][0], x[q][1]); w.y = pk2(x[q][2], x[q][3]); *(v2u*)(X1B + (size_t)row * DM + 256 * q + 4 * lane) = w; }
#endif
                }
                asm volatile("s_waitcnt vmcnt(0)" ::: "memory");
                f32x4 lgt0 = {0.f, 0.f, 0.f, 0.f}, lgt1 = {0.f, 0.f, 0.f, 0.f};
                {
                    const bf16* xa = X1R + (size_t)(row0 + r) * DM + 8 * g;
#pragma unroll 1
                    for (int kq = 0; kq < 4; ++kq) {
                        bf16x8 af[8], h0[8], h1[8], l0[8], l1[8];
#pragma unroll
                        for (int j = 0; j < 8; ++j) { const int kb = kq * 8 + j; af[j] = *(const bf16x8*)(xa + 32 * kb);
                            h0[j] = *(const LAS bf16x8*)(wH + r * WP + (32 * kb + 8 * g) * 2); h1[j] = *(const LAS bf16x8*)(wH + (16 + r) * WP + (32 * kb + 8 * g) * 2);
                            l0[j] = *(const LAS bf16x8*)(wL + r * WP + (32 * kb + 8 * g) * 2); l1[j] = *(const LAS bf16x8*)(wL + (16 + r) * WP + (32 * kb + 8 * g) * 2); }
#pragma unroll
                        for (int j = 0; j < 8; ++j) { lgt0 = MFMA32(af[j], h0[j], lgt0); lgt1 = MFMA32(af[j], h1[j], lgt1); lgt0 = MFMA32(af[j], l0[j], lgt0); lgt1 = MFMA32(af[j], l1[j], lgt1); }
                    }
                }
#pragma unroll
                for (int i = 0; i < 4; ++i) {
                    float v0 = lgt0[i] + rb0, v1 = lgt1[i] + rb1; int se[4]; float sv[4];
#pragma unroll
                    for (int k = 0; k < 4; ++k) {
                        float m = fmaxf(v0, v1);
                        m = fmaxf(m, dppf<0xB1>(m)); m = fmaxf(m, dppf<0x4E>(m)); m = fmaxf(m, dppf<0x141>(m)); m = fmaxf(m, dppf<0x140>(m));
                        int ec = (v0 == m) ? r : ((v1 == m) ? 16 + r : 99);
                        ec = min(ec, dppi<0xB1>(ec)); ec = min(ec, dppi<0x4E>(ec)); ec = min(ec, dppi<0x141>(ec)); ec = min(ec, dppi<0x140>(ec));
                        se[k] = ec; sv[k] = m;
                        if (ec == r) v0 = -3.0e38f;
                        if (ec == 16 + r) v1 = -3.0e38f;
                    }
                    const float e1 = __expf(sv[1] - sv[0]), e2 = __expf(sv[2] - sv[0]), e3 = __expf(sv[3] - sv[0]); const float inv = 1.0f / (1.0f + e1 + e2 + e3);
                    if (r < 4) { const int rloc = wave * 16 + 4 * g + i; const int ee = r == 0 ? se[0] : (r == 1 ? se[1] : (r == 2 ? se[2] : se[3])); const float ww = (r == 0 ? 1.0f : (r == 1 ? e1 : (r == 2 ? e2 : e3))) * inv;
                        sel[rloc * 4 + r] = ee; selw[rloc * 4 + r] = ww; }
                }
                __syncthreads();
                const int myE = sel[tid]; const int rank = __hip_atomic_fetch_add(lcnt + myE, 1, __ATOMIC_RELAXED, __HIP_MEMORY_SCOPE_WORKGROUP);
                __syncthreads();
                if (tid < 32) lbase[tid] = (int)__hip_atomic_fetch_add(ctl + CW_ECNT + (L + 4 * rep_) * 32 + tid, (unsigned)lcnt[tid], RLX_AGENT);
                __syncthreads();
                { const int pos = lbase[myE] + rank; const size_t ti = (size_t)myE * ECAP + pos; ROWDST[ti] = (blk * 128 + (tid >> 2)) * 4 + (tid & 3); ROWGATE[ti] = selw[tid]; }
                __syncthreads();
            }
            GRID_BAR();
        } }
#endif
#if SITE(9)
        { KArgs ap = kargs(); const int tid = otid(wave0); LAS unsigned char* lds = olds(lds0); (void)tid;
        if (IN(pb + 5)) for (int rep_ = 0; rep_ < REP(9); ++rep_) {
            unsigned char* ws = ap->ws; unsigned* ctl = (unsigned*)(ws + WS_CTL);
            LAS int* tpre = (LAS int*)(lds + MISC_OFF + MO_TPRE); LAS int* ebase = (LAS int*)(lds + MISC_OFF + MO_EBASE); LAS int* ecnt = (LAS int*)(lds + MISC_OFF + MO_ECNT);
            if (tid < NE) ecnt[tid] = (int)__hip_atomic_load(ctl + CW_ECNT + L * 32 + tid, RLX_AGENT);
            __syncthreads();
            if (tid == 0) { int t = 0;
_Pragma("unroll 1")
 for (int e = 0; e < NE; ++e) { const int c = ecnt[e]; tpre[e] = t; ebase[e] = t * 256; t += (c + 255) >> 8; } tpre[NE] = t; }
            __syncthreads();
            LAS int* ul = (LAS int*)(lds + MISC_OFF + MO_ULIST);
            constexpr int EB = MOE_FP8 ? 1 : 2;
            pg8::build_units_moe(tid, ul, tpre, ebase, ecnt, 8, DM * EB, 2048u * DM * EB);
            { LAS int* gall = (LAS int*)(lds + MISC_OFF + MO_GALL); const int* rd = (const int*)(ws + WS_ROWDST);
              for (int i = tid; i < GALL_UNITS * 256; i += 512) { const int uu = i >> 8, rr = i & 255;
                  if (ul[uu * 8 + 0]) gall[i] = (int)((unsigned)rd[ul[uu * 8 + 7] + min(rr, ul[uu * 8 + 5] - 1)] >> 2); }
              __syncthreads(); }
            pg8::EpiMoeGU E{ws, L};
            pg8::gemm_phase<pg8::EpiMoeGU, true, true, MOE_FP8 != 0>(tid, lds, ul, (LAS int*)(lds + MISC_OFF + MO_GALL), (const char*)(ws + WS_X1B), (const char*)(ws + WS_W_GU + (size_t)L * NE * 2048 * DM * EB), (const int*)(ws + WS_ROWDST), DM * EB, E);
            GRID_BAR();
        } }
#endif
#if SITE(10)
        { KArgs ap = kargs(); const int tid = otid(wave0); LAS unsigned char* lds = olds(lds0); (void)tid;
        if (IN(pb + 6)) for (int rep_ = 0; rep_ < REP(10); ++rep_) {
            unsigned char* ws = ap->ws; unsigned* ctl = (unsigned*)(ws + WS_CTL);
            LAS int* tpre = (LAS int*)(lds + MISC_OFF + MO_TPRE); LAS int* ebase = (LAS int*)(lds + MISC_OFF + MO_EBASE); LAS int* ecnt = (LAS int*)(lds + MISC_OFF + MO_ECNT);
            __syncthreads();
            if (tid < NE) ecnt[tid] = (int)__hip_atomic_load(ctl + CW_ECNT + L * 32 + tid, RLX_AGENT);
            __syncthreads();
            if (tid == 0) { int t = 0;
_Pragma("unroll 1")
 for (int e = 0; e < NE; ++e) { const int c = ecnt[e]; tpre[e] = t; ebase[e] = t * 256; t += (c + 255) >> 8; } tpre[NE] = t; }
            __syncthreads();
            LAS int* ul = (LAS int*)(lds + MISC_OFF + MO_ULIST);
            constexpr int EB = MOE_FP8 ? 1 : 2;
            pg8::build_units_moe(tid, ul, tpre, ebase, ecnt, 4, DM * EB, (unsigned)DM * DM * EB);
            pg8::EpiMoeDown E{ws, ap->in[I_BDN] + (size_t)L * NE * DM};
            pg8::gemm_phase<pg8::EpiMoeDown, false, true, MOE_FP8 != 0>(tid, lds, ul, (LAS int*)(lds + MISC_OFF + MO_GTAB), (const char*)(ws + WS_ACT), (const char*)(ws + WS_W_DN + (size_t)L * NE * DM * DM * EB), nullptr, DM * EB, E);
            GRID_BAR();
        } }
#endif
#if SITE(11)
        { KArgs ap = kargs(); const int tid = otid(wave0); LAS unsigned char* lds = olds(lds0); (void)tid;
        if (IN(pb + 7)) for (int rep_ = 0; rep_ < REP(11); ++rep_) {
            const int lane = tid & 63, wave = __builtin_amdgcn_readfirstlane(tid >> 6), gw = VCU() * 8 + wave, NGW = gridDim.x * 8;
            unsigned char* ws = ap->ws; const bf16* X1R = (const bf16*)(ws + WS_X1F); const bf16* YS = (const bf16*)(ws + WS_YSLOT); bf16* XB = (bf16*)(ws + WS_XB); float* out = ap->out;
            const float* lg = ap->in[I_LNFG] + L * DM; const float* lbb = ap->in[I_LNFB] + L * DM;
#if YS_FP8
            typedef unsigned ys_t; constexpr int YSB = 1;
#else
            typedef v2u ys_t; constexpr int YSB = 2;
#endif
            v2u xn[4]; f32x4 g4[4], b4[4]; ys_t yn[4][4];
#pragma unroll
            for (int q = 0; q < 4; ++q) { g4[q] = *(const f32x4*)(lg + 256 * q + 4 * lane); b4[q] = *(const f32x4*)(lbb + 256 * q + 4 * lane); xn[q] = *(const v2u*)(X1R + (size_t)gw * DM + 256 * q + 4 * lane);
#pragma unroll
                for (int k = 0; k < 4; ++k) yn[q][k] = *(const ys_t*)((const unsigned char*)YS + (((size_t)gw * 4 + k) * DM + 256 * q + 4 * lane) * YSB); }
#pragma unroll 1
            for (int row = gw; row < NTOK; row += NGW) {
                f32x4 x[4]; ys_t yc[4][4]; float s = 0.f;
#pragma unroll
                for (int q = 0; q < 4; ++q) { x[q] = (f32x4){bflo(xn[q].x), bfhi(xn[q].x), bflo(xn[q].y), bfhi(xn[q].y)} * DN_ALPHA;
#pragma unroll
                    for (int k = 0; k < 4; ++k) yc[q][k] = yn[q][k]; }
                if (row + NGW < NTOK) {
#pragma unroll
                    for (int q = 0; q < 4; ++q) { xn[q] = *(const v2u*)(X1R + (size_t)(row + NGW) * DM + 256 * q + 4 * lane);
#pragma unroll
                        for (int k = 0; k < 4; ++k) yn[q][k] = *(const ys_t*)((const unsigned char*)YS + (((size_t)(row + NGW) * 4 + k) * DM + 256 * q + 4 * lane) * YSB); } }
#pragma unroll
                for (int q = 0; q < 4; ++q) {
#pragma unroll
#if YS_FP8
                    for (int k = 0; k < 4; ++k) { const f32x2 lo = __builtin_amdgcn_cvt_pk_f32_fp8((int)yc[q][k], false), hi = __builtin_amdgcn_cvt_pk_f32_fp8((int)yc[q][k], true);
                        x[q][0] += lo[0] * 0.015625f; x[q][1] += lo[1] * 0.015625f; x[q][2] += hi[0] * 0.015625f; x[q][3] += hi[1] * 0.015625f; }
#else
                    for (int k = 0; k < 4; ++k) { const v2u w = yc[q][k]; x[q][0] += bflo(w.x); x[q][1] += bfhi(w.x); x[q][2] += bflo(w.y); x[q][3] += bfhi(w.y); }
#endif
                    s += (x[q][0] + x[q][1]) + (x[q][2] + x[q][3]); }
                const float mu = wave_sum(s) * (1.0f / DM); float qq = 0.f;
#pragma unroll
                for (int q = 0; q < 4; ++q) { x[q] = x[q] - mu; qq += (x[q][0] * x[q][0] + x[q][1] * x[q][1]) + (x[q][2] * x[q][2] + x[q][3] * x[q][3]); }
                const float rs = 1.0f / sqrtf(wave_sum(qq) * (1.0f / DM) + LN_EPS);
#pragma unroll
                for (int q = 0; q < 4; ++q) { x[q] = x[q] * rs * g4[q] + b4[q];
                    if (L + 1 == DEPTH) *(f32x4*)(out + (size_t)row * DM + 256 * q + 4 * lane) = x[q];
                    else { v2u w; w.x = pk2(x[q][0], x[q][1]); w.y = pk2(x[q][2], x[q][3]); *(v2u*)(XB + (size_t)row * DM + 256 * q + 4 * lane) = w; } }
            }
            if (L + 1 < DEPTH) GRID_BAR();
        } }
#endif
    }
#undef IN
#undef GRID_BAR
}

extern "C" void kernel_launch(void* const* d_in, const int* in_sizes, int n_in, void* d_out, int out_size, void* d_ws, size_t ws_size, hipStream_t stream) {
    static int grid = 0;
    if (grid == 0) {
        if (n_in != 17 || out_size != NTOK * DM || ws_size < WS_END) { fprintf(stderr, "kernel_launch: unexpected shapes (n_in %d, out %d, ws %zu < %zu)\n", n_in, out_size, ws_size, (size_t)WS_END); grid = -1; return; }
        int dev = 0, cus = 0, per_cu = 0;
        if (hipGetDevice(&dev) != hipSuccess || hipDeviceGetAttribute(&cus, hipDeviceAttributeMultiprocessorCount, dev) != hipSuccess) { grid = -1; return; }
        if (hipFuncSetAttribute((const void*)mk_fwd, hipFuncAttributeMaxDynamicSharedMemorySize, LDS_BYTES) != hipSuccess) { fprintf(stderr, "kernel_launch: hipFuncSetAttribute failed\n"); grid = -1; return; }
        if (hipOccupancyMaxActiveBlocksPerMultiprocessor(&per_cu, (const void*)mk_fwd, 512, LDS_BYTES) != hipSuccess || per_cu < 1) { fprintf(stderr, "kernel_launch: occupancy query says %d\n", per_cu); }
        (void)hipGetLastError();
        grid = cus;
    }
    if (grid < 0) return;
    (void)hipMemsetAsync((char*)d_ws + WS_CTL, 0, CTL_ZERO_BYTES, stream);
    Args a{};
    for (int i = 0; i < 17; ++i) a.in[i] = (const float*)d_in[i];
    a.out = (float*)d_out; a.ws = (unsigned char*)d_ws;
#if MK_MULTI
    for (int p = 0; p < 1 + 8 * DEPTH; ++p) { a.ph_lo = p; a.ph_hi = p + 1; hipLaunchKernelGGL(mk_fwd, dim3(grid), dim3(512), LDS_BYTES, stream, a); }
#else
    a.ph_lo = 0; a.ph_hi = 1 + 8 * DEPTH;
    hipLaunchKernelGGL(mk_fwd, dim3(grid), dim3(512), LDS_BYTES, stream, a);
#endif
}
```

```cpp
#include <hip/hip_runtime.h>
#include <cstdio>
#include <cstdint>

#ifndef MK_MULTI
#define MK_MULTI 0
#endif
#ifndef PROBE_EPI2
#define PROBE_EPI2 0
#endif
#ifndef MOE_FP8
#define MOE_FP8 1
#endif
#ifndef YS_FP8
#define YS_FP8 1
#endif
#ifndef SLOW_HGRN
#define SLOW_HGRN 0
#endif
#ifndef SLOW_RET
#define SLOW_RET 0
#endif

#define GAS __attribute__((address_space(1)))
#define LAS __attribute__((address_space(3)))
typedef unsigned short bf16;
typedef unsigned v4u __attribute__((ext_vector_type(4)));
typedef unsigned v2u __attribute__((ext_vector_type(2)));
typedef float f32x4 __attribute__((ext_vector_type(4)));
typedef float f32x2 __attribute__((ext_vector_type(2)));
typedef short bf16x8 __attribute__((ext_vector_type(8)));
typedef GAS unsigned gu32;

constexpr int DM = 1024, NBATCH = 16, SEQ = 2048, NTOK = NBATCH * SEQ, DEPTH = 4;
constexpr int NE = 32, TOPK = 4;
constexpr int HG_HEADS = 8, HG_K = 128;
constexpr int RT_HEADS = 4, RT_K = 256, RT_V = 512, RT_VD = 2048, RT_IN = 6144, HG_IN = 4096;
constexpr int ECAP = NTOK;
constexpr int MOE_ROWS = NTOK * TOPK + NE * 256;
constexpr float DN_ALPHA = 1.681792830507429f;
constexpr float LN_EPS = 1e-5f, RMS_EPS = 1e-6f;

constexpr size_t MiB = 1ull << 20;
constexpr size_t WS_CTL = 0, CTL_ZERO_BYTES = 1 * MiB;
constexpr size_t WS_LBS = 1 * MiB;
constexpr size_t WS_WRH = 1 * MiB + 128 * 1024, WS_WRL = 1 * MiB + 512 * 1024;
constexpr size_t WS_BGU = 2 * MiB;
constexpr size_t WS_ROT = 4 * MiB;
constexpr size_t WS_ROWDST = 8 * MiB;
constexpr size_t WS_ROWGATE = 12 * MiB;
constexpr size_t WS_W_HIN = 16 * MiB;
constexpr size_t WS_W_HOUT = WS_W_HIN + 16 * MiB;
constexpr size_t WS_W_RIN = WS_W_HOUT + 4 * MiB;
constexpr size_t WS_W_ROUT = WS_W_RIN + 24 * MiB;
constexpr size_t WS_W_GU = WS_W_ROUT + 8 * MiB;
constexpr size_t WS_W_DN = WS_W_GU + 512 * MiB;
constexpr size_t WS_XB = WS_W_DN + 256 * MiB;
constexpr size_t WS_H = WS_XB + 64 * MiB;
constexpr size_t WS_DEC = WS_H + 320 * MiB;
constexpr size_t WS_SSP = WS_DEC + 16 * MiB;
constexpr size_t WS_O = WS_H + 384 * MiB;
constexpr size_t WS_A2 = WS_O + 128 * MiB;
constexpr size_t WS_Y = WS_A2 + 128 * MiB;
constexpr size_t WS_X1F = WS_Y + 128 * MiB;
constexpr size_t WS_X1B = WS_X1F + 128 * MiB;
constexpr size_t WS_ACT = WS_X1B + 64 * MiB;
constexpr size_t WS_YSLOT = WS_ACT + 272 * MiB;
constexpr size_t WS_END = WS_YSLOT + 256 * MiB;

constexpr int CW_BAR = 4096;
constexpr int CW_SS = 65536;
constexpr int CW_ECNT = 16384;

constexpr int RING_BYTES = 131072;
constexpr int MISC_OFF = 135168;
constexpr int LDS_BYTES = 163840;
constexpr int MO_BARW = 0;
constexpr int MO_GTAB = 64;
constexpr int MO_TPRE = 64 + 2048;
constexpr int MO_EBASE = MO_TPRE + 160;
constexpr int MO_ECNT = MO_EBASE + 128;
constexpr int MO_LCNT = MO_ECNT + 128;
constexpr int MO_LBASE = MO_LCNT + 128;
constexpr int MO_SEL = MO_LBASE + 128;
constexpr int MO_SELW = MO_SEL + 2048;
constexpr int MO_RANK = MO_SELW + 2048;
constexpr int MO_ULIST = MO_RANK + 2048;
constexpr int MO_GALL = 10240;
constexpr int GALL_UNITS = 18;
static_assert(MO_ULIST + 1024 <= MO_GALL && MISC_OFF + MO_GALL + GALL_UNITS * 1024 <= LDS_BYTES, "LDS map");

#define RLX_AGENT __ATOMIC_RELAXED, __HIP_MEMORY_SCOPE_AGENT
#define LDS_WAIT() asm volatile("s_waitcnt lgkmcnt(0)" ::: "memory")
#define VM_WAIT() asm volatile("s_waitcnt vmcnt(0)" ::: "memory")

__device__ __forceinline__ unsigned f2bf(float f) { unsigned u = __builtin_bit_cast(unsigned, f); return (u + 0x7fffu + ((u >> 16) & 1u)) >> 16; }
__device__ __forceinline__ unsigned pk2(float lo, float hi) { return f2bf(lo) | (f2bf(hi) << 16); }
__device__ __forceinline__ unsigned cvt_pk_bf16(float lo, float hi) { unsigned r; asm volatile("v_cvt_pk_bf16_f32 %0, %1, %2" : "=v"(r) : "v"(lo), "v"(hi)); return r; }
#if MOE_FP8
constexpr float X_SCALE = 4.0f, WGU_SCALE = 64.0f, ACT_SCALE = 4.0f, WDN_SCALE = 128.0f;
constexpr float GU_DESCALE = 1.0f / (X_SCALE * WGU_SCALE), DN_DESCALE = 1.0f / (ACT_SCALE * WDN_SCALE);
#else
constexpr float GU_DESCALE = 1.0f, DN_DESCALE = 1.0f, ACT_SCALE = 1.0f;
#endif
__device__ __forceinline__ unsigned pk4_fp8(float a, float b, float c, float d) {
    a = __builtin_amdgcn_fmed3f(a, -448.0f, 448.0f); b = __builtin_amdgcn_fmed3f(b, -448.0f, 448.0f); c = __builtin_amdgcn_fmed3f(c, -448.0f, 448.0f); d = __builtin_amdgcn_fmed3f(d, -448.0f, 448.0f);
    int p = __builtin_amdgcn_cvt_pk_fp8_f32(a, b, 0, false); p = __builtin_amdgcn_cvt_pk_fp8_f32(c, d, p, true); return (unsigned)p; }
__device__ __forceinline__ float bflo(unsigned u) { return __builtin_bit_cast(float, u << 16); }
__device__ __forceinline__ float bfhi(unsigned u) { return __builtin_bit_cast(float, u & 0xffff0000u); }
__device__ __forceinline__ float bf1(bf16 b) { return __builtin_bit_cast(float, ((unsigned)b) << 16); }
__device__ __forceinline__ float fexp(float x) { return __builtin_amdgcn_exp2f(x * 1.4426950408889634f); }
__device__ __forceinline__ float frcp(float x) { return __builtin_amdgcn_rcpf(x); }
__device__ __forceinline__ float fsigmoid(float x) { return frcp(1.0f + fexp(-x)); }
__device__ __forceinline__ float wave_sum(float v) {
#pragma unroll
    for (int o = 1; o < 64; o <<= 1) v += __shfl_xor(v, o);
    return v;
}
__device__ __forceinline__ float wave_max(float v) {
#pragma unroll
    for (int o = 1; o < 64; o <<= 1) v = fmaxf(v, __shfl_xor(v, o));
    return v;
}

template <int CTRL> __device__ __forceinline__ float dppf(float v) { return __builtin_bit_cast(float, __builtin_amdgcn_update_dpp(0, __builtin_bit_cast(int, v), CTRL, 0xf, 0xf, true)); }
template <int CTRL> __device__ __forceinline__ int dppi(int v) { return __builtin_amdgcn_update_dpp(0, v, CTRL, 0xf, 0xf, true); }
__device__ __forceinline__ float rlane(float v, int l) { return __builtin_bit_cast(float, __builtin_amdgcn_readlane(__builtin_bit_cast(int, v), l)); }
__device__ __forceinline__ float wave_sum_u(float v) {
    v += dppf<0xB1>(v); v += dppf<0x4E>(v); v += dppf<0x141>(v); v += dppf<0x140>(v);
    return (rlane(v, 0) + rlane(v, 16)) + (rlane(v, 32) + rlane(v, 48));
}
#define XB_TMO      128
#define XB_XCNT(j)  (256  + 64 * (j))
#define XB_XSUB(j)  (1280 + 64 * (j))
#define XB_XGEN(j)  (2304 + 64 * (j))
#define XB_TOP      3328
#define XB_TOPGEN   3392
#define XCD_BAR_WORDS 3456
#define XB_SPIN_CAP (1u << 22)

__device__ __forceinline__ unsigned xb_ld(unsigned* p)              { return __hip_atomic_load(p, __ATOMIC_RELAXED, __HIP_MEMORY_SCOPE_AGENT); }
__device__ __forceinline__ unsigned xb_add(unsigned* p, unsigned v) { return __hip_atomic_fetch_add(p, v, __ATOMIC_RELAXED, __HIP_MEMORY_SCOPE_AGENT); }
__device__ __forceinline__ unsigned xb_xcc_id() { return (unsigned)__builtin_amdgcn_s_getreg((3 << 11) | 20) & 0xFu; }
#define XB_SPIN(cond, bar) do { unsigned _sp = 0; while (cond) { __builtin_amdgcn_s_sleep(1); \
    if ((++_sp & 255u) == 0u) { if (xb_ld(&(bar)[XB_TMO])) break; if (_sp > XB_SPIN_CAP) { atomicAdd(&(bar)[XB_TMO], 1u); break; } } } } while (0)

struct XcdBarrier { unsigned* bar; unsigned x; volatile LAS unsigned* st; };

__device__ __forceinline__ XcdBarrier xcd_barrier_post(unsigned* bar, volatile LAS unsigned* st) {
    XcdBarrier b; b.bar = bar; b.x = xb_xcc_id(); b.st = st;
    if (threadIdx.x == 0) (void)xb_add(&bar[XB_XCNT(b.x)], 1u);
    return b;
}
__device__ __forceinline__ void xcd_barrier_complete(unsigned* bar, unsigned x, unsigned& nloc, unsigned& nx) {
    const unsigned G = gridDim.x * gridDim.y * gridDim.z;
    unsigned sum, cnt, mine, sp = 0u;
    for (;;) {
        sum = 0u; cnt = 0u; mine = 0u;
#pragma unroll
        for (unsigned j = 0; j < 16; ++j) { const unsigned c = xb_ld(&bar[XB_XCNT(j)]); sum += c; cnt += (c > 0u) ? 1u : 0u; mine = (j == x) ? c : mine; }
        if (sum == G) break;
        __builtin_amdgcn_s_sleep(1);
        if ((++sp & 255u) == 0u) { if (xb_ld(&bar[XB_TMO])) break; if (sp > XB_SPIN_CAP) { atomicAdd(&bar[XB_TMO], 1u); break; } }
    }
    nloc = mine > 0u ? mine : 1u; nx = cnt > 0u ? cnt : 1u;
}
__device__ __forceinline__ void xcd_barrier(const XcdBarrier& b) {
    asm volatile("s_waitcnt vmcnt(0)" ::: "memory");
    __syncthreads();
    if (threadIdx.x == 0) {
        unsigned* bar = b.bar;
        __builtin_amdgcn_s_waitcnt(0);
        unsigned nloc = b.st[0], nx = b.st[1];
        if (nloc == 0u) { xcd_barrier_complete(bar, b.x, nloc, nx); b.st[0] = nloc; b.st[1] = nx; }
        const unsigned old = xb_add(&bar[XB_XSUB(b.x)], 1u);
        const unsigned gen = old / nloc;
        if (old + 1u == (gen + 1u) * nloc) {
            __builtin_amdgcn_fence(__ATOMIC_RELEASE, "agent");
            asm volatile("s_waitcnt vmcnt(0)" ::: "memory");
            const unsigned og = xb_add(&bar[XB_TOP], 1u);
            const unsigned tg = og / nx;
            if (og + 1u == (tg + 1u) * nx) xb_add(&bar[XB_TOPGEN], 1u);
            else XB_SPIN(xb_ld(&bar[XB_TOPGEN]) == tg, bar);
            __builtin_amdgcn_fence(__ATOMIC_ACQUIRE, "agent");
            xb_add(&bar[XB_XGEN(b.x)], 1u);
            asm volatile("s_waitcnt vmcnt(0)" ::: "memory");
        } else {
            XB_SPIN(xb_ld(&bar[XB_XGEN(b.x)]) == gen, bar);
            __builtin_amdgcn_fence(__ATOMIC_ACQUIRE, "agent");
            asm volatile("s_waitcnt vmcnt(0)" ::: "memory");
        }
    }
    __syncthreads();
}

namespace pg8 {
constexpr int BM = 256, BK = 64, HALF = 128, HTB = HALF * BK * 2, STAGE_BYTES = 8 * HTB, NXCD = 8, WGM = 8, MAXU = 32;
__host__ __device__ __forceinline__ int lds_byte(int r, int c) { const int st = (r >> 4) * 2 + (c >> 5), rr = r & 15, cc = c & 31, ob = rr * 64 + cc * 2; return st * 1024 + (ob ^ (((ob >> 9) & 1) << 5)); }
__host__ __device__ __forceinline__ void stage_rc(int b, int& R, int& C) { const int st = b / 1024, sb = b % 1024, swz = sb ^ (((sb >> 9) & 1) << 5); R = (st >> 1) * 16 + swz / 64; C = (st & 1) * 32 + (swz % 64) / 2; }
__host__ __device__ __forceinline__ int perm32(int rho) { const int n = rho >> 4, i = rho & 15; return 8 * (i >> 2) + 4 * n + (i & 3); }

struct Unit { int pm, pn, e, rowbase, cnt; unsigned boff; int gidx; };

__device__ __forceinline__ bool tile_of(long L, int nM, int nN, int& gm, int& pn) {
    const int nwg = nM * nN; if (L >= nwg) return false;
    int wgid = (int)L; { const int q = nwg / NXCD, r = nwg % NXCD, xcd = wgid % NXCD, off = wgid / NXCD; wgid = (xcd < r ? xcd * (q + 1) : r * (q + 1) + (xcd - r) * q) + off; }
    const int nig = WGM * nN, gid = wgid / nig, fm = gid * WGM, gsz = (nM - fm) < WGM ? (nM - fm) : WGM;
    gm = fm + ((wgid % nig) % gsz); pn = (wgid % nig) / gsz; return true;
}
__device__ __forceinline__ void build_units_dense(const int i, LAS int* ul, int nM, int nN, int RB) {
    if (i < MAXU) { int gm = 0, pn = 0; const bool ok = tile_of((long)i * gridDim.x + blockIdx.x, nM, nN, gm, pn);
        ul[i * 8 + 0] = ok ? 1 : 0; ul[i * 8 + 1] = gm; ul[i * 8 + 2] = pn; ul[i * 8 + 3] = 0; ul[i * 8 + 4] = gm * BM; ul[i * 8 + 5] = BM; ul[i * 8 + 6] = (int)((unsigned)pn * BM * (unsigned)RB); ul[i * 8 + 7] = 0; }
    __syncthreads();
}
__device__ __forceinline__ void build_units_moe(const int i, LAS int* ul, const LAS int* tpre, const LAS int* ebase, const LAS int* ecnt, int nN, int RB, unsigned wstride) {
    if (i < MAXU) { int gm = 0, pn = 0; const bool ok = tile_of((long)i * gridDim.x + blockIdx.x, tpre[NE], nN, gm, pn);
        int e = 0;
_Pragma("unroll 1")
        for (int s = 16; s >= 1; s >>= 1) { if (e + s < NE && tpre[e + s] <= gm) e += s; }
        const int pm = gm - tpre[e];
        ul[i * 8 + 0] = ok ? 1 : 0; ul[i * 8 + 1] = pm; ul[i * 8 + 2] = pn; ul[i * 8 + 3] = e; ul[i * 8 + 4] = ebase[e] + pm * BM; ul[i * 8 + 5] = ecnt[e] - pm * BM;
        ul[i * 8 + 6] = (int)((unsigned)e * wstride + (unsigned)pn * BM * (unsigned)RB); ul[i * 8 + 7] = e * ECAP + pm * BM; }
    __syncthreads();
}
__device__ __forceinline__ bool ld_unit(const LAS int* ul, int i, Unit& u) {
    if (i >= MAXU) return false;
    const LAS int* p = ul + i * 8;
    if (__builtin_amdgcn_readfirstlane(p[0]) == 0) return false;
    u.pm = __builtin_amdgcn_readfirstlane(p[1]); u.pn = __builtin_amdgcn_readfirstlane(p[2]); u.e = __builtin_amdgcn_readfirstlane(p[3]); u.rowbase = __builtin_amdgcn_readfirstlane(p[4]);
    u.cnt = __builtin_amdgcn_readfirstlane(p[5]); u.boff = (unsigned)__builtin_amdgcn_readfirstlane(p[6]); u.gidx = __builtin_amdgcn_readfirstlane(p[7]); return true;
}
__device__ __forceinline__ void glds16(const char* sbase, unsigned voff, LAS unsigned char* dst) {
    asm volatile("" : "+s"(sbase));
    __builtin_amdgcn_global_load_lds((const unsigned*)(sbase + voff), (LAS unsigned*)dst, 16, 0, 0);
}
template <bool GATHER> __device__ __forceinline__ void stage_a(LAS unsigned char* dst, const char* sbase, unsigned o0, unsigned o1, size_t r64) {
    glds16(sbase, o0, dst);
    if constexpr (GATHER) glds16(sbase, o1, dst + 8192);
    else glds16(sbase + r64, o0, dst + 8192);
}

typedef int v8i __attribute__((ext_vector_type(8)));
typedef int v4i __attribute__((ext_vector_type(4)));
__device__ __forceinline__ v8i cat_frag(const bf16x8& a, const bf16x8& b) { return __builtin_shufflevector(__builtin_bit_cast(v4i, a), __builtin_bit_cast(v4i, b), 0, 1, 2, 3, 4, 5, 6, 7); }
template <class Epi, bool GATHER, bool ALIGN_EPI, bool FP8>
__device__ __forceinline__ void gemm_phase(const int tid, LAS unsigned char* lds, const LAS int* ul, LAS int* gtab, const char* Abase, const char* Bbase, const int* rowdst, const int RB, const Epi& E, LAS unsigned char* epl = nullptr) {
    const int wid = __builtin_amdgcn_readfirstlane(tid >> 6), lane = tid & 63, wr = wid >> 2, wc = wid & 3, fr = lane & 15, fq = lane >> 4;
    const int nt = RB / 128;
    int R0, C0; stage_rc(tid * 16, R0, C0);
    const int Rb0 = Epi::PERM ? ((R0 & ~31) + perm32(R0 & 31)) : R0;
    const unsigned voffB = (unsigned)(Rb0 * RB + C0 * 2);
    const unsigned cb0 = (unsigned)C0 * 2u, K2 = (unsigned)RB;
    const size_t kstep = (size_t)128;
    const size_t r64 = (size_t)64 * RB;
    const size_t hstep = (size_t)HALF * RB;
    const unsigned ldsw = (unsigned)wid * 1024u;
    const int aoff = lds_byte(wr * 64 + fr, fq * 8), boff = lds_byte(wc * 32 + fr, fq * 8);
#define PG8_SA(b, h) (((b) * 2 + (h)) * HTB)
#define PG8_SB(b, h) ((4 + (b) * 2 + (h)) * HTB)
#define PG8_STAGE(bufoff, gbase) do { glds16((const char*)(gbase), voffB, lds + (bufoff) + ldsw); glds16((const char*)(gbase) + r64, voffB, lds + (bufoff) + ldsw + 8192); } while (0)
#define PG8_STAGEA0(bufoff, kb, o0, o1) stage_a<GATHER>(lds + (bufoff) + ldsw, Abase + (kb), o0, o1, r64)
#define PG8_STAGEA1(bufoff, kb, o0, o2, o3) stage_a<GATHER>(lds + (bufoff) + ldsw, Abase + (kb) + (GATHER ? (size_t)0 : hstep), GATHER ? (o2) : (o0), o3, r64)
#define PG8_LDA(dst, b, h) do { _Pragma("unroll") for (int m = 0; m < 4; ++m) { const v4i _l = *(const LAS v4i*)(lds + PG8_SA(b, h) + aoff + m * 2048), _h = *(const LAS v4i*)(lds + PG8_SA(b, h) + aoff + m * 2048 + 1024); dst[m] = __builtin_shufflevector(_l, _h, 0, 1, 2, 3, 4, 5, 6, 7); } } while (0)
#define PG8_LDB(dst, b, h) do { _Pragma("unroll") for (int n = 0; n < 2; ++n) { const v4i _l = *(const LAS v4i*)(lds + PG8_SB(b, h) + boff + n * 2048), _h = *(const LAS v4i*)(lds + PG8_SB(b, h) + boff + n * 2048 + 1024); dst[n] = __builtin_shufflevector(_l, _h, 0, 1, 2, 3, 4, 5, 6, 7); } } while (0)
#define PG8_LO(x) __builtin_bit_cast(bf16x8, __builtin_shufflevector(x, x, 0, 1, 2, 3))
#define PG8_HI(x) __builtin_bit_cast(bf16x8, __builtin_shufflevector(x, x, 4, 5, 6, 7))
#define PG8_MMA(ai, bj, At, Bt) do { __builtin_amdgcn_s_setprio(1); _Pragma("unroll") for (int m = 0; m < 4; ++m) _Pragma("unroll") for (int n = 0; n < 2; ++n) { \
        if constexpr (FP8) asm volatile("v_mfma_scale_f32_16x16x128_f8f6f4 %0, %1, %2, %0, %3, %3 op_sel_hi:[0,0,0]" : "+v"(acc[ai][bj][m][n]) : "v"(Bt[n]), "v"(At[m]), "v"(sc1)); \
        else { acc[ai][bj][m][n] = __builtin_amdgcn_mfma_f32_16x16x32_bf16(PG8_LO(Bt[n]), PG8_LO(At[m]), acc[ai][bj][m][n], 0, 0, 0); \
               acc[ai][bj][m][n] = __builtin_amdgcn_mfma_f32_16x16x32_bf16(PG8_HI(Bt[n]), PG8_HI(At[m]), acc[ai][bj][m][n], 0, 0, 0); } } \
        __builtin_amdgcn_s_setprio(0); } while (0)
#define PG8_WAIT_V(n) asm volatile("s_waitcnt vmcnt(" #n ")" ::: "memory")
#define PG8_WAIT_L(n) asm volatile("s_waitcnt lgkmcnt(" #n ")" ::: "memory")
#define PG8_BAR __builtin_amdgcn_s_barrier()
#define PG8_SCHED __builtin_amdgcn_sched_barrier(0)
    Unit cur, nxt; int ui = 0;
    if (!ld_unit(ul, 0, cur)) return;
    f32x4 acc[2][2][4][2];
#pragma unroll
    for (int a = 0; a < 2; ++a)
#pragma unroll
        for (int b = 0; b < 2; ++b)
#pragma unroll
            for (int m = 0; m < 4; ++m)
#pragma unroll
                for (int n = 0; n < 2; ++n) acc[a][b][m][n] = (f32x4){0.f, 0.f, 0.f, 0.f};
    v8i At[4], B0[2], B1[2];
    const int sc1 = 0x7f7f7f7f;
    unsigned oA0, oA1 = 0, oA2 = 0, oA3 = 0, oN0, oN1 = 0, oN2 = 0, oN3 = 0;
    if constexpr (GATHER) {
        oA0 = (unsigned)gtab[R0] * K2 + cb0; oA1 = (unsigned)gtab[R0 + 64] * K2 + cb0; oA2 = (unsigned)gtab[R0 + 128] * K2 + cb0; oA3 = (unsigned)gtab[R0 + 192] * K2 + cb0;
    } else {
        oA0 = (unsigned)(cur.rowbase + R0) * K2 + cb0;
    }
    oN0 = oA0; oN1 = oA1; oN2 = oA2; oN3 = oA3;
    const char* cB = Bbase + cur.boff;
    PG8_STAGE(PG8_SB(0, 0), cB); PG8_STAGE(PG8_SB(0, 1), cB + hstep); PG8_STAGEA0(PG8_SA(0, 0), (size_t)0, oA0, oA1); PG8_STAGEA1(PG8_SA(0, 1), (size_t)0, oA0, oA2, oA3);
    if (wr == 1) PG8_BAR;
    PG8_WAIT_V(2); PG8_BAR;
    PG8_STAGE(PG8_SB(1, 0), cB + kstep); PG8_STAGEA0(PG8_SA(1, 0), kstep, oA0, oA1); PG8_STAGE(PG8_SB(1, 1), cB + hstep + kstep);
    PG8_WAIT_V(6); PG8_BAR;
    for (;;) {
        const bool has_next = ld_unit(ul, ui + 1, nxt);
        if constexpr (Epi::HAS_PRE) E.pre(cur, epl + (ui & 1) * Epi::PRE_BYTES, wid, lane);
        const char* nB = has_next ? Bbase + nxt.boff : cB;
_Pragma("unroll 1")
        for (int t = 0; t < nt; t += 2) {
            const bool last = (t == nt - 2);
            if (last && has_next) {
                if constexpr (GATHER) {
                    const LAS int* gt = gtab + (ui + 1) * 256;
                    oN0 = (unsigned)gt[R0] * K2 + cb0; oN1 = (unsigned)gt[R0 + 64] * K2 + cb0; oN2 = (unsigned)gt[R0 + 128] * K2 + cb0; oN3 = (unsigned)gt[R0 + 192] * K2 + cb0;
                } else {
                    oN0 = (unsigned)(nxt.rowbase + R0) * K2 + cb0;
                }
            }
            const size_t kb1 = (size_t)(t + 1) * kstep;
            const size_t kb2 = last ? (size_t)0 : (size_t)(t + 2) * kstep, kb3 = kb2 + kstep;
            const unsigned p0 = last ? oN0 : oA0, p1 = last ? oN1 : oA1, p2 = last ? oN2 : oA2, p3 = last ? oN3 : oA3;
            const char* b2 = last ? nB : cB + (size_t)(t + 2) * kstep; const char* b3 = b2 + kstep;
            PG8_LDB(B0, 0, 0); PG8_LDB(B1, 0, 1); PG8_SCHED; PG8_LDA(At, 0, 0); PG8_STAGEA1(PG8_SA(1, 1), kb1, oA0, oA2, oA3);
            PG8_WAIT_V(8); PG8_WAIT_L(0); PG8_BAR; PG8_MMA(0, 0, At, B0); PG8_MMA(0, 1, At, B1); PG8_BAR; PG8_SCHED;
            PG8_LDA(At, 0, 1); PG8_STAGE(PG8_SB(0, 0), b2); PG8_STAGE(PG8_SB(0, 1), b2 + hstep); PG8_STAGEA0(PG8_SA(0, 0), kb2, p0, p1);
            PG8_WAIT_V(8); PG8_WAIT_L(0); PG8_BAR; PG8_MMA(1, 0, At, B0); PG8_MMA(1, 1, At, B1); PG8_BAR; PG8_SCHED;
            PG8_LDB(B0, 1, 0); PG8_LDB(B1, 1, 1); PG8_SCHED; PG8_LDA(At, 1, 0); PG8_STAGEA1(PG8_SA(0, 1), kb2, p0, p2, p3);
            PG8_WAIT_V(8); PG8_WAIT_L(0); PG8_BAR; PG8_MMA(0, 0, At, B0); PG8_MMA(0, 1, At, B1); PG8_BAR; PG8_SCHED;
            PG8_LDA(At, 1, 1); PG8_STAGE(PG8_SB(1, 0), b3); PG8_STAGE(PG8_SB(1, 1), b3 + hstep); PG8_STAGEA0(PG8_SA(1, 0), kb3, p0, p1);
            PG8_WAIT_V(8); PG8_WAIT_L(0); PG8_BAR; PG8_MMA(1, 0, At, B0); PG8_MMA(1, 1, At, B1); PG8_BAR; PG8_SCHED;
        }
        if constexpr (FP8) asm volatile("s_nop 7\n\ts_nop 7\n\ts_nop 7" ::: "memory");
        if constexpr (ALIGN_EPI) { if (wr == 0) PG8_BAR; }
        if constexpr (Epi::HAS_PRE) E(acc, cur, wr, wc, fr, fq, epl + (ui & 1) * Epi::PRE_BYTES); else E(acc, cur, wr, wc, fr, fq);
#if PROBE_EPI2
        if constexpr (FP8) { if constexpr (Epi::HAS_PRE) E(acc, cur, wr, wc, fr, fq, epl + (ui & 1) * Epi::PRE_BYTES); else E(acc, cur, wr, wc, fr, fq); }
#endif
        if (!has_next) break;
#pragma unroll
        for (int a = 0; a < 2; ++a)
#pragma unroll
            for (int b = 0; b < 2; ++b)
#pragma unroll
                for (int m = 0; m < 4; ++m)
#pragma unroll
                    for (int n = 0; n < 2; ++n) acc[a][b][m][n] = (f32x4){0.f, 0.f, 0.f, 0.f};
        cur = nxt; cB = nB; oA0 = oN0; oA1 = oN1; oA2 = oN2; oA3 = oN3; ++ui;
        if constexpr (ALIGN_EPI) { if (wr == 1) PG8_BAR; }
    }
    PG8_WAIT_V(0);
    if constexpr (!ALIGN_EPI) { if (wr == 0) PG8_BAR; }
    PG8_BAR;
#undef PG8_SA
#undef PG8_SB
#undef PG8_STAGE
#undef PG8_STAGEA0
#undef PG8_STAGEA1
#undef PG8_LDA
#undef PG8_LDB
#undef PG8_LO
#undef PG8_HI
#undef PG8_MMA
#undef PG8_WAIT_V
#undef PG8_WAIT_L
#undef PG8_BAR
#undef PG8_SCHED
}

__device__ __forceinline__ GAS unsigned char* launder(unsigned char* p) { asm volatile("" : "+s"(p)); return (GAS unsigned char*)p; }
#define OPAQUE_LANE(fr, fq) asm volatile("" : "+v"(fr), "+v"(fq))
struct EpiHgrnIn {
    static constexpr bool PERM = true, HAS_PRE = false; static constexpr int PRE_BYTES = 0;
    unsigned char* ws0; int L;
    __device__ __forceinline__ void operator()(const f32x4 (&acc)[2][2][4][2], const Unit& u, int wr, int wc, int fr, int fq) const {
        OPAQUE_LANE(fr, fq);
        GAS unsigned char* ws = launder(ws0);
        GAS bf16* QD = (GAS bf16*)(ws + WS_H);
        const int row0 = u.rowbase + wr * 64 + fr;
        if (u.pn >= 8) {
            const bool isg = u.pn >= 12; GAS bf16* base = QD + (size_t)(isg ? 4 : 3) * NTOK * DM; const int colt = (u.pn - (isg ? 12 : 8)) * BM + wc * 32 + 8 * fq;
#pragma unroll
            for (int ai = 0; ai < 2; ++ai)
#pragma unroll
                for (int m = 0; m < 4; ++m) { GAS bf16* rowp = base + (size_t)(row0 + ai * HALF + m * 16) * DM + colt;
#pragma unroll
                    for (int bj = 0; bj < 2; ++bj) { f32x4 v0 = acc[ai][bj][m][0], v1 = acc[ai][bj][m][1];
                        if (isg) {
#pragma unroll
                            for (int j = 0; j < 4; ++j) { v0[j] = v0[j] * fsigmoid(v0[j]); v1[j] = v1[j] * fsigmoid(v1[j]); } }
                        v4u w; w.x = cvt_pk_bf16(v0[0], v0[1]); w.y = cvt_pk_bf16(v0[2], v0[3]); w.z = cvt_pk_bf16(v1[0], v1[1]); w.w = cvt_pk_bf16(v1[2], v1[3]);
                        *(GAS v4u*)(rowp + bj * HALF) = w; } }
            return;
        }
        const int col = u.pn * HG_K + wc * 32 + 8 * fq;
        const GAS float* lb = (const GAS float*)(ws + WS_LBS) + L * DM;
        const f32x4 lb0 = *(const GAS f32x4*)(lb + col), lb1 = *(const GAS f32x4*)(lb + col + 4);
#if !SLOW_HGRN
        const int lane = fq * 16 + fr;
        GAS float* DEC = (GAS float*)(ws + WS_DEC);
#endif
#pragma unroll
        for (int ai = 0; ai < 2; ++ai)
#pragma unroll
            for (int m = 0; m < 4; ++m) {
                const int row = row0 + ai * HALF + m * 16;
                float qd[8], ki[8];
#if SLOW_HGRN
                float ks[8];
#endif
#if !SLOW_HGRN
                float de[8];
#endif
#pragma unroll
                for (int j = 0; j < 8; ++j) {
                    const float q = acc[ai][0][m][j >> 2][j & 3], f = acc[ai][1][m][j >> 2][j & 3], lbv = j < 4 ? lb0[j & 3] : lb1[j & 3];
                    const float sg = fsigmoid(f), fg = lbv + (1.0f - lbv) * sg, kk = (1.0f - lbv) * (1.0f - sg);
#if SLOW_HGRN
                    qd[j] = q * fsigmoid(q); ki[j] = kk; ks[j] = fg;
#else
                    float P = fg;
                    P *= __builtin_bit_cast(float, __builtin_amdgcn_update_dpp(0x3f800000, __builtin_bit_cast(int, P), 0x111, 0xf, 0xf, false));
                    P *= __builtin_bit_cast(float, __builtin_amdgcn_update_dpp(0x3f800000, __builtin_bit_cast(int, P), 0x112, 0xf, 0xf, false));
                    P *= __builtin_bit_cast(float, __builtin_amdgcn_update_dpp(0x3f800000, __builtin_bit_cast(int, P), 0x114, 0xf, 0xf, false));
                    P *= __builtin_bit_cast(float, __builtin_amdgcn_update_dpp(0x3f800000, __builtin_bit_cast(int, P), 0x118, 0xf, 0xf, false));
                    const float Pl = __shfl(P, lane | 15), iP = frcp(fmaxf(P, 1e-30f));
                    qd[j] = q * fsigmoid(q) * P; ki[j] = kk * iP; de[j] = Pl;
#endif
                }
                const size_t o = (size_t)row * DM + col;
                v4u w;
                w.x = cvt_pk_bf16(qd[0], qd[1]); w.y = cvt_pk_bf16(qd[2], qd[3]); w.z = cvt_pk_bf16(qd[4], qd[5]); w.w = cvt_pk_bf16(qd[6], qd[7]); *(GAS v4u*)(QD + o) = w;
                w.x = cvt_pk_bf16(ki[0], ki[1]); w.y = cvt_pk_bf16(ki[2], ki[3]); w.z = cvt_pk_bf16(ki[4], ki[5]); w.w = cvt_pk_bf16(ki[6], ki[7]); *(GAS v4u*)(QD + (size_t)NTOK * DM + o) = w;
#if SLOW_HGRN
                w.x = cvt_pk_bf16(ks[0], ks[1]); w.y = cvt_pk_bf16(ks[2], ks[3]); w.z = cvt_pk_bf16(ks[4], ks[5]); w.w = cvt_pk_bf16(ks[6], ks[7]); *(GAS v4u*)(QD + 2 * (size_t)NTOK * DM + o) = w;
#endif
#if !SLOW_HGRN
                if (fr == 0) { GAS float* dp = DEC + (size_t)(row >> 4) * DM + col; *(GAS f32x4*)dp = (f32x4){de[0], de[1], de[2], de[3]}; *(GAS f32x4*)(dp + 4) = (f32x4){de[4], de[5], de[6], de[7]}; }
#endif
            }
    }
};
struct EpiRetIn {
    static constexpr bool PERM = true, HAS_PRE = false; static constexpr int PRE_BYTES = 0;
    unsigned char* ws0;
    __device__ __forceinline__ void operator()(const f32x4 (&acc)[2][2][4][2], const Unit& u, int wr, int wc, int fr, int fq) const {
        OPAQUE_LANE(fr, fq);
        GAS unsigned char* ws = launder(ws0);
        GAS bf16* H = (GAS bf16*)(ws + WS_H); const GAS float* rot = (const GAS float*)(ws + WS_ROT);
        const int row0 = u.rowbase + wr * 64 + fr; const int colt = u.pn * BM + wc * 32 + 8 * fq;
        const int kind = u.pn < 4 ? 0 : (u.pn < 8 ? 1 : (u.pn < 16 ? 2 : 3));
#pragma unroll
        for (int ai = 0; ai < 2; ++ai)
#pragma unroll
            for (int m = 0; m < 4; ++m) { const int row = row0 + ai * HALF + m * 16; GAS bf16* rowp = H + (size_t)row * RT_IN + colt; const int pos = row & (SEQ - 1);
#pragma unroll
                for (int bj = 0; bj < 2; ++bj) { f32x4 v0 = acc[ai][bj][m][0], v1 = acc[ai][bj][m][1];
                    if (kind <= 1) {
                        const int p0 = (bj * HALF + wc * 32 + 8 * fq) >> 1;
                        const GAS float* rp = rot + ((size_t)pos * 128 + p0) * 2;
                        const f32x4 r0 = *(const GAS f32x4*)rp, r1 = *(const GAS f32x4*)(rp + 4);
                        const float sc = kind == 1 ? 0.0625f : 1.0f;
                        f32x4 o0, o1;
                        o0[0] = (v0[0] * r0[0] - v0[1] * r0[1]) * sc; o0[1] = (v0[1] * r0[0] + v0[0] * r0[1]) * sc;
                        o0[2] = (v0[2] * r0[2] - v0[3] * r0[3]) * sc; o0[3] = (v0[3] * r0[2] + v0[2] * r0[3]) * sc;
                        o1[0] = (v1[0] * r1[0] - v1[1] * r1[1]) * sc; o1[1] = (v1[1] * r1[0] + v1[0] * r1[1]) * sc;
                        o1[2] = (v1[2] * r1[2] - v1[3] * r1[3]) * sc; o1[3] = (v1[3] * r1[2] + v1[2] * r1[3]) * sc;
                        v0 = o0; v1 = o1;
                    } else if (kind == 3) {
#pragma unroll
                        for (int j = 0; j < 4; ++j) { v0[j] = v0[j] * fsigmoid(v0[j]); v1[j] = v1[j] * fsigmoid(v1[j]); }
                    }
                    v4u w; w.x = cvt_pk_bf16(v0[0], v0[1]); w.y = cvt_pk_bf16(v0[2], v0[3]); w.z = cvt_pk_bf16(v1[0], v1[1]); w.w = cvt_pk_bf16(v1[2], v1[3]);
                    *(GAS v4u*)(rowp + bj * HALF) = w; } }
    }
};
struct EpiRes {
    static constexpr bool PERM = true, HAS_PRE = false; static constexpr int PRE_BYTES = 0;
    unsigned char* ws0; int ssoff;
    __device__ __forceinline__ void operator()(const f32x4 (&acc)[2][2][4][2], const Unit& u, int wr, int wc, int fr, int fq) const {
        OPAQUE_LANE(fr, fq);
        GAS unsigned char* ws = launder(ws0);
        GAS bf16* Y = (GAS bf16*)(ws + WS_Y); const GAS bf16* X = (const GAS bf16*)(ws + WS_XB);
        const int row0 = u.rowbase + wr * 64 + fr, col0 = u.pn * BM + wc * 32 + 8 * fq;
#pragma unroll
        for (int ai = 0; ai < 2; ++ai)
#pragma unroll
            for (int m = 0; m < 4; ++m) { const size_t off = (size_t)(row0 + ai * HALF + m * 16) * DM + col0;
                float rsc = 1.0f;
                if (ssoff >= 0) { const GAS float* sp = (const GAS float*)(ws + WS_SSP) + row0 + ai * HALF + m * 16; float ssum = 0.f;
#pragma unroll
                    for (int hh = 0; hh < HG_HEADS; ++hh) ssum += sp[(size_t)hh * NTOK];
                    rsc = 1.0f / sqrtf(ssum * (1.0f / DM) + RMS_EPS); }
#pragma unroll
                for (int bj = 0; bj < 2; ++bj) { const v4u xs = *(const GAS v4u*)(X + off + bj * HALF); const f32x4 a0 = acc[ai][bj][m][0] * rsc, a1 = acc[ai][bj][m][1] * rsc;
                    v4u w; w.x = cvt_pk_bf16(bflo(xs.x) * DN_ALPHA + a0[0], bfhi(xs.x) * DN_ALPHA + a0[1]); w.y = cvt_pk_bf16(bflo(xs.y) * DN_ALPHA + a0[2], bfhi(xs.y) * DN_ALPHA + a0[3]);
                    w.z = cvt_pk_bf16(bflo(xs.z) * DN_ALPHA + a1[0], bfhi(xs.z) * DN_ALPHA + a1[1]); w.w = cvt_pk_bf16(bflo(xs.w) * DN_ALPHA + a1[2], bfhi(xs.w) * DN_ALPHA + a1[3]);
                    *(GAS v4u*)(Y + off + bj * HALF) = w; } }
    }
};
struct EpiMoeGU {
    static constexpr bool PERM = true, HAS_PRE = true; static constexpr int PRE_BYTES = 1024;
    unsigned char* ws0; int L;
    __device__ __forceinline__ void pre(const Unit& u, LAS unsigned char* buf, int wid, int lane) const {
        if (wid == 0) glds16((const char*)(ws0 + WS_BGU) + ((size_t)L * NE * 2048 + ((size_t)u.e * 8 + u.pn) * 256) * 4, (unsigned)lane * 16u, buf);
    }
    __device__ __forceinline__ void operator()(const f32x4 (&acc)[2][2][4][2], const Unit& u, int wr, int wc, int fr, int fq, const LAS unsigned char* buf) const {
        OPAQUE_LANE(fr, fq);
        GAS unsigned char* ws = launder(ws0);
        const int row0 = u.rowbase + wr * 64 + fr; const int c8 = wc * 32 + 8 * fq;
        const LAS float* bp = (const LAS float*)buf + c8;
        const f32x4 bg0 = *(const LAS f32x4*)bp, bg1 = *(const LAS f32x4*)(bp + 4);
        const f32x4 bl0 = (*(const LAS f32x4*)(bp + HALF) + 1.0f) * ACT_SCALE, bl1 = (*(const LAS f32x4*)(bp + HALF + 4) + 1.0f) * ACT_SCALE;
#pragma unroll
        for (int ai = 0; ai < 2; ++ai)
#pragma unroll
            for (int m = 0; m < 4; ++m) { const size_t eo = (size_t)(row0 + ai * HALF + m * 16) * DM + u.pn * HALF + c8;
                float a[8];
#pragma unroll
                for (int j = 0; j < 8; ++j) {
                    const float g = fminf(fmaf(acc[ai][0][m][j >> 2][j & 3], GU_DESCALE, j < 4 ? bg0[j & 3] : bg1[j & 3]), 7.0f);
                    const float l1 = __builtin_amdgcn_fmed3f(fmaf(acc[ai][1][m][j >> 2][j & 3], GU_DESCALE * ACT_SCALE, j < 4 ? bl0[j & 3] : bl1[j & 3]), -6.0f * ACT_SCALE, 8.0f * ACT_SCALE);
                    a[j] = g * frcp(1.0f + __builtin_amdgcn_exp2f(g * -2.4554669595930156f)) * l1;
                }
#if MOE_FP8
                v2u w;
                { int p = __builtin_amdgcn_cvt_pk_fp8_f32(a[0], a[1], 0, false); p = __builtin_amdgcn_cvt_pk_fp8_f32(a[2], a[3], p, true); w.x = (unsigned)p; }
                { int p = __builtin_amdgcn_cvt_pk_fp8_f32(a[4], a[5], 0, false); p = __builtin_amdgcn_cvt_pk_fp8_f32(a[6], a[7], p, true); w.y = (unsigned)p; }
                *(GAS v2u*)(ws + WS_ACT + eo) = w;
#else
                v4u w; w.x = cvt_pk_bf16(a[0], a[1]); w.y = cvt_pk_bf16(a[2], a[3]); w.z = cvt_pk_bf16(a[4], a[5]); w.w = cvt_pk_bf16(a[6], a[7]);
                *(GAS v4u*)((GAS bf16*)(ws + WS_ACT) + eo) = w;
#endif
            }
    }
};
struct EpiMoeDown {
    static constexpr bool PERM = true, HAS_PRE = true; static constexpr int PRE_BYTES = 3072;
    unsigned char* ws0; const float* bias;
    __device__ __forceinline__ void pre(const Unit& u, LAS unsigned char* buf, int wid, int lane) const {
        if (wid == 0) glds16((const char*)(bias + (size_t)u.e * DM + u.pn * BM), (unsigned)lane * 16u, buf);
        if (wid == 1) glds16((const char*)(ws0 + WS_ROWDST) + (size_t)u.gidx * 4, (unsigned)lane * 16u, buf + 1024);
        if (wid == 2) glds16((const char*)(ws0 + WS_ROWGATE) + (size_t)u.gidx * 4, (unsigned)lane * 16u, buf + 2048);
    }
    __device__ __forceinline__ void operator()(const f32x4 (&acc)[2][2][4][2], const Unit& u, int wr, int wc, int fr, int fq, const LAS unsigned char* buf) const {
        OPAQUE_LANE(fr, fq);
        GAS unsigned char* ws = launder(ws0);
        GAS bf16* YS = (GAS bf16*)(ws + WS_YSLOT);
        const int c8 = u.pn * BM + wc * 32 + 8 * fq;
        const LAS float* bp = (const LAS float*)buf + wc * 32 + 8 * fq;
        f32x4 bv[2][2];
#pragma unroll
        for (int bj = 0; bj < 2; ++bj) { bv[bj][0] = *(const LAS f32x4*)(bp + bj * HALF); bv[bj][1] = *(const LAS f32x4*)(bp + bj * HALF + 4); }
#pragma unroll
        for (int ai = 0; ai < 2; ++ai)
#pragma unroll
            for (int m = 0; m < 4; ++m) { const int r = ai * HALF + wr * 64 + m * 16 + fr;
                if (r < u.cnt) {
                    const int dst = ((const LAS int*)(buf + 1024))[r]; const float gt = ((const LAS float*)(buf + 2048))[r];
#if YS_FP8
                    GAS unsigned char* rowp = (GAS unsigned char*)YS + (size_t)dst * DM + c8;
#pragma unroll
                    for (int bj = 0; bj < 2; ++bj) { const f32x4 v0 = (acc[ai][bj][m][0] * DN_DESCALE + bv[bj][0]) * (gt * 64.0f), v1 = (acc[ai][bj][m][1] * DN_DESCALE + bv[bj][1]) * (gt * 64.0f);
                        v2u w; w.x = pk4_fp8(v0[0], v0[1], v0[2], v0[3]); w.y = pk4_fp8(v1[0], v1[1], v1[2], v1[3]);
                        *(GAS v2u*)(rowp + bj * HALF) = w; } } }
#else
                    GAS bf16* rowp = YS + (size_t)dst * DM + c8;
#pragma unroll
                    for (int bj = 0; bj < 2; ++bj) { const f32x4 v0 = (acc[ai][bj][m][0] * DN_DESCALE + bv[bj][0]) * gt, v1 = (acc[ai][bj][m][1] * DN_DESCALE + bv[bj][1]) * gt;
                        v4u w; w.x = cvt_pk_bf16(v0[0], v0[1]); w.y = cvt_pk_bf16(v0[2], v0[3]); w.z = cvt_pk_bf16(v1[0], v1[1]); w.w = cvt_pk_bf16(v1[2], v1[3]);
                        *(GAS v4u*)(rowp + bj * HALF) = w; } } }
#endif
    }
};
}

typedef short s16x4 __attribute__((ext_vector_type(4)));
typedef __bf16 bf16x2_t __attribute__((ext_vector_type(2)));
__device__ __forceinline__ unsigned cvtpk(float lo, float hi) { f32x2 v = {lo, hi}; bf16x2_t b = __builtin_convertvector(v, bf16x2_t); return __builtin_bit_cast(unsigned, b); }
__device__ __forceinline__ s16x4 tr_read(const LAS unsigned char* p) { return __builtin_bit_cast(s16x4, __builtin_amdgcn_ds_read_tr16_b64_v4i16((LAS s16x4*)p)); }
__device__ __forceinline__ bf16x8 cat8(s16x4 lo, s16x4 hi) { return __builtin_shufflevector(lo, hi, 0, 1, 2, 3, 4, 5, 6, 7); }
__device__ __forceinline__ bf16x8 pack8(const f32x4& a, const f32x4& b) { v4u p; p.x = cvtpk(a[0], a[1]); p.y = cvtpk(a[2], a[3]); p.z = cvtpk(b[0], b[1]); p.w = cvtpk(b[2], b[3]); return __builtin_bit_cast(bf16x8, p); }
__device__ __forceinline__ s16x4 pack4(const f32x4& a) { v2u p; p.x = cvtpk(a[0], a[1]); p.y = cvtpk(a[2], a[3]); return __builtin_bit_cast(s16x4, p); }
#define LDS_BARRIER() do { asm volatile("s_waitcnt lgkmcnt(0)" ::: "memory"); __builtin_amdgcn_s_barrier(); asm volatile("" ::: "memory"); } while (0)
#define MFMA32(a, b, c) __builtin_amdgcn_mfma_f32_16x16x32_bf16((a), (b), (c), 0, 0, 0)
#define MFMA16(a, b, c) __builtin_amdgcn_mfma_f32_16x16x16bf16_1k((a), (b), (c), 0, 0, 0)

__device__ __forceinline__ void ret_fast(const int tid, LAS unsigned char* lds, const bf16* HB, bf16* OB) {
    constexpr int QP = 528, VP = 272, PP = 144;
    constexpr int OFF_Q = 0, OFF_K = 64 * QP, OFF_V = 2 * 64 * QP, OFF_P = OFF_V + 64 * VP;
    const int lane0 = tid & 63, w = __builtin_amdgcn_readfirstlane(tid >> 6);
    const int prow = tid >> 3, pc = tid & 7;
    for (int un0 = blockIdx.x; un0 < NBATCH * RT_HEADS * 4; un0 += gridDim.x) {
        const int un = (gridDim.x == 256) ? ((un0 & 7) * 32 + (un0 >> 3)) : un0;
        const int b = un >> 4, h = (un >> 2) & 3, vs = un & 3;
        const float l2g = __builtin_amdgcn_logf(1.0f - __builtin_amdgcn_exp2f(-5.0f - (float)h));
        const float dC = __builtin_amdgcn_exp2f(64.0f * l2g);
        f32x4 st[16];
#pragma unroll
        for (int i = 0; i < 16; ++i) st[i] = (f32x4){0.f, 0.f, 0.f, 0.f};
        const bf16* gbase = HB + (size_t)(b * SEQ + prow) * RT_IN;
        v4u pq[4], pk[4], pv[2];
#pragma unroll
        for (int j = 0; j < 4; ++j) { pq[j] = *(const v4u*)(gbase + h * 256 + (pc + 8 * j) * 8); pk[j] = *(const v4u*)(gbase + 1024 + h * 256 + (pc + 8 * j) * 8); }
#pragma unroll
        for (int j = 0; j < 2; ++j) pv[j] = *(const v4u*)(gbase + 2048 + h * 512 + vs * 128 + (pc + 8 * j) * 8);
#pragma unroll 1
        for (int ch = 0; ch < SEQ / 64; ++ch) {
            int lane = lane0; asm volatile("" : "+v"(lane));
            const int r = lane & 15, g = lane >> 4, q4 = (lane & 15) >> 2, p4 = lane & 3;
            LDS_BARRIER();
#pragma unroll
            for (int j = 0; j < 4; ++j) { *(LAS v4u*)(lds + OFF_Q + prow * QP + (pc + 8 * j) * 16) = pq[j]; *(LAS v4u*)(lds + OFF_K + prow * QP + (pc + 8 * j) * 16) = pk[j]; }
#pragma unroll
            for (int j = 0; j < 2; ++j) *(LAS v4u*)(lds + OFF_V + prow * VP + (pc + 8 * j) * 16) = pv[j];
            if (ch + 1 < SEQ / 64) {
                const bf16* gn = gbase + (size_t)(ch + 1) * 64 * RT_IN;
#pragma unroll
                for (int j = 0; j < 4; ++j) { pq[j] = *(const v4u*)(gn + h * 256 + (pc + 8 * j) * 8); pk[j] = *(const v4u*)(gn + 1024 + h * 256 + (pc + 8 * j) * 8); }
#pragma unroll
                for (int j = 0; j < 2; ++j) pv[j] = *(const v4u*)(gn + 2048 + h * 512 + vs * 128 + (pc + 8 * j) * 8);
            }
            LDS_BARRIER();
            {
                const int ct = w >> 1, st0 = 2 * (w & 1);
                f32x4 sa0 = {0.f, 0.f, 0.f, 0.f}, sa1 = {0.f, 0.f, 0.f, 0.f};
                const LAS unsigned char* qb = lds + OFF_Q + (16 * ct + r) * QP + g * 16;
                const LAS unsigned char* kb0 = lds + OFF_K + (16 * st0 + r) * QP + g * 16;
#pragma unroll
                for (int hb = 0; hb < 4; ++hb) {
                    bf16x8 qf[2], k0[2], k1[2];
#pragma unroll
                    for (int kk = 0; kk < 2; ++kk) { const int kb = hb * 2 + kk; qf[kk] = *(const LAS bf16x8*)(qb + kb * 64); k0[kk] = *(const LAS bf16x8*)(kb0 + kb * 64); k1[kk] = *(const LAS bf16x8*)(kb0 + 16 * QP + kb * 64); }
                    asm volatile("" : "+v"(qf[0]), "+v"(qf[1]), "+v"(k0[0]), "+v"(k0[1]), "+v"(k1[0]), "+v"(k1[1]) :: "memory");
#pragma unroll
                    for (int kk = 0; kk < 2; ++kk) { sa0 = MFMA32(k0[kk], qf[kk], sa0); sa1 = MFMA32(k1[kk], qf[kk], sa1); }
                }
                const int c = 16 * ct + r;
#pragma unroll
                for (int t = 0; t < 2; ++t) {
                    const f32x4 sa = t ? sa1 : sa0; const int s0 = 16 * (st0 + t) + 4 * g; float v[4];
#pragma unroll
                    for (int i = 0; i < 4; ++i) { const int d = c - (s0 + i); v[i] = d >= 0 ? sa[i] * __builtin_amdgcn_exp2f((float)d * l2g) : 0.f; }
                    v2u pw; pw.x = cvtpk(v[0], v[1]); pw.y = cvtpk(v[2], v[3]);
                    *(LAS v2u*)(lds + OFF_P + c * PP + s0 * 2) = pw;
                }
            }
            LDS_BARRIER();
            f32x4 o[4];
#pragma unroll
            for (int ct = 0; ct < 4; ++ct) o[ct] = (f32x4){0.f, 0.f, 0.f, 0.f};
            {
                s16x4 ql[2][4], qh[2][4];
                const LAS unsigned char* qp0 = lds + OFF_Q + r * QP + (4 * g) * 2;
#pragma unroll
                for (int ct = 0; ct < 4; ++ct) { ql[0][ct] = *(const LAS s16x4*)(qp0 + ct * 16 * QP); qh[0][ct] = *(const LAS s16x4*)(qp0 + ct * 16 * QP + 32); }
#pragma unroll
                for (int kb = 0; kb < 8; ++kb) {
                    const int cu = kb & 1, nx = cu ^ 1;
                    if (kb + 1 < 8) {
#pragma unroll
                        for (int ct = 0; ct < 4; ++ct) { ql[nx][ct] = *(const LAS s16x4*)(qp0 + ct * 16 * QP + (kb + 1) * 64); qh[nx][ct] = *(const LAS s16x4*)(qp0 + ct * 16 * QP + (kb + 1) * 64 + 32); }
                    }
                    asm volatile("" : "+v"(ql[cu][0]), "+v"(ql[cu][1]), "+v"(ql[cu][2]), "+v"(ql[cu][3]), "+v"(qh[cu][0]), "+v"(qh[cu][1]), "+v"(qh[cu][2]), "+v"(qh[cu][3]) :: "memory");
                    const bf16x8 sa = pack8(st[2 * kb], st[2 * kb + 1]);
#pragma unroll
                    for (int ct = 0; ct < 4; ++ct) o[ct] = MFMA32(sa, cat8(ql[cu][ct], qh[cu][ct]), o[ct]);
                }
            }
            bf16x8 vf[2], pf[6];
            {
                s16x4 t0[2], t1[2];
#pragma unroll
                for (int sb = 0; sb < 2; ++sb) { const LAS unsigned char* vp = lds + OFF_V + (32 * sb + 8 * g + q4) * VP + (16 * w + 4 * p4) * 2; t0[sb] = tr_read(vp); t1[sb] = tr_read(vp + 4 * VP); }
                pf[0] = *(const LAS bf16x8*)(lds + OFF_P + (0 + r) * PP + (8 * g) * 2);
                pf[1] = *(const LAS bf16x8*)(lds + OFF_P + (16 + r) * PP + (8 * g) * 2);
                pf[2] = *(const LAS bf16x8*)(lds + OFF_P + (32 + r) * PP + (8 * g) * 2);
                pf[3] = *(const LAS bf16x8*)(lds + OFF_P + (32 + r) * PP + (32 + 8 * g) * 2);
                pf[4] = *(const LAS bf16x8*)(lds + OFF_P + (48 + r) * PP + (8 * g) * 2);
                pf[5] = *(const LAS bf16x8*)(lds + OFF_P + (48 + r) * PP + (32 + 8 * g) * 2);
                asm volatile("" : "+v"(t0[0]), "+v"(t0[1]), "+v"(t1[0]), "+v"(t1[1]), "+v"(pf[0]), "+v"(pf[1]), "+v"(pf[2]), "+v"(pf[3]), "+v"(pf[4]), "+v"(pf[5]) :: "memory");
                vf[0] = cat8(t0[0], t1[0]); vf[1] = cat8(t0[1], t1[1]);
            }
#pragma unroll
            for (int ct = 0; ct < 4; ++ct) o[ct] = o[ct] * __builtin_amdgcn_exp2f((float)(16 * ct + r + 1) * l2g);
            o[0] = MFMA32(vf[0], pf[0], o[0]); o[1] = MFMA32(vf[0], pf[1], o[1]);
            o[2] = MFMA32(vf[0], pf[2], o[2]); o[2] = MFMA32(vf[1], pf[3], o[2]);
            o[3] = MFMA32(vf[0], pf[4], o[3]); o[3] = MFMA32(vf[1], pf[5], o[3]);
            {
                bf16* ob = OB + (size_t)(b * SEQ + ch * 64 + r) * RT_VD + h * 512 + vs * 128 + 16 * w + 4 * g;
#pragma unroll
                for (int ct = 0; ct < 4; ++ct) { v2u ow; ow.x = cvtpk(o[ct][0], o[ct][1]); ow.y = cvtpk(o[ct][2], o[ct][3]); *(v2u*)(ob + (size_t)ct * 16 * RT_VD) = ow; }
            }
            bf16x8 vz[2];
#pragma unroll
            for (int sb = 0; sb < 2; ++sb) {
                const v4u raw = __builtin_bit_cast(v4u, vf[sb]); float f[8] = {bflo(raw.x), bfhi(raw.x), bflo(raw.y), bfhi(raw.y), bflo(raw.z), bfhi(raw.z), bflo(raw.w), bfhi(raw.w)};
#pragma unroll
                for (int j = 0; j < 8; ++j) f[j] *= __builtin_amdgcn_exp2f((float)(63 - (32 * sb + 8 * g + j)) * l2g);
                v4u z; z.x = cvtpk(f[0], f[1]); z.y = cvtpk(f[2], f[3]); z.z = cvtpk(f[4], f[5]); z.w = cvtpk(f[6], f[7]); vz[sb] = __builtin_bit_cast(bf16x8, z);
            }
            {
                const LAS unsigned char* kp0 = lds + OFF_K + (8 * g + q4) * QP + (4 * p4) * 2;
#pragma unroll
                for (int kq = 0; kq < 4; ++kq) {
                    s16x4 ka[4][2], kbh[4][2];
#pragma unroll
                    for (int j = 0; j < 4; ++j)
#pragma unroll
                        for (int sb = 0; sb < 2; ++sb) { const LAS unsigned char* kp = kp0 + (32 * sb) * QP + (16 * (kq * 4 + j)) * 2; ka[j][sb] = tr_read(kp); kbh[j][sb] = tr_read(kp + 4 * QP); }
                    asm volatile("" : "+v"(ka[0][0]), "+v"(ka[0][1]), "+v"(ka[1][0]), "+v"(ka[1][1]), "+v"(ka[2][0]), "+v"(ka[2][1]), "+v"(ka[3][0]), "+v"(ka[3][1]),
                                      "+v"(kbh[0][0]), "+v"(kbh[0][1]), "+v"(kbh[1][0]), "+v"(kbh[1][1]), "+v"(kbh[2][0]), "+v"(kbh[2][1]), "+v"(kbh[3][0]), "+v"(kbh[3][1]) :: "memory");
#pragma unroll
                    for (int j = 0; j < 4; ++j) { const int kt = kq * 4 + j;
                        st[kt] = st[kt] * dC;
                        st[kt] = MFMA32(cat8(ka[j][0], kbh[j][0]), vz[0], st[kt]);
                        st[kt] = MFMA32(cat8(ka[j][1], kbh[j][1]), vz[1], st[kt]); }
                }
            }
        }
        LDS_BARRIER();
    }
}

__device__ __forceinline__ void hgrn_fast(const int tid, LAS unsigned char* lds, const bf16* QD, const bf16* KI, const bf16* GG, const bf16* VV, const float* DEC, const float* ng, bf16* A2, float* SS) {
    constexpr int TP = 272;
    constexpr int OFF_QD = 0, OFF_KI = 64 * TP, OFF_G = 2 * 64 * TP, OFF_V = 3 * 64 * TP, OFF_DEC = 4 * 64 * TP, OFF_SS = OFF_DEC + 2048;
    const int lane = tid & 63, w = __builtin_amdgcn_readfirstlane(tid >> 6), r = lane & 15, g = lane >> 4, q4 = (lane & 15) >> 2, p4 = lane & 3;
    const int prow = tid >> 3, pc = tid & 7;
    for (int un = blockIdx.x; un < NBATCH * HG_HEADS; un += gridDim.x) {
        const int b = un >> 3, h = un & 7;
        f32x4 st[8];
#pragma unroll
        for (int i = 0; i < 8; ++i) st[i] = (f32x4){0.f, 0.f, 0.f, 0.f};
        const f32x4 ng4 = *(const f32x4*)(ng + h * 128 + 16 * w + 4 * g);
        const size_t goff = (size_t)(b * SEQ + prow) * DM + h * 128;
        v4u p0[2], p1[2], p2[2], p3[2]; f32x4 pd = {0.f, 0.f, 0.f, 0.f};
#pragma unroll
        for (int j = 0; j < 2; ++j) { const size_t o = goff + (pc + 8 * j) * 8; p0[j] = *(const v4u*)(QD + o); p1[j] = *(const v4u*)(KI + o); p2[j] = *(const v4u*)(GG + o); p3[j] = *(const v4u*)(VV + o); }
        if (tid < 128) pd = *(const f32x4*)(DEC + (size_t)((b * SEQ) / 16 + (tid >> 5)) * DM + h * 128 + (tid & 31) * 4);
#pragma unroll 1
        for (int rd = 0; rd < SEQ / 64; ++rd) {
            LDS_BARRIER();
            if (rd > 0 && tid < 64) {
                float s = 0.f;
#pragma unroll
                for (int ww = 0; ww < 8; ++ww) s += *(const LAS float*)(lds + OFF_SS + (ww * 64 + tid) * 4);
                SS[(size_t)h * NTOK + (size_t)b * SEQ + (rd - 1) * 64 + tid] = s;
            }
#pragma unroll
            for (int j = 0; j < 2; ++j) { const int lo = prow * TP + (pc + 8 * j) * 16; *(LAS v4u*)(lds + OFF_QD + lo) = p0[j]; *(LAS v4u*)(lds + OFF_KI + lo) = p1[j]; *(LAS v4u*)(lds + OFF_G + lo) = p2[j]; *(LAS v4u*)(lds + OFF_V + lo) = p3[j]; }
            if (tid < 128) *(LAS f32x4*)(lds + OFF_DEC + tid * 16) = pd;
            if (rd + 1 < SEQ / 64) {
                const size_t gn = goff + (size_t)(rd + 1) * 64 * DM;
#pragma unroll
                for (int j = 0; j < 2; ++j) { const size_t o = gn + (pc + 8 * j) * 8; p0[j] = *(const v4u*)(QD + o); p1[j] = *(const v4u*)(KI + o); p2[j] = *(const v4u*)(GG + o); p3[j] = *(const v4u*)(VV + o); }
                if (tid < 128) pd = *(const f32x4*)(DEC + (size_t)((b * SEQ + (rd + 1) * 64) / 16 + (tid >> 5)) * DM + h * 128 + (tid & 31) * 4);
            }
            LDS_BARRIER();
#pragma unroll 1
            for (int cc = 0; cc < 4; ++cc) {
                s16x4 ql[4], qh[4], kl[4], kh[4], ktr[8]; f32x4 d4[8];
#pragma unroll
                for (int kb = 0; kb < 4; ++kb) {
                    const int off = (16 * cc + r) * TP + (32 * kb + 4 * g) * 2;
                    ql[kb] = *(const LAS s16x4*)(lds + OFF_QD + off); qh[kb] = *(const LAS s16x4*)(lds + OFF_QD + off + 32);
                    kl[kb] = *(const LAS s16x4*)(lds + OFF_KI + off); kh[kb] = *(const LAS s16x4*)(lds + OFF_KI + off + 32);
                }
                s16x4 vfr = tr_read(lds + OFF_V + (16 * cc + 4 * g + q4) * TP + (16 * w + 4 * p4) * 2);
                s16x4 gfr = *(const LAS s16x4*)(lds + OFF_G + (16 * cc + r) * TP + (16 * w + 4 * g) * 2);
#pragma unroll
                for (int kt = 0; kt < 8; ++kt) {
                    d4[kt] = *(const LAS f32x4*)(lds + OFF_DEC + cc * 512 + (16 * kt + 4 * g) * 4);
                    ktr[kt] = tr_read(lds + OFF_KI + (16 * cc + 4 * g + q4) * TP + (16 * kt + 4 * p4) * 2);
                }
                asm volatile("" : "+v"(ql[0]), "+v"(ql[1]), "+v"(ql[2]), "+v"(ql[3]), "+v"(qh[0]), "+v"(qh[1]), "+v"(qh[2]), "+v"(qh[3]),
                                  "+v"(kl[0]), "+v"(kl[1]), "+v"(kl[2]), "+v"(kl[3]), "+v"(kh[0]), "+v"(kh[1]), "+v"(kh[2]), "+v"(kh[3]), "+v"(vfr), "+v"(gfr));
                asm volatile("" : "+v"(ktr[0]), "+v"(ktr[1]), "+v"(ktr[2]), "+v"(ktr[3]), "+v"(ktr[4]), "+v"(ktr[5]), "+v"(ktr[6]), "+v"(ktr[7]),
                                  "+v"(d4[0]), "+v"(d4[1]), "+v"(d4[2]), "+v"(d4[3]), "+v"(d4[4]), "+v"(d4[5]), "+v"(d4[6]), "+v"(d4[7]));
                bf16x8 qf[4];
#pragma unroll
                for (int kb = 0; kb < 4; ++kb) qf[kb] = cat8(ql[kb], qh[kb]);
                f32x4 sc = {0.f, 0.f, 0.f, 0.f}, oa = {0.f, 0.f, 0.f, 0.f};
#pragma unroll
                for (int kb = 0; kb < 4; ++kb) sc = MFMA32(cat8(kl[kb], kh[kb]), qf[kb], sc);
#pragma unroll
                for (int kb = 0; kb < 4; ++kb) oa = MFMA32(pack8(st[2 * kb], st[2 * kb + 1]), qf[kb], oa);
#pragma unroll
                for (int kt = 0; kt < 8; ++kt) st[kt] = MFMA16(ktr[kt], vfr, st[kt]) * d4[kt];
#pragma unroll
                for (int i = 0; i < 4; ++i) sc[i] = (4 * g + i <= r) ? sc[i] : 0.f;
                oa = MFMA16(vfr, pack4(sc), oa);
                { const v2u gr = __builtin_bit_cast(v2u, gfr);
                  v2u ow; ow.x = cvtpk(oa[0] * ng4[0] * bflo(gr.x), oa[1] * ng4[1] * bfhi(gr.x)); ow.y = cvtpk(oa[2] * ng4[2] * bflo(gr.y), oa[3] * ng4[3] * bfhi(gr.y));
                  *(v2u*)(A2 + (size_t)(b * SEQ + rd * 64 + cc * 16 + r) * DM + h * 128 + 16 * w + 4 * g) = ow;
                  float p = (oa[0] * oa[0] + oa[1] * oa[1]) + (oa[2] * oa[2] + oa[3] * oa[3]);
                  p += __shfl_xor(p, 16); p += __shfl_xor(p, 32);
                  if (lane < 16) *(LAS float*)(lds + OFF_SS + (w * 64 + cc * 16 + r) * 4) = p; }
            }
        }
        LDS_BARRIER();
        if (tid < 64) { float s = 0.f;
#pragma unroll
            for (int ww = 0; ww < 8; ++ww) s += *(const LAS float*)(lds + OFF_SS + (ww * 64 + tid) * 4);
            SS[(size_t)h * NTOK + (size_t)b * SEQ + (SEQ / 64 - 1) * 64 + tid] = s; }
        LDS_BARRIER();
    }
}

struct Args { const float* in[17]; float* out; unsigned char* ws; int ph_lo, ph_hi; };
enum { I_X = 0, I_HWIN, I_HNG, I_HWOUT, I_LB, I_RWIN, I_RWOUT, I_LNMG, I_LNMB, I_LNFG, I_LNFB, I_RW, I_RB, I_WGU, I_BGU, I_WDN, I_BDN };

__device__ __forceinline__ int dest_row(int mode, int n) {
    if (mode == 1) { if (n < 1024) return ((n >> 7) << 8) + (n & 127); if (n < 2048) { const int q = n - 1024; return ((q >> 7) << 8) + 128 + (q & 127); } return n; }
    if (mode == 2) { const int j2 = n >> 1; return ((j2 >> 7) << 8) + ((n & 1) << 7) + (j2 & 127); }
    return n;
}
__device__ __forceinline__ void transpose_item(const float* W, int K, int N, bf16* WT, int mode, LAS float* scr, int item, int lane) {
    const int nblk = N / 64, kb = item / nblk, nb = item % nblk, k0 = 64 * kb, n0 = 64 * nb;
#pragma unroll 4
    for (int i = 0; i < 16; ++i) { const int kk = 4 * i + (lane >> 4), c4 = (lane & 15) * 4;
        const f32x4 v = *(const GAS f32x4*)(W + (size_t)(k0 + kk) * N + n0 + c4);
        LAS float* s = scr + kk * 65 + c4; s[0] = v[0]; s[1] = v[1]; s[2] = v[2]; s[3] = v[3]; }
    LDS_WAIT(); asm volatile("" ::: "memory");
    const int c = lane & 7;
#pragma unroll 2
    for (int j = 0; j < 8; ++j) { const int n = (lane >> 3) + 8 * j; const LAS float* s = scr + (8 * c) * 65 + n;
        v4u o; o.x = pk2(s[0 * 65], s[1 * 65]); o.y = pk2(s[2 * 65], s[3 * 65]); o.z = pk2(s[4 * 65], s[5 * 65]); o.w = pk2(s[6 * 65], s[7 * 65]);
        *(GAS v4u*)(WT + (size_t)dest_row(mode, n0 + n) * K + k0 + 8 * c) = o; }
    LDS_WAIT(); asm volatile("" ::: "memory");
}

__device__ __forceinline__ void transpose_item_fp8(const float* W, int K, int N, unsigned char* WT, int mode, float scale, LAS float* scr, int item, int lane) {
    const int nblk = N / 64, kb = item / nblk, nb = item % nblk, k0 = 64 * kb, n0 = 64 * nb;
#pragma unroll 4
    for (int i = 0; i < 16; ++i) { const int kk = 4 * i + (lane >> 4), c4 = (lane & 15) * 4;
        const f32x4 v = *(const GAS f32x4*)(W + (size_t)(k0 + kk) * N + n0 + c4);
        LAS float* s = scr + kk * 65 + c4; s[0] = v[0]; s[1] = v[1]; s[2] = v[2]; s[3] = v[3]; }
    LDS_WAIT(); asm volatile("" ::: "memory");
    const int c = lane & 7;
#pragma unroll 2
    for (int j = 0; j < 8; ++j) { const int n = (lane >> 3) + 8 * j; const LAS float* s = scr + (8 * c) * 65 + n;
        v2u o; o.x = pk4_fp8(s[0 * 65] * scale, s[1 * 65] * scale, s[2 * 65] * scale, s[3 * 65] * scale); o.y = pk4_fp8(s[4 * 65] * scale, s[5 * 65] * scale, s[6 * 65] * scale, s[7 * 65] * scale);
        *(GAS v2u*)(WT + (size_t)dest_row(mode, n0 + n) * K + k0 + 8 * c) = o; }
    LDS_WAIT(); asm volatile("" ::: "memory");
}

#ifndef SITE_MASK
#define SITE_MASK 0xffff
#endif
#define SITE(n) (((SITE_MASK) >> (n)) & 1)
#ifndef PROBE_MASK
#define PROBE_MASK 0
#endif
#define REP(n) (1 + (((PROBE_MASK) >> (n)) & 1))
typedef const __attribute__((address_space(4))) Args* KArgs;
__device__ __forceinline__ int otid(int wave0) { int l; asm volatile("v_mbcnt_lo_u32_b32 %0, -1, 0\n\tv_mbcnt_hi_u32_b32 %0, -1, %0" : "=v"(l)); asm volatile("" : "+s"(wave0)); return wave0 * 64 + l; }
__device__ __forceinline__ LAS unsigned char* olds(LAS unsigned char* p) { asm volatile("" : "+s"(p)); return p; }
__device__ __forceinline__ KArgs kargs() { KArgs p = (KArgs)__builtin_amdgcn_kernarg_segment_ptr(); asm volatile("" : "+s"(p)); return p; }
#define IN(k) (ap->ph_lo <= (k) && (k) < ap->ph_hi)
#ifndef PROBE_BAR
#define PROBE_BAR 1
#endif
#define GRID_BAR() for (int _r = 0; _r < PROBE_BAR; ++_r) do { if (ap->ph_hi - ap->ph_lo > 1) { XcdBarrier _b; _b.bar = (unsigned*)(ap->ws + WS_CTL) + CW_BAR; _b.x = xb_xcc_id(); _b.st = (volatile LAS unsigned*)(lds + MISC_OFF + MO_BARW); xcd_barrier(_b); } } while (0)
#define VCU() ((gridDim.x % 8 == 0) ? (int)((blockIdx.x % 8) * (gridDim.x / 8) + blockIdx.x / 8) : (int)blockIdx.x)

__global__ void __launch_bounds__(512, 2) mk_fwd(Args args_unused) {
    extern __shared__ __attribute__((aligned(16))) unsigned char lds_raw[];
    LAS unsigned char* const lds0 = (LAS unsigned char*)lds_raw;
    const int wave0 = __builtin_amdgcn_readfirstlane((int)(threadIdx.x >> 6));
    {
        LAS unsigned char* lds = lds0;
        for (int u = threadIdx.x; u < (LDS_BYTES - MISC_OFF) / 4; u += 512) ((LAS unsigned*)(lds + MISC_OFF))[u] = 0u;
        __syncthreads();
        KArgs ap = kargs();
        if (ap->ph_hi - ap->ph_lo > 1) (void)xcd_barrier_post((unsigned*)(ap->ws + WS_CTL) + CW_BAR, (volatile LAS unsigned*)(lds + MISC_OFF + MO_BARW));
    }

#if SITE(0)
    { KArgs ap = kargs(); const int tid = otid(wave0); LAS unsigned char* lds = olds(lds0); (void)tid;
    if (IN(0)) for (int rep_ = 0; rep_ < REP(0); ++rep_) {
        const int lane = tid & 63, wave = __builtin_amdgcn_readfirstlane(tid >> 6), G = gridDim.x, vcu = VCU(), gw = vcu * 8 + wave, NGW = G * 8;
        unsigned char* ws = ap->ws;
        LAS float* scr = (LAS float*)(lds + wave * 16640);
        constexpr int I_HIN = 2 * 16 * 64, I_HOUT = 2 * 16 * 16, I_RIN = 2 * 16 * 96, I_ROUT = 2 * 32 * 16, I_GU = 128 * 16 * 32, I_DN = 128 * 16 * 16;
        constexpr int NITEMS = I_HIN + I_HOUT + I_RIN + I_ROUT + I_GU + I_DN;
        for (int it = gw; it < NITEMS; it += NGW) {
            int r = it;
            if (r < I_HIN) { const int j = r / (16 * 64); transpose_item(ap->in[I_HWIN] + (size_t)j * DM * HG_IN, DM, HG_IN, (bf16*)(ws + WS_W_HIN) + (size_t)j * HG_IN * DM, 1, scr, r % (16 * 64), lane); continue; } r -= I_HIN;
            if (r < I_HOUT) { const int j = r / 256; transpose_item(ap->in[I_HWOUT] + (size_t)j * DM * DM, DM, DM, (bf16*)(ws + WS_W_HOUT) + (size_t)j * DM * DM, 0, scr, r % 256, lane); continue; } r -= I_HOUT;
            if (r < I_RIN) { const int j = r / (16 * 96); transpose_item(ap->in[I_RWIN] + (size_t)j * DM * RT_IN, DM, RT_IN, (bf16*)(ws + WS_W_RIN) + (size_t)j * RT_IN * DM, 0, scr, r % (16 * 96), lane); continue; } r -= I_RIN;
            if (r < I_ROUT) { const int j = r / 512; transpose_item(ap->in[I_RWOUT] + (size_t)j * RT_VD * DM, RT_VD, DM, (bf16*)(ws + WS_W_ROUT) + (size_t)j * DM * RT_VD, 0, scr, r % 512, lane); continue; } r -= I_ROUT;
#if MOE_FP8
            if (r < I_GU) { const int j = r / 512; transpose_item_fp8(ap->in[I_WGU] + (size_t)j * DM * 2048, DM, 2048, ws + WS_W_GU + (size_t)j * 2048 * DM, 2, WGU_SCALE, scr, r % 512, lane); continue; } r -= I_GU;
            { const int j = r / 256; transpose_item_fp8(ap->in[I_WDN] + (size_t)j * DM * DM, DM, DM, ws + WS_W_DN + (size_t)j * DM * DM, 0, WDN_SCALE, scr, r % 256, lane); }
#else
            if (r < I_GU) { const int j = r / 512; transpose_item(ap->in[I_WGU] + (size_t)j * DM * 2048, DM, 2048, (bf16*)(ws + WS_W_GU) + (size_t)j * 2048 * DM, 2, scr, r % 512, lane); continue; } r -= I_GU;
            { const int j = r / 256; transpose_item(ap->in[I_WDN] + (size_t)j * DM * DM, DM, DM, (bf16*)(ws + WS_W_DN) + (size_t)j * DM * DM, 0, scr, r % 256, lane); }
#endif
        }
        const int gt = vcu * 512 + tid, NGT = G * 512;
        float* LBS = (float*)(ws + WS_LBS); float* BGU = (float*)(ws + WS_BGU); float* ROT = (float*)(ws + WS_ROT); bf16* XB = (bf16*)(ws + WS_XB);
        for (int d = gt; d < DM; d += NGT) { const float* lbp = ap->in[I_LB]; const float v0 = lbp[d], v1 = lbp[DM + d], v2 = lbp[2 * DM + d], v3 = lbp[3 * DM + d]; const float mx = fmaxf(fmaxf(v0, v1), fmaxf(v2, v3));
            const float e0 = __expf(v0 - mx), e1 = __expf(v1 - mx), e2 = __expf(v2 - mx), e3 = __expf(v3 - mx), is = 1.0f / (e0 + e1 + e2 + e3);
            LBS[d] = 0.f; LBS[DM + d] = e1 * is; LBS[2 * DM + d] = (e1 + e2) * is; LBS[3 * DM + d] = (e1 + e2 + e3) * is; }
        for (int i = gt; i < SEQ * 128; i += NGT) { const int pos = i >> 7, p = i & 127; const float inv = 1.0f / __builtin_amdgcn_exp2f(13.287712379549449f * ((float)p / 127.0f)); const float th = (float)pos * inv;
            double rev = (double)th * 0.15915494309189535; rev -= floor(rev); const float fr = (float)rev; ROT[2 * i] = __builtin_amdgcn_cosf(fr); ROT[2 * i + 1] = __builtin_amdgcn_sinf(fr); }
        for (int i = gt; i < 4 * DM * NE; i += NGT) { const int l = i >> 15, d = (i >> 5) & 1023, e = i & 31; const float wv = ap->in[I_RW][i]; const unsigned hb = f2bf(wv); const float hv = __builtin_bit_cast(float, hb << 16);
            ((bf16*)(ws + WS_WRH))[(size_t)l * 32768 + e * 1024 + d] = (bf16)hb; ((bf16*)(ws + WS_WRL))[(size_t)l * 32768 + e * 1024 + d] = (bf16)f2bf(wv - hv); }
        for (int i = gt; i < 4 * 32 * 2048; i += NGT) { const int le = i >> 11, n = i & 2047; BGU[(size_t)le * 2048 + dest_row(2, n)] = ap->in[I_BGU][i]; }
        for (size_t i = (size_t)gt; i < (size_t)NTOK * DM / 4; i += NGT) { const f32x4 v = ((const f32x4*)ap->in[I_X])[i]; v2u o; o.x = pk2(v[0], v[1]); o.y = pk2(v[2], v[3]); ((v2u*)XB)[i] = o; }
        GRID_BAR();
    } }
#endif

#pragma unroll 1
    for (int L = 0; L < DEPTH; ++L) {
        const int pb = 1 + 8 * L;
        if ((L & 1) == 0) {
#if SITE(1)
            { KArgs ap = kargs(); const int tid = otid(wave0); LAS unsigned char* lds = olds(lds0); (void)tid;
            if (IN(pb + 0)) for (int rep_ = 0; rep_ < REP(1); ++rep_) {
                unsigned char* ws = ap->ws; const int j = L >> 1;
                LAS int* ul = (LAS int*)(lds + MISC_OFF + MO_ULIST);
                pg8::build_units_dense(tid, ul, NTOK / 256, HG_IN / 256, DM * 2);
                pg8::EpiHgrnIn E{ws, L};
                pg8::gemm_phase<pg8::EpiHgrnIn, false, true, false>(tid, lds, ul, (LAS int*)(lds + MISC_OFF + MO_GTAB), (const char*)(ws + WS_XB), (const char*)((bf16*)(ws + WS_W_HIN) + (size_t)j * HG_IN * DM), nullptr, DM * 2, E);
                GRID_BAR();
            } }
#endif
#if SITE(2)
            { KArgs ap = kargs(); const int tid = otid(wave0); LAS unsigned char* lds = olds(lds0); (void)tid;
            if (IN(pb + 1)) for (int rep_ = 0; rep_ < REP(2); ++rep_) {
#if !SLOW_HGRN
                { unsigned char* ws = ap->ws; const bf16* QD = (const bf16*)(ws + WS_H);
                  hgrn_fast(tid, lds, QD, QD + (size_t)NTOK * DM, QD + 4 * (size_t)NTOK * DM, QD + 3 * (size_t)NTOK * DM, (const float*)(ws + WS_DEC), ap->in[I_HNG] + (L >> 1) * DM,
                            (bf16*)(ws + WS_A2), (float*)(ws + WS_SSP)); }
#else
                unsigned char* ws = ap->ws; const bf16* QD = (const bf16*)(ws + WS_H); const bf16* KI = QD + (size_t)NTOK * DM; const bf16* KS = QD + 2 * (size_t)NTOK * DM; const bf16* VV = QD + 3 * (size_t)NTOK * DM; bf16* OB = (bf16*)(ws + WS_O);
                LAS float* qf = (LAS float*)lds; LAS float* kf = qf + 16 * 4 * 36; LAS float* ff = kf + 16 * 4 * 36; LAS float* vf = ff + 16 * 4 * 36;
                for (int un = blockIdx.x; un < NBATCH * HG_HEADS; un += gridDim.x) {
                    const int b = un >> 3, h = un & 7; const int vc = tid >> 2, kq = tid & 3;
                    float st[32];
#pragma unroll
                    for (int i = 0; i < 32; ++i) st[i] = 0.f;
                    for (int t0 = 0; t0 < SEQ; t0 += 16) {
                        __syncthreads();
                        for (int e = tid; e < 16 * 128; e += 512) { const int tt = e >> 7, k = e & 127; const size_t gi = (size_t)(b * SEQ + t0 + tt) * DM + h * 128 + k; const int li = tt * 144 + (k & 3) * 36 + (k >> 2);
                            qf[li] = bf1(QD[gi]); kf[li] = bf1(KI[gi]); ff[li] = bf1(KS[gi]); vf[tt * 128 + k] = bf1(VV[gi]); }
                        __syncthreads();
                        for (int tt = 0; tt < 16; ++tt) {
                            const float v = vf[tt * 128 + vc]; float a = 0.f; const int lb = tt * 144 + kq * 36;
#pragma unroll
                            for (int i = 0; i < 32; ++i) { st[i] = ff[lb + i] * st[i] + kf[lb + i] * v; a += qf[lb + i] * st[i]; }
                            a += __shfl_xor(a, 1); a += __shfl_xor(a, 2);
                            if (kq == 0) OB[(size_t)(b * SEQ + t0 + tt) * DM + h * 128 + vc] = (bf16)f2bf(a);
                        }
                    }
                }
#endif
                GRID_BAR();
            } }
#endif
#if SITE(3) && SLOW_HGRN
            { KArgs ap = kargs(); const int tid = otid(wave0); LAS unsigned char* lds = olds(lds0); (void)tid;
            if (IN(pb + 2)) for (int rep_ = 0; rep_ < REP(3); ++rep_) {
                const int lane = tid & 63, wave = __builtin_amdgcn_readfirstlane(tid >> 6), gw = VCU() * 8 + wave, NGW = gridDim.x * 8;
                unsigned char* ws = ap->ws; const bf16* OB = (const bf16*)(ws + WS_O); const bf16* GG = (const bf16*)(ws + WS_H) + 4 * (size_t)NTOK * DM; bf16* A2 = (bf16*)(ws + WS_A2);
                const float* ng = ap->in[I_HNG] + (L >> 1) * DM;
                f32x4 g4[4];
#pragma unroll
                for (int q = 0; q < 4; ++q) g4[q] = *(const f32x4*)(ng + 256 * q + 4 * lane);
                v2u on[4], gn[4];
#pragma unroll
                for (int q = 0; q < 4; ++q) { on[q] = *(const v2u*)(OB + (size_t)gw * DM + 256 * q + 4 * lane); gn[q] = *(const v2u*)(GG + (size_t)gw * DM + 256 * q + 4 * lane); }
#pragma unroll 1
                for (int row = gw; row < NTOK; row += NGW) {
                    v2u oc[4], gc[4];
#pragma unroll
                    for (int q = 0; q < 4; ++q) { oc[q] = on[q]; gc[q] = gn[q]; }
                    if (row + NGW < NTOK) {
#pragma unroll
                        for (int q = 0; q < 4; ++q) { on[q] = *(const v2u*)(OB + (size_t)(row + NGW) * DM + 256 * q + 4 * lane); gn[q] = *(const v2u*)(GG + (size_t)(row + NGW) * DM + 256 * q + 4 * lane); } }
                    float o[16]; float ss = 0.f;
#pragma unroll
                    for (int q = 0; q < 4; ++q) { o[4 * q] = bflo(oc[q].x); o[4 * q + 1] = bfhi(oc[q].x); o[4 * q + 2] = bflo(oc[q].y); o[4 * q + 3] = bfhi(oc[q].y); }
#pragma unroll
                    for (int i = 0; i < 16; ++i) ss += o[i] * o[i];
                    const float rs = 1.0f / sqrtf(wave_sum(ss) * (1.0f / DM) + RMS_EPS);
#pragma unroll
                    for (int q = 0; q < 4; ++q) {
                        v2u w; w.x = pk2(o[4 * q] * rs * g4[q][0] * bflo(gc[q].x), o[4 * q + 1] * rs * g4[q][1] * bfhi(gc[q].x)); w.y = pk2(o[4 * q + 2] * rs * g4[q][2] * bflo(gc[q].y), o[4 * q + 3] * rs * g4[q][3] * bfhi(gc[q].y));
                        *(v2u*)(A2 + (size_t)row * DM + 256 * q + 4 * lane) = w; }
                }
                GRID_BAR();
            } }
#endif
        } else {
#if SITE(4)
            { KArgs ap = kargs(); const int tid = otid(wave0); LAS unsigned char* lds = olds(lds0); (void)tid;
            if (IN(pb + 0)) for (int rep_ = 0; rep_ < REP(4); ++rep_) {
                unsigned char* ws = ap->ws; const int j = L >> 1;
                LAS int* ul = (LAS int*)(lds + MISC_OFF + MO_ULIST);
                pg8::build_units_dense(tid, ul, NTOK / 256, RT_IN / 256, DM * 2);
                pg8::EpiRetIn E{ws};
                pg8::gemm_phase<pg8::EpiRetIn, false, true, false>(tid, lds, ul, (LAS int*)(lds + MISC_OFF + MO_GTAB), (const char*)(ws + WS_XB), (const char*)((bf16*)(ws + WS_W_RIN) + (size_t)j * RT_IN * DM), nullptr, DM * 2, E);
                GRID_BAR();
            } }
#endif
#if SITE(5)
            { KArgs ap = kargs(); const int tid = otid(wave0); LAS unsigned char* lds = olds(lds0); (void)tid;
            if (IN(pb + 1)) for (int rep_ = 0; rep_ < REP(5); ++rep_) {
#if !SLOW_RET
                { unsigned char* ws = ap->ws; ret_fast(tid, lds, (const bf16*)(ws + WS_H), (bf16*)(ws + WS_O)); }
#else
                unsigned char* ws = ap->ws; const bf16* HB = (const bf16*)(ws + WS_H); bf16* OB = (bf16*)(ws + WS_O);
                LAS float* qf = (LAS float*)lds; LAS float* kf = qf + 16 * 4 * 68; LAS float* vf = kf + 16 * 4 * 68;
                for (int un = blockIdx.x; un < NBATCH * RT_HEADS * 4; un += gridDim.x) {
                    const int b = un >> 4, h = (un >> 2) & 3, vq = un & 3; const int vc = tid >> 2, kq = tid & 3;
                    const float gam = 1.0f - exp2f(-5.0f - (float)h);
                    float st[64];
#pragma unroll
                    for (int i = 0; i < 64; ++i) st[i] = 0.f;
                    for (int t0 = 0; t0 < SEQ; t0 += 16) {
                        __syncthreads();
                        for (int e = tid; e < 16 * 256; e += 512) { const int tt = e >> 8, k = e & 255; const size_t gi = (size_t)(b * SEQ + t0 + tt) * RT_IN + h * 256 + k; const int li = tt * 272 + (k & 3) * 68 + (k >> 2);
                            qf[li] = bf1(HB[gi]); kf[li] = bf1(HB[gi + 1024]); }
                        for (int e = tid; e < 16 * 128; e += 512) { const int tt = e >> 7, c = e & 127; vf[e] = bf1(HB[(size_t)(b * SEQ + t0 + tt) * RT_IN + 2048 + h * 512 + vq * 128 + c]); }
                        __syncthreads();
                        for (int tt = 0; tt < 16; ++tt) {
                            const float v = vf[tt * 128 + vc]; float a = 0.f; const int lb = tt * 272 + kq * 68;
#pragma unroll
                            for (int i = 0; i < 64; ++i) { st[i] = gam * st[i] + kf[lb + i] * v; a += qf[lb + i] * st[i]; }
                            a += __shfl_xor(a, 1); a += __shfl_xor(a, 2);
                            if (kq == 0) OB[(size_t)(b * SEQ + t0 + tt) * RT_VD + h * 512 + vq * 128 + vc] = (bf16)f2bf(a);
                        }
                    }
                }
#endif
                GRID_BAR();
            } }
#endif
#if SITE(6)
            { KArgs ap = kargs(); const int tid = otid(wave0); LAS unsigned char* lds = olds(lds0); (void)tid;
            if (IN(pb + 2)) for (int rep_ = 0; rep_ < REP(6); ++rep_) {
                const int lane = tid & 63, wave = __builtin_amdgcn_readfirstlane(tid >> 6), gw = VCU() * 8 + wave, NGW = gridDim.x * 8;
                unsigned char* ws = ap->ws; const bf16* OB = (const bf16*)(ws + WS_O); const bf16* HB = (const bf16*)(ws + WS_H); bf16* A2 = (bf16*)(ws + WS_A2);
                v4u on[4], gn[4];
#pragma unroll
                for (int h = 0; h < 4; ++h) { on[h] = *(const v4u*)(OB + (size_t)gw * RT_VD + 512 * h + 8 * lane); gn[h] = *(const v4u*)(HB + (size_t)gw * RT_IN + 4096 + 512 * h + 8 * lane); }
#pragma unroll 1
                for (int row = gw; row < NTOK; row += NGW) {
                    v4u oc[4], gc[4];
#pragma unroll
                    for (int h = 0; h < 4; ++h) { oc[h] = on[h]; gc[h] = gn[h]; }
                    if (row + NGW < NTOK) {
#pragma unroll
                        for (int h = 0; h < 4; ++h) { on[h] = *(const v4u*)(OB + (size_t)(row + NGW) * RT_VD + 512 * h + 8 * lane); gn[h] = *(const v4u*)(HB + (size_t)(row + NGW) * RT_IN + 4096 + 512 * h + 8 * lane); } }
#pragma unroll
                    for (int h = 0; h < 4; ++h) {
                        const v4u w = oc[h];
                        float o[8] = {bflo(w.x), bfhi(w.x), bflo(w.y), bfhi(w.y), bflo(w.z), bfhi(w.z), bflo(w.w), bfhi(w.w)};
                        float s = 0.f;
#pragma unroll
                        for (int i = 0; i < 8; ++i) s += o[i];
                        const float mu = wave_sum(s) * (1.0f / 512.0f); float q = 0.f;
#pragma unroll
                        for (int i = 0; i < 8; ++i) { o[i] -= mu; q += o[i] * o[i]; }
                        const float rs = 1.0f / sqrtf(wave_sum(q) * (1.0f / 512.0f) + LN_EPS);
                        const v4u g = gc[h];
                        v4u r; r.x = pk2(o[0] * rs * bflo(g.x), o[1] * rs * bfhi(g.x)); r.y = pk2(o[2] * rs * bflo(g.y), o[3] * rs * bfhi(g.y));
                        r.z = pk2(o[4] * rs * bflo(g.z), o[5] * rs * bfhi(g.z)); r.w = pk2(o[6] * rs * bflo(g.w), o[7] * rs * bfhi(g.w));
                        *(v4u*)(A2 + (size_t)row * RT_VD + 512 * h + 8 * lane) = r;
                    }
                }
                GRID_BAR();
            } }
#endif
        }
#if SITE(7)
        { KArgs ap = kargs(); const int tid = otid(wave0); LAS unsigned char* lds = olds(lds0); (void)tid;
        if (IN(pb + 3)) for (int rep_ = 0; rep_ < REP(7); ++rep_) {
            unsigned char* ws = ap->ws; const int j = L >> 1; const bool ret = (L & 1) != 0;
            const int Ko = ret ? RT_VD : DM;
            LAS int* ul = (LAS int*)(lds + MISC_OFF + MO_ULIST);
            pg8::build_units_dense(tid, ul, NTOK / 256, DM / 256, Ko * 2);
            const char* Bt = ret ? (const char*)((bf16*)(ws + WS_W_ROUT) + (size_t)j * DM * RT_VD) : (const char*)((bf16*)(ws + WS_W_HOUT) + (size_t)j * DM * DM);
            pg8::EpiRes E{ws, (ret || SLOW_HGRN) ? -1 : 0};
            pg8::gemm_phase<pg8::EpiRes, false, true, false>(tid, lds, ul, (LAS int*)(lds + MISC_OFF + MO_GTAB), (const char*)(ws + WS_A2), Bt, nullptr, Ko * 2, E);
            GRID_BAR();
        } }
#endif
#if SITE(8)
        { KArgs ap = kargs(); const int tid = otid(wave0); LAS unsigned char* lds = olds(lds0); (void)tid;
        if (IN(pb + 4)) for (int rep_ = 0; rep_ < REP(8); ++rep_) {
            const int lane = tid & 63, wave = __builtin_amdgcn_readfirstlane(tid >> 6), r = lane & 15, g = lane >> 4;
            unsigned char* ws = ap->ws; unsigned* ctl = (unsigned*)(ws + WS_CTL);
            const bf16* Y = (const bf16*)(ws + WS_Y); bf16* X1R = (bf16*)(ws + WS_X1F); bf16* X1B = (bf16*)(ws + WS_X1B);
            int* ROWDST = (int*)(ws + WS_ROWDST); float* ROWGATE = (float*)(ws + WS_ROWGATE);
            constexpr int WP = 2064;
            LAS unsigned char* wH = lds; LAS unsigned char* wL = lds + 32 * WP;
            LAS int* lcnt = (LAS int*)(lds + MISC_OFF + MO_LCNT); LAS int* lbase = (LAS int*)(lds + MISC_OFF + MO_LBASE);
            LAS int* sel = (LAS int*)(lds + MISC_OFF + MO_SEL); LAS float* selw = (LAS float*)(lds + MISC_OFF + MO_SELW);
            const float* rb = ap->in[I_RB] + L * NE;
            const float* lg = ap->in[I_LNMG] + L * DM; const float* lbb = ap->in[I_LNMB] + L * DM;
            { const v4u* gh = (const v4u*)(ws + WS_WRH) + (size_t)L * 4096; const v4u* gl = (const v4u*)(ws + WS_WRL) + (size_t)L * 4096;
              for (int c = tid; c < 4096; c += 512) { const int e = c >> 7, cc = c & 127; *(LAS v4u*)(wH + e * WP + cc * 16) = gh[c]; *(LAS v4u*)(wL + e * WP + cc * 16) = gl[c]; } }
            const float rb0 = rb[r], rb1 = rb[16 + r];
            for (int blk = VCU(); blk < NTOK / 128; blk += gridDim.x) {
                if (tid < 32) lcnt[tid] = 0;
                __syncthreads();
                const int row0 = blk * 128 + wave * 16;
                v2u xn[4];
#pragma unroll
                for (int q = 0; q < 4; ++q) xn[q] = *(const v2u*)(Y + (size_t)row0 * DM + 256 * q + 4 * lane);
#pragma unroll 1
                for (int rr = 0; rr < 16; ++rr) {
                    const int row = row0 + rr;
                    f32x4 x[4]; float s = 0.f;
#pragma unroll
                    for (int q = 0; q < 4; ++q) { x[q] = (f32x4){bflo(xn[q].x), bfhi(xn[q].x), bflo(xn[q].y), bfhi(xn[q].y)}; s += (x[q][0] + x[q][1]) + (x[q][2] + x[q][3]); }
                    if (rr + 1 < 16) {
#pragma unroll
                        for (int q = 0; q < 4; ++q) xn[q] = *(const v2u*)(Y + (size_t)(row + 1) * DM + 256 * q + 4 * lane); }
                    const float mu = wave_sum_u(s) * (1.0f / DM); float qq = 0.f;
#pragma unroll
                    for (int q = 0; q < 4; ++q) { x[q] = x[q] - mu; qq += (x[q][0] * x[q][0] + x[q][1] * x[q][1]) + (x[q][2] * x[q][2] + x[q][3] * x[q][3]); }
                    const float rs = 1.0f / sqrtf(wave_sum_u(qq) * (1.0f / DM) + LN_EPS);
#pragma unroll
                    for (int q = 0; q < 4; ++q) { const f32x4 g4 = *(const f32x4*)(lg + 256 * q + 4 * lane), b4 = *(const f32x4*)(lbb + 256 * q + 4 * lane); x[q] = x[q] * rs * g4 + b4;
                        { v2u wr_; wr_.x = pk2(x[q][0], x[q][1]); wr_.y = pk2(x[q][2], x[q][3]); *(v2u*)(X1R + (size_t)row * DM + 256 * q + 4 * lane) = wr_; }
#if MOE_FP8
                        *(unsigned*)((unsigned char*)X1B + (size_t)row * DM + 256 * q + 4 * lane) = pk4_fp8(x[q][0] * X_SCALE, x[q][1] * X_SCALE, x[q][2] * X_SCALE, x[q][3] * X_SCALE); }
#else
                        v2u w; w.x = pk2(x[q][0], x[q][1]); w.y = pk2(x[q][2], x[q][3]); *(v2u*)(X1B + (size_t)row * DM + 256 * q + 4 * lane) = w; }
#endif
                }
                asm volatile("s_waitcnt vmcnt(0)" ::: "memory");
                f32x4 lgt0 = {0.f, 0.f, 0.f, 0.f}, lgt1 = {0.f, 0.f, 0.f, 0.f};
                {
                    const bf16* xa = X1R + (size_t)(row0 + r) * DM + 8 * g;
#pragma unroll 1
                    for (int kq = 0; kq < 4; ++kq) {
                        bf16x8 af[8], h0[8], h1[8], l0[8], l1[8];
#pragma unroll
                        for (int j = 0; j < 8; ++j) { const int kb = kq * 8 + j; af[j] = *(const bf16x8*)(xa + 32 * kb);
                            h0[j] = *(const LAS bf16x8*)(wH + r * WP + (32 * kb + 8 * g) * 2); h1[j] = *(const LAS bf16x8*)(wH + (16 + r) * WP + (32 * kb + 8 * g) * 2);
                            l0[j] = *(const LAS bf16x8*)(wL + r * WP + (32 * kb + 8 * g) * 2); l1[j] = *(const LAS bf16x8*)(wL + (16 + r) * WP + (32 * kb + 8 * g) * 2); }
#pragma unroll
                        for (int j = 0; j < 8; ++j) { lgt0 = MFMA32(af[j], h0[j], lgt0); lgt1 = MFMA32(af[j], h1[j], lgt1); lgt0 = MFMA32(af[j], l0[j], lgt0); lgt1 = MFMA32(af[j], l1[j], lgt1); }
                    }
                }
#pragma unroll
                for (int i = 0; i < 4; ++i) {
                    float v0 = lgt0[i] + rb0, v1 = lgt1[i] + rb1; int se[4]; float sv[4];
#pragma unroll
                    for (int k = 0; k < 4; ++k) {
                        float m = fmaxf(v0, v1);
                        m = fmaxf(m, dppf<0xB1>(m)); m = fmaxf(m, dppf<0x4E>(m)); m = fmaxf(m, dppf<0x141>(m)); m = fmaxf(m, dppf<0x140>(m));
                        int ec = (v0 == m) ? r : ((v1 == m) ? 16 + r : 99);
                        ec = min(ec, dppi<0xB1>(ec)); ec = min(ec, dppi<0x4E>(ec)); ec = min(ec, dppi<0x141>(ec)); ec = min(ec, dppi<0x140>(ec));
                        se[k] = ec; sv[k] = m;
                        if (ec == r) v0 = -3.0e38f;
                        if (ec == 16 + r) v1 = -3.0e38f;
                    }
                    const float e1 = __expf(sv[1] - sv[0]), e2 = __expf(sv[2] - sv[0]), e3 = __expf(sv[3] - sv[0]); const float inv = 1.0f / (1.0f + e1 + e2 + e3);
                    if (r < 4) { const int rloc = wave * 16 + 4 * g + i; const int ee = r == 0 ? se[0] : (r == 1 ? se[1] : (r == 2 ? se[2] : se[3])); const float ww = (r == 0 ? 1.0f : (r == 1 ? e1 : (r == 2 ? e2 : e3))) * inv;
                        sel[rloc * 4 + r] = ee; selw[rloc * 4 + r] = ww; }
                }
                __syncthreads();
                const int myE = sel[tid]; const int rank = __hip_atomic_fetch_add(lcnt + myE, 1, __ATOMIC_RELAXED, __HIP_MEMORY_SCOPE_WORKGROUP);
                __syncthreads();
                if (tid < 32) lbase[tid] = (int)__hip_atomic_fetch_add(ctl + CW_ECNT + (L + 4 * rep_) * 32 + tid, (unsigned)lcnt[tid], RLX_AGENT);
                __syncthreads();
                { const int pos = lbase[myE] + rank; const size_t ti = (size_t)myE * ECAP + pos; ROWDST[ti] = (blk * 128 + (tid >> 2)) * 4 + (tid & 3); ROWGATE[ti] = selw[tid]; }
                __syncthreads();
            }
            GRID_BAR();
        } }
#endif
#if SITE(9)
        { KArgs ap = kargs(); const int tid = otid(wave0); LAS unsigned char* lds = olds(lds0); (void)tid;
        if (IN(pb + 5)) for (int rep_ = 0; rep_ < REP(9); ++rep_) {
            unsigned char* ws = ap->ws; unsigned* ctl = (unsigned*)(ws + WS_CTL);
            LAS int* tpre = (LAS int*)(lds + MISC_OFF + MO_TPRE); LAS int* ebase = (LAS int*)(lds + MISC_OFF + MO_EBASE); LAS int* ecnt = (LAS int*)(lds + MISC_OFF + MO_ECNT);
            if (tid < NE) ecnt[tid] = (int)__hip_atomic_load(ctl + CW_ECNT + L * 32 + tid, RLX_AGENT);
            __syncthreads();
            if (tid == 0) { int t = 0;
_Pragma("unroll 1")
 for (int e = 0; e < NE; ++e) { const int c = ecnt[e]; tpre[e] = t; ebase[e] = t * 256; t += (c + 255) >> 8; } tpre[NE] = t; }
            __syncthreads();
            LAS int* ul = (LAS int*)(lds + MISC_OFF + MO_ULIST);
            constexpr int EB = MOE_FP8 ? 1 : 2;
            pg8::build_units_moe(tid, ul, tpre, ebase, ecnt, 8, DM * EB, 2048u * DM * EB);
            { LAS int* gall = (LAS int*)(lds + MISC_OFF + MO_GALL); const int* rd = (const int*)(ws + WS_ROWDST);
              for (int i = tid; i < GALL_UNITS * 256; i += 512) { const int uu = i >> 8, rr = i & 255;
                  if (ul[uu * 8 + 0]) gall[i] = (int)((unsigned)rd[ul[uu * 8 + 7] + min(rr, ul[uu * 8 + 5] - 1)] >> 2); }
              __syncthreads(); }
            pg8::EpiMoeGU E{ws, L};
            pg8::gemm_phase<pg8::EpiMoeGU, true, true, MOE_FP8 != 0>(tid, lds, ul, (LAS int*)(lds + MISC_OFF + MO_GALL), (const char*)(ws + WS_X1B), (const char*)(ws + WS_W_GU + (size_t)L * NE * 2048 * DM * EB), (const int*)(ws + WS_ROWDST), DM * EB, E, lds + MISC_OFF + MO_GTAB);
            GRID_BAR();
        } }
#endif
#if SITE(10)
        { KArgs ap = kargs(); const int tid = otid(wave0); LAS unsigned char* lds = olds(lds0); (void)tid;
        if (IN(pb + 6)) for (int rep_ = 0; rep_ < REP(10); ++rep_) {
            unsigned char* ws = ap->ws; unsigned* ctl = (unsigned*)(ws + WS_CTL);
            LAS int* tpre = (LAS int*)(lds + MISC_OFF + MO_TPRE); LAS int* ebase = (LAS int*)(lds + MISC_OFF + MO_EBASE); LAS int* ecnt = (LAS int*)(lds + MISC_OFF + MO_ECNT);
            __syncthreads();
            if (tid < NE) ecnt[tid] = (int)__hip_atomic_load(ctl + CW_ECNT + L * 32 + tid, RLX_AGENT);
            __syncthreads();
            if (tid == 0) { int t = 0;
_Pragma("unroll 1")
 for (int e = 0; e < NE; ++e) { const int c = ecnt[e]; tpre[e] = t; ebase[e] = t * 256; t += (c + 255) >> 8; } tpre[NE] = t; }
            __syncthreads();
            LAS int* ul = (LAS int*)(lds + MISC_OFF + MO_ULIST);
            constexpr int EB = MOE_FP8 ? 1 : 2;
            pg8::build_units_moe(tid, ul, tpre, ebase, ecnt, 4, DM * EB, (unsigned)DM * DM * EB);
            pg8::EpiMoeDown E{ws, ap->in[I_BDN] + (size_t)L * NE * DM};
            pg8::gemm_phase<pg8::EpiMoeDown, false, true, MOE_FP8 != 0>(tid, lds, ul, (LAS int*)(lds + MISC_OFF + MO_GTAB), (const char*)(ws + WS_ACT), (const char*)(ws + WS_W_DN + (size_t)L * NE * DM * DM * EB), nullptr, DM * EB, E, lds + MISC_OFF + MO_GALL);
            GRID_BAR();
        } }
#endif
#if SITE(11)
        { KArgs ap = kargs(); const int tid = otid(wave0); LAS unsigned char* lds = olds(lds0); (void)tid;
        if (IN(pb + 7)) for (int rep_ = 0; rep_ < REP(11); ++rep_) {
            const int lane = tid & 63, wave = __builtin_amdgcn_readfirstlane(tid >> 6), gw = VCU() * 8 + wave, NGW = gridDim.x * 8;
            unsigned char* ws = ap->ws; const bf16* X1R = (const bf16*)(ws + WS_X1F); const bf16* YS = (const bf16*)(ws + WS_YSLOT); bf16* XB = (bf16*)(ws + WS_XB); float* out = ap->out;
            const float* lg = ap->in[I_LNFG] + L * DM; const float* lbb = ap->in[I_LNFB] + L * DM;
#if YS_FP8
            typedef unsigned ys_t; constexpr int YSB = 1;
#else
            typedef v2u ys_t; constexpr int YSB = 2;
#endif
            v2u xn[4]; f32x4 g4[4], b4[4]; ys_t yn[4][4];
#pragma unroll
            for (int q = 0; q < 4; ++q) { g4[q] = *(const f32x4*)(lg + 256 * q + 4 * lane); b4[q] = *(const f32x4*)(lbb + 256 * q + 4 * lane); xn[q] = *(const v2u*)(X1R + (size_t)gw * DM + 256 * q + 4 * lane);
#pragma unroll
                for (int k = 0; k < 4; ++k) yn[q][k] = *(const ys_t*)((const unsigned char*)YS + (((size_t)gw * 4 + k) * DM + 256 * q + 4 * lane) * YSB); }
#pragma unroll 1
            for (int row = gw; row < NTOK; row += NGW) {
                f32x4 x[4]; ys_t yc[4][4]; float s = 0.f;
#pragma unroll
                for (int q = 0; q < 4; ++q) { x[q] = (f32x4){bflo(xn[q].x), bfhi(xn[q].x), bflo(xn[q].y), bfhi(xn[q].y)} * DN_ALPHA;
#pragma unroll
                    for (int k = 0; k < 4; ++k) yc[q][k] = yn[q][k]; }
                if (row + NGW < NTOK) {
#pragma unroll
                    for (int q = 0; q < 4; ++q) { xn[q] = *(const v2u*)(X1R + (size_t)(row + NGW) * DM + 256 * q + 4 * lane);
#pragma unroll
                        for (int k = 0; k < 4; ++k) yn[q][k] = *(const ys_t*)((const unsigned char*)YS + (((size_t)(row + NGW) * 4 + k) * DM + 256 * q + 4 * lane) * YSB); } }
#pragma unroll
                for (int q = 0; q < 4; ++q) {
#pragma unroll
#if YS_FP8
                    for (int k = 0; k < 4; ++k) { const f32x2 lo = __builtin_amdgcn_cvt_pk_f32_fp8((int)yc[q][k], false), hi = __builtin_amdgcn_cvt_pk_f32_fp8((int)yc[q][k], true);
                        x[q][0] += lo[0] * 0.015625f; x[q][1] += lo[1] * 0.015625f; x[q][2] += hi[0] * 0.015625f; x[q][3] += hi[1] * 0.015625f; }
#else
                    for (int k = 0; k < 4; ++k) { const v2u w = yc[q][k]; x[q][0] += bflo(w.x); x[q][1] += bfhi(w.x); x[q][2] += bflo(w.y); x[q][3] += bfhi(w.y); }
#endif
                    s += (x[q][0] + x[q][1]) + (x[q][2] + x[q][3]); }
                const float mu = wave_sum(s) * (1.0f / DM); float qq = 0.f;
#pragma unroll
                for (int q = 0; q < 4; ++q) { x[q] = x[q] - mu; qq += (x[q][0] * x[q][0] + x[q][1] * x[q][1]) + (x[q][2] * x[q][2] + x[q][3] * x[q][3]); }
                const float rs = 1.0f / sqrtf(wave_sum(qq) * (1.0f / DM) + LN_EPS);
#pragma unroll
                for (int q = 0; q < 4; ++q) { x[q] = x[q] * rs * g4[q] + b4[q];
                    if (L + 1 == DEPTH) *(f32x4*)(out + (size_t)row * DM + 256 * q + 4 * lane) = x[q];
                    else { v2u w; w.x = pk2(x[q][0], x[q][1]); w.y = pk2(x[q][2], x[q][3]); *(v2u*)(XB + (size_t)row * DM + 256 * q + 4 * lane) = w; } }
            }
            if (L + 1 < DEPTH) GRID_BAR();
        } }
#endif
    }
#undef IN
#undef GRID_BAR
}

extern "C" void kernel_launch(void* const* d_in, const int* in_sizes, int n_in, void* d_out, int out_size, void* d_ws, size_t ws_size, hipStream_t stream) {
    static int grid = 0;
    if (grid == 0) {
        if (n_in != 17 || out_size != NTOK * DM || ws_size < WS_END) { fprintf(stderr, "kernel_launch: unexpected shapes (n_in %d, out %d, ws %zu < %zu)\n", n_in, out_size, ws_size, (size_t)WS_END); grid = -1; return; }
        int dev = 0, cus = 0, per_cu = 0;
        if (hipGetDevice(&dev) != hipSuccess || hipDeviceGetAttribute(&cus, hipDeviceAttributeMultiprocessorCount, dev) != hipSuccess) { grid = -1; return; }
        if (hipFuncSetAttribute((const void*)mk_fwd, hipFuncAttributeMaxDynamicSharedMemorySize, LDS_BYTES) != hipSuccess) { fprintf(stderr, "kernel_launch: hipFuncSetAttribute failed\n"); grid = -1; return; }
        if (hipOccupancyMaxActiveBlocksPerMultiprocessor(&per_cu, (const void*)mk_fwd, 512, LDS_BYTES) != hipSuccess || per_cu < 1) { fprintf(stderr, "kernel_launch: occupancy query says %d\n", per_cu); }
        (void)hipGetLastError();
        grid = cus;
    }
    if (grid < 0) return;
    (void)hipMemsetAsync((char*)d_ws + WS_CTL, 0, CTL_ZERO_BYTES, stream);
    Args a{};
    for (int i = 0; i < 17; ++i) a.in[i] = (const float*)d_in[i];
    a.out = (float*)d_out; a.ws = (unsigned char*)d_ws;
#if MK_MULTI
    for (int p = 0; p < 1 + 8 * DEPTH; ++p) { a.ph_lo = p; a.ph_hi = p + 1; hipLaunchKernelGGL(mk_fwd, dim3(grid), dim3(512), LDS_BYTES, stream, a); }
#else
    a.ph_lo = 0; a.ph_hi = 1 + 8 * DEPTH;
    hipLaunchKernelGGL(mk_fwd, dim3(grid), dim3(512), LDS_BYTES, stream, a);
#endif
}
```

```cpp
#include <hip/hip_runtime.h>
#include <cstdio>
#include <cstdint>

#ifndef MK_MULTI
#define MK_MULTI 0
#endif
#ifndef PROBE_EPI2
#define PROBE_EPI2 0
#endif
#ifndef MOE_FP8
#define MOE_FP8 1
#endif
#ifndef YS_FP8
#define YS_FP8 1
#endif
#ifndef SLOW_HGRN
#define SLOW_HGRN 0
#endif
#ifndef SLOW_RET
#define SLOW_RET 0
#endif

#define GAS __attribute__((address_space(1)))
#define LAS __attribute__((address_space(3)))
typedef unsigned short bf16;
typedef unsigned v4u __attribute__((ext_vector_type(4)));
typedef unsigned v2u __attribute__((ext_vector_type(2)));
typedef float f32x4 __attribute__((ext_vector_type(4)));
typedef float f32x2 __attribute__((ext_vector_type(2)));
typedef short bf16x8 __attribute__((ext_vector_type(8)));
typedef GAS unsigned gu32;

constexpr int DM = 1024, NBATCH = 16, SEQ = 2048, NTOK = NBATCH * SEQ, DEPTH = 4;
constexpr int NE = 32, TOPK = 4;
constexpr int HG_HEADS = 8, HG_K = 128;
constexpr int RT_HEADS = 4, RT_K = 256, RT_V = 512, RT_VD = 2048, RT_IN = 6144, HG_IN = 4096;
constexpr int ECAP = NTOK;
constexpr int MOE_ROWS = NTOK * TOPK + NE * 256;
constexpr float DN_ALPHA = 1.681792830507429f;
constexpr float LN_EPS = 1e-5f, RMS_EPS = 1e-6f;

constexpr size_t MiB = 1ull << 20;
constexpr size_t WS_CTL = 0, CTL_ZERO_BYTES = 1 * MiB;
constexpr size_t WS_LBS = 1 * MiB;
constexpr size_t WS_WRH = 1 * MiB + 128 * 1024, WS_WRL = 1 * MiB + 512 * 1024;
constexpr size_t WS_BGU = 2 * MiB;
constexpr size_t WS_ROT = 4 * MiB;
constexpr size_t WS_ROWDST = 8 * MiB;
constexpr size_t WS_ROWGATE = 12 * MiB;
constexpr size_t WS_W_HIN = 16 * MiB;
constexpr size_t WS_W_HOUT = WS_W_HIN + 16 * MiB;
constexpr size_t WS_W_RIN = WS_W_HOUT + 4 * MiB;
constexpr size_t WS_W_ROUT = WS_W_RIN + 24 * MiB;
constexpr size_t WS_W_GU = WS_W_ROUT + 8 * MiB;
constexpr size_t WS_W_DN = WS_W_GU + 512 * MiB;
constexpr size_t WS_XB = WS_W_DN + 256 * MiB;
constexpr size_t WS_H = WS_XB + 64 * MiB;
constexpr size_t WS_DEC = WS_H + 320 * MiB;
constexpr size_t WS_SSP = WS_DEC + 16 * MiB;
constexpr size_t WS_O = WS_H + 384 * MiB;
constexpr size_t WS_A2 = WS_O + 128 * MiB;
constexpr size_t WS_Y = WS_A2 + 128 * MiB;
constexpr size_t WS_X1F = WS_Y + 128 * MiB;
constexpr size_t WS_X1B = WS_X1F + 128 * MiB;
constexpr size_t WS_ACT = WS_X1B + 64 * MiB;
constexpr size_t WS_YSLOT = WS_ACT + 272 * MiB;
constexpr size_t WS_END = WS_YSLOT + 256 * MiB;

constexpr int CW_BAR = 4096;
constexpr int CW_SS = 65536;
constexpr int CW_ECNT = 16384;

constexpr int RING_BYTES = 131072;
constexpr int MISC_OFF = 135168;
constexpr int LDS_BYTES = 163840;
constexpr int MO_BARW = 0;
constexpr int MO_GTAB = 64;
constexpr int MO_TPRE = 64 + 2048;
constexpr int MO_EBASE = MO_TPRE + 160;
constexpr int MO_ECNT = MO_EBASE + 128;
constexpr int MO_LCNT = MO_ECNT + 128;
constexpr int MO_LBASE = MO_LCNT + 128;
constexpr int MO_SEL = MO_LBASE + 128;
constexpr int MO_SELW = MO_SEL + 2048;
constexpr int MO_RANK = MO_SELW + 2048;
constexpr int MO_ULIST = MO_RANK + 2048;
constexpr int MO_GALL = 10240;
constexpr int GALL_UNITS = 18;
static_assert(MO_ULIST + 1024 <= MO_GALL && MISC_OFF + MO_GALL + GALL_UNITS * 1024 <= LDS_BYTES, "LDS map");

#define RLX_AGENT __ATOMIC_RELAXED, __HIP_MEMORY_SCOPE_AGENT
#define LDS_WAIT() asm volatile("s_waitcnt lgkmcnt(0)" ::: "memory")
#define VM_WAIT() asm volatile("s_waitcnt vmcnt(0)" ::: "memory")

__device__ __forceinline__ unsigned f2bf(float f) { unsigned u = __builtin_bit_cast(unsigned, f); return (u + 0x7fffu + ((u >> 16) & 1u)) >> 16; }
__device__ __forceinline__ unsigned pk2(float lo, float hi) { return f2bf(lo) | (f2bf(hi) << 16); }
__device__ __forceinline__ unsigned cvt_pk_bf16(float lo, float hi) { unsigned r; asm volatile("v_cvt_pk_bf16_f32 %0, %1, %2" : "=v"(r) : "v"(lo), "v"(hi)); return r; }
#if MOE_FP8
constexpr float X_SCALE = 4.0f, WGU_SCALE = 64.0f, ACT_SCALE = 4.0f, WDN_SCALE = 128.0f;
constexpr float GU_DESCALE = 1.0f / (X_SCALE * WGU_SCALE), DN_DESCALE = 1.0f / (ACT_SCALE * WDN_SCALE);
#else
constexpr float GU_DESCALE = 1.0f, DN_DESCALE = 1.0f, ACT_SCALE = 1.0f;
#endif
__device__ __forceinline__ unsigned pk4_fp8(float a, float b, float c, float d) {
    a = __builtin_amdgcn_fmed3f(a, -448.0f, 448.0f); b = __builtin_amdgcn_fmed3f(b, -448.0f, 448.0f); c = __builtin_amdgcn_fmed3f(c, -448.0f, 448.0f); d = __builtin_amdgcn_fmed3f(d, -448.0f, 448.0f);
    int p = __builtin_amdgcn_cvt_pk_fp8_f32(a, b, 0, false); p = __builtin_amdgcn_cvt_pk_fp8_f32(c, d, p, true); return (unsigned)p; }
__device__ __forceinline__ float bflo(unsigned u) { return __builtin_bit_cast(float, u << 16); }
__device__ __forceinline__ float bfhi(unsigned u) { return __builtin_bit_cast(float, u & 0xffff0000u); }
__device__ __forceinline__ float bf1(bf16 b) { return __builtin_bit_cast(float, ((unsigned)b) << 16); }
__device__ __forceinline__ float fexp(float x) { return __builtin_amdgcn_exp2f(x * 1.4426950408889634f); }
__device__ __forceinline__ float frcp(float x) { return __builtin_amdgcn_rcpf(x); }
__device__ __forceinline__ float fsigmoid(float x) { return frcp(1.0f + fexp(-x)); }
__device__ __forceinline__ float wave_sum(float v) {
#pragma unroll
    for (int o = 1; o < 64; o <<= 1) v += __shfl_xor(v, o);
    return v;
}
__device__ __forceinline__ float wave_max(float v) {
#pragma unroll
    for (int o = 1; o < 64; o <<= 1) v = fmaxf(v, __shfl_xor(v, o));
    return v;
}

template <int CTRL> __device__ __forceinline__ float dppf(float v) { return __builtin_bit_cast(float, __builtin_amdgcn_update_dpp(0, __builtin_bit_cast(int, v), CTRL, 0xf, 0xf, true)); }
template <int CTRL> __device__ __forceinline__ int dppi(int v) { return __builtin_amdgcn_update_dpp(0, v, CTRL, 0xf, 0xf, true); }
__device__ __forceinline__ float rlane(float v, int l) { return __builtin_bit_cast(float, __builtin_amdgcn_readlane(__builtin_bit_cast(int, v), l)); }
__device__ __forceinline__ float wave_sum_u(float v) {
    v += dppf<0xB1>(v); v += dppf<0x4E>(v); v += dppf<0x141>(v); v += dppf<0x140>(v);
    return (rlane(v, 0) + rlane(v, 16)) + (rlane(v, 32) + rlane(v, 48));
}
#define XB_TMO      128
#define XB_XCNT(j)  (256  + 64 * (j))
#define XB_XSUB(j)  (1280 + 64 * (j))
#define XB_XGEN(j)  (2304 + 64 * (j))
#define XB_TOP      3328
#define XB_TOPGEN   3392
#define XCD_BAR_WORDS 3456
#define XB_SPIN_CAP (1u << 22)

__device__ __forceinline__ unsigned xb_ld(unsigned* p)              { return __hip_atomic_load(p, __ATOMIC_RELAXED, __HIP_MEMORY_SCOPE_AGENT); }
__device__ __forceinline__ unsigned xb_add(unsigned* p, unsigned v) { return __hip_atomic_fetch_add(p, v, __ATOMIC_RELAXED, __HIP_MEMORY_SCOPE_AGENT); }
__device__ __forceinline__ unsigned xb_xcc_id() { return (unsigned)__builtin_amdgcn_s_getreg((3 << 11) | 20) & 0xFu; }
#define XB_SPIN(cond, bar) do { unsigned _sp = 0; while (cond) { __builtin_amdgcn_s_sleep(1); \
    if ((++_sp & 255u) == 0u) { if (xb_ld(&(bar)[XB_TMO])) break; if (_sp > XB_SPIN_CAP) { atomicAdd(&(bar)[XB_TMO], 1u); break; } } } } while (0)

struct XcdBarrier { unsigned* bar; unsigned x; volatile LAS unsigned* st; };

__device__ __forceinline__ XcdBarrier xcd_barrier_post(unsigned* bar, volatile LAS unsigned* st) {
    XcdBarrier b; b.bar = bar; b.x = xb_xcc_id(); b.st = st;
    if (threadIdx.x == 0) (void)xb_add(&bar[XB_XCNT(b.x)], 1u);
    return b;
}
__device__ __forceinline__ void xcd_barrier_complete(unsigned* bar, unsigned x, unsigned& nloc, unsigned& nx) {
    const unsigned G = gridDim.x * gridDim.y * gridDim.z;
    unsigned sum, cnt, mine, sp = 0u;
    for (;;) {
        sum = 0u; cnt = 0u; mine = 0u;
#pragma unroll
        for (unsigned j = 0; j < 16; ++j) { const unsigned c = xb_ld(&bar[XB_XCNT(j)]); sum += c; cnt += (c > 0u) ? 1u : 0u; mine = (j == x) ? c : mine; }
        if (sum == G) break;
        __builtin_amdgcn_s_sleep(1);
        if ((++sp & 255u) == 0u) { if (xb_ld(&bar[XB_TMO])) break; if (sp > XB_SPIN_CAP) { atomicAdd(&bar[XB_TMO], 1u); break; } }
    }
    nloc = mine > 0u ? mine : 1u; nx = cnt > 0u ? cnt : 1u;
}
__device__ __forceinline__ void xcd_barrier(const XcdBarrier& b) {
    asm volatile("s_waitcnt vmcnt(0)" ::: "memory");
    __syncthreads();
    if (threadIdx.x == 0) {
        unsigned* bar = b.bar;
        __builtin_amdgcn_s_waitcnt(0);
        unsigned nloc = b.st[0], nx = b.st[1];
        if (nloc == 0u) { xcd_barrier_complete(bar, b.x, nloc, nx); b.st[0] = nloc; b.st[1] = nx; }
        const unsigned old = xb_add(&bar[XB_XSUB(b.x)], 1u);
        const unsigned gen = old / nloc;
        if (old + 1u == (gen + 1u) * nloc) {
            __builtin_amdgcn_fence(__ATOMIC_RELEASE, "agent");
            asm volatile("s_waitcnt vmcnt(0)" ::: "memory");
            const unsigned og = xb_add(&bar[XB_TOP], 1u);
            const unsigned tg = og / nx;
            if (og + 1u == (tg + 1u) * nx) xb_add(&bar[XB_TOPGEN], 1u);
            else XB_SPIN(xb_ld(&bar[XB_TOPGEN]) == tg, bar);
            __builtin_amdgcn_fence(__ATOMIC_ACQUIRE, "agent");
            xb_add(&bar[XB_XGEN(b.x)], 1u);
            asm volatile("s_waitcnt vmcnt(0)" ::: "memory");
        } else {
            XB_SPIN(xb_ld(&bar[XB_XGEN(b.x)]) == gen, bar);
            __builtin_amdgcn_fence(__ATOMIC_ACQUIRE, "agent");
            asm volatile("s_waitcnt vmcnt(0)" ::: "memory");
        }
    }
    __syncthreads();
}

namespace pg8 {
constexpr int BM = 256, BK = 64, HALF = 128, HTB = HALF * BK * 2, STAGE_BYTES = 8 * HTB, NXCD = 8, WGM = 8, MAXU = 32;
__host__ __device__ __forceinline__ int lds_byte(int r, int c) { const int st = (r >> 4) * 2 + (c >> 5), rr = r & 15, cc = c & 31, ob = rr * 64 + cc * 2; return st * 1024 + (ob ^ (((ob >> 9) & 1) << 5)); }
__host__ __device__ __forceinline__ void stage_rc(int b, int& R, int& C) { const int st = b / 1024, sb = b % 1024, swz = sb ^ (((sb >> 9) & 1) << 5); R = (st >> 1) * 16 + swz / 64; C = (st & 1) * 32 + (swz % 64) / 2; }
__host__ __device__ __forceinline__ int perm32(int rho) { const int n = rho >> 4, i = rho & 15; return 8 * (i >> 2) + 4 * n + (i & 3); }

struct Unit { int pm, pn, e, rowbase, cnt; unsigned boff; int gidx; };

__device__ __forceinline__ bool tile_of(long L, int nM, int nN, int& gm, int& pn) {
    const int nwg = nM * nN; if (L >= nwg) return false;
    int wgid = (int)L; { const int q = nwg / NXCD, r = nwg % NXCD, xcd = wgid % NXCD, off = wgid / NXCD; wgid = (xcd < r ? xcd * (q + 1) : r * (q + 1) + (xcd - r) * q) + off; }
    const int nig = WGM * nN, gid = wgid / nig, fm = gid * WGM, gsz = (nM - fm) < WGM ? (nM - fm) : WGM;
    gm = fm + ((wgid % nig) % gsz); pn = (wgid % nig) / gsz; return true;
}
__device__ __forceinline__ void build_units_dense(const int i, LAS int* ul, int nM, int nN, int RB) {
    if (i < MAXU) { int gm = 0, pn = 0; const bool ok = tile_of((long)i * gridDim.x + blockIdx.x, nM, nN, gm, pn);
        ul[i * 8 + 0] = ok ? 1 : 0; ul[i * 8 + 1] = gm; ul[i * 8 + 2] = pn; ul[i * 8 + 3] = 0; ul[i * 8 + 4] = gm * BM; ul[i * 8 + 5] = BM; ul[i * 8 + 6] = (int)((unsigned)pn * BM * (unsigned)RB); ul[i * 8 + 7] = 0; }
    __syncthreads();
}
__device__ __forceinline__ void build_units_moe(const int i, LAS int* ul, const LAS int* tpre, const LAS int* ebase, const LAS int* ecnt, int nN, int RB, unsigned wstride) {
    if (i < MAXU) { int gm = 0, pn = 0; const bool ok = tile_of((long)i * gridDim.x + blockIdx.x, tpre[NE], nN, gm, pn);
        int e = 0;
_Pragma("unroll 1")
        for (int s = 16; s >= 1; s >>= 1) { if (e + s < NE && tpre[e + s] <= gm) e += s; }
        const int pm = gm - tpre[e];
        ul[i * 8 + 0] = ok ? 1 : 0; ul[i * 8 + 1] = pm; ul[i * 8 + 2] = pn; ul[i * 8 + 3] = e; ul[i * 8 + 4] = ebase[e] + pm * BM; ul[i * 8 + 5] = ecnt[e] - pm * BM;
        ul[i * 8 + 6] = (int)((unsigned)e * wstride + (unsigned)pn * BM * (unsigned)RB); ul[i * 8 + 7] = e * ECAP + pm * BM; }
    __syncthreads();
}
__device__ __forceinline__ bool ld_unit(const LAS int* ul, int i, Unit& u) {
    if (i >= MAXU) return false;
    const LAS int* p = ul + i * 8;
    if (__builtin_amdgcn_readfirstlane(p[0]) == 0) return false;
    u.pm = __builtin_amdgcn_readfirstlane(p[1]); u.pn = __builtin_amdgcn_readfirstlane(p[2]); u.e = __builtin_amdgcn_readfirstlane(p[3]); u.rowbase = __builtin_amdgcn_readfirstlane(p[4]);
    u.cnt = __builtin_amdgcn_readfirstlane(p[5]); u.boff = (unsigned)__builtin_amdgcn_readfirstlane(p[6]); u.gidx = __builtin_amdgcn_readfirstlane(p[7]); return true;
}
__device__ __forceinline__ void glds16(const char* sbase, unsigned voff, LAS unsigned char* dst) {
    asm volatile("" : "+s"(sbase));
    __builtin_amdgcn_global_load_lds((const unsigned*)(sbase + voff), (LAS unsigned*)dst, 16, 0, 0);
}
template <bool GATHER> __device__ __forceinline__ void stage_a(LAS unsigned char* dst, const char* sbase, unsigned o0, unsigned o1, size_t r64) {
    glds16(sbase, o0, dst);
    if constexpr (GATHER) glds16(sbase, o1, dst + 8192);
    else glds16(sbase + r64, o0, dst + 8192);
}

typedef int v8i __attribute__((ext_vector_type(8)));
typedef int v4i __attribute__((ext_vector_type(4)));
__device__ __forceinline__ v8i cat_frag(const bf16x8& a, const bf16x8& b) { return __builtin_shufflevector(__builtin_bit_cast(v4i, a), __builtin_bit_cast(v4i, b), 0, 1, 2, 3, 4, 5, 6, 7); }
template <class Epi, bool GATHER, bool ALIGN_EPI, bool FP8>
__device__ __forceinline__ void gemm_phase(const int tid, LAS unsigned char* lds, const LAS int* ul, LAS int* gtab, const char* Abase, const char* Bbase, const int* rowdst, const int RB, const Epi& E, LAS unsigned char* epl = nullptr) {
    const int wid = __builtin_amdgcn_readfirstlane(tid >> 6), lane = tid & 63, wr = wid >> 2, wc = wid & 3, fr = lane & 15, fq = lane >> 4;
    const int nt = RB / 128;
    int R0, C0; stage_rc(tid * 16, R0, C0);
    const int Rb0 = Epi::PERM ? ((R0 & ~31) + perm32(R0 & 31)) : R0;
    const unsigned voffB = (unsigned)(Rb0 * RB + C0 * 2);
    const unsigned cb0 = (unsigned)C0 * 2u, K2 = (unsigned)RB;
    const size_t kstep = (size_t)128;
    const size_t r64 = (size_t)64 * RB;
    const size_t hstep = (size_t)HALF * RB;
    const unsigned ldsw = (unsigned)wid * 1024u;
    const int aoff = lds_byte(wr * 64 + fr, fq * 8), boff = lds_byte(wc * 32 + fr, fq * 8);
#define PG8_SA(b, h) (((b) * 2 + (h)) * HTB)
#define PG8_SB(b, h) ((4 + (b) * 2 + (h)) * HTB)
#define PG8_STAGE(bufoff, gbase) do { glds16((const char*)(gbase), voffB, lds + (bufoff) + ldsw); glds16((const char*)(gbase) + r64, voffB, lds + (bufoff) + ldsw + 8192); } while (0)
#define PG8_STAGEA0(bufoff, kb, o0, o1) stage_a<GATHER>(lds + (bufoff) + ldsw, Abase + (kb), o0, o1, r64)
#define PG8_STAGEA1(bufoff, kb, o0, o2, o3) stage_a<GATHER>(lds + (bufoff) + ldsw, Abase + (kb) + (GATHER ? (size_t)0 : hstep), GATHER ? (o2) : (o0), o3, r64)
#define PG8_LDA(dst, b, h) do { _Pragma("unroll") for (int m = 0; m < 4; ++m) { const v4i _l = *(const LAS v4i*)(lds + PG8_SA(b, h) + aoff + m * 2048), _h = *(const LAS v4i*)(lds + PG8_SA(b, h) + aoff + m * 2048 + 1024); dst[m] = __builtin_shufflevector(_l, _h, 0, 1, 2, 3, 4, 5, 6, 7); } } while (0)
#define PG8_LDB(dst, b, h) do { _Pragma("unroll") for (int n = 0; n < 2; ++n) { const v4i _l = *(const LAS v4i*)(lds + PG8_SB(b, h) + boff + n * 2048), _h = *(const LAS v4i*)(lds + PG8_SB(b, h) + boff + n * 2048 + 1024); dst[n] = __builtin_shufflevector(_l, _h, 0, 1, 2, 3, 4, 5, 6, 7); } } while (0)
#define PG8_LO(x) __builtin_bit_cast(bf16x8, __builtin_shufflevector(x, x, 0, 1, 2, 3))
#define PG8_HI(x) __builtin_bit_cast(bf16x8, __builtin_shufflevector(x, x, 4, 5, 6, 7))
#define PG8_MMA(ai, bj, At, Bt) do { __builtin_amdgcn_s_setprio(1); _Pragma("unroll") for (int m = 0; m < 4; ++m) _Pragma("unroll") for (int n = 0; n < 2; ++n) { \
        if constexpr (FP8) asm volatile("v_mfma_scale_f32_16x16x128_f8f6f4 %0, %1, %2, %0, %3, %3 op_sel_hi:[0,0,0]" : "+v"(acc[ai][bj][m][n]) : "v"(Bt[n]), "v"(At[m]), "v"(sc1)); \
        else { acc[ai][bj][m][n] = __builtin_amdgcn_mfma_f32_16x16x32_bf16(PG8_LO(Bt[n]), PG8_LO(At[m]), acc[ai][bj][m][n], 0, 0, 0); \
               acc[ai][bj][m][n] = __builtin_amdgcn_mfma_f32_16x16x32_bf16(PG8_HI(Bt[n]), PG8_HI(At[m]), acc[ai][bj][m][n], 0, 0, 0); } } \
        __builtin_amdgcn_s_setprio(0); } while (0)
#define PG8_WAIT_V(n) asm volatile("s_waitcnt vmcnt(" #n ")" ::: "memory")
#define PG8_WAIT_L(n) asm volatile("s_waitcnt lgkmcnt(" #n ")" ::: "memory")
#define PG8_BAR __builtin_amdgcn_s_barrier()
#define PG8_SCHED __builtin_amdgcn_sched_barrier(0)
    Unit cur, nxt; int ui = 0;
    if (!ld_unit(ul, 0, cur)) return;
    f32x4 acc[2][2][4][2];
#pragma unroll
    for (int a = 0; a < 2; ++a)
#pragma unroll
        for (int b = 0; b < 2; ++b)
#pragma unroll
            for (int m = 0; m < 4; ++m)
#pragma unroll
                for (int n = 0; n < 2; ++n) acc[a][b][m][n] = (f32x4){0.f, 0.f, 0.f, 0.f};
    v8i At[4], B0[2], B1[2];
    const int sc1 = 0x7f7f7f7f;
    unsigned oA0, oA1 = 0, oA2 = 0, oA3 = 0, oN0, oN1 = 0, oN2 = 0, oN3 = 0;
    if constexpr (GATHER) {
        oA0 = (unsigned)gtab[R0] * K2 + cb0; oA1 = (unsigned)gtab[R0 + 64] * K2 + cb0; oA2 = (unsigned)gtab[R0 + 128] * K2 + cb0; oA3 = (unsigned)gtab[R0 + 192] * K2 + cb0;
    } else {
        oA0 = (unsigned)(cur.rowbase + R0) * K2 + cb0;
    }
    oN0 = oA0; oN1 = oA1; oN2 = oA2; oN3 = oA3;
    const char* cB = Bbase + cur.boff;
    PG8_STAGE(PG8_SB(0, 0), cB); PG8_STAGE(PG8_SB(0, 1), cB + hstep); PG8_STAGEA0(PG8_SA(0, 0), (size_t)0, oA0, oA1); PG8_STAGEA1(PG8_SA(0, 1), (size_t)0, oA0, oA2, oA3);
    if (wr == 1) PG8_BAR;
    PG8_WAIT_V(2); PG8_BAR;
    PG8_STAGE(PG8_SB(1, 0), cB + kstep); PG8_STAGEA0(PG8_SA(1, 0), kstep, oA0, oA1); PG8_STAGE(PG8_SB(1, 1), cB + hstep + kstep);
    PG8_WAIT_V(6); PG8_BAR;
    for (;;) {
        const bool has_next = ld_unit(ul, ui + 1, nxt);
        if constexpr (Epi::HAS_PRE) E.pre(cur, epl + (ui & 1) * Epi::PRE_BYTES, wid, lane);
        const char* nB = has_next ? Bbase + nxt.boff : cB;
_Pragma("unroll 1")
        for (int t = 0; t < nt; t += 2) {
            const bool last = (t == nt - 2);
            if (last && has_next) {
                if constexpr (GATHER) {
                    const LAS int* gt = gtab + (ui + 1) * 256;
                    oN0 = (unsigned)gt[R0] * K2 + cb0; oN1 = (unsigned)gt[R0 + 64] * K2 + cb0; oN2 = (unsigned)gt[R0 + 128] * K2 + cb0; oN3 = (unsigned)gt[R0 + 192] * K2 + cb0;
                } else {
                    oN0 = (unsigned)(nxt.rowbase + R0) * K2 + cb0;
                }
            }
            const size_t kb1 = (size_t)(t + 1) * kstep;
            const size_t kb2 = last ? (size_t)0 : (size_t)(t + 2) * kstep, kb3 = kb2 + kstep;
            const unsigned p0 = last ? oN0 : oA0, p1 = last ? oN1 : oA1, p2 = last ? oN2 : oA2, p3 = last ? oN3 : oA3;
            const char* b2 = last ? nB : cB + (size_t)(t + 2) * kstep; const char* b3 = b2 + kstep;
            PG8_LDB(B0, 0, 0); PG8_LDB(B1, 0, 1); PG8_SCHED; PG8_LDA(At, 0, 0); PG8_STAGEA1(PG8_SA(1, 1), kb1, oA0, oA2, oA3);
            PG8_WAIT_V(8); PG8_WAIT_L(0); PG8_BAR; PG8_MMA(0, 0, At, B0); PG8_MMA(0, 1, At, B1); PG8_BAR; PG8_SCHED;
            PG8_LDA(At, 0, 1); PG8_STAGE(PG8_SB(0, 0), b2); PG8_STAGE(PG8_SB(0, 1), b2 + hstep); PG8_STAGEA0(PG8_SA(0, 0), kb2, p0, p1);
            PG8_WAIT_V(8); PG8_WAIT_L(0); PG8_BAR; PG8_MMA(1, 0, At, B0); PG8_MMA(1, 1, At, B1); PG8_BAR; PG8_SCHED;
            PG8_LDB(B0, 1, 0); PG8_LDB(B1, 1, 1); PG8_SCHED; PG8_LDA(At, 1, 0); PG8_STAGEA1(PG8_SA(0, 1), kb2, p0, p2, p3);
            PG8_WAIT_V(8); PG8_WAIT_L(0); PG8_BAR; PG8_MMA(0, 0, At, B0); PG8_MMA(0, 1, At, B1); PG8_BAR; PG8_SCHED;
            PG8_LDA(At, 1, 1); PG8_STAGE(PG8_SB(1, 0), b3); PG8_STAGE(PG8_SB(1, 1), b3 + hstep); PG8_STAGEA0(PG8_SA(1, 0), kb3, p0, p1);
            PG8_WAIT_V(8); PG8_WAIT_L(0); PG8_BAR; PG8_MMA(1, 0, At, B0); PG8_MMA(1, 1, At, B1); PG8_BAR; PG8_SCHED;
        }
        if constexpr (FP8) asm volatile("s_nop 7\n\ts_nop 7\n\ts_nop 7" ::: "memory");
        if constexpr (ALIGN_EPI) { if (wr == 0) PG8_BAR; }
        if constexpr (Epi::HAS_PRE) E(acc, cur, wr, wc, fr, fq, epl + (ui & 1) * Epi::PRE_BYTES); else E(acc, cur, wr, wc, fr, fq);
#if PROBE_EPI2
        if constexpr (FP8) { if constexpr (Epi::HAS_PRE) E(acc, cur, wr, wc, fr, fq, epl + (ui & 1) * Epi::PRE_BYTES); else E(acc, cur, wr, wc, fr, fq); }
#endif
        if (!has_next) break;
#pragma unroll
        for (int a = 0; a < 2; ++a)
#pragma unroll
            for (int b = 0; b < 2; ++b)
#pragma unroll
                for (int m = 0; m < 4; ++m)
#pragma unroll
                    for (int n = 0; n < 2; ++n) acc[a][b][m][n] = (f32x4){0.f, 0.f, 0.f, 0.f};
        cur = nxt; cB = nB; oA0 = oN0; oA1 = oN1; oA2 = oN2; oA3 = oN3; ++ui;
        if constexpr (ALIGN_EPI) { if (wr == 1) PG8_BAR; }
    }
    PG8_WAIT_V(0);
    if constexpr (!ALIGN_EPI) { if (wr == 0) PG8_BAR; }
    PG8_BAR;
#undef PG8_SA
#undef PG8_SB
#undef PG8_STAGE
#undef PG8_STAGEA0
#undef PG8_STAGEA1
#undef PG8_LDA
#undef PG8_LDB
#undef PG8_LO
#undef PG8_HI
#undef PG8_MMA
#undef PG8_WAIT_V
#undef PG8_WAIT_L
#undef PG8_BAR
#undef PG8_SCHED
}

__device__ __forceinline__ GAS unsigned char* launder(unsigned char* p) { asm volatile("" : "+s"(p)); return (GAS unsigned char*)p; }
#define OPAQUE_LANE(fr, fq) asm volatile("" : "+v"(fr), "+v"(fq))
struct EpiHgrnIn {
    static constexpr bool PERM = true, HAS_PRE = true; static constexpr int PRE_BYTES = 1024;
    unsigned char* ws0; int L;
    __device__ __forceinline__ void pre(const Unit& u, LAS unsigned char* buf, int wid, int lane) const {
        if (wid == 0 && u.pn < 8) glds16((const char*)(ws0 + WS_LBS) + ((size_t)L * DM + (size_t)u.pn * HG_K) * 4, (unsigned)lane * 16u, buf);
    }
    __device__ __forceinline__ void operator()(const f32x4 (&acc)[2][2][4][2], const Unit& u, int wr, int wc, int fr, int fq, const LAS unsigned char* buf) const {
        OPAQUE_LANE(fr, fq);
        GAS unsigned char* ws = launder(ws0);
        GAS bf16* QD = (GAS bf16*)(ws + WS_H);
        const int row0 = u.rowbase + wr * 64 + fr;
        if (u.pn >= 8) {
            const bool isg = u.pn >= 12; GAS bf16* base = QD + (size_t)(isg ? 4 : 3) * NTOK * DM; const int colt = (u.pn - (isg ? 12 : 8)) * BM + wc * 32 + 8 * fq;
#pragma unroll
            for (int ai = 0; ai < 2; ++ai)
#pragma unroll
                for (int m = 0; m < 4; ++m) { GAS bf16* rowp = base + (size_t)(row0 + ai * HALF + m * 16) * DM + colt;
#pragma unroll
                    for (int bj = 0; bj < 2; ++bj) { f32x4 v0 = acc[ai][bj][m][0], v1 = acc[ai][bj][m][1];
                        if (isg) {
#pragma unroll
                            for (int j = 0; j < 4; ++j) { v0[j] = v0[j] * fsigmoid(v0[j]); v1[j] = v1[j] * fsigmoid(v1[j]); } }
                        v4u w; w.x = cvt_pk_bf16(v0[0], v0[1]); w.y = cvt_pk_bf16(v0[2], v0[3]); w.z = cvt_pk_bf16(v1[0], v1[1]); w.w = cvt_pk_bf16(v1[2], v1[3]);
                        *(GAS v4u*)(rowp + bj * HALF) = w; } }
            return;
        }
        const int col = u.pn * HG_K + wc * 32 + 8 * fq;
        const LAS float* lb = (const LAS float*)buf + wc * 32 + 8 * fq;
        const f32x4 lb0 = *(const LAS f32x4*)lb, lb1 = *(const LAS f32x4*)(lb + 4);
#if !SLOW_HGRN
        const int lane = fq * 16 + fr;
        GAS float* DEC = (GAS float*)(ws + WS_DEC);
#endif
#pragma unroll
        for (int ai = 0; ai < 2; ++ai)
#pragma unroll
            for (int m = 0; m < 4; ++m) {
                const int row = row0 + ai * HALF + m * 16;
                float qd[8], ki[8];
#if SLOW_HGRN
                float ks[8];
#endif
#if !SLOW_HGRN
                float de[8];
#endif
#pragma unroll
                for (int j = 0; j < 8; ++j) {
                    const float q = acc[ai][0][m][j >> 2][j & 3], f = acc[ai][1][m][j >> 2][j & 3], lbv = j < 4 ? lb0[j & 3] : lb1[j & 3];
                    const float sg = fsigmoid(f), fg = lbv + (1.0f - lbv) * sg, kk = (1.0f - lbv) * (1.0f - sg);
#if SLOW_HGRN
                    qd[j] = q * fsigmoid(q); ki[j] = kk; ks[j] = fg;
#else
                    float P = fg;
                    P *= __builtin_bit_cast(float, __builtin_amdgcn_update_dpp(0x3f800000, __builtin_bit_cast(int, P), 0x111, 0xf, 0xf, false));
                    P *= __builtin_bit_cast(float, __builtin_amdgcn_update_dpp(0x3f800000, __builtin_bit_cast(int, P), 0x112, 0xf, 0xf, false));
                    P *= __builtin_bit_cast(float, __builtin_amdgcn_update_dpp(0x3f800000, __builtin_bit_cast(int, P), 0x114, 0xf, 0xf, false));
                    P *= __builtin_bit_cast(float, __builtin_amdgcn_update_dpp(0x3f800000, __builtin_bit_cast(int, P), 0x118, 0xf, 0xf, false));
                    const float Pl = __shfl(P, lane | 15), iP = frcp(fmaxf(P, 1e-30f));
                    qd[j] = q * fsigmoid(q) * P; ki[j] = kk * iP; de[j] = Pl;
#endif
                }
                const size_t o = (size_t)row * DM + col;
                v4u w;
                w.x = cvt_pk_bf16(qd[0], qd[1]); w.y = cvt_pk_bf16(qd[2], qd[3]); w.z = cvt_pk_bf16(qd[4], qd[5]); w.w = cvt_pk_bf16(qd[6], qd[7]); *(GAS v4u*)(QD + o) = w;
                w.x = cvt_pk_bf16(ki[0], ki[1]); w.y = cvt_pk_bf16(ki[2], ki[3]); w.z = cvt_pk_bf16(ki[4], ki[5]); w.w = cvt_pk_bf16(ki[6], ki[7]); *(GAS v4u*)(QD + (size_t)NTOK * DM + o) = w;
#if SLOW_HGRN
                w.x = cvt_pk_bf16(ks[0], ks[1]); w.y = cvt_pk_bf16(ks[2], ks[3]); w.z = cvt_pk_bf16(ks[4], ks[5]); w.w = cvt_pk_bf16(ks[6], ks[7]); *(GAS v4u*)(QD + 2 * (size_t)NTOK * DM + o) = w;
#endif
#if !SLOW_HGRN
                if (fr == 0) { GAS float* dp = DEC + (size_t)(row >> 4) * DM + col; *(GAS f32x4*)dp = (f32x4){de[0], de[1], de[2], de[3]}; *(GAS f32x4*)(dp + 4) = (f32x4){de[4], de[5], de[6], de[7]}; }
#endif
            }
    }
};
struct EpiRetIn {
    static constexpr bool PERM = true, HAS_PRE = false; static constexpr int PRE_BYTES = 0;
    unsigned char* ws0;
    __device__ __forceinline__ void operator()(const f32x4 (&acc)[2][2][4][2], const Unit& u, int wr, int wc, int fr, int fq) const {
        OPAQUE_LANE(fr, fq);
        GAS unsigned char* ws = launder(ws0);
        GAS bf16* H = (GAS bf16*)(ws + WS_H); const GAS float* rot = (const GAS float*)(ws + WS_ROT);
        const int row0 = u.rowbase + wr * 64 + fr; const int colt = u.pn * BM + wc * 32 + 8 * fq;
        const int kind = u.pn < 4 ? 0 : (u.pn < 8 ? 1 : (u.pn < 16 ? 2 : 3));
#pragma unroll
        for (int ai = 0; ai < 2; ++ai)
#pragma unroll
            for (int m = 0; m < 4; ++m) { const int row = row0 + ai * HALF + m * 16; GAS bf16* rowp = H + (size_t)row * RT_IN + colt; const int pos = row & (SEQ - 1);
#pragma unroll
                for (int bj = 0; bj < 2; ++bj) { f32x4 v0 = acc[ai][bj][m][0], v1 = acc[ai][bj][m][1];
                    if (kind <= 1) {
                        const int p0 = (bj * HALF + wc * 32 + 8 * fq) >> 1;
                        const GAS float* rp = rot + ((size_t)pos * 128 + p0) * 2;
                        const f32x4 r0 = *(const GAS f32x4*)rp, r1 = *(const GAS f32x4*)(rp + 4);
                        const float sc = kind == 1 ? 0.0625f : 1.0f;
                        f32x4 o0, o1;
                        o0[0] = (v0[0] * r0[0] - v0[1] * r0[1]) * sc; o0[1] = (v0[1] * r0[0] + v0[0] * r0[1]) * sc;
                        o0[2] = (v0[2] * r0[2] - v0[3] * r0[3]) * sc; o0[3] = (v0[3] * r0[2] + v0[2] * r0[3]) * sc;
                        o1[0] = (v1[0] * r1[0] - v1[1] * r1[1]) * sc; o1[1] = (v1[1] * r1[0] + v1[0] * r1[1]) * sc;
                        o1[2] = (v1[2] * r1[2] - v1[3] * r1[3]) * sc; o1[3] = (v1[3] * r1[2] + v1[2] * r1[3]) * sc;
                        v0 = o0; v1 = o1;
                    } else if (kind == 3) {
#pragma unroll
                        for (int j = 0; j < 4; ++j) { v0[j] = v0[j] * fsigmoid(v0[j]); v1[j] = v1[j] * fsigmoid(v1[j]); }
                    }
                    v4u w; w.x = cvt_pk_bf16(v0[0], v0[1]); w.y = cvt_pk_bf16(v0[2], v0[3]); w.z = cvt_pk_bf16(v1[0], v1[1]); w.w = cvt_pk_bf16(v1[2], v1[3]);
                    *(GAS v4u*)(rowp + bj * HALF) = w; } }
    }
};
struct EpiRes {
    static constexpr bool PERM = true, HAS_PRE = false; static constexpr int PRE_BYTES = 0;
    unsigned char* ws0; int ssoff;
    __device__ __forceinline__ void operator()(const f32x4 (&acc)[2][2][4][2], const Unit& u, int wr, int wc, int fr, int fq) const {
        OPAQUE_LANE(fr, fq);
        GAS unsigned char* ws = launder(ws0);
        GAS bf16* Y = (GAS bf16*)(ws + WS_Y); const GAS bf16* X = (const GAS bf16*)(ws + WS_XB);
        const int row0 = u.rowbase + wr * 64 + fr, col0 = u.pn * BM + wc * 32 + 8 * fq;
#pragma unroll
        for (int ai = 0; ai < 2; ++ai)
#pragma unroll
            for (int m = 0; m < 4; ++m) { const size_t off = (size_t)(row0 + ai * HALF + m * 16) * DM + col0;
                float rsc = 1.0f;
                if (ssoff >= 0) { const GAS float* sp = (const GAS float*)(ws + WS_SSP) + row0 + ai * HALF + m * 16; float ssum = 0.f;
#pragma unroll
                    for (int hh = 0; hh < HG_HEADS; ++hh) ssum += sp[(size_t)hh * NTOK];
                    rsc = 1.0f / sqrtf(ssum * (1.0f / DM) + RMS_EPS); }
#pragma unroll
                for (int bj = 0; bj < 2; ++bj) { const v4u xs = *(const GAS v4u*)(X + off + bj * HALF); const f32x4 a0 = acc[ai][bj][m][0] * rsc, a1 = acc[ai][bj][m][1] * rsc;
                    v4u w; w.x = cvt_pk_bf16(bflo(xs.x) * DN_ALPHA + a0[0], bfhi(xs.x) * DN_ALPHA + a0[1]); w.y = cvt_pk_bf16(bflo(xs.y) * DN_ALPHA + a0[2], bfhi(xs.y) * DN_ALPHA + a0[3]);
                    w.z = cvt_pk_bf16(bflo(xs.z) * DN_ALPHA + a1[0], bfhi(xs.z) * DN_ALPHA + a1[1]); w.w = cvt_pk_bf16(bflo(xs.w) * DN_ALPHA + a1[2], bfhi(xs.w) * DN_ALPHA + a1[3]);
                    *(GAS v4u*)(Y + off + bj * HALF) = w; } }
    }
};
struct EpiMoeGU {
    static constexpr bool PERM = true, HAS_PRE = true; static constexpr int PRE_BYTES = 1024;
    unsigned char* ws0; int L;
    __device__ __forceinline__ void pre(const Unit& u, LAS unsigned char* buf, int wid, int lane) const {
        if (wid == 0) glds16((const char*)(ws0 + WS_BGU) + ((size_t)L * NE * 2048 + ((size_t)u.e * 8 + u.pn) * 256) * 4, (unsigned)lane * 16u, buf);
    }
    __device__ __forceinline__ void operator()(const f32x4 (&acc)[2][2][4][2], const Unit& u, int wr, int wc, int fr, int fq, const LAS unsigned char* buf) const {
        OPAQUE_LANE(fr, fq);
        GAS unsigned char* ws = launder(ws0);
        const int row0 = u.rowbase + wr * 64 + fr; const int c8 = wc * 32 + 8 * fq;
        const LAS float* bp = (const LAS float*)buf + c8;
        const f32x4 bg0 = *(const LAS f32x4*)bp, bg1 = *(const LAS f32x4*)(bp + 4);
        const f32x4 bl0 = (*(const LAS f32x4*)(bp + HALF) + 1.0f) * ACT_SCALE, bl1 = (*(const LAS f32x4*)(bp + HALF + 4) + 1.0f) * ACT_SCALE;
#pragma unroll
        for (int ai = 0; ai < 2; ++ai)
#pragma unroll
            for (int m = 0; m < 4; ++m) { const size_t eo = (size_t)(row0 + ai * HALF + m * 16) * DM + u.pn * HALF + c8;
                float a[8];
#pragma unroll
                for (int j = 0; j < 8; ++j) {
                    const float g = fminf(fmaf(acc[ai][0][m][j >> 2][j & 3], GU_DESCALE, j < 4 ? bg0[j & 3] : bg1[j & 3]), 7.0f);
                    const float l1 = __builtin_amdgcn_fmed3f(fmaf(acc[ai][1][m][j >> 2][j & 3], GU_DESCALE * ACT_SCALE, j < 4 ? bl0[j & 3] : bl1[j & 3]), -6.0f * ACT_SCALE, 8.0f * ACT_SCALE);
                    a[j] = g * frcp(1.0f + __builtin_amdgcn_exp2f(g * -2.4554669595930156f)) * l1;
                }
#if MOE_FP8
                v2u w;
                { int p = __builtin_amdgcn_cvt_pk_fp8_f32(a[0], a[1], 0, false); p = __builtin_amdgcn_cvt_pk_fp8_f32(a[2], a[3], p, true); w.x = (unsigned)p; }
                { int p = __builtin_amdgcn_cvt_pk_fp8_f32(a[4], a[5], 0, false); p = __builtin_amdgcn_cvt_pk_fp8_f32(a[6], a[7], p, true); w.y = (unsigned)p; }
                *(GAS v2u*)(ws + WS_ACT + eo) = w;
#else
                v4u w; w.x = cvt_pk_bf16(a[0], a[1]); w.y = cvt_pk_bf16(a[2], a[3]); w.z = cvt_pk_bf16(a[4], a[5]); w.w = cvt_pk_bf16(a[6], a[7]);
                *(GAS v4u*)((GAS bf16*)(ws + WS_ACT) + eo) = w;
#endif
            }
    }
};
struct EpiMoeDown {
    static constexpr bool PERM = true, HAS_PRE = true; static constexpr int PRE_BYTES = 3072;
    unsigned char* ws0; const float* bias;
    __device__ __forceinline__ void pre(const Unit& u, LAS unsigned char* buf, int wid, int lane) const {
        if (wid == 0) glds16((const char*)(bias + (size_t)u.e * DM + u.pn * BM), (unsigned)lane * 16u, buf);
        if (wid == 1) glds16((const char*)(ws0 + WS_ROWDST) + (size_t)u.gidx * 4, (unsigned)lane * 16u, buf + 1024);
        if (wid == 2) glds16((const char*)(ws0 + WS_ROWGATE) + (size_t)u.gidx * 4, (unsigned)lane * 16u, buf + 2048);
    }
    __device__ __forceinline__ void operator()(const f32x4 (&acc)[2][2][4][2], const Unit& u, int wr, int wc, int fr, int fq, const LAS unsigned char* buf) const {
        OPAQUE_LANE(fr, fq);
        GAS unsigned char* ws = launder(ws0);
        GAS bf16* YS = (GAS bf16*)(ws + WS_YSLOT);
        const int c8 = u.pn * BM + wc * 32 + 8 * fq;
        const LAS float* bp = (const LAS float*)buf + wc * 32 + 8 * fq;
        f32x4 bv[2][2];
#pragma unroll
        for (int bj = 0; bj < 2; ++bj) { bv[bj][0] = *(const LAS f32x4*)(bp + bj * HALF); bv[bj][1] = *(const LAS f32x4*)(bp + bj * HALF + 4); }
#pragma unroll
        for (int ai = 0; ai < 2; ++ai)
#pragma unroll
            for (int m = 0; m < 4; ++m) { const int r = ai * HALF + wr * 64 + m * 16 + fr;
                if (r < u.cnt) {
                    const int dst = ((const LAS int*)(buf + 1024))[r]; const float gt = ((const LAS float*)(buf + 2048))[r];
#if YS_FP8
                    GAS unsigned char* rowp = (GAS unsigned char*)YS + (size_t)dst * DM + c8;
#pragma unroll
                    for (int bj = 0; bj < 2; ++bj) { const f32x4 v0 = (acc[ai][bj][m][0] * DN_DESCALE + bv[bj][0]) * (gt * 64.0f), v1 = (acc[ai][bj][m][1] * DN_DESCALE + bv[bj][1]) * (gt * 64.0f);
                        v2u w; w.x = pk4_fp8(v0[0], v0[1], v0[2], v0[3]); w.y = pk4_fp8(v1[0], v1[1], v1[2], v1[3]);
                        *(GAS v2u*)(rowp + bj * HALF) = w; } } }
#else
                    GAS bf16* rowp = YS + (size_t)dst * DM + c8;
#pragma unroll
                    for (int bj = 0; bj < 2; ++bj) { const f32x4 v0 = (acc[ai][bj][m][0] * DN_DESCALE + bv[bj][0]) * gt, v1 = (acc[ai][bj][m][1] * DN_DESCALE + bv[bj][1]) * gt;
                        v4u w; w.x = cvt_pk_bf16(v0[0], v0[1]); w.y = cvt_pk_bf16(v0[2], v0[3]); w.z = cvt_pk_bf16(v1[0], v1[1]); w.w = cvt_pk_bf16(v1[2], v1[3]);
                        *(GAS v4u*)(rowp + bj * HALF) = w; } } }
#endif
    }
};
}

typedef short s16x4 __attribute__((ext_vector_type(4)));
typedef __bf16 bf16x2_t __attribute__((ext_vector_type(2)));
__device__ __forceinline__ unsigned cvtpk(float lo, float hi) { f32x2 v = {lo, hi}; bf16x2_t b = __builtin_convertvector(v, bf16x2_t); return __builtin_bit_cast(unsigned, b); }
__device__ __forceinline__ s16x4 tr_read(const LAS unsigned char* p) { return __builtin_bit_cast(s16x4, __builtin_amdgcn_ds_read_tr16_b64_v4i16((LAS s16x4*)p)); }
__device__ __forceinline__ bf16x8 cat8(s16x4 lo, s16x4 hi) { return __builtin_shufflevector(lo, hi, 0, 1, 2, 3, 4, 5, 6, 7); }
__device__ __forceinline__ bf16x8 pack8(const f32x4& a, const f32x4& b) { v4u p; p.x = cvtpk(a[0], a[1]); p.y = cvtpk(a[2], a[3]); p.z = cvtpk(b[0], b[1]); p.w = cvtpk(b[2], b[3]); return __builtin_bit_cast(bf16x8, p); }
__device__ __forceinline__ s16x4 pack4(const f32x4& a) { v2u p; p.x = cvtpk(a[0], a[1]); p.y = cvtpk(a[2], a[3]); return __builtin_bit_cast(s16x4, p); }
#define LDS_BARRIER() do { asm volatile("s_waitcnt lgkmcnt(0)" ::: "memory"); __builtin_amdgcn_s_barrier(); asm volatile("" ::: "memory"); } while (0)
#define MFMA32(a, b, c) __builtin_amdgcn_mfma_f32_16x16x32_bf16((a), (b), (c), 0, 0, 0)
#define MFMA16(a, b, c) __builtin_amdgcn_mfma_f32_16x16x16bf16_1k((a), (b), (c), 0, 0, 0)

__device__ __forceinline__ void ret_fast(const int tid, LAS unsigned char* lds, const bf16* HB, bf16* OB) {
    constexpr int QP = 528, VP = 272, PP = 144;
    constexpr int OFF_Q = 0, OFF_K = 64 * QP, OFF_V = 2 * 64 * QP, OFF_P = OFF_V + 64 * VP;
    const int lane0 = tid & 63, w = __builtin_amdgcn_readfirstlane(tid >> 6);
    const int prow = tid >> 3, pc = tid & 7;
    for (int un0 = blockIdx.x; un0 < NBATCH * RT_HEADS * 4; un0 += gridDim.x) {
        const int un = (gridDim.x == 256) ? ((un0 & 7) * 32 + (un0 >> 3)) : un0;
        const int b = un >> 4, h = (un >> 2) & 3, vs = un & 3;
        const float l2g = __builtin_amdgcn_logf(1.0f - __builtin_amdgcn_exp2f(-5.0f - (float)h));
        const float dC = __builtin_amdgcn_exp2f(64.0f * l2g);
        f32x4 st[16];
#pragma unroll
        for (int i = 0; i < 16; ++i) st[i] = (f32x4){0.f, 0.f, 0.f, 0.f};
        const bf16* gbase = HB + (size_t)(b * SEQ + prow) * RT_IN;
        v4u pq[4], pk[4], pv[2];
#pragma unroll
        for (int j = 0; j < 4; ++j) { pq[j] = *(const v4u*)(gbase + h * 256 + (pc + 8 * j) * 8); pk[j] = *(const v4u*)(gbase + 1024 + h * 256 + (pc + 8 * j) * 8); }
#pragma unroll
        for (int j = 0; j < 2; ++j) pv[j] = *(const v4u*)(gbase + 2048 + h * 512 + vs * 128 + (pc + 8 * j) * 8);
#pragma unroll 1
        for (int ch = 0; ch < SEQ / 64; ++ch) {
            int lane = lane0; asm volatile("" : "+v"(lane));
            const int r = lane & 15, g = lane >> 4, q4 = (lane & 15) >> 2, p4 = lane & 3;
            LDS_BARRIER();
#pragma unroll
            for (int j = 0; j < 4; ++j) { *(LAS v4u*)(lds + OFF_Q + prow * QP + (pc + 8 * j) * 16) = pq[j]; *(LAS v4u*)(lds + OFF_K + prow * QP + (pc + 8 * j) * 16) = pk[j]; }
#pragma unroll
            for (int j = 0; j < 2; ++j) *(LAS v4u*)(lds + OFF_V + prow * VP + (pc + 8 * j) * 16) = pv[j];
            if (ch + 1 < SEQ / 64) {
                const bf16* gn = gbase + (size_t)(ch + 1) * 64 * RT_IN;
#pragma unroll
                for (int j = 0; j < 4; ++j) { pq[j] = *(const v4u*)(gn + h * 256 + (pc + 8 * j) * 8); pk[j] = *(const v4u*)(gn + 1024 + h * 256 + (pc + 8 * j) * 8); }
#pragma unroll
                for (int j = 0; j < 2; ++j) pv[j] = *(const v4u*)(gn + 2048 + h * 512 + vs * 128 + (pc + 8 * j) * 8);
            }
            LDS_BARRIER();
            {
                const int ct = w >> 1, st0 = 2 * (w & 1);
                f32x4 sa0 = {0.f, 0.f, 0.f, 0.f}, sa1 = {0.f, 0.f, 0.f, 0.f};
                const LAS unsigned char* qb = lds + OFF_Q + (16 * ct + r) * QP + g * 16;
                const LAS unsigned char* kb0 = lds + OFF_K + (16 * st0 + r) * QP + g * 16;
#pragma unroll
                for (int hb = 0; hb < 4; ++hb) {
                    bf16x8 qf[2], k0[2], k1[2];
#pragma unroll
                    for (int kk = 0; kk < 2; ++kk) { const int kb = hb * 2 + kk; qf[kk] = *(const LAS bf16x8*)(qb + kb * 64); k0[kk] = *(const LAS bf16x8*)(kb0 + kb * 64); k1[kk] = *(const LAS bf16x8*)(kb0 + 16 * QP + kb * 64); }
                    asm volatile("" : "+v"(qf[0]), "+v"(qf[1]), "+v"(k0[0]), "+v"(k0[1]), "+v"(k1[0]), "+v"(k1[1]) :: "memory");
#pragma unroll
                    for (int kk = 0; kk < 2; ++kk) { sa0 = MFMA32(k0[kk], qf[kk], sa0); sa1 = MFMA32(k1[kk], qf[kk], sa1); }
                }
                const int c = 16 * ct + r;
#pragma unroll
                for (int t = 0; t < 2; ++t) {
                    const f32x4 sa = t ? sa1 : sa0; const int s0 = 16 * (st0 + t) + 4 * g; float v[4];
#pragma unroll
                    for (int i = 0; i < 4; ++i) { const int d = c - (s0 + i); v[i] = d >= 0 ? sa[i] * __builtin_amdgcn_exp2f((float)d * l2g) : 0.f; }
                    v2u pw; pw.x = cvtpk(v[0], v[1]); pw.y = cvtpk(v[2], v[3]);
                    *(LAS v2u*)(lds + OFF_P + c * PP + s0 * 2) = pw;
                }
            }
            LDS_BARRIER();
            f32x4 o[4];
#pragma unroll
            for (int ct = 0; ct < 4; ++ct) o[ct] = (f32x4){0.f, 0.f, 0.f, 0.f};
            {
                s16x4 ql[2][4], qh[2][4];
                const LAS unsigned char* qp0 = lds + OFF_Q + r * QP + (4 * g) * 2;
#pragma unroll
                for (int ct = 0; ct < 4; ++ct) { ql[0][ct] = *(const LAS s16x4*)(qp0 + ct * 16 * QP); qh[0][ct] = *(const LAS s16x4*)(qp0 + ct * 16 * QP + 32); }
#pragma unroll
                for (int kb = 0; kb < 8; ++kb) {
                    const int cu = kb & 1, nx = cu ^ 1;
                    if (kb + 1 < 8) {
#pragma unroll
                        for (int ct = 0; ct < 4; ++ct) { ql[nx][ct] = *(const LAS s16x4*)(qp0 + ct * 16 * QP + (kb + 1) * 64); qh[nx][ct] = *(const LAS s16x4*)(qp0 + ct * 16 * QP + (kb + 1) * 64 + 32); }
                    }
                    asm volatile("" : "+v"(ql[cu][0]), "+v"(ql[cu][1]), "+v"(ql[cu][2]), "+v"(ql[cu][3]), "+v"(qh[cu][0]), "+v"(qh[cu][1]), "+v"(qh[cu][2]), "+v"(qh[cu][3]) :: "memory");
                    const bf16x8 sa = pack8(st[2 * kb], st[2 * kb + 1]);
#pragma unroll
                    for (int ct = 0; ct < 4; ++ct) o[ct] = MFMA32(sa, cat8(ql[cu][ct], qh[cu][ct]), o[ct]);
                }
            }
            bf16x8 vf[2], pf[6];
            {
                s16x4 t0[2], t1[2];
#pragma unroll
                for (int sb = 0; sb < 2; ++sb) { const LAS unsigned char* vp = lds + OFF_V + (32 * sb + 8 * g + q4) * VP + (16 * w + 4 * p4) * 2; t0[sb] = tr_read(vp); t1[sb] = tr_read(vp + 4 * VP); }
                pf[0] = *(const LAS bf16x8*)(lds + OFF_P + (0 + r) * PP + (8 * g) * 2);
                pf[1] = *(const LAS bf16x8*)(lds + OFF_P + (16 + r) * PP + (8 * g) * 2);
                pf[2] = *(const LAS bf16x8*)(lds + OFF_P + (32 + r) * PP + (8 * g) * 2);
                pf[3] = *(const LAS bf16x8*)(lds + OFF_P + (32 + r) * PP + (32 + 8 * g) * 2);
                pf[4] = *(const LAS bf16x8*)(lds + OFF_P + (48 + r) * PP + (8 * g) * 2);
                pf[5] = *(const LAS bf16x8*)(lds + OFF_P + (48 + r) * PP + (32 + 8 * g) * 2);
                asm volatile("" : "+v"(t0[0]), "+v"(t0[1]), "+v"(t1[0]), "+v"(t1[1]), "+v"(pf[0]), "+v"(pf[1]), "+v"(pf[2]), "+v"(pf[3]), "+v"(pf[4]), "+v"(pf[5]) :: "memory");
                vf[0] = cat8(t0[0], t1[0]); vf[1] = cat8(t0[1], t1[1]);
            }
#pragma unroll
            for (int ct = 0; ct < 4; ++ct) o[ct] = o[ct] * __builtin_amdgcn_exp2f((float)(16 * ct + r + 1) * l2g);
            o[0] = MFMA32(vf[0], pf[0], o[0]); o[1] = MFMA32(vf[0], pf[1], o[1]);
            o[2] = MFMA32(vf[0], pf[2], o[2]); o[2] = MFMA32(vf[1], pf[3], o[2]);
            o[3] = MFMA32(vf[0], pf[4], o[3]); o[3] = MFMA32(vf[1], pf[5], o[3]);
            {
                bf16* ob = OB + (size_t)(b * SEQ + ch * 64 + r) * RT_VD + h * 512 + vs * 128 + 16 * w + 4 * g;
#pragma unroll
                for (int ct = 0; ct < 4; ++ct) { v2u ow; ow.x = cvtpk(o[ct][0], o[ct][1]); ow.y = cvtpk(o[ct][2], o[ct][3]); *(v2u*)(ob + (size_t)ct * 16 * RT_VD) = ow; }
            }
            bf16x8 vz[2];
#pragma unroll
            for (int sb = 0; sb < 2; ++sb) {
                const v4u raw = __builtin_bit_cast(v4u, vf[sb]); float f[8] = {bflo(raw.x), bfhi(raw.x), bflo(raw.y), bfhi(raw.y), bflo(raw.z), bfhi(raw.z), bflo(raw.w), bfhi(raw.w)};
#pragma unroll
                for (int j = 0; j < 8; ++j) f[j] *= __builtin_amdgcn_exp2f((float)(63 - (32 * sb + 8 * g + j)) * l2g);
                v4u z; z.x = cvtpk(f[0], f[1]); z.y = cvtpk(f[2], f[3]); z.z = cvtpk(f[4], f[5]); z.w = cvtpk(f[6], f[7]); vz[sb] = __builtin_bit_cast(bf16x8, z);
            }
            {
                const LAS unsigned char* kp0 = lds + OFF_K + (8 * g + q4) * QP + (4 * p4) * 2;
#pragma unroll
                for (int kq = 0; kq < 4; ++kq) {
                    s16x4 ka[4][2], kbh[4][2];
#pragma unroll
                    for (int j = 0; j < 4; ++j)
#pragma unroll
                        for (int sb = 0; sb < 2; ++sb) { const LAS unsigned char* kp = kp0 + (32 * sb) * QP + (16 * (kq * 4 + j)) * 2; ka[j][sb] = tr_read(kp); kbh[j][sb] = tr_read(kp + 4 * QP); }
                    asm volatile("" : "+v"(ka[0][0]), "+v"(ka[0][1]), "+v"(ka[1][0]), "+v"(ka[1][1]), "+v"(ka[2][0]), "+v"(ka[2][1]), "+v"(ka[3][0]), "+v"(ka[3][1]),
                                      "+v"(kbh[0][0]), "+v"(kbh[0][1]), "+v"(kbh[1][0]), "+v"(kbh[1][1]), "+v"(kbh[2][0]), "+v"(kbh[2][1]), "+v"(kbh[3][0]), "+v"(kbh[3][1]) :: "memory");
#pragma unroll
                    for (int j = 0; j < 4; ++j) { const int kt = kq * 4 + j;
                        st[kt] = st[kt] * dC;
                        st[kt] = MFMA32(cat8(ka[j][0], kbh[j][0]), vz[0], st[kt]);
                        st[kt] = MFMA32(cat8(ka[j][1], kbh[j][1]), vz[1], st[kt]); }
                }
            }
        }
        LDS_BARRIER();
    }
}

__device__ __forceinline__ void hgrn_fast(const int tid, LAS unsigned char* lds, const bf16* QD, const bf16* KI, const bf16* GG, const bf16* VV, const float* DEC, const float* ng, bf16* A2, float* SS) {
    constexpr int TP = 272;
    constexpr int OFF_QD = 0, OFF_KI = 64 * TP, OFF_G = 2 * 64 * TP, OFF_V = 3 * 64 * TP, OFF_DEC = 4 * 64 * TP, OFF_SS = OFF_DEC + 2048;
    const int lane = tid & 63, w = __builtin_amdgcn_readfirstlane(tid >> 6), r = lane & 15, g = lane >> 4, q4 = (lane & 15) >> 2, p4 = lane & 3;
    const int prow = tid >> 3, pc = tid & 7;
    for (int un = blockIdx.x; un < NBATCH * HG_HEADS; un += gridDim.x) {
        const int b = un >> 3, h = un & 7;
        f32x4 st[8];
#pragma unroll
        for (int i = 0; i < 8; ++i) st[i] = (f32x4){0.f, 0.f, 0.f, 0.f};
        const f32x4 ng4 = *(const f32x4*)(ng + h * 128 + 16 * w + 4 * g);
        const size_t goff = (size_t)(b * SEQ + prow) * DM + h * 128;
        v4u p0[2], p1[2], p2[2], p3[2]; f32x4 pd = {0.f, 0.f, 0.f, 0.f};
#pragma unroll
        for (int j = 0; j < 2; ++j) { const size_t o = goff + (pc + 8 * j) * 8; p0[j] = *(const v4u*)(QD + o); p1[j] = *(const v4u*)(KI + o); p2[j] = *(const v4u*)(GG + o); p3[j] = *(const v4u*)(VV + o); }
        if (tid < 128) pd = *(const f32x4*)(DEC + (size_t)((b * SEQ) / 16 + (tid >> 5)) * DM + h * 128 + (tid & 31) * 4);
#pragma unroll 1
        for (int rd = 0; rd < SEQ / 64; ++rd) {
            LDS_BARRIER();
            if (rd > 0 && tid < 64) {
                float s = 0.f;
#pragma unroll
                for (int ww = 0; ww < 8; ++ww) s += *(const LAS float*)(lds + OFF_SS + (ww * 64 + tid) * 4);
                SS[(size_t)h * NTOK + (size_t)b * SEQ + (rd - 1) * 64 + tid] = s;
            }
#pragma unroll
            for (int j = 0; j < 2; ++j) { const int lo = prow * TP + (pc + 8 * j) * 16; *(LAS v4u*)(lds + OFF_QD + lo) = p0[j]; *(LAS v4u*)(lds + OFF_KI + lo) = p1[j]; *(LAS v4u*)(lds + OFF_G + lo) = p2[j]; *(LAS v4u*)(lds + OFF_V + lo) = p3[j]; }
            if (tid < 128) *(LAS f32x4*)(lds + OFF_DEC + tid * 16) = pd;
            if (rd + 1 < SEQ / 64) {
                const size_t gn = goff + (size_t)(rd + 1) * 64 * DM;
#pragma unroll
                for (int j = 0; j < 2; ++j) { const size_t o = gn + (pc + 8 * j) * 8; p0[j] = *(const v4u*)(QD + o); p1[j] = *(const v4u*)(KI + o); p2[j] = *(const v4u*)(GG + o); p3[j] = *(const v4u*)(VV + o); }
                if (tid < 128) pd = *(const f32x4*)(DEC + (size_t)((b * SEQ + (rd + 1) * 64) / 16 + (tid >> 5)) * DM + h * 128 + (tid & 31) * 4);
            }
            LDS_BARRIER();
#pragma unroll 1
            for (int cc = 0; cc < 4; ++cc) {
                s16x4 ql[4], qh[4], kl[4], kh[4], ktr[8]; f32x4 d4[8];
#pragma unroll
                for (int kb = 0; kb < 4; ++kb) {
                    const int off = (16 * cc + r) * TP + (32 * kb + 4 * g) * 2;
                    ql[kb] = *(const LAS s16x4*)(lds + OFF_QD + off); qh[kb] = *(const LAS s16x4*)(lds + OFF_QD + off + 32);
                    kl[kb] = *(const LAS s16x4*)(lds + OFF_KI + off); kh[kb] = *(const LAS s16x4*)(lds + OFF_KI + off + 32);
                }
                s16x4 vfr = tr_read(lds + OFF_V + (16 * cc + 4 * g + q4) * TP + (16 * w + 4 * p4) * 2);
                s16x4 gfr = *(const LAS s16x4*)(lds + OFF_G + (16 * cc + r) * TP + (16 * w + 4 * g) * 2);
#pragma unroll
                for (int kt = 0; kt < 8; ++kt) {
                    d4[kt] = *(const LAS f32x4*)(lds + OFF_DEC + cc * 512 + (16 * kt + 4 * g) * 4);
                    ktr[kt] = tr_read(lds + OFF_KI + (16 * cc + 4 * g + q4) * TP + (16 * kt + 4 * p4) * 2);
                }
                asm volatile("" : "+v"(ql[0]), "+v"(ql[1]), "+v"(ql[2]), "+v"(ql[3]), "+v"(qh[0]), "+v"(qh[1]), "+v"(qh[2]), "+v"(qh[3]),
                                  "+v"(kl[0]), "+v"(kl[1]), "+v"(kl[2]), "+v"(kl[3]), "+v"(kh[0]), "+v"(kh[1]), "+v"(kh[2]), "+v"(kh[3]), "+v"(vfr), "+v"(gfr));
                asm volatile("" : "+v"(ktr[0]), "+v"(ktr[1]), "+v"(ktr[2]), "+v"(ktr[3]), "+v"(ktr[4]), "+v"(ktr[5]), "+v"(ktr[6]), "+v"(ktr[7]),
                                  "+v"(d4[0]), "+v"(d4[1]), "+v"(d4[2]), "+v"(d4[3]), "+v"(d4[4]), "+v"(d4[5]), "+v"(d4[6]), "+v"(d4[7]));
                bf16x8 qf[4];
#pragma unroll
                for (int kb = 0; kb < 4; ++kb) qf[kb] = cat8(ql[kb], qh[kb]);
                f32x4 sc = {0.f, 0.f, 0.f, 0.f}, oa = {0.f, 0.f, 0.f, 0.f};
#pragma unroll
                for (int kb = 0; kb < 4; ++kb) sc = MFMA32(cat8(kl[kb], kh[kb]), qf[kb], sc);
#pragma unroll
                for (int kb = 0; kb < 4; ++kb) oa = MFMA32(pack8(st[2 * kb], st[2 * kb + 1]), qf[kb], oa);
#pragma unroll
                for (int kt = 0; kt < 8; ++kt) st[kt] = MFMA16(ktr[kt], vfr, st[kt]) * d4[kt];
#pragma unroll
                for (int i = 0; i < 4; ++i) sc[i] = (4 * g + i <= r) ? sc[i] : 0.f;
                oa = MFMA16(vfr, pack4(sc), oa);
                { const v2u gr = __builtin_bit_cast(v2u, gfr);
                  v2u ow; ow.x = cvtpk(oa[0] * ng4[0] * bflo(gr.x), oa[1] * ng4[1] * bfhi(gr.x)); ow.y = cvtpk(oa[2] * ng4[2] * bflo(gr.y), oa[3] * ng4[3] * bfhi(gr.y));
                  *(v2u*)(A2 + (size_t)(b * SEQ + rd * 64 + cc * 16 + r) * DM + h * 128 + 16 * w + 4 * g) = ow;
                  float p = (oa[0] * oa[0] + oa[1] * oa[1]) + (oa[2] * oa[2] + oa[3] * oa[3]);
                  p += __shfl_xor(p, 16); p += __shfl_xor(p, 32);
                  if (lane < 16) *(LAS float*)(lds + OFF_SS + (w * 64 + cc * 16 + r) * 4) = p; }
            }
        }
        LDS_BARRIER();
        if (tid < 64) { float s = 0.f;
#pragma unroll
            for (int ww = 0; ww < 8; ++ww) s += *(const LAS float*)(lds + OFF_SS + (ww * 64 + tid) * 4);
            SS[(size_t)h * NTOK + (size_t)b * SEQ + (SEQ / 64 - 1) * 64 + tid] = s; }
        LDS_BARRIER();
    }
}

struct Args { const float* in[17]; float* out; unsigned char* ws; int ph_lo, ph_hi; };
enum { I_X = 0, I_HWIN, I_HNG, I_HWOUT, I_LB, I_RWIN, I_RWOUT, I_LNMG, I_LNMB, I_LNFG, I_LNFB, I_RW, I_RB, I_WGU, I_BGU, I_WDN, I_BDN };

__device__ __forceinline__ int dest_row(int mode, int n) {
    if (mode == 1) { if (n < 1024) return ((n >> 7) << 8) + (n & 127); if (n < 2048) { const int q = n - 1024; return ((q >> 7) << 8) + 128 + (q & 127); } return n; }
    if (mode == 2) { const int j2 = n >> 1; return ((j2 >> 7) << 8) + ((n & 1) << 7) + (j2 & 127); }
    return n;
}
__device__ __forceinline__ void transpose_item(const float* W, int K, int N, bf16* WT, int mode, LAS float* scr, int item, int lane) {
    const int nblk = N / 64, kb = item / nblk, nb = item % nblk, k0 = 64 * kb, n0 = 64 * nb;
#pragma unroll 4
    for (int i = 0; i < 16; ++i) { const int kk = 4 * i + (lane >> 4), c4 = (lane & 15) * 4;
        const f32x4 v = *(const GAS f32x4*)(W + (size_t)(k0 + kk) * N + n0 + c4);
        LAS float* s = scr + kk * 65 + c4; s[0] = v[0]; s[1] = v[1]; s[2] = v[2]; s[3] = v[3]; }
    LDS_WAIT(); asm volatile("" ::: "memory");
    const int c = lane & 7;
#pragma unroll 2
    for (int j = 0; j < 8; ++j) { const int n = (lane >> 3) + 8 * j; const LAS float* s = scr + (8 * c) * 65 + n;
        v4u o; o.x = pk2(s[0 * 65], s[1 * 65]); o.y = pk2(s[2 * 65], s[3 * 65]); o.z = pk2(s[4 * 65], s[5 * 65]); o.w = pk2(s[6 * 65], s[7 * 65]);
        *(GAS v4u*)(WT + (size_t)dest_row(mode, n0 + n) * K + k0 + 8 * c) = o; }
    LDS_WAIT(); asm volatile("" ::: "memory");
}

__device__ __forceinline__ void transpose_item_fp8(const float* W, int K, int N, unsigned char* WT, int mode, float scale, LAS float* scr, int item, int lane) {
    const int nblk = N / 64, kb = item / nblk, nb = item % nblk, k0 = 64 * kb, n0 = 64 * nb;
#pragma unroll 4
    for (int i = 0; i < 16; ++i) { const int kk = 4 * i + (lane >> 4), c4 = (lane & 15) * 4;
        const f32x4 v = *(const GAS f32x4*)(W + (size_t)(k0 + kk) * N + n0 + c4);
        LAS float* s = scr + kk * 65 + c4; s[0] = v[0]; s[1] = v[1]; s[2] = v[2]; s[3] = v[3]; }
    LDS_WAIT(); asm volatile("" ::: "memory");
    const int c = lane & 7;
#pragma unroll 2
    for (int j = 0; j < 8; ++j) { const int n = (lane >> 3) + 8 * j; const LAS float* s = scr + (8 * c) * 65 + n;
        v2u o; o.x = pk4_fp8(s[0 * 65] * scale, s[1 * 65] * scale, s[2 * 65] * scale, s[3 * 65] * scale); o.y = pk4_fp8(s[4 * 65] * scale, s[5 * 65] * scale, s[6 * 65] * scale, s[7 * 65] * scale);
        *(GAS v2u*)(WT + (size_t)dest_row(mode, n0 + n) * K + k0 + 8 * c) = o; }
    LDS_WAIT(); asm volatile("" ::: "memory");
}

#ifndef SITE_MASK
#define SITE_MASK 0xffff
#endif
#define SITE(n) (((SITE_MASK) >> (n)) & 1)
#ifndef PROBE_MASK
#define PROBE_MASK 0
#endif
#define REP(n) (1 + (((PROBE_MASK) >> (n)) & 1))
typedef const __attribute__((address_space(4))) Args* KArgs;
__device__ __forceinline__ int otid(int wave0) { int l; asm volatile("v_mbcnt_lo_u32_b32 %0, -1, 0\n\tv_mbcnt_hi_u32_b32 %0, -1, %0" : "=v"(l)); asm volatile("" : "+s"(wave0)); return wave0 * 64 + l; }
__device__ __forceinline__ LAS unsigned char* olds(LAS unsigned char* p) { asm volatile("" : "+s"(p)); return p; }
__device__ __forceinline__ KArgs kargs() { KArgs p = (KArgs)__builtin_amdgcn_kernarg_segment_ptr(); asm volatile("" : "+s"(p)); return p; }
#define IN(k) (ap->ph_lo <= (k) && (k) < ap->ph_hi)
#ifndef PROBE_BAR
#define PROBE_BAR 1
#endif
#define GRID_BAR() for (int _r = 0; _r < PROBE_BAR; ++_r) do { if (ap->ph_hi - ap->ph_lo > 1) { XcdBarrier _b; _b.bar = (unsigned*)(ap->ws + WS_CTL) + CW_BAR; _b.x = xb_xcc_id(); _b.st = (volatile LAS unsigned*)(lds + MISC_OFF + MO_BARW); xcd_barrier(_b); } } while (0)
#define VCU() ((gridDim.x % 8 == 0) ? (int)((blockIdx.x % 8) * (gridDim.x / 8) + blockIdx.x / 8) : (int)blockIdx.x)

__global__ void __launch_bounds__(512, 2) mk_fwd(Args args_unused) {
    extern __shared__ __attribute__((aligned(16))) unsigned char lds_raw[];
    LAS unsigned char* const lds0 = (LAS unsigned char*)lds_raw;
    const int wave0 = __builtin_amdgcn_readfirstlane((int)(threadIdx.x >> 6));
    {
        LAS unsigned char* lds = lds0;
        for (int u = threadIdx.x; u < (LDS_BYTES - MISC_OFF) / 4; u += 512) ((LAS unsigned*)(lds + MISC_OFF))[u] = 0u;
        __syncthreads();
        KArgs ap = kargs();
        if (ap->ph_hi - ap->ph_lo > 1) (void)xcd_barrier_post((unsigned*)(ap->ws + WS_CTL) + CW_BAR, (volatile LAS unsigned*)(lds + MISC_OFF + MO_BARW));
    }

#if SITE(0)
    { KArgs ap = kargs(); const int tid = otid(wave0); LAS unsigned char* lds = olds(lds0); (void)tid;
    if (IN(0)) for (int rep_ = 0; rep_ < REP(0); ++rep_) {
        const int lane = tid & 63, wave = __builtin_amdgcn_readfirstlane(tid >> 6), G = gridDim.x, vcu = VCU(), gw = vcu * 8 + wave, NGW = G * 8;
        unsigned char* ws = ap->ws;
        LAS float* scr = (LAS float*)(lds + wave * 16640);
        constexpr int I_HIN = 2 * 16 * 64, I_HOUT = 2 * 16 * 16, I_RIN = 2 * 16 * 96, I_ROUT = 2 * 32 * 16, I_GU = 128 * 16 * 32, I_DN = 128 * 16 * 16;
        constexpr int NITEMS = I_HIN + I_HOUT + I_RIN + I_ROUT + I_GU + I_DN;
        for (int it = gw; it < NITEMS; it += NGW) {
            int r = it;
            if (r < I_HIN) { const int j = r / (16 * 64); transpose_item(ap->in[I_HWIN] + (size_t)j * DM * HG_IN, DM, HG_IN, (bf16*)(ws + WS_W_HIN) + (size_t)j * HG_IN * DM, 1, scr, r % (16 * 64), lane); continue; } r -= I_HIN;
            if (r < I_HOUT) { const int j = r / 256; transpose_item(ap->in[I_HWOUT] + (size_t)j * DM * DM, DM, DM, (bf16*)(ws + WS_W_HOUT) + (size_t)j * DM * DM, 0, scr, r % 256, lane); continue; } r -= I_HOUT;
            if (r < I_RIN) { const int j = r / (16 * 96); transpose_item(ap->in[I_RWIN] + (size_t)j * DM * RT_IN, DM, RT_IN, (bf16*)(ws + WS_W_RIN) + (size_t)j * RT_IN * DM, 0, scr, r % (16 * 96), lane); continue; } r -= I_RIN;
            if (r < I_ROUT) { const int j = r / 512; transpose_item(ap->in[I_RWOUT] + (size_t)j * RT_VD * DM, RT_VD, DM, (bf16*)(ws + WS_W_ROUT) + (size_t)j * DM * RT_VD, 0, scr, r % 512, lane); continue; } r -= I_ROUT;
#if MOE_FP8
            if (r < I_GU) { const int j = r / 512; transpose_item_fp8(ap->in[I_WGU] + (size_t)j * DM * 2048, DM, 2048, ws + WS_W_GU + (size_t)j * 2048 * DM, 2, WGU_SCALE, scr, r % 512, lane); continue; } r -= I_GU;
            { const int j = r / 256; transpose_item_fp8(ap->in[I_WDN] + (size_t)j * DM * DM, DM, DM, ws + WS_W_DN + (size_t)j * DM * DM, 0, WDN_SCALE, scr, r % 256, lane); }
#else
            if (r < I_GU) { const int j = r / 512; transpose_item(ap->in[I_WGU] + (size_t)j * DM * 2048, DM, 2048, (bf16*)(ws + WS_W_GU) + (size_t)j * 2048 * DM, 2, scr, r % 512, lane); continue; } r -= I_GU;
            { const int j = r / 256; transpose_item(ap->in[I_WDN] + (size_t)j * DM * DM, DM, DM, (bf16*)(ws + WS_W_DN) + (size_t)j * DM * DM, 0, scr, r % 256, lane); }
#endif
        }
        const int gt = vcu * 512 + tid, NGT = G * 512;
        float* LBS = (float*)(ws + WS_LBS); float* BGU = (float*)(ws + WS_BGU); float* ROT = (float*)(ws + WS_ROT); bf16* XB = (bf16*)(ws + WS_XB);
        for (int d = gt; d < DM; d += NGT) { const float* lbp = ap->in[I_LB]; const float v0 = lbp[d], v1 = lbp[DM + d], v2 = lbp[2 * DM + d], v3 = lbp[3 * DM + d]; const float mx = fmaxf(fmaxf(v0, v1), fmaxf(v2, v3));
            const float e0 = __expf(v0 - mx), e1 = __expf(v1 - mx), e2 = __expf(v2 - mx), e3 = __expf(v3 - mx), is = 1.0f / (e0 + e1 + e2 + e3);
            LBS[d] = 0.f; LBS[DM + d] = e1 * is; LBS[2 * DM + d] = (e1 + e2) * is; LBS[3 * DM + d] = (e1 + e2 + e3) * is; }
        for (int i = gt; i < SEQ * 128; i += NGT) { const int pos = i >> 7, p = i & 127; const float inv = 1.0f / __builtin_amdgcn_exp2f(13.287712379549449f * ((float)p / 127.0f)); const float th = (float)pos * inv;
            double rev = (double)th * 0.15915494309189535; rev -= floor(rev); const float fr = (float)rev; ROT[2 * i] = __builtin_amdgcn_cosf(fr); ROT[2 * i + 1] = __builtin_amdgcn_sinf(fr); }
        for (int i = gt; i < 4 * DM * NE; i += NGT) { const int l = i >> 15, d = (i >> 5) & 1023, e = i & 31; const float wv = ap->in[I_RW][i]; const unsigned hb = f2bf(wv); const float hv = __builtin_bit_cast(float, hb << 16);
            ((bf16*)(ws + WS_WRH))[(size_t)l * 32768 + e * 1024 + d] = (bf16)hb; ((bf16*)(ws + WS_WRL))[(size_t)l * 32768 + e * 1024 + d] = (bf16)f2bf(wv - hv); }
        for (int i = gt; i < 4 * 32 * 2048; i += NGT) { const int le = i >> 11, n = i & 2047; BGU[(size_t)le * 2048 + dest_row(2, n)] = ap->in[I_BGU][i]; }
        for (size_t i = (size_t)gt; i < (size_t)NTOK * DM / 4; i += NGT) { const f32x4 v = ((const f32x4*)ap->in[I_X])[i]; v2u o; o.x = pk2(v[0], v[1]); o.y = pk2(v[2], v[3]); ((v2u*)XB)[i] = o; }
        GRID_BAR();
    } }
#endif

#pragma unroll 1
    for (int L = 0; L < DEPTH; ++L) {
        const int pb = 1 + 8 * L;
        if ((L & 1) == 0) {
#if SITE(1)
            { KArgs ap = kargs(); const int tid = otid(wave0); LAS unsigned char* lds = olds(lds0); (void)tid;
            if (IN(pb + 0)) for (int rep_ = 0; rep_ < REP(1); ++rep_) {
                unsigned char* ws = ap->ws; const int j = L >> 1;
                LAS int* ul = (LAS int*)(lds + MISC_OFF + MO_ULIST);
                pg8::build_units_dense(tid, ul, NTOK / 256, HG_IN / 256, DM * 2);
                pg8::EpiHgrnIn E{ws, L};
                pg8::gemm_phase<pg8::EpiHgrnIn, false, true, false>(tid, lds, ul, (LAS int*)(lds + MISC_OFF + MO_GTAB), (const char*)(ws + WS_XB), (const char*)((bf16*)(ws + WS_W_HIN) + (size_t)j * HG_IN * DM), nullptr, DM * 2, E, lds + MISC_OFF + MO_GTAB);
                GRID_BAR();
            } }
#endif
#if SITE(2)
            { KArgs ap = kargs(); const int tid = otid(wave0); LAS unsigned char* lds = olds(lds0); (void)tid;
            if (IN(pb + 1)) for (int rep_ = 0; rep_ < REP(2); ++rep_) {
#if !SLOW_HGRN
                { unsigned char* ws = ap->ws; const bf16* QD = (const bf16*)(ws + WS_H);
                  hgrn_fast(tid, lds, QD, QD + (size_t)NTOK * DM, QD + 4 * (size_t)NTOK * DM, QD + 3 * (size_t)NTOK * DM, (const float*)(ws + WS_DEC), ap->in[I_HNG] + (L >> 1) * DM,
                            (bf16*)(ws + WS_A2), (float*)(ws + WS_SSP)); }
#else
                unsigned char* ws = ap->ws; const bf16* QD = (const bf16*)(ws + WS_H); const bf16* KI = QD + (size_t)NTOK * DM; const bf16* KS = QD + 2 * (size_t)NTOK * DM; const bf16* VV = QD + 3 * (size_t)NTOK * DM; bf16* OB = (bf16*)(ws + WS_O);
                LAS float* qf = (LAS float*)lds; LAS float* kf = qf + 16 * 4 * 36; LAS float* ff = kf + 16 * 4 * 36; LAS float* vf = ff + 16 * 4 * 36;
                for (int un = blockIdx.x; un < NBATCH * HG_HEADS; un += gridDim.x) {
                    const int b = un >> 3, h = un & 7; const int vc = tid >> 2, kq = tid & 3;
                    float st[32];
#pragma unroll
                    for (int i = 0; i < 32; ++i) st[i] = 0.f;
                    for (int t0 = 0; t0 < SEQ; t0 += 16) {
                        __syncthreads();
                        for (int e = tid; e < 16 * 128; e += 512) { const int tt = e >> 7, k = e & 127; const size_t gi = (size_t)(b * SEQ + t0 + tt) * DM + h * 128 + k; const int li = tt * 144 + (k & 3) * 36 + (k >> 2);
                            qf[li] = bf1(QD[gi]); kf[li] = bf1(KI[gi]); ff[li] = bf1(KS[gi]); vf[tt * 128 + k] = bf1(VV[gi]); }
                        __syncthreads();
                        for (int tt = 0; tt < 16; ++tt) {
                            const float v = vf[tt * 128 + vc]; float a = 0.f; const int lb = tt * 144 + kq * 36;
#pragma unroll
                            for (int i = 0; i < 32; ++i) { st[i] = ff[lb + i] * st[i] + kf[lb + i] * v; a += qf[lb + i] * st[i]; }
                            a += __shfl_xor(a, 1); a += __shfl_xor(a, 2);
                            if (kq == 0) OB[(size_t)(b * SEQ + t0 + tt) * DM + h * 128 + vc] = (bf16)f2bf(a);
                        }
                    }
                }
#endif
                GRID_BAR();
            } }
#endif
#if SITE(3) && SLOW_HGRN
            { KArgs ap = kargs(); const int tid = otid(wave0); LAS unsigned char* lds = olds(lds0); (void)tid;
            if (IN(pb + 2)) for (int rep_ = 0; rep_ < REP(3); ++rep_) {
                const int lane = tid & 63, wave = __builtin_amdgcn_readfirstlane(tid >> 6), gw = VCU() * 8 + wave, NGW = gridDim.x * 8;
                unsigned char* ws = ap->ws; const bf16* OB = (const bf16*)(ws + WS_O); const bf16* GG = (const bf16*)(ws + WS_H) + 4 * (size_t)NTOK * DM; bf16* A2 = (bf16*)(ws + WS_A2);
                const float* ng = ap->in[I_HNG] + (L >> 1) * DM;
                f32x4 g4[4];
#pragma unroll
                for (int q = 0; q < 4; ++q) g4[q] = *(const f32x4*)(ng + 256 * q + 4 * lane);
                v2u on[4], gn[4];
#pragma unroll
                for (int q = 0; q < 4; ++q) { on[q] = *(const v2u*)(OB + (size_t)gw * DM + 256 * q + 4 * lane); gn[q] = *(const v2u*)(GG + (size_t)gw * DM + 256 * q + 4 * lane); }
#pragma unroll 1
                for (int row = gw; row < NTOK; row += NGW) {
                    v2u oc[4], gc[4];
#pragma unroll
                    for (int q = 0; q < 4; ++q) { oc[q] = on[q]; gc[q] = gn[q]; }
                    if (row + NGW < NTOK) {
#pragma unroll
                        for (int q = 0; q < 4; ++q) { on[q] = *(const v2u*)(OB + (size_t)(row + NGW) * DM + 256 * q + 4 * lane); gn[q] = *(const v2u*)(GG + (size_t)(row + NGW) * DM + 256 * q + 4 * lane); } }
                    float o[16]; float ss = 0.f;
#pragma unroll
                    for (int q = 0; q < 4; ++q) { o[4 * q] = bflo(oc[q].x); o[4 * q + 1] = bfhi(oc[q].x); o[4 * q + 2] = bflo(oc[q].y); o[4 * q + 3] = bfhi(oc[q].y); }
#pragma unroll
                    for (int i = 0; i < 16; ++i) ss += o[i] * o[i];
                    const float rs = 1.0f / sqrtf(wave_sum(ss) * (1.0f / DM) + RMS_EPS);
#pragma unroll
                    for (int q = 0; q < 4; ++q) {
                        v2u w; w.x = pk2(o[4 * q] * rs * g4[q][0] * bflo(gc[q].x), o[4 * q + 1] * rs * g4[q][1] * bfhi(gc[q].x)); w.y = pk2(o[4 * q + 2] * rs * g4[q][2] * bflo(gc[q].y), o[4 * q + 3] * rs * g4[q][3] * bfhi(gc[q].y));
                        *(v2u*)(A2 + (size_t)row * DM + 256 * q + 4 * lane) = w; }
                }
                GRID_BAR();
            } }
#endif
        } else {
#if SITE(4)
            { KArgs ap = kargs(); const int tid = otid(wave0); LAS unsigned char* lds = olds(lds0); (void)tid;
            if (IN(pb + 0)) for (int rep_ = 0; rep_ < REP(4); ++rep_) {
                unsigned char* ws = ap->ws; const int j = L >> 1;
                LAS int* ul = (LAS int*)(lds + MISC_OFF + MO_ULIST);
                pg8::build_units_dense(tid, ul, NTOK / 256, RT_IN / 256, DM * 2);
                pg8::EpiRetIn E{ws};
                pg8::gemm_phase<pg8::EpiRetIn, false, true, false>(tid, lds, ul, (LAS int*)(lds + MISC_OFF + MO_GTAB), (const char*)(ws + WS_XB), (const char*)((bf16*)(ws + WS_W_RIN) + (size_t)j * RT_IN * DM), nullptr, DM * 2, E);
                GRID_BAR();
            } }
#endif
#if SITE(5)
            { KArgs ap = kargs(); const int tid = otid(wave0); LAS unsigned char* lds = olds(lds0); (void)tid;
            if (IN(pb + 1)) for (int rep_ = 0; rep_ < REP(5); ++rep_) {
#if !SLOW_RET
                { unsigned char* ws = ap->ws; ret_fast(tid, lds, (const bf16*)(ws + WS_H), (bf16*)(ws + WS_O)); }
#else
                unsigned char* ws = ap->ws; const bf16* HB = (const bf16*)(ws + WS_H); bf16* OB = (bf16*)(ws + WS_O);
                LAS float* qf = (LAS float*)lds; LAS float* kf = qf + 16 * 4 * 68; LAS float* vf = kf + 16 * 4 * 68;
                for (int un = blockIdx.x; un < NBATCH * RT_HEADS * 4; un += gridDim.x) {
                    const int b = un >> 4, h = (un >> 2) & 3, vq = un & 3; const int vc = tid >> 2, kq = tid & 3;
                    const float gam = 1.0f - exp2f(-5.0f - (float)h);
                    float st[64];
#pragma unroll
                    for (int i = 0; i < 64; ++i) st[i] = 0.f;
                    for (int t0 = 0; t0 < SEQ; t0 += 16) {
                        __syncthreads();
                        for (int e = tid; e < 16 * 256; e += 512) { const int tt = e >> 8, k = e & 255; const size_t gi = (size_t)(b * SEQ + t0 + tt) * RT_IN + h * 256 + k; const int li = tt * 272 + (k & 3) * 68 + (k >> 2);
                            qf[li] = bf1(HB[gi]); kf[li] = bf1(HB[gi + 1024]); }
                        for (int e = tid; e < 16 * 128; e += 512) { const int tt = e >> 7, c = e & 127; vf[e] = bf1(HB[(size_t)(b * SEQ + t0 + tt) * RT_IN + 2048 + h * 512 + vq * 128 + c]); }
                        __syncthreads();
                        for (int tt = 0; tt < 16; ++tt) {
                            const float v = vf[tt * 128 + vc]; float a = 0.f; const int lb = tt * 272 + kq * 68;
#pragma unroll
                            for (int i = 0; i < 64; ++i) { st[i] = gam * st[i] + kf[lb + i] * v; a += qf[lb + i] * st[i]; }
                            a += __shfl_xor(a, 1); a += __shfl_xor(a, 2);
                            if (kq == 0) OB[(size_t)(b * SEQ + t0 + tt) * RT_VD + h * 512 + vq * 128 + vc] = (bf16)f2bf(a);
                        }
                    }
                }
#endif
                GRID_BAR();
            } }
#endif
#if SITE(6)
            { KArgs ap = kargs(); const int tid = otid(wave0); LAS unsigned char* lds = olds(lds0); (void)tid;
            if (IN(pb + 2)) for (int rep_ = 0; rep_ < REP(6); ++rep_) {
                const int lane = tid & 63, wave = __builtin_amdgcn_readfirstlane(tid >> 6), gw = VCU() * 8 + wave, NGW = gridDim.x * 8;
                unsigned char* ws = ap->ws; const bf16* OB = (const bf16*)(ws + WS_O); const bf16* HB = (const bf16*)(ws + WS_H); bf16* A2 = (bf16*)(ws + WS_A2);
                v4u on[4], gn[4];
#pragma unroll
                for (int h = 0; h < 4; ++h) { on[h] = *(const v4u*)(OB + (size_t)gw * RT_VD + 512 * h + 8 * lane); gn[h] = *(const v4u*)(HB + (size_t)gw * RT_IN + 4096 + 512 * h + 8 * lane); }
#pragma unroll 1
                for (int row = gw; row < NTOK; row += NGW) {
                    v4u oc[4], gc[4];
#pragma unroll
                    for (int h = 0; h < 4; ++h) { oc[h] = on[h]; gc[h] = gn[h]; }
                    if (row + NGW < NTOK) {
#pragma unroll
                        for (int h = 0; h < 4; ++h) { on[h] = *(const v4u*)(OB + (size_t)(row + NGW) * RT_VD + 512 * h + 8 * lane); gn[h] = *(const v4u*)(HB + (size_t)(row + NGW) * RT_IN + 4096 + 512 * h + 8 * lane); } }
#pragma unroll
                    for (int h = 0; h < 4; ++h) {
                        const v4u w = oc[h];
                        float o[8] = {bflo(w.x), bfhi(w.x), bflo(w.y), bfhi(w.y), bflo(w.z), bfhi(w.z), bflo(w.w), bfhi(w.w)};
                        float s = 0.f;
#pragma unroll
                        for (int i = 0; i < 8; ++i) s += o[i];
                        const float mu = wave_sum(s) * (1.0f / 512.0f); float q = 0.f;
#pragma unroll
                        for (int i = 0; i < 8; ++i) { o[i] -= mu; q += o[i] * o[i]; }
                        const float rs = 1.0f / sqrtf(wave_sum(q) * (1.0f / 512.0f) + LN_EPS);
                        const v4u g = gc[h];
                        v4u r; r.x = pk2(o[0] * rs * bflo(g.x), o[1] * rs * bfhi(g.x)); r.y = pk2(o[2] * rs * bflo(g.y), o[3] * rs * bfhi(g.y));
                        r.z = pk2(o[4] * rs * bflo(g.z), o[5] * rs * bfhi(g.z)); r.w = pk2(o[6] * rs * bflo(g.w), o[7] * rs * bfhi(g.w));
                        *(v4u*)(A2 + (size_t)row * RT_VD + 512 * h + 8 * lane) = r;
                    }
                }
                GRID_BAR();
            } }
#endif
        }
#if SITE(7)
        { KArgs ap = kargs(); const int tid = otid(wave0); LAS unsigned char* lds = olds(lds0); (void)tid;
        if (IN(pb + 3)) for (int rep_ = 0; rep_ < REP(7); ++rep_) {
            unsigned char* ws = ap->ws; const int j = L >> 1; const bool ret = (L & 1) != 0;
            const int Ko = ret ? RT_VD : DM;
            LAS int* ul = (LAS int*)(lds + MISC_OFF + MO_ULIST);
            pg8::build_units_dense(tid, ul, NTOK / 256, DM / 256, Ko * 2);
            const char* Bt = ret ? (const char*)((bf16*)(ws + WS_W_ROUT) + (size_t)j * DM * RT_VD) : (const char*)((bf16*)(ws + WS_W_HOUT) + (size_t)j * DM * DM);
            pg8::EpiRes E{ws, (ret || SLOW_HGRN) ? -1 : 0};
            pg8::gemm_phase<pg8::EpiRes, false, true, false>(tid, lds, ul, (LAS int*)(lds + MISC_OFF + MO_GTAB), (const char*)(ws + WS_A2), Bt, nullptr, Ko * 2, E);
            GRID_BAR();
        } }
#endif
#if SITE(8)
        { KArgs ap = kargs(); const int tid = otid(wave0); LAS unsigned char* lds = olds(lds0); (void)tid;
        if (IN(pb + 4)) for (int rep_ = 0; rep_ < REP(8); ++rep_) {
            const int lane = tid & 63, wave = __builtin_amdgcn_readfirstlane(tid >> 6), r = lane & 15, g = lane >> 4;
            unsigned char* ws = ap->ws; unsigned* ctl = (unsigned*)(ws + WS_CTL);
            const bf16* Y = (const bf16*)(ws + WS_Y); bf16* X1R = (bf16*)(ws + WS_X1F); bf16* X1B = (bf16*)(ws + WS_X1B);
            int* ROWDST = (int*)(ws + WS_ROWDST); float* ROWGATE = (float*)(ws + WS_ROWGATE);
            constexpr int WP = 2064;
            LAS unsigned char* wH = lds; LAS unsigned char* wL = lds + 32 * WP;
            LAS int* lcnt = (LAS int*)(lds + MISC_OFF + MO_LCNT); LAS int* lbase = (LAS int*)(lds + MISC_OFF + MO_LBASE);
            LAS int* sel = (LAS int*)(lds + MISC_OFF + MO_SEL); LAS float* selw = (LAS float*)(lds + MISC_OFF + MO_SELW);
            const float* rb = ap->in[I_RB] + L * NE;
            const float* lg = ap->in[I_LNMG] + L * DM; const float* lbb = ap->in[I_LNMB] + L * DM;
            { const v4u* gh = (const v4u*)(ws + WS_WRH) + (size_t)L * 4096; const v4u* gl = (const v4u*)(ws + WS_WRL) + (size_t)L * 4096;
              for (int c = tid; c < 4096; c += 512) { const int e = c >> 7, cc = c & 127; *(LAS v4u*)(wH + e * WP + cc * 16) = gh[c]; *(LAS v4u*)(wL + e * WP + cc * 16) = gl[c]; } }
            const float rb0 = rb[r], rb1 = rb[16 + r];
            for (int blk = VCU(); blk < NTOK / 128; blk += gridDim.x) {
                if (tid < 32) lcnt[tid] = 0;
                __syncthreads();
                const int row0 = blk * 128 + wave * 16;
                v2u xn[4];
#pragma unroll
                for (int q = 0; q < 4; ++q) xn[q] = *(const v2u*)(Y + (size_t)row0 * DM + 256 * q + 4 * lane);
#pragma unroll 1
                for (int rr = 0; rr < 16; ++rr) {
                    const int row = row0 + rr;
                    f32x4 x[4]; float s = 0.f;
#pragma unroll
                    for (int q = 0; q < 4; ++q) { x[q] = (f32x4){bflo(xn[q].x), bfhi(xn[q].x), bflo(xn[q].y), bfhi(xn[q].y)}; s += (x[q][0] + x[q][1]) + (x[q][2] + x[q][3]); }
                    if (rr + 1 < 16) {
#pragma unroll
                        for (int q = 0; q < 4; ++q) xn[q] = *(const v2u*)(Y + (size_t)(row + 1) * DM + 256 * q + 4 * lane); }
                    const float mu = wave_sum_u(s) * (1.0f / DM); float qq = 0.f;
#pragma unroll
                    for (int q = 0; q < 4; ++q) { x[q] = x[q] - mu; qq += (x[q][0] * x[q][0] + x[q][1] * x[q][1]) + (x[q][2] * x[q][2] + x[q][3] * x[q][3]); }
                    const float rs = 1.0f / sqrtf(wave_sum_u(qq) * (1.0f / DM) + LN_EPS);
#pragma unroll
                    for (int q = 0; q < 4; ++q) { const f32x4 g4 = *(const f32x4*)(lg + 256 * q + 4 * lane), b4 = *(const f32x4*)(lbb + 256 * q + 4 * lane); x[q] = x[q] * rs * g4 + b4;
                        { v2u wr_; wr_.x = pk2(x[q][0], x[q][1]); wr_.y = pk2(x[q][2], x[q][3]); *(v2u*)(X1R + (size_t)row * DM + 256 * q + 4 * lane) = wr_; }
#if MOE_FP8
                        *(unsigned*)((unsigned char*)X1B + (size_t)row * DM + 256 * q + 4 * lane) = pk4_fp8(x[q][0] * X_SCALE, x[q][1] * X_SCALE, x[q][2] * X_SCALE, x[q][3] * X_SCALE); }
#else
                        v2u w; w.x = pk2(x[q][0], x[q][1]); w.y = pk2(x[q][2], x[q][3]); *(v2u*)(X1B + (size_t)row * DM + 256 * q + 4 * lane) = w; }
#endif
                }
                asm volatile("s_waitcnt vmcnt(0)" ::: "memory");
                f32x4 lgt0 = {0.f, 0.f, 0.f, 0.f}, lgt1 = {0.f, 0.f, 0.f, 0.f};
                {
                    const bf16* xa = X1R + (size_t)(row0 + r) * DM + 8 * g;
#pragma unroll 1
                    for (int kq = 0; kq < 4; ++kq) {
                        bf16x8 af[8], h0[8], h1[8], l0[8], l1[8];
#pragma unroll
                        for (int j = 0; j < 8; ++j) { const int kb = kq * 8 + j; af[j] = *(const bf16x8*)(xa + 32 * kb);
                            h0[j] = *(const LAS bf16x8*)(wH + r * WP + (32 * kb + 8 * g) * 2); h1[j] = *(const LAS bf16x8*)(wH + (16 + r) * WP + (32 * kb + 8 * g) * 2);
                            l0[j] = *(const LAS bf16x8*)(wL + r * WP + (32 * kb + 8 * g) * 2); l1[j] = *(const LAS bf16x8*)(wL + (16 + r) * WP + (32 * kb + 8 * g) * 2); }
#pragma unroll
                        for (int j = 0; j < 8; ++j) { lgt0 = MFMA32(af[j], h0[j], lgt0); lgt1 = MFMA32(af[j], h1[j], lgt1); lgt0 = MFMA32(af[j], l0[j], lgt0); lgt1 = MFMA32(af[j], l1[j], lgt1); }
                    }
                }
#pragma unroll
                for (int i = 0; i < 4; ++i) {
                    float v0 = lgt0[i] + rb0, v1 = lgt1[i] + rb1; int se[4]; float sv[4];
#pragma unroll
                    for (int k = 0; k < 4; ++k) {
                        float m = fmaxf(v0, v1);
                        m = fmaxf(m, dppf<0xB1>(m)); m = fmaxf(m, dppf<0x4E>(m)); m = fmaxf(m, dppf<0x141>(m)); m = fmaxf(m, dppf<0x140>(m));
                        int ec = (v0 == m) ? r : ((v1 == m) ? 16 + r : 99);
                        ec = min(ec, dppi<0xB1>(ec)); ec = min(ec, dppi<0x4E>(ec)); ec = min(ec, dppi<0x141>(ec)); ec = min(ec, dppi<0x140>(ec));
                        se[k] = ec; sv[k] = m;
                        if (ec == r) v0 = -3.0e38f;
                        if (ec == 16 + r) v1 = -3.0e38f;
                    }
                    const float e1 = __expf(sv[1] - sv[0]), e2 = __expf(sv[2] - sv[0]), e3 = __expf(sv[3] - sv[0]); const float inv = 1.0f / (1.0f + e1 + e2 + e3);
                    if (r < 4) { const int rloc = wave * 16 + 4 * g + i; const int ee = r == 0 ? se[0] : (r == 1 ? se[1] : (r == 2 ? se[2] : se[3])); const float ww = (r == 0 ? 1.0f : (r == 1 ? e1 : (r == 2 ? e2 : e3))) * inv;
                        sel[rloc * 4 + r] = ee; selw[rloc * 4 + r] = ww; }
                }
                __syncthreads();
                const int myE = sel[tid]; const int rank = __hip_atomic_fetch_add(lcnt + myE, 1, __ATOMIC_RELAXED, __HIP_MEMORY_SCOPE_WORKGROUP);
                __syncthreads();
                if (tid < 32) lbase[tid] = (int)__hip_atomic_fetch_add(ctl + CW_ECNT + (L + 4 * rep_) * 32 + tid, (unsigned)lcnt[tid], RLX_AGENT);
                __syncthreads();
                { const int pos = lbase[myE] + rank; const size_t ti = (size_t)myE * ECAP + pos; ROWDST[ti] = (blk * 128 + (tid >> 2)) * 4 + (tid & 3); ROWGATE[ti] = selw[tid]; }
                __syncthreads();
            }
            GRID_BAR();
        } }
#endif
#if SITE(9)
        { KArgs ap = kargs(); const int tid = otid(wave0); LAS unsigned char* lds = olds(lds0); (void)tid;
        if (IN(pb + 5)) for (int rep_ = 0; rep_ < REP(9); ++rep_) {
            unsigned char* ws = ap->ws; unsigned* ctl = (unsigned*)(ws + WS_CTL);
            LAS int* tpre = (LAS int*)(lds + MISC_OFF + MO_TPRE); LAS int* ebase = (LAS int*)(lds + MISC_OFF + MO_EBASE); LAS int* ecnt = (LAS int*)(lds + MISC_OFF + MO_ECNT);
            if (tid < NE) ecnt[tid] = (int)__hip_atomic_load(ctl + CW_ECNT + L * 32 + tid, RLX_AGENT);
            __syncthreads();
            if (tid == 0) { int t = 0;
_Pragma("unroll 1")
 for (int e = 0; e < NE; ++e) { const int c = ecnt[e]; tpre[e] = t; ebase[e] = t * 256; t += (c + 255) >> 8; } tpre[NE] = t; }
            __syncthreads();
            LAS int* ul = (LAS int*)(lds + MISC_OFF + MO_ULIST);
            constexpr int EB = MOE_FP8 ? 1 : 2;
            pg8::build_units_moe(tid, ul, tpre, ebase, ecnt, 8, DM * EB, 2048u * DM * EB);
            { LAS int* gall = (LAS int*)(lds + MISC_OFF + MO_GALL); const int* rd = (const int*)(ws + WS_ROWDST);
              for (int i = tid; i < GALL_UNITS * 256; i += 512) { const int uu = i >> 8, rr = i & 255;
                  if (ul[uu * 8 + 0]) gall[i] = (int)((unsigned)rd[ul[uu * 8 + 7] + min(rr, ul[uu * 8 + 5] - 1)] >> 2); }
              __syncthreads(); }
            pg8::EpiMoeGU E{ws, L};
            pg8::gemm_phase<pg8::EpiMoeGU, true, true, MOE_FP8 != 0>(tid, lds, ul, (LAS int*)(lds + MISC_OFF + MO_GALL), (const char*)(ws + WS_X1B), (const char*)(ws + WS_W_GU + (size_t)L * NE * 2048 * DM * EB), (const int*)(ws + WS_ROWDST), DM * EB, E, lds + MISC_OFF + MO_GTAB);
            GRID_BAR();
        } }
#endif
#if SITE(10)
        { KArgs ap = kargs(); const int tid = otid(wave0); LAS unsigned char* lds = olds(lds0); (void)tid;
        if (IN(pb + 6)) for (int rep_ = 0; rep_ < REP(10); ++rep_) {
            unsigned char* ws = ap->ws; unsigned* ctl = (unsigned*)(ws + WS_CTL);
            LAS int* tpre = (LAS int*)(lds + MISC_OFF + MO_TPRE); LAS int* ebase = (LAS int*)(lds + MISC_OFF + MO_EBASE); LAS int* ecnt = (LAS int*)(lds + MISC_OFF + MO_ECNT);
            __syncthreads();
            if (tid < NE) ecnt[tid] = (int)__hip_atomic_load(ctl + CW_ECNT + L * 32 + tid, RLX_AGENT);
            __syncthreads();
            if (tid == 0) { int t = 0;
_Pragma("unroll 1")
 for (int e = 0; e < NE; ++e) { const int c = ecnt[e]; tpre[e] = t; ebase[e] = t * 256; t += (c + 255) >> 8; } tpre[NE] = t; }
            __syncthreads();
            LAS int* ul = (LAS int*)(lds + MISC_OFF + MO_ULIST);
            constexpr int EB = MOE_FP8 ? 1 : 2;
            pg8::build_units_moe(tid, ul, tpre, ebase, ecnt, 4, DM * EB, (unsigned)DM * DM * EB);
            pg8::EpiMoeDown E{ws, ap->in[I_BDN] + (size_t)L * NE * DM};
            pg8::gemm_phase<pg8::EpiMoeDown, false, true, MOE_FP8 != 0>(tid, lds, ul, (LAS int*)(lds + MISC_OFF + MO_GTAB), (const char*)(ws + WS_ACT), (const char*)(ws + WS_W_DN + (size_t)L * NE * DM * DM * EB), nullptr, DM * EB, E, lds + MISC_OFF + MO_GALL);
            GRID_BAR();
        } }
#endif
#if SITE(11)
        { KArgs ap = kargs(); const int tid = otid(wave0); LAS unsigned char* lds = olds(lds0); (void)tid;
        if (IN(pb + 7)) for (int rep_ = 0; rep_ < REP(11); ++rep_) {
            const int lane = tid & 63, wave = __builtin_amdgcn_readfirstlane(tid >> 6), gw = VCU() * 8 + wave, NGW = gridDim.x * 8;
            unsigned char* ws = ap->ws; const bf16* X1R = (const bf16*)(ws + WS_X1F); const bf16* YS = (const bf16*)(ws + WS_YSLOT); bf16* XB = (bf16*)(ws + WS_XB); float* out = ap->out;
            const float* lg = ap->in[I_LNFG] + L * DM; const float* lbb = ap->in[I_LNFB] + L * DM;
#if YS_FP8
            typedef unsigned ys_t; constexpr int YSB = 1;
#else
            typedef v2u ys_t; constexpr int YSB = 2;
#endif
            v2u xn[4]; f32x4 g4[4], b4[4]; ys_t yn[4][4];
#pragma unroll
            for (int q = 0; q < 4; ++q) { g4[q] = *(const f32x4*)(lg + 256 * q + 4 * lane); b4[q] = *(const f32x4*)(lbb + 256 * q + 4 * lane); xn[q] = *(const v2u*)(X1R + (size_t)gw * DM + 256 * q + 4 * lane);
#pragma unroll
                for (int k = 0; k < 4; ++k) yn[q][k] = *(const ys_t*)((const unsigned char*)YS + (((size_t)gw * 4 + k) * DM + 256 * q + 4 * lane) * YSB); }
#pragma unroll 1
            for (int row = gw; row < NTOK; row += NGW) {
                f32x4 x[4]; ys_t yc[4][4]; float s = 0.f;
#pragma unroll
                for (int q = 0; q < 4; ++q) { x[q] = (f32x4){bflo(xn[q].x), bfhi(xn[q].x), bflo(xn[q].y), bfhi(xn[q].y)} * DN_ALPHA;
#pragma unroll
                    for (int k = 0; k < 4; ++k) yc[q][k] = yn[q][k]; }
                if (row + NGW < NTOK) {
#pragma unroll
                    for (int q = 0; q < 4; ++q) { xn[q] = *(const v2u*)(X1R + (size_t)(row + NGW) * DM + 256 * q + 4 * lane);
#pragma unroll
                        for (int k = 0; k < 4; ++k) yn[q][k] = *(const ys_t*)((const unsigned char*)YS + (((size_t)(row + NGW) * 4 + k) * DM + 256 * q + 4 * lane) * YSB); } }
#pragma unroll
                for (int q = 0; q < 4; ++q) {
#pragma unroll
#if YS_FP8
                    for (int k = 0; k < 4; ++k) { const f32x2 lo = __builtin_amdgcn_cvt_pk_f32_fp8((int)yc[q][k], false), hi = __builtin_amdgcn_cvt_pk_f32_fp8((int)yc[q][k], true);
                        x[q][0] += lo[0] * 0.015625f; x[q][1] += lo[1] * 0.015625f; x[q][2] += hi[0] * 0.015625f; x[q][3] += hi[1] * 0.015625f; }
#else
                    for (int k = 0; k < 4; ++k) { const v2u w = yc[q][k]; x[q][0] += bflo(w.x); x[q][1] += bfhi(w.x); x[q][2] += bflo(w.y); x[q][3] += bfhi(w.y); }
#endif
                    s += (x[q][0] + x[q][1]) + (x[q][2] + x[q][3]); }
                const float mu = wave_sum(s) * (1.0f / DM); float qq = 0.f;
#pragma unroll
                for (int q = 0; q < 4; ++q) { x[q] = x[q] - mu; qq += (x[q][0] * x[q][0] + x[q][1] * x[q][1]) + (x[q][2] * x[q][2] + x[q][3] * x[q][3]); }
                const float rs = 1.0f / sqrtf(wave_sum(qq) * (1.0f / DM) + LN_EPS);
#pragma unroll
                for (int q = 0; q < 4; ++q) { x[q] = x[q] * rs * g4[q] + b4[q];
                    if (L + 1 == DEPTH) *(f32x4*)(out + (size_t)row * DM + 256 * q + 4 * lane) = x[q];
                    else { v2u w; w.x = pk2(x[q][0], x[q][1]); w.y = pk2(x[q][2], x[q][3]); *(v2u*)(XB + (size_t)row * DM + 256 * q + 4 * lane) = w; } }
            }
            if (L + 1 < DEPTH) GRID_BAR();
        } }
#endif
    }
#undef IN
#undef GRID_BAR
}

extern "C" void kernel_launch(void* const* d_in, const int* in_sizes, int n_in, void* d_out, int out_size, void* d_ws, size_t ws_size, hipStream_t stream) {
    static int grid = 0;
    if (grid == 0) {
        if (n_in != 17 || out_size != NTOK * DM || ws_size < WS_END) { fprintf(stderr, "kernel_launch: unexpected shapes (n_in %d, out %d, ws %zu < %zu)\n", n_in, out_size, ws_size, (size_t)WS_END); grid = -1; return; }
        int dev = 0, cus = 0, per_cu = 0;
        if (hipGetDevice(&dev) != hipSuccess || hipDeviceGetAttribute(&cus, hipDeviceAttributeMultiprocessorCount, dev) != hipSuccess) { grid = -1; return; }
        if (hipFuncSetAttribute((const void*)mk_fwd, hipFuncAttributeMaxDynamicSharedMemorySize, LDS_BYTES) != hipSuccess) { fprintf(stderr, "kernel_launch: hipFuncSetAttribute failed\n"); grid = -1; return; }
        if (hipOccupancyMaxActiveBlocksPerMultiprocessor(&per_cu, (const void*)mk_fwd, 512, LDS_BYTES) != hipSuccess || per_cu < 1) { fprintf(stderr, "kernel_launch: occupancy query says %d\n", per_cu); }
        (void)hipGetLastError();
        grid = cus;
    }
    if (grid < 0) return;
    (void)hipMemsetAsync((char*)d_ws + WS_CTL, 0, CTL_ZERO_BYTES, stream);
    Args a{};
    for (int i = 0; i < 17; ++i) a.in[i] = (const float*)d_in[i];
    a.out = (float*)d_out; a.ws = (unsigned char*)d_ws;
#if MK_MULTI
    for (int p = 0; p < 1 + 8 * DEPTH; ++p) { a.ph_lo = p; a.ph_hi = p + 1; hipLaunchKernelGGL(mk_fwd, dim3(grid), dim3(512), LDS_BYTES, stream, a); }
#else
    a.ph_lo = 0; a.ph_hi = 1 + 8 * DEPTH;
    hipLaunchKernelGGL(mk_fwd, dim3(grid), dim3(512), LDS_BYTES, stream, a);
#endif
}
```

```cpp
#include <hip/hip_runtime.h>
#include <cstdio>
#include <cstdint>

#ifndef MK_MULTI
#define MK_MULTI 0
#endif
#ifndef PROBE_EPI2
#define PROBE_EPI2 0
#endif
#ifndef MOE_FP8
#define MOE_FP8 1
#endif
#ifndef ROUT_FP8
#define ROUT_FP8 1
#endif
#ifndef YS_FP8
#define YS_FP8 1
#endif
#ifndef SLOW_HGRN
#define SLOW_HGRN 0
#endif
#ifndef SLOW_RET
#define SLOW_RET 0
#endif

#define GAS __attribute__((address_space(1)))
#define LAS __attribute__((address_space(3)))
typedef unsigned short bf16;
typedef unsigned v4u __attribute__((ext_vector_type(4)));
typedef unsigned v2u __attribute__((ext_vector_type(2)));
typedef float f32x4 __attribute__((ext_vector_type(4)));
typedef float f32x2 __attribute__((ext_vector_type(2)));
typedef short bf16x8 __attribute__((ext_vector_type(8)));
typedef GAS unsigned gu32;

constexpr int DM = 1024, NBATCH = 16, SEQ = 2048, NTOK = NBATCH * SEQ, DEPTH = 4;
constexpr int NE = 32, TOPK = 4;
constexpr int HG_HEADS = 8, HG_K = 128;
constexpr int RT_HEADS = 4, RT_K = 256, RT_V = 512, RT_VD = 2048, RT_IN = 6144, HG_IN = 4096;
constexpr int ECAP = NTOK;
constexpr int MOE_ROWS = NTOK * TOPK + NE * 256;
constexpr float DN_ALPHA = 1.681792830507429f;
constexpr float LN_EPS = 1e-5f, RMS_EPS = 1e-6f;

constexpr size_t MiB = 1ull << 20;
constexpr size_t WS_CTL = 0, CTL_ZERO_BYTES = 1 * MiB;
constexpr size_t WS_LBS = 1 * MiB;
constexpr size_t WS_WRH = 1 * MiB + 128 * 1024, WS_WRL = 1 * MiB + 512 * 1024;
constexpr size_t WS_BGU = 2 * MiB;
constexpr size_t WS_ROT = 4 * MiB;
constexpr size_t WS_ROWDST = 8 * MiB;
constexpr size_t WS_ROWGATE = 12 * MiB;
constexpr size_t WS_W_HIN = 16 * MiB;
constexpr size_t WS_W_HOUT = WS_W_HIN + 16 * MiB;
constexpr size_t WS_W_RIN = WS_W_HOUT + 4 * MiB;
constexpr size_t WS_W_ROUT = WS_W_RIN + 24 * MiB;
constexpr size_t WS_W_GU = WS_W_ROUT + 8 * MiB;
constexpr size_t WS_W_DN = WS_W_GU + 512 * MiB;
constexpr size_t WS_XB = WS_W_DN + 256 * MiB;
constexpr size_t WS_H = WS_XB + 64 * MiB;
constexpr size_t WS_DEC = WS_H + 320 * MiB;
constexpr size_t WS_SSP = WS_DEC + 16 * MiB;
constexpr size_t WS_O = WS_H + 384 * MiB;
constexpr size_t WS_A2 = WS_O + 128 * MiB;
constexpr size_t WS_Y = WS_A2 + 128 * MiB;
constexpr size_t WS_X1F = WS_Y + 128 * MiB;
constexpr size_t WS_X1B = WS_X1F + 128 * MiB;
constexpr size_t WS_ACT = WS_X1B + 64 * MiB;
constexpr size_t WS_YSLOT = WS_ACT + 272 * MiB;
constexpr size_t WS_W_ROUT8 = WS_YSLOT + 256 * MiB;
constexpr size_t WS_END = WS_W_ROUT8 + 4 * MiB;

constexpr int CW_BAR = 4096;
constexpr int CW_SS = 65536;
constexpr int CW_ECNT = 16384;

constexpr int RING_BYTES = 131072;
constexpr int MISC_OFF = 135168;
constexpr int LDS_BYTES = 163840;
constexpr int MO_BARW = 0;
constexpr int MO_GTAB = 64;
constexpr int MO_TPRE = 64 + 2048;
constexpr int MO_EBASE = MO_TPRE + 160;
constexpr int MO_ECNT = MO_EBASE + 128;
constexpr int MO_LCNT = MO_ECNT + 128;
constexpr int MO_LBASE = MO_LCNT + 128;
constexpr int MO_SEL = MO_LBASE + 128;
constexpr int MO_SELW = MO_SEL + 2048;
constexpr int MO_RANK = MO_SELW + 2048;
constexpr int MO_ULIST = MO_RANK + 2048;
constexpr int MO_GALL = 10240;
constexpr int GALL_UNITS = 18;
static_assert(MO_ULIST + 1024 <= MO_GALL && MISC_OFF + MO_GALL + GALL_UNITS * 1024 <= LDS_BYTES, "LDS map");

#define RLX_AGENT __ATOMIC_RELAXED, __HIP_MEMORY_SCOPE_AGENT
#define LDS_WAIT() asm volatile("s_waitcnt lgkmcnt(0)" ::: "memory")
#define VM_WAIT() asm volatile("s_waitcnt vmcnt(0)" ::: "memory")

__device__ __forceinline__ unsigned f2bf(float f) { unsigned u = __builtin_bit_cast(unsigned, f); return (u + 0x7fffu + ((u >> 16) & 1u)) >> 16; }
__device__ __forceinline__ unsigned pk2(float lo, float hi) { return f2bf(lo) | (f2bf(hi) << 16); }
__device__ __forceinline__ unsigned cvt_pk_bf16(float lo, float hi) { unsigned r; asm volatile("v_cvt_pk_bf16_f32 %0, %1, %2" : "=v"(r) : "v"(lo), "v"(hi)); return r; }
#if MOE_FP8
constexpr float X_SCALE = 4.0f, WGU_SCALE = 64.0f, ACT_SCALE = 4.0f, WDN_SCALE = 128.0f;
constexpr float GU_DESCALE = 1.0f / (X_SCALE * WGU_SCALE), DN_DESCALE = 1.0f / (ACT_SCALE * WDN_SCALE);
#else
constexpr float GU_DESCALE = 1.0f, DN_DESCALE = 1.0f, ACT_SCALE = 1.0f;
#endif
__device__ __forceinline__ unsigned pk4_fp8(float a, float b, float c, float d) {
    a = __builtin_amdgcn_fmed3f(a, -448.0f, 448.0f); b = __builtin_amdgcn_fmed3f(b, -448.0f, 448.0f); c = __builtin_amdgcn_fmed3f(c, -448.0f, 448.0f); d = __builtin_amdgcn_fmed3f(d, -448.0f, 448.0f);
    int p = __builtin_amdgcn_cvt_pk_fp8_f32(a, b, 0, false); p = __builtin_amdgcn_cvt_pk_fp8_f32(c, d, p, true); return (unsigned)p; }
__device__ __forceinline__ float bflo(unsigned u) { return __builtin_bit_cast(float, u << 16); }
__device__ __forceinline__ float bfhi(unsigned u) { return __builtin_bit_cast(float, u & 0xffff0000u); }
__device__ __forceinline__ float bf1(bf16 b) { return __builtin_bit_cast(float, ((unsigned)b) << 16); }
__device__ __forceinline__ float fexp(float x) { return __builtin_amdgcn_exp2f(x * 1.4426950408889634f); }
__device__ __forceinline__ float frcp(float x) { return __builtin_amdgcn_rcpf(x); }
__device__ __forceinline__ float fsigmoid(float x) { return frcp(1.0f + fexp(-x)); }
__device__ __forceinline__ float wave_sum(float v) {
#pragma unroll
    for (int o = 1; o < 64; o <<= 1) v += __shfl_xor(v, o);
    return v;
}
__device__ __forceinline__ float wave_max(float v) {
#pragma unroll
    for (int o = 1; o < 64; o <<= 1) v = fmaxf(v, __shfl_xor(v, o));
    return v;
}

template <int CTRL> __device__ __forceinline__ float dppf(float v) { return __builtin_bit_cast(float, __builtin_amdgcn_update_dpp(0, __builtin_bit_cast(int, v), CTRL, 0xf, 0xf, true)); }
template <int CTRL> __device__ __forceinline__ int dppi(int v) { return __builtin_amdgcn_update_dpp(0, v, CTRL, 0xf, 0xf, true); }
__device__ __forceinline__ float rlane(float v, int l) { return __builtin_bit_cast(float, __builtin_amdgcn_readlane(__builtin_bit_cast(int, v), l)); }
__device__ __forceinline__ float wave_sum_u(float v) {
    v += dppf<0xB1>(v); v += dppf<0x4E>(v); v += dppf<0x141>(v); v += dppf<0x140>(v);
    return (rlane(v, 0) + rlane(v, 16)) + (rlane(v, 32) + rlane(v, 48));
}
#define XB_TMO      128
#define XB_XCNT(j)  (256  + 64 * (j))
#define XB_XSUB(j)  (1280 + 64 * (j))
#define XB_XGEN(j)  (2304 + 64 * (j))
#define XB_TOP      3328
#define XB_TOPGEN   3392
#define XCD_BAR_WORDS 3456
#define XB_SPIN_CAP (1u << 22)

__device__ __forceinline__ unsigned xb_ld(unsigned* p)              { return __hip_atomic_load(p, __ATOMIC_RELAXED, __HIP_MEMORY_SCOPE_AGENT); }
__device__ __forceinline__ unsigned xb_add(unsigned* p, unsigned v) { return __hip_atomic_fetch_add(p, v, __ATOMIC_RELAXED, __HIP_MEMORY_SCOPE_AGENT); }
__device__ __forceinline__ unsigned xb_xcc_id() { return (unsigned)__builtin_amdgcn_s_getreg((3 << 11) | 20) & 0xFu; }
#define XB_SPIN(cond, bar) do { unsigned _sp = 0; while (cond) { __builtin_amdgcn_s_sleep(1); \
    if ((++_sp & 255u) == 0u) { if (xb_ld(&(bar)[XB_TMO])) break; if (_sp > XB_SPIN_CAP) { atomicAdd(&(bar)[XB_TMO], 1u); break; } } } } while (0)

struct XcdBarrier { unsigned* bar; unsigned x; volatile LAS unsigned* st; };

__device__ __forceinline__ XcdBarrier xcd_barrier_post(unsigned* bar, volatile LAS unsigned* st) {
    XcdBarrier b; b.bar = bar; b.x = xb_xcc_id(); b.st = st;
    if (threadIdx.x == 0) (void)xb_add(&bar[XB_XCNT(b.x)], 1u);
    return b;
}
__device__ __forceinline__ void xcd_barrier_complete(unsigned* bar, unsigned x, unsigned& nloc, unsigned& nx) {
    const unsigned G = gridDim.x * gridDim.y * gridDim.z;
    unsigned sum, cnt, mine, sp = 0u;
    for (;;) {
        sum = 0u; cnt = 0u; mine = 0u;
#pragma unroll
        for (unsigned j = 0; j < 16; ++j) { const unsigned c = xb_ld(&bar[XB_XCNT(j)]); sum += c; cnt += (c > 0u) ? 1u : 0u; mine = (j == x) ? c : mine; }
        if (sum == G) break;
        __builtin_amdgcn_s_sleep(1);
        if ((++sp & 255u) == 0u) { if (xb_ld(&bar[XB_TMO])) break; if (sp > XB_SPIN_CAP) { atomicAdd(&bar[XB_TMO], 1u); break; } }
    }
    nloc = mine > 0u ? mine : 1u; nx = cnt > 0u ? cnt : 1u;
}
__device__ __forceinline__ void xcd_barrier(const XcdBarrier& b) {
    asm volatile("s_waitcnt vmcnt(0)" ::: "memory");
    __syncthreads();
    if (threadIdx.x == 0) {
        unsigned* bar = b.bar;
        __builtin_amdgcn_s_waitcnt(0);
        unsigned nloc = b.st[0], nx = b.st[1];
        if (nloc == 0u) { xcd_barrier_complete(bar, b.x, nloc, nx); b.st[0] = nloc; b.st[1] = nx; }
        const unsigned old = xb_add(&bar[XB_XSUB(b.x)], 1u);
        const unsigned gen = old / nloc;
        if (old + 1u == (gen + 1u) * nloc) {
            __builtin_amdgcn_fence(__ATOMIC_RELEASE, "agent");
            asm volatile("s_waitcnt vmcnt(0)" ::: "memory");
            const unsigned og = xb_add(&bar[XB_TOP], 1u);
            const unsigned tg = og / nx;
            if (og + 1u == (tg + 1u) * nx) xb_add(&bar[XB_TOPGEN], 1u);
            else XB_SPIN(xb_ld(&bar[XB_TOPGEN]) == tg, bar);
            __builtin_amdgcn_fence(__ATOMIC_ACQUIRE, "agent");
            xb_add(&bar[XB_XGEN(b.x)], 1u);
            asm volatile("s_waitcnt vmcnt(0)" ::: "memory");
        } else {
            XB_SPIN(xb_ld(&bar[XB_XGEN(b.x)]) == gen, bar);
            __builtin_amdgcn_fence(__ATOMIC_ACQUIRE, "agent");
            asm volatile("s_waitcnt vmcnt(0)" ::: "memory");
        }
    }
    __syncthreads();
}

namespace pg8 {
constexpr int BM = 256, BK = 64, HALF = 128, HTB = HALF * BK * 2, STAGE_BYTES = 8 * HTB, NXCD = 8, WGM = 8, MAXU = 32;
__host__ __device__ __forceinline__ int lds_byte(int r, int c) { const int st = (r >> 4) * 2 + (c >> 5), rr = r & 15, cc = c & 31, ob = rr * 64 + cc * 2; return st * 1024 + (ob ^ (((ob >> 9) & 1) << 5)); }
__host__ __device__ __forceinline__ void stage_rc(int b, int& R, int& C) { const int st = b / 1024, sb = b % 1024, swz = sb ^ (((sb >> 9) & 1) << 5); R = (st >> 1) * 16 + swz / 64; C = (st & 1) * 32 + (swz % 64) / 2; }
__host__ __device__ __forceinline__ int perm32(int rho) { const int n = rho >> 4, i = rho & 15; return 8 * (i >> 2) + 4 * n + (i & 3); }

struct Unit { int pm, pn, e, rowbase, cnt; unsigned boff; int gidx; };

__device__ __forceinline__ bool tile_of(long L, int nM, int nN, int& gm, int& pn) {
    const int nwg = nM * nN; if (L >= nwg) return false;
    int wgid = (int)L; { const int q = nwg / NXCD, r = nwg % NXCD, xcd = wgid % NXCD, off = wgid / NXCD; wgid = (xcd < r ? xcd * (q + 1) : r * (q + 1) + (xcd - r) * q) + off; }
    const int nig = WGM * nN, gid = wgid / nig, fm = gid * WGM, gsz = (nM - fm) < WGM ? (nM - fm) : WGM;
    gm = fm + ((wgid % nig) % gsz); pn = (wgid % nig) / gsz; return true;
}
__device__ __forceinline__ void build_units_dense(const int i, LAS int* ul, int nM, int nN, int RB) {
    if (i < MAXU) { int gm = 0, pn = 0; const bool ok = tile_of((long)i * gridDim.x + blockIdx.x, nM, nN, gm, pn);
        ul[i * 8 + 0] = ok ? 1 : 0; ul[i * 8 + 1] = gm; ul[i * 8 + 2] = pn; ul[i * 8 + 3] = 0; ul[i * 8 + 4] = gm * BM; ul[i * 8 + 5] = BM; ul[i * 8 + 6] = (int)((unsigned)pn * BM * (unsigned)RB); ul[i * 8 + 7] = 0; }
    __syncthreads();
}
__device__ __forceinline__ void build_units_moe(const int i, LAS int* ul, const LAS int* tpre, const LAS int* ebase, const LAS int* ecnt, int nN, int RB, unsigned wstride) {
    if (i < MAXU) { int gm = 0, pn = 0; const bool ok = tile_of((long)i * gridDim.x + blockIdx.x, tpre[NE], nN, gm, pn);
        int e = 0;
_Pragma("unroll 1")
        for (int s = 16; s >= 1; s >>= 1) { if (e + s < NE && tpre[e + s] <= gm) e += s; }
        const int pm = gm - tpre[e];
        ul[i * 8 + 0] = ok ? 1 : 0; ul[i * 8 + 1] = pm; ul[i * 8 + 2] = pn; ul[i * 8 + 3] = e; ul[i * 8 + 4] = ebase[e] + pm * BM; ul[i * 8 + 5] = ecnt[e] - pm * BM;
        ul[i * 8 + 6] = (int)((unsigned)e * wstride + (unsigned)pn * BM * (unsigned)RB); ul[i * 8 + 7] = e * ECAP + pm * BM; }
    __syncthreads();
}
__device__ __forceinline__ bool ld_unit(const LAS int* ul, int i, Unit& u) {
    if (i >= MAXU) return false;
    const LAS int* p = ul + i * 8;
    if (__builtin_amdgcn_readfirstlane(p[0]) == 0) return false;
    u.pm = __builtin_amdgcn_readfirstlane(p[1]); u.pn = __builtin_amdgcn_readfirstlane(p[2]); u.e = __builtin_amdgcn_readfirstlane(p[3]); u.rowbase = __builtin_amdgcn_readfirstlane(p[4]);
    u.cnt = __builtin_amdgcn_readfirstlane(p[5]); u.boff = (unsigned)__builtin_amdgcn_readfirstlane(p[6]); u.gidx = __builtin_amdgcn_readfirstlane(p[7]); return true;
}
__device__ __forceinline__ void glds16(const char* sbase, unsigned voff, LAS unsigned char* dst) {
    asm volatile("" : "+s"(sbase));
    __builtin_amdgcn_global_load_lds((const unsigned*)(sbase + voff), (LAS unsigned*)dst, 16, 0, 0);
}
template <bool GATHER> __device__ __forceinline__ void stage_a(LAS unsigned char* dst, const char* sbase, unsigned o0, unsigned o1, size_t r64) {
    glds16(sbase, o0, dst);
    if constexpr (GATHER) glds16(sbase, o1, dst + 8192);
    else glds16(sbase + r64, o0, dst + 8192);
}

typedef int v8i __attribute__((ext_vector_type(8)));
typedef int v4i __attribute__((ext_vector_type(4)));
__device__ __forceinline__ v8i cat_frag(const bf16x8& a, const bf16x8& b) { return __builtin_shufflevector(__builtin_bit_cast(v4i, a), __builtin_bit_cast(v4i, b), 0, 1, 2, 3, 4, 5, 6, 7); }
template <class Epi, bool GATHER, bool ALIGN_EPI, bool FP8>
__device__ __forceinline__ void gemm_phase(const int tid, LAS unsigned char* lds, const LAS int* ul, LAS int* gtab, const char* Abase, const char* Bbase, const int* rowdst, const int RB, const Epi& E, LAS unsigned char* epl = nullptr) {
    const int wid = __builtin_amdgcn_readfirstlane(tid >> 6), lane = tid & 63, wr = wid >> 2, wc = wid & 3, fr = lane & 15, fq = lane >> 4;
    const int nt = RB / 128;
    int R0, C0; stage_rc(tid * 16, R0, C0);
    const int Rb0 = Epi::PERM ? ((R0 & ~31) + perm32(R0 & 31)) : R0;
    const unsigned voffB = (unsigned)(Rb0 * RB + C0 * 2);
    const unsigned cb0 = (unsigned)C0 * 2u, K2 = (unsigned)RB;
    const size_t kstep = (size_t)128;
    const size_t r64 = (size_t)64 * RB;
    const size_t hstep = (size_t)HALF * RB;
    const unsigned ldsw = (unsigned)wid * 1024u;
    const int aoff = lds_byte(wr * 64 + fr, fq * 8), boff = lds_byte(wc * 32 + fr, fq * 8);
#define PG8_SA(b, h) (((b) * 2 + (h)) * HTB)
#define PG8_SB(b, h) ((4 + (b) * 2 + (h)) * HTB)
#define PG8_STAGE(bufoff, gbase) do { glds16((const char*)(gbase), voffB, lds + (bufoff) + ldsw); glds16((const char*)(gbase) + r64, voffB, lds + (bufoff) + ldsw + 8192); } while (0)
#define PG8_STAGEA0(bufoff, kb, o0, o1) stage_a<GATHER>(lds + (bufoff) + ldsw, Abase + (kb), o0, o1, r64)
#define PG8_STAGEA1(bufoff, kb, o0, o2, o3) stage_a<GATHER>(lds + (bufoff) + ldsw, Abase + (kb) + (GATHER ? (size_t)0 : hstep), GATHER ? (o2) : (o0), o3, r64)
#define PG8_LDA(dst, b, h) do { _Pragma("unroll") for (int m = 0; m < 4; ++m) { const v4i _l = *(const LAS v4i*)(lds + PG8_SA(b, h) + aoff + m * 2048), _h = *(const LAS v4i*)(lds + PG8_SA(b, h) + aoff + m * 2048 + 1024); dst[m] = __builtin_shufflevector(_l, _h, 0, 1, 2, 3, 4, 5, 6, 7); } } while (0)
#define PG8_LDB(dst, b, h) do { _Pragma("unroll") for (int n = 0; n < 2; ++n) { const v4i _l = *(const LAS v4i*)(lds + PG8_SB(b, h) + boff + n * 2048), _h = *(const LAS v4i*)(lds + PG8_SB(b, h) + boff + n * 2048 + 1024); dst[n] = __builtin_shufflevector(_l, _h, 0, 1, 2, 3, 4, 5, 6, 7); } } while (0)
#define PG8_LO(x) __builtin_bit_cast(bf16x8, __builtin_shufflevector(x, x, 0, 1, 2, 3))
#define PG8_HI(x) __builtin_bit_cast(bf16x8, __builtin_shufflevector(x, x, 4, 5, 6, 7))
#define PG8_MMA(ai, bj, At, Bt) do { __builtin_amdgcn_s_setprio(1); _Pragma("unroll") for (int m = 0; m < 4; ++m) _Pragma("unroll") for (int n = 0; n < 2; ++n) { \
        if constexpr (FP8) asm volatile("v_mfma_scale_f32_16x16x128_f8f6f4 %0, %1, %2, %0, %3, %3 op_sel_hi:[0,0,0]" : "+v"(acc[ai][bj][m][n]) : "v"(Bt[n]), "v"(At[m]), "v"(sc1)); \
        else { acc[ai][bj][m][n] = __builtin_amdgcn_mfma_f32_16x16x32_bf16(PG8_LO(Bt[n]), PG8_LO(At[m]), acc[ai][bj][m][n], 0, 0, 0); \
               acc[ai][bj][m][n] = __builtin_amdgcn_mfma_f32_16x16x32_bf16(PG8_HI(Bt[n]), PG8_HI(At[m]), acc[ai][bj][m][n], 0, 0, 0); } } \
        __builtin_amdgcn_s_setprio(0); } while (0)
#define PG8_WAIT_V(n) asm volatile("s_waitcnt vmcnt(" #n ")" ::: "memory")
#define PG8_WAIT_L(n) asm volatile("s_waitcnt lgkmcnt(" #n ")" ::: "memory")
#define PG8_BAR __builtin_amdgcn_s_barrier()
#define PG8_SCHED __builtin_amdgcn_sched_barrier(0)
    Unit cur, nxt; int ui = 0;
    if (!ld_unit(ul, 0, cur)) return;
    f32x4 acc[2][2][4][2];
#pragma unroll
    for (int a = 0; a < 2; ++a)
#pragma unroll
        for (int b = 0; b < 2; ++b)
#pragma unroll
            for (int m = 0; m < 4; ++m)
#pragma unroll
                for (int n = 0; n < 2; ++n) acc[a][b][m][n] = (f32x4){0.f, 0.f, 0.f, 0.f};
    v8i At[4], B0[2], B1[2];
    const int sc1 = 0x7f7f7f7f;
    unsigned oA0, oA1 = 0, oA2 = 0, oA3 = 0, oN0, oN1 = 0, oN2 = 0, oN3 = 0;
    if constexpr (GATHER) {
        oA0 = (unsigned)gtab[R0] * K2 + cb0; oA1 = (unsigned)gtab[R0 + 64] * K2 + cb0; oA2 = (unsigned)gtab[R0 + 128] * K2 + cb0; oA3 = (unsigned)gtab[R0 + 192] * K2 + cb0;
    } else {
        oA0 = (unsigned)(cur.rowbase + R0) * K2 + cb0;
    }
    oN0 = oA0; oN1 = oA1; oN2 = oA2; oN3 = oA3;
    const char* cB = Bbase + cur.boff;
    PG8_STAGE(PG8_SB(0, 0), cB); PG8_STAGE(PG8_SB(0, 1), cB + hstep); PG8_STAGEA0(PG8_SA(0, 0), (size_t)0, oA0, oA1); PG8_STAGEA1(PG8_SA(0, 1), (size_t)0, oA0, oA2, oA3);
    if (wr == 1) PG8_BAR;
    PG8_WAIT_V(2); PG8_BAR;
    PG8_STAGE(PG8_SB(1, 0), cB + kstep); PG8_STAGEA0(PG8_SA(1, 0), kstep, oA0, oA1); PG8_STAGE(PG8_SB(1, 1), cB + hstep + kstep);
    PG8_WAIT_V(6); PG8_BAR;
    for (;;) {
        const bool has_next = ld_unit(ul, ui + 1, nxt);
        if constexpr (Epi::HAS_PRE) E.pre(cur, epl + (ui & 1) * Epi::PRE_BYTES, wid, lane);
        const char* nB = has_next ? Bbase + nxt.boff : cB;
_Pragma("unroll 1")
        for (int t = 0; t < nt; t += 2) {
            const bool last = (t == nt - 2);
            if (last && has_next) {
                if constexpr (GATHER) {
                    const LAS int* gt = gtab + (ui + 1) * 256;
                    oN0 = (unsigned)gt[R0] * K2 + cb0; oN1 = (unsigned)gt[R0 + 64] * K2 + cb0; oN2 = (unsigned)gt[R0 + 128] * K2 + cb0; oN3 = (unsigned)gt[R0 + 192] * K2 + cb0;
                } else {
                    oN0 = (unsigned)(nxt.rowbase + R0) * K2 + cb0;
                }
            }
            const size_t kb1 = (size_t)(t + 1) * kstep;
            const size_t kb2 = last ? (size_t)0 : (size_t)(t + 2) * kstep, kb3 = kb2 + kstep;
            const unsigned p0 = last ? oN0 : oA0, p1 = last ? oN1 : oA1, p2 = last ? oN2 : oA2, p3 = last ? oN3 : oA3;
            const char* b2 = last ? nB : cB + (size_t)(t + 2) * kstep; const char* b3 = b2 + kstep;
            PG8_LDB(B0, 0, 0); PG8_LDB(B1, 0, 1); PG8_SCHED; PG8_LDA(At, 0, 0); PG8_STAGEA1(PG8_SA(1, 1), kb1, oA0, oA2, oA3);
            PG8_WAIT_V(8); PG8_WAIT_L(0); PG8_BAR; PG8_MMA(0, 0, At, B0); PG8_MMA(0, 1, At, B1); PG8_BAR; PG8_SCHED;
            PG8_LDA(At, 0, 1); PG8_STAGE(PG8_SB(0, 0), b2); PG8_STAGE(PG8_SB(0, 1), b2 + hstep); PG8_STAGEA0(PG8_SA(0, 0), kb2, p0, p1);
            PG8_WAIT_V(8); PG8_WAIT_L(0); PG8_BAR; PG8_MMA(1, 0, At, B0); PG8_MMA(1, 1, At, B1); PG8_BAR; PG8_SCHED;
            PG8_LDB(B0, 1, 0); PG8_LDB(B1, 1, 1); PG8_SCHED; PG8_LDA(At, 1, 0); PG8_STAGEA1(PG8_SA(0, 1), kb2, p0, p2, p3);
            PG8_WAIT_V(8); PG8_WAIT_L(0); PG8_BAR; PG8_MMA(0, 0, At, B0); PG8_MMA(0, 1, At, B1); PG8_BAR; PG8_SCHED;
            PG8_LDA(At, 1, 1); PG8_STAGE(PG8_SB(1, 0), b3); PG8_STAGE(PG8_SB(1, 1), b3 + hstep); PG8_STAGEA0(PG8_SA(1, 0), kb3, p0, p1);
            PG8_WAIT_V(8); PG8_WAIT_L(0); PG8_BAR; PG8_MMA(1, 0, At, B0); PG8_MMA(1, 1, At, B1); PG8_BAR; PG8_SCHED;
        }
        if constexpr (FP8) asm volatile("s_nop 7\n\ts_nop 7\n\ts_nop 7" ::: "memory");
        if constexpr (ALIGN_EPI) { if (wr == 0) PG8_BAR; }
        if constexpr (Epi::HAS_PRE) E(acc, cur, wr, wc, fr, fq, epl + (ui & 1) * Epi::PRE_BYTES); else E(acc, cur, wr, wc, fr, fq);
#if PROBE_EPI2
        if constexpr (FP8) { if constexpr (Epi::HAS_PRE) E(acc, cur, wr, wc, fr, fq, epl + (ui & 1) * Epi::PRE_BYTES); else E(acc, cur, wr, wc, fr, fq); }
#endif
        if (!has_next) break;
#pragma unroll
        for (int a = 0; a < 2; ++a)
#pragma unroll
            for (int b = 0; b < 2; ++b)
#pragma unroll
                for (int m = 0; m < 4; ++m)
#pragma unroll
                    for (int n = 0; n < 2; ++n) acc[a][b][m][n] = (f32x4){0.f, 0.f, 0.f, 0.f};
        cur = nxt; cB = nB; oA0 = oN0; oA1 = oN1; oA2 = oN2; oA3 = oN3; ++ui;
        if constexpr (ALIGN_EPI) { if (wr == 1) PG8_BAR; }
    }
    PG8_WAIT_V(0);
    if constexpr (!ALIGN_EPI) { if (wr == 0) PG8_BAR; }
    PG8_BAR;
#undef PG8_SA
#undef PG8_SB
#undef PG8_STAGE
#undef PG8_STAGEA0
#undef PG8_STAGEA1
#undef PG8_LDA
#undef PG8_LDB
#undef PG8_LO
#undef PG8_HI
#undef PG8_MMA
#undef PG8_WAIT_V
#undef PG8_WAIT_L
#undef PG8_BAR
#undef PG8_SCHED
}

__device__ __forceinline__ GAS unsigned char* launder(unsigned char* p) { asm volatile("" : "+s"(p)); return (GAS unsigned char*)p; }
#define OPAQUE_LANE(fr, fq) asm volatile("" : "+v"(fr), "+v"(fq))
struct EpiHgrnIn {
    static constexpr bool PERM = true, HAS_PRE = true; static constexpr int PRE_BYTES = 1024;
    unsigned char* ws0; int L;
    __device__ __forceinline__ void pre(const Unit& u, LAS unsigned char* buf, int wid, int lane) const {
        if (wid == 0 && u.pn < 8) glds16((const char*)(ws0 + WS_LBS) + ((size_t)L * DM + (size_t)u.pn * HG_K) * 4, (unsigned)lane * 16u, buf);
    }
    __device__ __forceinline__ void operator()(const f32x4 (&acc)[2][2][4][2], const Unit& u, int wr, int wc, int fr, int fq, const LAS unsigned char* buf) const {
        OPAQUE_LANE(fr, fq);
        GAS unsigned char* ws = launder(ws0);
        GAS bf16* QD = (GAS bf16*)(ws + WS_H);
        const int row0 = u.rowbase + wr * 64 + fr;
        if (u.pn >= 8) {
            const bool isg = u.pn >= 12; GAS bf16* base = QD + (size_t)(isg ? 4 : 3) * NTOK * DM; const int colt = (u.pn - (isg ? 12 : 8)) * BM + wc * 32 + 8 * fq;
#pragma unroll
            for (int ai = 0; ai < 2; ++ai)
#pragma unroll
                for (int m = 0; m < 4; ++m) { GAS bf16* rowp = base + (size_t)(row0 + ai * HALF + m * 16) * DM + colt;
#pragma unroll
                    for (int bj = 0; bj < 2; ++bj) { f32x4 v0 = acc[ai][bj][m][0], v1 = acc[ai][bj][m][1];
                        if (isg) {
#pragma unroll
                            for (int j = 0; j < 4; ++j) { v0[j] = v0[j] * fsigmoid(v0[j]); v1[j] = v1[j] * fsigmoid(v1[j]); } }
                        v4u w; w.x = cvt_pk_bf16(v0[0], v0[1]); w.y = cvt_pk_bf16(v0[2], v0[3]); w.z = cvt_pk_bf16(v1[0], v1[1]); w.w = cvt_pk_bf16(v1[2], v1[3]);
                        *(GAS v4u*)(rowp + bj * HALF) = w; } }
            return;
        }
        const int col = u.pn * HG_K + wc * 32 + 8 * fq;
        const LAS float* lb = (const LAS float*)buf + wc * 32 + 8 * fq;
        const f32x4 lb0 = *(const LAS f32x4*)lb, lb1 = *(const LAS f32x4*)(lb + 4);
#if !SLOW_HGRN
        const int lane = fq * 16 + fr;
        GAS float* DEC = (GAS float*)(ws + WS_DEC);
#endif
#pragma unroll
        for (int ai = 0; ai < 2; ++ai)
#pragma unroll
            for (int m = 0; m < 4; ++m) {
                const int row = row0 + ai * HALF + m * 16;
                float qd[8], ki[8];
#if SLOW_HGRN
                float ks[8];
#endif
#if !SLOW_HGRN
                float de[8];
#endif
#pragma unroll
                for (int j = 0; j < 8; ++j) {
                    const float q = acc[ai][0][m][j >> 2][j & 3], f = acc[ai][1][m][j >> 2][j & 3], lbv = j < 4 ? lb0[j & 3] : lb1[j & 3];
                    const float sg = fsigmoid(f), fg = lbv + (1.0f - lbv) * sg, kk = (1.0f - lbv) * (1.0f - sg);
#if SLOW_HGRN
                    qd[j] = q * fsigmoid(q); ki[j] = kk; ks[j] = fg;
#else
                    float P = fg;
                    P *= __builtin_bit_cast(float, __builtin_amdgcn_update_dpp(0x3f800000, __builtin_bit_cast(int, P), 0x111, 0xf, 0xf, false));
                    P *= __builtin_bit_cast(float, __builtin_amdgcn_update_dpp(0x3f800000, __builtin_bit_cast(int, P), 0x112, 0xf, 0xf, false));
                    P *= __builtin_bit_cast(float, __builtin_amdgcn_update_dpp(0x3f800000, __builtin_bit_cast(int, P), 0x114, 0xf, 0xf, false));
                    P *= __builtin_bit_cast(float, __builtin_amdgcn_update_dpp(0x3f800000, __builtin_bit_cast(int, P), 0x118, 0xf, 0xf, false));
                    const float Pl = __shfl(P, lane | 15), iP = frcp(fmaxf(P, 1e-30f));
                    qd[j] = q * fsigmoid(q) * P; ki[j] = kk * iP; de[j] = Pl;
#endif
                }
                const size_t o = (size_t)row * DM + col;
                v4u w;
                w.x = cvt_pk_bf16(qd[0], qd[1]); w.y = cvt_pk_bf16(qd[2], qd[3]); w.z = cvt_pk_bf16(qd[4], qd[5]); w.w = cvt_pk_bf16(qd[6], qd[7]); *(GAS v4u*)(QD + o) = w;
                w.x = cvt_pk_bf16(ki[0], ki[1]); w.y = cvt_pk_bf16(ki[2], ki[3]); w.z = cvt_pk_bf16(ki[4], ki[5]); w.w = cvt_pk_bf16(ki[6], ki[7]); *(GAS v4u*)(QD + (size_t)NTOK * DM + o) = w;
#if SLOW_HGRN
                w.x = cvt_pk_bf16(ks[0], ks[1]); w.y = cvt_pk_bf16(ks[2], ks[3]); w.z = cvt_pk_bf16(ks[4], ks[5]); w.w = cvt_pk_bf16(ks[6], ks[7]); *(GAS v4u*)(QD + 2 * (size_t)NTOK * DM + o) = w;
#endif
#if !SLOW_HGRN
                if (fr == 0) { GAS float* dp = DEC + (size_t)(row >> 4) * DM + col; *(GAS f32x4*)dp = (f32x4){de[0], de[1], de[2], de[3]}; *(GAS f32x4*)(dp + 4) = (f32x4){de[4], de[5], de[6], de[7]}; }
#endif
            }
    }
};
struct EpiRetIn {
    static constexpr bool PERM = true, HAS_PRE = false; static constexpr int PRE_BYTES = 0;
    unsigned char* ws0;
    __device__ __forceinline__ void operator()(const f32x4 (&acc)[2][2][4][2], const Unit& u, int wr, int wc, int fr, int fq) const {
        OPAQUE_LANE(fr, fq);
        GAS unsigned char* ws = launder(ws0);
        GAS bf16* H = (GAS bf16*)(ws + WS_H); const GAS float* rot = (const GAS float*)(ws + WS_ROT);
        const int row0 = u.rowbase + wr * 64 + fr; const int colt = u.pn * BM + wc * 32 + 8 * fq;
        const int kind = u.pn < 4 ? 0 : (u.pn < 8 ? 1 : (u.pn < 16 ? 2 : 3));
#pragma unroll
        for (int ai = 0; ai < 2; ++ai)
#pragma unroll
            for (int m = 0; m < 4; ++m) { const int row = row0 + ai * HALF + m * 16; GAS bf16* rowp = H + (size_t)row * RT_IN + colt; const int pos = row & (SEQ - 1);
#pragma unroll
                for (int bj = 0; bj < 2; ++bj) { f32x4 v0 = acc[ai][bj][m][0], v1 = acc[ai][bj][m][1];
                    if (kind <= 1) {
                        const int p0 = (bj * HALF + wc * 32 + 8 * fq) >> 1;
                        const GAS float* rp = rot + ((size_t)pos * 128 + p0) * 2;
                        const f32x4 r0 = *(const GAS f32x4*)rp, r1 = *(const GAS f32x4*)(rp + 4);
                        const float sc = kind == 1 ? 0.0625f : 1.0f;
                        f32x4 o0, o1;
                        o0[0] = (v0[0] * r0[0] - v0[1] * r0[1]) * sc; o0[1] = (v0[1] * r0[0] + v0[0] * r0[1]) * sc;
                        o0[2] = (v0[2] * r0[2] - v0[3] * r0[3]) * sc; o0[3] = (v0[3] * r0[2] + v0[2] * r0[3]) * sc;
                        o1[0] = (v1[0] * r1[0] - v1[1] * r1[1]) * sc; o1[1] = (v1[1] * r1[0] + v1[0] * r1[1]) * sc;
                        o1[2] = (v1[2] * r1[2] - v1[3] * r1[3]) * sc; o1[3] = (v1[3] * r1[2] + v1[2] * r1[3]) * sc;
                        v0 = o0; v1 = o1;
                    } else if (kind == 3) {
#pragma unroll
                        for (int j = 0; j < 4; ++j) { v0[j] = v0[j] * fsigmoid(v0[j]); v1[j] = v1[j] * fsigmoid(v1[j]); }
                    }
                    v4u w; w.x = cvt_pk_bf16(v0[0], v0[1]); w.y = cvt_pk_bf16(v0[2], v0[3]); w.z = cvt_pk_bf16(v1[0], v1[1]); w.w = cvt_pk_bf16(v1[2], v1[3]);
                    *(GAS v4u*)(rowp + bj * HALF) = w; } }
    }
};
struct EpiRes {
    static constexpr bool PERM = true, HAS_PRE = false; static constexpr int PRE_BYTES = 0;
    unsigned char* ws0; int ssoff; float ds;
    __device__ __forceinline__ void operator()(const f32x4 (&acc)[2][2][4][2], const Unit& u, int wr, int wc, int fr, int fq) const {
        OPAQUE_LANE(fr, fq);
        GAS unsigned char* ws = launder(ws0);
        GAS bf16* Y = (GAS bf16*)(ws + WS_Y); const GAS bf16* X = (const GAS bf16*)(ws + WS_XB);
        const int row0 = u.rowbase + wr * 64 + fr, col0 = u.pn * BM + wc * 32 + 8 * fq;
#pragma unroll
        for (int ai = 0; ai < 2; ++ai)
#pragma unroll
            for (int m = 0; m < 4; ++m) { const size_t off = (size_t)(row0 + ai * HALF + m * 16) * DM + col0;
                float rsc = 1.0f;
                if (ssoff >= 0) { const GAS float* sp = (const GAS float*)(ws + WS_SSP) + row0 + ai * HALF + m * 16; float ssum = 0.f;
#pragma unroll
                    for (int hh = 0; hh < HG_HEADS; ++hh) ssum += sp[(size_t)hh * NTOK];
                    rsc = 1.0f / sqrtf(ssum * (1.0f / DM) + RMS_EPS); }
#pragma unroll
                for (int bj = 0; bj < 2; ++bj) { const v4u xs = *(const GAS v4u*)(X + off + bj * HALF); const f32x4 a0 = acc[ai][bj][m][0] * (rsc * ds), a1 = acc[ai][bj][m][1] * (rsc * ds);
                    v4u w; w.x = cvt_pk_bf16(bflo(xs.x) * DN_ALPHA + a0[0], bfhi(xs.x) * DN_ALPHA + a0[1]); w.y = cvt_pk_bf16(bflo(xs.y) * DN_ALPHA + a0[2], bfhi(xs.y) * DN_ALPHA + a0[3]);
                    w.z = cvt_pk_bf16(bflo(xs.z) * DN_ALPHA + a1[0], bfhi(xs.z) * DN_ALPHA + a1[1]); w.w = cvt_pk_bf16(bflo(xs.w) * DN_ALPHA + a1[2], bfhi(xs.w) * DN_ALPHA + a1[3]);
                    *(GAS v4u*)(Y + off + bj * HALF) = w; } }
    }
};
struct EpiMoeGU {
    static constexpr bool PERM = true, HAS_PRE = true; static constexpr int PRE_BYTES = 1024;
    unsigned char* ws0; int L;
    __device__ __forceinline__ void pre(const Unit& u, LAS unsigned char* buf, int wid, int lane) const {
        if (wid == 0) glds16((const char*)(ws0 + WS_BGU) + ((size_t)L * NE * 2048 + ((size_t)u.e * 8 + u.pn) * 256) * 4, (unsigned)lane * 16u, buf);
    }
    __device__ __forceinline__ void operator()(const f32x4 (&acc)[2][2][4][2], const Unit& u, int wr, int wc, int fr, int fq, const LAS unsigned char* buf) const {
        OPAQUE_LANE(fr, fq);
        GAS unsigned char* ws = launder(ws0);
        const int row0 = u.rowbase + wr * 64 + fr; const int c8 = wc * 32 + 8 * fq;
        const LAS float* bp = (const LAS float*)buf + c8;
        const f32x4 bg0 = *(const LAS f32x4*)bp, bg1 = *(const LAS f32x4*)(bp + 4);
        const f32x4 bl0 = (*(const LAS f32x4*)(bp + HALF) + 1.0f) * ACT_SCALE, bl1 = (*(const LAS f32x4*)(bp + HALF + 4) + 1.0f) * ACT_SCALE;
#pragma unroll
        for (int ai = 0; ai < 2; ++ai)
#pragma unroll
            for (int m = 0; m < 4; ++m) { const size_t eo = (size_t)(row0 + ai * HALF + m * 16) * DM + u.pn * HALF + c8;
                float a[8];
#pragma unroll
                for (int j = 0; j < 8; ++j) {
                    const float g = fminf(fmaf(acc[ai][0][m][j >> 2][j & 3], GU_DESCALE, j < 4 ? bg0[j & 3] : bg1[j & 3]), 7.0f);
                    const float l1 = __builtin_amdgcn_fmed3f(fmaf(acc[ai][1][m][j >> 2][j & 3], GU_DESCALE * ACT_SCALE, j < 4 ? bl0[j & 3] : bl1[j & 3]), -6.0f * ACT_SCALE, 8.0f * ACT_SCALE);
                    a[j] = g * frcp(1.0f + __builtin_amdgcn_exp2f(g * -2.4554669595930156f)) * l1;
                }
#if MOE_FP8
                v2u w;
                { int p = __builtin_amdgcn_cvt_pk_fp8_f32(a[0], a[1], 0, false); p = __builtin_amdgcn_cvt_pk_fp8_f32(a[2], a[3], p, true); w.x = (unsigned)p; }
                { int p = __builtin_amdgcn_cvt_pk_fp8_f32(a[4], a[5], 0, false); p = __builtin_amdgcn_cvt_pk_fp8_f32(a[6], a[7], p, true); w.y = (unsigned)p; }
                *(GAS v2u*)(ws + WS_ACT + eo) = w;
#else
                v4u w; w.x = cvt_pk_bf16(a[0], a[1]); w.y = cvt_pk_bf16(a[2], a[3]); w.z = cvt_pk_bf16(a[4], a[5]); w.w = cvt_pk_bf16(a[6], a[7]);
                *(GAS v4u*)((GAS bf16*)(ws + WS_ACT) + eo) = w;
#endif
            }
    }
};
struct EpiMoeDown {
    static constexpr bool PERM = true, HAS_PRE = true; static constexpr int PRE_BYTES = 3072;
    unsigned char* ws0; const float* bias;
    __device__ __forceinline__ void pre(const Unit& u, LAS unsigned char* buf, int wid, int lane) const {
        if (wid == 0) glds16((const char*)(bias + (size_t)u.e * DM + u.pn * BM), (unsigned)lane * 16u, buf);
        if (wid == 1) glds16((const char*)(ws0 + WS_ROWDST) + (size_t)u.gidx * 4, (unsigned)lane * 16u, buf + 1024);
        if (wid == 2) glds16((const char*)(ws0 + WS_ROWGATE) + (size_t)u.gidx * 4, (unsigned)lane * 16u, buf + 2048);
    }
    __device__ __forceinline__ void operator()(const f32x4 (&acc)[2][2][4][2], const Unit& u, int wr, int wc, int fr, int fq, const LAS unsigned char* buf) const {
        OPAQUE_LANE(fr, fq);
        GAS unsigned char* ws = launder(ws0);
        GAS bf16* YS = (GAS bf16*)(ws + WS_YSLOT);
        const int c8 = u.pn * BM + wc * 32 + 8 * fq;
        const LAS float* bp = (const LAS float*)buf + wc * 32 + 8 * fq;
        f32x4 bv[2][2];
#pragma unroll
        for (int bj = 0; bj < 2; ++bj) { bv[bj][0] = *(const LAS f32x4*)(bp + bj * HALF); bv[bj][1] = *(const LAS f32x4*)(bp + bj * HALF + 4); }
#pragma unroll
        for (int ai = 0; ai < 2; ++ai)
#pragma unroll
            for (int m = 0; m < 4; ++m) { const int r = ai * HALF + wr * 64 + m * 16 + fr;
                if (r < u.cnt) {
                    const int dst = ((const LAS int*)(buf + 1024))[r]; const float gt = ((const LAS float*)(buf + 2048))[r];
#if YS_FP8
                    GAS unsigned char* rowp = (GAS unsigned char*)YS + (size_t)dst * DM + c8;
#pragma unroll
                    for (int bj = 0; bj < 2; ++bj) { const f32x4 v0 = (acc[ai][bj][m][0] * DN_DESCALE + bv[bj][0]) * (gt * 64.0f), v1 = (acc[ai][bj][m][1] * DN_DESCALE + bv[bj][1]) * (gt * 64.0f);
                        v2u w; w.x = pk4_fp8(v0[0], v0[1], v0[2], v0[3]); w.y = pk4_fp8(v1[0], v1[1], v1[2], v1[3]);
                        *(GAS v2u*)(rowp + bj * HALF) = w; } } }
#else
                    GAS bf16* rowp = YS + (size_t)dst * DM + c8;
#pragma unroll
                    for (int bj = 0; bj < 2; ++bj) { const f32x4 v0 = (acc[ai][bj][m][0] * DN_DESCALE + bv[bj][0]) * gt, v1 = (acc[ai][bj][m][1] * DN_DESCALE + bv[bj][1]) * gt;
                        v4u w; w.x = cvt_pk_bf16(v0[0], v0[1]); w.y = cvt_pk_bf16(v0[2], v0[3]); w.z = cvt_pk_bf16(v1[0], v1[1]); w.w = cvt_pk_bf16(v1[2], v1[3]);
                        *(GAS v4u*)(rowp + bj * HALF) = w; } } }
#endif
    }
};
}

typedef short s16x4 __attribute__((ext_vector_type(4)));
typedef __bf16 bf16x2_t __attribute__((ext_vector_type(2)));
__device__ __forceinline__ unsigned cvtpk(float lo, float hi) { f32x2 v = {lo, hi}; bf16x2_t b = __builtin_convertvector(v, bf16x2_t); return __builtin_bit_cast(unsigned, b); }
__device__ __forceinline__ s16x4 tr_read(const LAS unsigned char* p) { return __builtin_bit_cast(s16x4, __builtin_amdgcn_ds_read_tr16_b64_v4i16((LAS s16x4*)p)); }
__device__ __forceinline__ bf16x8 cat8(s16x4 lo, s16x4 hi) { return __builtin_shufflevector(lo, hi, 0, 1, 2, 3, 4, 5, 6, 7); }
__device__ __forceinline__ bf16x8 pack8(const f32x4& a, const f32x4& b) { v4u p; p.x = cvtpk(a[0], a[1]); p.y = cvtpk(a[2], a[3]); p.z = cvtpk(b[0], b[1]); p.w = cvtpk(b[2], b[3]); return __builtin_bit_cast(bf16x8, p); }
__device__ __forceinline__ s16x4 pack4(const f32x4& a) { v2u p; p.x = cvtpk(a[0], a[1]); p.y = cvtpk(a[2], a[3]); return __builtin_bit_cast(s16x4, p); }
#define LDS_BARRIER() do { asm volatile("s_waitcnt lgkmcnt(0)" ::: "memory"); __builtin_amdgcn_s_barrier(); asm volatile("" ::: "memory"); } while (0)
#define MFMA32(a, b, c) __builtin_amdgcn_mfma_f32_16x16x32_bf16((a), (b), (c), 0, 0, 0)
#define MFMA16(a, b, c) __builtin_amdgcn_mfma_f32_16x16x16bf16_1k((a), (b), (c), 0, 0, 0)

__device__ __forceinline__ void ret_fast(const int tid, LAS unsigned char* lds, const bf16* HB, bf16* OB) {
    constexpr int QP = 528, VP = 272, PP = 144;
    constexpr int OFF_Q = 0, OFF_K = 64 * QP, OFF_V = 2 * 64 * QP, OFF_P = OFF_V + 64 * VP;
    const int lane0 = tid & 63, w = __builtin_amdgcn_readfirstlane(tid >> 6);
    const int prow = tid >> 3, pc = tid & 7;
    for (int un0 = blockIdx.x; un0 < NBATCH * RT_HEADS * 4; un0 += gridDim.x) {
        const int un = (gridDim.x == 256) ? ((un0 & 7) * 32 + (un0 >> 3)) : un0;
        const int b = un >> 4, h = (un >> 2) & 3, vs = un & 3;
        const float l2g = __builtin_amdgcn_logf(1.0f - __builtin_amdgcn_exp2f(-5.0f - (float)h));
        const float dC = __builtin_amdgcn_exp2f(64.0f * l2g);
        f32x4 st[16];
#pragma unroll
        for (int i = 0; i < 16; ++i) st[i] = (f32x4){0.f, 0.f, 0.f, 0.f};
        const bf16* gbase = HB + (size_t)(b * SEQ + prow) * RT_IN;
        v4u pq[4], pk[4], pv[2];
#pragma unroll
        for (int j = 0; j < 4; ++j) { pq[j] = *(const v4u*)(gbase + h * 256 + (pc + 8 * j) * 8); pk[j] = *(const v4u*)(gbase + 1024 + h * 256 + (pc + 8 * j) * 8); }
#pragma unroll
        for (int j = 0; j < 2; ++j) pv[j] = *(const v4u*)(gbase + 2048 + h * 512 + vs * 128 + (pc + 8 * j) * 8);
#pragma unroll 1
        for (int ch = 0; ch < SEQ / 64; ++ch) {
            int lane = lane0; asm volatile("" : "+v"(lane));
            const int r = lane & 15, g = lane >> 4, q4 = (lane & 15) >> 2, p4 = lane & 3;
            LDS_BARRIER();
#pragma unroll
            for (int j = 0; j < 4; ++j) { *(LAS v4u*)(lds + OFF_Q + prow * QP + (pc + 8 * j) * 16) = pq[j]; *(LAS v4u*)(lds + OFF_K + prow * QP + (pc + 8 * j) * 16) = pk[j]; }
#pragma unroll
            for (int j = 0; j < 2; ++j) *(LAS v4u*)(lds + OFF_V + prow * VP + (pc + 8 * j) * 16) = pv[j];
            if (ch + 1 < SEQ / 64) {
                const bf16* gn = gbase + (size_t)(ch + 1) * 64 * RT_IN;
#pragma unroll
                for (int j = 0; j < 4; ++j) { pq[j] = *(const v4u*)(gn + h * 256 + (pc + 8 * j) * 8); pk[j] = *(const v4u*)(gn + 1024 + h * 256 + (pc + 8 * j) * 8); }
#pragma unroll
                for (int j = 0; j < 2; ++j) pv[j] = *(const v4u*)(gn + 2048 + h * 512 + vs * 128 + (pc + 8 * j) * 8);
            }
            LDS_BARRIER();
            {
                const int ct = w >> 1, st0 = 2 * (w & 1);
                f32x4 sa0 = {0.f, 0.f, 0.f, 0.f}, sa1 = {0.f, 0.f, 0.f, 0.f};
                const LAS unsigned char* qb = lds + OFF_Q + (16 * ct + r) * QP + g * 16;
                const LAS unsigned char* kb0 = lds + OFF_K + (16 * st0 + r) * QP + g * 16;
#pragma unroll
                for (int hb = 0; hb < 4; ++hb) {
                    bf16x8 qf[2], k0[2], k1[2];
#pragma unroll
                    for (int kk = 0; kk < 2; ++kk) { const int kb = hb * 2 + kk; qf[kk] = *(const LAS bf16x8*)(qb + kb * 64); k0[kk] = *(const LAS bf16x8*)(kb0 + kb * 64); k1[kk] = *(const LAS bf16x8*)(kb0 + 16 * QP + kb * 64); }
                    asm volatile("" : "+v"(qf[0]), "+v"(qf[1]), "+v"(k0[0]), "+v"(k0[1]), "+v"(k1[0]), "+v"(k1[1]) :: "memory");
#pragma unroll
                    for (int kk = 0; kk < 2; ++kk) { sa0 = MFMA32(k0[kk], qf[kk], sa0); sa1 = MFMA32(k1[kk], qf[kk], sa1); }
                }
                const int c = 16 * ct + r;
#pragma unroll
                for (int t = 0; t < 2; ++t) {
                    const f32x4 sa = t ? sa1 : sa0; const int s0 = 16 * (st0 + t) + 4 * g; float v[4];
#pragma unroll
                    for (int i = 0; i < 4; ++i) { const int d = c - (s0 + i); v[i] = d >= 0 ? sa[i] * __builtin_amdgcn_exp2f((float)d * l2g) : 0.f; }
                    v2u pw; pw.x = cvtpk(v[0], v[1]); pw.y = cvtpk(v[2], v[3]);
                    *(LAS v2u*)(lds + OFF_P + c * PP + s0 * 2) = pw;
                }
            }
            LDS_BARRIER();
            f32x4 o[4];
#pragma unroll
            for (int ct = 0; ct < 4; ++ct) o[ct] = (f32x4){0.f, 0.f, 0.f, 0.f};
            {
                s16x4 ql[2][4], qh[2][4];
                const LAS unsigned char* qp0 = lds + OFF_Q + r * QP + (4 * g) * 2;
#pragma unroll
                for (int ct = 0; ct < 4; ++ct) { ql[0][ct] = *(const LAS s16x4*)(qp0 + ct * 16 * QP); qh[0][ct] = *(const LAS s16x4*)(qp0 + ct * 16 * QP + 32); }
#pragma unroll
                for (int kb = 0; kb < 8; ++kb) {
                    const int cu = kb & 1, nx = cu ^ 1;
                    if (kb + 1 < 8) {
#pragma unroll
                        for (int ct = 0; ct < 4; ++ct) { ql[nx][ct] = *(const LAS s16x4*)(qp0 + ct * 16 * QP + (kb + 1) * 64); qh[nx][ct] = *(const LAS s16x4*)(qp0 + ct * 16 * QP + (kb + 1) * 64 + 32); }
                    }
                    asm volatile("" : "+v"(ql[cu][0]), "+v"(ql[cu][1]), "+v"(ql[cu][2]), "+v"(ql[cu][3]), "+v"(qh[cu][0]), "+v"(qh[cu][1]), "+v"(qh[cu][2]), "+v"(qh[cu][3]) :: "memory");
                    const bf16x8 sa = pack8(st[2 * kb], st[2 * kb + 1]);
#pragma unroll
                    for (int ct = 0; ct < 4; ++ct) o[ct] = MFMA32(sa, cat8(ql[cu][ct], qh[cu][ct]), o[ct]);
                }
            }
            bf16x8 vf[2], pf[6];
            {
                s16x4 t0[2], t1[2];
#pragma unroll
                for (int sb = 0; sb < 2; ++sb) { const LAS unsigned char* vp = lds + OFF_V + (32 * sb + 8 * g + q4) * VP + (16 * w + 4 * p4) * 2; t0[sb] = tr_read(vp); t1[sb] = tr_read(vp + 4 * VP); }
                pf[0] = *(const LAS bf16x8*)(lds + OFF_P + (0 + r) * PP + (8 * g) * 2);
                pf[1] = *(const LAS bf16x8*)(lds + OFF_P + (16 + r) * PP + (8 * g) * 2);
                pf[2] = *(const LAS bf16x8*)(lds + OFF_P + (32 + r) * PP + (8 * g) * 2);
                pf[3] = *(const LAS bf16x8*)(lds + OFF_P + (32 + r) * PP + (32 + 8 * g) * 2);
                pf[4] = *(const LAS bf16x8*)(lds + OFF_P + (48 + r) * PP + (8 * g) * 2);
                pf[5] = *(const LAS bf16x8*)(lds + OFF_P + (48 + r) * PP + (32 + 8 * g) * 2);
                asm volatile("" : "+v"(t0[0]), "+v"(t0[1]), "+v"(t1[0]), "+v"(t1[1]), "+v"(pf[0]), "+v"(pf[1]), "+v"(pf[2]), "+v"(pf[3]), "+v"(pf[4]), "+v"(pf[5]) :: "memory");
                vf[0] = cat8(t0[0], t1[0]); vf[1] = cat8(t0[1], t1[1]);
            }
#pragma unroll
            for (int ct = 0; ct < 4; ++ct) o[ct] = o[ct] * __builtin_amdgcn_exp2f((float)(16 * ct + r + 1) * l2g);
            o[0] = MFMA32(vf[0], pf[0], o[0]); o[1] = MFMA32(vf[0], pf[1], o[1]);
            o[2] = MFMA32(vf[0], pf[2], o[2]); o[2] = MFMA32(vf[1], pf[3], o[2]);
            o[3] = MFMA32(vf[0], pf[4], o[3]); o[3] = MFMA32(vf[1], pf[5], o[3]);
            {
                bf16* ob = OB + (size_t)(b * SEQ + ch * 64 + r) * RT_VD + h * 512 + vs * 128 + 16 * w + 4 * g;
#pragma unroll
                for (int ct = 0; ct < 4; ++ct) { v2u ow; ow.x = cvtpk(o[ct][0], o[ct][1]); ow.y = cvtpk(o[ct][2], o[ct][3]); *(v2u*)(ob + (size_t)ct * 16 * RT_VD) = ow; }
            }
            bf16x8 vz[2];
#pragma unroll
            for (int sb = 0; sb < 2; ++sb) {
                const v4u raw = __builtin_bit_cast(v4u, vf[sb]); float f[8] = {bflo(raw.x), bfhi(raw.x), bflo(raw.y), bfhi(raw.y), bflo(raw.z), bfhi(raw.z), bflo(raw.w), bfhi(raw.w)};
#pragma unroll
                for (int j = 0; j < 8; ++j) f[j] *= __builtin_amdgcn_exp2f((float)(63 - (32 * sb + 8 * g + j)) * l2g);
                v4u z; z.x = cvtpk(f[0], f[1]); z.y = cvtpk(f[2], f[3]); z.z = cvtpk(f[4], f[5]); z.w = cvtpk(f[6], f[7]); vz[sb] = __builtin_bit_cast(bf16x8, z);
            }
            {
                const LAS unsigned char* kp0 = lds + OFF_K + (8 * g + q4) * QP + (4 * p4) * 2;
#pragma unroll
                for (int kq = 0; kq < 4; ++kq) {
                    s16x4 ka[4][2], kbh[4][2];
#pragma unroll
                    for (int j = 0; j < 4; ++j)
#pragma unroll
                        for (int sb = 0; sb < 2; ++sb) { const LAS unsigned char* kp = kp0 + (32 * sb) * QP + (16 * (kq * 4 + j)) * 2; ka[j][sb] = tr_read(kp); kbh[j][sb] = tr_read(kp + 4 * QP); }
                    asm volatile("" : "+v"(ka[0][0]), "+v"(ka[0][1]), "+v"(ka[1][0]), "+v"(ka[1][1]), "+v"(ka[2][0]), "+v"(ka[2][1]), "+v"(ka[3][0]), "+v"(ka[3][1]),
                                      "+v"(kbh[0][0]), "+v"(kbh[0][1]), "+v"(kbh[1][0]), "+v"(kbh[1][1]), "+v"(kbh[2][0]), "+v"(kbh[2][1]), "+v"(kbh[3][0]), "+v"(kbh[3][1]) :: "memory");
#pragma unroll
                    for (int j = 0; j < 4; ++j) { const int kt = kq * 4 + j;
                        st[kt] = st[kt] * dC;
                        st[kt] = MFMA32(cat8(ka[j][0], kbh[j][0]), vz[0], st[kt]);
                        st[kt] = MFMA32(cat8(ka[j][1], kbh[j][1]), vz[1], st[kt]); }
                }
            }
        }
        LDS_BARRIER();
    }
}

__device__ __forceinline__ void hgrn_fast(const int tid, LAS unsigned char* lds, const bf16* QD, const bf16* KI, const bf16* GG, const bf16* VV, const float* DEC, const float* ng, bf16* A2, float* SS) {
    constexpr int TP = 272;
    constexpr int OFF_QD = 0, OFF_KI = 64 * TP, OFF_G = 2 * 64 * TP, OFF_V = 3 * 64 * TP, OFF_DEC = 4 * 64 * TP, OFF_SS = OFF_DEC + 2048;
    const int lane = tid & 63, w = __builtin_amdgcn_readfirstlane(tid >> 6), r = lane & 15, g = lane >> 4, q4 = (lane & 15) >> 2, p4 = lane & 3;
    const int prow = tid >> 3, pc = tid & 7;
    for (int un = blockIdx.x; un < NBATCH * HG_HEADS; un += gridDim.x) {
        const int b = un >> 3, h = un & 7;
        f32x4 st[8];
#pragma unroll
        for (int i = 0; i < 8; ++i) st[i] = (f32x4){0.f, 0.f, 0.f, 0.f};
        const f32x4 ng4 = *(const f32x4*)(ng + h * 128 + 16 * w + 4 * g);
        const size_t goff = (size_t)(b * SEQ + prow) * DM + h * 128;
        v4u p0[2], p1[2], p2[2], p3[2]; f32x4 pd = {0.f, 0.f, 0.f, 0.f};
#pragma unroll
        for (int j = 0; j < 2; ++j) { const size_t o = goff + (pc + 8 * j) * 8; p0[j] = *(const v4u*)(QD + o); p1[j] = *(const v4u*)(KI + o); p2[j] = *(const v4u*)(GG + o); p3[j] = *(const v4u*)(VV + o); }
        if (tid < 128) pd = *(const f32x4*)(DEC + (size_t)((b * SEQ) / 16 + (tid >> 5)) * DM + h * 128 + (tid & 31) * 4);
#pragma unroll 1
        for (int rd = 0; rd < SEQ / 64; ++rd) {
            LDS_BARRIER();
            if (rd > 0 && tid < 64) {
                float s = 0.f;
#pragma unroll
                for (int ww = 0; ww < 8; ++ww) s += *(const LAS float*)(lds + OFF_SS + (ww * 64 + tid) * 4);
                SS[(size_t)h * NTOK + (size_t)b * SEQ + (rd - 1) * 64 + tid] = s;
            }
#pragma unroll
            for (int j = 0; j < 2; ++j) { const int lo = prow * TP + (pc + 8 * j) * 16; *(LAS v4u*)(lds + OFF_QD + lo) = p0[j]; *(LAS v4u*)(lds + OFF_KI + lo) = p1[j]; *(LAS v4u*)(lds + OFF_G + lo) = p2[j]; *(LAS v4u*)(lds + OFF_V + lo) = p3[j]; }
            if (tid < 128) *(LAS f32x4*)(lds + OFF_DEC + tid * 16) = pd;
            if (rd + 1 < SEQ / 64) {
                const size_t gn = goff + (size_t)(rd + 1) * 64 * DM;
#pragma unroll
                for (int j = 0; j < 2; ++j) { const size_t o = gn + (pc + 8 * j) * 8; p0[j] = *(const v4u*)(QD + o); p1[j] = *(const v4u*)(KI + o); p2[j] = *(const v4u*)(GG + o); p3[j] = *(const v4u*)(VV + o); }
                if (tid < 128) pd = *(const f32x4*)(DEC + (size_t)((b * SEQ + (rd + 1) * 64) / 16 + (tid >> 5)) * DM + h * 128 + (tid & 31) * 4);
            }
            LDS_BARRIER();
#pragma unroll 1
            for (int cc = 0; cc < 4; ++cc) {
                s16x4 ql[4], qh[4], kl[4], kh[4], ktr[8]; f32x4 d4[8];
#pragma unroll
                for (int kb = 0; kb < 4; ++kb) {
                    const int off = (16 * cc + r) * TP + (32 * kb + 4 * g) * 2;
                    ql[kb] = *(const LAS s16x4*)(lds + OFF_QD + off); qh[kb] = *(const LAS s16x4*)(lds + OFF_QD + off + 32);
                    kl[kb] = *(const LAS s16x4*)(lds + OFF_KI + off); kh[kb] = *(const LAS s16x4*)(lds + OFF_KI + off + 32);
                }
                s16x4 vfr = tr_read(lds + OFF_V + (16 * cc + 4 * g + q4) * TP + (16 * w + 4 * p4) * 2);
                s16x4 gfr = *(const LAS s16x4*)(lds + OFF_G + (16 * cc + r) * TP + (16 * w + 4 * g) * 2);
#pragma unroll
                for (int kt = 0; kt < 8; ++kt) {
                    d4[kt] = *(const LAS f32x4*)(lds + OFF_DEC + cc * 512 + (16 * kt + 4 * g) * 4);
                    ktr[kt] = tr_read(lds + OFF_KI + (16 * cc + 4 * g + q4) * TP + (16 * kt + 4 * p4) * 2);
                }
                asm volatile("" : "+v"(ql[0]), "+v"(ql[1]), "+v"(ql[2]), "+v"(ql[3]), "+v"(qh[0]), "+v"(qh[1]), "+v"(qh[2]), "+v"(qh[3]),
                                  "+v"(kl[0]), "+v"(kl[1]), "+v"(kl[2]), "+v"(kl[3]), "+v"(kh[0]), "+v"(kh[1]), "+v"(kh[2]), "+v"(kh[3]), "+v"(vfr), "+v"(gfr));
                asm volatile("" : "+v"(ktr[0]), "+v"(ktr[1]), "+v"(ktr[2]), "+v"(ktr[3]), "+v"(ktr[4]), "+v"(ktr[5]), "+v"(ktr[6]), "+v"(ktr[7]),
                                  "+v"(d4[0]), "+v"(d4[1]), "+v"(d4[2]), "+v"(d4[3]), "+v"(d4[4]), "+v"(d4[5]), "+v"(d4[6]), "+v"(d4[7]));
                bf16x8 qf[4];
#pragma unroll
                for (int kb = 0; kb < 4; ++kb) qf[kb] = cat8(ql[kb], qh[kb]);
                f32x4 sc = {0.f, 0.f, 0.f, 0.f}, oa = {0.f, 0.f, 0.f, 0.f};
#pragma unroll
                for (int kb = 0; kb < 4; ++kb) sc = MFMA32(cat8(kl[kb], kh[kb]), qf[kb], sc);
#pragma unroll
                for (int kb = 0; kb < 4; ++kb) oa = MFMA32(pack8(st[2 * kb], st[2 * kb + 1]), qf[kb], oa);
#pragma unroll
                for (int kt = 0; kt < 8; ++kt) st[kt] = MFMA16(ktr[kt], vfr, st[kt]) * d4[kt];
#pragma unroll
                for (int i = 0; i < 4; ++i) sc[i] = (4 * g + i <= r) ? sc[i] : 0.f;
                oa = MFMA16(vfr, pack4(sc), oa);
                { const v2u gr = __builtin_bit_cast(v2u, gfr);
                  v2u ow; ow.x = cvtpk(oa[0] * ng4[0] * bflo(gr.x), oa[1] * ng4[1] * bfhi(gr.x)); ow.y = cvtpk(oa[2] * ng4[2] * bflo(gr.y), oa[3] * ng4[3] * bfhi(gr.y));
                  *(v2u*)(A2 + (size_t)(b * SEQ + rd * 64 + cc * 16 + r) * DM + h * 128 + 16 * w + 4 * g) = ow;
                  float p = (oa[0] * oa[0] + oa[1] * oa[1]) + (oa[2] * oa[2] + oa[3] * oa[3]);
                  p += __shfl_xor(p, 16); p += __shfl_xor(p, 32);
                  if (lane < 16) *(LAS float*)(lds + OFF_SS + (w * 64 + cc * 16 + r) * 4) = p; }
            }
        }
        LDS_BARRIER();
        if (tid < 64) { float s = 0.f;
#pragma unroll
            for (int ww = 0; ww < 8; ++ww) s += *(const LAS float*)(lds + OFF_SS + (ww * 64 + tid) * 4);
            SS[(size_t)h * NTOK + (size_t)b * SEQ + (SEQ / 64 - 1) * 64 + tid] = s; }
        LDS_BARRIER();
    }
}

struct Args { const float* in[17]; float* out; unsigned char* ws; int ph_lo, ph_hi; };
enum { I_X = 0, I_HWIN, I_HNG, I_HWOUT, I_LB, I_RWIN, I_RWOUT, I_LNMG, I_LNMB, I_LNFG, I_LNFB, I_RW, I_RB, I_WGU, I_BGU, I_WDN, I_BDN };

__device__ __forceinline__ int dest_row(int mode, int n) {
    if (mode == 1) { if (n < 1024) return ((n >> 7) << 8) + (n & 127); if (n < 2048) { const int q = n - 1024; return ((q >> 7) << 8) + 128 + (q & 127); } return n; }
    if (mode == 2) { const int j2 = n >> 1; return ((j2 >> 7) << 8) + ((n & 1) << 7) + (j2 & 127); }
    return n;
}
__device__ __forceinline__ void transpose_item(const float* W, int K, int N, bf16* WT, int mode, LAS float* scr, int item, int lane) {
    const int nblk = N / 64, kb = item / nblk, nb = item % nblk, k0 = 64 * kb, n0 = 64 * nb;
#pragma unroll 4
    for (int i = 0; i < 16; ++i) { const int kk = 4 * i + (lane >> 4), c4 = (lane & 15) * 4;
        const f32x4 v = *(const GAS f32x4*)(W + (size_t)(k0 + kk) * N + n0 + c4);
        LAS float* s = scr + kk * 65 + c4; s[0] = v[0]; s[1] = v[1]; s[2] = v[2]; s[3] = v[3]; }
    LDS_WAIT(); asm volatile("" ::: "memory");
    const int c = lane & 7;
#pragma unroll 2
    for (int j = 0; j < 8; ++j) { const int n = (lane >> 3) + 8 * j; const LAS float* s = scr + (8 * c) * 65 + n;
        v4u o; o.x = pk2(s[0 * 65], s[1 * 65]); o.y = pk2(s[2 * 65], s[3 * 65]); o.z = pk2(s[4 * 65], s[5 * 65]); o.w = pk2(s[6 * 65], s[7 * 65]);
        *(GAS v4u*)(WT + (size_t)dest_row(mode, n0 + n) * K + k0 + 8 * c) = o; }
    LDS_WAIT(); asm volatile("" ::: "memory");
}

__device__ __forceinline__ void transpose_item_fp8(const float* W, int K, int N, unsigned char* WT, int mode, float scale, LAS float* scr, int item, int lane) {
    const int nblk = N / 64, kb = item / nblk, nb = item % nblk, k0 = 64 * kb, n0 = 64 * nb;
#pragma unroll 4
    for (int i = 0; i < 16; ++i) { const int kk = 4 * i + (lane >> 4), c4 = (lane & 15) * 4;
        const f32x4 v = *(const GAS f32x4*)(W + (size_t)(k0 + kk) * N + n0 + c4);
        LAS float* s = scr + kk * 65 + c4; s[0] = v[0]; s[1] = v[1]; s[2] = v[2]; s[3] = v[3]; }
    LDS_WAIT(); asm volatile("" ::: "memory");
    const int c = lane & 7;
#pragma unroll 2
    for (int j = 0; j < 8; ++j) { const int n = (lane >> 3) + 8 * j; const LAS float* s = scr + (8 * c) * 65 + n;
        v2u o; o.x = pk4_fp8(s[0 * 65] * scale, s[1 * 65] * scale, s[2 * 65] * scale, s[3 * 65] * scale); o.y = pk4_fp8(s[4 * 65] * scale, s[5 * 65] * scale, s[6 * 65] * scale, s[7 * 65] * scale);
        *(GAS v2u*)(WT + (size_t)dest_row(mode, n0 + n) * K + k0 + 8 * c) = o; }
    LDS_WAIT(); asm volatile("" ::: "memory");
}

#ifndef SITE_MASK
#define SITE_MASK 0xffff
#endif
#define SITE(n) (((SITE_MASK) >> (n)) & 1)
#ifndef PROBE_MASK
#define PROBE_MASK 0
#endif
#define REP(n) (1 + (((PROBE_MASK) >> (n)) & 1))
typedef const __attribute__((address_space(4))) Args* KArgs;
__device__ __forceinline__ int otid(int wave0) { int l; asm volatile("v_mbcnt_lo_u32_b32 %0, -1, 0\n\tv_mbcnt_hi_u32_b32 %0, -1, %0" : "=v"(l)); asm volatile("" : "+s"(wave0)); return wave0 * 64 + l; }
__device__ __forceinline__ LAS unsigned char* olds(LAS unsigned char* p) { asm volatile("" : "+s"(p)); return p; }
__device__ __forceinline__ KArgs kargs() { KArgs p = (KArgs)__builtin_amdgcn_kernarg_segment_ptr(); asm volatile("" : "+s"(p)); return p; }
#define IN(k) (ap->ph_lo <= (k) && (k) < ap->ph_hi)
#ifndef PROBE_BAR
#define PROBE_BAR 1
#endif
#define GRID_BAR() for (int _r = 0; _r < PROBE_BAR; ++_r) do { if (ap->ph_hi - ap->ph_lo > 1) { XcdBarrier _b; _b.bar = (unsigned*)(ap->ws + WS_CTL) + CW_BAR; _b.x = xb_xcc_id(); _b.st = (volatile LAS unsigned*)(lds + MISC_OFF + MO_BARW); xcd_barrier(_b); } } while (0)
#define VCU() ((gridDim.x % 8 == 0) ? (int)((blockIdx.x % 8) * (gridDim.x / 8) + blockIdx.x / 8) : (int)blockIdx.x)

__global__ void __launch_bounds__(512, 2) mk_fwd(Args args_unused) {
    extern __shared__ __attribute__((aligned(16))) unsigned char lds_raw[];
    LAS unsigned char* const lds0 = (LAS unsigned char*)lds_raw;
    const int wave0 = __builtin_amdgcn_readfirstlane((int)(threadIdx.x >> 6));
    {
        LAS unsigned char* lds = lds0;
        for (int u = threadIdx.x; u < (LDS_BYTES - MISC_OFF) / 4; u += 512) ((LAS unsigned*)(lds + MISC_OFF))[u] = 0u;
        __syncthreads();
        KArgs ap = kargs();
        if (ap->ph_hi - ap->ph_lo > 1) (void)xcd_barrier_post((unsigned*)(ap->ws + WS_CTL) + CW_BAR, (volatile LAS unsigned*)(lds + MISC_OFF + MO_BARW));
    }

#if SITE(0)
    { KArgs ap = kargs(); const int tid = otid(wave0); LAS unsigned char* lds = olds(lds0); (void)tid;
    if (IN(0)) for (int rep_ = 0; rep_ < REP(0); ++rep_) {
        const int lane = tid & 63, wave = __builtin_amdgcn_readfirstlane(tid >> 6), G = gridDim.x, vcu = VCU(), gw = vcu * 8 + wave, NGW = G * 8;
        unsigned char* ws = ap->ws;
        LAS float* scr = (LAS float*)(lds + wave * 16640);
        constexpr int I_HIN = 2 * 16 * 64, I_HOUT = 2 * 16 * 16, I_RIN = 2 * 16 * 96, I_ROUT = 2 * 32 * 16, I_GU = 128 * 16 * 32, I_DN = 128 * 16 * 16;
        constexpr int NITEMS = I_HIN + I_HOUT + I_RIN + I_ROUT + I_GU + I_DN + I_ROUT;
        for (int it = gw; it < NITEMS; it += NGW) {
            int r = it;
            if (r < I_HIN) { const int j = r / (16 * 64); transpose_item(ap->in[I_HWIN] + (size_t)j * DM * HG_IN, DM, HG_IN, (bf16*)(ws + WS_W_HIN) + (size_t)j * HG_IN * DM, 1, scr, r % (16 * 64), lane); continue; } r -= I_HIN;
            if (r < I_HOUT) { const int j = r / 256; transpose_item(ap->in[I_HWOUT] + (size_t)j * DM * DM, DM, DM, (bf16*)(ws + WS_W_HOUT) + (size_t)j * DM * DM, 0, scr, r % 256, lane); continue; } r -= I_HOUT;
            if (r < I_RIN) { const int j = r / (16 * 96); transpose_item(ap->in[I_RWIN] + (size_t)j * DM * RT_IN, DM, RT_IN, (bf16*)(ws + WS_W_RIN) + (size_t)j * RT_IN * DM, 0, scr, r % (16 * 96), lane); continue; } r -= I_RIN;
            if (r < I_ROUT) { const int j = r / 512; transpose_item(ap->in[I_RWOUT] + (size_t)j * RT_VD * DM, RT_VD, DM, (bf16*)(ws + WS_W_ROUT) + (size_t)j * DM * RT_VD, 0, scr, r % 512, lane); continue; } r -= I_ROUT;
#if MOE_FP8
            if (r < I_GU) { const int j = r / 512; transpose_item_fp8(ap->in[I_WGU] + (size_t)j * DM * 2048, DM, 2048, ws + WS_W_GU + (size_t)j * 2048 * DM, 2, WGU_SCALE, scr, r % 512, lane); continue; } r -= I_GU;
            if (r < I_DN) { const int j = r / 256; transpose_item_fp8(ap->in[I_WDN] + (size_t)j * DM * DM, DM, DM, ws + WS_W_DN + (size_t)j * DM * DM, 0, WDN_SCALE, scr, r % 256, lane); continue; } r -= I_DN;
            { const int j = r / 512; transpose_item_fp8(ap->in[I_RWOUT] + (size_t)j * RT_VD * DM, RT_VD, DM, ws + WS_W_ROUT8 + (size_t)j * DM * RT_VD, 0, 128.0f, scr, r % 512, lane); }
#else
            if (r < I_GU) { const int j = r / 512; transpose_item(ap->in[I_WGU] + (size_t)j * DM * 2048, DM, 2048, (bf16*)(ws + WS_W_GU) + (size_t)j * 2048 * DM, 2, scr, r % 512, lane); continue; } r -= I_GU;
            { const int j = r / 256; transpose_item(ap->in[I_WDN] + (size_t)j * DM * DM, DM, DM, (bf16*)(ws + WS_W_DN) + (size_t)j * DM * DM, 0, scr, r % 256, lane); }
#endif
        }
        const int gt = vcu * 512 + tid, NGT = G * 512;
        float* LBS = (float*)(ws + WS_LBS); float* BGU = (float*)(ws + WS_BGU); float* ROT = (float*)(ws + WS_ROT); bf16* XB = (bf16*)(ws + WS_XB);
        for (int d = gt; d < DM; d += NGT) { const float* lbp = ap->in[I_LB]; const float v0 = lbp[d], v1 = lbp[DM + d], v2 = lbp[2 * DM + d], v3 = lbp[3 * DM + d]; const float mx = fmaxf(fmaxf(v0, v1), fmaxf(v2, v3));
            const float e0 = __expf(v0 - mx), e1 = __expf(v1 - mx), e2 = __expf(v2 - mx), e3 = __expf(v3 - mx), is = 1.0f / (e0 + e1 + e2 + e3);
            LBS[d] = 0.f; LBS[DM + d] = e1 * is; LBS[2 * DM + d] = (e1 + e2) * is; LBS[3 * DM + d] = (e1 + e2 + e3) * is; }
        for (int i = gt; i < SEQ * 128; i += NGT) { const int pos = i >> 7, p = i & 127; const float inv = 1.0f / __builtin_amdgcn_exp2f(13.287712379549449f * ((float)p / 127.0f)); const float th = (float)pos * inv;
            double rev = (double)th * 0.15915494309189535; rev -= floor(rev); const float fr = (float)rev; ROT[2 * i] = __builtin_amdgcn_cosf(fr); ROT[2 * i + 1] = __builtin_amdgcn_sinf(fr); }
        for (int i = gt; i < 4 * DM * NE; i += NGT) { const int l = i >> 15, d = (i >> 5) & 1023, e = i & 31; const float wv = ap->in[I_RW][i]; const unsigned hb = f2bf(wv); const float hv = __builtin_bit_cast(float, hb << 16);
            ((bf16*)(ws + WS_WRH))[(size_t)l * 32768 + e * 1024 + d] = (bf16)hb; ((bf16*)(ws + WS_WRL))[(size_t)l * 32768 + e * 1024 + d] = (bf16)f2bf(wv - hv); }
        for (int i = gt; i < 4 * 32 * 2048; i += NGT) { const int le = i >> 11, n = i & 2047; BGU[(size_t)le * 2048 + dest_row(2, n)] = ap->in[I_BGU][i]; }
        for (size_t i = (size_t)gt; i < (size_t)NTOK * DM / 4; i += NGT) { const f32x4 v = ((const f32x4*)ap->in[I_X])[i]; v2u o; o.x = pk2(v[0], v[1]); o.y = pk2(v[2], v[3]); ((v2u*)XB)[i] = o; }
        GRID_BAR();
    } }
#endif

#pragma unroll 1
    for (int L = 0; L < DEPTH; ++L) {
        const int pb = 1 + 8 * L;
        if ((L & 1) == 0) {
#if SITE(1)
            { KArgs ap = kargs(); const int tid = otid(wave0); LAS unsigned char* lds = olds(lds0); (void)tid;
            if (IN(pb + 0)) for (int rep_ = 0; rep_ < REP(1); ++rep_) {
                unsigned char* ws = ap->ws; const int j = L >> 1;
                LAS int* ul = (LAS int*)(lds + MISC_OFF + MO_ULIST);
                pg8::build_units_dense(tid, ul, NTOK / 256, HG_IN / 256, DM * 2);
                pg8::EpiHgrnIn E{ws, L};
                pg8::gemm_phase<pg8::EpiHgrnIn, false, true, false>(tid, lds, ul, (LAS int*)(lds + MISC_OFF + MO_GTAB), (const char*)(ws + WS_XB), (const char*)((bf16*)(ws + WS_W_HIN) + (size_t)j * HG_IN * DM), nullptr, DM * 2, E, lds + MISC_OFF + MO_GTAB);
                GRID_BAR();
            } }
#endif
#if SITE(2)
            { KArgs ap = kargs(); const int tid = otid(wave0); LAS unsigned char* lds = olds(lds0); (void)tid;
            if (IN(pb + 1)) for (int rep_ = 0; rep_ < REP(2); ++rep_) {
#if !SLOW_HGRN
                { unsigned char* ws = ap->ws; const bf16* QD = (const bf16*)(ws + WS_H);
                  hgrn_fast(tid, lds, QD, QD + (size_t)NTOK * DM, QD + 4 * (size_t)NTOK * DM, QD + 3 * (size_t)NTOK * DM, (const float*)(ws + WS_DEC), ap->in[I_HNG] + (L >> 1) * DM,
                            (bf16*)(ws + WS_A2), (float*)(ws + WS_SSP)); }
#else
                unsigned char* ws = ap->ws; const bf16* QD = (const bf16*)(ws + WS_H); const bf16* KI = QD + (size_t)NTOK * DM; const bf16* KS = QD + 2 * (size_t)NTOK * DM; const bf16* VV = QD + 3 * (size_t)NTOK * DM; bf16* OB = (bf16*)(ws + WS_O);
                LAS float* qf = (LAS float*)lds; LAS float* kf = qf + 16 * 4 * 36; LAS float* ff = kf + 16 * 4 * 36; LAS float* vf = ff + 16 * 4 * 36;
                for (int un = blockIdx.x; un < NBATCH * HG_HEADS; un += gridDim.x) {
                    const int b = un >> 3, h = un & 7; const int vc = tid >> 2, kq = tid & 3;
                    float st[32];
#pragma unroll
                    for (int i = 0; i < 32; ++i) st[i] = 0.f;
                    for (int t0 = 0; t0 < SEQ; t0 += 16) {
                        __syncthreads();
                        for (int e = tid; e < 16 * 128; e += 512) { const int tt = e >> 7, k = e & 127; const size_t gi = (size_t)(b * SEQ + t0 + tt) * DM + h * 128 + k; const int li = tt * 144 + (k & 3) * 36 + (k >> 2);
                            qf[li] = bf1(QD[gi]); kf[li] = bf1(KI[gi]); ff[li] = bf1(KS[gi]); vf[tt * 128 + k] = bf1(VV[gi]); }
                        __syncthreads();
                        for (int tt = 0; tt < 16; ++tt) {
                            const float v = vf[tt * 128 + vc]; float a = 0.f; const int lb = tt * 144 + kq * 36;
#pragma unroll
                            for (int i = 0; i < 32; ++i) { st[i] = ff[lb + i] * st[i] + kf[lb + i] * v; a += qf[lb + i] * st[i]; }
                            a += __shfl_xor(a, 1); a += __shfl_xor(a, 2);
                            if (kq == 0) OB[(size_t)(b * SEQ + t0 + tt) * DM + h * 128 + vc] = (bf16)f2bf(a);
                        }
                    }
                }
#endif
                GRID_BAR();
            } }
#endif
#if SITE(3) && SLOW_HGRN
            { KArgs ap = kargs(); const int tid = otid(wave0); LAS unsigned char* lds = olds(lds0); (void)tid;
            if (IN(pb + 2)) for (int rep_ = 0; rep_ < REP(3); ++rep_) {
                const int lane = tid & 63, wave = __builtin_amdgcn_readfirstlane(tid >> 6), gw = VCU() * 8 + wave, NGW = gridDim.x * 8;
                unsigned char* ws = ap->ws; const bf16* OB = (const bf16*)(ws + WS_O); const bf16* GG = (const bf16*)(ws + WS_H) + 4 * (size_t)NTOK * DM; bf16* A2 = (bf16*)(ws + WS_A2);
                const float* ng = ap->in[I_HNG] + (L >> 1) * DM;
                f32x4 g4[4];
#pragma unroll
                for (int q = 0; q < 4; ++q) g4[q] = *(const f32x4*)(ng + 256 * q + 4 * lane);
                v2u on[4], gn[4];
#pragma unroll
                for (int q = 0; q < 4; ++q) { on[q] = *(const v2u*)(OB + (size_t)gw * DM + 256 * q + 4 * lane); gn[q] = *(const v2u*)(GG + (size_t)gw * DM + 256 * q + 4 * lane); }
#pragma unroll 1
                for (int row = gw; row < NTOK; row += NGW) {
                    v2u oc[4], gc[4];
#pragma unroll
                    for (int q = 0; q < 4; ++q) { oc[q] = on[q]; gc[q] = gn[q]; }
                    if (row + NGW < NTOK) {
#pragma unroll
                        for (int q = 0; q < 4; ++q) { on[q] = *(const v2u*)(OB + (size_t)(row + NGW) * DM + 256 * q + 4 * lane); gn[q] = *(const v2u*)(GG + (size_t)(row + NGW) * DM + 256 * q + 4 * lane); } }
                    float o[16]; float ss = 0.f;
#pragma unroll
                    for (int q = 0; q < 4; ++q) { o[4 * q] = bflo(oc[q].x); o[4 * q + 1] = bfhi(oc[q].x); o[4 * q + 2] = bflo(oc[q].y); o[4 * q + 3] = bfhi(oc[q].y); }
#pragma unroll
                    for (int i = 0; i < 16; ++i) ss += o[i] * o[i];
                    const float rs = 1.0f / sqrtf(wave_sum(ss) * (1.0f / DM) + RMS_EPS);
#pragma unroll
                    for (int q = 0; q < 4; ++q) {
                        v2u w; w.x = pk2(o[4 * q] * rs * g4[q][0] * bflo(gc[q].x), o[4 * q + 1] * rs * g4[q][1] * bfhi(gc[q].x)); w.y = pk2(o[4 * q + 2] * rs * g4[q][2] * bflo(gc[q].y), o[4 * q + 3] * rs * g4[q][3] * bfhi(gc[q].y));
                        *(v2u*)(A2 + (size_t)row * DM + 256 * q + 4 * lane) = w; }
                }
                GRID_BAR();
            } }
#endif
        } else {
#if SITE(4)
            { KArgs ap = kargs(); const int tid = otid(wave0); LAS unsigned char* lds = olds(lds0); (void)tid;
            if (IN(pb + 0)) for (int rep_ = 0; rep_ < REP(4); ++rep_) {
                unsigned char* ws = ap->ws; const int j = L >> 1;
                LAS int* ul = (LAS int*)(lds + MISC_OFF + MO_ULIST);
                pg8::build_units_dense(tid, ul, NTOK / 256, RT_IN / 256, DM * 2);
                pg8::EpiRetIn E{ws};
                pg8::gemm_phase<pg8::EpiRetIn, false, true, false>(tid, lds, ul, (LAS int*)(lds + MISC_OFF + MO_GTAB), (const char*)(ws + WS_XB), (const char*)((bf16*)(ws + WS_W_RIN) + (size_t)j * RT_IN * DM), nullptr, DM * 2, E);
                GRID_BAR();
            } }
#endif
#if SITE(5)
            { KArgs ap = kargs(); const int tid = otid(wave0); LAS unsigned char* lds = olds(lds0); (void)tid;
            if (IN(pb + 1)) for (int rep_ = 0; rep_ < REP(5); ++rep_) {
#if !SLOW_RET
                { unsigned char* ws = ap->ws; ret_fast(tid, lds, (const bf16*)(ws + WS_H), (bf16*)(ws + WS_O)); }
#else
                unsigned char* ws = ap->ws; const bf16* HB = (const bf16*)(ws + WS_H); bf16* OB = (bf16*)(ws + WS_O);
                LAS float* qf = (LAS float*)lds; LAS float* kf = qf + 16 * 4 * 68; LAS float* vf = kf + 16 * 4 * 68;
                for (int un = blockIdx.x; un < NBATCH * RT_HEADS * 4; un += gridDim.x) {
                    const int b = un >> 4, h = (un >> 2) & 3, vq = un & 3; const int vc = tid >> 2, kq = tid & 3;
                    const float gam = 1.0f - exp2f(-5.0f - (float)h);
                    float st[64];
#pragma unroll
                    for (int i = 0; i < 64; ++i) st[i] = 0.f;
                    for (int t0 = 0; t0 < SEQ; t0 += 16) {
                        __syncthreads();
                        for (int e = tid; e < 16 * 256; e += 512) { const int tt = e >> 8, k = e & 255; const size_t gi = (size_t)(b * SEQ + t0 + tt) * RT_IN + h * 256 + k; const int li = tt * 272 + (k & 3) * 68 + (k >> 2);
                            qf[li] = bf1(HB[gi]); kf[li] = bf1(HB[gi + 1024]); }
                        for (int e = tid; e < 16 * 128; e += 512) { const int tt = e >> 7, c = e & 127; vf[e] = bf1(HB[(size_t)(b * SEQ + t0 + tt) * RT_IN + 2048 + h * 512 + vq * 128 + c]); }
                        __syncthreads();
                        for (int tt = 0; tt < 16; ++tt) {
                            const float v = vf[tt * 128 + vc]; float a = 0.f; const int lb = tt * 272 + kq * 68;
#pragma unroll
                            for (int i = 0; i < 64; ++i) { st[i] = gam * st[i] + kf[lb + i] * v; a += qf[lb + i] * st[i]; }
                            a += __shfl_xor(a, 1); a += __shfl_xor(a, 2);
                            if (kq == 0) OB[(size_t)(b * SEQ + t0 + tt) * RT_VD + h * 512 + vq * 128 + vc] = (bf16)f2bf(a);
                        }
                    }
                }
#endif
                GRID_BAR();
            } }
#endif
#if SITE(6)
            { KArgs ap = kargs(); const int tid = otid(wave0); LAS unsigned char* lds = olds(lds0); (void)tid;
            if (IN(pb + 2)) for (int rep_ = 0; rep_ < REP(6); ++rep_) {
                const int lane = tid & 63, wave = __builtin_amdgcn_readfirstlane(tid >> 6), gw = VCU() * 8 + wave, NGW = gridDim.x * 8;
                unsigned char* ws = ap->ws; const bf16* OB = (const bf16*)(ws + WS_O); const bf16* HB = (const bf16*)(ws + WS_H); bf16* A2 = (bf16*)(ws + WS_A2);
                v4u on[4], gn[4];
#pragma unroll
                for (int h = 0; h < 4; ++h) { on[h] = *(const v4u*)(OB + (size_t)gw * RT_VD + 512 * h + 8 * lane); gn[h] = *(const v4u*)(HB + (size_t)gw * RT_IN + 4096 + 512 * h + 8 * lane); }
#pragma unroll 1
                for (int row = gw; row < NTOK; row += NGW) {
                    v4u oc[4], gc[4];
#pragma unroll
                    for (int h = 0; h < 4; ++h) { oc[h] = on[h]; gc[h] = gn[h]; }
                    if (row + NGW < NTOK) {
#pragma unroll
                        for (int h = 0; h < 4; ++h) { on[h] = *(const v4u*)(OB + (size_t)(row + NGW) * RT_VD + 512 * h + 8 * lane); gn[h] = *(const v4u*)(HB + (size_t)(row + NGW) * RT_IN + 4096 + 512 * h + 8 * lane); } }
#pragma unroll
                    for (int h = 0; h < 4; ++h) {
                        const v4u w = oc[h];
                        float o[8] = {bflo(w.x), bfhi(w.x), bflo(w.y), bfhi(w.y), bflo(w.z), bfhi(w.z), bflo(w.w), bfhi(w.w)};
                        float s = 0.f;
#pragma unroll
                        for (int i = 0; i < 8; ++i) s += o[i];
                        const float mu = wave_sum(s) * (1.0f / 512.0f); float q = 0.f;
#pragma unroll
                        for (int i = 0; i < 8; ++i) { o[i] -= mu; q += o[i] * o[i]; }
                        const float rs = 1.0f / sqrtf(wave_sum(q) * (1.0f / 512.0f) + LN_EPS);
                        const v4u g = gc[h];
#if ROUT_FP8
                        const float r8 = rs * 8.0f; v2u r; r.x = pk4_fp8(o[0] * r8 * bflo(g.x), o[1] * r8 * bfhi(g.x), o[2] * r8 * bflo(g.y), o[3] * r8 * bfhi(g.y));
                        r.y = pk4_fp8(o[4] * r8 * bflo(g.z), o[5] * r8 * bfhi(g.z), o[6] * r8 * bflo(g.w), o[7] * r8 * bfhi(g.w));
                        *(v2u*)((unsigned char*)A2 + (size_t)row * RT_VD + 512 * h + 8 * lane) = r;
#else
                        v4u r; r.x = pk2(o[0] * rs * bflo(g.x), o[1] * rs * bfhi(g.x)); r.y = pk2(o[2] * rs * bflo(g.y), o[3] * rs * bfhi(g.y));
                        r.z = pk2(o[4] * rs * bflo(g.z), o[5] * rs * bfhi(g.z)); r.w = pk2(o[6] * rs * bflo(g.w), o[7] * rs * bfhi(g.w));
                        *(v4u*)(A2 + (size_t)row * RT_VD + 512 * h + 8 * lane) = r;
#endif
                    }
                }
                GRID_BAR();
            } }
#endif
        }
#if SITE(7)
        { KArgs ap = kargs(); const int tid = otid(wave0); LAS unsigned char* lds = olds(lds0); (void)tid;
        if (IN(pb + 3)) for (int rep_ = 0; rep_ < REP(7); ++rep_) {
            unsigned char* ws = ap->ws; const int j = L >> 1; const bool ret = (L & 1) != 0;
            const int Ko = ret ? RT_VD : DM;
            LAS int* ul = (LAS int*)(lds + MISC_OFF + MO_ULIST);
            if (ret && ROUT_FP8) {
                pg8::build_units_dense(tid, ul, NTOK / 256, DM / 256, RT_VD);
                pg8::EpiRes E{ws, -1, 1.0f / (8.0f * 128.0f)};
                pg8::gemm_phase<pg8::EpiRes, false, true, true>(tid, lds, ul, (LAS int*)(lds + MISC_OFF + MO_GTAB), (const char*)(ws + WS_A2), (const char*)(ws + WS_W_ROUT8 + (size_t)j * DM * RT_VD), nullptr, RT_VD, E);
            } else {
                pg8::build_units_dense(tid, ul, NTOK / 256, DM / 256, Ko * 2);
                const char* Bt = ret ? (const char*)((bf16*)(ws + WS_W_ROUT) + (size_t)j * DM * RT_VD) : (const char*)((bf16*)(ws + WS_W_HOUT) + (size_t)j * DM * DM);
                pg8::EpiRes E{ws, (ret || SLOW_HGRN) ? -1 : 0, 1.0f};
                pg8::gemm_phase<pg8::EpiRes, false, true, false>(tid, lds, ul, (LAS int*)(lds + MISC_OFF + MO_GTAB), (const char*)(ws + WS_A2), Bt, nullptr, Ko * 2, E);
            }
            GRID_BAR();
        } }
#endif
#if SITE(8)
        { KArgs ap = kargs(); const int tid = otid(wave0); LAS unsigned char* lds = olds(lds0); (void)tid;
        if (IN(pb + 4)) for (int rep_ = 0; rep_ < REP(8); ++rep_) {
            const int lane = tid & 63, wave = __builtin_amdgcn_readfirstlane(tid >> 6), r = lane & 15, g = lane >> 4;
            unsigned char* ws = ap->ws; unsigned* ctl = (unsigned*)(ws + WS_CTL);
            const bf16* Y = (const bf16*)(ws + WS_Y); bf16* X1R = (bf16*)(ws + WS_X1F); bf16* X1B = (bf16*)(ws + WS_X1B);
            int* ROWDST = (int*)(ws + WS_ROWDST); float* ROWGATE = (float*)(ws + WS_ROWGATE);
            constexpr int WP = 2064;
            LAS unsigned char* wH = lds; LAS unsigned char* wL = lds + 32 * WP;
            LAS int* lcnt = (LAS int*)(lds + MISC_OFF + MO_LCNT); LAS int* lbase = (LAS int*)(lds + MISC_OFF + MO_LBASE);
            LAS int* sel = (LAS int*)(lds + MISC_OFF + MO_SEL); LAS float* selw = (LAS float*)(lds + MISC_OFF + MO_SELW);
            const float* rb = ap->in[I_RB] + L * NE;
            const float* lg = ap->in[I_LNMG] + L * DM; const float* lbb = ap->in[I_LNMB] + L * DM;
            { const v4u* gh = (const v4u*)(ws + WS_WRH) + (size_t)L * 4096; const v4u* gl = (const v4u*)(ws + WS_WRL) + (size_t)L * 4096;
              for (int c = tid; c < 4096; c += 512) { const int e = c >> 7, cc = c & 127; *(LAS v4u*)(wH + e * WP + cc * 16) = gh[c]; *(LAS v4u*)(wL + e * WP + cc * 16) = gl[c]; } }
            const float rb0 = rb[r], rb1 = rb[16 + r];
            for (int blk = VCU(); blk < NTOK / 128; blk += gridDim.x) {
                if (tid < 32) lcnt[tid] = 0;
                __syncthreads();
                const int row0 = blk * 128 + wave * 16;
                v2u xn[4];
#pragma unroll
                for (int q = 0; q < 4; ++q) xn[q] = *(const v2u*)(Y + (size_t)row0 * DM + 256 * q + 4 * lane);
#pragma unroll 1
                for (int rr = 0; rr < 16; ++rr) {
                    const int row = row0 + rr;
                    f32x4 x[4]; float s = 0.f;
#pragma unroll
                    for (int q = 0; q < 4; ++q) { x[q] = (f32x4){bflo(xn[q].x), bfhi(xn[q].x), bflo(xn[q].y), bfhi(xn[q].y)}; s += (x[q][0] + x[q][1]) + (x[q][2] + x[q][3]); }
                    if (rr + 1 < 16) {
#pragma unroll
                        for (int q = 0; q < 4; ++q) xn[q] = *(const v2u*)(Y + (size_t)(row + 1) * DM + 256 * q + 4 * lane); }
                    const float mu = wave_sum_u(s) * (1.0f / DM); float qq = 0.f;
#pragma unroll
                    for (int q = 0; q < 4; ++q) { x[q] = x[q] - mu; qq += (x[q][0] * x[q][0] + x[q][1] * x[q][1]) + (x[q][2] * x[q][2] + x[q][3] * x[q][3]); }
                    const float rs = 1.0f / sqrtf(wave_sum_u(qq) * (1.0f / DM) + LN_EPS);
#pragma unroll
                    for (int q = 0; q < 4; ++q) { const f32x4 g4 = *(const f32x4*)(lg + 256 * q + 4 * lane), b4 = *(const f32x4*)(lbb + 256 * q + 4 * lane); x[q] = x[q] * rs * g4 + b4;
                        { v2u wr_; wr_.x = pk2(x[q][0], x[q][1]); wr_.y = pk2(x[q][2], x[q][3]); *(v2u*)(X1R + (size_t)row * DM + 256 * q + 4 * lane) = wr_; }
#if MOE_FP8
                        *(unsigned*)((unsigned char*)X1B + (size_t)row * DM + 256 * q + 4 * lane) = pk4_fp8(x[q][0] * X_SCALE, x[q][1] * X_SCALE, x[q][2] * X_SCALE, x[q][3] * X_SCALE); }
#else
                        v2u w; w.x = pk2(x[q][0], x[q][1]); w.y = pk2(x[q][2], x[q][3]); *(v2u*)(X1B + (size_t)row * DM + 256 * q + 4 * lane) = w; }
#endif
                }
                asm volatile("s_waitcnt vmcnt(0)" ::: "memory");
                f32x4 lgt0 = {0.f, 0.f, 0.f, 0.f}, lgt1 = {0.f, 0.f, 0.f, 0.f};
                {
                    const bf16* xa = X1R + (size_t)(row0 + r) * DM + 8 * g;
#pragma unroll 1
                    for (int kq = 0; kq < 4; ++kq) {
                        bf16x8 af[8], h0[8], h1[8], l0[8], l1[8];
#pragma unroll
                        for (int j = 0; j < 8; ++j) { const int kb = kq * 8 + j; af[j] = *(const bf16x8*)(xa + 32 * kb);
                            h0[j] = *(const LAS bf16x8*)(wH + r * WP + (32 * kb + 8 * g) * 2); h1[j] = *(const LAS bf16x8*)(wH + (16 + r) * WP + (32 * kb + 8 * g) * 2);
                            l0[j] = *(const LAS bf16x8*)(wL + r * WP + (32 * kb + 8 * g) * 2); l1[j] = *(const LAS bf16x8*)(wL + (16 + r) * WP + (32 * kb + 8 * g) * 2); }
#pragma unroll
                        for (int j = 0; j < 8; ++j) { lgt0 = MFMA32(af[j], h0[j], lgt0); lgt1 = MFMA32(af[j], h1[j], lgt1); lgt0 = MFMA32(af[j], l0[j], lgt0); lgt1 = MFMA32(af[j], l1[j], lgt1); }
                    }
                }
#pragma unroll
                for (int i = 0; i < 4; ++i) {
                    float v0 = lgt0[i] + rb0, v1 = lgt1[i] + rb1; int se[4]; float sv[4];
#pragma unroll
                    for (int k = 0; k < 4; ++k) {
                        float m = fmaxf(v0, v1);
                        m = fmaxf(m, dppf<0xB1>(m)); m = fmaxf(m, dppf<0x4E>(m)); m = fmaxf(m, dppf<0x141>(m)); m = fmaxf(m, dppf<0x140>(m));
                        int ec = (v0 == m) ? r : ((v1 == m) ? 16 + r : 99);
                        ec = min(ec, dppi<0xB1>(ec)); ec = min(ec, dppi<0x4E>(ec)); ec = min(ec, dppi<0x141>(ec)); ec = min(ec, dppi<0x140>(ec));
                        se[k] = ec; sv[k] = m;
                        if (ec == r) v0 = -3.0e38f;
                        if (ec == 16 + r) v1 = -3.0e38f;
                    }
                    const float e1 = __expf(sv[1] - sv[0]), e2 = __expf(sv[2] - sv[0]), e3 = __expf(sv[3] - sv[0]); const float inv = 1.0f / (1.0f + e1 + e2 + e3);
                    if (r < 4) { const int rloc = wave * 16 + 4 * g + i; const int ee = r == 0 ? se[0] : (r == 1 ? se[1] : (r == 2 ? se[2] : se[3])); const float ww = (r == 0 ? 1.0f : (r == 1 ? e1 : (r == 2 ? e2 : e3))) * inv;
                        sel[rloc * 4 + r] = ee; selw[rloc * 4 + r] = ww; }
                }
                __syncthreads();
                const int myE = sel[tid]; const int rank = __hip_atomic_fetch_add(lcnt + myE, 1, __ATOMIC_RELAXED, __HIP_MEMORY_SCOPE_WORKGROUP);
                __syncthreads();
                if (tid < 32) lbase[tid] = (int)__hip_atomic_fetch_add(ctl + CW_ECNT + (L + 4 * rep_) * 32 + tid, (unsigned)lcnt[tid], RLX_AGENT);
                __syncthreads();
                { const int pos = lbase[myE] + rank; const size_t ti = (size_t)myE * ECAP + pos; ROWDST[ti] = (blk * 128 + (tid >> 2)) * 4 + (tid & 3); ROWGATE[ti] = selw[tid]; }
                __syncthreads();
            }
            GRID_BAR();
        } }
#endif
#if SITE(9)
        { KArgs ap = kargs(); const int tid = otid(wave0); LAS unsigned char* lds = olds(lds0); (void)tid;
        if (IN(pb + 5)) for (int rep_ = 0; rep_ < REP(9); ++rep_) {
            unsigned char* ws = ap->ws; unsigned* ctl = (unsigned*)(ws + WS_CTL);
            LAS int* tpre = (LAS int*)(lds + MISC_OFF + MO_TPRE); LAS int* ebase = (LAS int*)(lds + MISC_OFF + MO_EBASE); LAS int* ecnt = (LAS int*)(lds + MISC_OFF + MO_ECNT);
            if (tid < NE) ecnt[tid] = (int)__hip_atomic_load(ctl + CW_ECNT + L * 32 + tid, RLX_AGENT);
            __syncthreads();
            if (tid == 0) { int t = 0;
_Pragma("unroll 1")
 for (int e = 0; e < NE; ++e) { const int c = ecnt[e]; tpre[e] = t; ebase[e] = t * 256; t += (c + 255) >> 8; } tpre[NE] = t; }
            __syncthreads();
            LAS int* ul = (LAS int*)(lds + MISC_OFF + MO_ULIST);
            constexpr int EB = MOE_FP8 ? 1 : 2;
            pg8::build_units_moe(tid, ul, tpre, ebase, ecnt, 8, DM * EB, 2048u * DM * EB);
            { LAS int* gall = (LAS int*)(lds + MISC_OFF + MO_GALL); const int* rd = (const int*)(ws + WS_ROWDST);
              for (int i = tid; i < GALL_UNITS * 256; i += 512) { const int uu = i >> 8, rr = i & 255;
                  if (ul[uu * 8 + 0]) gall[i] = (int)((unsigned)rd[ul[uu * 8 + 7] + min(rr, ul[uu * 8 + 5] - 1)] >> 2); }
              __syncthreads(); }
            pg8::EpiMoeGU E{ws, L};
            pg8::gemm_phase<pg8::EpiMoeGU, true, true, MOE_FP8 != 0>(tid, lds, ul, (LAS int*)(lds + MISC_OFF + MO_GALL), (const char*)(ws + WS_X1B), (const char*)(ws + WS_W_GU + (size_t)L * NE * 2048 * DM * EB), (const int*)(ws + WS_ROWDST), DM * EB, E, lds + MISC_OFF + MO_GTAB);
            GRID_BAR();
        } }
#endif
#if SITE(10)
        { KArgs ap = kargs(); const int tid = otid(wave0); LAS unsigned char* lds = olds(lds0); (void)tid;
        if (IN(pb + 6)) for (int rep_ = 0; rep_ < REP(10); ++rep_) {
            unsigned char* ws = ap->ws; unsigned* ctl = (unsigned*)(ws + WS_CTL);
            LAS int* tpre = (LAS int*)(lds + MISC_OFF + MO_TPRE); LAS int* ebase = (LAS int*)(lds + MISC_OFF + MO_EBASE); LAS int* ecnt = (LAS int*)(lds + MISC_OFF + MO_ECNT);
            __syncthreads();
            if (tid < NE) ecnt[tid] = (int)__hip_atomic_load(ctl + CW_ECNT + L * 32 + tid, RLX_AGENT);
            __syncthreads();
            if (tid == 0) { int t = 0;
_Pragma("unroll 1")
 for (int e = 0; e < NE; ++e) { const int c = ecnt[e]; tpre[e] = t; ebase[e] = t * 256; t += (c + 255) >> 8; } tpre[NE] = t; }
            __syncthreads();
            LAS int* ul = (LAS int*)(lds + MISC_OFF + MO_ULIST);
            constexpr int EB = MOE_FP8 ? 1 : 2;
            pg8::build_units_moe(tid, ul, tpre, ebase, ecnt, 4, DM * EB, (unsigned)DM * DM * EB);
            pg8::EpiMoeDown E{ws, ap->in[I_BDN] + (size_t)L * NE * DM};
            pg8::gemm_phase<pg8::EpiMoeDown, false, true, MOE_FP8 != 0>(tid, lds, ul, (LAS int*)(lds + MISC_OFF + MO_GTAB), (const char*)(ws + WS_ACT), (const char*)(ws + WS_W_DN + (size_t)L * NE * DM * DM * EB), nullptr, DM * EB, E, lds + MISC_OFF + MO_GALL);
            GRID_BAR();
        } }
#endif
#if SITE(11)
        { KArgs ap = kargs(); const int tid = otid(wave0); LAS unsigned char* lds = olds(lds0); (void)tid;
        if (IN(pb + 7)) for (int rep_ = 0; rep_ < REP(11); ++rep_) {
            const int lane = tid & 63, wave = __builtin_amdgcn_readfirstlane(tid >> 6), gw = VCU() * 8 + wave, NGW = gridDim.x * 8;
            unsigned char* ws = ap->ws; const bf16* X1R = (const bf16*)(ws + WS_X1F); const bf16* YS = (const bf16*)(ws + WS_YSLOT); bf16* XB = (bf16*)(ws + WS_XB); float* out = ap->out;
            const float* lg = ap->in[I_LNFG] + L * DM; const float* lbb = ap->in[I_LNFB] + L * DM;
#if YS_FP8
            typedef unsigned ys_t; constexpr int YSB = 1;
#else
            typedef v2u ys_t; constexpr int YSB = 2;
#endif
            v2u xn[4]; f32x4 g4[4], b4[4]; ys_t yn[4][4];
#pragma unroll
            for (int q = 0; q < 4; ++q) { g4[q] = *(const f32x4*)(lg + 256 * q + 4 * lane); b4[q] = *(const f32x4*)(lbb + 256 * q + 4 * lane); xn[q] = *(const v2u*)(X1R + (size_t)gw * DM + 256 * q + 4 * lane);
#pragma unroll
                for (int k = 0; k < 4; ++k) yn[q][k] = *(const ys_t*)((const unsigned char*)YS + (((size_t)gw * 4 + k) * DM + 256 * q + 4 * lane) * YSB); }
#pragma unroll 1
            for (int row = gw; row < NTOK; row += NGW) {
                f32x4 x[4]; ys_t yc[4][4]; float s = 0.f;
#pragma unroll
                for (int q = 0; q < 4; ++q) { x[q] = (f32x4){bflo(xn[q].x), bfhi(xn[q].x), bflo(xn[q].y), bfhi(xn[q].y)} * DN_ALPHA;
#pragma unroll
                    for (int k = 0; k < 4; ++k) yc[q][k] = yn[q][k]; }
                if (row + NGW < NTOK) {
#pragma unroll
                    for (int q = 0; q < 4; ++q) { xn[q] = *(const v2u*)(X1R + (size_t)(row + NGW) * DM + 256 * q + 4 * lane);
#pragma unroll
                        for (int k = 0; k < 4; ++k) yn[q][k] = *(const ys_t*)((const unsigned char*)YS + (((size_t)(row + NGW) * 4 + k) * DM + 256 * q + 4 * lane) * YSB); } }
#pragma unroll
                for (int q = 0; q < 4; ++q) {
#pragma unroll
#if YS_FP8
                    for (int k = 0; k < 4; ++k) { const f32x2 lo = __builtin_amdgcn_cvt_pk_f32_fp8((int)yc[q][k], false), hi = __builtin_amdgcn_cvt_pk_f32_fp8((int)yc[q][k], true);
                        x[q][0] += lo[0] * 0.015625f; x[q][1] += lo[1] * 0.015625f; x[q][2] += hi[0] * 0.015625f; x[q][3] += hi[1] * 0.015625f; }
#else
                    for (int k = 0; k < 4; ++k) { const v2u w = yc[q][k]; x[q][0] += bflo(w.x); x[q][1] += bfhi(w.x); x[q][2] += bflo(w.y); x[q][3] += bfhi(w.y); }
#endif
                    s += (x[q][0] + x[q][1]) + (x[q][2] + x[q][3]); }
                const float mu = wave_sum(s) * (1.0f / DM); float qq = 0.f;
#pragma unroll
                for (int q = 0; q < 4; ++q) { x[q] = x[q] - mu; qq += (x[q][0] * x[q][0] + x[q][1] * x[q][1]) + (x[q][2] * x[q][2] + x[q][3] * x[q][3]); }
                const float rs = 1.0f / sqrtf(wave_sum(qq) * (1.0f / DM) + LN_EPS);
#pragma unroll
                for (int q = 0; q < 4; ++q) { x[q] = x[q] * rs * g4[q] + b4[q];
                    if (L + 1 == DEPTH) *(f32x4*)(out + (size_t)row * DM + 256 * q + 4 * lane) = x[q];
                    else { v2u w; w.x = pk2(x[q][0], x[q][1]); w.y = pk2(x[q][2], x[q][3]); *(v2u*)(XB + (size_t)row * DM + 256 * q + 4 * lane) = w; } }
            }
            if (L + 1 < DEPTH) GRID_BAR();
        } }
#endif
    }
#undef IN
#undef GRID_BAR
}

extern "C" void kernel_launch(void* const* d_in, const int* in_sizes, int n_in, void* d_out, int out_size, void* d_ws, size_t ws_size, hipStream_t stream) {
    static int grid = 0;
    if (grid == 0) {
        if (n_in != 17 || out_size != NTOK * DM || ws_size < WS_END) { fprintf(stderr, "kernel_launch: unexpected shapes (n_in %d, out %d, ws %zu < %zu)\n", n_in, out_size, ws_size, (size_t)WS_END); grid = -1; return; }
        int dev = 0, cus = 0, per_cu = 0;
        if (hipGetDevice(&dev) != hipSuccess || hipDeviceGetAttribute(&cus, hipDeviceAttributeMultiprocessorCount, dev) != hipSuccess) { grid = -1; return; }
        if (hipFuncSetAttribute((const void*)mk_fwd, hipFuncAttributeMaxDynamicSharedMemorySize, LDS_BYTES) != hipSuccess) { fprintf(stderr, "kernel_launch: hipFuncSetAttribute failed\n"); grid = -1; return; }
        if (hipOccupancyMaxActiveBlocksPerMultiprocessor(&per_cu, (const void*)mk_fwd, 512, LDS_BYTES) != hipSuccess || per_cu < 1) { fprintf(stderr, "kernel_launch: occupancy query says %d\n", per_cu); }
        (void)hipGetLastError();
        grid = cus;
    }
    if (grid < 0) return;
    (void)hipMemsetAsync((char*)d_ws + WS_CTL, 0, CTL_ZERO_BYTES, stream);
    Args a{};
    for (int i = 0; i < 17; ++i) a.in[i] = (const float*)d_in[i];
    a.out = (float*)d_out; a.ws = (unsigned char*)d_ws;
#if MK_MULTI
    for (int p = 0; p < 1 + 8 * DEPTH; ++p) { a.ph_lo = p; a.ph_hi = p + 1; hipLaunchKernelGGL(mk_fwd, dim3(grid), dim3(512), LDS_BYTES, stream, a); }
#else
    a.ph_lo = 0; a.ph_hi = 1 + 8 * DEPTH;
    hipLaunchKernelGGL(mk_fwd, dim3(grid), dim3(512), LDS_BYTES, stream, a);
#endif
}
```

```cpp
#include <hip/hip_runtime.h>
#include <cstdio>
#include <cstdint>

#ifndef MK_MULTI
#define MK_MULTI 0
#endif
#ifndef PROBE_EPI2
#define PROBE_EPI2 0
#endif
#ifndef MOE_FP8
#define MOE_FP8 1
#endif
#ifndef ROUT_FP8
#define ROUT_FP8 1
#endif
#ifndef YS_FP8
#define YS_FP8 1
#endif
#ifndef SLOW_HGRN
#define SLOW_HGRN 0
#endif
#ifndef SLOW_RET
#define SLOW_RET 0
#endif

#define GAS __attribute__((address_space(1)))
#define LAS __attribute__((address_space(3)))
typedef unsigned short bf16;
typedef unsigned v4u __attribute__((ext_vector_type(4)));
typedef unsigned v2u __attribute__((ext_vector_type(2)));
typedef float f32x4 __attribute__((ext_vector_type(4)));
typedef float f32x2 __attribute__((ext_vector_type(2)));
typedef short bf16x8 __attribute__((ext_vector_type(8)));
typedef GAS unsigned gu32;

constexpr int DM = 1024, NBATCH = 16, SEQ = 2048, NTOK = NBATCH * SEQ, DEPTH = 4;
constexpr int NE = 32, TOPK = 4;
constexpr int HG_HEADS = 8, HG_K = 128;
constexpr int RT_HEADS = 4, RT_K = 256, RT_V = 512, RT_VD = 2048, RT_IN = 6144, HG_IN = 4096;
constexpr int ECAP = NTOK;
constexpr int MOE_ROWS = NTOK * TOPK + NE * 256;
constexpr float DN_ALPHA = 1.681792830507429f;
constexpr float LN_EPS = 1e-5f, RMS_EPS = 1e-6f;

constexpr size_t MiB = 1ull << 20;
constexpr size_t WS_CTL = 0, CTL_ZERO_BYTES = 1 * MiB;
constexpr size_t WS_LBS = 1 * MiB;
constexpr size_t WS_WRH = 1 * MiB + 128 * 1024, WS_WRL = 1 * MiB + 512 * 1024;
constexpr size_t WS_BGU = 2 * MiB;
constexpr size_t WS_ROT = 4 * MiB;
constexpr size_t WS_ROWDST = 8 * MiB;
constexpr size_t WS_ROWGATE = 12 * MiB;
constexpr size_t WS_W_HIN = 16 * MiB;
constexpr size_t WS_W_HOUT = WS_W_HIN + 16 * MiB;
constexpr size_t WS_W_RIN = WS_W_HOUT + 4 * MiB;
constexpr size_t WS_W_ROUT = WS_W_RIN + 24 * MiB;
constexpr size_t WS_W_GU = WS_W_ROUT + 8 * MiB;
constexpr size_t WS_W_DN = WS_W_GU + 512 * MiB;
constexpr size_t WS_XB = WS_W_DN + 256 * MiB;
constexpr size_t WS_H = WS_XB + 64 * MiB;
constexpr size_t WS_DEC = WS_H + 320 * MiB;
constexpr size_t WS_SSP = WS_DEC + 16 * MiB;
constexpr size_t WS_O = WS_H + 384 * MiB;
constexpr size_t WS_A2 = WS_O + 128 * MiB;
constexpr size_t WS_Y = WS_A2 + 128 * MiB;
constexpr size_t WS_X1F = WS_Y + 128 * MiB;
constexpr size_t WS_X1B = WS_X1F + 128 * MiB;
constexpr size_t WS_ACT = WS_X1B + 64 * MiB;
constexpr size_t WS_YSLOT = WS_ACT + 272 * MiB;
constexpr size_t WS_W_ROUT8 = WS_YSLOT + 256 * MiB;
constexpr size_t WS_END = WS_W_ROUT8 + 4 * MiB;

constexpr int CW_BAR = 4096;
constexpr int CW_SS = 65536;
constexpr int CW_ECNT = 16384;

constexpr int RING_BYTES = 131072;
constexpr int MISC_OFF = 135168;
constexpr int LDS_BYTES = 163840;
constexpr int MO_BARW = 0;
constexpr int MO_GTAB = 64;
constexpr int MO_TPRE = 64 + 2048;
constexpr int MO_EBASE = MO_TPRE + 160;
constexpr int MO_ECNT = MO_EBASE + 128;
constexpr int MO_LCNT = MO_ECNT + 128;
constexpr int MO_LBASE = MO_LCNT + 128;
constexpr int MO_SEL = MO_LBASE + 128;
constexpr int MO_SELW = MO_SEL + 2048;
constexpr int MO_RANK = MO_SELW + 2048;
constexpr int MO_ULIST = MO_RANK + 2048;
constexpr int MO_GALL = 10240;
constexpr int GALL_UNITS = 18;
static_assert(MO_ULIST + 1024 <= MO_GALL && MISC_OFF + MO_GALL + GALL_UNITS * 1024 <= LDS_BYTES, "LDS map");

#define RLX_AGENT __ATOMIC_RELAXED, __HIP_MEMORY_SCOPE_AGENT
#define LDS_WAIT() asm volatile("s_waitcnt lgkmcnt(0)" ::: "memory")
#define VM_WAIT() asm volatile("s_waitcnt vmcnt(0)" ::: "memory")

__device__ __forceinline__ unsigned f2bf(float f) { unsigned u = __builtin_bit_cast(unsigned, f); return (u + 0x7fffu + ((u >> 16) & 1u)) >> 16; }
__device__ __forceinline__ unsigned pk2(float lo, float hi) { return f2bf(lo) | (f2bf(hi) << 16); }
__device__ __forceinline__ unsigned cvt_pk_bf16(float lo, float hi) { unsigned r; asm volatile("v_cvt_pk_bf16_f32 %0, %1, %2" : "=v"(r) : "v"(lo), "v"(hi)); return r; }
#if MOE_FP8
constexpr float X_SCALE = 4.0f, WGU_SCALE = 64.0f, ACT_SCALE = 4.0f, WDN_SCALE = 128.0f;
constexpr float GU_DESCALE = 1.0f / (X_SCALE * WGU_SCALE), DN_DESCALE = 1.0f / (ACT_SCALE * WDN_SCALE);
#else
constexpr float GU_DESCALE = 1.0f, DN_DESCALE = 1.0f, ACT_SCALE = 1.0f;
#endif
__device__ __forceinline__ unsigned pk4_fp8(float a, float b, float c, float d) {
    a = __builtin_amdgcn_fmed3f(a, -448.0f, 448.0f); b = __builtin_amdgcn_fmed3f(b, -448.0f, 448.0f); c = __builtin_amdgcn_fmed3f(c, -448.0f, 448.0f); d = __builtin_amdgcn_fmed3f(d, -448.0f, 448.0f);
    int p = __builtin_amdgcn_cvt_pk_fp8_f32(a, b, 0, false); p = __builtin_amdgcn_cvt_pk_fp8_f32(c, d, p, true); return (unsigned)p; }
__device__ __forceinline__ float bflo(unsigned u) { return __builtin_bit_cast(float, u << 16); }
__device__ __forceinline__ float bfhi(unsigned u) { return __builtin_bit_cast(float, u & 0xffff0000u); }
__device__ __forceinline__ float bf1(bf16 b) { return __builtin_bit_cast(float, ((unsigned)b) << 16); }
__device__ __forceinline__ float fexp(float x) { return __builtin_amdgcn_exp2f(x * 1.4426950408889634f); }
__device__ __forceinline__ float frcp(float x) { return __builtin_amdgcn_rcpf(x); }
__device__ __forceinline__ float fsigmoid(float x) { return frcp(1.0f + fexp(-x)); }
__device__ __forceinline__ float wave_sum(float v) {
#pragma unroll
    for (int o = 1; o < 64; o <<= 1) v += __shfl_xor(v, o);
    return v;
}
__device__ __forceinline__ float wave_max(float v) {
#pragma unroll
    for (int o = 1; o < 64; o <<= 1) v = fmaxf(v, __shfl_xor(v, o));
    return v;
}

template <int CTRL> __device__ __forceinline__ float dppf(float v) { return __builtin_bit_cast(float, __builtin_amdgcn_update_dpp(0, __builtin_bit_cast(int, v), CTRL, 0xf, 0xf, true)); }
template <int CTRL> __device__ __forceinline__ int dppi(int v) { return __builtin_amdgcn_update_dpp(0, v, CTRL, 0xf, 0xf, true); }
__device__ __forceinline__ float rlane(float v, int l) { return __builtin_bit_cast(float, __builtin_amdgcn_readlane(__builtin_bit_cast(int, v), l)); }
__device__ __forceinline__ float wave_sum_u(float v) {
    v += dppf<0xB1>(v); v += dppf<0x4E>(v); v += dppf<0x141>(v); v += dppf<0x140>(v);
    return (rlane(v, 0) + rlane(v, 16)) + (rlane(v, 32) + rlane(v, 48));
}
#define XB_TMO      128
#define XB_XCNT(j)  (256  + 64 * (j))
#define XB_XSUB(j)  (1280 + 64 * (j))
#define XB_XGEN(j)  (2304 + 64 * (j))
#define XB_TOP      3328
#define XB_TOPGEN   3392
#define XCD_BAR_WORDS 3456
#define XB_SPIN_CAP (1u << 22)

__device__ __forceinline__ unsigned xb_ld(unsigned* p)              { return __hip_atomic_load(p, __ATOMIC_RELAXED, __HIP_MEMORY_SCOPE_AGENT); }
__device__ __forceinline__ unsigned xb_add(unsigned* p, unsigned v) { return __hip_atomic_fetch_add(p, v, __ATOMIC_RELAXED, __HIP_MEMORY_SCOPE_AGENT); }
__device__ __forceinline__ unsigned xb_xcc_id() { return (unsigned)__builtin_amdgcn_s_getreg((3 << 11) | 20) & 0xFu; }
#define XB_SPIN(cond, bar) do { unsigned _sp = 0; while (cond) { __builtin_amdgcn_s_sleep(1); \
    if ((++_sp & 255u) == 0u) { if (xb_ld(&(bar)[XB_TMO])) break; if (_sp > XB_SPIN_CAP) { atomicAdd(&(bar)[XB_TMO], 1u); break; } } } } while (0)

struct XcdBarrier { unsigned* bar; unsigned x; volatile LAS unsigned* st; };

__device__ __forceinline__ XcdBarrier xcd_barrier_post(unsigned* bar, volatile LAS unsigned* st) {
    XcdBarrier b; b.bar = bar; b.x = xb_xcc_id(); b.st = st;
    if (threadIdx.x == 0) (void)xb_add(&bar[XB_XCNT(b.x)], 1u);
    return b;
}
__device__ __forceinline__ void xcd_barrier_complete(unsigned* bar, unsigned x, unsigned& nloc, unsigned& nx) {
    const unsigned G = gridDim.x * gridDim.y * gridDim.z;
    unsigned sum, cnt, mine, sp = 0u;
    for (;;) {
        sum = 0u; cnt = 0u; mine = 0u;
#pragma unroll
        for (unsigned j = 0; j < 16; ++j) { const unsigned c = xb_ld(&bar[XB_XCNT(j)]); sum += c; cnt += (c > 0u) ? 1u : 0u; mine = (j == x) ? c : mine; }
        if (sum == G) break;
        __builtin_amdgcn_s_sleep(1);
        if ((++sp & 255u) == 0u) { if (xb_ld(&bar[XB_TMO])) break; if (sp > XB_SPIN_CAP) { atomicAdd(&bar[XB_TMO], 1u); break; } }
    }
    nloc = mine > 0u ? mine : 1u; nx = cnt > 0u ? cnt : 1u;
}
__device__ __forceinline__ void xcd_barrier(const XcdBarrier& b) {
    asm volatile("s_waitcnt vmcnt(0)" ::: "memory");
    __syncthreads();
    if (threadIdx.x == 0) {
        unsigned* bar = b.bar;
        __builtin_amdgcn_s_waitcnt(0);
        unsigned nloc = b.st[0], nx = b.st[1];
        if (nloc == 0u) { xcd_barrier_complete(bar, b.x, nloc, nx); b.st[0] = nloc; b.st[1] = nx; }
        const unsigned old = xb_add(&bar[XB_XSUB(b.x)], 1u);
        const unsigned gen = old / nloc;
        if (old + 1u == (gen + 1u) * nloc) {
            __builtin_amdgcn_fence(__ATOMIC_RELEASE, "agent");
            asm volatile("s_waitcnt vmcnt(0)" ::: "memory");
            const unsigned og = xb_add(&bar[XB_TOP], 1u);
            const unsigned tg = og / nx;
            if (og + 1u == (tg + 1u) * nx) xb_add(&bar[XB_TOPGEN], 1u);
            else XB_SPIN(xb_ld(&bar[XB_TOPGEN]) == tg, bar);
            __builtin_amdgcn_fence(__ATOMIC_ACQUIRE, "agent");
            xb_add(&bar[XB_XGEN(b.x)], 1u);
            asm volatile("s_waitcnt vmcnt(0)" ::: "memory");
        } else {
            XB_SPIN(xb_ld(&bar[XB_XGEN(b.x)]) == gen, bar);
            __builtin_amdgcn_fence(__ATOMIC_ACQUIRE, "agent");
            asm volatile("s_waitcnt vmcnt(0)" ::: "memory");
        }
    }
    __syncthreads();
}

namespace pg8 {
constexpr int BM = 256, BK = 64, HALF = 128, HTB = HALF * BK * 2, STAGE_BYTES = 8 * HTB, NXCD = 8, WGM = 8, MAXU = 32;
__host__ __device__ __forceinline__ int lds_byte(int r, int c) { const int st = (r >> 4) * 2 + (c >> 5), rr = r & 15, cc = c & 31, ob = rr * 64 + cc * 2; return st * 1024 + (ob ^ (((ob >> 9) & 1) << 5)); }
__host__ __device__ __forceinline__ void stage_rc(int b, int& R, int& C) { const int st = b / 1024, sb = b % 1024, swz = sb ^ (((sb >> 9) & 1) << 5); R = (st >> 1) * 16 + swz / 64; C = (st & 1) * 32 + (swz % 64) / 2; }
__host__ __device__ __forceinline__ int perm32(int rho) { const int n = rho >> 4, i = rho & 15; return 8 * (i >> 2) + 4 * n + (i & 3); }

struct Unit { int pm, pn, e, rowbase, cnt; unsigned boff; int gidx; };

__device__ __forceinline__ bool tile_of(long L, int nM, int nN, int& gm, int& pn) {
    const int nwg = nM * nN; if (L >= nwg) return false;
    int wgid = (int)L; { const int q = nwg / NXCD, r = nwg % NXCD, xcd = wgid % NXCD, off = wgid / NXCD; wgid = (xcd < r ? xcd * (q + 1) : r * (q + 1) + (xcd - r) * q) + off; }
    const int nig = WGM * nN, gid = wgid / nig, fm = gid * WGM, gsz = (nM - fm) < WGM ? (nM - fm) : WGM;
    gm = fm + ((wgid % nig) % gsz); pn = (wgid % nig) / gsz; return true;
}
__device__ __forceinline__ void build_units_dense(const int i, LAS int* ul, int nM, int nN, int RB) {
    if (i < MAXU) { int gm = 0, pn = 0; const bool ok = tile_of((long)i * gridDim.x + blockIdx.x, nM, nN, gm, pn);
        ul[i * 8 + 0] = ok ? 1 : 0; ul[i * 8 + 1] = gm; ul[i * 8 + 2] = pn; ul[i * 8 + 3] = 0; ul[i * 8 + 4] = gm * BM; ul[i * 8 + 5] = BM; ul[i * 8 + 6] = (int)((unsigned)pn * BM * (unsigned)RB); ul[i * 8 + 7] = 0; }
    __syncthreads();
}
__device__ __forceinline__ void build_units_moe(const int i, LAS int* ul, const LAS int* tpre, const LAS int* ebase, const LAS int* ecnt, int nN, int RB, unsigned wstride) {
    if (i < MAXU) { int gm = 0, pn = 0; const bool ok = tile_of((long)i * gridDim.x + blockIdx.x, tpre[NE], nN, gm, pn);
        int e = 0;
_Pragma("unroll 1")
        for (int s = 16; s >= 1; s >>= 1) { if (e + s < NE && tpre[e + s] <= gm) e += s; }
        const int pm = gm - tpre[e];
        ul[i * 8 + 0] = ok ? 1 : 0; ul[i * 8 + 1] = pm; ul[i * 8 + 2] = pn; ul[i * 8 + 3] = e; ul[i * 8 + 4] = ebase[e] + pm * BM; ul[i * 8 + 5] = ecnt[e] - pm * BM;
        ul[i * 8 + 6] = (int)((unsigned)e * wstride + (unsigned)pn * BM * (unsigned)RB); ul[i * 8 + 7] = e * ECAP + pm * BM; }
    __syncthreads();
}
__device__ __forceinline__ bool ld_unit(const LAS int* ul, int i, Unit& u) {
    if (i >= MAXU) return false;
    const LAS int* p = ul + i * 8;
    if (__builtin_amdgcn_readfirstlane(p[0]) == 0) return false;
    u.pm = __builtin_amdgcn_readfirstlane(p[1]); u.pn = __builtin_amdgcn_readfirstlane(p[2]); u.e = __builtin_amdgcn_readfirstlane(p[3]); u.rowbase = __builtin_amdgcn_readfirstlane(p[4]);
    u.cnt = __builtin_amdgcn_readfirstlane(p[5]); u.boff = (unsigned)__builtin_amdgcn_readfirstlane(p[6]); u.gidx = __builtin_amdgcn_readfirstlane(p[7]); return true;
}
__device__ __forceinline__ void glds16(const char* sbase, unsigned voff, LAS unsigned char* dst) {
    asm volatile("" : "+s"(sbase));
    __builtin_amdgcn_global_load_lds((const unsigned*)(sbase + voff), (LAS unsigned*)dst, 16, 0, 0);
}
template <bool GATHER> __device__ __forceinline__ void stage_a(LAS unsigned char* dst, const char* sbase, unsigned o0, unsigned o1, size_t r64) {
    glds16(sbase, o0, dst);
    if constexpr (GATHER) glds16(sbase, o1, dst + 8192);
    else glds16(sbase + r64, o0, dst + 8192);
}

typedef int v8i __attribute__((ext_vector_type(8)));
typedef int v4i __attribute__((ext_vector_type(4)));
__device__ __forceinline__ v8i cat_frag(const bf16x8& a, const bf16x8& b) { return __builtin_shufflevector(__builtin_bit_cast(v4i, a), __builtin_bit_cast(v4i, b), 0, 1, 2, 3, 4, 5, 6, 7); }
template <class Epi, bool GATHER, bool ALIGN_EPI, bool FP8>
__device__ __forceinline__ void gemm_phase(const int tid, LAS unsigned char* lds, const LAS int* ul, LAS int* gtab, const char* Abase, const char* Bbase, const int* rowdst, const int RB, const Epi& E, LAS unsigned char* epl = nullptr) {
    const int wid = __builtin_amdgcn_readfirstlane(tid >> 6), lane = tid & 63, wr = wid >> 2, wc = wid & 3, fr = lane & 15, fq = lane >> 4;
    const int nt = RB / 128;
    int R0, C0; stage_rc(tid * 16, R0, C0);
    const int Rb0 = Epi::PERM ? ((R0 & ~31) + perm32(R0 & 31)) : R0;
    const unsigned voffB = (unsigned)(Rb0 * RB + C0 * 2);
    const unsigned cb0 = (unsigned)C0 * 2u, K2 = (unsigned)RB;
    const size_t kstep = (size_t)128;
    const size_t r64 = (size_t)64 * RB;
    const size_t hstep = (size_t)HALF * RB;
    const unsigned ldsw = (unsigned)wid * 1024u;
    const int aoff = lds_byte(wr * 64 + fr, fq * 8), boff = lds_byte(wc * 32 + fr, fq * 8);
#define PG8_SA(b, h) (((b) * 2 + (h)) * HTB)
#define PG8_SB(b, h) ((4 + (b) * 2 + (h)) * HTB)
#define PG8_STAGE(bufoff, gbase) do { glds16((const char*)(gbase), voffB, lds + (bufoff) + ldsw); glds16((const char*)(gbase) + r64, voffB, lds + (bufoff) + ldsw + 8192); } while (0)
#define PG8_STAGEA0(bufoff, kb, o0, o1) stage_a<GATHER>(lds + (bufoff) + ldsw, Abase + (kb), o0, o1, r64)
#define PG8_STAGEA1(bufoff, kb, o0, o2, o3) stage_a<GATHER>(lds + (bufoff) + ldsw, Abase + (kb) + (GATHER ? (size_t)0 : hstep), GATHER ? (o2) : (o0), o3, r64)
#define PG8_LDA(dst, b, h) do { _Pragma("unroll") for (int m = 0; m < 4; ++m) { const v4i _l = *(const LAS v4i*)(lds + PG8_SA(b, h) + aoff + m * 2048), _h = *(const LAS v4i*)(lds + PG8_SA(b, h) + aoff + m * 2048 + 1024); dst[m] = __builtin_shufflevector(_l, _h, 0, 1, 2, 3, 4, 5, 6, 7); } } while (0)
#define PG8_LDB(dst, b, h) do { _Pragma("unroll") for (int n = 0; n < 2; ++n) { const v4i _l = *(const LAS v4i*)(lds + PG8_SB(b, h) + boff + n * 2048), _h = *(const LAS v4i*)(lds + PG8_SB(b, h) + boff + n * 2048 + 1024); dst[n] = __builtin_shufflevector(_l, _h, 0, 1, 2, 3, 4, 5, 6, 7); } } while (0)
#define PG8_LO(x) __builtin_bit_cast(bf16x8, __builtin_shufflevector(x, x, 0, 1, 2, 3))
#define PG8_HI(x) __builtin_bit_cast(bf16x8, __builtin_shufflevector(x, x, 4, 5, 6, 7))
#define PG8_MMA(ai, bj, At, Bt) do { __builtin_amdgcn_s_setprio(1); _Pragma("unroll") for (int m = 0; m < 4; ++m) _Pragma("unroll") for (int n = 0; n < 2; ++n) { \
        if constexpr (FP8) asm volatile("v_mfma_scale_f32_16x16x128_f8f6f4 %0, %1, %2, %0, %3, %3 op_sel_hi:[0,0,0]" : "+v"(acc[ai][bj][m][n]) : "v"(Bt[n]), "v"(At[m]), "v"(sc1)); \
        else { acc[ai][bj][m][n] = __builtin_amdgcn_mfma_f32_16x16x32_bf16(PG8_LO(Bt[n]), PG8_LO(At[m]), acc[ai][bj][m][n], 0, 0, 0); \
               acc[ai][bj][m][n] = __builtin_amdgcn_mfma_f32_16x16x32_bf16(PG8_HI(Bt[n]), PG8_HI(At[m]), acc[ai][bj][m][n], 0, 0, 0); } } \
        __builtin_amdgcn_s_setprio(0); } while (0)
#define PG8_WAIT_V(n) asm volatile("s_waitcnt vmcnt(" #n ")" ::: "memory")
#define PG8_WAIT_L(n) asm volatile("s_waitcnt lgkmcnt(" #n ")" ::: "memory")
#define PG8_BAR __builtin_amdgcn_s_barrier()
#define PG8_SCHED __builtin_amdgcn_sched_barrier(0)
    Unit cur, nxt; int ui = 0;
    if (!ld_unit(ul, 0, cur)) return;
    f32x4 acc[2][2][4][2];
#pragma unroll
    for (int a = 0; a < 2; ++a)
#pragma unroll
        for (int b = 0; b < 2; ++b)
#pragma unroll
            for (int m = 0; m < 4; ++m)
#pragma unroll
                for (int n = 0; n < 2; ++n) acc[a][b][m][n] = (f32x4){0.f, 0.f, 0.f, 0.f};
    v8i At[4], B0[2], B1[2];
    const int sc1 = 0x7f7f7f7f;
    unsigned oA0, oA1 = 0, oA2 = 0, oA3 = 0, oN0, oN1 = 0, oN2 = 0, oN3 = 0;
    if constexpr (GATHER) {
        oA0 = (unsigned)gtab[R0] * K2 + cb0; oA1 = (unsigned)gtab[R0 + 64] * K2 + cb0; oA2 = (unsigned)gtab[R0 + 128] * K2 + cb0; oA3 = (unsigned)gtab[R0 + 192] * K2 + cb0;
    } else {
        oA0 = (unsigned)(cur.rowbase + R0) * K2 + cb0;
    }
    oN0 = oA0; oN1 = oA1; oN2 = oA2; oN3 = oA3;
    const char* cB = Bbase + cur.boff;
    PG8_STAGE(PG8_SB(0, 0), cB); PG8_STAGE(PG8_SB(0, 1), cB + hstep); PG8_STAGEA0(PG8_SA(0, 0), (size_t)0, oA0, oA1); PG8_STAGEA1(PG8_SA(0, 1), (size_t)0, oA0, oA2, oA3);
    if (wr == 1) PG8_BAR;
    PG8_WAIT_V(2); PG8_BAR;
    PG8_STAGE(PG8_SB(1, 0), cB + kstep); PG8_STAGEA0(PG8_SA(1, 0), kstep, oA0, oA1); PG8_STAGE(PG8_SB(1, 1), cB + hstep + kstep);
    PG8_WAIT_V(6); PG8_BAR;
    for (;;) {
        const bool has_next = ld_unit(ul, ui + 1, nxt);
        if constexpr (Epi::HAS_PRE) E.pre(cur, epl + (ui & 1) * Epi::PRE_BYTES, wid, lane);
        const char* nB = has_next ? Bbase + nxt.boff : cB;
_Pragma("unroll 1")
        for (int t = 0; t < nt; t += 2) {
            const bool last = (t == nt - 2);
            if (last && has_next) {
                if constexpr (GATHER) {
                    const LAS int* gt = gtab + (ui + 1) * 256;
                    oN0 = (unsigned)gt[R0] * K2 + cb0; oN1 = (unsigned)gt[R0 + 64] * K2 + cb0; oN2 = (unsigned)gt[R0 + 128] * K2 + cb0; oN3 = (unsigned)gt[R0 + 192] * K2 + cb0;
                } else {
                    oN0 = (unsigned)(nxt.rowbase + R0) * K2 + cb0;
                }
            }
            const size_t kb1 = (size_t)(t + 1) * kstep;
            const size_t kb2 = last ? (size_t)0 : (size_t)(t + 2) * kstep, kb3 = kb2 + kstep;
            const unsigned p0 = last ? oN0 : oA0, p1 = last ? oN1 : oA1, p2 = last ? oN2 : oA2, p3 = last ? oN3 : oA3;
            const char* b2 = last ? nB : cB + (size_t)(t + 2) * kstep; const char* b3 = b2 + kstep;
            PG8_LDB(B0, 0, 0); PG8_LDB(B1, 0, 1); PG8_SCHED; PG8_LDA(At, 0, 0); PG8_STAGEA1(PG8_SA(1, 1), kb1, oA0, oA2, oA3);
            PG8_WAIT_V(8); PG8_WAIT_L(0); PG8_BAR; PG8_MMA(0, 0, At, B0); PG8_MMA(0, 1, At, B1); PG8_BAR; PG8_SCHED;
            PG8_LDA(At, 0, 1); PG8_STAGE(PG8_SB(0, 0), b2); PG8_STAGE(PG8_SB(0, 1), b2 + hstep); PG8_STAGEA0(PG8_SA(0, 0), kb2, p0, p1);
            PG8_WAIT_V(8); PG8_WAIT_L(0); PG8_BAR; PG8_MMA(1, 0, At, B0); PG8_MMA(1, 1, At, B1); PG8_BAR; PG8_SCHED;
            PG8_LDB(B0, 1, 0); PG8_LDB(B1, 1, 1); PG8_SCHED; PG8_LDA(At, 1, 0); PG8_STAGEA1(PG8_SA(0, 1), kb2, p0, p2, p3);
            PG8_WAIT_V(8); PG8_WAIT_L(0); PG8_BAR; PG8_MMA(0, 0, At, B0); PG8_MMA(0, 1, At, B1); PG8_BAR; PG8_SCHED;
            PG8_LDA(At, 1, 1); PG8_STAGE(PG8_SB(1, 0), b3); PG8_STAGE(PG8_SB(1, 1), b3 + hstep); PG8_STAGEA0(PG8_SA(1, 0), kb3, p0, p1);
            PG8_WAIT_V(8); PG8_WAIT_L(0); PG8_BAR; PG8_MMA(1, 0, At, B0); PG8_MMA(1, 1, At, B1); PG8_BAR; PG8_SCHED;
        }
        if constexpr (FP8) asm volatile("s_nop 7\n\ts_nop 7\n\ts_nop 7" ::: "memory");
        if constexpr (ALIGN_EPI) { if (wr == 0) PG8_BAR; }
        if constexpr (Epi::HAS_PRE) E(acc, cur, wr, wc, fr, fq, epl + (ui & 1) * Epi::PRE_BYTES); else E(acc, cur, wr, wc, fr, fq);
#if PROBE_EPI2
        if constexpr (FP8) { if constexpr (Epi::HAS_PRE) E(acc, cur, wr, wc, fr, fq, epl + (ui & 1) * Epi::PRE_BYTES); else E(acc, cur, wr, wc, fr, fq); }
#endif
        if (!has_next) break;
#pragma unroll
        for (int a = 0; a < 2; ++a)
#pragma unroll
            for (int b = 0; b < 2; ++b)
#pragma unroll
                for (int m = 0; m < 4; ++m)
#pragma unroll
                    for (int n = 0; n < 2; ++n) acc[a][b][m][n] = (f32x4){0.f, 0.f, 0.f, 0.f};
        cur = nxt; cB = nB; oA0 = oN0; oA1 = oN1; oA2 = oN2; oA3 = oN3; ++ui;
        if constexpr (ALIGN_EPI) { if (wr == 1) PG8_BAR; }
    }
    PG8_WAIT_V(0);
    if constexpr (!ALIGN_EPI) { if (wr == 0) PG8_BAR; }
    PG8_BAR;
#undef PG8_SA
#undef PG8_SB
#undef PG8_STAGE
#undef PG8_STAGEA0
#undef PG8_STAGEA1
#undef PG8_LDA
#undef PG8_LDB
#undef PG8_LO
#undef PG8_HI
#undef PG8_MMA
#undef PG8_WAIT_V
#undef PG8_WAIT_L
#undef PG8_BAR
#undef PG8_SCHED
}

__device__ __forceinline__ GAS unsigned char* launder(unsigned char* p) { asm volatile("" : "+s"(p)); return (GAS unsigned char*)p; }
#define OPAQUE_LANE(fr, fq) asm volatile("" : "+v"(fr), "+v"(fq))
struct EpiHgrnIn {
    static constexpr bool PERM = true, HAS_PRE = true; static constexpr int PRE_BYTES = 1024;
    unsigned char* ws0; int L;
    __device__ __forceinline__ void pre(const Unit& u, LAS unsigned char* buf, int wid, int lane) const {
        if (wid == 0 && u.pn < 8) glds16((const char*)(ws0 + WS_LBS) + ((size_t)L * DM + (size_t)u.pn * HG_K) * 4, (unsigned)lane * 16u, buf);
    }
    __device__ __forceinline__ void operator()(const f32x4 (&acc)[2][2][4][2], const Unit& u, int wr, int wc, int fr, int fq, const LAS unsigned char* buf) const {
        OPAQUE_LANE(fr, fq);
        GAS unsigned char* ws = launder(ws0);
        GAS bf16* QD = (GAS bf16*)(ws + WS_H);
        const int row0 = u.rowbase + wr * 64 + fr;
        if (u.pn >= 8) {
            const bool isg = u.pn >= 12; GAS bf16* base = QD + (size_t)(isg ? 4 : 3) * NTOK * DM; const int colt = (u.pn - (isg ? 12 : 8)) * BM + wc * 32 + 8 * fq;
#pragma unroll
            for (int ai = 0; ai < 2; ++ai)
#pragma unroll
                for (int m = 0; m < 4; ++m) { GAS bf16* rowp = base + (size_t)(row0 + ai * HALF + m * 16) * DM + colt;
#pragma unroll
                    for (int bj = 0; bj < 2; ++bj) { f32x4 v0 = acc[ai][bj][m][0], v1 = acc[ai][bj][m][1];
                        if (isg) {
#pragma unroll
                            for (int j = 0; j < 4; ++j) { v0[j] = v0[j] * fsigmoid(v0[j]); v1[j] = v1[j] * fsigmoid(v1[j]); } }
                        v4u w; w.x = cvt_pk_bf16(v0[0], v0[1]); w.y = cvt_pk_bf16(v0[2], v0[3]); w.z = cvt_pk_bf16(v1[0], v1[1]); w.w = cvt_pk_bf16(v1[2], v1[3]);
                        *(GAS v4u*)(rowp + bj * HALF) = w; } }
            return;
        }
        const int col = u.pn * HG_K + wc * 32 + 8 * fq;
        const LAS float* lb = (const LAS float*)buf + wc * 32 + 8 * fq;
        const f32x4 lb0 = *(const LAS f32x4*)lb, lb1 = *(const LAS f32x4*)(lb + 4);
#if !SLOW_HGRN
        const int lane = fq * 16 + fr;
        GAS float* DEC = (GAS float*)(ws + WS_DEC);
#endif
#pragma unroll
        for (int ai = 0; ai < 2; ++ai)
#pragma unroll
            for (int m = 0; m < 4; ++m) {
                const int row = row0 + ai * HALF + m * 16;
                float qd[8], ki[8];
#if SLOW_HGRN
                float ks[8];
#endif
#if !SLOW_HGRN
                float de[8];
#endif
#pragma unroll
                for (int j = 0; j < 8; ++j) {
                    const float q = acc[ai][0][m][j >> 2][j & 3], f = acc[ai][1][m][j >> 2][j & 3], lbv = j < 4 ? lb0[j & 3] : lb1[j & 3];
                    const float sg = fsigmoid(f), fg = lbv + (1.0f - lbv) * sg, kk = (1.0f - lbv) * (1.0f - sg);
#if SLOW_HGRN
                    qd[j] = q * fsigmoid(q); ki[j] = kk; ks[j] = fg;
#else
                    float P = fg;
                    P *= __builtin_bit_cast(float, __builtin_amdgcn_update_dpp(0x3f800000, __builtin_bit_cast(int, P), 0x111, 0xf, 0xf, false));
                    P *= __builtin_bit_cast(float, __builtin_amdgcn_update_dpp(0x3f800000, __builtin_bit_cast(int, P), 0x112, 0xf, 0xf, false));
                    P *= __builtin_bit_cast(float, __builtin_amdgcn_update_dpp(0x3f800000, __builtin_bit_cast(int, P), 0x114, 0xf, 0xf, false));
                    P *= __builtin_bit_cast(float, __builtin_amdgcn_update_dpp(0x3f800000, __builtin_bit_cast(int, P), 0x118, 0xf, 0xf, false));
                    const float Pl = __shfl(P, lane | 15), iP = frcp(fmaxf(P, 1e-30f));
                    qd[j] = q * fsigmoid(q) * P; ki[j] = kk * iP; de[j] = Pl;
#endif
                }
                const size_t o = (size_t)row * DM + col;
                v4u w;
                w.x = cvt_pk_bf16(qd[0], qd[1]); w.y = cvt_pk_bf16(qd[2], qd[3]); w.z = cvt_pk_bf16(qd[4], qd[5]); w.w = cvt_pk_bf16(qd[6], qd[7]); *(GAS v4u*)(QD + o) = w;
                w.x = cvt_pk_bf16(ki[0], ki[1]); w.y = cvt_pk_bf16(ki[2], ki[3]); w.z = cvt_pk_bf16(ki[4], ki[5]); w.w = cvt_pk_bf16(ki[6], ki[7]); *(GAS v4u*)(QD + (size_t)NTOK * DM + o) = w;
#if SLOW_HGRN
                w.x = cvt_pk_bf16(ks[0], ks[1]); w.y = cvt_pk_bf16(ks[2], ks[3]); w.z = cvt_pk_bf16(ks[4], ks[5]); w.w = cvt_pk_bf16(ks[6], ks[7]); *(GAS v4u*)(QD + 2 * (size_t)NTOK * DM + o) = w;
#endif
#if !SLOW_HGRN
                if (fr == 0) { GAS float* dp = DEC + (size_t)(row >> 4) * DM + col; *(GAS f32x4*)dp = (f32x4){de[0], de[1], de[2], de[3]}; *(GAS f32x4*)(dp + 4) = (f32x4){de[4], de[5], de[6], de[7]}; }
#endif
            }
    }
};
struct EpiRetIn {
    static constexpr bool PERM = true, HAS_PRE = false; static constexpr int PRE_BYTES = 0;
    unsigned char* ws0;
    __device__ __forceinline__ void operator()(const f32x4 (&acc)[2][2][4][2], const Unit& u, int wr, int wc, int fr, int fq) const {
        OPAQUE_LANE(fr, fq);
        GAS unsigned char* ws = launder(ws0);
        GAS bf16* H = (GAS bf16*)(ws + WS_H); const GAS float* rot = (const GAS float*)(ws + WS_ROT);
        const int row0 = u.rowbase + wr * 64 + fr; const int colt = u.pn * BM + wc * 32 + 8 * fq;
        const int kind = u.pn < 4 ? 0 : (u.pn < 8 ? 1 : (u.pn < 16 ? 2 : 3));
#pragma unroll
        for (int ai = 0; ai < 2; ++ai)
#pragma unroll
            for (int m = 0; m < 4; ++m) { const int row = row0 + ai * HALF + m * 16; GAS bf16* rowp = H + (size_t)row * RT_IN + colt; const int pos = row & (SEQ - 1);
#pragma unroll
                for (int bj = 0; bj < 2; ++bj) { f32x4 v0 = acc[ai][bj][m][0], v1 = acc[ai][bj][m][1];
                    if (kind <= 1) {
                        const int p0 = (bj * HALF + wc * 32 + 8 * fq) >> 1;
                        const GAS float* rp = rot + ((size_t)pos * 128 + p0) * 2;
                        const f32x4 r0 = *(const GAS f32x4*)rp, r1 = *(const GAS f32x4*)(rp + 4);
                        const float sc = kind == 1 ? 0.0625f : 1.0f;
                        f32x4 o0, o1;
                        o0[0] = (v0[0] * r0[0] - v0[1] * r0[1]) * sc; o0[1] = (v0[1] * r0[0] + v0[0] * r0[1]) * sc;
                        o0[2] = (v0[2] * r0[2] - v0[3] * r0[3]) * sc; o0[3] = (v0[3] * r0[2] + v0[2] * r0[3]) * sc;
                        o1[0] = (v1[0] * r1[0] - v1[1] * r1[1]) * sc; o1[1] = (v1[1] * r1[0] + v1[0] * r1[1]) * sc;
                        o1[2] = (v1[2] * r1[2] - v1[3] * r1[3]) * sc; o1[3] = (v1[3] * r1[2] + v1[2] * r1[3]) * sc;
                        v0 = o0; v1 = o1;
                    } else if (kind == 3) {
#pragma unroll
                        for (int j = 0; j < 4; ++j) { v0[j] = v0[j] * fsigmoid(v0[j]); v1[j] = v1[j] * fsigmoid(v1[j]); }
                    }
                    v4u w; w.x = cvt_pk_bf16(v0[0], v0[1]); w.y = cvt_pk_bf16(v0[2], v0[3]); w.z = cvt_pk_bf16(v1[0], v1[1]); w.w = cvt_pk_bf16(v1[2], v1[3]);
                    *(GAS v4u*)(rowp + bj * HALF) = w; } }
    }
};
struct EpiRes {
    static constexpr bool PERM = true, HAS_PRE = false; static constexpr int PRE_BYTES = 0;
    unsigned char* ws0; int ssoff; float ds;
    __device__ __forceinline__ void operator()(const f32x4 (&acc)[2][2][4][2], const Unit& u, int wr, int wc, int fr, int fq) const {
        OPAQUE_LANE(fr, fq);
        GAS unsigned char* ws = launder(ws0);
        GAS bf16* Y = (GAS bf16*)(ws + WS_Y); const GAS bf16* X = (const GAS bf16*)(ws + WS_XB);
        const int row0 = u.rowbase + wr * 64 + fr, col0 = u.pn * BM + wc * 32 + 8 * fq;
#pragma unroll
        for (int ai = 0; ai < 2; ++ai)
#pragma unroll
            for (int m = 0; m < 4; ++m) { const size_t off = (size_t)(row0 + ai * HALF + m * 16) * DM + col0;
                float rsc = 1.0f;
                if (ssoff >= 0) { const GAS float* sp = (const GAS float*)(ws + WS_SSP) + row0 + ai * HALF + m * 16; float ssum = 0.f;
#pragma unroll
                    for (int hh = 0; hh < HG_HEADS * 2; ++hh) ssum += sp[(size_t)hh * NTOK];
                    rsc = 1.0f / sqrtf(ssum * (1.0f / DM) + RMS_EPS); }
#pragma unroll
                for (int bj = 0; bj < 2; ++bj) { const v4u xs = *(const GAS v4u*)(X + off + bj * HALF); const f32x4 a0 = acc[ai][bj][m][0] * (rsc * ds), a1 = acc[ai][bj][m][1] * (rsc * ds);
                    v4u w; w.x = cvt_pk_bf16(bflo(xs.x) * DN_ALPHA + a0[0], bfhi(xs.x) * DN_ALPHA + a0[1]); w.y = cvt_pk_bf16(bflo(xs.y) * DN_ALPHA + a0[2], bfhi(xs.y) * DN_ALPHA + a0[3]);
                    w.z = cvt_pk_bf16(bflo(xs.z) * DN_ALPHA + a1[0], bfhi(xs.z) * DN_ALPHA + a1[1]); w.w = cvt_pk_bf16(bflo(xs.w) * DN_ALPHA + a1[2], bfhi(xs.w) * DN_ALPHA + a1[3]);
                    *(GAS v4u*)(Y + off + bj * HALF) = w; } }
    }
};
struct EpiMoeGU {
    static constexpr bool PERM = true, HAS_PRE = true; static constexpr int PRE_BYTES = 1024;
    unsigned char* ws0; int L;
    __device__ __forceinline__ void pre(const Unit& u, LAS unsigned char* buf, int wid, int lane) const {
        if (wid == 0) glds16((const char*)(ws0 + WS_BGU) + ((size_t)L * NE * 2048 + ((size_t)u.e * 8 + u.pn) * 256) * 4, (unsigned)lane * 16u, buf);
    }
    __device__ __forceinline__ void operator()(const f32x4 (&acc)[2][2][4][2], const Unit& u, int wr, int wc, int fr, int fq, const LAS unsigned char* buf) const {
        OPAQUE_LANE(fr, fq);
        GAS unsigned char* ws = launder(ws0);
        const int row0 = u.rowbase + wr * 64 + fr; const int c8 = wc * 32 + 8 * fq;
        const LAS float* bp = (const LAS float*)buf + c8;
        const f32x4 bg0 = *(const LAS f32x4*)bp, bg1 = *(const LAS f32x4*)(bp + 4);
        const f32x4 bl0 = (*(const LAS f32x4*)(bp + HALF) + 1.0f) * ACT_SCALE, bl1 = (*(const LAS f32x4*)(bp + HALF + 4) + 1.0f) * ACT_SCALE;
#pragma unroll
        for (int ai = 0; ai < 2; ++ai)
#pragma unroll
            for (int m = 0; m < 4; ++m) { const size_t eo = (size_t)(row0 + ai * HALF + m * 16) * DM + u.pn * HALF + c8;
                float a[8];
#pragma unroll
                for (int j = 0; j < 8; ++j) {
                    const float g = fminf(fmaf(acc[ai][0][m][j >> 2][j & 3], GU_DESCALE, j < 4 ? bg0[j & 3] : bg1[j & 3]), 7.0f);
                    const float l1 = __builtin_amdgcn_fmed3f(fmaf(acc[ai][1][m][j >> 2][j & 3], GU_DESCALE * ACT_SCALE, j < 4 ? bl0[j & 3] : bl1[j & 3]), -6.0f * ACT_SCALE, 8.0f * ACT_SCALE);
                    a[j] = g * frcp(1.0f + __builtin_amdgcn_exp2f(g * -2.4554669595930156f)) * l1;
                }
#if MOE_FP8
                v2u w;
                { int p = __builtin_amdgcn_cvt_pk_fp8_f32(a[0], a[1], 0, false); p = __builtin_amdgcn_cvt_pk_fp8_f32(a[2], a[3], p, true); w.x = (unsigned)p; }
                { int p = __builtin_amdgcn_cvt_pk_fp8_f32(a[4], a[5], 0, false); p = __builtin_amdgcn_cvt_pk_fp8_f32(a[6], a[7], p, true); w.y = (unsigned)p; }
                *(GAS v2u*)(ws + WS_ACT + eo) = w;
#else
                v4u w; w.x = cvt_pk_bf16(a[0], a[1]); w.y = cvt_pk_bf16(a[2], a[3]); w.z = cvt_pk_bf16(a[4], a[5]); w.w = cvt_pk_bf16(a[6], a[7]);
                *(GAS v4u*)((GAS bf16*)(ws + WS_ACT) + eo) = w;
#endif
            }
    }
};
struct EpiMoeDown {
    static constexpr bool PERM = true, HAS_PRE = true; static constexpr int PRE_BYTES = 3072;
    unsigned char* ws0; const float* bias;
    __device__ __forceinline__ void pre(const Unit& u, LAS unsigned char* buf, int wid, int lane) const {
        if (wid == 0) glds16((const char*)(bias + (size_t)u.e * DM + u.pn * BM), (unsigned)lane * 16u, buf);
        if (wid == 1) glds16((const char*)(ws0 + WS_ROWDST) + (size_t)u.gidx * 4, (unsigned)lane * 16u, buf + 1024);
        if (wid == 2) glds16((const char*)(ws0 + WS_ROWGATE) + (size_t)u.gidx * 4, (unsigned)lane * 16u, buf + 2048);
    }
    __device__ __forceinline__ void operator()(const f32x4 (&acc)[2][2][4][2], const Unit& u, int wr, int wc, int fr, int fq, const LAS unsigned char* buf) const {
        OPAQUE_LANE(fr, fq);
        GAS unsigned char* ws = launder(ws0);
        GAS bf16* YS = (GAS bf16*)(ws + WS_YSLOT);
        const int c8 = u.pn * BM + wc * 32 + 8 * fq;
        const LAS float* bp = (const LAS float*)buf + wc * 32 + 8 * fq;
        f32x4 bv[2][2];
#pragma unroll
        for (int bj = 0; bj < 2; ++bj) { bv[bj][0] = *(const LAS f32x4*)(bp + bj * HALF); bv[bj][1] = *(const LAS f32x4*)(bp + bj * HALF + 4); }
#pragma unroll
        for (int ai = 0; ai < 2; ++ai)
#pragma unroll
            for (int m = 0; m < 4; ++m) { const int r = ai * HALF + wr * 64 + m * 16 + fr;
                if (r < u.cnt) {
                    const int dst = ((const LAS int*)(buf + 1024))[r]; const float gt = ((const LAS float*)(buf + 2048))[r];
#if YS_FP8
                    GAS unsigned char* rowp = (GAS unsigned char*)YS + (size_t)dst * DM + c8;
#pragma unroll
                    for (int bj = 0; bj < 2; ++bj) { const f32x4 v0 = (acc[ai][bj][m][0] * DN_DESCALE + bv[bj][0]) * (gt * 64.0f), v1 = (acc[ai][bj][m][1] * DN_DESCALE + bv[bj][1]) * (gt * 64.0f);
                        v2u w; w.x = pk4_fp8(v0[0], v0[1], v0[2], v0[3]); w.y = pk4_fp8(v1[0], v1[1], v1[2], v1[3]);
                        *(GAS v2u*)(rowp + bj * HALF) = w; } } }
#else
                    GAS bf16* rowp = YS + (size_t)dst * DM + c8;
#pragma unroll
                    for (int bj = 0; bj < 2; ++bj) { const f32x4 v0 = (acc[ai][bj][m][0] * DN_DESCALE + bv[bj][0]) * gt, v1 = (acc[ai][bj][m][1] * DN_DESCALE + bv[bj][1]) * gt;
                        v4u w; w.x = cvt_pk_bf16(v0[0], v0[1]); w.y = cvt_pk_bf16(v0[2], v0[3]); w.z = cvt_pk_bf16(v1[0], v1[1]); w.w = cvt_pk_bf16(v1[2], v1[3]);
                        *(GAS v4u*)(rowp + bj * HALF) = w; } } }
#endif
    }
};
}

typedef short s16x4 __attribute__((ext_vector_type(4)));
typedef __bf16 bf16x2_t __attribute__((ext_vector_type(2)));
__device__ __forceinline__ unsigned cvtpk(float lo, float hi) { f32x2 v = {lo, hi}; bf16x2_t b = __builtin_convertvector(v, bf16x2_t); return __builtin_bit_cast(unsigned, b); }
__device__ __forceinline__ s16x4 tr_read(const LAS unsigned char* p) { return __builtin_bit_cast(s16x4, __builtin_amdgcn_ds_read_tr16_b64_v4i16((LAS s16x4*)p)); }
__device__ __forceinline__ bf16x8 cat8(s16x4 lo, s16x4 hi) { return __builtin_shufflevector(lo, hi, 0, 1, 2, 3, 4, 5, 6, 7); }
__device__ __forceinline__ bf16x8 pack8(const f32x4& a, const f32x4& b) { v4u p; p.x = cvtpk(a[0], a[1]); p.y = cvtpk(a[2], a[3]); p.z = cvtpk(b[0], b[1]); p.w = cvtpk(b[2], b[3]); return __builtin_bit_cast(bf16x8, p); }
__device__ __forceinline__ s16x4 pack4(const f32x4& a) { v2u p; p.x = cvtpk(a[0], a[1]); p.y = cvtpk(a[2], a[3]); return __builtin_bit_cast(s16x4, p); }
#define LDS_BARRIER() do { asm volatile("s_waitcnt lgkmcnt(0)" ::: "memory"); __builtin_amdgcn_s_barrier(); asm volatile("" ::: "memory"); } while (0)
#define MFMA32(a, b, c) __builtin_amdgcn_mfma_f32_16x16x32_bf16((a), (b), (c), 0, 0, 0)
#define MFMA16(a, b, c) __builtin_amdgcn_mfma_f32_16x16x16bf16_1k((a), (b), (c), 0, 0, 0)

__device__ __forceinline__ void ret_fast(const int tid, LAS unsigned char* lds, const bf16* HB, bf16* OB) {
    constexpr int QP = 528, VP = 272, PP = 144;
    constexpr int OFF_Q = 0, OFF_K = 64 * QP, OFF_V = 2 * 64 * QP, OFF_P = OFF_V + 64 * VP;
    const int lane0 = tid & 63, w = __builtin_amdgcn_readfirstlane(tid >> 6);
    const int prow = tid >> 3, pc = tid & 7;
    for (int un0 = blockIdx.x; un0 < NBATCH * RT_HEADS * 4; un0 += gridDim.x) {
        const int un = (gridDim.x == 256) ? ((un0 & 7) * 32 + (un0 >> 3)) : un0;
        const int b = un >> 4, h = (un >> 2) & 3, vs = un & 3;
        const float l2g = __builtin_amdgcn_logf(1.0f - __builtin_amdgcn_exp2f(-5.0f - (float)h));
        const float dC = __builtin_amdgcn_exp2f(64.0f * l2g);
        f32x4 st[16];
#pragma unroll
        for (int i = 0; i < 16; ++i) st[i] = (f32x4){0.f, 0.f, 0.f, 0.f};
        const bf16* gbase = HB + (size_t)(b * SEQ + prow) * RT_IN;
        v4u pq[4], pk[4], pv[2];
#pragma unroll
        for (int j = 0; j < 4; ++j) { pq[j] = *(const v4u*)(gbase + h * 256 + (pc + 8 * j) * 8); pk[j] = *(const v4u*)(gbase + 1024 + h * 256 + (pc + 8 * j) * 8); }
#pragma unroll
        for (int j = 0; j < 2; ++j) pv[j] = *(const v4u*)(gbase + 2048 + h * 512 + vs * 128 + (pc + 8 * j) * 8);
#pragma unroll 1
        for (int ch = 0; ch < SEQ / 64; ++ch) {
            int lane = lane0; asm volatile("" : "+v"(lane));
            const int r = lane & 15, g = lane >> 4, q4 = (lane & 15) >> 2, p4 = lane & 3;
            LDS_BARRIER();
#pragma unroll
            for (int j = 0; j < 4; ++j) { *(LAS v4u*)(lds + OFF_Q + prow * QP + (pc + 8 * j) * 16) = pq[j]; *(LAS v4u*)(lds + OFF_K + prow * QP + (pc + 8 * j) * 16) = pk[j]; }
#pragma unroll
            for (int j = 0; j < 2; ++j) *(LAS v4u*)(lds + OFF_V + prow * VP + (pc + 8 * j) * 16) = pv[j];
            if (ch + 1 < SEQ / 64) {
                const bf16* gn = gbase + (size_t)(ch + 1) * 64 * RT_IN;
#pragma unroll
                for (int j = 0; j < 4; ++j) { pq[j] = *(const v4u*)(gn + h * 256 + (pc + 8 * j) * 8); pk[j] = *(const v4u*)(gn + 1024 + h * 256 + (pc + 8 * j) * 8); }
#pragma unroll
                for (int j = 0; j < 2; ++j) pv[j] = *(const v4u*)(gn + 2048 + h * 512 + vs * 128 + (pc + 8 * j) * 8);
            }
            LDS_BARRIER();
            {
                const int ct = w >> 1, st0 = 2 * (w & 1);
                f32x4 sa0 = {0.f, 0.f, 0.f, 0.f}, sa1 = {0.f, 0.f, 0.f, 0.f};
                const LAS unsigned char* qb = lds + OFF_Q + (16 * ct + r) * QP + g * 16;
                const LAS unsigned char* kb0 = lds + OFF_K + (16 * st0 + r) * QP + g * 16;
#pragma unroll
                for (int hb = 0; hb < 4; ++hb) {
                    bf16x8 qf[2], k0[2], k1[2];
#pragma unroll
                    for (int kk = 0; kk < 2; ++kk) { const int kb = hb * 2 + kk; qf[kk] = *(const LAS bf16x8*)(qb + kb * 64); k0[kk] = *(const LAS bf16x8*)(kb0 + kb * 64); k1[kk] = *(const LAS bf16x8*)(kb0 + 16 * QP + kb * 64); }
                    asm volatile("" : "+v"(qf[0]), "+v"(qf[1]), "+v"(k0[0]), "+v"(k0[1]), "+v"(k1[0]), "+v"(k1[1]) :: "memory");
#pragma unroll
                    for (int kk = 0; kk < 2; ++kk) { sa0 = MFMA32(k0[kk], qf[kk], sa0); sa1 = MFMA32(k1[kk], qf[kk], sa1); }
                }
                const int c = 16 * ct + r;
#pragma unroll
                for (int t = 0; t < 2; ++t) {
                    const f32x4 sa = t ? sa1 : sa0; const int s0 = 16 * (st0 + t) + 4 * g; float v[4];
#pragma unroll
                    for (int i = 0; i < 4; ++i) { const int d = c - (s0 + i); v[i] = d >= 0 ? sa[i] * __builtin_amdgcn_exp2f((float)d * l2g) : 0.f; }
                    v2u pw; pw.x = cvtpk(v[0], v[1]); pw.y = cvtpk(v[2], v[3]);
                    *(LAS v2u*)(lds + OFF_P + c * PP + s0 * 2) = pw;
                }
            }
            LDS_BARRIER();
            f32x4 o[4];
#pragma unroll
            for (int ct = 0; ct < 4; ++ct) o[ct] = (f32x4){0.f, 0.f, 0.f, 0.f};
            {
                s16x4 ql[2][4], qh[2][4];
                const LAS unsigned char* qp0 = lds + OFF_Q + r * QP + (4 * g) * 2;
#pragma unroll
                for (int ct = 0; ct < 4; ++ct) { ql[0][ct] = *(const LAS s16x4*)(qp0 + ct * 16 * QP); qh[0][ct] = *(const LAS s16x4*)(qp0 + ct * 16 * QP + 32); }
#pragma unroll
                for (int kb = 0; kb < 8; ++kb) {
                    const int cu = kb & 1, nx = cu ^ 1;
                    if (kb + 1 < 8) {
#pragma unroll
                        for (int ct = 0; ct < 4; ++ct) { ql[nx][ct] = *(const LAS s16x4*)(qp0 + ct * 16 * QP + (kb + 1) * 64); qh[nx][ct] = *(const LAS s16x4*)(qp0 + ct * 16 * QP + (kb + 1) * 64 + 32); }
                    }
                    asm volatile("" : "+v"(ql[cu][0]), "+v"(ql[cu][1]), "+v"(ql[cu][2]), "+v"(ql[cu][3]), "+v"(qh[cu][0]), "+v"(qh[cu][1]), "+v"(qh[cu][2]), "+v"(qh[cu][3]) :: "memory");
                    const bf16x8 sa = pack8(st[2 * kb], st[2 * kb + 1]);
#pragma unroll
                    for (int ct = 0; ct < 4; ++ct) o[ct] = MFMA32(sa, cat8(ql[cu][ct], qh[cu][ct]), o[ct]);
                }
            }
            bf16x8 vf[2], pf[6];
            {
                s16x4 t0[2], t1[2];
#pragma unroll
                for (int sb = 0; sb < 2; ++sb) { const LAS unsigned char* vp = lds + OFF_V + (32 * sb + 8 * g + q4) * VP + (16 * w + 4 * p4) * 2; t0[sb] = tr_read(vp); t1[sb] = tr_read(vp + 4 * VP); }
                pf[0] = *(const LAS bf16x8*)(lds + OFF_P + (0 + r) * PP + (8 * g) * 2);
                pf[1] = *(const LAS bf16x8*)(lds + OFF_P + (16 + r) * PP + (8 * g) * 2);
                pf[2] = *(const LAS bf16x8*)(lds + OFF_P + (32 + r) * PP + (8 * g) * 2);
                pf[3] = *(const LAS bf16x8*)(lds + OFF_P + (32 + r) * PP + (32 + 8 * g) * 2);
                pf[4] = *(const LAS bf16x8*)(lds + OFF_P + (48 + r) * PP + (8 * g) * 2);
                pf[5] = *(const LAS bf16x8*)(lds + OFF_P + (48 + r) * PP + (32 + 8 * g) * 2);
                asm volatile("" : "+v"(t0[0]), "+v"(t0[1]), "+v"(t1[0]), "+v"(t1[1]), "+v"(pf[0]), "+v"(pf[1]), "+v"(pf[2]), "+v"(pf[3]), "+v"(pf[4]), "+v"(pf[5]) :: "memory");
                vf[0] = cat8(t0[0], t1[0]); vf[1] = cat8(t0[1], t1[1]);
            }
#pragma unroll
            for (int ct = 0; ct < 4; ++ct) o[ct] = o[ct] * __builtin_amdgcn_exp2f((float)(16 * ct + r + 1) * l2g);
            o[0] = MFMA32(vf[0], pf[0], o[0]); o[1] = MFMA32(vf[0], pf[1], o[1]);
            o[2] = MFMA32(vf[0], pf[2], o[2]); o[2] = MFMA32(vf[1], pf[3], o[2]);
            o[3] = MFMA32(vf[0], pf[4], o[3]); o[3] = MFMA32(vf[1], pf[5], o[3]);
            {
                bf16* ob = OB + (size_t)(b * SEQ + ch * 64 + r) * RT_VD + h * 512 + vs * 128 + 16 * w + 4 * g;
#pragma unroll
                for (int ct = 0; ct < 4; ++ct) { v2u ow; ow.x = cvtpk(o[ct][0], o[ct][1]); ow.y = cvtpk(o[ct][2], o[ct][3]); *(v2u*)(ob + (size_t)ct * 16 * RT_VD) = ow; }
            }
            bf16x8 vz[2];
#pragma unroll
            for (int sb = 0; sb < 2; ++sb) {
                const v4u raw = __builtin_bit_cast(v4u, vf[sb]); float f[8] = {bflo(raw.x), bfhi(raw.x), bflo(raw.y), bfhi(raw.y), bflo(raw.z), bfhi(raw.z), bflo(raw.w), bfhi(raw.w)};
#pragma unroll
                for (int j = 0; j < 8; ++j) f[j] *= __builtin_amdgcn_exp2f((float)(63 - (32 * sb + 8 * g + j)) * l2g);
                v4u z; z.x = cvtpk(f[0], f[1]); z.y = cvtpk(f[2], f[3]); z.z = cvtpk(f[4], f[5]); z.w = cvtpk(f[6], f[7]); vz[sb] = __builtin_bit_cast(bf16x8, z);
            }
            {
                const LAS unsigned char* kp0 = lds + OFF_K + (8 * g + q4) * QP + (4 * p4) * 2;
#pragma unroll
                for (int kq = 0; kq < 4; ++kq) {
                    s16x4 ka[4][2], kbh[4][2];
#pragma unroll
                    for (int j = 0; j < 4; ++j)
#pragma unroll
                        for (int sb = 0; sb < 2; ++sb) { const LAS unsigned char* kp = kp0 + (32 * sb) * QP + (16 * (kq * 4 + j)) * 2; ka[j][sb] = tr_read(kp); kbh[j][sb] = tr_read(kp + 4 * QP); }
                    asm volatile("" : "+v"(ka[0][0]), "+v"(ka[0][1]), "+v"(ka[1][0]), "+v"(ka[1][1]), "+v"(ka[2][0]), "+v"(ka[2][1]), "+v"(ka[3][0]), "+v"(ka[3][1]),
                                      "+v"(kbh[0][0]), "+v"(kbh[0][1]), "+v"(kbh[1][0]), "+v"(kbh[1][1]), "+v"(kbh[2][0]), "+v"(kbh[2][1]), "+v"(kbh[3][0]), "+v"(kbh[3][1]) :: "memory");
#pragma unroll
                    for (int j = 0; j < 4; ++j) { const int kt = kq * 4 + j;
                        st[kt] = st[kt] * dC;
                        st[kt] = MFMA32(cat8(ka[j][0], kbh[j][0]), vz[0], st[kt]);
                        st[kt] = MFMA32(cat8(ka[j][1], kbh[j][1]), vz[1], st[kt]); }
                }
            }
        }
        LDS_BARRIER();
    }
}

__device__ __forceinline__ void hgrn_fast(const int tid, LAS unsigned char* lds, const bf16* QD, const bf16* KI, const bf16* GG, const bf16* VV, const float* DEC, const float* ng, bf16* A2, float* SS) {
    constexpr int TP = 272;
    constexpr int TPH = 144;
    constexpr int OFF_QD = 0, OFF_KI = 64 * TP, OFF_G = 2 * 64 * TP, OFF_V = OFF_G + 64 * TPH, OFF_DEC = OFF_V + 64 * TPH, OFF_SS = OFF_DEC + 2048;
    const int lane = tid & 63, w = __builtin_amdgcn_readfirstlane(tid >> 6), r = lane & 15, g = lane >> 4, q4 = (lane & 15) >> 2, p4 = lane & 3;
    const int prow = tid >> 3, pc = tid & 7;
    for (int un0 = blockIdx.x; un0 < NBATCH * HG_HEADS * 2; un0 += gridDim.x) {
        const int un = (gridDim.x == 256) ? ((((un0 & 7) * 16 + (un0 >> 4)) << 1) | ((un0 >> 3) & 1)) : un0;
        const int b = un >> 4, h = (un >> 1) & 7, vh = un & 1, wv = vh * 4 + (w & 3);
        f32x4 st[8];
#pragma unroll
        for (int i = 0; i < 8; ++i) st[i] = (f32x4){0.f, 0.f, 0.f, 0.f};
        const f32x4 ng4 = *(const f32x4*)(ng + h * 128 + 16 * wv + 4 * g);
        const size_t goff = (size_t)(b * SEQ + prow) * DM + h * 128;
        v4u p0[2], p1[2], p2, p3; f32x4 pd = {0.f, 0.f, 0.f, 0.f};
#pragma unroll
        for (int j = 0; j < 2; ++j) { const size_t o = goff + (pc + 8 * j) * 8; p0[j] = *(const v4u*)(QD + o); p1[j] = *(const v4u*)(KI + o); }
        p2 = *(const v4u*)(GG + goff + vh * 64 + pc * 8); p3 = *(const v4u*)(VV + goff + vh * 64 + pc * 8);
        if (tid < 128) pd = *(const f32x4*)(DEC + (size_t)((b * SEQ) / 16 + (tid >> 5)) * DM + h * 128 + (tid & 31) * 4);
#pragma unroll 1
        for (int rd = 0; rd < SEQ / 64; ++rd) {
            LDS_BARRIER();
            if (rd > 0 && tid < 64) {
                float s = 0.f;
#pragma unroll
                for (int ww = 0; ww < 4; ++ww) s += *(const LAS float*)(lds + OFF_SS + (ww * 64 + tid) * 4);
                SS[(size_t)(h * 2 + vh) * NTOK + (size_t)b * SEQ + (rd - 1) * 64 + tid] = s;
            }
#pragma unroll
            for (int j = 0; j < 2; ++j) { const int lo = prow * TP + (pc + 8 * j) * 16; *(LAS v4u*)(lds + OFF_QD + lo) = p0[j]; *(LAS v4u*)(lds + OFF_KI + lo) = p1[j]; }
            *(LAS v4u*)(lds + OFF_G + prow * TPH + pc * 16) = p2; *(LAS v4u*)(lds + OFF_V + prow * TPH + pc * 16) = p3;
            if (tid < 128) *(LAS f32x4*)(lds + OFF_DEC + tid * 16) = pd;
            if (rd + 1 < SEQ / 64) {
                const size_t gn = goff + (size_t)(rd + 1) * 64 * DM;
#pragma unroll
                for (int j = 0; j < 2; ++j) { const size_t o = gn + (pc + 8 * j) * 8; p0[j] = *(const v4u*)(QD + o); p1[j] = *(const v4u*)(KI + o); }
                p2 = *(const v4u*)(GG + gn + vh * 64 + pc * 8); p3 = *(const v4u*)(VV + gn + vh * 64 + pc * 8);
                if (tid < 128) pd = *(const f32x4*)(DEC + (size_t)((b * SEQ + (rd + 1) * 64) / 16 + (tid >> 5)) * DM + h * 128 + (tid & 31) * 4);
            }
            LDS_BARRIER();
            if (w < 4)
#pragma unroll 1
            for (int cc = 0; cc < 4; ++cc) {
                s16x4 ql[4], qh[4], kl[4], kh[4], ktr[8]; f32x4 d4[8];
#pragma unroll
                for (int kb = 0; kb < 4; ++kb) {
                    const int off = (16 * cc + r) * TP + (32 * kb + 4 * g) * 2;
                    ql[kb] = *(const LAS s16x4*)(lds + OFF_QD + off); qh[kb] = *(const LAS s16x4*)(lds + OFF_QD + off + 32);
                    kl[kb] = *(const LAS s16x4*)(lds + OFF_KI + off); kh[kb] = *(const LAS s16x4*)(lds + OFF_KI + off + 32);
                }
                s16x4 vfr = tr_read(lds + OFF_V + (16 * cc + 4 * g + q4) * TPH + (16 * (w & 3) + 4 * p4) * 2);
                s16x4 gfr = *(const LAS s16x4*)(lds + OFF_G + (16 * cc + r) * TPH + (16 * (w & 3) + 4 * g) * 2);
#pragma unroll
                for (int kt = 0; kt < 8; ++kt) {
                    d4[kt] = *(const LAS f32x4*)(lds + OFF_DEC + cc * 512 + (16 * kt + 4 * g) * 4);
                    ktr[kt] = tr_read(lds + OFF_KI + (16 * cc + 4 * g + q4) * TP + (16 * kt + 4 * p4) * 2);
                }
                asm volatile("" : "+v"(ql[0]), "+v"(ql[1]), "+v"(ql[2]), "+v"(ql[3]), "+v"(qh[0]), "+v"(qh[1]), "+v"(qh[2]), "+v"(qh[3]),
                                  "+v"(kl[0]), "+v"(kl[1]), "+v"(kl[2]), "+v"(kl[3]), "+v"(kh[0]), "+v"(kh[1]), "+v"(kh[2]), "+v"(kh[3]), "+v"(vfr), "+v"(gfr));
                asm volatile("" : "+v"(ktr[0]), "+v"(ktr[1]), "+v"(ktr[2]), "+v"(ktr[3]), "+v"(ktr[4]), "+v"(ktr[5]), "+v"(ktr[6]), "+v"(ktr[7]),
                                  "+v"(d4[0]), "+v"(d4[1]), "+v"(d4[2]), "+v"(d4[3]), "+v"(d4[4]), "+v"(d4[5]), "+v"(d4[6]), "+v"(d4[7]));
                bf16x8 qf[4];
#pragma unroll
                for (int kb = 0; kb < 4; ++kb) qf[kb] = cat8(ql[kb], qh[kb]);
                f32x4 sc = {0.f, 0.f, 0.f, 0.f}, oa = {0.f, 0.f, 0.f, 0.f};
#pragma unroll
                for (int kb = 0; kb < 4; ++kb) sc = MFMA32(cat8(kl[kb], kh[kb]), qf[kb], sc);
#pragma unroll
                for (int kb = 0; kb < 4; ++kb) oa = MFMA32(pack8(st[2 * kb], st[2 * kb + 1]), qf[kb], oa);
#pragma unroll
                for (int kt = 0; kt < 8; ++kt) st[kt] = MFMA16(ktr[kt], vfr, st[kt]) * d4[kt];
#pragma unroll
                for (int i = 0; i < 4; ++i) sc[i] = (4 * g + i <= r) ? sc[i] : 0.f;
                oa = MFMA16(vfr, pack4(sc), oa);
                { const v2u gr = __builtin_bit_cast(v2u, gfr);
                  v2u ow; ow.x = cvtpk(oa[0] * ng4[0] * bflo(gr.x), oa[1] * ng4[1] * bfhi(gr.x)); ow.y = cvtpk(oa[2] * ng4[2] * bflo(gr.y), oa[3] * ng4[3] * bfhi(gr.y));
                  *(v2u*)(A2 + (size_t)(b * SEQ + rd * 64 + cc * 16 + r) * DM + h * 128 + 16 * wv + 4 * g) = ow;
                  float p = (oa[0] * oa[0] + oa[1] * oa[1]) + (oa[2] * oa[2] + oa[3] * oa[3]);
                  p += __shfl_xor(p, 16); p += __shfl_xor(p, 32);
                  if (lane < 16) *(LAS float*)(lds + OFF_SS + (w * 64 + cc * 16 + r) * 4) = p; }
            }
        }
        LDS_BARRIER();
        if (tid < 64) { float s = 0.f;
#pragma unroll
            for (int ww = 0; ww < 4; ++ww) s += *(const LAS float*)(lds + OFF_SS + (ww * 64 + tid) * 4);
            SS[(size_t)(h * 2 + vh) * NTOK + (size_t)b * SEQ + (SEQ / 64 - 1) * 64 + tid] = s; }
        LDS_BARRIER();
    }
}

struct Args { const float* in[17]; float* out; unsigned char* ws; int ph_lo, ph_hi; };
enum { I_X = 0, I_HWIN, I_HNG, I_HWOUT, I_LB, I_RWIN, I_RWOUT, I_LNMG, I_LNMB, I_LNFG, I_LNFB, I_RW, I_RB, I_WGU, I_BGU, I_WDN, I_BDN };

__device__ __forceinline__ int dest_row(int mode, int n) {
    if (mode == 1) { if (n < 1024) return ((n >> 7) << 8) + (n & 127); if (n < 2048) { const int q = n - 1024; return ((q >> 7) << 8) + 128 + (q & 127); } return n; }
    if (mode == 2) { const int j2 = n >> 1; return ((j2 >> 7) << 8) + ((n & 1) << 7) + (j2 & 127); }
    return n;
}
__device__ __forceinline__ void transpose_item(const float* W, int K, int N, bf16* WT, int mode, LAS float* scr, int item, int lane) {
    const int nblk = N / 64, kb = item / nblk, nb = item % nblk, k0 = 64 * kb, n0 = 64 * nb;
#pragma unroll 4
    for (int i = 0; i < 16; ++i) { const int kk = 4 * i + (lane >> 4), c4 = (lane & 15) * 4;
        const f32x4 v = *(const GAS f32x4*)(W + (size_t)(k0 + kk) * N + n0 + c4);
        LAS float* s = scr + kk * 65 + c4; s[0] = v[0]; s[1] = v[1]; s[2] = v[2]; s[3] = v[3]; }
    LDS_WAIT(); asm volatile("" ::: "memory");
    const int c = lane & 7;
#pragma unroll 2
    for (int j = 0; j < 8; ++j) { const int n = (lane >> 3) + 8 * j; const LAS float* s = scr + (8 * c) * 65 + n;
        v4u o; o.x = pk2(s[0 * 65], s[1 * 65]); o.y = pk2(s[2 * 65], s[3 * 65]); o.z = pk2(s[4 * 65], s[5 * 65]); o.w = pk2(s[6 * 65], s[7 * 65]);
        *(GAS v4u*)(WT + (size_t)dest_row(mode, n0 + n) * K + k0 + 8 * c) = o; }
    LDS_WAIT(); asm volatile("" ::: "memory");
}

__device__ __forceinline__ void transpose_item_fp8(const float* W, int K, int N, unsigned char* WT, int mode, float scale, LAS float* scr, int item, int lane) {
    const int nblk = N / 64, kb = item / nblk, nb = item % nblk, k0 = 64 * kb, n0 = 64 * nb;
#pragma unroll 4
    for (int i = 0; i < 16; ++i) { const int kk = 4 * i + (lane >> 4), c4 = (lane & 15) * 4;
        const f32x4 v = *(const GAS f32x4*)(W + (size_t)(k0 + kk) * N + n0 + c4);
        LAS float* s = scr + kk * 65 + c4; s[0] = v[0]; s[1] = v[1]; s[2] = v[2]; s[3] = v[3]; }
    LDS_WAIT(); asm volatile("" ::: "memory");
    const int c = lane & 7;
#pragma unroll 2
    for (int j = 0; j < 8; ++j) { const int n = (lane >> 3) + 8 * j; const LAS float* s = scr + (8 * c) * 65 + n;
        v2u o; o.x = pk4_fp8(s[0 * 65] * scale, s[1 * 65] * scale, s[2 * 65] * scale, s[3 * 65] * scale); o.y = pk4_fp8(s[4 * 65] * scale, s[5 * 65] * scale, s[6 * 65] * scale, s[7 * 65] * scale);
        *(GAS v2u*)(WT + (size_t)dest_row(mode, n0 + n) * K + k0 + 8 * c) = o; }
    LDS_WAIT(); asm volatile("" ::: "memory");
}

#ifndef SITE_MASK
#define SITE_MASK 0xffff
#endif
#define SITE(n) (((SITE_MASK) >> (n)) & 1)
#ifndef PROBE_MASK
#define PROBE_MASK 0
#endif
#define REP(n) (1 + (((PROBE_MASK) >> (n)) & 1))
typedef const __attribute__((address_space(4))) Args* KArgs;
__device__ __forceinline__ int otid(int wave0) { int l; asm volatile("v_mbcnt_lo_u32_b32 %0, -1, 0\n\tv_mbcnt_hi_u32_b32 %0, -1, %0" : "=v"(l)); asm volatile("" : "+s"(wave0)); return wave0 * 64 + l; }
__device__ __forceinline__ LAS unsigned char* olds(LAS unsigned char* p) { asm volatile("" : "+s"(p)); return p; }
__device__ __forceinline__ KArgs kargs() { KArgs p = (KArgs)__builtin_amdgcn_kernarg_segment_ptr(); asm volatile("" : "+s"(p)); return p; }
#define IN(k) (ap->ph_lo <= (k) && (k) < ap->ph_hi)
#ifndef PROBE_BAR
#define PROBE_BAR 1
#endif
#define GRID_BAR() for (int _r = 0; _r < PROBE_BAR; ++_r) do { if (ap->ph_hi - ap->ph_lo > 1) { XcdBarrier _b; _b.bar = (unsigned*)(ap->ws + WS_CTL) + CW_BAR; _b.x = xb_xcc_id(); _b.st = (volatile LAS unsigned*)(lds + MISC_OFF + MO_BARW); xcd_barrier(_b); } } while (0)
#define VCU() ((gridDim.x % 8 == 0) ? (int)((blockIdx.x % 8) * (gridDim.x / 8) + blockIdx.x / 8) : (int)blockIdx.x)

__global__ void __launch_bounds__(512, 2) mk_fwd(Args args_unused) {
    extern __shared__ __attribute__((aligned(16))) unsigned char lds_raw[];
    LAS unsigned char* const lds0 = (LAS unsigned char*)lds_raw;
    const int wave0 = __builtin_amdgcn_readfirstlane((int)(threadIdx.x >> 6));
    {
        LAS unsigned char* lds = lds0;
        for (int u = threadIdx.x; u < (LDS_BYTES - MISC_OFF) / 4; u += 512) ((LAS unsigned*)(lds + MISC_OFF))[u] = 0u;
        __syncthreads();
        KArgs ap = kargs();
        if (ap->ph_hi - ap->ph_lo > 1) (void)xcd_barrier_post((unsigned*)(ap->ws + WS_CTL) + CW_BAR, (volatile LAS unsigned*)(lds + MISC_OFF + MO_BARW));
    }

#if SITE(0)
    { KArgs ap = kargs(); const int tid = otid(wave0); LAS unsigned char* lds = olds(lds0); (void)tid;
    if (IN(0)) for (int rep_ = 0; rep_ < REP(0); ++rep_) {
        const int lane = tid & 63, wave = __builtin_amdgcn_readfirstlane(tid >> 6), G = gridDim.x, vcu = VCU(), gw = vcu * 8 + wave, NGW = G * 8;
        unsigned char* ws = ap->ws;
        LAS float* scr = (LAS float*)(lds + wave * 16640);
        constexpr int I_HIN = 2 * 16 * 64, I_HOUT = 2 * 16 * 16, I_RIN = 2 * 16 * 96, I_ROUT = 2 * 32 * 16, I_GU = 128 * 16 * 32, I_DN = 128 * 16 * 16;
        constexpr int NITEMS = I_HIN + I_HOUT + I_RIN + I_ROUT + I_GU + I_DN + I_ROUT;
        for (int it = gw; it < NITEMS; it += NGW) {
            int r = it;
            if (r < I_HIN) { const int j = r / (16 * 64); transpose_item(ap->in[I_HWIN] + (size_t)j * DM * HG_IN, DM, HG_IN, (bf16*)(ws + WS_W_HIN) + (size_t)j * HG_IN * DM, 1, scr, r % (16 * 64), lane); continue; } r -= I_HIN;
            if (r < I_HOUT) { const int j = r / 256; transpose_item(ap->in[I_HWOUT] + (size_t)j * DM * DM, DM, DM, (bf16*)(ws + WS_W_HOUT) + (size_t)j * DM * DM, 0, scr, r % 256, lane); continue; } r -= I_HOUT;
            if (r < I_RIN) { const int j = r / (16 * 96); transpose_item(ap->in[I_RWIN] + (size_t)j * DM * RT_IN, DM, RT_IN, (bf16*)(ws + WS_W_RIN) + (size_t)j * RT_IN * DM, 0, scr, r % (16 * 96), lane); continue; } r -= I_RIN;
            if (r < I_ROUT) { const int j = r / 512; transpose_item(ap->in[I_RWOUT] + (size_t)j * RT_VD * DM, RT_VD, DM, (bf16*)(ws + WS_W_ROUT) + (size_t)j * DM * RT_VD, 0, scr, r % 512, lane); continue; } r -= I_ROUT;
#if MOE_FP8
            if (r < I_GU) { const int j = r / 512; transpose_item_fp8(ap->in[I_WGU] + (size_t)j * DM * 2048, DM, 2048, ws + WS_W_GU + (size_t)j * 2048 * DM, 2, WGU_SCALE, scr, r % 512, lane); continue; } r -= I_GU;
            if (r < I_DN) { const int j = r / 256; transpose_item_fp8(ap->in[I_WDN] + (size_t)j * DM * DM, DM, DM, ws + WS_W_DN + (size_t)j * DM * DM, 0, WDN_SCALE, scr, r % 256, lane); continue; } r -= I_DN;
            { const int j = r / 512; transpose_item_fp8(ap->in[I_RWOUT] + (size_t)j * RT_VD * DM, RT_VD, DM, ws + WS_W_ROUT8 + (size_t)j * DM * RT_VD, 0, 128.0f, scr, r % 512, lane); }
#else
            if (r < I_GU) { const int j = r / 512; transpose_item(ap->in[I_WGU] + (size_t)j * DM * 2048, DM, 2048, (bf16*)(ws + WS_W_GU) + (size_t)j * 2048 * DM, 2, scr, r % 512, lane); continue; } r -= I_GU;
            { const int j = r / 256; transpose_item(ap->in[I_WDN] + (size_t)j * DM * DM, DM, DM, (bf16*)(ws + WS_W_DN) + (size_t)j * DM * DM, 0, scr, r % 256, lane); }
#endif
        }
        const int gt = vcu * 512 + tid, NGT = G * 512;
        float* LBS = (float*)(ws + WS_LBS); float* BGU = (float*)(ws + WS_BGU); float* ROT = (float*)(ws + WS_ROT); bf16* XB = (bf16*)(ws + WS_XB);
        for (int d = gt; d < DM; d += NGT) { const float* lbp = ap->in[I_LB]; const float v0 = lbp[d], v1 = lbp[DM + d], v2 = lbp[2 * DM + d], v3 = lbp[3 * DM + d]; const float mx = fmaxf(fmaxf(v0, v1), fmaxf(v2, v3));
            const float e0 = __expf(v0 - mx), e1 = __expf(v1 - mx), e2 = __expf(v2 - mx), e3 = __expf(v3 - mx), is = 1.0f / (e0 + e1 + e2 + e3);
            LBS[d] = 0.f; LBS[DM + d] = e1 * is; LBS[2 * DM + d] = (e1 + e2) * is; LBS[3 * DM + d] = (e1 + e2 + e3) * is; }
        for (int i = gt; i < SEQ * 128; i += NGT) { const int pos = i >> 7, p = i & 127; const float inv = 1.0f / __builtin_amdgcn_exp2f(13.287712379549449f * ((float)p / 127.0f)); const float th = (float)pos * inv;
            double rev = (double)th * 0.15915494309189535; rev -= floor(rev); const float fr = (float)rev; ROT[2 * i] = __builtin_amdgcn_cosf(fr); ROT[2 * i + 1] = __builtin_amdgcn_sinf(fr); }
        for (int i = gt; i < 4 * DM * NE; i += NGT) { const int l = i >> 15, d = (i >> 5) & 1023, e = i & 31; const float wv = ap->in[I_RW][i]; const unsigned hb = f2bf(wv); const float hv = __builtin_bit_cast(float, hb << 16);
            ((bf16*)(ws + WS_WRH))[(size_t)l * 32768 + e * 1024 + d] = (bf16)hb; ((bf16*)(ws + WS_WRL))[(size_t)l * 32768 + e * 1024 + d] = (bf16)f2bf(wv - hv); }
        for (int i = gt; i < 4 * 32 * 2048; i += NGT) { const int le = i >> 11, n = i & 2047; BGU[(size_t)le * 2048 + dest_row(2, n)] = ap->in[I_BGU][i]; }
        for (size_t i = (size_t)gt; i < (size_t)NTOK * DM / 4; i += NGT) { const f32x4 v = ((const f32x4*)ap->in[I_X])[i]; v2u o; o.x = pk2(v[0], v[1]); o.y = pk2(v[2], v[3]); ((v2u*)XB)[i] = o; }
        GRID_BAR();
    } }
#endif

#pragma unroll 1
    for (int L = 0; L < DEPTH; ++L) {
        const int pb = 1 + 8 * L;
        if ((L & 1) == 0) {
#if SITE(1)
            { KArgs ap = kargs(); const int tid = otid(wave0); LAS unsigned char* lds = olds(lds0); (void)tid;
            if (IN(pb + 0)) for (int rep_ = 0; rep_ < REP(1); ++rep_) {
                unsigned char* ws = ap->ws; const int j = L >> 1;
                LAS int* ul = (LAS int*)(lds + MISC_OFF + MO_ULIST);
                pg8::build_units_dense(tid, ul, NTOK / 256, HG_IN / 256, DM * 2);
                pg8::EpiHgrnIn E{ws, L};
                pg8::gemm_phase<pg8::EpiHgrnIn, false, true, false>(tid, lds, ul, (LAS int*)(lds + MISC_OFF + MO_GTAB), (const char*)(ws + WS_XB), (const char*)((bf16*)(ws + WS_W_HIN) + (size_t)j * HG_IN * DM), nullptr, DM * 2, E, lds + MISC_OFF + MO_GTAB);
                GRID_BAR();
            } }
#endif
#if SITE(2)
            { KArgs ap = kargs(); const int tid = otid(wave0); LAS unsigned char* lds = olds(lds0); (void)tid;
            if (IN(pb + 1)) for (int rep_ = 0; rep_ < REP(2); ++rep_) {
#if !SLOW_HGRN
                { unsigned char* ws = ap->ws; const bf16* QD = (const bf16*)(ws + WS_H);
                  hgrn_fast(tid, lds, QD, QD + (size_t)NTOK * DM, QD + 4 * (size_t)NTOK * DM, QD + 3 * (size_t)NTOK * DM, (const float*)(ws + WS_DEC), ap->in[I_HNG] + (L >> 1) * DM,
                            (bf16*)(ws + WS_A2), (float*)(ws + WS_SSP)); }
#else
                unsigned char* ws = ap->ws; const bf16* QD = (const bf16*)(ws + WS_H); const bf16* KI = QD + (size_t)NTOK * DM; const bf16* KS = QD + 2 * (size_t)NTOK * DM; const bf16* VV = QD + 3 * (size_t)NTOK * DM; bf16* OB = (bf16*)(ws + WS_O);
                LAS float* qf = (LAS float*)lds; LAS float* kf = qf + 16 * 4 * 36; LAS float* ff = kf + 16 * 4 * 36; LAS float* vf = ff + 16 * 4 * 36;
                for (int un = blockIdx.x; un < NBATCH * HG_HEADS; un += gridDim.x) {
                    const int b = un >> 3, h = un & 7; const int vc = tid >> 2, kq = tid & 3;
                    float st[32];
#pragma unroll
                    for (int i = 0; i < 32; ++i) st[i] = 0.f;
                    for (int t0 = 0; t0 < SEQ; t0 += 16) {
                        __syncthreads();
                        for (int e = tid; e < 16 * 128; e += 512) { const int tt = e >> 7, k = e & 127; const size_t gi = (size_t)(b * SEQ + t0 + tt) * DM + h * 128 + k; const int li = tt * 144 + (k & 3) * 36 + (k >> 2);
                            qf[li] = bf1(QD[gi]); kf[li] = bf1(KI[gi]); ff[li] = bf1(KS[gi]); vf[tt * 128 + k] = bf1(VV[gi]); }
                        __syncthreads();
                        for (int tt = 0; tt < 16; ++tt) {
                            const float v = vf[tt * 128 + vc]; float a = 0.f; const int lb = tt * 144 + kq * 36;
#pragma unroll
                            for (int i = 0; i < 32; ++i) { st[i] = ff[lb + i] * st[i] + kf[lb + i] * v; a += qf[lb + i] * st[i]; }
                            a += __shfl_xor(a, 1); a += __shfl_xor(a, 2);
                            if (kq == 0) OB[(size_t)(b * SEQ + t0 + tt) * DM + h * 128 + vc] = (bf16)f2bf(a);
                        }
                    }
                }
#endif
                GRID_BAR();
            } }
#endif
#if SITE(3) && SLOW_HGRN
            { KArgs ap = kargs(); const int tid = otid(wave0); LAS unsigned char* lds = olds(lds0); (void)tid;
            if (IN(pb + 2)) for (int rep_ = 0; rep_ < REP(3); ++rep_) {
                const int lane = tid & 63, wave = __builtin_amdgcn_readfirstlane(tid >> 6), gw = VCU() * 8 + wave, NGW = gridDim.x * 8;
                unsigned char* ws = ap->ws; const bf16* OB = (const bf16*)(ws + WS_O); const bf16* GG = (const bf16*)(ws + WS_H) + 4 * (size_t)NTOK * DM; bf16* A2 = (bf16*)(ws + WS_A2);
                const float* ng = ap->in[I_HNG] + (L >> 1) * DM;
                f32x4 g4[4];
#pragma unroll
                for (int q = 0; q < 4; ++q) g4[q] = *(const f32x4*)(ng + 256 * q + 4 * lane);
                v2u on[4], gn[4];
#pragma unroll
                for (int q = 0; q < 4; ++q) { on[q] = *(const v2u*)(OB + (size_t)gw * DM + 256 * q + 4 * lane); gn[q] = *(const v2u*)(GG + (size_t)gw * DM + 256 * q + 4 * lane); }
#pragma unroll 1
                for (int row = gw; row < NTOK; row += NGW) {
                    v2u oc[4], gc[4];
#pragma unroll
                    for (int q = 0; q < 4; ++q) { oc[q] = on[q]; gc[q] = gn[q]; }
                    if (row + NGW < NTOK) {
#pragma unroll
                        for (int q = 0; q < 4; ++q) { on[q] = *(const v2u*)(OB + (size_t)(row + NGW) * DM + 256 * q + 4 * lane); gn[q] = *(const v2u*)(GG + (size_t)(row + NGW) * DM + 256 * q + 4 * lane); } }
                    float o[16]; float ss = 0.f;
#pragma unroll
                    for (int q = 0; q < 4; ++q) { o[4 * q] = bflo(oc[q].x); o[4 * q + 1] = bfhi(oc[q].x); o[4 * q + 2] = bflo(oc[q].y); o[4 * q + 3] = bfhi(oc[q].y); }
#pragma unroll
                    for (int i = 0; i < 16; ++i) ss += o[i] * o[i];
                    const float rs = 1.0f / sqrtf(wave_sum(ss) * (1.0f / DM) + RMS_EPS);
#pragma unroll
                    for (int q = 0; q < 4; ++q) {
                        v2u w; w.x = pk2(o[4 * q] * rs * g4[q][0] * bflo(gc[q].x), o[4 * q + 1] * rs * g4[q][1] * bfhi(gc[q].x)); w.y = pk2(o[4 * q + 2] * rs * g4[q][2] * bflo(gc[q].y), o[4 * q + 3] * rs * g4[q][3] * bfhi(gc[q].y));
                        *(v2u*)(A2 + (size_t)row * DM + 256 * q + 4 * lane) = w; }
                }
                GRID_BAR();
            } }
#endif
        } else {
#if SITE(4)
            { KArgs ap = kargs(); const int tid = otid(wave0); LAS unsigned char* lds = olds(lds0); (void)tid;
            if (IN(pb + 0)) for (int rep_ = 0; rep_ < REP(4); ++rep_) {
                unsigned char* ws = ap->ws; const int j = L >> 1;
                LAS int* ul = (LAS int*)(lds + MISC_OFF + MO_ULIST);
                pg8::build_units_dense(tid, ul, NTOK / 256, RT_IN / 256, DM * 2);
                pg8::EpiRetIn E{ws};
                pg8::gemm_phase<pg8::EpiRetIn, false, true, false>(tid, lds, ul, (LAS int*)(lds + MISC_OFF + MO_GTAB), (const char*)(ws + WS_XB), (const char*)((bf16*)(ws + WS_W_RIN) + (size_t)j * RT_IN * DM), nullptr, DM * 2, E);
                GRID_BAR();
            } }
#endif
#if SITE(5)
            { KArgs ap = kargs(); const int tid = otid(wave0); LAS unsigned char* lds = olds(lds0); (void)tid;
            if (IN(pb + 1)) for (int rep_ = 0; rep_ < REP(5); ++rep_) {
#if !SLOW_RET
                { unsigned char* ws = ap->ws; ret_fast(tid, lds, (const bf16*)(ws + WS_H), (bf16*)(ws + WS_O)); }
#else
                unsigned char* ws = ap->ws; const bf16* HB = (const bf16*)(ws + WS_H); bf16* OB = (bf16*)(ws + WS_O);
                LAS float* qf = (LAS float*)lds; LAS float* kf = qf + 16 * 4 * 68; LAS float* vf = kf + 16 * 4 * 68;
                for (int un = blockIdx.x; un < NBATCH * RT_HEADS * 4; un += gridDim.x) {
                    const int b = un >> 4, h = (un >> 2) & 3, vq = un & 3; const int vc = tid >> 2, kq = tid & 3;
                    const float gam = 1.0f - exp2f(-5.0f - (float)h);
                    float st[64];
#pragma unroll
                    for (int i = 0; i < 64; ++i) st[i] = 0.f;
                    for (int t0 = 0; t0 < SEQ; t0 += 16) {
                        __syncthreads();
                        for (int e = tid; e < 16 * 256; e += 512) { const int tt = e >> 8, k = e & 255; const size_t gi = (size_t)(b * SEQ + t0 + tt) * RT_IN + h * 256 + k; const int li = tt * 272 + (k & 3) * 68 + (k >> 2);
                            qf[li] = bf1(HB[gi]); kf[li] = bf1(HB[gi + 1024]); }
                        for (int e = tid; e < 16 * 128; e += 512) { const int tt = e >> 7, c = e & 127; vf[e] = bf1(HB[(size_t)(b * SEQ + t0 + tt) * RT_IN + 2048 + h * 512 + vq * 128 + c]); }
                        __syncthreads();
                        for (int tt = 0; tt < 16; ++tt) {
                            const float v = vf[tt * 128 + vc]; float a = 0.f; const int lb = tt * 272 + kq * 68;
#pragma unroll
                            for (int i = 0; i < 64; ++i) { st[i] = gam * st[i] + kf[lb + i] * v; a += qf[lb + i] * st[i]; }
                            a += __shfl_xor(a, 1); a += __shfl_xor(a, 2);
                            if (kq == 0) OB[(size_t)(b * SEQ + t0 + tt) * RT_VD + h * 512 + vq * 128 + vc] = (bf16)f2bf(a);
                        }
                    }
                }
#endif
                GRID_BAR();
            } }
#endif
#if SITE(6)
            { KArgs ap = kargs(); const int tid = otid(wave0); LAS unsigned char* lds = olds(lds0); (void)tid;
            if (IN(pb + 2)) for (int rep_ = 0; rep_ < REP(6); ++rep_) {
                const int lane = tid & 63, wave = __builtin_amdgcn_readfirstlane(tid >> 6), gw = VCU() * 8 + wave, NGW = gridDim.x * 8;
                unsigned char* ws = ap->ws; const bf16* OB = (const bf16*)(ws + WS_O); const bf16* HB = (const bf16*)(ws + WS_H); bf16* A2 = (bf16*)(ws + WS_A2);
                v4u on[4], gn[4];
#pragma unroll
                for (int h = 0; h < 4; ++h) { on[h] = *(const v4u*)(OB + (size_t)gw * RT_VD + 512 * h + 8 * lane); gn[h] = *(const v4u*)(HB + (size_t)gw * RT_IN + 4096 + 512 * h + 8 * lane); }
#pragma unroll 1
                for (int row = gw; row < NTOK; row += NGW) {
                    v4u oc[4], gc[4];
#pragma unroll
                    for (int h = 0; h < 4; ++h) { oc[h] = on[h]; gc[h] = gn[h]; }
                    if (row + NGW < NTOK) {
#pragma unroll
                        for (int h = 0; h < 4; ++h) { on[h] = *(const v4u*)(OB + (size_t)(row + NGW) * RT_VD + 512 * h + 8 * lane); gn[h] = *(const v4u*)(HB + (size_t)(row + NGW) * RT_IN + 4096 + 512 * h + 8 * lane); } }
#pragma unroll
                    for (int h = 0; h < 4; ++h) {
                        const v4u w = oc[h];
                        float o[8] = {bflo(w.x), bfhi(w.x), bflo(w.y), bfhi(w.y), bflo(w.z), bfhi(w.z), bflo(w.w), bfhi(w.w)};
                        float s = 0.f;
#pragma unroll
                        for (int i = 0; i < 8; ++i) s += o[i];
                        const float mu = wave_sum(s) * (1.0f / 512.0f); float q = 0.f;
#pragma unroll
                        for (int i = 0; i < 8; ++i) { o[i] -= mu; q += o[i] * o[i]; }
                        const float rs = 1.0f / sqrtf(wave_sum(q) * (1.0f / 512.0f) + LN_EPS);
                        const v4u g = gc[h];
#if ROUT_FP8
                        const float r8 = rs * 8.0f; v2u r; r.x = pk4_fp8(o[0] * r8 * bflo(g.x), o[1] * r8 * bfhi(g.x), o[2] * r8 * bflo(g.y), o[3] * r8 * bfhi(g.y));
                        r.y = pk4_fp8(o[4] * r8 * bflo(g.z), o[5] * r8 * bfhi(g.z), o[6] * r8 * bflo(g.w), o[7] * r8 * bfhi(g.w));
                        *(v2u*)((unsigned char*)A2 + (size_t)row * RT_VD + 512 * h + 8 * lane) = r;
#else
                        v4u r; r.x = pk2(o[0] * rs * bflo(g.x), o[1] * rs * bfhi(g.x)); r.y = pk2(o[2] * rs * bflo(g.y), o[3] * rs * bfhi(g.y));
                        r.z = pk2(o[4] * rs * bflo(g.z), o[5] * rs * bfhi(g.z)); r.w = pk2(o[6] * rs * bflo(g.w), o[7] * rs * bfhi(g.w));
                        *(v4u*)(A2 + (size_t)row * RT_VD + 512 * h + 8 * lane) = r;
#endif
                    }
                }
                GRID_BAR();
            } }
#endif
        }
#if SITE(7)
        { KArgs ap = kargs(); const int tid = otid(wave0); LAS unsigned char* lds = olds(lds0); (void)tid;
        if (IN(pb + 3)) for (int rep_ = 0; rep_ < REP(7); ++rep_) {
            unsigned char* ws = ap->ws; const int j = L >> 1; const bool ret = (L & 1) != 0;
            const int Ko = ret ? RT_VD : DM;
            LAS int* ul = (LAS int*)(lds + MISC_OFF + MO_ULIST);
            if (ret && ROUT_FP8) {
                pg8::build_units_dense(tid, ul, NTOK / 256, DM / 256, RT_VD);
                pg8::EpiRes E{ws, -1, 1.0f / (8.0f * 128.0f)};
                pg8::gemm_phase<pg8::EpiRes, false, true, true>(tid, lds, ul, (LAS int*)(lds + MISC_OFF + MO_GTAB), (const char*)(ws + WS_A2), (const char*)(ws + WS_W_ROUT8 + (size_t)j * DM * RT_VD), nullptr, RT_VD, E);
            } else {
                pg8::build_units_dense(tid, ul, NTOK / 256, DM / 256, Ko * 2);
                const char* Bt = ret ? (const char*)((bf16*)(ws + WS_W_ROUT) + (size_t)j * DM * RT_VD) : (const char*)((bf16*)(ws + WS_W_HOUT) + (size_t)j * DM * DM);
                pg8::EpiRes E{ws, (ret || SLOW_HGRN) ? -1 : 0, 1.0f};
                pg8::gemm_phase<pg8::EpiRes, false, true, false>(tid, lds, ul, (LAS int*)(lds + MISC_OFF + MO_GTAB), (const char*)(ws + WS_A2), Bt, nullptr, Ko * 2, E);
            }
            GRID_BAR();
        } }
#endif
#if SITE(8)
        { KArgs ap = kargs(); const int tid = otid(wave0); LAS unsigned char* lds = olds(lds0); (void)tid;
        if (IN(pb + 4)) for (int rep_ = 0; rep_ < REP(8); ++rep_) {
            const int lane = tid & 63, wave = __builtin_amdgcn_readfirstlane(tid >> 6), r = lane & 15, g = lane >> 4;
            unsigned char* ws = ap->ws; unsigned* ctl = (unsigned*)(ws + WS_CTL);
            const bf16* Y = (const bf16*)(ws + WS_Y); bf16* X1R = (bf16*)(ws + WS_X1F); bf16* X1B = (bf16*)(ws + WS_X1B);
            int* ROWDST = (int*)(ws + WS_ROWDST); float* ROWGATE = (float*)(ws + WS_ROWGATE);
            constexpr int WP = 2064;
            LAS unsigned char* wH = lds; LAS unsigned char* wL = lds + 32 * WP;
            LAS int* lcnt = (LAS int*)(lds + MISC_OFF + MO_LCNT); LAS int* lbase = (LAS int*)(lds + MISC_OFF + MO_LBASE);
            LAS int* sel = (LAS int*)(lds + MISC_OFF + MO_SEL); LAS float* selw = (LAS float*)(lds + MISC_OFF + MO_SELW);
            const float* rb = ap->in[I_RB] + L * NE;
            const float* lg = ap->in[I_LNMG] + L * DM; const float* lbb = ap->in[I_LNMB] + L * DM;
            { const v4u* gh = (const v4u*)(ws + WS_WRH) + (size_t)L * 4096; const v4u* gl = (const v4u*)(ws + WS_WRL) + (size_t)L * 4096;
              for (int c = tid; c < 4096; c += 512) { const int e = c >> 7, cc = c & 127; *(LAS v4u*)(wH + e * WP + cc * 16) = gh[c]; *(LAS v4u*)(wL + e * WP + cc * 16) = gl[c]; } }
            const float rb0 = rb[r], rb1 = rb[16 + r];
            for (int blk = VCU(); blk < NTOK / 128; blk += gridDim.x) {
                if (tid < 32) lcnt[tid] = 0;
                __syncthreads();
                const int row0 = blk * 128 + wave * 16;
                v2u xn[4];
#pragma unroll
                for (int q = 0; q < 4; ++q) xn[q] = *(const v2u*)(Y + (size_t)row0 * DM + 256 * q + 4 * lane);
#pragma unroll 1
                for (int rr = 0; rr < 16; ++rr) {
                    const int row = row0 + rr;
                    f32x4 x[4]; float s = 0.f;
#pragma unroll
                    for (int q = 0; q < 4; ++q) { x[q] = (f32x4){bflo(xn[q].x), bfhi(xn[q].x), bflo(xn[q].y), bfhi(xn[q].y)}; s += (x[q][0] + x[q][1]) + (x[q][2] + x[q][3]); }
                    if (rr + 1 < 16) {
#pragma unroll
                        for (int q = 0; q < 4; ++q) xn[q] = *(const v2u*)(Y + (size_t)(row + 1) * DM + 256 * q + 4 * lane); }
                    const float mu = wave_sum_u(s) * (1.0f / DM); float qq = 0.f;
#pragma unroll
                    for (int q = 0; q < 4; ++q) { x[q] = x[q] - mu; qq += (x[q][0] * x[q][0] + x[q][1] * x[q][1]) + (x[q][2] * x[q][2] + x[q][3] * x[q][3]); }
                    const float rs = 1.0f / sqrtf(wave_sum_u(qq) * (1.0f / DM) + LN_EPS);
#pragma unroll
                    for (int q = 0; q < 4; ++q) { const f32x4 g4 = *(const f32x4*)(lg + 256 * q + 4 * lane), b4 = *(const f32x4*)(lbb + 256 * q + 4 * lane); x[q] = x[q] * rs * g4 + b4;
                        { v2u wr_; wr_.x = pk2(x[q][0], x[q][1]); wr_.y = pk2(x[q][2], x[q][3]); *(v2u*)(X1R + (size_t)row * DM + 256 * q + 4 * lane) = wr_; }
#if MOE_FP8
                        *(unsigned*)((unsigned char*)X1B + (size_t)row * DM + 256 * q + 4 * lane) = pk4_fp8(x[q][0] * X_SCALE, x[q][1] * X_SCALE, x[q][2] * X_SCALE, x[q][3] * X_SCALE); }
#else
                        v2u w; w.x = pk2(x[q][0], x[q][1]); w.y = pk2(x[q][2], x[q][3]); *(v2u*)(X1B + (size_t)row * DM + 256 * q + 4 * lane) = w; }
#endif
                }
                asm volatile("s_waitcnt vmcnt(0)" ::: "memory");
                f32x4 lgt0 = {0.f, 0.f, 0.f, 0.f}, lgt1 = {0.f, 0.f, 0.f, 0.f};
                {
                    const bf16* xa = X1R + (size_t)(row0 + r) * DM + 8 * g;
#pragma unroll 1
                    for (int kq = 0; kq < 4; ++kq) {
                        bf16x8 af[8], h0[8], h1[8], l0[8], l1[8];
#pragma unroll
                        for (int j = 0; j < 8; ++j) { const int kb = kq * 8 + j; af[j] = *(const bf16x8*)(xa + 32 * kb);
                            h0[j] = *(const LAS bf16x8*)(wH + r * WP + (32 * kb + 8 * g) * 2); h1[j] = *(const LAS bf16x8*)(wH + (16 + r) * WP + (32 * kb + 8 * g) * 2);
                            l0[j] = *(const LAS bf16x8*)(wL + r * WP + (32 * kb + 8 * g) * 2); l1[j] = *(const LAS bf16x8*)(wL + (16 + r) * WP + (32 * kb + 8 * g) * 2); }
#pragma unroll
                        for (int j = 0; j < 8; ++j) { lgt0 = MFMA32(af[j], h0[j], lgt0); lgt1 = MFMA32(af[j], h1[j], lgt1); lgt0 = MFMA32(af[j], l0[j], lgt0); lgt1 = MFMA32(af[j], l1[j], lgt1); }
                    }
                }
#pragma unroll
                for (int i = 0; i < 4; ++i) {
                    float v0 = lgt0[i] + rb0, v1 = lgt1[i] + rb1; int se[4]; float sv[4];
#pragma unroll
                    for (int k = 0; k < 4; ++k) {
                        float m = fmaxf(v0, v1);
                        m = fmaxf(m, dppf<0xB1>(m)); m = fmaxf(m, dppf<0x4E>(m)); m = fmaxf(m, dppf<0x141>(m)); m = fmaxf(m, dppf<0x140>(m));
                        int ec = (v0 == m) ? r : ((v1 == m) ? 16 + r : 99);
                        ec = min(ec, dppi<0xB1>(ec)); ec = min(ec, dppi<0x4E>(ec)); ec = min(ec, dppi<0x141>(ec)); ec = min(ec, dppi<0x140>(ec));
                        se[k] = ec; sv[k] = m;
                        if (ec == r) v0 = -3.0e38f;
                        if (ec == 16 + r) v1 = -3.0e38f;
                    }
                    const float e1 = __expf(sv[1] - sv[0]), e2 = __expf(sv[2] - sv[0]), e3 = __expf(sv[3] - sv[0]); const float inv = 1.0f / (1.0f + e1 + e2 + e3);
                    if (r < 4) { const int rloc = wave * 16 + 4 * g + i; const int ee = r == 0 ? se[0] : (r == 1 ? se[1] : (r == 2 ? se[2] : se[3])); const float ww = (r == 0 ? 1.0f : (r == 1 ? e1 : (r == 2 ? e2 : e3))) * inv;
                        sel[rloc * 4 + r] = ee; selw[rloc * 4 + r] = ww; }
                }
                __syncthreads();
                const int myE = sel[tid]; const int rank = __hip_atomic_fetch_add(lcnt + myE, 1, __ATOMIC_RELAXED, __HIP_MEMORY_SCOPE_WORKGROUP);
                __syncthreads();
                if (tid < 32) lbase[tid] = (int)__hip_atomic_fetch_add(ctl + CW_ECNT + (L + 4 * rep_) * 32 + tid, (unsigned)lcnt[tid], RLX_AGENT);
                __syncthreads();
                { const int pos = lbase[myE] + rank; const size_t ti = (size_t)myE * ECAP + pos; ROWDST[ti] = (blk * 128 + (tid >> 2)) * 4 + (tid & 3); ROWGATE[ti] = selw[tid]; }
                __syncthreads();
            }
            GRID_BAR();
        } }
#endif
#if SITE(9)
        { KArgs ap = kargs(); const int tid = otid(wave0); LAS unsigned char* lds = olds(lds0); (void)tid;
        if (IN(pb + 5)) for (int rep_ = 0; rep_ < REP(9); ++rep_) {
            unsigned char* ws = ap->ws; unsigned* ctl = (unsigned*)(ws + WS_CTL);
            LAS int* tpre = (LAS int*)(lds + MISC_OFF + MO_TPRE); LAS int* ebase = (LAS int*)(lds + MISC_OFF + MO_EBASE); LAS int* ecnt = (LAS int*)(lds + MISC_OFF + MO_ECNT);
            if (tid < NE) ecnt[tid] = (int)__hip_atomic_load(ctl + CW_ECNT + L * 32 + tid, RLX_AGENT);
            __syncthreads();
            if (tid == 0) { int t = 0;
_Pragma("unroll 1")
 for (int e = 0; e < NE; ++e) { const int c = ecnt[e]; tpre[e] = t; ebase[e] = t * 256; t += (c + 255) >> 8; } tpre[NE] = t; }
            __syncthreads();
            LAS int* ul = (LAS int*)(lds + MISC_OFF + MO_ULIST);
            constexpr int EB = MOE_FP8 ? 1 : 2;
            pg8::build_units_moe(tid, ul, tpre, ebase, ecnt, 8, DM * EB, 2048u * DM * EB);
            { LAS int* gall = (LAS int*)(lds + MISC_OFF + MO_GALL); const int* rd = (const int*)(ws + WS_ROWDST);
              for (int i = tid; i < GALL_UNITS * 256; i += 512) { const int uu = i >> 8, rr = i & 255;
                  if (ul[uu * 8 + 0]) gall[i] = (int)((unsigned)rd[ul[uu * 8 + 7] + min(rr, ul[uu * 8 + 5] - 1)] >> 2); }
              __syncthreads(); }
            pg8::EpiMoeGU E{ws, L};
            pg8::gemm_phase<pg8::EpiMoeGU, true, true, MOE_FP8 != 0>(tid, lds, ul, (LAS int*)(lds + MISC_OFF + MO_GALL), (const char*)(ws + WS_X1B), (const char*)(ws + WS_W_GU + (size_t)L * NE * 2048 * DM * EB), (const int*)(ws + WS_ROWDST), DM * EB, E, lds + MISC_OFF + MO_GTAB);
            GRID_BAR();
        } }
#endif
#if SITE(10)
        { KArgs ap = kargs(); const int tid = otid(wave0); LAS unsigned char* lds = olds(lds0); (void)tid;
        if (IN(pb + 6)) for (int rep_ = 0; rep_ < REP(10); ++rep_) {
            unsigned char* ws = ap->ws; unsigned* ctl = (unsigned*)(ws + WS_CTL);
            LAS int* tpre = (LAS int*)(lds + MISC_OFF + MO_TPRE); LAS int* ebase = (LAS int*)(lds + MISC_OFF + MO_EBASE); LAS int* ecnt = (LAS int*)(lds + MISC_OFF + MO_ECNT);
            __syncthreads();
            if (tid < NE) ecnt[tid] = (int)__hip_atomic_load(ctl + CW_ECNT + L * 32 + tid, RLX_AGENT);
            __syncthreads();
            if (tid == 0) { int t = 0;
_Pragma("unroll 1")
 for (int e = 0; e < NE; ++e) { const int c = ecnt[e]; tpre[e] = t; ebase[e] = t * 256; t += (c + 255) >> 8; } tpre[NE] = t; }
            __syncthreads();
            LAS int* ul = (LAS int*)(lds + MISC_OFF + MO_ULIST);
            constexpr int EB = MOE_FP8 ? 1 : 2;
            pg8::build_units_moe(tid, ul, tpre, ebase, ecnt, 4, DM * EB, (unsigned)DM * DM * EB);
            pg8::EpiMoeDown E{ws, ap->in[I_BDN] + (size_t)L * NE * DM};
            pg8::gemm_phase<pg8::EpiMoeDown, false, true, MOE_FP8 != 0>(tid, lds, ul, (LAS int*)(lds + MISC_OFF + MO_GTAB), (const char*)(ws + WS_ACT), (const char*)(ws + WS_W_DN + (size_t)L * NE * DM * DM * EB), nullptr, DM * EB, E, lds + MISC_OFF + MO_GALL);
            GRID_BAR();
        } }
#endif
#if SITE(11)
        { KArgs ap = kargs(); const int tid = otid(wave0); LAS unsigned char* lds = olds(lds0); (void)tid;
        if (IN(pb + 7)) for (int rep_ = 0; rep_ < REP(11); ++rep_) {
            const int lane = tid & 63, wave = __builtin_amdgcn_readfirstlane(tid >> 6), gw = VCU() * 8 + wave, NGW = gridDim.x * 8;
            unsigned char* ws = ap->ws; const bf16* X1R = (const bf16*)(ws + WS_X1F); const bf16* YS = (const bf16*)(ws + WS_YSLOT); bf16* XB = (bf16*)(ws + WS_XB); float* out = ap->out;
            const float* lg = ap->in[I_LNFG] + L * DM; const float* lbb = ap->in[I_LNFB] + L * DM;
#if YS_FP8
            typedef unsigned ys_t; constexpr int YSB = 1;
#else
            typedef v2u ys_t; constexpr int YSB = 2;
#endif
            v2u xn[4]; f32x4 g4[4], b4[4]; ys_t yn[4][4];
#pragma unroll
            for (int q = 0; q < 4; ++q) { g4[q] = *(const f32x4*)(lg + 256 * q + 4 * lane); b4[q] = *(const f32x4*)(lbb + 256 * q + 4 * lane); xn[q] = *(const v2u*)(X1R + (size_t)gw * DM + 256 * q + 4 * lane);
#pragma unroll
                for (int k = 0; k < 4; ++k) yn[q][k] = *(const ys_t*)((const unsigned char*)YS + (((size_t)gw * 4 + k) * DM + 256 * q + 4 * lane) * YSB); }
#pragma unroll 1
            for (int row = gw; row < NTOK; row += NGW) {
                f32x4 x[4]; ys_t yc[4][4]; float s = 0.f;
#pragma unroll
                for (int q = 0; q < 4; ++q) { x[q] = (f32x4){bflo(xn[q].x), bfhi(xn[q].x), bflo(xn[q].y), bfhi(xn[q].y)} * DN_ALPHA;
#pragma unroll
                    for (int k = 0; k < 4; ++k) yc[q][k] = yn[q][k]; }
                if (row + NGW < NTOK) {
#pragma unroll
                    for (int q = 0; q < 4; ++q) { xn[q] = *(const v2u*)(X1R + (size_t)(row + NGW) * DM + 256 * q + 4 * lane);
#pragma unroll
                        for (int k = 0; k < 4; ++k) yn[q][k] = *(const ys_t*)((const unsigned char*)YS + (((size_t)(row + NGW) * 4 + k) * DM + 256 * q + 4 * lane) * YSB); } }
#pragma unroll
                for (int q = 0; q < 4; ++q) {
#pragma unroll
#if YS_FP8
                    for (int k = 0; k < 4; ++k) { const f32x2 lo = __builtin_amdgcn_cvt_pk_f32_fp8((int)yc[q][k], false), hi = __builtin_amdgcn_cvt_pk_f32_fp8((int)yc[q][k], true);
                        x[q][0] += lo[0] * 0.015625f; x[q][1] += lo[1] * 0.015625f; x[q][2] += hi[0] * 0.015625f; x[q][3] += hi[1] * 0.015625f; }
#else
                    for (int k = 0; k < 4; ++k) { const v2u w = yc[q][k]; x[q][0] += bflo(w.x); x[q][1] += bfhi(w.x); x[q][2] += bflo(w.y); x[q][3] += bfhi(w.y); }
#endif
                    s += (x[q][0] + x[q][1]) + (x[q][2] + x[q][3]); }
                const float mu = wave_sum(s) * (1.0f / DM); float qq = 0.f;
#pragma unroll
                for (int q = 0; q < 4; ++q) { x[q] = x[q] - mu; qq += (x[q][0] * x[q][0] + x[q][1] * x[q][1]) + (x[q][2] * x[q][2] + x[q][3] * x[q][3]); }
                const float rs = 1.0f / sqrtf(wave_sum(qq) * (1.0f / DM) + LN_EPS);
#pragma unroll
                for (int q = 0; q < 4; ++q) { x[q] = x[q] * rs * g4[q] + b4[q];
                    if (L + 1 == DEPTH) *(f32x4*)(out + (size_t)row * DM + 256 * q + 4 * lane) = x[q];
                    else { v2u w; w.x = pk2(x[q][0], x[q][1]); w.y = pk2(x[q][2], x[q][3]); *(v2u*)(XB + (size_t)row * DM + 256 * q + 4 * lane) = w; } }
            }
            if (L + 1 < DEPTH) GRID_BAR();
        } }
#endif
    }
#undef IN
#undef GRID_BAR
}

extern "C" void kernel_launch(void* const* d_in, const int* in_sizes, int n_in, void* d_out, int out_size, void* d_ws, size_t ws_size, hipStream_t stream) {
    static int grid = 0;
    if (grid == 0) {
        if (n_in != 17 || out_size != NTOK * DM || ws_size < WS_END) { fprintf(stderr, "kernel_launch: unexpected shapes (n_in %d, out %d, ws %zu < %zu)\n", n_in, out_size, ws_size, (size_t)WS_END); grid = -1; return; }
        int dev = 0, cus = 0, per_cu = 0;
        if (hipGetDevice(&dev) != hipSuccess || hipDeviceGetAttribute(&cus, hipDeviceAttributeMultiprocessorCount, dev) != hipSuccess) { grid = -1; return; }
        if (hipFuncSetAttribute((const void*)mk_fwd, hipFuncAttributeMaxDynamicSharedMemorySize, LDS_BYTES) != hipSuccess) { fprintf(stderr, "kernel_launch: hipFuncSetAttribute failed\n"); grid = -1; return; }
        if (hipOccupancyMaxActiveBlocksPerMultiprocessor(&per_cu, (const void*)mk_fwd, 512, LDS_BYTES) != hipSuccess || per_cu < 1) { fprintf(stderr, "kernel_launch: occupancy query says %d\n", per_cu); }
        (void)hipGetLastError();
        grid = cus;
    }
    if (grid < 0) return;
    (void)hipMemsetAsync((char*)d_ws + WS_CTL, 0, CTL_ZERO_BYTES, stream);
    Args a{};
    for (int i = 0; i < 17; ++i) a.in[i] = (const float*)d_in[i];
    a.out = (float*)d_out; a.ws = (unsigned char*)d_ws;
#if MK_MULTI
    for (int p = 0; p < 1 + 8 * DEPTH; ++p) { a.ph_lo = p; a.ph_hi = p + 1; hipLaunchKernelGGL(mk_fwd, dim3(grid), dim3(512), LDS_BYTES, stream, a); }
#else
    a.ph_lo = 0; a.ph_hi = 1 + 8 * DEPTH;
    hipLaunchKernelGGL(mk_fwd, dim3(grid), dim3(512), LDS_BYTES, stream, a);
#endif
}
```

```cpp
#include <hip/hip_runtime.h>
#include <cstdio>
#include <cstdint>

#ifndef MK_MULTI
#define MK_MULTI 0
#endif
#ifndef PROBE_EPI2
#define PROBE_EPI2 0
#endif
#ifndef MOE_FP8
#define MOE_FP8 1
#endif
#ifndef ROUT_FP8
#define ROUT_FP8 1
#endif
#ifndef YS_FP8
#define YS_FP8 1
#endif
#ifndef SLOW_HGRN
#define SLOW_HGRN 0
#endif
#ifndef SLOW_RET
#define SLOW_RET 0
#endif

#define GAS __attribute__((address_space(1)))
#define LAS __attribute__((address_space(3)))
typedef unsigned short bf16;
typedef unsigned v4u __attribute__((ext_vector_type(4)));
typedef unsigned v2u __attribute__((ext_vector_type(2)));
typedef float f32x4 __attribute__((ext_vector_type(4)));
typedef float f32x2 __attribute__((ext_vector_type(2)));
typedef short bf16x8 __attribute__((ext_vector_type(8)));
typedef GAS unsigned gu32;

constexpr int DM = 1024, NBATCH = 16, SEQ = 2048, NTOK = NBATCH * SEQ, DEPTH = 4;
constexpr int NE = 32, TOPK = 4;
constexpr int HG_HEADS = 8, HG_K = 128;
constexpr int RT_HEADS = 4, RT_K = 256, RT_V = 512, RT_VD = 2048, RT_IN = 6144, HG_IN = 4096;
constexpr int ECAP = NTOK;
constexpr int MOE_ROWS = NTOK * TOPK + NE * 256;
constexpr float DN_ALPHA = 1.681792830507429f;
constexpr float LN_EPS = 1e-5f, RMS_EPS = 1e-6f;

constexpr size_t MiB = 1ull << 20;
constexpr size_t WS_CTL = 0, CTL_ZERO_BYTES = 1 * MiB;
constexpr size_t WS_LBS = 1 * MiB;
constexpr size_t WS_WRH = 1 * MiB + 128 * 1024, WS_WRL = 1 * MiB + 512 * 1024;
constexpr size_t WS_BGU = 2 * MiB;
constexpr size_t WS_ROT = 4 * MiB;
constexpr size_t WS_ROWDST = 8 * MiB;
constexpr size_t WS_ROWGATE = 12 * MiB;
constexpr size_t WS_W_HIN = 16 * MiB;
constexpr size_t WS_W_HOUT = WS_W_HIN + 16 * MiB;
constexpr size_t WS_W_RIN = WS_W_HOUT + 4 * MiB;
constexpr size_t WS_W_ROUT = WS_W_RIN + 24 * MiB;
constexpr size_t WS_W_GU = WS_W_ROUT + 8 * MiB;
constexpr size_t WS_W_DN = WS_W_GU + 512 * MiB;
constexpr size_t WS_XB = WS_W_DN + 256 * MiB;
constexpr size_t WS_H = WS_XB + 64 * MiB;
constexpr size_t WS_DEC = WS_H + 320 * MiB;
constexpr size_t WS_SSP = WS_DEC + 16 * MiB;
constexpr size_t WS_O = WS_H + 384 * MiB;
constexpr size_t WS_A2 = WS_O + 128 * MiB;
constexpr size_t WS_Y = WS_A2 + 128 * MiB;
constexpr size_t WS_X1F = WS_Y + 128 * MiB;
constexpr size_t WS_X1B = WS_X1F + 128 * MiB;
constexpr size_t WS_ACT = WS_X1B + 64 * MiB;
constexpr size_t WS_YSLOT = WS_ACT + 272 * MiB;
constexpr size_t WS_W_ROUT8 = WS_YSLOT + 256 * MiB;
constexpr size_t WS_END = WS_W_ROUT8 + 4 * MiB;

constexpr int CW_BAR = 4096;
constexpr int CW_SS = 65536;
constexpr int CW_ECNT = 16384;

constexpr int RING_BYTES = 131072;
constexpr int MISC_OFF = 135168;
constexpr int LDS_BYTES = 163840;
constexpr int MO_BARW = 0;
constexpr int MO_GTAB = 64;
constexpr int MO_TPRE = 64 + 2048;
constexpr int MO_EBASE = MO_TPRE + 160;
constexpr int MO_ECNT = MO_EBASE + 128;
constexpr int MO_LCNT = MO_ECNT + 128;
constexpr int MO_LBASE = MO_LCNT + 128;
constexpr int MO_SEL = MO_LBASE + 128;
constexpr int MO_SELW = MO_SEL + 2048;
constexpr int MO_RANK = MO_SELW + 2048;
constexpr int MO_ULIST = MO_RANK + 2048;
constexpr int MO_GALL = 10240;
constexpr int GALL_UNITS = 18;
static_assert(MO_ULIST + 1024 <= MO_GALL && MISC_OFF + MO_GALL + GALL_UNITS * 1024 <= LDS_BYTES, "LDS map");

#define RLX_AGENT __ATOMIC_RELAXED, __HIP_MEMORY_SCOPE_AGENT
#define LDS_WAIT() asm volatile("s_waitcnt lgkmcnt(0)" ::: "memory")
#define VM_WAIT() asm volatile("s_waitcnt vmcnt(0)" ::: "memory")

__device__ __forceinline__ unsigned f2bf(float f) { unsigned u = __builtin_bit_cast(unsigned, f); return (u + 0x7fffu + ((u >> 16) & 1u)) >> 16; }
__device__ __forceinline__ unsigned pk2(float lo, float hi) { return f2bf(lo) | (f2bf(hi) << 16); }
__device__ __forceinline__ unsigned cvt_pk_bf16(float lo, float hi) { unsigned r; asm volatile("v_cvt_pk_bf16_f32 %0, %1, %2" : "=v"(r) : "v"(lo), "v"(hi)); return r; }
#if MOE_FP8
constexpr float X_SCALE = 4.0f, WGU_SCALE = 64.0f, ACT_SCALE = 4.0f, WDN_SCALE = 128.0f;
constexpr float GU_DESCALE = 1.0f / (X_SCALE * WGU_SCALE), DN_DESCALE = 1.0f / (ACT_SCALE * WDN_SCALE);
#else
constexpr float GU_DESCALE = 1.0f, DN_DESCALE = 1.0f, ACT_SCALE = 1.0f;
#endif
__device__ __forceinline__ unsigned pk4_fp8(float a, float b, float c, float d) {
    a = __builtin_amdgcn_fmed3f(a, -448.0f, 448.0f); b = __builtin_amdgcn_fmed3f(b, -448.0f, 448.0f); c = __builtin_amdgcn_fmed3f(c, -448.0f, 448.0f); d = __builtin_amdgcn_fmed3f(d, -448.0f, 448.0f);
    int p = __builtin_amdgcn_cvt_pk_fp8_f32(a, b, 0, false); p = __builtin_amdgcn_cvt_pk_fp8_f32(c, d, p, true); return (unsigned)p; }
__device__ __forceinline__ float bflo(unsigned u) { return __builtin_bit_cast(float, u << 16); }
__device__ __forceinline__ float bfhi(unsigned u) { return __builtin_bit_cast(float, u & 0xffff0000u); }
__device__ __forceinline__ float bf1(bf16 b) { return __builtin_bit_cast(float, ((unsigned)b) << 16); }
__device__ __forceinline__ float fexp(float x) { return __builtin_amdgcn_exp2f(x * 1.4426950408889634f); }
__device__ __forceinline__ float frcp(float x) { return __builtin_amdgcn_rcpf(x); }
__device__ __forceinline__ float fsigmoid(float x) { return frcp(1.0f + fexp(-x)); }
__device__ __forceinline__ float wave_sum(float v) {
#pragma unroll
    for (int o = 1; o < 64; o <<= 1) v += __shfl_xor(v, o);
    return v;
}
__device__ __forceinline__ float wave_max(float v) {
#pragma unroll
    for (int o = 1; o < 64; o <<= 1) v = fmaxf(v, __shfl_xor(v, o));
    return v;
}

template <int CTRL> __device__ __forceinline__ float dppf(float v) { return __builtin_bit_cast(float, __builtin_amdgcn_update_dpp(0, __builtin_bit_cast(int, v), CTRL, 0xf, 0xf, true)); }
template <int CTRL> __device__ __forceinline__ int dppi(int v) { return __builtin_amdgcn_update_dpp(0, v, CTRL, 0xf, 0xf, true); }
__device__ __forceinline__ float rlane(float v, int l) { return __builtin_bit_cast(float, __builtin_amdgcn_readlane(__builtin_bit_cast(int, v), l)); }
__device__ __forceinline__ float wave_sum_u(float v) {
    v += dppf<0xB1>(v); v += dppf<0x4E>(v); v += dppf<0x141>(v); v += dppf<0x140>(v);
    return (rlane(v, 0) + rlane(v, 16)) + (rlane(v, 32) + rlane(v, 48));
}
#define XB_TMO      128
#define XB_XCNT(j)  (256  + 64 * (j))
#define XB_XSUB(j)  (1280 + 64 * (j))
#define XB_XGEN(j)  (2304 + 64 * (j))
#define XB_TOP      3328
#define XB_TOPGEN   3392
#define XCD_BAR_WORDS 3456
#define XB_SPIN_CAP (1u << 22)

__device__ __forceinline__ unsigned xb_ld(unsigned* p)              { return __hip_atomic_load(p, __ATOMIC_RELAXED, __HIP_MEMORY_SCOPE_AGENT); }
__device__ __forceinline__ unsigned xb_add(unsigned* p, unsigned v) { return __hip_atomic_fetch_add(p, v, __ATOMIC_RELAXED, __HIP_MEMORY_SCOPE_AGENT); }
__device__ __forceinline__ unsigned xb_xcc_id() { return (unsigned)__builtin_amdgcn_s_getreg((3 << 11) | 20) & 0xFu; }
#define XB_SPIN(cond, bar) do { unsigned _sp = 0; while (cond) { __builtin_amdgcn_s_sleep(1); \
    if ((++_sp & 255u) == 0u) { if (xb_ld(&(bar)[XB_TMO])) break; if (_sp > XB_SPIN_CAP) { atomicAdd(&(bar)[XB_TMO], 1u); break; } } } } while (0)

struct XcdBarrier { unsigned* bar; unsigned x; volatile LAS unsigned* st; };

__device__ __forceinline__ XcdBarrier xcd_barrier_post(unsigned* bar, volatile LAS unsigned* st) {
    XcdBarrier b; b.bar = bar; b.x = xb_xcc_id(); b.st = st;
    if (threadIdx.x == 0) (void)xb_add(&bar[XB_XCNT(b.x)], 1u);
    return b;
}
__device__ __forceinline__ void xcd_barrier_complete(unsigned* bar, unsigned x, unsigned& nloc, unsigned& nx) {
    const unsigned G = gridDim.x * gridDim.y * gridDim.z;
    unsigned sum, cnt, mine, sp = 0u;
    for (;;) {
        sum = 0u; cnt = 0u; mine = 0u;
#pragma unroll
        for (unsigned j = 0; j < 16; ++j) { const unsigned c = xb_ld(&bar[XB_XCNT(j)]); sum += c; cnt += (c > 0u) ? 1u : 0u; mine = (j == x) ? c : mine; }
        if (sum == G) break;
        __builtin_amdgcn_s_sleep(1);
        if ((++sp & 255u) == 0u) { if (xb_ld(&bar[XB_TMO])) break; if (sp > XB_SPIN_CAP) { atomicAdd(&bar[XB_TMO], 1u); break; } }
    }
    nloc = mine > 0u ? mine : 1u; nx = cnt > 0u ? cnt : 1u;
}
__device__ __forceinline__ void xcd_barrier(const XcdBarrier& b) {
    asm volatile("s_waitcnt vmcnt(0)" ::: "memory");
    __syncthreads();
    if (threadIdx.x == 0) {
        unsigned* bar = b.bar;
        __builtin_amdgcn_s_waitcnt(0);
        unsigned nloc = b.st[0], nx = b.st[1];
        if (nloc == 0u) { xcd_barrier_complete(bar, b.x, nloc, nx); b.st[0] = nloc; b.st[1] = nx; }
        const unsigned old = xb_add(&bar[XB_XSUB(b.x)], 1u);
        const unsigned gen = old / nloc;
        if (old + 1u == (gen + 1u) * nloc) {
            __builtin_amdgcn_fence(__ATOMIC_RELEASE, "agent");
            asm volatile("s_waitcnt vmcnt(0)" ::: "memory");
            const unsigned og = xb_add(&bar[XB_TOP], 1u);
            const unsigned tg = og / nx;
            if (og + 1u == (tg + 1u) * nx) xb_add(&bar[XB_TOPGEN], 1u);
            else XB_SPIN(xb_ld(&bar[XB_TOPGEN]) == tg, bar);
            __builtin_amdgcn_fence(__ATOMIC_ACQUIRE, "agent");
            xb_add(&bar[XB_XGEN(b.x)], 1u);
            asm volatile("s_waitcnt vmcnt(0)" ::: "memory");
        } else {
            XB_SPIN(xb_ld(&bar[XB_XGEN(b.x)]) == gen, bar);
            __builtin_amdgcn_fence(__ATOMIC_ACQUIRE, "agent");
            asm volatile("s_waitcnt vmcnt(0)" ::: "memory");
        }
    }
    __syncthreads();
}

namespace pg8 {
constexpr int BM = 256, BK = 64, HALF = 128, HTB = HALF * BK * 2, STAGE_BYTES = 8 * HTB, NXCD = 8, WGM = 8, MAXU = 32;
__host__ __device__ __forceinline__ int lds_byte(int r, int c) { const int st = (r >> 4) * 2 + (c >> 5), rr = r & 15, cc = c & 31, ob = rr * 64 + cc * 2; return st * 1024 + (ob ^ (((ob >> 9) & 1) << 5)); }
__host__ __device__ __forceinline__ void stage_rc(int b, int& R, int& C) { const int st = b / 1024, sb = b % 1024, swz = sb ^ (((sb >> 9) & 1) << 5); R = (st >> 1) * 16 + swz / 64; C = (st & 1) * 32 + (swz % 64) / 2; }
__host__ __device__ __forceinline__ int perm32(int rho) { const int n = rho >> 4, i = rho & 15; return 8 * (i >> 2) + 4 * n + (i & 3); }

struct Unit { int pm, pn, e, rowbase, cnt; unsigned boff; int gidx; };

__device__ __forceinline__ bool tile_of(long L, int nM, int nN, int& gm, int& pn) {
    const int nwg = nM * nN; if (L >= nwg) return false;
    int wgid = (int)L; { const int q = nwg / NXCD, r = nwg % NXCD, xcd = wgid % NXCD, off = wgid / NXCD; wgid = (xcd < r ? xcd * (q + 1) : r * (q + 1) + (xcd - r) * q) + off; }
    const int nig = WGM * nN, gid = wgid / nig, fm = gid * WGM, gsz = (nM - fm) < WGM ? (nM - fm) : WGM;
    gm = fm + ((wgid % nig) % gsz); pn = (wgid % nig) / gsz; return true;
}
__device__ __forceinline__ void build_units_dense(const int i, LAS int* ul, int nM, int nN, int RB) {
    if (i < MAXU) { int gm = 0, pn = 0; const bool ok = tile_of((long)i * gridDim.x + blockIdx.x, nM, nN, gm, pn);
        ul[i * 8 + 0] = ok ? 1 : 0; ul[i * 8 + 1] = gm; ul[i * 8 + 2] = pn; ul[i * 8 + 3] = 0; ul[i * 8 + 4] = gm * BM; ul[i * 8 + 5] = BM; ul[i * 8 + 6] = (int)((unsigned)pn * BM * (unsigned)RB); ul[i * 8 + 7] = 0; }
    __syncthreads();
}
__device__ __forceinline__ void build_units_moe(const int i, LAS int* ul, const LAS int* tpre, const LAS int* ebase, const LAS int* ecnt, int nN, int RB, unsigned wstride) {
    if (i < MAXU) { int gm = 0, pn = 0; const bool ok = tile_of((long)i * gridDim.x + blockIdx.x, tpre[NE], nN, gm, pn);
        int e = 0;
_Pragma("unroll 1")
        for (int s = 16; s >= 1; s >>= 1) { if (e + s < NE && tpre[e + s] <= gm) e += s; }
        const int pm = gm - tpre[e];
        ul[i * 8 + 0] = ok ? 1 : 0; ul[i * 8 + 1] = pm; ul[i * 8 + 2] = pn; ul[i * 8 + 3] = e; ul[i * 8 + 4] = ebase[e] + pm * BM; ul[i * 8 + 5] = ecnt[e] - pm * BM;
        ul[i * 8 + 6] = (int)((unsigned)e * wstride + (unsigned)pn * BM * (unsigned)RB); ul[i * 8 + 7] = e * ECAP + pm * BM; }
    __syncthreads();
}
__device__ __forceinline__ bool ld_unit(const LAS int* ul, int i, Unit& u) {
    if (i >= MAXU) return false;
    const LAS int* p = ul + i * 8;
    if (__builtin_amdgcn_readfirstlane(p[0]) == 0) return false;
    u.pm = __builtin_amdgcn_readfirstlane(p[1]); u.pn = __builtin_amdgcn_readfirstlane(p[2]); u.e = __builtin_amdgcn_readfirstlane(p[3]); u.rowbase = __builtin_amdgcn_readfirstlane(p[4]);
    u.cnt = __builtin_amdgcn_readfirstlane(p[5]); u.boff = (unsigned)__builtin_amdgcn_readfirstlane(p[6]); u.gidx = __builtin_amdgcn_readfirstlane(p[7]); return true;
}
__device__ __forceinline__ void glds16(const char* sbase, unsigned voff, LAS unsigned char* dst) {
    asm volatile("" : "+s"(sbase));
    __builtin_amdgcn_global_load_lds((const unsigned*)(sbase + voff), (LAS unsigned*)dst, 16, 0, 0);
}
template <bool GATHER> __device__ __forceinline__ void stage_a(LAS unsigned char* dst, const char* sbase, unsigned o0, unsigned o1, size_t r64) {
    glds16(sbase, o0, dst);
    if constexpr (GATHER) glds16(sbase, o1, dst + 8192);
    else glds16(sbase + r64, o0, dst + 8192);
}

typedef int v8i __attribute__((ext_vector_type(8)));
typedef int v4i __attribute__((ext_vector_type(4)));
__device__ __forceinline__ v8i cat_frag(const bf16x8& a, const bf16x8& b) { return __builtin_shufflevector(__builtin_bit_cast(v4i, a), __builtin_bit_cast(v4i, b), 0, 1, 2, 3, 4, 5, 6, 7); }
template <class Epi, bool GATHER, bool ALIGN_EPI, bool FP8>
__device__ __forceinline__ void gemm_phase(const int tid, LAS unsigned char* lds, const LAS int* ul, LAS int* gtab, const char* Abase, const char* Bbase, const int* rowdst, const int RB, const Epi& E, LAS unsigned char* epl = nullptr) {
    const int wid = __builtin_amdgcn_readfirstlane(tid >> 6), lane = tid & 63, wr = wid >> 2, wc = wid & 3, fr = lane & 15, fq = lane >> 4;
    const int nt = RB / 128;
    int R0, C0; stage_rc(tid * 16, R0, C0);
    const int Rb0 = Epi::PERM ? ((R0 & ~31) + perm32(R0 & 31)) : R0;
    const unsigned voffB = (unsigned)(Rb0 * RB + C0 * 2);
    const unsigned cb0 = (unsigned)C0 * 2u, K2 = (unsigned)RB;
    const size_t kstep = (size_t)128;
    const size_t r64 = (size_t)64 * RB;
    const size_t hstep = (size_t)HALF * RB;
    const unsigned ldsw = (unsigned)wid * 1024u;
    const int aoff = lds_byte(wr * 64 + fr, fq * 8), boff = lds_byte(wc * 32 + fr, fq * 8);
#define PG8_SA(b, h) (((b) * 2 + (h)) * HTB)
#define PG8_SB(b, h) ((4 + (b) * 2 + (h)) * HTB)
#define PG8_STAGE(bufoff, gbase) do { glds16((const char*)(gbase), voffB, lds + (bufoff) + ldsw); glds16((const char*)(gbase) + r64, voffB, lds + (bufoff) + ldsw + 8192); } while (0)
#define PG8_STAGEA0(bufoff, kb, o0, o1) stage_a<GATHER>(lds + (bufoff) + ldsw, Abase + (kb), o0, o1, r64)
#define PG8_STAGEA1(bufoff, kb, o0, o2, o3) stage_a<GATHER>(lds + (bufoff) + ldsw, Abase + (kb) + (GATHER ? (size_t)0 : hstep), GATHER ? (o2) : (o0), o3, r64)
#define PG8_LDA(dst, b, h) do { _Pragma("unroll") for (int m = 0; m < 4; ++m) { const v4i _l = *(const LAS v4i*)(lds + PG8_SA(b, h) + aoff + m * 2048), _h = *(const LAS v4i*)(lds + PG8_SA(b, h) + aoff + m * 2048 + 1024); dst[m] = __builtin_shufflevector(_l, _h, 0, 1, 2, 3, 4, 5, 6, 7); } } while (0)
#define PG8_LDB(dst, b, h) do { _Pragma("unroll") for (int n = 0; n < 2; ++n) { const v4i _l = *(const LAS v4i*)(lds + PG8_SB(b, h) + boff + n * 2048), _h = *(const LAS v4i*)(lds + PG8_SB(b, h) + boff + n * 2048 + 1024); dst[n] = __builtin_shufflevector(_l, _h, 0, 1, 2, 3, 4, 5, 6, 7); } } while (0)
#define PG8_LO(x) __builtin_bit_cast(bf16x8, __builtin_shufflevector(x, x, 0, 1, 2, 3))
#define PG8_HI(x) __builtin_bit_cast(bf16x8, __builtin_shufflevector(x, x, 4, 5, 6, 7))
#define PG8_MMA(ai, bj, At, Bt) do { __builtin_amdgcn_s_setprio(1); _Pragma("unroll") for (int m = 0; m < 4; ++m) _Pragma("unroll") for (int n = 0; n < 2; ++n) { \
        if constexpr (FP8) asm volatile("v_mfma_scale_f32_16x16x128_f8f6f4 %0, %1, %2, %0, %3, %3 op_sel_hi:[0,0,0]" : "+v"(acc[ai][bj][m][n]) : "v"(Bt[n]), "v"(At[m]), "v"(sc1)); \
        else { acc[ai][bj][m][n] = __builtin_amdgcn_mfma_f32_16x16x32_bf16(PG8_LO(Bt[n]), PG8_LO(At[m]), acc[ai][bj][m][n], 0, 0, 0); \
               acc[ai][bj][m][n] = __builtin_amdgcn_mfma_f32_16x16x32_bf16(PG8_HI(Bt[n]), PG8_HI(At[m]), acc[ai][bj][m][n], 0, 0, 0); } } \
        __builtin_amdgcn_s_setprio(0); } while (0)
#define PG8_WAIT_V(n) asm volatile("s_waitcnt vmcnt(" #n ")" ::: "memory")
#define PG8_WAIT_L(n) asm volatile("s_waitcnt lgkmcnt(" #n ")" ::: "memory")
#define PG8_BAR __builtin_amdgcn_s_barrier()
#define PG8_SCHED __builtin_amdgcn_sched_barrier(0)
    Unit cur, nxt; int ui = 0;
    if (!ld_unit(ul, 0, cur)) return;
    f32x4 acc[2][2][4][2];
#pragma unroll
    for (int a = 0; a < 2; ++a)
#pragma unroll
        for (int b = 0; b < 2; ++b)
#pragma unroll
            for (int m = 0; m < 4; ++m)
#pragma unroll
                for (int n = 0; n < 2; ++n) acc[a][b][m][n] = (f32x4){0.f, 0.f, 0.f, 0.f};
    v8i At[4], B0[2], B1[2];
    const int sc1 = 0x7f7f7f7f;
    unsigned oA0, oA1 = 0, oA2 = 0, oA3 = 0, oN0, oN1 = 0, oN2 = 0, oN3 = 0;
    if constexpr (GATHER) {
        oA0 = (unsigned)gtab[R0] * K2 + cb0; oA1 = (unsigned)gtab[R0 + 64] * K2 + cb0; oA2 = (unsigned)gtab[R0 + 128] * K2 + cb0; oA3 = (unsigned)gtab[R0 + 192] * K2 + cb0;
    } else {
        oA0 = (unsigned)(cur.rowbase + R0) * K2 + cb0;
    }
    oN0 = oA0; oN1 = oA1; oN2 = oA2; oN3 = oA3;
    const char* cB = Bbase + cur.boff;
    PG8_STAGE(PG8_SB(0, 0), cB); PG8_STAGE(PG8_SB(0, 1), cB + hstep); PG8_STAGEA0(PG8_SA(0, 0), (size_t)0, oA0, oA1); PG8_STAGEA1(PG8_SA(0, 1), (size_t)0, oA0, oA2, oA3);
    if (wr == 1) PG8_BAR;
    PG8_WAIT_V(2); PG8_BAR;
    PG8_STAGE(PG8_SB(1, 0), cB + kstep); PG8_STAGEA0(PG8_SA(1, 0), kstep, oA0, oA1); PG8_STAGE(PG8_SB(1, 1), cB + hstep + kstep);
    PG8_WAIT_V(6); PG8_BAR;
    for (;;) {
        const bool has_next = ld_unit(ul, ui + 1, nxt);
        if constexpr (Epi::HAS_PRE) E.pre(cur, epl + (ui & 1) * Epi::PRE_BYTES, wid, lane);
        const char* nB = has_next ? Bbase + nxt.boff : cB;
_Pragma("unroll 1")
        for (int t = 0; t < nt; t += 2) {
            const bool last = (t == nt - 2);
            if (last && has_next) {
                if constexpr (GATHER) {
                    const LAS int* gt = gtab + (ui + 1) * 256;
                    oN0 = (unsigned)gt[R0] * K2 + cb0; oN1 = (unsigned)gt[R0 + 64] * K2 + cb0; oN2 = (unsigned)gt[R0 + 128] * K2 + cb0; oN3 = (unsigned)gt[R0 + 192] * K2 + cb0;
                } else {
                    oN0 = (unsigned)(nxt.rowbase + R0) * K2 + cb0;
                }
            }
            const size_t kb1 = (size_t)(t + 1) * kstep;
            const size_t kb2 = last ? (size_t)0 : (size_t)(t + 2) * kstep, kb3 = kb2 + kstep;
            const unsigned p0 = last ? oN0 : oA0, p1 = last ? oN1 : oA1, p2 = last ? oN2 : oA2, p3 = last ? oN3 : oA3;
            const char* b2 = last ? nB : cB + (size_t)(t + 2) * kstep; const char* b3 = b2 + kstep;
            PG8_LDB(B0, 0, 0); PG8_LDB(B1, 0, 1); PG8_SCHED; PG8_LDA(At, 0, 0); PG8_STAGEA1(PG8_SA(1, 1), kb1, oA0, oA2, oA3);
            PG8_WAIT_V(8); PG8_WAIT_L(0); PG8_BAR; PG8_MMA(0, 0, At, B0); PG8_MMA(0, 1, At, B1); PG8_BAR; PG8_SCHED;
            PG8_LDA(At, 0, 1); PG8_STAGE(PG8_SB(0, 0), b2); PG8_STAGE(PG8_SB(0, 1), b2 + hstep); PG8_STAGEA0(PG8_SA(0, 0), kb2, p0, p1);
            PG8_WAIT_V(8); PG8_WAIT_L(0); PG8_BAR; PG8_MMA(1, 0, At, B0); PG8_MMA(1, 1, At, B1); PG8_BAR; PG8_SCHED;
            PG8_LDB(B0, 1, 0); PG8_LDB(B1, 1, 1); PG8_SCHED; PG8_LDA(At, 1, 0); PG8_STAGEA1(PG8_SA(0, 1), kb2, p0, p2, p3);
            PG8_WAIT_V(8); PG8_WAIT_L(0); PG8_BAR; PG8_MMA(0, 0, At, B0); PG8_MMA(0, 1, At, B1); PG8_BAR; PG8_SCHED;
            PG8_LDA(At, 1, 1); PG8_STAGE(PG8_SB(1, 0), b3); PG8_STAGE(PG8_SB(1, 1), b3 + hstep); PG8_STAGEA0(PG8_SA(1, 0), kb3, p0, p1);
            PG8_WAIT_V(8); PG8_WAIT_L(0); PG8_BAR; PG8_MMA(1, 0, At, B0); PG8_MMA(1, 1, At, B1); PG8_BAR; PG8_SCHED;
        }
        if constexpr (FP8) asm volatile("s_nop 7\n\ts_nop 7\n\ts_nop 7" ::: "memory");
        if constexpr (ALIGN_EPI) { if (wr == 0) PG8_BAR; }
        if constexpr (Epi::HAS_PRE) E(acc, cur, wr, wc, fr, fq, epl + (ui & 1) * Epi::PRE_BYTES); else E(acc, cur, wr, wc, fr, fq);
#if PROBE_EPI2
        if constexpr (FP8) { if constexpr (Epi::HAS_PRE) E(acc, cur, wr, wc, fr, fq, epl + (ui & 1) * Epi::PRE_BYTES); else E(acc, cur, wr, wc, fr, fq); }
#endif
        if (!has_next) break;
#pragma unroll
        for (int a = 0; a < 2; ++a)
#pragma unroll
            for (int b = 0; b < 2; ++b)
#pragma unroll
                for (int m = 0; m < 4; ++m)
#pragma unroll
                    for (int n = 0; n < 2; ++n) acc[a][b][m][n] = (f32x4){0.f, 0.f, 0.f, 0.f};
        cur = nxt; cB = nB; oA0 = oN0; oA1 = oN1; oA2 = oN2; oA3 = oN3; ++ui;
        if constexpr (ALIGN_EPI) { if (wr == 1) PG8_BAR; }
    }
    PG8_WAIT_V(0);
    if constexpr (!ALIGN_EPI) { if (wr == 0) PG8_BAR; }
    PG8_BAR;
#undef PG8_SA
#undef PG8_SB
#undef PG8_STAGE
#undef PG8_STAGEA0
#undef PG8_STAGEA1
#undef PG8_LDA
#undef PG8_LDB
#undef PG8_LO
#undef PG8_HI
#undef PG8_MMA
#undef PG8_WAIT_V
#undef PG8_WAIT_L
#undef PG8_BAR
#undef PG8_SCHED
}

__device__ __forceinline__ GAS unsigned char* launder(unsigned char* p) { asm volatile("" : "+s"(p)); return (GAS unsigned char*)p; }
#define OPAQUE_LANE(fr, fq) asm volatile("" : "+v"(fr), "+v"(fq))
struct EpiHgrnIn {
    static constexpr bool PERM = true, HAS_PRE = true; static constexpr int PRE_BYTES = 1024;
    unsigned char* ws0; int L;
    __device__ __forceinline__ void pre(const Unit& u, LAS unsigned char* buf, int wid, int lane) const {
        if (wid == 0 && u.pn < 8) glds16((const char*)(ws0 + WS_LBS) + ((size_t)L * DM + (size_t)u.pn * HG_K) * 4, (unsigned)lane * 16u, buf);
    }
    __device__ __forceinline__ void operator()(const f32x4 (&acc)[2][2][4][2], const Unit& u, int wr, int wc, int fr, int fq, const LAS unsigned char* buf) const {
        OPAQUE_LANE(fr, fq);
        GAS unsigned char* ws = launder(ws0);
        GAS bf16* QD = (GAS bf16*)(ws + WS_H);
        const int row0 = u.rowbase + wr * 64 + fr;
        if (u.pn >= 8) {
            const bool isg = u.pn >= 12; GAS bf16* base = QD + (size_t)(isg ? 4 : 3) * NTOK * DM; const int colt = (u.pn - (isg ? 12 : 8)) * BM + wc * 32 + 8 * fq;
#pragma unroll
            for (int ai = 0; ai < 2; ++ai)
#pragma unroll
                for (int m = 0; m < 4; ++m) { GAS bf16* rowp = base + (size_t)(row0 + ai * HALF + m * 16) * DM + colt;
#pragma unroll
                    for (int bj = 0; bj < 2; ++bj) { f32x4 v0 = acc[ai][bj][m][0], v1 = acc[ai][bj][m][1];
                        if (isg) {
#pragma unroll
                            for (int j = 0; j < 4; ++j) { v0[j] = v0[j] * fsigmoid(v0[j]); v1[j] = v1[j] * fsigmoid(v1[j]); } }
                        v4u w; w.x = cvt_pk_bf16(v0[0], v0[1]); w.y = cvt_pk_bf16(v0[2], v0[3]); w.z = cvt_pk_bf16(v1[0], v1[1]); w.w = cvt_pk_bf16(v1[2], v1[3]);
                        *(GAS v4u*)(rowp + bj * HALF) = w; } }
            return;
        }
        const int col = u.pn * HG_K + wc * 32 + 8 * fq;
        const LAS float* lb = (const LAS float*)buf + wc * 32 + 8 * fq;
        const f32x4 lb0 = *(const LAS f32x4*)lb, lb1 = *(const LAS f32x4*)(lb + 4);
#if !SLOW_HGRN
        const int lane = fq * 16 + fr;
        GAS float* DEC = (GAS float*)(ws + WS_DEC);
#endif
#pragma unroll
        for (int ai = 0; ai < 2; ++ai)
#pragma unroll
            for (int m = 0; m < 4; ++m) {
                const int row = row0 + ai * HALF + m * 16;
                float qd[8], ki[8];
#if SLOW_HGRN
                float ks[8];
#endif
#if !SLOW_HGRN
                float de[8];
#endif
#pragma unroll
                for (int j = 0; j < 8; ++j) {
                    const float q = acc[ai][0][m][j >> 2][j & 3], f = acc[ai][1][m][j >> 2][j & 3], lbv = j < 4 ? lb0[j & 3] : lb1[j & 3];
                    const float sg = fsigmoid(f), fg = lbv + (1.0f - lbv) * sg, kk = (1.0f - lbv) * (1.0f - sg);
#if SLOW_HGRN
                    qd[j] = q * fsigmoid(q); ki[j] = kk; ks[j] = fg;
#else
                    float P = fg;
                    P *= __builtin_bit_cast(float, __builtin_amdgcn_update_dpp(0x3f800000, __builtin_bit_cast(int, P), 0x111, 0xf, 0xf, false));
                    P *= __builtin_bit_cast(float, __builtin_amdgcn_update_dpp(0x3f800000, __builtin_bit_cast(int, P), 0x112, 0xf, 0xf, false));
                    P *= __builtin_bit_cast(float, __builtin_amdgcn_update_dpp(0x3f800000, __builtin_bit_cast(int, P), 0x114, 0xf, 0xf, false));
                    P *= __builtin_bit_cast(float, __builtin_amdgcn_update_dpp(0x3f800000, __builtin_bit_cast(int, P), 0x118, 0xf, 0xf, false));
                    const float Pl = __shfl(P, lane | 15), iP = frcp(fmaxf(P, 1e-30f));
                    qd[j] = q * fsigmoid(q) * P; ki[j] = kk * iP; de[j] = Pl;
#endif
                }
                const size_t o = (size_t)row * DM + col;
                v4u w;
                w.x = cvt_pk_bf16(qd[0], qd[1]); w.y = cvt_pk_bf16(qd[2], qd[3]); w.z = cvt_pk_bf16(qd[4], qd[5]); w.w = cvt_pk_bf16(qd[6], qd[7]); *(GAS v4u*)(QD + o) = w;
                w.x = cvt_pk_bf16(ki[0], ki[1]); w.y = cvt_pk_bf16(ki[2], ki[3]); w.z = cvt_pk_bf16(ki[4], ki[5]); w.w = cvt_pk_bf16(ki[6], ki[7]); *(GAS v4u*)(QD + (size_t)NTOK * DM + o) = w;
#if SLOW_HGRN
                w.x = cvt_pk_bf16(ks[0], ks[1]); w.y = cvt_pk_bf16(ks[2], ks[3]); w.z = cvt_pk_bf16(ks[4], ks[5]); w.w = cvt_pk_bf16(ks[6], ks[7]); *(GAS v4u*)(QD + 2 * (size_t)NTOK * DM + o) = w;
#endif
#if !SLOW_HGRN
                if (fr == 0) { GAS float* dp = DEC + (size_t)(row >> 4) * DM + col; *(GAS f32x4*)dp = (f32x4){de[0], de[1], de[2], de[3]}; *(GAS f32x4*)(dp + 4) = (f32x4){de[4], de[5], de[6], de[7]}; }
#endif
            }
    }
};
struct EpiRetIn {
    static constexpr bool PERM = true, HAS_PRE = false; static constexpr int PRE_BYTES = 0;
    unsigned char* ws0;
    __device__ __forceinline__ void operator()(const f32x4 (&acc)[2][2][4][2], const Unit& u, int wr, int wc, int fr, int fq) const {
        OPAQUE_LANE(fr, fq);
        GAS unsigned char* ws = launder(ws0);
        GAS bf16* H = (GAS bf16*)(ws + WS_H); const GAS float* rot = (const GAS float*)(ws + WS_ROT);
        const int row0 = u.rowbase + wr * 64 + fr; const int colt = u.pn * BM + wc * 32 + 8 * fq;
        const int kind = u.pn < 4 ? 0 : (u.pn < 8 ? 1 : (u.pn < 16 ? 2 : 3));
#pragma unroll
        for (int ai = 0; ai < 2; ++ai)
#pragma unroll
            for (int m = 0; m < 4; ++m) { const int row = row0 + ai * HALF + m * 16; GAS bf16* rowp = H + (size_t)row * RT_IN + colt; const int pos = row & (SEQ - 1);
#pragma unroll
                for (int bj = 0; bj < 2; ++bj) { f32x4 v0 = acc[ai][bj][m][0], v1 = acc[ai][bj][m][1];
                    if (kind <= 1) {
                        const int p0 = (bj * HALF + wc * 32 + 8 * fq) >> 1;
                        const GAS float* rp = rot + ((size_t)pos * 128 + p0) * 2;
                        const f32x4 r0 = *(const GAS f32x4*)rp, r1 = *(const GAS f32x4*)(rp + 4);
                        const float sc = kind == 1 ? 0.0625f : 1.0f;
                        f32x4 o0, o1;
                        o0[0] = (v0[0] * r0[0] - v0[1] * r0[1]) * sc; o0[1] = (v0[1] * r0[0] + v0[0] * r0[1]) * sc;
                        o0[2] = (v0[2] * r0[2] - v0[3] * r0[3]) * sc; o0[3] = (v0[3] * r0[2] + v0[2] * r0[3]) * sc;
                        o1[0] = (v1[0] * r1[0] - v1[1] * r1[1]) * sc; o1[1] = (v1[1] * r1[0] + v1[0] * r1[1]) * sc;
                        o1[2] = (v1[2] * r1[2] - v1[3] * r1[3]) * sc; o1[3] = (v1[3] * r1[2] + v1[2] * r1[3]) * sc;
                        v0 = o0; v1 = o1;
                    } else if (kind == 3) {
#pragma unroll
                        for (int j = 0; j < 4; ++j) { v0[j] = v0[j] * fsigmoid(v0[j]); v1[j] = v1[j] * fsigmoid(v1[j]); }
                    }
                    v4u w; w.x = cvt_pk_bf16(v0[0], v0[1]); w.y = cvt_pk_bf16(v0[2], v0[3]); w.z = cvt_pk_bf16(v1[0], v1[1]); w.w = cvt_pk_bf16(v1[2], v1[3]);
                    *(GAS v4u*)(rowp + bj * HALF) = w; } }
    }
};
struct EpiRes {
    static constexpr bool PERM = true, HAS_PRE = false; static constexpr int PRE_BYTES = 0;
    unsigned char* ws0; int ssoff; float ds;
    __device__ __forceinline__ void operator()(const f32x4 (&acc)[2][2][4][2], const Unit& u, int wr, int wc, int fr, int fq) const {
        OPAQUE_LANE(fr, fq);
        GAS unsigned char* ws = launder(ws0);
        GAS bf16* Y = (GAS bf16*)(ws + WS_Y); const GAS bf16* X = (const GAS bf16*)(ws + WS_XB);
        const int row0 = u.rowbase + wr * 64 + fr, col0 = u.pn * BM + wc * 32 + 8 * fq;
#pragma unroll
        for (int ai = 0; ai < 2; ++ai)
#pragma unroll
            for (int m = 0; m < 4; ++m) { const size_t off = (size_t)(row0 + ai * HALF + m * 16) * DM + col0;
                float rsc = 1.0f;
                if (ssoff >= 0) { const GAS float* sp = (const GAS float*)(ws + WS_SSP) + row0 + ai * HALF + m * 16; float ssum = 0.f;
#pragma unroll
                    for (int hh = 0; hh < HG_HEADS * 2; ++hh) ssum += sp[(size_t)hh * NTOK];
                    rsc = 1.0f / sqrtf(ssum * (1.0f / DM) + RMS_EPS); }
#pragma unroll
                for (int bj = 0; bj < 2; ++bj) { const v4u xs = *(const GAS v4u*)(X + off + bj * HALF); const f32x4 a0 = acc[ai][bj][m][0] * (rsc * ds), a1 = acc[ai][bj][m][1] * (rsc * ds);
                    v4u w; w.x = cvt_pk_bf16(bflo(xs.x) * DN_ALPHA + a0[0], bfhi(xs.x) * DN_ALPHA + a0[1]); w.y = cvt_pk_bf16(bflo(xs.y) * DN_ALPHA + a0[2], bfhi(xs.y) * DN_ALPHA + a0[3]);
                    w.z = cvt_pk_bf16(bflo(xs.z) * DN_ALPHA + a1[0], bfhi(xs.z) * DN_ALPHA + a1[1]); w.w = cvt_pk_bf16(bflo(xs.w) * DN_ALPHA + a1[2], bfhi(xs.w) * DN_ALPHA + a1[3]);
                    *(GAS v4u*)(Y + off + bj * HALF) = w; } }
    }
};
struct EpiMoeGU {
    static constexpr bool PERM = true, HAS_PRE = true; static constexpr int PRE_BYTES = 1024;
    unsigned char* ws0; int L;
    __device__ __forceinline__ void pre(const Unit& u, LAS unsigned char* buf, int wid, int lane) const {
        if (wid == 0) glds16((const char*)(ws0 + WS_BGU) + ((size_t)L * NE * 2048 + ((size_t)u.e * 8 + u.pn) * 256) * 4, (unsigned)lane * 16u, buf);
    }
    __device__ __forceinline__ void operator()(const f32x4 (&acc)[2][2][4][2], const Unit& u, int wr, int wc, int fr, int fq, const LAS unsigned char* buf) const {
        OPAQUE_LANE(fr, fq);
        GAS unsigned char* ws = launder(ws0);
        const int row0 = u.rowbase + wr * 64 + fr; const int c8 = wc * 32 + 8 * fq;
        const LAS float* bp = (const LAS float*)buf + c8;
        constexpr float CS = -2.4554669595930156f, K1 = GU_DESCALE * CS, K2 = GU_DESCALE * ACT_SCALE / CS, GLO = 7.0f * CS, LLO = -6.0f * ACT_SCALE / CS, LHI = 8.0f * ACT_SCALE / CS;
        f32x2 bgc[4], blc[4];
        { const f32x4 bg0 = *(const LAS f32x4*)bp, bg1 = *(const LAS f32x4*)(bp + 4), bl0 = *(const LAS f32x4*)(bp + HALF), bl1 = *(const LAS f32x4*)(bp + HALF + 4);
          bgc[0] = __builtin_shufflevector(bg0, bg0, 0, 1) * CS; bgc[1] = __builtin_shufflevector(bg0, bg0, 2, 3) * CS; bgc[2] = __builtin_shufflevector(bg1, bg1, 0, 1) * CS; bgc[3] = __builtin_shufflevector(bg1, bg1, 2, 3) * CS;
          blc[0] = __builtin_shufflevector(bl0, bl0, 0, 1) * (ACT_SCALE / CS) + (ACT_SCALE / CS); blc[1] = __builtin_shufflevector(bl0, bl0, 2, 3) * (ACT_SCALE / CS) + (ACT_SCALE / CS);
          blc[2] = __builtin_shufflevector(bl1, bl1, 0, 1) * (ACT_SCALE / CS) + (ACT_SCALE / CS); blc[3] = __builtin_shufflevector(bl1, bl1, 2, 3) * (ACT_SCALE / CS) + (ACT_SCALE / CS); }
#pragma unroll
        for (int ai = 0; ai < 2; ++ai)
#pragma unroll
            for (int m = 0; m < 4; ++m) { const size_t eo = (size_t)(row0 + ai * HALF + m * 16) * DM + u.pn * HALF + c8;
                float a[8];
#pragma unroll
                for (int p = 0; p < 4; ++p) {
                    const f32x4 ag4 = acc[ai][0][m][p >> 1], al4 = acc[ai][1][m][p >> 1];
                    const f32x2 ag = (p & 1) ? __builtin_shufflevector(ag4, ag4, 2, 3) : __builtin_shufflevector(ag4, ag4, 0, 1);
                    const f32x2 al = (p & 1) ? __builtin_shufflevector(al4, al4, 2, 3) : __builtin_shufflevector(al4, al4, 0, 1);
                    f32x2 gc = ag * K1 + bgc[p]; gc.x = fmaxf(gc.x, GLO); gc.y = fmaxf(gc.y, GLO);
                    f32x2 lc = al * K2 + blc[p]; lc.x = __builtin_amdgcn_fmed3f(lc.x, LLO, LHI); lc.y = __builtin_amdgcn_fmed3f(lc.y, LLO, LHI);
                    f32x2 d; d.x = __builtin_amdgcn_exp2f(gc.x); d.y = __builtin_amdgcn_exp2f(gc.y); d = d + 1.0f;
                    f32x2 sg; sg.x = frcp(d.x); sg.y = frcp(d.y);
                    const f32x2 r = gc * sg * lc;
                    a[2 * p] = r.x; a[2 * p + 1] = r.y;
                }
#if MOE_FP8
                v2u w;
                { int p = __builtin_amdgcn_cvt_pk_fp8_f32(a[0], a[1], 0, false); p = __builtin_amdgcn_cvt_pk_fp8_f32(a[2], a[3], p, true); w.x = (unsigned)p; }
                { int p = __builtin_amdgcn_cvt_pk_fp8_f32(a[4], a[5], 0, false); p = __builtin_amdgcn_cvt_pk_fp8_f32(a[6], a[7], p, true); w.y = (unsigned)p; }
                *(GAS v2u*)(ws + WS_ACT + eo) = w;
#else
                v4u w; w.x = cvt_pk_bf16(a[0], a[1]); w.y = cvt_pk_bf16(a[2], a[3]); w.z = cvt_pk_bf16(a[4], a[5]); w.w = cvt_pk_bf16(a[6], a[7]);
                *(GAS v4u*)((GAS bf16*)(ws + WS_ACT) + eo) = w;
#endif
            }
    }
};
struct EpiMoeDown {
    static constexpr bool PERM = true, HAS_PRE = true; static constexpr int PRE_BYTES = 3072;
    unsigned char* ws0; const float* bias;
    __device__ __forceinline__ void pre(const Unit& u, LAS unsigned char* buf, int wid, int lane) const {
        if (wid == 0) glds16((const char*)(bias + (size_t)u.e * DM + u.pn * BM), (unsigned)lane * 16u, buf);
        if (wid == 1) glds16((const char*)(ws0 + WS_ROWDST) + (size_t)u.gidx * 4, (unsigned)lane * 16u, buf + 1024);
        if (wid == 2) glds16((const char*)(ws0 + WS_ROWGATE) + (size_t)u.gidx * 4, (unsigned)lane * 16u, buf + 2048);
    }
    __device__ __forceinline__ void operator()(const f32x4 (&acc)[2][2][4][2], const Unit& u, int wr, int wc, int fr, int fq, const LAS unsigned char* buf) const {
        OPAQUE_LANE(fr, fq);
        GAS unsigned char* ws = launder(ws0);
        GAS bf16* YS = (GAS bf16*)(ws + WS_YSLOT);
        const int c8 = u.pn * BM + wc * 32 + 8 * fq;
        const LAS float* bp = (const LAS float*)buf + wc * 32 + 8 * fq;
        f32x4 bv[2][2];
#pragma unroll
        for (int bj = 0; bj < 2; ++bj) { bv[bj][0] = *(const LAS f32x4*)(bp + bj * HALF); bv[bj][1] = *(const LAS f32x4*)(bp + bj * HALF + 4); }
#pragma unroll
        for (int ai = 0; ai < 2; ++ai)
#pragma unroll
            for (int m = 0; m < 4; ++m) { const int r = ai * HALF + wr * 64 + m * 16 + fr;
                if (r < u.cnt) {
                    const int dst = ((const LAS int*)(buf + 1024))[r]; const float gt = ((const LAS float*)(buf + 2048))[r];
#if YS_FP8
                    GAS unsigned char* rowp = (GAS unsigned char*)YS + (size_t)dst * DM + c8;
#pragma unroll
                    for (int bj = 0; bj < 2; ++bj) { const f32x4 v0 = (acc[ai][bj][m][0] * DN_DESCALE + bv[bj][0]) * (gt * 64.0f), v1 = (acc[ai][bj][m][1] * DN_DESCALE + bv[bj][1]) * (gt * 64.0f);
                        v2u w; w.x = pk4_fp8(v0[0], v0[1], v0[2], v0[3]); w.y = pk4_fp8(v1[0], v1[1], v1[2], v1[3]);
                        *(GAS v2u*)(rowp + bj * HALF) = w; } } }
#else
                    GAS bf16* rowp = YS + (size_t)dst * DM + c8;
#pragma unroll
                    for (int bj = 0; bj < 2; ++bj) { const f32x4 v0 = (acc[ai][bj][m][0] * DN_DESCALE + bv[bj][0]) * gt, v1 = (acc[ai][bj][m][1] * DN_DESCALE + bv[bj][1]) * gt;
                        v4u w; w.x = cvt_pk_bf16(v0[0], v0[1]); w.y = cvt_pk_bf16(v0[2], v0[3]); w.z = cvt_pk_bf16(v1[0], v1[1]); w.w = cvt_pk_bf16(v1[2], v1[3]);
                        *(GAS v4u*)(rowp + bj * HALF) = w; } } }
#endif
    }
};
}

typedef short s16x4 __attribute__((ext_vector_type(4)));
typedef __bf16 bf16x2_t __attribute__((ext_vector_type(2)));
__device__ __forceinline__ unsigned cvtpk(float lo, float hi) { f32x2 v = {lo, hi}; bf16x2_t b = __builtin_convertvector(v, bf16x2_t); return __builtin_bit_cast(unsigned, b); }
__device__ __forceinline__ s16x4 tr_read(const LAS unsigned char* p) { return __builtin_bit_cast(s16x4, __builtin_amdgcn_ds_read_tr16_b64_v4i16((LAS s16x4*)p)); }
__device__ __forceinline__ bf16x8 cat8(s16x4 lo, s16x4 hi) { return __builtin_shufflevector(lo, hi, 0, 1, 2, 3, 4, 5, 6, 7); }
__device__ __forceinline__ bf16x8 pack8(const f32x4& a, const f32x4& b) { v4u p; p.x = cvtpk(a[0], a[1]); p.y = cvtpk(a[2], a[3]); p.z = cvtpk(b[0], b[1]); p.w = cvtpk(b[2], b[3]); return __builtin_bit_cast(bf16x8, p); }
__device__ __forceinline__ s16x4 pack4(const f32x4& a) { v2u p; p.x = cvtpk(a[0], a[1]); p.y = cvtpk(a[2], a[3]); return __builtin_bit_cast(s16x4, p); }
#define LDS_BARRIER() do { asm volatile("s_waitcnt lgkmcnt(0)" ::: "memory"); __builtin_amdgcn_s_barrier(); asm volatile("" ::: "memory"); } while (0)
#define MFMA32(a, b, c) __builtin_amdgcn_mfma_f32_16x16x32_bf16((a), (b), (c), 0, 0, 0)
#define MFMA16(a, b, c) __builtin_amdgcn_mfma_f32_16x16x16bf16_1k((a), (b), (c), 0, 0, 0)

__device__ __forceinline__ void ret_fast(const int tid, LAS unsigned char* lds, const bf16* HB, bf16* OB) {
    constexpr int QP = 528, VP = 272, PP = 144;
    constexpr int OFF_Q = 0, OFF_K = 64 * QP, OFF_V = 2 * 64 * QP, OFF_P = OFF_V + 64 * VP;
    const int lane0 = tid & 63, w = __builtin_amdgcn_readfirstlane(tid >> 6);
    const int prow = tid >> 3, pc = tid & 7;
    for (int un0 = blockIdx.x; un0 < NBATCH * RT_HEADS * 4; un0 += gridDim.x) {
        const int un = (gridDim.x == 256) ? ((un0 & 7) * 32 + (un0 >> 3)) : un0;
        const int b = un >> 4, h = (un >> 2) & 3, vs = un & 3;
        const float l2g = __builtin_amdgcn_logf(1.0f - __builtin_amdgcn_exp2f(-5.0f - (float)h));
        const float dC = __builtin_amdgcn_exp2f(64.0f * l2g);
        f32x4 st[16];
#pragma unroll
        for (int i = 0; i < 16; ++i) st[i] = (f32x4){0.f, 0.f, 0.f, 0.f};
        const bf16* gbase = HB + (size_t)(b * SEQ + prow) * RT_IN;
        v4u pq[4], pk[4], pv[2];
#pragma unroll
        for (int j = 0; j < 4; ++j) { pq[j] = *(const v4u*)(gbase + h * 256 + (pc + 8 * j) * 8); pk[j] = *(const v4u*)(gbase + 1024 + h * 256 + (pc + 8 * j) * 8); }
#pragma unroll
        for (int j = 0; j < 2; ++j) pv[j] = *(const v4u*)(gbase + 2048 + h * 512 + vs * 128 + (pc + 8 * j) * 8);
#pragma unroll 1
        for (int ch = 0; ch < SEQ / 64; ++ch) {
            int lane = lane0; asm volatile("" : "+v"(lane));
            const int r = lane & 15, g = lane >> 4, q4 = (lane & 15) >> 2, p4 = lane & 3;
            LDS_BARRIER();
#pragma unroll
            for (int j = 0; j < 4; ++j) { *(LAS v4u*)(lds + OFF_Q + prow * QP + (pc + 8 * j) * 16) = pq[j]; *(LAS v4u*)(lds + OFF_K + prow * QP + (pc + 8 * j) * 16) = pk[j]; }
#pragma unroll
            for (int j = 0; j < 2; ++j) *(LAS v4u*)(lds + OFF_V + prow * VP + (pc + 8 * j) * 16) = pv[j];
            if (ch + 1 < SEQ / 64) {
                const bf16* gn = gbase + (size_t)(ch + 1) * 64 * RT_IN;
#pragma unroll
                for (int j = 0; j < 4; ++j) { pq[j] = *(const v4u*)(gn + h * 256 + (pc + 8 * j) * 8); pk[j] = *(const v4u*)(gn + 1024 + h * 256 + (pc + 8 * j) * 8); }
#pragma unroll
                for (int j = 0; j < 2; ++j) pv[j] = *(const v4u*)(gn + 2048 + h * 512 + vs * 128 + (pc + 8 * j) * 8);
            }
            LDS_BARRIER();
            {
                const int ct = w >> 1, st0 = 2 * (w & 1);
                f32x4 sa0 = {0.f, 0.f, 0.f, 0.f}, sa1 = {0.f, 0.f, 0.f, 0.f};
                const LAS unsigned char* qb = lds + OFF_Q + (16 * ct + r) * QP + g * 16;
                const LAS unsigned char* kb0 = lds + OFF_K + (16 * st0 + r) * QP + g * 16;
#pragma unroll
                for (int hb = 0; hb < 4; ++hb) {
                    bf16x8 qf[2], k0[2], k1[2];
#pragma unroll
                    for (int kk = 0; kk < 2; ++kk) { const int kb = hb * 2 + kk; qf[kk] = *(const LAS bf16x8*)(qb + kb * 64); k0[kk] = *(const LAS bf16x8*)(kb0 + kb * 64); k1[kk] = *(const LAS bf16x8*)(kb0 + 16 * QP + kb * 64); }
                    asm volatile("" : "+v"(qf[0]), "+v"(qf[1]), "+v"(k0[0]), "+v"(k0[1]), "+v"(k1[0]), "+v"(k1[1]) :: "memory");
#pragma unroll
                    for (int kk = 0; kk < 2; ++kk) { sa0 = MFMA32(k0[kk], qf[kk], sa0); sa1 = MFMA32(k1[kk], qf[kk], sa1); }
                }
                const int c = 16 * ct + r;
#pragma unroll
                for (int t = 0; t < 2; ++t) {
                    const f32x4 sa = t ? sa1 : sa0; const int s0 = 16 * (st0 + t) + 4 * g; float v[4];
#pragma unroll
                    for (int i = 0; i < 4; ++i) { const int d = c - (s0 + i); v[i] = d >= 0 ? sa[i] * __builtin_amdgcn_exp2f((float)d * l2g) : 0.f; }
                    v2u pw; pw.x = cvtpk(v[0], v[1]); pw.y = cvtpk(v[2], v[3]);
                    *(LAS v2u*)(lds + OFF_P + c * PP + s0 * 2) = pw;
                }
            }
            LDS_BARRIER();
            f32x4 o[4];
#pragma unroll
            for (int ct = 0; ct < 4; ++ct) o[ct] = (f32x4){0.f, 0.f, 0.f, 0.f};
            {
                s16x4 ql[2][4], qh[2][4];
                const LAS unsigned char* qp0 = lds + OFF_Q + r * QP + (4 * g) * 2;
#pragma unroll
                for (int ct = 0; ct < 4; ++ct) { ql[0][ct] = *(const LAS s16x4*)(qp0 + ct * 16 * QP); qh[0][ct] = *(const LAS s16x4*)(qp0 + ct * 16 * QP + 32); }
#pragma unroll
                for (int kb = 0; kb < 8; ++kb) {
                    const int cu = kb & 1, nx = cu ^ 1;
                    if (kb + 1 < 8) {
#pragma unroll
                        for (int ct = 0; ct < 4; ++ct) { ql[nx][ct] = *(const LAS s16x4*)(qp0 + ct * 16 * QP + (kb + 1) * 64); qh[nx][ct] = *(const LAS s16x4*)(qp0 + ct * 16 * QP + (kb + 1) * 64 + 32); }
                    }
                    asm volatile("" : "+v"(ql[cu][0]), "+v"(ql[cu][1]), "+v"(ql[cu][2]), "+v"(ql[cu][3]), "+v"(qh[cu][0]), "+v"(qh[cu][1]), "+v"(qh[cu][2]), "+v"(qh[cu][3]) :: "memory");
                    const bf16x8 sa = pack8(st[2 * kb], st[2 * kb + 1]);
#pragma unroll
                    for (int ct = 0; ct < 4; ++ct) o[ct] = MFMA32(sa, cat8(ql[cu][ct], qh[cu][ct]), o[ct]);
                }
            }
            bf16x8 vf[2], pf[6];
            {
                s16x4 t0[2], t1[2];
#pragma unroll
                for (int sb = 0; sb < 2; ++sb) { const LAS unsigned char* vp = lds + OFF_V + (32 * sb + 8 * g + q4) * VP + (16 * w + 4 * p4) * 2; t0[sb] = tr_read(vp); t1[sb] = tr_read(vp + 4 * VP); }
                pf[0] = *(const LAS bf16x8*)(lds + OFF_P + (0 + r) * PP + (8 * g) * 2);
                pf[1] = *(const LAS bf16x8*)(lds + OFF_P + (16 + r) * PP + (8 * g) * 2);
                pf[2] = *(const LAS bf16x8*)(lds + OFF_P + (32 + r) * PP + (8 * g) * 2);
                pf[3] = *(const LAS bf16x8*)(lds + OFF_P + (32 + r) * PP + (32 + 8 * g) * 2);
                pf[4] = *(const LAS bf16x8*)(lds + OFF_P + (48 + r) * PP + (8 * g) * 2);
                pf[5] = *(const LAS bf16x8*)(lds + OFF_P + (48 + r) * PP + (32 + 8 * g) * 2);
                asm volatile("" : "+v"(t0[0]), "+v"(t0[1]), "+v"(t1[0]), "+v"(t1[1]), "+v"(pf[0]), "+v"(pf[1]), "+v"(pf[2]), "+v"(pf[3]), "+v"(pf[4]), "+v"(pf[5]) :: "memory");
                vf[0] = cat8(t0[0], t1[0]); vf[1] = cat8(t0[1], t1[1]);
            }
#pragma unroll
            for (int ct = 0; ct < 4; ++ct) o[ct] = o[ct] * __builtin_amdgcn_exp2f((float)(16 * ct + r + 1) * l2g);
            o[0] = MFMA32(vf[0], pf[0], o[0]); o[1] = MFMA32(vf[0], pf[1], o[1]);
            o[2] = MFMA32(vf[0], pf[2], o[2]); o[2] = MFMA32(vf[1], pf[3], o[2]);
            o[3] = MFMA32(vf[0], pf[4], o[3]); o[3] = MFMA32(vf[1], pf[5], o[3]);
            {
                bf16* ob = OB + (size_t)(b * SEQ + ch * 64 + r) * RT_VD + h * 512 + vs * 128 + 16 * w + 4 * g;
#pragma unroll
                for (int ct = 0; ct < 4; ++ct) { v2u ow; ow.x = cvtpk(o[ct][0], o[ct][1]); ow.y = cvtpk(o[ct][2], o[ct][3]); *(v2u*)(ob + (size_t)ct * 16 * RT_VD) = ow; }
            }
            bf16x8 vz[2];
#pragma unroll
            for (int sb = 0; sb < 2; ++sb) {
                const v4u raw = __builtin_bit_cast(v4u, vf[sb]); float f[8] = {bflo(raw.x), bfhi(raw.x), bflo(raw.y), bfhi(raw.y), bflo(raw.z), bfhi(raw.z), bflo(raw.w), bfhi(raw.w)};
#pragma unroll
                for (int j = 0; j < 8; ++j) f[j] *= __builtin_amdgcn_exp2f((float)(63 - (32 * sb + 8 * g + j)) * l2g);
                v4u z; z.x = cvtpk(f[0], f[1]); z.y = cvtpk(f[2], f[3]); z.z = cvtpk(f[4], f[5]); z.w = cvtpk(f[6], f[7]); vz[sb] = __builtin_bit_cast(bf16x8, z);
            }
            {
                const LAS unsigned char* kp0 = lds + OFF_K + (8 * g + q4) * QP + (4 * p4) * 2;
#pragma unroll
                for (int kq = 0; kq < 4; ++kq) {
                    s16x4 ka[4][2], kbh[4][2];
#pragma unroll
                    for (int j = 0; j < 4; ++j)
#pragma unroll
                        for (int sb = 0; sb < 2; ++sb) { const LAS unsigned char* kp = kp0 + (32 * sb) * QP + (16 * (kq * 4 + j)) * 2; ka[j][sb] = tr_read(kp); kbh[j][sb] = tr_read(kp + 4 * QP); }
                    asm volatile("" : "+v"(ka[0][0]), "+v"(ka[0][1]), "+v"(ka[1][0]), "+v"(ka[1][1]), "+v"(ka[2][0]), "+v"(ka[2][1]), "+v"(ka[3][0]), "+v"(ka[3][1]),
                                      "+v"(kbh[0][0]), "+v"(kbh[0][1]), "+v"(kbh[1][0]), "+v"(kbh[1][1]), "+v"(kbh[2][0]), "+v"(kbh[2][1]), "+v"(kbh[3][0]), "+v"(kbh[3][1]) :: "memory");
#pragma unroll
                    for (int j = 0; j < 4; ++j) { const int kt = kq * 4 + j;
                        st[kt] = st[kt] * dC;
                        st[kt] = MFMA32(cat8(ka[j][0], kbh[j][0]), vz[0], st[kt]);
                        st[kt] = MFMA32(cat8(ka[j][1], kbh[j][1]), vz[1], st[kt]); }
                }
            }
        }
        LDS_BARRIER();
    }
}

__device__ __forceinline__ void hgrn_fast(const int tid, LAS unsigned char* lds, const bf16* QD, const bf16* KI, const bf16* GG, const bf16* VV, const float* DEC, const float* ng, bf16* A2, float* SS) {
    constexpr int TP = 272;
    constexpr int TPH = 144;
    constexpr int OFF_QD = 0, OFF_KI = 64 * TP, OFF_G = 2 * 64 * TP, OFF_V = OFF_G + 64 * TPH, OFF_DEC = OFF_V + 64 * TPH, OFF_SS = OFF_DEC + 2048;
    const int lane = tid & 63, w = __builtin_amdgcn_readfirstlane(tid >> 6), r = lane & 15, g = lane >> 4, q4 = (lane & 15) >> 2, p4 = lane & 3;
    const int prow = tid >> 3, pc = tid & 7;
    for (int un0 = blockIdx.x; un0 < NBATCH * HG_HEADS * 2; un0 += gridDim.x) {
        const int un = (gridDim.x == 256) ? ((((un0 & 7) * 16 + (un0 >> 4)) << 1) | ((un0 >> 3) & 1)) : un0;
        const int b = un >> 4, h = (un >> 1) & 7, vh = un & 1, wv = vh * 4 + (w & 3);
        f32x4 st[8];
#pragma unroll
        for (int i = 0; i < 8; ++i) st[i] = (f32x4){0.f, 0.f, 0.f, 0.f};
        const f32x4 ng4 = *(const f32x4*)(ng + h * 128 + 16 * wv + 4 * g);
        const size_t goff = (size_t)(b * SEQ + prow) * DM + h * 128;
        v4u p0[2], p1[2], p2, p3; f32x4 pd = {0.f, 0.f, 0.f, 0.f};
#pragma unroll
        for (int j = 0; j < 2; ++j) { const size_t o = goff + (pc + 8 * j) * 8; p0[j] = *(const v4u*)(QD + o); p1[j] = *(const v4u*)(KI + o); }
        p2 = *(const v4u*)(GG + goff + vh * 64 + pc * 8); p3 = *(const v4u*)(VV + goff + vh * 64 + pc * 8);
        if (tid < 128) pd = *(const f32x4*)(DEC + (size_t)((b * SEQ) / 16 + (tid >> 5)) * DM + h * 128 + (tid & 31) * 4);
#pragma unroll 1
        for (int rd = 0; rd < SEQ / 64; ++rd) {
            LDS_BARRIER();
            if (rd > 0 && tid < 64) {
                float s = 0.f;
#pragma unroll
                for (int ww = 0; ww < 4; ++ww) s += *(const LAS float*)(lds + OFF_SS + (ww * 64 + tid) * 4);
                SS[(size_t)(h * 2 + vh) * NTOK + (size_t)b * SEQ + (rd - 1) * 64 + tid] = s;
            }
#pragma unroll
            for (int j = 0; j < 2; ++j) { const int lo = prow * TP + (pc + 8 * j) * 16; *(LAS v4u*)(lds + OFF_QD + lo) = p0[j]; *(LAS v4u*)(lds + OFF_KI + lo) = p1[j]; }
            *(LAS v4u*)(lds + OFF_G + prow * TPH + pc * 16) = p2; *(LAS v4u*)(lds + OFF_V + prow * TPH + pc * 16) = p3;
            if (tid < 128) *(LAS f32x4*)(lds + OFF_DEC + tid * 16) = pd;
            if (rd + 1 < SEQ / 64) {
                const size_t gn = goff + (size_t)(rd + 1) * 64 * DM;
#pragma unroll
                for (int j = 0; j < 2; ++j) { const size_t o = gn + (pc + 8 * j) * 8; p0[j] = *(const v4u*)(QD + o); p1[j] = *(const v4u*)(KI + o); }
                p2 = *(const v4u*)(GG + gn + vh * 64 + pc * 8); p3 = *(const v4u*)(VV + gn + vh * 64 + pc * 8);
                if (tid < 128) pd = *(const f32x4*)(DEC + (size_t)((b * SEQ + (rd + 1) * 64) / 16 + (tid >> 5)) * DM + h * 128 + (tid & 31) * 4);
            }
            LDS_BARRIER();
            if (w < 4)
#pragma unroll 1
            for (int cc = 0; cc < 4; ++cc) {
                s16x4 ql[4], qh[4], kl[4], kh[4], ktr[8]; f32x4 d4[8];
#pragma unroll
                for (int kb = 0; kb < 4; ++kb) {
                    const int off = (16 * cc + r) * TP + (32 * kb + 4 * g) * 2;
                    ql[kb] = *(const LAS s16x4*)(lds + OFF_QD + off); qh[kb] = *(const LAS s16x4*)(lds + OFF_QD + off + 32);
                    kl[kb] = *(const LAS s16x4*)(lds + OFF_KI + off); kh[kb] = *(const LAS s16x4*)(lds + OFF_KI + off + 32);
                }
                s16x4 vfr = tr_read(lds + OFF_V + (16 * cc + 4 * g + q4) * TPH + (16 * (w & 3) + 4 * p4) * 2);
                s16x4 gfr = *(const LAS s16x4*)(lds + OFF_G + (16 * cc + r) * TPH + (16 * (w & 3) + 4 * g) * 2);
#pragma unroll
                for (int kt = 0; kt < 8; ++kt) {
                    d4[kt] = *(const LAS f32x4*)(lds + OFF_DEC + cc * 512 + (16 * kt + 4 * g) * 4);
                    ktr[kt] = tr_read(lds + OFF_KI + (16 * cc + 4 * g + q4) * TP + (16 * kt + 4 * p4) * 2);
                }
                asm volatile("" : "+v"(ql[0]), "+v"(ql[1]), "+v"(ql[2]), "+v"(ql[3]), "+v"(qh[0]), "+v"(qh[1]), "+v"(qh[2]), "+v"(qh[3]),
                                  "+v"(kl[0]), "+v"(kl[1]), "+v"(kl[2]), "+v"(kl[3]), "+v"(kh[0]), "+v"(kh[1]), "+v"(kh[2]), "+v"(kh[3]), "+v"(vfr), "+v"(gfr));
                asm volatile("" : "+v"(ktr[0]), "+v"(ktr[1]), "+v"(ktr[2]), "+v"(ktr[3]), "+v"(ktr[4]), "+v"(ktr[5]), "+v"(ktr[6]), "+v"(ktr[7]),
                                  "+v"(d4[0]), "+v"(d4[1]), "+v"(d4[2]), "+v"(d4[3]), "+v"(d4[4]), "+v"(d4[5]), "+v"(d4[6]), "+v"(d4[7]));
                bf16x8 qf[4];
#pragma unroll
                for (int kb = 0; kb < 4; ++kb) qf[kb] = cat8(ql[kb], qh[kb]);
                f32x4 sc = {0.f, 0.f, 0.f, 0.f}, oa = {0.f, 0.f, 0.f, 0.f};
#pragma unroll
                for (int kb = 0; kb < 4; ++kb) sc = MFMA32(cat8(kl[kb], kh[kb]), qf[kb], sc);
#pragma unroll
                for (int kb = 0; kb < 4; ++kb) oa = MFMA32(pack8(st[2 * kb], st[2 * kb + 1]), qf[kb], oa);
#pragma unroll
                for (int kt = 0; kt < 8; ++kt) st[kt] = MFMA16(ktr[kt], vfr, st[kt]) * d4[kt];
#pragma unroll
                for (int i = 0; i < 4; ++i) sc[i] = (4 * g + i <= r) ? sc[i] : 0.f;
                oa = MFMA16(vfr, pack4(sc), oa);
                { const v2u gr = __builtin_bit_cast(v2u, gfr);
                  v2u ow; ow.x = cvtpk(oa[0] * ng4[0] * bflo(gr.x), oa[1] * ng4[1] * bfhi(gr.x)); ow.y = cvtpk(oa[2] * ng4[2] * bflo(gr.y), oa[3] * ng4[3] * bfhi(gr.y));
                  *(v2u*)(A2 + (size_t)(b * SEQ + rd * 64 + cc * 16 + r) * DM + h * 128 + 16 * wv + 4 * g) = ow;
                  float p = (oa[0] * oa[0] + oa[1] * oa[1]) + (oa[2] * oa[2] + oa[3] * oa[3]);
                  p += __shfl_xor(p, 16); p += __shfl_xor(p, 32);
                  if (lane < 16) *(LAS float*)(lds + OFF_SS + (w * 64 + cc * 16 + r) * 4) = p; }
            }
        }
        LDS_BARRIER();
        if (tid < 64) { float s = 0.f;
#pragma unroll
            for (int ww = 0; ww < 4; ++ww) s += *(const LAS float*)(lds + OFF_SS + (ww * 64 + tid) * 4);
            SS[(size_t)(h * 2 + vh) * NTOK + (size_t)b * SEQ + (SEQ / 64 - 1) * 64 + tid] = s; }
        LDS_BARRIER();
    }
}

struct Args { const float* in[17]; float* out; unsigned char* ws; int ph_lo, ph_hi; };
enum { I_X = 0, I_HWIN, I_HNG, I_HWOUT, I_LB, I_RWIN, I_RWOUT, I_LNMG, I_LNMB, I_LNFG, I_LNFB, I_RW, I_RB, I_WGU, I_BGU, I_WDN, I_BDN };

__device__ __forceinline__ int dest_row(int mode, int n) {
    if (mode == 1) { if (n < 1024) return ((n >> 7) << 8) + (n & 127); if (n < 2048) { const int q = n - 1024; return ((q >> 7) << 8) + 128 + (q & 127); } return n; }
    if (mode == 2) { const int j2 = n >> 1; return ((j2 >> 7) << 8) + ((n & 1) << 7) + (j2 & 127); }
    return n;
}
__device__ __forceinline__ void transpose_item(const float* W, int K, int N, bf16* WT, int mode, LAS float* scr, int item, int lane) {
    const int nblk = N / 64, kb = item / nblk, nb = item % nblk, k0 = 64 * kb, n0 = 64 * nb;
#pragma unroll 4
    for (int i = 0; i < 16; ++i) { const int kk = 4 * i + (lane >> 4), c4 = (lane & 15) * 4;
        const f32x4 v = *(const GAS f32x4*)(W + (size_t)(k0 + kk) * N + n0 + c4);
        LAS float* s = scr + kk * 65 + c4; s[0] = v[0]; s[1] = v[1]; s[2] = v[2]; s[3] = v[3]; }
    LDS_WAIT(); asm volatile("" ::: "memory");
    const int c = lane & 7;
#pragma unroll 2
    for (int j = 0; j < 8; ++j) { const int n = (lane >> 3) + 8 * j; const LAS float* s = scr + (8 * c) * 65 + n;
        v4u o; o.x = pk2(s[0 * 65], s[1 * 65]); o.y = pk2(s[2 * 65], s[3 * 65]); o.z = pk2(s[4 * 65], s[5 * 65]); o.w = pk2(s[6 * 65], s[7 * 65]);
        *(GAS v4u*)(WT + (size_t)dest_row(mode, n0 + n) * K + k0 + 8 * c) = o; }
    LDS_WAIT(); asm volatile("" ::: "memory");
}

__device__ __forceinline__ void transpose_item_fp8(const float* W, int K, int N, unsigned char* WT, int mode, float scale, LAS float* scr, int item, int lane) {
    const int nblk = N / 64, kb = item / nblk, nb = item % nblk, k0 = 64 * kb, n0 = 64 * nb;
#pragma unroll 4
    for (int i = 0; i < 16; ++i) { const int kk = 4 * i + (lane >> 4), c4 = (lane & 15) * 4;
        const f32x4 v = *(const GAS f32x4*)(W + (size_t)(k0 + kk) * N + n0 + c4);
        LAS float* s = scr + kk * 65 + c4; s[0] = v[0]; s[1] = v[1]; s[2] = v[2]; s[3] = v[3]; }
    LDS_WAIT(); asm volatile("" ::: "memory");
    const int c = lane & 7;
#pragma unroll 2
    for (int j = 0; j < 8; ++j) { const int n = (lane >> 3) + 8 * j; const LAS float* s = scr + (8 * c) * 65 + n;
        v2u o; o.x = pk4_fp8(s[0 * 65] * scale, s[1 * 65] * scale, s[2 * 65] * scale, s[3 * 65] * scale); o.y = pk4_fp8(s[4 * 65] * scale, s[5 * 65] * scale, s[6 * 65] * scale, s[7 * 65] * scale);
        *(GAS v2u*)(WT + (size_t)dest_row(mode, n0 + n) * K + k0 + 8 * c) = o; }
    LDS_WAIT(); asm volatile("" ::: "memory");
}

#ifndef SITE_MASK
#define SITE_MASK 0xffff
#endif
#define SITE(n) (((SITE_MASK) >> (n)) & 1)
#ifndef PROBE_MASK
#define PROBE_MASK 0
#endif
#define REP(n) (1 + (((PROBE_MASK) >> (n)) & 1))
typedef const __attribute__((address_space(4))) Args* KArgs;
__device__ __forceinline__ int otid(int wave0) { int l; asm volatile("v_mbcnt_lo_u32_b32 %0, -1, 0\n\tv_mbcnt_hi_u32_b32 %0, -1, %0" : "=v"(l)); asm volatile("" : "+s"(wave0)); return wave0 * 64 + l; }
__device__ __forceinline__ LAS unsigned char* olds(LAS unsigned char* p) { asm volatile("" : "+s"(p)); return p; }
__device__ __forceinline__ KArgs kargs() { KArgs p = (KArgs)__builtin_amdgcn_kernarg_segment_ptr(); asm volatile("" : "+s"(p)); return p; }
#define IN(k) (ap->ph_lo <= (k) && (k) < ap->ph_hi)
#ifndef PROBE_BAR
#define PROBE_BAR 1
#endif
#define GRID_BAR() for (int _r = 0; _r < PROBE_BAR; ++_r) do { if (ap->ph_hi - ap->ph_lo > 1) { XcdBarrier _b; _b.bar = (unsigned*)(ap->ws + WS_CTL) + CW_BAR; _b.x = xb_xcc_id(); _b.st = (volatile LAS unsigned*)(lds + MISC_OFF + MO_BARW); xcd_barrier(_b); } } while (0)
#define VCU() ((gridDim.x % 8 == 0) ? (int)((blockIdx.x % 8) * (gridDim.x / 8) + blockIdx.x / 8) : (int)blockIdx.x)

__global__ void __launch_bounds__(512, 2) mk_fwd(Args args_unused) {
    extern __shared__ __attribute__((aligned(16))) unsigned char lds_raw[];
    LAS unsigned char* const lds0 = (LAS unsigned char*)lds_raw;
    const int wave0 = __builtin_amdgcn_readfirstlane((int)(threadIdx.x >> 6));
    {
        LAS unsigned char* lds = lds0;
        for (int u = threadIdx.x; u < (LDS_BYTES - MISC_OFF) / 4; u += 512) ((LAS unsigned*)(lds + MISC_OFF))[u] = 0u;
        __syncthreads();
        KArgs ap = kargs();
        if (ap->ph_hi - ap->ph_lo > 1) (void)xcd_barrier_post((unsigned*)(ap->ws + WS_CTL) + CW_BAR, (volatile LAS unsigned*)(lds + MISC_OFF + MO_BARW));
    }

#if SITE(0)
    { KArgs ap = kargs(); const int tid = otid(wave0); LAS unsigned char* lds = olds(lds0); (void)tid;
    if (IN(0)) for (int rep_ = 0; rep_ < REP(0); ++rep_) {
        const int lane = tid & 63, wave = __builtin_amdgcn_readfirstlane(tid >> 6), G = gridDim.x, vcu = VCU(), gw = vcu * 8 + wave, NGW = G * 8;
        unsigned char* ws = ap->ws;
        LAS float* scr = (LAS float*)(lds + wave * 16640);
        constexpr int I_HIN = 2 * 16 * 64, I_HOUT = 2 * 16 * 16, I_RIN = 2 * 16 * 96, I_ROUT = 2 * 32 * 16, I_GU = 128 * 16 * 32, I_DN = 128 * 16 * 16;
        constexpr int NITEMS = I_HIN + I_HOUT + I_RIN + I_ROUT + I_GU + I_DN + I_ROUT;
        for (int it = gw; it < NITEMS; it += NGW) {
            int r = it;
            if (r < I_HIN) { const int j = r / (16 * 64); transpose_item(ap->in[I_HWIN] + (size_t)j * DM * HG_IN, DM, HG_IN, (bf16*)(ws + WS_W_HIN) + (size_t)j * HG_IN * DM, 1, scr, r % (16 * 64), lane); continue; } r -= I_HIN;
            if (r < I_HOUT) { const int j = r / 256; transpose_item(ap->in[I_HWOUT] + (size_t)j * DM * DM, DM, DM, (bf16*)(ws + WS_W_HOUT) + (size_t)j * DM * DM, 0, scr, r % 256, lane); continue; } r -= I_HOUT;
            if (r < I_RIN) { const int j = r / (16 * 96); transpose_item(ap->in[I_RWIN] + (size_t)j * DM * RT_IN, DM, RT_IN, (bf16*)(ws + WS_W_RIN) + (size_t)j * RT_IN * DM, 0, scr, r % (16 * 96), lane); continue; } r -= I_RIN;
            if (r < I_ROUT) { const int j = r / 512; transpose_item(ap->in[I_RWOUT] + (size_t)j * RT_VD * DM, RT_VD, DM, (bf16*)(ws + WS_W_ROUT) + (size_t)j * DM * RT_VD, 0, scr, r % 512, lane); continue; } r -= I_ROUT;
#if MOE_FP8
            if (r < I_GU) { const int j = r / 512; transpose_item_fp8(ap->in[I_WGU] + (size_t)j * DM * 2048, DM, 2048, ws + WS_W_GU + (size_t)j * 2048 * DM, 2, WGU_SCALE, scr, r % 512, lane); continue; } r -= I_GU;
            if (r < I_DN) { const int j = r / 256; transpose_item_fp8(ap->in[I_WDN] + (size_t)j * DM * DM, DM, DM, ws + WS_W_DN + (size_t)j * DM * DM, 0, WDN_SCALE, scr, r % 256, lane); continue; } r -= I_DN;
            { const int j = r / 512; transpose_item_fp8(ap->in[I_RWOUT] + (size_t)j * RT_VD * DM, RT_VD, DM, ws + WS_W_ROUT8 + (size_t)j * DM * RT_VD, 0, 128.0f, scr, r % 512, lane); }
#else
            if (r < I_GU) { const int j = r / 512; transpose_item(ap->in[I_WGU] + (size_t)j * DM * 2048, DM, 2048, (bf16*)(ws + WS_W_GU) + (size_t)j * 2048 * DM, 2, scr, r % 512, lane); continue; } r -= I_GU;
            { const int j = r / 256; transpose_item(ap->in[I_WDN] + (size_t)j * DM * DM, DM, DM, (bf16*)(ws + WS_W_DN) + (size_t)j * DM * DM, 0, scr, r % 256, lane); }
#endif
        }
        const int gt = vcu * 512 + tid, NGT = G * 512;
        float* LBS = (float*)(ws + WS_LBS); float* BGU = (float*)(ws + WS_BGU); float* ROT = (float*)(ws + WS_ROT); bf16* XB = (bf16*)(ws + WS_XB);
        for (int d = gt; d < DM; d += NGT) { const float* lbp = ap->in[I_LB]; const float v0 = lbp[d], v1 = lbp[DM + d], v2 = lbp[2 * DM + d], v3 = lbp[3 * DM + d]; const float mx = fmaxf(fmaxf(v0, v1), fmaxf(v2, v3));
            const float e0 = __expf(v0 - mx), e1 = __expf(v1 - mx), e2 = __expf(v2 - mx), e3 = __expf(v3 - mx), is = 1.0f / (e0 + e1 + e2 + e3);
            LBS[d] = 0.f; LBS[DM + d] = e1 * is; LBS[2 * DM + d] = (e1 + e2) * is; LBS[3 * DM + d] = (e1 + e2 + e3) * is; }
        for (int i = gt; i < SEQ * 128; i += NGT) { const int pos = i >> 7, p = i & 127; const float inv = 1.0f / __builtin_amdgcn_exp2f(13.287712379549449f * ((float)p / 127.0f)); const float th = (float)pos * inv;
            double rev = (double)th * 0.15915494309189535; rev -= floor(rev); const float fr = (float)rev; ROT[2 * i] = __builtin_amdgcn_cosf(fr); ROT[2 * i + 1] = __builtin_amdgcn_sinf(fr); }
        for (int i = gt; i < 4 * DM * NE; i += NGT) { const int l = i >> 15, d = (i >> 5) & 1023, e = i & 31; const float wv = ap->in[I_RW][i]; const unsigned hb = f2bf(wv); const float hv = __builtin_bit_cast(float, hb << 16);
            ((bf16*)(ws + WS_WRH))[(size_t)l * 32768 + e * 1024 + d] = (bf16)hb; ((bf16*)(ws + WS_WRL))[(size_t)l * 32768 + e * 1024 + d] = (bf16)f2bf(wv - hv); }
        for (int i = gt; i < 4 * 32 * 2048; i += NGT) { const int le = i >> 11, n = i & 2047; BGU[(size_t)le * 2048 + dest_row(2, n)] = ap->in[I_BGU][i]; }
        for (size_t i = (size_t)gt; i < (size_t)NTOK * DM / 4; i += NGT) { const f32x4 v = ((const f32x4*)ap->in[I_X])[i]; v2u o; o.x = pk2(v[0], v[1]); o.y = pk2(v[2], v[3]); ((v2u*)XB)[i] = o; }
        GRID_BAR();
    } }
#endif

#pragma unroll 1
    for (int L = 0; L < DEPTH; ++L) {
        const int pb = 1 + 8 * L;
        if ((L & 1) == 0) {
#if SITE(1)
            { KArgs ap = kargs(); const int tid = otid(wave0); LAS unsigned char* lds = olds(lds0); (void)tid;
            if (IN(pb + 0)) for (int rep_ = 0; rep_ < REP(1); ++rep_) {
                unsigned char* ws = ap->ws; const int j = L >> 1;
                LAS int* ul = (LAS int*)(lds + MISC_OFF + MO_ULIST);
                pg8::build_units_dense(tid, ul, NTOK / 256, HG_IN / 256, DM * 2);
                pg8::EpiHgrnIn E{ws, L};
                pg8::gemm_phase<pg8::EpiHgrnIn, false, true, false>(tid, lds, ul, (LAS int*)(lds + MISC_OFF + MO_GTAB), (const char*)(ws + WS_XB), (const char*)((bf16*)(ws + WS_W_HIN) + (size_t)j * HG_IN * DM), nullptr, DM * 2, E, lds + MISC_OFF + MO_GTAB);
                GRID_BAR();
            } }
#endif
#if SITE(2)
            { KArgs ap = kargs(); const int tid = otid(wave0); LAS unsigned char* lds = olds(lds0); (void)tid;
            if (IN(pb + 1)) for (int rep_ = 0; rep_ < REP(2); ++rep_) {
#if !SLOW_HGRN
                { unsigned char* ws = ap->ws; const bf16* QD = (const bf16*)(ws + WS_H);
                  hgrn_fast(tid, lds, QD, QD + (size_t)NTOK * DM, QD + 4 * (size_t)NTOK * DM, QD + 3 * (size_t)NTOK * DM, (const float*)(ws + WS_DEC), ap->in[I_HNG] + (L >> 1) * DM,
                            (bf16*)(ws + WS_A2), (float*)(ws + WS_SSP)); }
#else
                unsigned char* ws = ap->ws; const bf16* QD = (const bf16*)(ws + WS_H); const bf16* KI = QD + (size_t)NTOK * DM; const bf16* KS = QD + 2 * (size_t)NTOK * DM; const bf16* VV = QD + 3 * (size_t)NTOK * DM; bf16* OB = (bf16*)(ws + WS_O);
                LAS float* qf = (LAS float*)lds; LAS float* kf = qf + 16 * 4 * 36; LAS float* ff = kf + 16 * 4 * 36; LAS float* vf = ff + 16 * 4 * 36;
                for (int un = blockIdx.x; un < NBATCH * HG_HEADS; un += gridDim.x) {
                    const int b = un >> 3, h = un & 7; const int vc = tid >> 2, kq = tid & 3;
                    float st[32];
#pragma unroll
                    for (int i = 0; i < 32; ++i) st[i] = 0.f;
                    for (int t0 = 0; t0 < SEQ; t0 += 16) {
                        __syncthreads();
                        for (int e = tid; e < 16 * 128; e += 512) { const int tt = e >> 7, k = e & 127; const size_t gi = (size_t)(b * SEQ + t0 + tt) * DM + h * 128 + k; const int li = tt * 144 + (k & 3) * 36 + (k >> 2);
                            qf[li] = bf1(QD[gi]); kf[li] = bf1(KI[gi]); ff[li] = bf1(KS[gi]); vf[tt * 128 + k] = bf1(VV[gi]); }
                        __syncthreads();
                        for (int tt = 0; tt < 16; ++tt) {
                            const float v = vf[tt * 128 + vc]; float a = 0.f; const int lb = tt * 144 + kq * 36;
#pragma unroll
                            for (int i = 0; i < 32; ++i) { st[i] = ff[lb + i] * st[i] + kf[lb + i] * v; a += qf[lb + i] * st[i]; }
                            a += __shfl_xor(a, 1); a += __shfl_xor(a, 2);
                            if (kq == 0) OB[(size_t)(b * SEQ + t0 + tt) * DM + h * 128 + vc] = (bf16)f2bf(a);
                        }
                    }
                }
#endif
                GRID_BAR();
            } }
#endif
#if SITE(3) && SLOW_HGRN
            { KArgs ap = kargs(); const int tid = otid(wave0); LAS unsigned char* lds = olds(lds0); (void)tid;
            if (IN(pb + 2)) for (int rep_ = 0; rep_ < REP(3); ++rep_) {
                const int lane = tid & 63, wave = __builtin_amdgcn_readfirstlane(tid >> 6), gw = VCU() * 8 + wave, NGW = gridDim.x * 8;
                unsigned char* ws = ap->ws; const bf16* OB = (const bf16*)(ws + WS_O); const bf16* GG = (const bf16*)(ws + WS_H) + 4 * (size_t)NTOK * DM; bf16* A2 = (bf16*)(ws + WS_A2);
                const float* ng = ap->in[I_HNG] + (L >> 1) * DM;
                f32x4 g4[4];
#pragma unroll
                for (int q = 0; q < 4; ++q) g4[q] = *(const f32x4*)(ng + 256 * q + 4 * lane);
                v2u on[4], gn[4];
#pragma unroll
                for (int q = 0; q < 4; ++q) { on[q] = *(const v2u*)(OB + (size_t)gw * DM + 256 * q + 4 * lane); gn[q] = *(const v2u*)(GG + (size_t)gw * DM + 256 * q + 4 * lane); }
#pragma unroll 1
                for (int row = gw; row < NTOK; row += NGW) {
                    v2u oc[4], gc[4];
#pragma unroll
                    for (int q = 0; q < 4; ++q) { oc[q] = on[q]; gc[q] = gn[q]; }
                    if (row + NGW < NTOK) {
#pragma unroll
                        for (int q = 0; q < 4; ++q) { on[q] = *(const v2u*)(OB + (size_t)(row + NGW) * DM + 256 * q + 4 * lane); gn[q] = *(const v2u*)(GG + (size_t)(row + NGW) * DM + 256 * q + 4 * lane); } }
                    float o[16]; float ss = 0.f;
#pragma unroll
                    for (int q = 0; q < 4; ++q) { o[4 * q] = bflo(oc[q].x); o[4 * q + 1] = bfhi(oc[q].x); o[4 * q + 2] = bflo(oc[q].y); o[4 * q + 3] = bfhi(oc[q].y); }
#pragma unroll
                    for (int i = 0; i < 16; ++i) ss += o[i] * o[i];
                    const float rs = 1.0f / sqrtf(wave_sum(ss) * (1.0f / DM) + RMS_EPS);
#pragma unroll
                    for (int q = 0; q < 4; ++q) {
                        v2u w; w.x = pk2(o[4 * q] * rs * g4[q][0] * bflo(gc[q].x), o[4 * q + 1] * rs * g4[q][1] * bfhi(gc[q].x)); w.y = pk2(o[4 * q + 2] * rs * g4[q][2] * bflo(gc[q].y), o[4 * q + 3] * rs * g4[q][3] * bfhi(gc[q].y));
                        *(v2u*)(A2 + (size_t)row * DM + 256 * q + 4 * lane) = w; }
                }
                GRID_BAR();
            } }
#endif
        } else {
#if SITE(4)
            { KArgs ap = kargs(); const int tid = otid(wave0); LAS unsigned char* lds = olds(lds0); (void)tid;
            if (IN(pb + 0)) for (int rep_ = 0; rep_ < REP(4); ++rep_) {
                unsigned char* ws = ap->ws; const int j = L >> 1;
                LAS int* ul = (LAS int*)(lds + MISC_OFF + MO_ULIST);
                pg8::build_units_dense(tid, ul, NTOK / 256, RT_IN / 256, DM * 2);
                pg8::EpiRetIn E{ws};
                pg8::gemm_phase<pg8::EpiRetIn, false, true, false>(tid, lds, ul, (LAS int*)(lds + MISC_OFF + MO_GTAB), (const char*)(ws + WS_XB), (const char*)((bf16*)(ws + WS_W_RIN) + (size_t)j * RT_IN * DM), nullptr, DM * 2, E);
                GRID_BAR();
            } }
#endif
#if SITE(5)
            { KArgs ap = kargs(); const int tid = otid(wave0); LAS unsigned char* lds = olds(lds0); (void)tid;
            if (IN(pb + 1)) for (int rep_ = 0; rep_ < REP(5); ++rep_) {
#if !SLOW_RET
                { unsigned char* ws = ap->ws; ret_fast(tid, lds, (const bf16*)(ws + WS_H), (bf16*)(ws + WS_O)); }
#else
                unsigned char* ws = ap->ws; const bf16* HB = (const bf16*)(ws + WS_H); bf16* OB = (bf16*)(ws + WS_O);
                LAS float* qf = (LAS float*)lds; LAS float* kf = qf + 16 * 4 * 68; LAS float* vf = kf + 16 * 4 * 68;
                for (int un = blockIdx.x; un < NBATCH * RT_HEADS * 4; un += gridDim.x) {
                    const int b = un >> 4, h = (un >> 2) & 3, vq = un & 3; const int vc = tid >> 2, kq = tid & 3;
                    const float gam = 1.0f - exp2f(-5.0f - (float)h);
                    float st[64];
#pragma unroll
                    for (int i = 0; i < 64; ++i) st[i] = 0.f;
                    for (int t0 = 0; t0 < SEQ; t0 += 16) {
                        __syncthreads();
                        for (int e = tid; e < 16 * 256; e += 512) { const int tt = e >> 8, k = e & 255; const size_t gi = (size_t)(b * SEQ + t0 + tt) * RT_IN + h * 256 + k; const int li = tt * 272 + (k & 3) * 68 + (k >> 2);
                            qf[li] = bf1(HB[gi]); kf[li] = bf1(HB[gi + 1024]); }
                        for (int e = tid; e < 16 * 128; e += 512) { const int tt = e >> 7, c = e & 127; vf[e] = bf1(HB[(size_t)(b * SEQ + t0 + tt) * RT_IN + 2048 + h * 512 + vq * 128 + c]); }
                        __syncthreads();
                        for (int tt = 0; tt < 16; ++tt) {
                            const float v = vf[tt * 128 + vc]; float a = 0.f; const int lb = tt * 272 + kq * 68;
#pragma unroll
                            for (int i = 0; i < 64; ++i) { st[i] = gam * st[i] + kf[lb + i] * v; a += qf[lb + i] * st[i]; }
                            a += __shfl_xor(a, 1); a += __shfl_xor(a, 2);
                            if (kq == 0) OB[(size_t)(b * SEQ + t0 + tt) * RT_VD + h * 512 + vq * 128 + vc] = (bf16)f2bf(a);
                        }
                    }
                }
#endif
                GRID_BAR();
            } }
#endif
#if SITE(6)
            { KArgs ap = kargs(); const int tid = otid(wave0); LAS unsigned char* lds = olds(lds0); (void)tid;
            if (IN(pb + 2)) for (int rep_ = 0; rep_ < REP(6); ++rep_) {
                const int lane = tid & 63, wave = __builtin_amdgcn_readfirstlane(tid >> 6), gw = VCU() * 8 + wave, NGW = gridDim.x * 8;
                unsigned char* ws = ap->ws; const bf16* OB = (const bf16*)(ws + WS_O); const bf16* HB = (const bf16*)(ws + WS_H); bf16* A2 = (bf16*)(ws + WS_A2);
                v4u on[4], gn[4];
#pragma unroll
                for (int h = 0; h < 4; ++h) { on[h] = *(const v4u*)(OB + (size_t)gw * RT_VD + 512 * h + 8 * lane); gn[h] = *(const v4u*)(HB + (size_t)gw * RT_IN + 4096 + 512 * h + 8 * lane); }
#pragma unroll 1
                for (int row = gw; row < NTOK; row += NGW) {
                    v4u oc[4], gc[4];
#pragma unroll
                    for (int h = 0; h < 4; ++h) { oc[h] = on[h]; gc[h] = gn[h]; }
                    if (row + NGW < NTOK) {
#pragma unroll
                        for (int h = 0; h < 4; ++h) { on[h] = *(const v4u*)(OB + (size_t)(row + NGW) * RT_VD + 512 * h + 8 * lane); gn[h] = *(const v4u*)(HB + (size_t)(row + NGW) * RT_IN + 4096 + 512 * h + 8 * lane); } }
#pragma unroll
                    for (int h = 0; h < 4; ++h) {
                        const v4u w = oc[h];
                        float o[8] = {bflo(w.x), bfhi(w.x), bflo(w.y), bfhi(w.y), bflo(w.z), bfhi(w.z), bflo(w.w), bfhi(w.w)};
                        float s = 0.f;
#pragma unroll
                        for (int i = 0; i < 8; ++i) s += o[i];
                        const float mu = wave_sum(s) * (1.0f / 512.0f); float q = 0.f;
#pragma unroll
                        for (int i = 0; i < 8; ++i) { o[i] -= mu; q += o[i] * o[i]; }
                        const float rs = 1.0f / sqrtf(wave_sum(q) * (1.0f / 512.0f) + LN_EPS);
                        const v4u g = gc[h];
#if ROUT_FP8
                        const float r8 = rs * 8.0f; v2u r; r.x = pk4_fp8(o[0] * r8 * bflo(g.x), o[1] * r8 * bfhi(g.x), o[2] * r8 * bflo(g.y), o[3] * r8 * bfhi(g.y));
                        r.y = pk4_fp8(o[4] * r8 * bflo(g.z), o[5] * r8 * bfhi(g.z), o[6] * r8 * bflo(g.w), o[7] * r8 * bfhi(g.w));
                        *(v2u*)((unsigned char*)A2 + (size_t)row * RT_VD + 512 * h + 8 * lane) = r;
#else
                        v4u r; r.x = pk2(o[0] * rs * bflo(g.x), o[1] * rs * bfhi(g.x)); r.y = pk2(o[2] * rs * bflo(g.y), o[3] * rs * bfhi(g.y));
                        r.z = pk2(o[4] * rs * bflo(g.z), o[5] * rs * bfhi(g.z)); r.w = pk2(o[6] * rs * bflo(g.w), o[7] * rs * bfhi(g.w));
                        *(v4u*)(A2 + (size_t)row * RT_VD + 512 * h + 8 * lane) = r;
#endif
                    }
                }
                GRID_BAR();
            } }
#endif
        }
#if SITE(7)
        { KArgs ap = kargs(); const int tid = otid(wave0); LAS unsigned char* lds = olds(lds0); (void)tid;
        if (IN(pb + 3)) for (int rep_ = 0; rep_ < REP(7); ++rep_) {
            unsigned char* ws = ap->ws; const int j = L >> 1; const bool ret = (L & 1) != 0;
            const int Ko = ret ? RT_VD : DM;
            LAS int* ul = (LAS int*)(lds + MISC_OFF + MO_ULIST);
            if (ret && ROUT_FP8) {
                pg8::build_units_dense(tid, ul, NTOK / 256, DM / 256, RT_VD);
                pg8::EpiRes E{ws, -1, 1.0f / (8.0f * 128.0f)};
                pg8::gemm_phase<pg8::EpiRes, false, true, true>(tid, lds, ul, (LAS int*)(lds + MISC_OFF + MO_GTAB), (const char*)(ws + WS_A2), (const char*)(ws + WS_W_ROUT8 + (size_t)j * DM * RT_VD), nullptr, RT_VD, E);
            } else {
                pg8::build_units_dense(tid, ul, NTOK / 256, DM / 256, Ko * 2);
                const char* Bt = ret ? (const char*)((bf16*)(ws + WS_W_ROUT) + (size_t)j * DM * RT_VD) : (const char*)((bf16*)(ws + WS_W_HOUT) + (size_t)j * DM * DM);
                pg8::EpiRes E{ws, (ret || SLOW_HGRN) ? -1 : 0, 1.0f};
                pg8::gemm_phase<pg8::EpiRes, false, true, false>(tid, lds, ul, (LAS int*)(lds + MISC_OFF + MO_GTAB), (const char*)(ws + WS_A2), Bt, nullptr, Ko * 2, E);
            }
            GRID_BAR();
        } }
#endif
#if SITE(8)
        { KArgs ap = kargs(); const int tid = otid(wave0); LAS unsigned char* lds = olds(lds0); (void)tid;
        if (IN(pb + 4)) for (int rep_ = 0; rep_ < REP(8); ++rep_) {
            const int lane = tid & 63, wave = __builtin_amdgcn_readfirstlane(tid >> 6), r = lane & 15, g = lane >> 4;
            unsigned char* ws = ap->ws; unsigned* ctl = (unsigned*)(ws + WS_CTL);
            const bf16* Y = (const bf16*)(ws + WS_Y); bf16* X1R = (bf16*)(ws + WS_X1F); bf16* X1B = (bf16*)(ws + WS_X1B);
            int* ROWDST = (int*)(ws + WS_ROWDST); float* ROWGATE = (float*)(ws + WS_ROWGATE);
            constexpr int WP = 2064;
            LAS unsigned char* wH = lds; LAS unsigned char* wL = lds + 32 * WP;
            LAS int* lcnt = (LAS int*)(lds + MISC_OFF + MO_LCNT); LAS int* lbase = (LAS int*)(lds + MISC_OFF + MO_LBASE);
            LAS int* sel = (LAS int*)(lds + MISC_OFF + MO_SEL); LAS float* selw = (LAS float*)(lds + MISC_OFF + MO_SELW);
            const float* rb = ap->in[I_RB] + L * NE;
            const float* lg = ap->in[I_LNMG] + L * DM; const float* lbb = ap->in[I_LNMB] + L * DM;
            { const v4u* gh = (const v4u*)(ws + WS_WRH) + (size_t)L * 4096; const v4u* gl = (const v4u*)(ws + WS_WRL) + (size_t)L * 4096;
              for (int c = tid; c < 4096; c += 512) { const int e = c >> 7, cc = c & 127; *(LAS v4u*)(wH + e * WP + cc * 16) = gh[c]; *(LAS v4u*)(wL + e * WP + cc * 16) = gl[c]; } }
            const float rb0 = rb[r], rb1 = rb[16 + r];
            for (int blk = VCU(); blk < NTOK / 128; blk += gridDim.x) {
                if (tid < 32) lcnt[tid] = 0;
                __syncthreads();
                const int row0 = blk * 128 + wave * 16;
                v2u xn[4];
#pragma unroll
                for (int q = 0; q < 4; ++q) xn[q] = *(const v2u*)(Y + (size_t)row0 * DM + 256 * q + 4 * lane);
#pragma unroll 1
                for (int rr = 0; rr < 16; ++rr) {
                    const int row = row0 + rr;
                    f32x4 x[4]; float s = 0.f;
#pragma unroll
                    for (int q = 0; q < 4; ++q) { x[q] = (f32x4){bflo(xn[q].x), bfhi(xn[q].x), bflo(xn[q].y), bfhi(xn[q].y)}; s += (x[q][0] + x[q][1]) + (x[q][2] + x[q][3]); }
                    if (rr + 1 < 16) {
#pragma unroll
                        for (int q = 0; q < 4; ++q) xn[q] = *(const v2u*)(Y + (size_t)(row + 1) * DM + 256 * q + 4 * lane); }
                    const float mu = wave_sum_u(s) * (1.0f / DM); float qq = 0.f;
#pragma unroll
                    for (int q = 0; q < 4; ++q) { x[q] = x[q] - mu; qq += (x[q][0] * x[q][0] + x[q][1] * x[q][1]) + (x[q][2] * x[q][2] + x[q][3] * x[q][3]); }
                    const float rs = 1.0f / sqrtf(wave_sum_u(qq) * (1.0f / DM) + LN_EPS);
#pragma unroll
                    for (int q = 0; q < 4; ++q) { const f32x4 g4 = *(const f32x4*)(lg + 256 * q + 4 * lane), b4 = *(const f32x4*)(lbb + 256 * q + 4 * lane); x[q] = x[q] * rs * g4 + b4;
                        { v2u wr_; wr_.x = pk2(x[q][0], x[q][1]); wr_.y = pk2(x[q][2], x[q][3]); *(v2u*)(X1R + (size_t)row * DM + 256 * q + 4 * lane) = wr_; }
#if MOE_FP8
                        *(unsigned*)((unsigned char*)X1B + (size_t)row * DM + 256 * q + 4 * lane) = pk4_fp8(x[q][0] * X_SCALE, x[q][1] * X_SCALE, x[q][2] * X_SCALE, x[q][3] * X_SCALE); }
#else
                        v2u w; w.x = pk2(x[q][0], x[q][1]); w.y = pk2(x[q][2], x[q][3]); *(v2u*)(X1B + (size_t)row * DM + 256 * q + 4 * lane) = w; }
#endif
                }
                asm volatile("s_waitcnt vmcnt(0)" ::: "memory");
                f32x4 lgt0 = {0.f, 0.f, 0.f, 0.f}, lgt1 = {0.f, 0.f, 0.f, 0.f};
                {
                    const bf16* xa = X1R + (size_t)(row0 + r) * DM + 8 * g;
#pragma unroll 1
                    for (int kq = 0; kq < 4; ++kq) {
                        bf16x8 af[8], h0[8], h1[8], l0[8], l1[8];
#pragma unroll
                        for (int j = 0; j < 8; ++j) { const int kb = kq * 8 + j; af[j] = *(const bf16x8*)(xa + 32 * kb);
                            h0[j] = *(const LAS bf16x8*)(wH + r * WP + (32 * kb + 8 * g) * 2); h1[j] = *(const LAS bf16x8*)(wH + (16 + r) * WP + (32 * kb + 8 * g) * 2);
                            l0[j] = *(const LAS bf16x8*)(wL + r * WP + (32 * kb + 8 * g) * 2); l1[j] = *(const LAS bf16x8*)(wL + (16 + r) * WP + (32 * kb + 8 * g) * 2); }
#pragma unroll
                        for (int j = 0; j < 8; ++j) { lgt0 = MFMA32(af[j], h0[j], lgt0); lgt1 = MFMA32(af[j], h1[j], lgt1); lgt0 = MFMA32(af[j], l0[j], lgt0); lgt1 = MFMA32(af[j], l1[j], lgt1); }
                    }
                }
#pragma unroll
                for (int i = 0; i < 4; ++i) {
                    float v0 = lgt0[i] + rb0, v1 = lgt1[i] + rb1; int se[4]; float sv[4];
#pragma unroll
                    for (int k = 0; k < 4; ++k) {
                        float m = fmaxf(v0, v1);
                        m = fmaxf(m, dppf<0xB1>(m)); m = fmaxf(m, dppf<0x4E>(m)); m = fmaxf(m, dppf<0x141>(m)); m = fmaxf(m, dppf<0x140>(m));
                        int ec = (v0 == m) ? r : ((v1 == m) ? 16 + r : 99);
                        ec = min(ec, dppi<0xB1>(ec)); ec = min(ec, dppi<0x4E>(ec)); ec = min(ec, dppi<0x141>(ec)); ec = min(ec, dppi<0x140>(ec));
                        se[k] = ec; sv[k] = m;
                        if (ec == r) v0 = -3.0e38f;
                        if (ec == 16 + r) v1 = -3.0e38f;
                    }
                    const float e1 = __expf(sv[1] - sv[0]), e2 = __expf(sv[2] - sv[0]), e3 = __expf(sv[3] - sv[0]); const float inv = 1.0f / (1.0f + e1 + e2 + e3);
                    if (r < 4) { const int rloc = wave * 16 + 4 * g + i; const int ee = r == 0 ? se[0] : (r == 1 ? se[1] : (r == 2 ? se[2] : se[3])); const float ww = (r == 0 ? 1.0f : (r == 1 ? e1 : (r == 2 ? e2 : e3))) * inv;
                        sel[rloc * 4 + r] = ee; selw[rloc * 4 + r] = ww; }
                }
                __syncthreads();
                const int myE = sel[tid]; const int rank = __hip_atomic_fetch_add(lcnt + myE, 1, __ATOMIC_RELAXED, __HIP_MEMORY_SCOPE_WORKGROUP);
                __syncthreads();
                if (tid < 32) lbase[tid] = (int)__hip_atomic_fetch_add(ctl + CW_ECNT + (L + 4 * rep_) * 32 + tid, (unsigned)lcnt[tid], RLX_AGENT);
                __syncthreads();
                { const int pos = lbase[myE] + rank; const size_t ti = (size_t)myE * ECAP + pos; ROWDST[ti] = (blk * 128 + (tid >> 2)) * 4 + (tid & 3); ROWGATE[ti] = selw[tid]; }
                __syncthreads();
            }
            GRID_BAR();
        } }
#endif
#if SITE(9)
        { KArgs ap = kargs(); const int tid = otid(wave0); LAS unsigned char* lds = olds(lds0); (void)tid;
        if (IN(pb + 5)) for (int rep_ = 0; rep_ < REP(9); ++rep_) {
            unsigned char* ws = ap->ws; unsigned* ctl = (unsigned*)(ws + WS_CTL);
            LAS int* tpre = (LAS int*)(lds + MISC_OFF + MO_TPRE); LAS int* ebase = (LAS int*)(lds + MISC_OFF + MO_EBASE); LAS int* ecnt = (LAS int*)(lds + MISC_OFF + MO_ECNT);
            if (tid < NE) ecnt[tid] = (int)__hip_atomic_load(ctl + CW_ECNT + L * 32 + tid, RLX_AGENT);
            __syncthreads();
            if (tid == 0) { int t = 0;
_Pragma("unroll 1")
 for (int e = 0; e < NE; ++e) { const int c = ecnt[e]; tpre[e] = t; ebase[e] = t * 256; t += (c + 255) >> 8; } tpre[NE] = t; }
            __syncthreads();
            LAS int* ul = (LAS int*)(lds + MISC_OFF + MO_ULIST);
            constexpr int EB = MOE_FP8 ? 1 : 2;
            pg8::build_units_moe(tid, ul, tpre, ebase, ecnt, 8, DM * EB, 2048u * DM * EB);
            { LAS int* gall = (LAS int*)(lds + MISC_OFF + MO_GALL); const int* rd = (const int*)(ws + WS_ROWDST);
              for (int i = tid; i < GALL_UNITS * 256; i += 512) { const int uu = i >> 8, rr = i & 255;
                  if (ul[uu * 8 + 0]) gall[i] = (int)((unsigned)rd[ul[uu * 8 + 7] + min(rr, ul[uu * 8 + 5] - 1)] >> 2); }
              __syncthreads(); }
            pg8::EpiMoeGU E{ws, L};
            pg8::gemm_phase<pg8::EpiMoeGU, true, true, MOE_FP8 != 0>(tid, lds, ul, (LAS int*)(lds + MISC_OFF + MO_GALL), (const char*)(ws + WS_X1B), (const char*)(ws + WS_W_GU + (size_t)L * NE * 2048 * DM * EB), (const int*)(ws + WS_ROWDST), DM * EB, E, lds + MISC_OFF + MO_GTAB);
            GRID_BAR();
        } }
#endif
#if SITE(10)
        { KArgs ap = kargs(); const int tid = otid(wave0); LAS unsigned char* lds = olds(lds0); (void)tid;
        if (IN(pb + 6)) for (int rep_ = 0; rep_ < REP(10); ++rep_) {
            unsigned char* ws = ap->ws; unsigned* ctl = (unsigned*)(ws + WS_CTL);
            LAS int* tpre = (LAS int*)(lds + MISC_OFF + MO_TPRE); LAS int* ebase = (LAS int*)(lds + MISC_OFF + MO_EBASE); LAS int* ecnt = (LAS int*)(lds + MISC_OFF + MO_ECNT);
            __syncthreads();
            if (tid < NE) ecnt[tid] = (int)__hip_atomic_load(ctl + CW_ECNT + L * 32 + tid, RLX_AGENT);
            __syncthreads();
            if (tid == 0) { int t = 0;
_Pragma("unroll 1")
 for (int e = 0; e < NE; ++e) { const int c = ecnt[e]; tpre[e] = t; ebase[e] = t * 256; t += (c + 255) >> 8; } tpre[NE] = t; }
            __syncthreads();
            LAS int* ul = (LAS int*)(lds + MISC_OFF + MO_ULIST);
            constexpr int EB = MOE_FP8 ? 1 : 2;
            pg8::build_units_moe(tid, ul, tpre, ebase, ecnt, 4, DM * EB, (unsigned)DM * DM * EB);
            pg8::EpiMoeDown E{ws, ap->in[I_BDN] + (size_t)L * NE * DM};
            pg8::gemm_phase<pg8::EpiMoeDown, false, true, MOE_FP8 != 0>(tid, lds, ul, (LAS int*)(lds + MISC_OFF + MO_GTAB), (const char*)(ws + WS_ACT), (const char*)(ws + WS_W_DN + (size_t)L * NE * DM * DM * EB), nullptr, DM * EB, E, lds + MISC_OFF + MO_GALL);
            GRID_BAR();
        } }
#endif
#if SITE(11)
        { KArgs ap = kargs(); const int tid = otid(wave0); LAS unsigned char* lds = olds(lds0); (void)tid;
        if (IN(pb + 7)) for (int rep_ = 0; rep_ < REP(11); ++rep_) {
            const int lane = tid & 63, wave = __builtin_amdgcn_readfirstlane(tid >> 6), gw = VCU() * 8 + wave, NGW = gridDim.x * 8;
            unsigned char* ws = ap->ws; const bf16* X1R = (const bf16*)(ws + WS_X1F); const bf16* YS = (const bf16*)(ws + WS_YSLOT); bf16* XB = (bf16*)(ws + WS_XB); float* out = ap->out;
            const float* lg = ap->in[I_LNFG] + L * DM; const float* lbb = ap->in[I_LNFB] + L * DM;
#if YS_FP8
            typedef unsigned ys_t; constexpr int YSB = 1;
#else
            typedef v2u ys_t; constexpr int YSB = 2;
#endif
            v2u xn[4]; f32x4 g4[4], b4[4]; ys_t yn[4][4];
#pragma unroll
            for (int q = 0; q < 4; ++q) { g4[q] = *(const f32x4*)(lg + 256 * q + 4 * lane); b4[q] = *(const f32x4*)(lbb + 256 * q + 4 * lane); xn[q] = *(const v2u*)(X1R + (size_t)gw * DM + 256 * q + 4 * lane);
#pragma unroll
                for (int k = 0; k < 4; ++k) yn[q][k] = *(const ys_t*)((const unsigned char*)YS + (((size_t)gw * 4 + k) * DM + 256 * q + 4 * lane) * YSB); }
#pragma unroll 1
            for (int row = gw; row < NTOK; row += NGW) {
                f32x4 x[4]; ys_t yc[4][4]; float s = 0.f;
#pragma unroll
                for (int q = 0; q < 4; ++q) { x[q] = (f32x4){bflo(xn[q].x), bfhi(xn[q].x), bflo(xn[q].y), bfhi(xn[q].y)} * DN_ALPHA;
#pragma unroll
                    for (int k = 0; k < 4; ++k) yc[q][k] = yn[q][k]; }
                if (row + NGW < NTOK) {
#pragma unroll
                    for (int q = 0; q < 4; ++q) { xn[q] = *(const v2u*)(X1R + (size_t)(row + NGW) * DM + 256 * q + 4 * lane);
#pragma unroll
                        for (int k = 0; k < 4; ++k) yn[q][k] = *(const ys_t*)((const unsigned char*)YS + (((size_t)(row + NGW) * 4 + k) * DM + 256 * q + 4 * lane) * YSB); } }
#pragma unroll
                for (int q = 0; q < 4; ++q) {
#pragma unroll
#if YS_FP8
                    for (int k = 0; k < 4; ++k) { const f32x2 lo = __builtin_amdgcn_cvt_pk_f32_fp8((int)yc[q][k], false), hi = __builtin_amdgcn_cvt_pk_f32_fp8((int)yc[q][k], true);
                        x[q][0] += lo[0] * 0.015625f; x[q][1] += lo[1] * 0.015625f; x[q][2] += hi[0] * 0.015625f; x[q][3] += hi[1] * 0.015625f; }
#else
                    for (int k = 0; k < 4; ++k) { const v2u w = yc[q][k]; x[q][0] += bflo(w.x); x[q][1] += bfhi(w.x); x[q][2] += bflo(w.y); x[q][3] += bfhi(w.y); }
#endif
                    s += (x[q][0] + x[q][1]) + (x[q][2] + x[q][3]); }
                const float mu = wave_sum(s) * (1.0f / DM); float qq = 0.f;
#pragma unroll
                for (int q = 0; q < 4; ++q) { x[q] = x[q] - mu; qq += (x[q][0] * x[q][0] + x[q][1] * x[q][1]) + (x[q][2] * x[q][2] + x[q][3] * x[q][3]); }
                const float rs = 1.0f / sqrtf(wave_sum(qq) * (1.0f / DM) + LN_EPS);
#pragma unroll
                for (int q = 0; q < 4; ++q) { x[q] = x[q] * rs * g4[q] + b4[q];
                    if (L + 1 == DEPTH) *(f32x4*)(out + (size_t)row * DM + 256 * q + 4 * lane) = x[q];
                    else { v2u w; w.x = pk2(x[q][0], x[q][1]); w.y = pk2(x[q][2], x[q][3]); *(v2u*)(XB + (size_t)row * DM + 256 * q + 4 * lane) = w; } }
            }
            if (L + 1 < DEPTH) GRID_BAR();
        } }
#endif
    }
#undef IN
#undef GRID_BAR
}

extern "C" void kernel_launch(void* const* d_in, const int* in_sizes, int n_in, void* d_out, int out_size, void* d_ws, size_t ws_size, hipStream_t stream) {
    static int grid = 0;
    if (grid == 0) {
        if (n_in != 17 || out_size != NTOK * DM || ws_size < WS_END) { fprintf(stderr, "kernel_launch: unexpected shapes (n_in %d, out %d, ws %zu < %zu)\n", n_in, out_size, ws_size, (size_t)WS_END); grid = -1; return; }
        int dev = 0, cus = 0, per_cu = 0;
        if (hipGetDevice(&dev) != hipSuccess || hipDeviceGetAttribute(&cus, hipDeviceAttributeMultiprocessorCount, dev) != hipSuccess) { grid = -1; return; }
        if (hipFuncSetAttribute((const void*)mk_fwd, hipFuncAttributeMaxDynamicSharedMemorySize, LDS_BYTES) != hipSuccess) { fprintf(stderr, "kernel_launch: hipFuncSetAttribute failed\n"); grid = -1; return; }
        if (hipOccupancyMaxActiveBlocksPerMultiprocessor(&per_cu, (const void*)mk_fwd, 512, LDS_BYTES) != hipSuccess || per_cu < 1) { fprintf(stderr, "kernel_launch: occupancy query says %d\n", per_cu); }
        (void)hipGetLastError();
        grid = cus;
    }
    if (grid < 0) return;
    (void)hipMemsetAsync((char*)d_ws + WS_CTL, 0, CTL_ZERO_BYTES, stream);
    Args a{};
    for (int i = 0; i < 17; ++i) a.in[i] = (const float*)d_in[i];
    a.out = (float*)d_out; a.ws = (unsigned char*)d_ws;
#if MK_MULTI
    for (int p = 0; p < 1 + 8 * DEPTH; ++p) { a.ph_lo = p; a.ph_hi = p + 1; hipLaunchKernelGGL(mk_fwd, dim3(grid), dim3(512), LDS_BYTES, stream, a); }
#else
    a.ph_lo = 0; a.ph_hi = 1 + 8 * DEPTH;
    hipLaunchKernelGGL(mk_fwd, dim3(grid), dim3(512), LDS_BYTES, stream, a);
#endif
}
```

```cpp
#include <hip/hip_runtime.h>
#include <cstdio>
#include <cstdint>

#ifndef MK_MULTI
#define MK_MULTI 0
#endif
#ifndef PROBE_EPI2
#define PROBE_EPI2 0
#endif
#ifndef MOE_FP8
#define MOE_FP8 1
#endif
#ifndef ROUT_FP8
#define ROUT_FP8 1
#endif
#ifndef YS_FP8
#define YS_FP8 1
#endif
#ifndef SLOW_HGRN
#define SLOW_HGRN 0
#endif
#ifndef SLOW_RET
#define SLOW_RET 0
#endif

#define GAS __attribute__((address_space(1)))
#define LAS __attribute__((address_space(3)))
typedef unsigned short bf16;
typedef unsigned v4u __attribute__((ext_vector_type(4)));
typedef unsigned v2u __attribute__((ext_vector_type(2)));
typedef float f32x4 __attribute__((ext_vector_type(4)));
typedef float f32x2 __attribute__((ext_vector_type(2)));
typedef short bf16x8 __attribute__((ext_vector_type(8)));
typedef GAS unsigned gu32;

constexpr int DM = 1024, NBATCH = 16, SEQ = 2048, NTOK = NBATCH * SEQ, DEPTH = 4;
constexpr int NE = 32, TOPK = 4;
constexpr int HG_HEADS = 8, HG_K = 128;
constexpr int RT_HEADS = 4, RT_K = 256, RT_V = 512, RT_VD = 2048, RT_IN = 6144, HG_IN = 4096;
constexpr int ECAP = NTOK;
constexpr int MOE_ROWS = NTOK * TOPK + NE * 256;
constexpr float DN_ALPHA = 1.681792830507429f;
constexpr float LN_EPS = 1e-5f, RMS_EPS = 1e-6f;

constexpr size_t MiB = 1ull << 20;
constexpr size_t WS_CTL = 0, CTL_ZERO_BYTES = 1 * MiB;
constexpr size_t WS_LBS = 1 * MiB;
constexpr size_t WS_WRH = 1 * MiB + 128 * 1024, WS_WRL = 1 * MiB + 512 * 1024;
constexpr size_t WS_BGU = 2 * MiB;
constexpr size_t WS_ROT = 4 * MiB;
constexpr size_t WS_ROWDST = 8 * MiB;
constexpr size_t WS_ROWGATE = 12 * MiB;
constexpr size_t WS_W_HIN = 16 * MiB;
constexpr size_t WS_W_HOUT = WS_W_HIN + 16 * MiB;
constexpr size_t WS_W_RIN = WS_W_HOUT + 4 * MiB;
constexpr size_t WS_W_ROUT = WS_W_RIN + 24 * MiB;
constexpr size_t WS_W_GU = WS_W_ROUT + 8 * MiB;
constexpr size_t WS_W_DN = WS_W_GU + 512 * MiB;
constexpr size_t WS_XB = WS_W_DN + 256 * MiB;
constexpr size_t WS_H = WS_XB + 64 * MiB;
constexpr size_t WS_DEC = WS_H + 320 * MiB;
constexpr size_t WS_SSP = WS_DEC + 16 * MiB;
constexpr size_t WS_O = WS_H + 384 * MiB;
constexpr size_t WS_A2 = WS_O + 128 * MiB;
constexpr size_t WS_Y = WS_A2 + 128 * MiB;
constexpr size_t WS_X1F = WS_Y + 128 * MiB;
constexpr size_t WS_X1B = WS_X1F + 128 * MiB;
constexpr size_t WS_ACT = WS_X1B + 64 * MiB;
constexpr size_t WS_YSLOT = WS_ACT + 272 * MiB;
constexpr size_t WS_W_ROUT8 = WS_YSLOT + 256 * MiB;
constexpr size_t WS_END = WS_W_ROUT8 + 4 * MiB;

constexpr int CW_BAR = 4096;
constexpr int CW_SS = 65536;
constexpr int CW_ECNT = 16384;

constexpr int RING_BYTES = 131072;
constexpr int MISC_OFF = 135168;
constexpr int LDS_BYTES = 163840;
constexpr int MO_BARW = 0;
constexpr int MO_GTAB = 64;
constexpr int MO_TPRE = 64 + 2048;
constexpr int MO_EBASE = MO_TPRE + 160;
constexpr int MO_ECNT = MO_EBASE + 128;
constexpr int MO_LCNT = MO_ECNT + 128;
constexpr int MO_LBASE = MO_LCNT + 128;
constexpr int MO_SEL = MO_LBASE + 128;
constexpr int MO_SELW = MO_SEL + 2048;
constexpr int MO_RANK = MO_SELW + 2048;
constexpr int MO_ULIST = MO_RANK + 2048;
constexpr int MO_GALL = 10240;
constexpr int GALL_UNITS = 18;
static_assert(MO_ULIST + 1024 <= MO_GALL && MISC_OFF + MO_GALL + GALL_UNITS * 1024 <= LDS_BYTES, "LDS map");

#define RLX_AGENT __ATOMIC_RELAXED, __HIP_MEMORY_SCOPE_AGENT
#define LDS_WAIT() asm volatile("s_waitcnt lgkmcnt(0)" ::: "memory")
#define VM_WAIT() asm volatile("s_waitcnt vmcnt(0)" ::: "memory")

__device__ __forceinline__ unsigned f2bf(float f) { unsigned u = __builtin_bit_cast(unsigned, f); return (u + 0x7fffu + ((u >> 16) & 1u)) >> 16; }
__device__ __forceinline__ unsigned pk2(float lo, float hi) { return f2bf(lo) | (f2bf(hi) << 16); }
__device__ __forceinline__ unsigned cvt_pk_bf16(float lo, float hi) { unsigned r; asm volatile("v_cvt_pk_bf16_f32 %0, %1, %2" : "=v"(r) : "v"(lo), "v"(hi)); return r; }
#if MOE_FP8
constexpr float X_SCALE = 4.0f, WGU_SCALE = 64.0f, ACT_SCALE = 4.0f, WDN_SCALE = 128.0f;
constexpr float GU_DESCALE = 1.0f / (X_SCALE * WGU_SCALE), DN_DESCALE = 1.0f / (ACT_SCALE * WDN_SCALE);
#else
constexpr float GU_DESCALE = 1.0f, DN_DESCALE = 1.0f, ACT_SCALE = 1.0f;
#endif
__device__ __forceinline__ unsigned pk4_fp8(float a, float b, float c, float d) {
    a = __builtin_amdgcn_fmed3f(a, -448.0f, 448.0f); b = __builtin_amdgcn_fmed3f(b, -448.0f, 448.0f); c = __builtin_amdgcn_fmed3f(c, -448.0f, 448.0f); d = __builtin_amdgcn_fmed3f(d, -448.0f, 448.0f);
    int p = __builtin_amdgcn_cvt_pk_fp8_f32(a, b, 0, false); p = __builtin_amdgcn_cvt_pk_fp8_f32(c, d, p, true); return (unsigned)p; }
__device__ __forceinline__ float bflo(unsigned u) { return __builtin_bit_cast(float, u << 16); }
__device__ __forceinline__ float bfhi(unsigned u) { return __builtin_bit_cast(float, u & 0xffff0000u); }
__device__ __forceinline__ float bf1(bf16 b) { return __builtin_bit_cast(float, ((unsigned)b) << 16); }
__device__ __forceinline__ float fexp(float x) { return __builtin_amdgcn_exp2f(x * 1.4426950408889634f); }
__device__ __forceinline__ float frcp(float x) { return __builtin_amdgcn_rcpf(x); }
__device__ __forceinline__ float fsigmoid(float x) { return frcp(1.0f + fexp(-x)); }
__device__ __forceinline__ float wave_sum(float v) {
#pragma unroll
    for (int o = 1; o < 64; o <<= 1) v += __shfl_xor(v, o);
    return v;
}
__device__ __forceinline__ float wave_max(float v) {
#pragma unroll
    for (int o = 1; o < 64; o <<= 1) v = fmaxf(v, __shfl_xor(v, o));
    return v;
}

template <int CTRL> __device__ __forceinline__ float dppf(float v) { return __builtin_bit_cast(float, __builtin_amdgcn_update_dpp(0, __builtin_bit_cast(int, v), CTRL, 0xf, 0xf, true)); }
template <int CTRL> __device__ __forceinline__ int dppi(int v) { return __builtin_amdgcn_update_dpp(0, v, CTRL, 0xf, 0xf, true); }
__device__ __forceinline__ float rlane(float v, int l) { return __builtin_bit_cast(float, __builtin_amdgcn_readlane(__builtin_bit_cast(int, v), l)); }
__device__ __forceinline__ float wave_sum_u(float v) {
    v += dppf<0xB1>(v); v += dppf<0x4E>(v); v += dppf<0x141>(v); v += dppf<0x140>(v);
    return (rlane(v, 0) + rlane(v, 16)) + (rlane(v, 32) + rlane(v, 48));
}
#define XB_TMO      128
#define XB_XCNT(j)  (256  + 64 * (j))
#define XB_XSUB(j)  (1280 + 64 * (j))
#define XB_XGEN(j)  (2304 + 64 * (j))
#define XB_TOP      3328
#define XB_TOPGEN   3392
#define XCD_BAR_WORDS 3456
#define XB_SPIN_CAP (1u << 22)

__device__ __forceinline__ unsigned xb_ld(unsigned* p)              { return __hip_atomic_load(p, __ATOMIC_RELAXED, __HIP_MEMORY_SCOPE_AGENT); }
__device__ __forceinline__ unsigned xb_add(unsigned* p, unsigned v) { return __hip_atomic_fetch_add(p, v, __ATOMIC_RELAXED, __HIP_MEMORY_SCOPE_AGENT); }
__device__ __forceinline__ unsigned xb_xcc_id() { return (unsigned)__builtin_amdgcn_s_getreg((3 << 11) | 20) & 0xFu; }
#define XB_SPIN(cond, bar) do { unsigned _sp = 0; while (cond) { __builtin_amdgcn_s_sleep(1); \
    if ((++_sp & 255u) == 0u) { if (xb_ld(&(bar)[XB_TMO])) break; if (_sp > XB_SPIN_CAP) { atomicAdd(&(bar)[XB_TMO], 1u); break; } } } } while (0)

struct XcdBarrier { unsigned* bar; unsigned x; volatile LAS unsigned* st; };

__device__ __forceinline__ XcdBarrier xcd_barrier_post(unsigned* bar, volatile LAS unsigned* st) {
    XcdBarrier b; b.bar = bar; b.x = xb_xcc_id(); b.st = st;
    if (threadIdx.x == 0) (void)xb_add(&bar[XB_XCNT(b.x)], 1u);
    return b;
}
__device__ __forceinline__ void xcd_barrier_complete(unsigned* bar, unsigned x, unsigned& nloc, unsigned& nx) {
    const unsigned G = gridDim.x * gridDim.y * gridDim.z;
    unsigned sum, cnt, mine, sp = 0u;
    for (;;) {
        sum = 0u; cnt = 0u; mine = 0u;
#pragma unroll
        for (unsigned j = 0; j < 16; ++j) { const unsigned c = xb_ld(&bar[XB_XCNT(j)]); sum += c; cnt += (c > 0u) ? 1u : 0u; mine = (j == x) ? c : mine; }
        if (sum == G) break;
        __builtin_amdgcn_s_sleep(1);
        if ((++sp & 255u) == 0u) { if (xb_ld(&bar[XB_TMO])) break; if (sp > XB_SPIN_CAP) { atomicAdd(&bar[XB_TMO], 1u); break; } }
    }
    nloc = mine > 0u ? mine : 1u; nx = cnt > 0u ? cnt : 1u;
}
__device__ __forceinline__ void xcd_barrier(const XcdBarrier& b) {
    asm volatile("s_waitcnt vmcnt(0)" ::: "memory");
    __syncthreads();
    if (threadIdx.x == 0) {
        unsigned* bar = b.bar;
        __builtin_amdgcn_s_waitcnt(0);
        unsigned nloc = b.st[0], nx = b.st[1];
        if (nloc == 0u) { xcd_barrier_complete(bar, b.x, nloc, nx); b.st[0] = nloc; b.st[1] = nx; }
        const unsigned old = xb_add(&bar[XB_XSUB(b.x)], 1u);
        const unsigned gen = old / nloc;
        if (old + 1u == (gen + 1u) * nloc) {
            __builtin_amdgcn_fence(__ATOMIC_RELEASE, "agent");
            asm volatile("s_waitcnt vmcnt(0)" ::: "memory");
            const unsigned og = xb_add(&bar[XB_TOP], 1u);
            const unsigned tg = og / nx;
            if (og + 1u == (tg + 1u) * nx) xb_add(&bar[XB_TOPGEN], 1u);
            else XB_SPIN(xb_ld(&bar[XB_TOPGEN]) == tg, bar);
            __builtin_amdgcn_fence(__ATOMIC_ACQUIRE, "agent");
            xb_add(&bar[XB_XGEN(b.x)], 1u);
            asm volatile("s_waitcnt vmcnt(0)" ::: "memory");
        } else {
            XB_SPIN(xb_ld(&bar[XB_TOPGEN]) == gen, bar);
            __builtin_amdgcn_fence(__ATOMIC_ACQUIRE, "agent");
            asm volatile("s_waitcnt vmcnt(0)" ::: "memory");
        }
    }
    __syncthreads();
}

namespace pg8 {
constexpr int BM = 256, BK = 64, HALF = 128, HTB = HALF * BK * 2, STAGE_BYTES = 8 * HTB, NXCD = 8, WGM = 8, MAXU = 32;
__host__ __device__ __forceinline__ int lds_byte(int r, int c) { const int st = (r >> 4) * 2 + (c >> 5), rr = r & 15, cc = c & 31, ob = rr * 64 + cc * 2; return st * 1024 + (ob ^ (((ob >> 9) & 1) << 5)); }
__host__ __device__ __forceinline__ void stage_rc(int b, int& R, int& C) { const int st = b / 1024, sb = b % 1024, swz = sb ^ (((sb >> 9) & 1) << 5); R = (st >> 1) * 16 + swz / 64; C = (st & 1) * 32 + (swz % 64) / 2; }
__host__ __device__ __forceinline__ int perm32(int rho) { const int n = rho >> 4, i = rho & 15; return 8 * (i >> 2) + 4 * n + (i & 3); }

struct Unit { int pm, pn, e, rowbase, cnt; unsigned boff; int gidx; };

__device__ __forceinline__ bool tile_of(long L, int nM, int nN, int& gm, int& pn) {
    const int nwg = nM * nN; if (L >= nwg) return false;
    int wgid = (int)L; { const int q = nwg / NXCD, r = nwg % NXCD, xcd = wgid % NXCD, off = wgid / NXCD; wgid = (xcd < r ? xcd * (q + 1) : r * (q + 1) + (xcd - r) * q) + off; }
    const int nig = WGM * nN, gid = wgid / nig, fm = gid * WGM, gsz = (nM - fm) < WGM ? (nM - fm) : WGM;
    gm = fm + ((wgid % nig) % gsz); pn = (wgid % nig) / gsz; return true;
}
__device__ __forceinline__ void build_units_dense(const int i, LAS int* ul, int nM, int nN, int RB) {
    if (i < MAXU) { int gm = 0, pn = 0; const bool ok = tile_of((long)i * gridDim.x + blockIdx.x, nM, nN, gm, pn);
        ul[i * 8 + 0] = ok ? 1 : 0; ul[i * 8 + 1] = gm; ul[i * 8 + 2] = pn; ul[i * 8 + 3] = 0; ul[i * 8 + 4] = gm * BM; ul[i * 8 + 5] = BM; ul[i * 8 + 6] = (int)((unsigned)pn * BM * (unsigned)RB); ul[i * 8 + 7] = 0; }
    __syncthreads();
}
__device__ __forceinline__ void build_units_moe(const int i, LAS int* ul, const LAS int* tpre, const LAS int* ebase, const LAS int* ecnt, int nN, int RB, unsigned wstride) {
    if (i < MAXU) { int gm = 0, pn = 0; const bool ok = tile_of((long)i * gridDim.x + blockIdx.x, tpre[NE], nN, gm, pn);
        int e = 0;
_Pragma("unroll 1")
        for (int s = 16; s >= 1; s >>= 1) { if (e + s < NE && tpre[e + s] <= gm) e += s; }
        const int pm = gm - tpre[e];
        ul[i * 8 + 0] = ok ? 1 : 0; ul[i * 8 + 1] = pm; ul[i * 8 + 2] = pn; ul[i * 8 + 3] = e; ul[i * 8 + 4] = ebase[e] + pm * BM; ul[i * 8 + 5] = ecnt[e] - pm * BM;
        ul[i * 8 + 6] = (int)((unsigned)e * wstride + (unsigned)pn * BM * (unsigned)RB); ul[i * 8 + 7] = e * ECAP + pm * BM; }
    __syncthreads();
}
typedef int v4i __attribute__((ext_vector_type(4)));
__device__ __forceinline__ bool ld_unit(const LAS int* ul, int i, Unit& u) {
    if (i >= MAXU) return false;
    const v4i a = *(const LAS v4i*)(ul + i * 8), b = *(const LAS v4i*)(ul + i * 8 + 4);
    if (__builtin_amdgcn_readfirstlane(a.x) == 0) return false;
    u.pm = __builtin_amdgcn_readfirstlane(a.y); u.pn = __builtin_amdgcn_readfirstlane(a.z); u.e = __builtin_amdgcn_readfirstlane(a.w); u.rowbase = __builtin_amdgcn_readfirstlane(b.x);
    u.cnt = __builtin_amdgcn_readfirstlane(b.y); u.boff = (unsigned)__builtin_amdgcn_readfirstlane(b.z); u.gidx = __builtin_amdgcn_readfirstlane(b.w); return true;
}
__device__ __forceinline__ void glds16(const char* sbase, unsigned voff, LAS unsigned char* dst) {
    asm volatile("" : "+s"(sbase));
    __builtin_amdgcn_global_load_lds((const unsigned*)(sbase + voff), (LAS unsigned*)dst, 16, 0, 0);
}
template <bool GATHER> __device__ __forceinline__ void stage_a(LAS unsigned char* dst, const char* sbase, unsigned o0, unsigned o1, size_t r64) {
    glds16(sbase, o0, dst);
    if constexpr (GATHER) glds16(sbase, o1, dst + 8192);
    else glds16(sbase + r64, o0, dst + 8192);
}

typedef int v8i __attribute__((ext_vector_type(8)));
__device__ __forceinline__ v8i cat_frag(const bf16x8& a, const bf16x8& b) { return __builtin_shufflevector(__builtin_bit_cast(v4i, a), __builtin_bit_cast(v4i, b), 0, 1, 2, 3, 4, 5, 6, 7); }
template <class Epi, bool GATHER, bool ALIGN_EPI, bool FP8>
__device__ __forceinline__ void gemm_phase(const int tid, LAS unsigned char* lds, const LAS int* ul, LAS int* gtab, const char* Abase, const char* Bbase, const int* rowdst, const int RB, const Epi& E, LAS unsigned char* epl = nullptr) {
    const int wid = __builtin_amdgcn_readfirstlane(tid >> 6), lane = tid & 63, wr = wid >> 2, wc = wid & 3, fr = lane & 15, fq = lane >> 4;
    const int nt = RB / 128;
    int R0, C0; stage_rc(tid * 16, R0, C0);
    const int Rb0 = Epi::PERM ? ((R0 & ~31) + perm32(R0 & 31)) : R0;
    const unsigned voffB = (unsigned)(Rb0 * RB + C0 * 2);
    const unsigned cb0 = (unsigned)C0 * 2u, K2 = (unsigned)RB;
    const size_t kstep = (size_t)128;
    const size_t r64 = (size_t)64 * RB;
    const size_t hstep = (size_t)HALF * RB;
    const unsigned ldsw = (unsigned)wid * 1024u;
    const int aoff = lds_byte(wr * 64 + fr, fq * 8), boff = lds_byte(wc * 32 + fr, fq * 8);
#define PG8_SA(b, h) (((b) * 2 + (h)) * HTB)
#define PG8_SB(b, h) ((4 + (b) * 2 + (h)) * HTB)
#define PG8_STAGE(bufoff, gbase) do { glds16((const char*)(gbase), voffB, lds + (bufoff) + ldsw); glds16((const char*)(gbase) + r64, voffB, lds + (bufoff) + ldsw + 8192); } while (0)
#define PG8_STAGEA0(bufoff, kb, o0, o1) stage_a<GATHER>(lds + (bufoff) + ldsw, Abase + (kb), o0, o1, r64)
#define PG8_STAGEA1(bufoff, kb, o0, o2, o3) stage_a<GATHER>(lds + (bufoff) + ldsw, Abase + (kb) + (GATHER ? (size_t)0 : hstep), GATHER ? (o2) : (o0), o3, r64)
#define PG8_LDA(dst, b, h) do { _Pragma("unroll") for (int m = 0; m < 4; ++m) { const v4i _l = *(const LAS v4i*)(lds + PG8_SA(b, h) + aoff + m * 2048), _h = *(const LAS v4i*)(lds + PG8_SA(b, h) + aoff + m * 2048 + 1024); dst[m] = __builtin_shufflevector(_l, _h, 0, 1, 2, 3, 4, 5, 6, 7); } } while (0)
#define PG8_LDB(dst, b, h) do { _Pragma("unroll") for (int n = 0; n < 2; ++n) { const v4i _l = *(const LAS v4i*)(lds + PG8_SB(b, h) + boff + n * 2048), _h = *(const LAS v4i*)(lds + PG8_SB(b, h) + boff + n * 2048 + 1024); dst[n] = __builtin_shufflevector(_l, _h, 0, 1, 2, 3, 4, 5, 6, 7); } } while (0)
#define PG8_LO(x) __builtin_bit_cast(bf16x8, __builtin_shufflevector(x, x, 0, 1, 2, 3))
#define PG8_HI(x) __builtin_bit_cast(bf16x8, __builtin_shufflevector(x, x, 4, 5, 6, 7))
#define PG8_MMA(ai, bj, At, Bt) do { __builtin_amdgcn_s_setprio(1); _Pragma("unroll") for (int m = 0; m < 4; ++m) _Pragma("unroll") for (int n = 0; n < 2; ++n) { \
        if constexpr (FP8) asm volatile("v_mfma_scale_f32_16x16x128_f8f6f4 %0, %1, %2, %0, %3, %3 op_sel_hi:[0,0,0]" : "+v"(acc[ai][bj][m][n]) : "v"(Bt[n]), "v"(At[m]), "v"(sc1)); \
        else { acc[ai][bj][m][n] = __builtin_amdgcn_mfma_f32_16x16x32_bf16(PG8_LO(Bt[n]), PG8_LO(At[m]), acc[ai][bj][m][n], 0, 0, 0); \
               acc[ai][bj][m][n] = __builtin_amdgcn_mfma_f32_16x16x32_bf16(PG8_HI(Bt[n]), PG8_HI(At[m]), acc[ai][bj][m][n], 0, 0, 0); } } \
        __builtin_amdgcn_s_setprio(0); } while (0)
#define PG8_WAIT_V(n) asm volatile("s_waitcnt vmcnt(" #n ")" ::: "memory")
#define PG8_WAIT_L(n) asm volatile("s_waitcnt lgkmcnt(" #n ")" ::: "memory")
#define PG8_BAR __builtin_amdgcn_s_barrier()
#define PG8_SCHED __builtin_amdgcn_sched_barrier(0)
    Unit cur, nxt; int ui = 0;
    if (!ld_unit(ul, 0, cur)) return;
    f32x4 acc[2][2][4][2];
#pragma unroll
    for (int a = 0; a < 2; ++a)
#pragma unroll
        for (int b = 0; b < 2; ++b)
#pragma unroll
            for (int m = 0; m < 4; ++m)
#pragma unroll
                for (int n = 0; n < 2; ++n) { double z0, z1; asm volatile("v_mov_b64 %0, 0\n\tv_mov_b64 %1, 0" : "=v"(z0), "=v"(z1)); typedef double d2_t __attribute__((ext_vector_type(2))); acc[a][b][m][n] = __builtin_bit_cast(f32x4, (d2_t){z0, z1}); }
    v8i At[4], B0[2], B1[2];
    const int sc1 = 0x7f7f7f7f;
    unsigned oA0, oA1 = 0, oA2 = 0, oA3 = 0, oN0, oN1 = 0, oN2 = 0, oN3 = 0;
    if constexpr (GATHER) {
        oA0 = (unsigned)gtab[R0] * K2 + cb0; oA1 = (unsigned)gtab[R0 + 64] * K2 + cb0; oA2 = (unsigned)gtab[R0 + 128] * K2 + cb0; oA3 = (unsigned)gtab[R0 + 192] * K2 + cb0;
    } else {
        oA0 = (unsigned)(cur.rowbase + R0) * K2 + cb0;
    }
    oN0 = oA0; oN1 = oA1; oN2 = oA2; oN3 = oA3;
    const char* cB = Bbase + cur.boff;
    PG8_STAGE(PG8_SB(0, 0), cB); PG8_STAGE(PG8_SB(0, 1), cB + hstep); PG8_STAGEA0(PG8_SA(0, 0), (size_t)0, oA0, oA1); PG8_STAGEA1(PG8_SA(0, 1), (size_t)0, oA0, oA2, oA3);
    if (wr == 1) PG8_BAR;
    PG8_WAIT_V(2); PG8_BAR;
    PG8_STAGE(PG8_SB(1, 0), cB + kstep); PG8_STAGEA0(PG8_SA(1, 0), kstep, oA0, oA1); PG8_STAGE(PG8_SB(1, 1), cB + hstep + kstep);
    PG8_WAIT_V(6); PG8_BAR;
    for (;;) {
        const bool has_next = ld_unit(ul, ui + 1, nxt);
        if constexpr (Epi::HAS_PRE) E.pre(cur, epl + (ui & 1) * Epi::PRE_BYTES, wid, lane);
        const char* nB = has_next ? Bbase + nxt.boff : cB;
_Pragma("unroll 1")
        for (int t = 0; t < nt; t += 2) {
            const bool last = (t == nt - 2);
            if (last && has_next) {
                if constexpr (GATHER) {
                    const LAS int* gt = gtab + (ui + 1) * 256;
                    oN0 = (unsigned)gt[R0] * K2 + cb0; oN1 = (unsigned)gt[R0 + 64] * K2 + cb0; oN2 = (unsigned)gt[R0 + 128] * K2 + cb0; oN3 = (unsigned)gt[R0 + 192] * K2 + cb0;
                } else {
                    oN0 = (unsigned)(nxt.rowbase + R0) * K2 + cb0;
                }
            }
            const size_t kb1 = (size_t)(t + 1) * kstep;
            const size_t kb2 = last ? (size_t)0 : (size_t)(t + 2) * kstep, kb3 = kb2 + kstep;
            const unsigned p0 = last ? oN0 : oA0, p1 = last ? oN1 : oA1, p2 = last ? oN2 : oA2, p3 = last ? oN3 : oA3;
            const char* b2 = last ? nB : cB + (size_t)(t + 2) * kstep; const char* b3 = b2 + kstep;
            PG8_LDB(B0, 0, 0); PG8_LDB(B1, 0, 1); PG8_SCHED; PG8_LDA(At, 0, 0); PG8_STAGEA1(PG8_SA(1, 1), kb1, oA0, oA2, oA3);
            PG8_WAIT_V(8); PG8_WAIT_L(0); PG8_BAR; PG8_MMA(0, 0, At, B0); PG8_MMA(0, 1, At, B1); PG8_BAR; PG8_SCHED;
            PG8_LDA(At, 0, 1); PG8_STAGE(PG8_SB(0, 0), b2); PG8_STAGE(PG8_SB(0, 1), b2 + hstep); PG8_STAGEA0(PG8_SA(0, 0), kb2, p0, p1);
            PG8_WAIT_V(8); PG8_WAIT_L(0); PG8_BAR; PG8_MMA(1, 0, At, B0); PG8_MMA(1, 1, At, B1); PG8_BAR; PG8_SCHED;
            PG8_LDB(B0, 1, 0); PG8_LDB(B1, 1, 1); PG8_SCHED; PG8_LDA(At, 1, 0); PG8_STAGEA1(PG8_SA(0, 1), kb2, p0, p2, p3);
            PG8_WAIT_V(8); PG8_WAIT_L(0); PG8_BAR; PG8_MMA(0, 0, At, B0); PG8_MMA(0, 1, At, B1); PG8_BAR; PG8_SCHED;
            PG8_LDA(At, 1, 1); PG8_STAGE(PG8_SB(1, 0), b3); PG8_STAGE(PG8_SB(1, 1), b3 + hstep); PG8_STAGEA0(PG8_SA(1, 0), kb3, p0, p1);
            PG8_WAIT_V(8); PG8_WAIT_L(0); PG8_BAR; PG8_MMA(1, 0, At, B0); PG8_MMA(1, 1, At, B1); PG8_BAR; PG8_SCHED;
        }
        asm volatile("s_nop 7\n\ts_nop 7\n\ts_nop 7" ::: "memory");
        if constexpr (ALIGN_EPI) { if (wr == 0) PG8_BAR; }
        if constexpr (Epi::HAS_PRE) E(acc, cur, wr, wc, fr, fq, epl + (ui & 1) * Epi::PRE_BYTES); else E(acc, cur, wr, wc, fr, fq);
#if PROBE_EPI2
        if constexpr (FP8) { if constexpr (Epi::HAS_PRE) E(acc, cur, wr, wc, fr, fq, epl + (ui & 1) * Epi::PRE_BYTES); else E(acc, cur, wr, wc, fr, fq); }
#endif
        if (!has_next) break;
#pragma unroll
        for (int a = 0; a < 2; ++a)
#pragma unroll
            for (int b = 0; b < 2; ++b)
#pragma unroll
                for (int m = 0; m < 4; ++m)
#pragma unroll
                    for (int n = 0; n < 2; ++n) { double z0, z1; asm volatile("v_mov_b64 %0, 0\n\tv_mov_b64 %1, 0" : "=v"(z0), "=v"(z1)); typedef double d2_t __attribute__((ext_vector_type(2))); acc[a][b][m][n] = __builtin_bit_cast(f32x4, (d2_t){z0, z1}); }
        cur = nxt; cB = nB; oA0 = oN0; oA1 = oN1; oA2 = oN2; oA3 = oN3; ++ui;
        if constexpr (ALIGN_EPI) { if (wr == 1) PG8_BAR; }
    }
    PG8_WAIT_V(0);
    if constexpr (!ALIGN_EPI) { if (wr == 0) PG8_BAR; }
    PG8_BAR;
#undef PG8_SA
#undef PG8_SB
#undef PG8_STAGE
#undef PG8_STAGEA0
#undef PG8_STAGEA1
#undef PG8_LDA
#undef PG8_LDB
#undef PG8_LO
#undef PG8_HI
#undef PG8_MMA
#undef PG8_WAIT_V
#undef PG8_WAIT_L
#undef PG8_BAR
#undef PG8_SCHED
}

__device__ __forceinline__ GAS unsigned char* launder(unsigned char* p) { asm volatile("" : "+s"(p)); return (GAS unsigned char*)p; }
#define OPAQUE_LANE(fr, fq) asm volatile("" : "+v"(fr), "+v"(fq))
__device__ __forceinline__ f32x2 sigm2(const f32x2 v) { f32x2 e = v * -1.4426950408889634f; e.x = __builtin_amdgcn_exp2f(e.x); e.y = __builtin_amdgcn_exp2f(e.y); e = e + 1.0f; e.x = frcp(e.x); e.y = frcp(e.y); return e; }
__device__ __forceinline__ f32x4 silu4(const f32x4 v) { f32x4 e = v * -1.4426950408889634f;
#pragma unroll
    for (int j = 0; j < 4; ++j) e[j] = __builtin_amdgcn_exp2f(e[j]);
    e = e + 1.0f;
#pragma unroll
    for (int j = 0; j < 4; ++j) e[j] = frcp(e[j]);
    return v * e; }
__device__ __forceinline__ void row_scan_mul8(float& a, float& b, float& c, float& d, float& e, float& f, float& g, float& h) {
#define RSM_STEP(s) "v_mul_f32_dpp %0, %0, %0 row_shr:" #s " row_mask:0xf bank_mask:0xf\n\tv_mul_f32_dpp %1, %1, %1 row_shr:" #s " row_mask:0xf bank_mask:0xf\n\tv_mul_f32_dpp %2, %2, %2 row_shr:" #s " row_mask:0xf bank_mask:0xf\n\tv_mul_f32_dpp %3, %3, %3 row_shr:" #s " row_mask:0xf bank_mask:0xf\n\t" \
                    "v_mul_f32_dpp %4, %4, %4 row_shr:" #s " row_mask:0xf bank_mask:0xf\n\tv_mul_f32_dpp %5, %5, %5 row_shr:" #s " row_mask:0xf bank_mask:0xf\n\tv_mul_f32_dpp %6, %6, %6 row_shr:" #s " row_mask:0xf bank_mask:0xf\n\tv_mul_f32_dpp %7, %7, %7 row_shr:" #s " row_mask:0xf bank_mask:0xf\n\t"
    asm volatile("s_nop 1\n\t" RSM_STEP(1) RSM_STEP(2) RSM_STEP(4) RSM_STEP(8) : "+v"(a), "+v"(b), "+v"(c), "+v"(d), "+v"(e), "+v"(f), "+v"(g), "+v"(h));
#undef RSM_STEP
}
struct EpiHgrnIn {
    static constexpr bool PERM = true, HAS_PRE = true; static constexpr int PRE_BYTES = 1024;
    unsigned char* ws0; int L;
    __device__ __forceinline__ void pre(const Unit& u, LAS unsigned char* buf, int wid, int lane) const {
        if (wid == 0 && u.pn < 8) glds16((const char*)(ws0 + WS_LBS) + ((size_t)L * DM + (size_t)u.pn * HG_K) * 4, (unsigned)lane * 16u, buf);
    }
    __device__ __forceinline__ void operator()(const f32x4 (&acc)[2][2][4][2], const Unit& u, int wr, int wc, int fr, int fq, const LAS unsigned char* buf) const {
        OPAQUE_LANE(fr, fq);
        GAS unsigned char* ws = launder(ws0);
        GAS bf16* QD = (GAS bf16*)(ws + WS_H);
        const int row0 = u.rowbase + wr * 64 + fr;
        if (u.pn >= 8) {
            const bool isg = u.pn >= 12; GAS bf16* base = QD + (size_t)(isg ? 4 : 3) * NTOK * DM; const int colt = (u.pn - (isg ? 12 : 8)) * BM + wc * 32 + 8 * fq;
#pragma unroll
            for (int ai = 0; ai < 2; ++ai)
#pragma unroll
                for (int m = 0; m < 4; ++m) { GAS bf16* rowp = base + (size_t)(row0 + ai * HALF + m * 16) * DM + colt;
#pragma unroll
                    for (int bj = 0; bj < 2; ++bj) { f32x4 v0 = acc[ai][bj][m][0], v1 = acc[ai][bj][m][1];
                        if (isg) { v0 = silu4(v0); v1 = silu4(v1); }
                        v4u w; w.x = cvt_pk_bf16(v0[0], v0[1]); w.y = cvt_pk_bf16(v0[2], v0[3]); w.z = cvt_pk_bf16(v1[0], v1[1]); w.w = cvt_pk_bf16(v1[2], v1[3]);
                        *(GAS v4u*)(rowp + bj * HALF) = w; } }
            return;
        }
        const int col = u.pn * HG_K + wc * 32 + 8 * fq;
        const LAS float* lb = (const LAS float*)buf + wc * 32 + 8 * fq;
        const f32x4 lb0 = *(const LAS f32x4*)lb, lb1 = *(const LAS f32x4*)(lb + 4);
        GAS float* DEC = (GAS float*)(ws + WS_DEC);
        f32x2 lbp[4], oml[4];
        lbp[0] = __builtin_shufflevector(lb0, lb0, 0, 1); lbp[1] = __builtin_shufflevector(lb0, lb0, 2, 3); lbp[2] = __builtin_shufflevector(lb1, lb1, 0, 1); lbp[3] = __builtin_shufflevector(lb1, lb1, 2, 3);
#pragma unroll
        for (int p = 0; p < 4; ++p) oml[p] = 1.0f - lbp[p];
#pragma unroll
        for (int ai = 0; ai < 2; ++ai)
#pragma unroll
            for (int m = 0; m < 4; ++m) {
                const int row = row0 + ai * HALF + m * 16;
                float qd[8], ki[8], P[8];
#pragma unroll
                for (int p = 0; p < 4; ++p) {
                    const f32x4 q4 = acc[ai][0][m][p >> 1], f4 = acc[ai][1][m][p >> 1];
                    const f32x2 q2 = (p & 1) ? __builtin_shufflevector(q4, q4, 2, 3) : __builtin_shufflevector(q4, q4, 0, 1);
                    const f32x2 f2 = (p & 1) ? __builtin_shufflevector(f4, f4, 2, 3) : __builtin_shufflevector(f4, f4, 0, 1);
                    const f32x2 sg = sigm2(f2), fg = oml[p] * sg + lbp[p], kk = oml[p] * (1.0f - sg), sq = q2 * sigm2(q2);
                    P[2 * p] = fg.x; P[2 * p + 1] = fg.y; ki[2 * p] = kk.x; ki[2 * p + 1] = kk.y; qd[2 * p] = sq.x; qd[2 * p + 1] = sq.y;
                }
                row_scan_mul8(P[0], P[1], P[2], P[3], P[4], P[5], P[6], P[7]);
#pragma unroll
                for (int j = 0; j < 8; ++j) { const float iP = frcp(fmaxf(P[j], 1e-30f));
                    qd[j] *= P[j]; ki[j] *= iP; }
                const size_t o = (size_t)row * DM + col;
                v4u w;
                w.x = cvt_pk_bf16(qd[0], qd[1]); w.y = cvt_pk_bf16(qd[2], qd[3]); w.z = cvt_pk_bf16(qd[4], qd[5]); w.w = cvt_pk_bf16(qd[6], qd[7]); *(GAS v4u*)(QD + o) = w;
                w.x = cvt_pk_bf16(ki[0], ki[1]); w.y = cvt_pk_bf16(ki[2], ki[3]); w.z = cvt_pk_bf16(ki[4], ki[5]); w.w = cvt_pk_bf16(ki[6], ki[7]); *(GAS v4u*)(QD + (size_t)NTOK * DM + o) = w;
                if (fr == 15) { GAS float* dp = DEC + (size_t)(row >> 4) * DM + col; *(GAS f32x4*)dp = (f32x4){P[0], P[1], P[2], P[3]}; *(GAS f32x4*)(dp + 4) = (f32x4){P[4], P[5], P[6], P[7]}; }
            }
    }
};
struct EpiRetIn {
    static constexpr bool PERM = true, HAS_PRE = false; static constexpr int PRE_BYTES = 0;
    unsigned char* ws0;
    __device__ __forceinline__ void operator()(const f32x4 (&acc)[2][2][4][2], const Unit& u, int wr, int wc, int fr, int fq) const {
        OPAQUE_LANE(fr, fq);
        GAS unsigned char* ws = launder(ws0);
        GAS bf16* H = (GAS bf16*)(ws + WS_H);
        const int row0 = u.rowbase + wr * 64 + fr; const int colt = u.pn * BM + wc * 32 + 8 * fq;
        const int kind = u.pn < 4 ? 0 : (u.pn < 8 ? 1 : (u.pn < 16 ? 2 : 3));
        float ivf[2][4];
        if (kind <= 1) {
#pragma unroll
            for (int bj = 0; bj < 2; ++bj)
#pragma unroll
                for (int k = 0; k < 4; ++k) { const int p = ((bj * HALF + wc * 32 + 8 * fq) >> 1) + k; ivf[bj][k] = (1.0f / __builtin_amdgcn_exp2f(13.287712379549449f * ((float)p / 127.0f))); }
        }
#pragma unroll
        for (int ai = 0; ai < 2; ++ai)
#pragma unroll
            for (int m = 0; m < 4; ++m) { const int row = row0 + ai * HALF + m * 16; GAS bf16* rowp = H + (size_t)row * RT_IN + colt; const int pos = row & (SEQ - 1);
#pragma unroll
                for (int bj = 0; bj < 2; ++bj) { f32x4 v0 = acc[ai][bj][m][0], v1 = acc[ai][bj][m][1];
                    if (kind <= 1) {
                        f32x4 r0, r1;
#pragma unroll
                        for (int k = 0; k < 4; ++k) { const float th = (float)pos * ivf[bj][k]; const float fr2 = __builtin_amdgcn_fractf(th * 0.15915494309189535f);
                            const float cs = __builtin_amdgcn_cosf(fr2), sn = __builtin_amdgcn_sinf(fr2);
                            if (k < 2) { r0[2 * k] = cs; r0[2 * k + 1] = sn; } else { r1[2 * (k - 2)] = cs; r1[2 * (k - 2) + 1] = sn; } }
                        const float sc = kind == 1 ? 0.0625f : 1.0f;
                        f32x4 o0, o1;
                        o0[0] = (v0[0] * r0[0] - v0[1] * r0[1]) * sc; o0[1] = (v0[1] * r0[0] + v0[0] * r0[1]) * sc;
                        o0[2] = (v0[2] * r0[2] - v0[3] * r0[3]) * sc; o0[3] = (v0[3] * r0[2] + v0[2] * r0[3]) * sc;
                        o1[0] = (v1[0] * r1[0] - v1[1] * r1[1]) * sc; o1[1] = (v1[1] * r1[0] + v1[0] * r1[1]) * sc;
                        o1[2] = (v1[2] * r1[2] - v1[3] * r1[3]) * sc; o1[3] = (v1[3] * r1[2] + v1[2] * r1[3]) * sc;
                        v0 = o0; v1 = o1;
                    } else if (kind == 3) { v0 = silu4(v0); v1 = silu4(v1); }
                    v4u w; w.x = cvt_pk_bf16(v0[0], v0[1]); w.y = cvt_pk_bf16(v0[2], v0[3]); w.z = cvt_pk_bf16(v1[0], v1[1]); w.w = cvt_pk_bf16(v1[2], v1[3]);
                    *(GAS v4u*)(rowp + bj * HALF) = w; } }
    }
};
struct EpiRes {
    static constexpr bool PERM = true, HAS_PRE = true; static constexpr int PRE_BYTES = 1024;
    unsigned char* ws0; int ssoff; float ds;
    __device__ __forceinline__ void pre(const Unit& u, LAS unsigned char* buf, int wid, int lane) const {
        if (ssoff < 0) return;
        const int t = wid * 64 + lane, r = t >> 1, hf = t & 1;
        const GAS float* sp = (const GAS float*)(launder(ws0) + WS_SSP) + (size_t)(hf * HG_HEADS) * NTOK + u.rowbase + r;
        float s = 0.f;
#pragma unroll
        for (int hh = 0; hh < HG_HEADS; ++hh) s += sp[(size_t)hh * NTOK];
        s += dppf<0xB1>(s);
        if (hf == 0) ((LAS float*)buf)[r] = 1.0f / sqrtf(s * (1.0f / DM) + RMS_EPS);
    }
    __device__ __forceinline__ void operator()(const f32x4 (&acc)[2][2][4][2], const Unit& u, int wr, int wc, int fr, int fq, const LAS unsigned char* buf) const {
        OPAQUE_LANE(fr, fq);
        GAS unsigned char* ws = launder(ws0);
        GAS bf16* Y = (GAS bf16*)(ws + WS_Y); const GAS bf16* X = (const GAS bf16*)(ws + WS_XB);
        const int row0 = u.rowbase + wr * 64 + fr, col0 = u.pn * BM + wc * 32 + 8 * fq;
        v4u xs[2][4][2];
#pragma unroll
        for (int ai = 0; ai < 2; ++ai)
#pragma unroll
            for (int m = 0; m < 4; ++m)
#pragma unroll
                for (int bj = 0; bj < 2; ++bj) xs[ai][m][bj] = *(const GAS v4u*)(X + (size_t)(row0 + ai * HALF + m * 16) * DM + col0 + bj * HALF);
        asm volatile("" : "+v"(xs[0][0][0]), "+v"(xs[0][0][1]), "+v"(xs[0][1][0]), "+v"(xs[0][1][1]), "+v"(xs[0][2][0]), "+v"(xs[0][2][1]), "+v"(xs[0][3][0]), "+v"(xs[0][3][1]));
        asm volatile("" : "+v"(xs[1][0][0]), "+v"(xs[1][0][1]), "+v"(xs[1][1][0]), "+v"(xs[1][1][1]), "+v"(xs[1][2][0]), "+v"(xs[1][2][1]), "+v"(xs[1][3][0]), "+v"(xs[1][3][1]));
#pragma unroll
        for (int ai = 0; ai < 2; ++ai)
#pragma unroll
            for (int m = 0; m < 4; ++m) { const size_t off = (size_t)(row0 + ai * HALF + m * 16) * DM + col0;
                const float rsc = ssoff >= 0 ? ((const LAS float*)buf)[wr * 64 + fr + ai * HALF + m * 16] : 1.0f;
#pragma unroll
                for (int bj = 0; bj < 2; ++bj) { const v4u x4 = xs[ai][m][bj]; const f32x4 a0 = acc[ai][bj][m][0] * (rsc * ds), a1 = acc[ai][bj][m][1] * (rsc * ds);
                    v4u w; w.x = cvt_pk_bf16(bflo(x4.x) * DN_ALPHA + a0[0], bfhi(x4.x) * DN_ALPHA + a0[1]); w.y = cvt_pk_bf16(bflo(x4.y) * DN_ALPHA + a0[2], bfhi(x4.y) * DN_ALPHA + a0[3]);
                    w.z = cvt_pk_bf16(bflo(x4.z) * DN_ALPHA + a1[0], bfhi(x4.z) * DN_ALPHA + a1[1]); w.w = cvt_pk_bf16(bflo(x4.w) * DN_ALPHA + a1[2], bfhi(x4.w) * DN_ALPHA + a1[3]);
                    *(GAS v4u*)(Y + off + bj * HALF) = w; } }
    }
};
struct EpiMoeGU {
    static constexpr bool PERM = true, HAS_PRE = true; static constexpr int PRE_BYTES = 1024;
    unsigned char* ws0; int L;
    __device__ __forceinline__ void pre(const Unit& u, LAS unsigned char* buf, int wid, int lane) const {
        if (wid == 0) glds16((const char*)(ws0 + WS_BGU) + ((size_t)L * NE * 2048 + ((size_t)u.e * 8 + u.pn) * 256) * 4, (unsigned)lane * 16u, buf);
    }
    __device__ __forceinline__ void operator()(const f32x4 (&acc)[2][2][4][2], const Unit& u, int wr, int wc, int fr, int fq, const LAS unsigned char* buf) const {
        OPAQUE_LANE(fr, fq);
        GAS unsigned char* ws = launder(ws0);
        const int row0 = u.rowbase + wr * 64 + fr; const int c8 = wc * 32 + 8 * fq;
        const LAS float* bp = (const LAS float*)buf + c8;
        constexpr float CS = -2.4554669595930156f, K1 = GU_DESCALE * CS, K2 = GU_DESCALE * ACT_SCALE / CS, GLO = 7.0f * CS, LLO = -6.0f * ACT_SCALE / CS, LHI = 8.0f * ACT_SCALE / CS;
        f32x2 bgc[4], blc[4];
        { const f32x4 bg0 = *(const LAS f32x4*)bp, bg1 = *(const LAS f32x4*)(bp + 4), bl0 = *(const LAS f32x4*)(bp + HALF), bl1 = *(const LAS f32x4*)(bp + HALF + 4);
          bgc[0] = __builtin_shufflevector(bg0, bg0, 0, 1) * CS; bgc[1] = __builtin_shufflevector(bg0, bg0, 2, 3) * CS; bgc[2] = __builtin_shufflevector(bg1, bg1, 0, 1) * CS; bgc[3] = __builtin_shufflevector(bg1, bg1, 2, 3) * CS;
          blc[0] = __builtin_shufflevector(bl0, bl0, 0, 1) * (ACT_SCALE / CS) + (ACT_SCALE / CS); blc[1] = __builtin_shufflevector(bl0, bl0, 2, 3) * (ACT_SCALE / CS) + (ACT_SCALE / CS);
          blc[2] = __builtin_shufflevector(bl1, bl1, 0, 1) * (ACT_SCALE / CS) + (ACT_SCALE / CS); blc[3] = __builtin_shufflevector(bl1, bl1, 2, 3) * (ACT_SCALE / CS) + (ACT_SCALE / CS); }
#pragma unroll
        for (int ai = 0; ai < 2; ++ai)
#pragma unroll
            for (int m = 0; m < 4; ++m) { const size_t eo = (size_t)(row0 + ai * HALF + m * 16) * DM + u.pn * HALF + c8;
                float a[8];
#pragma unroll
                for (int p = 0; p < 4; ++p) {
                    const f32x4 ag4 = acc[ai][0][m][p >> 1], al4 = acc[ai][1][m][p >> 1];
                    const f32x2 ag = (p & 1) ? __builtin_shufflevector(ag4, ag4, 2, 3) : __builtin_shufflevector(ag4, ag4, 0, 1);
                    const f32x2 al = (p & 1) ? __builtin_shufflevector(al4, al4, 2, 3) : __builtin_shufflevector(al4, al4, 0, 1);
                    f32x2 gc = ag * K1 + bgc[p]; gc.x = fmaxf(gc.x, GLO); gc.y = fmaxf(gc.y, GLO);
                    f32x2 lc = al * K2 + blc[p]; lc.x = __builtin_amdgcn_fmed3f(lc.x, LLO, LHI); lc.y = __builtin_amdgcn_fmed3f(lc.y, LLO, LHI);
                    f32x2 d; d.x = __builtin_amdgcn_exp2f(gc.x); d.y = __builtin_amdgcn_exp2f(gc.y); d = d + 1.0f;
                    f32x2 sg; sg.x = frcp(d.x); sg.y = frcp(d.y);
                    const f32x2 r = gc * sg * lc;
                    a[2 * p] = r.x; a[2 * p + 1] = r.y;
                }
#if MOE_FP8
                v2u w;
                { int p = __builtin_amdgcn_cvt_pk_fp8_f32(a[0], a[1], 0, false); p = __builtin_amdgcn_cvt_pk_fp8_f32(a[2], a[3], p, true); w.x = (unsigned)p; }
                { int p = __builtin_amdgcn_cvt_pk_fp8_f32(a[4], a[5], 0, false); p = __builtin_amdgcn_cvt_pk_fp8_f32(a[6], a[7], p, true); w.y = (unsigned)p; }
                *(GAS v2u*)(ws + WS_ACT + eo) = w;
#else
                v4u w; w.x = cvt_pk_bf16(a[0], a[1]); w.y = cvt_pk_bf16(a[2], a[3]); w.z = cvt_pk_bf16(a[4], a[5]); w.w = cvt_pk_bf16(a[6], a[7]);
                *(GAS v4u*)((GAS bf16*)(ws + WS_ACT) + eo) = w;
#endif
            }
    }
};
struct EpiMoeDown {
    static constexpr bool PERM = true, HAS_PRE = true; static constexpr int PRE_BYTES = 3072;
    unsigned char* ws0; const float* bias;
    __device__ __forceinline__ void pre(const Unit& u, LAS unsigned char* buf, int wid, int lane) const {
        if (wid == 0) glds16((const char*)(bias + (size_t)u.e * DM + u.pn * BM), (unsigned)lane * 16u, buf);
        if (wid == 1) glds16((const char*)(ws0 + WS_ROWDST) + (size_t)u.gidx * 4, (unsigned)lane * 16u, buf + 1024);
        if (wid == 2) glds16((const char*)(ws0 + WS_ROWGATE) + (size_t)u.gidx * 4, (unsigned)lane * 16u, buf + 2048);
    }
    __device__ __forceinline__ void operator()(const f32x4 (&acc)[2][2][4][2], const Unit& u, int wr, int wc, int fr, int fq, const LAS unsigned char* buf) const {
        OPAQUE_LANE(fr, fq);
        GAS unsigned char* ws = launder(ws0);
        GAS bf16* YS = (GAS bf16*)(ws + WS_YSLOT);
        const int c8 = u.pn * BM + wc * 32 + 8 * fq;
        const LAS float* bp = (const LAS float*)buf + wc * 32 + 8 * fq;
        f32x4 bv[2][2];
#pragma unroll
        for (int bj = 0; bj < 2; ++bj) { bv[bj][0] = *(const LAS f32x4*)(bp + bj * HALF); bv[bj][1] = *(const LAS f32x4*)(bp + bj * HALF + 4); }
#pragma unroll
        for (int ai = 0; ai < 2; ++ai)
#pragma unroll
            for (int m = 0; m < 4; ++m) { const int r = ai * HALF + wr * 64 + m * 16 + fr;
                if (r < u.cnt) {
                    const int dst = ((const LAS int*)(buf + 1024))[r]; const float gt = ((const LAS float*)(buf + 2048))[r];
#if YS_FP8
                    GAS unsigned char* rowp = (GAS unsigned char*)YS + (size_t)dst * DM + c8;
#pragma unroll
                    for (int bj = 0; bj < 2; ++bj) { const f32x4 v0 = (acc[ai][bj][m][0] * DN_DESCALE + bv[bj][0]) * (gt * 64.0f), v1 = (acc[ai][bj][m][1] * DN_DESCALE + bv[bj][1]) * (gt * 64.0f);
                        v2u w; w.x = pk4_fp8(v0[0], v0[1], v0[2], v0[3]); w.y = pk4_fp8(v1[0], v1[1], v1[2], v1[3]);
                        *(GAS v2u*)(rowp + bj * HALF) = w; } } }
#else
                    GAS bf16* rowp = YS + (size_t)dst * DM + c8;
#pragma unroll
                    for (int bj = 0; bj < 2; ++bj) { const f32x4 v0 = (acc[ai][bj][m][0] * DN_DESCALE + bv[bj][0]) * gt, v1 = (acc[ai][bj][m][1] * DN_DESCALE + bv[bj][1]) * gt;
                        v4u w; w.x = cvt_pk_bf16(v0[0], v0[1]); w.y = cvt_pk_bf16(v0[2], v0[3]); w.z = cvt_pk_bf16(v1[0], v1[1]); w.w = cvt_pk_bf16(v1[2], v1[3]);
                        *(GAS v4u*)(rowp + bj * HALF) = w; } } }
#endif
    }
};
}

typedef short s16x4 __attribute__((ext_vector_type(4)));
typedef __bf16 bf16x2_t __attribute__((ext_vector_type(2)));
__device__ __forceinline__ unsigned cvtpk(float lo, float hi) { f32x2 v = {lo, hi}; bf16x2_t b = __builtin_convertvector(v, bf16x2_t); return __builtin_bit_cast(unsigned, b); }
__device__ __forceinline__ s16x4 tr_read(const LAS unsigned char* p) { return __builtin_bit_cast(s16x4, __builtin_amdgcn_ds_read_tr16_b64_v4i16((LAS s16x4*)p)); }
__device__ __forceinline__ bf16x8 cat8(s16x4 lo, s16x4 hi) { return __builtin_shufflevector(lo, hi, 0, 1, 2, 3, 4, 5, 6, 7); }
__device__ __forceinline__ bf16x8 pack8(const f32x4& a, const f32x4& b) { v4u p; p.x = cvtpk(a[0], a[1]); p.y = cvtpk(a[2], a[3]); p.z = cvtpk(b[0], b[1]); p.w = cvtpk(b[2], b[3]); return __builtin_bit_cast(bf16x8, p); }
__device__ __forceinline__ s16x4 pack4(const f32x4& a) { v2u p; p.x = cvtpk(a[0], a[1]); p.y = cvtpk(a[2], a[3]); return __builtin_bit_cast(s16x4, p); }
#define LDS_BARRIER() do { asm volatile("s_waitcnt lgkmcnt(0)" ::: "memory"); __builtin_amdgcn_s_barrier(); asm volatile("" ::: "memory"); } while (0)
#define MFMA32(a, b, c) __builtin_amdgcn_mfma_f32_16x16x32_bf16((a), (b), (c), 0, 0, 0)
#define MFMA16(a, b, c) __builtin_amdgcn_mfma_f32_16x16x16bf16_1k((a), (b), (c), 0, 0, 0)

__device__ __forceinline__ void ret_fast(const int tid, LAS unsigned char* lds, const bf16* HB, bf16* OB) {
    constexpr int QP = 528, VP = 272, PP = 144;
    constexpr int OFF_Q = 0, OFF_K = 64 * QP, OFF_V = 2 * 64 * QP, OFF_P = OFF_V + 64 * VP;
    const int lane0 = tid & 63, w = __builtin_amdgcn_readfirstlane(tid >> 6);
    const int prow = tid >> 3, pc = tid & 7;
    for (int un0 = blockIdx.x; un0 < NBATCH * RT_HEADS * 4; un0 += gridDim.x) {
        const int un = (gridDim.x == 256) ? ((un0 & 7) * 32 + (un0 >> 3)) : un0;
        const int b = un >> 4, h = (un >> 2) & 3, vs = un & 3;
        const float l2g = __builtin_amdgcn_logf(1.0f - __builtin_amdgcn_exp2f(-5.0f - (float)h));
        const float dC = __builtin_amdgcn_exp2f(64.0f * l2g);
        f32x4 st[16];
#pragma unroll
        for (int i = 0; i < 16; ++i) st[i] = (f32x4){0.f, 0.f, 0.f, 0.f};
        const bf16* gbase = HB + (size_t)(b * SEQ + prow) * RT_IN;
        v4u pq[4], pk[4], pv[2];
#pragma unroll
        for (int j = 0; j < 4; ++j) { pq[j] = *(const v4u*)(gbase + h * 256 + (pc + 8 * j) * 8); pk[j] = *(const v4u*)(gbase + 1024 + h * 256 + (pc + 8 * j) * 8); }
#pragma unroll
        for (int j = 0; j < 2; ++j) pv[j] = *(const v4u*)(gbase + 2048 + h * 512 + vs * 128 + (pc + 8 * j) * 8);
#pragma unroll 1
        for (int ch = 0; ch < SEQ / 64; ++ch) {
            int lane = lane0; asm volatile("" : "+v"(lane));
            const int r = lane & 15, g = lane >> 4, q4 = (lane & 15) >> 2, p4 = lane & 3;
            LDS_BARRIER();
#pragma unroll
            for (int j = 0; j < 4; ++j) { *(LAS v4u*)(lds + OFF_Q + prow * QP + (pc + 8 * j) * 16) = pq[j]; *(LAS v4u*)(lds + OFF_K + prow * QP + (pc + 8 * j) * 16) = pk[j]; }
#pragma unroll
            for (int j = 0; j < 2; ++j) *(LAS v4u*)(lds + OFF_V + prow * VP + (pc + 8 * j) * 16) = pv[j];
            if (ch + 1 < SEQ / 64) {
                const bf16* gn = gbase + (size_t)(ch + 1) * 64 * RT_IN;
#pragma unroll
                for (int j = 0; j < 4; ++j) { pq[j] = *(const v4u*)(gn + h * 256 + (pc + 8 * j) * 8); pk[j] = *(const v4u*)(gn + 1024 + h * 256 + (pc + 8 * j) * 8); }
#pragma unroll
                for (int j = 0; j < 2; ++j) pv[j] = *(const v4u*)(gn + 2048 + h * 512 + vs * 128 + (pc + 8 * j) * 8);
            }
            LDS_BARRIER();
            {
                const int ct = w >> 1, st0 = 2 * (w & 1);
                f32x4 sa0 = {0.f, 0.f, 0.f, 0.f}, sa1 = {0.f, 0.f, 0.f, 0.f};
                const LAS unsigned char* qb = lds + OFF_Q + (16 * ct + r) * QP + g * 16;
                const LAS unsigned char* kb0 = lds + OFF_K + (16 * st0 + r) * QP + g * 16;
#pragma unroll
                for (int hb = 0; hb < 4; ++hb) {
                    bf16x8 qf[2], k0[2], k1[2];
#pragma unroll
                    for (int kk = 0; kk < 2; ++kk) { const int kb = hb * 2 + kk; qf[kk] = *(const LAS bf16x8*)(qb + kb * 64); k0[kk] = *(const LAS bf16x8*)(kb0 + kb * 64); k1[kk] = *(const LAS bf16x8*)(kb0 + 16 * QP + kb * 64); }
                    asm volatile("" : "+v"(qf[0]), "+v"(qf[1]), "+v"(k0[0]), "+v"(k0[1]), "+v"(k1[0]), "+v"(k1[1]) :: "memory");
#pragma unroll
                    for (int kk = 0; kk < 2; ++kk) { sa0 = MFMA32(k0[kk], qf[kk], sa0); sa1 = MFMA32(k1[kk], qf[kk], sa1); }
                }
                asm volatile("s_nop 7\n\ts_nop 7" : "+v"(sa0), "+v"(sa1));
                const int c = 16 * ct + r;
#pragma unroll
                for (int t = 0; t < 2; ++t) {
                    const f32x4 sa = t ? sa1 : sa0; const int s0 = 16 * (st0 + t) + 4 * g; float v[4];
#pragma unroll
                    for (int i = 0; i < 4; ++i) { const int d = c - (s0 + i); v[i] = d >= 0 ? sa[i] * __builtin_amdgcn_exp2f((float)d * l2g) : 0.f; }
                    v2u pw; pw.x = cvtpk(v[0], v[1]); pw.y = cvtpk(v[2], v[3]);
                    *(LAS v2u*)(lds + OFF_P + c * PP + s0 * 2) = pw;
                }
            }
            LDS_BARRIER();
            f32x4 o[4];
#pragma unroll
            for (int ct = 0; ct < 4; ++ct) o[ct] = (f32x4){0.f, 0.f, 0.f, 0.f};
            {
                s16x4 ql[2][4], qh[2][4];
                const LAS unsigned char* qp0 = lds + OFF_Q + r * QP + (4 * g) * 2;
#pragma unroll
                for (int ct = 0; ct < 4; ++ct) { ql[0][ct] = *(const LAS s16x4*)(qp0 + ct * 16 * QP); qh[0][ct] = *(const LAS s16x4*)(qp0 + ct * 16 * QP + 32); }
#pragma unroll
                for (int kb = 0; kb < 8; ++kb) {
                    const int cu = kb & 1, nx = cu ^ 1;
                    if (kb + 1 < 8) {
#pragma unroll
                        for (int ct = 0; ct < 4; ++ct) { ql[nx][ct] = *(const LAS s16x4*)(qp0 + ct * 16 * QP + (kb + 1) * 64); qh[nx][ct] = *(const LAS s16x4*)(qp0 + ct * 16 * QP + (kb + 1) * 64 + 32); }
                    }
                    asm volatile("" : "+v"(ql[cu][0]), "+v"(ql[cu][1]), "+v"(ql[cu][2]), "+v"(ql[cu][3]), "+v"(qh[cu][0]), "+v"(qh[cu][1]), "+v"(qh[cu][2]), "+v"(qh[cu][3]) :: "memory");
                    const bf16x8 sa = pack8(st[2 * kb], st[2 * kb + 1]);
#pragma unroll
                    for (int ct = 0; ct < 4; ++ct) o[ct] = MFMA32(sa, cat8(ql[cu][ct], qh[cu][ct]), o[ct]);
                }
            }
            bf16x8 vf[2], pf[6];
            {
                s16x4 t0[2], t1[2];
#pragma unroll
                for (int sb = 0; sb < 2; ++sb) { const LAS unsigned char* vp = lds + OFF_V + (32 * sb + 8 * g + q4) * VP + (16 * w + 4 * p4) * 2; t0[sb] = tr_read(vp); t1[sb] = tr_read(vp + 4 * VP); }
                pf[0] = *(const LAS bf16x8*)(lds + OFF_P + (0 + r) * PP + (8 * g) * 2);
                pf[1] = *(const LAS bf16x8*)(lds + OFF_P + (16 + r) * PP + (8 * g) * 2);
                pf[2] = *(const LAS bf16x8*)(lds + OFF_P + (32 + r) * PP + (8 * g) * 2);
                pf[3] = *(const LAS bf16x8*)(lds + OFF_P + (32 + r) * PP + (32 + 8 * g) * 2);
                pf[4] = *(const LAS bf16x8*)(lds + OFF_P + (48 + r) * PP + (8 * g) * 2);
                pf[5] = *(const LAS bf16x8*)(lds + OFF_P + (48 + r) * PP + (32 + 8 * g) * 2);
                asm volatile("" : "+v"(t0[0]), "+v"(t0[1]), "+v"(t1[0]), "+v"(t1[1]), "+v"(pf[0]), "+v"(pf[1]), "+v"(pf[2]), "+v"(pf[3]), "+v"(pf[4]), "+v"(pf[5]) :: "memory");
                vf[0] = cat8(t0[0], t1[0]); vf[1] = cat8(t0[1], t1[1]);
            }
            asm volatile("s_nop 7\n\ts_nop 7" : "+v"(o[0]), "+v"(o[1]), "+v"(o[2]), "+v"(o[3]));
#pragma unroll
            for (int ct = 0; ct < 4; ++ct) o[ct] = o[ct] * __builtin_amdgcn_exp2f((float)(16 * ct + r + 1) * l2g);
            o[0] = MFMA32(vf[0], pf[0], o[0]); o[1] = MFMA32(vf[0], pf[1], o[1]);
            o[2] = MFMA32(vf[0], pf[2], o[2]); o[2] = MFMA32(vf[1], pf[3], o[2]);
            o[3] = MFMA32(vf[0], pf[4], o[3]); o[3] = MFMA32(vf[1], pf[5], o[3]);
            asm volatile("s_nop 7\n\ts_nop 7" : "+v"(o[0]), "+v"(o[1]), "+v"(o[2]), "+v"(o[3]));
            {
                bf16* ob = OB + (size_t)(b * SEQ + ch * 64 + r) * RT_VD + h * 512 + vs * 128 + 16 * w + 4 * g;
#pragma unroll
                for (int ct = 0; ct < 4; ++ct) { v2u ow; ow.x = cvtpk(o[ct][0], o[ct][1]); ow.y = cvtpk(o[ct][2], o[ct][3]); *(v2u*)(ob + (size_t)ct * 16 * RT_VD) = ow; }
            }
            bf16x8 vz[2];
#pragma unroll
            for (int sb = 0; sb < 2; ++sb) {
                const v4u raw = __builtin_bit_cast(v4u, vf[sb]); float f[8] = {bflo(raw.x), bfhi(raw.x), bflo(raw.y), bfhi(raw.y), bflo(raw.z), bfhi(raw.z), bflo(raw.w), bfhi(raw.w)};
#pragma unroll
                for (int j = 0; j < 8; ++j) f[j] *= __builtin_amdgcn_exp2f((float)(63 - (32 * sb + 8 * g + j)) * l2g);
                v4u z; z.x = cvtpk(f[0], f[1]); z.y = cvtpk(f[2], f[3]); z.z = cvtpk(f[4], f[5]); z.w = cvtpk(f[6], f[7]); vz[sb] = __builtin_bit_cast(bf16x8, z);
            }
            {
                const LAS unsigned char* kp0 = lds + OFF_K + (8 * g + q4) * QP + (4 * p4) * 2;
#pragma unroll
                for (int kq = 0; kq < 4; ++kq) {
                    s16x4 ka[4][2], kbh[4][2];
#pragma unroll
                    for (int j = 0; j < 4; ++j)
#pragma unroll
                        for (int sb = 0; sb < 2; ++sb) { const LAS unsigned char* kp = kp0 + (32 * sb) * QP + (16 * (kq * 4 + j)) * 2; ka[j][sb] = tr_read(kp); kbh[j][sb] = tr_read(kp + 4 * QP); }
                    asm volatile("" : "+v"(ka[0][0]), "+v"(ka[0][1]), "+v"(ka[1][0]), "+v"(ka[1][1]), "+v"(ka[2][0]), "+v"(ka[2][1]), "+v"(ka[3][0]), "+v"(ka[3][1]),
                                      "+v"(kbh[0][0]), "+v"(kbh[0][1]), "+v"(kbh[1][0]), "+v"(kbh[1][1]), "+v"(kbh[2][0]), "+v"(kbh[2][1]), "+v"(kbh[3][0]), "+v"(kbh[3][1]) :: "memory");
#pragma unroll
                    for (int j = 0; j < 4; ++j) { const int kt = kq * 4 + j;
                        st[kt] = st[kt] * dC;
                        st[kt] = MFMA32(cat8(ka[j][0], kbh[j][0]), vz[0], st[kt]);
                        st[kt] = MFMA32(cat8(ka[j][1], kbh[j][1]), vz[1], st[kt]); }
                }
            }
        }
        LDS_BARRIER();
    }
}

__device__ __forceinline__ void hgrn_fast(const int tid, LAS unsigned char* lds, const bf16* QD, const bf16* KI, const bf16* GG, const bf16* VV, const float* DEC, const float* ng, bf16* A2, float* SS) {
    constexpr int TP = 272;
    constexpr int TPH = 144;
    constexpr int OFF_QD = 0, OFF_KI = 64 * TP, OFF_G = 2 * 64 * TP, OFF_V = OFF_G + 64 * TPH, OFF_DEC = OFF_V + 64 * TPH, OFF_SS = OFF_DEC + 2048;
    const int lane = tid & 63, w = __builtin_amdgcn_readfirstlane(tid >> 6), r = lane & 15, g = lane >> 4, q4 = (lane & 15) >> 2, p4 = lane & 3;
    const int prow = tid >> 3, pc = tid & 7;
    for (int un0 = blockIdx.x; un0 < NBATCH * HG_HEADS * 2; un0 += gridDim.x) {
        const int un = (gridDim.x == 256) ? ((((un0 & 7) * 16 + (un0 >> 4)) << 1) | ((un0 >> 3) & 1)) : un0;
        const int b = un >> 4, h = (un >> 1) & 7, vh = un & 1, wv = vh * 4 + (w & 3);
        f32x4 st[8];
#pragma unroll
        for (int i = 0; i < 8; ++i) st[i] = (f32x4){0.f, 0.f, 0.f, 0.f};
        const f32x4 ng4 = *(const f32x4*)(ng + h * 128 + 16 * wv + 4 * g);
        const size_t goff = (size_t)(b * SEQ + prow) * DM + h * 128;
        v4u p0[2], p1[2], p2, p3; f32x4 pd = {0.f, 0.f, 0.f, 0.f};
#pragma unroll
        for (int j = 0; j < 2; ++j) { const size_t o = goff + (pc + 8 * j) * 8; p0[j] = *(const v4u*)(QD + o); p1[j] = *(const v4u*)(KI + o); }
        p2 = *(const v4u*)(GG + goff + vh * 64 + pc * 8); p3 = *(const v4u*)(VV + goff + vh * 64 + pc * 8);
        if (tid < 128) pd = *(const f32x4*)(DEC + (size_t)((b * SEQ) / 16 + (tid >> 5)) * DM + h * 128 + (tid & 31) * 4);
#pragma unroll 1
        for (int rd = 0; rd < SEQ / 64; ++rd) {
            LDS_BARRIER();
            if (rd > 0 && tid < 64) {
                float s = 0.f;
#pragma unroll
                for (int ww = 0; ww < 4; ++ww) s += *(const LAS float*)(lds + OFF_SS + (ww * 64 + tid) * 4);
                SS[(size_t)(h * 2 + vh) * NTOK + (size_t)b * SEQ + (rd - 1) * 64 + tid] = s;
            }
#pragma unroll
            for (int j = 0; j < 2; ++j) { const int lo = prow * TP + (pc + 8 * j) * 16; *(LAS v4u*)(lds + OFF_QD + lo) = p0[j]; *(LAS v4u*)(lds + OFF_KI + lo) = p1[j]; }
            *(LAS v4u*)(lds + OFF_G + prow * TPH + pc * 16) = p2; *(LAS v4u*)(lds + OFF_V + prow * TPH + pc * 16) = p3;
            if (tid < 128) *(LAS f32x4*)(lds + OFF_DEC + tid * 16) = pd;
            if (rd + 1 < SEQ / 64) {
                const size_t gn = goff + (size_t)(rd + 1) * 64 * DM;
#pragma unroll
                for (int j = 0; j < 2; ++j) { const size_t o = gn + (pc + 8 * j) * 8; p0[j] = *(const v4u*)(QD + o); p1[j] = *(const v4u*)(KI + o); }
                p2 = *(const v4u*)(GG + gn + vh * 64 + pc * 8); p3 = *(const v4u*)(VV + gn + vh * 64 + pc * 8);
                if (tid < 128) pd = *(const f32x4*)(DEC + (size_t)((b * SEQ + (rd + 1) * 64) / 16 + (tid >> 5)) * DM + h * 128 + (tid & 31) * 4);
            }
            LDS_BARRIER();
            if (w < 4)
#pragma unroll 1
            for (int cc = 0; cc < 4; ++cc) {
                s16x4 ql[4], qh[4], kl[4], kh[4], ktr[8]; f32x4 d4[8];
#pragma unroll
                for (int kb = 0; kb < 4; ++kb) {
                    const int off = (16 * cc + r) * TP + (32 * kb + 4 * g) * 2;
                    ql[kb] = *(const LAS s16x4*)(lds + OFF_QD + off); qh[kb] = *(const LAS s16x4*)(lds + OFF_QD + off + 32);
                    kl[kb] = *(const LAS s16x4*)(lds + OFF_KI + off); kh[kb] = *(const LAS s16x4*)(lds + OFF_KI + off + 32);
                }
                s16x4 vfr = tr_read(lds + OFF_V + (16 * cc + 4 * g + q4) * TPH + (16 * (w & 3) + 4 * p4) * 2);
                s16x4 gfr = *(const LAS s16x4*)(lds + OFF_G + (16 * cc + r) * TPH + (16 * (w & 3) + 4 * g) * 2);
#pragma unroll
                for (int kt = 0; kt < 8; ++kt) {
                    d4[kt] = *(const LAS f32x4*)(lds + OFF_DEC + cc * 512 + (16 * kt + 4 * g) * 4);
                    ktr[kt] = tr_read(lds + OFF_KI + (16 * cc + 4 * g + q4) * TP + (16 * kt + 4 * p4) * 2);
                }
                asm volatile("" : "+v"(ql[0]), "+v"(ql[1]), "+v"(ql[2]), "+v"(ql[3]), "+v"(qh[0]), "+v"(qh[1]), "+v"(qh[2]), "+v"(qh[3]),
                                  "+v"(kl[0]), "+v"(kl[1]), "+v"(kl[2]), "+v"(kl[3]), "+v"(kh[0]), "+v"(kh[1]), "+v"(kh[2]), "+v"(kh[3]), "+v"(vfr), "+v"(gfr));
                asm volatile("" : "+v"(ktr[0]), "+v"(ktr[1]), "+v"(ktr[2]), "+v"(ktr[3]), "+v"(ktr[4]), "+v"(ktr[5]), "+v"(ktr[6]), "+v"(ktr[7]),
                                  "+v"(d4[0]), "+v"(d4[1]), "+v"(d4[2]), "+v"(d4[3]), "+v"(d4[4]), "+v"(d4[5]), "+v"(d4[6]), "+v"(d4[7]));
                bf16x8 qf[4];
#pragma unroll
                for (int kb = 0; kb < 4; ++kb) qf[kb] = cat8(ql[kb], qh[kb]);
                f32x4 sc = {0.f, 0.f, 0.f, 0.f}, oa = {0.f, 0.f, 0.f, 0.f};
#pragma unroll
                for (int kb = 0; kb < 4; ++kb) sc = MFMA32(cat8(kl[kb], kh[kb]), qf[kb], sc);
#pragma unroll
                for (int kb = 0; kb < 4; ++kb) oa = MFMA32(pack8(st[2 * kb], st[2 * kb + 1]), qf[kb], oa);
#pragma unroll
                for (int kt = 0; kt < 8; ++kt) st[kt] = MFMA16(ktr[kt], vfr, st[kt]);
                asm volatile("s_nop 7\n\ts_nop 7" : "+v"(st[0]), "+v"(st[1]), "+v"(st[2]), "+v"(st[3]), "+v"(st[4]), "+v"(st[5]), "+v"(st[6]), "+v"(st[7]), "+v"(sc), "+v"(oa));
#pragma unroll
                for (int kt = 0; kt < 8; ++kt) st[kt] = st[kt] * d4[kt];
#pragma unroll
                for (int i = 0; i < 4; ++i) sc[i] = (4 * g + i <= r) ? sc[i] : 0.f;
                oa = MFMA16(vfr, pack4(sc), oa);
                asm volatile("s_nop 7\n\ts_nop 7" : "+v"(oa));
                { const v2u gr = __builtin_bit_cast(v2u, gfr);
                  v2u ow; ow.x = cvtpk(oa[0] * ng4[0] * bflo(gr.x), oa[1] * ng4[1] * bfhi(gr.x)); ow.y = cvtpk(oa[2] * ng4[2] * bflo(gr.y), oa[3] * ng4[3] * bfhi(gr.y));
                  *(v2u*)(A2 + (size_t)(b * SEQ + rd * 64 + cc * 16 + r) * DM + h * 128 + 16 * wv + 4 * g) = ow;
                  float p = (oa[0] * oa[0] + oa[1] * oa[1]) + (oa[2] * oa[2] + oa[3] * oa[3]);
                  { const unsigned pb = __builtin_bit_cast(unsigned, p); auto sw = __builtin_amdgcn_permlane16_swap(pb, pb, false, false); p = __builtin_bit_cast(float, (unsigned)sw[0]) + __builtin_bit_cast(float, (unsigned)sw[1]); }
                  { const unsigned pb = __builtin_bit_cast(unsigned, p); auto sw = __builtin_amdgcn_permlane32_swap(pb, pb, false, false); p = __builtin_bit_cast(float, (unsigned)sw[0]) + __builtin_bit_cast(float, (unsigned)sw[1]); }
                  if (lane < 16) *(LAS float*)(lds + OFF_SS + (w * 64 + cc * 16 + r) * 4) = p; }
            }
        }
        LDS_BARRIER();
        if (tid < 64) { float s = 0.f;
#pragma unroll
            for (int ww = 0; ww < 4; ++ww) s += *(const LAS float*)(lds + OFF_SS + (ww * 64 + tid) * 4);
            SS[(size_t)(h * 2 + vh) * NTOK + (size_t)b * SEQ + (SEQ / 64 - 1) * 64 + tid] = s; }
        LDS_BARRIER();
    }
}

struct Args { const float* in[17]; float* out; unsigned char* ws; int ph_lo, ph_hi; };
enum { I_X = 0, I_HWIN, I_HNG, I_HWOUT, I_LB, I_RWIN, I_RWOUT, I_LNMG, I_LNMB, I_LNFG, I_LNFB, I_RW, I_RB, I_WGU, I_BGU, I_WDN, I_BDN };

__device__ __forceinline__ int dest_row(int mode, int n) {
    if (mode == 1) { if (n < 1024) return ((n >> 7) << 8) + (n & 127); if (n < 2048) { const int q = n - 1024; return ((q >> 7) << 8) + 128 + (q & 127); } return n; }
    if (mode == 2) { const int j2 = n >> 1; return ((j2 >> 7) << 8) + ((n & 1) << 7) + (j2 & 127); }
    return n;
}
__device__ __forceinline__ void transpose_item(const float* W, int K, int N, bf16* WT, int mode, LAS float* scr, int item, int lane) {
    const int nblk = N / 64, kb = item / nblk, nb = item % nblk, k0 = 64 * kb, n0 = 64 * nb;
#pragma unroll 4
    for (int i = 0; i < 16; ++i) { const int kk = 4 * i + (lane >> 4), c4 = (lane & 15) * 4;
        const f32x4 v = *(const GAS f32x4*)(W + (size_t)(k0 + kk) * N + n0 + c4);
        LAS float* s = scr + kk * 65 + c4; s[0] = v[0]; s[1] = v[1]; s[2] = v[2]; s[3] = v[3]; }
    LDS_WAIT(); asm volatile("" ::: "memory");
    const int c = lane & 7;
#pragma unroll 2
    for (int j = 0; j < 8; ++j) { const int n = (lane >> 3) + 8 * j; const LAS float* s = scr + (8 * c) * 65 + n;
        v4u o; o.x = pk2(s[0 * 65], s[1 * 65]); o.y = pk2(s[2 * 65], s[3 * 65]); o.z = pk2(s[4 * 65], s[5 * 65]); o.w = pk2(s[6 * 65], s[7 * 65]);
        *(GAS v4u*)(WT + (size_t)dest_row(mode, n0 + n) * K + k0 + 8 * c) = o; }
    LDS_WAIT(); asm volatile("" ::: "memory");
}

__device__ __forceinline__ void transpose_item_fp8(const float* W, int K, int N, unsigned char* WT, int mode, float scale, LAS float* scr, int item, int lane) {
    const int nblk = N / 64, kb = item / nblk, nb = item % nblk, k0 = 64 * kb, n0 = 64 * nb;
#pragma unroll 4
    for (int i = 0; i < 16; ++i) { const int kk = 4 * i + (lane >> 4), c4 = (lane & 15) * 4;
        const f32x4 v = *(const GAS f32x4*)(W + (size_t)(k0 + kk) * N + n0 + c4);
        LAS float* s = scr + kk * 65 + c4; s[0] = v[0]; s[1] = v[1]; s[2] = v[2]; s[3] = v[3]; }
    LDS_WAIT(); asm volatile("" ::: "memory");
    const int c = lane & 7;
#pragma unroll 2
    for (int j = 0; j < 8; ++j) { const int n = (lane >> 3) + 8 * j; const LAS float* s = scr + (8 * c) * 65 + n;
        v2u o; o.x = pk4_fp8(s[0 * 65] * scale, s[1 * 65] * scale, s[2 * 65] * scale, s[3 * 65] * scale); o.y = pk4_fp8(s[4 * 65] * scale, s[5 * 65] * scale, s[6 * 65] * scale, s[7 * 65] * scale);
        *(GAS v2u*)(WT + (size_t)dest_row(mode, n0 + n) * K + k0 + 8 * c) = o; }
    LDS_WAIT(); asm volatile("" ::: "memory");
}

#ifndef SITE_MASK
#define SITE_MASK 0xffff
#endif
#define SITE(n) (((SITE_MASK) >> (n)) & 1)
#ifndef PROBE_MASK
#define PROBE_MASK 0
#endif
#define REP(n) (1 + (((PROBE_MASK) >> (n)) & 1))
typedef const __attribute__((address_space(4))) Args* KArgs;
__device__ __forceinline__ int otid(int wave0) { int l; asm volatile("v_mbcnt_lo_u32_b32 %0, -1, 0\n\tv_mbcnt_hi_u32_b32 %0, -1, %0" : "=v"(l)); asm volatile("" : "+s"(wave0)); return wave0 * 64 + l; }
__device__ __forceinline__ LAS unsigned char* olds(LAS unsigned char* p) { asm volatile("" : "+s"(p)); return p; }
__device__ __forceinline__ KArgs kargs() { KArgs p = (KArgs)__builtin_amdgcn_kernarg_segment_ptr(); asm volatile("" : "+s"(p)); return p; }
#define IN(k) (ap->ph_lo <= (k) && (k) < ap->ph_hi)
#ifndef PROBE_BAR
#define PROBE_BAR 1
#endif
#define GRID_BAR() for (int _r = 0; _r < PROBE_BAR; ++_r) do { if (ap->ph_hi - ap->ph_lo > 1) { XcdBarrier _b; _b.bar = (unsigned*)(ap->ws + WS_CTL) + CW_BAR; _b.x = xb_xcc_id(); _b.st = (volatile LAS unsigned*)(lds + MISC_OFF + MO_BARW); xcd_barrier(_b); } } while (0)
#define VCU() ((gridDim.x % 8 == 0) ? (int)((blockIdx.x % 8) * (gridDim.x / 8) + blockIdx.x / 8) : (int)blockIdx.x)

__global__ void __launch_bounds__(512, 2) mk_fwd(Args args_unused) {
    extern __shared__ __attribute__((aligned(16))) unsigned char lds_raw[];
    LAS unsigned char* const lds0 = (LAS unsigned char*)lds_raw;
    const int wave0 = __builtin_amdgcn_readfirstlane((int)(threadIdx.x >> 6));
    {
        LAS unsigned char* lds = lds0;
        for (int u = threadIdx.x; u < (LDS_BYTES - MISC_OFF) / 4; u += 512) ((LAS unsigned*)(lds + MISC_OFF))[u] = 0u;
        __syncthreads();
        KArgs ap = kargs();
        if (ap->ph_hi - ap->ph_lo > 1) (void)xcd_barrier_post((unsigned*)(ap->ws + WS_CTL) + CW_BAR, (volatile LAS unsigned*)(lds + MISC_OFF + MO_BARW));
    }

#if SITE(0)
    { KArgs ap = kargs(); const int tid = otid(wave0); LAS unsigned char* lds = olds(lds0); (void)tid;
    if (IN(0)) for (int rep_ = 0; rep_ < REP(0); ++rep_) {
        const int lane = tid & 63, wave = __builtin_amdgcn_readfirstlane(tid >> 6), G = gridDim.x, vcu = VCU(), gw = vcu * 8 + wave, NGW = G * 8;
        unsigned char* ws = ap->ws;
        LAS float* scr = (LAS float*)(lds + wave * 16640);
        constexpr int I_HIN = 2 * 16 * 64, I_HOUT = 2 * 16 * 16, I_RIN = 2 * 16 * 96, I_ROUT = 2 * 32 * 16, I_GU = 128 * 16 * 32, I_DN = 128 * 16 * 16;
        constexpr int NITEMS = I_HIN + I_HOUT + I_RIN + I_ROUT + I_GU + I_DN + I_ROUT;
        for (int it = gw; it < NITEMS; it += NGW) {
            int r = it;
            if (r < I_HIN) { const int j = r / (16 * 64); transpose_item(ap->in[I_HWIN] + (size_t)j * DM * HG_IN, DM, HG_IN, (bf16*)(ws + WS_W_HIN) + (size_t)j * HG_IN * DM, 1, scr, r % (16 * 64), lane); continue; } r -= I_HIN;
            if (r < I_HOUT) { const int j = r / 256; transpose_item(ap->in[I_HWOUT] + (size_t)j * DM * DM, DM, DM, (bf16*)(ws + WS_W_HOUT) + (size_t)j * DM * DM, 0, scr, r % 256, lane); continue; } r -= I_HOUT;
            if (r < I_RIN) { const int j = r / (16 * 96); transpose_item(ap->in[I_RWIN] + (size_t)j * DM * RT_IN, DM, RT_IN, (bf16*)(ws + WS_W_RIN) + (size_t)j * RT_IN * DM, 0, scr, r % (16 * 96), lane); continue; } r -= I_RIN;
            if (r < I_ROUT) { const int j = r / 512; transpose_item(ap->in[I_RWOUT] + (size_t)j * RT_VD * DM, RT_VD, DM, (bf16*)(ws + WS_W_ROUT) + (size_t)j * DM * RT_VD, 0, scr, r % 512, lane); continue; } r -= I_ROUT;
#if MOE_FP8
            if (r < I_GU) { const int j = r / 512; transpose_item_fp8(ap->in[I_WGU] + (size_t)j * DM * 2048, DM, 2048, ws + WS_W_GU + (size_t)j * 2048 * DM, 2, WGU_SCALE, scr, r % 512, lane); continue; } r -= I_GU;
            if (r < I_DN) { const int j = r / 256; transpose_item_fp8(ap->in[I_WDN] + (size_t)j * DM * DM, DM, DM, ws + WS_W_DN + (size_t)j * DM * DM, 0, WDN_SCALE, scr, r % 256, lane); continue; } r -= I_DN;
            { const int j = r / 512; transpose_item_fp8(ap->in[I_RWOUT] + (size_t)j * RT_VD * DM, RT_VD, DM, ws + WS_W_ROUT8 + (size_t)j * DM * RT_VD, 0, 128.0f, scr, r % 512, lane); }
#else
            if (r < I_GU) { const int j = r / 512; transpose_item(ap->in[I_WGU] + (size_t)j * DM * 2048, DM, 2048, (bf16*)(ws + WS_W_GU) + (size_t)j * 2048 * DM, 2, scr, r % 512, lane); continue; } r -= I_GU;
            { const int j = r / 256; transpose_item(ap->in[I_WDN] + (size_t)j * DM * DM, DM, DM, (bf16*)(ws + WS_W_DN) + (size_t)j * DM * DM, 0, scr, r % 256, lane); }
#endif
        }
        const int gt = vcu * 512 + tid, NGT = G * 512;
        float* LBS = (float*)(ws + WS_LBS); float* BGU = (float*)(ws + WS_BGU); bf16* XB = (bf16*)(ws + WS_XB);
        for (int d = gt; d < DM; d += NGT) { const float* lbp = ap->in[I_LB]; const float v0 = lbp[d], v1 = lbp[DM + d], v2 = lbp[2 * DM + d], v3 = lbp[3 * DM + d]; const float mx = fmaxf(fmaxf(v0, v1), fmaxf(v2, v3));
            const float e0 = __expf(v0 - mx), e1 = __expf(v1 - mx), e2 = __expf(v2 - mx), e3 = __expf(v3 - mx), is = 1.0f / (e0 + e1 + e2 + e3);
            LBS[d] = 0.f; LBS[DM + d] = e1 * is; LBS[2 * DM + d] = (e1 + e2) * is; LBS[3 * DM + d] = (e1 + e2 + e3) * is; }
        for (int i = gt; i < 4 * DM * NE; i += NGT) { const int l = i >> 15, d = (i >> 5) & 1023, e = i & 31; const float wv = ap->in[I_RW][i]; const unsigned hb = f2bf(wv); const float hv = __builtin_bit_cast(float, hb << 16);
            ((bf16*)(ws + WS_WRH))[(size_t)l * 32768 + e * 1024 + d] = (bf16)hb; ((bf16*)(ws + WS_WRL))[(size_t)l * 32768 + e * 1024 + d] = (bf16)f2bf(wv - hv); }
        for (int i = gt; i < 4 * 32 * 2048; i += NGT) { const int le = i >> 11, n = i & 2047; BGU[(size_t)le * 2048 + dest_row(2, n)] = ap->in[I_BGU][i]; }
        for (size_t i = (size_t)gt; i < (size_t)NTOK * DM / 4; i += NGT) { const f32x4 v = ((const f32x4*)ap->in[I_X])[i]; v2u o; o.x = pk2(v[0], v[1]); o.y = pk2(v[2], v[3]); ((v2u*)XB)[i] = o; }
        GRID_BAR();
    } }
#endif

#pragma unroll 1
    for (int L = 0; L < DEPTH; ++L) {
        const int pb = 1 + 8 * L;
        if ((L & 1) == 0) {
#if SITE(1)
            { KArgs ap = kargs(); const int tid = otid(wave0); LAS unsigned char* lds = olds(lds0); (void)tid;
            if (IN(pb + 0)) for (int rep_ = 0; rep_ < REP(1); ++rep_) {
                unsigned char* ws = ap->ws; const int j = L >> 1;
                LAS int* ul = (LAS int*)(lds + MISC_OFF + MO_ULIST);
                pg8::build_units_dense(tid, ul, NTOK / 256, HG_IN / 256, DM * 2);
                pg8::EpiHgrnIn E{ws, L};
                pg8::gemm_phase<pg8::EpiHgrnIn, false, true, false>(tid, lds, ul, (LAS int*)(lds + MISC_OFF + MO_GTAB), (const char*)(ws + WS_XB), (const char*)((bf16*)(ws + WS_W_HIN) + (size_t)j * HG_IN * DM), nullptr, DM * 2, E, lds + MISC_OFF + MO_GTAB);
                GRID_BAR();
            } }
#endif
#if SITE(2)
            { KArgs ap = kargs(); const int tid = otid(wave0); LAS unsigned char* lds = olds(lds0); (void)tid;
            if (IN(pb + 1)) for (int rep_ = 0; rep_ < REP(2); ++rep_) {
#if !SLOW_HGRN
                { unsigned char* ws = ap->ws; const bf16* QD = (const bf16*)(ws + WS_H);
                  hgrn_fast(tid, lds, QD, QD + (size_t)NTOK * DM, QD + 4 * (size_t)NTOK * DM, QD + 3 * (size_t)NTOK * DM, (const float*)(ws + WS_DEC), ap->in[I_HNG] + (L >> 1) * DM,
                            (bf16*)(ws + WS_A2), (float*)(ws + WS_SSP)); }
#else
                unsigned char* ws = ap->ws; const bf16* QD = (const bf16*)(ws + WS_H); const bf16* KI = QD + (size_t)NTOK * DM; const bf16* KS = QD + 2 * (size_t)NTOK * DM; const bf16* VV = QD + 3 * (size_t)NTOK * DM; bf16* OB = (bf16*)(ws + WS_O);
                LAS float* qf = (LAS float*)lds; LAS float* kf = qf + 16 * 4 * 36; LAS float* ff = kf + 16 * 4 * 36; LAS float* vf = ff + 16 * 4 * 36;
                for (int un = blockIdx.x; un < NBATCH * HG_HEADS; un += gridDim.x) {
                    const int b = un >> 3, h = un & 7; const int vc = tid >> 2, kq = tid & 3;
                    float st[32];
#pragma unroll
                    for (int i = 0; i < 32; ++i) st[i] = 0.f;
                    for (int t0 = 0; t0 < SEQ; t0 += 16) {
                        __syncthreads();
                        for (int e = tid; e < 16 * 128; e += 512) { const int tt = e >> 7, k = e & 127; const size_t gi = (size_t)(b * SEQ + t0 + tt) * DM + h * 128 + k; const int li = tt * 144 + (k & 3) * 36 + (k >> 2);
                            qf[li] = bf1(QD[gi]); kf[li] = bf1(KI[gi]); ff[li] = bf1(KS[gi]); vf[tt * 128 + k] = bf1(VV[gi]); }
                        __syncthreads();
                        for (int tt = 0; tt < 16; ++tt) {
                            const float v = vf[tt * 128 + vc]; float a = 0.f; const int lb = tt * 144 + kq * 36;
#pragma unroll
                            for (int i = 0; i < 32; ++i) { st[i] = ff[lb + i] * st[i] + kf[lb + i] * v; a += qf[lb + i] * st[i]; }
                            a += __shfl_xor(a, 1); a += __shfl_xor(a, 2);
                            if (kq == 0) OB[(size_t)(b * SEQ + t0 + tt) * DM + h * 128 + vc] = (bf16)f2bf(a);
                        }
                    }
                }
#endif
                GRID_BAR();
            } }
#endif
#if SITE(3) && SLOW_HGRN
            { KArgs ap = kargs(); const int tid = otid(wave0); LAS unsigned char* lds = olds(lds0); (void)tid;
            if (IN(pb + 2)) for (int rep_ = 0; rep_ < REP(3); ++rep_) {
                const int lane = tid & 63, wave = __builtin_amdgcn_readfirstlane(tid >> 6), gw = VCU() * 8 + wave, NGW = gridDim.x * 8;
                unsigned char* ws = ap->ws; const bf16* OB = (const bf16*)(ws + WS_O); const bf16* GG = (const bf16*)(ws + WS_H) + 4 * (size_t)NTOK * DM; bf16* A2 = (bf16*)(ws + WS_A2);
                const float* ng = ap->in[I_HNG] + (L >> 1) * DM;
                f32x4 g4[4];
#pragma unroll
                for (int q = 0; q < 4; ++q) g4[q] = *(const f32x4*)(ng + 256 * q + 4 * lane);
                v2u on[4], gn[4];
#pragma unroll
                for (int q = 0; q < 4; ++q) { on[q] = *(const v2u*)(OB + (size_t)gw * DM + 256 * q + 4 * lane); gn[q] = *(const v2u*)(GG + (size_t)gw * DM + 256 * q + 4 * lane); }
#pragma unroll 1
                for (int row = gw; row < NTOK; row += NGW) {
                    v2u oc[4], gc[4];
#pragma unroll
                    for (int q = 0; q < 4; ++q) { oc[q] = on[q]; gc[q] = gn[q]; }
                    if (row + NGW < NTOK) {
#pragma unroll
                        for (int q = 0; q < 4; ++q) { on[q] = *(const v2u*)(OB + (size_t)(row + NGW) * DM + 256 * q + 4 * lane); gn[q] = *(const v2u*)(GG + (size_t)(row + NGW) * DM + 256 * q + 4 * lane); } }
                    float o[16]; float ss = 0.f;
#pragma unroll
                    for (int q = 0; q < 4; ++q) { o[4 * q] = bflo(oc[q].x); o[4 * q + 1] = bfhi(oc[q].x); o[4 * q + 2] = bflo(oc[q].y); o[4 * q + 3] = bfhi(oc[q].y); }
#pragma unroll
                    for (int i = 0; i < 16; ++i) ss += o[i] * o[i];
                    const float rs = 1.0f / sqrtf(wave_sum(ss) * (1.0f / DM) + RMS_EPS);
#pragma unroll
                    for (int q = 0; q < 4; ++q) {
                        v2u w; w.x = pk2(o[4 * q] * rs * g4[q][0] * bflo(gc[q].x), o[4 * q + 1] * rs * g4[q][1] * bfhi(gc[q].x)); w.y = pk2(o[4 * q + 2] * rs * g4[q][2] * bflo(gc[q].y), o[4 * q + 3] * rs * g4[q][3] * bfhi(gc[q].y));
                        *(v2u*)(A2 + (size_t)row * DM + 256 * q + 4 * lane) = w; }
                }
                GRID_BAR();
            } }
#endif
        } else {
#if SITE(4)
            { KArgs ap = kargs(); const int tid = otid(wave0); LAS unsigned char* lds = olds(lds0); (void)tid;
            if (IN(pb + 0)) for (int rep_ = 0; rep_ < REP(4); ++rep_) {
                unsigned char* ws = ap->ws; const int j = L >> 1;
                LAS int* ul = (LAS int*)(lds + MISC_OFF + MO_ULIST);
                pg8::build_units_dense(tid, ul, NTOK / 256, RT_IN / 256, DM * 2);
                pg8::EpiRetIn E{ws};
                pg8::gemm_phase<pg8::EpiRetIn, false, true, false>(tid, lds, ul, (LAS int*)(lds + MISC_OFF + MO_GTAB), (const char*)(ws + WS_XB), (const char*)((bf16*)(ws + WS_W_RIN) + (size_t)j * RT_IN * DM), nullptr, DM * 2, E);
                GRID_BAR();
            } }
#endif
#if SITE(5)
            { KArgs ap = kargs(); const int tid = otid(wave0); LAS unsigned char* lds = olds(lds0); (void)tid;
            if (IN(pb + 1)) for (int rep_ = 0; rep_ < REP(5); ++rep_) {
#if !SLOW_RET
                { unsigned char* ws = ap->ws; ret_fast(tid, lds, (const bf16*)(ws + WS_H), (bf16*)(ws + WS_O)); }
#else
                unsigned char* ws = ap->ws; const bf16* HB = (const bf16*)(ws + WS_H); bf16* OB = (bf16*)(ws + WS_O);
                LAS float* qf = (LAS float*)lds; LAS float* kf = qf + 16 * 4 * 68; LAS float* vf = kf + 16 * 4 * 68;
                for (int un = blockIdx.x; un < NBATCH * RT_HEADS * 4; un += gridDim.x) {
                    const int b = un >> 4, h = (un >> 2) & 3, vq = un & 3; const int vc = tid >> 2, kq = tid & 3;
                    const float gam = 1.0f - exp2f(-5.0f - (float)h);
                    float st[64];
#pragma unroll
                    for (int i = 0; i < 64; ++i) st[i] = 0.f;
                    for (int t0 = 0; t0 < SEQ; t0 += 16) {
                        __syncthreads();
                        for (int e = tid; e < 16 * 256; e += 512) { const int tt = e >> 8, k = e & 255; const size_t gi = (size_t)(b * SEQ + t0 + tt) * RT_IN + h * 256 + k; const int li = tt * 272 + (k & 3) * 68 + (k >> 2);
                            qf[li] = bf1(HB[gi]); kf[li] = bf1(HB[gi + 1024]); }
                        for (int e = tid; e < 16 * 128; e += 512) { const int tt = e >> 7, c = e & 127; vf[e] = bf1(HB[(size_t)(b * SEQ + t0 + tt) * RT_IN + 2048 + h * 512 + vq * 128 + c]); }
                        __syncthreads();
                        for (int tt = 0; tt < 16; ++tt) {
                            const float v = vf[tt * 128 + vc]; float a = 0.f; const int lb = tt * 272 + kq * 68;
#pragma unroll
                            for (int i = 0; i < 64; ++i) { st[i] = gam * st[i] + kf[lb + i] * v; a += qf[lb + i] * st[i]; }
                            a += __shfl_xor(a, 1); a += __shfl_xor(a, 2);
                            if (kq == 0) OB[(size_t)(b * SEQ + t0 + tt) * RT_VD + h * 512 + vq * 128 + vc] = (bf16)f2bf(a);
                        }
                    }
                }
#endif
                GRID_BAR();
            } }
#endif
#if SITE(6)
            { KArgs ap = kargs(); const int tid = otid(wave0); LAS unsigned char* lds = olds(lds0); (void)tid;
            if (IN(pb + 2)) for (int rep_ = 0; rep_ < REP(6); ++rep_) {
                const int lane = tid & 63, wave = __builtin_amdgcn_readfirstlane(tid >> 6), gw = VCU() * 8 + wave, NGW = gridDim.x * 8;
                unsigned char* ws = ap->ws; const bf16* OB = (const bf16*)(ws + WS_O); const bf16* HB = (const bf16*)(ws + WS_H); bf16* A2 = (bf16*)(ws + WS_A2);
                v4u on[4], gn[4];
#pragma unroll
                for (int h = 0; h < 4; ++h) { on[h] = *(const v4u*)(OB + (size_t)gw * RT_VD + 512 * h + 8 * lane); gn[h] = *(const v4u*)(HB + (size_t)gw * RT_IN + 4096 + 512 * h + 8 * lane); }
#pragma unroll 1
                for (int row = gw; row < NTOK; row += NGW) {
                    v4u oc[4], gc[4];
#pragma unroll
                    for (int h = 0; h < 4; ++h) { oc[h] = on[h]; gc[h] = gn[h]; }
                    if (row + NGW < NTOK) {
#pragma unroll
                        for (int h = 0; h < 4; ++h) { on[h] = *(const v4u*)(OB + (size_t)(row + NGW) * RT_VD + 512 * h + 8 * lane); gn[h] = *(const v4u*)(HB + (size_t)(row + NGW) * RT_IN + 4096 + 512 * h + 8 * lane); } }
#pragma unroll
                    for (int h = 0; h < 4; ++h) {
                        const v4u w = oc[h];
                        float o[8] = {bflo(w.x), bfhi(w.x), bflo(w.y), bfhi(w.y), bflo(w.z), bfhi(w.z), bflo(w.w), bfhi(w.w)};
                        float s = 0.f;
#pragma unroll
                        for (int i = 0; i < 8; ++i) s += o[i];
                        const float mu = wave_sum_u(s) * (1.0f / 512.0f); float q = 0.f;
#pragma unroll
                        for (int i = 0; i < 8; ++i) { o[i] -= mu; q += o[i] * o[i]; }
                        const float rs = 1.0f / sqrtf(wave_sum_u(q) * (1.0f / 512.0f) + LN_EPS);
                        const v4u g = gc[h];
#if ROUT_FP8
                        const float r8 = rs * 8.0f; v2u r; r.x = pk4_fp8(o[0] * r8 * bflo(g.x), o[1] * r8 * bfhi(g.x), o[2] * r8 * bflo(g.y), o[3] * r8 * bfhi(g.y));
                        r.y = pk4_fp8(o[4] * r8 * bflo(g.z), o[5] * r8 * bfhi(g.z), o[6] * r8 * bflo(g.w), o[7] * r8 * bfhi(g.w));
                        *(v2u*)((unsigned char*)A2 + (size_t)row * RT_VD + 512 * h + 8 * lane) = r;
#else
                        v4u r; r.x = pk2(o[0] * rs * bflo(g.x), o[1] * rs * bfhi(g.x)); r.y = pk2(o[2] * rs * bflo(g.y), o[3] * rs * bfhi(g.y));
                        r.z = pk2(o[4] * rs * bflo(g.z), o[5] * rs * bfhi(g.z)); r.w = pk2(o[6] * rs * bflo(g.w), o[7] * rs * bfhi(g.w));
                        *(v4u*)(A2 + (size_t)row * RT_VD + 512 * h + 8 * lane) = r;
#endif
                    }
                }
                GRID_BAR();
            } }
#endif
        }
#if SITE(7)
        { KArgs ap = kargs(); const int tid = otid(wave0); LAS unsigned char* lds = olds(lds0); (void)tid;
        if (IN(pb + 3)) for (int rep_ = 0; rep_ < REP(7); ++rep_) {
            unsigned char* ws = ap->ws; const int j = L >> 1; const bool ret = (L & 1) != 0;
            const int Ko = ret ? RT_VD : DM;
            LAS int* ul = (LAS int*)(lds + MISC_OFF + MO_ULIST);
            if (ret && ROUT_FP8) {
                pg8::build_units_dense(tid, ul, NTOK / 256, DM / 256, RT_VD);
                pg8::EpiRes E{ws, -1, 1.0f / (8.0f * 128.0f)};
                pg8::gemm_phase<pg8::EpiRes, false, true, true>(tid, lds, ul, (LAS int*)(lds + MISC_OFF + MO_GTAB), (const char*)(ws + WS_A2), (const char*)(ws + WS_W_ROUT8 + (size_t)j * DM * RT_VD), nullptr, RT_VD, E, lds + MISC_OFF + MO_GALL);
            } else {
                pg8::build_units_dense(tid, ul, NTOK / 256, DM / 256, Ko * 2);
                const char* Bt = ret ? (const char*)((bf16*)(ws + WS_W_ROUT) + (size_t)j * DM * RT_VD) : (const char*)((bf16*)(ws + WS_W_HOUT) + (size_t)j * DM * DM);
                pg8::EpiRes E{ws, (ret || SLOW_HGRN) ? -1 : 0, 1.0f};
                pg8::gemm_phase<pg8::EpiRes, false, true, false>(tid, lds, ul, (LAS int*)(lds + MISC_OFF + MO_GTAB), (const char*)(ws + WS_A2), Bt, nullptr, Ko * 2, E, lds + MISC_OFF + MO_GALL);
            }
            GRID_BAR();
        } }
#endif
#if SITE(8)
        { KArgs ap = kargs(); const int tid = otid(wave0); LAS unsigned char* lds = olds(lds0); (void)tid;
        if (IN(pb + 4)) for (int rep_ = 0; rep_ < REP(8); ++rep_) {
            const int lane = tid & 63, wave = __builtin_amdgcn_readfirstlane(tid >> 6), r = lane & 15, g = lane >> 4;
            unsigned char* ws = ap->ws; unsigned* ctl = (unsigned*)(ws + WS_CTL);
            const bf16* Y = (const bf16*)(ws + WS_Y); bf16* X1R = (bf16*)(ws + WS_X1F); bf16* X1B = (bf16*)(ws + WS_X1B);
            int* ROWDST = (int*)(ws + WS_ROWDST); float* ROWGATE = (float*)(ws + WS_ROWGATE);
            constexpr int WP = 2064;
            LAS unsigned char* wH = lds; LAS unsigned char* wL = lds + 32 * WP;
            LAS int* lcnt = (LAS int*)(lds + MISC_OFF + MO_LCNT); LAS int* lbase = (LAS int*)(lds + MISC_OFF + MO_LBASE);
            LAS int* sel = (LAS int*)(lds + MISC_OFF + MO_SEL); LAS float* selw = (LAS float*)(lds + MISC_OFF + MO_SELW);
            const float* rb = ap->in[I_RB] + L * NE;
            const float* lg = ap->in[I_LNMG] + L * DM; const float* lbb = ap->in[I_LNMB] + L * DM;
            { const v4u* gh = (const v4u*)(ws + WS_WRH) + (size_t)L * 4096; const v4u* gl = (const v4u*)(ws + WS_WRL) + (size_t)L * 4096;
              for (int c = tid; c < 4096; c += 512) { const int e = c >> 7, cc = c & 127; *(LAS v4u*)(wH + e * WP + cc * 16) = gh[c]; *(LAS v4u*)(wL + e * WP + cc * 16) = gl[c]; } }
            const float rb0 = rb[r], rb1 = rb[16 + r];
            f32x4 g4r[4], b4r[4];
#pragma unroll
            for (int q = 0; q < 4; ++q) { g4r[q] = *(const f32x4*)(lg + 256 * q + 4 * lane); b4r[q] = *(const f32x4*)(lbb + 256 * q + 4 * lane); }
            for (int blk = VCU(); blk < NTOK / 128; blk += gridDim.x) {
                if (tid < 32) lcnt[tid] = 0;
                __syncthreads();
                const int row0 = blk * 128 + wave * 16;
                v2u xn[4];
#pragma unroll
                for (int q = 0; q < 4; ++q) xn[q] = *(const v2u*)(Y + (size_t)row0 * DM + 256 * q + 4 * lane);
#pragma unroll 1
                for (int rr = 0; rr < 16; ++rr) {
                    const int row = row0 + rr;
                    f32x4 x[4]; float s = 0.f;
#pragma unroll
                    for (int q = 0; q < 4; ++q) { x[q] = (f32x4){bflo(xn[q].x), bfhi(xn[q].x), bflo(xn[q].y), bfhi(xn[q].y)}; s += (x[q][0] + x[q][1]) + (x[q][2] + x[q][3]); }
                    if (rr + 1 < 16) {
#pragma unroll
                        for (int q = 0; q < 4; ++q) xn[q] = *(const v2u*)(Y + (size_t)(row + 1) * DM + 256 * q + 4 * lane); }
                    const float mu = wave_sum_u(s) * (1.0f / DM); float qq = 0.f;
#pragma unroll
                    for (int q = 0; q < 4; ++q) { x[q] = x[q] - mu; qq += (x[q][0] * x[q][0] + x[q][1] * x[q][1]) + (x[q][2] * x[q][2] + x[q][3] * x[q][3]); }
                    const float rs = 1.0f / sqrtf(wave_sum_u(qq) * (1.0f / DM) + LN_EPS);
#pragma unroll
                    for (int q = 0; q < 4; ++q) { x[q] = x[q] * rs * g4r[q] + b4r[q];
                        { v2u wr_; wr_.x = pk2(x[q][0], x[q][1]); wr_.y = pk2(x[q][2], x[q][3]); *(v2u*)(X1R + (size_t)row * DM + 256 * q + 4 * lane) = wr_; }
#if MOE_FP8
                        *(unsigned*)((unsigned char*)X1B + (size_t)row * DM + 256 * q + 4 * lane) = pk4_fp8(x[q][0] * X_SCALE, x[q][1] * X_SCALE, x[q][2] * X_SCALE, x[q][3] * X_SCALE); }
#else
                        v2u w; w.x = pk2(x[q][0], x[q][1]); w.y = pk2(x[q][2], x[q][3]); *(v2u*)(X1B + (size_t)row * DM + 256 * q + 4 * lane) = w; }
#endif
                }
                asm volatile("s_waitcnt vmcnt(0)" ::: "memory");
                f32x4 lgt0 = {0.f, 0.f, 0.f, 0.f}, lgt1 = {0.f, 0.f, 0.f, 0.f};
                {
                    const bf16* xa = X1R + (size_t)(row0 + r) * DM + 8 * g;
#pragma unroll 1
                    for (int kq = 0; kq < 4; ++kq) {
                        bf16x8 af[8], h0[8], h1[8], l0[8], l1[8];
#pragma unroll
                        for (int j = 0; j < 8; ++j) { const int kb = kq * 8 + j; af[j] = *(const bf16x8*)(xa + 32 * kb);
                            h0[j] = *(const LAS bf16x8*)(wH + r * WP + (32 * kb + 8 * g) * 2); h1[j] = *(const LAS bf16x8*)(wH + (16 + r) * WP + (32 * kb + 8 * g) * 2);
                            l0[j] = *(const LAS bf16x8*)(wL + r * WP + (32 * kb + 8 * g) * 2); l1[j] = *(const LAS bf16x8*)(wL + (16 + r) * WP + (32 * kb + 8 * g) * 2); }
#pragma unroll
                        for (int j = 0; j < 8; ++j) { lgt0 = MFMA32(af[j], h0[j], lgt0); lgt1 = MFMA32(af[j], h1[j], lgt1); lgt0 = MFMA32(af[j], l0[j], lgt0); lgt1 = MFMA32(af[j], l1[j], lgt1); }
                    }
                }
                asm volatile("s_nop 7\n\ts_nop 7" : "+v"(lgt0), "+v"(lgt1));
#pragma unroll
                for (int i = 0; i < 4; ++i) {
                    float v0 = lgt0[i] + rb0, v1 = lgt1[i] + rb1; int se[4]; float sv[4];
#pragma unroll
                    for (int k = 0; k < 4; ++k) {
                        float m = fmaxf(v0, v1);
                        m = fmaxf(m, dppf<0xB1>(m)); m = fmaxf(m, dppf<0x4E>(m)); m = fmaxf(m, dppf<0x141>(m)); m = fmaxf(m, dppf<0x140>(m));
                        int ec = (v0 == m) ? r : ((v1 == m) ? 16 + r : 99);
                        ec = min(ec, dppi<0xB1>(ec)); ec = min(ec, dppi<0x4E>(ec)); ec = min(ec, dppi<0x141>(ec)); ec = min(ec, dppi<0x140>(ec));
                        se[k] = ec; sv[k] = m;
                        if (ec == r) v0 = -3.0e38f;
                        if (ec == 16 + r) v1 = -3.0e38f;
                    }
                    const float e1 = __expf(sv[1] - sv[0]), e2 = __expf(sv[2] - sv[0]), e3 = __expf(sv[3] - sv[0]); const float inv = 1.0f / (1.0f + e1 + e2 + e3);
                    if (r < 4) { const int rloc = wave * 16 + 4 * g + i; const int ee = r == 0 ? se[0] : (r == 1 ? se[1] : (r == 2 ? se[2] : se[3])); const float ww = (r == 0 ? 1.0f : (r == 1 ? e1 : (r == 2 ? e2 : e3))) * inv;
                        sel[rloc * 4 + r] = ee; selw[rloc * 4 + r] = ww; }
                }
                __syncthreads();
                const int myE = sel[tid]; const int rank = __hip_atomic_fetch_add(lcnt + myE, 1, __ATOMIC_RELAXED, __HIP_MEMORY_SCOPE_WORKGROUP);
                __syncthreads();
                if (tid < 32) lbase[tid] = (int)__hip_atomic_fetch_add(ctl + CW_ECNT + (L + 4 * rep_) * 32 + tid, (unsigned)lcnt[tid], RLX_AGENT);
                __syncthreads();
                { const int pos = lbase[myE] + rank; const size_t ti = (size_t)myE * ECAP + pos; ROWDST[ti] = (blk * 128 + (tid >> 2)) * 4 + (tid & 3); ROWGATE[ti] = selw[tid]; }
                __syncthreads();
            }
            GRID_BAR();
        } }
#endif
#if SITE(9)
        { KArgs ap = kargs(); const int tid = otid(wave0); LAS unsigned char* lds = olds(lds0); (void)tid;
        if (IN(pb + 5)) for (int rep_ = 0; rep_ < REP(9); ++rep_) {
            unsigned char* ws = ap->ws; unsigned* ctl = (unsigned*)(ws + WS_CTL);
            LAS int* tpre = (LAS int*)(lds + MISC_OFF + MO_TPRE); LAS int* ebase = (LAS int*)(lds + MISC_OFF + MO_EBASE); LAS int* ecnt = (LAS int*)(lds + MISC_OFF + MO_ECNT);
            if (tid < NE) ecnt[tid] = (int)__hip_atomic_load(ctl + CW_ECNT + L * 32 + tid, RLX_AGENT);
            __syncthreads();
            if (tid < 64) {
                const int tl = (tid < NE) ? ((ecnt[tid < NE ? tid : 0] + 255) >> 8) : 0; int sfx = tl;
#pragma unroll
                for (int k = 1; k < 32; k <<= 1) { const int up = __shfl_up(sfx, k, 64); if ((tid & 63) >= k) sfx += up; }
                if (tid < NE) { tpre[tid] = sfx - tl; ebase[tid] = (sfx - tl) * 256; }
                if (tid == NE - 1) tpre[NE] = sfx; }
            __syncthreads();
            LAS int* ul = (LAS int*)(lds + MISC_OFF + MO_ULIST);
            constexpr int EB = MOE_FP8 ? 1 : 2;
            pg8::build_units_moe(tid, ul, tpre, ebase, ecnt, 8, DM * EB, 2048u * DM * EB);
            { LAS int* gall = (LAS int*)(lds + MISC_OFF + MO_GALL); const int* rd = (const int*)(ws + WS_ROWDST);
              for (int i = tid; i < GALL_UNITS * 256; i += 512) { const int uu = i >> 8, rr = i & 255;
                  if (ul[uu * 8 + 0]) gall[i] = (int)((unsigned)rd[ul[uu * 8 + 7] + min(rr, ul[uu * 8 + 5] - 1)] >> 2); }
              __syncthreads(); }
            pg8::EpiMoeGU E{ws, L};
            pg8::gemm_phase<pg8::EpiMoeGU, true, true, MOE_FP8 != 0>(tid, lds, ul, (LAS int*)(lds + MISC_OFF + MO_GALL), (const char*)(ws + WS_X1B), (const char*)(ws + WS_W_GU + (size_t)L * NE * 2048 * DM * EB), (const int*)(ws + WS_ROWDST), DM * EB, E, lds + MISC_OFF + MO_GTAB);
            GRID_BAR();
        } }
#endif
#if SITE(10)
        { KArgs ap = kargs(); const int tid = otid(wave0); LAS unsigned char* lds = olds(lds0); (void)tid;
        if (IN(pb + 6)) for (int rep_ = 0; rep_ < REP(10); ++rep_) {
            unsigned char* ws = ap->ws; unsigned* ctl = (unsigned*)(ws + WS_CTL);
            LAS int* tpre = (LAS int*)(lds + MISC_OFF + MO_TPRE); LAS int* ebase = (LAS int*)(lds + MISC_OFF + MO_EBASE); LAS int* ecnt = (LAS int*)(lds + MISC_OFF + MO_ECNT);
            __syncthreads();
            if (tid < NE) ecnt[tid] = (int)__hip_atomic_load(ctl + CW_ECNT + L * 32 + tid, RLX_AGENT);
            __syncthreads();
            if (tid < 64) {
                const int tl = (tid < NE) ? ((ecnt[tid < NE ? tid : 0] + 255) >> 8) : 0; int sfx = tl;
#pragma unroll
                for (int k = 1; k < 32; k <<= 1) { const int up = __shfl_up(sfx, k, 64); if ((tid & 63) >= k) sfx += up; }
                if (tid < NE) { tpre[tid] = sfx - tl; ebase[tid] = (sfx - tl) * 256; }
                if (tid == NE - 1) tpre[NE] = sfx; }
            __syncthreads();
            LAS int* ul = (LAS int*)(lds + MISC_OFF + MO_ULIST);
            constexpr int EB = MOE_FP8 ? 1 : 2;
            pg8::build_units_moe(tid, ul, tpre, ebase, ecnt, 4, DM * EB, (unsigned)DM * DM * EB);
            pg8::EpiMoeDown E{ws, ap->in[I_BDN] + (size_t)L * NE * DM};
            pg8::gemm_phase<pg8::EpiMoeDown, false, true, MOE_FP8 != 0>(tid, lds, ul, (LAS int*)(lds + MISC_OFF + MO_GTAB), (const char*)(ws + WS_ACT), (const char*)(ws + WS_W_DN + (size_t)L * NE * DM * DM * EB), nullptr, DM * EB, E, lds + MISC_OFF + MO_GALL);
            GRID_BAR();
        } }
#endif
#if SITE(11)
        { KArgs ap = kargs(); const int tid = otid(wave0); LAS unsigned char* lds = olds(lds0); (void)tid;
        if (IN(pb + 7)) for (int rep_ = 0; rep_ < REP(11); ++rep_) {
            const int lane = tid & 63, wave = __builtin_amdgcn_readfirstlane(tid >> 6), gw = VCU() * 8 + wave, NGW = gridDim.x * 8;
            unsigned char* ws = ap->ws; const bf16* X1R = (const bf16*)(ws + WS_X1F); const bf16* YS = (const bf16*)(ws + WS_YSLOT); bf16* XB = (bf16*)(ws + WS_XB); float* out = ap->out;
            const float* lg = ap->in[I_LNFG] + L * DM; const float* lbb = ap->in[I_LNFB] + L * DM;
#if YS_FP8
            typedef unsigned ys_t; constexpr int YSB = 1;
#else
            typedef v2u ys_t; constexpr int YSB = 2;
#endif
            v2u xn[4]; f32x4 g4[4], b4[4]; ys_t yn[4][4];
#pragma unroll
            for (int q = 0; q < 4; ++q) { g4[q] = *(const f32x4*)(lg + 256 * q + 4 * lane); b4[q] = *(const f32x4*)(lbb + 256 * q + 4 * lane); xn[q] = *(const v2u*)(X1R + (size_t)gw * DM + 256 * q + 4 * lane);
#pragma unroll
                for (int k = 0; k < 4; ++k) yn[q][k] = *(const ys_t*)((const unsigned char*)YS + (((size_t)gw * 4 + k) * DM + 256 * q + 4 * lane) * YSB); }
#pragma unroll 1
            for (int row = gw; row < NTOK; row += NGW) {
                f32x4 x[4]; ys_t yc[4][4]; float s = 0.f;
#pragma unroll
                for (int q = 0; q < 4; ++q) { x[q] = (f32x4){bflo(xn[q].x), bfhi(xn[q].x), bflo(xn[q].y), bfhi(xn[q].y)} * DN_ALPHA;
#pragma unroll
                    for (int k = 0; k < 4; ++k) yc[q][k] = yn[q][k]; }
                if (row + NGW < NTOK) {
#pragma unroll
                    for (int q = 0; q < 4; ++q) { xn[q] = *(const v2u*)(X1R + (size_t)(row + NGW) * DM + 256 * q + 4 * lane);
#pragma unroll
                        for (int k = 0; k < 4; ++k) yn[q][k] = *(const ys_t*)((const unsigned char*)YS + (((size_t)(row + NGW) * 4 + k) * DM + 256 * q + 4 * lane) * YSB); } }
#pragma unroll
                for (int q = 0; q < 4; ++q) {
#pragma unroll
#if YS_FP8
                    for (int k = 0; k < 4; ++k) { const f32x2 lo = __builtin_amdgcn_cvt_pk_f32_fp8((int)yc[q][k], false), hi = __builtin_amdgcn_cvt_pk_f32_fp8((int)yc[q][k], true);
                        x[q][0] += lo[0] * 0.015625f; x[q][1] += lo[1] * 0.015625f; x[q][2] += hi[0] * 0.015625f; x[q][3] += hi[1] * 0.015625f; }
#else
                    for (int k = 0; k < 4; ++k) { const v2u w = yc[q][k]; x[q][0] += bflo(w.x); x[q][1] += bfhi(w.x); x[q][2] += bflo(w.y); x[q][3] += bfhi(w.y); }
#endif
                    s += (x[q][0] + x[q][1]) + (x[q][2] + x[q][3]); }
                const float mu = wave_sum_u(s) * (1.0f / DM); float qq = 0.f;
#pragma unroll
                for (int q = 0; q < 4; ++q) { x[q] = x[q] - mu; qq += (x[q][0] * x[q][0] + x[q][1] * x[q][1]) + (x[q][2] * x[q][2] + x[q][3] * x[q][3]); }
                const float rs = 1.0f / sqrtf(wave_sum_u(qq) * (1.0f / DM) + LN_EPS);
#pragma unroll
                for (int q = 0; q < 4; ++q) { x[q] = x[q] * rs * g4[q] + b4[q];
                    if (L + 1 == DEPTH) *(f32x4*)(out + (size_t)row * DM + 256 * q + 4 * lane) = x[q];
                    else { v2u w; w.x = pk2(x[q][0], x[q][1]); w.y = pk2(x[q][2], x[q][3]); *(v2u*)(XB + (size_t)row * DM + 256 * q + 4 * lane) = w; } }
            }
            if (L + 1 < DEPTH) GRID_BAR();
        } }
#endif
    }
#undef IN
#undef GRID_BAR
}

extern "C" void kernel_launch(void* const* d_in, const int* in_sizes, int n_in, void* d_out, int out_size, void* d_ws, size_t ws_size, hipStream_t stream) {
    static int grid = 0;
    if (grid == 0) {
        if (n_in != 17 || out_size != NTOK * DM || ws_size < WS_END) { fprintf(stderr, "kernel_launch: unexpected shapes (n_in %d, out %d, ws %zu < %zu)\n", n_in, out_size, ws_size, (size_t)WS_END); grid = -1; return; }
        int dev = 0, cus = 0, per_cu = 0;
        if (hipGetDevice(&dev) != hipSuccess || hipDeviceGetAttribute(&cus, hipDeviceAttributeMultiprocessorCount, dev) != hipSuccess) { grid = -1; return; }
        if (hipFuncSetAttribute((const void*)mk_fwd, hipFuncAttributeMaxDynamicSharedMemorySize, LDS_BYTES) != hipSuccess) { fprintf(stderr, "kernel_launch: hipFuncSetAttribute failed\n"); grid = -1; return; }
        if (hipOccupancyMaxActiveBlocksPerMultiprocessor(&per_cu, (const void*)mk_fwd, 512, LDS_BYTES) != hipSuccess || per_cu < 1) { fprintf(stderr, "kernel_launch: occupancy query says %d\n", per_cu); }
        (void)hipGetLastError();
        grid = cus;
    }
    if (grid < 0) return;
    (void)hipMemsetAsync((char*)d_ws + WS_CTL, 0, CTL_ZERO_BYTES, stream);
    Args a{};
    for (int i = 0; i < 17; ++i) a.in[i] = (const float*)d_in[i];
    a.out = (float*)d_out; a.ws = (unsigned char*)d_ws;
#if MK_MULTI
    for (int p = 0; p < 1 + 8 * DEPTH; ++p) { a.ph_lo = p; a.ph_hi = p + 1; hipLaunchKernelGGL(mk_fwd, dim3(grid), dim3(512), LDS_BYTES, stream, a); }
#else
    a.ph_lo = 0; a.ph_hi = 1 + 8 * DEPTH;
    hipLaunchKernelGGL(mk_fwd, dim3(grid), dim3(512), LDS_BYTES, stream, a);
#endif
}
```

```cpp
#include <hip/hip_runtime.h>
#include <cstdio>
#include <cstdint>

#ifndef MK_MULTI
#define MK_MULTI 0
#endif
#ifndef PROBE_EPI2
#define PROBE_EPI2 0
#endif
#ifndef MOE_FP8
#define MOE_FP8 1
#endif
#ifndef ROUT_FP8
#define ROUT_FP8 1
#endif
#ifndef YS_FP8
#define YS_FP8 1
#endif
#ifndef SLOW_HGRN
#define SLOW_HGRN 0
#endif
#ifndef SLOW_RET
#define SLOW_RET 0
#endif

#define GAS __attribute__((address_space(1)))
#define LAS __attribute__((address_space(3)))
typedef unsigned short bf16;
typedef unsigned v4u __attribute__((ext_vector_type(4)));
typedef unsigned v2u __attribute__((ext_vector_type(2)));
typedef float f32x4 __attribute__((ext_vector_type(4)));
typedef float f32x2 __attribute__((ext_vector_type(2)));
typedef short bf16x8 __attribute__((ext_vector_type(8)));
typedef GAS unsigned gu32;

constexpr int DM = 1024, NBATCH = 16, SEQ = 2048, NTOK = NBATCH * SEQ, DEPTH = 4;
constexpr int NE = 32, TOPK = 4;
constexpr int HG_HEADS = 8, HG_K = 128;
constexpr int RT_HEADS = 4, RT_K = 256, RT_V = 512, RT_VD = 2048, RT_IN = 6144, HG_IN = 4096;
constexpr int ECAP = NTOK;
constexpr int MOE_ROWS = NTOK * TOPK + NE * 256;
constexpr float DN_ALPHA = 1.681792830507429f;
constexpr float LN_EPS = 1e-5f, RMS_EPS = 1e-6f;

constexpr size_t MiB = 1ull << 20;
constexpr size_t WS_CTL = 0, CTL_ZERO_BYTES = 1 * MiB;
constexpr size_t WS_LBS = 1 * MiB;
constexpr size_t WS_WRH = 1 * MiB + 128 * 1024, WS_WRL = 1 * MiB + 512 * 1024;
constexpr size_t WS_BGU = 2 * MiB;
constexpr size_t WS_ROT = 4 * MiB;
constexpr size_t WS_ROWDST = 8 * MiB;
constexpr size_t WS_ROWGATE = 12 * MiB;
constexpr size_t WS_W_HIN = 16 * MiB;
constexpr size_t WS_W_HOUT = WS_W_HIN + 16 * MiB;
constexpr size_t WS_W_RIN = WS_W_HOUT + 4 * MiB;
constexpr size_t WS_W_ROUT = WS_W_RIN + 24 * MiB;
constexpr size_t WS_W_GU = WS_W_ROUT + 8 * MiB;
constexpr size_t WS_W_DN = WS_W_GU + 512 * MiB;
constexpr size_t WS_XB = WS_W_DN + 256 * MiB;
constexpr size_t WS_H = WS_XB + 64 * MiB;
constexpr size_t WS_DEC = WS_H + 320 * MiB;
constexpr size_t WS_SSP = WS_DEC + 16 * MiB;
constexpr size_t WS_O = WS_H + 384 * MiB;
constexpr size_t WS_A2 = WS_O + 128 * MiB;
constexpr size_t WS_Y = WS_A2 + 128 * MiB;
constexpr size_t WS_X1F = WS_Y + 128 * MiB;
constexpr size_t WS_X1B = WS_X1F + 128 * MiB;
constexpr size_t WS_ACT = WS_X1B + 64 * MiB;
constexpr size_t WS_YSLOT = WS_ACT + 272 * MiB;
constexpr size_t WS_W_ROUT8 = WS_YSLOT + 256 * MiB;
constexpr size_t WS_END = WS_W_ROUT8 + 4 * MiB;

constexpr int CW_BAR = 4096;
constexpr int CW_SS = 65536;
constexpr int CW_ECNT = 16384;

constexpr int RING_BYTES = 131072;
constexpr int MISC_OFF = 135168;
constexpr int LDS_BYTES = 163840;
constexpr int MO_BARW = 0;
constexpr int MO_GTAB = 64;
constexpr int MO_TPRE = 64 + 2048;
constexpr int MO_EBASE = MO_TPRE + 160;
constexpr int MO_ECNT = MO_EBASE + 128;
constexpr int MO_LCNT = MO_ECNT + 128;
constexpr int MO_LBASE = MO_LCNT + 128;
constexpr int MO_SEL = MO_LBASE + 128;
constexpr int MO_SELW = MO_SEL + 2048;
constexpr int MO_RANK = MO_SELW + 2048;
constexpr int MO_ULIST = MO_RANK + 2048;
constexpr int MO_GALL = 10240;
constexpr int GALL_UNITS = 18;
static_assert(MO_ULIST + 1024 <= MO_GALL && MISC_OFF + MO_GALL + GALL_UNITS * 1024 <= LDS_BYTES, "LDS map");

#define RLX_AGENT __ATOMIC_RELAXED, __HIP_MEMORY_SCOPE_AGENT
#define LDS_WAIT() asm volatile("s_waitcnt lgkmcnt(0)" ::: "memory")
#define VM_WAIT() asm volatile("s_waitcnt vmcnt(0)" ::: "memory")

__device__ __forceinline__ unsigned f2bf(float f) { unsigned u = __builtin_bit_cast(unsigned, f); return (u + 0x7fffu + ((u >> 16) & 1u)) >> 16; }
__device__ __forceinline__ unsigned pk2(float lo, float hi) { return f2bf(lo) | (f2bf(hi) << 16); }
__device__ __forceinline__ unsigned cvt_pk_bf16(float lo, float hi) { unsigned r; asm volatile("v_cvt_pk_bf16_f32 %0, %1, %2" : "=v"(r) : "v"(lo), "v"(hi)); return r; }
#if MOE_FP8
constexpr float X_SCALE = 4.0f, WGU_SCALE = 64.0f, ACT_SCALE = 4.0f, WDN_SCALE = 128.0f;
constexpr float GU_DESCALE = 1.0f / (X_SCALE * WGU_SCALE), DN_DESCALE = 1.0f / (ACT_SCALE * WDN_SCALE);
#else
constexpr float GU_DESCALE = 1.0f, DN_DESCALE = 1.0f, ACT_SCALE = 1.0f;
#endif
__device__ __forceinline__ unsigned pk4_fp8(float a, float b, float c, float d) {
    a = __builtin_amdgcn_fmed3f(a, -448.0f, 448.0f); b = __builtin_amdgcn_fmed3f(b, -448.0f, 448.0f); c = __builtin_amdgcn_fmed3f(c, -448.0f, 448.0f); d = __builtin_amdgcn_fmed3f(d, -448.0f, 448.0f);
    int p = __builtin_amdgcn_cvt_pk_fp8_f32(a, b, 0, false); p = __builtin_amdgcn_cvt_pk_fp8_f32(c, d, p, true); return (unsigned)p; }
__device__ __forceinline__ float bflo(unsigned u) { return __builtin_bit_cast(float, u << 16); }
__device__ __forceinline__ float bfhi(unsigned u) { return __builtin_bit_cast(float, u & 0xffff0000u); }
__device__ __forceinline__ float bf1(bf16 b) { return __builtin_bit_cast(float, ((unsigned)b) << 16); }
__device__ __forceinline__ float fexp(float x) { return __builtin_amdgcn_exp2f(x * 1.4426950408889634f); }
__device__ __forceinline__ float frcp(float x) { return __builtin_amdgcn_rcpf(x); }
__device__ __forceinline__ float fsigmoid(float x) { return frcp(1.0f + fexp(-x)); }
__device__ __forceinline__ float wave_sum(float v) {
#pragma unroll
    for (int o = 1; o < 64; o <<= 1) v += __shfl_xor(v, o);
    return v;
}
__device__ __forceinline__ float wave_max(float v) {
#pragma unroll
    for (int o = 1; o < 64; o <<= 1) v = fmaxf(v, __shfl_xor(v, o));
    return v;
}

template <int CTRL> __device__ __forceinline__ float dppf(float v) { return __builtin_bit_cast(float, __builtin_amdgcn_update_dpp(0, __builtin_bit_cast(int, v), CTRL, 0xf, 0xf, true)); }
template <int CTRL> __device__ __forceinline__ int dppi(int v) { return __builtin_amdgcn_update_dpp(0, v, CTRL, 0xf, 0xf, true); }
__device__ __forceinline__ float rlane(float v, int l) { return __builtin_bit_cast(float, __builtin_amdgcn_readlane(__builtin_bit_cast(int, v), l)); }
__device__ __forceinline__ float wave_sum_u(float v) {
    v += dppf<0xB1>(v); v += dppf<0x4E>(v); v += dppf<0x141>(v); v += dppf<0x140>(v);
    return (rlane(v, 0) + rlane(v, 16)) + (rlane(v, 32) + rlane(v, 48));
}
#define XB_TMO      128
#define XB_XCNT(j)  (256  + 64 * (j))
#define XB_XSUB(j)  (1280 + 64 * (j))
#define XB_XGEN(j)  (2304 + 64 * (j))
#define XB_TOP      3328
#define XB_TOPGEN   3392
#define XCD_BAR_WORDS 3456
#define XB_SPIN_CAP (1u << 22)

__device__ __forceinline__ unsigned xb_ld(unsigned* p)              { return __hip_atomic_load(p, __ATOMIC_RELAXED, __HIP_MEMORY_SCOPE_AGENT); }
__device__ __forceinline__ unsigned xb_add(unsigned* p, unsigned v) { return __hip_atomic_fetch_add(p, v, __ATOMIC_RELAXED, __HIP_MEMORY_SCOPE_AGENT); }
__device__ __forceinline__ unsigned xb_xcc_id() { return (unsigned)__builtin_amdgcn_s_getreg((3 << 11) | 20) & 0xFu; }
#define XB_SPIN(cond, bar) do { unsigned _sp = 0; while (cond) { __builtin_amdgcn_s_sleep(1); \
    if ((++_sp & 255u) == 0u) { if (xb_ld(&(bar)[XB_TMO])) break; if (_sp > XB_SPIN_CAP) { atomicAdd(&(bar)[XB_TMO], 1u); break; } } } } while (0)

struct XcdBarrier { unsigned* bar; unsigned x; volatile LAS unsigned* st; };

__device__ __forceinline__ XcdBarrier xcd_barrier_post(unsigned* bar, volatile LAS unsigned* st) {
    XcdBarrier b; b.bar = bar; b.x = xb_xcc_id(); b.st = st;
    if (threadIdx.x == 0) (void)xb_add(&bar[XB_XCNT(b.x)], 1u);
    return b;
}
__device__ __forceinline__ void xcd_barrier_complete(unsigned* bar, unsigned x, unsigned& nloc, unsigned& nx) {
    const unsigned G = gridDim.x * gridDim.y * gridDim.z;
    unsigned sum, cnt, mine, sp = 0u;
    for (;;) {
        sum = 0u; cnt = 0u; mine = 0u;
#pragma unroll
        for (unsigned j = 0; j < 16; ++j) { const unsigned c = xb_ld(&bar[XB_XCNT(j)]); sum += c; cnt += (c > 0u) ? 1u : 0u; mine = (j == x) ? c : mine; }
        if (sum == G) break;
        __builtin_amdgcn_s_sleep(1);
        if ((++sp & 255u) == 0u) { if (xb_ld(&bar[XB_TMO])) break; if (sp > XB_SPIN_CAP) { atomicAdd(&bar[XB_TMO], 1u); break; } }
    }
    nloc = mine > 0u ? mine : 1u; nx = cnt > 0u ? cnt : 1u;
}
__device__ __forceinline__ void xcd_barrier(const XcdBarrier& b) {
    asm volatile("s_waitcnt vmcnt(0)" ::: "memory");
    __syncthreads();
    if (threadIdx.x == 0) {
        unsigned* bar = b.bar;
        __builtin_amdgcn_s_waitcnt(0);
        unsigned nloc = b.st[0], nx = b.st[1];
        if (nloc == 0u) { xcd_barrier_complete(bar, b.x, nloc, nx); b.st[0] = nloc; b.st[1] = nx; }
        const unsigned old = xb_add(&bar[XB_XSUB(b.x)], 1u);
        const unsigned gen = old / nloc;
        if (old + 1u == (gen + 1u) * nloc) {
            __builtin_amdgcn_fence(__ATOMIC_RELEASE, "agent");
            asm volatile("s_waitcnt vmcnt(0)" ::: "memory");
            const unsigned og = xb_add(&bar[XB_TOP], 1u);
            const unsigned tg = og / nx;
            if (og + 1u == (tg + 1u) * nx) xb_add(&bar[XB_TOPGEN], 1u);
            else XB_SPIN(xb_ld(&bar[XB_TOPGEN]) == tg, bar);
            __builtin_amdgcn_fence(__ATOMIC_ACQUIRE, "agent");
            xb_add(&bar[XB_XGEN(b.x)], 1u);
            asm volatile("s_waitcnt vmcnt(0)" ::: "memory");
        } else {
            XB_SPIN(xb_ld(&bar[XB_XGEN(b.x)]) == gen, bar);
            __builtin_amdgcn_fence(__ATOMIC_ACQUIRE, "agent");
            asm volatile("s_waitcnt vmcnt(0)" ::: "memory");
        }
    }
    __syncthreads();
}

namespace pg8 {
constexpr int BM = 256, BK = 64, HALF = 128, HTB = HALF * BK * 2, STAGE_BYTES = 8 * HTB, NXCD = 8, WGM = 8, MAXU = 32;
__host__ __device__ __forceinline__ int lds_byte(int r, int c) { const int st = (r >> 4) * 2 + (c >> 5), rr = r & 15, cc = c & 31, ob = rr * 64 + cc * 2; return st * 1024 + (ob ^ (((ob >> 9) & 1) << 5)); }
__host__ __device__ __forceinline__ void stage_rc(int b, int& R, int& C) { const int st = b / 1024, sb = b % 1024, swz = sb ^ (((sb >> 9) & 1) << 5); R = (st >> 1) * 16 + swz / 64; C = (st & 1) * 32 + (swz % 64) / 2; }
__host__ __device__ __forceinline__ int perm32(int rho) { const int n = rho >> 4, i = rho & 15; return 8 * (i >> 2) + 4 * n + (i & 3); }

struct Unit { int pm, pn, e, rowbase, cnt; unsigned boff; int gidx; };

__device__ __forceinline__ bool tile_of(long L, int nM, int nN, int& gm, int& pn) {
    const int nwg = nM * nN; if (L >= nwg) return false;
    int wgid = (int)L; { const int q = nwg / NXCD, r = nwg % NXCD, xcd = wgid % NXCD, off = wgid / NXCD; wgid = (xcd < r ? xcd * (q + 1) : r * (q + 1) + (xcd - r) * q) + off; }
    const int nig = WGM * nN, gid = wgid / nig, fm = gid * WGM, gsz = (nM - fm) < WGM ? (nM - fm) : WGM;
    gm = fm + ((wgid % nig) % gsz); pn = (wgid % nig) / gsz; return true;
}
__device__ __forceinline__ void build_units_dense(const int i, LAS int* ul, int nM, int nN, int RB) {
    if (i < MAXU) { int gm = 0, pn = 0; const bool ok = tile_of((long)i * gridDim.x + blockIdx.x, nM, nN, gm, pn);
        ul[i * 8 + 0] = ok ? 1 : 0; ul[i * 8 + 1] = gm; ul[i * 8 + 2] = pn; ul[i * 8 + 3] = 0; ul[i * 8 + 4] = gm * BM; ul[i * 8 + 5] = BM; ul[i * 8 + 6] = (int)((unsigned)pn * BM * (unsigned)RB); ul[i * 8 + 7] = 0; }
    __syncthreads();
}
__device__ __forceinline__ void build_units_moe(const int i, LAS int* ul, const LAS int* tpre, const LAS int* ebase, const LAS int* ecnt, int nN, int RB, unsigned wstride) {
    if (i < MAXU) { int gm = 0, pn = 0; const bool ok = tile_of((long)i * gridDim.x + blockIdx.x, tpre[NE], nN, gm, pn);
        int e = 0;
_Pragma("unroll 1")
        for (int s = 16; s >= 1; s >>= 1) { if (e + s < NE && tpre[e + s] <= gm) e += s; }
        const int pm = gm - tpre[e];
        ul[i * 8 + 0] = ok ? 1 : 0; ul[i * 8 + 1] = pm; ul[i * 8 + 2] = pn; ul[i * 8 + 3] = e; ul[i * 8 + 4] = ebase[e] + pm * BM; ul[i * 8 + 5] = ecnt[e] - pm * BM;
        ul[i * 8 + 6] = (int)((unsigned)e * wstride + (unsigned)pn * BM * (unsigned)RB); ul[i * 8 + 7] = e * ECAP + pm * BM; }
    __syncthreads();
}
typedef int v4i __attribute__((ext_vector_type(4)));
__device__ __forceinline__ bool ld_unit(const LAS int* ul, int i, Unit& u) {
    if (i >= MAXU) return false;
    const v4i a = *(const LAS v4i*)(ul + i * 8), b = *(const LAS v4i*)(ul + i * 8 + 4);
    if (__builtin_amdgcn_readfirstlane(a.x) == 0) return false;
    u.pm = __builtin_amdgcn_readfirstlane(a.y); u.pn = __builtin_amdgcn_readfirstlane(a.z); u.e = __builtin_amdgcn_readfirstlane(a.w); u.rowbase = __builtin_amdgcn_readfirstlane(b.x);
    u.cnt = __builtin_amdgcn_readfirstlane(b.y); u.boff = (unsigned)__builtin_amdgcn_readfirstlane(b.z); u.gidx = __builtin_amdgcn_readfirstlane(b.w); return true;
}
__device__ __forceinline__ void glds16(const char* sbase, unsigned voff, LAS unsigned char* dst) {
    asm volatile("" : "+s"(sbase));
    __builtin_amdgcn_global_load_lds((const unsigned*)(sbase + voff), (LAS unsigned*)dst, 16, 0, 0);
}
template <bool GATHER> __device__ __forceinline__ void stage_a(LAS unsigned char* dst, const char* sbase, unsigned o0, unsigned o1, size_t r64) {
    glds16(sbase, o0, dst);
    if constexpr (GATHER) glds16(sbase, o1, dst + 8192);
    else glds16(sbase + r64, o0, dst + 8192);
}

typedef int v8i __attribute__((ext_vector_type(8)));
__device__ __forceinline__ v8i cat_frag(const bf16x8& a, const bf16x8& b) { return __builtin_shufflevector(__builtin_bit_cast(v4i, a), __builtin_bit_cast(v4i, b), 0, 1, 2, 3, 4, 5, 6, 7); }
template <class Epi, bool GATHER, bool ALIGN_EPI, bool FP8>
__device__ __forceinline__ void gemm_phase(const int tid, LAS unsigned char* lds, const LAS int* ul, LAS int* gtab, const char* Abase, const char* Bbase, const int* rowdst, const int RB, const Epi& E, LAS unsigned char* epl = nullptr) {
    const int wid = __builtin_amdgcn_readfirstlane(tid >> 6), lane = tid & 63, wr = wid >> 2, wc = wid & 3, fr = lane & 15, fq = lane >> 4;
    const int nt = RB / 128;
    int R0, C0; stage_rc(tid * 16, R0, C0);
    const int Rb0 = Epi::PERM ? ((R0 & ~31) + perm32(R0 & 31)) : R0;
    const unsigned voffB = (unsigned)(Rb0 * RB + C0 * 2);
    const unsigned cb0 = (unsigned)C0 * 2u, K2 = (unsigned)RB;
    const size_t kstep = (size_t)128;
    const size_t r64 = (size_t)64 * RB;
    const size_t hstep = (size_t)HALF * RB;
    const unsigned ldsw = (unsigned)wid * 1024u;
    const int aoff = lds_byte(wr * 64 + fr, fq * 8), boff = lds_byte(wc * 32 + fr, fq * 8);
#define PG8_SA(b, h) (((b) * 2 + (h)) * HTB)
#define PG8_SB(b, h) ((4 + (b) * 2 + (h)) * HTB)
#define PG8_STAGE(bufoff, gbase) do { glds16((const char*)(gbase), voffB, lds + (bufoff) + ldsw); glds16((const char*)(gbase) + r64, voffB, lds + (bufoff) + ldsw + 8192); } while (0)
#define PG8_STAGEA0(bufoff, kb, o0, o1) stage_a<GATHER>(lds + (bufoff) + ldsw, Abase + (kb), o0, o1, r64)
#define PG8_STAGEA1(bufoff, kb, o0, o2, o3) stage_a<GATHER>(lds + (bufoff) + ldsw, Abase + (kb) + (GATHER ? (size_t)0 : hstep), GATHER ? (o2) : (o0), o3, r64)
#define PG8_LDA(dst, b, h) do { _Pragma("unroll") for (int m = 0; m < 4; ++m) { const v4i _l = *(const LAS v4i*)(lds + PG8_SA(b, h) + aoff + m * 2048), _h = *(const LAS v4i*)(lds + PG8_SA(b, h) + aoff + m * 2048 + 1024); dst[m] = __builtin_shufflevector(_l, _h, 0, 1, 2, 3, 4, 5, 6, 7); } } while (0)
#define PG8_LDB(dst, b, h) do { _Pragma("unroll") for (int n = 0; n < 2; ++n) { const v4i _l = *(const LAS v4i*)(lds + PG8_SB(b, h) + boff + n * 2048), _h = *(const LAS v4i*)(lds + PG8_SB(b, h) + boff + n * 2048 + 1024); dst[n] = __builtin_shufflevector(_l, _h, 0, 1, 2, 3, 4, 5, 6, 7); } } while (0)
#define PG8_LO(x) __builtin_bit_cast(bf16x8, __builtin_shufflevector(x, x, 0, 1, 2, 3))
#define PG8_HI(x) __builtin_bit_cast(bf16x8, __builtin_shufflevector(x, x, 4, 5, 6, 7))
#define PG8_MMA(ai, bj, At, Bt) do { __builtin_amdgcn_s_setprio(1); _Pragma("unroll") for (int m = 0; m < 4; ++m) _Pragma("unroll") for (int n = 0; n < 2; ++n) { \
        if constexpr (FP8) asm volatile("v_mfma_scale_f32_16x16x128_f8f6f4 %0, %1, %2, %0, %3, %3 op_sel_hi:[0,0,0]" : "+v"(acc[ai][bj][m][n]) : "v"(Bt[n]), "v"(At[m]), "v"(sc1)); \
        else { acc[ai][bj][m][n] = __builtin_amdgcn_mfma_f32_16x16x32_bf16(PG8_LO(Bt[n]), PG8_LO(At[m]), acc[ai][bj][m][n], 0, 0, 0); \
               acc[ai][bj][m][n] = __builtin_amdgcn_mfma_f32_16x16x32_bf16(PG8_HI(Bt[n]), PG8_HI(At[m]), acc[ai][bj][m][n], 0, 0, 0); } } \
        __builtin_amdgcn_s_setprio(0); } while (0)
#define PG8_WAIT_V(n) asm volatile("s_waitcnt vmcnt(" #n ")" ::: "memory")
#define PG8_WAIT_L(n) asm volatile("s_waitcnt lgkmcnt(" #n ")" ::: "memory")
#define PG8_BAR __builtin_amdgcn_s_barrier()
#define PG8_SCHED __builtin_amdgcn_sched_barrier(0)
    Unit cur, nxt; int ui = 0;
    if (!ld_unit(ul, 0, cur)) return;
    f32x4 acc[2][2][4][2];
#pragma unroll
    for (int a = 0; a < 2; ++a)
#pragma unroll
        for (int b = 0; b < 2; ++b)
#pragma unroll
            for (int m = 0; m < 4; ++m)
#pragma unroll
                for (int n = 0; n < 2; ++n) { double z0, z1; asm volatile("v_mov_b64 %0, 0\n\tv_mov_b64 %1, 0" : "=v"(z0), "=v"(z1)); typedef double d2_t __attribute__((ext_vector_type(2))); acc[a][b][m][n] = __builtin_bit_cast(f32x4, (d2_t){z0, z1}); }
    v8i At[4], B0[2], B1[2];
    const int sc1 = 0x7f7f7f7f;
    unsigned oA0, oA1 = 0, oA2 = 0, oA3 = 0, oN0, oN1 = 0, oN2 = 0, oN3 = 0;
    if constexpr (GATHER) {
        oA0 = (unsigned)gtab[R0] * K2 + cb0; oA1 = (unsigned)gtab[R0 + 64] * K2 + cb0; oA2 = (unsigned)gtab[R0 + 128] * K2 + cb0; oA3 = (unsigned)gtab[R0 + 192] * K2 + cb0;
    } else {
        oA0 = (unsigned)(cur.rowbase + R0) * K2 + cb0;
    }
    oN0 = oA0; oN1 = oA1; oN2 = oA2; oN3 = oA3;
    const char* cB = Bbase + cur.boff;
    PG8_STAGE(PG8_SB(0, 0), cB); PG8_STAGE(PG8_SB(0, 1), cB + hstep); PG8_STAGEA0(PG8_SA(0, 0), (size_t)0, oA0, oA1); PG8_STAGEA1(PG8_SA(0, 1), (size_t)0, oA0, oA2, oA3);
    if (wr == 1) PG8_BAR;
    PG8_WAIT_V(2); PG8_BAR;
    PG8_STAGE(PG8_SB(1, 0), cB + kstep); PG8_STAGEA0(PG8_SA(1, 0), kstep, oA0, oA1); PG8_STAGE(PG8_SB(1, 1), cB + hstep + kstep);
    PG8_WAIT_V(6); PG8_BAR;
    for (;;) {
        const bool has_next = ld_unit(ul, ui + 1, nxt);
        if constexpr (Epi::HAS_PRE) E.pre(cur, epl + (ui & 1) * Epi::PRE_BYTES, wid, lane);
        const char* nB = has_next ? Bbase + nxt.boff : cB;
_Pragma("unroll 1")
        for (int t = 0; t < nt; t += 2) {
            const bool last = (t == nt - 2);
            if (last && has_next) {
                if constexpr (GATHER) {
                    const LAS int* gt = gtab + (ui + 1) * 256;
                    oN0 = (unsigned)gt[R0] * K2 + cb0; oN1 = (unsigned)gt[R0 + 64] * K2 + cb0; oN2 = (unsigned)gt[R0 + 128] * K2 + cb0; oN3 = (unsigned)gt[R0 + 192] * K2 + cb0;
                } else {
                    oN0 = (unsigned)(nxt.rowbase + R0) * K2 + cb0;
                }
            }
            const size_t kb1 = (size_t)(t + 1) * kstep;
            const size_t kb2 = last ? (size_t)0 : (size_t)(t + 2) * kstep, kb3 = kb2 + kstep;
            const unsigned p0 = last ? oN0 : oA0, p1 = last ? oN1 : oA1, p2 = last ? oN2 : oA2, p3 = last ? oN3 : oA3;
            const char* b2 = last ? nB : cB + (size_t)(t + 2) * kstep; const char* b3 = b2 + kstep;
            PG8_LDB(B0, 0, 0); PG8_LDB(B1, 0, 1); PG8_SCHED; PG8_LDA(At, 0, 0); PG8_STAGEA1(PG8_SA(1, 1), kb1, oA0, oA2, oA3);
            PG8_WAIT_V(8); PG8_WAIT_L(0); PG8_BAR; PG8_MMA(0, 0, At, B0); PG8_MMA(0, 1, At, B1); PG8_BAR; PG8_SCHED;
            PG8_LDA(At, 0, 1); PG8_STAGE(PG8_SB(0, 0), b2); PG8_STAGE(PG8_SB(0, 1), b2 + hstep); PG8_STAGEA0(PG8_SA(0, 0), kb2, p0, p1);
            PG8_WAIT_V(8); PG8_WAIT_L(0); PG8_BAR; PG8_MMA(1, 0, At, B0); PG8_MMA(1, 1, At, B1); PG8_BAR; PG8_SCHED;
            PG8_LDB(B0, 1, 0); PG8_LDB(B1, 1, 1); PG8_SCHED; PG8_LDA(At, 1, 0); PG8_STAGEA1(PG8_SA(0, 1), kb2, p0, p2, p3);
            PG8_WAIT_V(8); PG8_WAIT_L(0); PG8_BAR; PG8_MMA(0, 0, At, B0); PG8_MMA(0, 1, At, B1); PG8_BAR; PG8_SCHED;
            PG8_LDA(At, 1, 1); PG8_STAGE(PG8_SB(1, 0), b3); PG8_STAGE(PG8_SB(1, 1), b3 + hstep); PG8_STAGEA0(PG8_SA(1, 0), kb3, p0, p1);
            PG8_WAIT_V(8); PG8_WAIT_L(0); PG8_BAR; PG8_MMA(1, 0, At, B0); PG8_MMA(1, 1, At, B1); PG8_BAR; PG8_SCHED;
        }
        asm volatile("s_nop 7\n\ts_nop 7\n\ts_nop 7" ::: "memory");
        if constexpr (ALIGN_EPI) { if (wr == 0) PG8_BAR; }
        if constexpr (Epi::HAS_PRE) E(acc, cur, wr, wc, fr, fq, epl + (ui & 1) * Epi::PRE_BYTES); else E(acc, cur, wr, wc, fr, fq);
#if PROBE_EPI2
        if constexpr (FP8) { if constexpr (Epi::HAS_PRE) E(acc, cur, wr, wc, fr, fq, epl + (ui & 1) * Epi::PRE_BYTES); else E(acc, cur, wr, wc, fr, fq); }
#endif
        if (!has_next) break;
#pragma unroll
        for (int a = 0; a < 2; ++a)
#pragma unroll
            for (int b = 0; b < 2; ++b)
#pragma unroll
                for (int m = 0; m < 4; ++m)
#pragma unroll
                    for (int n = 0; n < 2; ++n) { double z0, z1; asm volatile("v_mov_b64 %0, 0\n\tv_mov_b64 %1, 0" : "=v"(z0), "=v"(z1)); typedef double d2_t __attribute__((ext_vector_type(2))); acc[a][b][m][n] = __builtin_bit_cast(f32x4, (d2_t){z0, z1}); }
        cur = nxt; cB = nB; oA0 = oN0; oA1 = oN1; oA2 = oN2; oA3 = oN3; ++ui;
        if constexpr (ALIGN_EPI) { if (wr == 1) PG8_BAR; }
    }
    PG8_WAIT_V(0);
    if constexpr (!ALIGN_EPI) { if (wr == 0) PG8_BAR; }
    PG8_BAR;
#undef PG8_SA
#undef PG8_SB
#undef PG8_STAGE
#undef PG8_STAGEA0
#undef PG8_STAGEA1
#undef PG8_LDA
#undef PG8_LDB
#undef PG8_LO
#undef PG8_HI
#undef PG8_MMA
#undef PG8_WAIT_V
#undef PG8_WAIT_L
#undef PG8_BAR
#undef PG8_SCHED
}

__device__ __forceinline__ GAS unsigned char* launder(unsigned char* p) { asm volatile("" : "+s"(p)); return (GAS unsigned char*)p; }
#define OPAQUE_LANE(fr, fq) asm volatile("" : "+v"(fr), "+v"(fq))
__device__ __forceinline__ f32x2 sigm2(const f32x2 v) { f32x2 e = v * -1.4426950408889634f; e.x = __builtin_amdgcn_exp2f(e.x); e.y = __builtin_amdgcn_exp2f(e.y); e = e + 1.0f; e.x = frcp(e.x); e.y = frcp(e.y); return e; }
__device__ __forceinline__ f32x4 silu4(const f32x4 v) { f32x4 e = v * -1.4426950408889634f;
#pragma unroll
    for (int j = 0; j < 4; ++j) e[j] = __builtin_amdgcn_exp2f(e[j]);
    e = e + 1.0f;
#pragma unroll
    for (int j = 0; j < 4; ++j) e[j] = frcp(e[j]);
    return v * e; }
__device__ __forceinline__ void row_scan_mul8(float& a, float& b, float& c, float& d, float& e, float& f, float& g, float& h) {
#define RSM_STEP(s) "v_mul_f32_dpp %0, %0, %0 row_shr:" #s " row_mask:0xf bank_mask:0xf\n\tv_mul_f32_dpp %1, %1, %1 row_shr:" #s " row_mask:0xf bank_mask:0xf\n\tv_mul_f32_dpp %2, %2, %2 row_shr:" #s " row_mask:0xf bank_mask:0xf\n\tv_mul_f32_dpp %3, %3, %3 row_shr:" #s " row_mask:0xf bank_mask:0xf\n\t" \
                    "v_mul_f32_dpp %4, %4, %4 row_shr:" #s " row_mask:0xf bank_mask:0xf\n\tv_mul_f32_dpp %5, %5, %5 row_shr:" #s " row_mask:0xf bank_mask:0xf\n\tv_mul_f32_dpp %6, %6, %6 row_shr:" #s " row_mask:0xf bank_mask:0xf\n\tv_mul_f32_dpp %7, %7, %7 row_shr:" #s " row_mask:0xf bank_mask:0xf\n\t"
    asm volatile("s_nop 1\n\t" RSM_STEP(1) RSM_STEP(2) RSM_STEP(4) RSM_STEP(8) : "+v"(a), "+v"(b), "+v"(c), "+v"(d), "+v"(e), "+v"(f), "+v"(g), "+v"(h));
#undef RSM_STEP
}
struct EpiHgrnIn {
    static constexpr bool PERM = true, HAS_PRE = true; static constexpr int PRE_BYTES = 1024;
    unsigned char* ws0; int L;
    __device__ __forceinline__ void pre(const Unit& u, LAS unsigned char* buf, int wid, int lane) const {
        if (wid == 0 && u.pn < 8) glds16((const char*)(ws0 + WS_LBS) + ((size_t)L * DM + (size_t)u.pn * HG_K) * 4, (unsigned)lane * 16u, buf);
    }
    __device__ __forceinline__ void operator()(const f32x4 (&acc)[2][2][4][2], const Unit& u, int wr, int wc, int fr, int fq, const LAS unsigned char* buf) const {
        OPAQUE_LANE(fr, fq);
        GAS unsigned char* ws = launder(ws0);
        GAS bf16* QD = (GAS bf16*)(ws + WS_H);
        const int row0 = u.rowbase + wr * 64 + fr;
        if (u.pn >= 8) {
            const bool isg = u.pn >= 12; GAS bf16* base = QD + (size_t)(isg ? 4 : 3) * NTOK * DM; const int colt = (u.pn - (isg ? 12 : 8)) * BM + wc * 32 + 8 * fq;
#pragma unroll
            for (int ai = 0; ai < 2; ++ai)
#pragma unroll
                for (int m = 0; m < 4; ++m) { GAS bf16* rowp = base + (size_t)(row0 + ai * HALF + m * 16) * DM + colt;
#pragma unroll
                    for (int bj = 0; bj < 2; ++bj) { f32x4 v0 = acc[ai][bj][m][0], v1 = acc[ai][bj][m][1];
                        if (isg) { v0 = silu4(v0); v1 = silu4(v1); }
                        v4u w; w.x = cvt_pk_bf16(v0[0], v0[1]); w.y = cvt_pk_bf16(v0[2], v0[3]); w.z = cvt_pk_bf16(v1[0], v1[1]); w.w = cvt_pk_bf16(v1[2], v1[3]);
                        *(GAS v4u*)(rowp + bj * HALF) = w; } }
            return;
        }
        const int col = u.pn * HG_K + wc * 32 + 8 * fq;
        const LAS float* lb = (const LAS float*)buf + wc * 32 + 8 * fq;
        const f32x4 lb0 = *(const LAS f32x4*)lb, lb1 = *(const LAS f32x4*)(lb + 4);
        GAS float* DEC = (GAS float*)(ws + WS_DEC);
        f32x2 lbp[4], oml[4];
        lbp[0] = __builtin_shufflevector(lb0, lb0, 0, 1); lbp[1] = __builtin_shufflevector(lb0, lb0, 2, 3); lbp[2] = __builtin_shufflevector(lb1, lb1, 0, 1); lbp[3] = __builtin_shufflevector(lb1, lb1, 2, 3);
#pragma unroll
        for (int p = 0; p < 4; ++p) oml[p] = 1.0f - lbp[p];
#pragma unroll
        for (int ai = 0; ai < 2; ++ai)
#pragma unroll
            for (int m = 0; m < 4; ++m) {
                const int row = row0 + ai * HALF + m * 16;
                float qd[8], ki[8], P[8];
#pragma unroll
                for (int p = 0; p < 4; ++p) {
                    const f32x4 q4 = acc[ai][0][m][p >> 1], f4 = acc[ai][1][m][p >> 1];
                    const f32x2 q2 = (p & 1) ? __builtin_shufflevector(q4, q4, 2, 3) : __builtin_shufflevector(q4, q4, 0, 1);
                    const f32x2 f2 = (p & 1) ? __builtin_shufflevector(f4, f4, 2, 3) : __builtin_shufflevector(f4, f4, 0, 1);
                    const f32x2 sg = sigm2(f2), fg = oml[p] * sg + lbp[p], kk = oml[p] * (1.0f - sg), sq = q2 * sigm2(q2);
                    P[2 * p] = fg.x; P[2 * p + 1] = fg.y; ki[2 * p] = kk.x; ki[2 * p + 1] = kk.y; qd[2 * p] = sq.x; qd[2 * p + 1] = sq.y;
                }
                row_scan_mul8(P[0], P[1], P[2], P[3], P[4], P[5], P[6], P[7]);
#pragma unroll
                for (int j = 0; j < 8; ++j) { const float iP = frcp(fmaxf(P[j], 1e-30f));
                    qd[j] *= P[j]; ki[j] *= iP; }
                const size_t o = (size_t)row * DM + col;
                v4u w;
                w.x = cvt_pk_bf16(qd[0], qd[1]); w.y = cvt_pk_bf16(qd[2], qd[3]); w.z = cvt_pk_bf16(qd[4], qd[5]); w.w = cvt_pk_bf16(qd[6], qd[7]); *(GAS v4u*)(QD + o) = w;
                w.x = cvt_pk_bf16(ki[0], ki[1]); w.y = cvt_pk_bf16(ki[2], ki[3]); w.z = cvt_pk_bf16(ki[4], ki[5]); w.w = cvt_pk_bf16(ki[6], ki[7]); *(GAS v4u*)(QD + (size_t)NTOK * DM + o) = w;
                if (fr == 15) { GAS float* dp = DEC + (size_t)(row >> 4) * DM + col; *(GAS f32x4*)dp = (f32x4){P[0], P[1], P[2], P[3]}; *(GAS f32x4*)(dp + 4) = (f32x4){P[4], P[5], P[6], P[7]}; }
            }
    }
};
struct EpiRetIn {
    static constexpr bool PERM = true, HAS_PRE = false; static constexpr int PRE_BYTES = 0;
    unsigned char* ws0;
    __device__ __forceinline__ void operator()(const f32x4 (&acc)[2][2][4][2], const Unit& u, int wr, int wc, int fr, int fq) const {
        OPAQUE_LANE(fr, fq);
        GAS unsigned char* ws = launder(ws0);
        GAS bf16* H = (GAS bf16*)(ws + WS_H);
        const int row0 = u.rowbase + wr * 64 + fr; const int colt = u.pn * BM + wc * 32 + 8 * fq;
        const int kind = u.pn < 4 ? 0 : (u.pn < 8 ? 1 : (u.pn < 16 ? 2 : 3));
        float ivf[2][4];
        if (kind <= 1) {
#pragma unroll
            for (int bj = 0; bj < 2; ++bj)
#pragma unroll
                for (int k = 0; k < 4; ++k) { const int p = ((bj * HALF + wc * 32 + 8 * fq) >> 1) + k; ivf[bj][k] = (1.0f / __builtin_amdgcn_exp2f(13.287712379549449f * ((float)p / 127.0f))); }
        }
#pragma unroll
        for (int ai = 0; ai < 2; ++ai)
#pragma unroll
            for (int m = 0; m < 4; ++m) { const int row = row0 + ai * HALF + m * 16; GAS bf16* rowp = H + (size_t)row * RT_IN + colt; const int pos = row & (SEQ - 1);
#pragma unroll
                for (int bj = 0; bj < 2; ++bj) { f32x4 v0 = acc[ai][bj][m][0], v1 = acc[ai][bj][m][1];
                    if (kind <= 1) {
                        f32x4 r0, r1;
#pragma unroll
                        for (int k = 0; k < 4; ++k) { const float th = (float)pos * ivf[bj][k]; const float fr2 = __builtin_amdgcn_fractf(th * 0.15915494309189535f);
                            const float cs = __builtin_amdgcn_cosf(fr2), sn = __builtin_amdgcn_sinf(fr2);
                            if (k < 2) { r0[2 * k] = cs; r0[2 * k + 1] = sn; } else { r1[2 * (k - 2)] = cs; r1[2 * (k - 2) + 1] = sn; } }
                        const float sc = kind == 1 ? 0.0625f : 1.0f;
                        f32x4 o0, o1;
                        o0[0] = (v0[0] * r0[0] - v0[1] * r0[1]) * sc; o0[1] = (v0[1] * r0[0] + v0[0] * r0[1]) * sc;
                        o0[2] = (v0[2] * r0[2] - v0[3] * r0[3]) * sc; o0[3] = (v0[3] * r0[2] + v0[2] * r0[3]) * sc;
                        o1[0] = (v1[0] * r1[0] - v1[1] * r1[1]) * sc; o1[1] = (v1[1] * r1[0] + v1[0] * r1[1]) * sc;
                        o1[2] = (v1[2] * r1[2] - v1[3] * r1[3]) * sc; o1[3] = (v1[3] * r1[2] + v1[2] * r1[3]) * sc;
                        v0 = o0; v1 = o1;
                    } else if (kind == 3) { v0 = silu4(v0); v1 = silu4(v1); }
                    v4u w; w.x = cvt_pk_bf16(v0[0], v0[1]); w.y = cvt_pk_bf16(v0[2], v0[3]); w.z = cvt_pk_bf16(v1[0], v1[1]); w.w = cvt_pk_bf16(v1[2], v1[3]);
                    *(GAS v4u*)(rowp + bj * HALF) = w; } }
    }
};
struct EpiRes {
    static constexpr bool PERM = true, HAS_PRE = true; static constexpr int PRE_BYTES = 1024;
    unsigned char* ws0; int ssoff; float ds;
    __device__ __forceinline__ void pre(const Unit& u, LAS unsigned char* buf, int wid, int lane) const {
        if (ssoff < 0) return;
        const int t = wid * 64 + lane, r = t >> 1, hf = t & 1;
        const GAS float* sp = (const GAS float*)(launder(ws0) + WS_SSP) + (size_t)(hf * HG_HEADS) * NTOK + u.rowbase + r;
        float s = 0.f;
#pragma unroll
        for (int hh = 0; hh < HG_HEADS; ++hh) s += sp[(size_t)hh * NTOK];
        s += dppf<0xB1>(s);
        if (hf == 0) ((LAS float*)buf)[r] = 1.0f / sqrtf(s * (1.0f / DM) + RMS_EPS);
    }
    __device__ __forceinline__ void operator()(const f32x4 (&acc)[2][2][4][2], const Unit& u, int wr, int wc, int fr, int fq, const LAS unsigned char* buf) const {
        OPAQUE_LANE(fr, fq);
        GAS unsigned char* ws = launder(ws0);
        GAS bf16* Y = (GAS bf16*)(ws + WS_Y); const GAS bf16* X = (const GAS bf16*)(ws + WS_XB);
        const int row0 = u.rowbase + wr * 64 + fr, col0 = u.pn * BM + wc * 32 + 8 * fq;
        v4u xs[2][4][2];
#pragma unroll
        for (int ai = 0; ai < 2; ++ai)
#pragma unroll
            for (int m = 0; m < 4; ++m)
#pragma unroll
                for (int bj = 0; bj < 2; ++bj) xs[ai][m][bj] = *(const GAS v4u*)(X + (size_t)(row0 + ai * HALF + m * 16) * DM + col0 + bj * HALF);
        asm volatile("" : "+v"(xs[0][0][0]), "+v"(xs[0][0][1]), "+v"(xs[0][1][0]), "+v"(xs[0][1][1]), "+v"(xs[0][2][0]), "+v"(xs[0][2][1]), "+v"(xs[0][3][0]), "+v"(xs[0][3][1]));
        asm volatile("" : "+v"(xs[1][0][0]), "+v"(xs[1][0][1]), "+v"(xs[1][1][0]), "+v"(xs[1][1][1]), "+v"(xs[1][2][0]), "+v"(xs[1][2][1]), "+v"(xs[1][3][0]), "+v"(xs[1][3][1]));
#pragma unroll
        for (int ai = 0; ai < 2; ++ai)
#pragma unroll
            for (int m = 0; m < 4; ++m) { const size_t off = (size_t)(row0 + ai * HALF + m * 16) * DM + col0;
                const float rsc = ssoff >= 0 ? ((const LAS float*)buf)[wr * 64 + fr + ai * HALF + m * 16] : 1.0f;
#pragma unroll
                for (int bj = 0; bj < 2; ++bj) { const v4u x4 = xs[ai][m][bj]; const f32x4 a0 = acc[ai][bj][m][0] * (rsc * ds), a1 = acc[ai][bj][m][1] * (rsc * ds);
                    v4u w; w.x = cvt_pk_bf16(bflo(x4.x) * DN_ALPHA + a0[0], bfhi(x4.x) * DN_ALPHA + a0[1]); w.y = cvt_pk_bf16(bflo(x4.y) * DN_ALPHA + a0[2], bfhi(x4.y) * DN_ALPHA + a0[3]);
                    w.z = cvt_pk_bf16(bflo(x4.z) * DN_ALPHA + a1[0], bfhi(x4.z) * DN_ALPHA + a1[1]); w.w = cvt_pk_bf16(bflo(x4.w) * DN_ALPHA + a1[2], bfhi(x4.w) * DN_ALPHA + a1[3]);
                    *(GAS v4u*)(Y + off + bj * HALF) = w; } }
    }
};
struct EpiMoeGU {
    static constexpr bool PERM = true, HAS_PRE = true; static constexpr int PRE_BYTES = 1024;
    unsigned char* ws0; int L;
    __device__ __forceinline__ void pre(const Unit& u, LAS unsigned char* buf, int wid, int lane) const {
        if (wid == 0) glds16((const char*)(ws0 + WS_BGU) + ((size_t)L * NE * 2048 + ((size_t)u.e * 8 + u.pn) * 256) * 4, (unsigned)lane * 16u, buf);
    }
    __device__ __forceinline__ void operator()(const f32x4 (&acc)[2][2][4][2], const Unit& u, int wr, int wc, int fr, int fq, const LAS unsigned char* buf) const {
        OPAQUE_LANE(fr, fq);
        GAS unsigned char* ws = launder(ws0);
        const int row0 = u.rowbase + wr * 64 + fr; const int c8 = wc * 32 + 8 * fq;
        const LAS float* bp = (const LAS float*)buf + c8;
        constexpr float CS = -2.4554669595930156f, K1 = GU_DESCALE * CS, K2 = GU_DESCALE * ACT_SCALE / CS, GLO = 7.0f * CS, LLO = -6.0f * ACT_SCALE / CS, LHI = 8.0f * ACT_SCALE / CS;
        f32x2 bgc[4], blc[4];
        { const f32x4 bg0 = *(const LAS f32x4*)bp, bg1 = *(const LAS f32x4*)(bp + 4), bl0 = *(const LAS f32x4*)(bp + HALF), bl1 = *(const LAS f32x4*)(bp + HALF + 4);
          bgc[0] = __builtin_shufflevector(bg0, bg0, 0, 1) * CS; bgc[1] = __builtin_shufflevector(bg0, bg0, 2, 3) * CS; bgc[2] = __builtin_shufflevector(bg1, bg1, 0, 1) * CS; bgc[3] = __builtin_shufflevector(bg1, bg1, 2, 3) * CS;
          blc[0] = __builtin_shufflevector(bl0, bl0, 0, 1) * (ACT_SCALE / CS) + (ACT_SCALE / CS); blc[1] = __builtin_shufflevector(bl0, bl0, 2, 3) * (ACT_SCALE / CS) + (ACT_SCALE / CS);
          blc[2] = __builtin_shufflevector(bl1, bl1, 0, 1) * (ACT_SCALE / CS) + (ACT_SCALE / CS); blc[3] = __builtin_shufflevector(bl1, bl1, 2, 3) * (ACT_SCALE / CS) + (ACT_SCALE / CS); }
#pragma unroll
        for (int ai = 0; ai < 2; ++ai)
#pragma unroll
            for (int m = 0; m < 4; ++m) { const size_t eo = (size_t)(row0 + ai * HALF + m * 16) * DM + u.pn * HALF + c8;
                float a[8];
                f32x2 gcv[4], lcv[4], dv[4];
#pragma unroll
                for (int p = 0; p < 4; ++p) {
                    const f32x4 ag4 = acc[ai][0][m][p >> 1], al4 = acc[ai][1][m][p >> 1];
                    const f32x2 ag = (p & 1) ? __builtin_shufflevector(ag4, ag4, 2, 3) : __builtin_shufflevector(ag4, ag4, 0, 1);
                    const f32x2 al = (p & 1) ? __builtin_shufflevector(al4, al4, 2, 3) : __builtin_shufflevector(al4, al4, 0, 1);
                    f32x2 gc = ag * K1 + bgc[p]; gc.x = fmaxf(gc.x, GLO); gc.y = fmaxf(gc.y, GLO); gcv[p] = gc;
                    f32x2 lc = al * K2 + blc[p]; lc.x = __builtin_amdgcn_fmed3f(lc.x, LLO, LHI); lc.y = __builtin_amdgcn_fmed3f(lc.y, LLO, LHI); lcv[p] = lc;
                }
#pragma unroll
                for (int p = 0; p < 4; ++p) { dv[p].x = __builtin_amdgcn_exp2f(gcv[p].x); dv[p].y = __builtin_amdgcn_exp2f(gcv[p].y); }
#pragma unroll
                for (int p = 0; p < 4; ++p) { dv[p] = dv[p] + 1.0f; lcv[p] = lcv[p] * gcv[p]; }
#pragma unroll
                for (int p = 0; p < 4; ++p) { dv[p].x = frcp(dv[p].x); dv[p].y = frcp(dv[p].y); }
#pragma unroll
                for (int p = 0; p < 4; ++p) { const f32x2 r = lcv[p] * dv[p]; a[2 * p] = r.x; a[2 * p + 1] = r.y; }
#if MOE_FP8
                v2u w;
                { int p = __builtin_amdgcn_cvt_pk_fp8_f32(a[0], a[1], 0, false); p = __builtin_amdgcn_cvt_pk_fp8_f32(a[2], a[3], p, true); w.x = (unsigned)p; }
                { int p = __builtin_amdgcn_cvt_pk_fp8_f32(a[4], a[5], 0, false); p = __builtin_amdgcn_cvt_pk_fp8_f32(a[6], a[7], p, true); w.y = (unsigned)p; }
                *(GAS v2u*)(ws + WS_ACT + eo) = w;
#else
                v4u w; w.x = cvt_pk_bf16(a[0], a[1]); w.y = cvt_pk_bf16(a[2], a[3]); w.z = cvt_pk_bf16(a[4], a[5]); w.w = cvt_pk_bf16(a[6], a[7]);
                *(GAS v4u*)((GAS bf16*)(ws + WS_ACT) + eo) = w;
#endif
            }
    }
};
struct EpiMoeDown {
    static constexpr bool PERM = true, HAS_PRE = true; static constexpr int PRE_BYTES = 3072;
    unsigned char* ws0; const float* bias;
    __device__ __forceinline__ void pre(const Unit& u, LAS unsigned char* buf, int wid, int lane) const {
        if (wid == 0) glds16((const char*)(bias + (size_t)u.e * DM + u.pn * BM), (unsigned)lane * 16u, buf);
        if (wid == 1) glds16((const char*)(ws0 + WS_ROWDST) + (size_t)u.gidx * 4, (unsigned)lane * 16u, buf + 1024);
        if (wid == 2) glds16((const char*)(ws0 + WS_ROWGATE) + (size_t)u.gidx * 4, (unsigned)lane * 16u, buf + 2048);
    }
    __device__ __forceinline__ void operator()(const f32x4 (&acc)[2][2][4][2], const Unit& u, int wr, int wc, int fr, int fq, const LAS unsigned char* buf) const {
        OPAQUE_LANE(fr, fq);
        GAS unsigned char* ws = launder(ws0);
        GAS bf16* YS = (GAS bf16*)(ws + WS_YSLOT);
        const int c8 = u.pn * BM + wc * 32 + 8 * fq;
        const LAS float* bp = (const LAS float*)buf + wc * 32 + 8 * fq;
        f32x4 bv[2][2];
#pragma unroll
        for (int bj = 0; bj < 2; ++bj) { bv[bj][0] = *(const LAS f32x4*)(bp + bj * HALF); bv[bj][1] = *(const LAS f32x4*)(bp + bj * HALF + 4); }
#pragma unroll
        for (int ai = 0; ai < 2; ++ai)
#pragma unroll
            for (int m = 0; m < 4; ++m) { const int r = ai * HALF + wr * 64 + m * 16 + fr;
                if (r < u.cnt) {
                    const int dst = ((const LAS int*)(buf + 1024))[r]; const float gt = ((const LAS float*)(buf + 2048))[r];
#if YS_FP8
                    GAS unsigned char* rowp = (GAS unsigned char*)YS + (size_t)dst * DM + c8;
#pragma unroll
                    for (int bj = 0; bj < 2; ++bj) { const f32x4 v0 = (acc[ai][bj][m][0] * DN_DESCALE + bv[bj][0]) * (gt * 64.0f), v1 = (acc[ai][bj][m][1] * DN_DESCALE + bv[bj][1]) * (gt * 64.0f);
                        v2u w; w.x = pk4_fp8(v0[0], v0[1], v0[2], v0[3]); w.y = pk4_fp8(v1[0], v1[1], v1[2], v1[3]);
                        *(GAS v2u*)(rowp + bj * HALF) = w; } } }
#else
                    GAS bf16* rowp = YS + (size_t)dst * DM + c8;
#pragma unroll
                    for (int bj = 0; bj < 2; ++bj) { const f32x4 v0 = (acc[ai][bj][m][0] * DN_DESCALE + bv[bj][0]) * gt, v1 = (acc[ai][bj][m][1] * DN_DESCALE + bv[bj][1]) * gt;
                        v4u w; w.x = cvt_pk_bf16(v0[0], v0[1]); w.y = cvt_pk_bf16(v0[2], v0[3]); w.z = cvt_pk_bf16(v1[0], v1[1]); w.w = cvt_pk_bf16(v1[2], v1[3]);
                        *(GAS v4u*)(rowp + bj * HALF) = w; } } }
#endif
    }
};
}

typedef short s16x4 __attribute__((ext_vector_type(4)));
typedef __bf16 bf16x2_t __attribute__((ext_vector_type(2)));
__device__ __forceinline__ unsigned cvtpk(float lo, float hi) { f32x2 v = {lo, hi}; bf16x2_t b = __builtin_convertvector(v, bf16x2_t); return __builtin_bit_cast(unsigned, b); }
__device__ __forceinline__ s16x4 tr_read(const LAS unsigned char* p) { return __builtin_bit_cast(s16x4, __builtin_amdgcn_ds_read_tr16_b64_v4i16((LAS s16x4*)p)); }
__device__ __forceinline__ bf16x8 cat8(s16x4 lo, s16x4 hi) { return __builtin_shufflevector(lo, hi, 0, 1, 2, 3, 4, 5, 6, 7); }
__device__ __forceinline__ bf16x8 pack8(const f32x4& a, const f32x4& b) { v4u p; p.x = cvtpk(a[0], a[1]); p.y = cvtpk(a[2], a[3]); p.z = cvtpk(b[0], b[1]); p.w = cvtpk(b[2], b[3]); return __builtin_bit_cast(bf16x8, p); }
__device__ __forceinline__ s16x4 pack4(const f32x4& a) { v2u p; p.x = cvtpk(a[0], a[1]); p.y = cvtpk(a[2], a[3]); return __builtin_bit_cast(s16x4, p); }
#define LDS_BARRIER() do { asm volatile("s_waitcnt lgkmcnt(0)" ::: "memory"); __builtin_amdgcn_s_barrier(); asm volatile("" ::: "memory"); } while (0)
#define MFMA32(a, b, c) __builtin_amdgcn_mfma_f32_16x16x32_bf16((a), (b), (c), 0, 0, 0)
#define MFMA16(a, b, c) __builtin_amdgcn_mfma_f32_16x16x16bf16_1k((a), (b), (c), 0, 0, 0)

__device__ __forceinline__ void ret_fast(const int tid, LAS unsigned char* lds, const bf16* HB, bf16* OB) {
    constexpr int QP = 528, VP = 272, PP = 144;
    constexpr int OFF_Q = 0, OFF_K = 64 * QP, OFF_V = 2 * 64 * QP, OFF_P = OFF_V + 64 * VP;
    const int lane0 = tid & 63, w = __builtin_amdgcn_readfirstlane(tid >> 6);
    const int prow = tid >> 3, pc = tid & 7;
    for (int un0 = blockIdx.x; un0 < NBATCH * RT_HEADS * 4; un0 += gridDim.x) {
        const int un = (gridDim.x == 256) ? ((un0 & 7) * 32 + (un0 >> 3)) : un0;
        const int b = un >> 4, h = (un >> 2) & 3, vs = un & 3;
        const float l2g = __builtin_amdgcn_logf(1.0f - __builtin_amdgcn_exp2f(-5.0f - (float)h));
        const float dC = __builtin_amdgcn_exp2f(64.0f * l2g);
        f32x4 st[16];
#pragma unroll
        for (int i = 0; i < 16; ++i) st[i] = (f32x4){0.f, 0.f, 0.f, 0.f};
        const bf16* gbase = HB + (size_t)(b * SEQ + prow) * RT_IN;
        v4u pq[4], pk[4], pv[2];
#pragma unroll
        for (int j = 0; j < 4; ++j) { pq[j] = *(const v4u*)(gbase + h * 256 + (pc + 8 * j) * 8); pk[j] = *(const v4u*)(gbase + 1024 + h * 256 + (pc + 8 * j) * 8); }
#pragma unroll
        for (int j = 0; j < 2; ++j) pv[j] = *(const v4u*)(gbase + 2048 + h * 512 + vs * 128 + (pc + 8 * j) * 8);
#pragma unroll 1
        for (int ch = 0; ch < SEQ / 64; ++ch) {
            int lane = lane0; asm volatile("" : "+v"(lane));
            const int r = lane & 15, g = lane >> 4, q4 = (lane & 15) >> 2, p4 = lane & 3;
            LDS_BARRIER();
#pragma unroll
            for (int j = 0; j < 4; ++j) { *(LAS v4u*)(lds + OFF_Q + prow * QP + (pc + 8 * j) * 16) = pq[j]; *(LAS v4u*)(lds + OFF_K + prow * QP + (pc + 8 * j) * 16) = pk[j]; }
#pragma unroll
            for (int j = 0; j < 2; ++j) *(LAS v4u*)(lds + OFF_V + prow * VP + (pc + 8 * j) * 16) = pv[j];
            if (ch + 1 < SEQ / 64) {
                const bf16* gn = gbase + (size_t)(ch + 1) * 64 * RT_IN;
#pragma unroll
                for (int j = 0; j < 4; ++j) { pq[j] = *(const v4u*)(gn + h * 256 + (pc + 8 * j) * 8); pk[j] = *(const v4u*)(gn + 1024 + h * 256 + (pc + 8 * j) * 8); }
#pragma unroll
                for (int j = 0; j < 2; ++j) pv[j] = *(const v4u*)(gn + 2048 + h * 512 + vs * 128 + (pc + 8 * j) * 8);
            }
            LDS_BARRIER();
            {
                const int ct = w >> 1, st0 = 2 * (w & 1);
                f32x4 sa0 = {0.f, 0.f, 0.f, 0.f}, sa1 = {0.f, 0.f, 0.f, 0.f};
                const LAS unsigned char* qb = lds + OFF_Q + (16 * ct + r) * QP + g * 16;
                const LAS unsigned char* kb0 = lds + OFF_K + (16 * st0 + r) * QP + g * 16;
#pragma unroll
                for (int hb = 0; hb < 4; ++hb) {
                    bf16x8 qf[2], k0[2], k1[2];
#pragma unroll
                    for (int kk = 0; kk < 2; ++kk) { const int kb = hb * 2 + kk; qf[kk] = *(const LAS bf16x8*)(qb + kb * 64); k0[kk] = *(const LAS bf16x8*)(kb0 + kb * 64); k1[kk] = *(const LAS bf16x8*)(kb0 + 16 * QP + kb * 64); }
                    asm volatile("" : "+v"(qf[0]), "+v"(qf[1]), "+v"(k0[0]), "+v"(k0[1]), "+v"(k1[0]), "+v"(k1[1]) :: "memory");
#pragma unroll
                    for (int kk = 0; kk < 2; ++kk) { sa0 = MFMA32(k0[kk], qf[kk], sa0); sa1 = MFMA32(k1[kk], qf[kk], sa1); }
                }
                asm volatile("s_nop 7\n\ts_nop 7" : "+v"(sa0), "+v"(sa1));
                const int c = 16 * ct + r;
#pragma unroll
                for (int t = 0; t < 2; ++t) {
                    const f32x4 sa = t ? sa1 : sa0; const int s0 = 16 * (st0 + t) + 4 * g; float v[4];
#pragma unroll
                    for (int i = 0; i < 4; ++i) { const int d = c - (s0 + i); v[i] = d >= 0 ? sa[i] * __builtin_amdgcn_exp2f((float)d * l2g) : 0.f; }
                    v2u pw; pw.x = cvtpk(v[0], v[1]); pw.y = cvtpk(v[2], v[3]);
                    *(LAS v2u*)(lds + OFF_P + c * PP + s0 * 2) = pw;
                }
            }
            LDS_BARRIER();
            f32x4 o[4];
#pragma unroll
            for (int ct = 0; ct < 4; ++ct) o[ct] = (f32x4){0.f, 0.f, 0.f, 0.f};
            {
                s16x4 ql[2][4], qh[2][4];
                const LAS unsigned char* qp0 = lds + OFF_Q + r * QP + (4 * g) * 2;
#pragma unroll
                for (int ct = 0; ct < 4; ++ct) { ql[0][ct] = *(const LAS s16x4*)(qp0 + ct * 16 * QP); qh[0][ct] = *(const LAS s16x4*)(qp0 + ct * 16 * QP + 32); }
#pragma unroll
                for (int kb = 0; kb < 8; ++kb) {
                    const int cu = kb & 1, nx = cu ^ 1;
                    if (kb + 1 < 8) {
#pragma unroll
                        for (int ct = 0; ct < 4; ++ct) { ql[nx][ct] = *(const LAS s16x4*)(qp0 + ct * 16 * QP + (kb + 1) * 64); qh[nx][ct] = *(const LAS s16x4*)(qp0 + ct * 16 * QP + (kb + 1) * 64 + 32); }
                    }
                    asm volatile("" : "+v"(ql[cu][0]), "+v"(ql[cu][1]), "+v"(ql[cu][2]), "+v"(ql[cu][3]), "+v"(qh[cu][0]), "+v"(qh[cu][1]), "+v"(qh[cu][2]), "+v"(qh[cu][3]) :: "memory");
                    const bf16x8 sa = pack8(st[2 * kb], st[2 * kb + 1]);
#pragma unroll
                    for (int ct = 0; ct < 4; ++ct) o[ct] = MFMA32(sa, cat8(ql[cu][ct], qh[cu][ct]), o[ct]);
                }
            }
            bf16x8 vf[2], pf[6];
            {
                s16x4 t0[2], t1[2];
#pragma unroll
                for (int sb = 0; sb < 2; ++sb) { const LAS unsigned char* vp = lds + OFF_V + (32 * sb + 8 * g + q4) * VP + (16 * w + 4 * p4) * 2; t0[sb] = tr_read(vp); t1[sb] = tr_read(vp + 4 * VP); }
                pf[0] = *(const LAS bf16x8*)(lds + OFF_P + (0 + r) * PP + (8 * g) * 2);
                pf[1] = *(const LAS bf16x8*)(lds + OFF_P + (16 + r) * PP + (8 * g) * 2);
                pf[2] = *(const LAS bf16x8*)(lds + OFF_P + (32 + r) * PP + (8 * g) * 2);
                pf[3] = *(const LAS bf16x8*)(lds + OFF_P + (32 + r) * PP + (32 + 8 * g) * 2);
                pf[4] = *(const LAS bf16x8*)(lds + OFF_P + (48 + r) * PP + (8 * g) * 2);
                pf[5] = *(const LAS bf16x8*)(lds + OFF_P + (48 + r) * PP + (32 + 8 * g) * 2);
                asm volatile("" : "+v"(t0[0]), "+v"(t0[1]), "+v"(t1[0]), "+v"(t1[1]), "+v"(pf[0]), "+v"(pf[1]), "+v"(pf[2]), "+v"(pf[3]), "+v"(pf[4]), "+v"(pf[5]) :: "memory");
                vf[0] = cat8(t0[0], t1[0]); vf[1] = cat8(t0[1], t1[1]);
            }
            asm volatile("s_nop 7\n\ts_nop 7" : "+v"(o[0]), "+v"(o[1]), "+v"(o[2]), "+v"(o[3]));
#pragma unroll
            for (int ct = 0; ct < 4; ++ct) o[ct] = o[ct] * __builtin_amdgcn_exp2f((float)(16 * ct + r + 1) * l2g);
            o[0] = MFMA32(vf[0], pf[0], o[0]); o[1] = MFMA32(vf[0], pf[1], o[1]);
            o[2] = MFMA32(vf[0], pf[2], o[2]); o[2] = MFMA32(vf[1], pf[3], o[2]);
            o[3] = MFMA32(vf[0], pf[4], o[3]); o[3] = MFMA32(vf[1], pf[5], o[3]);
            asm volatile("s_nop 7\n\ts_nop 7" : "+v"(o[0]), "+v"(o[1]), "+v"(o[2]), "+v"(o[3]));
            {
                bf16* ob = OB + (size_t)(b * SEQ + ch * 64 + r) * RT_VD + h * 512 + vs * 128 + 16 * w + 4 * g;
#pragma unroll
                for (int ct = 0; ct < 4; ++ct) { v2u ow; ow.x = cvtpk(o[ct][0], o[ct][1]); ow.y = cvtpk(o[ct][2], o[ct][3]); *(v2u*)(ob + (size_t)ct * 16 * RT_VD) = ow; }
            }
            bf16x8 vz[2];
#pragma unroll
            for (int sb = 0; sb < 2; ++sb) {
                const v4u raw = __builtin_bit_cast(v4u, vf[sb]); float f[8] = {bflo(raw.x), bfhi(raw.x), bflo(raw.y), bfhi(raw.y), bflo(raw.z), bfhi(raw.z), bflo(raw.w), bfhi(raw.w)};
#pragma unroll
                for (int j = 0; j < 8; ++j) f[j] *= __builtin_amdgcn_exp2f((float)(63 - (32 * sb + 8 * g + j)) * l2g);
                v4u z; z.x = cvtpk(f[0], f[1]); z.y = cvtpk(f[2], f[3]); z.z = cvtpk(f[4], f[5]); z.w = cvtpk(f[6], f[7]); vz[sb] = __builtin_bit_cast(bf16x8, z);
            }
            {
                const LAS unsigned char* kp0 = lds + OFF_K + (8 * g + q4) * QP + (4 * p4) * 2;
#pragma unroll
                for (int kq = 0; kq < 4; ++kq) {
                    s16x4 ka[4][2], kbh[4][2];
#pragma unroll
                    for (int j = 0; j < 4; ++j)
#pragma unroll
                        for (int sb = 0; sb < 2; ++sb) { const LAS unsigned char* kp = kp0 + (32 * sb) * QP + (16 * (kq * 4 + j)) * 2; ka[j][sb] = tr_read(kp); kbh[j][sb] = tr_read(kp + 4 * QP); }
                    asm volatile("" : "+v"(ka[0][0]), "+v"(ka[0][1]), "+v"(ka[1][0]), "+v"(ka[1][1]), "+v"(ka[2][0]), "+v"(ka[2][1]), "+v"(ka[3][0]), "+v"(ka[3][1]),
                                      "+v"(kbh[0][0]), "+v"(kbh[0][1]), "+v"(kbh[1][0]), "+v"(kbh[1][1]), "+v"(kbh[2][0]), "+v"(kbh[2][1]), "+v"(kbh[3][0]), "+v"(kbh[3][1]) :: "memory");
#pragma unroll
                    for (int j = 0; j < 4; ++j) { const int kt = kq * 4 + j;
                        st[kt] = st[kt] * dC;
                        st[kt] = MFMA32(cat8(ka[j][0], kbh[j][0]), vz[0], st[kt]);
                        st[kt] = MFMA32(cat8(ka[j][1], kbh[j][1]), vz[1], st[kt]); }
                }
            }
        }
        LDS_BARRIER();
    }
}

__device__ __forceinline__ void hgrn_fast(const int tid, LAS unsigned char* lds, const bf16* QD, const bf16* KI, const bf16* GG, const bf16* VV, const float* DEC, const float* ng, bf16* A2, float* SS) {
    constexpr int TP = 272;
    constexpr int TPH = 144;
    constexpr int OFF_QD = 0, OFF_KI = 64 * TP, OFF_G = 2 * 64 * TP, OFF_V = OFF_G + 64 * TPH, OFF_DEC = OFF_V + 64 * TPH, OFF_SS = OFF_DEC + 2048;
    const int lane = tid & 63, w = __builtin_amdgcn_readfirstlane(tid >> 6), r = lane & 15, g = lane >> 4, q4 = (lane & 15) >> 2, p4 = lane & 3;
    const int prow = tid >> 3, pc = tid & 7;
    for (int un0 = blockIdx.x; un0 < NBATCH * HG_HEADS * 2; un0 += gridDim.x) {
        const int un = (gridDim.x == 256) ? ((((un0 & 7) * 16 + (un0 >> 4)) << 1) | ((un0 >> 3) & 1)) : un0;
        const int b = un >> 4, h = (un >> 1) & 7, vh = un & 1, wv = vh * 4 + (w & 3);
        f32x4 st[8];
#pragma unroll
        for (int i = 0; i < 8; ++i) st[i] = (f32x4){0.f, 0.f, 0.f, 0.f};
        const f32x4 ng4 = *(const f32x4*)(ng + h * 128 + 16 * wv + 4 * g);
        const size_t goff = (size_t)(b * SEQ + prow) * DM + h * 128;
        v4u p0[2], p1[2], p2, p3; f32x4 pd = {0.f, 0.f, 0.f, 0.f};
#pragma unroll
        for (int j = 0; j < 2; ++j) { const size_t o = goff + (pc + 8 * j) * 8; p0[j] = *(const v4u*)(QD + o); p1[j] = *(const v4u*)(KI + o); }
        p2 = *(const v4u*)(GG + goff + vh * 64 + pc * 8); p3 = *(const v4u*)(VV + goff + vh * 64 + pc * 8);
        if (tid < 128) pd = *(const f32x4*)(DEC + (size_t)((b * SEQ) / 16 + (tid >> 5)) * DM + h * 128 + (tid & 31) * 4);
#pragma unroll 1
        for (int rd = 0; rd < SEQ / 64; ++rd) {
            LDS_BARRIER();
            if (rd > 0 && tid < 64) {
                float s = 0.f;
#pragma unroll
                for (int ww = 0; ww < 4; ++ww) s += *(const LAS float*)(lds + OFF_SS + (ww * 64 + tid) * 4);
                SS[(size_t)(h * 2 + vh) * NTOK + (size_t)b * SEQ + (rd - 1) * 64 + tid] = s;
            }
#pragma unroll
            for (int j = 0; j < 2; ++j) { const int lo = prow * TP + (pc + 8 * j) * 16; *(LAS v4u*)(lds + OFF_QD + lo) = p0[j]; *(LAS v4u*)(lds + OFF_KI + lo) = p1[j]; }
            *(LAS v4u*)(lds + OFF_G + prow * TPH + pc * 16) = p2; *(LAS v4u*)(lds + OFF_V + prow * TPH + pc * 16) = p3;
            if (tid < 128) *(LAS f32x4*)(lds + OFF_DEC + tid * 16) = pd;
            if (rd + 1 < SEQ / 64) {
                const size_t gn = goff + (size_t)(rd + 1) * 64 * DM;
#pragma unroll
                for (int j = 0; j < 2; ++j) { const size_t o = gn + (pc + 8 * j) * 8; p0[j] = *(const v4u*)(QD + o); p1[j] = *(const v4u*)(KI + o); }
                p2 = *(const v4u*)(GG + gn + vh * 64 + pc * 8); p3 = *(const v4u*)(VV + gn + vh * 64 + pc * 8);
                if (tid < 128) pd = *(const f32x4*)(DEC + (size_t)((b * SEQ + (rd + 1) * 64) / 16 + (tid >> 5)) * DM + h * 128 + (tid & 31) * 4);
            }
            LDS_BARRIER();
            if (w < 4)
#pragma unroll 1
            for (int cc = 0; cc < 4; ++cc) {
                s16x4 ql[4], qh[4], kl[4], kh[4], ktr[8]; f32x4 d4[8];
#pragma unroll
                for (int kb = 0; kb < 4; ++kb) {
                    const int off = (16 * cc + r) * TP + (32 * kb + 4 * g) * 2;
                    ql[kb] = *(const LAS s16x4*)(lds + OFF_QD + off); qh[kb] = *(const LAS s16x4*)(lds + OFF_QD + off + 32);
                    kl[kb] = *(const LAS s16x4*)(lds + OFF_KI + off); kh[kb] = *(const LAS s16x4*)(lds + OFF_KI + off + 32);
                }
                s16x4 vfr = tr_read(lds + OFF_V + (16 * cc + 4 * g + q4) * TPH + (16 * (w & 3) + 4 * p4) * 2);
                s16x4 gfr = *(const LAS s16x4*)(lds + OFF_G + (16 * cc + r) * TPH + (16 * (w & 3) + 4 * g) * 2);
#pragma unroll
                for (int kt = 0; kt < 8; ++kt) {
                    d4[kt] = *(const LAS f32x4*)(lds + OFF_DEC + cc * 512 + (16 * kt + 4 * g) * 4);
                    ktr[kt] = tr_read(lds + OFF_KI + (16 * cc + 4 * g + q4) * TP + (16 * kt + 4 * p4) * 2);
                }
                asm volatile("" : "+v"(ql[0]), "+v"(ql[1]), "+v"(ql[2]), "+v"(ql[3]), "+v"(qh[0]), "+v"(qh[1]), "+v"(qh[2]), "+v"(qh[3]),
                                  "+v"(kl[0]), "+v"(kl[1]), "+v"(kl[2]), "+v"(kl[3]), "+v"(kh[0]), "+v"(kh[1]), "+v"(kh[2]), "+v"(kh[3]), "+v"(vfr), "+v"(gfr));
                asm volatile("" : "+v"(ktr[0]), "+v"(ktr[1]), "+v"(ktr[2]), "+v"(ktr[3]), "+v"(ktr[4]), "+v"(ktr[5]), "+v"(ktr[6]), "+v"(ktr[7]),
                                  "+v"(d4[0]), "+v"(d4[1]), "+v"(d4[2]), "+v"(d4[3]), "+v"(d4[4]), "+v"(d4[5]), "+v"(d4[6]), "+v"(d4[7]));
                bf16x8 qf[4];
#pragma unroll
                for (int kb = 0; kb < 4; ++kb) qf[kb] = cat8(ql[kb], qh[kb]);
                f32x4 sc = {0.f, 0.f, 0.f, 0.f}, oa = {0.f, 0.f, 0.f, 0.f};
#pragma unroll
                for (int kb = 0; kb < 4; ++kb) sc = MFMA32(cat8(kl[kb], kh[kb]), qf[kb], sc);
#pragma unroll
                for (int kb = 0; kb < 4; ++kb) oa = MFMA32(pack8(st[2 * kb], st[2 * kb + 1]), qf[kb], oa);
#pragma unroll
                for (int kt = 0; kt < 8; ++kt) st[kt] = MFMA16(ktr[kt], vfr, st[kt]);
                asm volatile("s_nop 7\n\ts_nop 7" : "+v"(st[0]), "+v"(st[1]), "+v"(st[2]), "+v"(st[3]), "+v"(st[4]), "+v"(st[5]), "+v"(st[6]), "+v"(st[7]), "+v"(sc), "+v"(oa));
#pragma unroll
                for (int kt = 0; kt < 8; ++kt) st[kt] = st[kt] * d4[kt];
#pragma unroll
                for (int i = 0; i < 4; ++i) sc[i] = (4 * g + i <= r) ? sc[i] : 0.f;
                oa = MFMA16(vfr, pack4(sc), oa);
                asm volatile("s_nop 7\n\ts_nop 7" : "+v"(oa));
                { const v2u gr = __builtin_bit_cast(v2u, gfr);
                  v2u ow; ow.x = cvtpk(oa[0] * ng4[0] * bflo(gr.x), oa[1] * ng4[1] * bfhi(gr.x)); ow.y = cvtpk(oa[2] * ng4[2] * bflo(gr.y), oa[3] * ng4[3] * bfhi(gr.y));
                  *(v2u*)(A2 + (size_t)(b * SEQ + rd * 64 + cc * 16 + r) * DM + h * 128 + 16 * wv + 4 * g) = ow;
                  float p = (oa[0] * oa[0] + oa[1] * oa[1]) + (oa[2] * oa[2] + oa[3] * oa[3]);
                  { const unsigned pb = __builtin_bit_cast(unsigned, p); auto sw = __builtin_amdgcn_permlane16_swap(pb, pb, false, false); p = __builtin_bit_cast(float, (unsigned)sw[0]) + __builtin_bit_cast(float, (unsigned)sw[1]); }
                  { const unsigned pb = __builtin_bit_cast(unsigned, p); auto sw = __builtin_amdgcn_permlane32_swap(pb, pb, false, false); p = __builtin_bit_cast(float, (unsigned)sw[0]) + __builtin_bit_cast(float, (unsigned)sw[1]); }
                  if (lane < 16) *(LAS float*)(lds + OFF_SS + (w * 64 + cc * 16 + r) * 4) = p; }
            }
        }
        LDS_BARRIER();
        if (tid < 64) { float s = 0.f;
#pragma unroll
            for (int ww = 0; ww < 4; ++ww) s += *(const LAS float*)(lds + OFF_SS + (ww * 64 + tid) * 4);
            SS[(size_t)(h * 2 + vh) * NTOK + (size_t)b * SEQ + (SEQ / 64 - 1) * 64 + tid] = s; }
        LDS_BARRIER();
    }
}

struct Args { const float* in[17]; float* out; unsigned char* ws; int ph_lo, ph_hi; };
enum { I_X = 0, I_HWIN, I_HNG, I_HWOUT, I_LB, I_RWIN, I_RWOUT, I_LNMG, I_LNMB, I_LNFG, I_LNFB, I_RW, I_RB, I_WGU, I_BGU, I_WDN, I_BDN };

__device__ __forceinline__ int dest_row(int mode, int n) {
    if (mode == 1) { if (n < 1024) return ((n >> 7) << 8) + (n & 127); if (n < 2048) { const int q = n - 1024; return ((q >> 7) << 8) + 128 + (q & 127); } return n; }
    if (mode == 2) { const int j2 = n >> 1; return ((j2 >> 7) << 8) + ((n & 1) << 7) + (j2 & 127); }
    return n;
}
__device__ __forceinline__ void transpose_item(const float* W, int K, int N, bf16* WT, int mode, LAS float* scr, int item, int lane) {
    const int nblk = N / 64, kb = item / nblk, nb = item % nblk, k0 = 64 * kb, n0 = 64 * nb;
#pragma unroll 4
    for (int i = 0; i < 16; ++i) { const int kk = 4 * i + (lane >> 4), c4 = (lane & 15) * 4;
        const f32x4 v = *(const GAS f32x4*)(W + (size_t)(k0 + kk) * N + n0 + c4);
        LAS float* s = scr + kk * 65 + c4; s[0] = v[0]; s[1] = v[1]; s[2] = v[2]; s[3] = v[3]; }
    LDS_WAIT(); asm volatile("" ::: "memory");
    const int c = lane & 7;
#pragma unroll 2
    for (int j = 0; j < 8; ++j) { const int n = (lane >> 3) + 8 * j; const LAS float* s = scr + (8 * c) * 65 + n;
        v4u o; o.x = pk2(s[0 * 65], s[1 * 65]); o.y = pk2(s[2 * 65], s[3 * 65]); o.z = pk2(s[4 * 65], s[5 * 65]); o.w = pk2(s[6 * 65], s[7 * 65]);
        *(GAS v4u*)(WT + (size_t)dest_row(mode, n0 + n) * K + k0 + 8 * c) = o; }
    LDS_WAIT(); asm volatile("" ::: "memory");
}

__device__ __forceinline__ void transpose_item_fp8(const float* W, int K, int N, unsigned char* WT, int mode, float scale, LAS float* scr, int item, int lane) {
    const int nblk = N / 64, kb = item / nblk, nb = item % nblk, k0 = 64 * kb, n0 = 64 * nb;
#pragma unroll 4
    for (int i = 0; i < 16; ++i) { const int kk = 4 * i + (lane >> 4), c4 = (lane & 15) * 4;
        const f32x4 v = *(const GAS f32x4*)(W + (size_t)(k0 + kk) * N + n0 + c4);
        LAS float* s = scr + kk * 65 + c4; s[0] = v[0]; s[1] = v[1]; s[2] = v[2]; s[3] = v[3]; }
    LDS_WAIT(); asm volatile("" ::: "memory");
    const int c = lane & 7;
#pragma unroll 2
    for (int j = 0; j < 8; ++j) { const int n = (lane >> 3) + 8 * j; const LAS float* s = scr + (8 * c) * 65 + n;
        v2u o; o.x = pk4_fp8(s[0 * 65] * scale, s[1 * 65] * scale, s[2 * 65] * scale, s[3 * 65] * scale); o.y = pk4_fp8(s[4 * 65] * scale, s[5 * 65] * scale, s[6 * 65] * scale, s[7 * 65] * scale);
        *(GAS v2u*)(WT + (size_t)dest_row(mode, n0 + n) * K + k0 + 8 * c) = o; }
    LDS_WAIT(); asm volatile("" ::: "memory");
}

#ifndef SITE_MASK
#define SITE_MASK 0xffff
#endif
#define SITE(n) (((SITE_MASK) >> (n)) & 1)
#ifndef PROBE_MASK
#define PROBE_MASK 0
#endif
#define REP(n) (1 + (((PROBE_MASK) >> (n)) & 1))
typedef const __attribute__((address_space(4))) Args* KArgs;
__device__ __forceinline__ int otid(int wave0) { int l; asm volatile("v_mbcnt_lo_u32_b32 %0, -1, 0\n\tv_mbcnt_hi_u32_b32 %0, -1, %0" : "=v"(l)); asm volatile("" : "+s"(wave0)); return wave0 * 64 + l; }
__device__ __forceinline__ LAS unsigned char* olds(LAS unsigned char* p) { asm volatile("" : "+s"(p)); return p; }
__device__ __forceinline__ KArgs kargs() { KArgs p = (KArgs)__builtin_amdgcn_kernarg_segment_ptr(); asm volatile("" : "+s"(p)); return p; }
#define IN(k) (ap->ph_lo <= (k) && (k) < ap->ph_hi)
#ifndef PROBE_BAR
#define PROBE_BAR 1
#endif
#define GRID_BAR() for (int _r = 0; _r < PROBE_BAR; ++_r) do { if (ap->ph_hi - ap->ph_lo > 1) { XcdBarrier _b; _b.bar = (unsigned*)(ap->ws + WS_CTL) + CW_BAR; _b.x = xb_xcc_id(); _b.st = (volatile LAS unsigned*)(lds + MISC_OFF + MO_BARW); xcd_barrier(_b); } } while (0)
#define VCU() ((gridDim.x % 8 == 0) ? (int)((blockIdx.x % 8) * (gridDim.x / 8) + blockIdx.x / 8) : (int)blockIdx.x)

__global__ void __launch_bounds__(512, 2) mk_fwd(Args args_unused) {
    extern __shared__ __attribute__((aligned(16))) unsigned char lds_raw[];
    LAS unsigned char* const lds0 = (LAS unsigned char*)lds_raw;
    const int wave0 = __builtin_amdgcn_readfirstlane((int)(threadIdx.x >> 6));
    {
        LAS unsigned char* lds = lds0;
        for (int u = threadIdx.x; u < (LDS_BYTES - MISC_OFF) / 4; u += 512) ((LAS unsigned*)(lds + MISC_OFF))[u] = 0u;
        __syncthreads();
        KArgs ap = kargs();
        if (ap->ph_hi - ap->ph_lo > 1) (void)xcd_barrier_post((unsigned*)(ap->ws + WS_CTL) + CW_BAR, (volatile LAS unsigned*)(lds + MISC_OFF + MO_BARW));
    }

#if SITE(0)
    { KArgs ap = kargs(); const int tid = otid(wave0); LAS unsigned char* lds = olds(lds0); (void)tid;
    if (IN(0)) for (int rep_ = 0; rep_ < REP(0); ++rep_) {
        const int lane = tid & 63, wave = __builtin_amdgcn_readfirstlane(tid >> 6), G = gridDim.x, vcu = VCU(), gw = vcu * 8 + wave, NGW = G * 8;
        unsigned char* ws = ap->ws;
        LAS float* scr = (LAS float*)(lds + wave * 16640);
        constexpr int I_HIN = 2 * 16 * 64, I_HOUT = 2 * 16 * 16, I_RIN = 2 * 16 * 96, I_ROUT = 2 * 32 * 16, I_GU = 128 * 16 * 32, I_DN = 128 * 16 * 16;
        constexpr int NITEMS = I_HIN + I_HOUT + I_RIN + I_ROUT + I_GU + I_DN + I_ROUT;
        for (int it = gw; it < NITEMS; it += NGW) {
            int r = it;
            if (r < I_HIN) { const int j = r / (16 * 64); transpose_item(ap->in[I_HWIN] + (size_t)j * DM * HG_IN, DM, HG_IN, (bf16*)(ws + WS_W_HIN) + (size_t)j * HG_IN * DM, 1, scr, r % (16 * 64), lane); continue; } r -= I_HIN;
            if (r < I_HOUT) { const int j = r / 256; transpose_item(ap->in[I_HWOUT] + (size_t)j * DM * DM, DM, DM, (bf16*)(ws + WS_W_HOUT) + (size_t)j * DM * DM, 0, scr, r % 256, lane); continue; } r -= I_HOUT;
            if (r < I_RIN) { const int j = r / (16 * 96); transpose_item(ap->in[I_RWIN] + (size_t)j * DM * RT_IN, DM, RT_IN, (bf16*)(ws + WS_W_RIN) + (size_t)j * RT_IN * DM, 0, scr, r % (16 * 96), lane); continue; } r -= I_RIN;
            if (r < I_ROUT) { const int j = r / 512; transpose_item(ap->in[I_RWOUT] + (size_t)j * RT_VD * DM, RT_VD, DM, (bf16*)(ws + WS_W_ROUT) + (size_t)j * DM * RT_VD, 0, scr, r % 512, lane); continue; } r -= I_ROUT;
#if MOE_FP8
            if (r < I_GU) { const int j = r / 512; transpose_item_fp8(ap->in[I_WGU] + (size_t)j * DM * 2048, DM, 2048, ws + WS_W_GU + (size_t)j * 2048 * DM, 2, WGU_SCALE, scr, r % 512, lane); continue; } r -= I_GU;
            if (r < I_DN) { const int j = r / 256; transpose_item_fp8(ap->in[I_WDN] + (size_t)j * DM * DM, DM, DM, ws + WS_W_DN + (size_t)j * DM * DM, 0, WDN_SCALE, scr, r % 256, lane); continue; } r -= I_DN;
            { const int j = r / 512; transpose_item_fp8(ap->in[I_RWOUT] + (size_t)j * RT_VD * DM, RT_VD, DM, ws + WS_W_ROUT8 + (size_t)j * DM * RT_VD, 0, 128.0f, scr, r % 512, lane); }
#else
            if (r < I_GU) { const int j = r / 512; transpose_item(ap->in[I_WGU] + (size_t)j * DM * 2048, DM, 2048, (bf16*)(ws + WS_W_GU) + (size_t)j * 2048 * DM, 2, scr, r % 512, lane); continue; } r -= I_GU;
            { const int j = r / 256; transpose_item(ap->in[I_WDN] + (size_t)j * DM * DM, DM, DM, (bf16*)(ws + WS_W_DN) + (size_t)j * DM * DM, 0, scr, r % 256, lane); }
#endif
        }
        const int gt = vcu * 512 + tid, NGT = G * 512;
        float* LBS = (float*)(ws + WS_LBS); float* BGU = (float*)(ws + WS_BGU); bf16* XB = (bf16*)(ws + WS_XB);
        for (int d = gt; d < DM; d += NGT) { const float* lbp = ap->in[I_LB]; const float v0 = lbp[d], v1 = lbp[DM + d], v2 = lbp[2 * DM + d], v3 = lbp[3 * DM + d]; const float mx = fmaxf(fmaxf(v0, v1), fmaxf(v2, v3));
            const float e0 = __expf(v0 - mx), e1 = __expf(v1 - mx), e2 = __expf(v2 - mx), e3 = __expf(v3 - mx), is = 1.0f / (e0 + e1 + e2 + e3);
            LBS[d] = 0.f; LBS[DM + d] = e1 * is; LBS[2 * DM + d] = (e1 + e2) * is; LBS[3 * DM + d] = (e1 + e2 + e3) * is; }
        for (int i = gt; i < 4 * DM * NE; i += NGT) { const int l = i >> 15, d = (i >> 5) & 1023, e = i & 31; const float wv = ap->in[I_RW][i]; const unsigned hb = f2bf(wv); const float hv = __builtin_bit_cast(float, hb << 16);
            ((bf16*)(ws + WS_WRH))[(size_t)l * 32768 + e * 1024 + d] = (bf16)hb; ((bf16*)(ws + WS_WRL))[(size_t)l * 32768 + e * 1024 + d] = (bf16)f2bf(wv - hv); }
        for (int i = gt; i < 4 * 32 * 2048; i += NGT) { const int le = i >> 11, n = i & 2047; BGU[(size_t)le * 2048 + dest_row(2, n)] = ap->in[I_BGU][i]; }
        for (size_t i = (size_t)gt; i < (size_t)NTOK * DM / 4; i += NGT) { const f32x4 v = ((const f32x4*)ap->in[I_X])[i]; v2u o; o.x = pk2(v[0], v[1]); o.y = pk2(v[2], v[3]); ((v2u*)XB)[i] = o; }
        GRID_BAR();
    } }
#endif

#pragma unroll 1
    for (int L = 0; L < DEPTH; ++L) {
        const int pb = 1 + 8 * L;
        if ((L & 1) == 0) {
#if SITE(1)
            { KArgs ap = kargs(); const int tid = otid(wave0); LAS unsigned char* lds = olds(lds0); (void)tid;
            if (IN(pb + 0)) for (int rep_ = 0; rep_ < REP(1); ++rep_) {
                unsigned char* ws = ap->ws; const int j = L >> 1;
                LAS int* ul = (LAS int*)(lds + MISC_OFF + MO_ULIST);
                pg8::build_units_dense(tid, ul, NTOK / 256, HG_IN / 256, DM * 2);
                pg8::EpiHgrnIn E{ws, L};
                pg8::gemm_phase<pg8::EpiHgrnIn, false, true, false>(tid, lds, ul, (LAS int*)(lds + MISC_OFF + MO_GTAB), (const char*)(ws + WS_XB), (const char*)((bf16*)(ws + WS_W_HIN) + (size_t)j * HG_IN * DM), nullptr, DM * 2, E, lds + MISC_OFF + MO_GTAB);
                GRID_BAR();
            } }
#endif
#if SITE(2)
            { KArgs ap = kargs(); const int tid = otid(wave0); LAS unsigned char* lds = olds(lds0); (void)tid;
            if (IN(pb + 1)) for (int rep_ = 0; rep_ < REP(2); ++rep_) {
#if !SLOW_HGRN
                { unsigned char* ws = ap->ws; const bf16* QD = (const bf16*)(ws + WS_H);
                  hgrn_fast(tid, lds, QD, QD + (size_t)NTOK * DM, QD + 4 * (size_t)NTOK * DM, QD + 3 * (size_t)NTOK * DM, (const float*)(ws + WS_DEC), ap->in[I_HNG] + (L >> 1) * DM,
                            (bf16*)(ws + WS_A2), (float*)(ws + WS_SSP)); }
#else
                unsigned char* ws = ap->ws; const bf16* QD = (const bf16*)(ws + WS_H); const bf16* KI = QD + (size_t)NTOK * DM; const bf16* KS = QD + 2 * (size_t)NTOK * DM; const bf16* VV = QD + 3 * (size_t)NTOK * DM; bf16* OB = (bf16*)(ws + WS_O);
                LAS float* qf = (LAS float*)lds; LAS float* kf = qf + 16 * 4 * 36; LAS float* ff = kf + 16 * 4 * 36; LAS float* vf = ff + 16 * 4 * 36;
                for (int un = blockIdx.x; un < NBATCH * HG_HEADS; un += gridDim.x) {
                    const int b = un >> 3, h = un & 7; const int vc = tid >> 2, kq = tid & 3;
                    float st[32];
#pragma unroll
                    for (int i = 0; i < 32; ++i) st[i] = 0.f;
                    for (int t0 = 0; t0 < SEQ; t0 += 16) {
                        __syncthreads();
                        for (int e = tid; e < 16 * 128; e += 512) { const int tt = e >> 7, k = e & 127; const size_t gi = (size_t)(b * SEQ + t0 + tt) * DM + h * 128 + k; const int li = tt * 144 + (k & 3) * 36 + (k >> 2);
                            qf[li] = bf1(QD[gi]); kf[li] = bf1(KI[gi]); ff[li] = bf1(KS[gi]); vf[tt * 128 + k] = bf1(VV[gi]); }
                        __syncthreads();
                        for (int tt = 0; tt < 16; ++tt) {
                            const float v = vf[tt * 128 + vc]; float a = 0.f; const int lb = tt * 144 + kq * 36;
#pragma unroll
                            for (int i = 0; i < 32; ++i) { st[i] = ff[lb + i] * st[i] + kf[lb + i] * v; a += qf[lb + i] * st[i]; }
                            a += __shfl_xor(a, 1); a += __shfl_xor(a, 2);
                            if (kq == 0) OB[(size_t)(b * SEQ + t0 + tt) * DM + h * 128 + vc] = (bf16)f2bf(a);
                        }
                    }
                }
#endif
                GRID_BAR();
            } }
#endif
#if SITE(3) && SLOW_HGRN
            { KArgs ap = kargs(); const int tid = otid(wave0); LAS unsigned char* lds = olds(lds0); (void)tid;
            if (IN(pb + 2)) for (int rep_ = 0; rep_ < REP(3); ++rep_) {
                const int lane = tid & 63, wave = __builtin_amdgcn_readfirstlane(tid >> 6), gw = VCU() * 8 + wave, NGW = gridDim.x * 8;
                unsigned char* ws = ap->ws; const bf16* OB = (const bf16*)(ws + WS_O); const bf16* GG = (const bf16*)(ws + WS_H) + 4 * (size_t)NTOK * DM; bf16* A2 = (bf16*)(ws + WS_A2);
                const float* ng = ap->in[I_HNG] + (L >> 1) * DM;
                f32x4 g4[4];
#pragma unroll
                for (int q = 0; q < 4; ++q) g4[q] = *(const f32x4*)(ng + 256 * q + 4 * lane);
                v2u on[4], gn[4];
#pragma unroll
                for (int q = 0; q < 4; ++q) { on[q] = *(const v2u*)(OB + (size_t)gw * DM + 256 * q + 4 * lane); gn[q] = *(const v2u*)(GG + (size_t)gw * DM + 256 * q + 4 * lane); }
#pragma unroll 1
                for (int row = gw; row < NTOK; row += NGW) {
                    v2u oc[4], gc[4];
#pragma unroll
                    for (int q = 0; q < 4; ++q) { oc[q] = on[q]; gc[q] = gn[q]; }
                    if (row + NGW < NTOK) {
#pragma unroll
                        for (int q = 0; q < 4; ++q) { on[q] = *(const v2u*)(OB + (size_t)(row + NGW) * DM + 256 * q + 4 * lane); gn[q] = *(const v2u*)(GG + (size_t)(row + NGW) * DM + 256 * q + 4 * lane); } }
                    float o[16]; float ss = 0.f;
#pragma unroll
                    for (int q = 0; q < 4; ++q) { o[4 * q] = bflo(oc[q].x); o[4 * q + 1] = bfhi(oc[q].x); o[4 * q + 2] = bflo(oc[q].y); o[4 * q + 3] = bfhi(oc[q].y); }
#pragma unroll
                    for (int i = 0; i < 16; ++i) ss += o[i] * o[i];
                    const float rs = 1.0f / sqrtf(wave_sum(ss) * (1.0f / DM) + RMS_EPS);
#pragma unroll
                    for (int q = 0; q < 4; ++q) {
                        v2u w; w.x = pk2(o[4 * q] * rs * g4[q][0] * bflo(gc[q].x), o[4 * q + 1] * rs * g4[q][1] * bfhi(gc[q].x)); w.y = pk2(o[4 * q + 2] * rs * g4[q][2] * bflo(gc[q].y), o[4 * q + 3] * rs * g4[q][3] * bfhi(gc[q].y));
                        *(v2u*)(A2 + (size_t)row * DM + 256 * q + 4 * lane) = w; }
                }
                GRID_BAR();
            } }
#endif
        } else {
#if SITE(4)
            { KArgs ap = kargs(); const int tid = otid(wave0); LAS unsigned char* lds = olds(lds0); (void)tid;
            if (IN(pb + 0)) for (int rep_ = 0; rep_ < REP(4); ++rep_) {
                unsigned char* ws = ap->ws; const int j = L >> 1;
                LAS int* ul = (LAS int*)(lds + MISC_OFF + MO_ULIST);
                pg8::build_units_dense(tid, ul, NTOK / 256, RT_IN / 256, DM * 2);
                pg8::EpiRetIn E{ws};
                pg8::gemm_phase<pg8::EpiRetIn, false, true, false>(tid, lds, ul, (LAS int*)(lds + MISC_OFF + MO_GTAB), (const char*)(ws + WS_XB), (const char*)((bf16*)(ws + WS_W_RIN) + (size_t)j * RT_IN * DM), nullptr, DM * 2, E);
                GRID_BAR();
            } }
#endif
#if SITE(5)
            { KArgs ap = kargs(); const int tid = otid(wave0); LAS unsigned char* lds = olds(lds0); (void)tid;
            if (IN(pb + 1)) for (int rep_ = 0; rep_ < REP(5); ++rep_) {
#if !SLOW_RET
                { unsigned char* ws = ap->ws; ret_fast(tid, lds, (const bf16*)(ws + WS_H), (bf16*)(ws + WS_O)); }
#else
                unsigned char* ws = ap->ws; const bf16* HB = (const bf16*)(ws + WS_H); bf16* OB = (bf16*)(ws + WS_O);
                LAS float* qf = (LAS float*)lds; LAS float* kf = qf + 16 * 4 * 68; LAS float* vf = kf + 16 * 4 * 68;
                for (int un = blockIdx.x; un < NBATCH * RT_HEADS * 4; un += gridDim.x) {
                    const int b = un >> 4, h = (un >> 2) & 3, vq = un & 3; const int vc = tid >> 2, kq = tid & 3;
                    const float gam = 1.0f - exp2f(-5.0f - (float)h);
                    float st[64];
#pragma unroll
                    for (int i = 0; i < 64; ++i) st[i] = 0.f;
                    for (int t0 = 0; t0 < SEQ; t0 += 16) {
                        __syncthreads();
                        for (int e = tid; e < 16 * 256; e += 512) { const int tt = e >> 8, k = e & 255; const size_t gi = (size_t)(b * SEQ + t0 + tt) * RT_IN + h * 256 + k; const int li = tt * 272 + (k & 3) * 68 + (k >> 2);
                            qf[li] = bf1(HB[gi]); kf[li] = bf1(HB[gi + 1024]); }
                        for (int e = tid; e < 16 * 128; e += 512) { const int tt = e >> 7, c = e & 127; vf[e] = bf1(HB[(size_t)(b * SEQ + t0 + tt) * RT_IN + 2048 + h * 512 + vq * 128 + c]); }
                        __syncthreads();
                        for (int tt = 0; tt < 16; ++tt) {
                            const float v = vf[tt * 128 + vc]; float a = 0.f; const int lb = tt * 272 + kq * 68;
#pragma unroll
                            for (int i = 0; i < 64; ++i) { st[i] = gam * st[i] + kf[lb + i] * v; a += qf[lb + i] * st[i]; }
                            a += __shfl_xor(a, 1); a += __shfl_xor(a, 2);
                            if (kq == 0) OB[(size_t)(b * SEQ + t0 + tt) * RT_VD + h * 512 + vq * 128 + vc] = (bf16)f2bf(a);
                        }
                    }
                }
#endif
                GRID_BAR();
            } }
#endif
#if SITE(6)
            { KArgs ap = kargs(); const int tid = otid(wave0); LAS unsigned char* lds = olds(lds0); (void)tid;
            if (IN(pb + 2)) for (int rep_ = 0; rep_ < REP(6); ++rep_) {
                const int lane = tid & 63, wave = __builtin_amdgcn_readfirstlane(tid >> 6), gw = VCU() * 8 + wave, NGW = gridDim.x * 8;
                unsigned char* ws = ap->ws; const bf16* OB = (const bf16*)(ws + WS_O); const bf16* HB = (const bf16*)(ws + WS_H); bf16* A2 = (bf16*)(ws + WS_A2);
                v4u on[4], gn[4];
#pragma unroll
                for (int h = 0; h < 4; ++h) { on[h] = *(const v4u*)(OB + (size_t)gw * RT_VD + 512 * h + 8 * lane); gn[h] = *(const v4u*)(HB + (size_t)gw * RT_IN + 4096 + 512 * h + 8 * lane); }
#pragma unroll 1
                for (int row = gw; row < NTOK; row += NGW) {
                    v4u oc[4], gc[4];
#pragma unroll
                    for (int h = 0; h < 4; ++h) { oc[h] = on[h]; gc[h] = gn[h]; }
                    if (row + NGW < NTOK) {
#pragma unroll
                        for (int h = 0; h < 4; ++h) { on[h] = *(const v4u*)(OB + (size_t)(row + NGW) * RT_VD + 512 * h + 8 * lane); gn[h] = *(const v4u*)(HB + (size_t)(row + NGW) * RT_IN + 4096 + 512 * h + 8 * lane); } }
#pragma unroll
                    for (int h = 0; h < 4; ++h) {
                        const v4u w = oc[h];
                        float o[8] = {bflo(w.x), bfhi(w.x), bflo(w.y), bfhi(w.y), bflo(w.z), bfhi(w.z), bflo(w.w), bfhi(w.w)};
                        float s = 0.f;
#pragma unroll
                        for (int i = 0; i < 8; ++i) s += o[i];
                        const float mu = wave_sum_u(s) * (1.0f / 512.0f); float q = 0.f;
#pragma unroll
                        for (int i = 0; i < 8; ++i) { o[i] -= mu; q += o[i] * o[i]; }
                        const float rs = 1.0f / sqrtf(wave_sum_u(q) * (1.0f / 512.0f) + LN_EPS);
                        const v4u g = gc[h];
#if ROUT_FP8
                        const float r8 = rs * 8.0f; v2u r; r.x = pk4_fp8(o[0] * r8 * bflo(g.x), o[1] * r8 * bfhi(g.x), o[2] * r8 * bflo(g.y), o[3] * r8 * bfhi(g.y));
                        r.y = pk4_fp8(o[4] * r8 * bflo(g.z), o[5] * r8 * bfhi(g.z), o[6] * r8 * bflo(g.w), o[7] * r8 * bfhi(g.w));
                        *(v2u*)((unsigned char*)A2 + (size_t)row * RT_VD + 512 * h + 8 * lane) = r;
#else
                        v4u r; r.x = pk2(o[0] * rs * bflo(g.x), o[1] * rs * bfhi(g.x)); r.y = pk2(o[2] * rs * bflo(g.y), o[3] * rs * bfhi(g.y));
                        r.z = pk2(o[4] * rs * bflo(g.z), o[5] * rs * bfhi(g.z)); r.w = pk2(o[6] * rs * bflo(g.w), o[7] * rs * bfhi(g.w));
                        *(v4u*)(A2 + (size_t)row * RT_VD + 512 * h + 8 * lane) = r;
#endif
                    }
                }
                GRID_BAR();
            } }
#endif
        }
#if SITE(7)
        { KArgs ap = kargs(); const int tid = otid(wave0); LAS unsigned char* lds = olds(lds0); (void)tid;
        if (IN(pb + 3)) for (int rep_ = 0; rep_ < REP(7); ++rep_) {
            unsigned char* ws = ap->ws; const int j = L >> 1; const bool ret = (L & 1) != 0;
            const int Ko = ret ? RT_VD : DM;
            LAS int* ul = (LAS int*)(lds + MISC_OFF + MO_ULIST);
            if (ret && ROUT_FP8) {
                pg8::build_units_dense(tid, ul, NTOK / 256, DM / 256, RT_VD);
                pg8::EpiRes E{ws, -1, 1.0f / (8.0f * 128.0f)};
                pg8::gemm_phase<pg8::EpiRes, false, true, true>(tid, lds, ul, (LAS int*)(lds + MISC_OFF + MO_GTAB), (const char*)(ws + WS_A2), (const char*)(ws + WS_W_ROUT8 + (size_t)j * DM * RT_VD), nullptr, RT_VD, E, lds + MISC_OFF + MO_GALL);
            } else {
                pg8::build_units_dense(tid, ul, NTOK / 256, DM / 256, Ko * 2);
                const char* Bt = ret ? (const char*)((bf16*)(ws + WS_W_ROUT) + (size_t)j * DM * RT_VD) : (const char*)((bf16*)(ws + WS_W_HOUT) + (size_t)j * DM * DM);
                pg8::EpiRes E{ws, (ret || SLOW_HGRN) ? -1 : 0, 1.0f};
                pg8::gemm_phase<pg8::EpiRes, false, true, false>(tid, lds, ul, (LAS int*)(lds + MISC_OFF + MO_GTAB), (const char*)(ws + WS_A2), Bt, nullptr, Ko * 2, E, lds + MISC_OFF + MO_GALL);
            }
            GRID_BAR();
        } }
#endif
#if SITE(8)
        { KArgs ap = kargs(); const int tid = otid(wave0); LAS unsigned char* lds = olds(lds0); (void)tid;
        if (IN(pb + 4)) for (int rep_ = 0; rep_ < REP(8); ++rep_) {
            const int lane = tid & 63, wave = __builtin_amdgcn_readfirstlane(tid >> 6), r = lane & 15, g = lane >> 4;
            unsigned char* ws = ap->ws; unsigned* ctl = (unsigned*)(ws + WS_CTL);
            const bf16* Y = (const bf16*)(ws + WS_Y); bf16* X1R = (bf16*)(ws + WS_X1F); bf16* X1B = (bf16*)(ws + WS_X1B);
            int* ROWDST = (int*)(ws + WS_ROWDST); float* ROWGATE = (float*)(ws + WS_ROWGATE);
            constexpr int WP = 2064;
            LAS unsigned char* wH = lds; LAS unsigned char* wL = lds + 32 * WP;
            LAS int* lcnt = (LAS int*)(lds + MISC_OFF + MO_LCNT); LAS int* lbase = (LAS int*)(lds + MISC_OFF + MO_LBASE);
            LAS int* sel = (LAS int*)(lds + MISC_OFF + MO_SEL); LAS float* selw = (LAS float*)(lds + MISC_OFF + MO_SELW);
            const float* rb = ap->in[I_RB] + L * NE;
            const float* lg = ap->in[I_LNMG] + L * DM; const float* lbb = ap->in[I_LNMB] + L * DM;
            { const v4u* gh = (const v4u*)(ws + WS_WRH) + (size_t)L * 4096; const v4u* gl = (const v4u*)(ws + WS_WRL) + (size_t)L * 4096;
              for (int c = tid; c < 4096; c += 512) { const int e = c >> 7, cc = c & 127; *(LAS v4u*)(wH + e * WP + cc * 16) = gh[c]; *(LAS v4u*)(wL + e * WP + cc * 16) = gl[c]; } }
            const float rb0 = rb[r], rb1 = rb[16 + r];
            f32x4 g4r[4], b4r[4];
#pragma unroll
            for (int q = 0; q < 4; ++q) { g4r[q] = *(const f32x4*)(lg + 256 * q + 4 * lane); b4r[q] = *(const f32x4*)(lbb + 256 * q + 4 * lane); }
            for (int blk = VCU(); blk < NTOK / 128; blk += gridDim.x) {
                if (tid < 32) lcnt[tid] = 0;
                __syncthreads();
                const int row0 = blk * 128 + wave * 16;
                v2u xn[4];
#pragma unroll
                for (int q = 0; q < 4; ++q) xn[q] = *(const v2u*)(Y + (size_t)row0 * DM + 256 * q + 4 * lane);
#pragma unroll 1
                for (int rr = 0; rr < 16; ++rr) {
                    const int row = row0 + rr;
                    f32x4 x[4]; float s = 0.f;
#pragma unroll
                    for (int q = 0; q < 4; ++q) { x[q] = (f32x4){bflo(xn[q].x), bfhi(xn[q].x), bflo(xn[q].y), bfhi(xn[q].y)}; s += (x[q][0] + x[q][1]) + (x[q][2] + x[q][3]); }
                    if (rr + 1 < 16) {
#pragma unroll
                        for (int q = 0; q < 4; ++q) xn[q] = *(const v2u*)(Y + (size_t)(row + 1) * DM + 256 * q + 4 * lane); }
                    const float mu = wave_sum_u(s) * (1.0f / DM); float qq = 0.f;
#pragma unroll
                    for (int q = 0; q < 4; ++q) { x[q] = x[q] - mu; qq += (x[q][0] * x[q][0] + x[q][1] * x[q][1]) + (x[q][2] * x[q][2] + x[q][3] * x[q][3]); }
                    const float rs = 1.0f / sqrtf(wave_sum_u(qq) * (1.0f / DM) + LN_EPS);
#pragma unroll
                    for (int q = 0; q < 4; ++q) { x[q] = x[q] * rs * g4r[q] + b4r[q];
                        { v2u wr_; wr_.x = pk2(x[q][0], x[q][1]); wr_.y = pk2(x[q][2], x[q][3]); *(v2u*)(X1R + (size_t)row * DM + 256 * q + 4 * lane) = wr_; }
#if MOE_FP8
                        *(unsigned*)((unsigned char*)X1B + (size_t)row * DM + 256 * q + 4 * lane) = pk4_fp8(x[q][0] * X_SCALE, x[q][1] * X_SCALE, x[q][2] * X_SCALE, x[q][3] * X_SCALE); }
#else
                        v2u w; w.x = pk2(x[q][0], x[q][1]); w.y = pk2(x[q][2], x[q][3]); *(v2u*)(X1B + (size_t)row * DM + 256 * q + 4 * lane) = w; }
#endif
                }
                asm volatile("s_waitcnt vmcnt(0)" ::: "memory");
                f32x4 lgt0 = {0.f, 0.f, 0.f, 0.f}, lgt1 = {0.f, 0.f, 0.f, 0.f};
                {
                    const bf16* xa = X1R + (size_t)(row0 + r) * DM + 8 * g;
#pragma unroll 1
                    for (int kq = 0; kq < 4; ++kq) {
                        bf16x8 af[8], h0[8], h1[8], l0[8], l1[8];
#pragma unroll
                        for (int j = 0; j < 8; ++j) { const int kb = kq * 8 + j; af[j] = *(const bf16x8*)(xa + 32 * kb);
                            h0[j] = *(const LAS bf16x8*)(wH + r * WP + (32 * kb + 8 * g) * 2); h1[j] = *(const LAS bf16x8*)(wH + (16 + r) * WP + (32 * kb + 8 * g) * 2);
                            l0[j] = *(const LAS bf16x8*)(wL + r * WP + (32 * kb + 8 * g) * 2); l1[j] = *(const LAS bf16x8*)(wL + (16 + r) * WP + (32 * kb + 8 * g) * 2); }
#pragma unroll
                        for (int j = 0; j < 8; ++j) { lgt0 = MFMA32(af[j], h0[j], lgt0); lgt1 = MFMA32(af[j], h1[j], lgt1); lgt0 = MFMA32(af[j], l0[j], lgt0); lgt1 = MFMA32(af[j], l1[j], lgt1); }
                    }
                }
                asm volatile("s_nop 7\n\ts_nop 7" : "+v"(lgt0), "+v"(lgt1));
#pragma unroll
                for (int i = 0; i < 4; ++i) {
                    float v0 = lgt0[i] + rb0, v1 = lgt1[i] + rb1; int se[4]; float sv[4];
#pragma unroll
                    for (int k = 0; k < 4; ++k) {
                        float m = fmaxf(v0, v1);
                        m = fmaxf(m, dppf<0xB1>(m)); m = fmaxf(m, dppf<0x4E>(m)); m = fmaxf(m, dppf<0x141>(m)); m = fmaxf(m, dppf<0x140>(m));
                        int ec = (v0 == m) ? r : ((v1 == m) ? 16 + r : 99);
                        ec = min(ec, dppi<0xB1>(ec)); ec = min(ec, dppi<0x4E>(ec)); ec = min(ec, dppi<0x141>(ec)); ec = min(ec, dppi<0x140>(ec));
                        se[k] = ec; sv[k] = m;
                        if (ec == r) v0 = -3.0e38f;
                        if (ec == 16 + r) v1 = -3.0e38f;
                    }
                    const float e1 = __expf(sv[1] - sv[0]), e2 = __expf(sv[2] - sv[0]), e3 = __expf(sv[3] - sv[0]); const float inv = 1.0f / (1.0f + e1 + e2 + e3);
                    if (r < 4) { const int rloc = wave * 16 + 4 * g + i; const int ee = r == 0 ? se[0] : (r == 1 ? se[1] : (r == 2 ? se[2] : se[3])); const float ww = (r == 0 ? 1.0f : (r == 1 ? e1 : (r == 2 ? e2 : e3))) * inv;
                        sel[rloc * 4 + r] = ee; selw[rloc * 4 + r] = ww; }
                }
                __syncthreads();
                const int myE = sel[tid]; const int rank = __hip_atomic_fetch_add(lcnt + myE, 1, __ATOMIC_RELAXED, __HIP_MEMORY_SCOPE_WORKGROUP);
                __syncthreads();
                if (tid < 32) lbase[tid] = (int)__hip_atomic_fetch_add(ctl + CW_ECNT + (L + 4 * rep_) * 32 + tid, (unsigned)lcnt[tid], RLX_AGENT);
                __syncthreads();
                { const int pos = lbase[myE] + rank; const size_t ti = (size_t)myE * ECAP + pos; ROWDST[ti] = (blk * 128 + (tid >> 2)) * 4 + (tid & 3); ROWGATE[ti] = selw[tid]; }
                __syncthreads();
            }
            GRID_BAR();
        } }
#endif
#if SITE(9)
        { KArgs ap = kargs(); const int tid = otid(wave0); LAS unsigned char* lds = olds(lds0); (void)tid;
        if (IN(pb + 5)) for (int rep_ = 0; rep_ < REP(9); ++rep_) {
            unsigned char* ws = ap->ws; unsigned* ctl = (unsigned*)(ws + WS_CTL);
            LAS int* tpre = (LAS int*)(lds + MISC_OFF + MO_TPRE); LAS int* ebase = (LAS int*)(lds + MISC_OFF + MO_EBASE); LAS int* ecnt = (LAS int*)(lds + MISC_OFF + MO_ECNT);
            if (tid < NE) ecnt[tid] = (int)__hip_atomic_load(ctl + CW_ECNT + L * 32 + tid, RLX_AGENT);
            __syncthreads();
            if (tid < 64) {
                const int tl = (tid < NE) ? ((ecnt[tid < NE ? tid : 0] + 255) >> 8) : 0; int sfx = tl;
#pragma unroll
                for (int k = 1; k < 32; k <<= 1) { const int up = __shfl_up(sfx, k, 64); if ((tid & 63) >= k) sfx += up; }
                if (tid < NE) { tpre[tid] = sfx - tl; ebase[tid] = (sfx - tl) * 256; }
                if (tid == NE - 1) tpre[NE] = sfx; }
            __syncthreads();
            LAS int* ul = (LAS int*)(lds + MISC_OFF + MO_ULIST);
            constexpr int EB = MOE_FP8 ? 1 : 2;
            pg8::build_units_moe(tid, ul, tpre, ebase, ecnt, 8, DM * EB, 2048u * DM * EB);
            { LAS int* gall = (LAS int*)(lds + MISC_OFF + MO_GALL); const int* rd = (const int*)(ws + WS_ROWDST);
              for (int i = tid; i < GALL_UNITS * 256; i += 512) { const int uu = i >> 8, rr = i & 255;
                  if (ul[uu * 8 + 0]) gall[i] = (int)((unsigned)rd[ul[uu * 8 + 7] + min(rr, ul[uu * 8 + 5] - 1)] >> 2); }
              __syncthreads(); }
            pg8::EpiMoeGU E{ws, L};
            pg8::gemm_phase<pg8::EpiMoeGU, true, true, MOE_FP8 != 0>(tid, lds, ul, (LAS int*)(lds + MISC_OFF + MO_GALL), (const char*)(ws + WS_X1B), (const char*)(ws + WS_W_GU + (size_t)L * NE * 2048 * DM * EB), (const int*)(ws + WS_ROWDST), DM * EB, E, lds + MISC_OFF + MO_GTAB);
            GRID_BAR();
        } }
#endif
#if SITE(10)
        { KArgs ap = kargs(); const int tid = otid(wave0); LAS unsigned char* lds = olds(lds0); (void)tid;
        if (IN(pb + 6)) for (int rep_ = 0; rep_ < REP(10); ++rep_) {
            unsigned char* ws = ap->ws; unsigned* ctl = (unsigned*)(ws + WS_CTL);
            LAS int* tpre = (LAS int*)(lds + MISC_OFF + MO_TPRE); LAS int* ebase = (LAS int*)(lds + MISC_OFF + MO_EBASE); LAS int* ecnt = (LAS int*)(lds + MISC_OFF + MO_ECNT);
            __syncthreads();
            if (tid < NE) ecnt[tid] = (int)__hip_atomic_load(ctl + CW_ECNT + L * 32 + tid, RLX_AGENT);
            __syncthreads();
            if (tid < 64) {
                const int tl = (tid < NE) ? ((ecnt[tid < NE ? tid : 0] + 255) >> 8) : 0; int sfx = tl;
#pragma unroll
                for (int k = 1; k < 32; k <<= 1) { const int up = __shfl_up(sfx, k, 64); if ((tid & 63) >= k) sfx += up; }
                if (tid < NE) { tpre[tid] = sfx - tl; ebase[tid] = (sfx - tl) * 256; }
                if (tid == NE - 1) tpre[NE] = sfx; }
            __syncthreads();
            LAS int* ul = (LAS int*)(lds + MISC_OFF + MO_ULIST);
            constexpr int EB = MOE_FP8 ? 1 : 2;
            pg8::build_units_moe(tid, ul, tpre, ebase, ecnt, 4, DM * EB, (unsigned)DM * DM * EB);
            pg8::EpiMoeDown E{ws, ap->in[I_BDN] + (size_t)L * NE * DM};
            pg8::gemm_phase<pg8::EpiMoeDown, false, true, MOE_FP8 != 0>(tid, lds, ul, (LAS int*)(lds + MISC_OFF + MO_GTAB), (const char*)(ws + WS_ACT), (const char*)(ws + WS_W_DN + (size_t)L * NE * DM * DM * EB), nullptr, DM * EB, E, lds + MISC_OFF + MO_GALL);
            GRID_BAR();
        } }
#endif
#if SITE(11)
        { KArgs ap = kargs(); const int tid = otid(wave0); LAS unsigned char* lds = olds(lds0); (void)tid;
        if (IN(pb + 7)) for (int rep_ = 0; rep_ < REP(11); ++rep_) {
            const int lane = tid & 63, wave = __builtin_amdgcn_readfirstlane(tid >> 6), gw = VCU() * 8 + wave, NGW = gridDim.x * 8;
            unsigned char* ws = ap->ws; const bf16* X1R = (const bf16*)(ws + WS_X1F); const bf16* YS = (const bf16*)(ws + WS_YSLOT); bf16* XB = (bf16*)(ws + WS_XB); float* out = ap->out;
            const float* lg = ap->in[I_LNFG] + L * DM; const float* lbb = ap->in[I_LNFB] + L * DM;
#if YS_FP8
            typedef unsigned ys_t; constexpr int YSB = 1;
#else
            typedef v2u ys_t; constexpr int YSB = 2;
#endif
            v2u xn[4]; f32x4 g4[4], b4[4]; ys_t yn[4][4];
#pragma unroll
            for (int q = 0; q < 4; ++q) { g4[q] = *(const f32x4*)(lg + 256 * q + 4 * lane); b4[q] = *(const f32x4*)(lbb + 256 * q + 4 * lane); xn[q] = *(const v2u*)(X1R + (size_t)gw * DM + 256 * q + 4 * lane);
#pragma unroll
                for (int k = 0; k < 4; ++k) yn[q][k] = *(const ys_t*)((const unsigned char*)YS + (((size_t)gw * 4 + k) * DM + 256 * q + 4 * lane) * YSB); }
#pragma unroll 1
            for (int row = gw; row < NTOK; row += NGW) {
                f32x4 x[4]; ys_t yc[4][4]; float s = 0.f;
#pragma unroll
                for (int q = 0; q < 4; ++q) { x[q] = (f32x4){bflo(xn[q].x), bfhi(xn[q].x), bflo(xn[q].y), bfhi(xn[q].y)} * DN_ALPHA;
#pragma unroll
                    for (int k = 0; k < 4; ++k) yc[q][k] = yn[q][k]; }
                if (row + NGW < NTOK) {
#pragma unroll
                    for (int q = 0; q < 4; ++q) { xn[q] = *(const v2u*)(X1R + (size_t)(row + NGW) * DM + 256 * q + 4 * lane);
#pragma unroll
                        for (int k = 0; k < 4; ++k) yn[q][k] = *(const ys_t*)((const unsigned char*)YS + (((size_t)(row + NGW) * 4 + k) * DM + 256 * q + 4 * lane) * YSB); } }
#pragma unroll
                for (int q = 0; q < 4; ++q) {
#pragma unroll
#if YS_FP8
                    for (int k = 0; k < 4; ++k) { const f32x2 lo = __builtin_amdgcn_cvt_pk_f32_fp8((int)yc[q][k], false), hi = __builtin_amdgcn_cvt_pk_f32_fp8((int)yc[q][k], true);
                        x[q][0] += lo[0] * 0.015625f; x[q][1] += lo[1] * 0.015625f; x[q][2] += hi[0] * 0.015625f; x[q][3] += hi[1] * 0.015625f; }
#else
                    for (int k = 0; k < 4; ++k) { const v2u w = yc[q][k]; x[q][0] += bflo(w.x); x[q][1] += bfhi(w.x); x[q][2] += bflo(w.y); x[q][3] += bfhi(w.y); }
#endif
                    s += (x[q][0] + x[q][1]) + (x[q][2] + x[q][3]); }
                const float mu = wave_sum_u(s) * (1.0f / DM); float qq = 0.f;
#pragma unroll
                for (int q = 0; q < 4; ++q) { x[q] = x[q] - mu; qq += (x[q][0] * x[q][0] + x[q][1] * x[q][1]) + (x[q][2] * x[q][2] + x[q][3] * x[q][3]); }
                const float rs = 1.0f / sqrtf(wave_sum_u(qq) * (1.0f / DM) + LN_EPS);
#pragma unroll
                for (int q = 0; q < 4; ++q) { x[q] = x[q] * rs * g4[q] + b4[q];
                    if (L + 1 == DEPTH) *(f32x4*)(out + (size_t)row * DM + 256 * q + 4 * lane) = x[q];
                    else { v2u w; w.x = pk2(x[q][0], x[q][1]); w.y = pk2(x[q][2], x[q][3]); *(v2u*)(XB + (size_t)row * DM + 256 * q + 4 * lane) = w; } }
            }
            if (L + 1 < DEPTH) GRID_BAR();
        } }
#endif
    }
#undef IN
#undef GRID_BAR
}

extern "C" void kernel_launch(void* const* d_in, const int* in_sizes, int n_in, void* d_out, int out_size, void* d_ws, size_t ws_size, hipStream_t stream) {
    static int grid = 0;
    if (grid == 0) {
        if (n_in != 17 || out_size != NTOK * DM || ws_size < WS_END) { fprintf(stderr, "kernel_launch: unexpected shapes (n_in %d, out %d, ws %zu < %zu)\n", n_in, out_size, ws_size, (size_t)WS_END); grid = -1; return; }
        int dev = 0, cus = 0, per_cu = 0;
        if (hipGetDevice(&dev) != hipSuccess || hipDeviceGetAttribute(&cus, hipDeviceAttributeMultiprocessorCount, dev) != hipSuccess) { grid = -1; return; }
        if (hipFuncSetAttribute((const void*)mk_fwd, hipFuncAttributeMaxDynamicSharedMemorySize, LDS_BYTES) != hipSuccess) { fprintf(stderr, "kernel_launch: hipFuncSetAttribute failed\n"); grid = -1; return; }
        if (hipOccupancyMaxActiveBlocksPerMultiprocessor(&per_cu, (const void*)mk_fwd, 512, LDS_BYTES) != hipSuccess || per_cu < 1) { fprintf(stderr, "kernel_launch: occupancy query says %d\n", per_cu); }
        (void)hipGetLastError();
        grid = cus;
    }
    if (grid < 0) return;
    (void)hipMemsetAsync((char*)d_ws + WS_CTL, 0, CTL_ZERO_BYTES, stream);
    Args a{};
    for (int i = 0; i < 17; ++i) a.in[i] = (const float*)d_in[i];
    a.out = (float*)d_out; a.ws = (unsigned char*)d_ws;
#if MK_MULTI
    for (int p = 0; p < 1 + 8 * DEPTH; ++p) { a.ph_lo = p; a.ph_hi = p + 1; hipLaunchKernelGGL(mk_fwd, dim3(grid), dim3(512), LDS_BYTES, stream, a); }
#else
    a.ph_lo = 0; a.ph_hi = 1 + 8 * DEPTH;
    hipLaunchKernelGGL(mk_fwd, dim3(grid), dim3(512), LDS_BYTES, stream, a);
#endif
}
```

```cpp
#include <hip/hip_runtime.h>
#include <cstdio>
#include <cstdint>

#ifndef MK_MULTI
#define MK_MULTI 0
#endif
#ifndef PROBE_EPI2
#define PROBE_EPI2 0
#endif
#ifndef MOE_FP8
#define MOE_FP8 1
#endif
#ifndef ROUT_FP8
#define ROUT_FP8 1
#endif
#ifndef YS_FP8
#define YS_FP8 1
#endif
#ifndef SLOW_HGRN
#define SLOW_HGRN 0
#endif
#ifndef SLOW_RET
#define SLOW_RET 0
#endif

#define GAS __attribute__((address_space(1)))
#define LAS __attribute__((address_space(3)))
typedef unsigned short bf16;
typedef unsigned v4u __attribute__((ext_vector_type(4)));
typedef unsigned v2u __attribute__((ext_vector_type(2)));
typedef float f32x4 __attribute__((ext_vector_type(4)));
typedef float f32x2 __attribute__((ext_vector_type(2)));
typedef short bf16x8 __attribute__((ext_vector_type(8)));
typedef GAS unsigned gu32;

constexpr int DM = 1024, NBATCH = 16, SEQ = 2048, NTOK = NBATCH * SEQ, DEPTH = 4;
constexpr int NE = 32, TOPK = 4;
constexpr int HG_HEADS = 8, HG_K = 128;
constexpr int RT_HEADS = 4, RT_K = 256, RT_V = 512, RT_VD = 2048, RT_IN = 6144, HG_IN = 4096;
constexpr int ECAP = NTOK;
constexpr int MOE_ROWS = NTOK * TOPK + NE * 256;
constexpr float DN_ALPHA = 1.681792830507429f;
constexpr float LN_EPS = 1e-5f, RMS_EPS = 1e-6f;

constexpr size_t MiB = 1ull << 20;
constexpr size_t WS_CTL = 0, CTL_ZERO_BYTES = 1 * MiB;
constexpr size_t WS_LBS = 1 * MiB;
constexpr size_t WS_WRH = 1 * MiB + 128 * 1024, WS_WRL = 1 * MiB + 512 * 1024;
constexpr size_t WS_BGU = 2 * MiB;
constexpr size_t WS_ROT = 4 * MiB;
constexpr size_t WS_ROWDST = 8 * MiB;
constexpr size_t WS_ROWGATE = 12 * MiB;
constexpr size_t WS_W_HIN = 16 * MiB;
constexpr size_t WS_W_HOUT = WS_W_HIN + 16 * MiB;
constexpr size_t WS_W_RIN = WS_W_HOUT + 4 * MiB;
constexpr size_t WS_W_ROUT = WS_W_RIN + 24 * MiB;
constexpr size_t WS_W_GU = WS_W_ROUT + 8 * MiB;
constexpr size_t WS_W_DN = WS_W_GU + 512 * MiB;
constexpr size_t WS_XB = WS_W_DN + 256 * MiB;
constexpr size_t WS_H = WS_XB + 64 * MiB;
constexpr size_t WS_DEC = WS_H + 320 * MiB;
constexpr size_t WS_SSP = WS_DEC + 16 * MiB;
constexpr size_t WS_O = WS_H + 384 * MiB;
constexpr size_t WS_A2 = WS_O + 128 * MiB;
constexpr size_t WS_Y = WS_A2 + 128 * MiB;
constexpr size_t WS_X1F = WS_Y + 128 * MiB;
constexpr size_t WS_X1B = WS_X1F + 128 * MiB;
constexpr size_t WS_ACT = WS_X1B + 64 * MiB;
constexpr size_t WS_YSLOT = WS_ACT + 272 * MiB;
constexpr size_t WS_W_ROUT8 = WS_YSLOT + 256 * MiB;
constexpr size_t WS_END = WS_W_ROUT8 + 4 * MiB;

constexpr int CW_BAR = 4096;
constexpr int CW_SS = 65536;
constexpr int CW_ECNT = 16384;

constexpr int RING_BYTES = 131072;
constexpr int MISC_OFF = 135168;
constexpr int LDS_BYTES = 163840;
constexpr int MO_BARW = 0;
constexpr int MO_GTAB = 64;
constexpr int MO_TPRE = 64 + 2048;
constexpr int MO_EBASE = MO_TPRE + 160;
constexpr int MO_ECNT = MO_EBASE + 128;
constexpr int MO_LCNT = MO_ECNT + 128;
constexpr int MO_LBASE = MO_LCNT + 128;
constexpr int MO_SEL = MO_LBASE + 128;
constexpr int MO_SELW = MO_SEL + 2048;
constexpr int MO_RANK = MO_SELW + 2048;
constexpr int MO_ULIST = MO_RANK + 2048;
constexpr int MO_GALL = 10240;
constexpr int GALL_UNITS = 18;
static_assert(MO_ULIST + 1024 <= MO_GALL && MISC_OFF + MO_GALL + GALL_UNITS * 1024 <= LDS_BYTES, "LDS map");

constexpr float RG_SCALE = 16.0f;
constexpr float RO_SCALE = 16.0f;
#define RLX_AGENT __ATOMIC_RELAXED, __HIP_MEMORY_SCOPE_AGENT
#define LDS_WAIT() asm volatile("s_waitcnt lgkmcnt(0)" ::: "memory")
#define VM_WAIT() asm volatile("s_waitcnt vmcnt(0)" ::: "memory")

__device__ __forceinline__ unsigned f2bf(float f) { unsigned u = __builtin_bit_cast(unsigned, f); return (u + 0x7fffu + ((u >> 16) & 1u)) >> 16; }
__device__ __forceinline__ unsigned pk2(float lo, float hi) { return f2bf(lo) | (f2bf(hi) << 16); }
__device__ __forceinline__ unsigned cvt_pk_bf16(float lo, float hi) { unsigned r; asm volatile("v_cvt_pk_bf16_f32 %0, %1, %2" : "=v"(r) : "v"(lo), "v"(hi)); return r; }
#if MOE_FP8
constexpr float X_SCALE = 4.0f, WGU_SCALE = 64.0f, ACT_SCALE = 4.0f, WDN_SCALE = 128.0f;
constexpr float GU_DESCALE = 1.0f / (X_SCALE * WGU_SCALE), DN_DESCALE = 1.0f / (ACT_SCALE * WDN_SCALE);
#else
constexpr float GU_DESCALE = 1.0f, DN_DESCALE = 1.0f, ACT_SCALE = 1.0f;
#endif
__device__ __forceinline__ unsigned pk4_fp8(float a, float b, float c, float d) {
    a = __builtin_amdgcn_fmed3f(a, -448.0f, 448.0f); b = __builtin_amdgcn_fmed3f(b, -448.0f, 448.0f); c = __builtin_amdgcn_fmed3f(c, -448.0f, 448.0f); d = __builtin_amdgcn_fmed3f(d, -448.0f, 448.0f);
    int p = __builtin_amdgcn_cvt_pk_fp8_f32(a, b, 0, false); p = __builtin_amdgcn_cvt_pk_fp8_f32(c, d, p, true); return (unsigned)p; }
__device__ __forceinline__ float bflo(unsigned u) { return __builtin_bit_cast(float, u << 16); }
__device__ __forceinline__ float bfhi(unsigned u) { return __builtin_bit_cast(float, u & 0xffff0000u); }
__device__ __forceinline__ float bf1(bf16 b) { return __builtin_bit_cast(float, ((unsigned)b) << 16); }
__device__ __forceinline__ float fexp(float x) { return __builtin_amdgcn_exp2f(x * 1.4426950408889634f); }
__device__ __forceinline__ float frcp(float x) { return __builtin_amdgcn_rcpf(x); }
__device__ __forceinline__ float fsigmoid(float x) { return frcp(1.0f + fexp(-x)); }
__device__ __forceinline__ float wave_sum(float v) {
#pragma unroll
    for (int o = 1; o < 64; o <<= 1) v += __shfl_xor(v, o);
    return v;
}
__device__ __forceinline__ float wave_max(float v) {
#pragma unroll
    for (int o = 1; o < 64; o <<= 1) v = fmaxf(v, __shfl_xor(v, o));
    return v;
}

template <int CTRL> __device__ __forceinline__ float dppf(float v) { return __builtin_bit_cast(float, __builtin_amdgcn_update_dpp(0, __builtin_bit_cast(int, v), CTRL, 0xf, 0xf, true)); }
template <int CTRL> __device__ __forceinline__ int dppi(int v) { return __builtin_amdgcn_update_dpp(0, v, CTRL, 0xf, 0xf, true); }
__device__ __forceinline__ float rlane(float v, int l) { return __builtin_bit_cast(float, __builtin_amdgcn_readlane(__builtin_bit_cast(int, v), l)); }
__device__ __forceinline__ float wave_sum_u(float v) {
    v += dppf<0xB1>(v); v += dppf<0x4E>(v); v += dppf<0x141>(v); v += dppf<0x140>(v);
    return (rlane(v, 0) + rlane(v, 16)) + (rlane(v, 32) + rlane(v, 48));
}
#define XB_TMO      128
#define XB_XCNT(j)  (256  + 64 * (j))
#define XB_XSUB(j)  (1280 + 64 * (j))
#define XB_XGEN(j)  (2304 + 64 * (j))
#define XB_TOP      3328
#define XB_TOPGEN   3392
#define XCD_BAR_WORDS 3456
#define XB_SPIN_CAP (1u << 22)

__device__ __forceinline__ unsigned xb_ld(unsigned* p)              { return __hip_atomic_load(p, __ATOMIC_RELAXED, __HIP_MEMORY_SCOPE_AGENT); }
__device__ __forceinline__ unsigned xb_add(unsigned* p, unsigned v) { return __hip_atomic_fetch_add(p, v, __ATOMIC_RELAXED, __HIP_MEMORY_SCOPE_AGENT); }
__device__ __forceinline__ unsigned xb_xcc_id() { return (unsigned)__builtin_amdgcn_s_getreg((3 << 11) | 20) & 0xFu; }
#define XB_SPIN(cond, bar) do { unsigned _sp = 0; while (cond) { __builtin_amdgcn_s_sleep(1); \
    if ((++_sp & 255u) == 0u) { if (xb_ld(&(bar)[XB_TMO])) break; if (_sp > XB_SPIN_CAP) { atomicAdd(&(bar)[XB_TMO], 1u); break; } } } } while (0)

struct XcdBarrier { unsigned* bar; unsigned x; volatile LAS unsigned* st; };

__device__ __forceinline__ XcdBarrier xcd_barrier_post(unsigned* bar, volatile LAS unsigned* st) {
    XcdBarrier b; b.bar = bar; b.x = xb_xcc_id(); b.st = st;
    if (threadIdx.x == 0) (void)xb_add(&bar[XB_XCNT(b.x)], 1u);
    return b;
}
__device__ __forceinline__ void xcd_barrier_complete(unsigned* bar, unsigned x, unsigned& nloc, unsigned& nx) {
    const unsigned G = gridDim.x * gridDim.y * gridDim.z;
    unsigned sum, cnt, mine, sp = 0u;
    for (;;) {
        sum = 0u; cnt = 0u; mine = 0u;
#pragma unroll
        for (unsigned j = 0; j < 16; ++j) { const unsigned c = xb_ld(&bar[XB_XCNT(j)]); sum += c; cnt += (c > 0u) ? 1u : 0u; mine = (j == x) ? c : mine; }
        if (sum == G) break;
        __builtin_amdgcn_s_sleep(1);
        if ((++sp & 255u) == 0u) { if (xb_ld(&bar[XB_TMO])) break; if (sp > XB_SPIN_CAP) { atomicAdd(&bar[XB_TMO], 1u); break; } }
    }
    nloc = mine > 0u ? mine : 1u; nx = cnt > 0u ? cnt : 1u;
}
__device__ __forceinline__ void xcd_barrier(const XcdBarrier& b) {
    asm volatile("s_waitcnt vmcnt(0)" ::: "memory");
    __syncthreads();
    if (threadIdx.x == 0) {
        unsigned* bar = b.bar;
        __builtin_amdgcn_s_waitcnt(0);
        unsigned nloc = b.st[0], nx = b.st[1];
        if (nloc == 0u) { xcd_barrier_complete(bar, b.x, nloc, nx); b.st[0] = nloc; b.st[1] = nx; }
        const unsigned old = xb_add(&bar[XB_XSUB(b.x)], 1u);
        const unsigned gen = old / nloc;
        if (old + 1u == (gen + 1u) * nloc) {
            __builtin_amdgcn_fence(__ATOMIC_RELEASE, "agent");
            asm volatile("s_waitcnt vmcnt(0)" ::: "memory");
            const unsigned og = xb_add(&bar[XB_TOP], 1u);
            const unsigned tg = og / nx;
            if (og + 1u == (tg + 1u) * nx) xb_add(&bar[XB_TOPGEN], 1u);
            else XB_SPIN(xb_ld(&bar[XB_TOPGEN]) == tg, bar);
            __builtin_amdgcn_fence(__ATOMIC_ACQUIRE, "agent");
            xb_add(&bar[XB_XGEN(b.x)], 1u);
            asm volatile("s_waitcnt vmcnt(0)" ::: "memory");
        } else {
            XB_SPIN(xb_ld(&bar[XB_XGEN(b.x)]) == gen, bar);
            __builtin_amdgcn_fence(__ATOMIC_ACQUIRE, "agent");
            asm volatile("s_waitcnt vmcnt(0)" ::: "memory");
        }
    }
    __syncthreads();
}

namespace pg8 {
constexpr int BM = 256, BK = 64, HALF = 128, HTB = HALF * BK * 2, STAGE_BYTES = 8 * HTB, NXCD = 8, WGM = 8, MAXU = 32;
__host__ __device__ __forceinline__ int lds_byte(int r, int c) { const int st = (r >> 4) * 2 + (c >> 5), rr = r & 15, cc = c & 31, ob = rr * 64 + cc * 2; return st * 1024 + (ob ^ (((ob >> 9) & 1) << 5)); }
__host__ __device__ __forceinline__ void stage_rc(int b, int& R, int& C) { const int st = b / 1024, sb = b % 1024, swz = sb ^ (((sb >> 9) & 1) << 5); R = (st >> 1) * 16 + swz / 64; C = (st & 1) * 32 + (swz % 64) / 2; }
__host__ __device__ __forceinline__ int perm32(int rho) { const int n = rho >> 4, i = rho & 15; return 8 * (i >> 2) + 4 * n + (i & 3); }

struct Unit { int pm, pn, e, rowbase, cnt; unsigned boff; int gidx; };

__device__ __forceinline__ bool tile_of(long L, int nM, int nN, int& gm, int& pn) {
    const int nwg = nM * nN; if (L >= nwg) return false;
    int wgid = (int)L; { const int q = nwg / NXCD, r = nwg % NXCD, xcd = wgid % NXCD, off = wgid / NXCD; wgid = (xcd < r ? xcd * (q + 1) : r * (q + 1) + (xcd - r) * q) + off; }
    const int nig = WGM * nN, gid = wgid / nig, fm = gid * WGM, gsz = (nM - fm) < WGM ? (nM - fm) : WGM;
    gm = fm + ((wgid % nig) % gsz); pn = (wgid % nig) / gsz; return true;
}
__device__ __forceinline__ void build_units_dense(const int i, LAS int* ul, int nM, int nN, int RB) {
    if (i < MAXU) { int gm = 0, pn = 0; const bool ok = tile_of((long)i * gridDim.x + blockIdx.x, nM, nN, gm, pn);
        ul[i * 8 + 0] = ok ? 1 : 0; ul[i * 8 + 1] = gm; ul[i * 8 + 2] = pn; ul[i * 8 + 3] = 0; ul[i * 8 + 4] = gm * BM; ul[i * 8 + 5] = BM; ul[i * 8 + 6] = (int)((unsigned)pn * BM * (unsigned)RB); ul[i * 8 + 7] = 0; }
    __syncthreads();
}
__device__ __forceinline__ void build_units_moe(const int i, LAS int* ul, const LAS int* tpre, const LAS int* ebase, const LAS int* ecnt, int nN, int RB, unsigned wstride) {
    if (i < MAXU) { int gm = 0, pn = 0; const bool ok = tile_of((long)i * gridDim.x + blockIdx.x, tpre[NE], nN, gm, pn);
        int e = 0;
_Pragma("unroll 1")
        for (int s = 16; s >= 1; s >>= 1) { if (e + s < NE && tpre[e + s] <= gm) e += s; }
        const int pm = gm - tpre[e];
        ul[i * 8 + 0] = ok ? 1 : 0; ul[i * 8 + 1] = pm; ul[i * 8 + 2] = pn; ul[i * 8 + 3] = e; ul[i * 8 + 4] = ebase[e] + pm * BM; ul[i * 8 + 5] = ecnt[e] - pm * BM;
        ul[i * 8 + 6] = (int)((unsigned)e * wstride + (unsigned)pn * BM * (unsigned)RB); ul[i * 8 + 7] = e * ECAP + pm * BM; }
    __syncthreads();
}
typedef int v4i __attribute__((ext_vector_type(4)));
__device__ __forceinline__ bool ld_unit(const LAS int* ul, int i, Unit& u) {
    if (i >= MAXU) return false;
    const v4i a = *(const LAS v4i*)(ul + i * 8), b = *(const LAS v4i*)(ul + i * 8 + 4);
    if (__builtin_amdgcn_readfirstlane(a.x) == 0) return false;
    u.pm = __builtin_amdgcn_readfirstlane(a.y); u.pn = __builtin_amdgcn_readfirstlane(a.z); u.e = __builtin_amdgcn_readfirstlane(a.w); u.rowbase = __builtin_amdgcn_readfirstlane(b.x);
    u.cnt = __builtin_amdgcn_readfirstlane(b.y); u.boff = (unsigned)__builtin_amdgcn_readfirstlane(b.z); u.gidx = __builtin_amdgcn_readfirstlane(b.w); return true;
}
__device__ __forceinline__ void glds16(const char* sbase, unsigned voff, LAS unsigned char* dst) {
    asm volatile("" : "+s"(sbase));
    __builtin_amdgcn_global_load_lds((const unsigned*)(sbase + voff), (LAS unsigned*)dst, 16, 0, 0);
}
template <bool GATHER> __device__ __forceinline__ void stage_a(LAS unsigned char* dst, const char* sbase, unsigned o0, unsigned o1, size_t r64) {
    glds16(sbase, o0, dst);
    if constexpr (GATHER) glds16(sbase, o1, dst + 8192);
    else glds16(sbase + r64, o0, dst + 8192);
}

typedef int v8i __attribute__((ext_vector_type(8)));
__device__ __forceinline__ v8i cat_frag(const bf16x8& a, const bf16x8& b) { return __builtin_shufflevector(__builtin_bit_cast(v4i, a), __builtin_bit_cast(v4i, b), 0, 1, 2, 3, 4, 5, 6, 7); }
template <class Epi, bool GATHER, bool ALIGN_EPI, bool FP8>
__device__ __forceinline__ void gemm_phase(const int tid, LAS unsigned char* lds, const LAS int* ul, LAS int* gtab, const char* Abase, const char* Bbase, const int* rowdst, const int RB, const Epi& E, LAS unsigned char* epl = nullptr) {
    const int wid = __builtin_amdgcn_readfirstlane(tid >> 6), lane = tid & 63, wr = wid >> 2, wc = wid & 3, fr = lane & 15, fq = lane >> 4;
    const int nt = RB / 128;
    int R0, C0; stage_rc(tid * 16, R0, C0);
    const int Rb0 = Epi::PERM ? ((R0 & ~31) + perm32(R0 & 31)) : R0;
    const unsigned voffB = (unsigned)(Rb0 * RB + C0 * 2);
    const unsigned cb0 = (unsigned)C0 * 2u, K2 = (unsigned)RB;
    const size_t kstep = (size_t)128;
    const size_t r64 = (size_t)64 * RB;
    const size_t hstep = (size_t)HALF * RB;
    const unsigned ldsw = (unsigned)wid * 1024u;
    const int aoff = lds_byte(wr * 64 + fr, fq * 8), boff = lds_byte(wc * 32 + fr, fq * 8);
#define PG8_SA(b, h) (((b) * 2 + (h)) * HTB)
#define PG8_SB(b, h) ((4 + (b) * 2 + (h)) * HTB)
#define PG8_STAGE(bufoff, gbase) do { glds16((const char*)(gbase), voffB, lds + (bufoff) + ldsw); glds16((const char*)(gbase) + r64, voffB, lds + (bufoff) + ldsw + 8192); } while (0)
#define PG8_STAGEA0(bufoff, kb, o0, o1) stage_a<GATHER>(lds + (bufoff) + ldsw, Abase + (kb), o0, o1, r64)
#define PG8_STAGEA1(bufoff, kb, o0, o2, o3) stage_a<GATHER>(lds + (bufoff) + ldsw, Abase + (kb) + (GATHER ? (size_t)0 : hstep), GATHER ? (o2) : (o0), o3, r64)
#define PG8_LDA(dst, b, h) do { _Pragma("unroll") for (int m = 0; m < 4; ++m) { const v4i _l = *(const LAS v4i*)(lds + PG8_SA(b, h) + aoff + m * 2048), _h = *(const LAS v4i*)(lds + PG8_SA(b, h) + aoff + m * 2048 + 1024); dst[m] = __builtin_shufflevector(_l, _h, 0, 1, 2, 3, 4, 5, 6, 7); } } while (0)
#define PG8_LDB(dst, b, h) do { _Pragma("unroll") for (int n = 0; n < 2; ++n) { const v4i _l = *(const LAS v4i*)(lds + PG8_SB(b, h) + boff + n * 2048), _h = *(const LAS v4i*)(lds + PG8_SB(b, h) + boff + n * 2048 + 1024); dst[n] = __builtin_shufflevector(_l, _h, 0, 1, 2, 3, 4, 5, 6, 7); } } while (0)
#define PG8_LO(x) __builtin_bit_cast(bf16x8, __builtin_shufflevector(x, x, 0, 1, 2, 3))
#define PG8_HI(x) __builtin_bit_cast(bf16x8, __builtin_shufflevector(x, x, 4, 5, 6, 7))
#define PG8_MMA(ai, bj, At, Bt) do { __builtin_amdgcn_s_setprio(1); _Pragma("unroll") for (int m = 0; m < 4; ++m) _Pragma("unroll") for (int n = 0; n < 2; ++n) { \
        if constexpr (FP8) asm volatile("v_mfma_scale_f32_16x16x128_f8f6f4 %0, %1, %2, %0, %3, %3 op_sel_hi:[0,0,0]" : "+v"(acc[ai][bj][m][n]) : "v"(Bt[n]), "v"(At[m]), "v"(sc1)); \
        else { acc[ai][bj][m][n] = __builtin_amdgcn_mfma_f32_16x16x32_bf16(PG8_LO(Bt[n]), PG8_LO(At[m]), acc[ai][bj][m][n], 0, 0, 0); \
               acc[ai][bj][m][n] = __builtin_amdgcn_mfma_f32_16x16x32_bf16(PG8_HI(Bt[n]), PG8_HI(At[m]), acc[ai][bj][m][n], 0, 0, 0); } } \
        __builtin_amdgcn_s_setprio(0); } while (0)
#define PG8_WAIT_V(n) asm volatile("s_waitcnt vmcnt(" #n ")" ::: "memory")
#define PG8_WAIT_L(n) asm volatile("s_waitcnt lgkmcnt(" #n ")" ::: "memory")
#define PG8_BAR __builtin_amdgcn_s_barrier()
#define PG8_SCHED __builtin_amdgcn_sched_barrier(0)
    Unit cur, nxt; int ui = 0;
    if (!ld_unit(ul, 0, cur)) return;
    f32x4 acc[2][2][4][2];
#pragma unroll
    for (int a = 0; a < 2; ++a)
#pragma unroll
        for (int b = 0; b < 2; ++b)
#pragma unroll
            for (int m = 0; m < 4; ++m)
#pragma unroll
                for (int n = 0; n < 2; ++n) { double z0, z1; asm volatile("v_mov_b64 %0, 0\n\tv_mov_b64 %1, 0" : "=v"(z0), "=v"(z1)); typedef double d2_t __attribute__((ext_vector_type(2))); acc[a][b][m][n] = __builtin_bit_cast(f32x4, (d2_t){z0, z1}); }
    v8i At[4], B0[2], B1[2];
    const int sc1 = 0x7f7f7f7f;
    unsigned oA0, oA1 = 0, oA2 = 0, oA3 = 0, oN0, oN1 = 0, oN2 = 0, oN3 = 0;
    if constexpr (GATHER) {
        oA0 = (unsigned)gtab[R0] * K2 + cb0; oA1 = (unsigned)gtab[R0 + 64] * K2 + cb0; oA2 = (unsigned)gtab[R0 + 128] * K2 + cb0; oA3 = (unsigned)gtab[R0 + 192] * K2 + cb0;
    } else {
        oA0 = (unsigned)(cur.rowbase + R0) * K2 + cb0;
    }
    oN0 = oA0; oN1 = oA1; oN2 = oA2; oN3 = oA3;
    const char* cB = Bbase + cur.boff;
    PG8_STAGE(PG8_SB(0, 0), cB); PG8_STAGE(PG8_SB(0, 1), cB + hstep); PG8_STAGEA0(PG8_SA(0, 0), (size_t)0, oA0, oA1); PG8_STAGEA1(PG8_SA(0, 1), (size_t)0, oA0, oA2, oA3);
    if (wr == 1) PG8_BAR;
    PG8_WAIT_V(2); PG8_BAR;
    PG8_STAGE(PG8_SB(1, 0), cB + kstep); PG8_STAGEA0(PG8_SA(1, 0), kstep, oA0, oA1); PG8_STAGE(PG8_SB(1, 1), cB + hstep + kstep);
    PG8_WAIT_V(6); PG8_BAR;
    for (;;) {
        const bool has_next = ld_unit(ul, ui + 1, nxt);
        if constexpr (Epi::HAS_PRE) E.pre(cur, epl + (ui & 1) * Epi::PRE_BYTES, wid, lane);
        const char* nB = has_next ? Bbase + nxt.boff : cB;
_Pragma("unroll 1")
        for (int t = 0; t < nt; t += 2) {
            const bool last = (t == nt - 2);
            if (last && has_next) {
                if constexpr (GATHER) {
                    const LAS int* gt = gtab + (ui + 1) * 256;
                    oN0 = (unsigned)gt[R0] * K2 + cb0; oN1 = (unsigned)gt[R0 + 64] * K2 + cb0; oN2 = (unsigned)gt[R0 + 128] * K2 + cb0; oN3 = (unsigned)gt[R0 + 192] * K2 + cb0;
                } else {
                    oN0 = (unsigned)(nxt.rowbase + R0) * K2 + cb0;
                }
            }
            const size_t kb1 = (size_t)(t + 1) * kstep;
            const size_t kb2 = last ? (size_t)0 : (size_t)(t + 2) * kstep, kb3 = kb2 + kstep;
            const unsigned p0 = last ? oN0 : oA0, p1 = last ? oN1 : oA1, p2 = last ? oN2 : oA2, p3 = last ? oN3 : oA3;
            const char* b2 = last ? nB : cB + (size_t)(t + 2) * kstep; const char* b3 = b2 + kstep;
            PG8_LDB(B0, 0, 0); PG8_LDB(B1, 0, 1); PG8_SCHED; PG8_LDA(At, 0, 0); PG8_STAGEA1(PG8_SA(1, 1), kb1, oA0, oA2, oA3);
            PG8_WAIT_V(8); PG8_WAIT_L(0); PG8_BAR; PG8_MMA(0, 0, At, B0); PG8_MMA(0, 1, At, B1); PG8_BAR; PG8_SCHED;
            PG8_LDA(At, 0, 1); PG8_STAGE(PG8_SB(0, 0), b2); PG8_STAGE(PG8_SB(0, 1), b2 + hstep); PG8_STAGEA0(PG8_SA(0, 0), kb2, p0, p1);
            PG8_WAIT_V(8); PG8_WAIT_L(0); PG8_BAR; PG8_MMA(1, 0, At, B0); PG8_MMA(1, 1, At, B1); PG8_BAR; PG8_SCHED;
            PG8_LDB(B0, 1, 0); PG8_LDB(B1, 1, 1); PG8_SCHED; PG8_LDA(At, 1, 0); PG8_STAGEA1(PG8_SA(0, 1), kb2, p0, p2, p3);
            PG8_WAIT_V(8); PG8_WAIT_L(0); PG8_BAR; PG8_MMA(0, 0, At, B0); PG8_MMA(0, 1, At, B1); PG8_BAR; PG8_SCHED;
            PG8_LDA(At, 1, 1); PG8_STAGE(PG8_SB(1, 0), b3); PG8_STAGE(PG8_SB(1, 1), b3 + hstep); PG8_STAGEA0(PG8_SA(1, 0), kb3, p0, p1);
            PG8_WAIT_V(8); PG8_WAIT_L(0); PG8_BAR; PG8_MMA(1, 0, At, B0); PG8_MMA(1, 1, At, B1); PG8_BAR; PG8_SCHED;
        }
        asm volatile("s_nop 7\n\ts_nop 7\n\ts_nop 7" ::: "memory");
        if constexpr (ALIGN_EPI) { if (wr == 0) PG8_BAR; }
        if constexpr (Epi::HAS_PRE) E(acc, cur, wr, wc, fr, fq, epl + (ui & 1) * Epi::PRE_BYTES); else E(acc, cur, wr, wc, fr, fq);
#if PROBE_EPI2
        if constexpr (FP8) { if constexpr (Epi::HAS_PRE) E(acc, cur, wr, wc, fr, fq, epl + (ui & 1) * Epi::PRE_BYTES); else E(acc, cur, wr, wc, fr, fq); }
#endif
        if (!has_next) break;
#pragma unroll
        for (int a = 0; a < 2; ++a)
#pragma unroll
            for (int b = 0; b < 2; ++b)
#pragma unroll
                for (int m = 0; m < 4; ++m)
#pragma unroll
                    for (int n = 0; n < 2; ++n) { double z0, z1; asm volatile("v_mov_b64 %0, 0\n\tv_mov_b64 %1, 0" : "=v"(z0), "=v"(z1)); typedef double d2_t __attribute__((ext_vector_type(2))); acc[a][b][m][n] = __builtin_bit_cast(f32x4, (d2_t){z0, z1}); }
        cur = nxt; cB = nB; oA0 = oN0; oA1 = oN1; oA2 = oN2; oA3 = oN3; ++ui;
        if constexpr (ALIGN_EPI) { if (wr == 1) PG8_BAR; }
    }
    PG8_WAIT_V(0);
    if constexpr (!ALIGN_EPI) { if (wr == 0) PG8_BAR; }
    PG8_BAR;
#undef PG8_SA
#undef PG8_SB
#undef PG8_STAGE
#undef PG8_STAGEA0
#undef PG8_STAGEA1
#undef PG8_LDA
#undef PG8_LDB
#undef PG8_LO
#undef PG8_HI
#undef PG8_MMA
#undef PG8_WAIT_V
#undef PG8_WAIT_L
#undef PG8_BAR
#undef PG8_SCHED
}

__device__ __forceinline__ GAS unsigned char* launder(unsigned char* p) { asm volatile("" : "+s"(p)); return (GAS unsigned char*)p; }
#define OPAQUE_LANE(fr, fq) asm volatile("" : "+v"(fr), "+v"(fq))
__device__ __forceinline__ f32x2 sigm2(const f32x2 v) { f32x2 e = v * -1.4426950408889634f; e.x = __builtin_amdgcn_exp2f(e.x); e.y = __builtin_amdgcn_exp2f(e.y); e = e + 1.0f; e.x = frcp(e.x); e.y = frcp(e.y); return e; }
__device__ __forceinline__ f32x4 silu4(const f32x4 v) { f32x4 e = v * -1.4426950408889634f;
#pragma unroll
    for (int j = 0; j < 4; ++j) e[j] = __builtin_amdgcn_exp2f(e[j]);
    e = e + 1.0f;
#pragma unroll
    for (int j = 0; j < 4; ++j) e[j] = frcp(e[j]);
    return v * e; }
__device__ __forceinline__ void row_scan_mul8(float& a, float& b, float& c, float& d, float& e, float& f, float& g, float& h) {
#define RSM_STEP(s) "v_mul_f32_dpp %0, %0, %0 row_shr:" #s " row_mask:0xf bank_mask:0xf\n\tv_mul_f32_dpp %1, %1, %1 row_shr:" #s " row_mask:0xf bank_mask:0xf\n\tv_mul_f32_dpp %2, %2, %2 row_shr:" #s " row_mask:0xf bank_mask:0xf\n\tv_mul_f32_dpp %3, %3, %3 row_shr:" #s " row_mask:0xf bank_mask:0xf\n\t" \
                    "v_mul_f32_dpp %4, %4, %4 row_shr:" #s " row_mask:0xf bank_mask:0xf\n\tv_mul_f32_dpp %5, %5, %5 row_shr:" #s " row_mask:0xf bank_mask:0xf\n\tv_mul_f32_dpp %6, %6, %6 row_shr:" #s " row_mask:0xf bank_mask:0xf\n\tv_mul_f32_dpp %7, %7, %7 row_shr:" #s " row_mask:0xf bank_mask:0xf\n\t"
    asm volatile("s_nop 1\n\t" RSM_STEP(1) RSM_STEP(2) RSM_STEP(4) RSM_STEP(8) : "+v"(a), "+v"(b), "+v"(c), "+v"(d), "+v"(e), "+v"(f), "+v"(g), "+v"(h));
#undef RSM_STEP
}
struct EpiHgrnIn {
    static constexpr bool PERM = true, HAS_PRE = true; static constexpr int PRE_BYTES = 1024;
    unsigned char* ws0; int L;
    __device__ __forceinline__ void pre(const Unit& u, LAS unsigned char* buf, int wid, int lane) const {
        if (wid == 0 && u.pn < 8) glds16((const char*)(ws0 + WS_LBS) + ((size_t)L * DM + (size_t)u.pn * HG_K) * 4, (unsigned)lane * 16u, buf);
    }
    __device__ __forceinline__ void operator()(const f32x4 (&acc)[2][2][4][2], const Unit& u, int wr, int wc, int fr, int fq, const LAS unsigned char* buf) const {
        OPAQUE_LANE(fr, fq);
        GAS unsigned char* ws = launder(ws0);
        GAS bf16* QD = (GAS bf16*)(ws + WS_H);
        const int row0 = u.rowbase + wr * 64 + fr;
        if (u.pn >= 8) {
            const bool isg = u.pn >= 12; GAS bf16* base = QD + (size_t)(isg ? 4 : 3) * NTOK * DM; const int colt = (u.pn - (isg ? 12 : 8)) * BM + wc * 32 + 8 * fq;
#pragma unroll
            for (int ai = 0; ai < 2; ++ai)
#pragma unroll
                for (int m = 0; m < 4; ++m) { GAS bf16* rowp = base + (size_t)(row0 + ai * HALF + m * 16) * DM + colt;
#pragma unroll
                    for (int bj = 0; bj < 2; ++bj) { f32x4 v0 = acc[ai][bj][m][0], v1 = acc[ai][bj][m][1];
                        if (isg) { v0 = silu4(v0); v1 = silu4(v1); }
                        v4u w; w.x = cvt_pk_bf16(v0[0], v0[1]); w.y = cvt_pk_bf16(v0[2], v0[3]); w.z = cvt_pk_bf16(v1[0], v1[1]); w.w = cvt_pk_bf16(v1[2], v1[3]);
                        *(GAS v4u*)(rowp + bj * HALF) = w; } }
            return;
        }
        const int col = u.pn * HG_K + wc * 32 + 8 * fq;
        const LAS float* lb = (const LAS float*)buf + wc * 32 + 8 * fq;
        const f32x4 lb0 = *(const LAS f32x4*)lb, lb1 = *(const LAS f32x4*)(lb + 4);
        GAS float* DEC = (GAS float*)(ws + WS_DEC);
        f32x2 lbp[4], oml[4];
        lbp[0] = __builtin_shufflevector(lb0, lb0, 0, 1); lbp[1] = __builtin_shufflevector(lb0, lb0, 2, 3); lbp[2] = __builtin_shufflevector(lb1, lb1, 0, 1); lbp[3] = __builtin_shufflevector(lb1, lb1, 2, 3);
#pragma unroll
        for (int p = 0; p < 4; ++p) oml[p] = 1.0f - lbp[p];
#pragma unroll
        for (int ai = 0; ai < 2; ++ai)
#pragma unroll
            for (int m = 0; m < 4; ++m) {
                const int row = row0 + ai * HALF + m * 16;
                float qd[8], ki[8], P[8];
#pragma unroll
                for (int p = 0; p < 4; ++p) {
                    const f32x4 q4 = acc[ai][0][m][p >> 1], f4 = acc[ai][1][m][p >> 1];
                    const f32x2 q2 = (p & 1) ? __builtin_shufflevector(q4, q4, 2, 3) : __builtin_shufflevector(q4, q4, 0, 1);
                    const f32x2 f2 = (p & 1) ? __builtin_shufflevector(f4, f4, 2, 3) : __builtin_shufflevector(f4, f4, 0, 1);
                    const f32x2 sg = sigm2(f2), fg = oml[p] * sg + lbp[p], kk = oml[p] * (1.0f - sg), sq = q2 * sigm2(q2);
                    P[2 * p] = fg.x; P[2 * p + 1] = fg.y; ki[2 * p] = kk.x; ki[2 * p + 1] = kk.y; qd[2 * p] = sq.x; qd[2 * p + 1] = sq.y;
                }
                row_scan_mul8(P[0], P[1], P[2], P[3], P[4], P[5], P[6], P[7]);
#pragma unroll
                for (int j = 0; j < 8; ++j) { const float iP = frcp(fmaxf(P[j], 1e-30f));
                    qd[j] *= P[j]; ki[j] *= iP; }
                const size_t o = (size_t)row * DM + col;
                v4u w;
                w.x = cvt_pk_bf16(qd[0], qd[1]); w.y = cvt_pk_bf16(qd[2], qd[3]); w.z = cvt_pk_bf16(qd[4], qd[5]); w.w = cvt_pk_bf16(qd[6], qd[7]); *(GAS v4u*)(QD + o) = w;
                w.x = cvt_pk_bf16(ki[0], ki[1]); w.y = cvt_pk_bf16(ki[2], ki[3]); w.z = cvt_pk_bf16(ki[4], ki[5]); w.w = cvt_pk_bf16(ki[6], ki[7]); *(GAS v4u*)(QD + (size_t)NTOK * DM + o) = w;
                if (fr == 15) { GAS float* dp = DEC + (size_t)(row >> 4) * DM + col; *(GAS f32x4*)dp = (f32x4){P[0], P[1], P[2], P[3]}; *(GAS f32x4*)(dp + 4) = (f32x4){P[4], P[5], P[6], P[7]}; }
            }
    }
};
struct EpiRetIn {
    static constexpr bool PERM = true, HAS_PRE = false; static constexpr int PRE_BYTES = 0;
    unsigned char* ws0;
    __device__ __forceinline__ void operator()(const f32x4 (&acc)[2][2][4][2], const Unit& u, int wr, int wc, int fr, int fq) const {
        OPAQUE_LANE(fr, fq);
        GAS unsigned char* ws = launder(ws0);
        GAS bf16* H = (GAS bf16*)(ws + WS_H);
        const int row0 = u.rowbase + wr * 64 + fr; const int colt = u.pn * BM + wc * 32 + 8 * fq;
        const int kind = u.pn < 4 ? 0 : (u.pn < 8 ? 1 : (u.pn < 16 ? 2 : 3));
        float ivf[2][4];
        if (kind <= 1) {
#pragma unroll
            for (int bj = 0; bj < 2; ++bj)
#pragma unroll
                for (int k = 0; k < 4; ++k) { const int p = ((bj * HALF + wc * 32 + 8 * fq) >> 1) + k; ivf[bj][k] = (1.0f / __builtin_amdgcn_exp2f(13.287712379549449f * ((float)p / 127.0f))); }
        }
#pragma unroll
        for (int ai = 0; ai < 2; ++ai)
#pragma unroll
            for (int m = 0; m < 4; ++m) { const int row = row0 + ai * HALF + m * 16; GAS bf16* rowp = H + (size_t)row * RT_IN + colt; const int pos = row & (SEQ - 1);
#pragma unroll
                for (int bj = 0; bj < 2; ++bj) { f32x4 v0 = acc[ai][bj][m][0], v1 = acc[ai][bj][m][1];
                    if (kind <= 1) {
                        f32x4 r0, r1;
#pragma unroll
                        for (int k = 0; k < 4; ++k) { const float th = (float)pos * ivf[bj][k]; const float fr2 = __builtin_amdgcn_fractf(th * 0.15915494309189535f);
                            const float cs = __builtin_amdgcn_cosf(fr2), sn = __builtin_amdgcn_sinf(fr2);
                            if (k < 2) { r0[2 * k] = cs; r0[2 * k + 1] = sn; } else { r1[2 * (k - 2)] = cs; r1[2 * (k - 2) + 1] = sn; } }
                        const float sc = kind == 1 ? 0.0625f : 1.0f;
                        f32x4 o0, o1;
                        o0[0] = (v0[0] * r0[0] - v0[1] * r0[1]) * sc; o0[1] = (v0[1] * r0[0] + v0[0] * r0[1]) * sc;
                        o0[2] = (v0[2] * r0[2] - v0[3] * r0[3]) * sc; o0[3] = (v0[3] * r0[2] + v0[2] * r0[3]) * sc;
                        o1[0] = (v1[0] * r1[0] - v1[1] * r1[1]) * sc; o1[1] = (v1[1] * r1[0] + v1[0] * r1[1]) * sc;
                        o1[2] = (v1[2] * r1[2] - v1[3] * r1[3]) * sc; o1[3] = (v1[3] * r1[2] + v1[2] * r1[3]) * sc;
                        v0 = o0; v1 = o1;
                    } else if (kind == 3) {
                        v0 = silu4(v0) * RG_SCALE; v1 = silu4(v1) * RG_SCALE;
                        v2u w8; w8.x = pk4_fp8(v0[0], v0[1], v0[2], v0[3]); w8.y = pk4_fp8(v1[0], v1[1], v1[2], v1[3]);
                        *(GAS v2u*)((GAS unsigned char*)H + (size_t)row * (RT_IN * 2) + 8192 + (colt - 4096) + bj * HALF) = w8;
                        continue; }
                    v4u w; w.x = cvt_pk_bf16(v0[0], v0[1]); w.y = cvt_pk_bf16(v0[2], v0[3]); w.z = cvt_pk_bf16(v1[0], v1[1]); w.w = cvt_pk_bf16(v1[2], v1[3]);
                    *(GAS v4u*)(rowp + bj * HALF) = w; } }
    }
};
struct EpiRes {
    static constexpr bool PERM = true, HAS_PRE = true; static constexpr int PRE_BYTES = 1024;
    unsigned char* ws0; int ssoff; float ds;
    __device__ __forceinline__ void pre(const Unit& u, LAS unsigned char* buf, int wid, int lane) const {
        if (ssoff < 0) return;
        const int t = wid * 64 + lane, r = t >> 1, hf = t & 1;
        const GAS float* sp = (const GAS float*)(launder(ws0) + WS_SSP) + (size_t)(hf * HG_HEADS) * NTOK + u.rowbase + r;
        float s = 0.f;
#pragma unroll
        for (int hh = 0; hh < HG_HEADS; ++hh) s += sp[(size_t)hh * NTOK];
        s += dppf<0xB1>(s);
        if (hf == 0) ((LAS float*)buf)[r] = 1.0f / sqrtf(s * (1.0f / DM) + RMS_EPS);
    }
    __device__ __forceinline__ void operator()(const f32x4 (&acc)[2][2][4][2], const Unit& u, int wr, int wc, int fr, int fq, const LAS unsigned char* buf) const {
        OPAQUE_LANE(fr, fq);
        GAS unsigned char* ws = launder(ws0);
        GAS bf16* Y = (GAS bf16*)(ws + WS_Y); const GAS bf16* X = (const GAS bf16*)(ws + WS_XB);
        const int row0 = u.rowbase + wr * 64 + fr, col0 = u.pn * BM + wc * 32 + 8 * fq;
        v4u xs[2][4][2];
#pragma unroll
        for (int ai = 0; ai < 2; ++ai)
#pragma unroll
            for (int m = 0; m < 4; ++m)
#pragma unroll
                for (int bj = 0; bj < 2; ++bj) xs[ai][m][bj] = *(const GAS v4u*)(X + (size_t)(row0 + ai * HALF + m * 16) * DM + col0 + bj * HALF);
        asm volatile("" : "+v"(xs[0][0][0]), "+v"(xs[0][0][1]), "+v"(xs[0][1][0]), "+v"(xs[0][1][1]), "+v"(xs[0][2][0]), "+v"(xs[0][2][1]), "+v"(xs[0][3][0]), "+v"(xs[0][3][1]));
        asm volatile("" : "+v"(xs[1][0][0]), "+v"(xs[1][0][1]), "+v"(xs[1][1][0]), "+v"(xs[1][1][1]), "+v"(xs[1][2][0]), "+v"(xs[1][2][1]), "+v"(xs[1][3][0]), "+v"(xs[1][3][1]));
#pragma unroll
        for (int ai = 0; ai < 2; ++ai)
#pragma unroll
            for (int m = 0; m < 4; ++m) { const size_t off = (size_t)(row0 + ai * HALF + m * 16) * DM + col0;
                const float rsc = ssoff >= 0 ? ((const LAS float*)buf)[wr * 64 + fr + ai * HALF + m * 16] : 1.0f;
#pragma unroll
                for (int bj = 0; bj < 2; ++bj) { const v4u x4 = xs[ai][m][bj]; const f32x4 a0 = acc[ai][bj][m][0] * (rsc * ds), a1 = acc[ai][bj][m][1] * (rsc * ds);
                    v4u w; w.x = cvt_pk_bf16(bflo(x4.x) * DN_ALPHA + a0[0], bfhi(x4.x) * DN_ALPHA + a0[1]); w.y = cvt_pk_bf16(bflo(x4.y) * DN_ALPHA + a0[2], bfhi(x4.y) * DN_ALPHA + a0[3]);
                    w.z = cvt_pk_bf16(bflo(x4.z) * DN_ALPHA + a1[0], bfhi(x4.z) * DN_ALPHA + a1[1]); w.w = cvt_pk_bf16(bflo(x4.w) * DN_ALPHA + a1[2], bfhi(x4.w) * DN_ALPHA + a1[3]);
                    *(GAS v4u*)(Y + off + bj * HALF) = w; } }
    }
};
struct EpiMoeGU {
    static constexpr bool PERM = true, HAS_PRE = true; static constexpr int PRE_BYTES = 1024;
    unsigned char* ws0; int L;
    __device__ __forceinline__ void pre(const Unit& u, LAS unsigned char* buf, int wid, int lane) const {
        if (wid == 0) glds16((const char*)(ws0 + WS_BGU) + ((size_t)L * NE * 2048 + ((size_t)u.e * 8 + u.pn) * 256) * 4, (unsigned)lane * 16u, buf);
    }
    __device__ __forceinline__ void operator()(const f32x4 (&acc)[2][2][4][2], const Unit& u, int wr, int wc, int fr, int fq, const LAS unsigned char* buf) const {
        OPAQUE_LANE(fr, fq);
        GAS unsigned char* ws = launder(ws0);
        const int row0 = u.rowbase + wr * 64 + fr; const int c8 = wc * 32 + 8 * fq;
        const LAS float* bp = (const LAS float*)buf + c8;
        constexpr float CS = -2.4554669595930156f, K1 = GU_DESCALE * CS, K2 = GU_DESCALE * ACT_SCALE / CS, GLO = 7.0f * CS, LLO = -6.0f * ACT_SCALE / CS, LHI = 8.0f * ACT_SCALE / CS;
        f32x2 bgc[4], blc[4];
        { const f32x4 bg0 = *(const LAS f32x4*)bp, bg1 = *(const LAS f32x4*)(bp + 4), bl0 = *(const LAS f32x4*)(bp + HALF), bl1 = *(const LAS f32x4*)(bp + HALF + 4);
          bgc[0] = __builtin_shufflevector(bg0, bg0, 0, 1) * CS; bgc[1] = __builtin_shufflevector(bg0, bg0, 2, 3) * CS; bgc[2] = __builtin_shufflevector(bg1, bg1, 0, 1) * CS; bgc[3] = __builtin_shufflevector(bg1, bg1, 2, 3) * CS;
          blc[0] = __builtin_shufflevector(bl0, bl0, 0, 1) * (ACT_SCALE / CS) + (ACT_SCALE / CS); blc[1] = __builtin_shufflevector(bl0, bl0, 2, 3) * (ACT_SCALE / CS) + (ACT_SCALE / CS);
          blc[2] = __builtin_shufflevector(bl1, bl1, 0, 1) * (ACT_SCALE / CS) + (ACT_SCALE / CS); blc[3] = __builtin_shufflevector(bl1, bl1, 2, 3) * (ACT_SCALE / CS) + (ACT_SCALE / CS); }
#pragma unroll
        for (int ai = 0; ai < 2; ++ai)
#pragma unroll
            for (int m = 0; m < 4; ++m) { const size_t eo = (size_t)(row0 + ai * HALF + m * 16) * DM + u.pn * HALF + c8;
                float a[8];
                f32x2 gcv[4], lcv[4], dv[4];
#pragma unroll
                for (int p = 0; p < 4; ++p) {
                    const f32x4 ag4 = acc[ai][0][m][p >> 1], al4 = acc[ai][1][m][p >> 1];
                    const f32x2 ag = (p & 1) ? __builtin_shufflevector(ag4, ag4, 2, 3) : __builtin_shufflevector(ag4, ag4, 0, 1);
                    const f32x2 al = (p & 1) ? __builtin_shufflevector(al4, al4, 2, 3) : __builtin_shufflevector(al4, al4, 0, 1);
                    f32x2 gc = ag * K1 + bgc[p]; gc.x = fmaxf(gc.x, GLO); gc.y = fmaxf(gc.y, GLO); gcv[p] = gc;
                    f32x2 lc = al * K2 + blc[p]; lc.x = __builtin_amdgcn_fmed3f(lc.x, LLO, LHI); lc.y = __builtin_amdgcn_fmed3f(lc.y, LLO, LHI); lcv[p] = lc;
                }
#pragma unroll
                for (int p = 0; p < 4; ++p) { dv[p].x = __builtin_amdgcn_exp2f(gcv[p].x); dv[p].y = __builtin_amdgcn_exp2f(gcv[p].y); }
#pragma unroll
                for (int p = 0; p < 4; ++p) { dv[p] = dv[p] + 1.0f; lcv[p] = lcv[p] * gcv[p]; }
#pragma unroll
                for (int p = 0; p < 4; ++p) { dv[p].x = frcp(dv[p].x); dv[p].y = frcp(dv[p].y); }
#pragma unroll
                for (int p = 0; p < 4; ++p) { const f32x2 r = lcv[p] * dv[p]; a[2 * p] = r.x; a[2 * p + 1] = r.y; }
#if MOE_FP8
                v2u w;
                { int p = __builtin_amdgcn_cvt_pk_fp8_f32(a[0], a[1], 0, false); p = __builtin_amdgcn_cvt_pk_fp8_f32(a[2], a[3], p, true); w.x = (unsigned)p; }
                { int p = __builtin_amdgcn_cvt_pk_fp8_f32(a[4], a[5], 0, false); p = __builtin_amdgcn_cvt_pk_fp8_f32(a[6], a[7], p, true); w.y = (unsigned)p; }
                *(GAS v2u*)(ws + WS_ACT + eo) = w;
#else
                v4u w; w.x = cvt_pk_bf16(a[0], a[1]); w.y = cvt_pk_bf16(a[2], a[3]); w.z = cvt_pk_bf16(a[4], a[5]); w.w = cvt_pk_bf16(a[6], a[7]);
                *(GAS v4u*)((GAS bf16*)(ws + WS_ACT) + eo) = w;
#endif
            }
    }
};
struct EpiMoeDown {
    static constexpr bool PERM = true, HAS_PRE = true; static constexpr int PRE_BYTES = 3072;
    unsigned char* ws0; const float* bias;
    __device__ __forceinline__ void pre(const Unit& u, LAS unsigned char* buf, int wid, int lane) const {
        if (wid == 0) glds16((const char*)(bias + (size_t)u.e * DM + u.pn * BM), (unsigned)lane * 16u, buf);
        if (wid == 1) glds16((const char*)(ws0 + WS_ROWDST) + (size_t)u.gidx * 4, (unsigned)lane * 16u, buf + 1024);
        if (wid == 2) glds16((const char*)(ws0 + WS_ROWGATE) + (size_t)u.gidx * 4, (unsigned)lane * 16u, buf + 2048);
    }
    __device__ __forceinline__ void operator()(const f32x4 (&acc)[2][2][4][2], const Unit& u, int wr, int wc, int fr, int fq, const LAS unsigned char* buf) const {
        OPAQUE_LANE(fr, fq);
        GAS unsigned char* ws = launder(ws0);
        GAS bf16* YS = (GAS bf16*)(ws + WS_YSLOT);
        const int c8 = u.pn * BM + wc * 32 + 8 * fq;
        const LAS float* bp = (const LAS float*)buf + wc * 32 + 8 * fq;
        f32x4 bv[2][2];
#pragma unroll
        for (int bj = 0; bj < 2; ++bj) { bv[bj][0] = *(const LAS f32x4*)(bp + bj * HALF); bv[bj][1] = *(const LAS f32x4*)(bp + bj * HALF + 4); }
#pragma unroll
        for (int ai = 0; ai < 2; ++ai)
#pragma unroll
            for (int m = 0; m < 4; ++m) { const int r = ai * HALF + wr * 64 + m * 16 + fr;
                if (r < u.cnt) {
                    const int dst = ((const LAS int*)(buf + 1024))[r]; const float gt = ((const LAS float*)(buf + 2048))[r];
#if YS_FP8
                    GAS unsigned char* rowp = (GAS unsigned char*)YS + (size_t)dst * DM + c8;
#pragma unroll
                    for (int bj = 0; bj < 2; ++bj) { const f32x4 v0 = (acc[ai][bj][m][0] * DN_DESCALE + bv[bj][0]) * (gt * 64.0f), v1 = (acc[ai][bj][m][1] * DN_DESCALE + bv[bj][1]) * (gt * 64.0f);
                        v2u w; w.x = pk4_fp8(v0[0], v0[1], v0[2], v0[3]); w.y = pk4_fp8(v1[0], v1[1], v1[2], v1[3]);
                        *(GAS v2u*)(rowp + bj * HALF) = w; } } }
#else
                    GAS bf16* rowp = YS + (size_t)dst * DM + c8;
#pragma unroll
                    for (int bj = 0; bj < 2; ++bj) { const f32x4 v0 = (acc[ai][bj][m][0] * DN_DESCALE + bv[bj][0]) * gt, v1 = (acc[ai][bj][m][1] * DN_DESCALE + bv[bj][1]) * gt;
                        v4u w; w.x = cvt_pk_bf16(v0[0], v0[1]); w.y = cvt_pk_bf16(v0[2], v0[3]); w.z = cvt_pk_bf16(v1[0], v1[1]); w.w = cvt_pk_bf16(v1[2], v1[3]);
                        *(GAS v4u*)(rowp + bj * HALF) = w; } } }
#endif
    }
};
}

typedef short s16x4 __attribute__((ext_vector_type(4)));
typedef __bf16 bf16x2_t __attribute__((ext_vector_type(2)));
__device__ __forceinline__ unsigned cvtpk(float lo, float hi) { f32x2 v = {lo, hi}; bf16x2_t b = __builtin_convertvector(v, bf16x2_t); return __builtin_bit_cast(unsigned, b); }
__device__ __forceinline__ s16x4 tr_read(const LAS unsigned char* p) { return __builtin_bit_cast(s16x4, __builtin_amdgcn_ds_read_tr16_b64_v4i16((LAS s16x4*)p)); }
__device__ __forceinline__ bf16x8 cat8(s16x4 lo, s16x4 hi) { return __builtin_shufflevector(lo, hi, 0, 1, 2, 3, 4, 5, 6, 7); }
__device__ __forceinline__ bf16x8 pack8(const f32x4& a, const f32x4& b) { v4u p; p.x = cvtpk(a[0], a[1]); p.y = cvtpk(a[2], a[3]); p.z = cvtpk(b[0], b[1]); p.w = cvtpk(b[2], b[3]); return __builtin_bit_cast(bf16x8, p); }
__device__ __forceinline__ s16x4 pack4(const f32x4& a) { v2u p; p.x = cvtpk(a[0], a[1]); p.y = cvtpk(a[2], a[3]); return __builtin_bit_cast(s16x4, p); }
#define LDS_BARRIER() do { asm volatile("s_waitcnt lgkmcnt(0)" ::: "memory"); __builtin_amdgcn_s_barrier(); asm volatile("" ::: "memory"); } while (0)
#define MFMA32(a, b, c) __builtin_amdgcn_mfma_f32_16x16x32_bf16((a), (b), (c), 0, 0, 0)
#define MFMA16(a, b, c) __builtin_amdgcn_mfma_f32_16x16x16bf16_1k((a), (b), (c), 0, 0, 0)

__device__ __forceinline__ void ret_fast(const int tid, LAS unsigned char* lds, const bf16* HB, bf16* OB) {
    constexpr int QP = 528, VP = 272, PP = 144;
    constexpr int OFF_Q = 0, OFF_K = 64 * QP, OFF_V = 2 * 64 * QP, OFF_P = OFF_V + 64 * VP;
    const int lane0 = tid & 63, w = __builtin_amdgcn_readfirstlane(tid >> 6);
    const int prow = tid >> 3, pc = tid & 7;
    for (int un0 = blockIdx.x; un0 < NBATCH * RT_HEADS * 4; un0 += gridDim.x) {
        const int un = (gridDim.x == 256) ? ((un0 & 7) * 32 + (un0 >> 3)) : un0;
        const int b = un >> 4, h = (un >> 2) & 3, vs = un & 3;
        const float l2g = __builtin_amdgcn_logf(1.0f - __builtin_amdgcn_exp2f(-5.0f - (float)h));
        const float dC = __builtin_amdgcn_exp2f(64.0f * l2g);
        f32x4 st[16];
#pragma unroll
        for (int i = 0; i < 16; ++i) st[i] = (f32x4){0.f, 0.f, 0.f, 0.f};
        const bf16* gbase = HB + (size_t)(b * SEQ + prow) * RT_IN;
        v4u pq[4], pk[4], pv[2];
#pragma unroll
        for (int j = 0; j < 4; ++j) { pq[j] = *(const v4u*)(gbase + h * 256 + (pc + 8 * j) * 8); pk[j] = *(const v4u*)(gbase + 1024 + h * 256 + (pc + 8 * j) * 8); }
#pragma unroll
        for (int j = 0; j < 2; ++j) pv[j] = *(const v4u*)(gbase + 2048 + h * 512 + vs * 128 + (pc + 8 * j) * 8);
#pragma unroll 1
        for (int ch = 0; ch < SEQ / 64; ++ch) {
            int lane = lane0; asm volatile("" : "+v"(lane));
            const int r = lane & 15, g = lane >> 4, q4 = (lane & 15) >> 2, p4 = lane & 3;
            LDS_BARRIER();
#pragma unroll
            for (int j = 0; j < 4; ++j) { *(LAS v4u*)(lds + OFF_Q + prow * QP + (pc + 8 * j) * 16) = pq[j]; *(LAS v4u*)(lds + OFF_K + prow * QP + (pc + 8 * j) * 16) = pk[j]; }
#pragma unroll
            for (int j = 0; j < 2; ++j) *(LAS v4u*)(lds + OFF_V + prow * VP + (pc + 8 * j) * 16) = pv[j];
            if (ch + 1 < SEQ / 64) {
                const bf16* gn = gbase + (size_t)(ch + 1) * 64 * RT_IN;
#pragma unroll
                for (int j = 0; j < 4; ++j) { pq[j] = *(const v4u*)(gn + h * 256 + (pc + 8 * j) * 8); pk[j] = *(const v4u*)(gn + 1024 + h * 256 + (pc + 8 * j) * 8); }
#pragma unroll
                for (int j = 0; j < 2; ++j) pv[j] = *(const v4u*)(gn + 2048 + h * 512 + vs * 128 + (pc + 8 * j) * 8);
            }
            LDS_BARRIER();
            {
                const int ct = w >> 1, st0 = 2 * (w & 1);
                f32x4 sa0 = {0.f, 0.f, 0.f, 0.f}, sa1 = {0.f, 0.f, 0.f, 0.f};
                const LAS unsigned char* qb = lds + OFF_Q + (16 * ct + r) * QP + g * 16;
                const LAS unsigned char* kb0 = lds + OFF_K + (16 * st0 + r) * QP + g * 16;
#pragma unroll
                for (int hb = 0; hb < 4; ++hb) {
                    bf16x8 qf[2], k0[2], k1[2];
#pragma unroll
                    for (int kk = 0; kk < 2; ++kk) { const int kb = hb * 2 + kk; qf[kk] = *(const LAS bf16x8*)(qb + kb * 64); k0[kk] = *(const LAS bf16x8*)(kb0 + kb * 64); k1[kk] = *(const LAS bf16x8*)(kb0 + 16 * QP + kb * 64); }
                    asm volatile("" : "+v"(qf[0]), "+v"(qf[1]), "+v"(k0[0]), "+v"(k0[1]), "+v"(k1[0]), "+v"(k1[1]) :: "memory");
#pragma unroll
                    for (int kk = 0; kk < 2; ++kk) { sa0 = MFMA32(k0[kk], qf[kk], sa0); sa1 = MFMA32(k1[kk], qf[kk], sa1); }
                }
                asm volatile("s_nop 7\n\ts_nop 7" : "+v"(sa0), "+v"(sa1));
                const int c = 16 * ct + r;
#pragma unroll
                for (int t = 0; t < 2; ++t) {
                    const f32x4 sa = t ? sa1 : sa0; const int s0 = 16 * (st0 + t) + 4 * g; float v[4];
#pragma unroll
                    for (int i = 0; i < 4; ++i) { const int d = c - (s0 + i); v[i] = d >= 0 ? sa[i] * __builtin_amdgcn_exp2f((float)d * l2g) : 0.f; }
                    v2u pw; pw.x = cvtpk(v[0], v[1]); pw.y = cvtpk(v[2], v[3]);
                    *(LAS v2u*)(lds + OFF_P + c * PP + s0 * 2) = pw;
                }
            }
            LDS_BARRIER();
            f32x4 o[4];
#pragma unroll
            for (int ct = 0; ct < 4; ++ct) o[ct] = (f32x4){0.f, 0.f, 0.f, 0.f};
            {
                s16x4 ql[2][4], qh[2][4];
                const LAS unsigned char* qp0 = lds + OFF_Q + r * QP + (4 * g) * 2;
#pragma unroll
                for (int ct = 0; ct < 4; ++ct) { ql[0][ct] = *(const LAS s16x4*)(qp0 + ct * 16 * QP); qh[0][ct] = *(const LAS s16x4*)(qp0 + ct * 16 * QP + 32); }
#pragma unroll
                for (int kb = 0; kb < 8; ++kb) {
                    const int cu = kb & 1, nx = cu ^ 1;
                    if (kb + 1 < 8) {
#pragma unroll
                        for (int ct = 0; ct < 4; ++ct) { ql[nx][ct] = *(const LAS s16x4*)(qp0 + ct * 16 * QP + (kb + 1) * 64); qh[nx][ct] = *(const LAS s16x4*)(qp0 + ct * 16 * QP + (kb + 1) * 64 + 32); }
                    }
                    asm volatile("" : "+v"(ql[cu][0]), "+v"(ql[cu][1]), "+v"(ql[cu][2]), "+v"(ql[cu][3]), "+v"(qh[cu][0]), "+v"(qh[cu][1]), "+v"(qh[cu][2]), "+v"(qh[cu][3]) :: "memory");
                    const bf16x8 sa = pack8(st[2 * kb], st[2 * kb + 1]);
#pragma unroll
                    for (int ct = 0; ct < 4; ++ct) o[ct] = MFMA32(sa, cat8(ql[cu][ct], qh[cu][ct]), o[ct]);
                }
            }
            bf16x8 vf[2], pf[6];
            {
                s16x4 t0[2], t1[2];
#pragma unroll
                for (int sb = 0; sb < 2; ++sb) { const LAS unsigned char* vp = lds + OFF_V + (32 * sb + 8 * g + q4) * VP + (16 * w + 4 * p4) * 2; t0[sb] = tr_read(vp); t1[sb] = tr_read(vp + 4 * VP); }
                pf[0] = *(const LAS bf16x8*)(lds + OFF_P + (0 + r) * PP + (8 * g) * 2);
                pf[1] = *(const LAS bf16x8*)(lds + OFF_P + (16 + r) * PP + (8 * g) * 2);
                pf[2] = *(const LAS bf16x8*)(lds + OFF_P + (32 + r) * PP + (8 * g) * 2);
                pf[3] = *(const LAS bf16x8*)(lds + OFF_P + (32 + r) * PP + (32 + 8 * g) * 2);
                pf[4] = *(const LAS bf16x8*)(lds + OFF_P + (48 + r) * PP + (8 * g) * 2);
                pf[5] = *(const LAS bf16x8*)(lds + OFF_P + (48 + r) * PP + (32 + 8 * g) * 2);
                asm volatile("" : "+v"(t0[0]), "+v"(t0[1]), "+v"(t1[0]), "+v"(t1[1]), "+v"(pf[0]), "+v"(pf[1]), "+v"(pf[2]), "+v"(pf[3]), "+v"(pf[4]), "+v"(pf[5]) :: "memory");
                vf[0] = cat8(t0[0], t1[0]); vf[1] = cat8(t0[1], t1[1]);
            }
            asm volatile("s_nop 7\n\ts_nop 7" : "+v"(o[0]), "+v"(o[1]), "+v"(o[2]), "+v"(o[3]));
#pragma unroll
            for (int ct = 0; ct < 4; ++ct) o[ct] = o[ct] * __builtin_amdgcn_exp2f((float)(16 * ct + r + 1) * l2g);
            o[0] = MFMA32(vf[0], pf[0], o[0]); o[1] = MFMA32(vf[0], pf[1], o[1]);
            o[2] = MFMA32(vf[0], pf[2], o[2]); o[2] = MFMA32(vf[1], pf[3], o[2]);
            o[3] = MFMA32(vf[0], pf[4], o[3]); o[3] = MFMA32(vf[1], pf[5], o[3]);
            asm volatile("s_nop 7\n\ts_nop 7" : "+v"(o[0]), "+v"(o[1]), "+v"(o[2]), "+v"(o[3]));
            {
                unsigned char* ob = (unsigned char*)OB + (size_t)(b * SEQ + ch * 64 + r) * RT_VD + h * 512 + vs * 128 + 16 * w + 4 * g;
#pragma unroll
                for (int ct = 0; ct < 4; ++ct) *(unsigned*)(ob + (size_t)ct * 16 * RT_VD) = pk4_fp8(o[ct][0] * RO_SCALE, o[ct][1] * RO_SCALE, o[ct][2] * RO_SCALE, o[ct][3] * RO_SCALE);
            }
            bf16x8 vz[2];
#pragma unroll
            for (int sb = 0; sb < 2; ++sb) {
                const v4u raw = __builtin_bit_cast(v4u, vf[sb]); float f[8] = {bflo(raw.x), bfhi(raw.x), bflo(raw.y), bfhi(raw.y), bflo(raw.z), bfhi(raw.z), bflo(raw.w), bfhi(raw.w)};
#pragma unroll
                for (int j = 0; j < 8; ++j) f[j] *= __builtin_amdgcn_exp2f((float)(63 - (32 * sb + 8 * g + j)) * l2g);
                v4u z; z.x = cvtpk(f[0], f[1]); z.y = cvtpk(f[2], f[3]); z.z = cvtpk(f[4], f[5]); z.w = cvtpk(f[6], f[7]); vz[sb] = __builtin_bit_cast(bf16x8, z);
            }
            {
                const LAS unsigned char* kp0 = lds + OFF_K + (8 * g + q4) * QP + (4 * p4) * 2;
#pragma unroll
                for (int kq = 0; kq < 4; ++kq) {
                    s16x4 ka[4][2], kbh[4][2];
#pragma unroll
                    for (int j = 0; j < 4; ++j)
#pragma unroll
                        for (int sb = 0; sb < 2; ++sb) { const LAS unsigned char* kp = kp0 + (32 * sb) * QP + (16 * (kq * 4 + j)) * 2; ka[j][sb] = tr_read(kp); kbh[j][sb] = tr_read(kp + 4 * QP); }
                    asm volatile("" : "+v"(ka[0][0]), "+v"(ka[0][1]), "+v"(ka[1][0]), "+v"(ka[1][1]), "+v"(ka[2][0]), "+v"(ka[2][1]), "+v"(ka[3][0]), "+v"(ka[3][1]),
                                      "+v"(kbh[0][0]), "+v"(kbh[0][1]), "+v"(kbh[1][0]), "+v"(kbh[1][1]), "+v"(kbh[2][0]), "+v"(kbh[2][1]), "+v"(kbh[3][0]), "+v"(kbh[3][1]) :: "memory");
#pragma unroll
                    for (int j = 0; j < 4; ++j) { const int kt = kq * 4 + j;
                        st[kt] = st[kt] * dC;
                        st[kt] = MFMA32(cat8(ka[j][0], kbh[j][0]), vz[0], st[kt]);
                        st[kt] = MFMA32(cat8(ka[j][1], kbh[j][1]), vz[1], st[kt]); }
                }
            }
        }
        LDS_BARRIER();
    }
}

__device__ __forceinline__ void hgrn_fast(const int tid, LAS unsigned char* lds, const bf16* QD, const bf16* KI, const bf16* GG, const bf16* VV, const float* DEC, const float* ng, bf16* A2, float* SS) {
    constexpr int TP = 272;
    constexpr int TPH = 144;
    constexpr int OFF_QD = 0, OFF_KI = 64 * TP, OFF_G = 2 * 64 * TP, OFF_V = OFF_G + 64 * TPH, OFF_DEC = OFF_V + 64 * TPH, OFF_SS = OFF_DEC + 2048;
    const int lane = tid & 63, w = __builtin_amdgcn_readfirstlane(tid >> 6), r = lane & 15, g = lane >> 4, q4 = (lane & 15) >> 2, p4 = lane & 3;
    const int prow = tid >> 3, pc = tid & 7;
    for (int un0 = blockIdx.x; un0 < NBATCH * HG_HEADS * 2; un0 += gridDim.x) {
        const int un = (gridDim.x == 256) ? ((((un0 & 7) * 16 + (un0 >> 4)) << 1) | ((un0 >> 3) & 1)) : un0;
        const int b = un >> 4, h = (un >> 1) & 7, vh = un & 1, wv = vh * 4 + (w & 3);
        f32x4 st[8];
#pragma unroll
        for (int i = 0; i < 8; ++i) st[i] = (f32x4){0.f, 0.f, 0.f, 0.f};
        const f32x4 ng4 = *(const f32x4*)(ng + h * 128 + 16 * wv + 4 * g);
        const size_t goff = (size_t)(b * SEQ + prow) * DM + h * 128;
        v4u p0[2], p1[2], p2, p3; f32x4 pd = {0.f, 0.f, 0.f, 0.f};
#pragma unroll
        for (int j = 0; j < 2; ++j) { const size_t o = goff + (pc + 8 * j) * 8; p0[j] = *(const v4u*)(QD + o); p1[j] = *(const v4u*)(KI + o); }
        p2 = *(const v4u*)(GG + goff + vh * 64 + pc * 8); p3 = *(const v4u*)(VV + goff + vh * 64 + pc * 8);
        if (tid < 128) pd = *(const f32x4*)(DEC + (size_t)((b * SEQ) / 16 + (tid >> 5)) * DM + h * 128 + (tid & 31) * 4);
#pragma unroll 1
        for (int rd = 0; rd < SEQ / 64; ++rd) {
            LDS_BARRIER();
            if (rd > 0 && tid < 64) {
                float s = 0.f;
#pragma unroll
                for (int ww = 0; ww < 4; ++ww) s += *(const LAS float*)(lds + OFF_SS + (ww * 64 + tid) * 4);
                SS[(size_t)(h * 2 + vh) * NTOK + (size_t)b * SEQ + (rd - 1) * 64 + tid] = s;
            }
#pragma unroll
            for (int j = 0; j < 2; ++j) { const int lo = prow * TP + (pc + 8 * j) * 16; *(LAS v4u*)(lds + OFF_QD + lo) = p0[j]; *(LAS v4u*)(lds + OFF_KI + lo) = p1[j]; }
            *(LAS v4u*)(lds + OFF_G + prow * TPH + pc * 16) = p2; *(LAS v4u*)(lds + OFF_V + prow * TPH + pc * 16) = p3;
            if (tid < 128) *(LAS f32x4*)(lds + OFF_DEC + tid * 16) = pd;
            if (rd + 1 < SEQ / 64) {
                const size_t gn = goff + (size_t)(rd + 1) * 64 * DM;
#pragma unroll
                for (int j = 0; j < 2; ++j) { const size_t o = gn + (pc + 8 * j) * 8; p0[j] = *(const v4u*)(QD + o); p1[j] = *(const v4u*)(KI + o); }
                p2 = *(const v4u*)(GG + gn + vh * 64 + pc * 8); p3 = *(const v4u*)(VV + gn + vh * 64 + pc * 8);
                if (tid < 128) pd = *(const f32x4*)(DEC + (size_t)((b * SEQ + (rd + 1) * 64) / 16 + (tid >> 5)) * DM + h * 128 + (tid & 31) * 4);
            }
            LDS_BARRIER();
            if (w < 4)
#pragma unroll 1
            for (int cc = 0; cc < 4; ++cc) {
                s16x4 ql[4], qh[4], kl[4], kh[4], ktr[8]; f32x4 d4[8];
#pragma unroll
                for (int kb = 0; kb < 4; ++kb) {
                    const int off = (16 * cc + r) * TP + (32 * kb + 4 * g) * 2;
                    ql[kb] = *(const LAS s16x4*)(lds + OFF_QD + off); qh[kb] = *(const LAS s16x4*)(lds + OFF_QD + off + 32);
                    kl[kb] = *(const LAS s16x4*)(lds + OFF_KI + off); kh[kb] = *(const LAS s16x4*)(lds + OFF_KI + off + 32);
                }
                s16x4 vfr = tr_read(lds + OFF_V + (16 * cc + 4 * g + q4) * TPH + (16 * (w & 3) + 4 * p4) * 2);
                s16x4 gfr = *(const LAS s16x4*)(lds + OFF_G + (16 * cc + r) * TPH + (16 * (w & 3) + 4 * g) * 2);
#pragma unroll
                for (int kt = 0; kt < 8; ++kt) {
                    d4[kt] = *(const LAS f32x4*)(lds + OFF_DEC + cc * 512 + (16 * kt + 4 * g) * 4);
                    ktr[kt] = tr_read(lds + OFF_KI + (16 * cc + 4 * g + q4) * TP + (16 * kt + 4 * p4) * 2);
                }
                asm volatile("" : "+v"(ql[0]), "+v"(ql[1]), "+v"(ql[2]), "+v"(ql[3]), "+v"(qh[0]), "+v"(qh[1]), "+v"(qh[2]), "+v"(qh[3]),
                                  "+v"(kl[0]), "+v"(kl[1]), "+v"(kl[2]), "+v"(kl[3]), "+v"(kh[0]), "+v"(kh[1]), "+v"(kh[2]), "+v"(kh[3]), "+v"(vfr), "+v"(gfr));
                asm volatile("" : "+v"(ktr[0]), "+v"(ktr[1]), "+v"(ktr[2]), "+v"(ktr[3]), "+v"(ktr[4]), "+v"(ktr[5]), "+v"(ktr[6]), "+v"(ktr[7]),
                                  "+v"(d4[0]), "+v"(d4[1]), "+v"(d4[2]), "+v"(d4[3]), "+v"(d4[4]), "+v"(d4[5]), "+v"(d4[6]), "+v"(d4[7]));
                bf16x8 qf[4];
#pragma unroll
                for (int kb = 0; kb < 4; ++kb) qf[kb] = cat8(ql[kb], qh[kb]);
                f32x4 sc = {0.f, 0.f, 0.f, 0.f}, oa = {0.f, 0.f, 0.f, 0.f};
#pragma unroll
                for (int kb = 0; kb < 4; ++kb) sc = MFMA32(cat8(kl[kb], kh[kb]), qf[kb], sc);
#pragma unroll
                for (int kb = 0; kb < 4; ++kb) oa = MFMA32(pack8(st[2 * kb], st[2 * kb + 1]), qf[kb], oa);
#pragma unroll
                for (int kt = 0; kt < 8; ++kt) st[kt] = MFMA16(ktr[kt], vfr, st[kt]);
                asm volatile("s_nop 7\n\ts_nop 7" : "+v"(st[0]), "+v"(st[1]), "+v"(st[2]), "+v"(st[3]), "+v"(st[4]), "+v"(st[5]), "+v"(st[6]), "+v"(st[7]), "+v"(sc), "+v"(oa));
#pragma unroll
                for (int kt = 0; kt < 8; ++kt) st[kt] = st[kt] * d4[kt];
#pragma unroll
                for (int i = 0; i < 4; ++i) sc[i] = (4 * g + i <= r) ? sc[i] : 0.f;
                oa = MFMA16(vfr, pack4(sc), oa);
                asm volatile("s_nop 7\n\ts_nop 7" : "+v"(oa));
                { const v2u gr = __builtin_bit_cast(v2u, gfr);
                  v2u ow; ow.x = cvtpk(oa[0] * ng4[0] * bflo(gr.x), oa[1] * ng4[1] * bfhi(gr.x)); ow.y = cvtpk(oa[2] * ng4[2] * bflo(gr.y), oa[3] * ng4[3] * bfhi(gr.y));
                  *(v2u*)(A2 + (size_t)(b * SEQ + rd * 64 + cc * 16 + r) * DM + h * 128 + 16 * wv + 4 * g) = ow;
                  float p = (oa[0] * oa[0] + oa[1] * oa[1]) + (oa[2] * oa[2] + oa[3] * oa[3]);
                  { const unsigned pb = __builtin_bit_cast(unsigned, p); auto sw = __builtin_amdgcn_permlane16_swap(pb, pb, false, false); p = __builtin_bit_cast(float, (unsigned)sw[0]) + __builtin_bit_cast(float, (unsigned)sw[1]); }
                  { const unsigned pb = __builtin_bit_cast(unsigned, p); auto sw = __builtin_amdgcn_permlane32_swap(pb, pb, false, false); p = __builtin_bit_cast(float, (unsigned)sw[0]) + __builtin_bit_cast(float, (unsigned)sw[1]); }
                  if (lane < 16) *(LAS float*)(lds + OFF_SS + (w * 64 + cc * 16 + r) * 4) = p; }
            }
        }
        LDS_BARRIER();
        if (tid < 64) { float s = 0.f;
#pragma unroll
            for (int ww = 0; ww < 4; ++ww) s += *(const LAS float*)(lds + OFF_SS + (ww * 64 + tid) * 4);
            SS[(size_t)(h * 2 + vh) * NTOK + (size_t)b * SEQ + (SEQ / 64 - 1) * 64 + tid] = s; }
        LDS_BARRIER();
    }
}

struct Args { const float* in[17]; float* out; unsigned char* ws; int ph_lo, ph_hi; };
enum { I_X = 0, I_HWIN, I_HNG, I_HWOUT, I_LB, I_RWIN, I_RWOUT, I_LNMG, I_LNMB, I_LNFG, I_LNFB, I_RW, I_RB, I_WGU, I_BGU, I_WDN, I_BDN };

__device__ __forceinline__ int dest_row(int mode, int n) {
    if (mode == 1) { if (n < 1024) return ((n >> 7) << 8) + (n & 127); if (n < 2048) { const int q = n - 1024; return ((q >> 7) << 8) + 128 + (q & 127); } return n; }
    if (mode == 2) { const int j2 = n >> 1; return ((j2 >> 7) << 8) + ((n & 1) << 7) + (j2 & 127); }
    return n;
}
__device__ __forceinline__ void transpose_item(const float* W, int K, int N, bf16* WT, int mode, LAS float* scr, int item, int lane) {
    const int nblk = N / 64, kb = item / nblk, nb = item % nblk, k0 = 64 * kb, n0 = 64 * nb;
#pragma unroll 4
    for (int i = 0; i < 16; ++i) { const int kk = 4 * i + (lane >> 4), c4 = (lane & 15) * 4;
        const f32x4 v = *(const GAS f32x4*)(W + (size_t)(k0 + kk) * N + n0 + c4);
        LAS float* s = scr + kk * 65 + c4; s[0] = v[0]; s[1] = v[1]; s[2] = v[2]; s[3] = v[3]; }
    LDS_WAIT(); asm volatile("" ::: "memory");
    const int c = lane & 7;
#pragma unroll 2
    for (int j = 0; j < 8; ++j) { const int n = (lane >> 3) + 8 * j; const LAS float* s = scr + (8 * c) * 65 + n;
        v4u o; o.x = pk2(s[0 * 65], s[1 * 65]); o.y = pk2(s[2 * 65], s[3 * 65]); o.z = pk2(s[4 * 65], s[5 * 65]); o.w = pk2(s[6 * 65], s[7 * 65]);
        *(GAS v4u*)(WT + (size_t)dest_row(mode, n0 + n) * K + k0 + 8 * c) = o; }
    LDS_WAIT(); asm volatile("" ::: "memory");
}

__device__ __forceinline__ void transpose_item_fp8(const float* W, int K, int N, unsigned char* WT, int mode, float scale, LAS float* scr, int item, int lane) {
    const int nblk = N / 64, kb = item / nblk, nb = item % nblk, k0 = 64 * kb, n0 = 64 * nb;
#pragma unroll 4
    for (int i = 0; i < 16; ++i) { const int kk = 4 * i + (lane >> 4), c4 = (lane & 15) * 4;
        const f32x4 v = *(const GAS f32x4*)(W + (size_t)(k0 + kk) * N + n0 + c4);
        LAS float* s = scr + kk * 65 + c4; s[0] = v[0]; s[1] = v[1]; s[2] = v[2]; s[3] = v[3]; }
    LDS_WAIT(); asm volatile("" ::: "memory");
    const int c = lane & 7;
#pragma unroll 2
    for (int j = 0; j < 8; ++j) { const int n = (lane >> 3) + 8 * j; const LAS float* s = scr + (8 * c) * 65 + n;
        v2u o; o.x = pk4_fp8(s[0 * 65] * scale, s[1 * 65] * scale, s[2 * 65] * scale, s[3 * 65] * scale); o.y = pk4_fp8(s[4 * 65] * scale, s[5 * 65] * scale, s[6 * 65] * scale, s[7 * 65] * scale);
        *(GAS v2u*)(WT + (size_t)dest_row(mode, n0 + n) * K + k0 + 8 * c) = o; }
    LDS_WAIT(); asm volatile("" ::: "memory");
}

#ifndef SITE_MASK
#define SITE_MASK 0xffff
#endif
#define SITE(n) (((SITE_MASK) >> (n)) & 1)
#ifndef PROBE_MASK
#define PROBE_MASK 0
#endif
#define REP(n) (1 + (((PROBE_MASK) >> (n)) & 1))
typedef const __attribute__((address_space(4))) Args* KArgs;
__device__ __forceinline__ int otid(int wave0) { int l; asm volatile("v_mbcnt_lo_u32_b32 %0, -1, 0\n\tv_mbcnt_hi_u32_b32 %0, -1, %0" : "=v"(l)); asm volatile("" : "+s"(wave0)); return wave0 * 64 + l; }
__device__ __forceinline__ LAS unsigned char* olds(LAS unsigned char* p) { asm volatile("" : "+s"(p)); return p; }
__device__ __forceinline__ KArgs kargs() { KArgs p = (KArgs)__builtin_amdgcn_kernarg_segment_ptr(); asm volatile("" : "+s"(p)); return p; }
#define IN(k) (ap->ph_lo <= (k) && (k) < ap->ph_hi)
#ifndef PROBE_BAR
#define PROBE_BAR 1
#endif
#define GRID_BAR() for (int _r = 0; _r < PROBE_BAR; ++_r) do { if (ap->ph_hi - ap->ph_lo > 1) { XcdBarrier _b; _b.bar = (unsigned*)(ap->ws + WS_CTL) + CW_BAR; _b.x = xb_xcc_id(); _b.st = (volatile LAS unsigned*)(lds + MISC_OFF + MO_BARW); xcd_barrier(_b); } } while (0)
#define VCU() ((gridDim.x % 8 == 0) ? (int)((blockIdx.x % 8) * (gridDim.x / 8) + blockIdx.x / 8) : (int)blockIdx.x)

__global__ void __launch_bounds__(512, 2) mk_fwd(Args args_unused) {
    extern __shared__ __attribute__((aligned(16))) unsigned char lds_raw[];
    LAS unsigned char* const lds0 = (LAS unsigned char*)lds_raw;
    const int wave0 = __builtin_amdgcn_readfirstlane((int)(threadIdx.x >> 6));
    {
        LAS unsigned char* lds = lds0;
        for (int u = threadIdx.x; u < (LDS_BYTES - MISC_OFF) / 4; u += 512) ((LAS unsigned*)(lds + MISC_OFF))[u] = 0u;
        __syncthreads();
        KArgs ap = kargs();
        if (ap->ph_hi - ap->ph_lo > 1) (void)xcd_barrier_post((unsigned*)(ap->ws + WS_CTL) + CW_BAR, (volatile LAS unsigned*)(lds + MISC_OFF + MO_BARW));
    }

#if SITE(0)
    { KArgs ap = kargs(); const int tid = otid(wave0); LAS unsigned char* lds = olds(lds0); (void)tid;
    if (IN(0)) for (int rep_ = 0; rep_ < REP(0); ++rep_) {
        const int lane = tid & 63, wave = __builtin_amdgcn_readfirstlane(tid >> 6), G = gridDim.x, vcu = VCU(), gw = vcu * 8 + wave, NGW = G * 8;
        unsigned char* ws = ap->ws;
        LAS float* scr = (LAS float*)(lds + wave * 16640);
        constexpr int I_HIN = 2 * 16 * 64, I_HOUT = 2 * 16 * 16, I_RIN = 2 * 16 * 96, I_ROUT = 2 * 32 * 16, I_GU = 128 * 16 * 32, I_DN = 128 * 16 * 16;
        constexpr int NITEMS = I_HIN + I_HOUT + I_RIN + I_ROUT + I_GU + I_DN + I_ROUT;
        for (int it = gw; it < NITEMS; it += NGW) {
            int r = it;
            if (r < I_HIN) { const int j = r / (16 * 64); transpose_item(ap->in[I_HWIN] + (size_t)j * DM * HG_IN, DM, HG_IN, (bf16*)(ws + WS_W_HIN) + (size_t)j * HG_IN * DM, 1, scr, r % (16 * 64), lane); continue; } r -= I_HIN;
            if (r < I_HOUT) { const int j = r / 256; transpose_item(ap->in[I_HWOUT] + (size_t)j * DM * DM, DM, DM, (bf16*)(ws + WS_W_HOUT) + (size_t)j * DM * DM, 0, scr, r % 256, lane); continue; } r -= I_HOUT;
            if (r < I_RIN) { const int j = r / (16 * 96); transpose_item(ap->in[I_RWIN] + (size_t)j * DM * RT_IN, DM, RT_IN, (bf16*)(ws + WS_W_RIN) + (size_t)j * RT_IN * DM, 0, scr, r % (16 * 96), lane); continue; } r -= I_RIN;
            if (r < I_ROUT) { const int j = r / 512; transpose_item(ap->in[I_RWOUT] + (size_t)j * RT_VD * DM, RT_VD, DM, (bf16*)(ws + WS_W_ROUT) + (size_t)j * DM * RT_VD, 0, scr, r % 512, lane); continue; } r -= I_ROUT;
#if MOE_FP8
            if (r < I_GU) { const int j = r / 512; transpose_item_fp8(ap->in[I_WGU] + (size_t)j * DM * 2048, DM, 2048, ws + WS_W_GU + (size_t)j * 2048 * DM, 2, WGU_SCALE, scr, r % 512, lane); continue; } r -= I_GU;
            if (r < I_DN) { const int j = r / 256; transpose_item_fp8(ap->in[I_WDN] + (size_t)j * DM * DM, DM, DM, ws + WS_W_DN + (size_t)j * DM * DM, 0, WDN_SCALE, scr, r % 256, lane); continue; } r -= I_DN;
            { const int j = r / 512; transpose_item_fp8(ap->in[I_RWOUT] + (size_t)j * RT_VD * DM, RT_VD, DM, ws + WS_W_ROUT8 + (size_t)j * DM * RT_VD, 0, 128.0f, scr, r % 512, lane); }
#else
            if (r < I_GU) { const int j = r / 512; transpose_item(ap->in[I_WGU] + (size_t)j * DM * 2048, DM, 2048, (bf16*)(ws + WS_W_GU) + (size_t)j * 2048 * DM, 2, scr, r % 512, lane); continue; } r -= I_GU;
            { const int j = r / 256; transpose_item(ap->in[I_WDN] + (size_t)j * DM * DM, DM, DM, (bf16*)(ws + WS_W_DN) + (size_t)j * DM * DM, 0, scr, r % 256, lane); }
#endif
        }
        const int gt = vcu * 512 + tid, NGT = G * 512;
        float* LBS = (float*)(ws + WS_LBS); float* BGU = (float*)(ws + WS_BGU); bf16* XB = (bf16*)(ws + WS_XB);
        for (int d = gt; d < DM; d += NGT) { const float* lbp = ap->in[I_LB]; const float v0 = lbp[d], v1 = lbp[DM + d], v2 = lbp[2 * DM + d], v3 = lbp[3 * DM + d]; const float mx = fmaxf(fmaxf(v0, v1), fmaxf(v2, v3));
            const float e0 = __expf(v0 - mx), e1 = __expf(v1 - mx), e2 = __expf(v2 - mx), e3 = __expf(v3 - mx), is = 1.0f / (e0 + e1 + e2 + e3);
            LBS[d] = 0.f; LBS[DM + d] = e1 * is; LBS[2 * DM + d] = (e1 + e2) * is; LBS[3 * DM + d] = (e1 + e2 + e3) * is; }
        for (int i = gt; i < 4 * DM * NE; i += NGT) { const int l = i >> 15, d = (i >> 5) & 1023, e = i & 31; const float wv = ap->in[I_RW][i]; const unsigned hb = f2bf(wv); const float hv = __builtin_bit_cast(float, hb << 16);
            ((bf16*)(ws + WS_WRH))[(size_t)l * 32768 + e * 1024 + d] = (bf16)hb; ((bf16*)(ws + WS_WRL))[(size_t)l * 32768 + e * 1024 + d] = (bf16)f2bf(wv - hv); }
        for (int i = gt; i < 4 * 32 * 2048; i += NGT) { const int le = i >> 11, n = i & 2047; BGU[(size_t)le * 2048 + dest_row(2, n)] = ap->in[I_BGU][i]; }
        for (size_t i = (size_t)gt; i < (size_t)NTOK * DM / 4; i += NGT) { const f32x4 v = ((const f32x4*)ap->in[I_X])[i]; v2u o; o.x = pk2(v[0], v[1]); o.y = pk2(v[2], v[3]); ((v2u*)XB)[i] = o; }
        GRID_BAR();
    } }
#endif

#pragma unroll 1
    for (int L = 0; L < DEPTH; ++L) {
        const int pb = 1 + 8 * L;
        if ((L & 1) == 0) {
#if SITE(1)
            { KArgs ap = kargs(); const int tid = otid(wave0); LAS unsigned char* lds = olds(lds0); (void)tid;
            if (IN(pb + 0)) for (int rep_ = 0; rep_ < REP(1); ++rep_) {
                unsigned char* ws = ap->ws; const int j = L >> 1;
                LAS int* ul = (LAS int*)(lds + MISC_OFF + MO_ULIST);
                pg8::build_units_dense(tid, ul, NTOK / 256, HG_IN / 256, DM * 2);
                pg8::EpiHgrnIn E{ws, L};
                pg8::gemm_phase<pg8::EpiHgrnIn, false, true, false>(tid, lds, ul, (LAS int*)(lds + MISC_OFF + MO_GTAB), (const char*)(ws + WS_XB), (const char*)((bf16*)(ws + WS_W_HIN) + (size_t)j * HG_IN * DM), nullptr, DM * 2, E, lds + MISC_OFF + MO_GTAB);
                GRID_BAR();
            } }
#endif
#if SITE(2)
            { KArgs ap = kargs(); const int tid = otid(wave0); LAS unsigned char* lds = olds(lds0); (void)tid;
            if (IN(pb + 1)) for (int rep_ = 0; rep_ < REP(2); ++rep_) {
#if !SLOW_HGRN
                { unsigned char* ws = ap->ws; const bf16* QD = (const bf16*)(ws + WS_H);
                  hgrn_fast(tid, lds, QD, QD + (size_t)NTOK * DM, QD + 4 * (size_t)NTOK * DM, QD + 3 * (size_t)NTOK * DM, (const float*)(ws + WS_DEC), ap->in[I_HNG] + (L >> 1) * DM,
                            (bf16*)(ws + WS_A2), (float*)(ws + WS_SSP)); }
#else
                unsigned char* ws = ap->ws; const bf16* QD = (const bf16*)(ws + WS_H); const bf16* KI = QD + (size_t)NTOK * DM; const bf16* KS = QD + 2 * (size_t)NTOK * DM; const bf16* VV = QD + 3 * (size_t)NTOK * DM; bf16* OB = (bf16*)(ws + WS_O);
                LAS float* qf = (LAS float*)lds; LAS float* kf = qf + 16 * 4 * 36; LAS float* ff = kf + 16 * 4 * 36; LAS float* vf = ff + 16 * 4 * 36;
                for (int un = blockIdx.x; un < NBATCH * HG_HEADS; un += gridDim.x) {
                    const int b = un >> 3, h = un & 7; const int vc = tid >> 2, kq = tid & 3;
                    float st[32];
#pragma unroll
                    for (int i = 0; i < 32; ++i) st[i] = 0.f;
                    for (int t0 = 0; t0 < SEQ; t0 += 16) {
                        __syncthreads();
                        for (int e = tid; e < 16 * 128; e += 512) { const int tt = e >> 7, k = e & 127; const size_t gi = (size_t)(b * SEQ + t0 + tt) * DM + h * 128 + k; const int li = tt * 144 + (k & 3) * 36 + (k >> 2);
                            qf[li] = bf1(QD[gi]); kf[li] = bf1(KI[gi]); ff[li] = bf1(KS[gi]); vf[tt * 128 + k] = bf1(VV[gi]); }
                        __syncthreads();
                        for (int tt = 0; tt < 16; ++tt) {
                            const float v = vf[tt * 128 + vc]; float a = 0.f; const int lb = tt * 144 + kq * 36;
#pragma unroll
                            for (int i = 0; i < 32; ++i) { st[i] = ff[lb + i] * st[i] + kf[lb + i] * v; a += qf[lb + i] * st[i]; }
                            a += __shfl_xor(a, 1); a += __shfl_xor(a, 2);
                            if (kq == 0) OB[(size_t)(b * SEQ + t0 + tt) * DM + h * 128 + vc] = (bf16)f2bf(a);
                        }
                    }
                }
#endif
                GRID_BAR();
            } }
#endif
#if SITE(3) && SLOW_HGRN
            { KArgs ap = kargs(); const int tid = otid(wave0); LAS unsigned char* lds = olds(lds0); (void)tid;
            if (IN(pb + 2)) for (int rep_ = 0; rep_ < REP(3); ++rep_) {
                const int lane = tid & 63, wave = __builtin_amdgcn_readfirstlane(tid >> 6), gw = VCU() * 8 + wave, NGW = gridDim.x * 8;
                unsigned char* ws = ap->ws; const bf16* OB = (const bf16*)(ws + WS_O); const bf16* GG = (const bf16*)(ws + WS_H) + 4 * (size_t)NTOK * DM; bf16* A2 = (bf16*)(ws + WS_A2);
                const float* ng = ap->in[I_HNG] + (L >> 1) * DM;
                f32x4 g4[4];
#pragma unroll
                for (int q = 0; q < 4; ++q) g4[q] = *(const f32x4*)(ng + 256 * q + 4 * lane);
                v2u on[4], gn[4];
#pragma unroll
                for (int q = 0; q < 4; ++q) { on[q] = *(const v2u*)(OB + (size_t)gw * DM + 256 * q + 4 * lane); gn[q] = *(const v2u*)(GG + (size_t)gw * DM + 256 * q + 4 * lane); }
#pragma unroll 1
                for (int row = gw; row < NTOK; row += NGW) {
                    v2u oc[4], gc[4];
#pragma unroll
                    for (int q = 0; q < 4; ++q) { oc[q] = on[q]; gc[q] = gn[q]; }
                    if (row + NGW < NTOK) {
#pragma unroll
                        for (int q = 0; q < 4; ++q) { on[q] = *(const v2u*)(OB + (size_t)(row + NGW) * DM + 256 * q + 4 * lane); gn[q] = *(const v2u*)(GG + (size_t)(row + NGW) * DM + 256 * q + 4 * lane); } }
                    float o[16]; float ss = 0.f;
#pragma unroll
                    for (int q = 0; q < 4; ++q) { o[4 * q] = bflo(oc[q].x); o[4 * q + 1] = bfhi(oc[q].x); o[4 * q + 2] = bflo(oc[q].y); o[4 * q + 3] = bfhi(oc[q].y); }
#pragma unroll
                    for (int i = 0; i < 16; ++i) ss += o[i] * o[i];
                    const float rs = 1.0f / sqrtf(wave_sum(ss) * (1.0f / DM) + RMS_EPS);
#pragma unroll
                    for (int q = 0; q < 4; ++q) {
                        v2u w; w.x = pk2(o[4 * q] * rs * g4[q][0] * bflo(gc[q].x), o[4 * q + 1] * rs * g4[q][1] * bfhi(gc[q].x)); w.y = pk2(o[4 * q + 2] * rs * g4[q][2] * bflo(gc[q].y), o[4 * q + 3] * rs * g4[q][3] * bfhi(gc[q].y));
                        *(v2u*)(A2 + (size_t)row * DM + 256 * q + 4 * lane) = w; }
                }
                GRID_BAR();
            } }
#endif
        } else {
#if SITE(4)
            { KArgs ap = kargs(); const int tid = otid(wave0); LAS unsigned char* lds = olds(lds0); (void)tid;
            if (IN(pb + 0)) for (int rep_ = 0; rep_ < REP(4); ++rep_) {
                unsigned char* ws = ap->ws; const int j = L >> 1;
                LAS int* ul = (LAS int*)(lds + MISC_OFF + MO_ULIST);
                pg8::build_units_dense(tid, ul, NTOK / 256, RT_IN / 256, DM * 2);
                pg8::EpiRetIn E{ws};
                pg8::gemm_phase<pg8::EpiRetIn, false, true, false>(tid, lds, ul, (LAS int*)(lds + MISC_OFF + MO_GTAB), (const char*)(ws + WS_XB), (const char*)((bf16*)(ws + WS_W_RIN) + (size_t)j * RT_IN * DM), nullptr, DM * 2, E);
                GRID_BAR();
            } }
#endif
#if SITE(5)
            { KArgs ap = kargs(); const int tid = otid(wave0); LAS unsigned char* lds = olds(lds0); (void)tid;
            if (IN(pb + 1)) for (int rep_ = 0; rep_ < REP(5); ++rep_) {
#if !SLOW_RET
                { unsigned char* ws = ap->ws; ret_fast(tid, lds, (const bf16*)(ws + WS_H), (bf16*)(ws + WS_O)); }
#else
                unsigned char* ws = ap->ws; const bf16* HB = (const bf16*)(ws + WS_H); bf16* OB = (bf16*)(ws + WS_O);
                LAS float* qf = (LAS float*)lds; LAS float* kf = qf + 16 * 4 * 68; LAS float* vf = kf + 16 * 4 * 68;
                for (int un = blockIdx.x; un < NBATCH * RT_HEADS * 4; un += gridDim.x) {
                    const int b = un >> 4, h = (un >> 2) & 3, vq = un & 3; const int vc = tid >> 2, kq = tid & 3;
                    const float gam = 1.0f - exp2f(-5.0f - (float)h);
                    float st[64];
#pragma unroll
                    for (int i = 0; i < 64; ++i) st[i] = 0.f;
                    for (int t0 = 0; t0 < SEQ; t0 += 16) {
                        __syncthreads();
                        for (int e = tid; e < 16 * 256; e += 512) { const int tt = e >> 8, k = e & 255; const size_t gi = (size_t)(b * SEQ + t0 + tt) * RT_IN + h * 256 + k; const int li = tt * 272 + (k & 3) * 68 + (k >> 2);
                            qf[li] = bf1(HB[gi]); kf[li] = bf1(HB[gi + 1024]); }
                        for (int e = tid; e < 16 * 128; e += 512) { const int tt = e >> 7, c = e & 127; vf[e] = bf1(HB[(size_t)(b * SEQ + t0 + tt) * RT_IN + 2048 + h * 512 + vq * 128 + c]); }
                        __syncthreads();
                        for (int tt = 0; tt < 16; ++tt) {
                            const float v = vf[tt * 128 + vc]; float a = 0.f; const int lb = tt * 272 + kq * 68;
#pragma unroll
                            for (int i = 0; i < 64; ++i) { st[i] = gam * st[i] + kf[lb + i] * v; a += qf[lb + i] * st[i]; }
                            a += __shfl_xor(a, 1); a += __shfl_xor(a, 2);
                            if (kq == 0) OB[(size_t)(b * SEQ + t0 + tt) * RT_VD + h * 512 + vq * 128 + vc] = (bf16)f2bf(a);
                        }
                    }
                }
#endif
                GRID_BAR();
            } }
#endif
#if SITE(6)
            { KArgs ap = kargs(); const int tid = otid(wave0); LAS unsigned char* lds = olds(lds0); (void)tid;
            if (IN(pb + 2)) for (int rep_ = 0; rep_ < REP(6); ++rep_) {
                const int lane = tid & 63, wave = __builtin_amdgcn_readfirstlane(tid >> 6), gw = VCU() * 8 + wave, NGW = gridDim.x * 8;
                unsigned char* ws = ap->ws; const bf16* OB = (const bf16*)(ws + WS_O); const bf16* HB = (const bf16*)(ws + WS_H); bf16* A2 = (bf16*)(ws + WS_A2);
                v2u on[4], gn[4];
#pragma unroll
                for (int h = 0; h < 4; ++h) { on[h] = *(const v2u*)((const unsigned char*)OB + (size_t)gw * RT_VD + 512 * h + 8 * lane); gn[h] = *(const v2u*)((const unsigned char*)HB + (size_t)gw * (RT_IN * 2) + 8192 + 512 * h + 8 * lane); }
#pragma unroll 1
                for (int row = gw; row < NTOK; row += NGW) {
                    v2u oc[4], gc[4];
#pragma unroll
                    for (int h = 0; h < 4; ++h) { oc[h] = on[h]; gc[h] = gn[h]; }
                    if (row + NGW < NTOK) {
#pragma unroll
                        for (int h = 0; h < 4; ++h) { on[h] = *(const v2u*)((const unsigned char*)OB + (size_t)(row + NGW) * RT_VD + 512 * h + 8 * lane); gn[h] = *(const v2u*)((const unsigned char*)HB + (size_t)(row + NGW) * (RT_IN * 2) + 8192 + 512 * h + 8 * lane); } }
#pragma unroll
                    for (int h = 0; h < 4; ++h) {
                        const v2u w = oc[h];
                        const f32x2 o01 = __builtin_amdgcn_cvt_pk_f32_fp8((int)w.x, false), o23 = __builtin_amdgcn_cvt_pk_f32_fp8((int)w.x, true), o45 = __builtin_amdgcn_cvt_pk_f32_fp8((int)w.y, false), o67 = __builtin_amdgcn_cvt_pk_f32_fp8((int)w.y, true);
                        float o[8] = {o01[0], o01[1], o23[0], o23[1], o45[0], o45[1], o67[0], o67[1]};
                        float s = 0.f;
#pragma unroll
                        for (int i = 0; i < 8; ++i) s += o[i];
                        const float mu = wave_sum_u(s) * (1.0f / 512.0f); float q = 0.f;
#pragma unroll
                        for (int i = 0; i < 8; ++i) { o[i] -= mu; q += o[i] * o[i]; }
                        const float rs = 1.0f / sqrtf(wave_sum_u(q) * (1.0f / 512.0f) + LN_EPS * RO_SCALE * RO_SCALE);
                        const v2u g = gc[h];
                        const f32x2 g01 = __builtin_amdgcn_cvt_pk_f32_fp8((int)g.x, false), g23 = __builtin_amdgcn_cvt_pk_f32_fp8((int)g.x, true), g45 = __builtin_amdgcn_cvt_pk_f32_fp8((int)g.y, false), g67 = __builtin_amdgcn_cvt_pk_f32_fp8((int)g.y, true);
#if ROUT_FP8
                        const float r8 = rs * (8.0f / RG_SCALE); v2u r; r.x = pk4_fp8(o[0] * r8 * g01[0], o[1] * r8 * g01[1], o[2] * r8 * g23[0], o[3] * r8 * g23[1]);
                        r.y = pk4_fp8(o[4] * r8 * g45[0], o[5] * r8 * g45[1], o[6] * r8 * g67[0], o[7] * r8 * g67[1]);
                        *(v2u*)((unsigned char*)A2 + (size_t)row * RT_VD + 512 * h + 8 * lane) = r;
#else
                        v4u r; r.x = pk2(o[0] * rs * bflo(g.x), o[1] * rs * bfhi(g.x)); r.y = pk2(o[2] * rs * bflo(g.y), o[3] * rs * bfhi(g.y));
                        r.z = pk2(o[4] * rs * bflo(g.z), o[5] * rs * bfhi(g.z)); r.w = pk2(o[6] * rs * bflo(g.w), o[7] * rs * bfhi(g.w));
                        *(v4u*)(A2 + (size_t)row * RT_VD + 512 * h + 8 * lane) = r;
#endif
                    }
                }
                GRID_BAR();
            } }
#endif
        }
#if SITE(7)
        { KArgs ap = kargs(); const int tid = otid(wave0); LAS unsigned char* lds = olds(lds0); (void)tid;
        if (IN(pb + 3)) for (int rep_ = 0; rep_ < REP(7); ++rep_) {
            unsigned char* ws = ap->ws; const int j = L >> 1; const bool ret = (L & 1) != 0;
            const int Ko = ret ? RT_VD : DM;
            LAS int* ul = (LAS int*)(lds + MISC_OFF + MO_ULIST);
            if (ret && ROUT_FP8) {
                pg8::build_units_dense(tid, ul, NTOK / 256, DM / 256, RT_VD);
                pg8::EpiRes E{ws, -1, 1.0f / (8.0f * 128.0f)};
                pg8::gemm_phase<pg8::EpiRes, false, true, true>(tid, lds, ul, (LAS int*)(lds + MISC_OFF + MO_GTAB), (const char*)(ws + WS_A2), (const char*)(ws + WS_W_ROUT8 + (size_t)j * DM * RT_VD), nullptr, RT_VD, E, lds + MISC_OFF + MO_GALL);
            } else {
                pg8::build_units_dense(tid, ul, NTOK / 256, DM / 256, Ko * 2);
                const char* Bt = ret ? (const char*)((bf16*)(ws + WS_W_ROUT) + (size_t)j * DM * RT_VD) : (const char*)((bf16*)(ws + WS_W_HOUT) + (size_t)j * DM * DM);
                pg8::EpiRes E{ws, (ret || SLOW_HGRN) ? -1 : 0, 1.0f};
                pg8::gemm_phase<pg8::EpiRes, false, true, false>(tid, lds, ul, (LAS int*)(lds + MISC_OFF + MO_GTAB), (const char*)(ws + WS_A2), Bt, nullptr, Ko * 2, E, lds + MISC_OFF + MO_GALL);
            }
            GRID_BAR();
        } }
#endif
#if SITE(8)
        { KArgs ap = kargs(); const int tid = otid(wave0); LAS unsigned char* lds = olds(lds0); (void)tid;
        if (IN(pb + 4)) for (int rep_ = 0; rep_ < REP(8); ++rep_) {
            const int lane = tid & 63, wave = __builtin_amdgcn_readfirstlane(tid >> 6), r = lane & 15, g = lane >> 4;
            unsigned char* ws = ap->ws; unsigned* ctl = (unsigned*)(ws + WS_CTL);
            const bf16* Y = (const bf16*)(ws + WS_Y); bf16* X1R = (bf16*)(ws + WS_X1F); bf16* X1B = (bf16*)(ws + WS_X1B);
            int* ROWDST = (int*)(ws + WS_ROWDST); float* ROWGATE = (float*)(ws + WS_ROWGATE);
            constexpr int WP = 2064;
            LAS unsigned char* wH = lds; LAS unsigned char* wL = lds + 32 * WP;
            LAS int* lcnt = (LAS int*)(lds + MISC_OFF + MO_LCNT); LAS int* lbase = (LAS int*)(lds + MISC_OFF + MO_LBASE);
            LAS int* sel = (LAS int*)(lds + MISC_OFF + MO_SEL); LAS float* selw = (LAS float*)(lds + MISC_OFF + MO_SELW);
            const float* rb = ap->in[I_RB] + L * NE;
            const float* lg = ap->in[I_LNMG] + L * DM; const float* lbb = ap->in[I_LNMB] + L * DM;
            { const v4u* gh = (const v4u*)(ws + WS_WRH) + (size_t)L * 4096; const v4u* gl = (const v4u*)(ws + WS_WRL) + (size_t)L * 4096;
              for (int c = tid; c < 4096; c += 512) { const int e = c >> 7, cc = c & 127; *(LAS v4u*)(wH + e * WP + cc * 16) = gh[c]; *(LAS v4u*)(wL + e * WP + cc * 16) = gl[c]; } }
            const float rb0 = rb[r], rb1 = rb[16 + r];
            f32x4 g4r[4], b4r[4];
#pragma unroll
            for (int q = 0; q < 4; ++q) { g4r[q] = *(const f32x4*)(lg + 256 * q + 4 * lane); b4r[q] = *(const f32x4*)(lbb + 256 * q + 4 * lane); }
            for (int blk = VCU(); blk < NTOK / 128; blk += gridDim.x) {
                if (tid < 32) lcnt[tid] = 0;
                __syncthreads();
                const int row0 = blk * 128 + wave * 16;
                v2u xn[4];
#pragma unroll
                for (int q = 0; q < 4; ++q) xn[q] = *(const v2u*)(Y + (size_t)row0 * DM + 256 * q + 4 * lane);
#pragma unroll 1
                for (int rr = 0; rr < 16; ++rr) {
                    const int row = row0 + rr;
                    f32x4 x[4]; float s = 0.f;
#pragma unroll
                    for (int q = 0; q < 4; ++q) { x[q] = (f32x4){bflo(xn[q].x), bfhi(xn[q].x), bflo(xn[q].y), bfhi(xn[q].y)}; s += (x[q][0] + x[q][1]) + (x[q][2] + x[q][3]); }
                    if (rr + 1 < 16) {
#pragma unroll
                        for (int q = 0; q < 4; ++q) xn[q] = *(const v2u*)(Y + (size_t)(row + 1) * DM + 256 * q + 4 * lane); }
                    const float mu = wave_sum_u(s) * (1.0f / DM); float qq = 0.f;
#pragma unroll
                    for (int q = 0; q < 4; ++q) { x[q] = x[q] - mu; qq += (x[q][0] * x[q][0] + x[q][1] * x[q][1]) + (x[q][2] * x[q][2] + x[q][3] * x[q][3]); }
                    const float rs = 1.0f / sqrtf(wave_sum_u(qq) * (1.0f / DM) + LN_EPS);
#pragma unroll
                    for (int q = 0; q < 4; ++q) { x[q] = x[q] * rs * g4r[q] + b4r[q];
                        { v2u wr_; wr_.x = pk2(x[q][0], x[q][1]); wr_.y = pk2(x[q][2], x[q][3]); *(v2u*)(X1R + (size_t)row * DM + 256 * q + 4 * lane) = wr_; }
#if MOE_FP8
                        *(unsigned*)((unsigned char*)X1B + (size_t)row * DM + 256 * q + 4 * lane) = pk4_fp8(x[q][0] * X_SCALE, x[q][1] * X_SCALE, x[q][2] * X_SCALE, x[q][3] * X_SCALE); }
#else
                        v2u w; w.x = pk2(x[q][0], x[q][1]); w.y = pk2(x[q][2], x[q][3]); *(v2u*)(X1B + (size_t)row * DM + 256 * q + 4 * lane) = w; }
#endif
                }
                asm volatile("s_waitcnt vmcnt(0)" ::: "memory");
                f32x4 lgt0 = {0.f, 0.f, 0.f, 0.f}, lgt1 = {0.f, 0.f, 0.f, 0.f};
                {
                    const bf16* xa = X1R + (size_t)(row0 + r) * DM + 8 * g;
#pragma unroll 1
                    for (int kq = 0; kq < 4; ++kq) {
                        bf16x8 af[8], h0[8], h1[8], l0[8], l1[8];
#pragma unroll
                        for (int j = 0; j < 8; ++j) { const int kb = kq * 8 + j; af[j] = *(const bf16x8*)(xa + 32 * kb);
                            h0[j] = *(const LAS bf16x8*)(wH + r * WP + (32 * kb + 8 * g) * 2); h1[j] = *(const LAS bf16x8*)(wH + (16 + r) * WP + (32 * kb + 8 * g) * 2);
                            l0[j] = *(const LAS bf16x8*)(wL + r * WP + (32 * kb + 8 * g) * 2); l1[j] = *(const LAS bf16x8*)(wL + (16 + r) * WP + (32 * kb + 8 * g) * 2); }
#pragma unroll
                        for (int j = 0; j < 8; ++j) { lgt0 = MFMA32(af[j], h0[j], lgt0); lgt1 = MFMA32(af[j], h1[j], lgt1); lgt0 = MFMA32(af[j], l0[j], lgt0); lgt1 = MFMA32(af[j], l1[j], lgt1); }
                    }
                }
                asm volatile("s_nop 7\n\ts_nop 7" : "+v"(lgt0), "+v"(lgt1));
#pragma unroll
                for (int i = 0; i < 4; ++i) {
                    float v0 = lgt0[i] + rb0, v1 = lgt1[i] + rb1; int se[4]; float sv[4];
#pragma unroll
                    for (int k = 0; k < 4; ++k) {
                        float m = fmaxf(v0, v1);
                        m = fmaxf(m, dppf<0xB1>(m)); m = fmaxf(m, dppf<0x4E>(m)); m = fmaxf(m, dppf<0x141>(m)); m = fmaxf(m, dppf<0x140>(m));
                        int ec = (v0 == m) ? r : ((v1 == m) ? 16 + r : 99);
                        ec = min(ec, dppi<0xB1>(ec)); ec = min(ec, dppi<0x4E>(ec)); ec = min(ec, dppi<0x141>(ec)); ec = min(ec, dppi<0x140>(ec));
                        se[k] = ec; sv[k] = m;
                        if (ec == r) v0 = -3.0e38f;
                        if (ec == 16 + r) v1 = -3.0e38f;
                    }
                    const float e1 = __expf(sv[1] - sv[0]), e2 = __expf(sv[2] - sv[0]), e3 = __expf(sv[3] - sv[0]); const float inv = 1.0f / (1.0f + e1 + e2 + e3);
                    if (r < 4) { const int rloc = wave * 16 + 4 * g + i; const int ee = r == 0 ? se[0] : (r == 1 ? se[1] : (r == 2 ? se[2] : se[3])); const float ww = (r == 0 ? 1.0f : (r == 1 ? e1 : (r == 2 ? e2 : e3))) * inv;
                        sel[rloc * 4 + r] = ee; selw[rloc * 4 + r] = ww; }
                }
                __syncthreads();
                const int myE = sel[tid]; const int rank = __hip_atomic_fetch_add(lcnt + myE, 1, __ATOMIC_RELAXED, __HIP_MEMORY_SCOPE_WORKGROUP);
                __syncthreads();
                if (tid < 32) lbase[tid] = (int)__hip_atomic_fetch_add(ctl + CW_ECNT + (L + 4 * rep_) * 32 + tid, (unsigned)lcnt[tid], RLX_AGENT);
                __syncthreads();
                { const int pos = lbase[myE] + rank; const size_t ti = (size_t)myE * ECAP + pos; ROWDST[ti] = (blk * 128 + (tid >> 2)) * 4 + (tid & 3); ROWGATE[ti] = selw[tid]; }
                __syncthreads();
            }
            GRID_BAR();
        } }
#endif
#if SITE(9)
        { KArgs ap = kargs(); const int tid = otid(wave0); LAS unsigned char* lds = olds(lds0); (void)tid;
        if (IN(pb + 5)) for (int rep_ = 0; rep_ < REP(9); ++rep_) {
            unsigned char* ws = ap->ws; unsigned* ctl = (unsigned*)(ws + WS_CTL);
            LAS int* tpre = (LAS int*)(lds + MISC_OFF + MO_TPRE); LAS int* ebase = (LAS int*)(lds + MISC_OFF + MO_EBASE); LAS int* ecnt = (LAS int*)(lds + MISC_OFF + MO_ECNT);
            if (tid < NE) ecnt[tid] = (int)__hip_atomic_load(ctl + CW_ECNT + L * 32 + tid, RLX_AGENT);
            __syncthreads();
            if (tid < 64) {
                const int tl = (tid < NE) ? ((ecnt[tid < NE ? tid : 0] + 255) >> 8) : 0; int sfx = tl;
#pragma unroll
                for (int k = 1; k < 32; k <<= 1) { const int up = __shfl_up(sfx, k, 64); if ((tid & 63) >= k) sfx += up; }
                if (tid < NE) { tpre[tid] = sfx - tl; ebase[tid] = (sfx - tl) * 256; }
                if (tid == NE - 1) tpre[NE] = sfx; }
            __syncthreads();
            LAS int* ul = (LAS int*)(lds + MISC_OFF + MO_ULIST);
            constexpr int EB = MOE_FP8 ? 1 : 2;
            pg8::build_units_moe(tid, ul, tpre, ebase, ecnt, 8, DM * EB, 2048u * DM * EB);
            { LAS int* gall = (LAS int*)(lds + MISC_OFF + MO_GALL); const int* rd = (const int*)(ws + WS_ROWDST);
              for (int i = tid; i < GALL_UNITS * 256; i += 512) { const int uu = i >> 8, rr = i & 255;
                  if (ul[uu * 8 + 0]) gall[i] = (int)((unsigned)rd[ul[uu * 8 + 7] + min(rr, ul[uu * 8 + 5] - 1)] >> 2); }
              __syncthreads(); }
            pg8::EpiMoeGU E{ws, L};
            pg8::gemm_phase<pg8::EpiMoeGU, true, true, MOE_FP8 != 0>(tid, lds, ul, (LAS int*)(lds + MISC_OFF + MO_GALL), (const char*)(ws + WS_X1B), (const char*)(ws + WS_W_GU + (size_t)L * NE * 2048 * DM * EB), (const int*)(ws + WS_ROWDST), DM * EB, E, lds + MISC_OFF + MO_GTAB);
            GRID_BAR();
        } }
#endif
#if SITE(10)
        { KArgs ap = kargs(); const int tid = otid(wave0); LAS unsigned char* lds = olds(lds0); (void)tid;
        if (IN(pb + 6)) for (int rep_ = 0; rep_ < REP(10); ++rep_) {
            unsigned char* ws = ap->ws; unsigned* ctl = (unsigned*)(ws + WS_CTL);
            LAS int* tpre = (LAS int*)(lds + MISC_OFF + MO_TPRE); LAS int* ebase = (LAS int*)(lds + MISC_OFF + MO_EBASE); LAS int* ecnt = (LAS int*)(lds + MISC_OFF + MO_ECNT);
            __syncthreads();
            if (tid < NE) ecnt[tid] = (int)__hip_atomic_load(ctl + CW_ECNT + L * 32 + tid, RLX_AGENT);
            __syncthreads();
            if (tid < 64) {
                const int tl = (tid < NE) ? ((ecnt[tid < NE ? tid : 0] + 255) >> 8) : 0; int sfx = tl;
#pragma unroll
                for (int k = 1; k < 32; k <<= 1) { const int up = __shfl_up(sfx, k, 64); if ((tid & 63) >= k) sfx += up; }
                if (tid < NE) { tpre[tid] = sfx - tl; ebase[tid] = (sfx - tl) * 256; }
                if (tid == NE - 1) tpre[NE] = sfx; }
            __syncthreads();
            LAS int* ul = (LAS int*)(lds + MISC_OFF + MO_ULIST);
            constexpr int EB = MOE_FP8 ? 1 : 2;
            pg8::build_units_moe(tid, ul, tpre, ebase, ecnt, 4, DM * EB, (unsigned)DM * DM * EB);
            pg8::EpiMoeDown E{ws, ap->in[I_BDN] + (size_t)L * NE * DM};
            pg8::gemm_phase<pg8::EpiMoeDown, false, true, MOE_FP8 != 0>(tid, lds, ul, (LAS int*)(lds + MISC_OFF + MO_GTAB), (const char*)(ws + WS_ACT), (const char*)(ws + WS_W_DN + (size_t)L * NE * DM * DM * EB), nullptr, DM * EB, E, lds + MISC_OFF + MO_GALL);
            GRID_BAR();
        } }
#endif
#if SITE(11)
        { KArgs ap = kargs(); const int tid = otid(wave0); LAS unsigned char* lds = olds(lds0); (void)tid;
        if (IN(pb + 7)) for (int rep_ = 0; rep_ < REP(11); ++rep_) {
            const int lane = tid & 63, wave = __builtin_amdgcn_readfirstlane(tid >> 6), gw = VCU() * 8 + wave, NGW = gridDim.x * 8;
            unsigned char* ws = ap->ws; const bf16* X1R = (const bf16*)(ws + WS_X1F); const bf16* YS = (const bf16*)(ws + WS_YSLOT); bf16* XB = (bf16*)(ws + WS_XB); float* out = ap->out;
            const float* lg = ap->in[I_LNFG] + L * DM; const float* lbb = ap->in[I_LNFB] + L * DM;
#if YS_FP8
            typedef unsigned ys_t; constexpr int YSB = 1;
#else
            typedef v2u ys_t; constexpr int YSB = 2;
#endif
            v2u xn[4]; f32x4 g4[4], b4[4]; ys_t yn[4][4];
#pragma unroll
            for (int q = 0; q < 4; ++q) { g4[q] = *(const f32x4*)(lg + 256 * q + 4 * lane); b4[q] = *(const f32x4*)(lbb + 256 * q + 4 * lane); xn[q] = *(const v2u*)(X1R + (size_t)gw * DM + 256 * q + 4 * lane);
#pragma unroll
                for (int k = 0; k < 4; ++k) yn[q][k] = *(const ys_t*)((const unsigned char*)YS + (((size_t)gw * 4 + k) * DM + 256 * q + 4 * lane) * YSB); }
#pragma unroll 1
            for (int row = gw; row < NTOK; row += NGW) {
                f32x4 x[4]; ys_t yc[4][4]; float s = 0.f;
#pragma unroll
                for (int q = 0; q < 4; ++q) { x[q] = (f32x4){bflo(xn[q].x), bfhi(xn[q].x), bflo(xn[q].y), bfhi(xn[q].y)} * DN_ALPHA;
#pragma unroll
                    for (int k = 0; k < 4; ++k) yc[q][k] = yn[q][k]; }
                if (row + NGW < NTOK) {
#pragma unroll
                    for (int q = 0; q < 4; ++q) { xn[q] = *(const v2u*)(X1R + (size_t)(row + NGW) * DM + 256 * q + 4 * lane);
#pragma unroll
                        for (int k = 0; k < 4; ++k) yn[q][k] = *(const ys_t*)((const unsigned char*)YS + (((size_t)(row + NGW) * 4 + k) * DM + 256 * q + 4 * lane) * YSB); } }
#pragma unroll
                for (int q = 0; q < 4; ++q) {
#pragma unroll
#if YS_FP8
                    for (int k = 0; k < 4; ++k) { const f32x2 lo = __builtin_amdgcn_cvt_pk_f32_fp8((int)yc[q][k], false), hi = __builtin_amdgcn_cvt_pk_f32_fp8((int)yc[q][k], true);
                        x[q][0] += lo[0] * 0.015625f; x[q][1] += lo[1] * 0.015625f; x[q][2] += hi[0] * 0.015625f; x[q][3] += hi[1] * 0.015625f; }
#else
                    for (int k = 0; k < 4; ++k) { const v2u w = yc[q][k]; x[q][0] += bflo(w.x); x[q][1] += bfhi(w.x); x[q][2] += bflo(w.y); x[q][3] += bfhi(w.y); }
#endif
                    s += (x[q][0] + x[q][1]) + (x[q][2] + x[q][3]); }
                const float mu = wave_sum_u(s) * (1.0f / DM); float qq = 0.f;
#pragma unroll
                for (int q = 0; q < 4; ++q) { x[q] = x[q] - mu; qq += (x[q][0] * x[q][0] + x[q][1] * x[q][1]) + (x[q][2] * x[q][2] + x[q][3] * x[q][3]); }
                const float rs = 1.0f / sqrtf(wave_sum_u(qq) * (1.0f / DM) + LN_EPS);
#pragma unroll
                for (int q = 0; q < 4; ++q) { x[q] = x[q] * rs * g4[q] + b4[q];
                    if (L + 1 == DEPTH) __builtin_nontemporal_store(x[q], (f32x4*)(out + (size_t)row * DM + 256 * q + 4 * lane));
                    else { v2u w; w.x = pk2(x[q][0], x[q][1]); w.y = pk2(x[q][2], x[q][3]); *(v2u*)(XB + (size_t)row * DM + 256 * q + 4 * lane) = w; } }
            }
            if (L + 1 < DEPTH) GRID_BAR();
        } }
#endif
    }
#undef IN
#undef GRID_BAR
}

extern "C" void kernel_launch(void* const* d_in, const int* in_sizes, int n_in, void* d_out, int out_size, void* d_ws, size_t ws_size, hipStream_t stream) {
    static int grid = 0;
    if (grid == 0) {
        if (n_in != 17 || out_size != NTOK * DM || ws_size < WS_END) { fprintf(stderr, "kernel_launch: unexpected shapes (n_in %d, out %d, ws %zu < %zu)\n", n_in, out_size, ws_size, (size_t)WS_END); grid = -1; return; }
        int dev = 0, cus = 0, per_cu = 0;
        if (hipGetDevice(&dev) != hipSuccess || hipDeviceGetAttribute(&cus, hipDeviceAttributeMultiprocessorCount, dev) != hipSuccess) { grid = -1; return; }
        if (hipFuncSetAttribute((const void*)mk_fwd, hipFuncAttributeMaxDynamicSharedMemorySize, LDS_BYTES) != hipSuccess) { fprintf(stderr, "kernel_launch: hipFuncSetAttribute failed\n"); grid = -1; return; }
        if (hipOccupancyMaxActiveBlocksPerMultiprocessor(&per_cu, (const void*)mk_fwd, 512, LDS_BYTES) != hipSuccess || per_cu < 1) { fprintf(stderr, "kernel_launch: occupancy query says %d\n", per_cu); }
        (void)hipGetLastError();
        grid = cus;
    }
    if (grid < 0) return;
    (void)hipMemsetAsync((char*)d_ws + WS_CTL, 0, CTL_ZERO_BYTES, stream);
    Args a{};
    for (int i = 0; i < 17; ++i) a.in[i] = (const float*)d_in[i];
    a.out = (float*)d_out; a.ws = (unsigned char*)d_ws;
#if MK_MULTI
    for (int p = 0; p < 1 + 8 * DEPTH; ++p) { a.ph_lo = p; a.ph_hi = p + 1; hipLaunchKernelGGL(mk_fwd, dim3(grid), dim3(512), LDS_BYTES, stream, a); }
#else
    a.ph_lo = 0; a.ph_hi = 1 + 8 * DEPTH;
    hipLaunchKernelGGL(mk_fwd, dim3(grid), dim3(512), LDS_BYTES, stream, a);
#endif
}
```
